# Optimizing an MI355X kernel written in HIP

```python
import jax, jax.numpy as jnp
from jax import lax
import numpy as np

D_MODEL = 1024
BATCH = 32
SEQ = 2048
DEPTH = 4

GRID_W = 64
CTX_LEN = 256
N_MIXERS = 2
HEAD_SIZE = 64
N_HEADS = D_MODEL // HEAD_SIZE
DECAY_LORA = 64
ICLR_LORA = 64
VRES_LORA = 32
GATE_LORA = 128
GN_EPS = 64e-5
N_DIR = 2
CHUNK = 128
SG_GROUPS = 16
SG_FFN = 4 * D_MODEL
SG_HALF = SG_FFN // 2
N_EXPERTS = 16
N_EXPERT_GROUPS = 4
TOP_K = 2
EXPERT_FFN = 512
N_MOD = 6
NORM_EPS = 1e-6
LN_EPS = 1e-5

kernel_name = "hybrid_rwkv7_chunksgu_groupmoe_prefix"


def rms_norm(x, g):
    xf = x.astype(jnp.float32)
    y = xf * lax.rsqrt(jnp.mean(xf * xf, axis=-1, keepdims=True) + NORM_EPS)
    return (y * g.astype(jnp.float32)).astype(x.dtype)


def layer_norm(x, g, b):
    xf = x.astype(jnp.float32)
    mu = jnp.mean(xf, axis=-1, keepdims=True)
    var = jnp.mean(jnp.square(xf - mu), axis=-1, keepdims=True)
    return ((xf - mu) * lax.rsqrt(var + LN_EPS) * g.astype(jnp.float32) + b.astype(jnp.float32)).astype(x.dtype)


def modulation(cvec, w, b):
    m = jax.nn.silu(cvec) @ w + b
    m = m.reshape(-1, 1, N_MOD, m.shape[-1] // N_MOD)
    return tuple(m[:, :, j, :] for j in range(N_MOD))


def ada_norm(x, g, shift, scale):
    return rms_norm(x, g) * (1 + scale) + shift


def shift_1d(x):
    half = x.shape[-1] // 2
    prev = jnp.pad(x[:, :-1, :half], ((0, 0), (1, 0), (0, 0)))
    nxt = jnp.pad(x[:, 1:, half:], ((0, 0), (0, 1), (0, 0)))
    return jnp.concatenate([prev, nxt], axis=-1)


def shift_grid(x):
    B, L, D = x.shape
    rows = L // GRID_W
    q = D // 4
    g = x.reshape(B, rows, GRID_W, D)
    left = jnp.pad(g[:, :, :-1, :q], ((0, 0), (0, 0), (1, 0), (0, 0)))
    right = jnp.pad(g[:, :, 1:, q:2 * q], ((0, 0), (0, 0), (0, 1), (0, 0)))
    up = jnp.pad(g[:, :-1, :, 2 * q:3 * q], ((0, 0), (1, 0), (0, 0), (0, 0)))
    down = jnp.pad(g[:, 1:, :, 3 * q:], ((0, 0), (0, 1), (0, 0), (0, 0)))
    return jnp.concatenate([left, right, up, down], axis=-1).reshape(B, L, D)


def wkv_scan(decay, k, v, kk, a, r, s0, reverse):
    seq = [decay, k, v, kk, a] + ([] if r is None else [r])
    xs = tuple(jnp.moveaxis(t, 1, 0) for t in seq)

    def step(s, inp):
        w_t, k_t, v_t, kk_t, a_t = inp[:5]
        sa = jnp.einsum('bhvk,bhk->bhv', s, kk_t)
        s = (s * w_t[:, :, None, :]
             - sa[..., None] * (kk_t * a_t)[:, :, None, :]
             + v_t[..., None] * k_t[:, :, None, :])
        y = None if r is None else jnp.einsum('bhvk,bhk->bhv', s, inp[5])
        return s, y

    s_fin, ys = lax.scan(step, s0, xs, reverse=reverse)
    return (None if r is None else jnp.moveaxis(ys, 0, 1)), s_fin


def rwkv7_bidir(h_ctx, h_lat, v_first, ctx_out, mu, w_r, w_k, w_v, w_o, w0, w1, w2, a0, a1, a2, vres,
                g1, g2, k_k, k_a, r_k, lnx_g, lnx_b):
    B, Lc, D = h_ctx.shape
    H, N = N_HEADS, HEAD_SIZE
    lo = 0 if ctx_out else Lc
    h = jnp.concatenate([h_ctx, h_lat], axis=1)
    xx = jnp.concatenate([shift_1d(h_ctx), shift_grid(h_lat)], axis=1) - h
    xw, xk, xv, xa = (h + xx * mu[j] for j in (1, 2, 3, 4))
    xr = h[:, lo:] + xx[:, lo:] * mu[0]
    xg = h[:, lo:] + xx[:, lo:] * mu[5]
    k = xk @ w_k
    v = xv @ w_v
    if v_first is None:
        v_first = v
    else:
        v0, v1, v2 = vres
        v = v + (v_first - v) * jax.nn.sigmoid(v0 + (xv @ v1) @ v2)
    r = xr @ w_r
    g = jax.nn.sigmoid(xg @ g1) @ g2

    heads = lambda t: t.reshape(B, -1, H, N).astype(jnp.float32)
    r_h, v_h, k_h = heads(r), heads(v), heads(k)
    kk = heads(k * k_k)
    kk = kk / jnp.maximum(jnp.sqrt(jnp.sum(kk * kk, axis=-1, keepdims=True)), 1e-12)
    k_a_h = k_a.reshape(H, N).astype(jnp.float32)
    r_k_f = r_k.astype(jnp.float32)
    s_zero = jnp.zeros((B, H, N, N), jnp.float32)
    rc = r_h[:, :Lc] if ctx_out else None
    rl = r_h[:, Lc - lo:]

    y = None
    bonus = None
    for d in range(N_DIR):
        w_log = -jax.nn.softplus(-(w0[d] + jnp.tanh(xw @ w1[d]) @ w2[d])) - 0.5
        decay = jnp.exp(-jnp.exp(heads(w_log)))
        a = heads(jax.nn.sigmoid(a0[d] + (xa @ a1[d]) @ a2[d]))
        k_d = k_h * (1 + (a - 1) * k_a_h)
        rev = d == 1
        yc, s_ctx = wkv_scan(decay[:, :Lc], k_d[:, :Lc], v_h[:, :Lc], kk[:, :Lc], a[:, :Lc], rc, s_zero, rev)
        yl, _ = wkv_scan(decay[:, Lc:], k_d[:, Lc:], v_h[:, Lc:], kk[:, Lc:], a[:, Lc:], rl, s_ctx, rev)
        y_d = jnp.concatenate([yc, yl], axis=1) if ctx_out else yl
        b_d = jnp.sum(r_h * k_d[:, lo:] * r_k_f, axis=-1, keepdims=True) * v_h[:, lo:]
        y = y_d if y is None else y + y_d
        bonus = b_d if bonus is None else bonus + b_d

    mean = jnp.mean(y, axis=-1, keepdims=True)
    var = jnp.mean(jnp.square(y - mean), axis=-1, keepdims=True)
    y = ((y - mean) * lax.rsqrt(var + GN_EPS)).reshape(B, -1, D) * lnx_g + lnx_b + bonus.reshape(B, -1, D)
    out = (y.astype(h.dtype) * g) @ w_o
    if ctx_out:
        return out[:, :Lc], out[:, Lc:], v_first
    return None, out, v_first


def chunk_sgu(h, w_in, b_in, ln_g, ln_b, w_s, b_s, w_out):
    B, L, _ = h.shape
    z = jax.nn.gelu(h @ w_in + b_in, approximate=False)
    u, v = jnp.split(z, 2, axis=-1)
    v = layer_norm(v, ln_g, ln_b)
    vc = v.reshape(B, L // CHUNK, CHUNK, SG_GROUPS, SG_HALF // SG_GROUPS)
    vs = jnp.einsum('gij,bcjgd->bcigd', w_s, vc) + b_s.T[:, :, None]
    return (u * vs.reshape(B, L, SG_HALF)) @ w_out


def moe_ffn(h, w_router, router_bias, w_gate, w_up, w_down):
    shp = h.shape
    t = h.reshape(-1, shp[-1])
    T = t.shape[0]
    scores = jax.nn.sigmoid((t @ w_router).astype(jnp.float32))
    biased = (scores + router_bias.astype(jnp.float32)).reshape(T, N_EXPERT_GROUPS, -1)
    group_score = jnp.sum(lax.top_k(biased, TOP_K)[0], axis=-1)
    best_group = jnp.argmax(group_score, axis=-1)
    in_group = jnp.arange(N_EXPERT_GROUPS)[None, :] == best_group[:, None]
    masked = jnp.where(in_group[:, :, None], biased, -jnp.inf).reshape(T, N_EXPERTS)
    _, idx = lax.top_k(masked, TOP_K)
    wts = jnp.take_along_axis(scores, idx, axis=-1)
    wts = wts / jnp.sum(wts, axis=-1, keepdims=True)
    gates = jnp.sum(jax.nn.one_hot(idx, N_EXPERTS, dtype=jnp.float32) * wts[..., None], axis=1).astype(t.dtype)
    out = jnp.zeros_like(t)
    for e in range(N_EXPERTS):
        he = jax.nn.silu(t @ w_gate[e]) * (t @ w_up[e])
        out = out + gates[:, e:e + 1] * (he @ w_down[e])
    return out.reshape(shp)


def setup_inputs(seed: int = 0) -> dict:
    key = jax.random.key(seed)
    ks = iter(jax.random.split(key, 64))
    D, E, F = D_MODEL, N_EXPERTS, EXPERT_FFN
    n_a = (DEPTH + N_MIXERS - 1) // N_MIXERS
    n_b = DEPTH // N_MIXERS
    n_v = max(n_a - 1, 0)

    def nrm(shape, scale):
        return jax.random.normal(next(ks), shape, jnp.float32) * scale

    def uni(shape, lo, hi):
        return jax.random.uniform(next(ks), shape, jnp.float32, lo, hi)

    return {
        "x": nrm((BATCH, SEQ, D), 1.0),
        "c": nrm((BATCH, D), 1.0),
        "ctx": nrm((BATCH, CTX_LEN, D), 1.0),
        "c_ctx": nrm((D,), 1.0),
        "w_mod": nrm((DEPTH, D, N_MOD * D), 0.5 * D ** -0.5),
        "b_mod": nrm((DEPTH, N_MOD * D), 0.02),
        "norm1_g": 1.0 + nrm((DEPTH, D), 0.05),
        "norm2_g": 1.0 + nrm((DEPTH, D), 0.05),
        "rw_mu": uni((n_a, 6, D), 0.2, 0.8),
        "rw_wr": nrm((n_a, D, D), D ** -0.5),
        "rw_wk": nrm((n_a, D, D), D ** -0.5),
        "rw_wv": nrm((n_a, D, D), D ** -0.5),
        "rw_wo": nrm((n_a, D, D), D ** -0.5),
        "rw_w0": uni((n_a, N_DIR, D), -6.0, 0.0),
        "rw_w1": nrm((n_a, N_DIR, D, DECAY_LORA), D ** -0.5),
        "rw_w2": nrm((n_a, N_DIR, DECAY_LORA, D), 0.1 * DECAY_LORA ** -0.5),
        "rw_a0": nrm((n_a, N_DIR, D), 0.5),
        "rw_a1": nrm((n_a, N_DIR, D, ICLR_LORA), D ** -0.5),
        "rw_a2": nrm((n_a, N_DIR, ICLR_LORA, D), 0.3 * ICLR_LORA ** -0.5),
        "rw_v0": nrm((n_v, D), 0.5),
        "rw_v1": nrm((n_v, D, VRES_LORA), D ** -0.5),
        "rw_v2": nrm((n_v, VRES_LORA, D), 0.3 * VRES_LORA ** -0.5),
        "rw_g1": nrm((n_a, D, GATE_LORA), D ** -0.5),
        "rw_g2": nrm((n_a, GATE_LORA, D), GATE_LORA ** -0.5),
        "rw_kk": 0.85 + nrm((n_a, D), 0.05),
        "rw_ka": 1.0 + nrm((n_a, D), 0.05),
        "rw_rk": nrm((n_a, N_HEADS, HEAD_SIZE), 0.1),
        "rw_lnx_g": 1.0 + nrm((n_a, D), 0.05),
        "rw_lnx_b": nrm((n_a, D), 0.01),
        "sg_w_in": nrm((n_b, D, SG_FFN), D ** -0.5),
        "sg_b_in": nrm((n_b, SG_FFN), 0.02),
        "sg_ln_g": 1.0 + nrm((n_b, SG_HALF), 0.05),
        "sg_ln_b": nrm((n_b, SG_HALF), 0.01),
        "sg_w_s": nrm((n_b, SG_GROUPS, CHUNK, CHUNK), CHUNK ** -0.5),
        "sg_b_s": 1.0 + nrm((n_b, SG_GROUPS, CHUNK), 0.1),
        "sg_w_out": nrm((n_b, SG_HALF, D), SG_HALF ** -0.5),
        "w_router": nrm((D, E), D ** -0.5),
        "router_bias": nrm((E,), 0.01),
        "ex_w_gate": nrm((DEPTH, E, D, F), D ** -0.5),
        "ex_w_up": nrm((DEPTH, E, D, F), D ** -0.5),
        "ex_w_down": nrm((DEPTH, E, F, D), F ** -0.5),
        "final_g": 1.0 + nrm((D,), 0.05),
    }


def reference(x, c, ctx, c_ctx, w_mod, b_mod, norm1_g, norm2_g, rw_mu, rw_wr, rw_wk, rw_wv, rw_wo,
              rw_w0, rw_w1, rw_w2, rw_a0, rw_a1, rw_a2, rw_v0, rw_v1, rw_v2, rw_g1, rw_g2, rw_kk, rw_ka,
              rw_rk, rw_lnx_g, rw_lnx_b, sg_w_in, sg_b_in, sg_ln_g, sg_ln_b, sg_w_s, sg_b_s, sg_w_out,
              w_router, router_bias, ex_w_gate, ex_w_up, ex_w_down, final_g):
    x_lat, x_ctx = x, ctx
    Lc = ctx.shape[1]
    v_first = None
    for i in range(DEPTH):
        mixer = i % N_MIXERS
        ctx_out = any(j % N_MIXERS == 0 for j in range(i + 1, DEPTH))
        ctx_live = ctx_out or mixer == 0
        sh1, sc1, gt1, sh2, sc2, gt2 = modulation(c, w_mod[i], b_mod[i])
        h_lat = ada_norm(x_lat, norm1_g[i], sh1, sc1)
        h_ctx = None
        if ctx_live:
            csh1, csc1, cgt1, csh2, csc2, cgt2 = modulation(c_ctx, w_mod[i], b_mod[i])
            h_ctx = ada_norm(x_ctx, norm1_g[i], csh1, csc1)

        if mixer == 0:
            a = i // N_MIXERS
            vres = (rw_v0[a - 1], rw_v1[a - 1], rw_v2[a - 1]) if a > 0 else None
            o_ctx, o_lat, v_first = rwkv7_bidir(
                h_ctx, h_lat, v_first, ctx_out, rw_mu[a], rw_wr[a], rw_wk[a], rw_wv[a], rw_wo[a],
                rw_w0[a], rw_w1[a], rw_w2[a], rw_a0[a], rw_a1[a], rw_a2[a], vres,
                rw_g1[a], rw_g2[a], rw_kk[a], rw_ka[a], rw_rk[a], rw_lnx_g[a], rw_lnx_b[a])
        else:
            b = i // N_MIXERS
            h_in = jnp.concatenate([h_ctx, h_lat], axis=1) if ctx_out else h_lat
            o_all = chunk_sgu(h_in, sg_w_in[b], sg_b_in[b], sg_ln_g[b], sg_ln_b[b], sg_w_s[b], sg_b_s[b],
                              sg_w_out[b])
            o_ctx, o_lat = (o_all[:, :Lc], o_all[:, Lc:]) if ctx_out else (None, o_all)

        x_lat = x_lat + gt1 * o_lat
        h_lat = ada_norm(x_lat, norm2_g[i], sh2, sc2)
        if ctx_out:
            x_ctx = x_ctx + cgt1 * o_ctx
            h_ctx = ada_norm(x_ctx, norm2_g[i], csh2, csc2)
            f = moe_ffn(jnp.concatenate([h_ctx, h_lat], axis=1), w_router, router_bias,
                        ex_w_gate[i], ex_w_up[i], ex_w_down[i])
            x_ctx = x_ctx + cgt2 * f[:, :Lc]
            x_lat = x_lat + gt2 * f[:, Lc:]
        else:
            x_lat = x_lat + gt2 * moe_ffn(h_lat, w_router, router_bias, ex_w_gate[i], ex_w_up[i], ex_w_down[i])
    return rms_norm(x_lat, final_g)
```

```cpp
#include <hip/hip_runtime.h>
#include <cstdio>
#include <cstdint>

#ifndef PER_PHASE_LAUNCH
#define PER_PHASE_LAUNCH 1
#endif

#define LAS __attribute__((address_space(3)))
typedef unsigned short bf16_t;
typedef short bf16x8 __attribute__((ext_vector_type(8)));
typedef float f32x4 __attribute__((ext_vector_type(4)));
typedef float f32x2 __attribute__((ext_vector_type(2)));
typedef float f32x16 __attribute__((ext_vector_type(16)));
typedef unsigned u32x4 __attribute__((ext_vector_type(4)));
typedef unsigned u32x2 __attribute__((ext_vector_type(2)));

constexpr int NB = 32, SEQ = 2048, LC = 256, LT = SEQ + LC, D = 1024, NH = 16;
constexpr int NG = 2, BG = NB / NG, TG = BG * LT;
constexpr int NTHREADS = 512, NWAVES = 8;
constexpr int N1CAT = 3584, K1CAT = 2048;
constexpr int NEXP = 16, FEXP = 512;

constexpr size_t al256(size_t x) { return (x + 255) & ~(size_t)255; }
constexpr int XCD_BAR_WORDS_C = 3456;
constexpr size_t WS_CTL = 0;
constexpr size_t CTL_BAR_BYTES = (size_t)XCD_BAR_WORDS_C * 4;
constexpr size_t CTL_CNT_OFF = al256(CTL_BAR_BYTES);
constexpr size_t CTL_BYTES = al256(CTL_CNT_OFF + (size_t)NG * 4 * 32 * 4);
constexpr size_t WS_X = al256(WS_CTL + CTL_BYTES);
constexpr size_t WS_VF = WS_X + (size_t)TG * D * 4;
constexpr size_t WS_MODL = WS_VF + (size_t)TG * D * 2;
constexpr size_t WS_MODC = WS_MODL + (size_t)4 * NB * 6 * D * 4;
constexpr size_t WS_W1CAT = al256(WS_MODC + (size_t)4 * 6 * D * 4);
constexpr size_t WS_WO = WS_W1CAT + (size_t)2 * N1CAT * K1CAT * 2;
constexpr size_t WS_G2T = WS_WO + (size_t)2 * D * D * 2;
constexpr size_t WS_V2T = WS_G2T + (size_t)2 * D * 256 * 2;
constexpr size_t WS_W2T = WS_V2T + (size_t)D * 256 * 2;
constexpr size_t WS_A2T = WS_W2T + (size_t)4 * D * 64 * 2;
constexpr size_t WS_WIN = WS_A2T + (size_t)4 * D * 64 * 2;
constexpr size_t WS_WOUT = WS_WIN + (size_t)2 * 4096 * D * 2;
constexpr size_t WS_WSP = WS_WOUT + (size_t)2 * D * 2048 * 2;
constexpr size_t WS_WGU = WS_WSP + (size_t)2 * 16 * 128 * 128 * 2;
constexpr size_t WS_WD = WS_WGU + (size_t)4 * NEXP * 1024 * D * 2;
constexpr size_t WS_ARENA = al256(WS_WD + (size_t)4 * NEXP * D * FEXP * 2);
constexpr size_t SZB = (size_t)TG * D * 2;
constexpr size_t AR_H2 = 0;
constexpr size_t AR_Y0 = 0, AR_Y1 = SZB;
constexpr size_t AR_R = 2 * SZB, AR_K = 3 * SZB, AR_V = 4 * SZB;
constexpr size_t AR_L1 = 5 * SZB;
constexpr size_t AR_DOT = AR_L1 + SZB / 2;
constexpr size_t AR_G = 6 * SZB;
constexpr size_t AR_VGATE = 0;
constexpr size_t AR_O = 3 * SZB;
constexpr size_t AR_H = 0;
constexpr size_t AR_Z = SZB;
constexpr size_t AR_P = 5 * SZB;
constexpr size_t AR_ST = 7 * SZB;
constexpr size_t AR_HM = 0;
constexpr size_t AR_HE = SZB;
constexpr size_t HE_ROWS = (size_t)2 * TG + 32 * 256;
constexpr size_t AR_LIST = al256(AR_HE + HE_ROWS * FEXP * 2);
constexpr size_t AR_LW = AR_LIST + (size_t)32 * TG * 4;
constexpr size_t AR_YM0 = 5 * SZB, AR_YM1 = 6 * SZB;
constexpr size_t ARENA_BYTES = 7 * SZB + al256((size_t)TG * 8) + 4096;
constexpr size_t WS_END = WS_ARENA + ARENA_BYTES;
static_assert(AR_LW + (size_t)32 * TG * 4 <= AR_YM0, "moe lists overlap");
static_assert(AR_DOT + (size_t)2 * TG * 16 * 4 <= AR_G, "dot overlap");

constexpr int LDS_STAGE = 131072;
constexpr int LDS_MISC = LDS_STAGE;
constexpr int LDS_BYTES = LDS_STAGE + 1024;

struct Params {
    const float* in[42];
    float* out;
    unsigned char* ws;
    int ph_lo, ph_hi;
};

__device__ __forceinline__ float bf2f(unsigned short b) { return __uint_as_float(((unsigned)b) << 16); }
__device__ __forceinline__ unsigned short f2bf(float f) { unsigned u = __float_as_uint(f); u += 0x7FFFu + ((u >> 16) & 1u); return (unsigned short)(u >> 16); }
__device__ __forceinline__ unsigned pk2(float lo, float hi) { return (unsigned)f2bf(lo) | ((unsigned)f2bf(hi) << 16); }
__device__ __forceinline__ float lo16(unsigned w) { return __uint_as_float(w << 16); }
__device__ __forceinline__ float hi16(unsigned w) { return __uint_as_float(w & 0xFFFF0000u); }
__device__ __forceinline__ float sigmoidf_(float x) { return 1.0f / (1.0f + __expf(-x)); }
__device__ __forceinline__ float tanhf_(float x) { return 1.0f - 2.0f / (__expf(2.0f * x) + 1.0f); }
__device__ __forceinline__ float wave_sum(float v) {
#pragma unroll
    for (int o = 32; o > 0; o >>= 1) v += __shfl_xor(v, o);
    return v;
}
template <int CTRL> __device__ __forceinline__ float dpp_f(float v) {
    return __int_as_float(__builtin_amdgcn_update_dpp(0, __float_as_int(v), CTRL, 0xF, 0xF, true));
}
__device__ __forceinline__ float red8(float v) { v += dpp_f<0xB1>(v); v += dpp_f<0x4E>(v); v += dpp_f<0x141>(v); return v; }
__device__ __forceinline__ float red16(float v) { v = red8(v); v += dpp_f<0x140>(v); return v; }
__device__ __forceinline__ float red4(float v) { v += dpp_f<0xB1>(v); v += dpp_f<0x4E>(v); return v; }
__device__ __forceinline__ float gelu_f(float v) {
    const float av = fabsf(v), t = __builtin_amdgcn_rcpf(av * 0.2316418882f + 1.0f);
    float q = t * 0.5307027145f + (-0.7265760135f); q = q * t + 0.7107068705f; q = q * t + (-0.142248368f); q = q * t + 0.127414796f; q = q * t;
    const float e = __builtin_amdgcn_exp2f((v * v) * (-0.72134752044f));
    const float m = v * (q * e);
    return v < 0.f ? m : v - m;
}

#define XB_TMO      128
#define XB_XCNT(j)  (256  + 64 * (j))
#define XB_XSUB(j)  (1280 + 64 * (j))
#define XB_XGEN(j)  (2304 + 64 * (j))
#define XB_TOP      3328
#define XB_TOPGEN   3392
#define XCD_BAR_WORDS 3456
#define XB_SPIN_CAP (1u << 22)
static_assert(XCD_BAR_WORDS == XCD_BAR_WORDS_C, "barrier words");
__device__ __forceinline__ unsigned xb_ld(unsigned* p)              { return __hip_atomic_load(p, __ATOMIC_RELAXED, __HIP_MEMORY_SCOPE_AGENT); }
__device__ __forceinline__ unsigned xb_add(unsigned* p, unsigned v) { return __hip_atomic_fetch_add(p, v, __ATOMIC_RELAXED, __HIP_MEMORY_SCOPE_AGENT); }
__device__ __forceinline__ unsigned xb_xcc_id() { return (unsigned)__builtin_amdgcn_s_getreg((3 << 11) | 20) & 0xFu; }
#define XB_SPIN(cond, bar) do { unsigned _sp = 0; while (cond) { __builtin_amdgcn_s_sleep(1); \
    if ((++_sp & 255u) == 0u) { if (xb_ld(&(bar)[XB_TMO])) break; if (_sp > XB_SPIN_CAP) { atomicAdd(&(bar)[XB_TMO], 1u); break; } } } } while (0)
struct XcdBarrier { unsigned* bar; unsigned x; volatile LAS unsigned* st; };
__device__ __forceinline__ XcdBarrier xcd_barrier_post(unsigned* bar, volatile LAS unsigned* st) {
    XcdBarrier b; b.bar = bar; b.x = xb_xcc_id(); b.st = st;
    if (threadIdx.x == 0) (void)xb_add(&bar[XB_XCNT(b.x)], 1u);
    return b;
}
__device__ __forceinline__ void xcd_barrier_complete(unsigned* bar, unsigned x, unsigned& nloc, unsigned& nx) {
    const unsigned G = gridDim.x * gridDim.y * gridDim.z;
    unsigned sum, cnt, mine, sp = 0u;
    for (;;) {
        sum = 0u; cnt = 0u; mine = 0u;
#pragma unroll
        for (unsigned j = 0; j < 16; ++j) { const unsigned c = xb_ld(&bar[XB_XCNT(j)]); sum += c; cnt += (c > 0u) ? 1u : 0u; mine = (j == x) ? c : mine; }
        if (sum == G) break;
        __builtin_amdgcn_s_sleep(1);
        if ((++sp & 255u) == 0u) { if (xb_ld(&bar[XB_TMO])) break; if (sp > XB_SPIN_CAP) { atomicAdd(&bar[XB_TMO], 1u); break; } }
    }
    nloc = mine > 0u ? mine : 1u; nx = cnt > 0u ? cnt : 1u;
}
__device__ __forceinline__ void xcd_barrier(const XcdBarrier& b) {
    asm volatile("s_waitcnt vmcnt(0)" ::: "memory");
    __syncthreads();
    if (threadIdx.x == 0) {
        unsigned* bar = b.bar;
        __builtin_amdgcn_s_waitcnt(0);
        unsigned nloc = b.st[0], nx = b.st[1];
        if (nloc == 0u) { xcd_barrier_complete(bar, b.x, nloc, nx); b.st[0] = nloc; b.st[1] = nx; }
        const unsigned old = xb_add(&bar[XB_XSUB(b.x)], 1u);
        const unsigned gen = old / nloc;
        if (old + 1u == (gen + 1u) * nloc) {
            __builtin_amdgcn_fence(__ATOMIC_RELEASE, "agent");
            asm volatile("s_waitcnt vmcnt(0)" ::: "memory");
            const unsigned og = xb_add(&bar[XB_TOP], 1u);
            const unsigned tg = og / nx;
            if (og + 1u == (tg + 1u) * nx) xb_add(&bar[XB_TOPGEN], 1u);
            else XB_SPIN(xb_ld(&bar[XB_TOPGEN]) == tg, bar);
            __builtin_amdgcn_fence(__ATOMIC_ACQUIRE, "agent");
            xb_add(&bar[XB_XGEN(b.x)], 1u);
            asm volatile("s_waitcnt vmcnt(0)" ::: "memory");
        } else {
            XB_SPIN(xb_ld(&bar[XB_XGEN(b.x)]) == gen, bar);
            __builtin_amdgcn_fence(__ATOMIC_ACQUIRE, "agent");
            asm volatile("s_waitcnt vmcnt(0)" ::: "memory");
        }
    }
    __syncthreads();
}

namespace pg8 {
constexpr int BM = 256, BK = 64, HALF = 128, HTB = HALF * BK * 2, STAGE_BYTES = 8 * HTB, NXCD = 8, WGM = 8;
__host__ __device__ __forceinline__ int lds_byte(int r, int c) { const int st = (r >> 4) * 2 + (c >> 5), rr = r & 15, cc = c & 31, ob = rr * 64 + cc * 2; return st * 1024 + (ob ^ (((ob >> 9) & 1) << 5)); }
__host__ __device__ __forceinline__ void stage_rc(int b, int& R, int& C) { const int st = b / 1024, sb = b % 1024, swz = sb ^ (((sb >> 9) & 1) << 5); R = (st >> 1) * 16 + swz / 64; C = (st & 1) * 32 + (swz % 64) / 2; }
struct Unit { int pm, pn, aux; };

struct SchedPlain {
    static constexpr bool GATHER = false;
    int nM, nN, nwg, G, c, skipctx;
    __device__ void init(int nM_, int nN_, int G_, int c_, int skipctx_) { nM = nM_; nN = nN_; nwg = nM * nN; G = G_; c = c_; skipctx = skipctx_; }
    __device__ bool next(int i, Unit& u) const {
        const long L = (long)i * G + c; if (L >= nwg) return false;
        int wgid = (int)L; { const int q = nwg / NXCD, r = nwg % NXCD, xcd = wgid % NXCD, off = wgid / NXCD; wgid = (xcd < r ? xcd * (q + 1) : r * (q + 1) + (xcd - r) * q) + off; }
        const int nig = WGM * nN, gid = wgid / nig, fm = gid * WGM, gsz = (nM - fm) < WGM ? (nM - fm) : WGM;
        int pm = fm + ((wgid % nig) % gsz); u.pn = (wgid % nig) / gsz; u.aux = 0;
        if (skipctx) pm = (pm >> 3) * 9 + 1 + (pm & 7);
        u.pm = pm; return true;
    }
    __device__ __forceinline__ int arow(const Unit& u, int r) const { return u.pm * BM + r; }
};
template <bool GATH> struct SchedMoe {
    static constexpr bool GATHER = GATH;
    const LAS int* cn; const LAS int* tb; const int* lists; int G, c, total;
    __device__ bool next(int i, Unit& u) const {
        const int U = i * G + c; if (U >= total * 4) return false;
        const int T = U >> 2, pn = U & 3; int l = 0;
        while (tb[l + 1] <= T) ++l;
        u.pm = T; u.pn = (l >> 1) * 4 + pn; u.aux = l | ((T - tb[l]) << 8); return true;
    }
    __device__ __forceinline__ int arow(const Unit& u, int r) const {
        if (!GATH) return u.pm * BM + r;
        const int l = u.aux & 255, idx = (u.aux >> 8) * BM + r;
        return idx < cn[l] ? lists[(size_t)l * TG + idx] : 0;
    }
};

template <class Epi, class Sched>
__device__ __forceinline__ void gemm_phase(const int tid, LAS unsigned char* lds, const bf16_t* A, int lda, const bf16_t* Bt, int ldb, int K, const Sched& S, const Epi& E) {
    constexpr bool GA = Sched::GATHER;
    const int wid = __builtin_amdgcn_readfirstlane(tid >> 6), lane = tid & 63, wr = wid >> 2, wc = wid & 3, fr = lane & 15, fq = lane >> 4;
    const int nt = K / BK;
    unsigned voffA[2], voffB[2];
#pragma unroll
    for (int i = 0; i < 2; ++i) { int R, C; stage_rc(tid * 16 + i * 8192, R, C); voffA[i] = (unsigned)(R * lda + C) * 2u; voffB[i] = (unsigned)(R * ldb + C) * 2u; }
    const size_t kstep = (size_t)(BK * 2);
    const size_t hstepA = (size_t)HALF * lda * 2, tstepA = 2 * hstepA;
    const size_t hstepB = (size_t)HALF * ldb * 2, tstepB = 2 * hstepB;
    const unsigned ldsw = (unsigned)wid * 1024u;
    const int aoff = lds_byte(wr * 64 + fr, fq * 8), boff = lds_byte(wc * 32 + fr, fq * 8);
#define PG8_SA(b, h) (((b) * 2 + (h)) * HTB)
#define PG8_SB(b, h) ((4 + (b) * 2 + (h)) * HTB)
#define PG8_STAGE(bufoff, gbase, voff) do { _Pragma("unroll") for (int _i = 0; _i < 2; ++_i) \
        __builtin_amdgcn_global_load_lds((const unsigned*)((const char*)(gbase) + (voff)[_i]), (LAS unsigned*)(lds + (bufoff) + ldsw + _i * 8192), 16, 0, 0); } while (0)
#define PG8_STAGE_A(bufoff, ub, gv, h, koff) do { if constexpr (GA) { PG8_STAGE(bufoff, (const char*)A + (koff), gv[h]); } else { PG8_STAGE(bufoff, (ub) + (h) * hstepA + (koff), voffA); } } while (0)
#define PG8_LDA(dst, b, h) do { _Pragma("unroll") for (int m = 0; m < 4; ++m) _Pragma("unroll") for (int k = 0; k < 2; ++k) dst[m][k] = *(const LAS bf16x8*)(lds + PG8_SA(b, h) + aoff + m * 2048 + k * 1024); } while (0)
#define PG8_LDB(dst, b, h) do { _Pragma("unroll") for (int n = 0; n < 2; ++n) _Pragma("unroll") for (int k = 0; k < 2; ++k) dst[n][k] = *(const LAS bf16x8*)(lds + PG8_SB(b, h) + boff + n * 2048 + k * 1024); } while (0)
#define PG8_MMA(ai, bj, At, Bt_) do { __builtin_amdgcn_s_setprio(1); _Pragma("unroll") for (int m = 0; m < 4; ++m) _Pragma("unroll") for (int n = 0; n < 2; ++n) _Pragma("unroll") for (int k = 0; k < 2; ++k) \
        acc[ai][bj][m][n] = __builtin_amdgcn_mfma_f32_16x16x32_bf16(Bt_[n][k], At[m][k], acc[ai][bj][m][n], 0, 0, 0); __builtin_amdgcn_s_setprio(0); } while (0)
#define PG8_WAIT_V(n) asm volatile("s_waitcnt vmcnt(" #n ")" ::: "memory")
#define PG8_WAIT_L(n) asm volatile("s_waitcnt lgkmcnt(" #n ")" ::: "memory")
#define PG8_BAR __builtin_amdgcn_s_barrier()
#define PG8_SCHED __builtin_amdgcn_sched_barrier(0)
#define PG8_GOFF(dst, u) do { if constexpr (GA) { _Pragma("unroll") for (int _h = 0; _h < 2; ++_h) _Pragma("unroll") for (int _i = 0; _i < 2; ++_i) { int R_, C_; stage_rc(tid * 16 + _i * 8192, R_, C_); \
        dst[_h][_i] = ((unsigned)S.arow(u, _h * HALF + R_) * (unsigned)lda + (unsigned)C_) * 2u; } } } while (0)
    Unit cur, nxt; int ui = 0;
    if (!S.next(0, cur)) return;
    f32x4 acc[2][2][4][2];
#pragma unroll
    for (int a = 0; a < 2; ++a)
#pragma unroll
        for (int b = 0; b < 2; ++b)
#pragma unroll
            for (int m = 0; m < 4; ++m)
#pragma unroll
                for (int n = 0; n < 2; ++n) acc[a][b][m][n] = (f32x4){0.f, 0.f, 0.f, 0.f};
    bf16x8 At[4][2], B0[2][2], B1[2][2];
    unsigned gAc[2][2], gAn[2][2];
    PG8_GOFF(gAc, cur);
    const char* cA = (const char*)A + (GA ? (size_t)0 : (size_t)cur.pm * tstepA);
    const char* cB = (const char*)Bt + (size_t)cur.pn * tstepB;
    PG8_STAGE(PG8_SB(0, 0), cB, voffB); PG8_STAGE_A(PG8_SA(0, 0), cA, gAc, 0, 0); PG8_STAGE(PG8_SB(0, 1), cB + hstepB, voffB); PG8_STAGE_A(PG8_SA(0, 1), cA, gAc, 1, 0);
    if (wr == 1) PG8_BAR;
    PG8_WAIT_V(4); PG8_BAR;
    PG8_STAGE(PG8_SB(1, 0), cB + kstep, voffB); PG8_STAGE_A(PG8_SA(1, 0), cA, gAc, 0, kstep); PG8_STAGE(PG8_SB(1, 1), cB + hstepB + kstep, voffB);
    PG8_WAIT_V(6); PG8_BAR;
    for (;;) {
        const bool has_next = S.next(ui + 1, nxt);
        if (has_next) { PG8_GOFF(gAn, nxt); }
        else if constexpr (GA) {
#pragma unroll
            for (int _h = 0; _h < 2; ++_h)
#pragma unroll
                for (int _i = 0; _i < 2; ++_i) gAn[_h][_i] = gAc[_h][_i];
        }
        const char* nA = (has_next && !GA) ? (const char*)A + (size_t)nxt.pm * tstepA : cA;
        const char* nB = has_next ? (const char*)Bt + (size_t)nxt.pn * tstepB : cB;
#pragma unroll 1
        for (int t = 0; t < nt; t += 2) {
            const bool last = (t == nt - 2);
            const size_t k1 = (size_t)(t + 1) * kstep;
            const size_t k2 = last ? (size_t)0 : (size_t)(t + 2) * kstep, k3 = k2 + kstep;
            const char* a2 = last ? nA : cA; const char* b2 = last ? nB : cB;
            unsigned g2[2][2];
            if constexpr (GA) {
#pragma unroll
                for (int _h = 0; _h < 2; ++_h)
#pragma unroll
                    for (int _i = 0; _i < 2; ++_i) g2[_h][_i] = last ? gAn[_h][_i] : gAc[_h][_i];
            }
            PG8_LDB(B0, 0, 0); PG8_SCHED; PG8_LDA(At, 0, 0); PG8_STAGE_A(PG8_SA(1, 1), cA, gAc, 1, k1);
            PG8_WAIT_L(8); PG8_BAR; PG8_WAIT_L(0); PG8_MMA(0, 0, At, B0); PG8_BAR; PG8_SCHED;
            PG8_LDB(B1, 0, 1); PG8_STAGE(PG8_SB(0, 0), b2 + k2, voffB);
            PG8_BAR; PG8_WAIT_L(0); PG8_MMA(0, 1, At, B1); PG8_BAR;
            PG8_LDA(At, 0, 1); PG8_STAGE_A(PG8_SA(0, 0), a2, g2, 0, k2);
            PG8_BAR; PG8_WAIT_L(0); PG8_MMA(1, 0, At, B0); PG8_BAR; PG8_SCHED;
            PG8_STAGE(PG8_SB(0, 1), b2 + hstepB + k2, voffB);
            PG8_WAIT_V(6); PG8_BAR; PG8_MMA(1, 1, At, B1); PG8_BAR;
            PG8_LDB(B0, 1, 0); PG8_SCHED; PG8_LDA(At, 1, 0); PG8_STAGE_A(PG8_SA(0, 1), a2, g2, 1, k2);
            PG8_WAIT_L(8); PG8_BAR; PG8_WAIT_L(0); PG8_MMA(0, 0, At, B0); PG8_BAR; PG8_SCHED;
            PG8_LDB(B1, 1, 1); PG8_STAGE(PG8_SB(1, 0), b2 + k3, voffB);
            PG8_BAR; PG8_WAIT_L(0); PG8_MMA(0, 1, At, B1); PG8_BAR;
            PG8_LDA(At, 1, 1); PG8_STAGE_A(PG8_SA(1, 0), a2, g2, 0, k3);
            PG8_BAR; PG8_WAIT_L(0); PG8_MMA(1, 0, At, B0); PG8_BAR; PG8_SCHED;
            PG8_STAGE(PG8_SB(1, 1), b2 + hstepB + k3, voffB);
            PG8_WAIT_V(6); PG8_BAR; PG8_MMA(1, 1, At, B1); PG8_BAR;
        }
        { int fr_e = fr, fq_e = fq; asm volatile("" : "+v"(fr_e), "+v"(fq_e)); E(acc, cur, wr, wc, fr_e, fq_e); }
        if (!has_next) break;
#pragma unroll
        for (int a = 0; a < 2; ++a)
#pragma unroll
            for (int b = 0; b < 2; ++b)
#pragma unroll
                for (int m = 0; m < 4; ++m)
#pragma unroll
                    for (int n = 0; n < 2; ++n) acc[a][b][m][n] = (f32x4){0.f, 0.f, 0.f, 0.f};
        cur = nxt; cA = nA; cB = nB; ++ui;
        if constexpr (GA) {
#pragma unroll
            for (int _h = 0; _h < 2; ++_h)
#pragma unroll
                for (int _i = 0; _i < 2; ++_i) gAc[_h][_i] = gAn[_h][_i];
        }
    }
    PG8_WAIT_V(0);
    if (wr == 0) PG8_BAR;
    PG8_BAR;
#undef PG8_SA
#undef PG8_SB
#undef PG8_STAGE
#undef PG8_STAGE_A
#undef PG8_LDA
#undef PG8_LDB
#undef PG8_MMA
#undef PG8_WAIT_V
#undef PG8_WAIT_L
#undef PG8_BAR
#undef PG8_SCHED
#undef PG8_GOFF
}
}
using pg8::Unit;

#define EPI_LOOP_BEGIN \
    _Pragma("unroll") for (int ai = 0; ai < 2; ++ai) _Pragma("unroll") for (int m = 0; m < 4; ++m) { const int trow = ai * 128 + wr * 64 + m * 16 + fr; \
    _Pragma("unroll") for (int bj = 0; bj < 2; ++bj) _Pragma("unroll") for (int n = 0; n < 2; ++n) { const int tcol = bj * 128 + wc * 32 + n * 16 + 4 * fq; const f32x4 v = acc[ai][bj][m][n];
#define EPI_LOOP_END } asm volatile("" ::: "memory"); }

struct EpiG1 {
    unsigned char* ws; size_t voff;
    __device__ __forceinline__ void operator()(const f32x4 (&acc)[2][2][4][2], const Unit& u, int wr, int wc, int fr, int fq) const {
        const int pn = u.pn; const size_t row0 = (size_t)u.pm * 256;
        if (pn < 12) {
            const size_t off = pn < 4 ? (WS_ARENA + AR_R) : (pn < 8 ? (WS_ARENA + AR_K) : voff);
            bf16_t* dst = (bf16_t*)(ws + off); const int cb = (pn & 3) * 256;
            EPI_LOOP_BEGIN
                u32x2 w; w.x = pk2(v[0], v[1]); w.y = pk2(v[2], v[3]);
                *(u32x2*)(dst + (row0 + trow) * D + cb + tcol) = w;
            EPI_LOOP_END
        } else {
            bf16_t* L1 = (bf16_t*)(ws + WS_ARENA + AR_L1);
            const int cb = (pn - 12) * 256;
            EPI_LOOP_BEGIN
                f32x4 o = v;
                if (pn == 12 && bj == 0) { o[0] = tanhf_(v[0]); o[1] = tanhf_(v[1]); o[2] = tanhf_(v[2]); o[3] = tanhf_(v[3]); }
                if (pn == 13 && bj == 0) { o[0] = sigmoidf_(v[0]); o[1] = sigmoidf_(v[1]); o[2] = sigmoidf_(v[2]); o[3] = sigmoidf_(v[3]); }
                u32x2 w; w.x = pk2(o[0], o[1]); w.y = pk2(o[2], o[3]);
                *(u32x2*)(L1 + (row0 + trow) * 512 + cb + tcol) = w;
            EPI_LOOP_END
        }
    }
};
template <int ACT> struct EpiStore {
    bf16_t* O; const float* bias;
    __device__ __forceinline__ void operator()(const f32x4 (&acc)[2][2][4][2], const Unit& u, int wr, int wc, int fr, int fq) const {
        const size_t row0 = (size_t)u.pm * 256; const int cb = u.pn * 256;
        EPI_LOOP_BEGIN
            f32x4 o = v;
            if (ACT == 1) { const f32x4 b = *(const f32x4*)(bias + cb + tcol); o[0] = sigmoidf_(v[0] + b[0]); o[1] = sigmoidf_(v[1] + b[1]); o[2] = sigmoidf_(v[2] + b[2]); o[3] = sigmoidf_(v[3] + b[3]); }
            u32x2 w; w.x = pk2(o[0], o[1]); w.y = pk2(o[2], o[3]);
            *(u32x2*)(O + (row0 + trow) * D + cb + tcol) = w;
        EPI_LOOP_END
    }
};
struct EpiGelu {
    bf16_t* Z; const float* bias;
    __device__ __forceinline__ void operator()(const f32x4 (&acc)[2][2][4][2], const Unit& u, int wr, int wc, int fr, int fq) const {
        const size_t row0 = (size_t)u.pm * 256; const int cb = u.pn * 256;
        EPI_LOOP_BEGIN
            const f32x4 b = *(const f32x4*)(bias + cb + tcol);
            u32x2 w; w.x = pk2(gelu_f(v[0] + b[0]), gelu_f(v[1] + b[1])); w.y = pk2(gelu_f(v[2] + b[2]), gelu_f(v[3] + b[3]));
            *(u32x2*)(Z + (row0 + trow) * 4096 + cb + tcol) = w;
        EPI_LOOP_END
    }
};
struct EpiMG {
    bf16_t* HE;
    __device__ __forceinline__ void operator()(const f32x4 (&acc)[2][2][4][2], const Unit& u, int wr, int wc, int fr, int fq) const {
        const size_t row0 = (size_t)u.pm * 256; const int pnl = u.pn & 3;
#pragma unroll
        for (int ai = 0; ai < 2; ++ai)
#pragma unroll
            for (int m = 0; m < 4; ++m) { const int trow = ai * 128 + wr * 64 + m * 16 + fr;
#pragma unroll
                for (int bj = 0; bj < 2; ++bj) {
                    const f32x4 gt = acc[ai][bj][m][0], up = acc[ai][bj][m][1];
                    const int f = (8 * pnl + 4 * bj + wc) * 16 + 4 * fq;
                    float o[4];
#pragma unroll
                    for (int e = 0; e < 4; ++e) o[e] = gt[e] * sigmoidf_(gt[e]) * up[e];
                    u32x2 w; w.x = pk2(o[0], o[1]); w.y = pk2(o[2], o[3]);
                    *(u32x2*)(HE + (row0 + trow) * FEXP + f) = w;
                } }
    }
};
struct EpiMD {
    bf16_t* Y0; const int* lists; const float* lw; const LAS int* cn;
    __device__ __forceinline__ void operator()(const f32x4 (&acc)[2][2][4][2], const Unit& u, int wr, int wc, int fr, int fq) const {
        const int l = u.aux & 255, t0 = (u.aux >> 8) * 256, cnt = cn[l]; const int cb = (u.pn & 3) * 256;
        bf16_t* Y = Y0 + (size_t)(l & 1) * ((AR_YM1 - AR_YM0) / 2);
#pragma unroll
        for (int ai = 0; ai < 2; ++ai)
#pragma unroll
            for (int m = 0; m < 4; ++m) { const int trow = ai * 128 + wr * 64 + m * 16 + fr; const int idx = t0 + trow;
                if (idx < cnt) {
                    const int tok = lists[(size_t)l * TG + idx]; const float wgt = lw[(size_t)l * TG + idx];
#pragma unroll
                    for (int bj = 0; bj < 2; ++bj)
#pragma unroll
                        for (int n = 0; n < 2; ++n) { const int tcol = bj * 128 + wc * 32 + n * 16 + 4 * fq; const f32x4 v = acc[ai][bj][m][n];
                            u32x2 w; w.x = pk2(v[0] * wgt, v[1] * wgt); w.y = pk2(v[2] * wgt, v[3] * wgt);
                            *(u32x2*)(Y + (size_t)tok * D + cb + tcol) = w; }
                } }
    }
};

struct Frame {
    const Params __attribute__((address_space(4)))* kp; LAS unsigned char* lds; int tid, lane, wave, G, bid;
    unsigned char* ws;
    __device__ __forceinline__ const float* in(int k) const { return kp->in[k]; }
    __device__ __forceinline__ float* outp() const { return kp->out; }
    template <class T> __device__ __forceinline__ T* wsp(size_t off) const { return (T*)(ws + off); }
    template <class T> __device__ __forceinline__ T* ar(size_t off) const { return (T*)(ws + WS_ARENA + off); }
    __device__ __forceinline__ const float* modL(int layer, int b, int j) const { return (const float*)(ws + WS_MODL) + (((size_t)layer * NB + b) * 6 + j) * D; }
    __device__ __forceinline__ const float* modC(int layer, int j) const { return (const float*)(ws + WS_MODC) + ((size_t)layer * 6 + j) * D; }
};

struct TJob { const float* src; bf16_t* dst; const float* ksc; int lds, K, N, ldd, kofs, nofs, inter; };
constexpr int NJOBS = 2 * 24 + 1 + 4 + 4 * NEXP * 3;
__device__ __forceinline__ TJob get_job(const Frame& F, int j) {
    TJob J; J.ksc = nullptr; J.kofs = 0; J.nofs = 0; J.inter = 0; J.K = 0; J.N = 0; J.lds = 0; J.ldd = 0; J.src = nullptr; J.dst = nullptr;
    if (j < 48) {
        const int a = j / 24, q = j % 24;
        if (q < 18) {
            const int half = q / 9, w = q % 9; const float* mu = F.in(8) + (size_t)a * 6 * D;
            J.dst = F.wsp<bf16_t>(WS_W1CAT) + (size_t)a * N1CAT * K1CAT; J.ldd = K1CAT; J.kofs = half * 1024; J.K = D; int mi = 0;
            if (w == 0) { J.src = F.in(9) + (size_t)a * D * D; J.lds = D; J.N = D; J.nofs = 0; mi = 0; }
            else if (w == 1) { J.src = F.in(10) + (size_t)a * D * D; J.lds = D; J.N = D; J.nofs = 1024; mi = 2; }
            else if (w == 2) { J.src = F.in(11) + (size_t)a * D * D; J.lds = D; J.N = D; J.nofs = 2048; mi = 3; }
            else if (w < 5) { const int d = w - 3; J.src = F.in(14) + ((size_t)a * 2 + d) * D * 64; J.lds = 64; J.N = 64; J.nofs = 3072 + d * 64; mi = 1; }
            else if (w < 7) { const int d = w - 5; J.src = F.in(17) + ((size_t)a * 2 + d) * D * 64; J.lds = 64; J.N = 64; J.nofs = 3200 + d * 64; mi = 4; }
            else if (w == 7) { J.src = F.in(22) + (size_t)a * D * 128; J.lds = 128; J.N = 128; J.nofs = 3328; mi = 5; }
            else { J.src = F.in(20); J.lds = 32; J.N = (a == 1) ? 32 : 0; J.nofs = 3456; mi = 3; }
            if (half) J.ksc = mu + mi * D;
        } else if (q == 18) { J.src = F.in(12) + (size_t)a * D * D; J.lds = D; J.K = D; J.N = D; J.dst = F.wsp<bf16_t>(WS_WO) + (size_t)a * D * D; J.ldd = D; }
        else if (q == 19) { J.src = F.in(23) + (size_t)a * 128 * D; J.lds = D; J.K = 128; J.N = D; J.dst = F.wsp<bf16_t>(WS_G2T) + (size_t)a * D * 256; J.ldd = 256; }
        else if (q < 22) { const int d = q - 20; J.src = F.in(15) + ((size_t)a * 2 + d) * 64 * D; J.lds = D; J.K = 64; J.N = D; J.dst = F.wsp<bf16_t>(WS_W2T) + ((size_t)a * 2 + d) * D * 64; J.ldd = 64; }
        else { const int d = q - 22; J.src = F.in(18) + ((size_t)a * 2 + d) * 64 * D; J.lds = D; J.K = 64; J.N = D; J.dst = F.wsp<bf16_t>(WS_A2T) + ((size_t)a * 2 + d) * D * 64; J.ldd = 64; }
    } else if (j == 48) { J.src = F.in(21); J.lds = D; J.K = 32; J.N = D; J.dst = F.wsp<bf16_t>(WS_V2T); J.ldd = 256; J.kofs = 128; }
    else if (j < 53) {
        const int q = j - 49, b = q >> 1;
        if ((q & 1) == 0) { J.src = F.in(29) + (size_t)b * D * 4096; J.lds = 4096; J.K = D; J.N = 4096; J.dst = F.wsp<bf16_t>(WS_WIN) + (size_t)b * 4096 * D; J.ldd = D; }
        else { J.src = F.in(35) + (size_t)b * 2048 * D; J.lds = D; J.K = 2048; J.N = D; J.dst = F.wsp<bf16_t>(WS_WOUT) + (size_t)b * D * 2048; J.ldd = 2048; }
    } else {
        const int q = j - 53, ie = q / 3, w = q % 3;
        if (w < 2) { J.src = F.in(38 + w) + (size_t)ie * D * FEXP; J.lds = FEXP; J.K = D; J.N = FEXP; J.dst = F.wsp<bf16_t>(WS_WGU) + (size_t)ie * 1024 * D; J.ldd = D; J.nofs = w * 16; J.inter = 1; }
        else { J.src = F.in(40) + (size_t)ie * FEXP * D; J.lds = D; J.K = FEXP; J.N = D; J.dst = F.wsp<bf16_t>(WS_WD) + (size_t)ie * D * FEXP; J.ldd = FEXP; }
    }
    return J;
}
__device__ __forceinline__ void transpose_all(const Frame& F) {
    LAS float* tile = (LAS float*)F.lds;
    int tilectr = 0;
#pragma unroll 1
    for (int j = 0; j < NJOBS; ++j) {
        const TJob J = get_job(F, j);
        const int tk = (J.K + 63) / 64, tn = (J.N + 63) / 64, ntile = tk * tn;
        int t = (F.bid - (tilectr % F.G) + F.G) % F.G;
        tilectr += ntile;
#pragma unroll 1
        for (; t < ntile; t += F.G) {
            const int k0 = (t / tn) * 64, n0 = (t % tn) * 64;
            __syncthreads();
#pragma unroll
            for (int e = 0; e < 8; ++e) { const int idx = F.tid + e * 512, kk = idx >> 6, nn = idx & 63;
                float v = 0.f; if (k0 + kk < J.K && n0 + nn < J.N) { v = J.src[(size_t)(k0 + kk) * J.lds + n0 + nn]; if (J.ksc) v *= J.ksc[k0 + kk]; }
                tile[kk * 65 + nn] = v; }
            __syncthreads();
#pragma unroll
            for (int e = 0; e < 8; ++e) { const int idx = F.tid + e * 512, nn = idx >> 6, kk = idx & 63;
                if (k0 + kk < J.K && n0 + nn < J.N) { const int n = n0 + nn; const int row = J.nofs + (J.inter ? ((n >> 4) * 32 + (n & 15)) : n);
                    J.dst[(size_t)row * J.ldd + J.kofs + k0 + kk] = f2bf(tile[kk * 65 + nn]); } }
        }
    }
    __syncthreads();
}
__device__ __forceinline__ void zero_rows(const Frame& F, bf16_t* dst, int ldd, int row0, int nrows, int col0, int ncols) {
    const int per = ncols / 8; const long tot = (long)nrows * per;
    for (long i = (long)F.bid * NTHREADS + F.tid; i < tot; i += (long)F.G * NTHREADS) { const int r = (int)(i / per), c = (int)(i % per) * 8;
        *(u32x4*)(dst + (size_t)(row0 + r) * ldd + col0 + c) = (u32x4){0u, 0u, 0u, 0u}; }
}
__device__ __forceinline__ void phase_prologue(const Frame& F) {
    {
        LAS float* sl = (LAS float*)F.lds;
        LAS float* red = (LAS float*)(F.lds + 33 * 256 * 4);
        const float* c = F.in(1); const float* cc = F.in(3); const float* wm = F.in(4); const float* bm = F.in(5);
        const int tx = F.tid & 63, ty = F.tid >> 6;
        for (int unit = F.bid; unit < 4 * 96; unit += F.G) {
            const int layer = unit / 96, col0 = (unit % 96) * 64;
            float acc[33];
#pragma unroll
            for (int r = 0; r < 33; ++r) acc[r] = 0.f;
#pragma unroll 1
            for (int kc = 0; kc < 4; ++kc) {
                __syncthreads();
                for (int i = F.tid; i < 33 * 256; i += NTHREADS) { const int r = i >> 8, k = (i & 255) + kc * 256; const float x = r < 32 ? c[r * D + k] : cc[k]; sl[i] = x * sigmoidf_(x); }
                __syncthreads();
#pragma unroll 1
                for (int k4 = 0; k4 < 32; k4 += 4) {
                    const int kl = ty * 32 + k4;
                    float w[4];
#pragma unroll
                    for (int e = 0; e < 4; ++e) w[e] = wm[((size_t)layer * D + kc * 256 + kl + e) * 6144 + col0 + tx];
#pragma unroll
                    for (int r = 0; r < 33; ++r) { const f32x4 s = *(const LAS f32x4*)(sl + r * 256 + kl); acc[r] += s[0] * w[0] + s[1] * w[1] + s[2] * w[2] + s[3] * w[3]; if ((r & 7) == 7) asm volatile("" ::: "memory"); }
                }
            }
            __syncthreads();
#pragma unroll
            for (int r = 0; r < 33; ++r) red[(ty * 33 + r) * 64 + tx] = acc[r];
            __syncthreads();
            for (int i = F.tid; i < 33 * 64; i += NTHREADS) { const int r = i >> 6, x = i & 63; float s = 0.f;
#pragma unroll
                for (int y = 0; y < 8; ++y) s += red[(y * 33 + r) * 64 + x];
                const int col = col0 + x; s += bm[layer * 6144 + col];
                if (r < 32) F.wsp<float>(WS_MODL)[((size_t)layer * NB + r) * 6144 + col] = s; else F.wsp<float>(WS_MODC)[(size_t)layer * 6144 + col] = s; }
        }
    }
    __syncthreads();
    transpose_all(F);
    for (int a = 0; a < 2; ++a) {
        bf16_t* W1 = F.wsp<bf16_t>(WS_W1CAT) + (size_t)a * N1CAT * K1CAT;
        if (a == 0) zero_rows(F, W1, K1CAT, 3456, 128, 0, K1CAT); else zero_rows(F, W1, K1CAT, 3488, 96, 0, K1CAT);
        zero_rows(F, F.wsp<bf16_t>(WS_G2T) + (size_t)a * D * 256, 256, 0, D, 128, 128);
    }
    zero_rows(F, F.wsp<bf16_t>(WS_V2T), 256, 0, D, 0, 128); zero_rows(F, F.wsp<bf16_t>(WS_V2T), 256, 0, D, 160, 96);
    {
        const float* src = F.in(33); bf16_t* dst = F.wsp<bf16_t>(WS_WSP); const long tot = (long)2 * 16 * 128 * 128 / 4;
        for (long i = (long)F.bid * NTHREADS + F.tid; i < tot; i += (long)F.G * NTHREADS) { const f32x4 v = *(const f32x4*)(src + i * 4); u32x2 w; w.x = pk2(v[0], v[1]); w.y = pk2(v[2], v[3]); *(u32x2*)(dst + i * 4) = w; }
    }
    __syncthreads();
}

__device__ __forceinline__ void phase_norm1(const Frame& F, int g, int layer  , bf16_t* dst, int ldh) {
    float* X = F.wsp<float>(WS_X);
    const bf16_t* Y0 = F.ar<bf16_t>(AR_YM0); const bf16_t* Y1 = F.ar<bf16_t>(AR_YM1);
    const bool fin = layer == 4;
    for (int r = F.bid * NWAVES + F.wave; r < TG; r += F.G * NWAVES) {
        const int bl = r / LT, t = r % LT, b = g * BG + bl; const bool isctx = t < LC;
        if (isctx && layer >= 3) continue;
        f32x4 x[4];
        if (layer == 0) {
            const float* src = isctx ? F.in(2) + ((size_t)b * LC + t) * D : F.in(0) + ((size_t)b * SEQ + (t - LC)) * D;
#pragma unroll
            for (int q = 0; q < 4; ++q) x[q] = *(const f32x4*)(src + q * 256 + F.lane * 4);
        } else {
            const float* gt = isctx ? F.modC(layer - 1, 5) : F.modL(layer - 1, b, 5);
#pragma unroll
            for (int q = 0; q < 4; ++q) { const int c = q * 256 + F.lane * 4;
                x[q] = *(const f32x4*)(X + (size_t)r * D + c);
                const u32x2 a = *(const u32x2*)(Y0 + (size_t)r * D + c), bb = *(const u32x2*)(Y1 + (size_t)r * D + c);
                const f32x4 gv = *(const f32x4*)(gt + c);
                x[q][0] += gv[0] * (lo16(a.x) + lo16(bb.x)); x[q][1] += gv[1] * (hi16(a.x) + hi16(bb.x));
                x[q][2] += gv[2] * (lo16(a.y) + lo16(bb.y)); x[q][3] += gv[3] * (hi16(a.y) + hi16(bb.y)); }
        }
        float ss = 0.f;
#pragma unroll
        for (int q = 0; q < 4; ++q) ss += x[q][0] * x[q][0] + x[q][1] * x[q][1] + x[q][2] * x[q][2] + x[q][3] * x[q][3];
        ss = wave_sum(ss);
        const float rstd = rsqrtf(ss * (1.0f / D) + 1e-6f);
        if (fin) {
            float* o = F.outp() + ((size_t)b * SEQ + (t - LC)) * D; const float* fg = F.in(41);
#pragma unroll
            for (int q = 0; q < 4; ++q) { const int c = q * 256 + F.lane * 4; const f32x4 gv = *(const f32x4*)(fg + c); *(f32x4*)(o + c) = x[q] * rstd * gv; }
        } else {
            const float* gn = F.in(6) + (size_t)layer * D;
            const float* sh = isctx ? F.modC(layer, 0) : F.modL(layer, b, 0);
            const float* sc = isctx ? F.modC(layer, 1) : F.modL(layer, b, 1);
#pragma unroll
            for (int q = 0; q < 4; ++q) { const int c = q * 256 + F.lane * 4;
                *(f32x4*)(X + (size_t)r * D + c) = x[q];
                const f32x4 gv = *(const f32x4*)(gn + c), sv = *(const f32x4*)(sh + c), cv = *(const f32x4*)(sc + c);
                const f32x4 h = x[q] * rstd * gv * (1.0f + cv) + sv;
                u32x2 w; w.x = pk2(h[0], h[1]); w.y = pk2(h[2], h[3]);
                *(u32x2*)(dst + (size_t)r * ldh + c) = w; }
        }
    }
}
__device__ __forceinline__ void phase_mix(const Frame& F) {
    bf16_t* H2 = F.ar<bf16_t>(AR_H2);
    for (int r = F.bid * NWAVES + F.wave; r < TG; r += F.G * NWAVES) {
        const int t = r % LT; const bool isctx = t < LC; const int p = t - LC;
#pragma unroll
        for (int q = 0; q < 2; ++q) {
            const int c = q * 512 + F.lane * 8;
            int nr;
            if (isctx) nr = (q == 0) ? (t > 0 ? r - 1 : -1) : (t < LC - 1 ? r + 1 : -1);
            else { const int qu = c >> 8;
                nr = qu == 0 ? ((p & 63) > 0 ? r - 1 : -1) : qu == 1 ? ((p & 63) < 63 ? r + 1 : -1) : qu == 2 ? (p >= 64 ? r - 64 : -1) : (p < SEQ - 64 ? r + 64 : -1); }
            const u32x4 hs = *(const u32x4*)(H2 + (size_t)r * 2048 + c);
            u32x4 hn = (u32x4){0u, 0u, 0u, 0u};
            if (nr >= 0) hn = *(const u32x4*)(H2 + (size_t)nr * 2048 + c);
            u32x4 o;
            o.x = pk2(lo16(hn.x) - lo16(hs.x), hi16(hn.x) - hi16(hs.x)); o.y = pk2(lo16(hn.y) - lo16(hs.y), hi16(hn.y) - hi16(hs.y));
            o.z = pk2(lo16(hn.z) - lo16(hs.z), hi16(hn.z) - hi16(hs.z)); o.w = pk2(lo16(hn.w) - lo16(hs.w), hi16(hn.w) - hi16(hs.w));
            *(u32x4*)(H2 + (size_t)r * 2048 + 1024 + c) = o;
        }
    }
}
__device__ __forceinline__ void phase_vfix(const Frame& F) {
    bf16_t* V = F.ar<bf16_t>(AR_V); const bf16_t* VF = F.wsp<bf16_t>(WS_VF); const bf16_t* GT = F.ar<bf16_t>(AR_VGATE);
    const size_t tot = (size_t)TG * D / 8;
    for (size_t i = (size_t)F.bid * NTHREADS + F.tid; i < tot; i += (size_t)F.G * NTHREADS) {
        const u32x4 v = *(const u32x4*)(V + i * 8), f = *(const u32x4*)(VF + i * 8), g = *(const u32x4*)(GT + i * 8);
        u32x4 o;
        o.x = pk2(lo16(v.x) + (lo16(f.x) - lo16(v.x)) * lo16(g.x), hi16(v.x) + (hi16(f.x) - hi16(v.x)) * hi16(g.x));
        o.y = pk2(lo16(v.y) + (lo16(f.y) - lo16(v.y)) * lo16(g.y), hi16(v.y) + (hi16(f.y) - hi16(v.y)) * hi16(g.y));
        o.z = pk2(lo16(v.z) + (lo16(f.z) - lo16(v.z)) * lo16(g.z), hi16(v.z) + (hi16(f.z) - hi16(v.z)) * hi16(g.z));
        o.w = pk2(lo16(v.w) + (lo16(f.w) - lo16(v.w)) * lo16(g.w), hi16(v.w) + (hi16(f.w) - hi16(v.w)) * hi16(g.w));
        *(u32x4*)(V + i * 8) = o;
    }
}
__device__ __forceinline__ void phase_post(const Frame& F, int a, const bf16_t* V) {
    bf16_t* Y0 = F.ar<bf16_t>(AR_Y0); const bf16_t* Y1 = F.ar<bf16_t>(AR_Y1); const float* DOT = F.ar<float>(AR_DOT); const bf16_t* Gb = F.ar<bf16_t>(AR_G);
    const float* lg = F.in(27) + (size_t)a * D; const float* lb = F.in(28) + (size_t)a * D;
    for (int r = F.bid * NWAVES + F.wave; r < TG; r += F.G * NWAVES) {
        const int c = F.lane * 16, h = F.lane >> 2;
        float y[16], vv[16];
#pragma unroll
        for (int q = 0; q < 2; ++q) {
            const u32x4 a0 = *(const u32x4*)(Y0 + (size_t)r * D + c + q * 8), a1 = *(const u32x4*)(Y1 + (size_t)r * D + c + q * 8), v4 = *(const u32x4*)(V + (size_t)r * D + c + q * 8);
            y[q * 8 + 0] = lo16(a0.x) + lo16(a1.x); y[q * 8 + 1] = hi16(a0.x) + hi16(a1.x); y[q * 8 + 2] = lo16(a0.y) + lo16(a1.y); y[q * 8 + 3] = hi16(a0.y) + hi16(a1.y);
            y[q * 8 + 4] = lo16(a0.z) + lo16(a1.z); y[q * 8 + 5] = hi16(a0.z) + hi16(a1.z); y[q * 8 + 6] = lo16(a0.w) + lo16(a1.w); y[q * 8 + 7] = hi16(a0.w) + hi16(a1.w);
            vv[q * 8 + 0] = lo16(v4.x); vv[q * 8 + 1] = hi16(v4.x); vv[q * 8 + 2] = lo16(v4.y); vv[q * 8 + 3] = hi16(v4.y);
            vv[q * 8 + 4] = lo16(v4.z); vv[q * 8 + 5] = hi16(v4.z); vv[q * 8 + 6] = lo16(v4.w); vv[q * 8 + 7] = hi16(v4.w);
        }
        float s = 0.f;
#pragma unroll
        for (int e = 0; e < 16; ++e) s += y[e];
        s = red4(s); const float mean = s * (1.0f / 64.0f);
        float qv = 0.f;
#pragma unroll
        for (int e = 0; e < 16; ++e) { const float dd = y[e] - mean; qv += dd * dd; }
        qv = red4(qv); const float rstd = rsqrtf(qv * (1.0f / 64.0f) + 64e-5f);
        const float dsum = DOT[(size_t)r * NH + h] + DOT[((size_t)TG + r) * NH + h];
        unsigned o[8];
        const u32x4 g0 = *(const u32x4*)(Gb + (size_t)r * D + c), g1 = *(const u32x4*)(Gb + (size_t)r * D + c + 8);
        const unsigned gw[8] = {g0.x, g0.y, g0.z, g0.w, g1.x, g1.y, g1.z, g1.w};
#pragma unroll
        for (int e = 0; e < 16; e += 2) {
            const float o0 = ((y[e] - mean) * rstd * lg[c + e] + lb[c + e] + vv[e] * dsum) * lo16(gw[e >> 1]);
            const float o1 = ((y[e + 1] - mean) * rstd * lg[c + e + 1] + lb[c + e + 1] + vv[e + 1] * dsum) * hi16(gw[e >> 1]);
            o[e >> 1] = pk2(o0, o1);
        }
        *(u32x4*)(Y0 + (size_t)r * D + c) = (u32x4){o[0], o[1], o[2], o[3]};
        *(u32x4*)(Y0 + (size_t)r * D + c + 8) = (u32x4){o[4], o[5], o[6], o[7]};
    }
}
__device__ __forceinline__ void phase_norm2(const Frame& F, int g, int layer) {
    float* X = F.wsp<float>(WS_X); bf16_t* HM = F.ar<bf16_t>(AR_HM); const bf16_t* Ob = F.ar<bf16_t>(AR_O);
    int* lists = F.ar<int>(AR_LIST); float* lwt = F.ar<float>(AR_LW);
    unsigned* cnt = (unsigned*)(F.ws + WS_CTL + CTL_CNT_OFF) + ((size_t)g * 4 + layer) * 32;
    LAS float* wr = (LAS float*)F.lds;
    __syncthreads();
    for (int i = F.tid; i < D * NEXP / 4; i += NTHREADS) *(LAS f32x4*)(wr + i * 4) = *(const f32x4*)(F.in(36) + i * 4);
    __syncthreads();
    const float* rbias = F.in(37);
    const bool ctx_out = layer < 2;
    for (int r = F.bid * NWAVES + F.wave; r < TG; r += F.G * NWAVES) {
        const int bl = r / LT, t = r % LT, b = g * BG + bl; const bool isctx = t < LC;
        if (isctx && !ctx_out) continue;
        f32x4 x[4]; float ss = 0.f;
        const float* gt1 = isctx ? F.modC(layer, 2) : F.modL(layer, b, 2);
#pragma unroll
        for (int q = 0; q < 4; ++q) { const int c = q * 256 + F.lane * 4;
            x[q] = *(const f32x4*)(X + (size_t)r * D + c);
            const u32x2 ob = *(const u32x2*)(Ob + (size_t)r * D + c); const f32x4 gv = *(const f32x4*)(gt1 + c);
            x[q][0] += gv[0] * lo16(ob.x); x[q][1] += gv[1] * hi16(ob.x); x[q][2] += gv[2] * lo16(ob.y); x[q][3] += gv[3] * hi16(ob.y);
            *(f32x4*)(X + (size_t)r * D + c) = x[q];
            ss += x[q][0] * x[q][0] + x[q][1] * x[q][1] + x[q][2] * x[q][2] + x[q][3] * x[q][3]; }
        ss = wave_sum(ss);
        const float rstd = rsqrtf(ss * (1.0f / D) + 1e-6f);
        const float* gn = F.in(7) + (size_t)layer * D;
        const float* sh = isctx ? F.modC(layer, 3) : F.modL(layer, b, 3);
        const float* sc = isctx ? F.modC(layer, 4) : F.modL(layer, b, 4);
        float lg[16];
#pragma unroll
        for (int e = 0; e < 16; ++e) lg[e] = 0.f;
#pragma unroll
        for (int q = 0; q < 4; ++q) { const int c = q * 256 + F.lane * 4;
            const f32x4 gv = *(const f32x4*)(gn + c), sv = *(const f32x4*)(sh + c), cv = *(const f32x4*)(sc + c);
            const f32x4 h = x[q] * rstd * gv * (1.0f + cv) + sv;
            u32x2 w; w.x = pk2(h[0], h[1]); w.y = pk2(h[2], h[3]);
            *(u32x2*)(HM + (size_t)r * D + c) = w;
#pragma unroll
            for (int j = 0; j < 4; ++j) {
#pragma unroll
                for (int e4 = 0; e4 < 4; ++e4) { const f32x4 wv = *(const LAS f32x4*)(wr + (c + j) * 16 + e4 * 4);
                    lg[e4 * 4 + 0] += h[j] * wv[0]; lg[e4 * 4 + 1] += h[j] * wv[1]; lg[e4 * 4 + 2] += h[j] * wv[2]; lg[e4 * 4 + 3] += h[j] * wv[3]; } }
        }
#pragma unroll
        for (int e = 0; e < 16; ++e) lg[e] = wave_sum(lg[e]);
        float sc_[16], bs[16];
#pragma unroll
        for (int e = 0; e < 16; ++e) { sc_[e] = sigmoidf_(lg[e]); bs[e] = sc_[e] + rbias[e]; }
        float gs[4];
#pragma unroll
        for (int gq = 0; gq < 4; ++gq) { float m1 = -1e30f, m2 = -1e30f;
#pragma unroll
            for (int j = 0; j < 4; ++j) { const float v = bs[gq * 4 + j]; if (v > m1) { m2 = m1; m1 = v; } else if (v > m2) m2 = v; }
            gs[gq] = m1 + m2; }
        int best = 0; float bv = gs[0];
#pragma unroll
        for (int gq = 1; gq < 4; ++gq) if (gs[gq] > bv) { bv = gs[gq]; best = gq; }
        float cb[4], cs[4];
#pragma unroll
        for (int j = 0; j < 4; ++j) { cb[j] = best == 0 ? bs[j] : best == 1 ? bs[4 + j] : best == 2 ? bs[8 + j] : bs[12 + j]; cs[j] = best == 0 ? sc_[j] : best == 1 ? sc_[4 + j] : best == 2 ? sc_[8 + j] : sc_[12 + j]; }
        int j1 = 0; float v1 = cb[0];
#pragma unroll
        for (int j = 1; j < 4; ++j) if (cb[j] > v1) { v1 = cb[j]; j1 = j; }
        int j2 = -1; float v2 = -1e30f;
#pragma unroll
        for (int j = 0; j < 4; ++j) if (j != j1 && cb[j] > v2) { v2 = cb[j]; j2 = j; }
        const float s1 = j1 == 0 ? cs[0] : j1 == 1 ? cs[1] : j1 == 2 ? cs[2] : cs[3];
        const float s2 = j2 == 0 ? cs[0] : j2 == 1 ? cs[1] : j2 == 2 ? cs[2] : cs[3];
        const float inv = 1.0f / (s1 + s2);
        if (F.lane == 0) {
            const int e1 = best * 4 + j1, e2 = best * 4 + j2;
            const unsigned p1 = atomicAdd(&cnt[e1 * 2 + 0], 1u), p2 = atomicAdd(&cnt[e2 * 2 + 1], 1u);
            lists[(size_t)(e1 * 2 + 0) * TG + p1] = r; lwt[(size_t)(e1 * 2 + 0) * TG + p1] = s1 * inv;
            lists[(size_t)(e2 * 2 + 1) * TG + p2] = r; lwt[(size_t)(e2 * 2 + 1) * TG + p2] = s2 * inv;
        }
    }
    __syncthreads();
}
__device__ __forceinline__ int moe_tables(const Frame& F, int g, int layer) {
    LAS int* cn = (LAS int*)(F.lds + LDS_MISC + 64); LAS int* tb = (LAS int*)(F.lds + LDS_MISC + 192);
    const unsigned* cnt = (const unsigned*)(F.ws + WS_CTL + CTL_CNT_OFF) + ((size_t)g * 4 + layer) * 32;
    __syncthreads();
    if (F.tid == 0) { int acc = 0; for (int l = 0; l < 32; ++l) { const int c = (int)__hip_atomic_load(cnt + l, __ATOMIC_RELAXED, __HIP_MEMORY_SCOPE_AGENT); cn[l] = c; tb[l] = acc; acc += (c + 255) >> 8; } tb[32] = acc; }
    __syncthreads();
    return tb[32];
}

constexpr int SC_OPB = 6 * 4096;
constexpr int SC_HALF = 2 * SC_OPB + 4096 + 4096;
static_assert(2 * SC_HALF <= LDS_STAGE, "scan lds");
__device__ __forceinline__ int scan_tok(int d, int s) { return d == 0 ? s : (s < LC ? (LC - 1 - s) : (LT + LC - 1 - s)); }
__device__ __forceinline__ void phase_scan(const Frame& F, int a, const bf16_t* V) {
    const bf16_t* R = F.ar<bf16_t>(AR_R); const bf16_t* Kb = F.ar<bf16_t>(AR_K); const bf16_t* L1 = F.ar<bf16_t>(AR_L1);
    const int half = F.wave >> 2, q = F.wave & 3, lane = F.lane, li = q * 64 + lane;
    LAS unsigned char* hb = F.lds + half * SC_HALF;
    LAS float* aT = (LAS float*)(hb + 2 * SC_OPB); LAS float* ybuf = (LAS float*)(hb + 2 * SC_OPB + 4096);
    const int arr = q >> 1, ntl = (q & 1) * 2;
    const int i = lane >> 3, j = lane & 7, r0 = 16 * q + 2 * i;
    const int tB = li >> 4, k4 = (li & 15) * 4;
    for (int pr = F.bid; pr < BG * 16; pr += F.G) {
        const int bl = pr >> 4, d = (pr >> 3) & 1, hp = pr & 7, h = hp * 2 + half;
        bf16_t* Yd = F.ar<bf16_t>(d ? AR_Y1 : AR_Y0); float* DOT = F.ar<float>(AR_DOT) + (size_t)d * TG * NH;
        const size_t rowb = (size_t)bl * LT;
        const bf16_t* W2 = (arr == 0 ? F.wsp<bf16_t>(WS_W2T) : F.wsp<bf16_t>(WS_A2T)) + ((size_t)a * 2 + d) * D * 64;
        bf16x8 Bf[2][2]; float bias[2];
#pragma unroll
        for (int nt = 0; nt < 2; ++nt) { const int cc = h * 64 + (ntl + nt) * 16 + (lane & 15);
            bias[nt] = (arr == 0 ? F.in(13) : F.in(16))[((size_t)a * 2 + d) * D + cc];
#pragma unroll
            for (int s = 0; s < 2; ++s) Bf[nt][s] = *(const bf16x8*)(W2 + (size_t)cc * 64 + 32 * s + 8 * (lane >> 4)); }
        const f32x4 kkc = *(const f32x4*)(F.in(24) + (size_t)a * D + h * 64 + k4), kac = *(const f32x4*)(F.in(25) + (size_t)a * D + h * 64 + k4), rkc = *(const f32x4*)(F.in(26) + (size_t)a * D + h * 64 + k4);
        const int acol = arr * 128 + d * 64 + 8 * (lane >> 4);
        float S0[8], S1[8];
#pragma unroll
        for (int c = 0; c < 8; ++c) { S0[c] = 0.f; S1[c] = 0.f; }
        bf16x8 Af[2]; u32x2 kraw, rraw, vraw;
#define SC_LOAD(ch) do { const size_t rowA = rowb + scan_tok(d, (ch) * 16 + (lane & 15)); \
        Af[0] = *(const bf16x8*)(L1 + rowA * 512 + acol); Af[1] = *(const bf16x8*)(L1 + rowA * 512 + acol + 32); \
        const size_t rowBq = (rowb + scan_tok(d, (ch) * 16 + tB)) * D + h * 64 + k4; \
        kraw = *(const u32x2*)(Kb + rowBq); rraw = *(const u32x2*)(R + rowBq); vraw = *(const u32x2*)(V + rowBq); } while (0)
#define SC_PASSA(buf) do { LAS float* op = (LAS float*)(hb + (buf) * SC_OPB); \
        _Pragma("unroll") for (int nt = 0; nt < 2; ++nt) { f32x4 ac = (f32x4){0.f, 0.f, 0.f, 0.f}; \
            ac = __builtin_amdgcn_mfma_f32_16x16x32_bf16(Af[0], Bf[nt][0], ac, 0, 0, 0); ac = __builtin_amdgcn_mfma_f32_16x16x32_bf16(Af[1], Bf[nt][1], ac, 0, 0, 0); \
            const int n = (ntl + nt) * 16 + (lane & 15); \
            _Pragma("unroll") for (int rg = 0; rg < 4; ++rg) { const int t = (lane >> 4) * 4 + rg; const float x = ac[rg] + bias[nt]; \
                if (arr == 0) { const float nx = -x; const float sp = nx > 20.f ? nx : __logf(1.0f + __expf(nx)); op[1024 + t * 64 + n] = __expf(-__expf(-sp - 0.5f)); } \
                else aT[t * 64 + n] = sigmoidf_(x); } } } while (0)
#define SC_PASSB(ch, buf) do { LAS float* op = (LAS float*)(hb + (buf) * SC_OPB); \
        const float kf[4] = {lo16(kraw.x), hi16(kraw.x), lo16(kraw.y), hi16(kraw.y)}; const float rf[4] = {lo16(rraw.x), hi16(rraw.x), lo16(rraw.y), hi16(rraw.y)}; \
        const float vf[4] = {lo16(vraw.x), hi16(vraw.x), lo16(vraw.y), hi16(vraw.y)}; \
        const f32x4 av = *(const LAS f32x4*)(aT + tB * 64 + k4); \
        float kq[4], ssq = 0.f; _Pragma("unroll") for (int e = 0; e < 4; ++e) { kq[e] = kf[e] * kkc[e]; ssq += kq[e] * kq[e]; } \
        ssq = red16(ssq); const float inv = 1.0f / fmaxf(sqrtf(ssq), 1e-12f); \
        f32x4 o_kk, o_kka, o_kd, o_r, o_v; float dp = 0.f; \
        _Pragma("unroll") for (int e = 0; e < 4; ++e) { const float kkv = kq[e] * inv; const float kd = kf[e] * (1.0f + (av[e] - 1.0f) * kac[e]); \
            o_kk[e] = kkv; o_kka[e] = kkv * av[e]; o_kd[e] = kd; o_r[e] = rf[e]; o_v[e] = vf[e]; dp += rf[e] * kd * rkc[e]; } \
        dp = red16(dp); \
        if ((li & 15) == 0) DOT[(rowb + scan_tok(d, (ch) * 16 + tB)) * NH + h] = dp; \
        *(LAS f32x4*)(op + 0 * 1024 + tB * 64 + k4) = o_kk; *(LAS f32x4*)(op + 2 * 1024 + tB * 64 + k4) = o_kka; *(LAS f32x4*)(op + 3 * 1024 + tB * 64 + k4) = o_kd; \
        *(LAS f32x4*)(op + 4 * 1024 + tB * 64 + k4) = o_r; *(LAS f32x4*)(op + 5 * 1024 + tB * 64 + k4) = o_v; } while (0)
        __syncthreads();
        SC_LOAD(0);
        SC_PASSA(0);
        __syncthreads();
        SC_PASSB(0, 0);
        __syncthreads();
        constexpr int NCH = LT / 16;
        for (int ch = 0; ch < NCH; ++ch) {
            const int buf = ch & 1;
            if (ch + 1 < NCH) SC_LOAD(ch + 1);
            const LAS float* op = (const LAS float*)(hb + buf * SC_OPB);
#pragma unroll 2
            for (int t = 0; t < 16; ++t) {
                const LAS float* ob = op + t * 64 + j * 8;
                const f32x4 kkA = *(const LAS f32x4*)(ob), kkB = *(const LAS f32x4*)(ob + 4);
                const f32x4 dcA = *(const LAS f32x4*)(ob + 1024), dcB = *(const LAS f32x4*)(ob + 1024 + 4);
                const f32x4 kaA = *(const LAS f32x4*)(ob + 2048), kaB = *(const LAS f32x4*)(ob + 2048 + 4);
                const f32x4 kdA = *(const LAS f32x4*)(ob + 3072), kdB = *(const LAS f32x4*)(ob + 3072 + 4);
                const f32x4 rrA = *(const LAS f32x4*)(ob + 4096), rrB = *(const LAS f32x4*)(ob + 4096 + 4);
                const f32x2 vv = *(const LAS f32x2*)(op + 5 * 1024 + t * 64 + r0);
                const float kk[8] = {kkA[0], kkA[1], kkA[2], kkA[3], kkB[0], kkB[1], kkB[2], kkB[3]};
                const float dc[8] = {dcA[0], dcA[1], dcA[2], dcA[3], dcB[0], dcB[1], dcB[2], dcB[3]};
                const float ka[8] = {kaA[0], kaA[1], kaA[2], kaA[3], kaB[0], kaB[1], kaB[2], kaB[3]};
                const float kd[8] = {kdA[0], kdA[1], kdA[2], kdA[3], kdB[0], kdB[1], kdB[2], kdB[3]};
                const float rr[8] = {rrA[0], rrA[1], rrA[2], rrA[3], rrB[0], rrB[1], rrB[2], rrB[3]};
                float sa0 = 0.f, sa1 = 0.f;
#pragma unroll
                for (int c = 0; c < 8; ++c) { sa0 += S0[c] * kk[c]; sa1 += S1[c] * kk[c]; }
                sa0 = red8(sa0); sa1 = red8(sa1);
                float y0 = 0.f, y1 = 0.f;
#pragma unroll
                for (int c = 0; c < 8; ++c) {
                    S0[c] = S0[c] * dc[c] + (vv[0] * kd[c] - sa0 * ka[c]);
                    S1[c] = S1[c] * dc[c] + (vv[1] * kd[c] - sa1 * ka[c]);
                    y0 += S0[c] * rr[c]; y1 += S1[c] * rr[c];
                }
                y0 = red8(y0); y1 = red8(y1);
                if (j == 0) *(LAS f32x2*)(ybuf + t * 64 + r0) = (f32x2){y0, y1};
            }
            __syncthreads();
            {
                const f32x4 yv = *(const LAS f32x4*)(ybuf + tB * 64 + k4);
                u32x2 w; w.x = pk2(yv[0], yv[1]); w.y = pk2(yv[2], yv[3]);
                *(u32x2*)(Yd + (rowb + scan_tok(d, ch * 16 + tB)) * D + h * 64 + k4) = w;
            }
            if (ch + 1 < NCH) SC_PASSA(buf ^ 1);
            __syncthreads();
            if (ch + 1 < NCH) SC_PASSB(ch + 1, buf ^ 1);
            __syncthreads();
        }
#undef SC_LOAD
#undef SC_PASSA
#undef SC_PASSB
    }
}

__device__ __forceinline__ void phase_sgstats(const Frame& F, int layer) {
    const bf16_t* Z = F.ar<bf16_t>(AR_Z); float* ST = F.ar<float>(AR_ST);
    for (int r = F.bid * NWAVES + F.wave; r < TG; r += F.G * NWAVES) {
        const int t = r % LT; if (t < LC && layer >= 3) continue;
        float x[32];
#pragma unroll
        for (int q = 0; q < 4; ++q) { const u32x4 w = *(const u32x4*)(Z + (size_t)r * 4096 + 2048 + q * 512 + F.lane * 8);
            x[q * 8 + 0] = lo16(w.x); x[q * 8 + 1] = hi16(w.x); x[q * 8 + 2] = lo16(w.y); x[q * 8 + 3] = hi16(w.y); x[q * 8 + 4] = lo16(w.z); x[q * 8 + 5] = hi16(w.z); x[q * 8 + 6] = lo16(w.w); x[q * 8 + 7] = hi16(w.w); }
        float s = 0.f;
#pragma unroll
        for (int e = 0; e < 32; ++e) s += x[e];
        s = wave_sum(s); const float mean = s * (1.0f / 2048.0f);
        float qv = 0.f;
#pragma unroll
        for (int e = 0; e < 32; ++e) { const float dd = x[e] - mean; qv += dd * dd; }
        qv = wave_sum(qv);
        if (F.lane == 0) *(f32x2*)(ST + (size_t)r * 2) = (f32x2){mean, rsqrtf(qv * (1.0f / 2048.0f) + 1e-5f)};
    }
}
__device__ __forceinline__ int vt_off(int dch, int jb) { return dch * 256 + ((jb ^ ((dch & 15) ^ (((dch >> 4) & 7) << 1))) << 4); }
__device__ __forceinline__ void phase_spatial(const Frame& F, int bsg, int layer) {
    const bf16_t* Z = F.ar<bf16_t>(AR_Z); const float* ST = F.ar<float>(AR_ST); bf16_t* Pb = F.ar<bf16_t>(AR_P);
    const bf16_t* Ws = F.wsp<bf16_t>(WS_WSP) + (size_t)bsg * 16 * 128 * 128;
    const float* lng = F.in(31) + (size_t)bsg * 2048; const float* lnb = F.in(32) + (size_t)bsg * 2048; const float* bs = F.in(34) + (size_t)bsg * 16 * 128;
    LAS unsigned char* vt = F.lds;
    const int skip = layer >= 3;
    const int nchunk = skip ? BG * 16 : BG * 18;
    const int w = F.wave, lane = F.lane, dt = w >> 1, it0 = (w & 1) * 2;
    for (int U = F.bid; U < nchunk * 16; U += F.G) {
        const int lc = U >> 4, gi = U & 15;
        const int chunk = skip ? (lc >> 4) * 18 + 2 + (lc & 15) : lc;
        const size_t row0 = (size_t)chunk * 128;
        __syncthreads();
#pragma unroll
        for (int k = 0; k < 4; ++k) {
            const int p = F.tid + 512 * k, jj = p >> 4, c8 = (p & 15) * 8;
            const u32x4 zz = *(const u32x4*)(Z + (row0 + jj) * 4096 + 2048 + gi * 128 + c8);
            const f32x2 st = *(const f32x2*)(ST + (row0 + jj) * 2);
            const float xv[8] = {lo16(zz.x), hi16(zz.x), lo16(zz.y), hi16(zz.y), lo16(zz.z), hi16(zz.z), lo16(zz.w), hi16(zz.w)};
#pragma unroll
            for (int e = 0; e < 8; ++e) { const int dch = c8 + e; const float val = (xv[e] - st[0]) * st[1] * lng[gi * 128 + dch] + lnb[gi * 128 + dch];
                *(LAS unsigned short*)(vt + vt_off(dch, jj >> 3) + (jj & 7) * 2) = f2bf(val); }
        }
        __syncthreads();
        f32x16 acc0, acc1;
#pragma unroll
        for (int e = 0; e < 16; ++e) { acc0[e] = 0.f; acc1[e] = 0.f; }
        const int dA = dt * 32 + (lane & 31);
        const bf16_t* w0p = Ws + ((size_t)gi * 128 + it0 * 32 + (lane & 31)) * 128 + 8 * (lane >> 5);
#pragma unroll
        for (int s = 0; s < 8; ++s) {
            const bf16x8 Afr = *(const LAS bf16x8*)(vt + vt_off(dA, 2 * s + (lane >> 5)));
            const bf16x8 B0 = *(const bf16x8*)(w0p + 16 * s), B1 = *(const bf16x8*)(w0p + 32 * 128 + 16 * s);
            acc0 = __builtin_amdgcn_mfma_f32_32x32x16_bf16(Afr, B0, acc0, 0, 0, 0);
            acc1 = __builtin_amdgcn_mfma_f32_32x32x16_bf16(Afr, B1, acc1, 0, 0, 0);
        }
#pragma unroll
        for (int it = 0; it < 2; ++it) {
            const int ii = (it0 + it) * 32 + (lane & 31); const size_t row = row0 + ii; const float bias = bs[gi * 128 + ii];
#pragma unroll
            for (int rq = 0; rq < 4; ++rq) {
                const int d0 = dt * 32 + 8 * rq + 4 * (lane >> 5);
                const u32x2 uu = *(const u32x2*)(Z + row * 4096 + gi * 128 + d0);
                float vs[4];
#pragma unroll
                for (int e = 0; e < 4; ++e) vs[e] = (it == 0 ? acc0[rq * 4 + e] : acc1[rq * 4 + e]) + bias;
                u32x2 o; o.x = pk2(lo16(uu.x) * vs[0], hi16(uu.x) * vs[1]); o.y = pk2(lo16(uu.y) * vs[2], hi16(uu.y) * vs[3]);
                *(u32x2*)(Pb + row * 2048 + gi * 128 + d0) = o;
            }
        }
    }
    __syncthreads();
}

__global__ void __launch_bounds__(NTHREADS, 2) fwd_kernel(Params P) {
    extern __shared__ __attribute__((aligned(16))) unsigned char lds_raw[];
    Frame F; F.lds = (LAS unsigned char*)lds_raw; F.tid = threadIdx.x; F.lane = F.tid & 63; F.wave = __builtin_amdgcn_readfirstlane(F.tid >> 6);
    F.G = gridDim.x; F.bid = blockIdx.x; F.ws = P.ws; F.kp = (const Params __attribute__((address_space(4)))*)__builtin_amdgcn_kernarg_segment_ptr();
    const int lo = P.ph_lo, hi = P.ph_hi;
    volatile LAS unsigned* misc = (volatile LAS unsigned*)(F.lds + LDS_MISC);
    if (F.tid < 4) misc[F.tid] = 0u;
    __syncthreads();
    XcdBarrier bar; bar.bar = (unsigned*)(F.ws + WS_CTL); bar.x = 0; bar.st = misc;
    if (hi - lo > 1) bar = xcd_barrier_post((unsigned*)(F.ws + WS_CTL), misc);
    int ph = 0;
#define RUN(...) do { if (ph >= lo && ph < hi) { { int t_ = threadIdx.x; const Params __attribute__((address_space(4)))* kp_ = (const Params __attribute__((address_space(4)))*)__builtin_amdgcn_kernarg_segment_ptr(); asm volatile("" : "+v"(t_), "+s"(kp_)); F.tid = t_; F.lane = t_ & 63; F.kp = kp_; F.ws = kp_->ws; } __VA_ARGS__; if (ph + 1 < hi) xcd_barrier(bar); } ++ph; } while (0)

    RUN(phase_prologue(F));
    for (int g = 0; g < NG; ++g) {
        for (int layer = 0; layer < 4; ++layer) {
            const int a = layer >> 1;
            if ((layer & 1) == 0) {
                const bf16_t* Vc = layer == 0 ? F.wsp<bf16_t>(WS_VF) : F.ar<bf16_t>(AR_V);
                RUN(phase_norm1(F, g, layer, F.ar<bf16_t>(AR_H2), 2048));
                RUN(phase_mix(F));
                RUN({ pg8::SchedPlain S; S.init(TG / 256, N1CAT / 256, F.G, F.bid, 0);
                      EpiG1 E{F.ws, layer == 0 ? WS_VF : WS_ARENA + AR_V};
                      pg8::gemm_phase(F.tid, F.lds, F.ar<bf16_t>(AR_H2), K1CAT, F.wsp<bf16_t>(WS_W1CAT) + (size_t)a * N1CAT * K1CAT, K1CAT, K1CAT, S, E); });
                if (layer == 2) {
                    RUN({ pg8::SchedPlain S; S.init(TG / 256, 4, F.G, F.bid, 0);
                          EpiStore<1> E{F.ar<bf16_t>(AR_VGATE), F.in(19)};
                          pg8::gemm_phase(F.tid, F.lds, F.ar<bf16_t>(AR_L1) + 256, 512, F.wsp<bf16_t>(WS_V2T), 256, 256, S, E); });
                    RUN(phase_vfix(F));
                }
                RUN(phase_scan(F, a, Vc));
                RUN({ pg8::SchedPlain S; S.init(TG / 256, 4, F.G, F.bid, 0);
                      EpiStore<0> E{F.ar<bf16_t>(AR_G), nullptr};
                      pg8::gemm_phase(F.tid, F.lds, F.ar<bf16_t>(AR_L1) + 256, 512, F.wsp<bf16_t>(WS_G2T) + (size_t)a * D * 256, 256, 256, S, E); });
                RUN(phase_post(F, a, Vc));
                RUN({ const int skip = layer == 2; pg8::SchedPlain S; S.init(skip ? BG * 8 : TG / 256, 4, F.G, F.bid, skip);
                      EpiStore<0> E{F.ar<bf16_t>(AR_O), nullptr};
                      pg8::gemm_phase(F.tid, F.lds, F.ar<bf16_t>(AR_Y0), D, F.wsp<bf16_t>(WS_WO) + (size_t)a * D * D, D, D, S, E); });
            } else {
                const int skip = layer == 3;
                RUN(phase_norm1(F, g, layer, F.ar<bf16_t>(AR_H), D));
                RUN({ pg8::SchedPlain S; S.init(skip ? BG * 8 : TG / 256, 16, F.G, F.bid, skip);
                      EpiGelu E{F.ar<bf16_t>(AR_Z), F.in(30) + (size_t)a * 4096};
                      pg8::gemm_phase(F.tid, F.lds, F.ar<bf16_t>(AR_H), D, F.wsp<bf16_t>(WS_WIN) + (size_t)a * 4096 * D, D, D, S, E); });
                RUN(phase_sgstats(F, layer));
                RUN(phase_spatial(F, a, layer));
                RUN({ pg8::SchedPlain S; S.init(skip ? BG * 8 : TG / 256, 4, F.G, F.bid, skip);
                      EpiStore<0> E{F.ar<bf16_t>(AR_O), nullptr};
                      pg8::gemm_phase(F.tid, F.lds, F.ar<bf16_t>(AR_P), 2048, F.wsp<bf16_t>(WS_WOUT) + (size_t)a * D * 2048, 2048, 2048, S, E); });
            }
            RUN(phase_norm2(F, g, layer));
            RUN({ const int total = moe_tables(F, g, layer);
                  pg8::SchedMoe<true> S{(const LAS int*)(F.lds + LDS_MISC + 64), (const LAS int*)(F.lds + LDS_MISC + 192), F.ar<int>(AR_LIST), F.G, F.bid, total};
                  EpiMG E{F.ar<bf16_t>(AR_HE)};
                  pg8::gemm_phase(F.tid, F.lds, F.ar<bf16_t>(AR_HM), D, F.wsp<bf16_t>(WS_WGU) + (size_t)layer * NEXP * 1024 * D, D, D, S, E); });
            RUN({ const int total = moe_tables(F, g, layer);
                  pg8::SchedMoe<false> S{(const LAS int*)(F.lds + LDS_MISC + 64), (const LAS int*)(F.lds + LDS_MISC + 192), F.ar<int>(AR_LIST), F.G, F.bid, total};
                  EpiMD E{F.ar<bf16_t>(AR_YM0), F.ar<int>(AR_LIST), F.ar<float>(AR_LW), (const LAS int*)(F.lds + LDS_MISC + 64)};
                  pg8::gemm_phase(F.tid, F.lds, F.ar<bf16_t>(AR_HE), FEXP, F.wsp<bf16_t>(WS_WD) + (size_t)layer * NEXP * D * FEXP, FEXP, FEXP, S, E); });
        }
        RUN(phase_norm1(F, g, 4, nullptr, 0));
    }
#undef RUN
}
constexpr int NPHASES = 1 + NG * (10 + 8 + 12 + 8 + 1);

__global__ void nan_fill(float* out, size_t n) { for (size_t i = (size_t)blockIdx.x * blockDim.x + threadIdx.x; i < n; i += (size_t)gridDim.x * blockDim.x) out[i] = __uint_as_float(0x7FC00000u); }

extern "C" void kernel_launch(void* const* d_in, const int* in_sizes, int n_in, void* d_out, int out_size, void* d_ws, size_t ws_size, hipStream_t stream) {
    static int grid = 0;
    if (grid == 0) {
        int dev = 0, cus = 0, per_cu = 0;
        if (n_in != 42 || ws_size < WS_END || hipGetDevice(&dev) != hipSuccess || hipDeviceGetAttribute(&cus, hipDeviceAttributeMultiprocessorCount, dev) != hipSuccess) {
            fprintf(stderr, "kernel_launch: bad setup (n_in %d, ws %zu need %zu)\n", n_in, ws_size, (size_t)WS_END); grid = -1;
        } else if (hipFuncSetAttribute((const void*)fwd_kernel, hipFuncAttributeMaxDynamicSharedMemorySize, LDS_BYTES) != hipSuccess) { fprintf(stderr, "kernel_launch: hipFuncSetAttribute failed\n"); grid = -1; }
        else {
            if (hipOccupancyMaxActiveBlocksPerMultiprocessor(&per_cu, (const void*)fwd_kernel, NTHREADS, LDS_BYTES) != hipSuccess || per_cu < 1) { fprintf(stderr, "kernel_launch: occupancy query reports %d\n", per_cu); }
            (void)hipGetLastError();
            grid = cus;
        }
    }
    if (grid < 0) { hipLaunchKernelGGL(nan_fill, dim3(1024), dim3(256), 0, stream, (float*)d_out, (size_t)out_size); return; }
    (void)hipMemsetAsync((char*)d_ws + WS_CTL, 0, CTL_BYTES, stream);
    Params p{};
    for (int i = 0; i < 42; ++i) p.in[i] = (const float*)d_in[i];
    p.out = (float*)d_out; p.ws = (unsigned char*)d_ws;
#if PER_PHASE_LAUNCH
    for (int k = 0; k < NPHASES; ++k) { p.ph_lo = k; p.ph_hi = k + 1; hipLaunchKernelGGL(fwd_kernel, dim3(grid), dim3(NTHREADS), LDS_BYTES, stream, p); }
#else
    p.ph_lo = 0; p.ph_hi = NPHASES;
    hipLaunchKernelGGL(fwd_kernel, dim3(grid), dim3(NTHREADS), LDS_BYTES, stream, p);
#endif
}
```

```cpp
#include <hip/hip_runtime.h>
#include <cstdio>
#include <cstdint>

#ifndef PER_PHASE_LAUNCH
#define PER_PHASE_LAUNCH 0
#endif

#define LAS __attribute__((address_space(3)))
typedef unsigned short bf16_t;
typedef short bf16x8 __attribute__((ext_vector_type(8)));
typedef float f32x4 __attribute__((ext_vector_type(4)));
typedef float f32x2 __attribute__((ext_vector_type(2)));
typedef float f32x16 __attribute__((ext_vector_type(16)));
typedef unsigned u32x4 __attribute__((ext_vector_type(4)));
typedef unsigned u32x2 __attribute__((ext_vector_type(2)));

constexpr int NB = 32, SEQ = 2048, LC = 256, LT = SEQ + LC, D = 1024, NH = 16;
constexpr int NG = 2, BG = NB / NG, TG = BG * LT;
constexpr int NTHREADS = 512, NWAVES = 8;
constexpr int N1CAT = 3584, K1CAT = 2048;
constexpr int NEXP = 16, FEXP = 512;

constexpr size_t al256(size_t x) { return (x + 255) & ~(size_t)255; }
constexpr int XCD_BAR_WORDS_C = 3456;
constexpr size_t WS_CTL = 0;
constexpr size_t CTL_BAR_BYTES = (size_t)XCD_BAR_WORDS_C * 4;
constexpr size_t CTL_CNT_OFF = al256(CTL_BAR_BYTES);
constexpr size_t CTL_BYTES = al256(CTL_CNT_OFF + (size_t)NG * 4 * 32 * 4);
constexpr size_t WS_X = al256(WS_CTL + CTL_BYTES);
constexpr size_t WS_VF = WS_X + (size_t)TG * D * 4;
constexpr size_t WS_MODL = WS_VF + (size_t)TG * D * 2;
constexpr size_t WS_MODC = WS_MODL + (size_t)4 * NB * 6 * D * 4;
constexpr size_t WS_W1CAT = al256(WS_MODC + (size_t)4 * 6 * D * 4);
constexpr size_t WS_WO = WS_W1CAT + (size_t)2 * N1CAT * K1CAT * 2;
constexpr size_t WS_G2T = WS_WO + (size_t)2 * D * D * 2;
constexpr size_t WS_V2T = WS_G2T + (size_t)2 * D * 256 * 2;
constexpr size_t WS_W2T = WS_V2T + (size_t)D * 256 * 2;
constexpr size_t WS_A2T = WS_W2T + (size_t)4 * D * 64 * 2;
constexpr size_t WS_WIN = WS_A2T + (size_t)4 * D * 64 * 2;
constexpr size_t WS_WOUT = WS_WIN + (size_t)2 * 4096 * D * 2;
constexpr size_t WS_WSP = WS_WOUT + (size_t)2 * D * 2048 * 2;
constexpr size_t WS_WGU = WS_WSP + (size_t)2 * 16 * 128 * 128 * 2;
constexpr size_t WS_WD = WS_WGU + (size_t)4 * NEXP * 1024 * D * 2;
constexpr size_t WS_ARENA = al256(WS_WD + (size_t)4 * NEXP * D * FEXP * 2);
constexpr size_t SZB = (size_t)TG * D * 2;
constexpr size_t AR_H2 = 0;
constexpr size_t AR_Y0 = 0, AR_Y1 = SZB;
constexpr size_t AR_R = 2 * SZB, AR_K = 3 * SZB, AR_V = 4 * SZB;
constexpr size_t AR_L1 = 5 * SZB;
constexpr size_t AR_DOT = AR_L1 + SZB / 2;
constexpr size_t AR_G = 6 * SZB;
constexpr size_t AR_VGATE = 0;
constexpr size_t AR_O = 3 * SZB;
constexpr size_t AR_H = 0;
constexpr size_t AR_Z = SZB;
constexpr size_t AR_P = 5 * SZB;
constexpr size_t AR_ST = 7 * SZB;
constexpr size_t AR_HM = 0;
constexpr size_t AR_HE = SZB;
constexpr size_t HE_ROWS = (size_t)2 * TG + 32 * 256;
constexpr size_t AR_LIST = al256(AR_HE + HE_ROWS * FEXP * 2);
constexpr size_t AR_LW = AR_LIST + (size_t)32 * TG * 4;
constexpr size_t AR_YM0 = 5 * SZB, AR_YM1 = 6 * SZB;
constexpr size_t ARENA_BYTES = 7 * SZB + al256((size_t)TG * 8) + 4096;
constexpr size_t WS_END = WS_ARENA + ARENA_BYTES;
static_assert(AR_LW + (size_t)32 * TG * 4 <= AR_YM0, "moe lists overlap");
static_assert(AR_DOT + (size_t)2 * TG * 16 * 4 <= AR_G, "dot overlap");

constexpr int LDS_STAGE = 131072;
constexpr int LDS_MISC = LDS_STAGE;
constexpr int LDS_BYTES = LDS_STAGE + 1024;

struct Params {
    const float* in[42];
    float* out;
    unsigned char* ws;
    int ph_lo, ph_hi;
};

__device__ __forceinline__ float bf2f(unsigned short b) { return __uint_as_float(((unsigned)b) << 16); }
__device__ __forceinline__ unsigned short f2bf(float f) { unsigned u = __float_as_uint(f); u += 0x7FFFu + ((u >> 16) & 1u); return (unsigned short)(u >> 16); }
__device__ __forceinline__ unsigned pk2(float lo, float hi) { return (unsigned)f2bf(lo) | ((unsigned)f2bf(hi) << 16); }
__device__ __forceinline__ float lo16(unsigned w) { return __uint_as_float(w << 16); }
__device__ __forceinline__ float hi16(unsigned w) { return __uint_as_float(w & 0xFFFF0000u); }
__device__ __forceinline__ float sigmoidf_(float x) { return 1.0f / (1.0f + __expf(-x)); }
__device__ __forceinline__ float tanhf_(float x) { return 1.0f - 2.0f / (__expf(2.0f * x) + 1.0f); }
__device__ __forceinline__ float wave_sum(float v) {
#pragma unroll
    for (int o = 32; o > 0; o >>= 1) v += __shfl_xor(v, o);
    return v;
}
template <int CTRL> __device__ __forceinline__ float dpp_f(float v) {
    return __int_as_float(__builtin_amdgcn_update_dpp(0, __float_as_int(v), CTRL, 0xF, 0xF, true));
}
__device__ __forceinline__ float red8(float v) { v += dpp_f<0xB1>(v); v += dpp_f<0x4E>(v); v += dpp_f<0x141>(v); return v; }
__device__ __forceinline__ float red16(float v) { v = red8(v); v += dpp_f<0x140>(v); return v; }
__device__ __forceinline__ float red4(float v) { v += dpp_f<0xB1>(v); v += dpp_f<0x4E>(v); return v; }
__device__ __forceinline__ float gelu_f(float v) {
    const float av = fabsf(v), t = __builtin_amdgcn_rcpf(av * 0.2316418882f + 1.0f);
    float q = t * 0.5307027145f + (-0.7265760135f); q = q * t + 0.7107068705f; q = q * t + (-0.142248368f); q = q * t + 0.127414796f; q = q * t;
    const float e = __builtin_amdgcn_exp2f((v * v) * (-0.72134752044f));
    const float m = v * (q * e);
    return v < 0.f ? m : v - m;
}

#define XB_TMO      128
#define XB_XCNT(j)  (256  + 64 * (j))
#define XB_XSUB(j)  (1280 + 64 * (j))
#define XB_XGEN(j)  (2304 + 64 * (j))
#define XB_TOP      3328
#define XB_TOPGEN   3392
#define XCD_BAR_WORDS 3456
#define XB_SPIN_CAP (1u << 22)
static_assert(XCD_BAR_WORDS == XCD_BAR_WORDS_C, "barrier words");
__device__ __forceinline__ unsigned xb_ld(unsigned* p)              { return __hip_atomic_load(p, __ATOMIC_RELAXED, __HIP_MEMORY_SCOPE_AGENT); }
__device__ __forceinline__ unsigned xb_add(unsigned* p, unsigned v) { return __hip_atomic_fetch_add(p, v, __ATOMIC_RELAXED, __HIP_MEMORY_SCOPE_AGENT); }
__device__ __forceinline__ unsigned xb_xcc_id() { return (unsigned)__builtin_amdgcn_s_getreg((3 << 11) | 20) & 0xFu; }
#define XB_SPIN(cond, bar) do { unsigned _sp = 0; while (cond) { __builtin_amdgcn_s_sleep(1); \
    if ((++_sp & 255u) == 0u) { if (xb_ld(&(bar)[XB_TMO])) break; if (_sp > XB_SPIN_CAP) { atomicAdd(&(bar)[XB_TMO], 1u); break; } } } } while (0)
struct XcdBarrier { unsigned* bar; unsigned x; volatile LAS unsigned* st; };
__device__ __forceinline__ XcdBarrier xcd_barrier_post(unsigned* bar, volatile LAS unsigned* st) {
    XcdBarrier b; b.bar = bar; b.x = xb_xcc_id(); b.st = st;
    if (threadIdx.x == 0) (void)xb_add(&bar[XB_XCNT(b.x)], 1u);
    return b;
}
__device__ __forceinline__ void xcd_barrier_complete(unsigned* bar, unsigned x, unsigned& nloc, unsigned& nx) {
    const unsigned G = gridDim.x * gridDim.y * gridDim.z;
    unsigned sum, cnt, mine, sp = 0u;
    for (;;) {
        sum = 0u; cnt = 0u; mine = 0u;
#pragma unroll
        for (unsigned j = 0; j < 16; ++j) { const unsigned c = xb_ld(&bar[XB_XCNT(j)]); sum += c; cnt += (c > 0u) ? 1u : 0u; mine = (j == x) ? c : mine; }
        if (sum == G) break;
        __builtin_amdgcn_s_sleep(1);
        if ((++sp & 255u) == 0u) { if (xb_ld(&bar[XB_TMO])) break; if (sp > XB_SPIN_CAP) { atomicAdd(&bar[XB_TMO], 1u); break; } }
    }
    nloc = mine > 0u ? mine : 1u; nx = cnt > 0u ? cnt : 1u;
}
__device__ __forceinline__ void xcd_barrier(const XcdBarrier& b) {
    asm volatile("s_waitcnt vmcnt(0)" ::: "memory");
    __syncthreads();
    if (threadIdx.x == 0) {
        unsigned* bar = b.bar;
        __builtin_amdgcn_s_waitcnt(0);
        unsigned nloc = b.st[0], nx = b.st[1];
        if (nloc == 0u) { xcd_barrier_complete(bar, b.x, nloc, nx); b.st[0] = nloc; b.st[1] = nx; }
        const unsigned old = xb_add(&bar[XB_XSUB(b.x)], 1u);
        const unsigned gen = old / nloc;
        if (old + 1u == (gen + 1u) * nloc) {
            __builtin_amdgcn_fence(__ATOMIC_RELEASE, "agent");
            asm volatile("s_waitcnt vmcnt(0)" ::: "memory");
            const unsigned og = xb_add(&bar[XB_TOP], 1u);
            const unsigned tg = og / nx;
            if (og + 1u == (tg + 1u) * nx) xb_add(&bar[XB_TOPGEN], 1u);
            else XB_SPIN(xb_ld(&bar[XB_TOPGEN]) == tg, bar);
            __builtin_amdgcn_fence(__ATOMIC_ACQUIRE, "agent");
            xb_add(&bar[XB_XGEN(b.x)], 1u);
            asm volatile("s_waitcnt vmcnt(0)" ::: "memory");
        } else {
            XB_SPIN(xb_ld(&bar[XB_XGEN(b.x)]) == gen, bar);
            __builtin_amdgcn_fence(__ATOMIC_ACQUIRE, "agent");
            asm volatile("s_waitcnt vmcnt(0)" ::: "memory");
        }
    }
    __syncthreads();
}

namespace pg8 {
constexpr int BM = 256, BK = 64, HALF = 128, HTB = HALF * BK * 2, STAGE_BYTES = 8 * HTB, NXCD = 8, WGM = 8;
__host__ __device__ __forceinline__ int lds_byte(int r, int c) { const int st = (r >> 4) * 2 + (c >> 5), rr = r & 15, cc = c & 31, ob = rr * 64 + cc * 2; return st * 1024 + (ob ^ (((ob >> 9) & 1) << 5)); }
__host__ __device__ __forceinline__ void stage_rc(int b, int& R, int& C) { const int st = b / 1024, sb = b % 1024, swz = sb ^ (((sb >> 9) & 1) << 5); R = (st >> 1) * 16 + swz / 64; C = (st & 1) * 32 + (swz % 64) / 2; }
struct Unit { int pm, pn, aux; };

struct SchedPlain {
    static constexpr bool GATHER = false;
    int nM, nN, nwg, G, c, skipctx;
    __device__ void init(int nM_, int nN_, int G_, int c_, int skipctx_) { nM = nM_; nN = nN_; nwg = nM * nN; G = G_; c = c_; skipctx = skipctx_; }
    __device__ bool next(int i, Unit& u) const {
        const long L = (long)i * G + c; if (L >= nwg) return false;
        int wgid = (int)L; { const int q = nwg / NXCD, r = nwg % NXCD, xcd = wgid % NXCD, off = wgid / NXCD; wgid = (xcd < r ? xcd * (q + 1) : r * (q + 1) + (xcd - r) * q) + off; }
        const int nig = WGM * nN, gid = wgid / nig, fm = gid * WGM, gsz = (nM - fm) < WGM ? (nM - fm) : WGM;
        int pm = fm + ((wgid % nig) % gsz); u.pn = (wgid % nig) / gsz; u.aux = 0;
        if (skipctx) pm = (pm >> 3) * 9 + 1 + (pm & 7);
        u.pm = pm; return true;
    }
    __device__ __forceinline__ int arow(const Unit& u, int r) const { return u.pm * BM + r; }
};
template <bool GATH> struct SchedMoe {
    static constexpr bool GATHER = GATH;
    const LAS int* cn; const LAS int* tb; const int* lists; int G, c, total;
    __device__ bool next(int i, Unit& u) const {
        const int U = i * G + c; if (U >= total * 4) return false;
        const int T = U >> 2, pn = U & 3; int l = 0;
        while (tb[l + 1] <= T) ++l;
        u.pm = T; u.pn = (l >> 1) * 4 + pn; u.aux = l | ((T - tb[l]) << 8); return true;
    }
    __device__ __forceinline__ int arow(const Unit& u, int r) const {
        if (!GATH) return u.pm * BM + r;
        const int l = u.aux & 255, idx = (u.aux >> 8) * BM + r;
        return idx < cn[l] ? lists[(size_t)l * TG + idx] : 0;
    }
};

template <class Epi, class Sched>
__device__ __forceinline__ void gemm_phase(const int tid, LAS unsigned char* lds, const bf16_t* A, int lda, const bf16_t* Bt, int ldb, int K, const Sched& S, const Epi& E) {
    constexpr bool GA = Sched::GATHER;
    const int wid = __builtin_amdgcn_readfirstlane(tid >> 6), lane = tid & 63, wr = wid >> 2, wc = wid & 3, fr = lane & 15, fq = lane >> 4;
    const int nt = K / BK;
    unsigned voffA[2], voffB[2];
#pragma unroll
    for (int i = 0; i < 2; ++i) { int R, C; stage_rc(tid * 16 + i * 8192, R, C); voffA[i] = (unsigned)(R * lda + C) * 2u; voffB[i] = (unsigned)(R * ldb + C) * 2u; }
    const size_t kstep = (size_t)(BK * 2);
    const size_t hstepA = (size_t)HALF * lda * 2, tstepA = 2 * hstepA;
    const size_t hstepB = (size_t)HALF * ldb * 2, tstepB = 2 * hstepB;
    const unsigned ldsw = (unsigned)wid * 1024u;
    const int aoff = lds_byte(wr * 64 + fr, fq * 8), boff = lds_byte(wc * 32 + fr, fq * 8);
#define PG8_SA(b, h) (((b) * 2 + (h)) * HTB)
#define PG8_SB(b, h) ((4 + (b) * 2 + (h)) * HTB)
#define PG8_STAGE(bufoff, gbase, voff) do { _Pragma("unroll") for (int _i = 0; _i < 2; ++_i) \
        __builtin_amdgcn_global_load_lds((const unsigned*)((const char*)(gbase) + (voff)[_i]), (LAS unsigned*)(lds + (bufoff) + ldsw + _i * 8192), 16, 0, 0); } while (0)
#define PG8_STAGE_A(bufoff, ub, gv, h, koff) do { if constexpr (GA) { PG8_STAGE(bufoff, (const char*)A + (koff), gv[h]); } else { PG8_STAGE(bufoff, (ub) + (h) * hstepA + (koff), voffA); } } while (0)
#define PG8_LDA(dst, b, h) do { _Pragma("unroll") for (int m = 0; m < 4; ++m) _Pragma("unroll") for (int k = 0; k < 2; ++k) dst[m][k] = *(const LAS bf16x8*)(lds + PG8_SA(b, h) + aoff + m * 2048 + k * 1024); } while (0)
#define PG8_LDB(dst, b, h) do { _Pragma("unroll") for (int n = 0; n < 2; ++n) _Pragma("unroll") for (int k = 0; k < 2; ++k) dst[n][k] = *(const LAS bf16x8*)(lds + PG8_SB(b, h) + boff + n * 2048 + k * 1024); } while (0)
#define PG8_MMA(ai, bj, At, Bt_) do { __builtin_amdgcn_s_setprio(1); _Pragma("unroll") for (int m = 0; m < 4; ++m) _Pragma("unroll") for (int n = 0; n < 2; ++n) _Pragma("unroll") for (int k = 0; k < 2; ++k) \
        acc[ai][bj][m][n] = __builtin_amdgcn_mfma_f32_16x16x32_bf16(Bt_[n][k], At[m][k], acc[ai][bj][m][n], 0, 0, 0); __builtin_amdgcn_s_setprio(0); } while (0)
#define PG8_WAIT_V(n) asm volatile("s_waitcnt vmcnt(" #n ")" ::: "memory")
#define PG8_WAIT_L(n) asm volatile("s_waitcnt lgkmcnt(" #n ")" ::: "memory")
#define PG8_BAR __builtin_amdgcn_s_barrier()
#define PG8_SCHED __builtin_amdgcn_sched_barrier(0)
#define PG8_GOFF(dst, u) do { if constexpr (GA) { _Pragma("unroll") for (int _h = 0; _h < 2; ++_h) _Pragma("unroll") for (int _i = 0; _i < 2; ++_i) { int R_, C_; stage_rc(tid * 16 + _i * 8192, R_, C_); \
        dst[_h][_i] = ((unsigned)S.arow(u, _h * HALF + R_) * (unsigned)lda + (unsigned)C_) * 2u; } } } while (0)
    Unit cur, nxt; int ui = 0;
    if (!S.next(0, cur)) return;
    f32x4 acc[2][2][4][2];
#pragma unroll
    for (int a = 0; a < 2; ++a)
#pragma unroll
        for (int b = 0; b < 2; ++b)
#pragma unroll
            for (int m = 0; m < 4; ++m)
#pragma unroll
                for (int n = 0; n < 2; ++n) acc[a][b][m][n] = (f32x4){0.f, 0.f, 0.f, 0.f};
    bf16x8 At[4][2], B0[2][2], B1[2][2];
    unsigned gAc[2][2], gAn[2][2];
    PG8_GOFF(gAc, cur);
    const char* cA = (const char*)A + (GA ? (size_t)0 : (size_t)cur.pm * tstepA);
    const char* cB = (const char*)Bt + (size_t)cur.pn * tstepB;
    PG8_STAGE(PG8_SB(0, 0), cB, voffB); PG8_STAGE_A(PG8_SA(0, 0), cA, gAc, 0, 0); PG8_STAGE(PG8_SB(0, 1), cB + hstepB, voffB); PG8_STAGE_A(PG8_SA(0, 1), cA, gAc, 1, 0);
    if (wr == 1) PG8_BAR;
    PG8_WAIT_V(4); PG8_BAR;
    PG8_STAGE(PG8_SB(1, 0), cB + kstep, voffB); PG8_STAGE_A(PG8_SA(1, 0), cA, gAc, 0, kstep); PG8_STAGE(PG8_SB(1, 1), cB + hstepB + kstep, voffB);
    PG8_WAIT_V(6); PG8_BAR;
    for (;;) {
        const bool has_next = S.next(ui + 1, nxt);
        if (has_next) { PG8_GOFF(gAn, nxt); }
        else if constexpr (GA) {
#pragma unroll
            for (int _h = 0; _h < 2; ++_h)
#pragma unroll
                for (int _i = 0; _i < 2; ++_i) gAn[_h][_i] = gAc[_h][_i];
        }
        const char* nA = (has_next && !GA) ? (const char*)A + (size_t)nxt.pm * tstepA : cA;
        const char* nB = has_next ? (const char*)Bt + (size_t)nxt.pn * tstepB : cB;
#pragma unroll 1
        for (int t = 0; t < nt; t += 2) {
            const bool last = (t == nt - 2);
            const size_t k1 = (size_t)(t + 1) * kstep;
            const size_t k2 = last ? (size_t)0 : (size_t)(t + 2) * kstep, k3 = k2 + kstep;
            const char* a2 = last ? nA : cA; const char* b2 = last ? nB : cB;
            unsigned g2[2][2];
            if constexpr (GA) {
#pragma unroll
                for (int _h = 0; _h < 2; ++_h)
#pragma unroll
                    for (int _i = 0; _i < 2; ++_i) g2[_h][_i] = last ? gAn[_h][_i] : gAc[_h][_i];
            }
            PG8_LDB(B0, 0, 0); PG8_SCHED; PG8_LDA(At, 0, 0); PG8_STAGE_A(PG8_SA(1, 1), cA, gAc, 1, k1);
            PG8_WAIT_L(8); PG8_BAR; PG8_WAIT_L(0); PG8_MMA(0, 0, At, B0); PG8_BAR; PG8_SCHED;
            PG8_LDB(B1, 0, 1); PG8_STAGE(PG8_SB(0, 0), b2 + k2, voffB);
            PG8_BAR; PG8_WAIT_L(0); PG8_MMA(0, 1, At, B1); PG8_BAR;
            PG8_LDA(At, 0, 1); PG8_STAGE_A(PG8_SA(0, 0), a2, g2, 0, k2);
            PG8_BAR; PG8_WAIT_L(0); PG8_MMA(1, 0, At, B0); PG8_BAR; PG8_SCHED;
            PG8_STAGE(PG8_SB(0, 1), b2 + hstepB + k2, voffB);
            PG8_WAIT_V(6); PG8_BAR; PG8_MMA(1, 1, At, B1); PG8_BAR;
            PG8_LDB(B0, 1, 0); PG8_SCHED; PG8_LDA(At, 1, 0); PG8_STAGE_A(PG8_SA(0, 1), a2, g2, 1, k2);
            PG8_WAIT_L(8); PG8_BAR; PG8_WAIT_L(0); PG8_MMA(0, 0, At, B0); PG8_BAR; PG8_SCHED;
            PG8_LDB(B1, 1, 1); PG8_STAGE(PG8_SB(1, 0), b2 + k3, voffB);
            PG8_BAR; PG8_WAIT_L(0); PG8_MMA(0, 1, At, B1); PG8_BAR;
            PG8_LDA(At, 1, 1); PG8_STAGE_A(PG8_SA(1, 0), a2, g2, 0, k3);
            PG8_BAR; PG8_WAIT_L(0); PG8_MMA(1, 0, At, B0); PG8_BAR; PG8_SCHED;
            PG8_STAGE(PG8_SB(1, 1), b2 + hstepB + k3, voffB);
            PG8_WAIT_V(6); PG8_BAR; PG8_MMA(1, 1, At, B1); PG8_BAR;
        }
        { int fr_e = fr, fq_e = fq; asm volatile("" : "+v"(fr_e), "+v"(fq_e)); E(acc, cur, wr, wc, fr_e, fq_e); }
        if (!has_next) break;
#pragma unroll
        for (int a = 0; a < 2; ++a)
#pragma unroll
            for (int b = 0; b < 2; ++b)
#pragma unroll
                for (int m = 0; m < 4; ++m)
#pragma unroll
                    for (int n = 0; n < 2; ++n) acc[a][b][m][n] = (f32x4){0.f, 0.f, 0.f, 0.f};
        cur = nxt; cA = nA; cB = nB; ++ui;
        if constexpr (GA) {
#pragma unroll
            for (int _h = 0; _h < 2; ++_h)
#pragma unroll
                for (int _i = 0; _i < 2; ++_i) gAc[_h][_i] = gAn[_h][_i];
        }
    }
    PG8_WAIT_V(0);
    if (wr == 0) PG8_BAR;
    PG8_BAR;
#undef PG8_SA
#undef PG8_SB
#undef PG8_STAGE
#undef PG8_STAGE_A
#undef PG8_LDA
#undef PG8_LDB
#undef PG8_MMA
#undef PG8_WAIT_V
#undef PG8_WAIT_L
#undef PG8_BAR
#undef PG8_SCHED
#undef PG8_GOFF
}
}
using pg8::Unit;

#define EPI_LOOP_BEGIN \
    _Pragma("unroll") for (int ai = 0; ai < 2; ++ai) _Pragma("unroll") for (int m = 0; m < 4; ++m) { const int trow = ai * 128 + wr * 64 + m * 16 + fr; \
    _Pragma("unroll") for (int bj = 0; bj < 2; ++bj) _Pragma("unroll") for (int n = 0; n < 2; ++n) { const int tcol = bj * 128 + wc * 32 + n * 16 + 4 * fq; const f32x4 v = acc[ai][bj][m][n];
#define EPI_LOOP_END } asm volatile("" ::: "memory"); }

struct EpiG1 {
    unsigned char* ws; size_t voff;
    __device__ __forceinline__ void operator()(const f32x4 (&acc)[2][2][4][2], const Unit& u, int wr, int wc, int fr, int fq) const {
        const int pn = u.pn; const size_t row0 = (size_t)u.pm * 256;
        if (pn < 12) {
            const size_t off = pn < 4 ? (WS_ARENA + AR_R) : (pn < 8 ? (WS_ARENA + AR_K) : voff);
            bf16_t* dst = (bf16_t*)(ws + off); const int cb = (pn & 3) * 256;
            EPI_LOOP_BEGIN
                u32x2 w; w.x = pk2(v[0], v[1]); w.y = pk2(v[2], v[3]);
                *(u32x2*)(dst + (row0 + trow) * D + cb + tcol) = w;
            EPI_LOOP_END
        } else {
            bf16_t* L1 = (bf16_t*)(ws + WS_ARENA + AR_L1);
            const int cb = (pn - 12) * 256;
            EPI_LOOP_BEGIN
                f32x4 o = v;
                if (pn == 12 && bj == 0) { o[0] = tanhf_(v[0]); o[1] = tanhf_(v[1]); o[2] = tanhf_(v[2]); o[3] = tanhf_(v[3]); }
                if (pn == 13 && bj == 0) { o[0] = sigmoidf_(v[0]); o[1] = sigmoidf_(v[1]); o[2] = sigmoidf_(v[2]); o[3] = sigmoidf_(v[3]); }
                u32x2 w; w.x = pk2(o[0], o[1]); w.y = pk2(o[2], o[3]);
                *(u32x2*)(L1 + (row0 + trow) * 512 + cb + tcol) = w;
            EPI_LOOP_END
        }
    }
};
template <int ACT> struct EpiStore {
    bf16_t* O; const float* bias;
    __device__ __forceinline__ void operator()(const f32x4 (&acc)[2][2][4][2], const Unit& u, int wr, int wc, int fr, int fq) const {
        const size_t row0 = (size_t)u.pm * 256; const int cb = u.pn * 256;
        EPI_LOOP_BEGIN
            f32x4 o = v;
            if (ACT == 1) { const f32x4 b = *(const f32x4*)(bias + cb + tcol); o[0] = sigmoidf_(v[0] + b[0]); o[1] = sigmoidf_(v[1] + b[1]); o[2] = sigmoidf_(v[2] + b[2]); o[3] = sigmoidf_(v[3] + b[3]); }
            u32x2 w; w.x = pk2(o[0], o[1]); w.y = pk2(o[2], o[3]);
            *(u32x2*)(O + (row0 + trow) * D + cb + tcol) = w;
        EPI_LOOP_END
    }
};
struct EpiGelu {
    bf16_t* Z; const float* bias;
    __device__ __forceinline__ void operator()(const f32x4 (&acc)[2][2][4][2], const Unit& u, int wr, int wc, int fr, int fq) const {
        const size_t row0 = (size_t)u.pm * 256; const int cb = u.pn * 256;
        EPI_LOOP_BEGIN
            const f32x4 b = *(const f32x4*)(bias + cb + tcol);
            u32x2 w; w.x = pk2(gelu_f(v[0] + b[0]), gelu_f(v[1] + b[1])); w.y = pk2(gelu_f(v[2] + b[2]), gelu_f(v[3] + b[3]));
            *(u32x2*)(Z + (row0 + trow) * 4096 + cb + tcol) = w;
        EPI_LOOP_END
    }
};
struct EpiMG {
    bf16_t* HE;
    __device__ __forceinline__ void operator()(const f32x4 (&acc)[2][2][4][2], const Unit& u, int wr, int wc, int fr, int fq) const {
        const size_t row0 = (size_t)u.pm * 256; const int pnl = u.pn & 3;
#pragma unroll
        for (int ai = 0; ai < 2; ++ai)
#pragma unroll
            for (int m = 0; m < 4; ++m) { const int trow = ai * 128 + wr * 64 + m * 16 + fr;
#pragma unroll
                for (int bj = 0; bj < 2; ++bj) {
                    const f32x4 gt = acc[ai][bj][m][0], up = acc[ai][bj][m][1];
                    const int f = (8 * pnl + 4 * bj + wc) * 16 + 4 * fq;
                    float o[4];
#pragma unroll
                    for (int e = 0; e < 4; ++e) o[e] = gt[e] * sigmoidf_(gt[e]) * up[e];
                    u32x2 w; w.x = pk2(o[0], o[1]); w.y = pk2(o[2], o[3]);
                    *(u32x2*)(HE + (row0 + trow) * FEXP + f) = w;
                } }
    }
};
struct EpiMD {
    bf16_t* Y0; const int* lists; const float* lw; const LAS int* cn;
    __device__ __forceinline__ void operator()(const f32x4 (&acc)[2][2][4][2], const Unit& u, int wr, int wc, int fr, int fq) const {
        const int l = u.aux & 255, t0 = (u.aux >> 8) * 256, cnt = cn[l]; const int cb = (u.pn & 3) * 256;
        bf16_t* Y = Y0 + (size_t)(l & 1) * ((AR_YM1 - AR_YM0) / 2);
#pragma unroll
        for (int ai = 0; ai < 2; ++ai)
#pragma unroll
            for (int m = 0; m < 4; ++m) { const int trow = ai * 128 + wr * 64 + m * 16 + fr; const int idx = t0 + trow;
                if (idx < cnt) {
                    const int tok = lists[(size_t)l * TG + idx]; const float wgt = lw[(size_t)l * TG + idx];
#pragma unroll
                    for (int bj = 0; bj < 2; ++bj)
#pragma unroll
                        for (int n = 0; n < 2; ++n) { const int tcol = bj * 128 + wc * 32 + n * 16 + 4 * fq; const f32x4 v = acc[ai][bj][m][n];
                            u32x2 w; w.x = pk2(v[0] * wgt, v[1] * wgt); w.y = pk2(v[2] * wgt, v[3] * wgt);
                            *(u32x2*)(Y + (size_t)tok * D + cb + tcol) = w; }
                } }
    }
};

struct Frame {
    const Params __attribute__((address_space(4)))* kp; LAS unsigned char* lds; int tid, lane, wave, G, bid;
    unsigned char* ws;
    __device__ __forceinline__ const float* in(int k) const { return kp->in[k]; }
    __device__ __forceinline__ float* outp() const { return kp->out; }
    template <class T> __device__ __forceinline__ T* wsp(size_t off) const { return (T*)(ws + off); }
    template <class T> __device__ __forceinline__ T* ar(size_t off) const { return (T*)(ws + WS_ARENA + off); }
    __device__ __forceinline__ const float* modL(int layer, int b, int j) const { return (const float*)(ws + WS_MODL) + (((size_t)layer * NB + b) * 6 + j) * D; }
    __device__ __forceinline__ const float* modC(int layer, int j) const { return (const float*)(ws + WS_MODC) + ((size_t)layer * 6 + j) * D; }
};

struct TJob { const float* src; bf16_t* dst; const float* ksc; int lds, K, N, ldd, kofs, nofs, inter; };
constexpr int NJOBS = 2 * 24 + 1 + 4 + 4 * NEXP * 3;
__device__ __forceinline__ TJob get_job(const Frame& F, int j) {
    TJob J; J.ksc = nullptr; J.kofs = 0; J.nofs = 0; J.inter = 0; J.K = 0; J.N = 0; J.lds = 0; J.ldd = 0; J.src = nullptr; J.dst = nullptr;
    if (j < 48) {
        const int a = j / 24, q = j % 24;
        if (q < 18) {
            const int half = q / 9, w = q % 9; const float* mu = F.in(8) + (size_t)a * 6 * D;
            J.dst = F.wsp<bf16_t>(WS_W1CAT) + (size_t)a * N1CAT * K1CAT; J.ldd = K1CAT; J.kofs = half * 1024; J.K = D; int mi = 0;
            if (w == 0) { J.src = F.in(9) + (size_t)a * D * D; J.lds = D; J.N = D; J.nofs = 0; mi = 0; }
            else if (w == 1) { J.src = F.in(10) + (size_t)a * D * D; J.lds = D; J.N = D; J.nofs = 1024; mi = 2; }
            else if (w == 2) { J.src = F.in(11) + (size_t)a * D * D; J.lds = D; J.N = D; J.nofs = 2048; mi = 3; }
            else if (w < 5) { const int d = w - 3; J.src = F.in(14) + ((size_t)a * 2 + d) * D * 64; J.lds = 64; J.N = 64; J.nofs = 3072 + d * 64; mi = 1; }
            else if (w < 7) { const int d = w - 5; J.src = F.in(17) + ((size_t)a * 2 + d) * D * 64; J.lds = 64; J.N = 64; J.nofs = 3200 + d * 64; mi = 4; }
            else if (w == 7) { J.src = F.in(22) + (size_t)a * D * 128; J.lds = 128; J.N = 128; J.nofs = 3328; mi = 5; }
            else { J.src = F.in(20); J.lds = 32; J.N = (a == 1) ? 32 : 0; J.nofs = 3456; mi = 3; }
            if (half) J.ksc = mu + mi * D;
        } else if (q == 18) { J.src = F.in(12) + (size_t)a * D * D; J.lds = D; J.K = D; J.N = D; J.dst = F.wsp<bf16_t>(WS_WO) + (size_t)a * D * D; J.ldd = D; }
        else if (q == 19) { J.src = F.in(23) + (size_t)a * 128 * D; J.lds = D; J.K = 128; J.N = D; J.dst = F.wsp<bf16_t>(WS_G2T) + (size_t)a * D * 256; J.ldd = 256; }
        else if (q < 22) { const int d = q - 20; J.src = F.in(15) + ((size_t)a * 2 + d) * 64 * D; J.lds = D; J.K = 64; J.N = D; J.dst = F.wsp<bf16_t>(WS_W2T) + ((size_t)a * 2 + d) * D * 64; J.ldd = 64; }
        else { const int d = q - 22; J.src = F.in(18) + ((size_t)a * 2 + d) * 64 * D; J.lds = D; J.K = 64; J.N = D; J.dst = F.wsp<bf16_t>(WS_A2T) + ((size_t)a * 2 + d) * D * 64; J.ldd = 64; }
    } else if (j == 48) { J.src = F.in(21); J.lds = D; J.K = 32; J.N = D; J.dst = F.wsp<bf16_t>(WS_V2T); J.ldd = 256; J.kofs = 128; }
    else if (j < 53) {
        const int q = j - 49, b = q >> 1;
        if ((q & 1) == 0) { J.src = F.in(29) + (size_t)b * D * 4096; J.lds = 4096; J.K = D; J.N = 4096; J.dst = F.wsp<bf16_t>(WS_WIN) + (size_t)b * 4096 * D; J.ldd = D; }
        else { J.src = F.in(35) + (size_t)b * 2048 * D; J.lds = D; J.K = 2048; J.N = D; J.dst = F.wsp<bf16_t>(WS_WOUT) + (size_t)b * D * 2048; J.ldd = 2048; }
    } else {
        const int q = j - 53, ie = q / 3, w = q % 3;
        if (w < 2) { J.src = F.in(38 + w) + (size_t)ie * D * FEXP; J.lds = FEXP; J.K = D; J.N = FEXP; J.dst = F.wsp<bf16_t>(WS_WGU) + (size_t)ie * 1024 * D; J.ldd = D; J.nofs = w * 16; J.inter = 1; }
        else { J.src = F.in(40) + (size_t)ie * FEXP * D; J.lds = D; J.K = FEXP; J.N = D; J.dst = F.wsp<bf16_t>(WS_WD) + (size_t)ie * D * FEXP; J.ldd = FEXP; }
    }
    return J;
}
__device__ __forceinline__ void transpose_all(const Frame& F) {
    LAS float* tile = (LAS float*)F.lds;
    int tilectr = 0;
#pragma unroll 1
    for (int j = 0; j < NJOBS; ++j) {
        const TJob J = get_job(F, j);
        const int tk = (J.K + 63) / 64, tn = (J.N + 63) / 64, ntile = tk * tn;
        int t = (F.bid - (tilectr % F.G) + F.G) % F.G;
        tilectr += ntile;
#pragma unroll 1
        for (; t < ntile; t += F.G) {
            const int k0 = (t / tn) * 64, n0 = (t % tn) * 64;
            __syncthreads();
#pragma unroll
            for (int e = 0; e < 8; ++e) { const int idx = F.tid + e * 512, kk = idx >> 6, nn = idx & 63;
                float v = 0.f; if (k0 + kk < J.K && n0 + nn < J.N) { v = J.src[(size_t)(k0 + kk) * J.lds + n0 + nn]; if (J.ksc) v *= J.ksc[k0 + kk]; }
                tile[kk * 65 + nn] = v; }
            __syncthreads();
#pragma unroll
            for (int e = 0; e < 8; ++e) { const int idx = F.tid + e * 512, nn = idx >> 6, kk = idx & 63;
                if (k0 + kk < J.K && n0 + nn < J.N) { const int n = n0 + nn; const int row = J.nofs + (J.inter ? ((n >> 4) * 32 + (n & 15)) : n);
                    J.dst[(size_t)row * J.ldd + J.kofs + k0 + kk] = f2bf(tile[kk * 65 + nn]); } }
        }
    }
    __syncthreads();
}
__device__ __forceinline__ void zero_rows(const Frame& F, bf16_t* dst, int ldd, int row0, int nrows, int col0, int ncols) {
    const int per = ncols / 8; const long tot = (long)nrows * per;
    for (long i = (long)F.bid * NTHREADS + F.tid; i < tot; i += (long)F.G * NTHREADS) { const int r = (int)(i / per), c = (int)(i % per) * 8;
        *(u32x4*)(dst + (size_t)(row0 + r) * ldd + col0 + c) = (u32x4){0u, 0u, 0u, 0u}; }
}
__device__ __forceinline__ void phase_prologue(const Frame& F) {
    {
        LAS float* sl = (LAS float*)F.lds;
        LAS float* red = (LAS float*)(F.lds + 33 * 256 * 4);
        const float* c = F.in(1); const float* cc = F.in(3); const float* wm = F.in(4); const float* bm = F.in(5);
        const int tx = F.tid & 63, ty = F.tid >> 6;
        for (int unit = F.bid; unit < 4 * 96; unit += F.G) {
            const int layer = unit / 96, col0 = (unit % 96) * 64;
            float acc[33];
#pragma unroll
            for (int r = 0; r < 33; ++r) acc[r] = 0.f;
#pragma unroll 1
            for (int kc = 0; kc < 4; ++kc) {
                __syncthreads();
                for (int i = F.tid; i < 33 * 256; i += NTHREADS) { const int r = i >> 8, k = (i & 255) + kc * 256; const float x = r < 32 ? c[r * D + k] : cc[k]; sl[i] = x * sigmoidf_(x); }
                __syncthreads();
#pragma unroll 1
                for (int k4 = 0; k4 < 32; k4 += 4) {
                    const int kl = ty * 32 + k4;
                    float w[4];
#pragma unroll
                    for (int e = 0; e < 4; ++e) w[e] = wm[((size_t)layer * D + kc * 256 + kl + e) * 6144 + col0 + tx];
#pragma unroll
                    for (int r = 0; r < 33; ++r) { const f32x4 s = *(const LAS f32x4*)(sl + r * 256 + kl); acc[r] += s[0] * w[0] + s[1] * w[1] + s[2] * w[2] + s[3] * w[3]; if ((r & 7) == 7) asm volatile("" ::: "memory"); }
                }
            }
            __syncthreads();
#pragma unroll
            for (int r = 0; r < 33; ++r) red[(ty * 33 + r) * 64 + tx] = acc[r];
            __syncthreads();
            for (int i = F.tid; i < 33 * 64; i += NTHREADS) { const int r = i >> 6, x = i & 63; float s = 0.f;
#pragma unroll
                for (int y = 0; y < 8; ++y) s += red[(y * 33 + r) * 64 + x];
                const int col = col0 + x; s += bm[layer * 6144 + col];
                if (r < 32) F.wsp<float>(WS_MODL)[((size_t)layer * NB + r) * 6144 + col] = s; else F.wsp<float>(WS_MODC)[(size_t)layer * 6144 + col] = s; }
        }
    }
    __syncthreads();
    transpose_all(F);
    for (int a = 0; a < 2; ++a) {
        bf16_t* W1 = F.wsp<bf16_t>(WS_W1CAT) + (size_t)a * N1CAT * K1CAT;
        if (a == 0) zero_rows(F, W1, K1CAT, 3456, 128, 0, K1CAT); else zero_rows(F, W1, K1CAT, 3488, 96, 0, K1CAT);
        zero_rows(F, F.wsp<bf16_t>(WS_G2T) + (size_t)a * D * 256, 256, 0, D, 128, 128);
    }
    zero_rows(F, F.wsp<bf16_t>(WS_V2T), 256, 0, D, 0, 128); zero_rows(F, F.wsp<bf16_t>(WS_V2T), 256, 0, D, 160, 96);
    {
        const float* src = F.in(33); bf16_t* dst = F.wsp<bf16_t>(WS_WSP); const long tot = (long)2 * 16 * 128 * 128 / 4;
        for (long i = (long)F.bid * NTHREADS + F.tid; i < tot; i += (long)F.G * NTHREADS) { const f32x4 v = *(const f32x4*)(src + i * 4); u32x2 w; w.x = pk2(v[0], v[1]); w.y = pk2(v[2], v[3]); *(u32x2*)(dst + i * 4) = w; }
    }
    __syncthreads();
}

__device__ __forceinline__ void phase_norm1(const Frame& F, int g, int layer  , bf16_t* dst, int ldh) {
    float* X = F.wsp<float>(WS_X);
    const bf16_t* Y0 = F.ar<bf16_t>(AR_YM0); const bf16_t* Y1 = F.ar<bf16_t>(AR_YM1);
    const bool fin = layer == 4;
    for (int r = F.bid * NWAVES + F.wave; r < TG; r += F.G * NWAVES) {
        const int bl = r / LT, t = r % LT, b = g * BG + bl; const bool isctx = t < LC;
        if (isctx && layer >= 3) continue;
        f32x4 x[4];
        if (layer == 0) {
            const float* src = isctx ? F.in(2) + ((size_t)b * LC + t) * D : F.in(0) + ((size_t)b * SEQ + (t - LC)) * D;
#pragma unroll
            for (int q = 0; q < 4; ++q) x[q] = *(const f32x4*)(src + q * 256 + F.lane * 4);
        } else {
            const float* gt = isctx ? F.modC(layer - 1, 5) : F.modL(layer - 1, b, 5);
#pragma unroll
            for (int q = 0; q < 4; ++q) { const int c = q * 256 + F.lane * 4;
                x[q] = *(const f32x4*)(X + (size_t)r * D + c);
                const u32x2 a = *(const u32x2*)(Y0 + (size_t)r * D + c), bb = *(const u32x2*)(Y1 + (size_t)r * D + c);
                const f32x4 gv = *(const f32x4*)(gt + c);
                x[q][0] += gv[0] * (lo16(a.x) + lo16(bb.x)); x[q][1] += gv[1] * (hi16(a.x) + hi16(bb.x));
                x[q][2] += gv[2] * (lo16(a.y) + lo16(bb.y)); x[q][3] += gv[3] * (hi16(a.y) + hi16(bb.y)); }
        }
        float ss = 0.f;
#pragma unroll
        for (int q = 0; q < 4; ++q) ss += x[q][0] * x[q][0] + x[q][1] * x[q][1] + x[q][2] * x[q][2] + x[q][3] * x[q][3];
        ss = wave_sum(ss);
        const float rstd = rsqrtf(ss * (1.0f / D) + 1e-6f);
        if (fin) {
            float* o = F.outp() + ((size_t)b * SEQ + (t - LC)) * D; const float* fg = F.in(41);
#pragma unroll
            for (int q = 0; q < 4; ++q) { const int c = q * 256 + F.lane * 4; const f32x4 gv = *(const f32x4*)(fg + c); *(f32x4*)(o + c) = x[q] * rstd * gv; }
        } else {
            const float* gn = F.in(6) + (size_t)layer * D;
            const float* sh = isctx ? F.modC(layer, 0) : F.modL(layer, b, 0);
            const float* sc = isctx ? F.modC(layer, 1) : F.modL(layer, b, 1);
#pragma unroll
            for (int q = 0; q < 4; ++q) { const int c = q * 256 + F.lane * 4;
                *(f32x4*)(X + (size_t)r * D + c) = x[q];
                const f32x4 gv = *(const f32x4*)(gn + c), sv = *(const f32x4*)(sh + c), cv = *(const f32x4*)(sc + c);
                const f32x4 h = x[q] * rstd * gv * (1.0f + cv) + sv;
                u32x2 w; w.x = pk2(h[0], h[1]); w.y = pk2(h[2], h[3]);
                *(u32x2*)(dst + (size_t)r * ldh + c) = w; }
        }
    }
}
__device__ __forceinline__ void phase_mix(const Frame& F) {
    bf16_t* H2 = F.ar<bf16_t>(AR_H2);
    for (int r = F.bid * NWAVES + F.wave; r < TG; r += F.G * NWAVES) {
        const int t = r % LT; const bool isctx = t < LC; const int p = t - LC;
#pragma unroll
        for (int q = 0; q < 2; ++q) {
            const int c = q * 512 + F.lane * 8;
            int nr;
            if (isctx) nr = (q == 0) ? (t > 0 ? r - 1 : -1) : (t < LC - 1 ? r + 1 : -1);
            else { const int qu = c >> 8;
                nr = qu == 0 ? ((p & 63) > 0 ? r - 1 : -1) : qu == 1 ? ((p & 63) < 63 ? r + 1 : -1) : qu == 2 ? (p >= 64 ? r - 64 : -1) : (p < SEQ - 64 ? r + 64 : -1); }
            const u32x4 hs = *(const u32x4*)(H2 + (size_t)r * 2048 + c);
            u32x4 hn = (u32x4){0u, 0u, 0u, 0u};
            if (nr >= 0) hn = *(const u32x4*)(H2 + (size_t)nr * 2048 + c);
            u32x4 o;
            o.x = pk2(lo16(hn.x) - lo16(hs.x), hi16(hn.x) - hi16(hs.x)); o.y = pk2(lo16(hn.y) - lo16(hs.y), hi16(hn.y) - hi16(hs.y));
            o.z = pk2(lo16(hn.z) - lo16(hs.z), hi16(hn.z) - hi16(hs.z)); o.w = pk2(lo16(hn.w) - lo16(hs.w), hi16(hn.w) - hi16(hs.w));
            *(u32x4*)(H2 + (size_t)r * 2048 + 1024 + c) = o;
        }
    }
}
__device__ __forceinline__ void phase_vfix(const Frame& F) {
    bf16_t* V = F.ar<bf16_t>(AR_V); const bf16_t* VF = F.wsp<bf16_t>(WS_VF); const bf16_t* GT = F.ar<bf16_t>(AR_VGATE);
    const size_t tot = (size_t)TG * D / 8;
    for (size_t i = (size_t)F.bid * NTHREADS + F.tid; i < tot; i += (size_t)F.G * NTHREADS) {
        const u32x4 v = *(const u32x4*)(V + i * 8), f = *(const u32x4*)(VF + i * 8), g = *(const u32x4*)(GT + i * 8);
        u32x4 o;
        o.x = pk2(lo16(v.x) + (lo16(f.x) - lo16(v.x)) * lo16(g.x), hi16(v.x) + (hi16(f.x) - hi16(v.x)) * hi16(g.x));
        o.y = pk2(lo16(v.y) + (lo16(f.y) - lo16(v.y)) * lo16(g.y), hi16(v.y) + (hi16(f.y) - hi16(v.y)) * hi16(g.y));
        o.z = pk2(lo16(v.z) + (lo16(f.z) - lo16(v.z)) * lo16(g.z), hi16(v.z) + (hi16(f.z) - hi16(v.z)) * hi16(g.z));
        o.w = pk2(lo16(v.w) + (lo16(f.w) - lo16(v.w)) * lo16(g.w), hi16(v.w) + (hi16(f.w) - hi16(v.w)) * hi16(g.w));
        *(u32x4*)(V + i * 8) = o;
    }
}
__device__ __forceinline__ void phase_post(const Frame& F, int a, const bf16_t* V) {
    bf16_t* Y0 = F.ar<bf16_t>(AR_Y0); const bf16_t* Y1 = F.ar<bf16_t>(AR_Y1); const float* DOT = F.ar<float>(AR_DOT); const bf16_t* Gb = F.ar<bf16_t>(AR_G);
    const float* lg = F.in(27) + (size_t)a * D; const float* lb = F.in(28) + (size_t)a * D;
    for (int r = F.bid * NWAVES + F.wave; r < TG; r += F.G * NWAVES) {
        const int c = F.lane * 16, h = F.lane >> 2;
        float y[16], vv[16];
#pragma unroll
        for (int q = 0; q < 2; ++q) {
            const u32x4 a0 = *(const u32x4*)(Y0 + (size_t)r * D + c + q * 8), a1 = *(const u32x4*)(Y1 + (size_t)r * D + c + q * 8), v4 = *(const u32x4*)(V + (size_t)r * D + c + q * 8);
            y[q * 8 + 0] = lo16(a0.x) + lo16(a1.x); y[q * 8 + 1] = hi16(a0.x) + hi16(a1.x); y[q * 8 + 2] = lo16(a0.y) + lo16(a1.y); y[q * 8 + 3] = hi16(a0.y) + hi16(a1.y);
            y[q * 8 + 4] = lo16(a0.z) + lo16(a1.z); y[q * 8 + 5] = hi16(a0.z) + hi16(a1.z); y[q * 8 + 6] = lo16(a0.w) + lo16(a1.w); y[q * 8 + 7] = hi16(a0.w) + hi16(a1.w);
            vv[q * 8 + 0] = lo16(v4.x); vv[q * 8 + 1] = hi16(v4.x); vv[q * 8 + 2] = lo16(v4.y); vv[q * 8 + 3] = hi16(v4.y);
            vv[q * 8 + 4] = lo16(v4.z); vv[q * 8 + 5] = hi16(v4.z); vv[q * 8 + 6] = lo16(v4.w); vv[q * 8 + 7] = hi16(v4.w);
        }
        float s = 0.f;
#pragma unroll
        for (int e = 0; e < 16; ++e) s += y[e];
        s = red4(s); const float mean = s * (1.0f / 64.0f);
        float qv = 0.f;
#pragma unroll
        for (int e = 0; e < 16; ++e) { const float dd = y[e] - mean; qv += dd * dd; }
        qv = red4(qv); const float rstd = rsqrtf(qv * (1.0f / 64.0f) + 64e-5f);
        const float dsum = DOT[(size_t)r * NH + h] + DOT[((size_t)TG + r) * NH + h];
        unsigned o[8];
        const u32x4 g0 = *(const u32x4*)(Gb + (size_t)r * D + c), g1 = *(const u32x4*)(Gb + (size_t)r * D + c + 8);
        const unsigned gw[8] = {g0.x, g0.y, g0.z, g0.w, g1.x, g1.y, g1.z, g1.w};
#pragma unroll
        for (int e = 0; e < 16; e += 2) {
            const float o0 = ((y[e] - mean) * rstd * lg[c + e] + lb[c + e] + vv[e] * dsum) * lo16(gw[e >> 1]);
            const float o1 = ((y[e + 1] - mean) * rstd * lg[c + e + 1] + lb[c + e + 1] + vv[e + 1] * dsum) * hi16(gw[e >> 1]);
            o[e >> 1] = pk2(o0, o1);
        }
        *(u32x4*)(Y0 + (size_t)r * D + c) = (u32x4){o[0], o[1], o[2], o[3]};
        *(u32x4*)(Y0 + (size_t)r * D + c + 8) = (u32x4){o[4], o[5], o[6], o[7]};
    }
}
__device__ __forceinline__ void phase_norm2(const Frame& F, int g, int layer) {
    float* X = F.wsp<float>(WS_X); bf16_t* HM = F.ar<bf16_t>(AR_HM); const bf16_t* Ob = F.ar<bf16_t>(AR_O);
    int* lists = F.ar<int>(AR_LIST); float* lwt = F.ar<float>(AR_LW);
    unsigned* cnt = (unsigned*)(F.ws + WS_CTL + CTL_CNT_OFF) + ((size_t)g * 4 + layer) * 32;
    LAS float* wr = (LAS float*)F.lds;
    __syncthreads();
    for (int i = F.tid; i < D * NEXP / 4; i += NTHREADS) *(LAS f32x4*)(wr + i * 4) = *(const f32x4*)(F.in(36) + i * 4);
    __syncthreads();
    const float* rbias = F.in(37);
    const bool ctx_out = layer < 2;
    for (int r = F.bid * NWAVES + F.wave; r < TG; r += F.G * NWAVES) {
        const int bl = r / LT, t = r % LT, b = g * BG + bl; const bool isctx = t < LC;
        if (isctx && !ctx_out) continue;
        f32x4 x[4]; float ss = 0.f;
        const float* gt1 = isctx ? F.modC(layer, 2) : F.modL(layer, b, 2);
#pragma unroll
        for (int q = 0; q < 4; ++q) { const int c = q * 256 + F.lane * 4;
            x[q] = *(const f32x4*)(X + (size_t)r * D + c);
            const u32x2 ob = *(const u32x2*)(Ob + (size_t)r * D + c); const f32x4 gv = *(const f32x4*)(gt1 + c);
            x[q][0] += gv[0] * lo16(ob.x); x[q][1] += gv[1] * hi16(ob.x); x[q][2] += gv[2] * lo16(ob.y); x[q][3] += gv[3] * hi16(ob.y);
            *(f32x4*)(X + (size_t)r * D + c) = x[q];
            ss += x[q][0] * x[q][0] + x[q][1] * x[q][1] + x[q][2] * x[q][2] + x[q][3] * x[q][3]; }
        ss = wave_sum(ss);
        const float rstd = rsqrtf(ss * (1.0f / D) + 1e-6f);
        const float* gn = F.in(7) + (size_t)layer * D;
        const float* sh = isctx ? F.modC(layer, 3) : F.modL(layer, b, 3);
        const float* sc = isctx ? F.modC(layer, 4) : F.modL(layer, b, 4);
        float lg[16];
#pragma unroll
        for (int e = 0; e < 16; ++e) lg[e] = 0.f;
#pragma unroll
        for (int q = 0; q < 4; ++q) { const int c = q * 256 + F.lane * 4;
            const f32x4 gv = *(const f32x4*)(gn + c), sv = *(const f32x4*)(sh + c), cv = *(const f32x4*)(sc + c);
            const f32x4 h = x[q] * rstd * gv * (1.0f + cv) + sv;
            u32x2 w; w.x = pk2(h[0], h[1]); w.y = pk2(h[2], h[3]);
            *(u32x2*)(HM + (size_t)r * D + c) = w;
#pragma unroll
            for (int j = 0; j < 4; ++j) {
#pragma unroll
                for (int e4 = 0; e4 < 4; ++e4) { const f32x4 wv = *(const LAS f32x4*)(wr + (c + j) * 16 + e4 * 4);
                    lg[e4 * 4 + 0] += h[j] * wv[0]; lg[e4 * 4 + 1] += h[j] * wv[1]; lg[e4 * 4 + 2] += h[j] * wv[2]; lg[e4 * 4 + 3] += h[j] * wv[3]; } }
        }
#pragma unroll
        for (int e = 0; e < 16; ++e) lg[e] = wave_sum(lg[e]);
        float sc_[16], bs[16];
#pragma unroll
        for (int e = 0; e < 16; ++e) { sc_[e] = sigmoidf_(lg[e]); bs[e] = sc_[e] + rbias[e]; }
        float gs[4];
#pragma unroll
        for (int gq = 0; gq < 4; ++gq) { float m1 = -1e30f, m2 = -1e30f;
#pragma unroll
            for (int j = 0; j < 4; ++j) { const float v = bs[gq * 4 + j]; if (v > m1) { m2 = m1; m1 = v; } else if (v > m2) m2 = v; }
            gs[gq] = m1 + m2; }
        int best = 0; float bv = gs[0];
#pragma unroll
        for (int gq = 1; gq < 4; ++gq) if (gs[gq] > bv) { bv = gs[gq]; best = gq; }
        float cb[4], cs[4];
#pragma unroll
        for (int j = 0; j < 4; ++j) { cb[j] = best == 0 ? bs[j] : best == 1 ? bs[4 + j] : best == 2 ? bs[8 + j] : bs[12 + j]; cs[j] = best == 0 ? sc_[j] : best == 1 ? sc_[4 + j] : best == 2 ? sc_[8 + j] : sc_[12 + j]; }
        int j1 = 0; float v1 = cb[0];
#pragma unroll
        for (int j = 1; j < 4; ++j) if (cb[j] > v1) { v1 = cb[j]; j1 = j; }
        int j2 = -1; float v2 = -1e30f;
#pragma unroll
        for (int j = 0; j < 4; ++j) if (j != j1 && cb[j] > v2) { v2 = cb[j]; j2 = j; }
        const float s1 = j1 == 0 ? cs[0] : j1 == 1 ? cs[1] : j1 == 2 ? cs[2] : cs[3];
        const float s2 = j2 == 0 ? cs[0] : j2 == 1 ? cs[1] : j2 == 2 ? cs[2] : cs[3];
        const float inv = 1.0f / (s1 + s2);
        if (F.lane == 0) {
            const int e1 = best * 4 + j1, e2 = best * 4 + j2;
            const unsigned p1 = atomicAdd(&cnt[e1 * 2 + 0], 1u), p2 = atomicAdd(&cnt[e2 * 2 + 1], 1u);
            lists[(size_t)(e1 * 2 + 0) * TG + p1] = r; lwt[(size_t)(e1 * 2 + 0) * TG + p1] = s1 * inv;
            lists[(size_t)(e2 * 2 + 1) * TG + p2] = r; lwt[(size_t)(e2 * 2 + 1) * TG + p2] = s2 * inv;
        }
    }
    __syncthreads();
}
__device__ __forceinline__ int moe_tables(const Frame& F, int g, int layer) {
    LAS int* cn = (LAS int*)(F.lds + LDS_MISC + 64); LAS int* tb = (LAS int*)(F.lds + LDS_MISC + 192);
    const unsigned* cnt = (const unsigned*)(F.ws + WS_CTL + CTL_CNT_OFF) + ((size_t)g * 4 + layer) * 32;
    __syncthreads();
    if (F.tid == 0) { int acc = 0; for (int l = 0; l < 32; ++l) { const int c = (int)__hip_atomic_load(cnt + l, __ATOMIC_RELAXED, __HIP_MEMORY_SCOPE_AGENT); cn[l] = c; tb[l] = acc; acc += (c + 255) >> 8; } tb[32] = acc; }
    __syncthreads();
    return tb[32];
}

constexpr int SC_OPB = 6 * 4096;
constexpr int SC_HALF = 2 * SC_OPB + 4096 + 4096;
static_assert(2 * SC_HALF <= LDS_STAGE, "scan lds");
__device__ __forceinline__ int scan_tok(int d, int s) { return d == 0 ? s : (s < LC ? (LC - 1 - s) : (LT + LC - 1 - s)); }
__device__ __forceinline__ void phase_scan(const Frame& F, int a, const bf16_t* V) {
    const bf16_t* R = F.ar<bf16_t>(AR_R); const bf16_t* Kb = F.ar<bf16_t>(AR_K); const bf16_t* L1 = F.ar<bf16_t>(AR_L1);
    const int half = F.wave >> 2, q = F.wave & 3, lane = F.lane, li = q * 64 + lane;
    LAS unsigned char* hb = F.lds + half * SC_HALF;
    LAS float* aT = (LAS float*)(hb + 2 * SC_OPB); LAS float* ybuf = (LAS float*)(hb + 2 * SC_OPB + 4096);
    const int arr = q >> 1, ntl = (q & 1) * 2;
    const int i = lane >> 3, j = lane & 7, r0 = 16 * q + 2 * i;
    const int tB = li >> 4, k4 = (li & 15) * 4;
    for (int pr = F.bid; pr < BG * 16; pr += F.G) {
        const int bl = pr >> 4, d = (pr >> 3) & 1, hp = pr & 7, h = hp * 2 + half;
        bf16_t* Yd = F.ar<bf16_t>(d ? AR_Y1 : AR_Y0); float* DOT = F.ar<float>(AR_DOT) + (size_t)d * TG * NH;
        const size_t rowb = (size_t)bl * LT;
        const bf16_t* W2 = (arr == 0 ? F.wsp<bf16_t>(WS_W2T) : F.wsp<bf16_t>(WS_A2T)) + ((size_t)a * 2 + d) * D * 64;
        bf16x8 Bf[2][2]; float bias[2];
#pragma unroll
        for (int nt = 0; nt < 2; ++nt) { const int cc = h * 64 + (ntl + nt) * 16 + (lane & 15);
            bias[nt] = (arr == 0 ? F.in(13) : F.in(16))[((size_t)a * 2 + d) * D + cc];
#pragma unroll
            for (int s = 0; s < 2; ++s) Bf[nt][s] = *(const bf16x8*)(W2 + (size_t)cc * 64 + 32 * s + 8 * (lane >> 4)); }
        const f32x4 kkc = *(const f32x4*)(F.in(24) + (size_t)a * D + h * 64 + k4), kac = *(const f32x4*)(F.in(25) + (size_t)a * D + h * 64 + k4), rkc = *(const f32x4*)(F.in(26) + (size_t)a * D + h * 64 + k4);
        const int acol = arr * 128 + d * 64 + 8 * (lane >> 4);
        float S0[8], S1[8];
#pragma unroll
        for (int c = 0; c < 8; ++c) { S0[c] = 0.f; S1[c] = 0.f; }
        bf16x8 Af[2]; u32x2 kraw, rraw, vraw;
#define SC_LOAD(ch) do { const size_t rowA = rowb + scan_tok(d, (ch) * 16 + (lane & 15)); \
        Af[0] = *(const bf16x8*)(L1 + rowA * 512 + acol); Af[1] = *(const bf16x8*)(L1 + rowA * 512 + acol + 32); \
        const size_t rowBq = (rowb + scan_tok(d, (ch) * 16 + tB)) * D + h * 64 + k4; \
        kraw = *(const u32x2*)(Kb + rowBq); rraw = *(const u32x2*)(R + rowBq); vraw = *(const u32x2*)(V + rowBq); } while (0)
#define SC_PASSA(buf) do { LAS float* op = (LAS float*)(hb + (buf) * SC_OPB); \
        _Pragma("unroll") for (int nt = 0; nt < 2; ++nt) { f32x4 ac = (f32x4){0.f, 0.f, 0.f, 0.f}; \
            ac = __builtin_amdgcn_mfma_f32_16x16x32_bf16(Af[0], Bf[nt][0], ac, 0, 0, 0); ac = __builtin_amdgcn_mfma_f32_16x16x32_bf16(Af[1], Bf[nt][1], ac, 0, 0, 0); \
            const int n = (ntl + nt) * 16 + (lane & 15); \
            _Pragma("unroll") for (int rg = 0; rg < 4; ++rg) { const int t = (lane >> 4) * 4 + rg; const float x = ac[rg] + bias[nt]; \
                if (arr == 0) { const float nx = -x; const float sp = nx > 20.f ? nx : __logf(1.0f + __expf(nx)); op[1024 + t * 64 + n] = __expf(-__expf(-sp - 0.5f)); } \
                else aT[t * 64 + n] = sigmoidf_(x); } } } while (0)
#define SC_PASSB(ch, buf) do { LAS float* op = (LAS float*)(hb + (buf) * SC_OPB); \
        const float kf[4] = {lo16(kraw.x), hi16(kraw.x), lo16(kraw.y), hi16(kraw.y)}; const float rf[4] = {lo16(rraw.x), hi16(rraw.x), lo16(rraw.y), hi16(rraw.y)}; \
        const float vf[4] = {lo16(vraw.x), hi16(vraw.x), lo16(vraw.y), hi16(vraw.y)}; \
        const f32x4 av = *(const LAS f32x4*)(aT + tB * 64 + k4); \
        float kq[4], ssq = 0.f; _Pragma("unroll") for (int e = 0; e < 4; ++e) { kq[e] = kf[e] * kkc[e]; ssq += kq[e] * kq[e]; } \
        ssq = red16(ssq); const float inv = 1.0f / fmaxf(sqrtf(ssq), 1e-12f); \
        f32x4 o_kk, o_kka, o_kd, o_r, o_v; float dp = 0.f; \
        _Pragma("unroll") for (int e = 0; e < 4; ++e) { const float kkv = kq[e] * inv; const float kd = kf[e] * (1.0f + (av[e] - 1.0f) * kac[e]); \
            o_kk[e] = kkv; o_kka[e] = kkv * av[e]; o_kd[e] = kd; o_r[e] = rf[e]; o_v[e] = vf[e]; dp += rf[e] * kd * rkc[e]; } \
        dp = red16(dp); \
        if ((li & 15) == 0) DOT[(rowb + scan_tok(d, (ch) * 16 + tB)) * NH + h] = dp; \
        *(LAS f32x4*)(op + 0 * 1024 + tB * 64 + k4) = o_kk; *(LAS f32x4*)(op + 2 * 1024 + tB * 64 + k4) = o_kka; *(LAS f32x4*)(op + 3 * 1024 + tB * 64 + k4) = o_kd; \
        *(LAS f32x4*)(op + 4 * 1024 + tB * 64 + k4) = o_r; *(LAS f32x4*)(op + 5 * 1024 + tB * 64 + k4) = o_v; } while (0)
        __syncthreads();
        SC_LOAD(0);
        SC_PASSA(0);
        __syncthreads();
        SC_PASSB(0, 0);
        __syncthreads();
        constexpr int NCH = LT / 16;
        for (int ch = 0; ch < NCH; ++ch) {
            const int buf = ch & 1;
            if (ch + 1 < NCH) SC_LOAD(ch + 1);
            const LAS float* op = (const LAS float*)(hb + buf * SC_OPB);
#pragma unroll 2
            for (int t = 0; t < 16; ++t) {
                const LAS float* ob = op + t * 64 + j * 8;
                const f32x4 kkA = *(const LAS f32x4*)(ob), kkB = *(const LAS f32x4*)(ob + 4);
                const f32x4 dcA = *(const LAS f32x4*)(ob + 1024), dcB = *(const LAS f32x4*)(ob + 1024 + 4);
                const f32x4 kaA = *(const LAS f32x4*)(ob + 2048), kaB = *(const LAS f32x4*)(ob + 2048 + 4);
                const f32x4 kdA = *(const LAS f32x4*)(ob + 3072), kdB = *(const LAS f32x4*)(ob + 3072 + 4);
                const f32x4 rrA = *(const LAS f32x4*)(ob + 4096), rrB = *(const LAS f32x4*)(ob + 4096 + 4);
                const f32x2 vv = *(const LAS f32x2*)(op + 5 * 1024 + t * 64 + r0);
                const float kk[8] = {kkA[0], kkA[1], kkA[2], kkA[3], kkB[0], kkB[1], kkB[2], kkB[3]};
                const float dc[8] = {dcA[0], dcA[1], dcA[2], dcA[3], dcB[0], dcB[1], dcB[2], dcB[3]};
                const float ka[8] = {kaA[0], kaA[1], kaA[2], kaA[3], kaB[0], kaB[1], kaB[2], kaB[3]};
                const float kd[8] = {kdA[0], kdA[1], kdA[2], kdA[3], kdB[0], kdB[1], kdB[2], kdB[3]};
                const float rr[8] = {rrA[0], rrA[1], rrA[2], rrA[3], rrB[0], rrB[1], rrB[2], rrB[3]};
                float sa0 = 0.f, sa1 = 0.f;
#pragma unroll
                for (int c = 0; c < 8; ++c) { sa0 += S0[c] * kk[c]; sa1 += S1[c] * kk[c]; }
                sa0 = red8(sa0); sa1 = red8(sa1);
                float y0 = 0.f, y1 = 0.f;
#pragma unroll
                for (int c = 0; c < 8; ++c) {
                    S0[c] = S0[c] * dc[c] + (vv[0] * kd[c] - sa0 * ka[c]);
                    S1[c] = S1[c] * dc[c] + (vv[1] * kd[c] - sa1 * ka[c]);
                    y0 += S0[c] * rr[c]; y1 += S1[c] * rr[c];
                }
                y0 = red8(y0); y1 = red8(y1);
                if (j == 0) *(LAS f32x2*)(ybuf + t * 64 + r0) = (f32x2){y0, y1};
            }
            __syncthreads();
            {
                const f32x4 yv = *(const LAS f32x4*)(ybuf + tB * 64 + k4);
                u32x2 w; w.x = pk2(yv[0], yv[1]); w.y = pk2(yv[2], yv[3]);
                *(u32x2*)(Yd + (rowb + scan_tok(d, ch * 16 + tB)) * D + h * 64 + k4) = w;
            }
            if (ch + 1 < NCH) SC_PASSA(buf ^ 1);
            __syncthreads();
            if (ch + 1 < NCH) SC_PASSB(ch + 1, buf ^ 1);
            __syncthreads();
        }
#undef SC_LOAD
#undef SC_PASSA
#undef SC_PASSB
    }
}

__device__ __forceinline__ void phase_sgstats(const Frame& F, int layer) {
    const bf16_t* Z = F.ar<bf16_t>(AR_Z); float* ST = F.ar<float>(AR_ST);
    for (int r = F.bid * NWAVES + F.wave; r < TG; r += F.G * NWAVES) {
        const int t = r % LT; if (t < LC && layer >= 3) continue;
        float x[32];
#pragma unroll
        for (int q = 0; q < 4; ++q) { const u32x4 w = *(const u32x4*)(Z + (size_t)r * 4096 + 2048 + q * 512 + F.lane * 8);
            x[q * 8 + 0] = lo16(w.x); x[q * 8 + 1] = hi16(w.x); x[q * 8 + 2] = lo16(w.y); x[q * 8 + 3] = hi16(w.y); x[q * 8 + 4] = lo16(w.z); x[q * 8 + 5] = hi16(w.z); x[q * 8 + 6] = lo16(w.w); x[q * 8 + 7] = hi16(w.w); }
        float s = 0.f;
#pragma unroll
        for (int e = 0; e < 32; ++e) s += x[e];
        s = wave_sum(s); const float mean = s * (1.0f / 2048.0f);
        float qv = 0.f;
#pragma unroll
        for (int e = 0; e < 32; ++e) { const float dd = x[e] - mean; qv += dd * dd; }
        qv = wave_sum(qv);
        if (F.lane == 0) *(f32x2*)(ST + (size_t)r * 2) = (f32x2){mean, rsqrtf(qv * (1.0f / 2048.0f) + 1e-5f)};
    }
}
__device__ __forceinline__ int vt_off(int dch, int jb) { return dch * 256 + ((jb ^ ((dch & 15) ^ (((dch >> 4) & 7) << 1))) << 4); }
__device__ __forceinline__ void phase_spatial(const Frame& F, int bsg, int layer) {
    const bf16_t* Z = F.ar<bf16_t>(AR_Z); const float* ST = F.ar<float>(AR_ST); bf16_t* Pb = F.ar<bf16_t>(AR_P);
    const bf16_t* Ws = F.wsp<bf16_t>(WS_WSP) + (size_t)bsg * 16 * 128 * 128;
    const float* lng = F.in(31) + (size_t)bsg * 2048; const float* lnb = F.in(32) + (size_t)bsg * 2048; const float* bs = F.in(34) + (size_t)bsg * 16 * 128;
    LAS unsigned char* vt = F.lds;
    const int skip = layer >= 3;
    const int nchunk = skip ? BG * 16 : BG * 18;
    const int w = F.wave, lane = F.lane, dt = w >> 1, it0 = (w & 1) * 2;
    for (int U = F.bid; U < nchunk * 16; U += F.G) {
        const int lc = U >> 4, gi = U & 15;
        const int chunk = skip ? (lc >> 4) * 18 + 2 + (lc & 15) : lc;
        const size_t row0 = (size_t)chunk * 128;
        __syncthreads();
#pragma unroll
        for (int k = 0; k < 4; ++k) {
            const int p = F.tid + 512 * k, jj = p >> 4, c8 = (p & 15) * 8;
            const u32x4 zz = *(const u32x4*)(Z + (row0 + jj) * 4096 + 2048 + gi * 128 + c8);
            const f32x2 st = *(const f32x2*)(ST + (row0 + jj) * 2);
            const float xv[8] = {lo16(zz.x), hi16(zz.x), lo16(zz.y), hi16(zz.y), lo16(zz.z), hi16(zz.z), lo16(zz.w), hi16(zz.w)};
#pragma unroll
            for (int e = 0; e < 8; ++e) { const int dch = c8 + e; const float val = (xv[e] - st[0]) * st[1] * lng[gi * 128 + dch] + lnb[gi * 128 + dch];
                *(LAS unsigned short*)(vt + vt_off(dch, jj >> 3) + (jj & 7) * 2) = f2bf(val); }
        }
        __syncthreads();
        f32x16 acc0, acc1;
#pragma unroll
        for (int e = 0; e < 16; ++e) { acc0[e] = 0.f; acc1[e] = 0.f; }
        const int dA = dt * 32 + (lane & 31);
        const bf16_t* w0p = Ws + ((size_t)gi * 128 + it0 * 32 + (lane & 31)) * 128 + 8 * (lane >> 5);
#pragma unroll
        for (int s = 0; s < 8; ++s) {
            const bf16x8 Afr = *(const LAS bf16x8*)(vt + vt_off(dA, 2 * s + (lane >> 5)));
            const bf16x8 B0 = *(const bf16x8*)(w0p + 16 * s), B1 = *(const bf16x8*)(w0p + 32 * 128 + 16 * s);
            acc0 = __builtin_amdgcn_mfma_f32_32x32x16_bf16(Afr, B0, acc0, 0, 0, 0);
            acc1 = __builtin_amdgcn_mfma_f32_32x32x16_bf16(Afr, B1, acc1, 0, 0, 0);
        }
#pragma unroll
        for (int it = 0; it < 2; ++it) {
            const int ii = (it0 + it) * 32 + (lane & 31); const size_t row = row0 + ii; const float bias = bs[gi * 128 + ii];
#pragma unroll
            for (int rq = 0; rq < 4; ++rq) {
                const int d0 = dt * 32 + 8 * rq + 4 * (lane >> 5);
                const u32x2 uu = *(const u32x2*)(Z + row * 4096 + gi * 128 + d0);
                float vs[4];
#pragma unroll
                for (int e = 0; e < 4; ++e) vs[e] = (it == 0 ? acc0[rq * 4 + e] : acc1[rq * 4 + e]) + bias;
                u32x2 o; o.x = pk2(lo16(uu.x) * vs[0], hi16(uu.x) * vs[1]); o.y = pk2(lo16(uu.y) * vs[2], hi16(uu.y) * vs[3]);
                *(u32x2*)(Pb + row * 2048 + gi * 128 + d0) = o;
            }
        }
    }
    __syncthreads();
}

__global__ void __launch_bounds__(NTHREADS, 2) fwd_kernel(Params P) {
    extern __shared__ __attribute__((aligned(16))) unsigned char lds_raw[];
    Frame F; F.lds = (LAS unsigned char*)lds_raw; F.tid = threadIdx.x; F.lane = F.tid & 63; F.wave = __builtin_amdgcn_readfirstlane(F.tid >> 6);
    F.G = gridDim.x; F.bid = blockIdx.x; F.ws = P.ws; F.kp = (const Params __attribute__((address_space(4)))*)__builtin_amdgcn_kernarg_segment_ptr();
    const int lo = P.ph_lo, hi = P.ph_hi;
    volatile LAS unsigned* misc = (volatile LAS unsigned*)(F.lds + LDS_MISC);
    if (F.tid < 4) misc[F.tid] = 0u;
    __syncthreads();
    XcdBarrier bar; bar.bar = (unsigned*)(F.ws + WS_CTL); bar.x = 0; bar.st = misc;
    if (hi - lo > 1) bar = xcd_barrier_post((unsigned*)(F.ws + WS_CTL), misc);
    int ph = 0;
#define RUN(...) do { if (ph >= lo && ph < hi) { { int t_ = threadIdx.x; const Params __attribute__((address_space(4)))* kp_ = (const Params __attribute__((address_space(4)))*)__builtin_amdgcn_kernarg_segment_ptr(); asm volatile("" : "+v"(t_), "+s"(kp_)); F.tid = t_; F.lane = t_ & 63; F.kp = kp_; F.ws = kp_->ws; } __VA_ARGS__; if (ph + 1 < hi) xcd_barrier(bar); } ++ph; } while (0)

    RUN(phase_prologue(F));
    for (int g = 0; g < NG; ++g) {
        for (int layer = 0; layer < 4; ++layer) {
            const int a = layer >> 1;
            if ((layer & 1) == 0) {
                const bf16_t* Vc = layer == 0 ? F.wsp<bf16_t>(WS_VF) : F.ar<bf16_t>(AR_V);
                RUN(phase_norm1(F, g, layer, F.ar<bf16_t>(AR_H2), 2048));
                RUN(phase_mix(F));
                RUN({ pg8::SchedPlain S; S.init(TG / 256, N1CAT / 256, F.G, F.bid, 0);
                      EpiG1 E{F.ws, layer == 0 ? WS_VF : WS_ARENA + AR_V};
                      pg8::gemm_phase(F.tid, F.lds, F.ar<bf16_t>(AR_H2), K1CAT, F.wsp<bf16_t>(WS_W1CAT) + (size_t)a * N1CAT * K1CAT, K1CAT, K1CAT, S, E); });
                if (layer == 2) {
                    RUN({ pg8::SchedPlain S; S.init(TG / 256, 4, F.G, F.bid, 0);
                          EpiStore<1> E{F.ar<bf16_t>(AR_VGATE), F.in(19)};
                          pg8::gemm_phase(F.tid, F.lds, F.ar<bf16_t>(AR_L1) + 256, 512, F.wsp<bf16_t>(WS_V2T), 256, 256, S, E); });
                    RUN(phase_vfix(F));
                }
                RUN(phase_scan(F, a, Vc));
                RUN({ pg8::SchedPlain S; S.init(TG / 256, 4, F.G, F.bid, 0);
                      EpiStore<0> E{F.ar<bf16_t>(AR_G), nullptr};
                      pg8::gemm_phase(F.tid, F.lds, F.ar<bf16_t>(AR_L1) + 256, 512, F.wsp<bf16_t>(WS_G2T) + (size_t)a * D * 256, 256, 256, S, E); });
                RUN(phase_post(F, a, Vc));
                RUN({ const int skip = layer == 2; pg8::SchedPlain S; S.init(skip ? BG * 8 : TG / 256, 4, F.G, F.bid, skip);
                      EpiStore<0> E{F.ar<bf16_t>(AR_O), nullptr};
                      pg8::gemm_phase(F.tid, F.lds, F.ar<bf16_t>(AR_Y0), D, F.wsp<bf16_t>(WS_WO) + (size_t)a * D * D, D, D, S, E); });
            } else {
                const int skip = layer == 3;
                RUN(phase_norm1(F, g, layer, F.ar<bf16_t>(AR_H), D));
                RUN({ pg8::SchedPlain S; S.init(skip ? BG * 8 : TG / 256, 16, F.G, F.bid, skip);
                      EpiGelu E{F.ar<bf16_t>(AR_Z), F.in(30) + (size_t)a * 4096};
                      pg8::gemm_phase(F.tid, F.lds, F.ar<bf16_t>(AR_H), D, F.wsp<bf16_t>(WS_WIN) + (size_t)a * 4096 * D, D, D, S, E); });
                RUN(phase_sgstats(F, layer));
                RUN(phase_spatial(F, a, layer));
                RUN({ pg8::SchedPlain S; S.init(skip ? BG * 8 : TG / 256, 4, F.G, F.bid, skip);
                      EpiStore<0> E{F.ar<bf16_t>(AR_O), nullptr};
                      pg8::gemm_phase(F.tid, F.lds, F.ar<bf16_t>(AR_P), 2048, F.wsp<bf16_t>(WS_WOUT) + (size_t)a * D * 2048, 2048, 2048, S, E); });
            }
            RUN(phase_norm2(F, g, layer));
            RUN({ const int total = moe_tables(F, g, layer);
                  pg8::SchedMoe<true> S{(const LAS int*)(F.lds + LDS_MISC + 64), (const LAS int*)(F.lds + LDS_MISC + 192), F.ar<int>(AR_LIST), F.G, F.bid, total};
                  EpiMG E{F.ar<bf16_t>(AR_HE)};
                  pg8::gemm_phase(F.tid, F.lds, F.ar<bf16_t>(AR_HM), D, F.wsp<bf16_t>(WS_WGU) + (size_t)layer * NEXP * 1024 * D, D, D, S, E); });
            RUN({ const int total = moe_tables(F, g, layer);
                  pg8::SchedMoe<false> S{(const LAS int*)(F.lds + LDS_MISC + 64), (const LAS int*)(F.lds + LDS_MISC + 192), F.ar<int>(AR_LIST), F.G, F.bid, total};
                  EpiMD E{F.ar<bf16_t>(AR_YM0), F.ar<int>(AR_LIST), F.ar<float>(AR_LW), (const LAS int*)(F.lds + LDS_MISC + 64)};
                  pg8::gemm_phase(F.tid, F.lds, F.ar<bf16_t>(AR_HE), FEXP, F.wsp<bf16_t>(WS_WD) + (size_t)layer * NEXP * D * FEXP, FEXP, FEXP, S, E); });
        }
        RUN(phase_norm1(F, g, 4, nullptr, 0));
    }
#undef RUN
}
constexpr int NPHASES = 1 + NG * (10 + 8 + 12 + 8 + 1);

__global__ void nan_fill(float* out, size_t n) { for (size_t i = (size_t)blockIdx.x * blockDim.x + threadIdx.x; i < n; i += (size_t)gridDim.x * blockDim.x) out[i] = __uint_as_float(0x7FC00000u); }

extern "C" void kernel_launch(void* const* d_in, const int* in_sizes, int n_in, void* d_out, int out_size, void* d_ws, size_t ws_size, hipStream_t stream) {
    static int grid = 0;
    if (grid == 0) {
        int dev = 0, cus = 0, per_cu = 0;
        if (n_in != 42 || ws_size < WS_END || hipGetDevice(&dev) != hipSuccess || hipDeviceGetAttribute(&cus, hipDeviceAttributeMultiprocessorCount, dev) != hipSuccess) {
            fprintf(stderr, "kernel_launch: bad setup (n_in %d, ws %zu need %zu)\n", n_in, ws_size, (size_t)WS_END); grid = -1;
        } else if (hipFuncSetAttribute((const void*)fwd_kernel, hipFuncAttributeMaxDynamicSharedMemorySize, LDS_BYTES) != hipSuccess) { fprintf(stderr, "kernel_launch: hipFuncSetAttribute failed\n"); grid = -1; }
        else {
            if (hipOccupancyMaxActiveBlocksPerMultiprocessor(&per_cu, (const void*)fwd_kernel, NTHREADS, LDS_BYTES) != hipSuccess || per_cu < 1) { fprintf(stderr, "kernel_launch: occupancy query reports %d\n", per_cu); }
            (void)hipGetLastError();
            grid = cus;
        }
    }
    if (grid < 0) { hipLaunchKernelGGL(nan_fill, dim3(1024), dim3(256), 0, stream, (float*)d_out, (size_t)out_size); return; }
    (void)hipMemsetAsync((char*)d_ws + WS_CTL, 0, CTL_BYTES, stream);
    Params p{};
    for (int i = 0; i < 42; ++i) p.in[i] = (const float*)d_in[i];
    p.out = (float*)d_out; p.ws = (unsigned char*)d_ws;
#if PER_PHASE_LAUNCH
    for (int k = 0; k < NPHASES; ++k) { p.ph_lo = k; p.ph_hi = k + 1; hipLaunchKernelGGL(fwd_kernel, dim3(grid), dim3(NTHREADS), LDS_BYTES, stream, p); }
#else
    p.ph_lo = 0; p.ph_hi = NPHASES;
    hipLaunchKernelGGL(fwd_kernel, dim3(grid), dim3(NTHREADS), LDS_BYTES, stream, p);
#endif
}
```

```cpp
#include <hip/hip_runtime.h>
#include <cstdio>
#include <cstdint>

#ifndef REP_MASK
#define REP_MASK 0u
#endif
#ifndef PER_PHASE_LAUNCH
#define PER_PHASE_LAUNCH 0
#endif

#define LAS __attribute__((address_space(3)))
typedef unsigned short bf16_t;
typedef short bf16x8 __attribute__((ext_vector_type(8)));
typedef float f32x4 __attribute__((ext_vector_type(4)));
typedef float f32x2 __attribute__((ext_vector_type(2)));
typedef float f32x16 __attribute__((ext_vector_type(16)));
typedef unsigned u32x4 __attribute__((ext_vector_type(4)));
typedef unsigned u32x2 __attribute__((ext_vector_type(2)));

constexpr int NB = 32, SEQ = 2048, LC = 256, LT = SEQ + LC, D = 1024, NH = 16;
constexpr int NG = 2, BG = NB / NG, TG = BG * LT;
constexpr int NTHREADS = 512, NWAVES = 8;
constexpr int N1CAT = 3584, K1CAT = 2048;
constexpr int NEXP = 16, FEXP = 512;

constexpr size_t al256(size_t x) { return (x + 255) & ~(size_t)255; }
constexpr int XCD_BAR_WORDS_C = 3456;
constexpr size_t WS_CTL = 0;
constexpr size_t CTL_BAR_BYTES = (size_t)XCD_BAR_WORDS_C * 4;
constexpr size_t CTL_CNT_OFF = al256(CTL_BAR_BYTES);
constexpr size_t CTL_BYTES = al256(CTL_CNT_OFF + (size_t)2 * NG * 4 * 32 * 64);
constexpr size_t WS_X = al256(WS_CTL + CTL_BYTES);
constexpr size_t WS_VF = WS_X + (size_t)TG * D * 4;
constexpr size_t WS_MODL = WS_VF + (size_t)TG * D * 2;
constexpr size_t WS_MODC = WS_MODL + (size_t)4 * NB * 6 * D * 4;
constexpr size_t WS_W1CAT = al256(WS_MODC + (size_t)4 * 6 * D * 4);
constexpr size_t WS_WO = WS_W1CAT + (size_t)2 * N1CAT * K1CAT * 2;
constexpr size_t WS_G2T = WS_WO + (size_t)2 * D * D * 2;
constexpr size_t WS_V2T = WS_G2T + (size_t)2 * D * 256 * 2;
constexpr size_t WS_W2T = WS_V2T + (size_t)D * 256 * 2;
constexpr size_t WS_A2T = WS_W2T + (size_t)4 * D * 64 * 2;
constexpr size_t WS_WIN = WS_A2T + (size_t)4 * D * 64 * 2;
constexpr size_t WS_WOUT = WS_WIN + (size_t)2 * 4096 * D * 2;
constexpr size_t WS_WSP = WS_WOUT + (size_t)2 * D * 2048 * 2;
constexpr size_t WS_WGU = WS_WSP + (size_t)2 * 16 * 128 * 128 * 2;
constexpr size_t WS_WD = WS_WGU + (size_t)4 * NEXP * 1024 * D * 2;
constexpr size_t WS_ARENA = al256(WS_WD + (size_t)4 * NEXP * D * FEXP * 2);
constexpr size_t SZB = (size_t)TG * D * 2;
constexpr size_t AR_H2 = 0;
constexpr size_t AR_Y0 = 0, AR_Y1 = SZB;
constexpr size_t AR_R = 2 * SZB, AR_K = 3 * SZB, AR_V = 4 * SZB;
constexpr size_t AR_L1 = 5 * SZB;
constexpr size_t AR_DOT = AR_L1 + SZB / 2;
constexpr size_t AR_G = 6 * SZB;
constexpr size_t AR_VGATE = 0;
constexpr size_t AR_O = 3 * SZB;
constexpr size_t AR_H = 0;
constexpr size_t AR_Z = SZB;
constexpr size_t AR_P = 5 * SZB;
constexpr size_t AR_ST = 7 * SZB;
constexpr size_t AR_HM = 0;
constexpr size_t AR_HE = SZB;
constexpr size_t HE_ROWS = (size_t)2 * TG + 32 * 256;
constexpr size_t AR_LIST = al256(AR_HE + HE_ROWS * FEXP * 2);
constexpr size_t AR_LW = AR_LIST + (size_t)32 * TG * 4;
constexpr size_t AR_YM0 = 5 * SZB, AR_YM1 = 6 * SZB;
constexpr size_t ARENA_BYTES = 7 * SZB + al256((size_t)TG * 8) + 4096;
constexpr size_t WS_END = WS_ARENA + ARENA_BYTES;
static_assert(AR_LW + (size_t)32 * TG * 4 <= AR_YM0, "moe lists overlap");
static_assert(AR_DOT + (size_t)2 * TG * 16 * 4 <= AR_G, "dot overlap");

constexpr int LDS_STAGE = 131072;
constexpr int LDS_MISC = LDS_STAGE;
constexpr int LDS_BYTES = LDS_STAGE + 1024;

struct Params {
    const float* in[42];
    float* out;
    unsigned char* ws;
    int ph_lo, ph_hi;
};

__device__ __forceinline__ float bf2f(unsigned short b) { return __uint_as_float(((unsigned)b) << 16); }
__device__ __forceinline__ unsigned short f2bf(float f) { unsigned u = __float_as_uint(f); u += 0x7FFFu + ((u >> 16) & 1u); return (unsigned short)(u >> 16); }
__device__ __forceinline__ unsigned pk2(float lo, float hi) { return (unsigned)f2bf(lo) | ((unsigned)f2bf(hi) << 16); }
__device__ __forceinline__ float lo16(unsigned w) { return __uint_as_float(w << 16); }
__device__ __forceinline__ float hi16(unsigned w) { return __uint_as_float(w & 0xFFFF0000u); }
__device__ __forceinline__ float sigmoidf_(float x) { return 1.0f / (1.0f + __expf(-x)); }
__device__ __forceinline__ float tanhf_(float x) { return 1.0f - 2.0f / (__expf(2.0f * x) + 1.0f); }
__device__ __forceinline__ float wave_sum(float v) {
#pragma unroll
    for (int o = 32; o > 0; o >>= 1) v += __shfl_xor(v, o);
    return v;
}
template <int CTRL> __device__ __forceinline__ float dpp_f(float v) {
    return __int_as_float(__builtin_amdgcn_update_dpp(0, __float_as_int(v), CTRL, 0xF, 0xF, true));
}
__device__ __forceinline__ float red8(float v) { v += dpp_f<0xB1>(v); v += dpp_f<0x4E>(v); v += dpp_f<0x141>(v); return v; }
__device__ __forceinline__ float red16(float v) { v = red8(v); v += dpp_f<0x140>(v); return v; }
__device__ __forceinline__ float wave_sum_dpp(float v) {
    v = red16(v);
    const float a = __int_as_float(__builtin_amdgcn_readlane(__float_as_int(v), 0)), b = __int_as_float(__builtin_amdgcn_readlane(__float_as_int(v), 16));
    const float c = __int_as_float(__builtin_amdgcn_readlane(__float_as_int(v), 32)), d = __int_as_float(__builtin_amdgcn_readlane(__float_as_int(v), 48));
    return (a + b) + (c + d);
}
__device__ __forceinline__ float red4(float v) { v += dpp_f<0xB1>(v); v += dpp_f<0x4E>(v); return v; }
__device__ __forceinline__ float gelu_f(float v) {
    const float av = fabsf(v), t = __builtin_amdgcn_rcpf(av * 0.2316418882f + 1.0f);
    float q = t * 0.5307027145f + (-0.7265760135f); q = q * t + 0.7107068705f; q = q * t + (-0.142248368f); q = q * t + 0.127414796f; q = q * t;
    const float e = __builtin_amdgcn_exp2f((v * v) * (-0.72134752044f));
    const float m = v * (q * e);
    return v < 0.f ? m : v - m;
}

#define XB_TMO      128
#define XB_XCNT(j)  (256  + 64 * (j))
#define XB_XSUB(j)  (1280 + 64 * (j))
#define XB_XGEN(j)  (2304 + 64 * (j))
#define XB_TOP      3328
#define XB_TOPGEN   3392
#define XCD_BAR_WORDS 3456
#define XB_SPIN_CAP (1u << 22)
static_assert(XCD_BAR_WORDS == XCD_BAR_WORDS_C, "barrier words");
__device__ __forceinline__ unsigned xb_ld(unsigned* p)              { return __hip_atomic_load(p, __ATOMIC_RELAXED, __HIP_MEMORY_SCOPE_AGENT); }
__device__ __forceinline__ unsigned xb_add(unsigned* p, unsigned v) { return __hip_atomic_fetch_add(p, v, __ATOMIC_RELAXED, __HIP_MEMORY_SCOPE_AGENT); }
__device__ __forceinline__ unsigned xb_xcc_id() { return (unsigned)__builtin_amdgcn_s_getreg((3 << 11) | 20) & 0xFu; }
#define XB_SPIN(cond, bar) do { unsigned _sp = 0; while (cond) { __builtin_amdgcn_s_sleep(1); \
    if ((++_sp & 255u) == 0u) { if (xb_ld(&(bar)[XB_TMO])) break; if (_sp > XB_SPIN_CAP) { atomicAdd(&(bar)[XB_TMO], 1u); break; } } } } while (0)
struct XcdBarrier { unsigned* bar; unsigned x; volatile LAS unsigned* st; };
__device__ __forceinline__ XcdBarrier xcd_barrier_post(unsigned* bar, volatile LAS unsigned* st) {
    XcdBarrier b; b.bar = bar; b.x = xb_xcc_id(); b.st = st;
    if (threadIdx.x == 0) (void)xb_add(&bar[XB_XCNT(b.x)], 1u);
    return b;
}
__device__ __forceinline__ void xcd_barrier_complete(unsigned* bar, unsigned x, unsigned& nloc, unsigned& nx) {
    const unsigned G = gridDim.x * gridDim.y * gridDim.z;
    unsigned sum, cnt, mine, sp = 0u;
    for (;;) {
        sum = 0u; cnt = 0u; mine = 0u;
#pragma unroll
        for (unsigned j = 0; j < 16; ++j) { const unsigned c = xb_ld(&bar[XB_XCNT(j)]); sum += c; cnt += (c > 0u) ? 1u : 0u; mine = (j == x) ? c : mine; }
        if (sum == G) break;
        __builtin_amdgcn_s_sleep(1);
        if ((++sp & 255u) == 0u) { if (xb_ld(&bar[XB_TMO])) break; if (sp > XB_SPIN_CAP) { atomicAdd(&bar[XB_TMO], 1u); break; } }
    }
    nloc = mine > 0u ? mine : 1u; nx = cnt > 0u ? cnt : 1u;
}
__device__ __forceinline__ void xcd_barrier(const XcdBarrier& b) {
    asm volatile("s_waitcnt vmcnt(0)" ::: "memory");
    __syncthreads();
    if (threadIdx.x == 0) {
        unsigned* bar = b.bar;
        __builtin_amdgcn_s_waitcnt(0);
        unsigned nloc = b.st[0], nx = b.st[1];
        if (nloc == 0u) { xcd_barrier_complete(bar, b.x, nloc, nx); b.st[0] = nloc; b.st[1] = nx; }
        const unsigned old = xb_add(&bar[XB_XSUB(b.x)], 1u);
        const unsigned gen = old / nloc;
        if (old + 1u == (gen + 1u) * nloc) {
            __builtin_amdgcn_fence(__ATOMIC_RELEASE, "agent");
            asm volatile("s_waitcnt vmcnt(0)" ::: "memory");
            const unsigned og = xb_add(&bar[XB_TOP], 1u);
            const unsigned tg = og / nx;
            if (og + 1u == (tg + 1u) * nx) xb_add(&bar[XB_TOPGEN], 1u);
            else XB_SPIN(xb_ld(&bar[XB_TOPGEN]) == tg, bar);
            __builtin_amdgcn_fence(__ATOMIC_ACQUIRE, "agent");
            xb_add(&bar[XB_XGEN(b.x)], 1u);
            asm volatile("s_waitcnt vmcnt(0)" ::: "memory");
        } else {
            XB_SPIN(xb_ld(&bar[XB_XGEN(b.x)]) == gen, bar);
            __builtin_amdgcn_fence(__ATOMIC_ACQUIRE, "agent");
            asm volatile("s_waitcnt vmcnt(0)" ::: "memory");
        }
    }
    __syncthreads();
}

namespace pg8 {
constexpr int BM = 256, BK = 64, HALF = 128, HTB = HALF * BK * 2, STAGE_BYTES = 8 * HTB, NXCD = 8, WGM = 8;
__host__ __device__ __forceinline__ int lds_byte(int r, int c) { const int st = (r >> 4) * 2 + (c >> 5), rr = r & 15, cc = c & 31, ob = rr * 64 + cc * 2; return st * 1024 + (ob ^ (((ob >> 9) & 1) << 5)); }
__host__ __device__ __forceinline__ void stage_rc(int b, int& R, int& C) { const int st = b / 1024, sb = b % 1024, swz = sb ^ (((sb >> 9) & 1) << 5); R = (st >> 1) * 16 + swz / 64; C = (st & 1) * 32 + (swz % 64) / 2; }
struct Unit { int pm, pn, aux; };

struct SchedPlain {
    static constexpr bool GATHER = false;
    int nM, nN, nwg, G, c, skipctx;
    __device__ void init(int nM_, int nN_, int G_, int c_, int skipctx_) { nM = nM_; nN = nN_; nwg = nM * nN; G = G_; c = c_; skipctx = skipctx_; }
    __device__ bool next(int i, Unit& u) const {
        const long L = (long)i * G + c; if (L >= nwg) return false;
        int wgid = (int)L; { const int q = nwg / NXCD, r = nwg % NXCD, xcd = wgid % NXCD, off = wgid / NXCD; wgid = (xcd < r ? xcd * (q + 1) : r * (q + 1) + (xcd - r) * q) + off; }
        const int nig = WGM * nN, gid = wgid / nig, fm = gid * WGM, gsz = (nM - fm) < WGM ? (nM - fm) : WGM;
        int pm = fm + ((wgid % nig) % gsz); u.pn = (wgid % nig) / gsz; u.aux = 0;
        if (skipctx) pm = (pm >> 3) * 9 + 1 + (pm & 7);
        u.pm = pm; return true;
    }
    __device__ __forceinline__ int arow(const Unit& u, int r) const { return u.pm * BM + r; }
};
template <bool GATH> struct SchedMoe {
    static constexpr bool GATHER = GATH;
    const LAS int* cn; const LAS int* tb; const int* lists; int G, c, total;
    __device__ bool next(int i, Unit& u) const {
        const int U = i * G + c; if (U >= total * 4) return false;
        const int T = U >> 2, pn = U & 3; int l = 0;
        while (tb[l + 1] <= T) ++l;
        u.pm = T; u.pn = (l >> 1) * 4 + pn; u.aux = l | ((T - tb[l]) << 8); return true;
    }
    __device__ __forceinline__ int arow(const Unit& u, int r) const {
        if (!GATH) return u.pm * BM + r;
        const int l = u.aux & 255, idx = (u.aux >> 8) * BM + r;
        return idx < cn[l] ? lists[(size_t)l * TG + idx] : 0;
    }
};

template <class Epi, class Sched>
__device__ __forceinline__ void gemm_phase(const int tid, LAS unsigned char* lds, const bf16_t* A, int lda, const bf16_t* Bt, int ldb, int K, const Sched& S, const Epi& E) {
    constexpr bool GA = Sched::GATHER;
    const int wid = __builtin_amdgcn_readfirstlane(tid >> 6), lane = tid & 63, wr = wid >> 2, wc = wid & 3, fr = lane & 15, fq = lane >> 4;
    const int nt = K / BK;
    unsigned voffA[2], voffB[2];
#pragma unroll
    for (int i = 0; i < 2; ++i) { int R, C; stage_rc(tid * 16 + i * 8192, R, C); voffA[i] = (unsigned)(R * lda + C) * 2u; voffB[i] = (unsigned)(R * ldb + C) * 2u; }
    const size_t kstep = (size_t)(BK * 2);
    const size_t hstepA = (size_t)HALF * lda * 2, tstepA = 2 * hstepA;
    const size_t hstepB = (size_t)HALF * ldb * 2, tstepB = 2 * hstepB;
    const unsigned ldsw = (unsigned)wid * 1024u;
    const int aoff = lds_byte(wr * 64 + fr, fq * 8), boff = lds_byte(wc * 32 + fr, fq * 8);
#define PG8_SA(b, h) (((b) * 2 + (h)) * HTB)
#define PG8_SB(b, h) ((4 + (b) * 2 + (h)) * HTB)
#define PG8_STAGE(bufoff, gbase, voff) do { _Pragma("unroll") for (int _i = 0; _i < 2; ++_i) \
        __builtin_amdgcn_global_load_lds((const unsigned*)((const char*)(gbase) + (voff)[_i]), (LAS unsigned*)(lds + (bufoff) + ldsw + _i * 8192), 16, 0, 0); } while (0)
#define PG8_STAGE_A(bufoff, ub, gv, h, koff) do { if constexpr (GA) { PG8_STAGE(bufoff, (const char*)A + (koff), gv[h]); } else { PG8_STAGE(bufoff, (ub) + (h) * hstepA + (koff), voffA); } } while (0)
#define PG8_LDA(dst, b, h) do { _Pragma("unroll") for (int m = 0; m < 4; ++m) _Pragma("unroll") for (int k = 0; k < 2; ++k) dst[m][k] = *(const LAS bf16x8*)(lds + PG8_SA(b, h) + aoff + m * 2048 + k * 1024); } while (0)
#define PG8_LDB(dst, b, h) do { _Pragma("unroll") for (int n = 0; n < 2; ++n) _Pragma("unroll") for (int k = 0; k < 2; ++k) dst[n][k] = *(const LAS bf16x8*)(lds + PG8_SB(b, h) + boff + n * 2048 + k * 1024); } while (0)
#define PG8_MMA(ai, bj, At, Bt_) do { __builtin_amdgcn_s_setprio(1); _Pragma("unroll") for (int m = 0; m < 4; ++m) _Pragma("unroll") for (int n = 0; n < 2; ++n) _Pragma("unroll") for (int k = 0; k < 2; ++k) \
        acc[ai][bj][m][n] = __builtin_amdgcn_mfma_f32_16x16x32_bf16(Bt_[n][k], At[m][k], acc[ai][bj][m][n], 0, 0, 0); __builtin_amdgcn_s_setprio(0); } while (0)
#define PG8_WAIT_V(n) asm volatile("s_waitcnt vmcnt(" #n ")" ::: "memory")
#define PG8_WAIT_L(n) asm volatile("s_waitcnt lgkmcnt(" #n ")" ::: "memory")
#define PG8_BAR __builtin_amdgcn_s_barrier()
#define PG8_SCHED __builtin_amdgcn_sched_barrier(0)
#define PG8_GOFF(dst, u) do { if constexpr (GA) { _Pragma("unroll") for (int _h = 0; _h < 2; ++_h) _Pragma("unroll") for (int _i = 0; _i < 2; ++_i) { int R_, C_; stage_rc(tid * 16 + _i * 8192, R_, C_); \
        dst[_h][_i] = ((unsigned)S.arow(u, _h * HALF + R_) * (unsigned)lda + (unsigned)C_) * 2u; } } } while (0)
    Unit cur, nxt; int ui = 0;
    if (!S.next(0, cur)) return;
    f32x4 acc[2][2][4][2];
#pragma unroll
    for (int a = 0; a < 2; ++a)
#pragma unroll
        for (int b = 0; b < 2; ++b)
#pragma unroll
            for (int m = 0; m < 4; ++m)
#pragma unroll
                for (int n = 0; n < 2; ++n) acc[a][b][m][n] = (f32x4){0.f, 0.f, 0.f, 0.f};
    bf16x8 At[4][2], B0[2][2], B1[2][2];
    unsigned gAc[2][2], gAn[2][2];
    PG8_GOFF(gAc, cur);
    const char* cA = (const char*)A + (GA ? (size_t)0 : (size_t)cur.pm * tstepA);
    const char* cB = (const char*)Bt + (size_t)cur.pn * tstepB;
    PG8_STAGE(PG8_SB(0, 0), cB, voffB); PG8_STAGE_A(PG8_SA(0, 0), cA, gAc, 0, 0); PG8_STAGE(PG8_SB(0, 1), cB + hstepB, voffB); PG8_STAGE_A(PG8_SA(0, 1), cA, gAc, 1, 0);
    if (wr == 1) PG8_BAR;
    PG8_WAIT_V(4); PG8_BAR;
    PG8_STAGE(PG8_SB(1, 0), cB + kstep, voffB); PG8_STAGE_A(PG8_SA(1, 0), cA, gAc, 0, kstep); PG8_STAGE(PG8_SB(1, 1), cB + hstepB + kstep, voffB);
    PG8_WAIT_V(6); PG8_BAR;
    for (;;) {
        const bool has_next = S.next(ui + 1, nxt);
        if (has_next) { PG8_GOFF(gAn, nxt); }
        else if constexpr (GA) {
#pragma unroll
            for (int _h = 0; _h < 2; ++_h)
#pragma unroll
                for (int _i = 0; _i < 2; ++_i) gAn[_h][_i] = gAc[_h][_i];
        }
        const char* nA = (has_next && !GA) ? (const char*)A + (size_t)nxt.pm * tstepA : cA;
        const char* nB = has_next ? (const char*)Bt + (size_t)nxt.pn * tstepB : cB;
#pragma unroll 1
        for (int t = 0; t < nt; t += 2) {
            const bool last = (t == nt - 2);
            const size_t k1 = (size_t)(t + 1) * kstep;
            const size_t k2 = last ? (size_t)0 : (size_t)(t + 2) * kstep, k3 = k2 + kstep;
            const char* a2 = last ? nA : cA; const char* b2 = last ? nB : cB;
            unsigned g2[2][2];
            if constexpr (GA) {
#pragma unroll
                for (int _h = 0; _h < 2; ++_h)
#pragma unroll
                    for (int _i = 0; _i < 2; ++_i) g2[_h][_i] = last ? gAn[_h][_i] : gAc[_h][_i];
            }
            PG8_LDB(B0, 0, 0); PG8_SCHED; PG8_LDA(At, 0, 0); PG8_STAGE_A(PG8_SA(1, 1), cA, gAc, 1, k1);
            PG8_WAIT_L(8); PG8_BAR; PG8_WAIT_L(0); PG8_MMA(0, 0, At, B0); PG8_BAR; PG8_SCHED;
            PG8_LDB(B1, 0, 1); PG8_STAGE(PG8_SB(0, 0), b2 + k2, voffB);
            PG8_BAR; PG8_WAIT_L(0); PG8_MMA(0, 1, At, B1); PG8_BAR;
            PG8_LDA(At, 0, 1); PG8_STAGE_A(PG8_SA(0, 0), a2, g2, 0, k2);
            PG8_BAR; PG8_WAIT_L(0); PG8_MMA(1, 0, At, B0); PG8_BAR; PG8_SCHED;
            PG8_STAGE(PG8_SB(0, 1), b2 + hstepB + k2, voffB);
            PG8_WAIT_V(6); PG8_BAR; PG8_MMA(1, 1, At, B1); PG8_BAR;
            PG8_LDB(B0, 1, 0); PG8_SCHED; PG8_LDA(At, 1, 0); PG8_STAGE_A(PG8_SA(0, 1), a2, g2, 1, k2);
            PG8_WAIT_L(8); PG8_BAR; PG8_WAIT_L(0); PG8_MMA(0, 0, At, B0); PG8_BAR; PG8_SCHED;
            PG8_LDB(B1, 1, 1); PG8_STAGE(PG8_SB(1, 0), b2 + k3, voffB);
            PG8_BAR; PG8_WAIT_L(0); PG8_MMA(0, 1, At, B1); PG8_BAR;
            PG8_LDA(At, 1, 1); PG8_STAGE_A(PG8_SA(1, 0), a2, g2, 0, k3);
            PG8_BAR; PG8_WAIT_L(0); PG8_MMA(1, 0, At, B0); PG8_BAR; PG8_SCHED;
            PG8_STAGE(PG8_SB(1, 1), b2 + hstepB + k3, voffB);
            PG8_WAIT_V(6); PG8_BAR; PG8_MMA(1, 1, At, B1); PG8_BAR;
        }
        { int fr_e = fr, fq_e = fq; asm volatile("" : "+v"(fr_e), "+v"(fq_e)); E(acc, cur, wr, wc, fr_e, fq_e); }
        if (!has_next) break;
#pragma unroll
        for (int a = 0; a < 2; ++a)
#pragma unroll
            for (int b = 0; b < 2; ++b)
#pragma unroll
                for (int m = 0; m < 4; ++m)
#pragma unroll
                    for (int n = 0; n < 2; ++n) acc[a][b][m][n] = (f32x4){0.f, 0.f, 0.f, 0.f};
        cur = nxt; cA = nA; cB = nB; ++ui;
        if constexpr (GA) {
#pragma unroll
            for (int _h = 0; _h < 2; ++_h)
#pragma unroll
                for (int _i = 0; _i < 2; ++_i) gAc[_h][_i] = gAn[_h][_i];
        }
    }
    PG8_WAIT_V(0);
    if (wr == 0) PG8_BAR;
    PG8_BAR;
#undef PG8_SA
#undef PG8_SB
#undef PG8_STAGE
#undef PG8_STAGE_A
#undef PG8_LDA
#undef PG8_LDB
#undef PG8_MMA
#undef PG8_WAIT_V
#undef PG8_WAIT_L
#undef PG8_BAR
#undef PG8_SCHED
#undef PG8_GOFF
}
}
using pg8::Unit;

#define EPI_LOOP_BEGIN \
    _Pragma("unroll") for (int ai = 0; ai < 2; ++ai) _Pragma("unroll") for (int m = 0; m < 4; ++m) { const int trow = ai * 128 + wr * 64 + m * 16 + fr; \
    _Pragma("unroll") for (int bj = 0; bj < 2; ++bj) _Pragma("unroll") for (int n = 0; n < 2; ++n) { const int tcol = bj * 128 + wc * 32 + n * 16 + 4 * fq; const f32x4 v = acc[ai][bj][m][n];
#define EPI_LOOP_END } asm volatile("" ::: "memory"); }

struct EpiG1 {
    unsigned char* ws; size_t voff;
    __device__ __forceinline__ void operator()(const f32x4 (&acc)[2][2][4][2], const Unit& u, int wr, int wc, int fr, int fq) const {
        const int pn = u.pn; const size_t row0 = (size_t)u.pm * 256;
        if (pn < 12) {
            const size_t off = pn < 4 ? (WS_ARENA + AR_R) : (pn < 8 ? (WS_ARENA + AR_K) : voff);
            bf16_t* dst = (bf16_t*)(ws + off); const int cb = (pn & 3) * 256;
            EPI_LOOP_BEGIN
                u32x2 w; w.x = pk2(v[0], v[1]); w.y = pk2(v[2], v[3]);
                *(u32x2*)(dst + (row0 + trow) * D + cb + tcol) = w;
            EPI_LOOP_END
        } else {
            bf16_t* L1 = (bf16_t*)(ws + WS_ARENA + AR_L1);
            const int cb = (pn - 12) * 256;
            EPI_LOOP_BEGIN
                f32x4 o = v;
                if (pn == 12 && bj == 0) { o[0] = tanhf_(v[0]); o[1] = tanhf_(v[1]); o[2] = tanhf_(v[2]); o[3] = tanhf_(v[3]); }
                if (pn == 13 && bj == 0) { o[0] = sigmoidf_(v[0]); o[1] = sigmoidf_(v[1]); o[2] = sigmoidf_(v[2]); o[3] = sigmoidf_(v[3]); }
                u32x2 w; w.x = pk2(o[0], o[1]); w.y = pk2(o[2], o[3]);
                *(u32x2*)(L1 + (row0 + trow) * 512 + cb + tcol) = w;
            EPI_LOOP_END
        }
    }
};
template <int ACT> struct EpiStore {
    bf16_t* O; const float* bias;
    __device__ __forceinline__ void operator()(const f32x4 (&acc)[2][2][4][2], const Unit& u, int wr, int wc, int fr, int fq) const {
        const size_t row0 = (size_t)u.pm * 256; const int cb = u.pn * 256;
        EPI_LOOP_BEGIN
            f32x4 o = v;
            if (ACT == 1) { const f32x4 b = *(const f32x4*)(bias + cb + tcol); o[0] = sigmoidf_(v[0] + b[0]); o[1] = sigmoidf_(v[1] + b[1]); o[2] = sigmoidf_(v[2] + b[2]); o[3] = sigmoidf_(v[3] + b[3]); }
            u32x2 w; w.x = pk2(o[0], o[1]); w.y = pk2(o[2], o[3]);
            *(u32x2*)(O + (row0 + trow) * D + cb + tcol) = w;
        EPI_LOOP_END
    }
};
struct EpiGelu {
    bf16_t* Z; const float* bias;
    __device__ __forceinline__ void operator()(const f32x4 (&acc)[2][2][4][2], const Unit& u, int wr, int wc, int fr, int fq) const {
        const size_t row0 = (size_t)u.pm * 256; const int cb = u.pn * 256;
        EPI_LOOP_BEGIN
            const f32x4 b = *(const f32x4*)(bias + cb + tcol);
            u32x2 w; w.x = pk2(gelu_f(v[0] + b[0]), gelu_f(v[1] + b[1])); w.y = pk2(gelu_f(v[2] + b[2]), gelu_f(v[3] + b[3]));
            *(u32x2*)(Z + (row0 + trow) * 4096 + cb + tcol) = w;
        EPI_LOOP_END
    }
};
struct EpiMG {
    bf16_t* HE;
    __device__ __forceinline__ void operator()(const f32x4 (&acc)[2][2][4][2], const Unit& u, int wr, int wc, int fr, int fq) const {
        const size_t row0 = (size_t)u.pm * 256; const int pnl = u.pn & 3;
#pragma unroll
        for (int ai = 0; ai < 2; ++ai)
#pragma unroll
            for (int m = 0; m < 4; ++m) { const int trow = ai * 128 + wr * 64 + m * 16 + fr;
#pragma unroll
                for (int bj = 0; bj < 2; ++bj) {
                    const f32x4 gt = acc[ai][bj][m][0], up = acc[ai][bj][m][1];
                    const int f = (8 * pnl + 4 * bj + wc) * 16 + 4 * fq;
                    float o[4];
#pragma unroll
                    for (int e = 0; e < 4; ++e) o[e] = gt[e] * sigmoidf_(gt[e]) * up[e];
                    u32x2 w; w.x = pk2(o[0], o[1]); w.y = pk2(o[2], o[3]);
                    *(u32x2*)(HE + (row0 + trow) * FEXP + f) = w;
                } }
    }
};
struct EpiMD {
    bf16_t* Y0; const int* lists; const float* lw; const LAS int* cn;
    __device__ __forceinline__ void operator()(const f32x4 (&acc)[2][2][4][2], const Unit& u, int wr, int wc, int fr, int fq) const {
        const int l = u.aux & 255, t0 = (u.aux >> 8) * 256, cnt = cn[l]; const int cb = (u.pn & 3) * 256;
        bf16_t* Y = Y0 + (size_t)(l & 1) * ((AR_YM1 - AR_YM0) / 2);
#pragma unroll
        for (int ai = 0; ai < 2; ++ai)
#pragma unroll
            for (int m = 0; m < 4; ++m) { const int trow = ai * 128 + wr * 64 + m * 16 + fr; const int idx = t0 + trow;
                if (idx < cnt) {
                    const int tok = lists[(size_t)l * TG + idx]; const float wgt = lw[(size_t)l * TG + idx];
#pragma unroll
                    for (int bj = 0; bj < 2; ++bj)
#pragma unroll
                        for (int n = 0; n < 2; ++n) { const int tcol = bj * 128 + wc * 32 + n * 16 + 4 * fq; const f32x4 v = acc[ai][bj][m][n];
                            u32x2 w; w.x = pk2(v[0] * wgt, v[1] * wgt); w.y = pk2(v[2] * wgt, v[3] * wgt);
                            *(u32x2*)(Y + (size_t)tok * D + cb + tcol) = w; }
                } }
    }
};

struct Frame {
    const Params __attribute__((address_space(4)))* kp; LAS unsigned char* lds; int tid, lane, wave, G, bid;
    unsigned char* ws;
    __device__ __forceinline__ const float* in(int k) const { return kp->in[k]; }
    __device__ __forceinline__ float* outp() const { return kp->out; }
    template <class T> __device__ __forceinline__ T* wsp(size_t off) const { return (T*)(ws + off); }
    template <class T> __device__ __forceinline__ T* ar(size_t off) const { return (T*)(ws + WS_ARENA + off); }
    __device__ __forceinline__ const float* modL(int layer, int b, int j) const { return (const float*)(ws + WS_MODL) + (((size_t)layer * NB + b) * 6 + j) * D; }
    __device__ __forceinline__ const float* modC(int layer, int j) const { return (const float*)(ws + WS_MODC) + ((size_t)layer * 6 + j) * D; }
};

struct TJob { const float* src; bf16_t* dst; const float* ksc; int lds, K, N, ldd, kofs, nofs, inter; };
constexpr int NJOBS = 2 * 24 + 1 + 4 + 4 * NEXP * 3;
__device__ __forceinline__ TJob get_job(const Frame& F, int j) {
    TJob J; J.ksc = nullptr; J.kofs = 0; J.nofs = 0; J.inter = 0; J.K = 0; J.N = 0; J.lds = 0; J.ldd = 0; J.src = nullptr; J.dst = nullptr;
    if (j < 48) {
        const int a = j / 24, q = j % 24;
        if (q < 18) {
            const int half = q / 9, w = q % 9; const float* mu = F.in(8) + (size_t)a * 6 * D;
            J.dst = F.wsp<bf16_t>(WS_W1CAT) + (size_t)a * N1CAT * K1CAT; J.ldd = K1CAT; J.kofs = half * 1024; J.K = D; int mi = 0;
            if (w == 0) { J.src = F.in(9) + (size_t)a * D * D; J.lds = D; J.N = D; J.nofs = 0; mi = 0; }
            else if (w == 1) { J.src = F.in(10) + (size_t)a * D * D; J.lds = D; J.N = D; J.nofs = 1024; mi = 2; }
            else if (w == 2) { J.src = F.in(11) + (size_t)a * D * D; J.lds = D; J.N = D; J.nofs = 2048; mi = 3; }
            else if (w < 5) { const int d = w - 3; J.src = F.in(14) + ((size_t)a * 2 + d) * D * 64; J.lds = 64; J.N = 64; J.nofs = 3072 + d * 64; mi = 1; }
            else if (w < 7) { const int d = w - 5; J.src = F.in(17) + ((size_t)a * 2 + d) * D * 64; J.lds = 64; J.N = 64; J.nofs = 3200 + d * 64; mi = 4; }
            else if (w == 7) { J.src = F.in(22) + (size_t)a * D * 128; J.lds = 128; J.N = 128; J.nofs = 3328; mi = 5; }
            else { J.src = F.in(20); J.lds = 32; J.N = (a == 1) ? 32 : 0; J.nofs = 3456; mi = 3; }
            if (half) J.ksc = mu + mi * D;
        } else if (q == 18) { J.src = F.in(12) + (size_t)a * D * D; J.lds = D; J.K = D; J.N = D; J.dst = F.wsp<bf16_t>(WS_WO) + (size_t)a * D * D; J.ldd = D; }
        else if (q == 19) { J.src = F.in(23) + (size_t)a * 128 * D; J.lds = D; J.K = 128; J.N = D; J.dst = F.wsp<bf16_t>(WS_G2T) + (size_t)a * D * 256; J.ldd = 256; }
        else if (q < 22) { const int d = q - 20; J.src = F.in(15) + ((size_t)a * 2 + d) * 64 * D; J.lds = D; J.K = 64; J.N = D; J.dst = F.wsp<bf16_t>(WS_W2T) + ((size_t)a * 2 + d) * D * 64; J.ldd = 64; }
        else { const int d = q - 22; J.src = F.in(18) + ((size_t)a * 2 + d) * 64 * D; J.lds = D; J.K = 64; J.N = D; J.dst = F.wsp<bf16_t>(WS_A2T) + ((size_t)a * 2 + d) * D * 64; J.ldd = 64; }
    } else if (j == 48) { J.src = F.in(21); J.lds = D; J.K = 32; J.N = D; J.dst = F.wsp<bf16_t>(WS_V2T); J.ldd = 256; J.kofs = 128; }
    else if (j < 53) {
        const int q = j - 49, b = q >> 1;
        if ((q & 1) == 0) { J.src = F.in(29) + (size_t)b * D * 4096; J.lds = 4096; J.K = D; J.N = 4096; J.dst = F.wsp<bf16_t>(WS_WIN) + (size_t)b * 4096 * D; J.ldd = D; }
        else { J.src = F.in(35) + (size_t)b * 2048 * D; J.lds = D; J.K = 2048; J.N = D; J.dst = F.wsp<bf16_t>(WS_WOUT) + (size_t)b * D * 2048; J.ldd = 2048; }
    } else {
        const int q = j - 53, ie = q / 3, w = q % 3;
        if (w < 2) { J.src = F.in(38 + w) + (size_t)ie * D * FEXP; J.lds = FEXP; J.K = D; J.N = FEXP; J.dst = F.wsp<bf16_t>(WS_WGU) + (size_t)ie * 1024 * D; J.ldd = D; J.nofs = w * 16; J.inter = 1; }
        else { J.src = F.in(40) + (size_t)ie * FEXP * D; J.lds = D; J.K = FEXP; J.N = D; J.dst = F.wsp<bf16_t>(WS_WD) + (size_t)ie * D * FEXP; J.ldd = FEXP; }
    }
    return J;
}
__device__ __forceinline__ void transpose_all(const Frame& F) {
    LAS float* tile = (LAS float*)F.lds;
    int tilectr = 0;
#pragma unroll 1
    for (int j = 0; j < NJOBS; ++j) {
        const TJob J = get_job(F, j);
        const int tk = (J.K + 63) / 64, tn = (J.N + 63) / 64, ntile = tk * tn;
        int t = (F.bid - (tilectr % F.G) + F.G) % F.G;
        tilectr += ntile;
#pragma unroll 1
        for (; t < ntile; t += F.G) {
            const int k0 = (t / tn) * 64, n0 = (t % tn) * 64;
            __syncthreads();
#pragma unroll
            for (int e = 0; e < 8; ++e) { const int idx = F.tid + e * 512, kk = idx >> 6, nn = idx & 63;
                float v = 0.f; if (k0 + kk < J.K && n0 + nn < J.N) { v = J.src[(size_t)(k0 + kk) * J.lds + n0 + nn]; if (J.ksc) v *= J.ksc[k0 + kk]; }
                tile[kk * 65 + nn] = v; }
            __syncthreads();
#pragma unroll
            for (int e = 0; e < 8; ++e) { const int idx = F.tid + e * 512, nn = idx >> 6, kk = idx & 63;
                if (k0 + kk < J.K && n0 + nn < J.N) { const int n = n0 + nn; const int row = J.nofs + (J.inter ? ((n >> 4) * 32 + (n & 15)) : n);
                    J.dst[(size_t)row * J.ldd + J.kofs + k0 + kk] = f2bf(tile[kk * 65 + nn]); } }
        }
    }
    __syncthreads();
}
__device__ __forceinline__ void zero_rows(const Frame& F, bf16_t* dst, int ldd, int row0, int nrows, int col0, int ncols) {
    const int per = ncols / 8; const long tot = (long)nrows * per;
    for (long i = (long)F.bid * NTHREADS + F.tid; i < tot; i += (long)F.G * NTHREADS) { const int r = (int)(i / per), c = (int)(i % per) * 8;
        *(u32x4*)(dst + (size_t)(row0 + r) * ldd + col0 + c) = (u32x4){0u, 0u, 0u, 0u}; }
}
__device__ __forceinline__ void phase_prologue(const Frame& F) {
    {
        LAS float* sl = (LAS float*)F.lds;
        LAS float* red = (LAS float*)(F.lds + 33 * 256 * 4);
        const float* c = F.in(1); const float* cc = F.in(3); const float* wm = F.in(4); const float* bm = F.in(5);
        const int tx = F.tid & 63, ty = F.tid >> 6;
        for (int unit = F.bid; unit < 4 * 96; unit += F.G) {
            const int layer = unit / 96, col0 = (unit % 96) * 64;
            float acc[33];
#pragma unroll
            for (int r = 0; r < 33; ++r) acc[r] = 0.f;
#pragma unroll 1
            for (int kc = 0; kc < 4; ++kc) {
                __syncthreads();
                for (int i = F.tid; i < 33 * 256; i += NTHREADS) { const int r = i >> 8, k = (i & 255) + kc * 256; const float x = r < 32 ? c[r * D + k] : cc[k]; sl[i] = x * sigmoidf_(x); }
                __syncthreads();
#pragma unroll 1
                for (int k4 = 0; k4 < 32; k4 += 4) {
                    const int kl = ty * 32 + k4;
                    float w[4];
#pragma unroll
                    for (int e = 0; e < 4; ++e) w[e] = wm[((size_t)layer * D + kc * 256 + kl + e) * 6144 + col0 + tx];
#pragma unroll
                    for (int r = 0; r < 33; ++r) { const f32x4 s = *(const LAS f32x4*)(sl + r * 256 + kl); acc[r] += s[0] * w[0] + s[1] * w[1] + s[2] * w[2] + s[3] * w[3]; if ((r & 7) == 7) asm volatile("" ::: "memory"); }
                }
            }
            __syncthreads();
#pragma unroll
            for (int r = 0; r < 33; ++r) red[(ty * 33 + r) * 64 + tx] = acc[r];
            __syncthreads();
            for (int i = F.tid; i < 33 * 64; i += NTHREADS) { const int r = i >> 6, x = i & 63; float s = 0.f;
#pragma unroll
                for (int y = 0; y < 8; ++y) s += red[(y * 33 + r) * 64 + x];
                const int col = col0 + x; s += bm[layer * 6144 + col];
                if (r < 32) F.wsp<float>(WS_MODL)[((size_t)layer * NB + r) * 6144 + col] = s; else F.wsp<float>(WS_MODC)[(size_t)layer * 6144 + col] = s; }
        }
    }
    __syncthreads();
    transpose_all(F);
    for (int a = 0; a < 2; ++a) {
        bf16_t* W1 = F.wsp<bf16_t>(WS_W1CAT) + (size_t)a * N1CAT * K1CAT;
        if (a == 0) zero_rows(F, W1, K1CAT, 3456, 128, 0, K1CAT); else zero_rows(F, W1, K1CAT, 3488, 96, 0, K1CAT);
        zero_rows(F, F.wsp<bf16_t>(WS_G2T) + (size_t)a * D * 256, 256, 0, D, 128, 128);
    }
    zero_rows(F, F.wsp<bf16_t>(WS_V2T), 256, 0, D, 0, 128); zero_rows(F, F.wsp<bf16_t>(WS_V2T), 256, 0, D, 160, 96);
    {
        const float* src = F.in(33); bf16_t* dst = F.wsp<bf16_t>(WS_WSP); const long tot = (long)2 * 16 * 128 * 128 / 4;
        for (long i = (long)F.bid * NTHREADS + F.tid; i < tot; i += (long)F.G * NTHREADS) { const f32x4 v = *(const f32x4*)(src + i * 4); u32x2 w; w.x = pk2(v[0], v[1]); w.y = pk2(v[2], v[3]); *(u32x2*)(dst + i * 4) = w; }
    }
    __syncthreads();
}

__device__ __forceinline__ void phase_norm1(const Frame& F, int g, int layer  , bf16_t* dst, int ldh, bool dry = false) {
    float* X = F.wsp<float>(WS_X);
    const bf16_t* Y0 = F.ar<bf16_t>(AR_YM0); const bf16_t* Y1 = F.ar<bf16_t>(AR_YM1);
    const bool fin = layer == 4;
    for (int r = F.bid * NWAVES + F.wave; r < TG; r += F.G * NWAVES) {
        const int bl = r / LT, t = r % LT, b = g * BG + bl; const bool isctx = t < LC;
        if (isctx && layer >= 3) continue;
        f32x4 x[4], xo[4];
#pragma unroll
        for (int q = 0; q < 4; ++q) xo[q] = (f32x4){0.f, 0.f, 0.f, 0.f};
        if (layer == 0) {
            const float* src = isctx ? F.in(2) + ((size_t)b * LC + t) * D : F.in(0) + ((size_t)b * SEQ + (t - LC)) * D;
#pragma unroll
            for (int q = 0; q < 4; ++q) x[q] = *(const f32x4*)(src + q * 256 + F.lane * 4);
        } else {
            const float* gt = isctx ? F.modC(layer - 1, 5) : F.modL(layer - 1, b, 5);
#pragma unroll
            for (int q = 0; q < 4; ++q) { const int c = q * 256 + F.lane * 4;
                x[q] = *(const f32x4*)(X + (size_t)r * D + c); xo[q] = x[q];
                const u32x2 a = *(const u32x2*)(Y0 + (size_t)r * D + c), bb = *(const u32x2*)(Y1 + (size_t)r * D + c);
                const f32x4 gv = *(const f32x4*)(gt + c);
                x[q][0] += gv[0] * (lo16(a.x) + lo16(bb.x)); x[q][1] += gv[1] * (hi16(a.x) + hi16(bb.x));
                x[q][2] += gv[2] * (lo16(a.y) + lo16(bb.y)); x[q][3] += gv[3] * (hi16(a.y) + hi16(bb.y)); }
        }
        float ss = 0.f;
#pragma unroll
        for (int q = 0; q < 4; ++q) ss += x[q][0] * x[q][0] + x[q][1] * x[q][1] + x[q][2] * x[q][2] + x[q][3] * x[q][3];
        ss = wave_sum(ss);
        const float rstd = rsqrtf(ss * (1.0f / D) + 1e-6f);
        if (fin) {
            float* o = F.outp() + ((size_t)b * SEQ + (t - LC)) * D; const float* fg = F.in(41);
#pragma unroll
            for (int q = 0; q < 4; ++q) { const int c = q * 256 + F.lane * 4; const f32x4 gv = *(const f32x4*)(fg + c); *(f32x4*)(o + c) = x[q] * rstd * gv; }
        } else {
            const float* gn = F.in(6) + (size_t)layer * D;
            const float* sh = isctx ? F.modC(layer, 0) : F.modL(layer, b, 0);
            const float* sc = isctx ? F.modC(layer, 1) : F.modL(layer, b, 1);
#pragma unroll
            for (int q = 0; q < 4; ++q) { const int c = q * 256 + F.lane * 4;
                *(f32x4*)(X + (size_t)r * D + c) = (dry && layer > 0) ? xo[q] : x[q];
                const f32x4 gv = *(const f32x4*)(gn + c), sv = *(const f32x4*)(sh + c), cv = *(const f32x4*)(sc + c);
                const f32x4 h = x[q] * rstd * gv * (1.0f + cv) + sv;
                u32x2 w; w.x = pk2(h[0], h[1]); w.y = pk2(h[2], h[3]);
                *(u32x2*)(dst + (size_t)r * ldh + c) = w; }
        }
    }
}
__device__ __forceinline__ void phase_mix(const Frame& F) {
    bf16_t* H2 = F.ar<bf16_t>(AR_H2);
    for (int r = F.bid * NWAVES + F.wave; r < TG; r += F.G * NWAVES) {
        const int t = r % LT; const bool isctx = t < LC; const int p = t - LC;
#pragma unroll
        for (int q = 0; q < 2; ++q) {
            const int c = q * 512 + F.lane * 8;
            int nr;
            if (isctx) nr = (q == 0) ? (t > 0 ? r - 1 : -1) : (t < LC - 1 ? r + 1 : -1);
            else { const int qu = c >> 8;
                nr = qu == 0 ? ((p & 63) > 0 ? r - 1 : -1) : qu == 1 ? ((p & 63) < 63 ? r + 1 : -1) : qu == 2 ? (p >= 64 ? r - 64 : -1) : (p < SEQ - 64 ? r + 64 : -1); }
            const u32x4 hs = *(const u32x4*)(H2 + (size_t)r * 2048 + c);
            u32x4 hn = (u32x4){0u, 0u, 0u, 0u};
            if (nr >= 0) hn = *(const u32x4*)(H2 + (size_t)nr * 2048 + c);
            u32x4 o;
            o.x = pk2(lo16(hn.x) - lo16(hs.x), hi16(hn.x) - hi16(hs.x)); o.y = pk2(lo16(hn.y) - lo16(hs.y), hi16(hn.y) - hi16(hs.y));
            o.z = pk2(lo16(hn.z) - lo16(hs.z), hi16(hn.z) - hi16(hs.z)); o.w = pk2(lo16(hn.w) - lo16(hs.w), hi16(hn.w) - hi16(hs.w));
            *(u32x4*)(H2 + (size_t)r * 2048 + 1024 + c) = o;
        }
    }
}
__device__ __forceinline__ void phase_vfix(const Frame& F) {
    bf16_t* V = F.ar<bf16_t>(AR_V); const bf16_t* VF = F.wsp<bf16_t>(WS_VF); const bf16_t* GT = F.ar<bf16_t>(AR_VGATE);
    const size_t tot = (size_t)TG * D / 8;
    for (size_t i = (size_t)F.bid * NTHREADS + F.tid; i < tot; i += (size_t)F.G * NTHREADS) {
        const u32x4 v = *(const u32x4*)(V + i * 8), f = *(const u32x4*)(VF + i * 8), g = *(const u32x4*)(GT + i * 8);
        u32x4 o;
        o.x = pk2(lo16(v.x) + (lo16(f.x) - lo16(v.x)) * lo16(g.x), hi16(v.x) + (hi16(f.x) - hi16(v.x)) * hi16(g.x));
        o.y = pk2(lo16(v.y) + (lo16(f.y) - lo16(v.y)) * lo16(g.y), hi16(v.y) + (hi16(f.y) - hi16(v.y)) * hi16(g.y));
        o.z = pk2(lo16(v.z) + (lo16(f.z) - lo16(v.z)) * lo16(g.z), hi16(v.z) + (hi16(f.z) - hi16(v.z)) * hi16(g.z));
        o.w = pk2(lo16(v.w) + (lo16(f.w) - lo16(v.w)) * lo16(g.w), hi16(v.w) + (hi16(f.w) - hi16(v.w)) * hi16(g.w));
        *(u32x4*)(V + i * 8) = o;
    }
}
__device__ __forceinline__ void phase_post(const Frame& F, int a, const bf16_t* V) {
    const bf16_t* Y0 = F.ar<bf16_t>(AR_Y0); bf16_t* YG = F.ar<bf16_t>(AR_R); const bf16_t* Y1 = F.ar<bf16_t>(AR_Y1); const float* DOT = F.ar<float>(AR_DOT); const bf16_t* Gb = F.ar<bf16_t>(AR_G);
    const float* lg = F.in(27) + (size_t)a * D; const float* lb = F.in(28) + (size_t)a * D;
    for (int r = F.bid * NWAVES + F.wave; r < TG; r += F.G * NWAVES) {
        const int c = F.lane * 16, h = F.lane >> 2;
        float y[16], vv[16];
#pragma unroll
        for (int q = 0; q < 2; ++q) {
            const u32x4 a0 = *(const u32x4*)(Y0 + (size_t)r * D + c + q * 8), a1 = *(const u32x4*)(Y1 + (size_t)r * D + c + q * 8), v4 = *(const u32x4*)(V + (size_t)r * D + c + q * 8);
            y[q * 8 + 0] = lo16(a0.x) + lo16(a1.x); y[q * 8 + 1] = hi16(a0.x) + hi16(a1.x); y[q * 8 + 2] = lo16(a0.y) + lo16(a1.y); y[q * 8 + 3] = hi16(a0.y) + hi16(a1.y);
            y[q * 8 + 4] = lo16(a0.z) + lo16(a1.z); y[q * 8 + 5] = hi16(a0.z) + hi16(a1.z); y[q * 8 + 6] = lo16(a0.w) + lo16(a1.w); y[q * 8 + 7] = hi16(a0.w) + hi16(a1.w);
            vv[q * 8 + 0] = lo16(v4.x); vv[q * 8 + 1] = hi16(v4.x); vv[q * 8 + 2] = lo16(v4.y); vv[q * 8 + 3] = hi16(v4.y);
            vv[q * 8 + 4] = lo16(v4.z); vv[q * 8 + 5] = hi16(v4.z); vv[q * 8 + 6] = lo16(v4.w); vv[q * 8 + 7] = hi16(v4.w);
        }
        float s = 0.f;
#pragma unroll
        for (int e = 0; e < 16; ++e) s += y[e];
        s = red4(s); const float mean = s * (1.0f / 64.0f);
        float qv = 0.f;
#pragma unroll
        for (int e = 0; e < 16; ++e) { const float dd = y[e] - mean; qv += dd * dd; }
        qv = red4(qv); const float rstd = rsqrtf(qv * (1.0f / 64.0f) + 64e-5f);
        const float dsum = DOT[(size_t)r * NH + h] + DOT[((size_t)TG + r) * NH + h];
        unsigned o[8];
        const u32x4 g0 = *(const u32x4*)(Gb + (size_t)r * D + c), g1 = *(const u32x4*)(Gb + (size_t)r * D + c + 8);
        const unsigned gw[8] = {g0.x, g0.y, g0.z, g0.w, g1.x, g1.y, g1.z, g1.w};
#pragma unroll
        for (int e = 0; e < 16; e += 2) {
            const float o0 = ((y[e] - mean) * rstd * lg[c + e] + lb[c + e] + vv[e] * dsum) * lo16(gw[e >> 1]);
            const float o1 = ((y[e + 1] - mean) * rstd * lg[c + e + 1] + lb[c + e + 1] + vv[e + 1] * dsum) * hi16(gw[e >> 1]);
            o[e >> 1] = pk2(o0, o1);
        }
        *(u32x4*)(YG + (size_t)r * D + c) = (u32x4){o[0], o[1], o[2], o[3]};
        *(u32x4*)(YG + (size_t)r * D + c + 8) = (u32x4){o[4], o[5], o[6], o[7]};
    }
}
__device__ __forceinline__ void phase_norm2(const Frame& F, int g, int layer, bool dry = false) {
    float* X = F.wsp<float>(WS_X); bf16_t* HM = F.ar<bf16_t>(AR_HM); const bf16_t* Ob = F.ar<bf16_t>(AR_O);
    int* lists = dry ? F.ar<int>(AR_YM0) : F.ar<int>(AR_LIST); float* lwt = dry ? F.ar<float>(AR_YM0) + (size_t)32 * TG : F.ar<float>(AR_LW);
    unsigned* cnt = (unsigned*)(F.ws + WS_CTL + CTL_CNT_OFF) + (((size_t)g * 4 + layer) * 32 + (dry ? NG * 4 * 32 : 0)) * 16;
    LAS float* wr = (LAS float*)F.lds;
    __syncthreads();
    for (int i = F.tid; i < D * NEXP / 4; i += NTHREADS) { const int c = i >> 2, e4 = i & 3; const int rho = (c & ~255) + (c & 3) * 64 + ((c & 255) >> 2);
        *(LAS f32x4*)(wr + rho * 20 + e4 * 4) = *(const f32x4*)(F.in(36) + i * 4); }
    __syncthreads();
    const float* rbias = F.in(37);
    const bool ctx_out = layer < 2;
    LAS int* lcnt = (LAS int*)(F.lds + LDS_MISC + 512);
    LAS int* lbase = (LAS int*)(F.lds + LDS_MISC + 640);
    LAS int* rec = (LAS int*)(F.lds + 81920);
    const int niter = (TG + F.G * NWAVES - 1) / (F.G * NWAVES);
    for (int it0 = 0; it0 < niter; it0 += 64) {
        if (F.tid < 32) lcnt[F.tid] = 0;
        __syncthreads();
        const int itn = (niter - it0) < 64 ? (niter - it0) : 64;
        for (int itl = 0; itl < itn; ++itl) {
            const int r = (F.bid + (it0 + itl) * F.G) * NWAVES + F.wave;
            const int bl = r / LT, t = r % LT, b = g * BG + bl; const bool isctx = t < LC;
            const int slot = itl * NWAVES + F.wave;
            if (r >= TG || (isctx && !ctx_out)) { if (F.lane == 0) rec[slot * 4] = -1; continue; }
            f32x4 x[4]; float ss = 0.f;
            const float* gt1 = isctx ? F.modC(layer, 2) : F.modL(layer, b, 2);
#pragma unroll
            for (int q = 0; q < 4; ++q) { const int c = q * 256 + F.lane * 4;
                x[q] = *(const f32x4*)(X + (size_t)r * D + c);
                const u32x2 ob = *(const u32x2*)(Ob + (size_t)r * D + c); const f32x4 gv = *(const f32x4*)(gt1 + c);
                const f32x4 xo = x[q];
                x[q][0] += gv[0] * lo16(ob.x); x[q][1] += gv[1] * hi16(ob.x); x[q][2] += gv[2] * lo16(ob.y); x[q][3] += gv[3] * hi16(ob.y);
                *(f32x4*)(X + (size_t)r * D + c) = dry ? xo : x[q];
                ss += x[q][0] * x[q][0] + x[q][1] * x[q][1] + x[q][2] * x[q][2] + x[q][3] * x[q][3]; }
            ss = wave_sum(ss);
            const float rstd = rsqrtf(ss * (1.0f / D) + 1e-6f);
            const float* gn = F.in(7) + (size_t)layer * D;
            const float* sh = isctx ? F.modC(layer, 3) : F.modL(layer, b, 3);
            const float* sc = isctx ? F.modC(layer, 4) : F.modL(layer, b, 4);
            float lg[16];
#pragma unroll
            for (int e = 0; e < 16; ++e) lg[e] = 0.f;
#pragma unroll
            for (int q = 0; q < 4; ++q) { const int c = q * 256 + F.lane * 4;
                const f32x4 gv = *(const f32x4*)(gn + c), sv = *(const f32x4*)(sh + c), cv = *(const f32x4*)(sc + c);
                const f32x4 h = x[q] * rstd * gv * (1.0f + cv) + sv;
                u32x2 w; w.x = pk2(h[0], h[1]); w.y = pk2(h[2], h[3]);
                *(u32x2*)(HM + (size_t)r * D + c) = w;
#pragma unroll
                for (int j = 0; j < 4; ++j) {
#pragma unroll
                    for (int e4 = 0; e4 < 4; ++e4) { const f32x4 wv = *(const LAS f32x4*)(wr + (q * 256 + j * 64 + F.lane) * 20 + e4 * 4);
                        lg[e4 * 4 + 0] += h[j] * wv[0]; lg[e4 * 4 + 1] += h[j] * wv[1]; lg[e4 * 4 + 2] += h[j] * wv[2]; lg[e4 * 4 + 3] += h[j] * wv[3]; } }
            }
#pragma unroll
            for (int e = 0; e < 16; ++e) lg[e] = wave_sum_dpp(lg[e]);
            float sc_[16], bs[16];
#pragma unroll
            for (int e = 0; e < 16; ++e) { sc_[e] = sigmoidf_(lg[e]); bs[e] = sc_[e] + rbias[e]; }
            float gs[4];
#pragma unroll
            for (int gq = 0; gq < 4; ++gq) { float m1 = -1e30f, m2 = -1e30f;
#pragma unroll
                for (int j = 0; j < 4; ++j) { const float v = bs[gq * 4 + j]; if (v > m1) { m2 = m1; m1 = v; } else if (v > m2) m2 = v; }
                gs[gq] = m1 + m2; }
            int best = 0; float bv = gs[0];
#pragma unroll
            for (int gq = 1; gq < 4; ++gq) if (gs[gq] > bv) { bv = gs[gq]; best = gq; }
            float cb[4], cs[4];
#pragma unroll
            for (int j = 0; j < 4; ++j) { cb[j] = best == 0 ? bs[j] : best == 1 ? bs[4 + j] : best == 2 ? bs[8 + j] : bs[12 + j]; cs[j] = best == 0 ? sc_[j] : best == 1 ? sc_[4 + j] : best == 2 ? sc_[8 + j] : sc_[12 + j]; }
            int j1 = 0; float v1 = cb[0];
#pragma unroll
            for (int j = 1; j < 4; ++j) if (cb[j] > v1) { v1 = cb[j]; j1 = j; }
            int j2 = -1; float v2 = -1e30f;
#pragma unroll
            for (int j = 0; j < 4; ++j) if (j != j1 && cb[j] > v2) { v2 = cb[j]; j2 = j; }
            const float s1 = j1 == 0 ? cs[0] : j1 == 1 ? cs[1] : j1 == 2 ? cs[2] : cs[3];
            const float s2 = j2 == 0 ? cs[0] : j2 == 1 ? cs[1] : j2 == 2 ? cs[2] : cs[3];
            const float inv = 1.0f / (s1 + s2);
            if (F.lane == 0) {
                const int l1 = (best * 4 + j1) * 2 + 0, l2 = (best * 4 + j2) * 2 + 1;
                const int p1 = __hip_atomic_fetch_add(lcnt + l1, 1, __ATOMIC_RELAXED, __HIP_MEMORY_SCOPE_WORKGROUP);
                const int p2 = __hip_atomic_fetch_add(lcnt + l2, 1, __ATOMIC_RELAXED, __HIP_MEMORY_SCOPE_WORKGROUP);
                rec[slot * 4 + 0] = l1 | (p1 << 8); rec[slot * 4 + 1] = l2 | (p2 << 8);
                rec[slot * 4 + 2] = __float_as_int(s1 * inv); rec[slot * 4 + 3] = __float_as_int(s2 * inv);
            }
        }
        __syncthreads();
        if (F.tid < 32) { const int c = lcnt[F.tid]; lbase[F.tid] = c ? (int)atomicAdd(&cnt[F.tid * 16], (unsigned)c) : 0; }
        __syncthreads();
        for (int slot = F.tid; slot < itn * NWAVES; slot += NTHREADS) {
            const int a0 = rec[slot * 4 + 0]; if (a0 < 0) continue;
            const int a1 = rec[slot * 4 + 1];
            const int r = (F.bid + (it0 + slot / NWAVES) * F.G) * NWAVES + (slot % NWAVES);
            const int l1 = a0 & 255, l2 = a1 & 255; const int q1 = lbase[l1] + (a0 >> 8), q2 = lbase[l2] + (a1 >> 8);
            lists[(size_t)l1 * TG + q1] = r; lwt[(size_t)l1 * TG + q1] = __int_as_float(rec[slot * 4 + 2]);
            lists[(size_t)l2 * TG + q2] = r; lwt[(size_t)l2 * TG + q2] = __int_as_float(rec[slot * 4 + 3]);
        }
        __syncthreads();
    }
}
__device__ __forceinline__ int moe_tables(const Frame& F, int g, int layer) {
    LAS int* cn = (LAS int*)(F.lds + LDS_MISC + 64); LAS int* tb = (LAS int*)(F.lds + LDS_MISC + 192);
    const unsigned* cnt = (const unsigned*)(F.ws + WS_CTL + CTL_CNT_OFF) + ((size_t)g * 4 + layer) * 32 * 16;
    __syncthreads();
    if (F.tid == 0) { int acc = 0; for (int l = 0; l < 32; ++l) { const int c = (int)__hip_atomic_load(cnt + l * 16, __ATOMIC_RELAXED, __HIP_MEMORY_SCOPE_AGENT); cn[l] = c; tb[l] = acc; acc += (c + 255) >> 8; } tb[32] = acc; }
    __syncthreads();
    return tb[32];
}

constexpr int SC_OPB = 6 * 4096;
constexpr int SC_HALF = 2 * SC_OPB + 4096 + 4096;
static_assert(2 * SC_HALF <= LDS_STAGE, "scan lds");
__device__ __forceinline__ int scan_tok(int d, int s) { return d == 0 ? s : (s < LC ? (LC - 1 - s) : (LT + LC - 1 - s)); }
__device__ __forceinline__ void phase_scan(const Frame& F, int a, const bf16_t* V) {
    const bf16_t* R = F.ar<bf16_t>(AR_R); const bf16_t* Kb = F.ar<bf16_t>(AR_K); const bf16_t* L1 = F.ar<bf16_t>(AR_L1);
    const int half = F.wave >> 2, q = F.wave & 3, lane = F.lane, li = q * 64 + lane;
    LAS unsigned char* hb = F.lds + half * SC_HALF;
    LAS float* aT = (LAS float*)(hb + 2 * SC_OPB); LAS float* ybuf = (LAS float*)(hb + 2 * SC_OPB + 4096);
    const int arr = q >> 1, ntl = (q & 1) * 2;
    const int i = lane >> 3, j = lane & 7, r0 = 16 * q + 2 * i;
    const int tB = li >> 4, k4 = (li & 15) * 4;
    for (int pr = F.bid; pr < BG * 16; pr += F.G) {
        const int bl = pr >> 4, d = (pr >> 3) & 1, hp = pr & 7, h = hp * 2 + half;
        bf16_t* Yd = F.ar<bf16_t>(d ? AR_Y1 : AR_Y0); float* DOT = F.ar<float>(AR_DOT) + (size_t)d * TG * NH;
        const size_t rowb = (size_t)bl * LT;
        const bf16_t* W2 = (arr == 0 ? F.wsp<bf16_t>(WS_W2T) : F.wsp<bf16_t>(WS_A2T)) + ((size_t)a * 2 + d) * D * 64;
        bf16x8 Bf[2][2]; float bias[2];
#pragma unroll
        for (int nt = 0; nt < 2; ++nt) { const int cc = h * 64 + (ntl + nt) * 16 + (lane & 15);
            bias[nt] = (arr == 0 ? F.in(13) : F.in(16))[((size_t)a * 2 + d) * D + cc];
#pragma unroll
            for (int s = 0; s < 2; ++s) Bf[nt][s] = *(const bf16x8*)(W2 + (size_t)cc * 64 + 32 * s + 8 * (lane >> 4)); }
        const f32x4 kkc = *(const f32x4*)(F.in(24) + (size_t)a * D + h * 64 + k4), kac = *(const f32x4*)(F.in(25) + (size_t)a * D + h * 64 + k4), rkc = *(const f32x4*)(F.in(26) + (size_t)a * D + h * 64 + k4);
        const int acol = arr * 128 + d * 64 + 8 * (lane >> 4);
        float S0[8], S1[8];
#pragma unroll
        for (int c = 0; c < 8; ++c) { S0[c] = 0.f; S1[c] = 0.f; }
        bf16x8 Af[2]; u32x2 kraw, rraw, vraw;
#define SC_LOAD(ch) do { const size_t rowA = rowb + scan_tok(d, (ch) * 16 + (lane & 15)); \
        Af[0] = *(const bf16x8*)(L1 + rowA * 512 + acol); Af[1] = *(const bf16x8*)(L1 + rowA * 512 + acol + 32); \
        const size_t rowBq = (rowb + scan_tok(d, (ch) * 16 + tB)) * D + h * 64 + k4; \
        kraw = *(const u32x2*)(Kb + rowBq); rraw = *(const u32x2*)(R + rowBq); vraw = *(const u32x2*)(V + rowBq); } while (0)
#define SC_PASSA(buf) do { LAS float* op = (LAS float*)(hb + (buf) * SC_OPB); \
        _Pragma("unroll") for (int nt = 0; nt < 2; ++nt) { f32x4 ac = (f32x4){0.f, 0.f, 0.f, 0.f}; \
            ac = __builtin_amdgcn_mfma_f32_16x16x32_bf16(Af[0], Bf[nt][0], ac, 0, 0, 0); ac = __builtin_amdgcn_mfma_f32_16x16x32_bf16(Af[1], Bf[nt][1], ac, 0, 0, 0); \
            const int n = (ntl + nt) * 16 + (lane & 15); \
            _Pragma("unroll") for (int rg = 0; rg < 4; ++rg) { const int t = (lane >> 4) * 4 + rg; const float x = ac[rg] + bias[nt]; \
                if (arr == 0) { const float nx = -x; const float sp = nx > 20.f ? nx : __logf(1.0f + __expf(nx)); op[1024 + t * 64 + n] = __expf(-__expf(-sp - 0.5f)); } \
                else aT[t * 64 + n] = sigmoidf_(x); } } } while (0)
#define SC_PASSB(ch, buf) do { LAS float* op = (LAS float*)(hb + (buf) * SC_OPB); \
        const float kf[4] = {lo16(kraw.x), hi16(kraw.x), lo16(kraw.y), hi16(kraw.y)}; const float rf[4] = {lo16(rraw.x), hi16(rraw.x), lo16(rraw.y), hi16(rraw.y)}; \
        const float vf[4] = {lo16(vraw.x), hi16(vraw.x), lo16(vraw.y), hi16(vraw.y)}; \
        const f32x4 av = *(const LAS f32x4*)(aT + tB * 64 + k4); \
        float kq[4], ssq = 0.f; _Pragma("unroll") for (int e = 0; e < 4; ++e) { kq[e] = kf[e] * kkc[e]; ssq += kq[e] * kq[e]; } \
        ssq = red16(ssq); const float inv = 1.0f / fmaxf(sqrtf(ssq), 1e-12f); \
        f32x4 o_kk, o_kka, o_kd, o_r, o_v; float dp = 0.f; \
        _Pragma("unroll") for (int e = 0; e < 4; ++e) { const float kkv = kq[e] * inv; const float kd = kf[e] * (1.0f + (av[e] - 1.0f) * kac[e]); \
            o_kk[e] = kkv; o_kka[e] = kkv * av[e]; o_kd[e] = kd; o_r[e] = rf[e]; o_v[e] = vf[e]; dp += rf[e] * kd * rkc[e]; } \
        dp = red16(dp); \
        if ((li & 15) == 0) DOT[(rowb + scan_tok(d, (ch) * 16 + tB)) * NH + h] = dp; \
        *(LAS f32x4*)(op + 0 * 1024 + tB * 64 + k4) = o_kk; *(LAS f32x4*)(op + 2 * 1024 + tB * 64 + k4) = o_kka; *(LAS f32x4*)(op + 3 * 1024 + tB * 64 + k4) = o_kd; \
        *(LAS f32x4*)(op + 4 * 1024 + tB * 64 + k4) = o_r; *(LAS f32x4*)(op + 5 * 1024 + tB * 64 + k4) = o_v; } while (0)
        __syncthreads();
        SC_LOAD(0);
        SC_PASSA(0);
        __syncthreads();
        SC_PASSB(0, 0);
        __syncthreads();
        constexpr int NCH = LT / 16;
        for (int ch = 0; ch < NCH; ++ch) {
            const int buf = ch & 1;
            if (ch + 1 < NCH) SC_LOAD(ch + 1);
            const LAS float* op = (const LAS float*)(hb + buf * SC_OPB);
            f32x4 cA[5], cB[5], nA[5], nB[5]; f32x2 cv, nv;
#define SC_OPLOAD(dA, dB, dv, t) do { const LAS float* ob_ = op + (t) * 64 + j * 8; \
                _Pragma("unroll") for (int q_ = 0; q_ < 5; ++q_) { dA[q_] = *(const LAS f32x4*)(ob_ + q_ * 1024); dB[q_] = *(const LAS f32x4*)(ob_ + q_ * 1024 + 4); } \
                dv = *(const LAS f32x2*)(op + 5 * 1024 + (t) * 64 + r0); } while (0)
            SC_OPLOAD(cA, cB, cv, 0);
#pragma unroll
            for (int t = 0; t < 16; ++t) {
                if (t + 1 < 16) SC_OPLOAD(nA, nB, nv, t + 1);
                const float kk[8] = {cA[0][0], cA[0][1], cA[0][2], cA[0][3], cB[0][0], cB[0][1], cB[0][2], cB[0][3]};
                const float dc[8] = {cA[1][0], cA[1][1], cA[1][2], cA[1][3], cB[1][0], cB[1][1], cB[1][2], cB[1][3]};
                const float ka[8] = {cA[2][0], cA[2][1], cA[2][2], cA[2][3], cB[2][0], cB[2][1], cB[2][2], cB[2][3]};
                const float kd[8] = {cA[3][0], cA[3][1], cA[3][2], cA[3][3], cB[3][0], cB[3][1], cB[3][2], cB[3][3]};
                const float rr[8] = {cA[4][0], cA[4][1], cA[4][2], cA[4][3], cB[4][0], cB[4][1], cB[4][2], cB[4][3]};
                float sa0 = (S0[0] * kk[0] + S0[1] * kk[1]) + (S0[2] * kk[2] + S0[3] * kk[3]) + ((S0[4] * kk[4] + S0[5] * kk[5]) + (S0[6] * kk[6] + S0[7] * kk[7]));
                float sa1 = (S1[0] * kk[0] + S1[1] * kk[1]) + (S1[2] * kk[2] + S1[3] * kk[3]) + ((S1[4] * kk[4] + S1[5] * kk[5]) + (S1[6] * kk[6] + S1[7] * kk[7]));
                sa0 = red8(sa0); sa1 = red8(sa1);
#pragma unroll
                for (int c = 0; c < 8; ++c) {
                    S0[c] = S0[c] * dc[c] + (cv[0] * kd[c] - sa0 * ka[c]);
                    S1[c] = S1[c] * dc[c] + (cv[1] * kd[c] - sa1 * ka[c]);
                }
                float y0 = (S0[0] * rr[0] + S0[1] * rr[1]) + (S0[2] * rr[2] + S0[3] * rr[3]) + ((S0[4] * rr[4] + S0[5] * rr[5]) + (S0[6] * rr[6] + S0[7] * rr[7]));
                float y1 = (S1[0] * rr[0] + S1[1] * rr[1]) + (S1[2] * rr[2] + S1[3] * rr[3]) + ((S1[4] * rr[4] + S1[5] * rr[5]) + (S1[6] * rr[6] + S1[7] * rr[7]));
                y0 = red8(y0); y1 = red8(y1);
                if (j == 0) *(LAS f32x2*)(ybuf + t * 64 + r0) = (f32x2){y0, y1};
#pragma unroll
                for (int q_ = 0; q_ < 5; ++q_) { cA[q_] = nA[q_]; cB[q_] = nB[q_]; }
                cv = nv;
            }
#undef SC_OPLOAD
            __syncthreads();
            {
                const f32x4 yv = *(const LAS f32x4*)(ybuf + tB * 64 + k4);
                u32x2 w; w.x = pk2(yv[0], yv[1]); w.y = pk2(yv[2], yv[3]);
                *(u32x2*)(Yd + (rowb + scan_tok(d, ch * 16 + tB)) * D + h * 64 + k4) = w;
            }
            if (ch + 1 < NCH) SC_PASSA(buf ^ 1);
            __syncthreads();
            if (ch + 1 < NCH) SC_PASSB(ch + 1, buf ^ 1);
            __syncthreads();
        }
#undef SC_LOAD
#undef SC_PASSA
#undef SC_PASSB
    }
}

__device__ __forceinline__ void phase_sgstats(const Frame& F, int layer) {
    const bf16_t* Z = F.ar<bf16_t>(AR_Z); float* ST = F.ar<float>(AR_ST);
    for (int r = F.bid * NWAVES + F.wave; r < TG; r += F.G * NWAVES) {
        const int t = r % LT; if (t < LC && layer >= 3) continue;
        float x[32];
#pragma unroll
        for (int q = 0; q < 4; ++q) { const u32x4 w = *(const u32x4*)(Z + (size_t)r * 4096 + 2048 + q * 512 + F.lane * 8);
            x[q * 8 + 0] = lo16(w.x); x[q * 8 + 1] = hi16(w.x); x[q * 8 + 2] = lo16(w.y); x[q * 8 + 3] = hi16(w.y); x[q * 8 + 4] = lo16(w.z); x[q * 8 + 5] = hi16(w.z); x[q * 8 + 6] = lo16(w.w); x[q * 8 + 7] = hi16(w.w); }
        float s = 0.f;
#pragma unroll
        for (int e = 0; e < 32; ++e) s += x[e];
        s = wave_sum(s); const float mean = s * (1.0f / 2048.0f);
        float qv = 0.f;
#pragma unroll
        for (int e = 0; e < 32; ++e) { const float dd = x[e] - mean; qv += dd * dd; }
        qv = wave_sum(qv);
        if (F.lane == 0) *(f32x2*)(ST + (size_t)r * 2) = (f32x2){mean, rsqrtf(qv * (1.0f / 2048.0f) + 1e-5f)};
    }
}
__device__ __forceinline__ int vt_off(int dch, int jb) { return dch * 256 + ((jb ^ ((dch & 15) ^ (((dch >> 4) & 7) << 1))) << 4); }
__device__ __forceinline__ void phase_spatial(const Frame& F, int bsg, int layer) {
    const bf16_t* Z = F.ar<bf16_t>(AR_Z); const float* ST = F.ar<float>(AR_ST); bf16_t* Pb = F.ar<bf16_t>(AR_P);
    const bf16_t* Ws = F.wsp<bf16_t>(WS_WSP) + (size_t)bsg * 16 * 128 * 128;
    const float* lng = F.in(31) + (size_t)bsg * 2048; const float* lnb = F.in(32) + (size_t)bsg * 2048; const float* bs = F.in(34) + (size_t)bsg * 16 * 128;
    LAS unsigned char* vt = F.lds;
    const int skip = layer >= 3;
    const int nchunk = skip ? BG * 16 : BG * 18;
    const int w = F.wave, lane = F.lane, dt = w >> 1, it0 = (w & 1) * 2;
    for (int U = F.bid; U < nchunk * 16; U += F.G) {
        const int lc = U >> 4, gi = U & 15;
        const int chunk = skip ? (lc >> 4) * 18 + 2 + (lc & 15) : lc;
        const size_t row0 = (size_t)chunk * 128;
        __syncthreads();
#pragma unroll
        for (int k = 0; k < 4; ++k) {
            const int p = F.tid + 512 * k, jj = p >> 4, c8 = (p & 15) * 8;
            const u32x4 zz = *(const u32x4*)(Z + (row0 + jj) * 4096 + 2048 + gi * 128 + c8);
            const f32x2 st = *(const f32x2*)(ST + (row0 + jj) * 2);
            const float xv[8] = {lo16(zz.x), hi16(zz.x), lo16(zz.y), hi16(zz.y), lo16(zz.z), hi16(zz.z), lo16(zz.w), hi16(zz.w)};
#pragma unroll
            for (int e = 0; e < 8; ++e) { const int dch = c8 + e; const float val = (xv[e] - st[0]) * st[1] * lng[gi * 128 + dch] + lnb[gi * 128 + dch];
                *(LAS unsigned short*)(vt + vt_off(dch, jj >> 3) + (jj & 7) * 2) = f2bf(val); }
        }
        __syncthreads();
        f32x16 acc0, acc1;
#pragma unroll
        for (int e = 0; e < 16; ++e) { acc0[e] = 0.f; acc1[e] = 0.f; }
        const int dA = dt * 32 + (lane & 31);
        const bf16_t* w0p = Ws + ((size_t)gi * 128 + it0 * 32 + (lane & 31)) * 128 + 8 * (lane >> 5);
#pragma unroll
        for (int s = 0; s < 8; ++s) {
            const bf16x8 Afr = *(const LAS bf16x8*)(vt + vt_off(dA, 2 * s + (lane >> 5)));
            const bf16x8 B0 = *(const bf16x8*)(w0p + 16 * s), B1 = *(const bf16x8*)(w0p + 32 * 128 + 16 * s);
            acc0 = __builtin_amdgcn_mfma_f32_32x32x16_bf16(Afr, B0, acc0, 0, 0, 0);
            acc1 = __builtin_amdgcn_mfma_f32_32x32x16_bf16(Afr, B1, acc1, 0, 0, 0);
        }
#pragma unroll
        for (int it = 0; it < 2; ++it) {
            const int ii = (it0 + it) * 32 + (lane & 31); const size_t row = row0 + ii; const float bias = bs[gi * 128 + ii];
#pragma unroll
            for (int rq = 0; rq < 4; ++rq) {
                const int d0 = dt * 32 + 8 * rq + 4 * (lane >> 5);
                const u32x2 uu = *(const u32x2*)(Z + row * 4096 + gi * 128 + d0);
                float vs[4];
#pragma unroll
                for (int e = 0; e < 4; ++e) vs[e] = (it == 0 ? acc0[rq * 4 + e] : acc1[rq * 4 + e]) + bias;
                u32x2 o; o.x = pk2(lo16(uu.x) * vs[0], hi16(uu.x) * vs[1]); o.y = pk2(lo16(uu.y) * vs[2], hi16(uu.y) * vs[3]);
                *(u32x2*)(Pb + row * 2048 + gi * 128 + d0) = o;
            }
        }
    }
    __syncthreads();
}

__global__ void __launch_bounds__(NTHREADS, 2) fwd_kernel(Params P) {
    extern __shared__ __attribute__((aligned(16))) unsigned char lds_raw[];
    Frame F; F.lds = (LAS unsigned char*)lds_raw; F.tid = threadIdx.x; F.lane = F.tid & 63; F.wave = __builtin_amdgcn_readfirstlane(F.tid >> 6);
    F.G = gridDim.x; F.bid = blockIdx.x; F.ws = P.ws; F.kp = (const Params __attribute__((address_space(4)))*)__builtin_amdgcn_kernarg_segment_ptr();
    const int lo = P.ph_lo, hi = P.ph_hi;
    volatile LAS unsigned* misc = (volatile LAS unsigned*)(F.lds + LDS_MISC);
    if (F.tid < 4) misc[F.tid] = 0u;
    __syncthreads();
    XcdBarrier bar; bar.bar = (unsigned*)(F.ws + WS_CTL); bar.x = 0; bar.st = misc;
    if (hi - lo > 1) bar = xcd_barrier_post((unsigned*)(F.ws + WS_CTL), misc);
    int ph = 0;
#define RUN(id, ...) do { if (ph >= lo && ph < hi) { const int nrep_ = ((REP_MASK >> (id)) & 1u) ? 2 : 1; for (int rep_ = 0; rep_ < nrep_; ++rep_) { const bool dry_ = (rep_ + 1 < nrep_); (void)dry_; { int t_ = threadIdx.x; const Params __attribute__((address_space(4)))* kp_ = (const Params __attribute__((address_space(4)))*)__builtin_amdgcn_kernarg_segment_ptr(); asm volatile("" : "+v"(t_), "+s"(kp_)); F.tid = t_; F.lane = t_ & 63; F.kp = kp_; F.ws = kp_->ws; } __VA_ARGS__; if (rep_ + 1 < nrep_ || ph + 1 < hi) xcd_barrier(bar); } } ++ph; } while (0)

    RUN(0, phase_prologue(F));
    for (int g = 0; g < NG; ++g) {
        for (int layer = 0; layer < 4; ++layer) {
            const int a = layer >> 1;
            if ((layer & 1) == 0) {
                const bf16_t* Vc = layer == 0 ? F.wsp<bf16_t>(WS_VF) : F.ar<bf16_t>(AR_V);
                RUN(1, phase_norm1(F, g, layer, F.ar<bf16_t>(AR_H2), 2048, dry_));
                RUN(2, phase_mix(F));
                RUN(3, { pg8::SchedPlain S; S.init(TG / 256, N1CAT / 256, F.G, F.bid, 0);
                      EpiG1 E{F.ws, layer == 0 ? WS_VF : WS_ARENA + AR_V};
                      pg8::gemm_phase(F.tid, F.lds, F.ar<bf16_t>(AR_H2), K1CAT, F.wsp<bf16_t>(WS_W1CAT) + (size_t)a * N1CAT * K1CAT, K1CAT, K1CAT, S, E); });
                if (layer == 2) {
                    RUN(4, { pg8::SchedPlain S; S.init(TG / 256, 4, F.G, F.bid, 0);
                          EpiStore<1> E{F.ar<bf16_t>(AR_VGATE), F.in(19)};
                          pg8::gemm_phase(F.tid, F.lds, F.ar<bf16_t>(AR_L1) + 256, 512, F.wsp<bf16_t>(WS_V2T), 256, 256, S, E); });
                    RUN(5, phase_vfix(F));
                }
                RUN(6, phase_scan(F, a, Vc));
                RUN(7, { pg8::SchedPlain S; S.init(TG / 256, 4, F.G, F.bid, 0);
                      EpiStore<0> E{F.ar<bf16_t>(AR_G), nullptr};
                      pg8::gemm_phase(F.tid, F.lds, F.ar<bf16_t>(AR_L1) + 256, 512, F.wsp<bf16_t>(WS_G2T) + (size_t)a * D * 256, 256, 256, S, E); });
                RUN(8, phase_post(F, a, Vc));
                RUN(9, { const int skip = layer == 2; pg8::SchedPlain S; S.init(skip ? BG * 8 : TG / 256, 4, F.G, F.bid, skip);
                      EpiStore<0> E{F.ar<bf16_t>(AR_O), nullptr};
                      pg8::gemm_phase(F.tid, F.lds, F.ar<bf16_t>(AR_R), D, F.wsp<bf16_t>(WS_WO) + (size_t)a * D * D, D, D, S, E); });
            } else {
                const int skip = layer == 3;
                RUN(10, phase_norm1(F, g, layer, F.ar<bf16_t>(AR_H), D, dry_));
                RUN(11, { pg8::SchedPlain S; S.init(skip ? BG * 8 : TG / 256, 16, F.G, F.bid, skip);
                      EpiGelu E{F.ar<bf16_t>(AR_Z), F.in(30) + (size_t)a * 4096};
                      pg8::gemm_phase(F.tid, F.lds, F.ar<bf16_t>(AR_H), D, F.wsp<bf16_t>(WS_WIN) + (size_t)a * 4096 * D, D, D, S, E); });
                RUN(12, phase_sgstats(F, layer));
                RUN(13, phase_spatial(F, a, layer));
                RUN(14, { pg8::SchedPlain S; S.init(skip ? BG * 8 : TG / 256, 4, F.G, F.bid, skip);
                      EpiStore<0> E{F.ar<bf16_t>(AR_O), nullptr};
                      pg8::gemm_phase(F.tid, F.lds, F.ar<bf16_t>(AR_P), 2048, F.wsp<bf16_t>(WS_WOUT) + (size_t)a * D * 2048, 2048, 2048, S, E); });
            }
            RUN(15, phase_norm2(F, g, layer, dry_));
            RUN(16, { const int total = moe_tables(F, g, layer);
                  pg8::SchedMoe<true> S{(const LAS int*)(F.lds + LDS_MISC + 64), (const LAS int*)(F.lds + LDS_MISC + 192), F.ar<int>(AR_LIST), F.G, F.bid, total};
                  EpiMG E{F.ar<bf16_t>(AR_HE)};
                  pg8::gemm_phase(F.tid, F.lds, F.ar<bf16_t>(AR_HM), D, F.wsp<bf16_t>(WS_WGU) + (size_t)layer * NEXP * 1024 * D, D, D, S, E); });
            RUN(17, { const int total = moe_tables(F, g, layer);
                  pg8::SchedMoe<false> S{(const LAS int*)(F.lds + LDS_MISC + 64), (const LAS int*)(F.lds + LDS_MISC + 192), F.ar<int>(AR_LIST), F.G, F.bid, total};
                  EpiMD E{F.ar<bf16_t>(AR_YM0), F.ar<int>(AR_LIST), F.ar<float>(AR_LW), (const LAS int*)(F.lds + LDS_MISC + 64)};
                  pg8::gemm_phase(F.tid, F.lds, F.ar<bf16_t>(AR_HE), FEXP, F.wsp<bf16_t>(WS_WD) + (size_t)layer * NEXP * D * FEXP, FEXP, FEXP, S, E); });
        }
        RUN(18, phase_norm1(F, g, 4, nullptr, 0));
    }
#undef RUN
}
constexpr int NPHASES = 1 + NG * (10 + 8 + 12 + 8 + 1);

__global__ void nan_fill(float* out, size_t n) { for (size_t i = (size_t)blockIdx.x * blockDim.x + threadIdx.x; i < n; i += (size_t)gridDim.x * blockDim.x) out[i] = __uint_as_float(0x7FC00000u); }

extern "C" void kernel_launch(void* const* d_in, const int* in_sizes, int n_in, void* d_out, int out_size, void* d_ws, size_t ws_size, hipStream_t stream) {
    static int grid = 0;
    if (grid == 0) {
        int dev = 0, cus = 0, per_cu = 0;
        if (n_in != 42 || ws_size < WS_END || hipGetDevice(&dev) != hipSuccess || hipDeviceGetAttribute(&cus, hipDeviceAttributeMultiprocessorCount, dev) != hipSuccess) {
            fprintf(stderr, "kernel_launch: bad setup (n_in %d, ws %zu need %zu)\n", n_in, ws_size, (size_t)WS_END); grid = -1;
        } else if (hipFuncSetAttribute((const void*)fwd_kernel, hipFuncAttributeMaxDynamicSharedMemorySize, LDS_BYTES) != hipSuccess) { fprintf(stderr, "kernel_launch: hipFuncSetAttribute failed\n"); grid = -1; }
        else {
            if (hipOccupancyMaxActiveBlocksPerMultiprocessor(&per_cu, (const void*)fwd_kernel, NTHREADS, LDS_BYTES) != hipSuccess || per_cu < 1) { fprintf(stderr, "kernel_launch: occupancy query reports %d\n", per_cu); }
            (void)hipGetLastError();
            grid = cus;
        }
    }
    if (grid < 0) { hipLaunchKernelGGL(nan_fill, dim3(1024), dim3(256), 0, stream, (float*)d_out, (size_t)out_size); return; }
    (void)hipMemsetAsync((char*)d_ws + WS_CTL, 0, CTL_BYTES, stream);
    Params p{};
    for (int i = 0; i < 42; ++i) p.in[i] = (const float*)d_in[i];
    p.out = (float*)d_out; p.ws = (unsigned char*)d_ws;
#if PER_PHASE_LAUNCH
    for (int k = 0; k < NPHASES; ++k) { p.ph_lo = k; p.ph_hi = k + 1; hipLaunchKernelGGL(fwd_kernel, dim3(grid), dim3(NTHREADS), LDS_BYTES, stream, p); }
#else
    p.ph_lo = 0; p.ph_hi = NPHASES;
    hipLaunchKernelGGL(fwd_kernel, dim3(grid), dim3(NTHREADS), LDS_BYTES, stream, p);
#endif
}
```

```cpp
#include <hip/hip_runtime.h>
#include <cstdio>
#include <cstdint>

#ifndef REP_MASK
#define REP_MASK 0u
#endif
#ifndef PER_PHASE_LAUNCH
#define PER_PHASE_LAUNCH 0
#endif

#define LAS __attribute__((address_space(3)))
typedef unsigned short bf16_t;
typedef short bf16x8 __attribute__((ext_vector_type(8)));
typedef float f32x4 __attribute__((ext_vector_type(4)));
typedef float f32x2 __attribute__((ext_vector_type(2)));
typedef float f32x16 __attribute__((ext_vector_type(16)));
typedef unsigned u32x4 __attribute__((ext_vector_type(4)));
typedef unsigned u32x2 __attribute__((ext_vector_type(2)));

constexpr int NB = 32, SEQ = 2048, LC = 256, LT = SEQ + LC, D = 1024, NH = 16;
constexpr int NG = 2, BG = NB / NG, TG = BG * LT;
constexpr int NTHREADS = 512, NWAVES = 8;
constexpr int N1CAT = 3584, K1CAT = 2048;
constexpr int NEXP = 16, FEXP = 512;

constexpr size_t al256(size_t x) { return (x + 255) & ~(size_t)255; }
constexpr int XCD_BAR_WORDS_C = 3456;
constexpr size_t WS_CTL = 0;
constexpr size_t CTL_BAR_BYTES = (size_t)XCD_BAR_WORDS_C * 4;
constexpr size_t CTL_CNT_OFF = al256(CTL_BAR_BYTES);
constexpr size_t CTL_BYTES = al256(CTL_CNT_OFF + (size_t)2 * NG * 4 * 32 * 64);
constexpr size_t WS_X = al256(WS_CTL + CTL_BYTES);
constexpr size_t WS_VF = WS_X + (size_t)TG * D * 4;
constexpr size_t WS_MODL = WS_VF + (size_t)TG * D * 2;
constexpr size_t WS_MODC = WS_MODL + (size_t)4 * NB * 6 * D * 4;
constexpr size_t WS_W1CAT = al256(WS_MODC + (size_t)4 * 6 * D * 4);
constexpr size_t WS_WO = WS_W1CAT + (size_t)2 * N1CAT * K1CAT * 2;
constexpr size_t WS_G2T = WS_WO + (size_t)2 * D * D * 2;
constexpr size_t WS_V2T = WS_G2T + (size_t)2 * D * 256 * 2;
constexpr size_t WS_W2T = WS_V2T + (size_t)D * 256 * 2;
constexpr size_t WS_A2T = WS_W2T + (size_t)4 * D * 64 * 2;
constexpr size_t WS_WIN = WS_A2T + (size_t)4 * D * 64 * 2;
constexpr size_t WS_WOUT = WS_WIN + (size_t)2 * 4096 * D * 2;
constexpr size_t WS_WSP = WS_WOUT + (size_t)2 * D * 2048 * 2;
constexpr size_t WS_WGU = WS_WSP + (size_t)2 * 16 * 128 * 128 * 2;
constexpr size_t WS_WD = WS_WGU + (size_t)4 * NEXP * 1024 * D * 2;
constexpr size_t WS_ARENA = al256(WS_WD + (size_t)4 * NEXP * D * FEXP * 2);
constexpr size_t SZB = (size_t)TG * D * 2;
constexpr size_t AR_H2 = 0;
constexpr size_t AR_Y0 = 0, AR_Y1 = SZB;
constexpr size_t AR_R = 2 * SZB, AR_K = 3 * SZB, AR_V = 4 * SZB;
constexpr size_t AR_L1 = 5 * SZB;
constexpr size_t AR_DOT = AR_L1 + SZB / 2;
constexpr size_t AR_G = 6 * SZB;
constexpr size_t AR_VGATE = 0;
constexpr size_t AR_O = 3 * SZB;
constexpr size_t AR_H = 0;
constexpr size_t AR_Z = SZB;
constexpr size_t AR_P = 5 * SZB;
constexpr size_t AR_ST = 7 * SZB;
constexpr size_t AR_HM = 0;
constexpr size_t AR_HE = SZB;
constexpr size_t HE_ROWS = (size_t)2 * TG + 32 * 256;
constexpr size_t AR_LIST = al256(AR_HE + HE_ROWS * FEXP * 2);
constexpr size_t AR_LW = AR_LIST + (size_t)32 * TG * 4;
constexpr size_t AR_YM0 = 5 * SZB, AR_YM1 = 6 * SZB;
constexpr size_t ARENA_BYTES = 7 * SZB + al256((size_t)TG * 8) + 4096;
constexpr size_t WS_END = WS_ARENA + ARENA_BYTES;
static_assert(AR_LW + (size_t)32 * TG * 4 <= AR_YM0, "moe lists overlap");
static_assert(AR_DOT + (size_t)2 * TG * 16 * 4 <= AR_G, "dot overlap");

constexpr int LDS_STAGE = 131072;
constexpr int LDS_MISC = LDS_STAGE;
constexpr int LDS_BYTES = LDS_STAGE + 1024;

struct Params {
    const float* in[42];
    float* out;
    unsigned char* ws;
    int ph_lo, ph_hi;
};

__device__ __forceinline__ float bf2f(unsigned short b) { return __uint_as_float(((unsigned)b) << 16); }
__device__ __forceinline__ unsigned short f2bf(float f) { unsigned u = __float_as_uint(f); u += 0x7FFFu + ((u >> 16) & 1u); return (unsigned short)(u >> 16); }
__device__ __forceinline__ unsigned pk2(float lo, float hi) { return (unsigned)f2bf(lo) | ((unsigned)f2bf(hi) << 16); }
__device__ __forceinline__ float lo16(unsigned w) { return __uint_as_float(w << 16); }
__device__ __forceinline__ float hi16(unsigned w) { return __uint_as_float(w & 0xFFFF0000u); }
__device__ __forceinline__ float sigmoidf_(float x) { return 1.0f / (1.0f + __expf(-x)); }
__device__ __forceinline__ float tanhf_(float x) { return 1.0f - 2.0f / (__expf(2.0f * x) + 1.0f); }
__device__ __forceinline__ float wave_sum(float v) {
#pragma unroll
    for (int o = 32; o > 0; o >>= 1) v += __shfl_xor(v, o);
    return v;
}
template <int CTRL> __device__ __forceinline__ float dpp_f(float v) {
    return __int_as_float(__builtin_amdgcn_update_dpp(0, __float_as_int(v), CTRL, 0xF, 0xF, true));
}
__device__ __forceinline__ float red8(float v) { v += dpp_f<0xB1>(v); v += dpp_f<0x4E>(v); v += dpp_f<0x141>(v); return v; }
__device__ __forceinline__ float red16(float v) { v = red8(v); v += dpp_f<0x140>(v); return v; }
__device__ __forceinline__ float wave_sum_dpp(float v) {
    v = red16(v);
    const float a = __int_as_float(__builtin_amdgcn_readlane(__float_as_int(v), 0)), b = __int_as_float(__builtin_amdgcn_readlane(__float_as_int(v), 16));
    const float c = __int_as_float(__builtin_amdgcn_readlane(__float_as_int(v), 32)), d = __int_as_float(__builtin_amdgcn_readlane(__float_as_int(v), 48));
    return (a + b) + (c + d);
}
__device__ __forceinline__ float red4(float v) { v += dpp_f<0xB1>(v); v += dpp_f<0x4E>(v); return v; }
__device__ __forceinline__ f32x2 gelu_pk(f32x2 v) {
    const f32x2 av = __builtin_elementwise_abs(v), d = av * 0.2316418882f + 1.0f;
    f32x2 t; t.x = __builtin_amdgcn_rcpf(d.x); t.y = __builtin_amdgcn_rcpf(d.y);
    f32x2 q = t * 0.5307027145f + (-0.7265760135f); q = q * t + 0.7107068705f; q = q * t + (-0.142248368f); q = q * t + 0.127414796f; q = q * t;
    const f32x2 s = (v * v) * (-0.72134752044f);
    f32x2 e; e.x = __builtin_amdgcn_exp2f(s.x); e.y = __builtin_amdgcn_exp2f(s.y);
    const f32x2 m = v * (q * e), r = v - m;
    f32x2 o; o.x = v.x < 0.f ? m.x : r.x; o.y = v.y < 0.f ? m.y : r.y; return o;
}
__device__ __forceinline__ float gelu_f(float v) {
    const float av = fabsf(v), t = __builtin_amdgcn_rcpf(av * 0.2316418882f + 1.0f);
    float q = t * 0.5307027145f + (-0.7265760135f); q = q * t + 0.7107068705f; q = q * t + (-0.142248368f); q = q * t + 0.127414796f; q = q * t;
    const float e = __builtin_amdgcn_exp2f((v * v) * (-0.72134752044f));
    const float m = v * (q * e);
    return v < 0.f ? m : v - m;
}

#define XB_TMO      128
#define XB_XCNT(j)  (256  + 64 * (j))
#define XB_XSUB(j)  (1280 + 64 * (j))
#define XB_XGEN(j)  (2304 + 64 * (j))
#define XB_TOP      3328
#define XB_TOPGEN   3392
#define XCD_BAR_WORDS 3456
#define XB_SPIN_CAP (1u << 22)
static_assert(XCD_BAR_WORDS == XCD_BAR_WORDS_C, "barrier words");
__device__ __forceinline__ unsigned xb_ld(unsigned* p)              { return __hip_atomic_load(p, __ATOMIC_RELAXED, __HIP_MEMORY_SCOPE_AGENT); }
__device__ __forceinline__ unsigned xb_add(unsigned* p, unsigned v) { return __hip_atomic_fetch_add(p, v, __ATOMIC_RELAXED, __HIP_MEMORY_SCOPE_AGENT); }
__device__ __forceinline__ unsigned xb_xcc_id() { return (unsigned)__builtin_amdgcn_s_getreg((3 << 11) | 20) & 0xFu; }
#define XB_SPIN(cond, bar) do { unsigned _sp = 0; while (cond) { __builtin_amdgcn_s_sleep(1); \
    if ((++_sp & 255u) == 0u) { if (xb_ld(&(bar)[XB_TMO])) break; if (_sp > XB_SPIN_CAP) { atomicAdd(&(bar)[XB_TMO], 1u); break; } } } } while (0)
struct XcdBarrier { unsigned* bar; unsigned x; volatile LAS unsigned* st; };
__device__ __forceinline__ XcdBarrier xcd_barrier_post(unsigned* bar, volatile LAS unsigned* st) {
    XcdBarrier b; b.bar = bar; b.x = xb_xcc_id(); b.st = st;
    if (threadIdx.x == 0) (void)xb_add(&bar[XB_XCNT(b.x)], 1u);
    return b;
}
__device__ __forceinline__ void xcd_barrier_complete(unsigned* bar, unsigned x, unsigned& nloc, unsigned& nx) {
    const unsigned G = gridDim.x * gridDim.y * gridDim.z;
    unsigned sum, cnt, mine, sp = 0u;
    for (;;) {
        sum = 0u; cnt = 0u; mine = 0u;
#pragma unroll
        for (unsigned j = 0; j < 16; ++j) { const unsigned c = xb_ld(&bar[XB_XCNT(j)]); sum += c; cnt += (c > 0u) ? 1u : 0u; mine = (j == x) ? c : mine; }
        if (sum == G) break;
        __builtin_amdgcn_s_sleep(1);
        if ((++sp & 255u) == 0u) { if (xb_ld(&bar[XB_TMO])) break; if (sp > XB_SPIN_CAP) { atomicAdd(&bar[XB_TMO], 1u); break; } }
    }
    nloc = mine > 0u ? mine : 1u; nx = cnt > 0u ? cnt : 1u;
}
__device__ __forceinline__ void xcd_barrier(const XcdBarrier& b) {
    asm volatile("s_waitcnt vmcnt(0)" ::: "memory");
    __syncthreads();
    if (threadIdx.x == 0) {
        unsigned* bar = b.bar;
        __builtin_amdgcn_s_waitcnt(0);
        unsigned nloc = b.st[0], nx = b.st[1];
        if (nloc == 0u) { xcd_barrier_complete(bar, b.x, nloc, nx); b.st[0] = nloc; b.st[1] = nx; }
        const unsigned old = xb_add(&bar[XB_XSUB(b.x)], 1u);
        const unsigned gen = old / nloc;
        if (old + 1u == (gen + 1u) * nloc) {
            __builtin_amdgcn_fence(__ATOMIC_RELEASE, "agent");
            asm volatile("s_waitcnt vmcnt(0)" ::: "memory");
            const unsigned og = xb_add(&bar[XB_TOP], 1u);
            const unsigned tg = og / nx;
            if (og + 1u == (tg + 1u) * nx) xb_add(&bar[XB_TOPGEN], 1u);
            else XB_SPIN(xb_ld(&bar[XB_TOPGEN]) == tg, bar);
            __builtin_amdgcn_fence(__ATOMIC_ACQUIRE, "agent");
            xb_add(&bar[XB_XGEN(b.x)], 1u);
            asm volatile("s_waitcnt vmcnt(0)" ::: "memory");
        } else {
            XB_SPIN(xb_ld(&bar[XB_XGEN(b.x)]) == gen, bar);
            __builtin_amdgcn_fence(__ATOMIC_ACQUIRE, "agent");
            asm volatile("s_waitcnt vmcnt(0)" ::: "memory");
        }
    }
    __syncthreads();
}

namespace pg8 {
constexpr int BM = 256, BK = 64, HALF = 128, HTB = HALF * BK * 2, STAGE_BYTES = 8 * HTB, NXCD = 8, WGM = 8;
__host__ __device__ __forceinline__ int lds_byte(int r, int c) { const int st = (r >> 4) * 2 + (c >> 5), rr = r & 15, cc = c & 31, ob = rr * 64 + cc * 2; return st * 1024 + (ob ^ (((ob >> 9) & 1) << 5)); }
__host__ __device__ __forceinline__ void stage_rc(int b, int& R, int& C) { const int st = b / 1024, sb = b % 1024, swz = sb ^ (((sb >> 9) & 1) << 5); R = (st >> 1) * 16 + swz / 64; C = (st & 1) * 32 + (swz % 64) / 2; }
struct Unit { int pm, pn, aux; };

struct SchedPlain {
    static constexpr bool GATHER = false;
    int nM, nN, nwg, G, c, skipctx;
    __device__ void init(int nM_, int nN_, int G_, int c_, int skipctx_) { nM = nM_; nN = nN_; nwg = nM * nN; G = G_; c = c_; skipctx = skipctx_; }
    __device__ bool next(int i, Unit& u) const {
        const long L = (long)i * G + c; if (L >= nwg) return false;
        int wgid = (int)L; { const int q = nwg / NXCD, r = nwg % NXCD, xcd = wgid % NXCD, off = wgid / NXCD; wgid = (xcd < r ? xcd * (q + 1) : r * (q + 1) + (xcd - r) * q) + off; }
        const int nig = WGM * nN, gid = wgid / nig, fm = gid * WGM, gsz = (nM - fm) < WGM ? (nM - fm) : WGM;
        int pm = fm + ((wgid % nig) % gsz); u.pn = (wgid % nig) / gsz; u.aux = 0;
        if (skipctx) pm = (pm >> 3) * 9 + 1 + (pm & 7);
        u.pm = pm; return true;
    }
    __device__ __forceinline__ int arow(const Unit& u, int r) const { return u.pm * BM + r; }
};
template <bool GATH> struct SchedMoe {
    static constexpr bool GATHER = GATH;
    const LAS int* cn; const LAS int* tb; const int* lists; int G, c, total;
    __device__ bool next(int i, Unit& u) const {
        const int U = i * G + c; if (U >= total * 4) return false;
        const int T = U >> 2, pn = U & 3; int l = 0;
        while (tb[l + 1] <= T) ++l;
        u.pm = T; u.pn = (l >> 1) * 4 + pn; u.aux = l | ((T - tb[l]) << 8); return true;
    }
    __device__ __forceinline__ int arow(const Unit& u, int r) const {
        if (!GATH) return u.pm * BM + r;
        const int l = u.aux & 255, idx = (u.aux >> 8) * BM + r;
        return idx < cn[l] ? lists[(size_t)l * TG + idx] : 0;
    }
};

template <class Epi, class Sched>
__device__ __forceinline__ void gemm_phase(const int tid, LAS unsigned char* lds, const bf16_t* A, int lda, const bf16_t* Bt, int ldb, int K, const Sched& S, const Epi& E) {
    constexpr bool GA = Sched::GATHER;
    const int wid = __builtin_amdgcn_readfirstlane(tid >> 6), lane = tid & 63, wr = wid >> 2, wc = wid & 3, fr = lane & 15, fq = lane >> 4;
    const int nt = K / BK;
    unsigned voffA[2], voffB[2];
#pragma unroll
    for (int i = 0; i < 2; ++i) { int R, C; stage_rc(tid * 16 + i * 8192, R, C); voffA[i] = (unsigned)(R * lda + C) * 2u; voffB[i] = (unsigned)(R * ldb + C) * 2u; }
    const size_t kstep = (size_t)(BK * 2);
    const size_t hstepA = (size_t)HALF * lda * 2, tstepA = 2 * hstepA;
    const size_t hstepB = (size_t)HALF * ldb * 2, tstepB = 2 * hstepB;
    const unsigned ldsw = (unsigned)wid * 1024u;
    const int aoff = lds_byte(wr * 64 + fr, fq * 8), boff = lds_byte(wc * 32 + fr, fq * 8);
#define PG8_SA(b, h) (((b) * 2 + (h)) * HTB)
#define PG8_SB(b, h) ((4 + (b) * 2 + (h)) * HTB)
#define PG8_STAGE(bufoff, gbase, voff) do { _Pragma("unroll") for (int _i = 0; _i < 2; ++_i) \
        __builtin_amdgcn_global_load_lds((const unsigned*)((const char*)(gbase) + (voff)[_i]), (LAS unsigned*)(lds + (bufoff) + ldsw + _i * 8192), 16, 0, 0); } while (0)
#define PG8_STAGE_A(bufoff, ub, gv, h, koff) do { if constexpr (GA) { PG8_STAGE(bufoff, (const char*)A + (koff), gv[h]); } else { PG8_STAGE(bufoff, (ub) + (h) * hstepA + (koff), voffA); } } while (0)
#define PG8_LDA(dst, b, h) do { _Pragma("unroll") for (int m = 0; m < 4; ++m) _Pragma("unroll") for (int k = 0; k < 2; ++k) dst[m][k] = *(const LAS bf16x8*)(lds + PG8_SA(b, h) + aoff + m * 2048 + k * 1024); } while (0)
#define PG8_LDB(dst, b, h) do { _Pragma("unroll") for (int n = 0; n < 2; ++n) _Pragma("unroll") for (int k = 0; k < 2; ++k) dst[n][k] = *(const LAS bf16x8*)(lds + PG8_SB(b, h) + boff + n * 2048 + k * 1024); } while (0)
#define PG8_MMA(ai, bj, At, Bt_) do { __builtin_amdgcn_s_setprio(1); _Pragma("unroll") for (int m = 0; m < 4; ++m) _Pragma("unroll") for (int n = 0; n < 2; ++n) _Pragma("unroll") for (int k = 0; k < 2; ++k) \
        acc[ai][bj][m][n] = __builtin_amdgcn_mfma_f32_16x16x32_bf16(Bt_[n][k], At[m][k], acc[ai][bj][m][n], 0, 0, 0); __builtin_amdgcn_s_setprio(0); } while (0)
#define PG8_WAIT_V(n) asm volatile("s_waitcnt vmcnt(" #n ")" ::: "memory")
#define PG8_WAIT_L(n) asm volatile("s_waitcnt lgkmcnt(" #n ")" ::: "memory")
#define PG8_BAR __builtin_amdgcn_s_barrier()
#define PG8_SCHED __builtin_amdgcn_sched_barrier(0)
#define PG8_GOFF(dst, u) do { if constexpr (GA) { _Pragma("unroll") for (int _h = 0; _h < 2; ++_h) _Pragma("unroll") for (int _i = 0; _i < 2; ++_i) { int R_, C_; stage_rc(tid * 16 + _i * 8192, R_, C_); \
        dst[_h][_i] = ((unsigned)S.arow(u, _h * HALF + R_) * (unsigned)lda + (unsigned)C_) * 2u; } } } while (0)
    Unit cur, nxt; int ui = 0;
    if (!S.next(0, cur)) return;
    f32x4 acc[2][2][4][2];
#pragma unroll
    for (int a = 0; a < 2; ++a)
#pragma unroll
        for (int b = 0; b < 2; ++b)
#pragma unroll
            for (int m = 0; m < 4; ++m)
#pragma unroll
                for (int n = 0; n < 2; ++n) acc[a][b][m][n] = (f32x4){0.f, 0.f, 0.f, 0.f};
    bf16x8 At[4][2], B0[2][2], B1[2][2];
    unsigned gAc[2][2], gAn[2][2];
    PG8_GOFF(gAc, cur);
    const char* cA = (const char*)A + (GA ? (size_t)0 : (size_t)cur.pm * tstepA);
    const char* cB = (const char*)Bt + (size_t)cur.pn * tstepB;
    PG8_STAGE(PG8_SB(0, 0), cB, voffB); PG8_STAGE_A(PG8_SA(0, 0), cA, gAc, 0, 0); PG8_STAGE(PG8_SB(0, 1), cB + hstepB, voffB); PG8_STAGE_A(PG8_SA(0, 1), cA, gAc, 1, 0);
    if (wr == 1) PG8_BAR;
    PG8_WAIT_V(4); PG8_BAR;
    PG8_STAGE(PG8_SB(1, 0), cB + kstep, voffB); PG8_STAGE_A(PG8_SA(1, 0), cA, gAc, 0, kstep); PG8_STAGE(PG8_SB(1, 1), cB + hstepB + kstep, voffB);
    PG8_WAIT_V(6); PG8_BAR;
    for (;;) {
        const bool has_next = S.next(ui + 1, nxt);
        if (has_next) { PG8_GOFF(gAn, nxt); }
        else if constexpr (GA) {
#pragma unroll
            for (int _h = 0; _h < 2; ++_h)
#pragma unroll
                for (int _i = 0; _i < 2; ++_i) gAn[_h][_i] = gAc[_h][_i];
        }
        const char* nA = (has_next && !GA) ? (const char*)A + (size_t)nxt.pm * tstepA : cA;
        const char* nB = has_next ? (const char*)Bt + (size_t)nxt.pn * tstepB : cB;
#pragma unroll 1
        for (int t = 0; t < nt; t += 2) {
            const bool last = (t == nt - 2);
            const size_t k1 = (size_t)(t + 1) * kstep;
            const size_t k2 = last ? (size_t)0 : (size_t)(t + 2) * kstep, k3 = k2 + kstep;
            const char* a2 = last ? nA : cA; const char* b2 = last ? nB : cB;
            unsigned g2[2][2];
            if constexpr (GA) {
#pragma unroll
                for (int _h = 0; _h < 2; ++_h)
#pragma unroll
                    for (int _i = 0; _i < 2; ++_i) g2[_h][_i] = last ? gAn[_h][_i] : gAc[_h][_i];
            }
            PG8_LDB(B0, 0, 0); PG8_SCHED; PG8_LDA(At, 0, 0); PG8_STAGE_A(PG8_SA(1, 1), cA, gAc, 1, k1);
            PG8_WAIT_L(8); PG8_BAR; PG8_WAIT_L(0); PG8_MMA(0, 0, At, B0); PG8_BAR; PG8_SCHED;
            PG8_LDB(B1, 0, 1); PG8_STAGE(PG8_SB(0, 0), b2 + k2, voffB);
            PG8_BAR; PG8_WAIT_L(0); PG8_MMA(0, 1, At, B1); PG8_BAR;
            PG8_LDA(At, 0, 1); PG8_STAGE_A(PG8_SA(0, 0), a2, g2, 0, k2);
            PG8_BAR; PG8_WAIT_L(0); PG8_MMA(1, 0, At, B0); PG8_BAR; PG8_SCHED;
            PG8_STAGE(PG8_SB(0, 1), b2 + hstepB + k2, voffB);
            PG8_WAIT_V(6); PG8_BAR; PG8_MMA(1, 1, At, B1); PG8_BAR;
            PG8_LDB(B0, 1, 0); PG8_SCHED; PG8_LDA(At, 1, 0); PG8_STAGE_A(PG8_SA(0, 1), a2, g2, 1, k2);
            PG8_WAIT_L(8); PG8_BAR; PG8_WAIT_L(0); PG8_MMA(0, 0, At, B0); PG8_BAR; PG8_SCHED;
            PG8_LDB(B1, 1, 1); PG8_STAGE(PG8_SB(1, 0), b2 + k3, voffB);
            PG8_BAR; PG8_WAIT_L(0); PG8_MMA(0, 1, At, B1); PG8_BAR;
            PG8_LDA(At, 1, 1); PG8_STAGE_A(PG8_SA(1, 0), a2, g2, 0, k3);
            PG8_BAR; PG8_WAIT_L(0); PG8_MMA(1, 0, At, B0); PG8_BAR; PG8_SCHED;
            PG8_STAGE(PG8_SB(1, 1), b2 + hstepB + k3, voffB);
            PG8_WAIT_V(6); PG8_BAR; PG8_MMA(1, 1, At, B1); PG8_BAR;
        }
        { int fr_e = fr, fq_e = fq; asm volatile("" : "+v"(fr_e), "+v"(fq_e)); E(acc, cur, wr, wc, fr_e, fq_e); }
        if (!has_next) break;
#pragma unroll
        for (int a = 0; a < 2; ++a)
#pragma unroll
            for (int b = 0; b < 2; ++b)
#pragma unroll
                for (int m = 0; m < 4; ++m)
#pragma unroll
                    for (int n = 0; n < 2; ++n) acc[a][b][m][n] = (f32x4){0.f, 0.f, 0.f, 0.f};
        cur = nxt; cA = nA; cB = nB; ++ui;
        if constexpr (GA) {
#pragma unroll
            for (int _h = 0; _h < 2; ++_h)
#pragma unroll
                for (int _i = 0; _i < 2; ++_i) gAc[_h][_i] = gAn[_h][_i];
        }
    }
    PG8_WAIT_V(0);
    if (wr == 0) PG8_BAR;
    PG8_BAR;
#undef PG8_SA
#undef PG8_SB
#undef PG8_STAGE
#undef PG8_STAGE_A
#undef PG8_LDA
#undef PG8_LDB
#undef PG8_MMA
#undef PG8_WAIT_V
#undef PG8_WAIT_L
#undef PG8_BAR
#undef PG8_SCHED
#undef PG8_GOFF
}
}
using pg8::Unit;

#define EPI_LOOP_BEGIN \
    _Pragma("unroll") for (int ai = 0; ai < 2; ++ai) _Pragma("unroll") for (int m = 0; m < 4; ++m) { const int trow = ai * 128 + wr * 64 + m * 16 + fr; \
    _Pragma("unroll") for (int bj = 0; bj < 2; ++bj) _Pragma("unroll") for (int n = 0; n < 2; ++n) { const int tcol = bj * 128 + wc * 32 + n * 16 + 4 * fq; const f32x4 v = acc[ai][bj][m][n];
#define EPI_LOOP_END } asm volatile("" ::: "memory"); }

struct EpiG1 {
    unsigned char* ws; size_t voff;
    __device__ __forceinline__ void operator()(const f32x4 (&acc)[2][2][4][2], const Unit& u, int wr, int wc, int fr, int fq) const {
        const int pn = u.pn; const size_t row0 = (size_t)u.pm * 256;
        if (pn < 12) {
            const size_t off = pn < 4 ? (WS_ARENA + AR_R) : (pn < 8 ? (WS_ARENA + AR_K) : voff);
            bf16_t* dst = (bf16_t*)(ws + off); const int cb = (pn & 3) * 256;
            EPI_LOOP_BEGIN
                u32x2 w; w.x = pk2(v[0], v[1]); w.y = pk2(v[2], v[3]);
                *(u32x2*)(dst + (row0 + trow) * D + cb + tcol) = w;
            EPI_LOOP_END
        } else {
            bf16_t* L1 = (bf16_t*)(ws + WS_ARENA + AR_L1);
            const int cb = (pn - 12) * 256;
            EPI_LOOP_BEGIN
                f32x4 o = v;
                if (pn == 12 && bj == 0) { o[0] = tanhf_(v[0]); o[1] = tanhf_(v[1]); o[2] = tanhf_(v[2]); o[3] = tanhf_(v[3]); }
                if (pn == 13 && bj == 0) { o[0] = sigmoidf_(v[0]); o[1] = sigmoidf_(v[1]); o[2] = sigmoidf_(v[2]); o[3] = sigmoidf_(v[3]); }
                u32x2 w; w.x = pk2(o[0], o[1]); w.y = pk2(o[2], o[3]);
                *(u32x2*)(L1 + (row0 + trow) * 512 + cb + tcol) = w;
            EPI_LOOP_END
        }
    }
};
template <int ACT> struct EpiStore {
    bf16_t* O; const float* bias;
    __device__ __forceinline__ void operator()(const f32x4 (&acc)[2][2][4][2], const Unit& u, int wr, int wc, int fr, int fq) const {
        const size_t row0 = (size_t)u.pm * 256; const int cb = u.pn * 256;
        EPI_LOOP_BEGIN
            f32x4 o = v;
            if (ACT == 1) { const f32x4 b = *(const f32x4*)(bias + cb + tcol); o[0] = sigmoidf_(v[0] + b[0]); o[1] = sigmoidf_(v[1] + b[1]); o[2] = sigmoidf_(v[2] + b[2]); o[3] = sigmoidf_(v[3] + b[3]); }
            u32x2 w; w.x = pk2(o[0], o[1]); w.y = pk2(o[2], o[3]);
            *(u32x2*)(O + (row0 + trow) * D + cb + tcol) = w;
        EPI_LOOP_END
    }
};
struct EpiGelu {
    bf16_t* Z; const float* bias;
    __device__ __forceinline__ void operator()(const f32x4 (&acc)[2][2][4][2], const Unit& u, int wr, int wc, int fr, int fq) const {
        const size_t row0 = (size_t)u.pm * 256; const int cb = u.pn * 256;
        EPI_LOOP_BEGIN
            const f32x4 b = *(const f32x4*)(bias + cb + tcol);
            const f32x2 g0 = gelu_pk((f32x2){v[0] + b[0], v[1] + b[1]}), g1 = gelu_pk((f32x2){v[2] + b[2], v[3] + b[3]});
            u32x2 w; w.x = pk2(g0.x, g0.y); w.y = pk2(g1.x, g1.y);
            *(u32x2*)(Z + (row0 + trow) * 4096 + cb + tcol) = w;
        EPI_LOOP_END
    }
};
struct EpiMG {
    bf16_t* HE;
    __device__ __forceinline__ void operator()(const f32x4 (&acc)[2][2][4][2], const Unit& u, int wr, int wc, int fr, int fq) const {
        const size_t row0 = (size_t)u.pm * 256; const int pnl = u.pn & 3;
#pragma unroll
        for (int ai = 0; ai < 2; ++ai)
#pragma unroll
            for (int m = 0; m < 4; ++m) { const int trow = ai * 128 + wr * 64 + m * 16 + fr;
#pragma unroll
                for (int bj = 0; bj < 2; ++bj) {
                    const f32x4 gt = acc[ai][bj][m][0], up = acc[ai][bj][m][1];
                    const int f = (8 * pnl + 4 * bj + wc) * 16 + 4 * fq;
                    float o[4];
#pragma unroll
                    for (int e = 0; e < 4; ++e) o[e] = gt[e] * sigmoidf_(gt[e]) * up[e];
                    u32x2 w; w.x = pk2(o[0], o[1]); w.y = pk2(o[2], o[3]);
                    *(u32x2*)(HE + (row0 + trow) * FEXP + f) = w;
                } }
    }
};
struct EpiMD {
    bf16_t* Y0; const int* lists; const float* lw; const LAS int* cn;
    __device__ __forceinline__ void operator()(const f32x4 (&acc)[2][2][4][2], const Unit& u, int wr, int wc, int fr, int fq) const {
        const int l = u.aux & 255, t0 = (u.aux >> 8) * 256, cnt = cn[l]; const int cb = (u.pn & 3) * 256;
        bf16_t* Y = Y0 + (size_t)(l & 1) * ((AR_YM1 - AR_YM0) / 2);
#pragma unroll
        for (int ai = 0; ai < 2; ++ai)
#pragma unroll
            for (int m = 0; m < 4; ++m) { const int trow = ai * 128 + wr * 64 + m * 16 + fr; const int idx = t0 + trow;
                if (idx < cnt) {
                    const int tok = lists[(size_t)l * TG + idx]; const float wgt = lw[(size_t)l * TG + idx];
#pragma unroll
                    for (int bj = 0; bj < 2; ++bj)
#pragma unroll
                        for (int n = 0; n < 2; ++n) { const int tcol = bj * 128 + wc * 32 + n * 16 + 4 * fq; const f32x4 v = acc[ai][bj][m][n];
                            u32x2 w; w.x = pk2(v[0] * wgt, v[1] * wgt); w.y = pk2(v[2] * wgt, v[3] * wgt);
                            *(u32x2*)(Y + (size_t)tok * D + cb + tcol) = w; }
                } }
    }
};

struct Frame {
    const Params __attribute__((address_space(4)))* kp; LAS unsigned char* lds; int tid, lane, wave, G, bid;
    unsigned char* ws;
    __device__ __forceinline__ const float* in(int k) const { return kp->in[k]; }
    __device__ __forceinline__ float* outp() const { return kp->out; }
    template <class T> __device__ __forceinline__ T* wsp(size_t off) const { return (T*)(ws + off); }
    template <class T> __device__ __forceinline__ T* ar(size_t off) const { return (T*)(ws + WS_ARENA + off); }
    __device__ __forceinline__ const float* modL(int layer, int b, int j) const { return (const float*)(ws + WS_MODL) + (((size_t)layer * NB + b) * 6 + j) * D; }
    __device__ __forceinline__ const float* modC(int layer, int j) const { return (const float*)(ws + WS_MODC) + ((size_t)layer * 6 + j) * D; }
};

struct TJob { const float* src; bf16_t* dst; const float* ksc; int lds, K, N, ldd, kofs, nofs, inter; };
constexpr int NJOBS = 2 * 24 + 1 + 4 + 4 * NEXP * 3;
__device__ __forceinline__ TJob get_job(const Frame& F, int j) {
    TJob J; J.ksc = nullptr; J.kofs = 0; J.nofs = 0; J.inter = 0; J.K = 0; J.N = 0; J.lds = 0; J.ldd = 0; J.src = nullptr; J.dst = nullptr;
    if (j < 48) {
        const int a = j / 24, q = j % 24;
        if (q < 18) {
            const int half = q / 9, w = q % 9; const float* mu = F.in(8) + (size_t)a * 6 * D;
            J.dst = F.wsp<bf16_t>(WS_W1CAT) + (size_t)a * N1CAT * K1CAT; J.ldd = K1CAT; J.kofs = half * 1024; J.K = D; int mi = 0;
            if (w == 0) { J.src = F.in(9) + (size_t)a * D * D; J.lds = D; J.N = D; J.nofs = 0; mi = 0; }
            else if (w == 1) { J.src = F.in(10) + (size_t)a * D * D; J.lds = D; J.N = D; J.nofs = 1024; mi = 2; }
            else if (w == 2) { J.src = F.in(11) + (size_t)a * D * D; J.lds = D; J.N = D; J.nofs = 2048; mi = 3; }
            else if (w < 5) { const int d = w - 3; J.src = F.in(14) + ((size_t)a * 2 + d) * D * 64; J.lds = 64; J.N = 64; J.nofs = 3072 + d * 64; mi = 1; }
            else if (w < 7) { const int d = w - 5; J.src = F.in(17) + ((size_t)a * 2 + d) * D * 64; J.lds = 64; J.N = 64; J.nofs = 3200 + d * 64; mi = 4; }
            else if (w == 7) { J.src = F.in(22) + (size_t)a * D * 128; J.lds = 128; J.N = 128; J.nofs = 3328; mi = 5; }
            else { J.src = F.in(20); J.lds = 32; J.N = (a == 1) ? 32 : 0; J.nofs = 3456; mi = 3; }
            if (half) J.ksc = mu + mi * D;
        } else if (q == 18) { J.src = F.in(12) + (size_t)a * D * D; J.lds = D; J.K = D; J.N = D; J.dst = F.wsp<bf16_t>(WS_WO) + (size_t)a * D * D; J.ldd = D; }
        else if (q == 19) { J.src = F.in(23) + (size_t)a * 128 * D; J.lds = D; J.K = 128; J.N = D; J.dst = F.wsp<bf16_t>(WS_G2T) + (size_t)a * D * 256; J.ldd = 256; }
        else if (q < 22) { const int d = q - 20; J.src = F.in(15) + ((size_t)a * 2 + d) * 64 * D; J.lds = D; J.K = 64; J.N = D; J.dst = F.wsp<bf16_t>(WS_W2T) + ((size_t)a * 2 + d) * D * 64; J.ldd = 64; }
        else { const int d = q - 22; J.src = F.in(18) + ((size_t)a * 2 + d) * 64 * D; J.lds = D; J.K = 64; J.N = D; J.dst = F.wsp<bf16_t>(WS_A2T) + ((size_t)a * 2 + d) * D * 64; J.ldd = 64; }
    } else if (j == 48) { J.src = F.in(21); J.lds = D; J.K = 32; J.N = D; J.dst = F.wsp<bf16_t>(WS_V2T); J.ldd = 256; J.kofs = 128; }
    else if (j < 53) {
        const int q = j - 49, b = q >> 1;
        if ((q & 1) == 0) { J.src = F.in(29) + (size_t)b * D * 4096; J.lds = 4096; J.K = D; J.N = 4096; J.dst = F.wsp<bf16_t>(WS_WIN) + (size_t)b * 4096 * D; J.ldd = D; }
        else { J.src = F.in(35) + (size_t)b * 2048 * D; J.lds = D; J.K = 2048; J.N = D; J.dst = F.wsp<bf16_t>(WS_WOUT) + (size_t)b * D * 2048; J.ldd = 2048; }
    } else {
        const int q = j - 53, ie = q / 3, w = q % 3;
        if (w < 2) { J.src = F.in(38 + w) + (size_t)ie * D * FEXP; J.lds = FEXP; J.K = D; J.N = FEXP; J.dst = F.wsp<bf16_t>(WS_WGU) + (size_t)ie * 1024 * D; J.ldd = D; J.nofs = w * 16; J.inter = 1; }
        else { J.src = F.in(40) + (size_t)ie * FEXP * D; J.lds = D; J.K = FEXP; J.N = D; J.dst = F.wsp<bf16_t>(WS_WD) + (size_t)ie * D * FEXP; J.ldd = FEXP; }
    }
    return J;
}
__device__ __forceinline__ void transpose_all(const Frame& F) {
    LAS float* tile = (LAS float*)F.lds;
    int tilectr = 0;
#pragma unroll 1
    for (int j = 0; j < NJOBS; ++j) {
        const TJob J = get_job(F, j);
        const int tk = (J.K + 127) / 128, tn = (J.N + 127) / 128, ntile = tk * tn;
        int t = (F.bid - (tilectr % F.G) + F.G) % F.G;
        tilectr += ntile;
#pragma unroll 1
        for (; t < ntile; t += F.G) {
            const int k0 = (t / tn) * 128, n0 = (t % tn) * 128;
            __syncthreads();
            float v[32];
#pragma unroll
            for (int e = 0; e < 32; ++e) { const int idx = F.tid + e * 512, kk = idx >> 7, nn = idx & 127;
                v[e] = 0.f; if (k0 + kk < J.K && n0 + nn < J.N) v[e] = J.src[(size_t)(k0 + kk) * J.lds + n0 + nn]; }
#pragma unroll
            for (int e = 0; e < 32; ++e) { const int idx = F.tid + e * 512, kk = idx >> 7, nn = idx & 127;
                float x = v[e]; if (J.ksc && k0 + kk < J.K) x *= J.ksc[k0 + kk];
                tile[kk * 129 + nn] = x; }
            __syncthreads();
#pragma unroll
            for (int e = 0; e < 16; ++e) { const int idx = F.tid + e * 512, nn = idx >> 6, kk = (idx & 63) * 2;
                if (k0 + kk < J.K && n0 + nn < J.N) { const int n = n0 + nn; const int row = J.nofs + (J.inter ? ((n >> 4) * 32 + (n & 15)) : n);
                    *(unsigned*)(J.dst + (size_t)row * J.ldd + J.kofs + k0 + kk) = pk2(tile[kk * 129 + nn], tile[(kk + 1) * 129 + nn]); } }
        }
    }
    __syncthreads();
}
__device__ __forceinline__ void zero_rows(const Frame& F, bf16_t* dst, int ldd, int row0, int nrows, int col0, int ncols) {
    const int per = ncols / 8; const long tot = (long)nrows * per;
    for (long i = (long)F.bid * NTHREADS + F.tid; i < tot; i += (long)F.G * NTHREADS) { const int r = (int)(i / per), c = (int)(i % per) * 8;
        *(u32x4*)(dst + (size_t)(row0 + r) * ldd + col0 + c) = (u32x4){0u, 0u, 0u, 0u}; }
}
__device__ __forceinline__ void phase_prologue(const Frame& F) {
    {
        LAS float* sl = (LAS float*)F.lds;
        LAS float* red = (LAS float*)(F.lds + 33 * 256 * 4);
        const float* c = F.in(1); const float* cc = F.in(3); const float* wm = F.in(4); const float* bm = F.in(5);
        const int tx = F.tid & 63, ty = F.tid >> 6;
        for (int unit = F.bid; unit < 4 * 96; unit += F.G) {
            const int layer = unit / 96, col0 = (unit % 96) * 64;
            float acc[33];
#pragma unroll
            for (int r = 0; r < 33; ++r) acc[r] = 0.f;
#pragma unroll 1
            for (int kc = 0; kc < 4; ++kc) {
                __syncthreads();
                for (int i = F.tid; i < 33 * 256; i += NTHREADS) { const int r = i >> 8, k = (i & 255) + kc * 256; const float x = r < 32 ? c[r * D + k] : cc[k]; sl[i] = x * sigmoidf_(x); }
                __syncthreads();
#pragma unroll 1
                for (int k4 = 0; k4 < 32; k4 += 4) {
                    const int kl = ty * 32 + k4;
                    float w[4];
#pragma unroll
                    for (int e = 0; e < 4; ++e) w[e] = wm[((size_t)layer * D + kc * 256 + kl + e) * 6144 + col0 + tx];
#pragma unroll
                    for (int r = 0; r < 33; ++r) { const f32x4 s = *(const LAS f32x4*)(sl + r * 256 + kl); acc[r] += s[0] * w[0] + s[1] * w[1] + s[2] * w[2] + s[3] * w[3]; if ((r & 7) == 7) asm volatile("" ::: "memory"); }
                }
            }
            __syncthreads();
#pragma unroll
            for (int r = 0; r < 33; ++r) red[(ty * 33 + r) * 64 + tx] = acc[r];
            __syncthreads();
            for (int i = F.tid; i < 33 * 64; i += NTHREADS) { const int r = i >> 6, x = i & 63; float s = 0.f;
#pragma unroll
                for (int y = 0; y < 8; ++y) s += red[(y * 33 + r) * 64 + x];
                const int col = col0 + x; s += bm[layer * 6144 + col];
                if (r < 32) F.wsp<float>(WS_MODL)[((size_t)layer * NB + r) * 6144 + col] = s; else F.wsp<float>(WS_MODC)[(size_t)layer * 6144 + col] = s; }
        }
    }
    __syncthreads();
    transpose_all(F);
    for (int a = 0; a < 2; ++a) {
        bf16_t* W1 = F.wsp<bf16_t>(WS_W1CAT) + (size_t)a * N1CAT * K1CAT;
        if (a == 0) zero_rows(F, W1, K1CAT, 3456, 128, 0, K1CAT); else zero_rows(F, W1, K1CAT, 3488, 96, 0, K1CAT);
        zero_rows(F, F.wsp<bf16_t>(WS_G2T) + (size_t)a * D * 256, 256, 0, D, 128, 128);
    }
    zero_rows(F, F.wsp<bf16_t>(WS_V2T), 256, 0, D, 0, 128); zero_rows(F, F.wsp<bf16_t>(WS_V2T), 256, 0, D, 160, 96);
    {
        const float* src = F.in(33); bf16_t* dst = F.wsp<bf16_t>(WS_WSP); const long tot = (long)2 * 16 * 128 * 128 / 4;
        for (long i = (long)F.bid * NTHREADS + F.tid; i < tot; i += (long)F.G * NTHREADS) { const f32x4 v = *(const f32x4*)(src + i * 4); u32x2 w; w.x = pk2(v[0], v[1]); w.y = pk2(v[2], v[3]); *(u32x2*)(dst + i * 4) = w; }
    }
    __syncthreads();
}

__device__ __forceinline__ void phase_norm1(const Frame& F, int g, int layer  , bf16_t* dst, int ldh, bool dry = false) {
    float* X = F.wsp<float>(WS_X);
    const bf16_t* Y0 = F.ar<bf16_t>(AR_YM0); const bf16_t* Y1 = F.ar<bf16_t>(AR_YM1);
    const bool fin = layer == 4;
    for (int r = F.bid * NWAVES + F.wave; r < TG; r += F.G * NWAVES) {
        const int bl = r / LT, t = r % LT, b = g * BG + bl; const bool isctx = t < LC;
        if (isctx && layer >= 3) continue;
        f32x4 x[4], xo[4];
#pragma unroll
        for (int q = 0; q < 4; ++q) xo[q] = (f32x4){0.f, 0.f, 0.f, 0.f};
        if (layer == 0) {
            const float* src = isctx ? F.in(2) + ((size_t)b * LC + t) * D : F.in(0) + ((size_t)b * SEQ + (t - LC)) * D;
#pragma unroll
            for (int q = 0; q < 4; ++q) x[q] = *(const f32x4*)(src + q * 256 + F.lane * 4);
        } else {
            const float* gt = isctx ? F.modC(layer - 1, 5) : F.modL(layer - 1, b, 5);
#pragma unroll
            for (int q = 0; q < 4; ++q) { const int c = q * 256 + F.lane * 4;
                x[q] = *(const f32x4*)(X + (size_t)r * D + c); xo[q] = x[q];
                const u32x2 a = *(const u32x2*)(Y0 + (size_t)r * D + c), bb = *(const u32x2*)(Y1 + (size_t)r * D + c);
                const f32x4 gv = *(const f32x4*)(gt + c);
                x[q][0] += gv[0] * (lo16(a.x) + lo16(bb.x)); x[q][1] += gv[1] * (hi16(a.x) + hi16(bb.x));
                x[q][2] += gv[2] * (lo16(a.y) + lo16(bb.y)); x[q][3] += gv[3] * (hi16(a.y) + hi16(bb.y)); }
        }
        float ss = 0.f;
#pragma unroll
        for (int q = 0; q < 4; ++q) ss += x[q][0] * x[q][0] + x[q][1] * x[q][1] + x[q][2] * x[q][2] + x[q][3] * x[q][3];
        ss = wave_sum(ss);
        const float rstd = rsqrtf(ss * (1.0f / D) + 1e-6f);
        if (fin) {
            float* o = F.outp() + ((size_t)b * SEQ + (t - LC)) * D; const float* fg = F.in(41);
#pragma unroll
            for (int q = 0; q < 4; ++q) { const int c = q * 256 + F.lane * 4; const f32x4 gv = *(const f32x4*)(fg + c); *(f32x4*)(o + c) = x[q] * rstd * gv; }
        } else {
            const float* gn = F.in(6) + (size_t)layer * D;
            const float* sh = isctx ? F.modC(layer, 0) : F.modL(layer, b, 0);
            const float* sc = isctx ? F.modC(layer, 1) : F.modL(layer, b, 1);
#pragma unroll
            for (int q = 0; q < 4; ++q) { const int c = q * 256 + F.lane * 4;
                *(f32x4*)(X + (size_t)r * D + c) = (dry && layer > 0) ? xo[q] : x[q];
                const f32x4 gv = *(const f32x4*)(gn + c), sv = *(const f32x4*)(sh + c), cv = *(const f32x4*)(sc + c);
                const f32x4 h = x[q] * rstd * gv * (1.0f + cv) + sv;
                u32x2 w; w.x = pk2(h[0], h[1]); w.y = pk2(h[2], h[3]);
                *(u32x2*)(dst + (size_t)r * ldh + c) = w; }
        }
    }
}
__device__ __forceinline__ void phase_mix(const Frame& F) {
    bf16_t* H2 = F.ar<bf16_t>(AR_H2);
    for (int r = F.bid * NWAVES + F.wave; r < TG; r += F.G * NWAVES) {
        const int t = r % LT; const bool isctx = t < LC; const int p = t - LC;
#pragma unroll
        for (int q = 0; q < 2; ++q) {
            const int c = q * 512 + F.lane * 8;
            int nr;
            if (isctx) nr = (q == 0) ? (t > 0 ? r - 1 : -1) : (t < LC - 1 ? r + 1 : -1);
            else { const int qu = c >> 8;
                nr = qu == 0 ? ((p & 63) > 0 ? r - 1 : -1) : qu == 1 ? ((p & 63) < 63 ? r + 1 : -1) : qu == 2 ? (p >= 64 ? r - 64 : -1) : (p < SEQ - 64 ? r + 64 : -1); }
            const u32x4 hs = *(const u32x4*)(H2 + (size_t)r * 2048 + c);
            u32x4 hn = (u32x4){0u, 0u, 0u, 0u};
            if (nr >= 0) hn = *(const u32x4*)(H2 + (size_t)nr * 2048 + c);
            u32x4 o;
            o.x = pk2(lo16(hn.x) - lo16(hs.x), hi16(hn.x) - hi16(hs.x)); o.y = pk2(lo16(hn.y) - lo16(hs.y), hi16(hn.y) - hi16(hs.y));
            o.z = pk2(lo16(hn.z) - lo16(hs.z), hi16(hn.z) - hi16(hs.z)); o.w = pk2(lo16(hn.w) - lo16(hs.w), hi16(hn.w) - hi16(hs.w));
            *(u32x4*)(H2 + (size_t)r * 2048 + 1024 + c) = o;
        }
    }
}
__device__ __forceinline__ void phase_vfix(const Frame& F) {
    bf16_t* V = F.ar<bf16_t>(AR_V); const bf16_t* VF = F.wsp<bf16_t>(WS_VF); const bf16_t* GT = F.ar<bf16_t>(AR_VGATE);
    const size_t tot = (size_t)TG * D / 8;
    for (size_t i = (size_t)F.bid * NTHREADS + F.tid; i < tot; i += (size_t)F.G * NTHREADS) {
        const u32x4 v = *(const u32x4*)(V + i * 8), f = *(const u32x4*)(VF + i * 8), g = *(const u32x4*)(GT + i * 8);
        u32x4 o;
        o.x = pk2(lo16(v.x) + (lo16(f.x) - lo16(v.x)) * lo16(g.x), hi16(v.x) + (hi16(f.x) - hi16(v.x)) * hi16(g.x));
        o.y = pk2(lo16(v.y) + (lo16(f.y) - lo16(v.y)) * lo16(g.y), hi16(v.y) + (hi16(f.y) - hi16(v.y)) * hi16(g.y));
        o.z = pk2(lo16(v.z) + (lo16(f.z) - lo16(v.z)) * lo16(g.z), hi16(v.z) + (hi16(f.z) - hi16(v.z)) * hi16(g.z));
        o.w = pk2(lo16(v.w) + (lo16(f.w) - lo16(v.w)) * lo16(g.w), hi16(v.w) + (hi16(f.w) - hi16(v.w)) * hi16(g.w));
        *(u32x4*)(V + i * 8) = o;
    }
}
__device__ __forceinline__ void phase_post(const Frame& F, int a, const bf16_t* V) {
    const bf16_t* Y0 = F.ar<bf16_t>(AR_Y0); bf16_t* YG = F.ar<bf16_t>(AR_R); const bf16_t* Y1 = F.ar<bf16_t>(AR_Y1); const float* DOT = F.ar<float>(AR_DOT); const bf16_t* Gb = F.ar<bf16_t>(AR_G);
    const float* lg = F.in(27) + (size_t)a * D; const float* lb = F.in(28) + (size_t)a * D;
    for (int r = F.bid * NWAVES + F.wave; r < TG; r += F.G * NWAVES) {
        const int c = F.lane * 16, h = F.lane >> 2;
        float y[16], vv[16];
#pragma unroll
        for (int q = 0; q < 2; ++q) {
            const u32x4 a0 = *(const u32x4*)(Y0 + (size_t)r * D + c + q * 8), a1 = *(const u32x4*)(Y1 + (size_t)r * D + c + q * 8), v4 = *(const u32x4*)(V + (size_t)r * D + c + q * 8);
            y[q * 8 + 0] = lo16(a0.x) + lo16(a1.x); y[q * 8 + 1] = hi16(a0.x) + hi16(a1.x); y[q * 8 + 2] = lo16(a0.y) + lo16(a1.y); y[q * 8 + 3] = hi16(a0.y) + hi16(a1.y);
            y[q * 8 + 4] = lo16(a0.z) + lo16(a1.z); y[q * 8 + 5] = hi16(a0.z) + hi16(a1.z); y[q * 8 + 6] = lo16(a0.w) + lo16(a1.w); y[q * 8 + 7] = hi16(a0.w) + hi16(a1.w);
            vv[q * 8 + 0] = lo16(v4.x); vv[q * 8 + 1] = hi16(v4.x); vv[q * 8 + 2] = lo16(v4.y); vv[q * 8 + 3] = hi16(v4.y);
            vv[q * 8 + 4] = lo16(v4.z); vv[q * 8 + 5] = hi16(v4.z); vv[q * 8 + 6] = lo16(v4.w); vv[q * 8 + 7] = hi16(v4.w);
        }
        float s = 0.f;
#pragma unroll
        for (int e = 0; e < 16; ++e) s += y[e];
        s = red4(s); const float mean = s * (1.0f / 64.0f);
        float qv = 0.f;
#pragma unroll
        for (int e = 0; e < 16; ++e) { const float dd = y[e] - mean; qv += dd * dd; }
        qv = red4(qv); const float rstd = rsqrtf(qv * (1.0f / 64.0f) + 64e-5f);
        const float dsum = DOT[(size_t)r * NH + h] + DOT[((size_t)TG + r) * NH + h];
        unsigned o[8];
        const u32x4 g0 = *(const u32x4*)(Gb + (size_t)r * D + c), g1 = *(const u32x4*)(Gb + (size_t)r * D + c + 8);
        const unsigned gw[8] = {g0.x, g0.y, g0.z, g0.w, g1.x, g1.y, g1.z, g1.w};
#pragma unroll
        for (int e = 0; e < 16; e += 2) {
            const float o0 = ((y[e] - mean) * rstd * lg[c + e] + lb[c + e] + vv[e] * dsum) * lo16(gw[e >> 1]);
            const float o1 = ((y[e + 1] - mean) * rstd * lg[c + e + 1] + lb[c + e + 1] + vv[e + 1] * dsum) * hi16(gw[e >> 1]);
            o[e >> 1] = pk2(o0, o1);
        }
        *(u32x4*)(YG + (size_t)r * D + c) = (u32x4){o[0], o[1], o[2], o[3]};
        *(u32x4*)(YG + (size_t)r * D + c + 8) = (u32x4){o[4], o[5], o[6], o[7]};
    }
}
__device__ __forceinline__ void phase_norm2(const Frame& F, int g, int layer, bool dry = false) {
    float* X = F.wsp<float>(WS_X); bf16_t* HM = F.ar<bf16_t>(AR_HM); const bf16_t* Ob = F.ar<bf16_t>(AR_O);
    int* lists = dry ? F.ar<int>(AR_YM0) : F.ar<int>(AR_LIST); float* lwt = dry ? F.ar<float>(AR_YM0) + (size_t)32 * TG : F.ar<float>(AR_LW);
    unsigned* cnt = (unsigned*)(F.ws + WS_CTL + CTL_CNT_OFF) + (((size_t)g * 4 + layer) * 32 + (dry ? NG * 4 * 32 : 0)) * 16;
    LAS float* wr = (LAS float*)F.lds;
    __syncthreads();
    for (int i = F.tid; i < D * NEXP / 4; i += NTHREADS) { const int c = i >> 2, e4 = i & 3; const int rho = (c & ~255) + (c & 3) * 64 + ((c & 255) >> 2);
        *(LAS f32x4*)(wr + rho * 20 + e4 * 4) = *(const f32x4*)(F.in(36) + i * 4); }
    __syncthreads();
    const float* rbias = F.in(37);
    const bool ctx_out = layer < 2;
    LAS int* lcnt = (LAS int*)(F.lds + LDS_MISC + 512);
    LAS int* lbase = (LAS int*)(F.lds + LDS_MISC + 640);
    LAS int* rec = (LAS int*)(F.lds + 81920);
    const int niter = (TG + F.G * NWAVES - 1) / (F.G * NWAVES);
    for (int it0 = 0; it0 < niter; it0 += 64) {
        if (F.tid < 32) lcnt[F.tid] = 0;
        __syncthreads();
        const int itn = (niter - it0) < 64 ? (niter - it0) : 64;
        for (int itl = 0; itl < itn; ++itl) {
            const int r = (F.bid + (it0 + itl) * F.G) * NWAVES + F.wave;
            const int bl = r / LT, t = r % LT, b = g * BG + bl; const bool isctx = t < LC;
            const int slot = itl * NWAVES + F.wave;
            if (r >= TG || (isctx && !ctx_out)) { if (F.lane == 0) rec[slot * 4] = -1; continue; }
            f32x4 x[4]; float ss = 0.f;
            const float* gt1 = isctx ? F.modC(layer, 2) : F.modL(layer, b, 2);
#pragma unroll
            for (int q = 0; q < 4; ++q) { const int c = q * 256 + F.lane * 4;
                x[q] = *(const f32x4*)(X + (size_t)r * D + c);
                const u32x2 ob = *(const u32x2*)(Ob + (size_t)r * D + c); const f32x4 gv = *(const f32x4*)(gt1 + c);
                const f32x4 xo = x[q];
                x[q][0] += gv[0] * lo16(ob.x); x[q][1] += gv[1] * hi16(ob.x); x[q][2] += gv[2] * lo16(ob.y); x[q][3] += gv[3] * hi16(ob.y);
                *(f32x4*)(X + (size_t)r * D + c) = dry ? xo : x[q];
                ss += x[q][0] * x[q][0] + x[q][1] * x[q][1] + x[q][2] * x[q][2] + x[q][3] * x[q][3]; }
            ss = wave_sum(ss);
            const float rstd = rsqrtf(ss * (1.0f / D) + 1e-6f);
            const float* gn = F.in(7) + (size_t)layer * D;
            const float* sh = isctx ? F.modC(layer, 3) : F.modL(layer, b, 3);
            const float* sc = isctx ? F.modC(layer, 4) : F.modL(layer, b, 4);
            float lg[16];
#pragma unroll
            for (int e = 0; e < 16; ++e) lg[e] = 0.f;
#pragma unroll
            for (int q = 0; q < 4; ++q) { const int c = q * 256 + F.lane * 4;
                const f32x4 gv = *(const f32x4*)(gn + c), sv = *(const f32x4*)(sh + c), cv = *(const f32x4*)(sc + c);
                const f32x4 h = x[q] * rstd * gv * (1.0f + cv) + sv;
                u32x2 w; w.x = pk2(h[0], h[1]); w.y = pk2(h[2], h[3]);
                *(u32x2*)(HM + (size_t)r * D + c) = w;
#pragma unroll
                for (int j = 0; j < 4; ++j) {
#pragma unroll
                    for (int e4 = 0; e4 < 4; ++e4) { const f32x4 wv = *(const LAS f32x4*)(wr + (q * 256 + j * 64 + F.lane) * 20 + e4 * 4);
                        lg[e4 * 4 + 0] += h[j] * wv[0]; lg[e4 * 4 + 1] += h[j] * wv[1]; lg[e4 * 4 + 2] += h[j] * wv[2]; lg[e4 * 4 + 3] += h[j] * wv[3]; } }
            }
#pragma unroll
            for (int e = 0; e < 16; ++e) lg[e] = wave_sum_dpp(lg[e]);
            float sc_[16], bs[16];
#pragma unroll
            for (int e = 0; e < 16; ++e) { sc_[e] = sigmoidf_(lg[e]); bs[e] = sc_[e] + rbias[e]; }
            float gs[4];
#pragma unroll
            for (int gq = 0; gq < 4; ++gq) { float m1 = -1e30f, m2 = -1e30f;
#pragma unroll
                for (int j = 0; j < 4; ++j) { const float v = bs[gq * 4 + j]; if (v > m1) { m2 = m1; m1 = v; } else if (v > m2) m2 = v; }
                gs[gq] = m1 + m2; }
            int best = 0; float bv = gs[0];
#pragma unroll
            for (int gq = 1; gq < 4; ++gq) if (gs[gq] > bv) { bv = gs[gq]; best = gq; }
            float cb[4], cs[4];
#pragma unroll
            for (int j = 0; j < 4; ++j) { cb[j] = best == 0 ? bs[j] : best == 1 ? bs[4 + j] : best == 2 ? bs[8 + j] : bs[12 + j]; cs[j] = best == 0 ? sc_[j] : best == 1 ? sc_[4 + j] : best == 2 ? sc_[8 + j] : sc_[12 + j]; }
            int j1 = 0; float v1 = cb[0];
#pragma unroll
            for (int j = 1; j < 4; ++j) if (cb[j] > v1) { v1 = cb[j]; j1 = j; }
            int j2 = -1; float v2 = -1e30f;
#pragma unroll
            for (int j = 0; j < 4; ++j) if (j != j1 && cb[j] > v2) { v2 = cb[j]; j2 = j; }
            const float s1 = j1 == 0 ? cs[0] : j1 == 1 ? cs[1] : j1 == 2 ? cs[2] : cs[3];
            const float s2 = j2 == 0 ? cs[0] : j2 == 1 ? cs[1] : j2 == 2 ? cs[2] : cs[3];
            const float inv = 1.0f / (s1 + s2);
            if (F.lane == 0) {
                const int l1 = (best * 4 + j1) * 2 + 0, l2 = (best * 4 + j2) * 2 + 1;
                const int p1 = __hip_atomic_fetch_add(lcnt + l1, 1, __ATOMIC_RELAXED, __HIP_MEMORY_SCOPE_WORKGROUP);
                const int p2 = __hip_atomic_fetch_add(lcnt + l2, 1, __ATOMIC_RELAXED, __HIP_MEMORY_SCOPE_WORKGROUP);
                rec[slot * 4 + 0] = l1 | (p1 << 8); rec[slot * 4 + 1] = l2 | (p2 << 8);
                rec[slot * 4 + 2] = __float_as_int(s1 * inv); rec[slot * 4 + 3] = __float_as_int(s2 * inv);
            }
        }
        __syncthreads();
        if (F.tid < 32) { const int c = lcnt[F.tid]; lbase[F.tid] = c ? (int)atomicAdd(&cnt[F.tid * 16], (unsigned)c) : 0; }
        __syncthreads();
        for (int slot = F.tid; slot < itn * NWAVES; slot += NTHREADS) {
            const int a0 = rec[slot * 4 + 0]; if (a0 < 0) continue;
            const int a1 = rec[slot * 4 + 1];
            const int r = (F.bid + (it0 + slot / NWAVES) * F.G) * NWAVES + (slot % NWAVES);
            const int l1 = a0 & 255, l2 = a1 & 255; const int q1 = lbase[l1] + (a0 >> 8), q2 = lbase[l2] + (a1 >> 8);
            lists[(size_t)l1 * TG + q1] = r; lwt[(size_t)l1 * TG + q1] = __int_as_float(rec[slot * 4 + 2]);
            lists[(size_t)l2 * TG + q2] = r; lwt[(size_t)l2 * TG + q2] = __int_as_float(rec[slot * 4 + 3]);
        }
        __syncthreads();
    }
}
__device__ __forceinline__ int moe_tables(const Frame& F, int g, int layer) {
    LAS int* cn = (LAS int*)(F.lds + LDS_MISC + 64); LAS int* tb = (LAS int*)(F.lds + LDS_MISC + 192);
    const unsigned* cnt = (const unsigned*)(F.ws + WS_CTL + CTL_CNT_OFF) + ((size_t)g * 4 + layer) * 32 * 16;
    __syncthreads();
    if (F.tid == 0) { int acc = 0; for (int l = 0; l < 32; ++l) { const int c = (int)__hip_atomic_load(cnt + l * 16, __ATOMIC_RELAXED, __HIP_MEMORY_SCOPE_AGENT); cn[l] = c; tb[l] = acc; acc += (c + 255) >> 8; } tb[32] = acc; }
    __syncthreads();
    return tb[32];
}

constexpr int SC_OPB = 6 * 4096;
constexpr int SC_HALF = 2 * SC_OPB + 4096 + 4096;
static_assert(2 * SC_HALF <= LDS_STAGE, "scan lds");
__device__ __forceinline__ int scan_tok(int d, int s) { return d == 0 ? s : (s < LC ? (LC - 1 - s) : (LT + LC - 1 - s)); }
__device__ __forceinline__ void phase_scan(const Frame& F, int a, const bf16_t* V) {
    const bf16_t* R = F.ar<bf16_t>(AR_R); const bf16_t* Kb = F.ar<bf16_t>(AR_K); const bf16_t* L1 = F.ar<bf16_t>(AR_L1);
    const int half = F.wave >> 2, q = F.wave & 3, lane = F.lane, li = q * 64 + lane;
    LAS unsigned char* hb = F.lds + half * SC_HALF;
    LAS float* aT = (LAS float*)(hb + 2 * SC_OPB); LAS float* ybuf = (LAS float*)(hb + 2 * SC_OPB + 4096);
    const int arr = q >> 1, ntl = (q & 1) * 2;
    const int i = lane >> 3, j = lane & 7, r0 = 16 * q + 2 * i;
    const int tB = li >> 4, k4 = (li & 15) * 4;
    for (int pr = F.bid; pr < BG * 16; pr += F.G) {
        const int bl = pr >> 4, d = (pr >> 3) & 1, hp = pr & 7, h = hp * 2 + half;
        bf16_t* Yd = F.ar<bf16_t>(d ? AR_Y1 : AR_Y0); float* DOT = F.ar<float>(AR_DOT) + (size_t)d * TG * NH;
        const size_t rowb = (size_t)bl * LT;
        const bf16_t* W2 = (arr == 0 ? F.wsp<bf16_t>(WS_W2T) : F.wsp<bf16_t>(WS_A2T)) + ((size_t)a * 2 + d) * D * 64;
        bf16x8 Bf[2][2]; float bias[2];
#pragma unroll
        for (int nt = 0; nt < 2; ++nt) { const int cc = h * 64 + (ntl + nt) * 16 + (lane & 15);
            bias[nt] = (arr == 0 ? F.in(13) : F.in(16))[((size_t)a * 2 + d) * D + cc];
#pragma unroll
            for (int s = 0; s < 2; ++s) Bf[nt][s] = *(const bf16x8*)(W2 + (size_t)cc * 64 + 32 * s + 8 * (lane >> 4)); }
        const f32x4 kkc = *(const f32x4*)(F.in(24) + (size_t)a * D + h * 64 + k4), kac = *(const f32x4*)(F.in(25) + (size_t)a * D + h * 64 + k4), rkc = *(const f32x4*)(F.in(26) + (size_t)a * D + h * 64 + k4);
        const int acol = arr * 128 + d * 64 + 8 * (lane >> 4);
        float S0[8], S1[8];
#pragma unroll
        for (int c = 0; c < 8; ++c) { S0[c] = 0.f; S1[c] = 0.f; }
        bf16x8 Af[2]; u32x2 kraw, rraw, vraw;
#define SC_LOAD(ch) do { const size_t rowA = rowb + scan_tok(d, (ch) * 16 + (lane & 15)); \
        Af[0] = *(const bf16x8*)(L1 + rowA * 512 + acol); Af[1] = *(const bf16x8*)(L1 + rowA * 512 + acol + 32); \
        const size_t rowBq = (rowb + scan_tok(d, (ch) * 16 + tB)) * D + h * 64 + k4; \
        kraw = *(const u32x2*)(Kb + rowBq); rraw = *(const u32x2*)(R + rowBq); vraw = *(const u32x2*)(V + rowBq); } while (0)
#define SC_PASSA(buf) do { LAS float* op = (LAS float*)(hb + (buf) * SC_OPB); \
        _Pragma("unroll") for (int nt = 0; nt < 2; ++nt) { f32x4 ac = (f32x4){0.f, 0.f, 0.f, 0.f}; \
            ac = __builtin_amdgcn_mfma_f32_16x16x32_bf16(Af[0], Bf[nt][0], ac, 0, 0, 0); ac = __builtin_amdgcn_mfma_f32_16x16x32_bf16(Af[1], Bf[nt][1], ac, 0, 0, 0); \
            const int n = (ntl + nt) * 16 + (lane & 15); \
            _Pragma("unroll") for (int rg = 0; rg < 4; ++rg) { const int t = (lane >> 4) * 4 + rg; const float x = ac[rg] + bias[nt]; \
                if (arr == 0) { const float nx = -x; const float sp = nx > 20.f ? nx : __logf(1.0f + __expf(nx)); op[1024 + t * 64 + n] = __expf(-__expf(-sp - 0.5f)); } \
                else aT[t * 64 + n] = sigmoidf_(x); } } } while (0)
#define SC_PASSB(ch, buf) do { LAS float* op = (LAS float*)(hb + (buf) * SC_OPB); \
        const float kf[4] = {lo16(kraw.x), hi16(kraw.x), lo16(kraw.y), hi16(kraw.y)}; const float rf[4] = {lo16(rraw.x), hi16(rraw.x), lo16(rraw.y), hi16(rraw.y)}; \
        const float vf[4] = {lo16(vraw.x), hi16(vraw.x), lo16(vraw.y), hi16(vraw.y)}; \
        const f32x4 av = *(const LAS f32x4*)(aT + tB * 64 + k4); \
        float kq[4], ssq = 0.f; _Pragma("unroll") for (int e = 0; e < 4; ++e) { kq[e] = kf[e] * kkc[e]; ssq += kq[e] * kq[e]; } \
        ssq = red16(ssq); const float inv = 1.0f / fmaxf(sqrtf(ssq), 1e-12f); \
        f32x4 o_kk, o_kka, o_kd, o_r, o_v; float dp = 0.f; \
        _Pragma("unroll") for (int e = 0; e < 4; ++e) { const float kkv = kq[e] * inv; const float kd = kf[e] * (1.0f + (av[e] - 1.0f) * kac[e]); \
            o_kk[e] = kkv; o_kka[e] = kkv * av[e]; o_kd[e] = kd; o_r[e] = rf[e]; o_v[e] = vf[e]; dp += rf[e] * kd * rkc[e]; } \
        dp = red16(dp); \
        if ((li & 15) == 0) DOT[(rowb + scan_tok(d, (ch) * 16 + tB)) * NH + h] = dp; \
        *(LAS f32x4*)(op + 0 * 1024 + tB * 64 + k4) = o_kk; *(LAS f32x4*)(op + 2 * 1024 + tB * 64 + k4) = o_kka; *(LAS f32x4*)(op + 3 * 1024 + tB * 64 + k4) = o_kd; \
        *(LAS f32x4*)(op + 4 * 1024 + tB * 64 + k4) = o_r; *(LAS f32x4*)(op + 5 * 1024 + tB * 64 + k4) = o_v; } while (0)
        __syncthreads();
        SC_LOAD(0);
        SC_PASSA(0);
        __syncthreads();
        SC_PASSB(0, 0);
        __syncthreads();
        constexpr int NCH = LT / 16;
        for (int ch = 0; ch < NCH; ++ch) {
            const int buf = ch & 1;
            if (ch + 1 < NCH) SC_LOAD(ch + 1);
            const LAS float* op = (const LAS float*)(hb + buf * SC_OPB);
            f32x4 cA[5], cB[5], nA[5], nB[5]; f32x2 cv, nv;
#define SC_OPLOAD(dA, dB, dv, t) do { const LAS float* ob_ = op + (t) * 64 + j * 8; \
                _Pragma("unroll") for (int q_ = 0; q_ < 5; ++q_) { dA[q_] = *(const LAS f32x4*)(ob_ + q_ * 1024); dB[q_] = *(const LAS f32x4*)(ob_ + q_ * 1024 + 4); } \
                dv = *(const LAS f32x2*)(op + 5 * 1024 + (t) * 64 + r0); } while (0)
            SC_OPLOAD(cA, cB, cv, 0);
#pragma unroll
            for (int t = 0; t < 16; ++t) {
                if (t + 1 < 16) SC_OPLOAD(nA, nB, nv, t + 1);
                const float kk[8] = {cA[0][0], cA[0][1], cA[0][2], cA[0][3], cB[0][0], cB[0][1], cB[0][2], cB[0][3]};
                const float dc[8] = {cA[1][0], cA[1][1], cA[1][2], cA[1][3], cB[1][0], cB[1][1], cB[1][2], cB[1][3]};
                const float ka[8] = {cA[2][0], cA[2][1], cA[2][2], cA[2][3], cB[2][0], cB[2][1], cB[2][2], cB[2][3]};
                const float kd[8] = {cA[3][0], cA[3][1], cA[3][2], cA[3][3], cB[3][0], cB[3][1], cB[3][2], cB[3][3]};
                const float rr[8] = {cA[4][0], cA[4][1], cA[4][2], cA[4][3], cB[4][0], cB[4][1], cB[4][2], cB[4][3]};
                float sa0 = (S0[0] * kk[0] + S0[1] * kk[1]) + (S0[2] * kk[2] + S0[3] * kk[3]) + ((S0[4] * kk[4] + S0[5] * kk[5]) + (S0[6] * kk[6] + S0[7] * kk[7]));
                float sa1 = (S1[0] * kk[0] + S1[1] * kk[1]) + (S1[2] * kk[2] + S1[3] * kk[3]) + ((S1[4] * kk[4] + S1[5] * kk[5]) + (S1[6] * kk[6] + S1[7] * kk[7]));
                sa0 = red8(sa0); sa1 = red8(sa1);
#pragma unroll
                for (int c = 0; c < 8; ++c) {
                    S0[c] = S0[c] * dc[c] + (cv[0] * kd[c] - sa0 * ka[c]);
                    S1[c] = S1[c] * dc[c] + (cv[1] * kd[c] - sa1 * ka[c]);
                }
                float y0 = (S0[0] * rr[0] + S0[1] * rr[1]) + (S0[2] * rr[2] + S0[3] * rr[3]) + ((S0[4] * rr[4] + S0[5] * rr[5]) + (S0[6] * rr[6] + S0[7] * rr[7]));
                float y1 = (S1[0] * rr[0] + S1[1] * rr[1]) + (S1[2] * rr[2] + S1[3] * rr[3]) + ((S1[4] * rr[4] + S1[5] * rr[5]) + (S1[6] * rr[6] + S1[7] * rr[7]));
                y0 = red8(y0); y1 = red8(y1);
                if (j == 0) *(LAS f32x2*)(ybuf + t * 64 + r0) = (f32x2){y0, y1};
#pragma unroll
                for (int q_ = 0; q_ < 5; ++q_) { cA[q_] = nA[q_]; cB[q_] = nB[q_]; }
                cv = nv;
            }
#undef SC_OPLOAD
            __syncthreads();
            {
                const f32x4 yv = *(const LAS f32x4*)(ybuf + tB * 64 + k4);
                u32x2 w; w.x = pk2(yv[0], yv[1]); w.y = pk2(yv[2], yv[3]);
                *(u32x2*)(Yd + (rowb + scan_tok(d, ch * 16 + tB)) * D + h * 64 + k4) = w;
            }
            if (ch + 1 < NCH) SC_PASSA(buf ^ 1);
            __syncthreads();
            if (ch + 1 < NCH) SC_PASSB(ch + 1, buf ^ 1);
            __syncthreads();
        }
#undef SC_LOAD
#undef SC_PASSA
#undef SC_PASSB
    }
}

__device__ __forceinline__ void phase_sgstats(const Frame& F, int layer) {
    const bf16_t* Z = F.ar<bf16_t>(AR_Z); float* ST = F.ar<float>(AR_ST);
    for (int r = F.bid * NWAVES + F.wave; r < TG; r += F.G * NWAVES) {
        const int t = r % LT; if (t < LC && layer >= 3) continue;
        float x[32];
#pragma unroll
        for (int q = 0; q < 4; ++q) { const u32x4 w = *(const u32x4*)(Z + (size_t)r * 4096 + 2048 + q * 512 + F.lane * 8);
            x[q * 8 + 0] = lo16(w.x); x[q * 8 + 1] = hi16(w.x); x[q * 8 + 2] = lo16(w.y); x[q * 8 + 3] = hi16(w.y); x[q * 8 + 4] = lo16(w.z); x[q * 8 + 5] = hi16(w.z); x[q * 8 + 6] = lo16(w.w); x[q * 8 + 7] = hi16(w.w); }
        float s = 0.f;
#pragma unroll
        for (int e = 0; e < 32; ++e) s += x[e];
        s = wave_sum(s); const float mean = s * (1.0f / 2048.0f);
        float qv = 0.f;
#pragma unroll
        for (int e = 0; e < 32; ++e) { const float dd = x[e] - mean; qv += dd * dd; }
        qv = wave_sum(qv);
        if (F.lane == 0) *(f32x2*)(ST + (size_t)r * 2) = (f32x2){mean, rsqrtf(qv * (1.0f / 2048.0f) + 1e-5f)};
    }
}
__device__ __forceinline__ int vt_off(int dch, int jb) { return dch * 256 + ((jb ^ ((dch & 15) ^ (((dch >> 4) & 7) << 1))) << 4); }
__device__ __forceinline__ void phase_spatial(const Frame& F, int bsg, int layer) {
    const bf16_t* Z = F.ar<bf16_t>(AR_Z); const float* ST = F.ar<float>(AR_ST); bf16_t* Pb = F.ar<bf16_t>(AR_P);
    const bf16_t* Ws = F.wsp<bf16_t>(WS_WSP) + (size_t)bsg * 16 * 128 * 128;
    const float* lng = F.in(31) + (size_t)bsg * 2048; const float* lnb = F.in(32) + (size_t)bsg * 2048; const float* bs = F.in(34) + (size_t)bsg * 16 * 128;
    LAS unsigned char* vt = F.lds;
    const int skip = layer >= 3;
    const int nchunk = skip ? BG * 16 : BG * 18;
    const int w = F.wave, lane = F.lane, dt = w >> 1, it0 = (w & 1) * 2;
    for (int U = F.bid; U < nchunk * 16; U += F.G) {
        const int lc = U >> 4, gi = U & 15;
        const int chunk = skip ? (lc >> 4) * 18 + 2 + (lc & 15) : lc;
        const size_t row0 = (size_t)chunk * 128;
        __syncthreads();
#pragma unroll
        for (int k = 0; k < 4; ++k) {
            const int p = F.tid + 512 * k, jj = p >> 4, c8 = (p & 15) * 8;
            const u32x4 zz = *(const u32x4*)(Z + (row0 + jj) * 4096 + 2048 + gi * 128 + c8);
            const f32x2 st = *(const f32x2*)(ST + (row0 + jj) * 2);
            const float xv[8] = {lo16(zz.x), hi16(zz.x), lo16(zz.y), hi16(zz.y), lo16(zz.z), hi16(zz.z), lo16(zz.w), hi16(zz.w)};
#pragma unroll
            for (int e = 0; e < 8; ++e) { const int dch = c8 + e; const float val = (xv[e] - st[0]) * st[1] * lng[gi * 128 + dch] + lnb[gi * 128 + dch];
                *(LAS unsigned short*)(vt + vt_off(dch, jj >> 3) + (jj & 7) * 2) = f2bf(val); }
        }
        __syncthreads();
        f32x16 acc0, acc1;
#pragma unroll
        for (int e = 0; e < 16; ++e) { acc0[e] = 0.f; acc1[e] = 0.f; }
        const int dA = dt * 32 + (lane & 31);
        const bf16_t* w0p = Ws + ((size_t)gi * 128 + it0 * 32 + (lane & 31)) * 128 + 8 * (lane >> 5);
#pragma unroll
        for (int s = 0; s < 8; ++s) {
            const bf16x8 Afr = *(const LAS bf16x8*)(vt + vt_off(dA, 2 * s + (lane >> 5)));
            const bf16x8 B0 = *(const bf16x8*)(w0p + 16 * s), B1 = *(const bf16x8*)(w0p + 32 * 128 + 16 * s);
            acc0 = __builtin_amdgcn_mfma_f32_32x32x16_bf16(Afr, B0, acc0, 0, 0, 0);
            acc1 = __builtin_amdgcn_mfma_f32_32x32x16_bf16(Afr, B1, acc1, 0, 0, 0);
        }
#pragma unroll
        for (int it = 0; it < 2; ++it) {
            const int ii = (it0 + it) * 32 + (lane & 31); const size_t row = row0 + ii; const float bias = bs[gi * 128 + ii];
#pragma unroll
            for (int rq = 0; rq < 4; ++rq) {
                const int d0 = dt * 32 + 8 * rq + 4 * (lane >> 5);
                const u32x2 uu = *(const u32x2*)(Z + row * 4096 + gi * 128 + d0);
                float vs[4];
#pragma unroll
                for (int e = 0; e < 4; ++e) vs[e] = (it == 0 ? acc0[rq * 4 + e] : acc1[rq * 4 + e]) + bias;
                u32x2 o; o.x = pk2(lo16(uu.x) * vs[0], hi16(uu.x) * vs[1]); o.y = pk2(lo16(uu.y) * vs[2], hi16(uu.y) * vs[3]);
                *(u32x2*)(Pb + row * 2048 + gi * 128 + d0) = o;
            }
        }
    }
    __syncthreads();
}

__global__ void __launch_bounds__(NTHREADS, 2) fwd_kernel(Params P) {
    extern __shared__ __attribute__((aligned(16))) unsigned char lds_raw[];
    Frame F; F.lds = (LAS unsigned char*)lds_raw; F.tid = threadIdx.x; F.lane = F.tid & 63; F.wave = __builtin_amdgcn_readfirstlane(F.tid >> 6);
    F.G = gridDim.x; F.bid = blockIdx.x; F.ws = P.ws; F.kp = (const Params __attribute__((address_space(4)))*)__builtin_amdgcn_kernarg_segment_ptr();
    const int lo = P.ph_lo, hi = P.ph_hi;
    volatile LAS unsigned* misc = (volatile LAS unsigned*)(F.lds + LDS_MISC);
    if (F.tid < 4) misc[F.tid] = 0u;
    __syncthreads();
    XcdBarrier bar; bar.bar = (unsigned*)(F.ws + WS_CTL); bar.x = 0; bar.st = misc;
    if (hi - lo > 1) bar = xcd_barrier_post((unsigned*)(F.ws + WS_CTL), misc);
    int ph = 0;
#define RUN(id, ...) do { if (ph >= lo && ph < hi) { const int nrep_ = ((REP_MASK >> (id)) & 1u) ? 2 : 1; for (int rep_ = 0; rep_ < nrep_; ++rep_) { const bool dry_ = (rep_ + 1 < nrep_); (void)dry_; { int t_ = threadIdx.x; const Params __attribute__((address_space(4)))* kp_ = (const Params __attribute__((address_space(4)))*)__builtin_amdgcn_kernarg_segment_ptr(); asm volatile("" : "+v"(t_), "+s"(kp_)); F.tid = t_; F.lane = t_ & 63; F.kp = kp_; F.ws = kp_->ws; } __VA_ARGS__; if (rep_ + 1 < nrep_ || ph + 1 < hi) xcd_barrier(bar); } } ++ph; } while (0)

    RUN(0, phase_prologue(F));
    for (int g = 0; g < NG; ++g) {
        for (int layer = 0; layer < 4; ++layer) {
            const int a = layer >> 1;
            if ((layer & 1) == 0) {
                const bf16_t* Vc = layer == 0 ? F.wsp<bf16_t>(WS_VF) : F.ar<bf16_t>(AR_V);
                RUN(1, phase_norm1(F, g, layer, F.ar<bf16_t>(AR_H2), 2048, dry_));
                RUN(2, phase_mix(F));
                RUN(3, { pg8::SchedPlain S; S.init(TG / 256, N1CAT / 256, F.G, F.bid, 0);
                      EpiG1 E{F.ws, layer == 0 ? WS_VF : WS_ARENA + AR_V};
                      pg8::gemm_phase(F.tid, F.lds, F.ar<bf16_t>(AR_H2), K1CAT, F.wsp<bf16_t>(WS_W1CAT) + (size_t)a * N1CAT * K1CAT, K1CAT, K1CAT, S, E); });
                if (layer == 2) {
                    RUN(4, { pg8::SchedPlain S; S.init(TG / 256, 4, F.G, F.bid, 0);
                          EpiStore<1> E{F.ar<bf16_t>(AR_VGATE), F.in(19)};
                          pg8::gemm_phase(F.tid, F.lds, F.ar<bf16_t>(AR_L1) + 256, 512, F.wsp<bf16_t>(WS_V2T), 256, 256, S, E); });
                    RUN(5, phase_vfix(F));
                }
                RUN(6, phase_scan(F, a, Vc));
                RUN(7, { pg8::SchedPlain S; S.init(TG / 256, 4, F.G, F.bid, 0);
                      EpiStore<0> E{F.ar<bf16_t>(AR_G), nullptr};
                      pg8::gemm_phase(F.tid, F.lds, F.ar<bf16_t>(AR_L1) + 256, 512, F.wsp<bf16_t>(WS_G2T) + (size_t)a * D * 256, 256, 256, S, E); });
                RUN(8, phase_post(F, a, Vc));
                RUN(9, { const int skip = layer == 2; pg8::SchedPlain S; S.init(skip ? BG * 8 : TG / 256, 4, F.G, F.bid, skip);
                      EpiStore<0> E{F.ar<bf16_t>(AR_O), nullptr};
                      pg8::gemm_phase(F.tid, F.lds, F.ar<bf16_t>(AR_R), D, F.wsp<bf16_t>(WS_WO) + (size_t)a * D * D, D, D, S, E); });
            } else {
                const int skip = layer == 3;
                RUN(10, phase_norm1(F, g, layer, F.ar<bf16_t>(AR_H), D, dry_));
                RUN(11, { pg8::SchedPlain S; S.init(skip ? BG * 8 : TG / 256, 16, F.G, F.bid, skip);
                      EpiGelu E{F.ar<bf16_t>(AR_Z), F.in(30) + (size_t)a * 4096};
                      pg8::gemm_phase(F.tid, F.lds, F.ar<bf16_t>(AR_H), D, F.wsp<bf16_t>(WS_WIN) + (size_t)a * 4096 * D, D, D, S, E); });
                RUN(12, phase_sgstats(F, layer));
                RUN(13, phase_spatial(F, a, layer));
                RUN(14, { pg8::SchedPlain S; S.init(skip ? BG * 8 : TG / 256, 4, F.G, F.bid, skip);
                      EpiStore<0> E{F.ar<bf16_t>(AR_O), nullptr};
                      pg8::gemm_phase(F.tid, F.lds, F.ar<bf16_t>(AR_P), 2048, F.wsp<bf16_t>(WS_WOUT) + (size_t)a * D * 2048, 2048, 2048, S, E); });
            }
            RUN(15, phase_norm2(F, g, layer, dry_));
            RUN(16, { const int total = moe_tables(F, g, layer);
                  pg8::SchedMoe<true> S{(const LAS int*)(F.lds + LDS_MISC + 64), (const LAS int*)(F.lds + LDS_MISC + 192), F.ar<int>(AR_LIST), F.G, F.bid, total};
                  EpiMG E{F.ar<bf16_t>(AR_HE)};
                  pg8::gemm_phase(F.tid, F.lds, F.ar<bf16_t>(AR_HM), D, F.wsp<bf16_t>(WS_WGU) + (size_t)layer * NEXP * 1024 * D, D, D, S, E); });
            RUN(17, { const int total = moe_tables(F, g, layer);
                  pg8::SchedMoe<false> S{(const LAS int*)(F.lds + LDS_MISC + 64), (const LAS int*)(F.lds + LDS_MISC + 192), F.ar<int>(AR_LIST), F.G, F.bid, total};
                  EpiMD E{F.ar<bf16_t>(AR_YM0), F.ar<int>(AR_LIST), F.ar<float>(AR_LW), (const LAS int*)(F.lds + LDS_MISC + 64)};
                  pg8::gemm_phase(F.tid, F.lds, F.ar<bf16_t>(AR_HE), FEXP, F.wsp<bf16_t>(WS_WD) + (size_t)layer * NEXP * D * FEXP, FEXP, FEXP, S, E); });
        }
        RUN(18, phase_norm1(F, g, 4, nullptr, 0));
    }
#undef RUN
}
constexpr int NPHASES = 1 + NG * (10 + 8 + 12 + 8 + 1);

__global__ void nan_fill(float* out, size_t n) { for (size_t i = (size_t)blockIdx.x * blockDim.x + threadIdx.x; i < n; i += (size_t)gridDim.x * blockDim.x) out[i] = __uint_as_float(0x7FC00000u); }

extern "C" void kernel_launch(void* const* d_in, const int* in_sizes, int n_in, void* d_out, int out_size, void* d_ws, size_t ws_size, hipStream_t stream) {
    static int grid = 0;
    if (grid == 0) {
        int dev = 0, cus = 0, per_cu = 0;
        if (n_in != 42 || ws_size < WS_END || hipGetDevice(&dev) != hipSuccess || hipDeviceGetAttribute(&cus, hipDeviceAttributeMultiprocessorCount, dev) != hipSuccess) {
            fprintf(stderr, "kernel_launch: bad setup (n_in %d, ws %zu need %zu)\n", n_in, ws_size, (size_t)WS_END); grid = -1;
        } else if (hipFuncSetAttribute((const void*)fwd_kernel, hipFuncAttributeMaxDynamicSharedMemorySize, LDS_BYTES) != hipSuccess) { fprintf(stderr, "kernel_launch: hipFuncSetAttribute failed\n"); grid = -1; }
        else {
            if (hipOccupancyMaxActiveBlocksPerMultiprocessor(&per_cu, (const void*)fwd_kernel, NTHREADS, LDS_BYTES) != hipSuccess || per_cu < 1) { fprintf(stderr, "kernel_launch: occupancy query reports %d\n", per_cu); }
            (void)hipGetLastError();
            grid = cus;
        }
    }
    if (grid < 0) { hipLaunchKernelGGL(nan_fill, dim3(1024), dim3(256), 0, stream, (float*)d_out, (size_t)out_size); return; }
    (void)hipMemsetAsync((char*)d_ws + WS_CTL, 0, CTL_BYTES, stream);
    Params p{};
    for (int i = 0; i < 42; ++i) p.in[i] = (const float*)d_in[i];
    p.out = (float*)d_out; p.ws = (unsigned char*)d_ws;
#if PER_PHASE_LAUNCH
    for (int k = 0; k < NPHASES; ++k) { p.ph_lo = k; p.ph_hi = k + 1; hipLaunchKernelGGL(fwd_kernel, dim3(grid), dim3(NTHREADS), LDS_BYTES, stream, p); }
#else
    p.ph_lo = 0; p.ph_hi = NPHASES;
    hipLaunchKernelGGL(fwd_kernel, dim3(grid), dim3(NTHREADS), LDS_BYTES, stream, p);
#endif
}
```

```cpp
#include <hip/hip_runtime.h>
#include <cstdio>
#include <cstdint>

#ifndef REP_MASK
#define REP_MASK 0u
#endif
#ifndef PER_PHASE_LAUNCH
#define PER_PHASE_LAUNCH 0
#endif

#define LAS __attribute__((address_space(3)))
typedef unsigned short bf16_t;
typedef short bf16x8 __attribute__((ext_vector_type(8)));
typedef float f32x4 __attribute__((ext_vector_type(4)));
typedef float f32x2 __attribute__((ext_vector_type(2)));
typedef float f32x16 __attribute__((ext_vector_type(16)));
typedef unsigned u32x4 __attribute__((ext_vector_type(4)));
typedef unsigned u32x2 __attribute__((ext_vector_type(2)));

constexpr int NB = 32, SEQ = 2048, LC = 256, LT = SEQ + LC, D = 1024, NH = 16;
constexpr int NG = 2, BG = NB / NG, TG = BG * LT;
constexpr int NTHREADS = 512, NWAVES = 8;
constexpr int N1CAT = 3584, K1CAT = 2048;
constexpr int NEXP = 16, FEXP = 512;

constexpr size_t al256(size_t x) { return (x + 255) & ~(size_t)255; }
constexpr int XCD_BAR_WORDS_C = 3456;
constexpr size_t WS_CTL = 0;
constexpr size_t CTL_BAR_BYTES = (size_t)XCD_BAR_WORDS_C * 4;
constexpr size_t CTL_CNT_OFF = al256(CTL_BAR_BYTES);
constexpr size_t CTL_BYTES = al256(CTL_CNT_OFF + (size_t)2 * NG * 4 * 32 * 64);
constexpr size_t WS_X = al256(WS_CTL + CTL_BYTES);
constexpr size_t WS_VF = WS_X + (size_t)TG * D * 2;
constexpr size_t WS_MODL = WS_VF + (size_t)TG * D * 2;
constexpr size_t WS_MODC = WS_MODL + (size_t)4 * NB * 6 * D * 4;
constexpr size_t WS_WRKV = al256(WS_MODC + (size_t)4 * 6 * D * 4);
constexpr size_t WS_WL = WS_WRKV + (size_t)2 * 3072 * D * 2;
constexpr size_t WS_WO = WS_WL + (size_t)2 * 512 * K1CAT * 2;
constexpr size_t WS_G2T = WS_WO + (size_t)2 * D * D * 2;
constexpr size_t WS_V2T = WS_G2T + (size_t)2 * D * 256 * 2;
constexpr size_t WS_W2T = WS_V2T + (size_t)D * 256 * 2;
constexpr size_t WS_A2T = WS_W2T + (size_t)4 * D * 64 * 2;
constexpr size_t WS_WIN = WS_A2T + (size_t)4 * D * 64 * 2;
constexpr size_t WS_WOUT = WS_WIN + (size_t)2 * 4096 * D * 2;
constexpr size_t WS_WSP = WS_WOUT + (size_t)2 * D * 2048 * 2;
constexpr size_t WS_WGU = WS_WSP + (size_t)2 * 16 * 128 * 128 * 2;
constexpr size_t WS_WD = WS_WGU + (size_t)4 * NEXP * 1024 * D * 2;
constexpr size_t WS_ARENA = al256(WS_WD + (size_t)4 * NEXP * D * FEXP * 2);
constexpr size_t SZB = (size_t)TG * D * 2;
constexpr size_t AR_H2 = 0;
constexpr size_t AR_Y0 = 0, AR_Y1 = SZB;
constexpr size_t AR_XR = 2 * SZB;
constexpr size_t AR_R = 5 * SZB, AR_K = 6 * SZB, AR_V = 7 * SZB;
constexpr size_t AR_L1 = 8 * SZB;
constexpr size_t AR_DOT = AR_L1 + SZB / 2;
constexpr size_t AR_G = 2 * SZB;
constexpr size_t AR_VGATE = 0;
constexpr size_t AR_O = 3 * SZB;
constexpr size_t AR_H = 0;
constexpr size_t AR_Z = SZB;
constexpr size_t AR_P = 5 * SZB;
constexpr size_t AR_ST = 7 * SZB;
constexpr size_t AR_HM = 0;
constexpr size_t AR_HE = SZB;
constexpr size_t HE_ROWS = (size_t)2 * TG + 32 * 256;
constexpr size_t AR_LIST = al256(AR_HE + HE_ROWS * FEXP * 2);
constexpr size_t AR_LW = AR_LIST + (size_t)32 * TG * 4;
constexpr size_t AR_YM0 = 5 * SZB, AR_YM1 = 6 * SZB;
constexpr size_t ARENA_BYTES = AR_DOT + (size_t)2 * TG * 16 * 4 + 4096;
constexpr size_t WS_END = WS_ARENA + ARENA_BYTES;
static_assert(AR_LW + (size_t)32 * TG * 4 <= AR_O, "moe lists overlap");

constexpr int LDS_STAGE = 131072;
constexpr int LDS_MISC = LDS_STAGE;
constexpr int LDS_BYTES = LDS_STAGE + 1024;

struct Params {
    const float* in[42];
    float* out;
    unsigned char* ws;
    int ph_lo, ph_hi;
};

__device__ __forceinline__ float bf2f(unsigned short b) { return __uint_as_float(((unsigned)b) << 16); }
__device__ __forceinline__ unsigned short f2bf(float f) { unsigned u = __float_as_uint(f); u += 0x7FFFu + ((u >> 16) & 1u); return (unsigned short)(u >> 16); }
typedef __bf16 bf16x2_t __attribute__((ext_vector_type(2)));
__device__ __forceinline__ unsigned pk2(float lo, float hi) { const bf16x2_t v = __builtin_convertvector((f32x2){lo, hi}, bf16x2_t); return __builtin_bit_cast(unsigned, v); }
__device__ __forceinline__ float lo16(unsigned w) { return __uint_as_float(w << 16); }
__device__ __forceinline__ float hi16(unsigned w) { return __uint_as_float(w & 0xFFFF0000u); }
__device__ __forceinline__ float sigmoidf_(float x) { return __builtin_amdgcn_rcpf(1.0f + __expf(-x)); }
__device__ __forceinline__ float tanhf_(float x) { return 1.0f - 2.0f * __builtin_amdgcn_rcpf(__expf(2.0f * x) + 1.0f); }
__device__ __forceinline__ float wave_sum(float v) {
#pragma unroll
    for (int o = 32; o > 0; o >>= 1) v += __shfl_xor(v, o);
    return v;
}
template <int CTRL> __device__ __forceinline__ float dpp_f(float v) {
    return __int_as_float(__builtin_amdgcn_update_dpp(0, __float_as_int(v), CTRL, 0xF, 0xF, true));
}
__device__ __forceinline__ float red8(float v) { v += dpp_f<0xB1>(v); v += dpp_f<0x4E>(v); v += dpp_f<0x141>(v); return v; }
__device__ __forceinline__ float red16(float v) { v = red8(v); v += dpp_f<0x140>(v); return v; }
__device__ __forceinline__ float wave_sum_dpp(float v) {
    v = red16(v);
    const float a = __int_as_float(__builtin_amdgcn_readlane(__float_as_int(v), 0)), b = __int_as_float(__builtin_amdgcn_readlane(__float_as_int(v), 16));
    const float c = __int_as_float(__builtin_amdgcn_readlane(__float_as_int(v), 32)), d = __int_as_float(__builtin_amdgcn_readlane(__float_as_int(v), 48));
    return (a + b) + (c + d);
}
__device__ __forceinline__ float red4(float v) { v += dpp_f<0xB1>(v); v += dpp_f<0x4E>(v); return v; }
__device__ __forceinline__ f32x2 gelu_pk(f32x2 v) {
    const f32x2 av = __builtin_elementwise_abs(v), d = av * 0.2316418882f + 1.0f;
    f32x2 t; t.x = __builtin_amdgcn_rcpf(d.x); t.y = __builtin_amdgcn_rcpf(d.y);
    f32x2 q = t * 0.5307027145f + (-0.7265760135f); q = q * t + 0.7107068705f; q = q * t + (-0.142248368f); q = q * t + 0.127414796f; q = q * t;
    const f32x2 s = (v * v) * (-0.72134752044f);
    f32x2 e; e.x = __builtin_amdgcn_exp2f(s.x); e.y = __builtin_amdgcn_exp2f(s.y);
    const f32x2 m = v * (q * e), r = v - m;
    f32x2 o; o.x = v.x < 0.f ? m.x : r.x; o.y = v.y < 0.f ? m.y : r.y; return o;
}
__device__ __forceinline__ float gelu_f(float v) {
    const float av = fabsf(v), t = __builtin_amdgcn_rcpf(av * 0.2316418882f + 1.0f);
    float q = t * 0.5307027145f + (-0.7265760135f); q = q * t + 0.7107068705f; q = q * t + (-0.142248368f); q = q * t + 0.127414796f; q = q * t;
    const float e = __builtin_amdgcn_exp2f((v * v) * (-0.72134752044f));
    const float m = v * (q * e);
    return v < 0.f ? m : v - m;
}

#define XB_TMO      128
#define XB_XCNT(j)  (256  + 64 * (j))
#define XB_XSUB(j)  (1280 + 64 * (j))
#define XB_XGEN(j)  (2304 + 64 * (j))
#define XB_TOP      3328
#define XB_TOPGEN   3392
#define XCD_BAR_WORDS 3456
#define XB_SPIN_CAP (1u << 22)
static_assert(XCD_BAR_WORDS == XCD_BAR_WORDS_C, "barrier words");
__device__ __forceinline__ unsigned xb_ld(unsigned* p)              { return __hip_atomic_load(p, __ATOMIC_RELAXED, __HIP_MEMORY_SCOPE_AGENT); }
__device__ __forceinline__ unsigned xb_add(unsigned* p, unsigned v) { return __hip_atomic_fetch_add(p, v, __ATOMIC_RELAXED, __HIP_MEMORY_SCOPE_AGENT); }
__device__ __forceinline__ unsigned xb_xcc_id() { return (unsigned)__builtin_amdgcn_s_getreg((3 << 11) | 20) & 0xFu; }
#define XB_SPIN(cond, bar) do { unsigned _sp = 0; while (cond) { __builtin_amdgcn_s_sleep(1); \
    if ((++_sp & 255u) == 0u) { if (xb_ld(&(bar)[XB_TMO])) break; if (_sp > XB_SPIN_CAP) { atomicAdd(&(bar)[XB_TMO], 1u); break; } } } } while (0)
struct XcdBarrier { unsigned* bar; unsigned x; volatile LAS unsigned* st; };
__device__ __forceinline__ XcdBarrier xcd_barrier_post(unsigned* bar, volatile LAS unsigned* st) {
    XcdBarrier b; b.bar = bar; b.x = xb_xcc_id(); b.st = st;
    if (threadIdx.x == 0) (void)xb_add(&bar[XB_XCNT(b.x)], 1u);
    return b;
}
__device__ __forceinline__ void xcd_barrier_complete(unsigned* bar, unsigned x, unsigned& nloc, unsigned& nx) {
    const unsigned G = gridDim.x * gridDim.y * gridDim.z;
    unsigned sum, cnt, mine, sp = 0u;
    for (;;) {
        sum = 0u; cnt = 0u; mine = 0u;
#pragma unroll
        for (unsigned j = 0; j < 16; ++j) { const unsigned c = xb_ld(&bar[XB_XCNT(j)]); sum += c; cnt += (c > 0u) ? 1u : 0u; mine = (j == x) ? c : mine; }
        if (sum == G) break;
        __builtin_amdgcn_s_sleep(1);
        if ((++sp & 255u) == 0u) { if (xb_ld(&bar[XB_TMO])) break; if (sp > XB_SPIN_CAP) { atomicAdd(&bar[XB_TMO], 1u); break; } }
    }
    nloc = mine > 0u ? mine : 1u; nx = cnt > 0u ? cnt : 1u;
}
__device__ __forceinline__ void xcd_barrier(const XcdBarrier& b) {
    asm volatile("s_waitcnt vmcnt(0)" ::: "memory");
    __syncthreads();
    if (threadIdx.x == 0) {
        unsigned* bar = b.bar;
        __builtin_amdgcn_s_waitcnt(0);
        unsigned nloc = b.st[0], nx = b.st[1];
        if (nloc == 0u) { xcd_barrier_complete(bar, b.x, nloc, nx); b.st[0] = nloc; b.st[1] = nx; }
        const unsigned old = xb_add(&bar[XB_XSUB(b.x)], 1u);
        const unsigned gen = old / nloc;
        if (old + 1u == (gen + 1u) * nloc) {
            __builtin_amdgcn_fence(__ATOMIC_RELEASE, "agent");
            asm volatile("s_waitcnt vmcnt(0)" ::: "memory");
            const unsigned og = xb_add(&bar[XB_TOP], 1u);
            const unsigned tg = og / nx;
            if (og + 1u == (tg + 1u) * nx) xb_add(&bar[XB_TOPGEN], 1u);
            else XB_SPIN(xb_ld(&bar[XB_TOPGEN]) == tg, bar);
            __builtin_amdgcn_fence(__ATOMIC_ACQUIRE, "agent");
            xb_add(&bar[XB_XGEN(b.x)], 1u);
            asm volatile("s_waitcnt vmcnt(0)" ::: "memory");
        } else {
            XB_SPIN(xb_ld(&bar[XB_XGEN(b.x)]) == gen, bar);
            __builtin_amdgcn_fence(__ATOMIC_ACQUIRE, "agent");
            asm volatile("s_waitcnt vmcnt(0)" ::: "memory");
        }
    }
    __syncthreads();
}

namespace pg8 {
constexpr int BM = 256, BK = 64, HALF = 128, HTB = HALF * BK * 2, STAGE_BYTES = 8 * HTB, NXCD = 8, WGM = 8;
__host__ __device__ __forceinline__ int lds_byte(int r, int c) { const int st = (r >> 4) * 2 + (c >> 5), rr = r & 15, cc = c & 31, ob = rr * 64 + cc * 2; return st * 1024 + (ob ^ (((ob >> 9) & 1) << 5)); }
__host__ __device__ __forceinline__ void stage_rc(int b, int& R, int& C) { const int st = b / 1024, sb = b % 1024, swz = sb ^ (((sb >> 9) & 1) << 5); R = (st >> 1) * 16 + swz / 64; C = (st & 1) * 32 + (swz % 64) / 2; }
struct Unit { int pm, pn, aux; };

struct SchedPlain {
    static constexpr bool GATHER = false;
    int nM, nN, nwg, G, c, skipctx;
    __device__ void init(int nM_, int nN_, int G_, int c_, int skipctx_) { nM = nM_; nN = nN_; nwg = nM * nN; G = G_; c = c_; skipctx = skipctx_; }
    __device__ bool next(int i, Unit& u) const {
        const long L = (long)i * G + c; if (L >= nwg) return false;
        int wgid = (int)L; { const int q = nwg / NXCD, r = nwg % NXCD, xcd = wgid % NXCD, off = wgid / NXCD; wgid = (xcd < r ? xcd * (q + 1) : r * (q + 1) + (xcd - r) * q) + off; }
        const int nig = WGM * nN, gid = wgid / nig, fm = gid * WGM, gsz = (nM - fm) < WGM ? (nM - fm) : WGM;
        int pm = fm + ((wgid % nig) % gsz); u.pn = (wgid % nig) / gsz; u.aux = 0;
        if (skipctx) pm = (pm >> 3) * 9 + 1 + (pm & 7);
        u.pm = pm; return true;
    }
    __device__ __forceinline__ int arow(const Unit& u, int r) const { return u.pm * BM + r; }
};
struct SchedRKV : SchedPlain {
    __device__ bool next(int i, Unit& u) const { if (!SchedPlain::next(i, u)) return false; u.pm += (u.pn >> 2) * nM; return true; }
};
template <bool GATH> struct SchedMoe {
    static constexpr bool GATHER = GATH;
    const LAS int* cn; const LAS int* tb; const int* lists; int G, c, total;
    __device__ bool next(int i, Unit& u) const {
        const int U = i * G + c; if (U >= total * 4) return false;
        const int T = U >> 2, pn = U & 3; int l = 0;
        while (tb[l + 1] <= T) ++l;
        u.pm = T; u.pn = (l >> 1) * 4 + pn; u.aux = l | ((T - tb[l]) << 8); return true;
    }
    __device__ __forceinline__ int arow(const Unit& u, int r) const {
        if (!GATH) return u.pm * BM + r;
        const int l = u.aux & 255, idx = (u.aux >> 8) * BM + r;
        return idx < cn[l] ? lists[(size_t)l * TG + idx] : 0;
    }
};

template <class Epi, class Sched>
__device__ __forceinline__ void gemm_phase(const int tid, LAS unsigned char* lds, const bf16_t* A, int lda, const bf16_t* Bt, int ldb, int K, const Sched& S, const Epi& E) {
    constexpr bool GA = Sched::GATHER;
    const int wid = __builtin_amdgcn_readfirstlane(tid >> 6), lane = tid & 63, wr = wid >> 2, wc = wid & 3, fr = lane & 15, fq = lane >> 4;
    const int nt = K / BK;
    unsigned voffA[2], voffB[2];
#pragma unroll
    for (int i = 0; i < 2; ++i) { int R, C; stage_rc(tid * 16 + i * 8192, R, C); voffA[i] = (unsigned)(R * lda + C) * 2u; voffB[i] = (unsigned)(R * ldb + C) * 2u; }
    const size_t kstep = (size_t)(BK * 2);
    const size_t hstepA = (size_t)HALF * lda * 2, tstepA = 2 * hstepA;
    const size_t hstepB = (size_t)HALF * ldb * 2, tstepB = 2 * hstepB;
    const unsigned ldsw = (unsigned)wid * 1024u;
    const int aoff = lds_byte(wr * 64 + fr, fq * 8), boff = lds_byte(wc * 32 + fr, fq * 8);
#define PG8_SA(b, h) (((b) * 2 + (h)) * HTB)
#define PG8_SB(b, h) ((4 + (b) * 2 + (h)) * HTB)
#define PG8_STAGE(bufoff, gbase, voff) do { _Pragma("unroll") for (int _i = 0; _i < 2; ++_i) \
        __builtin_amdgcn_global_load_lds((const unsigned*)((const char*)(gbase) + (voff)[_i]), (LAS unsigned*)(lds + (bufoff) + ldsw + _i * 8192), 16, 0, 0); } while (0)
#define PG8_STAGE_A(bufoff, ub, gv, h, koff) do { if constexpr (GA) { PG8_STAGE(bufoff, (const char*)A + (koff), gv[h]); } else { PG8_STAGE(bufoff, (ub) + (h) * hstepA + (koff), voffA); } } while (0)
#define PG8_LDA(dst, b, h) do { _Pragma("unroll") for (int m = 0; m < 4; ++m) _Pragma("unroll") for (int k = 0; k < 2; ++k) dst[m][k] = *(const LAS bf16x8*)(lds + PG8_SA(b, h) + aoff + m * 2048 + k * 1024); } while (0)
#define PG8_LDB(dst, b, h) do { _Pragma("unroll") for (int n = 0; n < 2; ++n) _Pragma("unroll") for (int k = 0; k < 2; ++k) dst[n][k] = *(const LAS bf16x8*)(lds + PG8_SB(b, h) + boff + n * 2048 + k * 1024); } while (0)
#define PG8_MMA(ai, bj, At, Bt_) do { __builtin_amdgcn_s_setprio(1); _Pragma("unroll") for (int m = 0; m < 4; ++m) _Pragma("unroll") for (int n = 0; n < 2; ++n) _Pragma("unroll") for (int k = 0; k < 2; ++k) \
        acc[ai][bj][m][n] = __builtin_amdgcn_mfma_f32_16x16x32_bf16(Bt_[n][k], At[m][k], acc[ai][bj][m][n], 0, 0, 0); __builtin_amdgcn_s_setprio(0); } while (0)
#define PG8_WAIT_V(n) asm volatile("s_waitcnt vmcnt(" #n ")" ::: "memory")
#define PG8_WAIT_L(n) asm volatile("s_waitcnt lgkmcnt(" #n ")" ::: "memory")
#define PG8_BAR __builtin_amdgcn_s_barrier()
#define PG8_SCHED __builtin_amdgcn_sched_barrier(0)
#define PG8_GOFF(dst, u) do { if constexpr (GA) { _Pragma("unroll") for (int _h = 0; _h < 2; ++_h) _Pragma("unroll") for (int _i = 0; _i < 2; ++_i) { int R_, C_; stage_rc(tid * 16 + _i * 8192, R_, C_); \
        dst[_h][_i] = ((unsigned)S.arow(u, _h * HALF + R_) * (unsigned)lda + (unsigned)C_) * 2u; } } } while (0)
    Unit cur, nxt; int ui = 0;
    if (!S.next(0, cur)) return;
    f32x4 acc[2][2][4][2];
#pragma unroll
    for (int a = 0; a < 2; ++a)
#pragma unroll
        for (int b = 0; b < 2; ++b)
#pragma unroll
            for (int m = 0; m < 4; ++m)
#pragma unroll
                for (int n = 0; n < 2; ++n) acc[a][b][m][n] = (f32x4){0.f, 0.f, 0.f, 0.f};
    bf16x8 At[4][2], B0[2][2], B1[2][2];
    unsigned gAc[2][2], gAn[2][2];
    PG8_GOFF(gAc, cur);
    const char* cA = (const char*)A + (GA ? (size_t)0 : (size_t)cur.pm * tstepA);
    const char* cB = (const char*)Bt + (size_t)cur.pn * tstepB;
    PG8_STAGE(PG8_SB(0, 0), cB, voffB); PG8_STAGE_A(PG8_SA(0, 0), cA, gAc, 0, 0); PG8_STAGE(PG8_SB(0, 1), cB + hstepB, voffB); PG8_STAGE_A(PG8_SA(0, 1), cA, gAc, 1, 0);
    if (wr == 1) PG8_BAR;
    PG8_WAIT_V(4); PG8_BAR;
    PG8_STAGE(PG8_SB(1, 0), cB + kstep, voffB); PG8_STAGE_A(PG8_SA(1, 0), cA, gAc, 0, kstep); PG8_STAGE(PG8_SB(1, 1), cB + hstepB + kstep, voffB);
    PG8_WAIT_V(6); PG8_BAR;
    for (;;) {
        const bool has_next = S.next(ui + 1, nxt);
        if (has_next) { PG8_GOFF(gAn, nxt); }
        else if constexpr (GA) {
#pragma unroll
            for (int _h = 0; _h < 2; ++_h)
#pragma unroll
                for (int _i = 0; _i < 2; ++_i) gAn[_h][_i] = gAc[_h][_i];
        }
        const char* nA = (has_next && !GA) ? (const char*)A + (size_t)nxt.pm * tstepA : cA;
        const char* nB = has_next ? (const char*)Bt + (size_t)nxt.pn * tstepB : cB;
#pragma unroll 1
        for (int t = 0; t < nt; t += 2) {
            const bool last = (t == nt - 2);
            const size_t k1 = (size_t)(t + 1) * kstep;
            const size_t k2 = last ? (size_t)0 : (size_t)(t + 2) * kstep, k3 = k2 + kstep;
            const char* a2 = last ? nA : cA; const char* b2 = last ? nB : cB;
            unsigned g2[2][2];
            if constexpr (GA) {
#pragma unroll
                for (int _h = 0; _h < 2; ++_h)
#pragma unroll
                    for (int _i = 0; _i < 2; ++_i) g2[_h][_i] = last ? gAn[_h][_i] : gAc[_h][_i];
            }
            PG8_LDB(B0, 0, 0); PG8_SCHED; PG8_LDA(At, 0, 0); PG8_STAGE_A(PG8_SA(1, 1), cA, gAc, 1, k1);
            PG8_WAIT_L(8); PG8_BAR; PG8_WAIT_L(0); PG8_MMA(0, 0, At, B0); PG8_BAR; PG8_SCHED;
            PG8_LDB(B1, 0, 1); PG8_STAGE(PG8_SB(0, 0), b2 + k2, voffB);
            PG8_BAR; PG8_WAIT_L(0); PG8_MMA(0, 1, At, B1); PG8_BAR;
            PG8_LDA(At, 0, 1); PG8_STAGE_A(PG8_SA(0, 0), a2, g2, 0, k2);
            PG8_BAR; PG8_WAIT_L(0); PG8_MMA(1, 0, At, B0); PG8_BAR; PG8_SCHED;
            PG8_STAGE(PG8_SB(0, 1), b2 + hstepB + k2, voffB);
            PG8_WAIT_V(6); PG8_BAR; PG8_MMA(1, 1, At, B1); PG8_BAR;
            PG8_LDB(B0, 1, 0); PG8_SCHED; PG8_LDA(At, 1, 0); PG8_STAGE_A(PG8_SA(0, 1), a2, g2, 1, k2);
            PG8_WAIT_L(8); PG8_BAR; PG8_WAIT_L(0); PG8_MMA(0, 0, At, B0); PG8_BAR; PG8_SCHED;
            PG8_LDB(B1, 1, 1); PG8_STAGE(PG8_SB(1, 0), b2 + k3, voffB);
            PG8_BAR; PG8_WAIT_L(0); PG8_MMA(0, 1, At, B1); PG8_BAR;
            PG8_LDA(At, 1, 1); PG8_STAGE_A(PG8_SA(1, 0), a2, g2, 0, k3);
            PG8_BAR; PG8_WAIT_L(0); PG8_MMA(1, 0, At, B0); PG8_BAR; PG8_SCHED;
            PG8_STAGE(PG8_SB(1, 1), b2 + hstepB + k3, voffB);
            PG8_WAIT_V(6); PG8_BAR; PG8_MMA(1, 1, At, B1); PG8_BAR;
        }
        { int fr_e = fr, fq_e = fq; asm volatile("" : "+v"(fr_e), "+v"(fq_e)); E(acc, cur, wr, wc, fr_e, fq_e); }
        if (!has_next) break;
#pragma unroll
        for (int a = 0; a < 2; ++a)
#pragma unroll
            for (int b = 0; b < 2; ++b)
#pragma unroll
                for (int m = 0; m < 4; ++m)
#pragma unroll
                    for (int n = 0; n < 2; ++n) acc[a][b][m][n] = (f32x4){0.f, 0.f, 0.f, 0.f};
        cur = nxt; cA = nA; cB = nB; ++ui;
        if constexpr (GA) {
#pragma unroll
            for (int _h = 0; _h < 2; ++_h)
#pragma unroll
                for (int _i = 0; _i < 2; ++_i) gAc[_h][_i] = gAn[_h][_i];
        }
    }
    PG8_WAIT_V(0);
    if (wr == 0) PG8_BAR;
    PG8_BAR;
#undef PG8_SA
#undef PG8_SB
#undef PG8_STAGE
#undef PG8_STAGE_A
#undef PG8_LDA
#undef PG8_LDB
#undef PG8_MMA
#undef PG8_WAIT_V
#undef PG8_WAIT_L
#undef PG8_BAR
#undef PG8_SCHED
#undef PG8_GOFF
}
}
using pg8::Unit;

#define EPI_LOOP_BEGIN \
    _Pragma("unroll") for (int ai = 0; ai < 2; ++ai) _Pragma("unroll") for (int m = 0; m < 4; ++m) { const int trow = ai * 128 + wr * 64 + m * 16 + fr; \
    _Pragma("unroll") for (int bj = 0; bj < 2; ++bj) _Pragma("unroll") for (int n = 0; n < 2; ++n) { const int tcol = bj * 128 + wc * 32 + n * 16 + 4 * fq; const f32x4 v = acc[ai][bj][m][n];
#define EPI_LOOP_END } asm volatile("" ::: "memory"); }

struct EpiRKV {
    unsigned char* ws; size_t voff;
    __device__ __forceinline__ void operator()(const f32x4 (&acc)[2][2][4][2], const Unit& u, int wr, int wc, int fr, int fq) const {
        const int which = u.pn >> 2; const size_t row0 = (size_t)(u.pm - which * (TG / 256)) * 256;
        const size_t off = which == 0 ? (WS_ARENA + AR_R) : (which == 1 ? (WS_ARENA + AR_K) : voff);
        bf16_t* dst = (bf16_t*)(ws + off); const int cb = (u.pn & 3) * 256;
        EPI_LOOP_BEGIN
            u32x2 w; w.x = pk2(v[0], v[1]); w.y = pk2(v[2], v[3]);
            *(u32x2*)(dst + (row0 + trow) * D + cb + tcol) = w;
        EPI_LOOP_END
    }
};
struct EpiL1 {
    bf16_t* L1;
    __device__ __forceinline__ void operator()(const f32x4 (&acc)[2][2][4][2], const Unit& u, int wr, int wc, int fr, int fq) const {
        const int pn = u.pn; const size_t row0 = (size_t)u.pm * 256; const int cb = pn * 256;
        EPI_LOOP_BEGIN
            f32x4 o = v;
            if (pn == 0 && bj == 0) { o[0] = tanhf_(v[0]); o[1] = tanhf_(v[1]); o[2] = tanhf_(v[2]); o[3] = tanhf_(v[3]); }
            if (pn == 1 && bj == 0) { o[0] = sigmoidf_(v[0]); o[1] = sigmoidf_(v[1]); o[2] = sigmoidf_(v[2]); o[3] = sigmoidf_(v[3]); }
            u32x2 w; w.x = pk2(o[0], o[1]); w.y = pk2(o[2], o[3]);
            *(u32x2*)(L1 + (row0 + trow) * 512 + cb + tcol) = w;
        EPI_LOOP_END
    }
};
template <int ACT> struct EpiStore {
    bf16_t* O; const float* bias;
    __device__ __forceinline__ void operator()(const f32x4 (&acc)[2][2][4][2], const Unit& u, int wr, int wc, int fr, int fq) const {
        const size_t row0 = (size_t)u.pm * 256; const int cb = u.pn * 256;
        EPI_LOOP_BEGIN
            f32x4 o = v;
            if (ACT == 1) { const f32x4 b = *(const f32x4*)(bias + cb + tcol); o[0] = sigmoidf_(v[0] + b[0]); o[1] = sigmoidf_(v[1] + b[1]); o[2] = sigmoidf_(v[2] + b[2]); o[3] = sigmoidf_(v[3] + b[3]); }
            u32x2 w; w.x = pk2(o[0], o[1]); w.y = pk2(o[2], o[3]);
            *(u32x2*)(O + (row0 + trow) * D + cb + tcol) = w;
        EPI_LOOP_END
    }
};
struct EpiGelu {
    bf16_t* Z; const float* bias;
    __device__ __forceinline__ void operator()(const f32x4 (&acc)[2][2][4][2], const Unit& u, int wr, int wc, int fr, int fq) const {
        const size_t row0 = (size_t)u.pm * 256; const int cb = u.pn * 256;
        EPI_LOOP_BEGIN
            const f32x4 b = *(const f32x4*)(bias + cb + tcol);
            const f32x2 g0 = gelu_pk((f32x2){v[0] + b[0], v[1] + b[1]}), g1 = gelu_pk((f32x2){v[2] + b[2], v[3] + b[3]});
            u32x2 w; w.x = pk2(g0.x, g0.y); w.y = pk2(g1.x, g1.y);
            *(u32x2*)(Z + (row0 + trow) * 4096 + cb + tcol) = w;
        EPI_LOOP_END
    }
};
struct EpiMG {
    bf16_t* HE;
    __device__ __forceinline__ void operator()(const f32x4 (&acc)[2][2][4][2], const Unit& u, int wr, int wc, int fr, int fq) const {
        const size_t row0 = (size_t)u.pm * 256; const int pnl = u.pn & 3;
#pragma unroll
        for (int ai = 0; ai < 2; ++ai)
#pragma unroll
            for (int m = 0; m < 4; ++m) { const int trow = ai * 128 + wr * 64 + m * 16 + fr;
#pragma unroll
                for (int bj = 0; bj < 2; ++bj) {
                    const f32x4 gt = acc[ai][bj][m][0], up = acc[ai][bj][m][1];
                    const int f = (8 * pnl + 4 * bj + wc) * 16 + 4 * fq;
                    float o[4];
#pragma unroll
                    for (int e = 0; e < 4; ++e) o[e] = gt[e] * sigmoidf_(gt[e]) * up[e];
                    u32x2 w; w.x = pk2(o[0], o[1]); w.y = pk2(o[2], o[3]);
                    *(u32x2*)(HE + (row0 + trow) * FEXP + f) = w;
                } }
    }
};
struct EpiMD {
    bf16_t* Y0; const int* lists; const float* lw; const LAS int* cn;
    __device__ __forceinline__ void operator()(const f32x4 (&acc)[2][2][4][2], const Unit& u, int wr, int wc, int fr, int fq) const {
        const int l = u.aux & 255, t0 = (u.aux >> 8) * 256, cnt = cn[l]; const int cb = (u.pn & 3) * 256;
        bf16_t* Y = Y0 + (size_t)(l & 1) * ((AR_YM1 - AR_YM0) / 2);
#pragma unroll
        for (int ai = 0; ai < 2; ++ai)
#pragma unroll
            for (int m = 0; m < 4; ++m) { const int trow = ai * 128 + wr * 64 + m * 16 + fr; const int idx = t0 + trow;
                if (idx < cnt) {
                    const int tok = lists[(size_t)l * TG + idx]; const float wgt = lw[(size_t)l * TG + idx];
#pragma unroll
                    for (int bj = 0; bj < 2; ++bj)
#pragma unroll
                        for (int n = 0; n < 2; ++n) { const int tcol = bj * 128 + wc * 32 + n * 16 + 4 * fq; const f32x4 v = acc[ai][bj][m][n];
                            u32x2 w; w.x = pk2(v[0] * wgt, v[1] * wgt); w.y = pk2(v[2] * wgt, v[3] * wgt);
                            *(u32x2*)(Y + (size_t)tok * D + cb + tcol) = w; }
                } }
    }
};

struct Frame {
    const Params __attribute__((address_space(4)))* kp; LAS unsigned char* lds; int tid, lane, wave, G, bid;
    unsigned char* ws;
    __device__ __forceinline__ const float* in(int k) const { return kp->in[k]; }
    __device__ __forceinline__ float* outp() const { return kp->out; }
    template <class T> __device__ __forceinline__ T* wsp(size_t off) const { return (T*)(ws + off); }
    template <class T> __device__ __forceinline__ T* ar(size_t off) const { return (T*)(ws + WS_ARENA + off); }
    __device__ __forceinline__ const float* modL(int layer, int b, int j) const { return (const float*)(ws + WS_MODL) + (((size_t)layer * NB + b) * 6 + j) * D; }
    __device__ __forceinline__ const float* modC(int layer, int j) const { return (const float*)(ws + WS_MODC) + ((size_t)layer * 6 + j) * D; }
};

struct TJob { const float* src; bf16_t* dst; const float* ksc; int lds, K, N, ldd, kofs, nofs, inter; };
constexpr int NJOBS = 2 * 21 + 1 + 4 + 4 * NEXP * 3;
__device__ __forceinline__ TJob get_job(const Frame& F, int j) {
    TJob J; J.ksc = nullptr; J.kofs = 0; J.nofs = 0; J.inter = 0; J.K = 0; J.N = 0; J.lds = 0; J.ldd = 0; J.src = nullptr; J.dst = nullptr;
    if (j < 42) {
        const int a = j / 21, q = j % 21;
        if (q < 3) { J.src = F.in(9 + q) + (size_t)a * D * D; J.lds = D; J.K = D; J.N = D; J.dst = F.wsp<bf16_t>(WS_WRKV) + (size_t)a * 3072 * D; J.ldd = D; J.nofs = q * 1024; }
        else if (q < 15) {
            const int half = (q - 3) / 6, w = (q - 3) % 6; const float* mu = F.in(8) + (size_t)a * 6 * D;
            J.dst = F.wsp<bf16_t>(WS_WL) + (size_t)a * 512 * K1CAT; J.ldd = K1CAT; J.kofs = half * 1024; J.K = D; int mi = 0;
            if (w < 2) { J.src = F.in(14) + ((size_t)a * 2 + w) * D * 64; J.lds = 64; J.N = 64; J.nofs = w * 64; mi = 1; }
            else if (w < 4) { const int d = w - 2; J.src = F.in(17) + ((size_t)a * 2 + d) * D * 64; J.lds = 64; J.N = 64; J.nofs = 128 + d * 64; mi = 4; }
            else if (w == 4) { J.src = F.in(22) + (size_t)a * D * 128; J.lds = 128; J.N = 128; J.nofs = 256; mi = 5; }
            else { J.src = F.in(20); J.lds = 32; J.N = (a == 1) ? 32 : 0; J.nofs = 384; mi = 3; }
            if (half) J.ksc = mu + mi * D;
        } else if (q == 15) { J.src = F.in(12) + (size_t)a * D * D; J.lds = D; J.K = D; J.N = D; J.dst = F.wsp<bf16_t>(WS_WO) + (size_t)a * D * D; J.ldd = D; }
        else if (q == 16) { J.src = F.in(23) + (size_t)a * 128 * D; J.lds = D; J.K = 128; J.N = D; J.dst = F.wsp<bf16_t>(WS_G2T) + (size_t)a * D * 256; J.ldd = 256; }
        else if (q < 19) { const int d = q - 17; J.src = F.in(15) + ((size_t)a * 2 + d) * 64 * D; J.lds = D; J.K = 64; J.N = D; J.dst = F.wsp<bf16_t>(WS_W2T) + ((size_t)a * 2 + d) * D * 64; J.ldd = 64; }
        else { const int d = q - 19; J.src = F.in(18) + ((size_t)a * 2 + d) * 64 * D; J.lds = D; J.K = 64; J.N = D; J.dst = F.wsp<bf16_t>(WS_A2T) + ((size_t)a * 2 + d) * D * 64; J.ldd = 64; }
    } else if (j == 42) { J.src = F.in(21); J.lds = D; J.K = 32; J.N = D; J.dst = F.wsp<bf16_t>(WS_V2T); J.ldd = 256; J.kofs = 128; }
    else if (j < 47) {
        const int q = j - 43, b = q >> 1;
        if ((q & 1) == 0) { J.src = F.in(29) + (size_t)b * D * 4096; J.lds = 4096; J.K = D; J.N = 4096; J.dst = F.wsp<bf16_t>(WS_WIN) + (size_t)b * 4096 * D; J.ldd = D; }
        else { J.src = F.in(35) + (size_t)b * 2048 * D; J.lds = D; J.K = 2048; J.N = D; J.dst = F.wsp<bf16_t>(WS_WOUT) + (size_t)b * D * 2048; J.ldd = 2048; }
    } else {
        const int q = j - 47, ie = q / 3, w = q % 3;
        if (w < 2) { J.src = F.in(38 + w) + (size_t)ie * D * FEXP; J.lds = FEXP; J.K = D; J.N = FEXP; J.dst = F.wsp<bf16_t>(WS_WGU) + (size_t)ie * 1024 * D; J.ldd = D; J.nofs = w * 16; J.inter = 1; }
        else { J.src = F.in(40) + (size_t)ie * FEXP * D; J.lds = D; J.K = FEXP; J.N = D; J.dst = F.wsp<bf16_t>(WS_WD) + (size_t)ie * D * FEXP; J.ldd = FEXP; }
    }
    return J;
}
__device__ __forceinline__ void transpose_all(const Frame& F) {
    LAS float* tile = (LAS float*)F.lds;
    int tilectr = 0;
#pragma unroll 1
    for (int j = 0; j < NJOBS; ++j) {
        const TJob J = get_job(F, j);
        const int tk = (J.K + 127) / 128, tn = (J.N + 127) / 128, ntile = tk * tn;
        int t = (F.bid - (tilectr % F.G) + F.G) % F.G;
        tilectr += ntile;
#pragma unroll 1
        for (; t < ntile; t += F.G) {
            const int k0 = (t / tn) * 128, n0 = (t % tn) * 128;
            __syncthreads();
            float v[32];
#pragma unroll
            for (int e = 0; e < 32; ++e) { const int idx = F.tid + e * 512, kk = idx >> 7, nn = idx & 127;
                v[e] = 0.f; if (k0 + kk < J.K && n0 + nn < J.N) v[e] = J.src[(size_t)(k0 + kk) * J.lds + n0 + nn]; }
#pragma unroll
            for (int e = 0; e < 32; ++e) { const int idx = F.tid + e * 512, kk = idx >> 7, nn = idx & 127;
                float x = v[e]; if (J.ksc && k0 + kk < J.K) x *= J.ksc[k0 + kk];
                tile[kk * 129 + nn] = x; }
            __syncthreads();
#pragma unroll
            for (int e = 0; e < 16; ++e) { const int idx = F.tid + e * 512, nn = idx >> 6, kk = (idx & 63) * 2;
                if (k0 + kk < J.K && n0 + nn < J.N) { const int n = n0 + nn; const int row = J.nofs + (J.inter ? ((n >> 4) * 32 + (n & 15)) : n);
                    *(unsigned*)(J.dst + (size_t)row * J.ldd + J.kofs + k0 + kk) = pk2(tile[kk * 129 + nn], tile[(kk + 1) * 129 + nn]); } }
        }
    }
    __syncthreads();
}
__device__ __forceinline__ void zero_rows(const Frame& F, bf16_t* dst, int ldd, int row0, int nrows, int col0, int ncols) {
    const int per = ncols / 8; const long tot = (long)nrows * per;
    for (long i = (long)F.bid * NTHREADS + F.tid; i < tot; i += (long)F.G * NTHREADS) { const int r = (int)(i / per), c = (int)(i % per) * 8;
        *(u32x4*)(dst + (size_t)(row0 + r) * ldd + col0 + c) = (u32x4){0u, 0u, 0u, 0u}; }
}
__device__ __forceinline__ void phase_prologue(const Frame& F) {
    {
        LAS float* sl = (LAS float*)F.lds;
        LAS float* red = (LAS float*)(F.lds + 33 * 256 * 4);
        const float* c = F.in(1); const float* cc = F.in(3); const float* wm = F.in(4); const float* bm = F.in(5);
        const int tx = F.tid & 63, ty = F.tid >> 6;
        for (int unit = F.bid; unit < 4 * 96; unit += F.G) {
            const int layer = unit / 96, col0 = (unit % 96) * 64;
            float acc[33];
#pragma unroll
            for (int r = 0; r < 33; ++r) acc[r] = 0.f;
#pragma unroll 1
            for (int kc = 0; kc < 4; ++kc) {
                __syncthreads();
                for (int i = F.tid; i < 33 * 256; i += NTHREADS) { const int r = i >> 8, k = (i & 255) + kc * 256; const float x = r < 32 ? c[r * D + k] : cc[k]; sl[i] = x * sigmoidf_(x); }
                __syncthreads();
#pragma unroll 1
                for (int k4 = 0; k4 < 32; k4 += 4) {
                    const int kl = ty * 32 + k4;
                    float w[4];
#pragma unroll
                    for (int e = 0; e < 4; ++e) w[e] = wm[((size_t)layer * D + kc * 256 + kl + e) * 6144 + col0 + tx];
#pragma unroll
                    for (int r = 0; r < 33; ++r) { const f32x4 s = *(const LAS f32x4*)(sl + r * 256 + kl); acc[r] += s[0] * w[0] + s[1] * w[1] + s[2] * w[2] + s[3] * w[3]; if ((r & 7) == 7) asm volatile("" ::: "memory"); }
                }
            }
            __syncthreads();
#pragma unroll
            for (int r = 0; r < 33; ++r) red[(ty * 33 + r) * 64 + tx] = acc[r];
            __syncthreads();
            for (int i = F.tid; i < 33 * 64; i += NTHREADS) { const int r = i >> 6, x = i & 63; float s = 0.f;
#pragma unroll
                for (int y = 0; y < 8; ++y) s += red[(y * 33 + r) * 64 + x];
                const int col = col0 + x; s += bm[layer * 6144 + col];
                if (r < 32) F.wsp<float>(WS_MODL)[((size_t)layer * NB + r) * 6144 + col] = s; else F.wsp<float>(WS_MODC)[(size_t)layer * 6144 + col] = s; }
        }
    }
    __syncthreads();
    transpose_all(F);
    for (int a = 0; a < 2; ++a) {
        bf16_t* WLp = F.wsp<bf16_t>(WS_WL) + (size_t)a * 512 * K1CAT;
        if (a == 0) zero_rows(F, WLp, K1CAT, 384, 128, 0, K1CAT); else zero_rows(F, WLp, K1CAT, 416, 96, 0, K1CAT);
        zero_rows(F, F.wsp<bf16_t>(WS_G2T) + (size_t)a * D * 256, 256, 0, D, 128, 128);
    }
    zero_rows(F, F.wsp<bf16_t>(WS_V2T), 256, 0, D, 0, 128); zero_rows(F, F.wsp<bf16_t>(WS_V2T), 256, 0, D, 160, 96);
    {
        const float* src = F.in(33); bf16_t* dst = F.wsp<bf16_t>(WS_WSP); const long tot = (long)2 * 16 * 128 * 128 / 4;
        for (long i = (long)F.bid * NTHREADS + F.tid; i < tot; i += (long)F.G * NTHREADS) { const f32x4 v = *(const f32x4*)(src + i * 4); u32x2 w; w.x = pk2(v[0], v[1]); w.y = pk2(v[2], v[3]); *(u32x2*)(dst + i * 4) = w; }
    }
    __syncthreads();
}

__device__ __forceinline__ void phase_norm1(const Frame& F, int g, int layer  , bf16_t* dst, int ldh, bool dry = false) {
    bf16_t* X = F.wsp<bf16_t>(WS_X);
    const bf16_t* Y0 = F.ar<bf16_t>(AR_YM0); const bf16_t* Y1 = F.ar<bf16_t>(AR_YM1);
    const bool fin = layer == 4;
    for (int r = F.bid * NWAVES + F.wave; r < TG; r += F.G * NWAVES) {
        const int bl = r / LT, t = r % LT, b = g * BG + bl; const bool isctx = t < LC;
        if (isctx && layer >= 3) continue;
        f32x4 x[4], xo[4];
#pragma unroll
        for (int q = 0; q < 4; ++q) xo[q] = (f32x4){0.f, 0.f, 0.f, 0.f};
        if (layer == 0) {
            const float* src = isctx ? F.in(2) + ((size_t)b * LC + t) * D : F.in(0) + ((size_t)b * SEQ + (t - LC)) * D;
#pragma unroll
            for (int q = 0; q < 4; ++q) x[q] = *(const f32x4*)(src + q * 256 + F.lane * 4);
        } else {
            const float* gt = isctx ? F.modC(layer - 1, 5) : F.modL(layer - 1, b, 5);
#pragma unroll
            for (int q = 0; q < 4; ++q) { const int c = q * 256 + F.lane * 4;
                { const u32x2 xw = *(const u32x2*)(X + (size_t)r * D + c); x[q] = (f32x4){lo16(xw.x), hi16(xw.x), lo16(xw.y), hi16(xw.y)}; } xo[q] = x[q];
                const u32x2 a = *(const u32x2*)(Y0 + (size_t)r * D + c), bb = *(const u32x2*)(Y1 + (size_t)r * D + c);
                const f32x4 gv = *(const f32x4*)(gt + c);
                x[q][0] += gv[0] * (lo16(a.x) + lo16(bb.x)); x[q][1] += gv[1] * (hi16(a.x) + hi16(bb.x));
                x[q][2] += gv[2] * (lo16(a.y) + lo16(bb.y)); x[q][3] += gv[3] * (hi16(a.y) + hi16(bb.y)); }
        }
        float ss = 0.f;
#pragma unroll
        for (int q = 0; q < 4; ++q) ss += x[q][0] * x[q][0] + x[q][1] * x[q][1] + x[q][2] * x[q][2] + x[q][3] * x[q][3];
        ss = wave_sum(ss);
        const float rstd = rsqrtf(ss * (1.0f / D) + 1e-6f);
        if (fin) {
            float* o = F.outp() + ((size_t)b * SEQ + (t - LC)) * D; const float* fg = F.in(41);
#pragma unroll
            for (int q = 0; q < 4; ++q) { const int c = q * 256 + F.lane * 4; const f32x4 gv = *(const f32x4*)(fg + c); *(f32x4*)(o + c) = x[q] * rstd * gv; }
        } else {
            const float* gn = F.in(6) + (size_t)layer * D;
            const float* sh = isctx ? F.modC(layer, 0) : F.modL(layer, b, 0);
            const float* sc = isctx ? F.modC(layer, 1) : F.modL(layer, b, 1);
#pragma unroll
            for (int q = 0; q < 4; ++q) { const int c = q * 256 + F.lane * 4;
                { const f32x4 xs = (dry && layer > 0) ? xo[q] : x[q]; u32x2 xw; xw.x = pk2(xs[0], xs[1]); xw.y = pk2(xs[2], xs[3]); *(u32x2*)(X + (size_t)r * D + c) = xw; }
                const f32x4 gv = *(const f32x4*)(gn + c), sv = *(const f32x4*)(sh + c), cv = *(const f32x4*)(sc + c);
                const f32x4 h = x[q] * rstd * gv * (1.0f + cv) + sv;
                u32x2 w; w.x = pk2(h[0], h[1]); w.y = pk2(h[2], h[3]);
                *(u32x2*)(dst + (size_t)r * ldh + c) = w; }
        }
    }
}
__device__ __forceinline__ void phase_mix(const Frame& F, int a) {
    bf16_t* H2 = F.ar<bf16_t>(AR_H2); bf16_t* XM = F.ar<bf16_t>(AR_XR);
    const float* mu = F.in(8) + (size_t)a * 6 * D;
    for (int r = F.bid * NWAVES + F.wave; r < TG; r += F.G * NWAVES) {
        const int t = r % LT; const bool isctx = t < LC; const int p = t - LC;
#pragma unroll
        for (int q = 0; q < 2; ++q) {
            const int c = q * 512 + F.lane * 8;
            int nr;
            if (isctx) nr = (q == 0) ? (t > 0 ? r - 1 : -1) : (t < LC - 1 ? r + 1 : -1);
            else { const int qu = c >> 8;
                nr = qu == 0 ? ((p & 63) > 0 ? r - 1 : -1) : qu == 1 ? ((p & 63) < 63 ? r + 1 : -1) : qu == 2 ? (p >= 64 ? r - 64 : -1) : (p < SEQ - 64 ? r + 64 : -1); }
            const u32x4 hs = *(const u32x4*)(H2 + (size_t)r * 2048 + c);
            u32x4 hn = (u32x4){0u, 0u, 0u, 0u};
            if (nr >= 0) hn = *(const u32x4*)(H2 + (size_t)nr * 2048 + c);
            const float h[8] = {lo16(hs.x), hi16(hs.x), lo16(hs.y), hi16(hs.y), lo16(hs.z), hi16(hs.z), lo16(hs.w), hi16(hs.w)};
            const float n[8] = {lo16(hn.x), hi16(hn.x), lo16(hn.y), hi16(hn.y), lo16(hn.z), hi16(hn.z), lo16(hn.w), hi16(hn.w)};
            float dd[8];
#pragma unroll
            for (int e = 0; e < 8; ++e) dd[e] = n[e] - h[e];
            *(u32x4*)(H2 + (size_t)r * 2048 + 1024 + c) = (u32x4){pk2(dd[0], dd[1]), pk2(dd[2], dd[3]), pk2(dd[4], dd[5]), pk2(dd[6], dd[7])};
#pragma unroll
            for (int m = 0; m < 3; ++m) {
                const int mi = m == 0 ? 0 : (m == 1 ? 2 : 3);
                const f32x4 m0 = *(const f32x4*)(mu + mi * D + c), m1 = *(const f32x4*)(mu + mi * D + c + 4);
                float x[8];
#pragma unroll
                for (int e = 0; e < 4; ++e) { x[e] = h[e] + dd[e] * m0[e]; x[4 + e] = h[4 + e] + dd[4 + e] * m1[e]; }
                *(u32x4*)(XM + (size_t)m * TG * D + (size_t)r * D + c) = (u32x4){pk2(x[0], x[1]), pk2(x[2], x[3]), pk2(x[4], x[5]), pk2(x[6], x[7])};
            }
        }
    }
}
__device__ __forceinline__ void phase_vfix(const Frame& F) {
    bf16_t* V = F.ar<bf16_t>(AR_V); const bf16_t* VF = F.wsp<bf16_t>(WS_VF); const bf16_t* GT = F.ar<bf16_t>(AR_VGATE);
    const size_t tot = (size_t)TG * D / 8;
    for (size_t i = (size_t)F.bid * NTHREADS + F.tid; i < tot; i += (size_t)F.G * NTHREADS) {
        const u32x4 v = *(const u32x4*)(V + i * 8), f = *(const u32x4*)(VF + i * 8), g = *(const u32x4*)(GT + i * 8);
        u32x4 o;
        o.x = pk2(lo16(v.x) + (lo16(f.x) - lo16(v.x)) * lo16(g.x), hi16(v.x) + (hi16(f.x) - hi16(v.x)) * hi16(g.x));
        o.y = pk2(lo16(v.y) + (lo16(f.y) - lo16(v.y)) * lo16(g.y), hi16(v.y) + (hi16(f.y) - hi16(v.y)) * hi16(g.y));
        o.z = pk2(lo16(v.z) + (lo16(f.z) - lo16(v.z)) * lo16(g.z), hi16(v.z) + (hi16(f.z) - hi16(v.z)) * hi16(g.z));
        o.w = pk2(lo16(v.w) + (lo16(f.w) - lo16(v.w)) * lo16(g.w), hi16(v.w) + (hi16(f.w) - hi16(v.w)) * hi16(g.w));
        *(u32x4*)(V + i * 8) = o;
    }
}
__device__ __forceinline__ void phase_post(const Frame& F, int a, const bf16_t* V) {
    const bf16_t* Y0 = F.ar<bf16_t>(AR_Y0); bf16_t* YG = F.ar<bf16_t>(AR_R); const bf16_t* Y1 = F.ar<bf16_t>(AR_Y1); const float* DOT = F.ar<float>(AR_DOT); const bf16_t* Gb = F.ar<bf16_t>(AR_G);
    const float* lg = F.in(27) + (size_t)a * D; const float* lb = F.in(28) + (size_t)a * D;
    for (int r = F.bid * NWAVES + F.wave; r < TG; r += F.G * NWAVES) {
        const int c = F.lane * 16, h = F.lane >> 2;
        float y[16], vv[16];
#pragma unroll
        for (int q = 0; q < 2; ++q) {
            const u32x4 a0 = *(const u32x4*)(Y0 + (size_t)r * D + c + q * 8), a1 = *(const u32x4*)(Y1 + (size_t)r * D + c + q * 8), v4 = *(const u32x4*)(V + (size_t)r * D + c + q * 8);
            y[q * 8 + 0] = lo16(a0.x) + lo16(a1.x); y[q * 8 + 1] = hi16(a0.x) + hi16(a1.x); y[q * 8 + 2] = lo16(a0.y) + lo16(a1.y); y[q * 8 + 3] = hi16(a0.y) + hi16(a1.y);
            y[q * 8 + 4] = lo16(a0.z) + lo16(a1.z); y[q * 8 + 5] = hi16(a0.z) + hi16(a1.z); y[q * 8 + 6] = lo16(a0.w) + lo16(a1.w); y[q * 8 + 7] = hi16(a0.w) + hi16(a1.w);
            vv[q * 8 + 0] = lo16(v4.x); vv[q * 8 + 1] = hi16(v4.x); vv[q * 8 + 2] = lo16(v4.y); vv[q * 8 + 3] = hi16(v4.y);
            vv[q * 8 + 4] = lo16(v4.z); vv[q * 8 + 5] = hi16(v4.z); vv[q * 8 + 6] = lo16(v4.w); vv[q * 8 + 7] = hi16(v4.w);
        }
        float s = 0.f;
#pragma unroll
        for (int e = 0; e < 16; ++e) s += y[e];
        s = red4(s); const float mean = s * (1.0f / 64.0f);
        float qv = 0.f;
#pragma unroll
        for (int e = 0; e < 16; ++e) { const float dd = y[e] - mean; qv += dd * dd; }
        qv = red4(qv); const float rstd = rsqrtf(qv * (1.0f / 64.0f) + 64e-5f);
        const float dsum = DOT[(size_t)r * NH + h] + DOT[((size_t)TG + r) * NH + h];
        unsigned o[8];
        const u32x4 g0 = *(const u32x4*)(Gb + (size_t)r * D + c), g1 = *(const u32x4*)(Gb + (size_t)r * D + c + 8);
        const unsigned gw[8] = {g0.x, g0.y, g0.z, g0.w, g1.x, g1.y, g1.z, g1.w};
#pragma unroll
        for (int e = 0; e < 16; e += 2) {
            const float o0 = ((y[e] - mean) * rstd * lg[c + e] + lb[c + e] + vv[e] * dsum) * lo16(gw[e >> 1]);
            const float o1 = ((y[e + 1] - mean) * rstd * lg[c + e + 1] + lb[c + e + 1] + vv[e + 1] * dsum) * hi16(gw[e >> 1]);
            o[e >> 1] = pk2(o0, o1);
        }
        *(u32x4*)(YG + (size_t)r * D + c) = (u32x4){o[0], o[1], o[2], o[3]};
        *(u32x4*)(YG + (size_t)r * D + c + 8) = (u32x4){o[4], o[5], o[6], o[7]};
    }
}
__device__ __forceinline__ void phase_norm2(const Frame& F, int g, int layer, bool dry = false) {
    bf16_t* X = F.wsp<bf16_t>(WS_X); bf16_t* HM = F.ar<bf16_t>(AR_HM); const bf16_t* Ob = F.ar<bf16_t>(AR_O);
    int* lists = dry ? F.ar<int>(AR_YM0) : F.ar<int>(AR_LIST); float* lwt = dry ? F.ar<float>(AR_YM0) + (size_t)32 * TG : F.ar<float>(AR_LW);
    unsigned* cnt = (unsigned*)(F.ws + WS_CTL + CTL_CNT_OFF) + (((size_t)g * 4 + layer) * 32 + (dry ? NG * 4 * 32 : 0)) * 16;
    LAS float* wr = (LAS float*)F.lds;
    __syncthreads();
    for (int i = F.tid; i < D * NEXP / 4; i += NTHREADS) { const int c = i >> 2, e4 = i & 3; const int rho = (c & ~255) + (c & 3) * 64 + ((c & 255) >> 2);
        *(LAS f32x4*)(wr + rho * 20 + e4 * 4) = *(const f32x4*)(F.in(36) + i * 4); }
    __syncthreads();
    const float* rbias = F.in(37);
    const bool ctx_out = layer < 2;
    LAS int* lcnt = (LAS int*)(F.lds + LDS_MISC + 512);
    LAS int* lbase = (LAS int*)(F.lds + LDS_MISC + 640);
    LAS int* rec = (LAS int*)(F.lds + 81920);
    const int niter = (TG + F.G * NWAVES - 1) / (F.G * NWAVES);
    for (int it0 = 0; it0 < niter; it0 += 64) {
        if (F.tid < 32) lcnt[F.tid] = 0;
        __syncthreads();
        const int itn = (niter - it0) < 64 ? (niter - it0) : 64;
        for (int itl = 0; itl < itn; ++itl) {
            const int r = (F.bid + (it0 + itl) * F.G) * NWAVES + F.wave;
            const int bl = r / LT, t = r % LT, b = g * BG + bl; const bool isctx = t < LC;
            const int slot = itl * NWAVES + F.wave;
            if (r >= TG || (isctx && !ctx_out)) { if (F.lane == 0) rec[slot * 4] = -1; continue; }
            f32x4 x[4]; float ss = 0.f;
            const float* gt1 = isctx ? F.modC(layer, 2) : F.modL(layer, b, 2);
#pragma unroll
            for (int q = 0; q < 4; ++q) { const int c = q * 256 + F.lane * 4;
                { const u32x2 xw = *(const u32x2*)(X + (size_t)r * D + c); x[q] = (f32x4){lo16(xw.x), hi16(xw.x), lo16(xw.y), hi16(xw.y)}; }
                const u32x2 ob = *(const u32x2*)(Ob + (size_t)r * D + c); const f32x4 gv = *(const f32x4*)(gt1 + c);
                const f32x4 xo = x[q];
                x[q][0] += gv[0] * lo16(ob.x); x[q][1] += gv[1] * hi16(ob.x); x[q][2] += gv[2] * lo16(ob.y); x[q][3] += gv[3] * hi16(ob.y);
                { const f32x4 xs = dry ? xo : x[q]; u32x2 xw; xw.x = pk2(xs[0], xs[1]); xw.y = pk2(xs[2], xs[3]); *(u32x2*)(X + (size_t)r * D + c) = xw; }
                ss += x[q][0] * x[q][0] + x[q][1] * x[q][1] + x[q][2] * x[q][2] + x[q][3] * x[q][3]; }
            ss = wave_sum(ss);
            const float rstd = rsqrtf(ss * (1.0f / D) + 1e-6f);
            const float* gn = F.in(7) + (size_t)layer * D;
            const float* sh = isctx ? F.modC(layer, 3) : F.modL(layer, b, 3);
            const float* sc = isctx ? F.modC(layer, 4) : F.modL(layer, b, 4);
            float lg[16];
#pragma unroll
            for (int e = 0; e < 16; ++e) lg[e] = 0.f;
#pragma unroll
            for (int q = 0; q < 4; ++q) { const int c = q * 256 + F.lane * 4;
                const f32x4 gv = *(const f32x4*)(gn + c), sv = *(const f32x4*)(sh + c), cv = *(const f32x4*)(sc + c);
                const f32x4 h = x[q] * rstd * gv * (1.0f + cv) + sv;
                u32x2 w; w.x = pk2(h[0], h[1]); w.y = pk2(h[2], h[3]);
                *(u32x2*)(HM + (size_t)r * D + c) = w;
#pragma unroll
                for (int j = 0; j < 4; ++j) {
#pragma unroll
                    for (int e4 = 0; e4 < 4; ++e4) { const f32x4 wv = *(const LAS f32x4*)(wr + (q * 256 + j * 64 + F.lane) * 20 + e4 * 4);
                        lg[e4 * 4 + 0] += h[j] * wv[0]; lg[e4 * 4 + 1] += h[j] * wv[1]; lg[e4 * 4 + 2] += h[j] * wv[2]; lg[e4 * 4 + 3] += h[j] * wv[3]; } }
            }
#pragma unroll
            for (int e = 0; e < 16; ++e) lg[e] = wave_sum_dpp(lg[e]);
            float sc_[16], bs[16];
#pragma unroll
            for (int e = 0; e < 16; ++e) { sc_[e] = sigmoidf_(lg[e]); bs[e] = sc_[e] + rbias[e]; }
            float gs[4];
#pragma unroll
            for (int gq = 0; gq < 4; ++gq) { float m1 = -1e30f, m2 = -1e30f;
#pragma unroll
                for (int j = 0; j < 4; ++j) { const float v = bs[gq * 4 + j]; if (v > m1) { m2 = m1; m1 = v; } else if (v > m2) m2 = v; }
                gs[gq] = m1 + m2; }
            int best = 0; float bv = gs[0];
#pragma unroll
            for (int gq = 1; gq < 4; ++gq) if (gs[gq] > bv) { bv = gs[gq]; best = gq; }
            float cb[4], cs[4];
#pragma unroll
            for (int j = 0; j < 4; ++j) { cb[j] = best == 0 ? bs[j] : best == 1 ? bs[4 + j] : best == 2 ? bs[8 + j] : bs[12 + j]; cs[j] = best == 0 ? sc_[j] : best == 1 ? sc_[4 + j] : best == 2 ? sc_[8 + j] : sc_[12 + j]; }
            int j1 = 0; float v1 = cb[0];
#pragma unroll
            for (int j = 1; j < 4; ++j) if (cb[j] > v1) { v1 = cb[j]; j1 = j; }
            int j2 = -1; float v2 = -1e30f;
#pragma unroll
            for (int j = 0; j < 4; ++j) if (j != j1 && cb[j] > v2) { v2 = cb[j]; j2 = j; }
            const float s1 = j1 == 0 ? cs[0] : j1 == 1 ? cs[1] : j1 == 2 ? cs[2] : cs[3];
            const float s2 = j2 == 0 ? cs[0] : j2 == 1 ? cs[1] : j2 == 2 ? cs[2] : cs[3];
            const float inv = __builtin_amdgcn_rcpf(s1 + s2);
            if (F.lane == 0) {
                const int l1 = (best * 4 + j1) * 2 + 0, l2 = (best * 4 + j2) * 2 + 1;
                const int p1 = __hip_atomic_fetch_add(lcnt + l1, 1, __ATOMIC_RELAXED, __HIP_MEMORY_SCOPE_WORKGROUP);
                const int p2 = __hip_atomic_fetch_add(lcnt + l2, 1, __ATOMIC_RELAXED, __HIP_MEMORY_SCOPE_WORKGROUP);
                rec[slot * 4 + 0] = l1 | (p1 << 8); rec[slot * 4 + 1] = l2 | (p2 << 8);
                rec[slot * 4 + 2] = __float_as_int(s1 * inv); rec[slot * 4 + 3] = __float_as_int(s2 * inv);
            }
        }
        __syncthreads();
        if (F.tid < 32) { const int c = lcnt[F.tid]; lbase[F.tid] = c ? (int)atomicAdd(&cnt[F.tid * 16], (unsigned)c) : 0; }
        __syncthreads();
        for (int slot = F.tid; slot < itn * NWAVES; slot += NTHREADS) {
            const int a0 = rec[slot * 4 + 0]; if (a0 < 0) continue;
            const int a1 = rec[slot * 4 + 1];
            const int r = (F.bid + (it0 + slot / NWAVES) * F.G) * NWAVES + (slot % NWAVES);
            const int l1 = a0 & 255, l2 = a1 & 255; const int q1 = lbase[l1] + (a0 >> 8), q2 = lbase[l2] + (a1 >> 8);
            lists[(size_t)l1 * TG + q1] = r; lwt[(size_t)l1 * TG + q1] = __int_as_float(rec[slot * 4 + 2]);
            lists[(size_t)l2 * TG + q2] = r; lwt[(size_t)l2 * TG + q2] = __int_as_float(rec[slot * 4 + 3]);
        }
        __syncthreads();
    }
}
__device__ __forceinline__ int moe_tables(const Frame& F, int g, int layer) {
    LAS int* cn = (LAS int*)(F.lds + LDS_MISC + 64); LAS int* tb = (LAS int*)(F.lds + LDS_MISC + 192);
    const unsigned* cnt = (const unsigned*)(F.ws + WS_CTL + CTL_CNT_OFF) + ((size_t)g * 4 + layer) * 32 * 16;
    __syncthreads();
    if (F.tid == 0) { int acc = 0; for (int l = 0; l < 32; ++l) { const int c = (int)__hip_atomic_load(cnt + l * 16, __ATOMIC_RELAXED, __HIP_MEMORY_SCOPE_AGENT); cn[l] = c; tb[l] = acc; acc += (c + 255) >> 8; } tb[32] = acc; }
    __syncthreads();
    return tb[32];
}

constexpr int SC_OPB = 6 * 4096;
constexpr int SC_HALF = 2 * SC_OPB + 4096 + 4096;
static_assert(2 * SC_HALF <= LDS_STAGE, "scan lds");
__device__ __forceinline__ int scan_tok(int d, int s) { return d == 0 ? s : (s < LC ? (LC - 1 - s) : (LT + LC - 1 - s)); }
__device__ __forceinline__ void phase_scan(const Frame& F, int a, const bf16_t* V) {
    const bf16_t* R = F.ar<bf16_t>(AR_R); const bf16_t* Kb = F.ar<bf16_t>(AR_K); const bf16_t* L1 = F.ar<bf16_t>(AR_L1);
    const int half = F.wave >> 2, q = F.wave & 3, lane = F.lane, li = q * 64 + lane;
    LAS unsigned char* hb = F.lds + half * SC_HALF;
    LAS float* aT = (LAS float*)(hb + 2 * SC_OPB); LAS float* ybuf = (LAS float*)(hb + 2 * SC_OPB + 4096);
    const int arr = q >> 1, ntl = (q & 1) * 2;
    const int i = lane >> 3, j = lane & 7, r0 = 16 * q + 2 * i;
    const int tB = li >> 4, k4 = (li & 15) * 4;
    for (int pr = F.bid; pr < BG * 16; pr += F.G) {
        const int bl = pr >> 4, d = (pr >> 3) & 1, hp = pr & 7, h = hp * 2 + half;
        bf16_t* Yd = F.ar<bf16_t>(d ? AR_Y1 : AR_Y0); float* DOT = F.ar<float>(AR_DOT) + (size_t)d * TG * NH;
        const size_t rowb = (size_t)bl * LT;
        const bf16_t* W2 = (arr == 0 ? F.wsp<bf16_t>(WS_W2T) : F.wsp<bf16_t>(WS_A2T)) + ((size_t)a * 2 + d) * D * 64;
        bf16x8 Bf[2][2]; float bias[2];
#pragma unroll
        for (int nt = 0; nt < 2; ++nt) { const int cc = h * 64 + (ntl + nt) * 16 + (lane & 15);
            bias[nt] = (arr == 0 ? F.in(13) : F.in(16))[((size_t)a * 2 + d) * D + cc];
#pragma unroll
            for (int s = 0; s < 2; ++s) Bf[nt][s] = *(const bf16x8*)(W2 + (size_t)cc * 64 + 32 * s + 8 * (lane >> 4)); }
        const f32x4 kkc = *(const f32x4*)(F.in(24) + (size_t)a * D + h * 64 + k4), kac = *(const f32x4*)(F.in(25) + (size_t)a * D + h * 64 + k4), rkc = *(const f32x4*)(F.in(26) + (size_t)a * D + h * 64 + k4);
        const int acol = arr * 128 + d * 64 + 8 * (lane >> 4);
        float S0[8], S1[8];
#pragma unroll
        for (int c = 0; c < 8; ++c) { S0[c] = 0.f; S1[c] = 0.f; }
        bf16x8 Af[2]; u32x2 kraw, rraw, vraw;
#define SC_LOAD(ch) do { const size_t rowA = rowb + scan_tok(d, (ch) * 16 + (lane & 15)); \
        Af[0] = *(const bf16x8*)(L1 + rowA * 512 + acol); Af[1] = *(const bf16x8*)(L1 + rowA * 512 + acol + 32); \
        const size_t rowBq = (rowb + scan_tok(d, (ch) * 16 + tB)) * D + h * 64 + k4; \
        kraw = *(const u32x2*)(Kb + rowBq); rraw = *(const u32x2*)(R + rowBq); vraw = *(const u32x2*)(V + rowBq); } while (0)
#define SC_PASSA(buf) do { LAS float* op = (LAS float*)(hb + (buf) * SC_OPB); \
        _Pragma("unroll") for (int nt = 0; nt < 2; ++nt) { f32x4 ac = (f32x4){0.f, 0.f, 0.f, 0.f}; \
            ac = __builtin_amdgcn_mfma_f32_16x16x32_bf16(Af[0], Bf[nt][0], ac, 0, 0, 0); ac = __builtin_amdgcn_mfma_f32_16x16x32_bf16(Af[1], Bf[nt][1], ac, 0, 0, 0); \
            const int n = (ntl + nt) * 16 + (lane & 15); \
              \
            f32x4 sg; _Pragma("unroll") for (int rg = 0; rg < 4; ++rg) sg[rg] = sigmoidf_(ac[rg] + bias[nt]); \
            if (arr == 0) { _Pragma("unroll") for (int rg = 0; rg < 4; ++rg) op[1024 + ((lane >> 4) * 4 + rg) * 64 + n] = __expf(-0.60653066f * sg[rg]); } \
            else { _Pragma("unroll") for (int rg = 0; rg < 4; ++rg) aT[((lane >> 4) * 4 + rg) * 64 + n] = sg[rg]; } } } while (0)
#define SC_PASSB(ch, buf) do { LAS float* op = (LAS float*)(hb + (buf) * SC_OPB); \
        const float kf[4] = {lo16(kraw.x), hi16(kraw.x), lo16(kraw.y), hi16(kraw.y)}; const float rf[4] = {lo16(rraw.x), hi16(rraw.x), lo16(rraw.y), hi16(rraw.y)}; \
        const float vf[4] = {lo16(vraw.x), hi16(vraw.x), lo16(vraw.y), hi16(vraw.y)}; \
        const f32x4 av = *(const LAS f32x4*)(aT + tB * 64 + k4); \
        float kq[4], ssq = 0.f; _Pragma("unroll") for (int e = 0; e < 4; ++e) { kq[e] = kf[e] * kkc[e]; ssq += kq[e] * kq[e]; } \
        ssq = red16(ssq); const float inv = __builtin_amdgcn_rsqf(fmaxf(ssq, 1e-24f)); \
        f32x4 o_kk, o_kka, o_kd, o_r, o_v; float dp = 0.f; \
        _Pragma("unroll") for (int e = 0; e < 4; ++e) { const float kkv = kq[e] * inv; const float kd = kf[e] * (1.0f + (av[e] - 1.0f) * kac[e]); \
            o_kk[e] = kkv; o_kka[e] = kkv * av[e]; o_kd[e] = kd; o_r[e] = rf[e]; o_v[e] = vf[e]; dp += rf[e] * kd * rkc[e]; } \
        dp = red16(dp); \
        if ((li & 15) == 0) DOT[(rowb + scan_tok(d, (ch) * 16 + tB)) * NH + h] = dp; \
        *(LAS f32x4*)(op + 0 * 1024 + tB * 64 + k4) = o_kk; *(LAS f32x4*)(op + 2 * 1024 + tB * 64 + k4) = o_kka; *(LAS f32x4*)(op + 3 * 1024 + tB * 64 + k4) = o_kd; \
        *(LAS f32x4*)(op + 4 * 1024 + tB * 64 + k4) = o_r; *(LAS f32x4*)(op + 5 * 1024 + tB * 64 + k4) = o_v; } while (0)
        __syncthreads();
        SC_LOAD(0);
        SC_PASSA(0);
        __syncthreads();
        SC_PASSB(0, 0);
        __syncthreads();
        constexpr int NCH = LT / 16;
        for (int ch = 0; ch < NCH; ++ch) {
            const int buf = ch & 1;
            if (ch + 1 < NCH) SC_LOAD(ch + 1);
            const LAS float* op = (const LAS float*)(hb + buf * SC_OPB);
            f32x4 cA[5], cB[5], nA[5], nB[5]; f32x2 cv, nv;
#define SC_OPLOAD(dA, dB, dv, t) do { const LAS float* ob_ = op + (t) * 64 + j * 8; \
                _Pragma("unroll") for (int q_ = 0; q_ < 5; ++q_) { dA[q_] = *(const LAS f32x4*)(ob_ + q_ * 1024); dB[q_] = *(const LAS f32x4*)(ob_ + q_ * 1024 + 4); } \
                dv = *(const LAS f32x2*)(op + 5 * 1024 + (t) * 64 + r0); } while (0)
            SC_OPLOAD(cA, cB, cv, 0);
#pragma unroll
            for (int t = 0; t < 16; ++t) {
                if (t + 1 < 16) SC_OPLOAD(nA, nB, nv, t + 1);
                const float kk[8] = {cA[0][0], cA[0][1], cA[0][2], cA[0][3], cB[0][0], cB[0][1], cB[0][2], cB[0][3]};
                const float dc[8] = {cA[1][0], cA[1][1], cA[1][2], cA[1][3], cB[1][0], cB[1][1], cB[1][2], cB[1][3]};
                const float ka[8] = {cA[2][0], cA[2][1], cA[2][2], cA[2][3], cB[2][0], cB[2][1], cB[2][2], cB[2][3]};
                const float kd[8] = {cA[3][0], cA[3][1], cA[3][2], cA[3][3], cB[3][0], cB[3][1], cB[3][2], cB[3][3]};
                const float rr[8] = {cA[4][0], cA[4][1], cA[4][2], cA[4][3], cB[4][0], cB[4][1], cB[4][2], cB[4][3]};
                float sa0 = (S0[0] * kk[0] + S0[1] * kk[1]) + (S0[2] * kk[2] + S0[3] * kk[3]) + ((S0[4] * kk[4] + S0[5] * kk[5]) + (S0[6] * kk[6] + S0[7] * kk[7]));
                float sa1 = (S1[0] * kk[0] + S1[1] * kk[1]) + (S1[2] * kk[2] + S1[3] * kk[3]) + ((S1[4] * kk[4] + S1[5] * kk[5]) + (S1[6] * kk[6] + S1[7] * kk[7]));
                sa0 = red8(sa0); sa1 = red8(sa1);
#pragma unroll
                for (int c = 0; c < 8; ++c) {
                    S0[c] = S0[c] * dc[c] + (cv[0] * kd[c] - sa0 * ka[c]);
                    S1[c] = S1[c] * dc[c] + (cv[1] * kd[c] - sa1 * ka[c]);
                }
                float y0 = (S0[0] * rr[0] + S0[1] * rr[1]) + (S0[2] * rr[2] + S0[3] * rr[3]) + ((S0[4] * rr[4] + S0[5] * rr[5]) + (S0[6] * rr[6] + S0[7] * rr[7]));
                float y1 = (S1[0] * rr[0] + S1[1] * rr[1]) + (S1[2] * rr[2] + S1[3] * rr[3]) + ((S1[4] * rr[4] + S1[5] * rr[5]) + (S1[6] * rr[6] + S1[7] * rr[7]));
                y0 = red8(y0); y1 = red8(y1);
                if (j == 0) *(LAS f32x2*)(ybuf + t * 64 + r0) = (f32x2){y0, y1};
#pragma unroll
                for (int q_ = 0; q_ < 5; ++q_) { cA[q_] = nA[q_]; cB[q_] = nB[q_]; }
                cv = nv;
            }
#undef SC_OPLOAD
            __syncthreads();
            {
                const f32x4 yv = *(const LAS f32x4*)(ybuf + tB * 64 + k4);
                u32x2 w; w.x = pk2(yv[0], yv[1]); w.y = pk2(yv[2], yv[3]);
                *(u32x2*)(Yd + (rowb + scan_tok(d, ch * 16 + tB)) * D + h * 64 + k4) = w;
            }
            if (ch + 1 < NCH) SC_PASSA(buf ^ 1);
            __syncthreads();
            if (ch + 1 < NCH) SC_PASSB(ch + 1, buf ^ 1);
            __syncthreads();
        }
#undef SC_LOAD
#undef SC_PASSA
#undef SC_PASSB
    }
}

__device__ __forceinline__ void phase_sgstats(const Frame& F, int layer) {
    const bf16_t* Z = F.ar<bf16_t>(AR_Z); float* ST = F.ar<float>(AR_ST);
    for (int r = F.bid * NWAVES + F.wave; r < TG; r += F.G * NWAVES) {
        const int t = r % LT; if (t < LC && layer >= 3) continue;
        float x[32];
#pragma unroll
        for (int q = 0; q < 4; ++q) { const u32x4 w = *(const u32x4*)(Z + (size_t)r * 4096 + 2048 + q * 512 + F.lane * 8);
            x[q * 8 + 0] = lo16(w.x); x[q * 8 + 1] = hi16(w.x); x[q * 8 + 2] = lo16(w.y); x[q * 8 + 3] = hi16(w.y); x[q * 8 + 4] = lo16(w.z); x[q * 8 + 5] = hi16(w.z); x[q * 8 + 6] = lo16(w.w); x[q * 8 + 7] = hi16(w.w); }
        float s = 0.f;
#pragma unroll
        for (int e = 0; e < 32; ++e) s += x[e];
        s = wave_sum(s); const float mean = s * (1.0f / 2048.0f);
        float qv = 0.f;
#pragma unroll
        for (int e = 0; e < 32; ++e) { const float dd = x[e] - mean; qv += dd * dd; }
        qv = wave_sum(qv);
        if (F.lane == 0) *(f32x2*)(ST + (size_t)r * 2) = (f32x2){mean, rsqrtf(qv * (1.0f / 2048.0f) + 1e-5f)};
    }
}
__device__ __forceinline__ int vt_off(int dch, int jb) { return dch * 256 + ((jb ^ ((dch & 15) ^ (((dch >> 4) & 7) << 1))) << 4); }
__device__ __forceinline__ void phase_spatial(const Frame& F, int bsg, int layer) {
    const bf16_t* Z = F.ar<bf16_t>(AR_Z); const float* ST = F.ar<float>(AR_ST); bf16_t* Pb = F.ar<bf16_t>(AR_P);
    const bf16_t* Ws = F.wsp<bf16_t>(WS_WSP) + (size_t)bsg * 16 * 128 * 128;
    const float* lng = F.in(31) + (size_t)bsg * 2048; const float* lnb = F.in(32) + (size_t)bsg * 2048; const float* bs = F.in(34) + (size_t)bsg * 16 * 128;
    LAS unsigned char* vt = F.lds;
    const int skip = layer >= 3;
    const int nchunk = skip ? BG * 16 : BG * 18;
    const int w = F.wave, lane = F.lane, dt = w >> 1, it0 = (w & 1) * 2;
    for (int U = F.bid; U < nchunk * 16; U += F.G) {
        const int lc = U >> 4, gi = U & 15;
        const int chunk = skip ? (lc >> 4) * 18 + 2 + (lc & 15) : lc;
        const size_t row0 = (size_t)chunk * 128;
        __syncthreads();
#pragma unroll
        for (int k = 0; k < 4; ++k) {
            const int p = F.tid + 512 * k, jj = p >> 4, c8 = (p & 15) * 8;
            const u32x4 zz = *(const u32x4*)(Z + (row0 + jj) * 4096 + 2048 + gi * 128 + c8);
            const f32x2 st = *(const f32x2*)(ST + (row0 + jj) * 2);
            const float xv[8] = {lo16(zz.x), hi16(zz.x), lo16(zz.y), hi16(zz.y), lo16(zz.z), hi16(zz.z), lo16(zz.w), hi16(zz.w)};
#pragma unroll
            for (int e = 0; e < 8; ++e) { const int dch = c8 + e; const float val = (xv[e] - st[0]) * st[1] * lng[gi * 128 + dch] + lnb[gi * 128 + dch];
                *(LAS unsigned short*)(vt + vt_off(dch, jj >> 3) + (jj & 7) * 2) = f2bf(val); }
        }
        __syncthreads();
        f32x16 acc0, acc1;
#pragma unroll
        for (int e = 0; e < 16; ++e) { acc0[e] = 0.f; acc1[e] = 0.f; }
        const int dA = dt * 32 + (lane & 31);
        const bf16_t* w0p = Ws + ((size_t)gi * 128 + it0 * 32 + (lane & 31)) * 128 + 8 * (lane >> 5);
#pragma unroll
        for (int s = 0; s < 8; ++s) {
            const bf16x8 Afr = *(const LAS bf16x8*)(vt + vt_off(dA, 2 * s + (lane >> 5)));
            const bf16x8 B0 = *(const bf16x8*)(w0p + 16 * s), B1 = *(const bf16x8*)(w0p + 32 * 128 + 16 * s);
            acc0 = __builtin_amdgcn_mfma_f32_32x32x16_bf16(Afr, B0, acc0, 0, 0, 0);
            acc1 = __builtin_amdgcn_mfma_f32_32x32x16_bf16(Afr, B1, acc1, 0, 0, 0);
        }
#pragma unroll
        for (int it = 0; it < 2; ++it) {
            const int ii = (it0 + it) * 32 + (lane & 31); const size_t row = row0 + ii; const float bias = bs[gi * 128 + ii];
#pragma unroll
            for (int rq = 0; rq < 4; ++rq) {
                const int d0 = dt * 32 + 8 * rq + 4 * (lane >> 5);
                const u32x2 uu = *(const u32x2*)(Z + row * 4096 + gi * 128 + d0);
                float vs[4];
#pragma unroll
                for (int e = 0; e < 4; ++e) vs[e] = (it == 0 ? acc0[rq * 4 + e] : acc1[rq * 4 + e]) + bias;
                u32x2 o; o.x = pk2(lo16(uu.x) * vs[0], hi16(uu.x) * vs[1]); o.y = pk2(lo16(uu.y) * vs[2], hi16(uu.y) * vs[3]);
                *(u32x2*)(Pb + row * 2048 + gi * 128 + d0) = o;
            }
        }
    }
    __syncthreads();
}

__global__ void __launch_bounds__(NTHREADS, 2) fwd_kernel(Params P) {
    extern __shared__ __attribute__((aligned(16))) unsigned char lds_raw[];
    Frame F; F.lds = (LAS unsigned char*)lds_raw; F.tid = threadIdx.x; F.lane = F.tid & 63; F.wave = __builtin_amdgcn_readfirstlane(F.tid >> 6);
    F.G = gridDim.x; F.bid = blockIdx.x; F.ws = P.ws; F.kp = (const Params __attribute__((address_space(4)))*)__builtin_amdgcn_kernarg_segment_ptr();
    const int lo = P.ph_lo, hi = P.ph_hi;
    volatile LAS unsigned* misc = (volatile LAS unsigned*)(F.lds + LDS_MISC);
    if (F.tid < 4) misc[F.tid] = 0u;
    __syncthreads();
    XcdBarrier bar; bar.bar = (unsigned*)(F.ws + WS_CTL); bar.x = 0; bar.st = misc;
    if (hi - lo > 1) bar = xcd_barrier_post((unsigned*)(F.ws + WS_CTL), misc);
    int ph = 0;
#define RUN(id, ...) do { if (ph >= lo && ph < hi) { const int nrep_ = ((REP_MASK >> (id)) & 1u) ? 2 : 1; for (int rep_ = 0; rep_ < nrep_; ++rep_) { const bool dry_ = (rep_ + 1 < nrep_); (void)dry_; { int t_ = threadIdx.x; const Params __attribute__((address_space(4)))* kp_ = (const Params __attribute__((address_space(4)))*)__builtin_amdgcn_kernarg_segment_ptr(); asm volatile("" : "+v"(t_), "+s"(kp_)); F.tid = t_; F.lane = t_ & 63; F.kp = kp_; F.ws = kp_->ws; } __VA_ARGS__; if (rep_ + 1 < nrep_ || ph + 1 < hi) xcd_barrier(bar); } } ++ph; } while (0)

    RUN(0, phase_prologue(F));
    for (int g = 0; g < NG; ++g) {
        for (int layer = 0; layer < 4; ++layer) {
            const int a = layer >> 1;
            if ((layer & 1) == 0) {
                const bf16_t* Vc = layer == 0 ? F.wsp<bf16_t>(WS_VF) : F.ar<bf16_t>(AR_V);
                RUN(1, phase_norm1(F, g, layer, F.ar<bf16_t>(AR_H2), 2048, dry_));
                RUN(2, phase_mix(F, a));
                RUN(3, { { pg8::SchedPlain S; S.init(TG / 256, 2, F.G, F.bid, 0);
                        EpiL1 E{F.ar<bf16_t>(AR_L1)};
                        pg8::gemm_phase(F.tid, F.lds, F.ar<bf16_t>(AR_H2), K1CAT, F.wsp<bf16_t>(WS_WL) + (size_t)a * 512 * K1CAT, K1CAT, K1CAT, S, E); }
                      { pg8::SchedRKV S; S.init(TG / 256, 12, F.G, (F.bid + 192) % F.G, 0);
                        EpiRKV E{F.ws, layer == 0 ? WS_VF : WS_ARENA + AR_V};
                        pg8::gemm_phase(F.tid, F.lds, F.ar<bf16_t>(AR_XR), D, F.wsp<bf16_t>(WS_WRKV) + (size_t)a * 3072 * D, D, D, S, E); } });
                if (layer == 2) {
                    RUN(4, { pg8::SchedPlain S; S.init(TG / 256, 4, F.G, F.bid, 0);
                          EpiStore<1> E{F.ar<bf16_t>(AR_VGATE), F.in(19)};
                          pg8::gemm_phase(F.tid, F.lds, F.ar<bf16_t>(AR_L1) + 256, 512, F.wsp<bf16_t>(WS_V2T), 256, 256, S, E); });
                    RUN(5, phase_vfix(F));
                }
                RUN(6, phase_scan(F, a, Vc));
                RUN(7, { pg8::SchedPlain S; S.init(TG / 256, 4, F.G, F.bid, 0);
                      EpiStore<0> E{F.ar<bf16_t>(AR_G), nullptr};
                      pg8::gemm_phase(F.tid, F.lds, F.ar<bf16_t>(AR_L1) + 256, 512, F.wsp<bf16_t>(WS_G2T) + (size_t)a * D * 256, 256, 256, S, E); });
                RUN(8, phase_post(F, a, Vc));
                RUN(9, { const int skip = layer == 2; pg8::SchedPlain S; S.init(skip ? BG * 8 : TG / 256, 4, F.G, F.bid, skip);
                      EpiStore<0> E{F.ar<bf16_t>(AR_O), nullptr};
                      pg8::gemm_phase(F.tid, F.lds, F.ar<bf16_t>(AR_R), D, F.wsp<bf16_t>(WS_WO) + (size_t)a * D * D, D, D, S, E); });
            } else {
                const int skip = layer == 3;
                RUN(10, phase_norm1(F, g, layer, F.ar<bf16_t>(AR_H), D, dry_));
                RUN(11, { pg8::SchedPlain S; S.init(skip ? BG * 8 : TG / 256, 16, F.G, F.bid, skip);
                      EpiGelu E{F.ar<bf16_t>(AR_Z), F.in(30) + (size_t)a * 4096};
                      pg8::gemm_phase(F.tid, F.lds, F.ar<bf16_t>(AR_H), D, F.wsp<bf16_t>(WS_WIN) + (size_t)a * 4096 * D, D, D, S, E); });
                RUN(12, phase_sgstats(F, layer));
                RUN(13, phase_spatial(F, a, layer));
                RUN(14, { pg8::SchedPlain S; S.init(skip ? BG * 8 : TG / 256, 4, F.G, F.bid, skip);
                      EpiStore<0> E{F.ar<bf16_t>(AR_O), nullptr};
                      pg8::gemm_phase(F.tid, F.lds, F.ar<bf16_t>(AR_P), 2048, F.wsp<bf16_t>(WS_WOUT) + (size_t)a * D * 2048, 2048, 2048, S, E); });
            }
            RUN(15, phase_norm2(F, g, layer, dry_));
            RUN(16, { const int total = moe_tables(F, g, layer);
                  pg8::SchedMoe<true> S{(const LAS int*)(F.lds + LDS_MISC + 64), (const LAS int*)(F.lds + LDS_MISC + 192), F.ar<int>(AR_LIST), F.G, F.bid, total};
                  EpiMG E{F.ar<bf16_t>(AR_HE)};
                  pg8::gemm_phase(F.tid, F.lds, F.ar<bf16_t>(AR_HM), D, F.wsp<bf16_t>(WS_WGU) + (size_t)layer * NEXP * 1024 * D, D, D, S, E); });
            RUN(17, { const int total = moe_tables(F, g, layer);
                  pg8::SchedMoe<false> S{(const LAS int*)(F.lds + LDS_MISC + 64), (const LAS int*)(F.lds + LDS_MISC + 192), F.ar<int>(AR_LIST), F.G, F.bid, total};
                  EpiMD E{F.ar<bf16_t>(AR_YM0), F.ar<int>(AR_LIST), F.ar<float>(AR_LW), (const LAS int*)(F.lds + LDS_MISC + 64)};
                  pg8::gemm_phase(F.tid, F.lds, F.ar<bf16_t>(AR_HE), FEXP, F.wsp<bf16_t>(WS_WD) + (size_t)layer * NEXP * D * FEXP, FEXP, FEXP, S, E); });
        }
        RUN(18, phase_norm1(F, g, 4, nullptr, 0));
    }
#undef RUN
}
constexpr int NPHASES = 1 + NG * (10 + 8 + 12 + 8 + 1);

__global__ void nan_fill(float* out, size_t n) { for (size_t i = (size_t)blockIdx.x * blockDim.x + threadIdx.x; i < n; i += (size_t)gridDim.x * blockDim.x) out[i] = __uint_as_float(0x7FC00000u); }

extern "C" void kernel_launch(void* const* d_in, const int* in_sizes, int n_in, void* d_out, int out_size, void* d_ws, size_t ws_size, hipStream_t stream) {
    static int grid = 0;
    if (grid == 0) {
        int dev = 0, cus = 0, per_cu = 0;
        if (n_in != 42 || ws_size < WS_END || hipGetDevice(&dev) != hipSuccess || hipDeviceGetAttribute(&cus, hipDeviceAttributeMultiprocessorCount, dev) != hipSuccess) {
            fprintf(stderr, "kernel_launch: bad setup (n_in %d, ws %zu need %zu)\n", n_in, ws_size, (size_t)WS_END); grid = -1;
        } else if (hipFuncSetAttribute((const void*)fwd_kernel, hipFuncAttributeMaxDynamicSharedMemorySize, LDS_BYTES) != hipSuccess) { fprintf(stderr, "kernel_launch: hipFuncSetAttribute failed\n"); grid = -1; }
        else {
            if (hipOccupancyMaxActiveBlocksPerMultiprocessor(&per_cu, (const void*)fwd_kernel, NTHREADS, LDS_BYTES) != hipSuccess || per_cu < 1) { fprintf(stderr, "kernel_launch: occupancy query reports %d\n", per_cu); }
            (void)hipGetLastError();
            grid = cus;
        }
    }
    if (grid < 0) { hipLaunchKernelGGL(nan_fill, dim3(1024), dim3(256), 0, stream, (float*)d_out, (size_t)out_size); return; }
    (void)hipMemsetAsync((char*)d_ws + WS_CTL, 0, CTL_BYTES, stream);
    Params p{};
    for (int i = 0; i < 42; ++i) p.in[i] = (const float*)d_in[i];
    p.out = (float*)d_out; p.ws = (unsigned char*)d_ws;
#if PER_PHASE_LAUNCH
    for (int k = 0; k < NPHASES; ++k) { p.ph_lo = k; p.ph_hi = k + 1; hipLaunchKernelGGL(fwd_kernel, dim3(grid), dim3(NTHREADS), LDS_BYTES, stream, p); }
#else
    p.ph_lo = 0; p.ph_hi = NPHASES;
    hipLaunchKernelGGL(fwd_kernel, dim3(grid), dim3(NTHREADS), LDS_BYTES, stream, p);
#endif
}
```

```cpp
#include <hip/hip_runtime.h>
#include <cstdio>
#include <cstdint>

#ifndef REP_MASK
#define REP_MASK 0u
#endif
#ifndef PER_PHASE_LAUNCH
#define PER_PHASE_LAUNCH 0
#endif

#define LAS __attribute__((address_space(3)))
typedef unsigned short bf16_t;
typedef short bf16x8 __attribute__((ext_vector_type(8)));
typedef float f32x4 __attribute__((ext_vector_type(4)));
typedef float f32x2 __attribute__((ext_vector_type(2)));
typedef float f32x16 __attribute__((ext_vector_type(16)));
typedef unsigned u32x4 __attribute__((ext_vector_type(4)));
typedef unsigned u32x2 __attribute__((ext_vector_type(2)));

constexpr int NB = 32, SEQ = 2048, LC = 256, LT = SEQ + LC, D = 1024, NH = 16;
constexpr int NG = 2, BG = NB / NG, TG = BG * LT;
constexpr int NTHREADS = 512, NWAVES = 8;
constexpr int N1CAT = 3584, K1CAT = 2048;
constexpr int NEXP = 16, FEXP = 512;

constexpr size_t al256(size_t x) { return (x + 255) & ~(size_t)255; }
constexpr int XCD_BAR_WORDS_C = 3456;
constexpr size_t WS_CTL = 0;
constexpr size_t CTL_BAR_BYTES = (size_t)XCD_BAR_WORDS_C * 4;
constexpr size_t CTL_CNT_OFF = al256(CTL_BAR_BYTES);
constexpr size_t CTL_BYTES = al256(CTL_CNT_OFF + (size_t)2 * NG * 4 * 32 * 64);
constexpr size_t WS_X = al256(WS_CTL + CTL_BYTES);
constexpr size_t WS_VF = WS_X + (size_t)TG * D * 2;
constexpr size_t WS_MODL = WS_VF + (size_t)TG * D * 2;
constexpr size_t WS_MODC = WS_MODL + (size_t)4 * NB * 6 * D * 4;
constexpr size_t WS_WRKV = al256(WS_MODC + (size_t)4 * 6 * D * 4);
constexpr size_t WS_WL = WS_WRKV + (size_t)2 * 3072 * D * 2;
constexpr size_t WS_WO = WS_WL + (size_t)2 * 512 * K1CAT * 2;
constexpr size_t WS_G2T = WS_WO + (size_t)2 * D * D * 2;
constexpr size_t WS_V2T = WS_G2T + (size_t)2 * D * 256 * 2;
constexpr size_t WS_W2T = WS_V2T + (size_t)D * 256 * 2;
constexpr size_t WS_A2T = WS_W2T + (size_t)4 * D * 64 * 2;
constexpr size_t WS_WIN = WS_A2T + (size_t)4 * D * 64 * 2;
constexpr size_t WS_WOUT = WS_WIN + (size_t)2 * 4096 * D * 2;
constexpr size_t WS_WSP = WS_WOUT + (size_t)2 * D * 2048 * 2;
constexpr size_t WS_WGU = WS_WSP + (size_t)2 * 16 * 128 * 128 * 2;
constexpr size_t WS_WD = WS_WGU + (size_t)4 * NEXP * 1024 * D * 2;
constexpr size_t WS_ARENA = al256(WS_WD + (size_t)4 * NEXP * D * FEXP * 2);
constexpr size_t SZB = (size_t)TG * D * 2;
constexpr size_t AR_H2 = 0;
constexpr size_t AR_Y0 = 0, AR_Y1 = SZB;
constexpr size_t AR_XR = 2 * SZB;
constexpr size_t AR_R = 5 * SZB, AR_K = 6 * SZB, AR_V = 7 * SZB;
constexpr size_t AR_L1 = 8 * SZB;
constexpr size_t AR_DOT = AR_L1 + SZB / 2;
constexpr size_t AR_G = 2 * SZB;
constexpr size_t AR_VGATE = 0;
constexpr size_t AR_O = 3 * SZB;
constexpr size_t AR_H = 0;
constexpr size_t AR_Z = SZB;
constexpr size_t AR_P = 5 * SZB;
constexpr size_t AR_ST = 7 * SZB;
constexpr size_t AR_HM = 0;
constexpr size_t AR_HE = SZB;
constexpr size_t HE_ROWS = (size_t)2 * TG + 32 * 256;
constexpr size_t AR_LIST = al256(AR_HE + HE_ROWS * FEXP * 2);
constexpr size_t AR_LW = AR_LIST + (size_t)32 * TG * 4;
constexpr size_t AR_YM0 = 5 * SZB, AR_YM1 = 6 * SZB;
constexpr size_t ARENA_BYTES = AR_DOT + (size_t)2 * TG * 16 * 4 + 4096;
constexpr size_t WS_END = WS_ARENA + ARENA_BYTES;
static_assert(AR_LW + (size_t)32 * TG * 4 <= AR_O, "moe lists overlap");

constexpr int LDS_STAGE = 131072;
constexpr int LDS_MISC = LDS_STAGE;
constexpr int LDS_BYTES = LDS_STAGE + 1024;

struct Params {
    const float* in[42];
    float* out;
    unsigned char* ws;
    int ph_lo, ph_hi;
};

__device__ __forceinline__ float bf2f(unsigned short b) { return __uint_as_float(((unsigned)b) << 16); }
__device__ __forceinline__ unsigned short f2bf(float f) { unsigned u = __float_as_uint(f); u += 0x7FFFu + ((u >> 16) & 1u); return (unsigned short)(u >> 16); }
typedef __bf16 bf16x2_t __attribute__((ext_vector_type(2)));
__device__ __forceinline__ unsigned pk2(float lo, float hi) { const bf16x2_t v = __builtin_convertvector((f32x2){lo, hi}, bf16x2_t); return __builtin_bit_cast(unsigned, v); }
__device__ __forceinline__ float lo16(unsigned w) { return __uint_as_float(w << 16); }
__device__ __forceinline__ float hi16(unsigned w) { return __uint_as_float(w & 0xFFFF0000u); }
__device__ __forceinline__ float sigmoidf_(float x) { return __builtin_amdgcn_rcpf(1.0f + __expf(-x)); }
__device__ __forceinline__ float tanhf_(float x) { return 1.0f - 2.0f * __builtin_amdgcn_rcpf(__expf(2.0f * x) + 1.0f); }
__device__ __forceinline__ float wave_sum(float v) {
#pragma unroll
    for (int o = 32; o > 0; o >>= 1) v += __shfl_xor(v, o);
    return v;
}
template <int CTRL> __device__ __forceinline__ float dpp_f(float v) {
    return __int_as_float(__builtin_amdgcn_update_dpp(0, __float_as_int(v), CTRL, 0xF, 0xF, true));
}
__device__ __forceinline__ float red8(float v) { v += dpp_f<0xB1>(v); v += dpp_f<0x4E>(v); v += dpp_f<0x141>(v); return v; }
__device__ __forceinline__ float red16(float v) { v = red8(v); v += dpp_f<0x140>(v); return v; }
__device__ __forceinline__ float wave_sum_dpp(float v) {
    v = red16(v);
    const float a = __int_as_float(__builtin_amdgcn_readlane(__float_as_int(v), 0)), b = __int_as_float(__builtin_amdgcn_readlane(__float_as_int(v), 16));
    const float c = __int_as_float(__builtin_amdgcn_readlane(__float_as_int(v), 32)), d = __int_as_float(__builtin_amdgcn_readlane(__float_as_int(v), 48));
    return (a + b) + (c + d);
}
__device__ __forceinline__ float red4(float v) { v += dpp_f<0xB1>(v); v += dpp_f<0x4E>(v); return v; }
__device__ __forceinline__ f32x2 gelu_pk(f32x2 v) {
    const f32x2 av = __builtin_elementwise_abs(v), d = av * 0.2316418882f + 1.0f;
    f32x2 t; t.x = __builtin_amdgcn_rcpf(d.x); t.y = __builtin_amdgcn_rcpf(d.y);
    f32x2 q = t * 0.5307027145f + (-0.7265760135f); q = q * t + 0.7107068705f; q = q * t + (-0.142248368f); q = q * t + 0.127414796f; q = q * t;
    const f32x2 s = (v * v) * (-0.72134752044f);
    f32x2 e; e.x = __builtin_amdgcn_exp2f(s.x); e.y = __builtin_amdgcn_exp2f(s.y);
    const f32x2 m = v * (q * e), r = v - m;
    f32x2 o; o.x = v.x < 0.f ? m.x : r.x; o.y = v.y < 0.f ? m.y : r.y; return o;
}
__device__ __forceinline__ float gelu_f(float v) {
    const float av = fabsf(v), t = __builtin_amdgcn_rcpf(av * 0.2316418882f + 1.0f);
    float q = t * 0.5307027145f + (-0.7265760135f); q = q * t + 0.7107068705f; q = q * t + (-0.142248368f); q = q * t + 0.127414796f; q = q * t;
    const float e = __builtin_amdgcn_exp2f((v * v) * (-0.72134752044f));
    const float m = v * (q * e);
    return v < 0.f ? m : v - m;
}

#define XB_TMO      128
#define XB_XCNT(j)  (256  + 64 * (j))
#define XB_XSUB(j)  (1280 + 64 * (j))
#define XB_XGEN(j)  (2304 + 64 * (j))
#define XB_TOP      3328
#define XB_TOPGEN   3392
#define XCD_BAR_WORDS 3456
#define XB_SPIN_CAP (1u << 22)
static_assert(XCD_BAR_WORDS == XCD_BAR_WORDS_C, "barrier words");
__device__ __forceinline__ unsigned xb_ld(unsigned* p)              { return __hip_atomic_load(p, __ATOMIC_RELAXED, __HIP_MEMORY_SCOPE_AGENT); }
__device__ __forceinline__ unsigned xb_add(unsigned* p, unsigned v) { return __hip_atomic_fetch_add(p, v, __ATOMIC_RELAXED, __HIP_MEMORY_SCOPE_AGENT); }
__device__ __forceinline__ unsigned xb_xcc_id() { return (unsigned)__builtin_amdgcn_s_getreg((3 << 11) | 20) & 0xFu; }
#define XB_SPIN(cond, bar) do { unsigned _sp = 0; while (cond) { __builtin_amdgcn_s_sleep(1); \
    if ((++_sp & 255u) == 0u) { if (xb_ld(&(bar)[XB_TMO])) break; if (_sp > XB_SPIN_CAP) { atomicAdd(&(bar)[XB_TMO], 1u); break; } } } } while (0)
struct XcdBarrier { unsigned* bar; unsigned x; volatile LAS unsigned* st; };
__device__ __forceinline__ XcdBarrier xcd_barrier_post(unsigned* bar, volatile LAS unsigned* st) {
    XcdBarrier b; b.bar = bar; b.x = xb_xcc_id(); b.st = st;
    if (threadIdx.x == 0) (void)xb_add(&bar[XB_XCNT(b.x)], 1u);
    return b;
}
__device__ __forceinline__ void xcd_barrier_complete(unsigned* bar, unsigned x, unsigned& nloc, unsigned& nx) {
    const unsigned G = gridDim.x * gridDim.y * gridDim.z;
    unsigned sum, cnt, mine, sp = 0u;
    for (;;) {
        sum = 0u; cnt = 0u; mine = 0u;
#pragma unroll
        for (unsigned j = 0; j < 16; ++j) { const unsigned c = xb_ld(&bar[XB_XCNT(j)]); sum += c; cnt += (c > 0u) ? 1u : 0u; mine = (j == x) ? c : mine; }
        if (sum == G) break;
        __builtin_amdgcn_s_sleep(1);
        if ((++sp & 255u) == 0u) { if (xb_ld(&bar[XB_TMO])) break; if (sp > XB_SPIN_CAP) { atomicAdd(&bar[XB_TMO], 1u); break; } }
    }
    nloc = mine > 0u ? mine : 1u; nx = cnt > 0u ? cnt : 1u;
}
__device__ __forceinline__ void xcd_barrier(const XcdBarrier& b) {
    asm volatile("s_waitcnt vmcnt(0)" ::: "memory");
    __syncthreads();
    if (threadIdx.x == 0) {
        unsigned* bar = b.bar;
        __builtin_amdgcn_s_waitcnt(0);
        unsigned nloc = b.st[0], nx = b.st[1];
        if (nloc == 0u) { xcd_barrier_complete(bar, b.x, nloc, nx); b.st[0] = nloc; b.st[1] = nx; }
        const unsigned old = xb_add(&bar[XB_XSUB(b.x)], 1u);
        const unsigned gen = old / nloc;
        if (old + 1u == (gen + 1u) * nloc) {
            __builtin_amdgcn_fence(__ATOMIC_RELEASE, "agent");
            asm volatile("s_waitcnt vmcnt(0)" ::: "memory");
            const unsigned og = xb_add(&bar[XB_TOP], 1u);
            const unsigned tg = og / nx;
            if (og + 1u == (tg + 1u) * nx) xb_add(&bar[XB_TOPGEN], 1u);
            else XB_SPIN(xb_ld(&bar[XB_TOPGEN]) == tg, bar);
            __builtin_amdgcn_fence(__ATOMIC_ACQUIRE, "agent");
            xb_add(&bar[XB_XGEN(b.x)], 1u);
            asm volatile("s_waitcnt vmcnt(0)" ::: "memory");
        } else {
            XB_SPIN(xb_ld(&bar[XB_XGEN(b.x)]) == gen, bar);
            __builtin_amdgcn_fence(__ATOMIC_ACQUIRE, "agent");
            asm volatile("s_waitcnt vmcnt(0)" ::: "memory");
        }
    }
    __syncthreads();
}

namespace pg8 {
constexpr int BM = 256, BK = 64, HALF = 128, HTB = HALF * BK * 2, STAGE_BYTES = 8 * HTB, NXCD = 8, WGM = 8;
__host__ __device__ __forceinline__ int lds_byte(int r, int c) { const int st = (r >> 4) * 2 + (c >> 5), rr = r & 15, cc = c & 31, ob = rr * 64 + cc * 2; return st * 1024 + (ob ^ (((ob >> 9) & 1) << 5)); }
__host__ __device__ __forceinline__ void stage_rc(int b, int& R, int& C) { const int st = b / 1024, sb = b % 1024, swz = sb ^ (((sb >> 9) & 1) << 5); R = (st >> 1) * 16 + swz / 64; C = (st & 1) * 32 + (swz % 64) / 2; }
struct Unit { int pm, pn, aux; };

struct SchedPlain {
    static constexpr bool GATHER = false;
    int nM, nN, nwg, G, c, skipctx;
    __device__ void init(int nM_, int nN_, int G_, int c_, int skipctx_) { nM = nM_; nN = nN_; nwg = nM * nN; G = G_; c = c_; skipctx = skipctx_; }
    __device__ bool next(int i, Unit& u) const {
        const long L = (long)i * G + c; if (L >= nwg) return false;
        int wgid = (int)L; { const int q = nwg / NXCD, r = nwg % NXCD, xcd = wgid % NXCD, off = wgid / NXCD; wgid = (xcd < r ? xcd * (q + 1) : r * (q + 1) + (xcd - r) * q) + off; }
        const int nig = WGM * nN, gid = wgid / nig, fm = gid * WGM, gsz = (nM - fm) < WGM ? (nM - fm) : WGM;
        int pm = fm + ((wgid % nig) % gsz); u.pn = (wgid % nig) / gsz; u.aux = 0;
        if (skipctx) pm = (pm >> 3) * 9 + 1 + (pm & 7);
        u.pm = pm; return true;
    }
    __device__ __forceinline__ int arow(const Unit& u, int r) const { return u.pm * BM + r; }
};
struct SchedRKV : SchedPlain {
    __device__ bool next(int i, Unit& u) const { if (!SchedPlain::next(i, u)) return false; u.pm += (u.pn >> 2) * nM; return true; }
};
template <bool GATH> struct SchedMoe {
    static constexpr bool GATHER = GATH;
    const LAS int* cn; const LAS int* tb; const int* lists; int G, c, total;
    __device__ bool next(int i, Unit& u) const {
        const int U = i * G + c; if (U >= total * 4) return false;
        const int T = U >> 2, pn = U & 3; int l = 0;
        while (tb[l + 1] <= T) ++l;
        u.pm = T; u.pn = (l >> 1) * 4 + pn; u.aux = l | ((T - tb[l]) << 8); return true;
    }
    __device__ __forceinline__ int arow(const Unit& u, int r) const {
        if (!GATH) return u.pm * BM + r;
        const int l = u.aux & 255, idx = (u.aux >> 8) * BM + r;
        return idx < cn[l] ? lists[(size_t)l * TG + idx] : 0;
    }
};

template <class Epi, class Sched>
__device__ __forceinline__ void gemm_phase(const int tid, LAS unsigned char* lds, const bf16_t* A, int lda, const bf16_t* Bt, int ldb, int K, const Sched& S, const Epi& E) {
    constexpr bool GA = Sched::GATHER;
    const int wid = __builtin_amdgcn_readfirstlane(tid >> 6), lane = tid & 63, wr = wid >> 2, wc = wid & 3, fr = lane & 15, fq = lane >> 4;
    const int nt = K / BK;
    unsigned voffA[2], voffB[2];
#pragma unroll
    for (int i = 0; i < 2; ++i) { int R, C; stage_rc(tid * 16 + i * 8192, R, C); voffA[i] = (unsigned)(R * lda + C) * 2u; voffB[i] = (unsigned)(R * ldb + C) * 2u; }
    const size_t kstep = (size_t)(BK * 2);
    const size_t hstepA = (size_t)HALF * lda * 2, tstepA = 2 * hstepA;
    const size_t hstepB = (size_t)HALF * ldb * 2, tstepB = 2 * hstepB;
    const unsigned ldsw = (unsigned)wid * 1024u;
    const int aoff = lds_byte(wr * 64 + fr, fq * 8), boff = lds_byte(wc * 32 + fr, fq * 8);
#define PG8_SA(b, h) (((b) * 2 + (h)) * HTB)
#define PG8_SB(b, h) ((4 + (b) * 2 + (h)) * HTB)
#define PG8_STAGE(bufoff, gbase, voff) do { _Pragma("unroll") for (int _i = 0; _i < 2; ++_i) \
        __builtin_amdgcn_global_load_lds((const unsigned*)((const char*)(gbase) + (voff)[_i]), (LAS unsigned*)(lds + (bufoff) + ldsw + _i * 8192), 16, 0, 0); } while (0)
#define PG8_STAGE_A(bufoff, ub, gv, h, koff) do { if constexpr (GA) { PG8_STAGE(bufoff, (const char*)A + (koff), gv[h]); } else { PG8_STAGE(bufoff, (ub) + (h) * hstepA + (koff), voffA); } } while (0)
#define PG8_LDA(dst, b, h) do { _Pragma("unroll") for (int m = 0; m < 4; ++m) _Pragma("unroll") for (int k = 0; k < 2; ++k) dst[m][k] = *(const LAS bf16x8*)(lds + PG8_SA(b, h) + aoff + m * 2048 + k * 1024); } while (0)
#define PG8_LDB(dst, b, h) do { _Pragma("unroll") for (int n = 0; n < 2; ++n) _Pragma("unroll") for (int k = 0; k < 2; ++k) dst[n][k] = *(const LAS bf16x8*)(lds + PG8_SB(b, h) + boff + n * 2048 + k * 1024); } while (0)
#define PG8_MMA(ai, bj, At, Bt_) do { __builtin_amdgcn_s_setprio(1); _Pragma("unroll") for (int m = 0; m < 4; ++m) _Pragma("unroll") for (int n = 0; n < 2; ++n) _Pragma("unroll") for (int k = 0; k < 2; ++k) \
        acc[ai][bj][m][n] = __builtin_amdgcn_mfma_f32_16x16x32_bf16(Bt_[n][k], At[m][k], acc[ai][bj][m][n], 0, 0, 0); __builtin_amdgcn_s_setprio(0); } while (0)
#define PG8_WAIT_V(n) asm volatile("s_waitcnt vmcnt(" #n ")" ::: "memory")
#define PG8_WAIT_L(n) asm volatile("s_waitcnt lgkmcnt(" #n ")" ::: "memory")
#define PG8_BAR __builtin_amdgcn_s_barrier()
#define PG8_SCHED __builtin_amdgcn_sched_barrier(0)
#define PG8_GOFF(dst, u) do { if constexpr (GA) { _Pragma("unroll") for (int _h = 0; _h < 2; ++_h) _Pragma("unroll") for (int _i = 0; _i < 2; ++_i) { int R_, C_; stage_rc(tid * 16 + _i * 8192, R_, C_); \
        dst[_h][_i] = ((unsigned)S.arow(u, _h * HALF + R_) * (unsigned)lda + (unsigned)C_) * 2u; } } } while (0)
    Unit cur, nxt; int ui = 0;
    if (!S.next(0, cur)) return;
    f32x4 acc[2][2][4][2];
#pragma unroll
    for (int a = 0; a < 2; ++a)
#pragma unroll
        for (int b = 0; b < 2; ++b)
#pragma unroll
            for (int m = 0; m < 4; ++m)
#pragma unroll
                for (int n = 0; n < 2; ++n) acc[a][b][m][n] = (f32x4){0.f, 0.f, 0.f, 0.f};
    bf16x8 At[4][2], B0[2][2], B1[2][2];
    unsigned gAc[2][2], gAn[2][2];
    PG8_GOFF(gAc, cur);
    const char* cA = (const char*)A + (GA ? (size_t)0 : (size_t)cur.pm * tstepA);
    const char* cB = (const char*)Bt + (size_t)cur.pn * tstepB;
    PG8_STAGE(PG8_SB(0, 0), cB, voffB); PG8_STAGE_A(PG8_SA(0, 0), cA, gAc, 0, 0); PG8_STAGE(PG8_SB(0, 1), cB + hstepB, voffB); PG8_STAGE_A(PG8_SA(0, 1), cA, gAc, 1, 0);
    if (wr == 1) PG8_BAR;
    PG8_WAIT_V(4); PG8_BAR;
    PG8_STAGE(PG8_SB(1, 0), cB + kstep, voffB); PG8_STAGE_A(PG8_SA(1, 0), cA, gAc, 0, kstep); PG8_STAGE(PG8_SB(1, 1), cB + hstepB + kstep, voffB);
    PG8_WAIT_V(6); PG8_BAR;
    for (;;) {
        const bool has_next = S.next(ui + 1, nxt);
        if (has_next) { PG8_GOFF(gAn, nxt); }
        else if constexpr (GA) {
#pragma unroll
            for (int _h = 0; _h < 2; ++_h)
#pragma unroll
                for (int _i = 0; _i < 2; ++_i) gAn[_h][_i] = gAc[_h][_i];
        }
        const char* nA = (has_next && !GA) ? (const char*)A + (size_t)nxt.pm * tstepA : cA;
        const char* nB = has_next ? (const char*)Bt + (size_t)nxt.pn * tstepB : cB;
#pragma unroll 1
        for (int t = 0; t < nt; t += 2) {
            const bool last = (t == nt - 2);
            const size_t k1 = (size_t)(t + 1) * kstep;
            const size_t k2 = last ? (size_t)0 : (size_t)(t + 2) * kstep, k3 = k2 + kstep;
            const char* a2 = last ? nA : cA; const char* b2 = last ? nB : cB;
            unsigned g2[2][2];
            if constexpr (GA) {
#pragma unroll
                for (int _h = 0; _h < 2; ++_h)
#pragma unroll
                    for (int _i = 0; _i < 2; ++_i) g2[_h][_i] = last ? gAn[_h][_i] : gAc[_h][_i];
            }
            PG8_LDB(B0, 0, 0); PG8_SCHED; PG8_LDA(At, 0, 0); PG8_STAGE_A(PG8_SA(1, 1), cA, gAc, 1, k1);
            PG8_WAIT_L(8); PG8_BAR; PG8_WAIT_L(0); PG8_MMA(0, 0, At, B0); PG8_BAR; PG8_SCHED;
            PG8_LDB(B1, 0, 1); PG8_STAGE(PG8_SB(0, 0), b2 + k2, voffB);
            PG8_BAR; PG8_WAIT_L(0); PG8_MMA(0, 1, At, B1); PG8_BAR;
            PG8_LDA(At, 0, 1); PG8_STAGE_A(PG8_SA(0, 0), a2, g2, 0, k2);
            PG8_BAR; PG8_WAIT_L(0); PG8_MMA(1, 0, At, B0); PG8_BAR; PG8_SCHED;
            PG8_STAGE(PG8_SB(0, 1), b2 + hstepB + k2, voffB);
            PG8_WAIT_V(6); PG8_BAR; PG8_MMA(1, 1, At, B1); PG8_BAR;
            PG8_LDB(B0, 1, 0); PG8_SCHED; PG8_LDA(At, 1, 0); PG8_STAGE_A(PG8_SA(0, 1), a2, g2, 1, k2);
            PG8_WAIT_L(8); PG8_BAR; PG8_WAIT_L(0); PG8_MMA(0, 0, At, B0); PG8_BAR; PG8_SCHED;
            PG8_LDB(B1, 1, 1); PG8_STAGE(PG8_SB(1, 0), b2 + k3, voffB);
            PG8_BAR; PG8_WAIT_L(0); PG8_MMA(0, 1, At, B1); PG8_BAR;
            PG8_LDA(At, 1, 1); PG8_STAGE_A(PG8_SA(1, 0), a2, g2, 0, k3);
            PG8_BAR; PG8_WAIT_L(0); PG8_MMA(1, 0, At, B0); PG8_BAR; PG8_SCHED;
            PG8_STAGE(PG8_SB(1, 1), b2 + hstepB + k3, voffB);
            PG8_WAIT_V(6); PG8_BAR; PG8_MMA(1, 1, At, B1); PG8_BAR;
        }
        { int fr_e = fr, fq_e = fq; asm volatile("" : "+v"(fr_e), "+v"(fq_e)); E(acc, cur, wr, wc, fr_e, fq_e); }
        if (!has_next) break;
#pragma unroll
        for (int a = 0; a < 2; ++a)
#pragma unroll
            for (int b = 0; b < 2; ++b)
#pragma unroll
                for (int m = 0; m < 4; ++m)
#pragma unroll
                    for (int n = 0; n < 2; ++n) acc[a][b][m][n] = (f32x4){0.f, 0.f, 0.f, 0.f};
        cur = nxt; cA = nA; cB = nB; ++ui;
        if constexpr (GA) {
#pragma unroll
            for (int _h = 0; _h < 2; ++_h)
#pragma unroll
                for (int _i = 0; _i < 2; ++_i) gAc[_h][_i] = gAn[_h][_i];
        }
    }
    PG8_WAIT_V(0);
    if (wr == 0) PG8_BAR;
    PG8_BAR;
#undef PG8_SA
#undef PG8_SB
#undef PG8_STAGE
#undef PG8_STAGE_A
#undef PG8_LDA
#undef PG8_LDB
#undef PG8_MMA
#undef PG8_WAIT_V
#undef PG8_WAIT_L
#undef PG8_BAR
#undef PG8_SCHED
#undef PG8_GOFF
}
}
using pg8::Unit;

#define EPI_LOOP_BEGIN \
    _Pragma("unroll") for (int ai = 0; ai < 2; ++ai) _Pragma("unroll") for (int m = 0; m < 4; ++m) { const int trow = ai * 128 + wr * 64 + m * 16 + fr; \
    _Pragma("unroll") for (int bj = 0; bj < 2; ++bj) _Pragma("unroll") for (int n = 0; n < 2; ++n) { const int tcol = bj * 128 + wc * 32 + n * 16 + 4 * fq; const f32x4 v = acc[ai][bj][m][n];
#define EPI_LOOP_END } asm volatile("" ::: "memory"); }

struct EpiRKV {
    unsigned char* ws; size_t voff;
    __device__ __forceinline__ void operator()(const f32x4 (&acc)[2][2][4][2], const Unit& u, int wr, int wc, int fr, int fq) const {
        const int which = u.pn >> 2; const size_t row0 = (size_t)(u.pm - which * (TG / 256)) * 256;
        const size_t off = which == 0 ? (WS_ARENA + AR_R) : (which == 1 ? (WS_ARENA + AR_K) : voff);
        bf16_t* dst = (bf16_t*)(ws + off); const int cb = (u.pn & 3) * 256;
        EPI_LOOP_BEGIN
            u32x2 w; w.x = pk2(v[0], v[1]); w.y = pk2(v[2], v[3]);
            *(u32x2*)(dst + (row0 + trow) * D + cb + tcol) = w;
        EPI_LOOP_END
    }
};
struct EpiL1 {
    bf16_t* L1;
    __device__ __forceinline__ void operator()(const f32x4 (&acc)[2][2][4][2], const Unit& u, int wr, int wc, int fr, int fq) const {
        const int pn = u.pn; const size_t row0 = (size_t)u.pm * 256; const int cb = pn * 256;
        EPI_LOOP_BEGIN
            f32x4 o = v;
            if (pn == 0 && bj == 0) { o[0] = tanhf_(v[0]); o[1] = tanhf_(v[1]); o[2] = tanhf_(v[2]); o[3] = tanhf_(v[3]); }
            if (pn == 1 && bj == 0) { o[0] = sigmoidf_(v[0]); o[1] = sigmoidf_(v[1]); o[2] = sigmoidf_(v[2]); o[3] = sigmoidf_(v[3]); }
            u32x2 w; w.x = pk2(o[0], o[1]); w.y = pk2(o[2], o[3]);
            *(u32x2*)(L1 + (row0 + trow) * 512 + cb + tcol) = w;
        EPI_LOOP_END
    }
};
template <int ACT> struct EpiStore {
    bf16_t* O; const float* bias;
    __device__ __forceinline__ void operator()(const f32x4 (&acc)[2][2][4][2], const Unit& u, int wr, int wc, int fr, int fq) const {
        const size_t row0 = (size_t)u.pm * 256; const int cb = u.pn * 256;
        EPI_LOOP_BEGIN
            f32x4 o = v;
            if (ACT == 1) { const f32x4 b = *(const f32x4*)(bias + cb + tcol); o[0] = sigmoidf_(v[0] + b[0]); o[1] = sigmoidf_(v[1] + b[1]); o[2] = sigmoidf_(v[2] + b[2]); o[3] = sigmoidf_(v[3] + b[3]); }
            u32x2 w; w.x = pk2(o[0], o[1]); w.y = pk2(o[2], o[3]);
            *(u32x2*)(O + (row0 + trow) * D + cb + tcol) = w;
        EPI_LOOP_END
    }
};
struct EpiGelu {
    bf16_t* Z; const float* bias;
    __device__ __forceinline__ void operator()(const f32x4 (&acc)[2][2][4][2], const Unit& u, int wr, int wc, int fr, int fq) const {
        const size_t row0 = (size_t)u.pm * 256; const int cb = u.pn * 256;
        EPI_LOOP_BEGIN
            const f32x4 b = *(const f32x4*)(bias + cb + tcol);
            const f32x2 g0 = gelu_pk((f32x2){v[0] + b[0], v[1] + b[1]}), g1 = gelu_pk((f32x2){v[2] + b[2], v[3] + b[3]});
            u32x2 w; w.x = pk2(g0.x, g0.y); w.y = pk2(g1.x, g1.y);
            *(u32x2*)(Z + (row0 + trow) * 4096 + cb + tcol) = w;
        EPI_LOOP_END
    }
};
struct EpiMG {
    bf16_t* HE;
    __device__ __forceinline__ void operator()(const f32x4 (&acc)[2][2][4][2], const Unit& u, int wr, int wc, int fr, int fq) const {
        const size_t row0 = (size_t)u.pm * 256; const int pnl = u.pn & 3;
#pragma unroll
        for (int ai = 0; ai < 2; ++ai)
#pragma unroll
            for (int m = 0; m < 4; ++m) { const int trow = ai * 128 + wr * 64 + m * 16 + fr;
#pragma unroll
                for (int bj = 0; bj < 2; ++bj) {
                    const f32x4 gt = acc[ai][bj][m][0], up = acc[ai][bj][m][1];
                    const int f = (8 * pnl + 4 * bj + wc) * 16 + 4 * fq;
                    float o[4];
#pragma unroll
                    for (int e = 0; e < 4; ++e) o[e] = gt[e] * sigmoidf_(gt[e]) * up[e];
                    u32x2 w; w.x = pk2(o[0], o[1]); w.y = pk2(o[2], o[3]);
                    *(u32x2*)(HE + (row0 + trow) * FEXP + f) = w;
                } }
    }
};
struct EpiMD {
    bf16_t* Y0; const int* lists; const float* lw; const LAS int* cn;
    __device__ __forceinline__ void operator()(const f32x4 (&acc)[2][2][4][2], const Unit& u, int wr, int wc, int fr, int fq) const {
        const int l = u.aux & 255, t0 = (u.aux >> 8) * 256, cnt = cn[l]; const int cb = (u.pn & 3) * 256;
        bf16_t* Y = Y0 + (size_t)(l & 1) * ((AR_YM1 - AR_YM0) / 2);
#pragma unroll
        for (int ai = 0; ai < 2; ++ai)
#pragma unroll
            for (int m = 0; m < 4; ++m) { const int trow = ai * 128 + wr * 64 + m * 16 + fr; const int idx = t0 + trow;
                if (idx < cnt) {
                    const int tok = lists[(size_t)l * TG + idx]; const float wgt = lw[(size_t)l * TG + idx];
#pragma unroll
                    for (int bj = 0; bj < 2; ++bj)
#pragma unroll
                        for (int n = 0; n < 2; ++n) { const int tcol = bj * 128 + wc * 32 + n * 16 + 4 * fq; const f32x4 v = acc[ai][bj][m][n];
                            u32x2 w; w.x = pk2(v[0] * wgt, v[1] * wgt); w.y = pk2(v[2] * wgt, v[3] * wgt);
                            *(u32x2*)(Y + (size_t)tok * D + cb + tcol) = w; }
                } }
    }
};

struct Frame {
    const Params __attribute__((address_space(4)))* kp; LAS unsigned char* lds; int tid, lane, wave, G, bid;
    unsigned char* ws;
    __device__ __forceinline__ const float* in(int k) const { return kp->in[k]; }
    __device__ __forceinline__ float* outp() const { return kp->out; }
    template <class T> __device__ __forceinline__ T* wsp(size_t off) const { return (T*)(ws + off); }
    template <class T> __device__ __forceinline__ T* ar(size_t off) const { return (T*)(ws + WS_ARENA + off); }
    __device__ __forceinline__ const float* modL(int layer, int b, int j) const { return (const float*)(ws + WS_MODL) + (((size_t)layer * NB + b) * 6 + j) * D; }
    __device__ __forceinline__ const float* modC(int layer, int j) const { return (const float*)(ws + WS_MODC) + ((size_t)layer * 6 + j) * D; }
};

struct TJob { const float* src; bf16_t* dst; const float* ksc; int lds, K, N, ldd, kofs, nofs, inter; };
constexpr int NJOBS = 2 * 21 + 1 + 4 + 4 * NEXP * 3;
__device__ __forceinline__ TJob get_job(const Frame& F, int j) {
    TJob J; J.ksc = nullptr; J.kofs = 0; J.nofs = 0; J.inter = 0; J.K = 0; J.N = 0; J.lds = 0; J.ldd = 0; J.src = nullptr; J.dst = nullptr;
    if (j < 42) {
        const int a = j / 21, q = j % 21;
        if (q < 3) { J.src = F.in(9 + q) + (size_t)a * D * D; J.lds = D; J.K = D; J.N = D; J.dst = F.wsp<bf16_t>(WS_WRKV) + (size_t)a * 3072 * D; J.ldd = D; J.nofs = q * 1024; }
        else if (q < 15) {
            const int half = (q - 3) / 6, w = (q - 3) % 6; const float* mu = F.in(8) + (size_t)a * 6 * D;
            J.dst = F.wsp<bf16_t>(WS_WL) + (size_t)a * 512 * K1CAT; J.ldd = K1CAT; J.kofs = half * 1024; J.K = D; int mi = 0;
            if (w < 2) { J.src = F.in(14) + ((size_t)a * 2 + w) * D * 64; J.lds = 64; J.N = 64; J.nofs = w * 64; mi = 1; }
            else if (w < 4) { const int d = w - 2; J.src = F.in(17) + ((size_t)a * 2 + d) * D * 64; J.lds = 64; J.N = 64; J.nofs = 128 + d * 64; mi = 4; }
            else if (w == 4) { J.src = F.in(22) + (size_t)a * D * 128; J.lds = 128; J.N = 128; J.nofs = 256; mi = 5; }
            else { J.src = F.in(20); J.lds = 32; J.N = (a == 1) ? 32 : 0; J.nofs = 384; mi = 3; }
            if (half) J.ksc = mu + mi * D;
        } else if (q == 15) { J.src = F.in(12) + (size_t)a * D * D; J.lds = D; J.K = D; J.N = D; J.dst = F.wsp<bf16_t>(WS_WO) + (size_t)a * D * D; J.ldd = D; }
        else if (q == 16) { J.src = F.in(23) + (size_t)a * 128 * D; J.lds = D; J.K = 128; J.N = D; J.dst = F.wsp<bf16_t>(WS_G2T) + (size_t)a * D * 256; J.ldd = 256; }
        else if (q < 19) { const int d = q - 17; J.src = F.in(15) + ((size_t)a * 2 + d) * 64 * D; J.lds = D; J.K = 64; J.N = D; J.dst = F.wsp<bf16_t>(WS_W2T) + ((size_t)a * 2 + d) * D * 64; J.ldd = 64; }
        else { const int d = q - 19; J.src = F.in(18) + ((size_t)a * 2 + d) * 64 * D; J.lds = D; J.K = 64; J.N = D; J.dst = F.wsp<bf16_t>(WS_A2T) + ((size_t)a * 2 + d) * D * 64; J.ldd = 64; }
    } else if (j == 42) { J.src = F.in(21); J.lds = D; J.K = 32; J.N = D; J.dst = F.wsp<bf16_t>(WS_V2T); J.ldd = 256; J.kofs = 128; }
    else if (j < 47) {
        const int q = j - 43, b = q >> 1;
        if ((q & 1) == 0) { J.src = F.in(29) + (size_t)b * D * 4096; J.lds = 4096; J.K = D; J.N = 4096; J.dst = F.wsp<bf16_t>(WS_WIN) + (size_t)b * 4096 * D; J.ldd = D; }
        else { J.src = F.in(35) + (size_t)b * 2048 * D; J.lds = D; J.K = 2048; J.N = D; J.dst = F.wsp<bf16_t>(WS_WOUT) + (size_t)b * D * 2048; J.ldd = 2048; }
    } else {
        const int q = j - 47, ie = q / 3, w = q % 3;
        if (w < 2) { J.src = F.in(38 + w) + (size_t)ie * D * FEXP; J.lds = FEXP; J.K = D; J.N = FEXP; J.dst = F.wsp<bf16_t>(WS_WGU) + (size_t)ie * 1024 * D; J.ldd = D; J.nofs = w * 16; J.inter = 1; }
        else { J.src = F.in(40) + (size_t)ie * FEXP * D; J.lds = D; J.K = FEXP; J.N = D; J.dst = F.wsp<bf16_t>(WS_WD) + (size_t)ie * D * FEXP; J.ldd = FEXP; }
    }
    return J;
}
__device__ __forceinline__ void transpose_all(const Frame& F) {
    LAS float* tile = (LAS float*)F.lds;
    int tilectr = 0;
#pragma unroll 1
    for (int j = 0; j < NJOBS; ++j) {
        const TJob J = get_job(F, j);
        const int tk = (J.K + 127) / 128, tn = (J.N + 127) / 128, ntile = tk * tn;
        int t = (F.bid - (tilectr % F.G) + F.G) % F.G;
        tilectr += ntile;
#pragma unroll 1
        for (; t < ntile; t += F.G) {
            const int k0 = (t / tn) * 128, n0 = (t % tn) * 128;
            __syncthreads();
            float v[32];
#pragma unroll
            for (int e = 0; e < 32; ++e) { const int idx = F.tid + e * 512, kk = idx >> 7, nn = idx & 127;
                v[e] = 0.f; if (k0 + kk < J.K && n0 + nn < J.N) v[e] = J.src[(size_t)(k0 + kk) * J.lds + n0 + nn]; }
#pragma unroll
            for (int e = 0; e < 32; ++e) { const int idx = F.tid + e * 512, kk = idx >> 7, nn = idx & 127;
                float x = v[e]; if (J.ksc && k0 + kk < J.K) x *= J.ksc[k0 + kk];
                tile[kk * 129 + nn] = x; }
            __syncthreads();
#pragma unroll
            for (int e = 0; e < 16; ++e) { const int idx = F.tid + e * 512, nn = idx >> 6, kk = (idx & 63) * 2;
                if (k0 + kk < J.K && n0 + nn < J.N) { const int n = n0 + nn; const int row = J.nofs + (J.inter ? ((n >> 4) * 32 + (n & 15)) : n);
                    *(unsigned*)(J.dst + (size_t)row * J.ldd + J.kofs + k0 + kk) = pk2(tile[kk * 129 + nn], tile[(kk + 1) * 129 + nn]); } }
        }
    }
    __syncthreads();
}
__device__ __forceinline__ void zero_rows(const Frame& F, bf16_t* dst, int ldd, int row0, int nrows, int col0, int ncols) {
    const int per = ncols / 8; const long tot = (long)nrows * per;
    for (long i = (long)F.bid * NTHREADS + F.tid; i < tot; i += (long)F.G * NTHREADS) { const int r = (int)(i / per), c = (int)(i % per) * 8;
        *(u32x4*)(dst + (size_t)(row0 + r) * ldd + col0 + c) = (u32x4){0u, 0u, 0u, 0u}; }
}
__device__ __forceinline__ void phase_prologue(const Frame& F) {
    {
        LAS float* sl = (LAS float*)F.lds;
        LAS float* red = (LAS float*)(F.lds + 33 * 256 * 4);
        const float* c = F.in(1); const float* cc = F.in(3); const float* wm = F.in(4); const float* bm = F.in(5);
        const int tx = F.tid & 63, ty = F.tid >> 6;
        for (int unit = F.bid; unit < 4 * 96; unit += F.G) {
            const int layer = unit / 96, col0 = (unit % 96) * 64;
            float acc[33];
#pragma unroll
            for (int r = 0; r < 33; ++r) acc[r] = 0.f;
#pragma unroll 1
            for (int kc = 0; kc < 4; ++kc) {
                __syncthreads();
                for (int i = F.tid; i < 33 * 256; i += NTHREADS) { const int r = i >> 8, k = (i & 255) + kc * 256; const float x = r < 32 ? c[r * D + k] : cc[k]; sl[i] = x * sigmoidf_(x); }
                __syncthreads();
#pragma unroll 1
                for (int k4 = 0; k4 < 32; k4 += 4) {
                    const int kl = ty * 32 + k4;
                    float w[4];
#pragma unroll
                    for (int e = 0; e < 4; ++e) w[e] = wm[((size_t)layer * D + kc * 256 + kl + e) * 6144 + col0 + tx];
#pragma unroll
                    for (int r = 0; r < 33; ++r) { const f32x4 s = *(const LAS f32x4*)(sl + r * 256 + kl); acc[r] += s[0] * w[0] + s[1] * w[1] + s[2] * w[2] + s[3] * w[3]; if ((r & 7) == 7) asm volatile("" ::: "memory"); }
                }
            }
            __syncthreads();
#pragma unroll
            for (int r = 0; r < 33; ++r) red[(ty * 33 + r) * 64 + tx] = acc[r];
            __syncthreads();
            for (int i = F.tid; i < 33 * 64; i += NTHREADS) { const int r = i >> 6, x = i & 63; float s = 0.f;
#pragma unroll
                for (int y = 0; y < 8; ++y) s += red[(y * 33 + r) * 64 + x];
                const int col = col0 + x; s += bm[layer * 6144 + col];
                if (r < 32) F.wsp<float>(WS_MODL)[((size_t)layer * NB + r) * 6144 + col] = s; else F.wsp<float>(WS_MODC)[(size_t)layer * 6144 + col] = s; }
        }
    }
    __syncthreads();
    transpose_all(F);
    for (int a = 0; a < 2; ++a) {
        bf16_t* WLp = F.wsp<bf16_t>(WS_WL) + (size_t)a * 512 * K1CAT;
        if (a == 0) zero_rows(F, WLp, K1CAT, 384, 128, 0, K1CAT); else zero_rows(F, WLp, K1CAT, 416, 96, 0, K1CAT);
        zero_rows(F, F.wsp<bf16_t>(WS_G2T) + (size_t)a * D * 256, 256, 0, D, 128, 128);
    }
    zero_rows(F, F.wsp<bf16_t>(WS_V2T), 256, 0, D, 0, 128); zero_rows(F, F.wsp<bf16_t>(WS_V2T), 256, 0, D, 160, 96);
    {
        const float* src = F.in(33); bf16_t* dst = F.wsp<bf16_t>(WS_WSP); const long tot = (long)2 * 16 * 128 * 128 / 4;
        for (long i = (long)F.bid * NTHREADS + F.tid; i < tot; i += (long)F.G * NTHREADS) { const f32x4 v = *(const f32x4*)(src + i * 4); u32x2 w; w.x = pk2(v[0], v[1]); w.y = pk2(v[2], v[3]); *(u32x2*)(dst + i * 4) = w; }
    }
    __syncthreads();
}

__device__ __forceinline__ void phase_norm1(const Frame& F, int g, int layer  , bf16_t* dst, int ldh, bool dry = false) {
    bf16_t* X = F.wsp<bf16_t>(WS_X);
    const bf16_t* Y0 = F.ar<bf16_t>(AR_YM0); const bf16_t* Y1 = F.ar<bf16_t>(AR_YM1);
    const bool fin = layer == 4;
    const int rpb = (TG + F.G - 1) / F.G, rbeg = F.bid * rpb, rend = (rbeg + rpb) < TG ? (rbeg + rpb) : TG;
    int key = -1; f32x4 cg[4], cA[4], cB[4];
#pragma unroll
    for (int q = 0; q < 4; ++q) { cg[q] = (f32x4){0.f, 0.f, 0.f, 0.f}; cA[q] = cg[q]; cB[q] = cg[q]; }
    for (int r = rbeg + F.wave; r < rend; r += NWAVES) {
        const int bl = r / LT, t = r % LT, b = g * BG + bl; const bool isctx = t < LC;
        if (isctx && layer >= 3) continue;
        if (key != b * 2 + (int)isctx) {
            key = b * 2 + (int)isctx;
#pragma unroll
            for (int q = 0; q < 4; ++q) { const int c = q * 256 + F.lane * 4;
                if (layer > 0) cg[q] = *(const f32x4*)((isctx ? F.modC(layer - 1, 5) : F.modL(layer - 1, b, 5)) + c);
                if (fin) cA[q] = *(const f32x4*)(F.in(41) + c);
                else { const f32x4 gv = *(const f32x4*)(F.in(6) + (size_t)layer * D + c), cv = *(const f32x4*)((isctx ? F.modC(layer, 1) : F.modL(layer, b, 1)) + c);
                    cA[q] = gv * (1.0f + cv); cB[q] = *(const f32x4*)((isctx ? F.modC(layer, 0) : F.modL(layer, b, 0)) + c); } }
        }
        f32x4 x[4], xo[4];
#pragma unroll
        for (int q = 0; q < 4; ++q) xo[q] = (f32x4){0.f, 0.f, 0.f, 0.f};
        if (layer == 0) {
            const float* src = isctx ? F.in(2) + ((size_t)b * LC + t) * D : F.in(0) + ((size_t)b * SEQ + (t - LC)) * D;
#pragma unroll
            for (int q = 0; q < 4; ++q) x[q] = *(const f32x4*)(src + q * 256 + F.lane * 4);
        } else {
#pragma unroll
            for (int q = 0; q < 4; ++q) { const int c = q * 256 + F.lane * 4;
                { const u32x2 xw = *(const u32x2*)(X + (size_t)r * D + c); x[q] = (f32x4){lo16(xw.x), hi16(xw.x), lo16(xw.y), hi16(xw.y)}; } xo[q] = x[q];
                const u32x2 a = *(const u32x2*)(Y0 + (size_t)r * D + c), bb = *(const u32x2*)(Y1 + (size_t)r * D + c);
                x[q][0] += cg[q][0] * (lo16(a.x) + lo16(bb.x)); x[q][1] += cg[q][1] * (hi16(a.x) + hi16(bb.x));
                x[q][2] += cg[q][2] * (lo16(a.y) + lo16(bb.y)); x[q][3] += cg[q][3] * (hi16(a.y) + hi16(bb.y)); }
        }
        float ss = 0.f;
#pragma unroll
        for (int q = 0; q < 4; ++q) ss += x[q][0] * x[q][0] + x[q][1] * x[q][1] + x[q][2] * x[q][2] + x[q][3] * x[q][3];
        ss = wave_sum_dpp(ss);
        const float rstd = rsqrtf(ss * (1.0f / D) + 1e-6f);
        if (fin) {
            float* o = F.outp() + ((size_t)b * SEQ + (t - LC)) * D;
#pragma unroll
            for (int q = 0; q < 4; ++q) { const int c = q * 256 + F.lane * 4; *(f32x4*)(o + c) = x[q] * rstd * cA[q]; }
        } else {
#pragma unroll
            for (int q = 0; q < 4; ++q) { const int c = q * 256 + F.lane * 4;
                { const f32x4 xs = (dry && layer > 0) ? xo[q] : x[q]; u32x2 xw; xw.x = pk2(xs[0], xs[1]); xw.y = pk2(xs[2], xs[3]); *(u32x2*)(X + (size_t)r * D + c) = xw; }
                const f32x4 h = x[q] * rstd * cA[q] + cB[q];
                u32x2 w; w.x = pk2(h[0], h[1]); w.y = pk2(h[2], h[3]);
                *(u32x2*)(dst + (size_t)r * ldh + c) = w; }
        }
    }
}
__device__ __forceinline__ void phase_mix(const Frame& F, int a) {
    bf16_t* H2 = F.ar<bf16_t>(AR_H2); bf16_t* XM = F.ar<bf16_t>(AR_XR);
    const float* mu = F.in(8) + (size_t)a * 6 * D;
    f32x4 cm[2][3][2];
#pragma unroll
    for (int q = 0; q < 2; ++q)
#pragma unroll
        for (int m = 0; m < 3; ++m) { const int mi = m == 0 ? 0 : (m == 1 ? 2 : 3); const int c = q * 512 + F.lane * 8;
            cm[q][m][0] = *(const f32x4*)(mu + mi * D + c); cm[q][m][1] = *(const f32x4*)(mu + mi * D + c + 4); }
    const int rpb = (TG + F.G - 1) / F.G, rbeg = F.bid * rpb, rend = (rbeg + rpb) < TG ? (rbeg + rpb) : TG;
    for (int r = rbeg + F.wave; r < rend; r += NWAVES) {
        const int t = r % LT; const bool isctx = t < LC; const int p = t - LC;
#pragma unroll
        for (int q = 0; q < 2; ++q) {
            const int c = q * 512 + F.lane * 8;
            int nr;
            if (isctx) nr = (q == 0) ? (t > 0 ? r - 1 : -1) : (t < LC - 1 ? r + 1 : -1);
            else { const int qu = c >> 8;
                nr = qu == 0 ? ((p & 63) > 0 ? r - 1 : -1) : qu == 1 ? ((p & 63) < 63 ? r + 1 : -1) : qu == 2 ? (p >= 64 ? r - 64 : -1) : (p < SEQ - 64 ? r + 64 : -1); }
            const u32x4 hs = *(const u32x4*)(H2 + (size_t)r * 2048 + c);
            u32x4 hn = (u32x4){0u, 0u, 0u, 0u};
            if (nr >= 0) hn = *(const u32x4*)(H2 + (size_t)nr * 2048 + c);
            const float h[8] = {lo16(hs.x), hi16(hs.x), lo16(hs.y), hi16(hs.y), lo16(hs.z), hi16(hs.z), lo16(hs.w), hi16(hs.w)};
            const float n[8] = {lo16(hn.x), hi16(hn.x), lo16(hn.y), hi16(hn.y), lo16(hn.z), hi16(hn.z), lo16(hn.w), hi16(hn.w)};
            float dd[8];
#pragma unroll
            for (int e = 0; e < 8; ++e) dd[e] = n[e] - h[e];
            *(u32x4*)(H2 + (size_t)r * 2048 + 1024 + c) = (u32x4){pk2(dd[0], dd[1]), pk2(dd[2], dd[3]), pk2(dd[4], dd[5]), pk2(dd[6], dd[7])};
#pragma unroll
            for (int m = 0; m < 3; ++m) {
                const f32x4 m0 = cm[q][m][0], m1 = cm[q][m][1];
                float x[8];
#pragma unroll
                for (int e = 0; e < 4; ++e) { x[e] = h[e] + dd[e] * m0[e]; x[4 + e] = h[4 + e] + dd[4 + e] * m1[e]; }
                *(u32x4*)(XM + (size_t)m * TG * D + (size_t)r * D + c) = (u32x4){pk2(x[0], x[1]), pk2(x[2], x[3]), pk2(x[4], x[5]), pk2(x[6], x[7])};
            }
        }
    }
}
__device__ __forceinline__ void phase_vfix(const Frame& F) {
    bf16_t* V = F.ar<bf16_t>(AR_V); const bf16_t* VF = F.wsp<bf16_t>(WS_VF); const bf16_t* GT = F.ar<bf16_t>(AR_VGATE);
    const size_t tot = (size_t)TG * D / 8;
    for (size_t i = (size_t)F.bid * NTHREADS + F.tid; i < tot; i += (size_t)F.G * NTHREADS) {
        const u32x4 v = *(const u32x4*)(V + i * 8), f = *(const u32x4*)(VF + i * 8), g = *(const u32x4*)(GT + i * 8);
        u32x4 o;
        o.x = pk2(lo16(v.x) + (lo16(f.x) - lo16(v.x)) * lo16(g.x), hi16(v.x) + (hi16(f.x) - hi16(v.x)) * hi16(g.x));
        o.y = pk2(lo16(v.y) + (lo16(f.y) - lo16(v.y)) * lo16(g.y), hi16(v.y) + (hi16(f.y) - hi16(v.y)) * hi16(g.y));
        o.z = pk2(lo16(v.z) + (lo16(f.z) - lo16(v.z)) * lo16(g.z), hi16(v.z) + (hi16(f.z) - hi16(v.z)) * hi16(g.z));
        o.w = pk2(lo16(v.w) + (lo16(f.w) - lo16(v.w)) * lo16(g.w), hi16(v.w) + (hi16(f.w) - hi16(v.w)) * hi16(g.w));
        *(u32x4*)(V + i * 8) = o;
    }
}
__device__ __forceinline__ void phase_post(const Frame& F, int a, const bf16_t* V) {
    const bf16_t* Y0 = F.ar<bf16_t>(AR_Y0); bf16_t* YG = F.ar<bf16_t>(AR_R); const bf16_t* Y1 = F.ar<bf16_t>(AR_Y1); const float* DOT = F.ar<float>(AR_DOT); const bf16_t* Gb = F.ar<bf16_t>(AR_G);
    const float* lgp = F.in(27) + (size_t)a * D + F.lane * 16; const float* lbp = F.in(28) + (size_t)a * D + F.lane * 16;
    float lg[16], lb[16];
#pragma unroll
    for (int e = 0; e < 16; e += 4) { const f32x4 gq = *(const f32x4*)(lgp + e), bq = *(const f32x4*)(lbp + e);
        lg[e] = gq[0]; lg[e + 1] = gq[1]; lg[e + 2] = gq[2]; lg[e + 3] = gq[3]; lb[e] = bq[0]; lb[e + 1] = bq[1]; lb[e + 2] = bq[2]; lb[e + 3] = bq[3]; }
    const int rpb = (TG + F.G - 1) / F.G, rbeg = F.bid * rpb, rend = (rbeg + rpb) < TG ? (rbeg + rpb) : TG;
    for (int r = rbeg + F.wave; r < rend; r += NWAVES) {
        const int c = F.lane * 16, h = F.lane >> 2;
        float y[16], vv[16];
#pragma unroll
        for (int q = 0; q < 2; ++q) {
            const u32x4 a0 = *(const u32x4*)(Y0 + (size_t)r * D + c + q * 8), a1 = *(const u32x4*)(Y1 + (size_t)r * D + c + q * 8), v4 = *(const u32x4*)(V + (size_t)r * D + c + q * 8);
            y[q * 8 + 0] = lo16(a0.x) + lo16(a1.x); y[q * 8 + 1] = hi16(a0.x) + hi16(a1.x); y[q * 8 + 2] = lo16(a0.y) + lo16(a1.y); y[q * 8 + 3] = hi16(a0.y) + hi16(a1.y);
            y[q * 8 + 4] = lo16(a0.z) + lo16(a1.z); y[q * 8 + 5] = hi16(a0.z) + hi16(a1.z); y[q * 8 + 6] = lo16(a0.w) + lo16(a1.w); y[q * 8 + 7] = hi16(a0.w) + hi16(a1.w);
            vv[q * 8 + 0] = lo16(v4.x); vv[q * 8 + 1] = hi16(v4.x); vv[q * 8 + 2] = lo16(v4.y); vv[q * 8 + 3] = hi16(v4.y);
            vv[q * 8 + 4] = lo16(v4.z); vv[q * 8 + 5] = hi16(v4.z); vv[q * 8 + 6] = lo16(v4.w); vv[q * 8 + 7] = hi16(v4.w);
        }
        float s = 0.f;
#pragma unroll
        for (int e = 0; e < 16; ++e) s += y[e];
        s = red4(s); const float mean = s * (1.0f / 64.0f);
        float qv = 0.f;
#pragma unroll
        for (int e = 0; e < 16; ++e) { const float dd = y[e] - mean; qv += dd * dd; }
        qv = red4(qv); const float rstd = rsqrtf(qv * (1.0f / 64.0f) + 64e-5f);
        const float dsum = DOT[(size_t)r * NH + h] + DOT[((size_t)TG + r) * NH + h];
        unsigned o[8];
        const u32x4 g0 = *(const u32x4*)(Gb + (size_t)r * D + c), g1 = *(const u32x4*)(Gb + (size_t)r * D + c + 8);
        const unsigned gw[8] = {g0.x, g0.y, g0.z, g0.w, g1.x, g1.y, g1.z, g1.w};
#pragma unroll
        for (int e = 0; e < 16; e += 2) {
            const float o0 = ((y[e] - mean) * rstd * lg[e] + lb[e] + vv[e] * dsum) * lo16(gw[e >> 1]);
            const float o1 = ((y[e + 1] - mean) * rstd * lg[e + 1] + lb[e + 1] + vv[e + 1] * dsum) * hi16(gw[e >> 1]);
            o[e >> 1] = pk2(o0, o1);
        }
        *(u32x4*)(YG + (size_t)r * D + c) = (u32x4){o[0], o[1], o[2], o[3]};
        *(u32x4*)(YG + (size_t)r * D + c + 8) = (u32x4){o[4], o[5], o[6], o[7]};
    }
}
__device__ __forceinline__ void phase_norm2(const Frame& F, int g, int layer, bool dry = false) {
    bf16_t* X = F.wsp<bf16_t>(WS_X); bf16_t* HM = F.ar<bf16_t>(AR_HM); const bf16_t* Ob = F.ar<bf16_t>(AR_O);
    int* lists = dry ? F.ar<int>(AR_YM0) : F.ar<int>(AR_LIST); float* lwt = dry ? F.ar<float>(AR_YM0) + (size_t)32 * TG : F.ar<float>(AR_LW);
    unsigned* cnt = (unsigned*)(F.ws + WS_CTL + CTL_CNT_OFF) + (((size_t)g * 4 + layer) * 32 + (dry ? NG * 4 * 32 : 0)) * 16;
    LAS float* wr = (LAS float*)F.lds;
    __syncthreads();
    for (int i = F.tid; i < D * NEXP / 4; i += NTHREADS) { const int c = i >> 2, e4 = i & 3; const int rho = (c & ~255) + (c & 3) * 64 + ((c & 255) >> 2);
        *(LAS f32x4*)(wr + rho * 20 + e4 * 4) = *(const f32x4*)(F.in(36) + i * 4); }
    __syncthreads();
    const float* rbias = F.in(37);
    const bool ctx_out = layer < 2;
    LAS int* lcnt = (LAS int*)(F.lds + LDS_MISC + 512);
    LAS int* lbase = (LAS int*)(F.lds + LDS_MISC + 640);
    LAS int* rec = (LAS int*)(F.lds + 81920);
    const int rpb = (TG + F.G - 1) / F.G, rbeg = F.bid * rpb, rend = (rbeg + rpb) < TG ? (rbeg + rpb) : TG;
    const int niter = (rpb + NWAVES - 1) / NWAVES;
    int key = -1; f32x4 cg[4], cA[4], cB[4];
#pragma unroll
    for (int q = 0; q < 4; ++q) { cg[q] = (f32x4){0.f, 0.f, 0.f, 0.f}; cA[q] = cg[q]; cB[q] = cg[q]; }
    for (int it0 = 0; it0 < niter; it0 += 64) {
        if (F.tid < 32) lcnt[F.tid] = 0;
        __syncthreads();
        const int itn = (niter - it0) < 64 ? (niter - it0) : 64;
        for (int itl = 0; itl < itn; ++itl) {
            const int r = rbeg + (it0 + itl) * NWAVES + F.wave;
            const int bl = r / LT, t = r % LT, b = g * BG + bl; const bool isctx = t < LC;
            const int slot = itl * NWAVES + F.wave;
            if (r >= rend || (isctx && !ctx_out)) { if (F.lane == 0) rec[slot * 4] = -1; continue; }
            if (key != b * 2 + (int)isctx) {
                key = b * 2 + (int)isctx;
#pragma unroll
                for (int q = 0; q < 4; ++q) { const int c = q * 256 + F.lane * 4;
                    cg[q] = *(const f32x4*)((isctx ? F.modC(layer, 2) : F.modL(layer, b, 2)) + c);
                    const f32x4 gv = *(const f32x4*)(F.in(7) + (size_t)layer * D + c), cv = *(const f32x4*)((isctx ? F.modC(layer, 4) : F.modL(layer, b, 4)) + c);
                    cA[q] = gv * (1.0f + cv); cB[q] = *(const f32x4*)((isctx ? F.modC(layer, 3) : F.modL(layer, b, 3)) + c); }
            }
            f32x4 x[4]; float ss = 0.f;
#pragma unroll
            for (int q = 0; q < 4; ++q) { const int c = q * 256 + F.lane * 4;
                { const u32x2 xw = *(const u32x2*)(X + (size_t)r * D + c); x[q] = (f32x4){lo16(xw.x), hi16(xw.x), lo16(xw.y), hi16(xw.y)}; }
                const u32x2 ob = *(const u32x2*)(Ob + (size_t)r * D + c); const f32x4 gv = cg[q];
                const f32x4 xo = x[q];
                x[q][0] += gv[0] * lo16(ob.x); x[q][1] += gv[1] * hi16(ob.x); x[q][2] += gv[2] * lo16(ob.y); x[q][3] += gv[3] * hi16(ob.y);
                { const f32x4 xs = dry ? xo : x[q]; u32x2 xw; xw.x = pk2(xs[0], xs[1]); xw.y = pk2(xs[2], xs[3]); *(u32x2*)(X + (size_t)r * D + c) = xw; }
                ss += x[q][0] * x[q][0] + x[q][1] * x[q][1] + x[q][2] * x[q][2] + x[q][3] * x[q][3]; }
            ss = wave_sum_dpp(ss);
            const float rstd = rsqrtf(ss * (1.0f / D) + 1e-6f);
            float lg[16];
#pragma unroll
            for (int e = 0; e < 16; ++e) lg[e] = 0.f;
#pragma unroll
            for (int q = 0; q < 4; ++q) { const int c = q * 256 + F.lane * 4;
                const f32x4 h = x[q] * rstd * cA[q] + cB[q];
                u32x2 w; w.x = pk2(h[0], h[1]); w.y = pk2(h[2], h[3]);
                *(u32x2*)(HM + (size_t)r * D + c) = w;
#pragma unroll
                for (int j = 0; j < 4; ++j) {
#pragma unroll
                    for (int e4 = 0; e4 < 4; ++e4) { const f32x4 wv = *(const LAS f32x4*)(wr + (q * 256 + j * 64 + F.lane) * 20 + e4 * 4);
                        lg[e4 * 4 + 0] += h[j] * wv[0]; lg[e4 * 4 + 1] += h[j] * wv[1]; lg[e4 * 4 + 2] += h[j] * wv[2]; lg[e4 * 4 + 3] += h[j] * wv[3]; } }
            }
#pragma unroll
            for (int e = 0; e < 16; ++e) lg[e] = wave_sum_dpp(lg[e]);
            float sc_[16], bs[16];
#pragma unroll
            for (int e = 0; e < 16; ++e) { sc_[e] = sigmoidf_(lg[e]); bs[e] = sc_[e] + rbias[e]; }
            float gs[4];
#pragma unroll
            for (int gq = 0; gq < 4; ++gq) { float m1 = -1e30f, m2 = -1e30f;
#pragma unroll
                for (int j = 0; j < 4; ++j) { const float v = bs[gq * 4 + j]; if (v > m1) { m2 = m1; m1 = v; } else if (v > m2) m2 = v; }
                gs[gq] = m1 + m2; }
            int best = 0; float bv = gs[0];
#pragma unroll
            for (int gq = 1; gq < 4; ++gq) if (gs[gq] > bv) { bv = gs[gq]; best = gq; }
            float cb[4], cs[4];
#pragma unroll
            for (int j = 0; j < 4; ++j) { cb[j] = best == 0 ? bs[j] : best == 1 ? bs[4 + j] : best == 2 ? bs[8 + j] : bs[12 + j]; cs[j] = best == 0 ? sc_[j] : best == 1 ? sc_[4 + j] : best == 2 ? sc_[8 + j] : sc_[12 + j]; }
            int j1 = 0; float v1 = cb[0];
#pragma unroll
            for (int j = 1; j < 4; ++j) if (cb[j] > v1) { v1 = cb[j]; j1 = j; }
            int j2 = -1; float v2 = -1e30f;
#pragma unroll
            for (int j = 0; j < 4; ++j) if (j != j1 && cb[j] > v2) { v2 = cb[j]; j2 = j; }
            const float s1 = j1 == 0 ? cs[0] : j1 == 1 ? cs[1] : j1 == 2 ? cs[2] : cs[3];
            const float s2 = j2 == 0 ? cs[0] : j2 == 1 ? cs[1] : j2 == 2 ? cs[2] : cs[3];
            const float inv = __builtin_amdgcn_rcpf(s1 + s2);
            if (F.lane == 0) {
                const int l1 = (best * 4 + j1) * 2 + 0, l2 = (best * 4 + j2) * 2 + 1;
                const int p1 = __hip_atomic_fetch_add(lcnt + l1, 1, __ATOMIC_RELAXED, __HIP_MEMORY_SCOPE_WORKGROUP);
                const int p2 = __hip_atomic_fetch_add(lcnt + l2, 1, __ATOMIC_RELAXED, __HIP_MEMORY_SCOPE_WORKGROUP);
                rec[slot * 4 + 0] = l1 | (p1 << 8); rec[slot * 4 + 1] = l2 | (p2 << 8);
                rec[slot * 4 + 2] = __float_as_int(s1 * inv); rec[slot * 4 + 3] = __float_as_int(s2 * inv);
            }
        }
        __syncthreads();
        if (F.tid < 32) { const int c = lcnt[F.tid]; lbase[F.tid] = c ? (int)atomicAdd(&cnt[F.tid * 16], (unsigned)c) : 0; }
        __syncthreads();
        for (int slot = F.tid; slot < itn * NWAVES; slot += NTHREADS) {
            const int a0 = rec[slot * 4 + 0]; if (a0 < 0) continue;
            const int a1 = rec[slot * 4 + 1];
            const int r = rbeg + (it0 + slot / NWAVES) * NWAVES + (slot % NWAVES);
            const int l1 = a0 & 255, l2 = a1 & 255; const int q1 = lbase[l1] + (a0 >> 8), q2 = lbase[l2] + (a1 >> 8);
            lists[(size_t)l1 * TG + q1] = r; lwt[(size_t)l1 * TG + q1] = __int_as_float(rec[slot * 4 + 2]);
            lists[(size_t)l2 * TG + q2] = r; lwt[(size_t)l2 * TG + q2] = __int_as_float(rec[slot * 4 + 3]);
        }
        __syncthreads();
    }
}
__device__ __forceinline__ int moe_tables(const Frame& F, int g, int layer) {
    LAS int* cn = (LAS int*)(F.lds + LDS_MISC + 64); LAS int* tb = (LAS int*)(F.lds + LDS_MISC + 192);
    const unsigned* cnt = (const unsigned*)(F.ws + WS_CTL + CTL_CNT_OFF) + ((size_t)g * 4 + layer) * 32 * 16;
    __syncthreads();
    if (F.tid == 0) { int acc = 0; for (int l = 0; l < 32; ++l) { const int c = (int)__hip_atomic_load(cnt + l * 16, __ATOMIC_RELAXED, __HIP_MEMORY_SCOPE_AGENT); cn[l] = c; tb[l] = acc; acc += (c + 255) >> 8; } tb[32] = acc; }
    __syncthreads();
    return tb[32];
}

constexpr int SC_OPB = 6 * 4096;
constexpr int SC_HALF = 2 * SC_OPB + 4096 + 4096;
static_assert(2 * SC_HALF <= LDS_STAGE, "scan lds");
__device__ __forceinline__ int scan_tok(int d, int s) { return d == 0 ? s : (s < LC ? (LC - 1 - s) : (LT + LC - 1 - s)); }
__device__ __forceinline__ void phase_scan(const Frame& F, int a, const bf16_t* V) {
    const bf16_t* R = F.ar<bf16_t>(AR_R); const bf16_t* Kb = F.ar<bf16_t>(AR_K); const bf16_t* L1 = F.ar<bf16_t>(AR_L1);
    const int half = F.wave >> 2, q = F.wave & 3, lane = F.lane, li = q * 64 + lane;
    LAS unsigned char* hb = F.lds + half * SC_HALF;
    LAS float* aT = (LAS float*)(hb + 2 * SC_OPB); LAS float* ybuf = (LAS float*)(hb + 2 * SC_OPB + 4096);
    const int arr = q >> 1, ntl = (q & 1) * 2;
    const int i = lane >> 3, j = lane & 7, r0 = 16 * q + 2 * i;
    const int tB = li >> 4, k4 = (li & 15) * 4;
    for (int pr = F.bid; pr < BG * 16; pr += F.G) {
        const int bl = pr >> 4, d = (pr >> 3) & 1, hp = pr & 7, h = hp * 2 + half;
        bf16_t* Yd = F.ar<bf16_t>(d ? AR_Y1 : AR_Y0); float* DOT = F.ar<float>(AR_DOT) + (size_t)d * TG * NH;
        const size_t rowb = (size_t)bl * LT;
        const bf16_t* W2 = (arr == 0 ? F.wsp<bf16_t>(WS_W2T) : F.wsp<bf16_t>(WS_A2T)) + ((size_t)a * 2 + d) * D * 64;
        bf16x8 Bf[2][2]; float bias[2];
#pragma unroll
        for (int nt = 0; nt < 2; ++nt) { const int cc = h * 64 + (ntl + nt) * 16 + (lane & 15);
            bias[nt] = (arr == 0 ? F.in(13) : F.in(16))[((size_t)a * 2 + d) * D + cc];
#pragma unroll
            for (int s = 0; s < 2; ++s) Bf[nt][s] = *(const bf16x8*)(W2 + (size_t)cc * 64 + 32 * s + 8 * (lane >> 4)); }
        const f32x4 kkc = *(const f32x4*)(F.in(24) + (size_t)a * D + h * 64 + k4), kac = *(const f32x4*)(F.in(25) + (size_t)a * D + h * 64 + k4), rkc = *(const f32x4*)(F.in(26) + (size_t)a * D + h * 64 + k4);
        const int acol = arr * 128 + d * 64 + 8 * (lane >> 4);
        float S0[8], S1[8];
#pragma unroll
        for (int c = 0; c < 8; ++c) { S0[c] = 0.f; S1[c] = 0.f; }
        bf16x8 Af[2]; u32x2 kraw, rraw, vraw;
#define SC_LOAD(ch) do { const size_t rowA = rowb + scan_tok(d, (ch) * 16 + (lane & 15)); \
        Af[0] = *(const bf16x8*)(L1 + rowA * 512 + acol); Af[1] = *(const bf16x8*)(L1 + rowA * 512 + acol + 32); \
        const size_t rowBq = (rowb + scan_tok(d, (ch) * 16 + tB)) * D + h * 64 + k4; \
        kraw = *(const u32x2*)(Kb + rowBq); rraw = *(const u32x2*)(R + rowBq); vraw = *(const u32x2*)(V + rowBq); } while (0)
#define SC_PASSA(buf) do { LAS float* op = (LAS float*)(hb + (buf) * SC_OPB); \
        _Pragma("unroll") for (int nt = 0; nt < 2; ++nt) { f32x4 ac = (f32x4){0.f, 0.f, 0.f, 0.f}; \
            ac = __builtin_amdgcn_mfma_f32_16x16x32_bf16(Af[0], Bf[nt][0], ac, 0, 0, 0); ac = __builtin_amdgcn_mfma_f32_16x16x32_bf16(Af[1], Bf[nt][1], ac, 0, 0, 0); \
            const int n = (ntl + nt) * 16 + (lane & 15); \
              \
            f32x4 sg; _Pragma("unroll") for (int rg = 0; rg < 4; ++rg) sg[rg] = sigmoidf_(ac[rg] + bias[nt]); \
            if (arr == 0) { _Pragma("unroll") for (int rg = 0; rg < 4; ++rg) op[1024 + ((lane >> 4) * 4 + rg) * 64 + n] = __expf(-0.60653066f * sg[rg]); } \
            else { _Pragma("unroll") for (int rg = 0; rg < 4; ++rg) aT[((lane >> 4) * 4 + rg) * 64 + n] = sg[rg]; } } } while (0)
#define SC_PASSB(ch, buf) do { LAS float* op = (LAS float*)(hb + (buf) * SC_OPB); \
        const float kf[4] = {lo16(kraw.x), hi16(kraw.x), lo16(kraw.y), hi16(kraw.y)}; const float rf[4] = {lo16(rraw.x), hi16(rraw.x), lo16(rraw.y), hi16(rraw.y)}; \
        const float vf[4] = {lo16(vraw.x), hi16(vraw.x), lo16(vraw.y), hi16(vraw.y)}; \
        const f32x4 av = *(const LAS f32x4*)(aT + tB * 64 + k4); \
        float kq[4], ssq = 0.f; _Pragma("unroll") for (int e = 0; e < 4; ++e) { kq[e] = kf[e] * kkc[e]; ssq += kq[e] * kq[e]; } \
        ssq = red16(ssq); const float inv = __builtin_amdgcn_rsqf(fmaxf(ssq, 1e-24f)); \
        f32x4 o_kk, o_kka, o_kd, o_r, o_v; float dp = 0.f; \
        _Pragma("unroll") for (int e = 0; e < 4; ++e) { const float kkv = kq[e] * inv; const float kd = kf[e] * (1.0f + (av[e] - 1.0f) * kac[e]); \
            o_kk[e] = kkv; o_kka[e] = kkv * av[e]; o_kd[e] = kd; o_r[e] = rf[e]; o_v[e] = vf[e]; dp += rf[e] * kd * rkc[e]; } \
        dp = red16(dp); \
        if ((li & 15) == 0) DOT[(rowb + scan_tok(d, (ch) * 16 + tB)) * NH + h] = dp; \
        *(LAS f32x4*)(op + 0 * 1024 + tB * 64 + k4) = o_kk; *(LAS f32x4*)(op + 2 * 1024 + tB * 64 + k4) = o_kka; *(LAS f32x4*)(op + 3 * 1024 + tB * 64 + k4) = o_kd; \
        *(LAS f32x4*)(op + 4 * 1024 + tB * 64 + k4) = o_r; *(LAS f32x4*)(op + 5 * 1024 + tB * 64 + k4) = o_v; } while (0)
        __syncthreads();
        SC_LOAD(0);
        SC_PASSA(0);
        __syncthreads();
        SC_PASSB(0, 0);
        __syncthreads();
        constexpr int NCH = LT / 16;
        for (int ch = 0; ch < NCH; ++ch) {
            const int buf = ch & 1;
            if (ch + 1 < NCH) SC_LOAD(ch + 1);
            const LAS float* op = (const LAS float*)(hb + buf * SC_OPB);
            f32x4 cA[5], cB[5], nA[5], nB[5]; f32x2 cv, nv;
#define SC_OPLOAD(dA, dB, dv, t) do { const LAS float* ob_ = op + (t) * 64 + j * 8; \
                _Pragma("unroll") for (int q_ = 0; q_ < 5; ++q_) { dA[q_] = *(const LAS f32x4*)(ob_ + q_ * 1024); dB[q_] = *(const LAS f32x4*)(ob_ + q_ * 1024 + 4); } \
                dv = *(const LAS f32x2*)(op + 5 * 1024 + (t) * 64 + r0); } while (0)
            SC_OPLOAD(cA, cB, cv, 0);
#pragma unroll
            for (int t = 0; t < 16; ++t) {
                if (t + 1 < 16) SC_OPLOAD(nA, nB, nv, t + 1);
                const float kk[8] = {cA[0][0], cA[0][1], cA[0][2], cA[0][3], cB[0][0], cB[0][1], cB[0][2], cB[0][3]};
                const float dc[8] = {cA[1][0], cA[1][1], cA[1][2], cA[1][3], cB[1][0], cB[1][1], cB[1][2], cB[1][3]};
                const float ka[8] = {cA[2][0], cA[2][1], cA[2][2], cA[2][3], cB[2][0], cB[2][1], cB[2][2], cB[2][3]};
                const float kd[8] = {cA[3][0], cA[3][1], cA[3][2], cA[3][3], cB[3][0], cB[3][1], cB[3][2], cB[3][3]};
                const float rr[8] = {cA[4][0], cA[4][1], cA[4][2], cA[4][3], cB[4][0], cB[4][1], cB[4][2], cB[4][3]};
                float sa0 = (S0[0] * kk[0] + S0[1] * kk[1]) + (S0[2] * kk[2] + S0[3] * kk[3]) + ((S0[4] * kk[4] + S0[5] * kk[5]) + (S0[6] * kk[6] + S0[7] * kk[7]));
                float sa1 = (S1[0] * kk[0] + S1[1] * kk[1]) + (S1[2] * kk[2] + S1[3] * kk[3]) + ((S1[4] * kk[4] + S1[5] * kk[5]) + (S1[6] * kk[6] + S1[7] * kk[7]));
                sa0 = red8(sa0); sa1 = red8(sa1);
#pragma unroll
                for (int c = 0; c < 8; ++c) {
                    S0[c] = S0[c] * dc[c] + (cv[0] * kd[c] - sa0 * ka[c]);
                    S1[c] = S1[c] * dc[c] + (cv[1] * kd[c] - sa1 * ka[c]);
                }
                float y0 = (S0[0] * rr[0] + S0[1] * rr[1]) + (S0[2] * rr[2] + S0[3] * rr[3]) + ((S0[4] * rr[4] + S0[5] * rr[5]) + (S0[6] * rr[6] + S0[7] * rr[7]));
                float y1 = (S1[0] * rr[0] + S1[1] * rr[1]) + (S1[2] * rr[2] + S1[3] * rr[3]) + ((S1[4] * rr[4] + S1[5] * rr[5]) + (S1[6] * rr[6] + S1[7] * rr[7]));
                y0 = red8(y0); y1 = red8(y1);
                if (j == 0) *(LAS f32x2*)(ybuf + t * 64 + r0) = (f32x2){y0, y1};
#pragma unroll
                for (int q_ = 0; q_ < 5; ++q_) { cA[q_] = nA[q_]; cB[q_] = nB[q_]; }
                cv = nv;
            }
#undef SC_OPLOAD
            __syncthreads();
            {
                const f32x4 yv = *(const LAS f32x4*)(ybuf + tB * 64 + k4);
                u32x2 w; w.x = pk2(yv[0], yv[1]); w.y = pk2(yv[2], yv[3]);
                *(u32x2*)(Yd + (rowb + scan_tok(d, ch * 16 + tB)) * D + h * 64 + k4) = w;
            }
            if (ch + 1 < NCH) SC_PASSA(buf ^ 1);
            __syncthreads();
            if (ch + 1 < NCH) SC_PASSB(ch + 1, buf ^ 1);
            __syncthreads();
        }
#undef SC_LOAD
#undef SC_PASSA
#undef SC_PASSB
    }
}

__device__ __forceinline__ void phase_sgstats(const Frame& F, int layer) {
    const bf16_t* Z = F.ar<bf16_t>(AR_Z); float* ST = F.ar<float>(AR_ST);
    for (int r = F.bid * NWAVES + F.wave; r < TG; r += F.G * NWAVES) {
        const int t = r % LT; if (t < LC && layer >= 3) continue;
        float x[32];
#pragma unroll
        for (int q = 0; q < 4; ++q) { const u32x4 w = *(const u32x4*)(Z + (size_t)r * 4096 + 2048 + q * 512 + F.lane * 8);
            x[q * 8 + 0] = lo16(w.x); x[q * 8 + 1] = hi16(w.x); x[q * 8 + 2] = lo16(w.y); x[q * 8 + 3] = hi16(w.y); x[q * 8 + 4] = lo16(w.z); x[q * 8 + 5] = hi16(w.z); x[q * 8 + 6] = lo16(w.w); x[q * 8 + 7] = hi16(w.w); }
        float s = 0.f;
#pragma unroll
        for (int e = 0; e < 32; ++e) s += x[e];
        s = wave_sum(s); const float mean = s * (1.0f / 2048.0f);
        float qv = 0.f;
#pragma unroll
        for (int e = 0; e < 32; ++e) { const float dd = x[e] - mean; qv += dd * dd; }
        qv = wave_sum(qv);
        if (F.lane == 0) *(f32x2*)(ST + (size_t)r * 2) = (f32x2){mean, rsqrtf(qv * (1.0f / 2048.0f) + 1e-5f)};
    }
}
__device__ __forceinline__ int vt_off(int dch, int jb) { return dch * 256 + ((jb ^ ((dch & 15) ^ (((dch >> 4) & 7) << 1))) << 4); }
__device__ __forceinline__ void phase_spatial(const Frame& F, int bsg, int layer) {
    const bf16_t* Z = F.ar<bf16_t>(AR_Z); const float* ST = F.ar<float>(AR_ST); bf16_t* Pb = F.ar<bf16_t>(AR_P);
    const bf16_t* Ws = F.wsp<bf16_t>(WS_WSP) + (size_t)bsg * 16 * 128 * 128;
    const float* lng = F.in(31) + (size_t)bsg * 2048; const float* lnb = F.in(32) + (size_t)bsg * 2048; const float* bs = F.in(34) + (size_t)bsg * 16 * 128;
    LAS unsigned char* vt = F.lds;
    const int skip = layer >= 3;
    const int nchunk = skip ? BG * 16 : BG * 18;
    const int w = F.wave, lane = F.lane, dt = w >> 1, it0 = (w & 1) * 2;
    const int jj0 = F.tid >> 4, c8 = (F.tid & 15) * 8;
    u32x4 zz[4]; f32x2 st[4];
#define SP_ROW0(U_) ((size_t)(skip ? (((U_) >> 4) >> 4) * 18 + 2 + (((U_) >> 4) & 15) : ((U_) >> 4)) * 128)
#define SP_LOADZ(U_) do { const size_t r0_ = SP_ROW0(U_); const int gi_ = (U_) & 15; _Pragma("unroll") for (int k = 0; k < 4; ++k) { \
        zz[k] = *(const u32x4*)(Z + (r0_ + jj0 + 32 * k) * 4096 + 2048 + gi_ * 128 + c8); st[k] = *(const f32x2*)(ST + (r0_ + jj0 + 32 * k) * 2); } } while (0)
    if (F.bid < nchunk * 16) SP_LOADZ(F.bid);
    for (int U = F.bid; U < nchunk * 16; U += F.G) {
        const int gi = U & 15;
        const size_t row0 = SP_ROW0(U);
        const f32x4 g0 = *(const f32x4*)(lng + gi * 128 + c8), g1 = *(const f32x4*)(lng + gi * 128 + c8 + 4), b0 = *(const f32x4*)(lnb + gi * 128 + c8), b1 = *(const f32x4*)(lnb + gi * 128 + c8 + 4);
        const float gg[8] = {g0[0], g0[1], g0[2], g0[3], g1[0], g1[1], g1[2], g1[3]}, bb[8] = {b0[0], b0[1], b0[2], b0[3], b1[0], b1[1], b1[2], b1[3]};
        __syncthreads();
#pragma unroll
        for (int k = 0; k < 4; ++k) {
            const int jj = jj0 + 32 * k;
            const float xv[8] = {lo16(zz[k].x), hi16(zz[k].x), lo16(zz[k].y), hi16(zz[k].y), lo16(zz[k].z), hi16(zz[k].z), lo16(zz[k].w), hi16(zz[k].w)};
#pragma unroll
            for (int e = 0; e < 8; e += 2) {
                const unsigned pw = pk2((xv[e] - st[k][0]) * st[k][1] * gg[e] + bb[e], (xv[e + 1] - st[k][0]) * st[k][1] * gg[e + 1] + bb[e + 1]);
                *(LAS unsigned short*)(vt + vt_off(c8 + e, jj >> 3) + (jj & 7) * 2) = (unsigned short)(pw & 0xFFFFu);
                *(LAS unsigned short*)(vt + vt_off(c8 + e + 1, jj >> 3) + (jj & 7) * 2) = (unsigned short)(pw >> 16);
            }
        }
        const bf16_t* w0p = Ws + ((size_t)gi * 128 + it0 * 32 + (lane & 31)) * 128 + 8 * (lane >> 5);
        bf16x8 B0[8], B1[8];
#pragma unroll
        for (int s_ = 0; s_ < 8; ++s_) { B0[s_] = *(const bf16x8*)(w0p + 16 * s_); B1[s_] = *(const bf16x8*)(w0p + 32 * 128 + 16 * s_); }
        u32x2 uu[2][4]; float bias[2];
#pragma unroll
        for (int it = 0; it < 2; ++it) { const int ii = (it0 + it) * 32 + (lane & 31); bias[it] = bs[gi * 128 + ii];
#pragma unroll
            for (int rq = 0; rq < 4; ++rq) uu[it][rq] = *(const u32x2*)(Z + (row0 + ii) * 4096 + gi * 128 + dt * 32 + 8 * rq + 4 * (lane >> 5)); }
        if (U + F.G < nchunk * 16) SP_LOADZ(U + F.G);
        __syncthreads();
        f32x16 acc0, acc1;
#pragma unroll
        for (int e = 0; e < 16; ++e) { acc0[e] = 0.f; acc1[e] = 0.f; }
        const int dA = dt * 32 + (lane & 31);
#pragma unroll
        for (int s_ = 0; s_ < 8; ++s_) {
            const bf16x8 Afr = *(const LAS bf16x8*)(vt + vt_off(dA, 2 * s_ + (lane >> 5)));
            acc0 = __builtin_amdgcn_mfma_f32_32x32x16_bf16(Afr, B0[s_], acc0, 0, 0, 0);
            acc1 = __builtin_amdgcn_mfma_f32_32x32x16_bf16(Afr, B1[s_], acc1, 0, 0, 0);
        }
#pragma unroll
        for (int it = 0; it < 2; ++it) {
            const int ii = (it0 + it) * 32 + (lane & 31); const size_t row = row0 + ii;
#pragma unroll
            for (int rq = 0; rq < 4; ++rq) {
                const int d0 = dt * 32 + 8 * rq + 4 * (lane >> 5);
                float vs[4];
#pragma unroll
                for (int e = 0; e < 4; ++e) vs[e] = (it == 0 ? acc0[rq * 4 + e] : acc1[rq * 4 + e]) + bias[it];
                u32x2 o; o.x = pk2(lo16(uu[it][rq].x) * vs[0], hi16(uu[it][rq].x) * vs[1]); o.y = pk2(lo16(uu[it][rq].y) * vs[2], hi16(uu[it][rq].y) * vs[3]);
                *(u32x2*)(Pb + row * 2048 + gi * 128 + d0) = o;
            }
        }
    }
#undef SP_ROW0
#undef SP_LOADZ
    __syncthreads();
}

__global__ void __launch_bounds__(NTHREADS, 2) fwd_kernel(Params P) {
    extern __shared__ __attribute__((aligned(16))) unsigned char lds_raw[];
    Frame F; F.lds = (LAS unsigned char*)lds_raw; F.tid = threadIdx.x; F.lane = F.tid & 63; F.wave = __builtin_amdgcn_readfirstlane(F.tid >> 6);
    F.G = gridDim.x; F.bid = blockIdx.x; F.ws = P.ws; F.kp = (const Params __attribute__((address_space(4)))*)__builtin_amdgcn_kernarg_segment_ptr();
    const int lo = P.ph_lo, hi = P.ph_hi;
    volatile LAS unsigned* misc = (volatile LAS unsigned*)(F.lds + LDS_MISC);
    if (F.tid < 4) misc[F.tid] = 0u;
    __syncthreads();
    XcdBarrier bar; bar.bar = (unsigned*)(F.ws + WS_CTL); bar.x = 0; bar.st = misc;
    if (hi - lo > 1) bar = xcd_barrier_post((unsigned*)(F.ws + WS_CTL), misc);
    int ph = 0;
#define RUN(id, ...) do { if (ph >= lo && ph < hi) { const int nrep_ = ((REP_MASK >> (id)) & 1u) ? 2 : 1; for (int rep_ = 0; rep_ < nrep_; ++rep_) { const bool dry_ = (rep_ + 1 < nrep_); (void)dry_; { int t_ = threadIdx.x; const Params __attribute__((address_space(4)))* kp_ = (const Params __attribute__((address_space(4)))*)__builtin_amdgcn_kernarg_segment_ptr(); asm volatile("" : "+v"(t_), "+s"(kp_)); F.tid = t_; F.lane = t_ & 63; F.kp = kp_; F.ws = kp_->ws; } __VA_ARGS__; if (rep_ + 1 < nrep_ || ph + 1 < hi) xcd_barrier(bar); } } ++ph; } while (0)

    RUN(0, phase_prologue(F));
    for (int g = 0; g < NG; ++g) {
        for (int layer = 0; layer < 4; ++layer) {
            const int a = layer >> 1;
            if ((layer & 1) == 0) {
                const bf16_t* Vc = layer == 0 ? F.wsp<bf16_t>(WS_VF) : F.ar<bf16_t>(AR_V);
                RUN(1, phase_norm1(F, g, layer, F.ar<bf16_t>(AR_H2), 2048, dry_));
                RUN(2, phase_mix(F, a));
                RUN(3, { { pg8::SchedPlain S; S.init(TG / 256, 2, F.G, F.bid, 0);
                        EpiL1 E{F.ar<bf16_t>(AR_L1)};
                        pg8::gemm_phase(F.tid, F.lds, F.ar<bf16_t>(AR_H2), K1CAT, F.wsp<bf16_t>(WS_WL) + (size_t)a * 512 * K1CAT, K1CAT, K1CAT, S, E); }
                      { pg8::SchedRKV S; S.init(TG / 256, 12, F.G, (F.bid + 192) % F.G, 0);
                        EpiRKV E{F.ws, layer == 0 ? WS_VF : WS_ARENA + AR_V};
                        pg8::gemm_phase(F.tid, F.lds, F.ar<bf16_t>(AR_XR), D, F.wsp<bf16_t>(WS_WRKV) + (size_t)a * 3072 * D, D, D, S, E); } });
                if (layer == 2) {
                    RUN(4, { pg8::SchedPlain S; S.init(TG / 256, 4, F.G, F.bid, 0);
                          EpiStore<1> E{F.ar<bf16_t>(AR_VGATE), F.in(19)};
                          pg8::gemm_phase(F.tid, F.lds, F.ar<bf16_t>(AR_L1) + 256, 512, F.wsp<bf16_t>(WS_V2T), 256, 256, S, E); });
                    RUN(5, phase_vfix(F));
                }
                RUN(6, phase_scan(F, a, Vc));
                RUN(7, { pg8::SchedPlain S; S.init(TG / 256, 4, F.G, F.bid, 0);
                      EpiStore<0> E{F.ar<bf16_t>(AR_G), nullptr};
                      pg8::gemm_phase(F.tid, F.lds, F.ar<bf16_t>(AR_L1) + 256, 512, F.wsp<bf16_t>(WS_G2T) + (size_t)a * D * 256, 256, 256, S, E); });
                RUN(8, phase_post(F, a, Vc));
                RUN(9, { const int skip = layer == 2; pg8::SchedPlain S; S.init(skip ? BG * 8 : TG / 256, 4, F.G, F.bid, skip);
                      EpiStore<0> E{F.ar<bf16_t>(AR_O), nullptr};
                      pg8::gemm_phase(F.tid, F.lds, F.ar<bf16_t>(AR_R), D, F.wsp<bf16_t>(WS_WO) + (size_t)a * D * D, D, D, S, E); });
            } else {
                const int skip = layer == 3;
                RUN(10, phase_norm1(F, g, layer, F.ar<bf16_t>(AR_H), D, dry_));
                RUN(11, { pg8::SchedPlain S; S.init(skip ? BG * 8 : TG / 256, 16, F.G, F.bid, skip);
                      EpiGelu E{F.ar<bf16_t>(AR_Z), F.in(30) + (size_t)a * 4096};
                      pg8::gemm_phase(F.tid, F.lds, F.ar<bf16_t>(AR_H), D, F.wsp<bf16_t>(WS_WIN) + (size_t)a * 4096 * D, D, D, S, E); });
                RUN(12, phase_sgstats(F, layer));
                RUN(13, phase_spatial(F, a, layer));
                RUN(14, { pg8::SchedPlain S; S.init(skip ? BG * 8 : TG / 256, 4, F.G, F.bid, skip);
                      EpiStore<0> E{F.ar<bf16_t>(AR_O), nullptr};
                      pg8::gemm_phase(F.tid, F.lds, F.ar<bf16_t>(AR_P), 2048, F.wsp<bf16_t>(WS_WOUT) + (size_t)a * D * 2048, 2048, 2048, S, E); });
            }
            RUN(15, phase_norm2(F, g, layer, dry_));
            RUN(16, { const int total = moe_tables(F, g, layer);
                  pg8::SchedMoe<true> S{(const LAS int*)(F.lds + LDS_MISC + 64), (const LAS int*)(F.lds + LDS_MISC + 192), F.ar<int>(AR_LIST), F.G, F.bid, total};
                  EpiMG E{F.ar<bf16_t>(AR_HE)};
                  pg8::gemm_phase(F.tid, F.lds, F.ar<bf16_t>(AR_HM), D, F.wsp<bf16_t>(WS_WGU) + (size_t)layer * NEXP * 1024 * D, D, D, S, E); });
            RUN(17, { const int total = moe_tables(F, g, layer);
                  pg8::SchedMoe<false> S{(const LAS int*)(F.lds + LDS_MISC + 64), (const LAS int*)(F.lds + LDS_MISC + 192), F.ar<int>(AR_LIST), F.G, F.bid, total};
                  EpiMD E{F.ar<bf16_t>(AR_YM0), F.ar<int>(AR_LIST), F.ar<float>(AR_LW), (const LAS int*)(F.lds + LDS_MISC + 64)};
                  pg8::gemm_phase(F.tid, F.lds, F.ar<bf16_t>(AR_HE), FEXP, F.wsp<bf16_t>(WS_WD) + (size_t)layer * NEXP * D * FEXP, FEXP, FEXP, S, E); });
        }
        RUN(18, phase_norm1(F, g, 4, nullptr, 0));
    }
#undef RUN
}
constexpr int NPHASES = 1 + NG * (10 + 8 + 12 + 8 + 1);

__global__ void nan_fill(float* out, size_t n) { for (size_t i = (size_t)blockIdx.x * blockDim.x + threadIdx.x; i < n; i += (size_t)gridDim.x * blockDim.x) out[i] = __uint_as_float(0x7FC00000u); }

extern "C" void kernel_launch(void* const* d_in, const int* in_sizes, int n_in, void* d_out, int out_size, void* d_ws, size_t ws_size, hipStream_t stream) {
    static int grid = 0;
    if (grid == 0) {
        int dev = 0, cus = 0, per_cu = 0;
        if (n_in != 42 || ws_size < WS_END || hipGetDevice(&dev) != hipSuccess || hipDeviceGetAttribute(&cus, hipDeviceAttributeMultiprocessorCount, dev) != hipSuccess) {
            fprintf(stderr, "kernel_launch: bad setup (n_in %d, ws %zu need %zu)\n", n_in, ws_size, (size_t)WS_END); grid = -1;
        } else if (hipFuncSetAttribute((const void*)fwd_kernel, hipFuncAttributeMaxDynamicSharedMemorySize, LDS_BYTES) != hipSuccess) { fprintf(stderr, "kernel_launch: hipFuncSetAttribute failed\n"); grid = -1; }
        else {
            if (hipOccupancyMaxActiveBlocksPerMultiprocessor(&per_cu, (const void*)fwd_kernel, NTHREADS, LDS_BYTES) != hipSuccess || per_cu < 1) { fprintf(stderr, "kernel_launch: occupancy query reports %d\n", per_cu); }
            (void)hipGetLastError();
            grid = cus;
        }
    }
    if (grid < 0) { hipLaunchKernelGGL(nan_fill, dim3(1024), dim3(256), 0, stream, (float*)d_out, (size_t)out_size); return; }
    (void)hipMemsetAsync((char*)d_ws + WS_CTL, 0, CTL_BYTES, stream);
    Params p{};
    for (int i = 0; i < 42; ++i) p.in[i] = (const float*)d_in[i];
    p.out = (float*)d_out; p.ws = (unsigned char*)d_ws;
#if PER_PHASE_LAUNCH
    for (int k = 0; k < NPHASES; ++k) { p.ph_lo = k; p.ph_hi = k + 1; hipLaunchKernelGGL(fwd_kernel, dim3(grid), dim3(NTHREADS), LDS_BYTES, stream, p); }
#else
    p.ph_lo = 0; p.ph_hi = NPHASES;
    hipLaunchKernelGGL(fwd_kernel, dim3(grid), dim3(NTHREADS), LDS_BYTES, stream, p);
#endif
}
```

```cpp
#include <hip/hip_runtime.h>
#include <cstdio>
#include <cstdint>

#ifndef REP_MASK
#define REP_MASK 0u
#endif
#ifndef PER_PHASE_LAUNCH
#define PER_PHASE_LAUNCH 0
#endif

#define LAS __attribute__((address_space(3)))
typedef unsigned short bf16_t;
typedef short bf16x8 __attribute__((ext_vector_type(8)));
typedef float f32x4 __attribute__((ext_vector_type(4)));
typedef float f32x2 __attribute__((ext_vector_type(2)));
typedef float f32x16 __attribute__((ext_vector_type(16)));
typedef unsigned u32x4 __attribute__((ext_vector_type(4)));
typedef unsigned u32x2 __attribute__((ext_vector_type(2)));

constexpr int NB = 32, SEQ = 2048, LC = 256, LT = SEQ + LC, D = 1024, NH = 16;
constexpr int NG = 2, BG = NB / NG, TG = BG * LT;
constexpr int NTHREADS = 512, NWAVES = 8;
constexpr int N1CAT = 3584, K1CAT = 2048;
constexpr int NEXP = 16, FEXP = 512;

constexpr size_t al256(size_t x) { return (x + 255) & ~(size_t)255; }
constexpr int XCD_BAR_WORDS_C = 3456;
constexpr size_t WS_CTL = 0;
constexpr size_t CTL_BAR_BYTES = (size_t)XCD_BAR_WORDS_C * 4;
constexpr size_t CTL_CNT_OFF = al256(CTL_BAR_BYTES);
constexpr size_t CTL_BYTES = al256(CTL_CNT_OFF + (size_t)2 * NG * 4 * 32 * 64);
constexpr size_t WS_X = al256(WS_CTL + CTL_BYTES);
constexpr size_t WS_VF = WS_X + (size_t)TG * D * 2;
constexpr size_t WS_MODL = WS_VF + (size_t)TG * D * 2;
constexpr size_t WS_MODC = WS_MODL + (size_t)4 * NB * 6 * D * 4;
constexpr size_t WS_WRKV = al256(WS_MODC + (size_t)4 * 6 * D * 4);
constexpr size_t WS_WL = WS_WRKV + (size_t)2 * 3072 * D * 2;
constexpr size_t WS_WO = WS_WL + (size_t)2 * 512 * K1CAT * 2;
constexpr size_t WS_G2T = WS_WO + (size_t)2 * D * D * 2;
constexpr size_t WS_V2T = WS_G2T + (size_t)2 * D * 256 * 2;
constexpr size_t WS_W2T = WS_V2T + (size_t)D * 256 * 2;
constexpr size_t WS_A2T = WS_W2T + (size_t)4 * D * 64 * 2;
constexpr size_t WS_WIN = WS_A2T + (size_t)4 * D * 64 * 2;
constexpr size_t WS_WOUT = WS_WIN + (size_t)2 * 4096 * D * 2;
constexpr size_t WS_WSP = WS_WOUT + (size_t)2 * D * 2048 * 2;
constexpr size_t WS_WGU = WS_WSP + (size_t)2 * 16 * 128 * 128 * 2;
constexpr size_t WS_WD = WS_WGU + (size_t)4 * NEXP * 1024 * D * 2;
constexpr size_t WS_ARENA = al256(WS_WD + (size_t)4 * NEXP * D * FEXP * 2);
constexpr size_t SZB = (size_t)TG * D * 2;
constexpr size_t AR_H2 = 0;
constexpr size_t AR_Y0 = 0, AR_Y1 = SZB;
constexpr size_t AR_XR = 2 * SZB;
constexpr size_t AR_R = 5 * SZB, AR_K = 6 * SZB, AR_V = 7 * SZB;
constexpr size_t AR_L1 = 8 * SZB;
constexpr size_t AR_DOT = AR_L1 + SZB / 2;
constexpr size_t AR_G = 2 * SZB;
constexpr size_t AR_VGATE = 0;
constexpr size_t AR_O = 3 * SZB;
constexpr size_t AR_H = 0;
constexpr size_t AR_Z = SZB;
constexpr size_t AR_P = 5 * SZB;
constexpr size_t AR_ST = 7 * SZB;
constexpr size_t AR_HM = 0;
constexpr size_t AR_HE = SZB;
constexpr size_t HE_ROWS = (size_t)2 * TG + 32 * 256;
constexpr size_t AR_LIST = al256(AR_HE + HE_ROWS * FEXP * 2);
constexpr size_t AR_LW = AR_LIST + (size_t)32 * TG * 4;
constexpr size_t AR_YM0 = 5 * SZB, AR_YM1 = 6 * SZB;
constexpr size_t ARENA_BYTES = AR_DOT + (size_t)2 * TG * 16 * 4 + 4096;
constexpr size_t WS_END = WS_ARENA + ARENA_BYTES;
static_assert(AR_LW + (size_t)32 * TG * 4 <= AR_O, "moe lists overlap");

constexpr int LDS_STAGE = 131072;
constexpr int LDS_MISC = LDS_STAGE;
constexpr int LDS_BYTES = LDS_STAGE + 1024;

struct Params {
    const float* in[42];
    float* out;
    unsigned char* ws;
    int ph_lo, ph_hi;
};

__device__ __forceinline__ float bf2f(unsigned short b) { return __uint_as_float(((unsigned)b) << 16); }
__device__ __forceinline__ unsigned short f2bf(float f) { unsigned u = __float_as_uint(f); u += 0x7FFFu + ((u >> 16) & 1u); return (unsigned short)(u >> 16); }
typedef __bf16 bf16x2_t __attribute__((ext_vector_type(2)));
__device__ __forceinline__ unsigned pk2(float lo, float hi) { const bf16x2_t v = __builtin_convertvector((f32x2){lo, hi}, bf16x2_t); return __builtin_bit_cast(unsigned, v); }
__device__ __forceinline__ float lo16(unsigned w) { return __uint_as_float(w << 16); }
__device__ __forceinline__ float hi16(unsigned w) { return __uint_as_float(w & 0xFFFF0000u); }
__device__ __forceinline__ float sigmoidf_(float x) { return __builtin_amdgcn_rcpf(1.0f + __expf(-x)); }
__device__ __forceinline__ float tanhf_(float x) { return 1.0f - 2.0f * __builtin_amdgcn_rcpf(__expf(2.0f * x) + 1.0f); }
__device__ __forceinline__ float wave_sum(float v) {
#pragma unroll
    for (int o = 32; o > 0; o >>= 1) v += __shfl_xor(v, o);
    return v;
}
template <int CTRL> __device__ __forceinline__ float dpp_f(float v) {
    return __int_as_float(__builtin_amdgcn_update_dpp(0, __float_as_int(v), CTRL, 0xF, 0xF, true));
}
__device__ __forceinline__ float red8(float v) { v += dpp_f<0xB1>(v); v += dpp_f<0x4E>(v); v += dpp_f<0x141>(v); return v; }
__device__ __forceinline__ float red16(float v) { v = red8(v); v += dpp_f<0x140>(v); return v; }
__device__ __forceinline__ float wave_sum_dpp(float v) {
    v = red16(v);
    const float a = __int_as_float(__builtin_amdgcn_readlane(__float_as_int(v), 0)), b = __int_as_float(__builtin_amdgcn_readlane(__float_as_int(v), 16));
    const float c = __int_as_float(__builtin_amdgcn_readlane(__float_as_int(v), 32)), d = __int_as_float(__builtin_amdgcn_readlane(__float_as_int(v), 48));
    return (a + b) + (c + d);
}
__device__ __forceinline__ float red4(float v) { v += dpp_f<0xB1>(v); v += dpp_f<0x4E>(v); return v; }
__device__ __forceinline__ f32x2 gelu_pk(f32x2 v) {
    const f32x2 av = __builtin_elementwise_abs(v), d = av * 0.2316418882f + 1.0f;
    f32x2 t; t.x = __builtin_amdgcn_rcpf(d.x); t.y = __builtin_amdgcn_rcpf(d.y);
    f32x2 q = t * 0.5307027145f + (-0.7265760135f); q = q * t + 0.7107068705f; q = q * t + (-0.142248368f); q = q * t + 0.127414796f; q = q * t;
    const f32x2 s = (v * v) * (-0.72134752044f);
    f32x2 e; e.x = __builtin_amdgcn_exp2f(s.x); e.y = __builtin_amdgcn_exp2f(s.y);
    const f32x2 m = v * (q * e), r = v - m;
    f32x2 o; o.x = v.x < 0.f ? m.x : r.x; o.y = v.y < 0.f ? m.y : r.y; return o;
}
__device__ __forceinline__ float gelu_f(float v) {
    const float av = fabsf(v), t = __builtin_amdgcn_rcpf(av * 0.2316418882f + 1.0f);
    float q = t * 0.5307027145f + (-0.7265760135f); q = q * t + 0.7107068705f; q = q * t + (-0.142248368f); q = q * t + 0.127414796f; q = q * t;
    const float e = __builtin_amdgcn_exp2f((v * v) * (-0.72134752044f));
    const float m = v * (q * e);
    return v < 0.f ? m : v - m;
}

#define XB_TMO      128
#define XB_XCNT(j)  (256  + 64 * (j))
#define XB_XSUB(j)  (1280 + 64 * (j))
#define XB_XGEN(j)  (2304 + 64 * (j))
#define XB_TOP      3328
#define XB_TOPGEN   3392
#define XCD_BAR_WORDS 3456
#define XB_SPIN_CAP (1u << 22)
static_assert(XCD_BAR_WORDS == XCD_BAR_WORDS_C, "barrier words");
__device__ __forceinline__ unsigned xb_ld(unsigned* p)              { return __hip_atomic_load(p, __ATOMIC_RELAXED, __HIP_MEMORY_SCOPE_AGENT); }
__device__ __forceinline__ unsigned xb_add(unsigned* p, unsigned v) { return __hip_atomic_fetch_add(p, v, __ATOMIC_RELAXED, __HIP_MEMORY_SCOPE_AGENT); }
__device__ __forceinline__ unsigned xb_xcc_id() { return (unsigned)__builtin_amdgcn_s_getreg((3 << 11) | 20) & 0xFu; }
#define XB_SPIN(cond, bar) do { unsigned _sp = 0; while (cond) { __builtin_amdgcn_s_sleep(1); \
    if ((++_sp & 255u) == 0u) { if (xb_ld(&(bar)[XB_TMO])) break; if (_sp > XB_SPIN_CAP) { atomicAdd(&(bar)[XB_TMO], 1u); break; } } } } while (0)
struct XcdBarrier { unsigned* bar; unsigned x; volatile LAS unsigned* st; };
__device__ __forceinline__ XcdBarrier xcd_barrier_post(unsigned* bar, volatile LAS unsigned* st) {
    XcdBarrier b; b.bar = bar; b.x = xb_xcc_id(); b.st = st;
    if (threadIdx.x == 0) (void)xb_add(&bar[XB_XCNT(b.x)], 1u);
    return b;
}
__device__ __forceinline__ void xcd_barrier_complete(unsigned* bar, unsigned x, unsigned& nloc, unsigned& nx) {
    const unsigned G = gridDim.x * gridDim.y * gridDim.z;
    unsigned sum, cnt, mine, sp = 0u;
    for (;;) {
        sum = 0u; cnt = 0u; mine = 0u;
#pragma unroll
        for (unsigned j = 0; j < 16; ++j) { const unsigned c = xb_ld(&bar[XB_XCNT(j)]); sum += c; cnt += (c > 0u) ? 1u : 0u; mine = (j == x) ? c : mine; }
        if (sum == G) break;
        __builtin_amdgcn_s_sleep(1);
        if ((++sp & 255u) == 0u) { if (xb_ld(&bar[XB_TMO])) break; if (sp > XB_SPIN_CAP) { atomicAdd(&bar[XB_TMO], 1u); break; } }
    }
    nloc = mine > 0u ? mine : 1u; nx = cnt > 0u ? cnt : 1u;
}
__device__ __forceinline__ void xcd_barrier(const XcdBarrier& b) {
    asm volatile("s_waitcnt vmcnt(0)" ::: "memory");
    __syncthreads();
    if (threadIdx.x == 0) {
        unsigned* bar = b.bar;
        __builtin_amdgcn_s_waitcnt(0);
        unsigned nloc = b.st[0], nx = b.st[1];
        if (nloc == 0u) { xcd_barrier_complete(bar, b.x, nloc, nx); b.st[0] = nloc; b.st[1] = nx; }
        const unsigned old = xb_add(&bar[XB_XSUB(b.x)], 1u);
        const unsigned gen = old / nloc;
        if (old + 1u == (gen + 1u) * nloc) {
            __builtin_amdgcn_fence(__ATOMIC_RELEASE, "agent");
            asm volatile("s_waitcnt vmcnt(0)" ::: "memory");
            const unsigned og = xb_add(&bar[XB_TOP], 1u);
            const unsigned tg = og / nx;
            if (og + 1u == (tg + 1u) * nx) xb_add(&bar[XB_TOPGEN], 1u);
            else XB_SPIN(xb_ld(&bar[XB_TOPGEN]) == tg, bar);
            __builtin_amdgcn_fence(__ATOMIC_ACQUIRE, "agent");
            xb_add(&bar[XB_XGEN(b.x)], 1u);
            asm volatile("s_waitcnt vmcnt(0)" ::: "memory");
        } else {
            XB_SPIN(xb_ld(&bar[XB_XGEN(b.x)]) == gen, bar);
            __builtin_amdgcn_fence(__ATOMIC_ACQUIRE, "agent");
            asm volatile("s_waitcnt vmcnt(0)" ::: "memory");
        }
    }
    __syncthreads();
}

namespace pg8 {
constexpr int BM = 256, BK = 64, HALF = 128, HTB = HALF * BK * 2, STAGE_BYTES = 8 * HTB, NXCD = 8, WGM = 8;
__host__ __device__ __forceinline__ int lds_byte(int r, int c) { const int st = (r >> 4) * 2 + (c >> 5), rr = r & 15, cc = c & 31, ob = rr * 64 + cc * 2; return st * 1024 + (ob ^ (((ob >> 9) & 1) << 5)); }
__host__ __device__ __forceinline__ void stage_rc(int b, int& R, int& C) { const int st = b / 1024, sb = b % 1024, swz = sb ^ (((sb >> 9) & 1) << 5); R = (st >> 1) * 16 + swz / 64; C = (st & 1) * 32 + (swz % 64) / 2; }
struct Unit { int pm, pn, aux; };

struct SchedPlain {
    static constexpr bool GATHER = false;
    int nM, nN, nwg, G, c, skipctx;
    __device__ void init(int nM_, int nN_, int G_, int c_, int skipctx_) { nM = nM_; nN = nN_; nwg = nM * nN; G = G_; c = c_; skipctx = skipctx_; }
    __device__ bool next(int i, Unit& u) const {
        const long L = (long)i * G + c; if (L >= nwg) return false;
        int wgid = (int)L; { const int q = nwg / NXCD, r = nwg % NXCD, xcd = wgid % NXCD, off = wgid / NXCD; wgid = (xcd < r ? xcd * (q + 1) : r * (q + 1) + (xcd - r) * q) + off; }
        const int nig = WGM * nN, gid = wgid / nig, fm = gid * WGM, gsz = (nM - fm) < WGM ? (nM - fm) : WGM;
        int pm = fm + ((wgid % nig) % gsz); u.pn = (wgid % nig) / gsz; u.aux = 0;
        if (skipctx) pm = (pm >> 3) * 9 + 1 + (pm & 7);
        u.pm = pm; return true;
    }
    __device__ __forceinline__ int arow(const Unit& u, int r) const { return u.pm * BM + r; }
};
struct SchedRKV : SchedPlain {
    __device__ bool next(int i, Unit& u) const { if (!SchedPlain::next(i, u)) return false; u.pm += (u.pn >> 2) * nM; return true; }
};
template <bool GATH> struct SchedMoe {
    static constexpr bool GATHER = GATH;
    const LAS int* cn; const LAS int* tb; const int* lists; int G, c, total;
    __device__ bool next(int i, Unit& u) const {
        const int U = i * G + c; if (U >= total * 4) return false;
        const int T = U >> 2, pn = U & 3; int l = 0;
        while (tb[l + 1] <= T) ++l;
        u.pm = T; u.pn = (l >> 1) * 4 + pn; u.aux = l | ((T - tb[l]) << 8); return true;
    }
    __device__ __forceinline__ int arow(const Unit& u, int r) const {
        if (!GATH) return u.pm * BM + r;
        const int l = u.aux & 255, idx = (u.aux >> 8) * BM + r;
        return idx < cn[l] ? lists[(size_t)l * TG + idx] : 0;
    }
};

template <class Epi, class Sched>
__device__ __forceinline__ void gemm_phase(const int tid, LAS unsigned char* lds, const bf16_t* A, int lda, const bf16_t* Bt, int ldb, int K, const Sched& S, const Epi& E) {
    constexpr bool GA = Sched::GATHER;
    const int wid = __builtin_amdgcn_readfirstlane(tid >> 6), lane = tid & 63, wr = wid >> 2, wc = wid & 3, fr = lane & 15, fq = lane >> 4;
    const int nt = K / BK;
    unsigned voffA[2], voffB[2];
#pragma unroll
    for (int i = 0; i < 2; ++i) { int R, C; stage_rc(tid * 16 + i * 8192, R, C); voffA[i] = (unsigned)(R * lda + C) * 2u; voffB[i] = (unsigned)(R * ldb + C) * 2u; }
    const size_t kstep = (size_t)(BK * 2);
    const size_t hstepA = (size_t)HALF * lda * 2, tstepA = 2 * hstepA;
    const size_t hstepB = (size_t)HALF * ldb * 2, tstepB = 2 * hstepB;
    const unsigned ldsw = (unsigned)wid * 1024u;
    const int aoff = lds_byte(wr * 64 + fr, fq * 8), boff = lds_byte(wc * 32 + fr, fq * 8);
#define PG8_SA(b, h) (((b) * 2 + (h)) * HTB)
#define PG8_SB(b, h) ((4 + (b) * 2 + (h)) * HTB)
#define PG8_STAGE(bufoff, gbase, voff) do { _Pragma("unroll") for (int _i = 0; _i < 2; ++_i) \
        __builtin_amdgcn_global_load_lds((const unsigned*)((const char*)(gbase) + (voff)[_i]), (LAS unsigned*)(lds + (bufoff) + ldsw + _i * 8192), 16, 0, 0); } while (0)
#define PG8_STAGE_A(bufoff, ub, gv, h, koff) do { if constexpr (GA) { PG8_STAGE(bufoff, (const char*)A + (koff), gv[h]); } else { PG8_STAGE(bufoff, (ub) + (h) * hstepA + (koff), voffA); } } while (0)
#define PG8_LDA(dst, b, h) do { _Pragma("unroll") for (int m = 0; m < 4; ++m) _Pragma("unroll") for (int k = 0; k < 2; ++k) dst[m][k] = *(const LAS bf16x8*)(lds + PG8_SA(b, h) + aoff + m * 2048 + k * 1024); } while (0)
#define PG8_LDB(dst, b, h) do { _Pragma("unroll") for (int n = 0; n < 2; ++n) _Pragma("unroll") for (int k = 0; k < 2; ++k) dst[n][k] = *(const LAS bf16x8*)(lds + PG8_SB(b, h) + boff + n * 2048 + k * 1024); } while (0)
#define PG8_MMA(ai, bj, At, Bt_) do { __builtin_amdgcn_s_setprio(1); _Pragma("unroll") for (int m = 0; m < 4; ++m) _Pragma("unroll") for (int n = 0; n < 2; ++n) _Pragma("unroll") for (int k = 0; k < 2; ++k) \
        acc[ai][bj][m][n] = __builtin_amdgcn_mfma_f32_16x16x32_bf16(Bt_[n][k], At[m][k], acc[ai][bj][m][n], 0, 0, 0); __builtin_amdgcn_s_setprio(0); } while (0)
#define PG8_WAIT_V(n) asm volatile("s_waitcnt vmcnt(" #n ")" ::: "memory")
#define PG8_WAIT_L(n) asm volatile("s_waitcnt lgkmcnt(" #n ")" ::: "memory")
#define PG8_BAR __builtin_amdgcn_s_barrier()
#define PG8_SCHED __builtin_amdgcn_sched_barrier(0)
#define PG8_GOFF(dst, u) do { if constexpr (GA) { _Pragma("unroll") for (int _h = 0; _h < 2; ++_h) _Pragma("unroll") for (int _i = 0; _i < 2; ++_i) { int R_, C_; stage_rc(tid * 16 + _i * 8192, R_, C_); \
        dst[_h][_i] = ((unsigned)S.arow(u, _h * HALF + R_) * (unsigned)lda + (unsigned)C_) * 2u; } } } while (0)
    Unit cur, nxt; int ui = 0;
    if (!S.next(0, cur)) return;
    f32x4 acc[2][2][4][2];
#pragma unroll
    for (int a = 0; a < 2; ++a)
#pragma unroll
        for (int b = 0; b < 2; ++b)
#pragma unroll
            for (int m = 0; m < 4; ++m)
#pragma unroll
                for (int n = 0; n < 2; ++n) acc[a][b][m][n] = (f32x4){0.f, 0.f, 0.f, 0.f};
    bf16x8 At[4][2], B0[2][2], B1[2][2];
    unsigned gAc[2][2], gAn[2][2];
    PG8_GOFF(gAc, cur);
    const char* cA = (const char*)A + (GA ? (size_t)0 : (size_t)cur.pm * tstepA);
    const char* cB = (const char*)Bt + (size_t)cur.pn * tstepB;
    PG8_STAGE(PG8_SB(0, 0), cB, voffB); PG8_STAGE_A(PG8_SA(0, 0), cA, gAc, 0, 0); PG8_STAGE(PG8_SB(0, 1), cB + hstepB, voffB); PG8_STAGE_A(PG8_SA(0, 1), cA, gAc, 1, 0);
    if (wr == 1) PG8_BAR;
    PG8_WAIT_V(4); PG8_BAR;
    PG8_STAGE(PG8_SB(1, 0), cB + kstep, voffB); PG8_STAGE_A(PG8_SA(1, 0), cA, gAc, 0, kstep); PG8_STAGE(PG8_SB(1, 1), cB + hstepB + kstep, voffB);
    PG8_WAIT_V(6); PG8_BAR;
    for (;;) {
        const bool has_next = S.next(ui + 1, nxt);
        if (has_next) { PG8_GOFF(gAn, nxt); }
        else if constexpr (GA) {
#pragma unroll
            for (int _h = 0; _h < 2; ++_h)
#pragma unroll
                for (int _i = 0; _i < 2; ++_i) gAn[_h][_i] = gAc[_h][_i];
        }
        const char* nA = (has_next && !GA) ? (const char*)A + (size_t)nxt.pm * tstepA : cA;
        const char* nB = has_next ? (const char*)Bt + (size_t)nxt.pn * tstepB : cB;
#pragma unroll 1
        for (int t = 0; t < nt; t += 2) {
            const bool last = (t == nt - 2);
            const size_t k1 = (size_t)(t + 1) * kstep;
            const size_t k2 = last ? (size_t)0 : (size_t)(t + 2) * kstep, k3 = k2 + kstep;
            const char* a2 = last ? nA : cA; const char* b2 = last ? nB : cB;
            unsigned g2[2][2];
            if constexpr (GA) {
#pragma unroll
                for (int _h = 0; _h < 2; ++_h)
#pragma unroll
                    for (int _i = 0; _i < 2; ++_i) g2[_h][_i] = last ? gAn[_h][_i] : gAc[_h][_i];
            }
            PG8_LDB(B0, 0, 0); PG8_SCHED; PG8_LDA(At, 0, 0); PG8_STAGE_A(PG8_SA(1, 1), cA, gAc, 1, k1);
            PG8_WAIT_L(8); PG8_BAR; PG8_WAIT_L(0); PG8_MMA(0, 0, At, B0); PG8_BAR; PG8_SCHED;
            PG8_LDB(B1, 0, 1); PG8_STAGE(PG8_SB(0, 0), b2 + k2, voffB);
            PG8_BAR; PG8_WAIT_L(0); PG8_MMA(0, 1, At, B1); PG8_BAR;
            PG8_LDA(At, 0, 1); PG8_STAGE_A(PG8_SA(0, 0), a2, g2, 0, k2);
            PG8_BAR; PG8_WAIT_L(0); PG8_MMA(1, 0, At, B0); PG8_BAR; PG8_SCHED;
            PG8_STAGE(PG8_SB(0, 1), b2 + hstepB + k2, voffB);
            PG8_WAIT_V(6); PG8_BAR; PG8_MMA(1, 1, At, B1); PG8_BAR;
            PG8_LDB(B0, 1, 0); PG8_SCHED; PG8_LDA(At, 1, 0); PG8_STAGE_A(PG8_SA(0, 1), a2, g2, 1, k2);
            PG8_WAIT_L(8); PG8_BAR; PG8_WAIT_L(0); PG8_MMA(0, 0, At, B0); PG8_BAR; PG8_SCHED;
            PG8_LDB(B1, 1, 1); PG8_STAGE(PG8_SB(1, 0), b2 + k3, voffB);
            PG8_BAR; PG8_WAIT_L(0); PG8_MMA(0, 1, At, B1); PG8_BAR;
            PG8_LDA(At, 1, 1); PG8_STAGE_A(PG8_SA(1, 0), a2, g2, 0, k3);
            PG8_BAR; PG8_WAIT_L(0); PG8_MMA(1, 0, At, B0); PG8_BAR; PG8_SCHED;
            PG8_STAGE(PG8_SB(1, 1), b2 + hstepB + k3, voffB);
            PG8_WAIT_V(6); PG8_BAR; PG8_MMA(1, 1, At, B1); PG8_BAR;
        }
        { int fr_e = fr, fq_e = fq; asm volatile("" : "+v"(fr_e), "+v"(fq_e)); E(acc, cur, wr, wc, fr_e, fq_e); }
        if (!has_next) break;
#pragma unroll
        for (int a = 0; a < 2; ++a)
#pragma unroll
            for (int b = 0; b < 2; ++b)
#pragma unroll
                for (int m = 0; m < 4; ++m)
#pragma unroll
                    for (int n = 0; n < 2; ++n) acc[a][b][m][n] = (f32x4){0.f, 0.f, 0.f, 0.f};
        cur = nxt; cA = nA; cB = nB; ++ui;
        if constexpr (GA) {
#pragma unroll
            for (int _h = 0; _h < 2; ++_h)
#pragma unroll
                for (int _i = 0; _i < 2; ++_i) gAc[_h][_i] = gAn[_h][_i];
        }
    }
    PG8_WAIT_V(0);
    if (wr == 0) PG8_BAR;
    PG8_BAR;
#undef PG8_SA
#undef PG8_SB
#undef PG8_STAGE
#undef PG8_STAGE_A
#undef PG8_LDA
#undef PG8_LDB
#undef PG8_MMA
#undef PG8_WAIT_V
#undef PG8_WAIT_L
#undef PG8_BAR
#undef PG8_SCHED
#undef PG8_GOFF
}
}
using pg8::Unit;

#define EPI_LOOP_BEGIN \
    _Pragma("unroll") for (int ai = 0; ai < 2; ++ai) _Pragma("unroll") for (int m = 0; m < 4; ++m) { const int trow = ai * 128 + wr * 64 + m * 16 + fr; \
    _Pragma("unroll") for (int bj = 0; bj < 2; ++bj) _Pragma("unroll") for (int n = 0; n < 2; ++n) { const int tcol = bj * 128 + wc * 32 + n * 16 + 4 * fq; const f32x4 v = acc[ai][bj][m][n];
#define EPI_LOOP_END } asm volatile("" ::: "memory"); }

struct EpiRKV {
    unsigned char* ws; size_t voff;
    __device__ __forceinline__ void operator()(const f32x4 (&acc)[2][2][4][2], const Unit& u, int wr, int wc, int fr, int fq) const {
        const int which = u.pn >> 2; const size_t row0 = (size_t)(u.pm - which * (TG / 256)) * 256;
        const size_t off = which == 0 ? (WS_ARENA + AR_R) : (which == 1 ? (WS_ARENA + AR_K) : voff);
        bf16_t* dst = (bf16_t*)(ws + off); const int cb = (u.pn & 3) * 256;
        EPI_LOOP_BEGIN
            u32x2 w; w.x = pk2(v[0], v[1]); w.y = pk2(v[2], v[3]);
            *(u32x2*)(dst + (row0 + trow) * D + cb + tcol) = w;
        EPI_LOOP_END
    }
};
struct EpiL1 {
    bf16_t* L1;
    __device__ __forceinline__ void operator()(const f32x4 (&acc)[2][2][4][2], const Unit& u, int wr, int wc, int fr, int fq) const {
        const int pn = u.pn; const size_t row0 = (size_t)u.pm * 256; const int cb = pn * 256;
        EPI_LOOP_BEGIN
            f32x4 o = v;
            if (pn == 0 && bj == 0) { o[0] = tanhf_(v[0]); o[1] = tanhf_(v[1]); o[2] = tanhf_(v[2]); o[3] = tanhf_(v[3]); }
            if (pn == 1 && bj == 0) { o[0] = sigmoidf_(v[0]); o[1] = sigmoidf_(v[1]); o[2] = sigmoidf_(v[2]); o[3] = sigmoidf_(v[3]); }
            u32x2 w; w.x = pk2(o[0], o[1]); w.y = pk2(o[2], o[3]);
            *(u32x2*)(L1 + (row0 + trow) * 512 + cb + tcol) = w;
        EPI_LOOP_END
    }
};
template <int ACT> struct EpiStore {
    bf16_t* O; const float* bias;
    __device__ __forceinline__ void operator()(const f32x4 (&acc)[2][2][4][2], const Unit& u, int wr, int wc, int fr, int fq) const {
        const size_t row0 = (size_t)u.pm * 256; const int cb = u.pn * 256;
        EPI_LOOP_BEGIN
            f32x4 o = v;
            if (ACT == 1) { const f32x4 b = *(const f32x4*)(bias + cb + tcol); o[0] = sigmoidf_(v[0] + b[0]); o[1] = sigmoidf_(v[1] + b[1]); o[2] = sigmoidf_(v[2] + b[2]); o[3] = sigmoidf_(v[3] + b[3]); }
            u32x2 w; w.x = pk2(o[0], o[1]); w.y = pk2(o[2], o[3]);
            *(u32x2*)(O + (row0 + trow) * D + cb + tcol) = w;
        EPI_LOOP_END
    }
};
struct EpiGelu {
    bf16_t* Z; const float* bias;
    __device__ __forceinline__ void operator()(const f32x4 (&acc)[2][2][4][2], const Unit& u, int wr, int wc, int fr, int fq) const {
        const size_t row0 = (size_t)u.pm * 256; const int cb = u.pn * 256;
        EPI_LOOP_BEGIN
            const f32x4 b = *(const f32x4*)(bias + cb + tcol);
            const f32x2 g0 = gelu_pk((f32x2){v[0] + b[0], v[1] + b[1]}), g1 = gelu_pk((f32x2){v[2] + b[2], v[3] + b[3]});
            u32x2 w; w.x = pk2(g0.x, g0.y); w.y = pk2(g1.x, g1.y);
            *(u32x2*)(Z + (row0 + trow) * 4096 + cb + tcol) = w;
        EPI_LOOP_END
    }
};
struct EpiMG {
    bf16_t* HE;
    __device__ __forceinline__ void operator()(const f32x4 (&acc)[2][2][4][2], const Unit& u, int wr, int wc, int fr, int fq) const {
        const size_t row0 = (size_t)u.pm * 256; const int pnl = u.pn & 3;
#pragma unroll
        for (int ai = 0; ai < 2; ++ai)
#pragma unroll
            for (int m = 0; m < 4; ++m) { const int trow = ai * 128 + wr * 64 + m * 16 + fr;
#pragma unroll
                for (int bj = 0; bj < 2; ++bj) {
                    const f32x4 gt = acc[ai][bj][m][0], up = acc[ai][bj][m][1];
                    const int f = (8 * pnl + 4 * bj + wc) * 16 + 4 * fq;
                    float o[4];
#pragma unroll
                    for (int e = 0; e < 4; ++e) o[e] = gt[e] * sigmoidf_(gt[e]) * up[e];
                    u32x2 w; w.x = pk2(o[0], o[1]); w.y = pk2(o[2], o[3]);
                    *(u32x2*)(HE + (row0 + trow) * FEXP + f) = w;
                } }
    }
};
struct EpiMD {
    bf16_t* Y0; const int* lists; const float* lw; const LAS int* cn;
    __device__ __forceinline__ void operator()(const f32x4 (&acc)[2][2][4][2], const Unit& u, int wr, int wc, int fr, int fq) const {
        const int l = u.aux & 255, t0 = (u.aux >> 8) * 256, cnt = cn[l]; const int cb = (u.pn & 3) * 256;
        bf16_t* Y = Y0 + (size_t)(l & 1) * ((AR_YM1 - AR_YM0) / 2);
#pragma unroll
        for (int ai = 0; ai < 2; ++ai)
#pragma unroll
            for (int m = 0; m < 4; ++m) { const int trow = ai * 128 + wr * 64 + m * 16 + fr; const int idx = t0 + trow;
                if (idx < cnt) {
                    const int tok = lists[(size_t)l * TG + idx]; const float wgt = lw[(size_t)l * TG + idx];
#pragma unroll
                    for (int bj = 0; bj < 2; ++bj)
#pragma unroll
                        for (int n = 0; n < 2; ++n) { const int tcol = bj * 128 + wc * 32 + n * 16 + 4 * fq; const f32x4 v = acc[ai][bj][m][n];
                            u32x2 w; w.x = pk2(v[0] * wgt, v[1] * wgt); w.y = pk2(v[2] * wgt, v[3] * wgt);
                            *(u32x2*)(Y + (size_t)tok * D + cb + tcol) = w; }
                } }
    }
};

struct Frame {
    const Params __attribute__((address_space(4)))* kp; LAS unsigned char* lds; int tid, lane, wave, G, bid;
    unsigned char* ws;
    __device__ __forceinline__ const float* in(int k) const { return kp->in[k]; }
    __device__ __forceinline__ float* outp() const { return kp->out; }
    template <class T> __device__ __forceinline__ T* wsp(size_t off) const { return (T*)(ws + off); }
    template <class T> __device__ __forceinline__ T* ar(size_t off) const { return (T*)(ws + WS_ARENA + off); }
    __device__ __forceinline__ const float* modL(int layer, int b, int j) const { return (const float*)(ws + WS_MODL) + (((size_t)layer * NB + b) * 6 + j) * D; }
    __device__ __forceinline__ const float* modC(int layer, int j) const { return (const float*)(ws + WS_MODC) + ((size_t)layer * 6 + j) * D; }
};

struct TJob { const float* src; bf16_t* dst; const float* ksc; int lds, K, N, ldd, kofs, nofs, inter; };
constexpr int NJOBS = 2 * 21 + 1 + 4 + 4 * NEXP * 3;
__device__ __forceinline__ TJob get_job(const Frame& F, int j) {
    TJob J; J.ksc = nullptr; J.kofs = 0; J.nofs = 0; J.inter = 0; J.K = 0; J.N = 0; J.lds = 0; J.ldd = 0; J.src = nullptr; J.dst = nullptr;
    if (j < 42) {
        const int a = j / 21, q = j % 21;
        if (q < 3) { J.src = F.in(9 + q) + (size_t)a * D * D; J.lds = D; J.K = D; J.N = D; J.dst = F.wsp<bf16_t>(WS_WRKV) + (size_t)a * 3072 * D; J.ldd = D; J.nofs = q * 1024; }
        else if (q < 15) {
            const int half = (q - 3) / 6, w = (q - 3) % 6; const float* mu = F.in(8) + (size_t)a * 6 * D;
            J.dst = F.wsp<bf16_t>(WS_WL) + (size_t)a * 512 * K1CAT; J.ldd = K1CAT; J.kofs = half * 1024; J.K = D; int mi = 0;
            if (w < 2) { J.src = F.in(14) + ((size_t)a * 2 + w) * D * 64; J.lds = 64; J.N = 64; J.nofs = w * 64; mi = 1; }
            else if (w < 4) { const int d = w - 2; J.src = F.in(17) + ((size_t)a * 2 + d) * D * 64; J.lds = 64; J.N = 64; J.nofs = 128 + d * 64; mi = 4; }
            else if (w == 4) { J.src = F.in(22) + (size_t)a * D * 128; J.lds = 128; J.N = 128; J.nofs = 256; mi = 5; }
            else { J.src = F.in(20); J.lds = 32; J.N = (a == 1) ? 32 : 0; J.nofs = 384; mi = 3; }
            if (half) J.ksc = mu + mi * D;
        } else if (q == 15) { J.src = F.in(12) + (size_t)a * D * D; J.lds = D; J.K = D; J.N = D; J.dst = F.wsp<bf16_t>(WS_WO) + (size_t)a * D * D; J.ldd = D; }
        else if (q == 16) { J.src = F.in(23) + (size_t)a * 128 * D; J.lds = D; J.K = 128; J.N = D; J.dst = F.wsp<bf16_t>(WS_G2T) + (size_t)a * D * 256; J.ldd = 256; }
        else if (q < 19) { const int d = q - 17; J.src = F.in(15) + ((size_t)a * 2 + d) * 64 * D; J.lds = D; J.K = 64; J.N = D; J.dst = F.wsp<bf16_t>(WS_W2T) + ((size_t)a * 2 + d) * D * 64; J.ldd = 64; }
        else { const int d = q - 19; J.src = F.in(18) + ((size_t)a * 2 + d) * 64 * D; J.lds = D; J.K = 64; J.N = D; J.dst = F.wsp<bf16_t>(WS_A2T) + ((size_t)a * 2 + d) * D * 64; J.ldd = 64; }
    } else if (j == 42) { J.src = F.in(21); J.lds = D; J.K = 32; J.N = D; J.dst = F.wsp<bf16_t>(WS_V2T); J.ldd = 256; J.kofs = 128; }
    else if (j < 47) {
        const int q = j - 43, b = q >> 1;
        if ((q & 1) == 0) { J.src = F.in(29) + (size_t)b * D * 4096; J.lds = 4096; J.K = D; J.N = 4096; J.dst = F.wsp<bf16_t>(WS_WIN) + (size_t)b * 4096 * D; J.ldd = D; }
        else { J.src = F.in(35) + (size_t)b * 2048 * D; J.lds = D; J.K = 2048; J.N = D; J.dst = F.wsp<bf16_t>(WS_WOUT) + (size_t)b * D * 2048; J.ldd = 2048; }
    } else {
        const int q = j - 47, ie = q / 3, w = q % 3;
        if (w < 2) { J.src = F.in(38 + w) + (size_t)ie * D * FEXP; J.lds = FEXP; J.K = D; J.N = FEXP; J.dst = F.wsp<bf16_t>(WS_WGU) + (size_t)ie * 1024 * D; J.ldd = D; J.nofs = w * 16; J.inter = 1; }
        else { J.src = F.in(40) + (size_t)ie * FEXP * D; J.lds = D; J.K = FEXP; J.N = D; J.dst = F.wsp<bf16_t>(WS_WD) + (size_t)ie * D * FEXP; J.ldd = FEXP; }
    }
    return J;
}
__device__ __forceinline__ void transpose_all(const Frame& F) {
    LAS float* tile = (LAS float*)F.lds;
    int tilectr = 0;
#pragma unroll 1
    for (int j = 0; j < NJOBS; ++j) {
        const TJob J = get_job(F, j);
        const int tk = (J.K + 127) / 128, tn = (J.N + 127) / 128, ntile = tk * tn;
        int t = (F.bid - (tilectr % F.G) + F.G) % F.G;
        tilectr += ntile;
#pragma unroll 1
        for (; t < ntile; t += F.G) {
            const int k0 = (t / tn) * 128, n0 = (t % tn) * 128;
            __syncthreads();
            float v[32];
#pragma unroll
            for (int e = 0; e < 32; ++e) { const int idx = F.tid + e * 512, kk = idx >> 7, nn = idx & 127;
                v[e] = 0.f; if (k0 + kk < J.K && n0 + nn < J.N) v[e] = J.src[(size_t)(k0 + kk) * J.lds + n0 + nn]; }
#pragma unroll
            for (int e = 0; e < 32; ++e) { const int idx = F.tid + e * 512, kk = idx >> 7, nn = idx & 127;
                float x = v[e]; if (J.ksc && k0 + kk < J.K) x *= J.ksc[k0 + kk];
                tile[kk * 129 + nn] = x; }
            __syncthreads();
#pragma unroll
            for (int e = 0; e < 16; ++e) { const int idx = F.tid + e * 512, nn = idx >> 6, kk = (idx & 63) * 2;
                if (k0 + kk < J.K && n0 + nn < J.N) { const int n = n0 + nn; const int row = J.nofs + (J.inter ? ((n >> 4) * 32 + (n & 15)) : n);
                    *(unsigned*)(J.dst + (size_t)row * J.ldd + J.kofs + k0 + kk) = pk2(tile[kk * 129 + nn], tile[(kk + 1) * 129 + nn]); } }
        }
    }
    __syncthreads();
}
__device__ __forceinline__ void zero_rows(const Frame& F, bf16_t* dst, int ldd, int row0, int nrows, int col0, int ncols) {
    const int per = ncols / 8; const long tot = (long)nrows * per;
    for (long i = (long)F.bid * NTHREADS + F.tid; i < tot; i += (long)F.G * NTHREADS) { const int r = (int)(i / per), c = (int)(i % per) * 8;
        *(u32x4*)(dst + (size_t)(row0 + r) * ldd + col0 + c) = (u32x4){0u, 0u, 0u, 0u}; }
}
__device__ __forceinline__ void phase_prologue(const Frame& F) {
    {
        LAS float* sl = (LAS float*)F.lds;
        LAS float* red = (LAS float*)(F.lds + 33 * 256 * 4);
        const float* c = F.in(1); const float* cc = F.in(3); const float* wm = F.in(4); const float* bm = F.in(5);
        const int tx = F.tid & 63, ty = F.tid >> 6;
        for (int unit = F.bid; unit < 4 * 96; unit += F.G) {
            const int layer = unit / 96, col0 = (unit % 96) * 64;
            float acc[33];
#pragma unroll
            for (int r = 0; r < 33; ++r) acc[r] = 0.f;
#pragma unroll 1
            for (int kc = 0; kc < 4; ++kc) {
                __syncthreads();
                for (int i = F.tid; i < 33 * 256; i += NTHREADS) { const int r = i >> 8, k = (i & 255) + kc * 256; const float x = r < 32 ? c[r * D + k] : cc[k]; sl[i] = x * sigmoidf_(x); }
                __syncthreads();
#pragma unroll 1
                for (int k4 = 0; k4 < 32; k4 += 4) {
                    const int kl = ty * 32 + k4;
                    float w[4];
#pragma unroll
                    for (int e = 0; e < 4; ++e) w[e] = wm[((size_t)layer * D + kc * 256 + kl + e) * 6144 + col0 + tx];
#pragma unroll
                    for (int r = 0; r < 33; ++r) { const f32x4 s = *(const LAS f32x4*)(sl + r * 256 + kl); acc[r] += s[0] * w[0] + s[1] * w[1] + s[2] * w[2] + s[3] * w[3]; if ((r & 7) == 7) asm volatile("" ::: "memory"); }
                }
            }
            __syncthreads();
#pragma unroll
            for (int r = 0; r < 33; ++r) red[(ty * 33 + r) * 64 + tx] = acc[r];
            __syncthreads();
            for (int i = F.tid; i < 33 * 64; i += NTHREADS) { const int r = i >> 6, x = i & 63; float s = 0.f;
#pragma unroll
                for (int y = 0; y < 8; ++y) s += red[(y * 33 + r) * 64 + x];
                const int col = col0 + x; s += bm[layer * 6144 + col];
                if (r < 32) F.wsp<float>(WS_MODL)[((size_t)layer * NB + r) * 6144 + col] = s; else F.wsp<float>(WS_MODC)[(size_t)layer * 6144 + col] = s; }
        }
    }
    __syncthreads();
    transpose_all(F);
    for (int a = 0; a < 2; ++a) {
        bf16_t* WLp = F.wsp<bf16_t>(WS_WL) + (size_t)a * 512 * K1CAT;
        if (a == 0) zero_rows(F, WLp, K1CAT, 384, 128, 0, K1CAT); else zero_rows(F, WLp, K1CAT, 416, 96, 0, K1CAT);
        zero_rows(F, F.wsp<bf16_t>(WS_G2T) + (size_t)a * D * 256, 256, 0, D, 128, 128);
    }
    zero_rows(F, F.wsp<bf16_t>(WS_V2T), 256, 0, D, 0, 128); zero_rows(F, F.wsp<bf16_t>(WS_V2T), 256, 0, D, 160, 96);
    {
        const float* src = F.in(33); bf16_t* dst = F.wsp<bf16_t>(WS_WSP); const long tot = (long)2 * 16 * 128 * 128 / 4;
        for (long i = (long)F.bid * NTHREADS + F.tid; i < tot; i += (long)F.G * NTHREADS) { const f32x4 v = *(const f32x4*)(src + i * 4); u32x2 w; w.x = pk2(v[0], v[1]); w.y = pk2(v[2], v[3]); *(u32x2*)(dst + i * 4) = w; }
    }
    __syncthreads();
}

__device__ __forceinline__ void phase_norm1(const Frame& F, int g, int layer  , bf16_t* dst, int ldh, bool dry = false) {
    bf16_t* X = F.wsp<bf16_t>(WS_X);
    const bf16_t* Y0 = F.ar<bf16_t>(AR_YM0); const bf16_t* Y1 = F.ar<bf16_t>(AR_YM1);
    const bool fin = layer == 4;
    const int rpb = (TG + F.G - 1) / F.G, rbeg = F.bid * rpb, rend = (rbeg + rpb) < TG ? (rbeg + rpb) : TG;
    int key = -1; f32x4 cg[4], cA[4], cB[4];
#pragma unroll
    for (int q = 0; q < 4; ++q) { cg[q] = (f32x4){0.f, 0.f, 0.f, 0.f}; cA[q] = cg[q]; cB[q] = cg[q]; }
    for (int r = rbeg + F.wave; r < rend; r += NWAVES) {
        const int bl = r / LT, t = r % LT, b = g * BG + bl; const bool isctx = t < LC;
        if (isctx && layer >= 3) continue;
        if (key != b * 2 + (int)isctx) {
            key = b * 2 + (int)isctx;
#pragma unroll
            for (int q = 0; q < 4; ++q) { const int c = q * 256 + F.lane * 4;
                if (layer > 0) cg[q] = *(const f32x4*)((isctx ? F.modC(layer - 1, 5) : F.modL(layer - 1, b, 5)) + c);
                if (fin) cA[q] = *(const f32x4*)(F.in(41) + c);
                else { const f32x4 gv = *(const f32x4*)(F.in(6) + (size_t)layer * D + c), cv = *(const f32x4*)((isctx ? F.modC(layer, 1) : F.modL(layer, b, 1)) + c);
                    cA[q] = gv * (1.0f + cv); cB[q] = *(const f32x4*)((isctx ? F.modC(layer, 0) : F.modL(layer, b, 0)) + c); } }
        }
        f32x4 x[4], xo[4];
#pragma unroll
        for (int q = 0; q < 4; ++q) xo[q] = (f32x4){0.f, 0.f, 0.f, 0.f};
        if (layer == 0) {
            const float* src = isctx ? F.in(2) + ((size_t)b * LC + t) * D : F.in(0) + ((size_t)b * SEQ + (t - LC)) * D;
#pragma unroll
            for (int q = 0; q < 4; ++q) x[q] = *(const f32x4*)(src + q * 256 + F.lane * 4);
        } else {
#pragma unroll
            for (int q = 0; q < 4; ++q) { const int c = q * 256 + F.lane * 4;
                { const u32x2 xw = *(const u32x2*)(X + (size_t)r * D + c); x[q] = (f32x4){lo16(xw.x), hi16(xw.x), lo16(xw.y), hi16(xw.y)}; } xo[q] = x[q];
                const u32x2 a = *(const u32x2*)(Y0 + (size_t)r * D + c), bb = *(const u32x2*)(Y1 + (size_t)r * D + c);
                x[q][0] += cg[q][0] * (lo16(a.x) + lo16(bb.x)); x[q][1] += cg[q][1] * (hi16(a.x) + hi16(bb.x));
                x[q][2] += cg[q][2] * (lo16(a.y) + lo16(bb.y)); x[q][3] += cg[q][3] * (hi16(a.y) + hi16(bb.y)); }
        }
        float ss = 0.f;
#pragma unroll
        for (int q = 0; q < 4; ++q) ss += x[q][0] * x[q][0] + x[q][1] * x[q][1] + x[q][2] * x[q][2] + x[q][3] * x[q][3];
        ss = wave_sum_dpp(ss);
        const float rstd = rsqrtf(ss * (1.0f / D) + 1e-6f);
        if (fin) {
            float* o = F.outp() + ((size_t)b * SEQ + (t - LC)) * D;
#pragma unroll
            for (int q = 0; q < 4; ++q) { const int c = q * 256 + F.lane * 4; *(f32x4*)(o + c) = x[q] * rstd * cA[q]; }
        } else {
#pragma unroll
            for (int q = 0; q < 4; ++q) { const int c = q * 256 + F.lane * 4;
                { const f32x4 xs = (dry && layer > 0) ? xo[q] : x[q]; u32x2 xw; xw.x = pk2(xs[0], xs[1]); xw.y = pk2(xs[2], xs[3]); *(u32x2*)(X + (size_t)r * D + c) = xw; }
                const f32x4 h = x[q] * rstd * cA[q] + cB[q];
                u32x2 w; w.x = pk2(h[0], h[1]); w.y = pk2(h[2], h[3]);
                *(u32x2*)(dst + (size_t)r * ldh + c) = w; }
        }
    }
}
__device__ __forceinline__ void phase_mix(const Frame& F, int a) {
    bf16_t* H2 = F.ar<bf16_t>(AR_H2); bf16_t* XM = F.ar<bf16_t>(AR_XR);
    const float* mu = F.in(8) + (size_t)a * 6 * D;
    f32x4 cm[2][3][2];
#pragma unroll
    for (int q = 0; q < 2; ++q)
#pragma unroll
        for (int m = 0; m < 3; ++m) { const int mi = m == 0 ? 0 : (m == 1 ? 2 : 3); const int c = q * 512 + F.lane * 8;
            cm[q][m][0] = *(const f32x4*)(mu + mi * D + c); cm[q][m][1] = *(const f32x4*)(mu + mi * D + c + 4); }
    const int rpb = (TG + F.G - 1) / F.G, rbeg = F.bid * rpb, rend = (rbeg + rpb) < TG ? (rbeg + rpb) : TG;
    for (int r = rbeg + F.wave; r < rend; r += NWAVES) {
        const int t = r % LT; const bool isctx = t < LC; const int p = t - LC;
#pragma unroll
        for (int q = 0; q < 2; ++q) {
            const int c = q * 512 + F.lane * 8;
            int nr;
            if (isctx) nr = (q == 0) ? (t > 0 ? r - 1 : -1) : (t < LC - 1 ? r + 1 : -1);
            else { const int qu = c >> 8;
                nr = qu == 0 ? ((p & 63) > 0 ? r - 1 : -1) : qu == 1 ? ((p & 63) < 63 ? r + 1 : -1) : qu == 2 ? (p >= 64 ? r - 64 : -1) : (p < SEQ - 64 ? r + 64 : -1); }
            const u32x4 hs = *(const u32x4*)(H2 + (size_t)r * 2048 + c);
            u32x4 hn = (u32x4){0u, 0u, 0u, 0u};
            if (nr >= 0) hn = *(const u32x4*)(H2 + (size_t)nr * 2048 + c);
            const float h[8] = {lo16(hs.x), hi16(hs.x), lo16(hs.y), hi16(hs.y), lo16(hs.z), hi16(hs.z), lo16(hs.w), hi16(hs.w)};
            const float n[8] = {lo16(hn.x), hi16(hn.x), lo16(hn.y), hi16(hn.y), lo16(hn.z), hi16(hn.z), lo16(hn.w), hi16(hn.w)};
            float dd[8];
#pragma unroll
            for (int e = 0; e < 8; ++e) dd[e] = n[e] - h[e];
            *(u32x4*)(H2 + (size_t)r * 2048 + 1024 + c) = (u32x4){pk2(dd[0], dd[1]), pk2(dd[2], dd[3]), pk2(dd[4], dd[5]), pk2(dd[6], dd[7])};
#pragma unroll
            for (int m = 0; m < 3; ++m) {
                const f32x4 m0 = cm[q][m][0], m1 = cm[q][m][1];
                float x[8];
#pragma unroll
                for (int e = 0; e < 4; ++e) { x[e] = h[e] + dd[e] * m0[e]; x[4 + e] = h[4 + e] + dd[4 + e] * m1[e]; }
                *(u32x4*)(XM + (size_t)m * TG * D + (size_t)r * D + c) = (u32x4){pk2(x[0], x[1]), pk2(x[2], x[3]), pk2(x[4], x[5]), pk2(x[6], x[7])};
            }
        }
    }
}
__device__ __forceinline__ void phase_vfix(const Frame& F) {
    bf16_t* V = F.ar<bf16_t>(AR_V); const bf16_t* VF = F.wsp<bf16_t>(WS_VF); const bf16_t* GT = F.ar<bf16_t>(AR_VGATE);
    const size_t tot = (size_t)TG * D / 8;
    for (size_t i = (size_t)F.bid * NTHREADS + F.tid; i < tot; i += (size_t)F.G * NTHREADS) {
        const u32x4 v = *(const u32x4*)(V + i * 8), f = *(const u32x4*)(VF + i * 8), g = *(const u32x4*)(GT + i * 8);
        u32x4 o;
        o.x = pk2(lo16(v.x) + (lo16(f.x) - lo16(v.x)) * lo16(g.x), hi16(v.x) + (hi16(f.x) - hi16(v.x)) * hi16(g.x));
        o.y = pk2(lo16(v.y) + (lo16(f.y) - lo16(v.y)) * lo16(g.y), hi16(v.y) + (hi16(f.y) - hi16(v.y)) * hi16(g.y));
        o.z = pk2(lo16(v.z) + (lo16(f.z) - lo16(v.z)) * lo16(g.z), hi16(v.z) + (hi16(f.z) - hi16(v.z)) * hi16(g.z));
        o.w = pk2(lo16(v.w) + (lo16(f.w) - lo16(v.w)) * lo16(g.w), hi16(v.w) + (hi16(f.w) - hi16(v.w)) * hi16(g.w));
        *(u32x4*)(V + i * 8) = o;
    }
}
__device__ __forceinline__ void phase_post(const Frame& F, int a, const bf16_t* V) {
    const bf16_t* Y0 = F.ar<bf16_t>(AR_Y0); bf16_t* YG = F.ar<bf16_t>(AR_R); const bf16_t* Y1 = F.ar<bf16_t>(AR_Y1); const float* DOT = F.ar<float>(AR_DOT); const bf16_t* Gb = F.ar<bf16_t>(AR_G);
    const float* lgp = F.in(27) + (size_t)a * D + F.lane * 16; const float* lbp = F.in(28) + (size_t)a * D + F.lane * 16;
    float lg[16], lb[16];
#pragma unroll
    for (int e = 0; e < 16; e += 4) { const f32x4 gq = *(const f32x4*)(lgp + e), bq = *(const f32x4*)(lbp + e);
        lg[e] = gq[0]; lg[e + 1] = gq[1]; lg[e + 2] = gq[2]; lg[e + 3] = gq[3]; lb[e] = bq[0]; lb[e + 1] = bq[1]; lb[e + 2] = bq[2]; lb[e + 3] = bq[3]; }
    const int rpb = (TG + F.G - 1) / F.G, rbeg = F.bid * rpb, rend = (rbeg + rpb) < TG ? (rbeg + rpb) : TG;
    for (int r = rbeg + F.wave; r < rend; r += NWAVES) {
        const int c = F.lane * 16, h = F.lane >> 2;
        float y[16], vv[16];
#pragma unroll
        for (int q = 0; q < 2; ++q) {
            const u32x4 a0 = *(const u32x4*)(Y0 + (size_t)r * D + c + q * 8), a1 = *(const u32x4*)(Y1 + (size_t)r * D + c + q * 8), v4 = *(const u32x4*)(V + (size_t)r * D + c + q * 8);
            y[q * 8 + 0] = lo16(a0.x) + lo16(a1.x); y[q * 8 + 1] = hi16(a0.x) + hi16(a1.x); y[q * 8 + 2] = lo16(a0.y) + lo16(a1.y); y[q * 8 + 3] = hi16(a0.y) + hi16(a1.y);
            y[q * 8 + 4] = lo16(a0.z) + lo16(a1.z); y[q * 8 + 5] = hi16(a0.z) + hi16(a1.z); y[q * 8 + 6] = lo16(a0.w) + lo16(a1.w); y[q * 8 + 7] = hi16(a0.w) + hi16(a1.w);
            vv[q * 8 + 0] = lo16(v4.x); vv[q * 8 + 1] = hi16(v4.x); vv[q * 8 + 2] = lo16(v4.y); vv[q * 8 + 3] = hi16(v4.y);
            vv[q * 8 + 4] = lo16(v4.z); vv[q * 8 + 5] = hi16(v4.z); vv[q * 8 + 6] = lo16(v4.w); vv[q * 8 + 7] = hi16(v4.w);
        }
        float s = 0.f;
#pragma unroll
        for (int e = 0; e < 16; ++e) s += y[e];
        s = red4(s); const float mean = s * (1.0f / 64.0f);
        float qv = 0.f;
#pragma unroll
        for (int e = 0; e < 16; ++e) { const float dd = y[e] - mean; qv += dd * dd; }
        qv = red4(qv); const float rstd = rsqrtf(qv * (1.0f / 64.0f) + 64e-5f);
        const float dsum = DOT[(size_t)r * NH + h] + DOT[((size_t)TG + r) * NH + h];
        unsigned o[8];
        const u32x4 g0 = *(const u32x4*)(Gb + (size_t)r * D + c), g1 = *(const u32x4*)(Gb + (size_t)r * D + c + 8);
        const unsigned gw[8] = {g0.x, g0.y, g0.z, g0.w, g1.x, g1.y, g1.z, g1.w};
#pragma unroll
        for (int e = 0; e < 16; e += 2) {
            const float o0 = ((y[e] - mean) * rstd * lg[e] + lb[e] + vv[e] * dsum) * lo16(gw[e >> 1]);
            const float o1 = ((y[e + 1] - mean) * rstd * lg[e + 1] + lb[e + 1] + vv[e + 1] * dsum) * hi16(gw[e >> 1]);
            o[e >> 1] = pk2(o0, o1);
        }
        *(u32x4*)(YG + (size_t)r * D + c) = (u32x4){o[0], o[1], o[2], o[3]};
        *(u32x4*)(YG + (size_t)r * D + c + 8) = (u32x4){o[4], o[5], o[6], o[7]};
    }
}
__device__ __forceinline__ void phase_norm2(const Frame& F, int g, int layer, bool dry = false) {
    bf16_t* X = F.wsp<bf16_t>(WS_X); bf16_t* HM = F.ar<bf16_t>(AR_HM); const bf16_t* Ob = F.ar<bf16_t>(AR_O);
    int* lists = dry ? F.ar<int>(AR_YM0) : F.ar<int>(AR_LIST); float* lwt = dry ? F.ar<float>(AR_YM0) + (size_t)32 * TG : F.ar<float>(AR_LW);
    unsigned* cnt = (unsigned*)(F.ws + WS_CTL + CTL_CNT_OFF) + (((size_t)g * 4 + layer) * 32 + (dry ? NG * 4 * 32 : 0)) * 16;
    LAS float* wr = (LAS float*)F.lds;
    __syncthreads();
    for (int i = F.tid; i < D * NEXP / 4; i += NTHREADS) { const int c = i >> 2, e4 = i & 3; const int rho = (c & ~255) + (c & 3) * 64 + ((c & 255) >> 2);
        *(LAS f32x4*)(wr + rho * 20 + e4 * 4) = *(const f32x4*)(F.in(36) + i * 4); }
    __syncthreads();
    const float* rbias = F.in(37);
    const bool ctx_out = layer < 2;
    LAS int* lcnt = (LAS int*)(F.lds + LDS_MISC + 512);
    LAS int* lbase = (LAS int*)(F.lds + LDS_MISC + 640);
    LAS int* rec = (LAS int*)(F.lds + 81920);
    const int rpb = (TG + F.G - 1) / F.G, rbeg = F.bid * rpb, rend = (rbeg + rpb) < TG ? (rbeg + rpb) : TG;
    const int niter = (rpb + NWAVES - 1) / NWAVES;
    int key = -1; f32x4 cg[4], cA[4], cB[4];
#pragma unroll
    for (int q = 0; q < 4; ++q) { cg[q] = (f32x4){0.f, 0.f, 0.f, 0.f}; cA[q] = cg[q]; cB[q] = cg[q]; }
    for (int it0 = 0; it0 < niter; it0 += 64) {
        if (F.tid < 32) lcnt[F.tid] = 0;
        __syncthreads();
        const int itn = (niter - it0) < 64 ? (niter - it0) : 64;
        for (int itl = 0; itl < itn; ++itl) {
            const int r = rbeg + (it0 + itl) * NWAVES + F.wave;
            const int bl = r / LT, t = r % LT, b = g * BG + bl; const bool isctx = t < LC;
            const int slot = itl * NWAVES + F.wave;
            if (r >= rend || (isctx && !ctx_out)) { if (F.lane == 0) rec[slot * 4] = -1; continue; }
            if (key != b * 2 + (int)isctx) {
                key = b * 2 + (int)isctx;
#pragma unroll
                for (int q = 0; q < 4; ++q) { const int c = q * 256 + F.lane * 4;
                    cg[q] = *(const f32x4*)((isctx ? F.modC(layer, 2) : F.modL(layer, b, 2)) + c);
                    const f32x4 gv = *(const f32x4*)(F.in(7) + (size_t)layer * D + c), cv = *(const f32x4*)((isctx ? F.modC(layer, 4) : F.modL(layer, b, 4)) + c);
                    cA[q] = gv * (1.0f + cv); cB[q] = *(const f32x4*)((isctx ? F.modC(layer, 3) : F.modL(layer, b, 3)) + c); }
            }
            f32x4 x[4]; float ss = 0.f;
#pragma unroll
            for (int q = 0; q < 4; ++q) { const int c = q * 256 + F.lane * 4;
                { const u32x2 xw = *(const u32x2*)(X + (size_t)r * D + c); x[q] = (f32x4){lo16(xw.x), hi16(xw.x), lo16(xw.y), hi16(xw.y)}; }
                const u32x2 ob = *(const u32x2*)(Ob + (size_t)r * D + c); const f32x4 gv = cg[q];
                const f32x4 xo = x[q];
                x[q][0] += gv[0] * lo16(ob.x); x[q][1] += gv[1] * hi16(ob.x); x[q][2] += gv[2] * lo16(ob.y); x[q][3] += gv[3] * hi16(ob.y);
                { const f32x4 xs = dry ? xo : x[q]; u32x2 xw; xw.x = pk2(xs[0], xs[1]); xw.y = pk2(xs[2], xs[3]); *(u32x2*)(X + (size_t)r * D + c) = xw; }
                ss += x[q][0] * x[q][0] + x[q][1] * x[q][1] + x[q][2] * x[q][2] + x[q][3] * x[q][3]; }
            ss = wave_sum_dpp(ss);
            const float rstd = rsqrtf(ss * (1.0f / D) + 1e-6f);
            float lg[16];
#pragma unroll
            for (int e = 0; e < 16; ++e) lg[e] = 0.f;
#pragma unroll
            for (int q = 0; q < 4; ++q) { const int c = q * 256 + F.lane * 4;
                const f32x4 h = x[q] * rstd * cA[q] + cB[q];
                u32x2 w; w.x = pk2(h[0], h[1]); w.y = pk2(h[2], h[3]);
                *(u32x2*)(HM + (size_t)r * D + c) = w;
#pragma unroll
                for (int j = 0; j < 4; ++j) {
#pragma unroll
                    for (int e4 = 0; e4 < 4; ++e4) { const f32x4 wv = *(const LAS f32x4*)(wr + (q * 256 + j * 64 + F.lane) * 20 + e4 * 4);
                        lg[e4 * 4 + 0] += h[j] * wv[0]; lg[e4 * 4 + 1] += h[j] * wv[1]; lg[e4 * 4 + 2] += h[j] * wv[2]; lg[e4 * 4 + 3] += h[j] * wv[3]; } }
            }
#pragma unroll
            for (int e = 0; e < 16; ++e) lg[e] = wave_sum_dpp(lg[e]);
            float sc_[16], bs[16];
#pragma unroll
            for (int e = 0; e < 16; ++e) { sc_[e] = sigmoidf_(lg[e]); bs[e] = sc_[e] + rbias[e]; }
            float gs[4];
#pragma unroll
            for (int gq = 0; gq < 4; ++gq) { float m1 = -1e30f, m2 = -1e30f;
#pragma unroll
                for (int j = 0; j < 4; ++j) { const float v = bs[gq * 4 + j]; if (v > m1) { m2 = m1; m1 = v; } else if (v > m2) m2 = v; }
                gs[gq] = m1 + m2; }
            int best = 0; float bv = gs[0];
#pragma unroll
            for (int gq = 1; gq < 4; ++gq) if (gs[gq] > bv) { bv = gs[gq]; best = gq; }
            float cb[4], cs[4];
#pragma unroll
            for (int j = 0; j < 4; ++j) { cb[j] = best == 0 ? bs[j] : best == 1 ? bs[4 + j] : best == 2 ? bs[8 + j] : bs[12 + j]; cs[j] = best == 0 ? sc_[j] : best == 1 ? sc_[4 + j] : best == 2 ? sc_[8 + j] : sc_[12 + j]; }
            int j1 = 0; float v1 = cb[0];
#pragma unroll
            for (int j = 1; j < 4; ++j) if (cb[j] > v1) { v1 = cb[j]; j1 = j; }
            int j2 = -1; float v2 = -1e30f;
#pragma unroll
            for (int j = 0; j < 4; ++j) if (j != j1 && cb[j] > v2) { v2 = cb[j]; j2 = j; }
            const float s1 = j1 == 0 ? cs[0] : j1 == 1 ? cs[1] : j1 == 2 ? cs[2] : cs[3];
            const float s2 = j2 == 0 ? cs[0] : j2 == 1 ? cs[1] : j2 == 2 ? cs[2] : cs[3];
            const float inv = __builtin_amdgcn_rcpf(s1 + s2);
            if (F.lane == 0) {
                const int l1 = (best * 4 + j1) * 2 + 0, l2 = (best * 4 + j2) * 2 + 1;
                const int p1 = __hip_atomic_fetch_add(lcnt + l1, 1, __ATOMIC_RELAXED, __HIP_MEMORY_SCOPE_WORKGROUP);
                const int p2 = __hip_atomic_fetch_add(lcnt + l2, 1, __ATOMIC_RELAXED, __HIP_MEMORY_SCOPE_WORKGROUP);
                rec[slot * 4 + 0] = l1 | (p1 << 8); rec[slot * 4 + 1] = l2 | (p2 << 8);
                rec[slot * 4 + 2] = __float_as_int(s1 * inv); rec[slot * 4 + 3] = __float_as_int(s2 * inv);
            }
        }
        __syncthreads();
        if (F.tid < 32) { const int c = lcnt[F.tid]; lbase[F.tid] = c ? (int)atomicAdd(&cnt[F.tid * 16], (unsigned)c) : 0; }
        __syncthreads();
        for (int slot = F.tid; slot < itn * NWAVES; slot += NTHREADS) {
            const int a0 = rec[slot * 4 + 0]; if (a0 < 0) continue;
            const int a1 = rec[slot * 4 + 1];
            const int r = rbeg + (it0 + slot / NWAVES) * NWAVES + (slot % NWAVES);
            const int l1 = a0 & 255, l2 = a1 & 255; const int q1 = lbase[l1] + (a0 >> 8), q2 = lbase[l2] + (a1 >> 8);
            lists[(size_t)l1 * TG + q1] = r; lwt[(size_t)l1 * TG + q1] = __int_as_float(rec[slot * 4 + 2]);
            lists[(size_t)l2 * TG + q2] = r; lwt[(size_t)l2 * TG + q2] = __int_as_float(rec[slot * 4 + 3]);
        }
        __syncthreads();
    }
}
__device__ __forceinline__ int moe_tables(const Frame& F, int g, int layer) {
    LAS int* cn = (LAS int*)(F.lds + LDS_MISC + 64); LAS int* tb = (LAS int*)(F.lds + LDS_MISC + 192);
    const unsigned* cnt = (const unsigned*)(F.ws + WS_CTL + CTL_CNT_OFF) + ((size_t)g * 4 + layer) * 32 * 16;
    __syncthreads();
    if (F.tid == 0) { int acc = 0; for (int l = 0; l < 32; ++l) { const int c = (int)__hip_atomic_load(cnt + l * 16, __ATOMIC_RELAXED, __HIP_MEMORY_SCOPE_AGENT); cn[l] = c; tb[l] = acc; acc += (c + 255) >> 8; } tb[32] = acc; }
    __syncthreads();
    return tb[32];
}

constexpr int SC_OPB = 6 * 4096;
constexpr int SC_HALF = 2 * SC_OPB + 4096 + 4096;
static_assert(2 * SC_HALF <= LDS_STAGE, "scan lds");
__device__ __forceinline__ int scan_tok(int d, int s) { return d == 0 ? s : (s < LC ? (LC - 1 - s) : (LT + LC - 1 - s)); }
__device__ __forceinline__ void phase_scan(const Frame& F, int a, const bf16_t* V) {
    const bf16_t* R = F.ar<bf16_t>(AR_R); const bf16_t* Kb = F.ar<bf16_t>(AR_K); const bf16_t* L1 = F.ar<bf16_t>(AR_L1);
    const int half = F.wave >> 2, q = F.wave & 3, lane = F.lane, li = q * 64 + lane;
    LAS unsigned char* hb = F.lds + half * SC_HALF;
    LAS float* aT = (LAS float*)(hb + 2 * SC_OPB); LAS float* ybuf = (LAS float*)(hb + 2 * SC_OPB + 4096);
    const int arr = q >> 1, ntl = (q & 1) * 2;
    const int i = lane >> 3, j = lane & 7, r0 = 16 * q + 2 * i;
    const int tB = li >> 4, k4 = (li & 15) * 4;
    for (int pr = F.bid; pr < BG * 16; pr += F.G) {
        const int bl = pr >> 4, d = (pr >> 3) & 1, hp = pr & 7, h = hp * 2 + half;
        bf16_t* Yd = F.ar<bf16_t>(d ? AR_Y1 : AR_Y0); float* DOT = F.ar<float>(AR_DOT) + (size_t)d * TG * NH;
        const size_t rowb = (size_t)bl * LT;
        const bf16_t* W2 = (arr == 0 ? F.wsp<bf16_t>(WS_W2T) : F.wsp<bf16_t>(WS_A2T)) + ((size_t)a * 2 + d) * D * 64;
        bf16x8 Bf[2][2]; float bias[2];
#pragma unroll
        for (int nt = 0; nt < 2; ++nt) { const int cc = h * 64 + (ntl + nt) * 16 + (lane & 15);
            bias[nt] = (arr == 0 ? F.in(13) : F.in(16))[((size_t)a * 2 + d) * D + cc];
#pragma unroll
            for (int s = 0; s < 2; ++s) Bf[nt][s] = *(const bf16x8*)(W2 + (size_t)cc * 64 + 32 * s + 8 * (lane >> 4)); }
        const f32x4 kkc = *(const f32x4*)(F.in(24) + (size_t)a * D + h * 64 + k4), kac = *(const f32x4*)(F.in(25) + (size_t)a * D + h * 64 + k4), rkc = *(const f32x4*)(F.in(26) + (size_t)a * D + h * 64 + k4);
        const int acol = arr * 128 + d * 64 + 8 * (lane >> 4);
        float S0[8], S1[8];
#pragma unroll
        for (int c = 0; c < 8; ++c) { S0[c] = 0.f; S1[c] = 0.f; }
        bf16x8 Af[2]; u32x2 kraw, rraw, vraw;
#define SC_LOAD(ch) do { const size_t rowA = rowb + scan_tok(d, (ch) * 16 + (lane & 15)); \
        Af[0] = *(const bf16x8*)(L1 + rowA * 512 + acol); Af[1] = *(const bf16x8*)(L1 + rowA * 512 + acol + 32); \
        const size_t rowBq = (rowb + scan_tok(d, (ch) * 16 + tB)) * D + h * 64 + k4; \
        kraw = *(const u32x2*)(Kb + rowBq); rraw = *(const u32x2*)(R + rowBq); vraw = *(const u32x2*)(V + rowBq); } while (0)
#define SC_PASSA(buf) do { LAS float* op = (LAS float*)(hb + (buf) * SC_OPB); \
        _Pragma("unroll") for (int nt = 0; nt < 2; ++nt) { f32x4 ac = (f32x4){0.f, 0.f, 0.f, 0.f}; \
            ac = __builtin_amdgcn_mfma_f32_16x16x32_bf16(Af[0], Bf[nt][0], ac, 0, 0, 0); ac = __builtin_amdgcn_mfma_f32_16x16x32_bf16(Af[1], Bf[nt][1], ac, 0, 0, 0); \
            const int n = (ntl + nt) * 16 + (lane & 15); \
              \
            f32x4 sg; _Pragma("unroll") for (int rg = 0; rg < 4; ++rg) sg[rg] = sigmoidf_(ac[rg] + bias[nt]); \
            if (arr == 0) { _Pragma("unroll") for (int rg = 0; rg < 4; ++rg) op[1024 + ((lane >> 4) * 4 + rg) * 64 + n] = __expf(-0.60653066f * sg[rg]); } \
            else { _Pragma("unroll") for (int rg = 0; rg < 4; ++rg) aT[((lane >> 4) * 4 + rg) * 64 + n] = sg[rg]; } } } while (0)
#define SC_PASSB(ch, buf) do { LAS float* op = (LAS float*)(hb + (buf) * SC_OPB); \
        const float kf[4] = {lo16(kraw.x), hi16(kraw.x), lo16(kraw.y), hi16(kraw.y)}; const float rf[4] = {lo16(rraw.x), hi16(rraw.x), lo16(rraw.y), hi16(rraw.y)}; \
        const float vf[4] = {lo16(vraw.x), hi16(vraw.x), lo16(vraw.y), hi16(vraw.y)}; \
        const f32x4 av = *(const LAS f32x4*)(aT + tB * 64 + k4); \
        float kq[4], ssq = 0.f; _Pragma("unroll") for (int e = 0; e < 4; ++e) { kq[e] = kf[e] * kkc[e]; ssq += kq[e] * kq[e]; } \
        ssq = red16(ssq); const float inv = __builtin_amdgcn_rsqf(fmaxf(ssq, 1e-24f)); \
        f32x4 o_kk, o_kka, o_kd, o_r, o_v; float dp = 0.f; \
        _Pragma("unroll") for (int e = 0; e < 4; ++e) { const float kkv = kq[e] * inv; const float kd = kf[e] * (1.0f + (av[e] - 1.0f) * kac[e]); \
            o_kk[e] = kkv; o_kka[e] = kkv * av[e]; o_kd[e] = kd; o_r[e] = rf[e]; o_v[e] = vf[e]; dp += rf[e] * kd * rkc[e]; } \
        dp = red16(dp); \
        if ((li & 15) == 0) DOT[(rowb + scan_tok(d, (ch) * 16 + tB)) * NH + h] = dp; \
        *(LAS f32x4*)(op + 0 * 1024 + tB * 64 + k4) = o_kk; *(LAS f32x4*)(op + 2 * 1024 + tB * 64 + k4) = o_kka; *(LAS f32x4*)(op + 3 * 1024 + tB * 64 + k4) = o_kd; \
        *(LAS f32x4*)(op + 4 * 1024 + tB * 64 + k4) = o_r; *(LAS f32x4*)(op + 5 * 1024 + tB * 64 + k4) = o_v; } while (0)
        __syncthreads();
        SC_LOAD(0);
        SC_PASSA(0);
        __syncthreads();
        SC_PASSB(0, 0);
        __syncthreads();
        constexpr int NCH = LT / 16;
        for (int ch = 0; ch < NCH; ++ch) {
            const int buf = ch & 1;
            if (ch + 1 < NCH) SC_LOAD(ch + 1);
            const LAS float* op = (const LAS float*)(hb + buf * SC_OPB);
            f32x4 cA[5], cB[5], nA[5], nB[5]; f32x2 cv, nv;
#define SC_OPLOAD(dA, dB, dv, t) do { const LAS float* ob_ = op + (t) * 64 + j * 8; \
                _Pragma("unroll") for (int q_ = 0; q_ < 5; ++q_) { dA[q_] = *(const LAS f32x4*)(ob_ + q_ * 1024); dB[q_] = *(const LAS f32x4*)(ob_ + q_ * 1024 + 4); } \
                dv = *(const LAS f32x2*)(op + 5 * 1024 + (t) * 64 + r0); } while (0)
            SC_OPLOAD(cA, cB, cv, 0);
#pragma unroll
            for (int t = 0; t < 16; ++t) {
                if (t + 1 < 16) SC_OPLOAD(nA, nB, nv, t + 1);
                const float kk[8] = {cA[0][0], cA[0][1], cA[0][2], cA[0][3], cB[0][0], cB[0][1], cB[0][2], cB[0][3]};
                const float dc[8] = {cA[1][0], cA[1][1], cA[1][2], cA[1][3], cB[1][0], cB[1][1], cB[1][2], cB[1][3]};
                const float ka[8] = {cA[2][0], cA[2][1], cA[2][2], cA[2][3], cB[2][0], cB[2][1], cB[2][2], cB[2][3]};
                const float kd[8] = {cA[3][0], cA[3][1], cA[3][2], cA[3][3], cB[3][0], cB[3][1], cB[3][2], cB[3][3]};
                const float rr[8] = {cA[4][0], cA[4][1], cA[4][2], cA[4][3], cB[4][0], cB[4][1], cB[4][2], cB[4][3]};
                float sa0 = (S0[0] * kk[0] + S0[1] * kk[1]) + (S0[2] * kk[2] + S0[3] * kk[3]) + ((S0[4] * kk[4] + S0[5] * kk[5]) + (S0[6] * kk[6] + S0[7] * kk[7]));
                float sa1 = (S1[0] * kk[0] + S1[1] * kk[1]) + (S1[2] * kk[2] + S1[3] * kk[3]) + ((S1[4] * kk[4] + S1[5] * kk[5]) + (S1[6] * kk[6] + S1[7] * kk[7]));
                sa0 = red8(sa0); sa1 = red8(sa1);
#pragma unroll
                for (int c = 0; c < 8; ++c) {
                    S0[c] = S0[c] * dc[c] + (cv[0] * kd[c] - sa0 * ka[c]);
                    S1[c] = S1[c] * dc[c] + (cv[1] * kd[c] - sa1 * ka[c]);
                }
                float y0 = (S0[0] * rr[0] + S0[1] * rr[1]) + (S0[2] * rr[2] + S0[3] * rr[3]) + ((S0[4] * rr[4] + S0[5] * rr[5]) + (S0[6] * rr[6] + S0[7] * rr[7]));
                float y1 = (S1[0] * rr[0] + S1[1] * rr[1]) + (S1[2] * rr[2] + S1[3] * rr[3]) + ((S1[4] * rr[4] + S1[5] * rr[5]) + (S1[6] * rr[6] + S1[7] * rr[7]));
                y0 = red8(y0); y1 = red8(y1);
                if (j == 0) *(LAS f32x2*)(ybuf + t * 64 + r0) = (f32x2){y0, y1};
#pragma unroll
                for (int q_ = 0; q_ < 5; ++q_) { cA[q_] = nA[q_]; cB[q_] = nB[q_]; }
                cv = nv;
            }
#undef SC_OPLOAD
            __syncthreads();
            {
                const f32x4 yv = *(const LAS f32x4*)(ybuf + tB * 64 + k4);
                u32x2 w; w.x = pk2(yv[0], yv[1]); w.y = pk2(yv[2], yv[3]);
                *(u32x2*)(Yd + (rowb + scan_tok(d, ch * 16 + tB)) * D + h * 64 + k4) = w;
            }
            if (ch + 1 < NCH) SC_PASSA(buf ^ 1);
            __syncthreads();
            if (ch + 1 < NCH) SC_PASSB(ch + 1, buf ^ 1);
            __syncthreads();
        }
#undef SC_LOAD
#undef SC_PASSA
#undef SC_PASSB
    }
}

constexpr int S4_KKP = 0, S4_RPP = 2048, S4_KDP = 4096, S4_KAP = 6144, S4_KDT = 8192, S4_KAT = 10496, S4_VT = 12800, S4_A1 = 15104, S4_B1 = 15616, S4_B2 = 16128,
              S4_A2 = 16640, S4_P15 = 17664, S4_LI = 17920, S4_LX = 22016, S4_AT = 26112, S4_YB = 30208, S4_HALF = 34304;
static_assert(2 * S4_HALF <= LDS_STAGE, "scan4 lds");
#define MF16(a, b, c) __builtin_amdgcn_mfma_f32_16x16x32_bf16((a), (b), (c), 0, 0, 0)
__device__ __forceinline__ bf16x8 mkfrag(unsigned a, unsigned b, unsigned c, unsigned d) { return __builtin_bit_cast(bf16x8, (u32x4){a, b, c, d}); }
__device__ __forceinline__ void phase_scan4(const Frame& F, int a, const bf16_t* V) {
    const bf16_t* R = F.ar<bf16_t>(AR_R); const bf16_t* Kb = F.ar<bf16_t>(AR_K); const bf16_t* L1 = F.ar<bf16_t>(AR_L1);
    const int half = F.wave >> 2, q = F.wave & 3, lane = F.lane, li = q * 64 + lane;
    LAS unsigned char* hb = F.lds + half * S4_HALF;
    const int arr = q >> 1, ntl = (q & 1) * 2;
    const int g = lane >> 4, j = lane & 15;
    const int tB = li >> 4, k4 = (li & 15) * 4;
    const int poff = (tB * 64 + (k4 >> 5) * 32 + ((k4 >> 2) & 3) * 8 + ((k4 >> 4) & 1) * 4) * 2;
    f32x2 eye2[8];
#pragma unroll
    for (int p_ = 0; p_ < 8; ++p_) eye2[p_] = (f32x2){j == 2 * p_ ? 1.f : 0.f, j == 2 * p_ + 1 ? 1.f : 0.f};
    for (int pr = F.bid; pr < BG * 16; pr += F.G) {
        const int bl = pr >> 4, d = (pr >> 3) & 1, hp = pr & 7, h = hp * 2 + half;
        bf16_t* Yd = F.ar<bf16_t>(d ? AR_Y1 : AR_Y0); float* DOT = F.ar<float>(AR_DOT) + (size_t)d * TG * NH;
        const size_t rowb = (size_t)bl * LT;
        const bf16_t* W2 = (arr == 0 ? F.wsp<bf16_t>(WS_W2T) : F.wsp<bf16_t>(WS_A2T)) + ((size_t)a * 2 + d) * D * 64;
        const float* b0p = (arr == 0 ? F.in(13) : F.in(16)) + ((size_t)a * 2 + d) * D + h * 64;
        const int acol = arr * 128 + d * 64 + 8 * (lane >> 4);
        f32x4 Cb[4];
#pragma unroll
        for (int b = 0; b < 4; ++b) Cb[b] = (f32x4){0.f, 0.f, 0.f, 0.f};
        bf16x8 Af[2]; u32x2 kraw, rraw, vraw;
#define SC_LOAD(ch) do { const size_t rowA = rowb + scan_tok(d, (ch) * 16 + (lane & 15)); \
        Af[0] = *(const bf16x8*)(L1 + rowA * 512 + acol); Af[1] = *(const bf16x8*)(L1 + rowA * 512 + acol + 32); \
        const size_t rowBq = (rowb + scan_tok(d, (ch) * 16 + tB)) * D + h * 64 + k4; \
        kraw = *(const u32x2*)(Kb + rowBq); rraw = *(const u32x2*)(R + rowBq); vraw = *(const u32x2*)(V + rowBq); } while (0)
#define SC_PASSA() do { \
        _Pragma("unroll") for (int nt = 0; nt < 2; ++nt) { f32x4 ac = (f32x4){0.f, 0.f, 0.f, 0.f}; \
            const int n = (ntl + nt) * 16 + (lane & 15); const float bias_ = b0p[n]; \
            const bf16x8 bf0_ = *(const bf16x8*)(W2 + (size_t)(h * 64 + n) * 64 + 8 * (lane >> 4)), bf1_ = *(const bf16x8*)(W2 + (size_t)(h * 64 + n) * 64 + 32 + 8 * (lane >> 4)); \
            ac = MF16(Af[0], bf0_, ac); ac = MF16(Af[1], bf1_, ac); \
            f32x4 sg; _Pragma("unroll") for (int rg = 0; rg < 4; ++rg) sg[rg] = sigmoidf_(ac[rg] + bias_); \
            if (arr == 0) { \
                const float l0 = -0.60653066f * sg[0], l1 = -0.60653066f * sg[1], l2 = -0.60653066f * sg[2], l3 = -0.60653066f * sg[3]; \
                const float p0 = l0, p1 = p0 + l1, p2 = p1 + l2, p3 = p2 + l3;                         \
                const auto s16 = __builtin_amdgcn_permlane16_swap(__float_as_uint(p3), __float_as_uint(p3), false, false);     \
                const float sv = __uint_as_float(s16[0]), pq = sv + __uint_as_float(s16[1]); \
                const auto s32 = __builtin_amdgcn_permlane32_swap(__float_as_uint(pq), __float_as_uint(pq), false, false);     \
                const float E = ((g & 1) ? sv : 0.f) + ((g & 2) ? __uint_as_float(s32[0]) : 0.f);      \
                LAS float* li_ = (LAS float*)(hb + S4_LI) + (4 * g) * 64 + n; LAS float* lx_ = (LAS float*)(hb + S4_LX) + (4 * g) * 64 + n; \
                li_[0] = E + p0; li_[64] = E + p1; li_[128] = E + p2; li_[192] = E + p3; lx_[0] = E; lx_[64] = E + p0; lx_[128] = E + p1; lx_[192] = E + p2; \
            } else { _Pragma("unroll") for (int rg = 0; rg < 4; ++rg) ((LAS float*)(hb + S4_AT))[(4 * g + rg) * 64 + n] = sg[rg]; } } } while (0)
#define SC_PASSB(ch) do { \
        const f32x4 kkc = *(const f32x4*)(F.in(24) + (size_t)a * D + h * 64 + k4), kac = *(const f32x4*)(F.in(25) + (size_t)a * D + h * 64 + k4), rkc = *(const f32x4*)(F.in(26) + (size_t)a * D + h * 64 + k4); \
        const float kf[4] = {lo16(kraw.x), hi16(kraw.x), lo16(kraw.y), hi16(kraw.y)}; const float rf[4] = {lo16(rraw.x), hi16(rraw.x), lo16(rraw.y), hi16(rraw.y)}; \
        const f32x4 av = *(const LAS f32x4*)((LAS float*)(hb + S4_AT) + tB * 64 + k4), Li = *(const LAS f32x4*)((LAS float*)(hb + S4_LI) + tB * 64 + k4), Lx = *(const LAS f32x4*)((LAS float*)(hb + S4_LX) + tB * 64 + k4); \
        float kq[4], ssq = 0.f; _Pragma("unroll") for (int e = 0; e < 4; ++e) { kq[e] = kf[e] * kkc[e]; ssq += kq[e] * kq[e]; } \
        ssq = red16(ssq); const float inv = __builtin_amdgcn_rsqf(fmaxf(ssq, 1e-24f)); \
        float o_kk[4], o_ka[4], o_kd[4], o_r[4]; f32x4 o_p; float dp = 0.f; \
        _Pragma("unroll") for (int e = 0; e < 4; ++e) { const float Pt = __expf(Li[e]), Px = __expf(Lx[e]), iP = __builtin_amdgcn_rcpf(Pt); \
            const float kkv = kq[e] * inv; const float kd = kf[e] * (1.0f + (av[e] - 1.0f) * kac[e]); const float ka = kkv * av[e]; \
            o_kk[e] = kkv * Px; o_ka[e] = ka * iP; o_kd[e] = kd * iP; o_r[e] = rf[e] * Pt; o_p[e] = Pt; \
            dp += rf[e] * kd * rkc[e]; } \
        dp = red16(dp); \
        if ((li & 15) == 0) DOT[(rowb + scan_tok(d, (ch) * 16 + tB)) * NH + h] = dp; \
        const u32x2 w_kk = (u32x2){pk2(o_kk[0], o_kk[1]), pk2(o_kk[2], o_kk[3])}, w_r = (u32x2){pk2(o_r[0], o_r[1]), pk2(o_r[2], o_r[3])}; \
        const u32x2 w_kd = (u32x2){pk2(o_kd[0], o_kd[1]), pk2(o_kd[2], o_kd[3])}, w_ka = (u32x2){pk2(o_ka[0], o_ka[1]), pk2(o_ka[2], o_ka[3])}; \
        *(LAS u32x2*)(hb + S4_KKP + poff) = w_kk; *(LAS u32x2*)(hb + S4_RPP + poff) = w_r; *(LAS u32x2*)(hb + S4_KDP + poff) = w_kd; *(LAS u32x2*)(hb + S4_KAP + poff) = w_ka; \
        { LAS unsigned char* td = hb + S4_KDT + k4 * 36 + tB * 2; LAS unsigned char* ta = hb + S4_KAT + k4 * 36 + tB * 2; LAS unsigned char* tv = hb + S4_VT + k4 * 36 + tB * 2; \
          *(LAS unsigned short*)(td) = (unsigned short)w_kd.x; *(LAS unsigned short*)(td + 36) = (unsigned short)(w_kd.x >> 16); *(LAS unsigned short*)(td + 72) = (unsigned short)w_kd.y; *(LAS unsigned short*)(td + 108) = (unsigned short)(w_kd.y >> 16); \
          *(LAS unsigned short*)(ta) = (unsigned short)w_ka.x; *(LAS unsigned short*)(ta + 36) = (unsigned short)(w_ka.x >> 16); *(LAS unsigned short*)(ta + 72) = (unsigned short)w_ka.y; *(LAS unsigned short*)(ta + 108) = (unsigned short)(w_ka.y >> 16); \
          *(LAS unsigned short*)(tv) = (unsigned short)vraw.x; *(LAS unsigned short*)(tv + 36) = (unsigned short)(vraw.x >> 16); *(LAS unsigned short*)(tv + 72) = (unsigned short)vraw.y; *(LAS unsigned short*)(tv + 108) = (unsigned short)(vraw.y >> 16); } \
        if (tB == 15) *(LAS f32x4*)((LAS float*)(hb + S4_P15) + k4) = o_p; } while (0)
#define SC_PROD() do { const int lo_ = (q < 2 ? S4_KKP : S4_RPP) + j * 128 + g * 16, ro_ = ((q == 0 || q == 3) ? S4_KAP : S4_KDP) + j * 128 + g * 16; \
        f32x4 pa = (f32x4){0.f, 0.f, 0.f, 0.f}; \
        pa = MF16(*(const LAS bf16x8*)(hb + lo_), *(const LAS bf16x8*)(hb + ro_), pa); pa = MF16(*(const LAS bf16x8*)(hb + lo_ + 64), *(const LAS bf16x8*)(hb + ro_ + 64), pa); \
        _Pragma("unroll") for (int r_ = 0; r_ < 4; ++r_) { const int t_ = 4 * g + r_; const bool keep = (q < 2) ? (j < t_) : (j <= t_); pa[r_] = keep ? pa[r_] : 0.f; } \
        if (q == 0) { LAS float* dm = (LAS float*)(hb + S4_A2) + (4 * g) * 16 + j; dm[0] = pa[0]; dm[16] = pa[1]; dm[32] = pa[2]; dm[48] = pa[3]; } \
        else { LAS unsigned char* dm = hb + (q == 1 ? S4_A1 : (q == 2 ? S4_B1 : S4_B2)) + ((4 * g) * 16 + j) * 2; const unsigned w0_ = pk2(pa[0], pa[1]), w1_ = pk2(pa[2], pa[3]); \
            *(LAS unsigned short*)(dm) = (unsigned short)w0_; *(LAS unsigned short*)(dm + 32) = (unsigned short)(w0_ >> 16); *(LAS unsigned short*)(dm + 64) = (unsigned short)w1_; *(LAS unsigned short*)(dm + 96) = (unsigned short)(w1_ >> 16); } } while (0)
        __syncthreads();
        SC_LOAD(0);
        SC_PASSA();
        __syncthreads();
        SC_PASSB(0);
        __syncthreads();
        SC_PROD();
        __syncthreads();
        constexpr int NCH = LT / 16;
        for (int ch = 0; ch < NCH; ++ch) {
            if (ch + 1 < NCH) SC_LOAD(ch + 1);
            const bf16x8 Bs0 = mkfrag(pk2(Cb[0][0], Cb[0][1]), pk2(Cb[0][2], Cb[0][3]), pk2(Cb[1][0], Cb[1][1]), pk2(Cb[1][2], Cb[1][3]));
            const bf16x8 Bs1 = mkfrag(pk2(Cb[2][0], Cb[2][1]), pk2(Cb[2][2], Cb[2][3]), pk2(Cb[3][0], Cb[3][1]), pk2(Cb[3][2], Cb[3][3]));
            f32x4 X = (f32x4){0.f, 0.f, 0.f, 0.f}, H = (f32x4){0.f, 0.f, 0.f, 0.f};
            X = MF16(*(const LAS bf16x8*)(hb + S4_KKP + j * 128 + g * 16), Bs0, X); H = MF16(*(const LAS bf16x8*)(hb + S4_RPP + j * 128 + g * 16), Bs0, H);
            X = MF16(*(const LAS bf16x8*)(hb + S4_KKP + j * 128 + g * 16 + 64), Bs1, X); H = MF16(*(const LAS bf16x8*)(hb + S4_RPP + j * 128 + g * 16 + 64), Bs1, H);
            f32x2 ac2[8];
#pragma unroll
            for (int p_ = 0; p_ < 8; ++p_) ac2[p_] = eye2[p_];
            float Mr[16];
#pragma unroll
            for (int u = 15; u >= 1; --u) {
                const float mu = ac2[u >> 1][u & 1]; Mr[u] = mu;
#pragma unroll
                for (int x_ = 0; x_ * 4 < u; ++x_) {
                    const f32x4 av_ = *(const LAS f32x4*)((LAS float*)(hb + S4_A2) + u * 16 + 4 * x_);
                    ac2[2 * x_] = ac2[2 * x_] - (f32x2){mu, mu} * (f32x2){av_[0], av_[1]};
                    if (4 * x_ + 2 < u) ac2[2 * x_ + 1] = ac2[2 * x_ + 1] - (f32x2){mu, mu} * (f32x2){av_[2], av_[3]};
                }
            }
            Mr[0] = ac2[0][0];
            const u32x2 vw = (u32x2){*(const LAS unsigned*)(hb + S4_VT + (16 * q + j) * 36 + 8 * g), *(const LAS unsigned*)(hb + S4_VT + (16 * q + j) * 36 + 8 * g + 4)};
            const bf16x8 Bv = mkfrag(vw.x, vw.y, 0u, 0u);
            {
                const u32x2 a1w = *(const LAS u32x2*)(hb + S4_A1 + (j * 16 + 4 * g) * 2), b1w = *(const LAS u32x2*)(hb + S4_B1 + (j * 16 + 4 * g) * 2);
                X = MF16(mkfrag(a1w.x, a1w.y, 0u, 0u), Bv, X); H = MF16(mkfrag(b1w.x, b1w.y, 0u, 0u), Bv, H);
            }
            float mA[4];
#pragma unroll
            for (int r_ = 0; r_ < 4; ++r_) mA[r_] = g == 0 ? Mr[r_] : (g == 1 ? Mr[4 + r_] : (g == 2 ? Mr[8 + r_] : Mr[12 + r_]));
            f32x4 SA = (f32x4){0.f, 0.f, 0.f, 0.f};
            SA = MF16(mkfrag(pk2(mA[0], mA[1]), pk2(mA[2], mA[3]), 0u, 0u), mkfrag(pk2(X[0], X[1]), pk2(X[2], X[3]), 0u, 0u), SA);
            const bf16x8 Bn = mkfrag(pk2(-SA[0], -SA[1]), pk2(-SA[2], -SA[3]), 0u, 0u);
            {
                const u32x2 b2w = *(const LAS u32x2*)(hb + S4_B2 + (j * 16 + 4 * g) * 2);
                H = MF16(mkfrag(b2w.x, b2w.y, 0u, 0u), Bn, H);
                LAS float* yb = (LAS float*)(hb + S4_YB) + (4 * g) * 64 + 16 * q + j; yb[0] = H[0]; yb[64] = H[1]; yb[128] = H[2]; yb[192] = H[3];
            }
#pragma unroll
            for (int b = 0; b < 4; ++b) {
                const u32x2 kdw = (u32x2){*(const LAS unsigned*)(hb + S4_KDT + (16 * b + j) * 36 + 8 * g), *(const LAS unsigned*)(hb + S4_KDT + (16 * b + j) * 36 + 8 * g + 4)};
                const u32x2 kaw = (u32x2){*(const LAS unsigned*)(hb + S4_KAT + (16 * b + j) * 36 + 8 * g), *(const LAS unsigned*)(hb + S4_KAT + (16 * b + j) * 36 + 8 * g + 4)};
                Cb[b] = MF16(mkfrag(kdw.x, kdw.y, 0u, 0u), Bv, Cb[b]);
                Cb[b] = MF16(mkfrag(kaw.x, kaw.y, 0u, 0u), Bn, Cb[b]);
            }
#pragma unroll
            for (int b = 0; b < 4; ++b) { const f32x4 pv = *(const LAS f32x4*)((LAS float*)(hb + S4_P15) + 16 * b + 4 * g); Cb[b] = Cb[b] * pv; }
            __syncthreads();
            {
                const f32x4 yv = *(const LAS f32x4*)((LAS float*)(hb + S4_YB) + tB * 64 + k4);
                u32x2 w; w.x = pk2(yv[0], yv[1]); w.y = pk2(yv[2], yv[3]);
                *(u32x2*)(Yd + (rowb + scan_tok(d, ch * 16 + tB)) * D + h * 64 + k4) = w;
            }
            if (ch + 1 < NCH) {
                SC_PASSA();
                __syncthreads();
                SC_PASSB(ch + 1);
                __syncthreads();
                SC_PROD();
                __syncthreads();
            }
        }
#undef SC_LOAD
#undef SC_PASSA
#undef SC_PASSB
#undef SC_PROD
    }
}

__device__ __forceinline__ void phase_sgstats(const Frame& F, int layer) {
    const bf16_t* Z = F.ar<bf16_t>(AR_Z); float* ST = F.ar<float>(AR_ST);
    for (int r = F.bid * NWAVES + F.wave; r < TG; r += F.G * NWAVES) {
        const int t = r % LT; if (t < LC && layer >= 3) continue;
        float x[32];
#pragma unroll
        for (int q = 0; q < 4; ++q) { const u32x4 w = *(const u32x4*)(Z + (size_t)r * 4096 + 2048 + q * 512 + F.lane * 8);
            x[q * 8 + 0] = lo16(w.x); x[q * 8 + 1] = hi16(w.x); x[q * 8 + 2] = lo16(w.y); x[q * 8 + 3] = hi16(w.y); x[q * 8 + 4] = lo16(w.z); x[q * 8 + 5] = hi16(w.z); x[q * 8 + 6] = lo16(w.w); x[q * 8 + 7] = hi16(w.w); }
        float s = 0.f;
#pragma unroll
        for (int e = 0; e < 32; ++e) s += x[e];
        s = wave_sum(s); const float mean = s * (1.0f / 2048.0f);
        float qv = 0.f;
#pragma unroll
        for (int e = 0; e < 32; ++e) { const float dd = x[e] - mean; qv += dd * dd; }
        qv = wave_sum(qv);
        if (F.lane == 0) *(f32x2*)(ST + (size_t)r * 2) = (f32x2){mean, rsqrtf(qv * (1.0f / 2048.0f) + 1e-5f)};
    }
}
__device__ __forceinline__ int vt_off(int dch, int jb) { return dch * 256 + ((jb ^ ((dch & 15) ^ (((dch >> 4) & 7) << 1))) << 4); }
__device__ __forceinline__ void phase_spatial(const Frame& F, int bsg, int layer) {
    const bf16_t* Z = F.ar<bf16_t>(AR_Z); const float* ST = F.ar<float>(AR_ST); bf16_t* Pb = F.ar<bf16_t>(AR_P);
    const bf16_t* Ws = F.wsp<bf16_t>(WS_WSP) + (size_t)bsg * 16 * 128 * 128;
    const float* lng = F.in(31) + (size_t)bsg * 2048; const float* lnb = F.in(32) + (size_t)bsg * 2048; const float* bs = F.in(34) + (size_t)bsg * 16 * 128;
    LAS unsigned char* vt = F.lds;
    const int skip = layer >= 3;
    const int nchunk = skip ? BG * 16 : BG * 18;
    const int w = F.wave, lane = F.lane, dt = w >> 1, it0 = (w & 1) * 2;
    const int jj0 = F.tid >> 4, c8 = (F.tid & 15) * 8;
    u32x4 zz[4]; f32x2 st[4];
#define SP_ROW0(U_) ((size_t)(skip ? (((U_) >> 4) >> 4) * 18 + 2 + (((U_) >> 4) & 15) : ((U_) >> 4)) * 128)
#define SP_LOADZ(U_) do { const size_t r0_ = SP_ROW0(U_); const int gi_ = (U_) & 15; _Pragma("unroll") for (int k = 0; k < 4; ++k) { \
        zz[k] = *(const u32x4*)(Z + (r0_ + jj0 + 32 * k) * 4096 + 2048 + gi_ * 128 + c8); st[k] = *(const f32x2*)(ST + (r0_ + jj0 + 32 * k) * 2); } } while (0)
    if (F.bid < nchunk * 16) SP_LOADZ(F.bid);
    for (int U = F.bid; U < nchunk * 16; U += F.G) {
        const int gi = U & 15;
        const size_t row0 = SP_ROW0(U);
        const f32x4 g0 = *(const f32x4*)(lng + gi * 128 + c8), g1 = *(const f32x4*)(lng + gi * 128 + c8 + 4), b0 = *(const f32x4*)(lnb + gi * 128 + c8), b1 = *(const f32x4*)(lnb + gi * 128 + c8 + 4);
        const float gg[8] = {g0[0], g0[1], g0[2], g0[3], g1[0], g1[1], g1[2], g1[3]}, bb[8] = {b0[0], b0[1], b0[2], b0[3], b1[0], b1[1], b1[2], b1[3]};
        __syncthreads();
#pragma unroll
        for (int k = 0; k < 4; ++k) {
            const int jj = jj0 + 32 * k;
            const float xv[8] = {lo16(zz[k].x), hi16(zz[k].x), lo16(zz[k].y), hi16(zz[k].y), lo16(zz[k].z), hi16(zz[k].z), lo16(zz[k].w), hi16(zz[k].w)};
#pragma unroll
            for (int e = 0; e < 8; e += 2) {
                const unsigned pw = pk2((xv[e] - st[k][0]) * st[k][1] * gg[e] + bb[e], (xv[e + 1] - st[k][0]) * st[k][1] * gg[e + 1] + bb[e + 1]);
                *(LAS unsigned short*)(vt + vt_off(c8 + e, jj >> 3) + (jj & 7) * 2) = (unsigned short)(pw & 0xFFFFu);
                *(LAS unsigned short*)(vt + vt_off(c8 + e + 1, jj >> 3) + (jj & 7) * 2) = (unsigned short)(pw >> 16);
            }
        }
        const bf16_t* w0p = Ws + ((size_t)gi * 128 + it0 * 32 + (lane & 31)) * 128 + 8 * (lane >> 5);
        bf16x8 B0[8], B1[8];
#pragma unroll
        for (int s_ = 0; s_ < 8; ++s_) { B0[s_] = *(const bf16x8*)(w0p + 16 * s_); B1[s_] = *(const bf16x8*)(w0p + 32 * 128 + 16 * s_); }
        u32x2 uu[2][4]; float bias[2];
#pragma unroll
        for (int it = 0; it < 2; ++it) { const int ii = (it0 + it) * 32 + (lane & 31); bias[it] = bs[gi * 128 + ii];
#pragma unroll
            for (int rq = 0; rq < 4; ++rq) uu[it][rq] = *(const u32x2*)(Z + (row0 + ii) * 4096 + gi * 128 + dt * 32 + 8 * rq + 4 * (lane >> 5)); }
        if (U + F.G < nchunk * 16) SP_LOADZ(U + F.G);
        __syncthreads();
        f32x16 acc0, acc1;
#pragma unroll
        for (int e = 0; e < 16; ++e) { acc0[e] = 0.f; acc1[e] = 0.f; }
        const int dA = dt * 32 + (lane & 31);
#pragma unroll
        for (int s_ = 0; s_ < 8; ++s_) {
            const bf16x8 Afr = *(const LAS bf16x8*)(vt + vt_off(dA, 2 * s_ + (lane >> 5)));
            acc0 = __builtin_amdgcn_mfma_f32_32x32x16_bf16(Afr, B0[s_], acc0, 0, 0, 0);
            acc1 = __builtin_amdgcn_mfma_f32_32x32x16_bf16(Afr, B1[s_], acc1, 0, 0, 0);
        }
#pragma unroll
        for (int it = 0; it < 2; ++it) {
            const int ii = (it0 + it) * 32 + (lane & 31); const size_t row = row0 + ii;
#pragma unroll
            for (int rq = 0; rq < 4; ++rq) {
                const int d0 = dt * 32 + 8 * rq + 4 * (lane >> 5);
                float vs[4];
#pragma unroll
                for (int e = 0; e < 4; ++e) vs[e] = (it == 0 ? acc0[rq * 4 + e] : acc1[rq * 4 + e]) + bias[it];
                u32x2 o; o.x = pk2(lo16(uu[it][rq].x) * vs[0], hi16(uu[it][rq].x) * vs[1]); o.y = pk2(lo16(uu[it][rq].y) * vs[2], hi16(uu[it][rq].y) * vs[3]);
                *(u32x2*)(Pb + row * 2048 + gi * 128 + d0) = o;
            }
        }
    }
#undef SP_ROW0
#undef SP_LOADZ
    __syncthreads();
}

__global__ void __launch_bounds__(NTHREADS, 2) fwd_kernel(Params P) {
    extern __shared__ __attribute__((aligned(16))) unsigned char lds_raw[];
    Frame F; F.lds = (LAS unsigned char*)lds_raw; F.tid = threadIdx.x; F.lane = F.tid & 63; F.wave = __builtin_amdgcn_readfirstlane(F.tid >> 6);
    F.G = gridDim.x; F.bid = blockIdx.x; F.ws = P.ws; F.kp = (const Params __attribute__((address_space(4)))*)__builtin_amdgcn_kernarg_segment_ptr();
    const int lo = P.ph_lo, hi = P.ph_hi;
    volatile LAS unsigned* misc = (volatile LAS unsigned*)(F.lds + LDS_MISC);
    if (F.tid < 4) misc[F.tid] = 0u;
    __syncthreads();
    XcdBarrier bar; bar.bar = (unsigned*)(F.ws + WS_CTL); bar.x = 0; bar.st = misc;
    if (hi - lo > 1) bar = xcd_barrier_post((unsigned*)(F.ws + WS_CTL), misc);
    int ph = 0;
#define RUN(id, ...) do { if (ph >= lo && ph < hi) { const int nrep_ = ((REP_MASK >> (id)) & 1u) ? 2 : 1; for (int rep_ = 0; rep_ < nrep_; ++rep_) { const bool dry_ = (rep_ + 1 < nrep_); (void)dry_; { int t_ = threadIdx.x; const Params __attribute__((address_space(4)))* kp_ = (const Params __attribute__((address_space(4)))*)__builtin_amdgcn_kernarg_segment_ptr(); asm volatile("" : "+v"(t_), "+s"(kp_)); F.tid = t_; F.lane = t_ & 63; F.kp = kp_; F.ws = kp_->ws; } __VA_ARGS__; if (rep_ + 1 < nrep_ || ph + 1 < hi) xcd_barrier(bar); } } ++ph; } while (0)

    RUN(0, phase_prologue(F));
    for (int g = 0; g < NG; ++g) {
        for (int layer = 0; layer < 4; ++layer) {
            const int a = layer >> 1;
            if ((layer & 1) == 0) {
                const bf16_t* Vc = layer == 0 ? F.wsp<bf16_t>(WS_VF) : F.ar<bf16_t>(AR_V);
                RUN(1, phase_norm1(F, g, layer, F.ar<bf16_t>(AR_H2), 2048, dry_));
                RUN(2, phase_mix(F, a));
                RUN(3, { { pg8::SchedPlain S; S.init(TG / 256, 2, F.G, F.bid, 0);
                        EpiL1 E{F.ar<bf16_t>(AR_L1)};
                        pg8::gemm_phase(F.tid, F.lds, F.ar<bf16_t>(AR_H2), K1CAT, F.wsp<bf16_t>(WS_WL) + (size_t)a * 512 * K1CAT, K1CAT, K1CAT, S, E); }
                      { pg8::SchedRKV S; S.init(TG / 256, 12, F.G, (F.bid + 192) % F.G, 0);
                        EpiRKV E{F.ws, layer == 0 ? WS_VF : WS_ARENA + AR_V};
                        pg8::gemm_phase(F.tid, F.lds, F.ar<bf16_t>(AR_XR), D, F.wsp<bf16_t>(WS_WRKV) + (size_t)a * 3072 * D, D, D, S, E); } });
                if (layer == 2) {
                    RUN(4, { pg8::SchedPlain S; S.init(TG / 256, 4, F.G, F.bid, 0);
                          EpiStore<1> E{F.ar<bf16_t>(AR_VGATE), F.in(19)};
                          pg8::gemm_phase(F.tid, F.lds, F.ar<bf16_t>(AR_L1) + 256, 512, F.wsp<bf16_t>(WS_V2T), 256, 256, S, E); });
                    RUN(5, phase_vfix(F));
                }
                RUN(6, phase_scan4(F, a, Vc));
                RUN(7, { pg8::SchedPlain S; S.init(TG / 256, 4, F.G, F.bid, 0);
                      EpiStore<0> E{F.ar<bf16_t>(AR_G), nullptr};
                      pg8::gemm_phase(F.tid, F.lds, F.ar<bf16_t>(AR_L1) + 256, 512, F.wsp<bf16_t>(WS_G2T) + (size_t)a * D * 256, 256, 256, S, E); });
                RUN(8, phase_post(F, a, Vc));
                RUN(9, { const int skip = layer == 2; pg8::SchedPlain S; S.init(skip ? BG * 8 : TG / 256, 4, F.G, F.bid, skip);
                      EpiStore<0> E{F.ar<bf16_t>(AR_O), nullptr};
                      pg8::gemm_phase(F.tid, F.lds, F.ar<bf16_t>(AR_R), D, F.wsp<bf16_t>(WS_WO) + (size_t)a * D * D, D, D, S, E); });
            } else {
                const int skip = layer == 3;
                RUN(10, phase_norm1(F, g, layer, F.ar<bf16_t>(AR_H), D, dry_));
                RUN(11, { pg8::SchedPlain S; S.init(skip ? BG * 8 : TG / 256, 16, F.G, F.bid, skip);
                      EpiGelu E{F.ar<bf16_t>(AR_Z), F.in(30) + (size_t)a * 4096};
                      pg8::gemm_phase(F.tid, F.lds, F.ar<bf16_t>(AR_H), D, F.wsp<bf16_t>(WS_WIN) + (size_t)a * 4096 * D, D, D, S, E); });
                RUN(12, phase_sgstats(F, layer));
                RUN(13, phase_spatial(F, a, layer));
                RUN(14, { pg8::SchedPlain S; S.init(skip ? BG * 8 : TG / 256, 4, F.G, F.bid, skip);
                      EpiStore<0> E{F.ar<bf16_t>(AR_O), nullptr};
                      pg8::gemm_phase(F.tid, F.lds, F.ar<bf16_t>(AR_P), 2048, F.wsp<bf16_t>(WS_WOUT) + (size_t)a * D * 2048, 2048, 2048, S, E); });
            }
            RUN(15, phase_norm2(F, g, layer, dry_));
            RUN(16, { const int total = moe_tables(F, g, layer);
                  pg8::SchedMoe<true> S{(const LAS int*)(F.lds + LDS_MISC + 64), (const LAS int*)(F.lds + LDS_MISC + 192), F.ar<int>(AR_LIST), F.G, F.bid, total};
                  EpiMG E{F.ar<bf16_t>(AR_HE)};
                  pg8::gemm_phase(F.tid, F.lds, F.ar<bf16_t>(AR_HM), D, F.wsp<bf16_t>(WS_WGU) + (size_t)layer * NEXP * 1024 * D, D, D, S, E); });
            RUN(17, { const int total = moe_tables(F, g, layer);
                  pg8::SchedMoe<false> S{(const LAS int*)(F.lds + LDS_MISC + 64), (const LAS int*)(F.lds + LDS_MISC + 192), F.ar<int>(AR_LIST), F.G, F.bid, total};
                  EpiMD E{F.ar<bf16_t>(AR_YM0), F.ar<int>(AR_LIST), F.ar<float>(AR_LW), (const LAS int*)(F.lds + LDS_MISC + 64)};
                  pg8::gemm_phase(F.tid, F.lds, F.ar<bf16_t>(AR_HE), FEXP, F.wsp<bf16_t>(WS_WD) + (size_t)layer * NEXP * D * FEXP, FEXP, FEXP, S, E); });
        }
        RUN(18, phase_norm1(F, g, 4, nullptr, 0));
    }
#undef RUN
}
constexpr int NPHASES = 1 + NG * (10 + 8 + 12 + 8 + 1);

__global__ void nan_fill(float* out, size_t n) { for (size_t i = (size_t)blockIdx.x * blockDim.x + threadIdx.x; i < n; i += (size_t)gridDim.x * blockDim.x) out[i] = __uint_as_float(0x7FC00000u); }

extern "C" void kernel_launch(void* const* d_in, const int* in_sizes, int n_in, void* d_out, int out_size, void* d_ws, size_t ws_size, hipStream_t stream) {
    static int grid = 0;
    if (grid == 0) {
        int dev = 0, cus = 0, per_cu = 0;
        if (n_in != 42 || ws_size < WS_END || hipGetDevice(&dev) != hipSuccess || hipDeviceGetAttribute(&cus, hipDeviceAttributeMultiprocessorCount, dev) != hipSuccess) {
            fprintf(stderr, "kernel_launch: bad setup (n_in %d, ws %zu need %zu)\n", n_in, ws_size, (size_t)WS_END); grid = -1;
        } else if (hipFuncSetAttribute((const void*)fwd_kernel, hipFuncAttributeMaxDynamicSharedMemorySize, LDS_BYTES) != hipSuccess) { fprintf(stderr, "kernel_launch: hipFuncSetAttribute failed\n"); grid = -1; }
        else {
            if (hipOccupancyMaxActiveBlocksPerMultiprocessor(&per_cu, (const void*)fwd_kernel, NTHREADS, LDS_BYTES) != hipSuccess || per_cu < 1) { fprintf(stderr, "kernel_launch: occupancy query reports %d\n", per_cu); }
            (void)hipGetLastError();
            grid = cus;
        }
    }
    if (grid < 0) { hipLaunchKernelGGL(nan_fill, dim3(1024), dim3(256), 0, stream, (float*)d_out, (size_t)out_size); return; }
    (void)hipMemsetAsync((char*)d_ws + WS_CTL, 0, CTL_BYTES, stream);
    Params p{};
    for (int i = 0; i < 42; ++i) p.in[i] = (const float*)d_in[i];
    p.out = (float*)d_out; p.ws = (unsigned char*)d_ws;
#if PER_PHASE_LAUNCH
    for (int k = 0; k < NPHASES; ++k) { p.ph_lo = k; p.ph_hi = k + 1; hipLaunchKernelGGL(fwd_kernel, dim3(grid), dim3(NTHREADS), LDS_BYTES, stream, p); }
#else
    p.ph_lo = 0; p.ph_hi = NPHASES;
    hipLaunchKernelGGL(fwd_kernel, dim3(grid), dim3(NTHREADS), LDS_BYTES, stream, p);
#endif
}
```

```cpp
#include <hip/hip_runtime.h>
#include <cstdio>
#include <cstdint>

#ifndef REP_MASK
#define REP_MASK 0u
#endif
#ifndef PER_PHASE_LAUNCH
#define PER_PHASE_LAUNCH 0
#endif

#define LAS __attribute__((address_space(3)))
typedef unsigned short bf16_t;
typedef short bf16x8 __attribute__((ext_vector_type(8)));
typedef float f32x4 __attribute__((ext_vector_type(4)));
typedef float f32x2 __attribute__((ext_vector_type(2)));
typedef float f32x16 __attribute__((ext_vector_type(16)));
typedef unsigned u32x4 __attribute__((ext_vector_type(4)));
typedef unsigned u32x2 __attribute__((ext_vector_type(2)));

constexpr int NB = 32, SEQ = 2048, LC = 256, LT = SEQ + LC, D = 1024, NH = 16;
constexpr int NG = 2, BG = NB / NG, TG = BG * LT;
constexpr int NTHREADS = 512, NWAVES = 8;
constexpr int N1CAT = 3584, K1CAT = 2048;
constexpr int NEXP = 16, FEXP = 512;

constexpr size_t al256(size_t x) { return (x + 255) & ~(size_t)255; }
constexpr int XCD_BAR_WORDS_C = 3456;
constexpr size_t WS_CTL = 0;
constexpr size_t CTL_BAR_BYTES = (size_t)XCD_BAR_WORDS_C * 4;
constexpr size_t CTL_CNT_OFF = al256(CTL_BAR_BYTES);
constexpr size_t CTL_BYTES = al256(CTL_CNT_OFF + (size_t)2 * NG * 4 * 32 * 64);
constexpr size_t WS_X = al256(WS_CTL + CTL_BYTES);
constexpr size_t WS_VF = WS_X + (size_t)TG * D * 2;
constexpr size_t WS_MODL = WS_VF + (size_t)TG * D * 2;
constexpr size_t WS_MODC = WS_MODL + (size_t)4 * NB * 6 * D * 4;
constexpr size_t WS_WRKV = al256(WS_MODC + (size_t)4 * 6 * D * 4);
constexpr size_t WS_WL = WS_WRKV + (size_t)2 * 3072 * D * 2;
constexpr size_t WS_WO = WS_WL + (size_t)2 * 512 * K1CAT * 2;
constexpr size_t WS_G2T = WS_WO + (size_t)2 * D * D * 2;
constexpr size_t WS_V2T = WS_G2T + (size_t)2 * D * 256 * 2;
constexpr size_t WS_W2T = WS_V2T + (size_t)D * 256 * 2;
constexpr size_t WS_A2T = WS_W2T + (size_t)4 * D * 64 * 2;
constexpr size_t WS_WIN = WS_A2T + (size_t)4 * D * 64 * 2;
constexpr size_t WS_WOUT = WS_WIN + (size_t)2 * 4096 * D * 2;
constexpr size_t WS_WSP = WS_WOUT + (size_t)2 * D * 2048 * 2;
constexpr size_t WS_WGU = WS_WSP + (size_t)2 * 16 * 128 * 128 * 2;
constexpr size_t WS_WD = WS_WGU + (size_t)4 * NEXP * 1024 * D * 2;
constexpr size_t WS_ARENA = al256(WS_WD + (size_t)4 * NEXP * D * FEXP * 2);
constexpr size_t SZB = (size_t)TG * D * 2;
constexpr size_t AR_H2 = 0;
constexpr size_t AR_Y0 = 0, AR_Y1 = SZB;
constexpr size_t AR_XR = 2 * SZB;
constexpr size_t AR_R = 5 * SZB, AR_K = 6 * SZB, AR_V = 7 * SZB;
constexpr size_t AR_L1 = 8 * SZB;
constexpr size_t AR_DOT = AR_L1 + SZB / 2;
constexpr size_t AR_G = 2 * SZB;
constexpr size_t AR_VGATE = 0;
constexpr size_t AR_O = 3 * SZB;
constexpr size_t AR_H = 0;
constexpr size_t AR_Z = SZB;
constexpr size_t AR_P = 5 * SZB;
constexpr size_t AR_ST = 7 * SZB;
constexpr size_t AR_HM = 0;
constexpr size_t AR_HE = SZB;
constexpr size_t HE_ROWS = (size_t)2 * TG + 32 * 256;
constexpr size_t AR_LIST = al256(AR_HE + HE_ROWS * FEXP * 2);
constexpr size_t AR_LW = AR_LIST + (size_t)32 * TG * 4;
constexpr size_t AR_YM0 = 5 * SZB, AR_YM1 = 6 * SZB;
constexpr size_t ARENA_BYTES = AR_DOT + (size_t)2 * TG * 16 * 4 + 4096;
constexpr size_t WS_END = WS_ARENA + ARENA_BYTES;
static_assert(AR_LW + (size_t)32 * TG * 4 <= AR_O, "moe lists overlap");

constexpr int LDS_STAGE = 131072;
constexpr int LDS_MISC = LDS_STAGE;
constexpr int LDS_BYTES = LDS_STAGE + 1024;

struct Params {
    const float* in[42];
    float* out;
    unsigned char* ws;
    int ph_lo, ph_hi;
};

__device__ __forceinline__ float bf2f(unsigned short b) { return __uint_as_float(((unsigned)b) << 16); }
__device__ __forceinline__ unsigned short f2bf(float f) { unsigned u = __float_as_uint(f); u += 0x7FFFu + ((u >> 16) & 1u); return (unsigned short)(u >> 16); }
typedef __bf16 bf16x2_t __attribute__((ext_vector_type(2)));
__device__ __forceinline__ unsigned pk2(float lo, float hi) { const bf16x2_t v = __builtin_convertvector((f32x2){lo, hi}, bf16x2_t); return __builtin_bit_cast(unsigned, v); }
__device__ __forceinline__ float lo16(unsigned w) { return __uint_as_float(w << 16); }
__device__ __forceinline__ float hi16(unsigned w) { return __uint_as_float(w & 0xFFFF0000u); }
__device__ __forceinline__ float sigmoidf_(float x) { return __builtin_amdgcn_rcpf(1.0f + __expf(-x)); }
__device__ __forceinline__ float tanhf_(float x) { return 1.0f - 2.0f * __builtin_amdgcn_rcpf(__expf(2.0f * x) + 1.0f); }
__device__ __forceinline__ float wave_sum(float v) {
#pragma unroll
    for (int o = 32; o > 0; o >>= 1) v += __shfl_xor(v, o);
    return v;
}
template <int CTRL> __device__ __forceinline__ float dpp_f(float v) {
    return __int_as_float(__builtin_amdgcn_update_dpp(0, __float_as_int(v), CTRL, 0xF, 0xF, true));
}
__device__ __forceinline__ float red8(float v) { v += dpp_f<0xB1>(v); v += dpp_f<0x4E>(v); v += dpp_f<0x141>(v); return v; }
__device__ __forceinline__ float red16(float v) { v = red8(v); v += dpp_f<0x140>(v); return v; }
__device__ __forceinline__ float wave_sum_dpp(float v) {
    v = red16(v);
    const float a = __int_as_float(__builtin_amdgcn_readlane(__float_as_int(v), 0)), b = __int_as_float(__builtin_amdgcn_readlane(__float_as_int(v), 16));
    const float c = __int_as_float(__builtin_amdgcn_readlane(__float_as_int(v), 32)), d = __int_as_float(__builtin_amdgcn_readlane(__float_as_int(v), 48));
    return (a + b) + (c + d);
}
__device__ __forceinline__ float red4(float v) { v += dpp_f<0xB1>(v); v += dpp_f<0x4E>(v); return v; }
__device__ __forceinline__ f32x2 gelu_pk(f32x2 v) {
    const f32x2 av = __builtin_elementwise_abs(v), d = av * 0.2316418882f + 1.0f;
    f32x2 t; t.x = __builtin_amdgcn_rcpf(d.x); t.y = __builtin_amdgcn_rcpf(d.y);
    f32x2 q = t * 0.5307027145f + (-0.7265760135f); q = q * t + 0.7107068705f; q = q * t + (-0.142248368f); q = q * t + 0.127414796f; q = q * t;
    const f32x2 s = (v * v) * (-0.72134752044f);
    f32x2 e; e.x = __builtin_amdgcn_exp2f(s.x); e.y = __builtin_amdgcn_exp2f(s.y);
    const f32x2 m = v * (q * e), r = v - m;
    f32x2 o; o.x = v.x < 0.f ? m.x : r.x; o.y = v.y < 0.f ? m.y : r.y; return o;
}
__device__ __forceinline__ float gelu_f(float v) {
    const float av = fabsf(v), t = __builtin_amdgcn_rcpf(av * 0.2316418882f + 1.0f);
    float q = t * 0.5307027145f + (-0.7265760135f); q = q * t + 0.7107068705f; q = q * t + (-0.142248368f); q = q * t + 0.127414796f; q = q * t;
    const float e = __builtin_amdgcn_exp2f((v * v) * (-0.72134752044f));
    const float m = v * (q * e);
    return v < 0.f ? m : v - m;
}

#define XB_TMO      128
#define XB_XCNT(j)  (256  + 64 * (j))
#define XB_XSUB(j)  (1280 + 64 * (j))
#define XB_XGEN(j)  (2304 + 64 * (j))
#define XB_TOP      3328
#define XB_TOPGEN   3392
#define XCD_BAR_WORDS 3456
#define XB_SPIN_CAP (1u << 22)
static_assert(XCD_BAR_WORDS == XCD_BAR_WORDS_C, "barrier words");
__device__ __forceinline__ unsigned xb_ld(unsigned* p)              { return __hip_atomic_load(p, __ATOMIC_RELAXED, __HIP_MEMORY_SCOPE_AGENT); }
__device__ __forceinline__ unsigned xb_add(unsigned* p, unsigned v) { return __hip_atomic_fetch_add(p, v, __ATOMIC_RELAXED, __HIP_MEMORY_SCOPE_AGENT); }
__device__ __forceinline__ unsigned xb_xcc_id() { return (unsigned)__builtin_amdgcn_s_getreg((3 << 11) | 20) & 0xFu; }
#define XB_SPIN(cond, bar) do { unsigned _sp = 0; while (cond) { __builtin_amdgcn_s_sleep(1); \
    if ((++_sp & 255u) == 0u) { if (xb_ld(&(bar)[XB_TMO])) break; if (_sp > XB_SPIN_CAP) { atomicAdd(&(bar)[XB_TMO], 1u); break; } } } } while (0)
struct XcdBarrier { unsigned* bar; unsigned x; volatile LAS unsigned* st; };
__device__ __forceinline__ XcdBarrier xcd_barrier_post(unsigned* bar, volatile LAS unsigned* st) {
    XcdBarrier b; b.bar = bar; b.x = xb_xcc_id(); b.st = st;
    if (threadIdx.x == 0) (void)xb_add(&bar[XB_XCNT(b.x)], 1u);
    return b;
}
__device__ __forceinline__ void xcd_barrier_complete(unsigned* bar, unsigned x, unsigned& nloc, unsigned& nx) {
    const unsigned G = gridDim.x * gridDim.y * gridDim.z;
    unsigned sum, cnt, mine, sp = 0u;
    for (;;) {
        sum = 0u; cnt = 0u; mine = 0u;
#pragma unroll
        for (unsigned j = 0; j < 16; ++j) { const unsigned c = xb_ld(&bar[XB_XCNT(j)]); sum += c; cnt += (c > 0u) ? 1u : 0u; mine = (j == x) ? c : mine; }
        if (sum == G) break;
        __builtin_amdgcn_s_sleep(1);
        if ((++sp & 255u) == 0u) { if (xb_ld(&bar[XB_TMO])) break; if (sp > XB_SPIN_CAP) { atomicAdd(&bar[XB_TMO], 1u); break; } }
    }
    nloc = mine > 0u ? mine : 1u; nx = cnt > 0u ? cnt : 1u;
}
__device__ __forceinline__ void xcd_barrier(const XcdBarrier& b) {
    asm volatile("s_waitcnt vmcnt(0)" ::: "memory");
    __syncthreads();
    if (threadIdx.x == 0) {
        unsigned* bar = b.bar;
        __builtin_amdgcn_s_waitcnt(0);
        unsigned nloc = b.st[0], nx = b.st[1];
        if (nloc == 0u) { xcd_barrier_complete(bar, b.x, nloc, nx); b.st[0] = nloc; b.st[1] = nx; }
        const unsigned old = xb_add(&bar[XB_XSUB(b.x)], 1u);
        const unsigned gen = old / nloc;
        if (old + 1u == (gen + 1u) * nloc) {
            __builtin_amdgcn_fence(__ATOMIC_RELEASE, "agent");
            asm volatile("s_waitcnt vmcnt(0)" ::: "memory");
            const unsigned og = xb_add(&bar[XB_TOP], 1u);
            const unsigned tg = og / nx;
            if (og + 1u == (tg + 1u) * nx) xb_add(&bar[XB_TOPGEN], 1u);
            else XB_SPIN(xb_ld(&bar[XB_TOPGEN]) == tg, bar);
            __builtin_amdgcn_fence(__ATOMIC_ACQUIRE, "agent");
            xb_add(&bar[XB_XGEN(b.x)], 1u);
            asm volatile("s_waitcnt vmcnt(0)" ::: "memory");
        } else {
            XB_SPIN(xb_ld(&bar[XB_XGEN(b.x)]) == gen, bar);
            __builtin_amdgcn_fence(__ATOMIC_ACQUIRE, "agent");
            asm volatile("s_waitcnt vmcnt(0)" ::: "memory");
        }
    }
    __syncthreads();
}

namespace pg8 {
constexpr int BM = 256, BK = 64, HALF = 128, HTB = HALF * BK * 2, STAGE_BYTES = 8 * HTB, NXCD = 8, WGM = 8;
__host__ __device__ __forceinline__ int lds_byte(int r, int c) { const int st = (r >> 4) * 2 + (c >> 5), rr = r & 15, cc = c & 31, ob = rr * 64 + cc * 2; return st * 1024 + (ob ^ (((ob >> 9) & 1) << 5)); }
__host__ __device__ __forceinline__ void stage_rc(int b, int& R, int& C) { const int st = b / 1024, sb = b % 1024, swz = sb ^ (((sb >> 9) & 1) << 5); R = (st >> 1) * 16 + swz / 64; C = (st & 1) * 32 + (swz % 64) / 2; }
struct Unit { int pm, pn, aux; };

struct SchedPlain {
    static constexpr bool GATHER = false;
    int nM, nN, nwg, G, c, skipctx;
    __device__ void init(int nM_, int nN_, int G_, int c_, int skipctx_) { nM = nM_; nN = nN_; nwg = nM * nN; G = G_; c = c_; skipctx = skipctx_; }
    __device__ bool next(int i, Unit& u) const {
        const long L = (long)i * G + c; if (L >= nwg) return false;
        int wgid = (int)L; { const int q = nwg / NXCD, r = nwg % NXCD, xcd = wgid % NXCD, off = wgid / NXCD; wgid = (xcd < r ? xcd * (q + 1) : r * (q + 1) + (xcd - r) * q) + off; }
        const int nig = WGM * nN, gid = wgid / nig, fm = gid * WGM, gsz = (nM - fm) < WGM ? (nM - fm) : WGM;
        int pm = fm + ((wgid % nig) % gsz); u.pn = (wgid % nig) / gsz; u.aux = 0;
        if (skipctx) pm = (pm >> 3) * 9 + 1 + (pm & 7);
        u.pm = pm; return true;
    }
    __device__ __forceinline__ int arow(const Unit& u, int r) const { return u.pm * BM + r; }
};
struct SchedRKV : SchedPlain {
    __device__ bool next(int i, Unit& u) const { if (!SchedPlain::next(i, u)) return false; u.pm += (u.pn >> 2) * nM; return true; }
};
template <bool GATH> struct SchedMoe {
    static constexpr bool GATHER = GATH;
    const LAS int* cn; const LAS int* tb; const int* lists; int G, c, total;
    __device__ bool next(int i, Unit& u) const {
        const int U = i * G + c; if (U >= total * 4) return false;
        const int T = U >> 2, pn = U & 3; int l = 0;
        while (tb[l + 1] <= T) ++l;
        u.pm = T; u.pn = (l >> 1) * 4 + pn; u.aux = l | ((T - tb[l]) << 8); return true;
    }
    __device__ __forceinline__ int arow(const Unit& u, int r) const {
        if (!GATH) return u.pm * BM + r;
        const int l = u.aux & 255, idx = (u.aux >> 8) * BM + r;
        return idx < cn[l] ? lists[(size_t)l * TG + idx] : 0;
    }
};

template <class Epi, class Sched>
__device__ __forceinline__ void gemm_phase(const int tid, LAS unsigned char* lds, const bf16_t* A, int lda, const bf16_t* Bt, int ldb, int K, const Sched& S, const Epi& E) {
    constexpr bool GA = Sched::GATHER;
    const int wid = __builtin_amdgcn_readfirstlane(tid >> 6), lane = tid & 63, wr = wid >> 2, wc = wid & 3, fr = lane & 15, fq = lane >> 4;
    const int nt = K / BK;
    unsigned voffA[2], voffB[2];
#pragma unroll
    for (int i = 0; i < 2; ++i) { int R, C; stage_rc(tid * 16 + i * 8192, R, C); voffA[i] = (unsigned)(R * lda + C) * 2u; voffB[i] = (unsigned)(R * ldb + C) * 2u; }
    const size_t kstep = (size_t)(BK * 2);
    const size_t hstepA = (size_t)HALF * lda * 2, tstepA = 2 * hstepA;
    const size_t hstepB = (size_t)HALF * ldb * 2, tstepB = 2 * hstepB;
    const unsigned ldsw = (unsigned)wid * 1024u;
    const int aoff = lds_byte(wr * 64 + fr, fq * 8), boff = lds_byte(wc * 32 + fr, fq * 8);
#define PG8_SA(b, h) (((b) * 2 + (h)) * HTB)
#define PG8_SB(b, h) ((4 + (b) * 2 + (h)) * HTB)
#define PG8_STAGE(bufoff, gbase, voff) do { _Pragma("unroll") for (int _i = 0; _i < 2; ++_i) \
        __builtin_amdgcn_global_load_lds((const unsigned*)((const char*)(gbase) + (voff)[_i]), (LAS unsigned*)(lds + (bufoff) + ldsw + _i * 8192), 16, 0, 0); } while (0)
#define PG8_STAGE_A(bufoff, ub, gv, h, koff) do { if constexpr (GA) { PG8_STAGE(bufoff, (const char*)A + (koff), gv[h]); } else { PG8_STAGE(bufoff, (ub) + (h) * hstepA + (koff), voffA); } } while (0)
#define PG8_LDA(dst, b, h) do { _Pragma("unroll") for (int m = 0; m < 4; ++m) _Pragma("unroll") for (int k = 0; k < 2; ++k) dst[m][k] = *(const LAS bf16x8*)(lds + PG8_SA(b, h) + aoff + m * 2048 + k * 1024); } while (0)
#define PG8_LDB(dst, b, h) do { _Pragma("unroll") for (int n = 0; n < 2; ++n) _Pragma("unroll") for (int k = 0; k < 2; ++k) dst[n][k] = *(const LAS bf16x8*)(lds + PG8_SB(b, h) + boff + n * 2048 + k * 1024); } while (0)
#define PG8_MMA(ai, bj, At, Bt_) do { __builtin_amdgcn_s_setprio(1); _Pragma("unroll") for (int m = 0; m < 4; ++m) _Pragma("unroll") for (int n = 0; n < 2; ++n) _Pragma("unroll") for (int k = 0; k < 2; ++k) \
        acc[ai][bj][m][n] = __builtin_amdgcn_mfma_f32_16x16x32_bf16(Bt_[n][k], At[m][k], acc[ai][bj][m][n], 0, 0, 0); __builtin_amdgcn_s_setprio(0); } while (0)
#define PG8_WAIT_V(n) asm volatile("s_waitcnt vmcnt(" #n ")" ::: "memory")
#define PG8_WAIT_L(n) asm volatile("s_waitcnt lgkmcnt(" #n ")" ::: "memory")
#define PG8_BAR __builtin_amdgcn_s_barrier()
#define PG8_SCHED __builtin_amdgcn_sched_barrier(0)
#define PG8_GOFF(dst, u) do { if constexpr (GA) { _Pragma("unroll") for (int _h = 0; _h < 2; ++_h) _Pragma("unroll") for (int _i = 0; _i < 2; ++_i) { int R_, C_; stage_rc(tid * 16 + _i * 8192, R_, C_); \
        dst[_h][_i] = ((unsigned)S.arow(u, _h * HALF + R_) * (unsigned)lda + (unsigned)C_) * 2u; } } } while (0)
    Unit cur, nxt; int ui = 0;
    if (!S.next(0, cur)) return;
    f32x4 acc[2][2][4][2];
#pragma unroll
    for (int a = 0; a < 2; ++a)
#pragma unroll
        for (int b = 0; b < 2; ++b)
#pragma unroll
            for (int m = 0; m < 4; ++m)
#pragma unroll
                for (int n = 0; n < 2; ++n) acc[a][b][m][n] = (f32x4){0.f, 0.f, 0.f, 0.f};
    bf16x8 At[4][2], B0[2][2], B1[2][2];
    unsigned gAc[2][2], gAn[2][2];
    PG8_GOFF(gAc, cur);
    const char* cA = (const char*)A + (GA ? (size_t)0 : (size_t)cur.pm * tstepA);
    const char* cB = (const char*)Bt + (size_t)cur.pn * tstepB;
    PG8_STAGE(PG8_SB(0, 0), cB, voffB); PG8_STAGE_A(PG8_SA(0, 0), cA, gAc, 0, 0); PG8_STAGE(PG8_SB(0, 1), cB + hstepB, voffB); PG8_STAGE_A(PG8_SA(0, 1), cA, gAc, 1, 0);
    if (wr == 1) PG8_BAR;
    PG8_WAIT_V(4); PG8_BAR;
    PG8_STAGE(PG8_SB(1, 0), cB + kstep, voffB); PG8_STAGE_A(PG8_SA(1, 0), cA, gAc, 0, kstep); PG8_STAGE(PG8_SB(1, 1), cB + hstepB + kstep, voffB);
    PG8_WAIT_V(6); PG8_BAR;
    for (;;) {
        const bool has_next = S.next(ui + 1, nxt);
        if (has_next) { PG8_GOFF(gAn, nxt); }
        else if constexpr (GA) {
#pragma unroll
            for (int _h = 0; _h < 2; ++_h)
#pragma unroll
                for (int _i = 0; _i < 2; ++_i) gAn[_h][_i] = gAc[_h][_i];
        }
        const char* nA = (has_next && !GA) ? (const char*)A + (size_t)nxt.pm * tstepA : cA;
        const char* nB = has_next ? (const char*)Bt + (size_t)nxt.pn * tstepB : cB;
#pragma unroll 1
        for (int t = 0; t < nt; t += 2) {
            const bool last = (t == nt - 2);
            const size_t k1 = (size_t)(t + 1) * kstep;
            const size_t k2 = last ? (size_t)0 : (size_t)(t + 2) * kstep, k3 = k2 + kstep;
            const char* a2 = last ? nA : cA; const char* b2 = last ? nB : cB;
            unsigned g2[2][2];
            if constexpr (GA) {
#pragma unroll
                for (int _h = 0; _h < 2; ++_h)
#pragma unroll
                    for (int _i = 0; _i < 2; ++_i) g2[_h][_i] = last ? gAn[_h][_i] : gAc[_h][_i];
            }
            PG8_LDB(B0, 0, 0); PG8_SCHED; PG8_LDA(At, 0, 0); PG8_STAGE_A(PG8_SA(1, 1), cA, gAc, 1, k1);
            PG8_WAIT_L(8); PG8_BAR; PG8_WAIT_L(0); PG8_MMA(0, 0, At, B0); PG8_BAR; PG8_SCHED;
            PG8_LDB(B1, 0, 1); PG8_STAGE(PG8_SB(0, 0), b2 + k2, voffB);
            PG8_BAR; PG8_WAIT_L(0); PG8_MMA(0, 1, At, B1); PG8_BAR;
            PG8_LDA(At, 0, 1); PG8_STAGE_A(PG8_SA(0, 0), a2, g2, 0, k2);
            PG8_BAR; PG8_WAIT_L(0); PG8_MMA(1, 0, At, B0); PG8_BAR; PG8_SCHED;
            PG8_STAGE(PG8_SB(0, 1), b2 + hstepB + k2, voffB);
            PG8_WAIT_V(6); PG8_BAR; PG8_MMA(1, 1, At, B1); PG8_BAR;
            PG8_LDB(B0, 1, 0); PG8_SCHED; PG8_LDA(At, 1, 0); PG8_STAGE_A(PG8_SA(0, 1), a2, g2, 1, k2);
            PG8_WAIT_L(8); PG8_BAR; PG8_WAIT_L(0); PG8_MMA(0, 0, At, B0); PG8_BAR; PG8_SCHED;
            PG8_LDB(B1, 1, 1); PG8_STAGE(PG8_SB(1, 0), b2 + k3, voffB);
            PG8_BAR; PG8_WAIT_L(0); PG8_MMA(0, 1, At, B1); PG8_BAR;
            PG8_LDA(At, 1, 1); PG8_STAGE_A(PG8_SA(1, 0), a2, g2, 0, k3);
            PG8_BAR; PG8_WAIT_L(0); PG8_MMA(1, 0, At, B0); PG8_BAR; PG8_SCHED;
            PG8_STAGE(PG8_SB(1, 1), b2 + hstepB + k3, voffB);
            PG8_WAIT_V(6); PG8_BAR; PG8_MMA(1, 1, At, B1); PG8_BAR;
        }
        { int fr_e = fr, fq_e = fq; asm volatile("" : "+v"(fr_e), "+v"(fq_e)); E(acc, cur, wr, wc, fr_e, fq_e); }
        if (!has_next) break;
#pragma unroll
        for (int a = 0; a < 2; ++a)
#pragma unroll
            for (int b = 0; b < 2; ++b)
#pragma unroll
                for (int m = 0; m < 4; ++m)
#pragma unroll
                    for (int n = 0; n < 2; ++n) acc[a][b][m][n] = (f32x4){0.f, 0.f, 0.f, 0.f};
        cur = nxt; cA = nA; cB = nB; ++ui;
        if constexpr (GA) {
#pragma unroll
            for (int _h = 0; _h < 2; ++_h)
#pragma unroll
                for (int _i = 0; _i < 2; ++_i) gAc[_h][_i] = gAn[_h][_i];
        }
    }
    PG8_WAIT_V(0);
    if (wr == 0) PG8_BAR;
    PG8_BAR;
#undef PG8_SA
#undef PG8_SB
#undef PG8_STAGE
#undef PG8_STAGE_A
#undef PG8_LDA
#undef PG8_LDB
#undef PG8_MMA
#undef PG8_WAIT_V
#undef PG8_WAIT_L
#undef PG8_BAR
#undef PG8_SCHED
#undef PG8_GOFF
}
}
using pg8::Unit;

#define EPI_LOOP_BEGIN \
    _Pragma("unroll") for (int ai = 0; ai < 2; ++ai) _Pragma("unroll") for (int m = 0; m < 4; ++m) { const int trow = ai * 128 + wr * 64 + m * 16 + fr; \
    _Pragma("unroll") for (int bj = 0; bj < 2; ++bj) _Pragma("unroll") for (int n = 0; n < 2; ++n) { const int tcol = bj * 128 + wc * 32 + n * 16 + 4 * fq; const f32x4 v = acc[ai][bj][m][n];
#define EPI_LOOP_END } asm volatile("" ::: "memory"); }

struct EpiRKV {
    unsigned char* ws; size_t voff;
    __device__ __forceinline__ void operator()(const f32x4 (&acc)[2][2][4][2], const Unit& u, int wr, int wc, int fr, int fq) const {
        const int which = u.pn >> 2; const size_t row0 = (size_t)(u.pm - which * (TG / 256)) * 256;
        const size_t off = which == 0 ? (WS_ARENA + AR_R) : (which == 1 ? (WS_ARENA + AR_K) : voff);
        bf16_t* dst = (bf16_t*)(ws + off); const int cb = (u.pn & 3) * 256;
        EPI_LOOP_BEGIN
            u32x2 w; w.x = pk2(v[0], v[1]); w.y = pk2(v[2], v[3]);
            *(u32x2*)(dst + (row0 + trow) * D + cb + tcol) = w;
        EPI_LOOP_END
    }
};
struct EpiL1 {
    bf16_t* L1;
    __device__ __forceinline__ void operator()(const f32x4 (&acc)[2][2][4][2], const Unit& u, int wr, int wc, int fr, int fq) const {
        const int pn = u.pn; const size_t row0 = (size_t)u.pm * 256; const int cb = pn * 256;
        EPI_LOOP_BEGIN
            f32x4 o = v;
            if (pn == 0 && bj == 0) { o[0] = tanhf_(v[0]); o[1] = tanhf_(v[1]); o[2] = tanhf_(v[2]); o[3] = tanhf_(v[3]); }
            if (pn == 1 && bj == 0) { o[0] = sigmoidf_(v[0]); o[1] = sigmoidf_(v[1]); o[2] = sigmoidf_(v[2]); o[3] = sigmoidf_(v[3]); }
            u32x2 w; w.x = pk2(o[0], o[1]); w.y = pk2(o[2], o[3]);
            *(u32x2*)(L1 + (row0 + trow) * 512 + cb + tcol) = w;
        EPI_LOOP_END
    }
};
template <int ACT> struct EpiStore {
    bf16_t* O; const float* bias;
    __device__ __forceinline__ void operator()(const f32x4 (&acc)[2][2][4][2], const Unit& u, int wr, int wc, int fr, int fq) const {
        const size_t row0 = (size_t)u.pm * 256; const int cb = u.pn * 256;
        f32x4 bv[2][2];
#pragma unroll
        for (int bj = 0; bj < 2; ++bj)
#pragma unroll
            for (int n = 0; n < 2; ++n) bv[bj][n] = ACT == 1 ? *(const f32x4*)(bias + cb + bj * 128 + wc * 32 + n * 16 + 4 * fq) : (f32x4){0.f, 0.f, 0.f, 0.f};
        EPI_LOOP_BEGIN
            f32x4 o = v;
            if (ACT == 1) { const f32x4 b = bv[bj][n]; o[0] = sigmoidf_(v[0] + b[0]); o[1] = sigmoidf_(v[1] + b[1]); o[2] = sigmoidf_(v[2] + b[2]); o[3] = sigmoidf_(v[3] + b[3]); }
            u32x2 w; w.x = pk2(o[0], o[1]); w.y = pk2(o[2], o[3]);
            *(u32x2*)(O + (row0 + trow) * D + cb + tcol) = w;
        EPI_LOOP_END
    }
};
struct EpiGelu {
    bf16_t* Z; const float* bias;
    __device__ __forceinline__ void operator()(const f32x4 (&acc)[2][2][4][2], const Unit& u, int wr, int wc, int fr, int fq) const {
        const size_t row0 = (size_t)u.pm * 256; const int cb = u.pn * 256;
        f32x4 bv[2][2];
#pragma unroll
        for (int bj = 0; bj < 2; ++bj)
#pragma unroll
            for (int n = 0; n < 2; ++n) bv[bj][n] = *(const f32x4*)(bias + cb + bj * 128 + wc * 32 + n * 16 + 4 * fq);
        EPI_LOOP_BEGIN
            const f32x4 b = bv[bj][n];
            const f32x2 g0 = gelu_pk((f32x2){v[0] + b[0], v[1] + b[1]}), g1 = gelu_pk((f32x2){v[2] + b[2], v[3] + b[3]});
            u32x2 w; w.x = pk2(g0.x, g0.y); w.y = pk2(g1.x, g1.y);
            *(u32x2*)(Z + (row0 + trow) * 4096 + cb + tcol) = w;
        EPI_LOOP_END
    }
};
struct EpiMG {
    bf16_t* HE;
    __device__ __forceinline__ void operator()(const f32x4 (&acc)[2][2][4][2], const Unit& u, int wr, int wc, int fr, int fq) const {
        const size_t row0 = (size_t)u.pm * 256; const int pnl = u.pn & 3;
#pragma unroll
        for (int ai = 0; ai < 2; ++ai)
#pragma unroll
            for (int m = 0; m < 4; ++m) { const int trow = ai * 128 + wr * 64 + m * 16 + fr;
#pragma unroll
                for (int bj = 0; bj < 2; ++bj) {
                    const f32x4 gt = acc[ai][bj][m][0], up = acc[ai][bj][m][1];
                    const int f = (8 * pnl + 4 * bj + wc) * 16 + 4 * fq;
                    float o[4];
#pragma unroll
                    for (int e = 0; e < 4; ++e) o[e] = gt[e] * sigmoidf_(gt[e]) * up[e];
                    u32x2 w; w.x = pk2(o[0], o[1]); w.y = pk2(o[2], o[3]);
                    *(u32x2*)(HE + (row0 + trow) * FEXP + f) = w;
                } }
    }
};
struct EpiMD {
    bf16_t* Y0; const int* lists; const float* lw; const LAS int* cn;
    __device__ __forceinline__ void operator()(const f32x4 (&acc)[2][2][4][2], const Unit& u, int wr, int wc, int fr, int fq) const {
        const int l = u.aux & 255, t0 = (u.aux >> 8) * 256, cnt = cn[l]; const int cb = (u.pn & 3) * 256;
        bf16_t* Y = Y0 + (size_t)(l & 1) * ((AR_YM1 - AR_YM0) / 2);
        int tok[2][4]; float wgt[2][4];
#pragma unroll
        for (int ai = 0; ai < 2; ++ai)
#pragma unroll
            for (int m = 0; m < 4; ++m) { const int idx = t0 + ai * 128 + wr * 64 + m * 16 + fr; const bool ok = idx < cnt;
                tok[ai][m] = ok ? lists[(size_t)l * TG + idx] : -1; wgt[ai][m] = ok ? lw[(size_t)l * TG + idx] : 0.f; }
#pragma unroll
        for (int ai = 0; ai < 2; ++ai)
#pragma unroll
            for (int m = 0; m < 4; ++m) {
                if (tok[ai][m] >= 0) {
                    const float wg = wgt[ai][m]; bf16_t* yr = Y + (size_t)tok[ai][m] * D + cb;
#pragma unroll
                    for (int bj = 0; bj < 2; ++bj)
#pragma unroll
                        for (int n = 0; n < 2; ++n) { const int tcol = bj * 128 + wc * 32 + n * 16 + 4 * fq; const f32x4 v = acc[ai][bj][m][n];
                            u32x2 w; w.x = pk2(v[0] * wg, v[1] * wg); w.y = pk2(v[2] * wg, v[3] * wg);
                            *(u32x2*)(yr + tcol) = w; }
                } }
    }
};

struct Frame {
    const Params __attribute__((address_space(4)))* kp; LAS unsigned char* lds; int tid, lane, wave, G, bid;
    unsigned char* ws;
    __device__ __forceinline__ const float* in(int k) const { return kp->in[k]; }
    __device__ __forceinline__ float* outp() const { return kp->out; }
    template <class T> __device__ __forceinline__ T* wsp(size_t off) const { return (T*)(ws + off); }
    template <class T> __device__ __forceinline__ T* ar(size_t off) const { return (T*)(ws + WS_ARENA + off); }
    __device__ __forceinline__ const float* modL(int layer, int b, int j) const { return (const float*)(ws + WS_MODL) + (((size_t)layer * NB + b) * 6 + j) * D; }
    __device__ __forceinline__ const float* modC(int layer, int j) const { return (const float*)(ws + WS_MODC) + ((size_t)layer * 6 + j) * D; }
};

struct TJob { const float* src; bf16_t* dst; const float* ksc; int lds, K, N, ldd, kofs, nofs, inter; };
constexpr int NJOBS = 2 * 21 + 1 + 4 + 4 * NEXP * 3;
__device__ __forceinline__ TJob get_job(const Frame& F, int j) {
    TJob J; J.ksc = nullptr; J.kofs = 0; J.nofs = 0; J.inter = 0; J.K = 0; J.N = 0; J.lds = 0; J.ldd = 0; J.src = nullptr; J.dst = nullptr;
    if (j < 42) {
        const int a = j / 21, q = j % 21;
        if (q < 3) { J.src = F.in(9 + q) + (size_t)a * D * D; J.lds = D; J.K = D; J.N = D; J.dst = F.wsp<bf16_t>(WS_WRKV) + (size_t)a * 3072 * D; J.ldd = D; J.nofs = q * 1024; }
        else if (q < 15) {
            const int half = (q - 3) / 6, w = (q - 3) % 6; const float* mu = F.in(8) + (size_t)a * 6 * D;
            J.dst = F.wsp<bf16_t>(WS_WL) + (size_t)a * 512 * K1CAT; J.ldd = K1CAT; J.kofs = half * 1024; J.K = D; int mi = 0;
            if (w < 2) { J.src = F.in(14) + ((size_t)a * 2 + w) * D * 64; J.lds = 64; J.N = 64; J.nofs = w * 64; mi = 1; }
            else if (w < 4) { const int d = w - 2; J.src = F.in(17) + ((size_t)a * 2 + d) * D * 64; J.lds = 64; J.N = 64; J.nofs = 128 + d * 64; mi = 4; }
            else if (w == 4) { J.src = F.in(22) + (size_t)a * D * 128; J.lds = 128; J.N = 128; J.nofs = 256; mi = 5; }
            else { J.src = F.in(20); J.lds = 32; J.N = (a == 1) ? 32 : 0; J.nofs = 384; mi = 3; }
            if (half) J.ksc = mu + mi * D;
        } else if (q == 15) { J.src = F.in(12) + (size_t)a * D * D; J.lds = D; J.K = D; J.N = D; J.dst = F.wsp<bf16_t>(WS_WO) + (size_t)a * D * D; J.ldd = D; }
        else if (q == 16) { J.src = F.in(23) + (size_t)a * 128 * D; J.lds = D; J.K = 128; J.N = D; J.dst = F.wsp<bf16_t>(WS_G2T) + (size_t)a * D * 256; J.ldd = 256; }
        else if (q < 19) { const int d = q - 17; J.src = F.in(15) + ((size_t)a * 2 + d) * 64 * D; J.lds = D; J.K = 64; J.N = D; J.dst = F.wsp<bf16_t>(WS_W2T) + ((size_t)a * 2 + d) * D * 64; J.ldd = 64; }
        else { const int d = q - 19; J.src = F.in(18) + ((size_t)a * 2 + d) * 64 * D; J.lds = D; J.K = 64; J.N = D; J.dst = F.wsp<bf16_t>(WS_A2T) + ((size_t)a * 2 + d) * D * 64; J.ldd = 64; }
    } else if (j == 42) { J.src = F.in(21); J.lds = D; J.K = 32; J.N = D; J.dst = F.wsp<bf16_t>(WS_V2T); J.ldd = 256; J.kofs = 128; }
    else if (j < 47) {
        const int q = j - 43, b = q >> 1;
        if ((q & 1) == 0) { J.src = F.in(29) + (size_t)b * D * 4096; J.lds = 4096; J.K = D; J.N = 4096; J.dst = F.wsp<bf16_t>(WS_WIN) + (size_t)b * 4096 * D; J.ldd = D; }
        else { J.src = F.in(35) + (size_t)b * 2048 * D; J.lds = D; J.K = 2048; J.N = D; J.dst = F.wsp<bf16_t>(WS_WOUT) + (size_t)b * D * 2048; J.ldd = 2048; }
    } else {
        const int q = j - 47, ie = q / 3, w = q % 3;
        if (w < 2) { J.src = F.in(38 + w) + (size_t)ie * D * FEXP; J.lds = FEXP; J.K = D; J.N = FEXP; J.dst = F.wsp<bf16_t>(WS_WGU) + (size_t)ie * 1024 * D; J.ldd = D; J.nofs = w * 16; J.inter = 1; }
        else { J.src = F.in(40) + (size_t)ie * FEXP * D; J.lds = D; J.K = FEXP; J.N = D; J.dst = F.wsp<bf16_t>(WS_WD) + (size_t)ie * D * FEXP; J.ldd = FEXP; }
    }
    return J;
}
__device__ __forceinline__ void transpose_all(const Frame& F) {
    LAS float* tile = (LAS float*)F.lds;
    int tilectr = 0;
#pragma unroll 1
    for (int j = 0; j < NJOBS; ++j) {
        const TJob J = get_job(F, j);
        const int tk = (J.K + 127) / 128, tn = (J.N + 127) / 128, ntile = tk * tn;
        int t = (F.bid - (tilectr % F.G) + F.G) % F.G;
        tilectr += ntile;
#pragma unroll 1
        for (; t < ntile; t += F.G) {
            const int k0 = (t / tn) * 128, n0 = (t % tn) * 128;
            __syncthreads();
            float v[32];
#pragma unroll
            for (int e = 0; e < 32; ++e) { const int idx = F.tid + e * 512, kk = idx >> 7, nn = idx & 127;
                v[e] = 0.f; if (k0 + kk < J.K && n0 + nn < J.N) v[e] = J.src[(size_t)(k0 + kk) * J.lds + n0 + nn]; }
#pragma unroll
            for (int e = 0; e < 32; ++e) { const int idx = F.tid + e * 512, kk = idx >> 7, nn = idx & 127;
                float x = v[e]; if (J.ksc && k0 + kk < J.K) x *= J.ksc[k0 + kk];
                tile[kk * 129 + nn] = x; }
            __syncthreads();
#pragma unroll
            for (int e = 0; e < 16; ++e) { const int idx = F.tid + e * 512, nn = idx >> 6, kk = (idx & 63) * 2;
                if (k0 + kk < J.K && n0 + nn < J.N) { const int n = n0 + nn; const int row = J.nofs + (J.inter ? ((n >> 4) * 32 + (n & 15)) : n);
                    *(unsigned*)(J.dst + (size_t)row * J.ldd + J.kofs + k0 + kk) = pk2(tile[kk * 129 + nn], tile[(kk + 1) * 129 + nn]); } }
        }
    }
    __syncthreads();
}
__device__ __forceinline__ void zero_rows(const Frame& F, bf16_t* dst, int ldd, int row0, int nrows, int col0, int ncols) {
    const int per = ncols / 8; const long tot = (long)nrows * per;
    for (long i = (long)F.bid * NTHREADS + F.tid; i < tot; i += (long)F.G * NTHREADS) { const int r = (int)(i / per), c = (int)(i % per) * 8;
        *(u32x4*)(dst + (size_t)(row0 + r) * ldd + col0 + c) = (u32x4){0u, 0u, 0u, 0u}; }
}
__device__ __forceinline__ void phase_prologue(const Frame& F) {
    {
        LAS float* sl = (LAS float*)F.lds;
        LAS float* red = (LAS float*)(F.lds + 33 * 256 * 4);
        const float* c = F.in(1); const float* cc = F.in(3); const float* wm = F.in(4); const float* bm = F.in(5);
        const int tx = F.tid & 63, ty = F.tid >> 6;
        for (int unit = F.bid; unit < 4 * 96; unit += F.G) {
            const int layer = unit / 96, col0 = (unit % 96) * 64;
            float acc[33];
#pragma unroll
            for (int r = 0; r < 33; ++r) acc[r] = 0.f;
#pragma unroll 1
            for (int kc = 0; kc < 4; ++kc) {
                __syncthreads();
                for (int i = F.tid; i < 33 * 256; i += NTHREADS) { const int r = i >> 8, k = (i & 255) + kc * 256; const float x = r < 32 ? c[r * D + k] : cc[k]; sl[i] = x * sigmoidf_(x); }
                __syncthreads();
#pragma unroll 1
                for (int k4 = 0; k4 < 32; k4 += 4) {
                    const int kl = ty * 32 + k4;
                    float w[4];
#pragma unroll
                    for (int e = 0; e < 4; ++e) w[e] = wm[((size_t)layer * D + kc * 256 + kl + e) * 6144 + col0 + tx];
#pragma unroll
                    for (int r = 0; r < 33; ++r) { const f32x4 s = *(const LAS f32x4*)(sl + r * 256 + kl); acc[r] += s[0] * w[0] + s[1] * w[1] + s[2] * w[2] + s[3] * w[3]; if ((r & 7) == 7) asm volatile("" ::: "memory"); }
                }
            }
            __syncthreads();
#pragma unroll
            for (int r = 0; r < 33; ++r) red[(ty * 33 + r) * 64 + tx] = acc[r];
            __syncthreads();
            for (int i = F.tid; i < 33 * 64; i += NTHREADS) { const int r = i >> 6, x = i & 63; float s = 0.f;
#pragma unroll
                for (int y = 0; y < 8; ++y) s += red[(y * 33 + r) * 64 + x];
                const int col = col0 + x; s += bm[layer * 6144 + col];
                if (r < 32) F.wsp<float>(WS_MODL)[((size_t)layer * NB + r) * 6144 + col] = s; else F.wsp<float>(WS_MODC)[(size_t)layer * 6144 + col] = s; }
        }
    }
    __syncthreads();
    transpose_all(F);
    for (int a = 0; a < 2; ++a) {
        bf16_t* WLp = F.wsp<bf16_t>(WS_WL) + (size_t)a * 512 * K1CAT;
        if (a == 0) zero_rows(F, WLp, K1CAT, 384, 128, 0, K1CAT); else zero_rows(F, WLp, K1CAT, 416, 96, 0, K1CAT);
        zero_rows(F, F.wsp<bf16_t>(WS_G2T) + (size_t)a * D * 256, 256, 0, D, 128, 128);
    }
    zero_rows(F, F.wsp<bf16_t>(WS_V2T), 256, 0, D, 0, 128); zero_rows(F, F.wsp<bf16_t>(WS_V2T), 256, 0, D, 160, 96);
    {
        const float* src = F.in(33); bf16_t* dst = F.wsp<bf16_t>(WS_WSP); const long tot = (long)2 * 16 * 128 * 128 / 4;
        for (long i = (long)F.bid * NTHREADS + F.tid; i < tot; i += (long)F.G * NTHREADS) { const f32x4 v = *(const f32x4*)(src + i * 4); u32x2 w; w.x = pk2(v[0], v[1]); w.y = pk2(v[2], v[3]); *(u32x2*)(dst + i * 4) = w; }
    }
    __syncthreads();
}

__device__ __forceinline__ void phase_norm1(const Frame& F, int g, int layer  , bf16_t* dst, int ldh, bool dry = false) {
    bf16_t* X = F.wsp<bf16_t>(WS_X);
    const bf16_t* Y0 = F.ar<bf16_t>(AR_YM0); const bf16_t* Y1 = F.ar<bf16_t>(AR_YM1);
    const bool fin = layer == 4;
    const int rpb = (TG + F.G - 1) / F.G, rbeg = F.bid * rpb, rend = (rbeg + rpb) < TG ? (rbeg + rpb) : TG;
    int key = -1; f32x4 cg[4], cA[4], cB[4];
#pragma unroll
    for (int q = 0; q < 4; ++q) { cg[q] = (f32x4){0.f, 0.f, 0.f, 0.f}; cA[q] = cg[q]; cB[q] = cg[q]; }
    for (int r = rbeg + F.wave; r < rend; r += NWAVES) {
        const int bl = r / LT, t = r % LT, b = g * BG + bl; const bool isctx = t < LC;
        if (isctx && layer >= 3) continue;
        if (key != b * 2 + (int)isctx) {
            key = b * 2 + (int)isctx;
#pragma unroll
            for (int q = 0; q < 4; ++q) { const int c = q * 256 + F.lane * 4;
                if (layer > 0) cg[q] = *(const f32x4*)((isctx ? F.modC(layer - 1, 5) : F.modL(layer - 1, b, 5)) + c);
                if (fin) cA[q] = *(const f32x4*)(F.in(41) + c);
                else { const f32x4 gv = *(const f32x4*)(F.in(6) + (size_t)layer * D + c), cv = *(const f32x4*)((isctx ? F.modC(layer, 1) : F.modL(layer, b, 1)) + c);
                    cA[q] = gv * (1.0f + cv); cB[q] = *(const f32x4*)((isctx ? F.modC(layer, 0) : F.modL(layer, b, 0)) + c); } }
        }
        f32x4 x[4], xo[4];
#pragma unroll
        for (int q = 0; q < 4; ++q) xo[q] = (f32x4){0.f, 0.f, 0.f, 0.f};
        if (layer == 0) {
            const float* src = isctx ? F.in(2) + ((size_t)b * LC + t) * D : F.in(0) + ((size_t)b * SEQ + (t - LC)) * D;
#pragma unroll
            for (int q = 0; q < 4; ++q) x[q] = *(const f32x4*)(src + q * 256 + F.lane * 4);
        } else {
#pragma unroll
            for (int q = 0; q < 4; ++q) { const int c = q * 256 + F.lane * 4;
                { const u32x2 xw = *(const u32x2*)(X + (size_t)r * D + c); x[q] = (f32x4){lo16(xw.x), hi16(xw.x), lo16(xw.y), hi16(xw.y)}; } xo[q] = x[q];
                const u32x2 a = *(const u32x2*)(Y0 + (size_t)r * D + c), bb = *(const u32x2*)(Y1 + (size_t)r * D + c);
                x[q][0] += cg[q][0] * (lo16(a.x) + lo16(bb.x)); x[q][1] += cg[q][1] * (hi16(a.x) + hi16(bb.x));
                x[q][2] += cg[q][2] * (lo16(a.y) + lo16(bb.y)); x[q][3] += cg[q][3] * (hi16(a.y) + hi16(bb.y)); }
        }
        float ss = 0.f;
#pragma unroll
        for (int q = 0; q < 4; ++q) ss += x[q][0] * x[q][0] + x[q][1] * x[q][1] + x[q][2] * x[q][2] + x[q][3] * x[q][3];
        ss = wave_sum_dpp(ss);
        const float rstd = rsqrtf(ss * (1.0f / D) + 1e-6f);
        if (fin) {
            float* o = F.outp() + ((size_t)b * SEQ + (t - LC)) * D;
#pragma unroll
            for (int q = 0; q < 4; ++q) { const int c = q * 256 + F.lane * 4; *(f32x4*)(o + c) = x[q] * rstd * cA[q]; }
        } else {
#pragma unroll
            for (int q = 0; q < 4; ++q) { const int c = q * 256 + F.lane * 4;
                { const f32x4 xs = (dry && layer > 0) ? xo[q] : x[q]; u32x2 xw; xw.x = pk2(xs[0], xs[1]); xw.y = pk2(xs[2], xs[3]); *(u32x2*)(X + (size_t)r * D + c) = xw; }
                const f32x4 h = x[q] * rstd * cA[q] + cB[q];
                u32x2 w; w.x = pk2(h[0], h[1]); w.y = pk2(h[2], h[3]);
                *(u32x2*)(dst + (size_t)r * ldh + c) = w; }
        }
    }
}
__device__ __forceinline__ void phase_mix(const Frame& F, int a) {
    bf16_t* H2 = F.ar<bf16_t>(AR_H2); bf16_t* XM = F.ar<bf16_t>(AR_XR);
    const float* mu = F.in(8) + (size_t)a * 6 * D;
    f32x4 cm[2][3][2];
#pragma unroll
    for (int q = 0; q < 2; ++q)
#pragma unroll
        for (int m = 0; m < 3; ++m) { const int mi = m == 0 ? 0 : (m == 1 ? 2 : 3); const int c = q * 512 + F.lane * 8;
            cm[q][m][0] = *(const f32x4*)(mu + mi * D + c); cm[q][m][1] = *(const f32x4*)(mu + mi * D + c + 4); }
    const int rpb = (TG + F.G - 1) / F.G, rbeg = F.bid * rpb, rend = (rbeg + rpb) < TG ? (rbeg + rpb) : TG;
    for (int r = rbeg + F.wave; r < rend; r += NWAVES) {
        const int t = r % LT; const bool isctx = t < LC; const int p = t - LC;
#pragma unroll
        for (int q = 0; q < 2; ++q) {
            const int c = q * 512 + F.lane * 8;
            int nr;
            if (isctx) nr = (q == 0) ? (t > 0 ? r - 1 : -1) : (t < LC - 1 ? r + 1 : -1);
            else { const int qu = c >> 8;
                nr = qu == 0 ? ((p & 63) > 0 ? r - 1 : -1) : qu == 1 ? ((p & 63) < 63 ? r + 1 : -1) : qu == 2 ? (p >= 64 ? r - 64 : -1) : (p < SEQ - 64 ? r + 64 : -1); }
            const u32x4 hs = *(const u32x4*)(H2 + (size_t)r * 2048 + c);
            u32x4 hn = (u32x4){0u, 0u, 0u, 0u};
            if (nr >= 0) hn = *(const u32x4*)(H2 + (size_t)nr * 2048 + c);
            const float h[8] = {lo16(hs.x), hi16(hs.x), lo16(hs.y), hi16(hs.y), lo16(hs.z), hi16(hs.z), lo16(hs.w), hi16(hs.w)};
            const float n[8] = {lo16(hn.x), hi16(hn.x), lo16(hn.y), hi16(hn.y), lo16(hn.z), hi16(hn.z), lo16(hn.w), hi16(hn.w)};
            float dd[8];
#pragma unroll
            for (int e = 0; e < 8; ++e) dd[e] = n[e] - h[e];
            *(u32x4*)(H2 + (size_t)r * 2048 + 1024 + c) = (u32x4){pk2(dd[0], dd[1]), pk2(dd[2], dd[3]), pk2(dd[4], dd[5]), pk2(dd[6], dd[7])};
#pragma unroll
            for (int m = 0; m < 3; ++m) {
                const f32x4 m0 = cm[q][m][0], m1 = cm[q][m][1];
                float x[8];
#pragma unroll
                for (int e = 0; e < 4; ++e) { x[e] = h[e] + dd[e] * m0[e]; x[4 + e] = h[4 + e] + dd[4 + e] * m1[e]; }
                *(u32x4*)(XM + (size_t)m * TG * D + (size_t)r * D + c) = (u32x4){pk2(x[0], x[1]), pk2(x[2], x[3]), pk2(x[4], x[5]), pk2(x[6], x[7])};
            }
        }
    }
}
__device__ __forceinline__ void phase_vfix(const Frame& F) {
    bf16_t* V = F.ar<bf16_t>(AR_V); const bf16_t* VF = F.wsp<bf16_t>(WS_VF); const bf16_t* GT = F.ar<bf16_t>(AR_VGATE);
    const size_t tot = (size_t)TG * D / 8;
    for (size_t i = (size_t)F.bid * NTHREADS + F.tid; i < tot; i += (size_t)F.G * NTHREADS) {
        const u32x4 v = *(const u32x4*)(V + i * 8), f = *(const u32x4*)(VF + i * 8), g = *(const u32x4*)(GT + i * 8);
        u32x4 o;
        o.x = pk2(lo16(v.x) + (lo16(f.x) - lo16(v.x)) * lo16(g.x), hi16(v.x) + (hi16(f.x) - hi16(v.x)) * hi16(g.x));
        o.y = pk2(lo16(v.y) + (lo16(f.y) - lo16(v.y)) * lo16(g.y), hi16(v.y) + (hi16(f.y) - hi16(v.y)) * hi16(g.y));
        o.z = pk2(lo16(v.z) + (lo16(f.z) - lo16(v.z)) * lo16(g.z), hi16(v.z) + (hi16(f.z) - hi16(v.z)) * hi16(g.z));
        o.w = pk2(lo16(v.w) + (lo16(f.w) - lo16(v.w)) * lo16(g.w), hi16(v.w) + (hi16(f.w) - hi16(v.w)) * hi16(g.w));
        *(u32x4*)(V + i * 8) = o;
    }
}
__device__ __forceinline__ void phase_post(const Frame& F, int a, const bf16_t* V) {
    const bf16_t* Y0 = F.ar<bf16_t>(AR_Y0); bf16_t* YG = F.ar<bf16_t>(AR_R); const bf16_t* Y1 = F.ar<bf16_t>(AR_Y1); const float* DOT = F.ar<float>(AR_DOT); const bf16_t* Gb = F.ar<bf16_t>(AR_G);
    const float* lgp = F.in(27) + (size_t)a * D + F.lane * 16; const float* lbp = F.in(28) + (size_t)a * D + F.lane * 16;
    float lg[16], lb[16];
#pragma unroll
    for (int e = 0; e < 16; e += 4) { const f32x4 gq = *(const f32x4*)(lgp + e), bq = *(const f32x4*)(lbp + e);
        lg[e] = gq[0]; lg[e + 1] = gq[1]; lg[e + 2] = gq[2]; lg[e + 3] = gq[3]; lb[e] = bq[0]; lb[e + 1] = bq[1]; lb[e + 2] = bq[2]; lb[e + 3] = bq[3]; }
    const int rpb = (TG + F.G - 1) / F.G, rbeg = F.bid * rpb, rend = (rbeg + rpb) < TG ? (rbeg + rpb) : TG;
    for (int r = rbeg + F.wave; r < rend; r += NWAVES) {
        const int c = F.lane * 16, h = F.lane >> 2;
        float y[16], vv[16];
#pragma unroll
        for (int q = 0; q < 2; ++q) {
            const u32x4 a0 = *(const u32x4*)(Y0 + (size_t)r * D + c + q * 8), a1 = *(const u32x4*)(Y1 + (size_t)r * D + c + q * 8), v4 = *(const u32x4*)(V + (size_t)r * D + c + q * 8);
            y[q * 8 + 0] = lo16(a0.x) + lo16(a1.x); y[q * 8 + 1] = hi16(a0.x) + hi16(a1.x); y[q * 8 + 2] = lo16(a0.y) + lo16(a1.y); y[q * 8 + 3] = hi16(a0.y) + hi16(a1.y);
            y[q * 8 + 4] = lo16(a0.z) + lo16(a1.z); y[q * 8 + 5] = hi16(a0.z) + hi16(a1.z); y[q * 8 + 6] = lo16(a0.w) + lo16(a1.w); y[q * 8 + 7] = hi16(a0.w) + hi16(a1.w);
            vv[q * 8 + 0] = lo16(v4.x); vv[q * 8 + 1] = hi16(v4.x); vv[q * 8 + 2] = lo16(v4.y); vv[q * 8 + 3] = hi16(v4.y);
            vv[q * 8 + 4] = lo16(v4.z); vv[q * 8 + 5] = hi16(v4.z); vv[q * 8 + 6] = lo16(v4.w); vv[q * 8 + 7] = hi16(v4.w);
        }
        float s = 0.f;
#pragma unroll
        for (int e = 0; e < 16; ++e) s += y[e];
        s = red4(s); const float mean = s * (1.0f / 64.0f);
        float qv = 0.f;
#pragma unroll
        for (int e = 0; e < 16; ++e) { const float dd = y[e] - mean; qv += dd * dd; }
        qv = red4(qv); const float rstd = rsqrtf(qv * (1.0f / 64.0f) + 64e-5f);
        const float dsum = DOT[(size_t)r * NH + h] + DOT[((size_t)TG + r) * NH + h];
        unsigned o[8];
        const u32x4 g0 = *(const u32x4*)(Gb + (size_t)r * D + c), g1 = *(const u32x4*)(Gb + (size_t)r * D + c + 8);
        const unsigned gw[8] = {g0.x, g0.y, g0.z, g0.w, g1.x, g1.y, g1.z, g1.w};
#pragma unroll
        for (int e = 0; e < 16; e += 2) {
            const float o0 = ((y[e] - mean) * rstd * lg[e] + lb[e] + vv[e] * dsum) * lo16(gw[e >> 1]);
            const float o1 = ((y[e + 1] - mean) * rstd * lg[e + 1] + lb[e + 1] + vv[e + 1] * dsum) * hi16(gw[e >> 1]);
            o[e >> 1] = pk2(o0, o1);
        }
        *(u32x4*)(YG + (size_t)r * D + c) = (u32x4){o[0], o[1], o[2], o[3]};
        *(u32x4*)(YG + (size_t)r * D + c + 8) = (u32x4){o[4], o[5], o[6], o[7]};
    }
}
__device__ __forceinline__ void phase_norm2(const Frame& F, int g, int layer, bool dry = false) {
    bf16_t* X = F.wsp<bf16_t>(WS_X); bf16_t* HM = F.ar<bf16_t>(AR_HM); const bf16_t* Ob = F.ar<bf16_t>(AR_O);
    int* lists = dry ? F.ar<int>(AR_YM0) : F.ar<int>(AR_LIST); float* lwt = dry ? F.ar<float>(AR_YM0) + (size_t)32 * TG : F.ar<float>(AR_LW);
    unsigned* cnt = (unsigned*)(F.ws + WS_CTL + CTL_CNT_OFF) + (((size_t)g * 4 + layer) * 32 + (dry ? NG * 4 * 32 : 0)) * 16;
    LAS float* wr = (LAS float*)F.lds;
    __syncthreads();
    for (int i = F.tid; i < D * NEXP / 4; i += NTHREADS) { const int c = i >> 2, e4 = i & 3; const int rho = (c & ~255) + (c & 3) * 64 + ((c & 255) >> 2);
        *(LAS f32x4*)(wr + rho * 20 + e4 * 4) = *(const f32x4*)(F.in(36) + i * 4); }
    __syncthreads();
    const float* rbias = F.in(37);
    float rb4[4];
#pragma unroll
    for (int e = 0; e < 4; ++e) rb4[e] = rbias[(F.lane >> 4) * 4 + e];
    const bool ctx_out = layer < 2;
    LAS int* lcnt = (LAS int*)(F.lds + LDS_MISC + 512);
    LAS int* lbase = (LAS int*)(F.lds + LDS_MISC + 640);
    LAS int* rec = (LAS int*)(F.lds + 81920);
    const int rpb = (TG + F.G - 1) / F.G, rbeg = F.bid * rpb, rend = (rbeg + rpb) < TG ? (rbeg + rpb) : TG;
    const int niter = (rpb + NWAVES - 1) / NWAVES;
    int key = -1; f32x4 cg[4], cA[4], cB[4];
#pragma unroll
    for (int q = 0; q < 4; ++q) { cg[q] = (f32x4){0.f, 0.f, 0.f, 0.f}; cA[q] = cg[q]; cB[q] = cg[q]; }
    for (int it0 = 0; it0 < niter; it0 += 64) {
        if (F.tid < 32) lcnt[F.tid] = 0;
        __syncthreads();
        const int itn = (niter - it0) < 64 ? (niter - it0) : 64;
        for (int itl = 0; itl < itn; ++itl) {
            const int r = rbeg + (it0 + itl) * NWAVES + F.wave;
            const int bl = r / LT, t = r % LT, b = g * BG + bl; const bool isctx = t < LC;
            const int slot = itl * NWAVES + F.wave;
            if (r >= rend || (isctx && !ctx_out)) { if (F.lane == 0) rec[slot * 4] = -1; continue; }
            if (key != b * 2 + (int)isctx) {
                key = b * 2 + (int)isctx;
#pragma unroll
                for (int q = 0; q < 4; ++q) { const int c = q * 256 + F.lane * 4;
                    cg[q] = *(const f32x4*)((isctx ? F.modC(layer, 2) : F.modL(layer, b, 2)) + c);
                    const f32x4 gv = *(const f32x4*)(F.in(7) + (size_t)layer * D + c), cv = *(const f32x4*)((isctx ? F.modC(layer, 4) : F.modL(layer, b, 4)) + c);
                    cA[q] = gv * (1.0f + cv); cB[q] = *(const f32x4*)((isctx ? F.modC(layer, 3) : F.modL(layer, b, 3)) + c); }
            }
            f32x4 x[4]; float ss = 0.f;
#pragma unroll
            for (int q = 0; q < 4; ++q) { const int c = q * 256 + F.lane * 4;
                { const u32x2 xw = *(const u32x2*)(X + (size_t)r * D + c); x[q] = (f32x4){lo16(xw.x), hi16(xw.x), lo16(xw.y), hi16(xw.y)}; }
                const u32x2 ob = *(const u32x2*)(Ob + (size_t)r * D + c); const f32x4 gv = cg[q];
                const f32x4 xo = x[q];
                x[q][0] += gv[0] * lo16(ob.x); x[q][1] += gv[1] * hi16(ob.x); x[q][2] += gv[2] * lo16(ob.y); x[q][3] += gv[3] * hi16(ob.y);
                { const f32x4 xs = dry ? xo : x[q]; u32x2 xw; xw.x = pk2(xs[0], xs[1]); xw.y = pk2(xs[2], xs[3]); *(u32x2*)(X + (size_t)r * D + c) = xw; }
                ss += x[q][0] * x[q][0] + x[q][1] * x[q][1] + x[q][2] * x[q][2] + x[q][3] * x[q][3]; }
            ss = wave_sum_dpp(ss);
            const float rstd = rsqrtf(ss * (1.0f / D) + 1e-6f);
            float lg[16];
#pragma unroll
            for (int e = 0; e < 16; ++e) lg[e] = 0.f;
#pragma unroll
            for (int q = 0; q < 4; ++q) { const int c = q * 256 + F.lane * 4;
                const f32x4 h = x[q] * rstd * cA[q] + cB[q];
                u32x2 w; w.x = pk2(h[0], h[1]); w.y = pk2(h[2], h[3]);
                *(u32x2*)(HM + (size_t)r * D + c) = w;
#pragma unroll
                for (int j = 0; j < 4; ++j) {
#pragma unroll
                    for (int e4 = 0; e4 < 4; ++e4) { const f32x4 wv = *(const LAS f32x4*)(wr + (q * 256 + j * 64 + F.lane) * 20 + e4 * 4);
                        lg[e4 * 4 + 0] += h[j] * wv[0]; lg[e4 * 4 + 1] += h[j] * wv[1]; lg[e4 * 4 + 2] += h[j] * wv[2]; lg[e4 * 4 + 3] += h[j] * wv[3]; } }
            }
            float m8[8], xg[4];
#pragma unroll
            for (int e = 0; e < 8; ++e) { const auto sw = __builtin_amdgcn_permlane32_swap(__float_as_uint(lg[e]), __float_as_uint(lg[e + 8]), false, false); m8[e] = __uint_as_float(sw[0]) + __uint_as_float(sw[1]); }
#pragma unroll
            for (int e = 0; e < 4; ++e) { const auto sw = __builtin_amdgcn_permlane16_swap(__float_as_uint(m8[e]), __float_as_uint(m8[e + 4]), false, false); xg[e] = red16(__uint_as_float(sw[0]) + __uint_as_float(sw[1])); }
            float sc_[4], bs[4];
#pragma unroll
            for (int e = 0; e < 4; ++e) { sc_[e] = sigmoidf_(xg[e]); bs[e] = sc_[e] + rb4[e]; }
            const float hi01 = fmaxf(bs[0], bs[1]), lo01 = fminf(bs[0], bs[1]), hi23 = fmaxf(bs[2], bs[3]), lo23 = fminf(bs[2], bs[3]);
            const float gsc = fmaxf(hi01, hi23) + fmaxf(fminf(hi01, hi23), fmaxf(lo01, lo23));
            const float g0s = __int_as_float(__builtin_amdgcn_readlane(__float_as_int(gsc), 0)), g1s = __int_as_float(__builtin_amdgcn_readlane(__float_as_int(gsc), 16));
            const float g2s = __int_as_float(__builtin_amdgcn_readlane(__float_as_int(gsc), 32)), g3s = __int_as_float(__builtin_amdgcn_readlane(__float_as_int(gsc), 48));
            const bool c10 = g1s > g0s, c32 = g3s > g2s; const float v01 = c10 ? g1s : g0s, v23 = c32 ? g3s : g2s; const bool chi = v23 > v01;
            const int best = __builtin_amdgcn_readfirstlane(chi ? (c32 ? 3 : 2) : (c10 ? 1 : 0));
            float cb[4], cs[4];
#pragma unroll
            for (int e = 0; e < 4; ++e) { cb[e] = __int_as_float(__builtin_amdgcn_readlane(__float_as_int(bs[e]), best * 16)); cs[e] = __int_as_float(__builtin_amdgcn_readlane(__float_as_int(sc_[e]), best * 16)); }
            const bool d10 = cb[1] > cb[0], d32 = cb[3] > cb[2]; const float w01 = d10 ? cb[1] : cb[0], w23 = d32 ? cb[3] : cb[2]; const bool dhi = w23 > w01;
            const int j1 = dhi ? (d32 ? 3 : 2) : (d10 ? 1 : 0);
            const float e0 = j1 == 0 ? -1e30f : cb[0], e1 = j1 == 1 ? -1e30f : cb[1], e2 = j1 == 2 ? -1e30f : cb[2], e3 = j1 == 3 ? -1e30f : cb[3];
            const bool f10 = e1 > e0, f32_ = e3 > e2; const float u01 = f10 ? e1 : e0, u23 = f32_ ? e3 : e2; const bool fhi = u23 > u01;
            const int j2 = fhi ? (f32_ ? 3 : 2) : (f10 ? 1 : 0);
            const float s1 = (j1 & 2) ? ((j1 & 1) ? cs[3] : cs[2]) : ((j1 & 1) ? cs[1] : cs[0]);
            const float s2 = (j2 & 2) ? ((j2 & 1) ? cs[3] : cs[2]) : ((j2 & 1) ? cs[1] : cs[0]);
            const float inv = __builtin_amdgcn_rcpf(s1 + s2);
            if (F.lane == 0) {
                const int l1 = (best * 4 + j1) * 2 + 0, l2 = (best * 4 + j2) * 2 + 1;
                const int p1 = __hip_atomic_fetch_add(lcnt + l1, 1, __ATOMIC_RELAXED, __HIP_MEMORY_SCOPE_WORKGROUP);
                const int p2 = __hip_atomic_fetch_add(lcnt + l2, 1, __ATOMIC_RELAXED, __HIP_MEMORY_SCOPE_WORKGROUP);
                rec[slot * 4 + 0] = l1 | (p1 << 8); rec[slot * 4 + 1] = l2 | (p2 << 8);
                rec[slot * 4 + 2] = __float_as_int(s1 * inv); rec[slot * 4 + 3] = __float_as_int(s2 * inv);
            }
        }
        __syncthreads();
        if (F.tid < 32) { const int c = lcnt[F.tid]; lbase[F.tid] = c ? (int)atomicAdd(&cnt[F.tid * 16], (unsigned)c) : 0; }
        __syncthreads();
        for (int slot = F.tid; slot < itn * NWAVES; slot += NTHREADS) {
            const int a0 = rec[slot * 4 + 0]; if (a0 < 0) continue;
            const int a1 = rec[slot * 4 + 1];
            const int r = rbeg + (it0 + slot / NWAVES) * NWAVES + (slot % NWAVES);
            const int l1 = a0 & 255, l2 = a1 & 255; const int q1 = lbase[l1] + (a0 >> 8), q2 = lbase[l2] + (a1 >> 8);
            lists[(size_t)l1 * TG + q1] = r; lwt[(size_t)l1 * TG + q1] = __int_as_float(rec[slot * 4 + 2]);
            lists[(size_t)l2 * TG + q2] = r; lwt[(size_t)l2 * TG + q2] = __int_as_float(rec[slot * 4 + 3]);
        }
        __syncthreads();
    }
}
__device__ __forceinline__ int moe_tables(const Frame& F, int g, int layer) {
    LAS int* cn = (LAS int*)(F.lds + LDS_MISC + 64); LAS int* tb = (LAS int*)(F.lds + LDS_MISC + 192);
    const unsigned* cnt = (const unsigned*)(F.ws + WS_CTL + CTL_CNT_OFF) + ((size_t)g * 4 + layer) * 32 * 16;
    __syncthreads();
    if (F.tid < 32) cn[F.tid] = (int)__hip_atomic_load(cnt + F.tid * 16, __ATOMIC_RELAXED, __HIP_MEMORY_SCOPE_AGENT);
    __syncthreads();
    if (F.tid == 0) { int acc = 0; for (int l = 0; l < 32; ++l) { tb[l] = acc; acc += (cn[l] + 255) >> 8; } tb[32] = acc; }
    __syncthreads();
    return tb[32];
}

constexpr int SC_OPB = 6 * 4096;
constexpr int SC_HALF = 2 * SC_OPB + 4096 + 4096;
static_assert(2 * SC_HALF <= LDS_STAGE, "scan lds");
__device__ __forceinline__ int scan_tok(int d, int s) { return d == 0 ? s : (s < LC ? (LC - 1 - s) : (LT + LC - 1 - s)); }
__device__ __forceinline__ void phase_scan(const Frame& F, int a, const bf16_t* V) {
    const bf16_t* R = F.ar<bf16_t>(AR_R); const bf16_t* Kb = F.ar<bf16_t>(AR_K); const bf16_t* L1 = F.ar<bf16_t>(AR_L1);
    const int half = F.wave >> 2, q = F.wave & 3, lane = F.lane, li = q * 64 + lane;
    LAS unsigned char* hb = F.lds + half * SC_HALF;
    LAS float* aT = (LAS float*)(hb + 2 * SC_OPB); LAS float* ybuf = (LAS float*)(hb + 2 * SC_OPB + 4096);
    const int arr = q >> 1, ntl = (q & 1) * 2;
    const int i = lane >> 3, j = lane & 7, r0 = 16 * q + 2 * i;
    const int tB = li >> 4, k4 = (li & 15) * 4;
    for (int pr = F.bid; pr < BG * 16; pr += F.G) {
        const int bl = pr >> 4, d = (pr >> 3) & 1, hp = pr & 7, h = hp * 2 + half;
        bf16_t* Yd = F.ar<bf16_t>(d ? AR_Y1 : AR_Y0); float* DOT = F.ar<float>(AR_DOT) + (size_t)d * TG * NH;
        const size_t rowb = (size_t)bl * LT;
        const bf16_t* W2 = (arr == 0 ? F.wsp<bf16_t>(WS_W2T) : F.wsp<bf16_t>(WS_A2T)) + ((size_t)a * 2 + d) * D * 64;
        bf16x8 Bf[2][2]; float bias[2];
#pragma unroll
        for (int nt = 0; nt < 2; ++nt) { const int cc = h * 64 + (ntl + nt) * 16 + (lane & 15);
            bias[nt] = (arr == 0 ? F.in(13) : F.in(16))[((size_t)a * 2 + d) * D + cc];
#pragma unroll
            for (int s = 0; s < 2; ++s) Bf[nt][s] = *(const bf16x8*)(W2 + (size_t)cc * 64 + 32 * s + 8 * (lane >> 4)); }
        const f32x4 kkc = *(const f32x4*)(F.in(24) + (size_t)a * D + h * 64 + k4), kac = *(const f32x4*)(F.in(25) + (size_t)a * D + h * 64 + k4), rkc = *(const f32x4*)(F.in(26) + (size_t)a * D + h * 64 + k4);
        const int acol = arr * 128 + d * 64 + 8 * (lane >> 4);
        float S0[8], S1[8];
#pragma unroll
        for (int c = 0; c < 8; ++c) { S0[c] = 0.f; S1[c] = 0.f; }
        bf16x8 Af[2]; u32x2 kraw, rraw, vraw;
#define SC_LOAD(ch) do { const size_t rowA = rowb + scan_tok(d, (ch) * 16 + (lane & 15)); \
        Af[0] = *(const bf16x8*)(L1 + rowA * 512 + acol); Af[1] = *(const bf16x8*)(L1 + rowA * 512 + acol + 32); \
        const size_t rowBq = (rowb + scan_tok(d, (ch) * 16 + tB)) * D + h * 64 + k4; \
        kraw = *(const u32x2*)(Kb + rowBq); rraw = *(const u32x2*)(R + rowBq); vraw = *(const u32x2*)(V + rowBq); } while (0)
#define SC_PASSA(buf) do { LAS float* op = (LAS float*)(hb + (buf) * SC_OPB); \
        _Pragma("unroll") for (int nt = 0; nt < 2; ++nt) { f32x4 ac = (f32x4){0.f, 0.f, 0.f, 0.f}; \
            ac = __builtin_amdgcn_mfma_f32_16x16x32_bf16(Af[0], Bf[nt][0], ac, 0, 0, 0); ac = __builtin_amdgcn_mfma_f32_16x16x32_bf16(Af[1], Bf[nt][1], ac, 0, 0, 0); \
            const int n = (ntl + nt) * 16 + (lane & 15); \
              \
            f32x4 sg; _Pragma("unroll") for (int rg = 0; rg < 4; ++rg) sg[rg] = sigmoidf_(ac[rg] + bias[nt]); \
            if (arr == 0) { _Pragma("unroll") for (int rg = 0; rg < 4; ++rg) op[1024 + ((lane >> 4) * 4 + rg) * 64 + n] = __expf(-0.60653066f * sg[rg]); } \
            else { _Pragma("unroll") for (int rg = 0; rg < 4; ++rg) aT[((lane >> 4) * 4 + rg) * 64 + n] = sg[rg]; } } } while (0)
#define SC_PASSB(ch, buf) do { LAS float* op = (LAS float*)(hb + (buf) * SC_OPB); \
        const float kf[4] = {lo16(kraw.x), hi16(kraw.x), lo16(kraw.y), hi16(kraw.y)}; const float rf[4] = {lo16(rraw.x), hi16(rraw.x), lo16(rraw.y), hi16(rraw.y)}; \
        const float vf[4] = {lo16(vraw.x), hi16(vraw.x), lo16(vraw.y), hi16(vraw.y)}; \
        const f32x4 av = *(const LAS f32x4*)(aT + tB * 64 + k4); \
        float kq[4], ssq = 0.f; _Pragma("unroll") for (int e = 0; e < 4; ++e) { kq[e] = kf[e] * kkc[e]; ssq += kq[e] * kq[e]; } \
        ssq = red16(ssq); const float inv = __builtin_amdgcn_rsqf(fmaxf(ssq, 1e-24f)); \
        f32x4 o_kk, o_kka, o_kd, o_r, o_v; float dp = 0.f; \
        _Pragma("unroll") for (int e = 0; e < 4; ++e) { const float kkv = kq[e] * inv; const float kd = kf[e] * (1.0f + (av[e] - 1.0f) * kac[e]); \
            o_kk[e] = kkv; o_kka[e] = kkv * av[e]; o_kd[e] = kd; o_r[e] = rf[e]; o_v[e] = vf[e]; dp += rf[e] * kd * rkc[e]; } \
        dp = red16(dp); \
        if ((li & 15) == 0) DOT[(rowb + scan_tok(d, (ch) * 16 + tB)) * NH + h] = dp; \
        *(LAS f32x4*)(op + 0 * 1024 + tB * 64 + k4) = o_kk; *(LAS f32x4*)(op + 2 * 1024 + tB * 64 + k4) = o_kka; *(LAS f32x4*)(op + 3 * 1024 + tB * 64 + k4) = o_kd; \
        *(LAS f32x4*)(op + 4 * 1024 + tB * 64 + k4) = o_r; *(LAS f32x4*)(op + 5 * 1024 + tB * 64 + k4) = o_v; } while (0)
        __syncthreads();
        SC_LOAD(0);
        SC_PASSA(0);
        __syncthreads();
        SC_PASSB(0, 0);
        __syncthreads();
        constexpr int NCH = LT / 16;
        for (int ch = 0; ch < NCH; ++ch) {
            const int buf = ch & 1;
            if (ch + 1 < NCH) SC_LOAD(ch + 1);
            const LAS float* op = (const LAS float*)(hb + buf * SC_OPB);
            f32x4 cA[5], cB[5], nA[5], nB[5]; f32x2 cv, nv;
#define SC_OPLOAD(dA, dB, dv, t) do { const LAS float* ob_ = op + (t) * 64 + j * 8; \
                _Pragma("unroll") for (int q_ = 0; q_ < 5; ++q_) { dA[q_] = *(const LAS f32x4*)(ob_ + q_ * 1024); dB[q_] = *(const LAS f32x4*)(ob_ + q_ * 1024 + 4); } \
                dv = *(const LAS f32x2*)(op + 5 * 1024 + (t) * 64 + r0); } while (0)
            SC_OPLOAD(cA, cB, cv, 0);
#pragma unroll
            for (int t = 0; t < 16; ++t) {
                if (t + 1 < 16) SC_OPLOAD(nA, nB, nv, t + 1);
                const float kk[8] = {cA[0][0], cA[0][1], cA[0][2], cA[0][3], cB[0][0], cB[0][1], cB[0][2], cB[0][3]};
                const float dc[8] = {cA[1][0], cA[1][1], cA[1][2], cA[1][3], cB[1][0], cB[1][1], cB[1][2], cB[1][3]};
                const float ka[8] = {cA[2][0], cA[2][1], cA[2][2], cA[2][3], cB[2][0], cB[2][1], cB[2][2], cB[2][3]};
                const float kd[8] = {cA[3][0], cA[3][1], cA[3][2], cA[3][3], cB[3][0], cB[3][1], cB[3][2], cB[3][3]};
                const float rr[8] = {cA[4][0], cA[4][1], cA[4][2], cA[4][3], cB[4][0], cB[4][1], cB[4][2], cB[4][3]};
                float sa0 = (S0[0] * kk[0] + S0[1] * kk[1]) + (S0[2] * kk[2] + S0[3] * kk[3]) + ((S0[4] * kk[4] + S0[5] * kk[5]) + (S0[6] * kk[6] + S0[7] * kk[7]));
                float sa1 = (S1[0] * kk[0] + S1[1] * kk[1]) + (S1[2] * kk[2] + S1[3] * kk[3]) + ((S1[4] * kk[4] + S1[5] * kk[5]) + (S1[6] * kk[6] + S1[7] * kk[7]));
                sa0 = red8(sa0); sa1 = red8(sa1);
#pragma unroll
                for (int c = 0; c < 8; ++c) {
                    S0[c] = S0[c] * dc[c] + (cv[0] * kd[c] - sa0 * ka[c]);
                    S1[c] = S1[c] * dc[c] + (cv[1] * kd[c] - sa1 * ka[c]);
                }
                float y0 = (S0[0] * rr[0] + S0[1] * rr[1]) + (S0[2] * rr[2] + S0[3] * rr[3]) + ((S0[4] * rr[4] + S0[5] * rr[5]) + (S0[6] * rr[6] + S0[7] * rr[7]));
                float y1 = (S1[0] * rr[0] + S1[1] * rr[1]) + (S1[2] * rr[2] + S1[3] * rr[3]) + ((S1[4] * rr[4] + S1[5] * rr[5]) + (S1[6] * rr[6] + S1[7] * rr[7]));
                y0 = red8(y0); y1 = red8(y1);
                if (j == 0) *(LAS f32x2*)(ybuf + t * 64 + r0) = (f32x2){y0, y1};
#pragma unroll
                for (int q_ = 0; q_ < 5; ++q_) { cA[q_] = nA[q_]; cB[q_] = nB[q_]; }
                cv = nv;
            }
#undef SC_OPLOAD
            __syncthreads();
            {
                const f32x4 yv = *(const LAS f32x4*)(ybuf + tB * 64 + k4);
                u32x2 w; w.x = pk2(yv[0], yv[1]); w.y = pk2(yv[2], yv[3]);
                *(u32x2*)(Yd + (rowb + scan_tok(d, ch * 16 + tB)) * D + h * 64 + k4) = w;
            }
            if (ch + 1 < NCH) SC_PASSA(buf ^ 1);
            __syncthreads();
            if (ch + 1 < NCH) SC_PASSB(ch + 1, buf ^ 1);
            __syncthreads();
        }
#undef SC_LOAD
#undef SC_PASSA
#undef SC_PASSB
    }
}

constexpr int S4_KKP = 0, S4_RPP = 2048, S4_KDP = 4096, S4_KAP = 6144, S4_KDT = 8192, S4_KAT = 10496, S4_VT = 12800, S4_A1 = 15104, S4_B1 = 15616, S4_B2 = 16128,
              S4_A2 = 16640, S4_P15 = 17664, S4_LI = 17920, S4_LX = 22016, S4_AT = 26112, S4_YB = 30208, S4_HALF = 34304;
static_assert(2 * S4_HALF <= LDS_STAGE, "scan4 lds");
#define MF16(a, b, c) __builtin_amdgcn_mfma_f32_16x16x32_bf16((a), (b), (c), 0, 0, 0)
__device__ __forceinline__ bf16x8 mkfrag(unsigned a, unsigned b, unsigned c, unsigned d) { return __builtin_bit_cast(bf16x8, (u32x4){a, b, c, d}); }
__device__ __forceinline__ void phase_scan4(const Frame& F, int a, const bf16_t* V) {
    const bf16_t* R = F.ar<bf16_t>(AR_R); const bf16_t* Kb = F.ar<bf16_t>(AR_K); const bf16_t* L1 = F.ar<bf16_t>(AR_L1);
    const int half = F.wave >> 2, q = F.wave & 3, lane = F.lane, li = q * 64 + lane;
    LAS unsigned char* hb = F.lds + half * S4_HALF;
    const int arr = q >> 1, ntl = (q & 1) * 2;
    const int g = lane >> 4, j = lane & 15;
    const int tB = li >> 4, k4 = (li & 15) * 4;
    const int poff = (tB * 64 + (k4 >> 5) * 32 + ((k4 >> 2) & 3) * 8 + ((k4 >> 4) & 1) * 4) * 2;
    const float gm0 = g == 0 ? 1.f : 0.f, gm1 = g == 1 ? 1.f : 0.f, gm2 = g == 2 ? 1.f : 0.f, gm3 = g == 3 ? 1.f : 0.f;
    f32x2 eye2[8];
#pragma unroll
    for (int p_ = 0; p_ < 8; ++p_) eye2[p_] = (f32x2){j == 2 * p_ ? 1.f : 0.f, j == 2 * p_ + 1 ? 1.f : 0.f};
    for (int pr = F.bid; pr < BG * 16; pr += F.G) {
        const int bl = pr >> 4, d = (pr >> 3) & 1, hp = pr & 7, h = hp * 2 + half;
        bf16_t* Yd = F.ar<bf16_t>(d ? AR_Y1 : AR_Y0); float* DOT = F.ar<float>(AR_DOT) + (size_t)d * TG * NH;
        const size_t rowb = (size_t)bl * LT;
        const bf16_t* W2 = (arr == 0 ? F.wsp<bf16_t>(WS_W2T) : F.wsp<bf16_t>(WS_A2T)) + ((size_t)a * 2 + d) * D * 64;
        const float* b0p = (arr == 0 ? F.in(13) : F.in(16)) + ((size_t)a * 2 + d) * D + h * 64;
        const int acol = arr * 128 + d * 64 + 8 * (lane >> 4);
        f32x4 Cb[4];
#pragma unroll
        for (int b = 0; b < 4; ++b) Cb[b] = (f32x4){0.f, 0.f, 0.f, 0.f};
        bf16x8 Af[2]; u32x2 kraw, rraw, vraw;
#define SC_LOAD(ch) do { const size_t rowA = rowb + scan_tok(d, (ch) * 16 + (lane & 15)); \
        Af[0] = *(const bf16x8*)(L1 + rowA * 512 + acol); Af[1] = *(const bf16x8*)(L1 + rowA * 512 + acol + 32); \
        const size_t rowBq = (rowb + scan_tok(d, (ch) * 16 + tB)) * D + h * 64 + k4; \
        kraw = *(const u32x2*)(Kb + rowBq); rraw = *(const u32x2*)(R + rowBq); vraw = *(const u32x2*)(V + rowBq); } while (0)
#define SC_PASSA() do { \
        _Pragma("unroll") for (int nt = 0; nt < 2; ++nt) { f32x4 ac = (f32x4){0.f, 0.f, 0.f, 0.f}; \
            const int n = (ntl + nt) * 16 + (lane & 15); const float bias_ = b0p[n]; \
            const bf16x8 bf0_ = *(const bf16x8*)(W2 + (size_t)(h * 64 + n) * 64 + 8 * (lane >> 4)), bf1_ = *(const bf16x8*)(W2 + (size_t)(h * 64 + n) * 64 + 32 + 8 * (lane >> 4)); \
            ac = MF16(Af[0], bf0_, ac); ac = MF16(Af[1], bf1_, ac); \
            f32x4 sg; _Pragma("unroll") for (int rg = 0; rg < 4; ++rg) sg[rg] = sigmoidf_(ac[rg] + bias_); \
            if (arr == 0) { \
                const float l0 = -0.60653066f * sg[0], l1 = -0.60653066f * sg[1], l2 = -0.60653066f * sg[2], l3 = -0.60653066f * sg[3]; \
                const float p0 = l0, p1 = p0 + l1, p2 = p1 + l2, p3 = p2 + l3;                         \
                const auto s16 = __builtin_amdgcn_permlane16_swap(__float_as_uint(p3), __float_as_uint(p3), false, false);     \
                const float sv = __uint_as_float(s16[0]), pq = sv + __uint_as_float(s16[1]); \
                const auto s32 = __builtin_amdgcn_permlane32_swap(__float_as_uint(pq), __float_as_uint(pq), false, false);     \
                const float E = ((g & 1) ? sv : 0.f) + ((g & 2) ? __uint_as_float(s32[0]) : 0.f);      \
                LAS float* li_ = (LAS float*)(hb + S4_LI) + (4 * g) * 64 + n; LAS float* lx_ = (LAS float*)(hb + S4_LX) + (4 * g) * 64 + n; \
                li_[0] = E + p0; li_[64] = E + p1; li_[128] = E + p2; li_[192] = E + p3; lx_[0] = E; lx_[64] = E + p0; lx_[128] = E + p1; lx_[192] = E + p2; \
            } else { _Pragma("unroll") for (int rg = 0; rg < 4; ++rg) ((LAS float*)(hb + S4_AT))[(4 * g + rg) * 64 + n] = sg[rg]; } } } while (0)
#define SC_PASSB(ch) do { \
        const f32x4 kkc = *(const f32x4*)(F.in(24) + (size_t)a * D + h * 64 + k4), kac = *(const f32x4*)(F.in(25) + (size_t)a * D + h * 64 + k4), rkc = *(const f32x4*)(F.in(26) + (size_t)a * D + h * 64 + k4); \
        const float kf[4] = {lo16(kraw.x), hi16(kraw.x), lo16(kraw.y), hi16(kraw.y)}; const float rf[4] = {lo16(rraw.x), hi16(rraw.x), lo16(rraw.y), hi16(rraw.y)}; \
        const f32x4 av = *(const LAS f32x4*)((LAS float*)(hb + S4_AT) + tB * 64 + k4), Li = *(const LAS f32x4*)((LAS float*)(hb + S4_LI) + tB * 64 + k4), Lx = *(const LAS f32x4*)((LAS float*)(hb + S4_LX) + tB * 64 + k4); \
        float kq[4], ssq = 0.f; _Pragma("unroll") for (int e = 0; e < 4; ++e) { kq[e] = kf[e] * kkc[e]; ssq += kq[e] * kq[e]; } \
        ssq = red16(ssq); const float inv = __builtin_amdgcn_rsqf(fmaxf(ssq, 1e-24f)); \
        float o_kk[4], o_ka[4], o_kd[4], o_r[4]; f32x4 o_p; float dp = 0.f; \
        _Pragma("unroll") for (int e = 0; e < 4; ++e) { const float Pt = __expf(Li[e]), Px = __expf(Lx[e]), iP = __builtin_amdgcn_rcpf(Pt); \
            const float kkv = kq[e] * inv; const float kd = kf[e] * (1.0f + (av[e] - 1.0f) * kac[e]); const float ka = kkv * av[e]; \
            o_kk[e] = kkv * Px; o_ka[e] = ka * iP; o_kd[e] = kd * iP; o_r[e] = rf[e] * Pt; o_p[e] = Pt; \
            dp += rf[e] * kd * rkc[e]; } \
        dp = red16(dp); \
        if ((li & 15) == 0) DOT[(rowb + scan_tok(d, (ch) * 16 + tB)) * NH + h] = dp; \
        const u32x2 w_kk = (u32x2){pk2(o_kk[0], o_kk[1]), pk2(o_kk[2], o_kk[3])}, w_r = (u32x2){pk2(o_r[0], o_r[1]), pk2(o_r[2], o_r[3])}; \
        const u32x2 w_kd = (u32x2){pk2(o_kd[0], o_kd[1]), pk2(o_kd[2], o_kd[3])}, w_ka = (u32x2){pk2(o_ka[0], o_ka[1]), pk2(o_ka[2], o_ka[3])}; \
        *(LAS u32x2*)(hb + S4_KKP + poff) = w_kk; *(LAS u32x2*)(hb + S4_RPP + poff) = w_r; *(LAS u32x2*)(hb + S4_KDP + poff) = w_kd; *(LAS u32x2*)(hb + S4_KAP + poff) = w_ka; \
        { LAS unsigned char* td = hb + S4_KDT + k4 * 36 + tB * 2; LAS unsigned char* ta = hb + S4_KAT + k4 * 36 + tB * 2; LAS unsigned char* tv = hb + S4_VT + k4 * 36 + tB * 2; \
          *(LAS unsigned short*)(td) = (unsigned short)w_kd.x; *(LAS unsigned short*)(td + 36) = (unsigned short)(w_kd.x >> 16); *(LAS unsigned short*)(td + 72) = (unsigned short)w_kd.y; *(LAS unsigned short*)(td + 108) = (unsigned short)(w_kd.y >> 16); \
          *(LAS unsigned short*)(ta) = (unsigned short)w_ka.x; *(LAS unsigned short*)(ta + 36) = (unsigned short)(w_ka.x >> 16); *(LAS unsigned short*)(ta + 72) = (unsigned short)w_ka.y; *(LAS unsigned short*)(ta + 108) = (unsigned short)(w_ka.y >> 16); \
          *(LAS unsigned short*)(tv) = (unsigned short)vraw.x; *(LAS unsigned short*)(tv + 36) = (unsigned short)(vraw.x >> 16); *(LAS unsigned short*)(tv + 72) = (unsigned short)vraw.y; *(LAS unsigned short*)(tv + 108) = (unsigned short)(vraw.y >> 16); } \
        if (tB == 15) *(LAS f32x4*)((LAS float*)(hb + S4_P15) + k4) = o_p; } while (0)
#define SC_PROD() do { const int lo_ = (q < 2 ? S4_KKP : S4_RPP) + j * 128 + g * 16, ro_ = ((q == 0 || q == 3) ? S4_KAP : S4_KDP) + j * 128 + g * 16; \
        f32x4 pa = (f32x4){0.f, 0.f, 0.f, 0.f}; \
        pa = MF16(*(const LAS bf16x8*)(hb + lo_), *(const LAS bf16x8*)(hb + ro_), pa); pa = MF16(*(const LAS bf16x8*)(hb + lo_ + 64), *(const LAS bf16x8*)(hb + ro_ + 64), pa); \
        _Pragma("unroll") for (int r_ = 0; r_ < 4; ++r_) { const int t_ = 4 * g + r_; const bool keep = (q < 2) ? (j < t_) : (j <= t_); pa[r_] = keep ? pa[r_] : 0.f; } \
        if (q == 0) { LAS float* dm = (LAS float*)(hb + S4_A2) + (4 * g) * 16 + j; dm[0] = pa[0]; dm[16] = pa[1]; dm[32] = pa[2]; dm[48] = pa[3]; } \
        else { LAS unsigned char* dm = hb + (q == 1 ? S4_A1 : (q == 2 ? S4_B1 : S4_B2)) + ((4 * g) * 16 + j) * 2; const unsigned w0_ = pk2(pa[0], pa[1]), w1_ = pk2(pa[2], pa[3]); \
            *(LAS unsigned short*)(dm) = (unsigned short)w0_; *(LAS unsigned short*)(dm + 32) = (unsigned short)(w0_ >> 16); *(LAS unsigned short*)(dm + 64) = (unsigned short)w1_; *(LAS unsigned short*)(dm + 96) = (unsigned short)(w1_ >> 16); } } while (0)
        __syncthreads();
        SC_LOAD(0);
        SC_PASSA();
        __syncthreads();
        SC_PASSB(0);
        __syncthreads();
        SC_PROD();
        __syncthreads();
        constexpr int NCH = LT / 16;
        for (int ch = 0; ch < NCH; ++ch) {
            if (ch + 1 < NCH) SC_LOAD(ch + 1);
            const bf16x8 Bs0 = mkfrag(pk2(Cb[0][0], Cb[0][1]), pk2(Cb[0][2], Cb[0][3]), pk2(Cb[1][0], Cb[1][1]), pk2(Cb[1][2], Cb[1][3]));
            const bf16x8 Bs1 = mkfrag(pk2(Cb[2][0], Cb[2][1]), pk2(Cb[2][2], Cb[2][3]), pk2(Cb[3][0], Cb[3][1]), pk2(Cb[3][2], Cb[3][3]));
            f32x4 X = (f32x4){0.f, 0.f, 0.f, 0.f}, H = (f32x4){0.f, 0.f, 0.f, 0.f};
            X = MF16(*(const LAS bf16x8*)(hb + S4_KKP + j * 128 + g * 16), Bs0, X); H = MF16(*(const LAS bf16x8*)(hb + S4_RPP + j * 128 + g * 16), Bs0, H);
            X = MF16(*(const LAS bf16x8*)(hb + S4_KKP + j * 128 + g * 16 + 64), Bs1, X); H = MF16(*(const LAS bf16x8*)(hb + S4_RPP + j * 128 + g * 16 + 64), Bs1, H);
            f32x2 ac2[8];
#pragma unroll
            for (int p_ = 0; p_ < 8; ++p_) ac2[p_] = eye2[p_];
            float Mr[16];
            {
                f32x4 rw[7][4];
#pragma unroll
                for (int u = 15; u >= 9; --u)
#pragma unroll
                    for (int x_ = 0; x_ * 4 < u; ++x_) rw[u - 9][x_] = *(const LAS f32x4*)((LAS float*)(hb + S4_A2) + u * 16 + 4 * x_);
                __builtin_amdgcn_sched_barrier(0);
#pragma unroll
                for (int u = 15; u >= 9; --u) {
                    const float mu = ac2[u >> 1][u & 1]; Mr[u] = mu;
#pragma unroll
                    for (int x_ = 0; x_ * 4 < u; ++x_) {
                        const f32x4 av_ = rw[u - 9][x_];
                        ac2[2 * x_] = ac2[2 * x_] - (f32x2){mu, mu} * (f32x2){av_[0], av_[1]};
                        if (4 * x_ + 2 < u) ac2[2 * x_ + 1] = ac2[2 * x_ + 1] - (f32x2){mu, mu} * (f32x2){av_[2], av_[3]};
                    }
                }
            }
            {
                f32x4 rw[8][2];
#pragma unroll
                for (int u = 8; u >= 1; --u)
#pragma unroll
                    for (int x_ = 0; x_ * 4 < u; ++x_) rw[u - 1][x_] = *(const LAS f32x4*)((LAS float*)(hb + S4_A2) + u * 16 + 4 * x_);
                __builtin_amdgcn_sched_barrier(0);
#pragma unroll
                for (int u = 8; u >= 1; --u) {
                    const float mu = ac2[u >> 1][u & 1]; Mr[u] = mu;
#pragma unroll
                    for (int x_ = 0; x_ * 4 < u; ++x_) {
                        const f32x4 av_ = rw[u - 1][x_];
                        ac2[2 * x_] = ac2[2 * x_] - (f32x2){mu, mu} * (f32x2){av_[0], av_[1]};
                        if (4 * x_ + 2 < u) ac2[2 * x_ + 1] = ac2[2 * x_ + 1] - (f32x2){mu, mu} * (f32x2){av_[2], av_[3]};
                    }
                }
            }
            Mr[0] = ac2[0][0];
            const u32x2 vw = (u32x2){*(const LAS unsigned*)(hb + S4_VT + (16 * q + j) * 36 + 8 * g), *(const LAS unsigned*)(hb + S4_VT + (16 * q + j) * 36 + 8 * g + 4)};
            const bf16x8 Bv = mkfrag(vw.x, vw.y, 0u, 0u);
            {
                const u32x2 a1w = *(const LAS u32x2*)(hb + S4_A1 + (j * 16 + 4 * g) * 2), b1w = *(const LAS u32x2*)(hb + S4_B1 + (j * 16 + 4 * g) * 2);
                X = MF16(mkfrag(a1w.x, a1w.y, 0u, 0u), Bv, X); H = MF16(mkfrag(b1w.x, b1w.y, 0u, 0u), Bv, H);
            }
            float mA[4];
#pragma unroll
            for (int r_ = 0; r_ < 4; ++r_) mA[r_] = (Mr[r_] * gm0 + Mr[4 + r_] * gm1) + (Mr[8 + r_] * gm2 + Mr[12 + r_] * gm3);
            f32x4 SA = (f32x4){0.f, 0.f, 0.f, 0.f};
            SA = MF16(mkfrag(pk2(mA[0], mA[1]), pk2(mA[2], mA[3]), 0u, 0u), mkfrag(pk2(X[0], X[1]), pk2(X[2], X[3]), 0u, 0u), SA);
            const bf16x8 Bn = mkfrag(pk2(-SA[0], -SA[1]), pk2(-SA[2], -SA[3]), 0u, 0u);
            {
                const u32x2 b2w = *(const LAS u32x2*)(hb + S4_B2 + (j * 16 + 4 * g) * 2);
                H = MF16(mkfrag(b2w.x, b2w.y, 0u, 0u), Bn, H);
                LAS float* yb = (LAS float*)(hb + S4_YB) + (4 * g) * 64 + 16 * q + j; yb[0] = H[0]; yb[64] = H[1]; yb[128] = H[2]; yb[192] = H[3];
            }
#pragma unroll
            for (int b = 0; b < 4; ++b) {
                const u32x2 kdw = (u32x2){*(const LAS unsigned*)(hb + S4_KDT + (16 * b + j) * 36 + 8 * g), *(const LAS unsigned*)(hb + S4_KDT + (16 * b + j) * 36 + 8 * g + 4)};
                const u32x2 kaw = (u32x2){*(const LAS unsigned*)(hb + S4_KAT + (16 * b + j) * 36 + 8 * g), *(const LAS unsigned*)(hb + S4_KAT + (16 * b + j) * 36 + 8 * g + 4)};
                Cb[b] = MF16(mkfrag(kdw.x, kdw.y, 0u, 0u), Bv, Cb[b]);
                Cb[b] = MF16(mkfrag(kaw.x, kaw.y, 0u, 0u), Bn, Cb[b]);
            }
#pragma unroll
            for (int b = 0; b < 4; ++b) { const f32x4 pv = *(const LAS f32x4*)((LAS float*)(hb + S4_P15) + 16 * b + 4 * g); Cb[b] = Cb[b] * pv; }
            __syncthreads();
            {
                const f32x4 yv = *(const LAS f32x4*)((LAS float*)(hb + S4_YB) + tB * 64 + k4);
                u32x2 w; w.x = pk2(yv[0], yv[1]); w.y = pk2(yv[2], yv[3]);
                *(u32x2*)(Yd + (rowb + scan_tok(d, ch * 16 + tB)) * D + h * 64 + k4) = w;
            }
            if (ch + 1 < NCH) {
                SC_PASSA();
                __syncthreads();
                SC_PASSB(ch + 1);
                __syncthreads();
                SC_PROD();
                __syncthreads();
            }
        }
#undef SC_LOAD
#undef SC_PASSA
#undef SC_PASSB
#undef SC_PROD
    }
}

__device__ __forceinline__ void phase_sgstats(const Frame& F, int layer) {
    const bf16_t* Z = F.ar<bf16_t>(AR_Z); float* ST = F.ar<float>(AR_ST);
    for (int r = F.bid * NWAVES + F.wave; r < TG; r += F.G * NWAVES) {
        const int t = r % LT; if (t < LC && layer >= 3) continue;
        float x[32];
#pragma unroll
        for (int q = 0; q < 4; ++q) { const u32x4 w = *(const u32x4*)(Z + (size_t)r * 4096 + 2048 + q * 512 + F.lane * 8);
            x[q * 8 + 0] = lo16(w.x); x[q * 8 + 1] = hi16(w.x); x[q * 8 + 2] = lo16(w.y); x[q * 8 + 3] = hi16(w.y); x[q * 8 + 4] = lo16(w.z); x[q * 8 + 5] = hi16(w.z); x[q * 8 + 6] = lo16(w.w); x[q * 8 + 7] = hi16(w.w); }
        float s = 0.f;
#pragma unroll
        for (int e = 0; e < 32; ++e) s += x[e];
        s = wave_sum(s); const float mean = s * (1.0f / 2048.0f);
        float qv = 0.f;
#pragma unroll
        for (int e = 0; e < 32; ++e) { const float dd = x[e] - mean; qv += dd * dd; }
        qv = wave_sum(qv);
        if (F.lane == 0) *(f32x2*)(ST + (size_t)r * 2) = (f32x2){mean, rsqrtf(qv * (1.0f / 2048.0f) + 1e-5f)};
    }
}
__device__ __forceinline__ int vt_off(int dch, int jb) { return dch * 256 + ((jb ^ ((dch & 15) ^ (((dch >> 4) & 7) << 1))) << 4); }
__device__ __forceinline__ void phase_spatial(const Frame& F, int bsg, int layer) {
    const bf16_t* Z = F.ar<bf16_t>(AR_Z); const float* ST = F.ar<float>(AR_ST); bf16_t* Pb = F.ar<bf16_t>(AR_P);
    const bf16_t* Ws = F.wsp<bf16_t>(WS_WSP) + (size_t)bsg * 16 * 128 * 128;
    const float* lng = F.in(31) + (size_t)bsg * 2048; const float* lnb = F.in(32) + (size_t)bsg * 2048; const float* bs = F.in(34) + (size_t)bsg * 16 * 128;
    LAS unsigned char* vt = F.lds;
    const int skip = layer >= 3;
    const int nchunk = skip ? BG * 16 : BG * 18;
    const int w = F.wave, lane = F.lane, dt = w >> 1, it0 = (w & 1) * 2;
    const int jj0 = F.tid >> 4, c8 = (F.tid & 15) * 8;
    u32x4 zz[4]; f32x2 st[4];
#define SP_ROW0(U_) ((size_t)(skip ? (((U_) >> 4) >> 4) * 18 + 2 + (((U_) >> 4) & 15) : ((U_) >> 4)) * 128)
#define SP_LOADZ(U_) do { const size_t r0_ = SP_ROW0(U_); const int gi_ = (U_) & 15; _Pragma("unroll") for (int k = 0; k < 4; ++k) { \
        zz[k] = *(const u32x4*)(Z + (r0_ + jj0 + 32 * k) * 4096 + 2048 + gi_ * 128 + c8); st[k] = *(const f32x2*)(ST + (r0_ + jj0 + 32 * k) * 2); } } while (0)
    if (F.bid < nchunk * 16) SP_LOADZ(F.bid);
    for (int U = F.bid; U < nchunk * 16; U += F.G) {
        const int gi = U & 15;
        const size_t row0 = SP_ROW0(U);
        const f32x4 g0 = *(const f32x4*)(lng + gi * 128 + c8), g1 = *(const f32x4*)(lng + gi * 128 + c8 + 4), b0 = *(const f32x4*)(lnb + gi * 128 + c8), b1 = *(const f32x4*)(lnb + gi * 128 + c8 + 4);
        const float gg[8] = {g0[0], g0[1], g0[2], g0[3], g1[0], g1[1], g1[2], g1[3]}, bb[8] = {b0[0], b0[1], b0[2], b0[3], b1[0], b1[1], b1[2], b1[3]};
        __syncthreads();
#pragma unroll
        for (int k = 0; k < 4; ++k) {
            const int jj = jj0 + 32 * k;
            const float xv[8] = {lo16(zz[k].x), hi16(zz[k].x), lo16(zz[k].y), hi16(zz[k].y), lo16(zz[k].z), hi16(zz[k].z), lo16(zz[k].w), hi16(zz[k].w)};
#pragma unroll
            for (int e = 0; e < 8; e += 2) {
                const unsigned pw = pk2((xv[e] - st[k][0]) * st[k][1] * gg[e] + bb[e], (xv[e + 1] - st[k][0]) * st[k][1] * gg[e + 1] + bb[e + 1]);
                *(LAS unsigned short*)(vt + vt_off(c8 + e, jj >> 3) + (jj & 7) * 2) = (unsigned short)(pw & 0xFFFFu);
                *(LAS unsigned short*)(vt + vt_off(c8 + e + 1, jj >> 3) + (jj & 7) * 2) = (unsigned short)(pw >> 16);
            }
        }
        const bf16_t* w0p = Ws + ((size_t)gi * 128 + it0 * 32 + (lane & 31)) * 128 + 8 * (lane >> 5);
        bf16x8 B0[8], B1[8];
#pragma unroll
        for (int s_ = 0; s_ < 8; ++s_) { B0[s_] = *(const bf16x8*)(w0p + 16 * s_); B1[s_] = *(const bf16x8*)(w0p + 32 * 128 + 16 * s_); }
        u32x2 uu[2][4]; float bias[2];
#pragma unroll
        for (int it = 0; it < 2; ++it) { const int ii = (it0 + it) * 32 + (lane & 31); bias[it] = bs[gi * 128 + ii];
#pragma unroll
            for (int rq = 0; rq < 4; ++rq) uu[it][rq] = *(const u32x2*)(Z + (row0 + ii) * 4096 + gi * 128 + dt * 32 + 8 * rq + 4 * (lane >> 5)); }
        if (U + F.G < nchunk * 16) SP_LOADZ(U + F.G);
        __syncthreads();
        f32x16 acc0, acc1;
#pragma unroll
        for (int e = 0; e < 16; ++e) { acc0[e] = 0.f; acc1[e] = 0.f; }
        const int dA = dt * 32 + (lane & 31);
#pragma unroll
        for (int s_ = 0; s_ < 8; ++s_) {
            const bf16x8 Afr = *(const LAS bf16x8*)(vt + vt_off(dA, 2 * s_ + (lane >> 5)));
            acc0 = __builtin_amdgcn_mfma_f32_32x32x16_bf16(Afr, B0[s_], acc0, 0, 0, 0);
            acc1 = __builtin_amdgcn_mfma_f32_32x32x16_bf16(Afr, B1[s_], acc1, 0, 0, 0);
        }
#pragma unroll
        for (int it = 0; it < 2; ++it) {
            const int ii = (it0 + it) * 32 + (lane & 31); const size_t row = row0 + ii;
#pragma unroll
            for (int rq = 0; rq < 4; ++rq) {
                const int d0 = dt * 32 + 8 * rq + 4 * (lane >> 5);
                float vs[4];
#pragma unroll
                for (int e = 0; e < 4; ++e) vs[e] = (it == 0 ? acc0[rq * 4 + e] : acc1[rq * 4 + e]) + bias[it];
                u32x2 o; o.x = pk2(lo16(uu[it][rq].x) * vs[0], hi16(uu[it][rq].x) * vs[1]); o.y = pk2(lo16(uu[it][rq].y) * vs[2], hi16(uu[it][rq].y) * vs[3]);
                *(u32x2*)(Pb + row * 2048 + gi * 128 + d0) = o;
            }
        }
    }
#undef SP_ROW0
#undef SP_LOADZ
    __syncthreads();
}

__global__ void __launch_bounds__(NTHREADS, 2) fwd_kernel(Params P) {
    extern __shared__ __attribute__((aligned(16))) unsigned char lds_raw[];
    Frame F; F.lds = (LAS unsigned char*)lds_raw; F.tid = threadIdx.x; F.lane = F.tid & 63; F.wave = __builtin_amdgcn_readfirstlane(F.tid >> 6);
    F.G = gridDim.x; F.bid = blockIdx.x; F.ws = P.ws; F.kp = (const Params __attribute__((address_space(4)))*)__builtin_amdgcn_kernarg_segment_ptr();
    const int lo = P.ph_lo, hi = P.ph_hi;
    volatile LAS unsigned* misc = (volatile LAS unsigned*)(F.lds + LDS_MISC);
    if (F.tid < 4) misc[F.tid] = 0u;
    __syncthreads();
    XcdBarrier bar; bar.bar = (unsigned*)(F.ws + WS_CTL); bar.x = 0; bar.st = misc;
    if (hi - lo > 1) bar = xcd_barrier_post((unsigned*)(F.ws + WS_CTL), misc);
    int ph = 0;
#define RUN(id, ...) do { if (ph >= lo && ph < hi) { const int nrep_ = ((REP_MASK >> (id)) & 1u) ? 2 : 1; for (int rep_ = 0; rep_ < nrep_; ++rep_) { const bool dry_ = (rep_ + 1 < nrep_); (void)dry_; { int t_ = threadIdx.x; const Params __attribute__((address_space(4)))* kp_ = (const Params __attribute__((address_space(4)))*)__builtin_amdgcn_kernarg_segment_ptr(); asm volatile("" : "+v"(t_), "+s"(kp_)); F.tid = t_; F.lane = t_ & 63; F.kp = kp_; F.ws = kp_->ws; } __VA_ARGS__; if (rep_ + 1 < nrep_ || ph + 1 < hi) xcd_barrier(bar); } } ++ph; } while (0)

    RUN(0, phase_prologue(F));
    for (int g = 0; g < NG; ++g) {
        for (int layer = 0; layer < 4; ++layer) {
            const int a = layer >> 1;
            if ((layer & 1) == 0) {
                const bf16_t* Vc = layer == 0 ? F.wsp<bf16_t>(WS_VF) : F.ar<bf16_t>(AR_V);
                RUN(1, phase_norm1(F, g, layer, F.ar<bf16_t>(AR_H2), 2048, dry_));
                RUN(2, phase_mix(F, a));
                RUN(3, { { pg8::SchedPlain S; S.init(TG / 256, 2, F.G, F.bid, 0);
                        EpiL1 E{F.ar<bf16_t>(AR_L1)};
                        pg8::gemm_phase(F.tid, F.lds, F.ar<bf16_t>(AR_H2), K1CAT, F.wsp<bf16_t>(WS_WL) + (size_t)a * 512 * K1CAT, K1CAT, K1CAT, S, E); }
                      { pg8::SchedRKV S; S.init(TG / 256, 12, F.G, (F.bid + 192) % F.G, 0);
                        EpiRKV E{F.ws, layer == 0 ? WS_VF : WS_ARENA + AR_V};
                        pg8::gemm_phase(F.tid, F.lds, F.ar<bf16_t>(AR_XR), D, F.wsp<bf16_t>(WS_WRKV) + (size_t)a * 3072 * D, D, D, S, E); } });
                if (layer == 2) {
                    RUN(4, { pg8::SchedPlain S; S.init(TG / 256, 4, F.G, F.bid, 0);
                          EpiStore<1> E{F.ar<bf16_t>(AR_VGATE), F.in(19)};
                          pg8::gemm_phase(F.tid, F.lds, F.ar<bf16_t>(AR_L1) + 256, 512, F.wsp<bf16_t>(WS_V2T), 256, 256, S, E); });
                    RUN(5, phase_vfix(F));
                }
                RUN(6, phase_scan4(F, a, Vc));
                RUN(7, { pg8::SchedPlain S; S.init(TG / 256, 4, F.G, F.bid, 0);
                      EpiStore<0> E{F.ar<bf16_t>(AR_G), nullptr};
                      pg8::gemm_phase(F.tid, F.lds, F.ar<bf16_t>(AR_L1) + 256, 512, F.wsp<bf16_t>(WS_G2T) + (size_t)a * D * 256, 256, 256, S, E); });
                RUN(8, phase_post(F, a, Vc));
                RUN(9, { const int skip = layer == 2; pg8::SchedPlain S; S.init(skip ? BG * 8 : TG / 256, 4, F.G, F.bid, skip);
                      EpiStore<0> E{F.ar<bf16_t>(AR_O), nullptr};
                      pg8::gemm_phase(F.tid, F.lds, F.ar<bf16_t>(AR_R), D, F.wsp<bf16_t>(WS_WO) + (size_t)a * D * D, D, D, S, E); });
            } else {
                const int skip = layer == 3;
                RUN(10, phase_norm1(F, g, layer, F.ar<bf16_t>(AR_H), D, dry_));
                RUN(11, { pg8::SchedPlain S; S.init(skip ? BG * 8 : TG / 256, 16, F.G, F.bid, skip);
                      EpiGelu E{F.ar<bf16_t>(AR_Z), F.in(30) + (size_t)a * 4096};
                      pg8::gemm_phase(F.tid, F.lds, F.ar<bf16_t>(AR_H), D, F.wsp<bf16_t>(WS_WIN) + (size_t)a * 4096 * D, D, D, S, E); });
                RUN(12, phase_sgstats(F, layer));
                RUN(13, phase_spatial(F, a, layer));
                RUN(14, { pg8::SchedPlain S; S.init(skip ? BG * 8 : TG / 256, 4, F.G, F.bid, skip);
                      EpiStore<0> E{F.ar<bf16_t>(AR_O), nullptr};
                      pg8::gemm_phase(F.tid, F.lds, F.ar<bf16_t>(AR_P), 2048, F.wsp<bf16_t>(WS_WOUT) + (size_t)a * D * 2048, 2048, 2048, S, E); });
            }
            RUN(15, phase_norm2(F, g, layer, dry_));
            RUN(16, { const int total = moe_tables(F, g, layer);
                  pg8::SchedMoe<true> S{(const LAS int*)(F.lds + LDS_MISC + 64), (const LAS int*)(F.lds + LDS_MISC + 192), F.ar<int>(AR_LIST), F.G, F.bid, total};
                  EpiMG E{F.ar<bf16_t>(AR_HE)};
                  pg8::gemm_phase(F.tid, F.lds, F.ar<bf16_t>(AR_HM), D, F.wsp<bf16_t>(WS_WGU) + (size_t)layer * NEXP * 1024 * D, D, D, S, E); });
            RUN(17, { const int total = moe_tables(F, g, layer);
                  pg8::SchedMoe<false> S{(const LAS int*)(F.lds + LDS_MISC + 64), (const LAS int*)(F.lds + LDS_MISC + 192), F.ar<int>(AR_LIST), F.G, F.bid, total};
                  EpiMD E{F.ar<bf16_t>(AR_YM0), F.ar<int>(AR_LIST), F.ar<float>(AR_LW), (const LAS int*)(F.lds + LDS_MISC + 64)};
                  pg8::gemm_phase(F.tid, F.lds, F.ar<bf16_t>(AR_HE), FEXP, F.wsp<bf16_t>(WS_WD) + (size_t)layer * NEXP * D * FEXP, FEXP, FEXP, S, E); });
        }
        RUN(18, phase_norm1(F, g, 4, nullptr, 0));
    }
#undef RUN
}
constexpr int NPHASES = 1 + NG * (10 + 8 + 12 + 8 + 1);

__global__ void nan_fill(float* out, size_t n) { for (size_t i = (size_t)blockIdx.x * blockDim.x + threadIdx.x; i < n; i += (size_t)gridDim.x * blockDim.x) out[i] = __uint_as_float(0x7FC00000u); }

extern "C" void kernel_launch(void* const* d_in, const int* in_sizes, int n_in, void* d_out, int out_size, void* d_ws, size_t ws_size, hipStream_t stream) {
    static int grid = 0;
    if (grid == 0) {
        int dev = 0, cus = 0, per_cu = 0;
        if (n_in != 42 || ws_size < WS_END || hipGetDevice(&dev) != hipSuccess || hipDeviceGetAttribute(&cus, hipDeviceAttributeMultiprocessorCount, dev) != hipSuccess) {
            fprintf(stderr, "kernel_launch: bad setup (n_in %d, ws %zu need %zu)\n", n_in, ws_size, (size_t)WS_END); grid = -1;
        } else if (hipFuncSetAttribute((const void*)fwd_kernel, hipFuncAttributeMaxDynamicSharedMemorySize, LDS_BYTES) != hipSuccess) { fprintf(stderr, "kernel_launch: hipFuncSetAttribute failed\n"); grid = -1; }
        else {
            if (hipOccupancyMaxActiveBlocksPerMultiprocessor(&per_cu, (const void*)fwd_kernel, NTHREADS, LDS_BYTES) != hipSuccess || per_cu < 1) { fprintf(stderr, "kernel_launch: occupancy query reports %d\n", per_cu); }
            (void)hipGetLastError();
            grid = cus;
        }
    }
    if (grid < 0) { hipLaunchKernelGGL(nan_fill, dim3(1024), dim3(256), 0, stream, (float*)d_out, (size_t)out_size); return; }
    (void)hipMemsetAsync((char*)d_ws + WS_CTL, 0, CTL_BYTES, stream);
    Params p{};
    for (int i = 0; i < 42; ++i) p.in[i] = (const float*)d_in[i];
    p.out = (float*)d_out; p.ws = (unsigned char*)d_ws;
#if PER_PHASE_LAUNCH
    for (int k = 0; k < NPHASES; ++k) { p.ph_lo = k; p.ph_hi = k + 1; hipLaunchKernelGGL(fwd_kernel, dim3(grid), dim3(NTHREADS), LDS_BYTES, stream, p); }
#else
    p.ph_lo = 0; p.ph_hi = NPHASES;
    hipLaunchKernelGGL(fwd_kernel, dim3(grid), dim3(NTHREADS), LDS_BYTES, stream, p);
#endif
}
```

```cpp
#include <hip/hip_runtime.h>
#include <cstdio>
#include <cstdint>

#ifndef REP_MASK
#define REP_MASK 0u
#endif
#ifndef PER_PHASE_LAUNCH
#define PER_PHASE_LAUNCH 0
#endif

#define LAS __attribute__((address_space(3)))
typedef unsigned short bf16_t;
typedef short bf16x8 __attribute__((ext_vector_type(8)));
typedef float f32x4 __attribute__((ext_vector_type(4)));
typedef float f32x2 __attribute__((ext_vector_type(2)));
typedef float f32x16 __attribute__((ext_vector_type(16)));
typedef unsigned u32x4 __attribute__((ext_vector_type(4)));
typedef unsigned u32x2 __attribute__((ext_vector_type(2)));

constexpr int NB = 32, SEQ = 2048, LC = 256, LT = SEQ + LC, D = 1024, NH = 16;
constexpr int NG = 2, BG = NB / NG, TG = BG * LT;
constexpr int NTHREADS = 512, NWAVES = 8;
constexpr int N1CAT = 3584, K1CAT = 2048;
constexpr int NEXP = 16, FEXP = 512;

constexpr size_t al256(size_t x) { return (x + 255) & ~(size_t)255; }
constexpr int XCD_BAR_WORDS_C = 3456;
constexpr size_t WS_CTL = 0;
constexpr size_t CTL_BAR_BYTES = (size_t)XCD_BAR_WORDS_C * 4;
constexpr size_t CTL_CNT_OFF = al256(CTL_BAR_BYTES);
constexpr size_t CTL_BYTES = al256(CTL_CNT_OFF + (size_t)2 * NG * 4 * 32 * 64);
constexpr size_t WS_X = al256(WS_CTL + CTL_BYTES);
constexpr size_t WS_VF = WS_X + (size_t)TG * D * 2;
constexpr size_t WS_MODL = WS_VF + (size_t)TG * D * 2;
constexpr size_t WS_MODC = WS_MODL + (size_t)4 * NB * 6 * D * 4;
constexpr size_t WS_WRKV = al256(WS_MODC + (size_t)4 * 6 * D * 4);
constexpr size_t WS_WL = WS_WRKV + (size_t)2 * 3072 * D * 2;
constexpr size_t WS_WO = WS_WL + (size_t)2 * 512 * K1CAT * 2;
constexpr size_t WS_G2T = WS_WO + (size_t)2 * D * D * 2;
constexpr size_t WS_V2T = WS_G2T + (size_t)2 * D * 256 * 2;
constexpr size_t WS_W2T = WS_V2T + (size_t)D * 256 * 2;
constexpr size_t WS_A2T = WS_W2T + (size_t)4 * D * 64 * 2;
constexpr size_t WS_WIN = WS_A2T + (size_t)4 * D * 64 * 2;
constexpr size_t WS_WOUT = WS_WIN + (size_t)2 * 4096 * D * 2;
constexpr size_t WS_WSP = WS_WOUT + (size_t)2 * D * 2048 * 2;
constexpr size_t WS_WGU = WS_WSP + (size_t)2 * 16 * 128 * 128 * 2;
constexpr size_t WS_WD = WS_WGU + (size_t)4 * NEXP * 1024 * D * 2;
constexpr size_t WS_ARENA = al256(WS_WD + (size_t)4 * NEXP * D * FEXP * 2);
constexpr size_t SZB = (size_t)TG * D * 2;
constexpr size_t AR_H2 = 0;
constexpr size_t AR_Y0 = 0, AR_Y1 = SZB;
constexpr size_t AR_XR = 2 * SZB;
constexpr size_t AR_R = 5 * SZB, AR_K = 6 * SZB, AR_V = 7 * SZB;
constexpr size_t AR_L1 = 8 * SZB;
constexpr size_t AR_DOT = AR_L1 + SZB / 2;
constexpr size_t AR_G = 2 * SZB;
constexpr size_t AR_VGATE = 0;
constexpr size_t AR_O = 3 * SZB;
constexpr size_t AR_H = 0;
constexpr size_t AR_Z = SZB;
constexpr size_t AR_P = 5 * SZB;
constexpr size_t AR_ST = 7 * SZB;
constexpr size_t AR_HM = 0;
constexpr size_t AR_HE = SZB;
constexpr size_t HE_ROWS = (size_t)2 * TG + 32 * 256;
constexpr size_t AR_LIST = al256(AR_HE + HE_ROWS * FEXP * 2);
constexpr size_t AR_LW = AR_LIST + (size_t)32 * TG * 4;
constexpr size_t AR_YM0 = 5 * SZB, AR_YM1 = 6 * SZB;
constexpr size_t ARENA_BYTES = AR_DOT + (size_t)2 * TG * 16 * 4 + 4096;
constexpr size_t WS_END = WS_ARENA + ARENA_BYTES;
static_assert(AR_LW + (size_t)32 * TG * 4 <= AR_O, "moe lists overlap");

constexpr int LDS_STAGE = 131072;
constexpr int LDS_MISC = LDS_STAGE;
constexpr int LDS_BYTES = LDS_STAGE + 1024;

struct Params {
    const float* in[42];
    float* out;
    unsigned char* ws;
    int ph_lo, ph_hi;
};

__device__ __forceinline__ float bf2f(unsigned short b) { return __uint_as_float(((unsigned)b) << 16); }
__device__ __forceinline__ unsigned short f2bf(float f) { unsigned u = __float_as_uint(f); u += 0x7FFFu + ((u >> 16) & 1u); return (unsigned short)(u >> 16); }
typedef __bf16 bf16x2_t __attribute__((ext_vector_type(2)));
__device__ __forceinline__ unsigned pk2(float lo, float hi) { const bf16x2_t v = __builtin_convertvector((f32x2){lo, hi}, bf16x2_t); return __builtin_bit_cast(unsigned, v); }
__device__ __forceinline__ float lo16(unsigned w) { return __uint_as_float(w << 16); }
__device__ __forceinline__ float hi16(unsigned w) { return __uint_as_float(w & 0xFFFF0000u); }
__device__ __forceinline__ float sigmoidf_(float x) { return __builtin_amdgcn_rcpf(1.0f + __expf(-x)); }
__device__ __forceinline__ float tanhf_(float x) { return 1.0f - 2.0f * __builtin_amdgcn_rcpf(__expf(2.0f * x) + 1.0f); }
__device__ __forceinline__ float wave_sum(float v) {
#pragma unroll
    for (int o = 32; o > 0; o >>= 1) v += __shfl_xor(v, o);
    return v;
}
template <int CTRL> __device__ __forceinline__ float dpp_f(float v) {
    return __int_as_float(__builtin_amdgcn_update_dpp(0, __float_as_int(v), CTRL, 0xF, 0xF, true));
}
__device__ __forceinline__ float red8(float v) { v += dpp_f<0xB1>(v); v += dpp_f<0x4E>(v); v += dpp_f<0x141>(v); return v; }
__device__ __forceinline__ float red16(float v) { v = red8(v); v += dpp_f<0x140>(v); return v; }
__device__ __forceinline__ float wave_sum_dpp(float v) {
    v = red16(v);
    const float a = __int_as_float(__builtin_amdgcn_readlane(__float_as_int(v), 0)), b = __int_as_float(__builtin_amdgcn_readlane(__float_as_int(v), 16));
    const float c = __int_as_float(__builtin_amdgcn_readlane(__float_as_int(v), 32)), d = __int_as_float(__builtin_amdgcn_readlane(__float_as_int(v), 48));
    return (a + b) + (c + d);
}
__device__ __forceinline__ float red4(float v) { v += dpp_f<0xB1>(v); v += dpp_f<0x4E>(v); return v; }
__device__ __forceinline__ f32x2 gelu_pk(f32x2 v) {
    const f32x2 av = __builtin_elementwise_abs(v), d = av * 0.2316418882f + 1.0f;
    f32x2 t; t.x = __builtin_amdgcn_rcpf(d.x); t.y = __builtin_amdgcn_rcpf(d.y);
    f32x2 q = t * 0.5307027145f + (-0.7265760135f); q = q * t + 0.7107068705f; q = q * t + (-0.142248368f); q = q * t + 0.127414796f; q = q * t;
    const f32x2 s = (v * v) * (-0.72134752044f);
    f32x2 e; e.x = __builtin_amdgcn_exp2f(s.x); e.y = __builtin_amdgcn_exp2f(s.y);
    const f32x2 m = v * (q * e), r = v - m;
    f32x2 o; o.x = v.x < 0.f ? m.x : r.x; o.y = v.y < 0.f ? m.y : r.y; return o;
}
__device__ __forceinline__ float gelu_f(float v) {
    const float av = fabsf(v), t = __builtin_amdgcn_rcpf(av * 0.2316418882f + 1.0f);
    float q = t * 0.5307027145f + (-0.7265760135f); q = q * t + 0.7107068705f; q = q * t + (-0.142248368f); q = q * t + 0.127414796f; q = q * t;
    const float e = __builtin_amdgcn_exp2f((v * v) * (-0.72134752044f));
    const float m = v * (q * e);
    return v < 0.f ? m : v - m;
}

#define XB_TMO      128
#define XB_XCNT(j)  (256  + 64 * (j))
#define XB_XSUB(j)  (1280 + 64 * (j))
#define XB_XGEN(j)  (2304 + 64 * (j))
#define XB_TOP      3328
#define XB_TOPGEN   3392
#define XCD_BAR_WORDS 3456
#define XB_SPIN_CAP (1u << 22)
static_assert(XCD_BAR_WORDS == XCD_BAR_WORDS_C, "barrier words");
__device__ __forceinline__ unsigned xb_ld(unsigned* p)              { return __hip_atomic_load(p, __ATOMIC_RELAXED, __HIP_MEMORY_SCOPE_AGENT); }
__device__ __forceinline__ unsigned xb_add(unsigned* p, unsigned v) { return __hip_atomic_fetch_add(p, v, __ATOMIC_RELAXED, __HIP_MEMORY_SCOPE_AGENT); }
__device__ __forceinline__ unsigned xb_xcc_id() { return (unsigned)__builtin_amdgcn_s_getreg((3 << 11) | 20) & 0xFu; }
#define XB_SPIN(cond, bar) do { unsigned _sp = 0; while (cond) { __builtin_amdgcn_s_sleep(1); \
    if ((++_sp & 255u) == 0u) { if (xb_ld(&(bar)[XB_TMO])) break; if (_sp > XB_SPIN_CAP) { atomicAdd(&(bar)[XB_TMO], 1u); break; } } } } while (0)
struct XcdBarrier { unsigned* bar; unsigned x; volatile LAS unsigned* st; };
__device__ __forceinline__ XcdBarrier xcd_barrier_post(unsigned* bar, volatile LAS unsigned* st) {
    XcdBarrier b; b.bar = bar; b.x = xb_xcc_id(); b.st = st;
    if (threadIdx.x == 0) (void)xb_add(&bar[XB_XCNT(b.x)], 1u);
    return b;
}
__device__ __forceinline__ void xcd_barrier_complete(unsigned* bar, unsigned x, unsigned& nloc, unsigned& nx) {
    const unsigned G = gridDim.x * gridDim.y * gridDim.z;
    unsigned sum, cnt, mine, sp = 0u;
    for (;;) {
        sum = 0u; cnt = 0u; mine = 0u;
#pragma unroll
        for (unsigned j = 0; j < 16; ++j) { const unsigned c = xb_ld(&bar[XB_XCNT(j)]); sum += c; cnt += (c > 0u) ? 1u : 0u; mine = (j == x) ? c : mine; }
        if (sum == G) break;
        __builtin_amdgcn_s_sleep(1);
        if ((++sp & 255u) == 0u) { if (xb_ld(&bar[XB_TMO])) break; if (sp > XB_SPIN_CAP) { atomicAdd(&bar[XB_TMO], 1u); break; } }
    }
    nloc = mine > 0u ? mine : 1u; nx = cnt > 0u ? cnt : 1u;
}
__device__ __forceinline__ void xcd_barrier(const XcdBarrier& b) {
    asm volatile("s_waitcnt vmcnt(0)" ::: "memory");
    __syncthreads();
    if (threadIdx.x == 0) {
        unsigned* bar = b.bar;
        __builtin_amdgcn_s_waitcnt(0);
        unsigned nloc = b.st[0], nx = b.st[1];
        if (nloc == 0u) { xcd_barrier_complete(bar, b.x, nloc, nx); b.st[0] = nloc; b.st[1] = nx; }
        const unsigned old = xb_add(&bar[XB_XSUB(b.x)], 1u);
        const unsigned gen = old / nloc;
        if (old + 1u == (gen + 1u) * nloc) {
            __builtin_amdgcn_fence(__ATOMIC_RELEASE, "agent");
            asm volatile("s_waitcnt vmcnt(0)" ::: "memory");
            const unsigned og = xb_add(&bar[XB_TOP], 1u);
            const unsigned tg = og / nx;
            if (og + 1u == (tg + 1u) * nx) xb_add(&bar[XB_TOPGEN], 1u);
            else XB_SPIN(xb_ld(&bar[XB_TOPGEN]) == tg, bar);
            __builtin_amdgcn_fence(__ATOMIC_ACQUIRE, "agent");
            xb_add(&bar[XB_XGEN(b.x)], 1u);
            asm volatile("s_waitcnt vmcnt(0)" ::: "memory");
        } else {
            XB_SPIN(xb_ld(&bar[XB_XGEN(b.x)]) == gen, bar);
            __builtin_amdgcn_fence(__ATOMIC_ACQUIRE, "agent");
            asm volatile("s_waitcnt vmcnt(0)" ::: "memory");
        }
    }
    __syncthreads();
}

namespace pg8 {
constexpr int BM = 256, BK = 64, HALF = 128, HTB = HALF * BK * 2, STAGE_BYTES = 8 * HTB, NXCD = 8, WGM = 8;
__host__ __device__ __forceinline__ int lds_byte(int r, int c) { const int st = (r >> 4) * 2 + (c >> 5), rr = r & 15, cc = c & 31, ob = rr * 64 + cc * 2; return st * 1024 + (ob ^ (((ob >> 9) & 1) << 5)); }
__host__ __device__ __forceinline__ void stage_rc(int b, int& R, int& C) { const int st = b / 1024, sb = b % 1024, swz = sb ^ (((sb >> 9) & 1) << 5); R = (st >> 1) * 16 + swz / 64; C = (st & 1) * 32 + (swz % 64) / 2; }
__host__ __device__ __forceinline__ int perm32(int rho) { const int n = rho >> 4, i = rho & 15; return 8 * (i >> 2) + 4 * n + (i & 3); }
struct Unit { int pm, pn, aux; };

struct SchedPlain {
    static constexpr bool GATHER = false;
    int nM, nN, nwg, G, c, skipctx;
    __device__ void init(int nM_, int nN_, int G_, int c_, int skipctx_) { nM = nM_; nN = nN_; nwg = nM * nN; G = G_; c = c_; skipctx = skipctx_; }
    __device__ bool next(int i, Unit& u) const {
        const long L = (long)i * G + c; if (L >= nwg) return false;
        int wgid = (int)L; { const int q = nwg / NXCD, r = nwg % NXCD, xcd = wgid % NXCD, off = wgid / NXCD; wgid = (xcd < r ? xcd * (q + 1) : r * (q + 1) + (xcd - r) * q) + off; }
        const int nig = WGM * nN, gid = wgid / nig, fm = gid * WGM, gsz = (nM - fm) < WGM ? (nM - fm) : WGM;
        int pm = fm + ((wgid % nig) % gsz); u.pn = (wgid % nig) / gsz; u.aux = 0;
        if (skipctx) pm = (pm >> 3) * 9 + 1 + (pm & 7);
        u.pm = pm; return true;
    }
    __device__ __forceinline__ int arow(const Unit& u, int r) const { return u.pm * BM + r; }
};
struct SchedRKV : SchedPlain {
    __device__ bool next(int i, Unit& u) const { if (!SchedPlain::next(i, u)) return false; u.pm += (u.pn >> 2) * nM; return true; }
};
template <bool GATH> struct SchedMoe {
    static constexpr bool GATHER = GATH;
    const LAS int* cn; const LAS int* tb; const int* lists; int G, c, total;
    __device__ bool next(int i, Unit& u) const {
        const int U = i * G + c; if (U >= total * 4) return false;
        const int T = U >> 2, pn = U & 3; int l = 0;
        while (tb[l + 1] <= T) ++l;
        u.pm = T; u.pn = (l >> 1) * 4 + pn; u.aux = l | ((T - tb[l]) << 8); return true;
    }
    __device__ __forceinline__ int arow(const Unit& u, int r) const {
        if (!GATH) return u.pm * BM + r;
        const int l = u.aux & 255, idx = (u.aux >> 8) * BM + r;
        return idx < cn[l] ? lists[(size_t)l * TG + idx] : 0;
    }
};

template <class Epi, class Sched>
__device__ __forceinline__ void gemm_phase(const int tid, LAS unsigned char* lds, const bf16_t* A, int lda, const bf16_t* Bt, int ldb, int K, const Sched& S, const Epi& E) {
    constexpr bool GA = Sched::GATHER;
    const int wid = __builtin_amdgcn_readfirstlane(tid >> 6), lane = tid & 63, wr = wid >> 2, wc = wid & 3, fr = lane & 15, fq = lane >> 4;
    const int nt = K / BK;
    unsigned voffA[2], voffB[2];
#pragma unroll
    for (int i = 0; i < 2; ++i) { int R, C; stage_rc(tid * 16 + i * 8192, R, C); const int Rb = (R & ~31) + perm32(R & 31);
        voffA[i] = (unsigned)(R * lda + C) * 2u; voffB[i] = (unsigned)(Rb * ldb + C) * 2u; }
    const size_t kstep = (size_t)(BK * 2);
    const size_t hstepA = (size_t)HALF * lda * 2, tstepA = 2 * hstepA;
    const size_t hstepB = (size_t)HALF * ldb * 2, tstepB = 2 * hstepB;
    const unsigned ldsw = (unsigned)wid * 1024u;
    const int aoff = lds_byte(wr * 64 + fr, fq * 8), boff = lds_byte(wc * 32 + fr, fq * 8);
#define PG8_SA(b, h) (((b) * 2 + (h)) * HTB)
#define PG8_SB(b, h) ((4 + (b) * 2 + (h)) * HTB)
#define PG8_STAGE(bufoff, gbase, voff) do { _Pragma("unroll") for (int _i = 0; _i < 2; ++_i) \
        __builtin_amdgcn_global_load_lds((const unsigned*)((const char*)(gbase) + (voff)[_i]), (LAS unsigned*)(lds + (bufoff) + ldsw + _i * 8192), 16, 0, 0); } while (0)
#define PG8_STAGE_A(bufoff, ub, gv, h, koff) do { if constexpr (GA) { PG8_STAGE(bufoff, (const char*)A + (koff), gv[h]); } else { PG8_STAGE(bufoff, (ub) + (h) * hstepA + (koff), voffA); } } while (0)
#define PG8_LDA(dst, b, h) do { _Pragma("unroll") for (int m = 0; m < 4; ++m) _Pragma("unroll") for (int k = 0; k < 2; ++k) dst[m][k] = *(const LAS bf16x8*)(lds + PG8_SA(b, h) + aoff + m * 2048 + k * 1024); } while (0)
#define PG8_LDB(dst, b, h) do { _Pragma("unroll") for (int n = 0; n < 2; ++n) _Pragma("unroll") for (int k = 0; k < 2; ++k) dst[n][k] = *(const LAS bf16x8*)(lds + PG8_SB(b, h) + boff + n * 2048 + k * 1024); } while (0)
#define PG8_MMA(ai, bj, At, Bt_) do { __builtin_amdgcn_s_setprio(1); _Pragma("unroll") for (int m = 0; m < 4; ++m) _Pragma("unroll") for (int n = 0; n < 2; ++n) _Pragma("unroll") for (int k = 0; k < 2; ++k) \
        acc[ai][bj][m][n] = __builtin_amdgcn_mfma_f32_16x16x32_bf16(Bt_[n][k], At[m][k], acc[ai][bj][m][n], 0, 0, 0); __builtin_amdgcn_s_setprio(0); } while (0)
#define PG8_WAIT_V(n) asm volatile("s_waitcnt vmcnt(" #n ")" ::: "memory")
#define PG8_WAIT_L(n) asm volatile("s_waitcnt lgkmcnt(" #n ")" ::: "memory")
#define PG8_BAR __builtin_amdgcn_s_barrier()
#define PG8_SCHED __builtin_amdgcn_sched_barrier(0)
#define PG8_GOFF(dst, u) do { if constexpr (GA) { _Pragma("unroll") for (int _h = 0; _h < 2; ++_h) _Pragma("unroll") for (int _i = 0; _i < 2; ++_i) { int R_, C_; stage_rc(tid * 16 + _i * 8192, R_, C_); \
        dst[_h][_i] = ((unsigned)S.arow(u, _h * HALF + R_) * (unsigned)lda + (unsigned)C_) * 2u; } } } while (0)
    Unit cur, nxt; int ui = 0;
    if (!S.next(0, cur)) return;
    f32x4 acc[2][2][4][2];
#pragma unroll
    for (int a = 0; a < 2; ++a)
#pragma unroll
        for (int b = 0; b < 2; ++b)
#pragma unroll
            for (int m = 0; m < 4; ++m)
#pragma unroll
                for (int n = 0; n < 2; ++n) acc[a][b][m][n] = (f32x4){0.f, 0.f, 0.f, 0.f};
    bf16x8 At[4][2], B0[2][2], B1[2][2];
    unsigned gAc[2][2], gAn[2][2];
    PG8_GOFF(gAc, cur);
    const char* cA = (const char*)A + (GA ? (size_t)0 : (size_t)cur.pm * tstepA);
    const char* cB = (const char*)Bt + (size_t)cur.pn * tstepB;
    PG8_STAGE(PG8_SB(0, 0), cB, voffB); PG8_STAGE_A(PG8_SA(0, 0), cA, gAc, 0, 0); PG8_STAGE(PG8_SB(0, 1), cB + hstepB, voffB); PG8_STAGE_A(PG8_SA(0, 1), cA, gAc, 1, 0);
    if (wr == 1) PG8_BAR;
    PG8_WAIT_V(4); PG8_BAR;
    PG8_STAGE(PG8_SB(1, 0), cB + kstep, voffB); PG8_STAGE_A(PG8_SA(1, 0), cA, gAc, 0, kstep); PG8_STAGE(PG8_SB(1, 1), cB + hstepB + kstep, voffB);
    PG8_WAIT_V(6); PG8_BAR;
    for (;;) {
        const bool has_next = S.next(ui + 1, nxt);
        if (has_next) { PG8_GOFF(gAn, nxt); }
        else if constexpr (GA) {
#pragma unroll
            for (int _h = 0; _h < 2; ++_h)
#pragma unroll
                for (int _i = 0; _i < 2; ++_i) gAn[_h][_i] = gAc[_h][_i];
        }
        const char* nA = (has_next && !GA) ? (const char*)A + (size_t)nxt.pm * tstepA : cA;
        const char* nB = has_next ? (const char*)Bt + (size_t)nxt.pn * tstepB : cB;
#pragma unroll 1
        for (int t = 0; t < nt; t += 2) {
            const bool last = (t == nt - 2);
            const size_t k1 = (size_t)(t + 1) * kstep;
            const size_t k2 = last ? (size_t)0 : (size_t)(t + 2) * kstep, k3 = k2 + kstep;
            const char* a2 = last ? nA : cA; const char* b2 = last ? nB : cB;
            unsigned g2[2][2];
            if constexpr (GA) {
#pragma unroll
                for (int _h = 0; _h < 2; ++_h)
#pragma unroll
                    for (int _i = 0; _i < 2; ++_i) g2[_h][_i] = last ? gAn[_h][_i] : gAc[_h][_i];
            }
            PG8_LDB(B0, 0, 0); PG8_SCHED; PG8_LDA(At, 0, 0); PG8_STAGE_A(PG8_SA(1, 1), cA, gAc, 1, k1);
            PG8_WAIT_L(8); PG8_BAR; PG8_WAIT_L(0); PG8_MMA(0, 0, At, B0); PG8_BAR; PG8_SCHED;
            PG8_LDB(B1, 0, 1); PG8_STAGE(PG8_SB(0, 0), b2 + k2, voffB);
            PG8_BAR; PG8_WAIT_L(0); PG8_MMA(0, 1, At, B1); PG8_BAR;
            PG8_LDA(At, 0, 1); PG8_STAGE_A(PG8_SA(0, 0), a2, g2, 0, k2);
            PG8_BAR; PG8_WAIT_L(0); PG8_MMA(1, 0, At, B0); PG8_BAR; PG8_SCHED;
            PG8_STAGE(PG8_SB(0, 1), b2 + hstepB + k2, voffB);
            PG8_WAIT_V(6); PG8_BAR; PG8_MMA(1, 1, At, B1); PG8_BAR;
            PG8_LDB(B0, 1, 0); PG8_SCHED; PG8_LDA(At, 1, 0); PG8_STAGE_A(PG8_SA(0, 1), a2, g2, 1, k2);
            PG8_WAIT_L(8); PG8_BAR; PG8_WAIT_L(0); PG8_MMA(0, 0, At, B0); PG8_BAR; PG8_SCHED;
            PG8_LDB(B1, 1, 1); PG8_STAGE(PG8_SB(1, 0), b2 + k3, voffB);
            PG8_BAR; PG8_WAIT_L(0); PG8_MMA(0, 1, At, B1); PG8_BAR;
            PG8_LDA(At, 1, 1); PG8_STAGE_A(PG8_SA(1, 0), a2, g2, 0, k3);
            PG8_BAR; PG8_WAIT_L(0); PG8_MMA(1, 0, At, B0); PG8_BAR; PG8_SCHED;
            PG8_STAGE(PG8_SB(1, 1), b2 + hstepB + k3, voffB);
            PG8_WAIT_V(6); PG8_BAR; PG8_MMA(1, 1, At, B1); PG8_BAR;
        }
        { int fr_e = fr, fq_e = fq; asm volatile("" : "+v"(fr_e), "+v"(fq_e)); E(acc, cur, wr, wc, fr_e, fq_e); }
        if (!has_next) break;
#pragma unroll
        for (int a = 0; a < 2; ++a)
#pragma unroll
            for (int b = 0; b < 2; ++b)
#pragma unroll
                for (int m = 0; m < 4; ++m)
#pragma unroll
                    for (int n = 0; n < 2; ++n) acc[a][b][m][n] = (f32x4){0.f, 0.f, 0.f, 0.f};
        cur = nxt; cA = nA; cB = nB; ++ui;
        if constexpr (GA) {
#pragma unroll
            for (int _h = 0; _h < 2; ++_h)
#pragma unroll
                for (int _i = 0; _i < 2; ++_i) gAc[_h][_i] = gAn[_h][_i];
        }
    }
    PG8_WAIT_V(0);
    if (wr == 0) PG8_BAR;
    PG8_BAR;
#undef PG8_SA
#undef PG8_SB
#undef PG8_STAGE
#undef PG8_STAGE_A
#undef PG8_LDA
#undef PG8_LDB
#undef PG8_MMA
#undef PG8_WAIT_V
#undef PG8_WAIT_L
#undef PG8_BAR
#undef PG8_SCHED
#undef PG8_GOFF
}
}
using pg8::Unit;

#define EPI_LOOP_BEGIN \
    _Pragma("unroll") for (int ai = 0; ai < 2; ++ai) _Pragma("unroll") for (int m = 0; m < 4; ++m) { const int trow = ai * 128 + wr * 64 + m * 16 + fr; \
    _Pragma("unroll") for (int bj = 0; bj < 2; ++bj) { const int tcol = bj * 128 + wc * 32 + 8 * fq; const f32x4 v0 = acc[ai][bj][m][0], v1 = acc[ai][bj][m][1];
#define EPI_LOOP_END } asm volatile("" ::: "memory"); }
__device__ __forceinline__ u32x4 pk8(const f32x4 a, const f32x4 b) { return (u32x4){pk2(a[0], a[1]), pk2(a[2], a[3]), pk2(b[0], b[1]), pk2(b[2], b[3])}; }

struct EpiRKV {
    unsigned char* ws; size_t voff;
    __device__ __forceinline__ void operator()(const f32x4 (&acc)[2][2][4][2], const Unit& u, int wr, int wc, int fr, int fq) const {
        const int which = u.pn >> 2; const size_t row0 = (size_t)(u.pm - which * (TG / 256)) * 256;
        const size_t off = which == 0 ? (WS_ARENA + AR_R) : (which == 1 ? (WS_ARENA + AR_K) : voff);
        bf16_t* dst = (bf16_t*)(ws + off); const int cb = (u.pn & 3) * 256;
        EPI_LOOP_BEGIN
            *(u32x4*)(dst + (row0 + trow) * D + cb + tcol) = pk8(v0, v1);
        EPI_LOOP_END
    }
};
struct EpiL1 {
    bf16_t* L1;
    __device__ __forceinline__ void operator()(const f32x4 (&acc)[2][2][4][2], const Unit& u, int wr, int wc, int fr, int fq) const {
        const int pn = u.pn; const size_t row0 = (size_t)u.pm * 256; const int cb = pn * 256;
        EPI_LOOP_BEGIN
            f32x4 o0 = v0, o1 = v1;
            if (pn == 0 && bj == 0) { _Pragma("unroll") for (int e = 0; e < 4; ++e) { o0[e] = tanhf_(v0[e]); o1[e] = tanhf_(v1[e]); } }
            if (pn == 1 && bj == 0) { _Pragma("unroll") for (int e = 0; e < 4; ++e) { o0[e] = sigmoidf_(v0[e]); o1[e] = sigmoidf_(v1[e]); } }
            *(u32x4*)(L1 + (row0 + trow) * 512 + cb + tcol) = pk8(o0, o1);
        EPI_LOOP_END
    }
};
template <int ACT> struct EpiStore {
    bf16_t* O; const float* bias;
    __device__ __forceinline__ void operator()(const f32x4 (&acc)[2][2][4][2], const Unit& u, int wr, int wc, int fr, int fq) const {
        const size_t row0 = (size_t)u.pm * 256; const int cb = u.pn * 256;
        f32x4 bv[2][2];
#pragma unroll
        for (int bj = 0; bj < 2; ++bj)
#pragma unroll
            for (int n = 0; n < 2; ++n) bv[bj][n] = ACT == 1 ? *(const f32x4*)(bias + cb + bj * 128 + wc * 32 + 8 * fq + 4 * n) : (f32x4){0.f, 0.f, 0.f, 0.f};
        EPI_LOOP_BEGIN
            f32x4 o0 = v0, o1 = v1;
            if (ACT == 1) { _Pragma("unroll") for (int e = 0; e < 4; ++e) { o0[e] = sigmoidf_(v0[e] + bv[bj][0][e]); o1[e] = sigmoidf_(v1[e] + bv[bj][1][e]); } }
            *(u32x4*)(O + (row0 + trow) * D + cb + tcol) = pk8(o0, o1);
        EPI_LOOP_END
    }
};
struct EpiGelu {
    bf16_t* Z; const float* bias;
    __device__ __forceinline__ void operator()(const f32x4 (&acc)[2][2][4][2], const Unit& u, int wr, int wc, int fr, int fq) const {
        const size_t row0 = (size_t)u.pm * 256; const int cb = u.pn * 256;
        f32x4 bv[2][2];
#pragma unroll
        for (int bj = 0; bj < 2; ++bj)
#pragma unroll
            for (int n = 0; n < 2; ++n) bv[bj][n] = *(const f32x4*)(bias + cb + bj * 128 + wc * 32 + 8 * fq + 4 * n);
        EPI_LOOP_BEGIN
            const f32x4 b0 = bv[bj][0], b1 = bv[bj][1];
            const f32x2 g0 = gelu_pk((f32x2){v0[0] + b0[0], v0[1] + b0[1]}), g1 = gelu_pk((f32x2){v0[2] + b0[2], v0[3] + b0[3]});
            const f32x2 g2 = gelu_pk((f32x2){v1[0] + b1[0], v1[1] + b1[1]}), g3 = gelu_pk((f32x2){v1[2] + b1[2], v1[3] + b1[3]});
            *(u32x4*)(Z + (row0 + trow) * 4096 + cb + tcol) = (u32x4){pk2(g0.x, g0.y), pk2(g1.x, g1.y), pk2(g2.x, g2.y), pk2(g3.x, g3.y)};
        EPI_LOOP_END
    }
};
struct EpiMG {
    bf16_t* HE;
    __device__ __forceinline__ void operator()(const f32x4 (&acc)[2][2][4][2], const Unit& u, int wr, int wc, int fr, int fq) const {
        const size_t row0 = (size_t)u.pm * 256; const int pnl = u.pn & 3;
#pragma unroll
        for (int ai = 0; ai < 2; ++ai)
#pragma unroll
            for (int m = 0; m < 4; ++m) { const int trow = ai * 128 + wr * 64 + m * 16 + fr;
#pragma unroll
                for (int bj = 0; bj < 2; ++bj) {
                    const f32x4 gt = acc[ai][bj][m][0], up = acc[ai][bj][m][1];
                    const int f = (8 * pnl + 4 * bj + wc) * 16 + 4 * fq;
                    float o[4];
#pragma unroll
                    for (int e = 0; e < 4; ++e) o[e] = gt[e] * sigmoidf_(gt[e]) * up[e];
                    u32x2 w; w.x = pk2(o[0], o[1]); w.y = pk2(o[2], o[3]);
                    *(u32x2*)(HE + (row0 + trow) * FEXP + f) = w;
                } }
    }
};
struct EpiMD {
    bf16_t* Y0; const int* lists; const float* lw; const LAS int* cn;
    __device__ __forceinline__ void operator()(const f32x4 (&acc)[2][2][4][2], const Unit& u, int wr, int wc, int fr, int fq) const {
        const int l = u.aux & 255, t0 = (u.aux >> 8) * 256, cnt = cn[l]; const int cb = (u.pn & 3) * 256;
        bf16_t* Y = Y0 + (size_t)(l & 1) * ((AR_YM1 - AR_YM0) / 2);
        int tok[2][4]; float wgt[2][4];
#pragma unroll
        for (int ai = 0; ai < 2; ++ai)
#pragma unroll
            for (int m = 0; m < 4; ++m) { const int idx = t0 + ai * 128 + wr * 64 + m * 16 + fr; const bool ok = idx < cnt;
                tok[ai][m] = ok ? lists[(size_t)l * TG + idx] : -1; wgt[ai][m] = ok ? lw[(size_t)l * TG + idx] : 0.f; }
#pragma unroll
        for (int ai = 0; ai < 2; ++ai)
#pragma unroll
            for (int m = 0; m < 4; ++m) {
                if (tok[ai][m] >= 0) {
                    const float wg = wgt[ai][m]; bf16_t* yr = Y + (size_t)tok[ai][m] * D + cb;
#pragma unroll
                    for (int bj = 0; bj < 2; ++bj) { const int tcol = bj * 128 + wc * 32 + 8 * fq;
                        *(u32x4*)(yr + tcol) = pk8(acc[ai][bj][m][0] * wg, acc[ai][bj][m][1] * wg); }
                } }
    }
};

struct Frame {
    const Params __attribute__((address_space(4)))* kp; LAS unsigned char* lds; int tid, lane, wave, G, bid;
    unsigned char* ws;
    __device__ __forceinline__ const float* in(int k) const { return kp->in[k]; }
    __device__ __forceinline__ float* outp() const { return kp->out; }
    template <class T> __device__ __forceinline__ T* wsp(size_t off) const { return (T*)(ws + off); }
    template <class T> __device__ __forceinline__ T* ar(size_t off) const { return (T*)(ws + WS_ARENA + off); }
    __device__ __forceinline__ const float* modL(int layer, int b, int j) const { return (const float*)(ws + WS_MODL) + (((size_t)layer * NB + b) * 6 + j) * D; }
    __device__ __forceinline__ const float* modC(int layer, int j) const { return (const float*)(ws + WS_MODC) + ((size_t)layer * 6 + j) * D; }
};

struct TJob { const float* src; bf16_t* dst; const float* ksc; int lds, K, N, ldd, kofs, nofs, inter; };
constexpr int NJOBS = 2 * 21 + 1 + 4 + 4 * NEXP * 3;
__device__ __forceinline__ TJob get_job(const Frame& F, int j) {
    TJob J; J.ksc = nullptr; J.kofs = 0; J.nofs = 0; J.inter = 0; J.K = 0; J.N = 0; J.lds = 0; J.ldd = 0; J.src = nullptr; J.dst = nullptr;
    if (j < 42) {
        const int a = j / 21, q = j % 21;
        if (q < 3) { J.src = F.in(9 + q) + (size_t)a * D * D; J.lds = D; J.K = D; J.N = D; J.dst = F.wsp<bf16_t>(WS_WRKV) + (size_t)a * 3072 * D; J.ldd = D; J.nofs = q * 1024; }
        else if (q < 15) {
            const int half = (q - 3) / 6, w = (q - 3) % 6; const float* mu = F.in(8) + (size_t)a * 6 * D;
            J.dst = F.wsp<bf16_t>(WS_WL) + (size_t)a * 512 * K1CAT; J.ldd = K1CAT; J.kofs = half * 1024; J.K = D; int mi = 0;
            if (w < 2) { J.src = F.in(14) + ((size_t)a * 2 + w) * D * 64; J.lds = 64; J.N = 64; J.nofs = w * 64; mi = 1; }
            else if (w < 4) { const int d = w - 2; J.src = F.in(17) + ((size_t)a * 2 + d) * D * 64; J.lds = 64; J.N = 64; J.nofs = 128 + d * 64; mi = 4; }
            else if (w == 4) { J.src = F.in(22) + (size_t)a * D * 128; J.lds = 128; J.N = 128; J.nofs = 256; mi = 5; }
            else { J.src = F.in(20); J.lds = 32; J.N = (a == 1) ? 32 : 0; J.nofs = 384; mi = 3; }
            if (half) J.ksc = mu + mi * D;
        } else if (q == 15) { J.src = F.in(12) + (size_t)a * D * D; J.lds = D; J.K = D; J.N = D; J.dst = F.wsp<bf16_t>(WS_WO) + (size_t)a * D * D; J.ldd = D; }
        else if (q == 16) { J.src = F.in(23) + (size_t)a * 128 * D; J.lds = D; J.K = 128; J.N = D; J.dst = F.wsp<bf16_t>(WS_G2T) + (size_t)a * D * 256; J.ldd = 256; }
        else if (q < 19) { const int d = q - 17; J.src = F.in(15) + ((size_t)a * 2 + d) * 64 * D; J.lds = D; J.K = 64; J.N = D; J.dst = F.wsp<bf16_t>(WS_W2T) + ((size_t)a * 2 + d) * D * 64; J.ldd = 64; }
        else { const int d = q - 19; J.src = F.in(18) + ((size_t)a * 2 + d) * 64 * D; J.lds = D; J.K = 64; J.N = D; J.dst = F.wsp<bf16_t>(WS_A2T) + ((size_t)a * 2 + d) * D * 64; J.ldd = 64; }
    } else if (j == 42) { J.src = F.in(21); J.lds = D; J.K = 32; J.N = D; J.dst = F.wsp<bf16_t>(WS_V2T); J.ldd = 256; J.kofs = 128; }
    else if (j < 47) {
        const int q = j - 43, b = q >> 1;
        if ((q & 1) == 0) { J.src = F.in(29) + (size_t)b * D * 4096; J.lds = 4096; J.K = D; J.N = 4096; J.dst = F.wsp<bf16_t>(WS_WIN) + (size_t)b * 4096 * D; J.ldd = D; }
        else { J.src = F.in(35) + (size_t)b * 2048 * D; J.lds = D; J.K = 2048; J.N = D; J.dst = F.wsp<bf16_t>(WS_WOUT) + (size_t)b * D * 2048; J.ldd = 2048; }
    } else {
        const int q = j - 47, ie = q / 3, w = q % 3;
        if (w < 2) { J.src = F.in(38 + w) + (size_t)ie * D * FEXP; J.lds = FEXP; J.K = D; J.N = FEXP; J.dst = F.wsp<bf16_t>(WS_WGU) + (size_t)ie * 1024 * D; J.ldd = D; J.nofs = w * 4; J.inter = 1; }
        else { J.src = F.in(40) + (size_t)ie * FEXP * D; J.lds = D; J.K = FEXP; J.N = D; J.dst = F.wsp<bf16_t>(WS_WD) + (size_t)ie * D * FEXP; J.ldd = FEXP; }
    }
    return J;
}
__device__ __forceinline__ void transpose_all(const Frame& F) {
    LAS float* tile = (LAS float*)F.lds;
    int tilectr = 0;
#pragma unroll 1
    for (int j = 0; j < NJOBS; ++j) {
        const TJob J = get_job(F, j);
        const int tk = (J.K + 127) / 128, tn = (J.N + 127) / 128, ntile = tk * tn;
        int t = (F.bid - (tilectr % F.G) + F.G) % F.G;
        tilectr += ntile;
#pragma unroll 1
        for (; t < ntile; t += F.G) {
            const int k0 = (t / tn) * 128, n0 = (t % tn) * 128;
            __syncthreads();
            float v[32];
#pragma unroll
            for (int e = 0; e < 32; ++e) { const int idx = F.tid + e * 512, kk = idx >> 7, nn = idx & 127;
                v[e] = 0.f; if (k0 + kk < J.K && n0 + nn < J.N) v[e] = J.src[(size_t)(k0 + kk) * J.lds + n0 + nn]; }
#pragma unroll
            for (int e = 0; e < 32; ++e) { const int idx = F.tid + e * 512, kk = idx >> 7, nn = idx & 127;
                float x = v[e]; if (J.ksc && k0 + kk < J.K) x *= J.ksc[k0 + kk];
                tile[kk * 129 + nn] = x; }
            __syncthreads();
#pragma unroll
            for (int e = 0; e < 16; ++e) { const int idx = F.tid + e * 512, nn = idx >> 6, kk = (idx & 63) * 2;
                if (k0 + kk < J.K && n0 + nn < J.N) { const int n = n0 + nn; const int row = J.nofs + (J.inter ? ((n >> 4) * 32 + ((n & 15) >> 2) * 8 + (n & 3)) : n);
                    *(unsigned*)(J.dst + (size_t)row * J.ldd + J.kofs + k0 + kk) = pk2(tile[kk * 129 + nn], tile[(kk + 1) * 129 + nn]); } }
        }
    }
    __syncthreads();
}
__device__ __forceinline__ void zero_rows(const Frame& F, bf16_t* dst, int ldd, int row0, int nrows, int col0, int ncols) {
    const int per = ncols / 8; const long tot = (long)nrows * per;
    for (long i = (long)F.bid * NTHREADS + F.tid; i < tot; i += (long)F.G * NTHREADS) { const int r = (int)(i / per), c = (int)(i % per) * 8;
        *(u32x4*)(dst + (size_t)(row0 + r) * ldd + col0 + c) = (u32x4){0u, 0u, 0u, 0u}; }
}
__device__ __forceinline__ void phase_prologue(const Frame& F) {
    {
        LAS float* sl = (LAS float*)F.lds;
        LAS float* red = (LAS float*)(F.lds + 33 * 256 * 4);
        const float* c = F.in(1); const float* cc = F.in(3); const float* wm = F.in(4); const float* bm = F.in(5);
        const int tx = F.tid & 63, ty = F.tid >> 6;
        for (int unit = F.bid; unit < 4 * 96; unit += F.G) {
            const int layer = unit / 96, col0 = (unit % 96) * 64;
            float acc[33];
#pragma unroll
            for (int r = 0; r < 33; ++r) acc[r] = 0.f;
#pragma unroll 1
            for (int kc = 0; kc < 4; ++kc) {
                __syncthreads();
                for (int i = F.tid; i < 33 * 256; i += NTHREADS) { const int r = i >> 8, k = (i & 255) + kc * 256; const float x = r < 32 ? c[r * D + k] : cc[k]; sl[i] = x * sigmoidf_(x); }
                __syncthreads();
#pragma unroll 1
                for (int k4 = 0; k4 < 32; k4 += 4) {
                    const int kl = ty * 32 + k4;
                    float w[4];
#pragma unroll
                    for (int e = 0; e < 4; ++e) w[e] = wm[((size_t)layer * D + kc * 256 + kl + e) * 6144 + col0 + tx];
#pragma unroll
                    for (int r = 0; r < 33; ++r) { const f32x4 s = *(const LAS f32x4*)(sl + r * 256 + kl); acc[r] += s[0] * w[0] + s[1] * w[1] + s[2] * w[2] + s[3] * w[3]; if ((r & 7) == 7) asm volatile("" ::: "memory"); }
                }
            }
            __syncthreads();
#pragma unroll
            for (int r = 0; r < 33; ++r) red[(ty * 33 + r) * 64 + tx] = acc[r];
            __syncthreads();
            for (int i = F.tid; i < 33 * 64; i += NTHREADS) { const int r = i >> 6, x = i & 63; float s = 0.f;
#pragma unroll
                for (int y = 0; y < 8; ++y) s += red[(y * 33 + r) * 64 + x];
                const int col = col0 + x; s += bm[layer * 6144 + col];
                if (r < 32) F.wsp<float>(WS_MODL)[((size_t)layer * NB + r) * 6144 + col] = s; else F.wsp<float>(WS_MODC)[(size_t)layer * 6144 + col] = s; }
        }
    }
    __syncthreads();
    transpose_all(F);
    for (int a = 0; a < 2; ++a) {
        bf16_t* WLp = F.wsp<bf16_t>(WS_WL) + (size_t)a * 512 * K1CAT;
        if (a == 0) zero_rows(F, WLp, K1CAT, 384, 128, 0, K1CAT); else zero_rows(F, WLp, K1CAT, 416, 96, 0, K1CAT);
        zero_rows(F, F.wsp<bf16_t>(WS_G2T) + (size_t)a * D * 256, 256, 0, D, 128, 128);
    }
    zero_rows(F, F.wsp<bf16_t>(WS_V2T), 256, 0, D, 0, 128); zero_rows(F, F.wsp<bf16_t>(WS_V2T), 256, 0, D, 160, 96);
    {
        const float* src = F.in(33); bf16_t* dst = F.wsp<bf16_t>(WS_WSP); const long tot = (long)2 * 16 * 128 * 128 / 4;
        for (long i = (long)F.bid * NTHREADS + F.tid; i < tot; i += (long)F.G * NTHREADS) { const f32x4 v = *(const f32x4*)(src + i * 4); u32x2 w; w.x = pk2(v[0], v[1]); w.y = pk2(v[2], v[3]); *(u32x2*)(dst + i * 4) = w; }
    }
    __syncthreads();
}

__device__ __forceinline__ void phase_norm1(const Frame& F, int g, int layer  , bf16_t* dst, int ldh, bool dry = false) {
    bf16_t* X = F.wsp<bf16_t>(WS_X);
    const bf16_t* Y0 = F.ar<bf16_t>(AR_YM0); const bf16_t* Y1 = F.ar<bf16_t>(AR_YM1);
    const bool fin = layer == 4;
    const int rpb = (TG + F.G - 1) / F.G, rbeg = F.bid * rpb, rend = (rbeg + rpb) < TG ? (rbeg + rpb) : TG;
    int key = -1; f32x4 cg[4], cA[4], cB[4];
#pragma unroll
    for (int q = 0; q < 4; ++q) { cg[q] = (f32x4){0.f, 0.f, 0.f, 0.f}; cA[q] = cg[q]; cB[q] = cg[q]; }
    for (int r = rbeg + F.wave; r < rend; r += NWAVES) {
        const int bl = r / LT, t = r % LT, b = g * BG + bl; const bool isctx = t < LC;
        if (isctx && layer >= 3) continue;
        if (key != b * 2 + (int)isctx) {
            key = b * 2 + (int)isctx;
#pragma unroll
            for (int q = 0; q < 4; ++q) { const int c = q * 256 + F.lane * 4;
                if (layer > 0) cg[q] = *(const f32x4*)((isctx ? F.modC(layer - 1, 5) : F.modL(layer - 1, b, 5)) + c);
                if (fin) cA[q] = *(const f32x4*)(F.in(41) + c);
                else { const f32x4 gv = *(const f32x4*)(F.in(6) + (size_t)layer * D + c), cv = *(const f32x4*)((isctx ? F.modC(layer, 1) : F.modL(layer, b, 1)) + c);
                    cA[q] = gv * (1.0f + cv); cB[q] = *(const f32x4*)((isctx ? F.modC(layer, 0) : F.modL(layer, b, 0)) + c); } }
        }
        f32x4 x[4], xo[4];
#pragma unroll
        for (int q = 0; q < 4; ++q) xo[q] = (f32x4){0.f, 0.f, 0.f, 0.f};
        if (layer == 0) {
            const float* src = isctx ? F.in(2) + ((size_t)b * LC + t) * D : F.in(0) + ((size_t)b * SEQ + (t - LC)) * D;
#pragma unroll
            for (int q = 0; q < 4; ++q) x[q] = *(const f32x4*)(src + q * 256 + F.lane * 4);
        } else {
#pragma unroll
            for (int q = 0; q < 4; ++q) { const int c = q * 256 + F.lane * 4;
                { const u32x2 xw = *(const u32x2*)(X + (size_t)r * D + c); x[q] = (f32x4){lo16(xw.x), hi16(xw.x), lo16(xw.y), hi16(xw.y)}; } xo[q] = x[q];
                const u32x2 a = *(const u32x2*)(Y0 + (size_t)r * D + c), bb = *(const u32x2*)(Y1 + (size_t)r * D + c);
                x[q][0] += cg[q][0] * (lo16(a.x) + lo16(bb.x)); x[q][1] += cg[q][1] * (hi16(a.x) + hi16(bb.x));
                x[q][2] += cg[q][2] * (lo16(a.y) + lo16(bb.y)); x[q][3] += cg[q][3] * (hi16(a.y) + hi16(bb.y)); }
        }
        float ss = 0.f;
#pragma unroll
        for (int q = 0; q < 4; ++q) ss += x[q][0] * x[q][0] + x[q][1] * x[q][1] + x[q][2] * x[q][2] + x[q][3] * x[q][3];
        ss = wave_sum_dpp(ss);
        const float rstd = rsqrtf(ss * (1.0f / D) + 1e-6f);
        if (fin) {
            float* o = F.outp() + ((size_t)b * SEQ + (t - LC)) * D;
#pragma unroll
            for (int q = 0; q < 4; ++q) { const int c = q * 256 + F.lane * 4; *(f32x4*)(o + c) = x[q] * rstd * cA[q]; }
        } else {
#pragma unroll
            for (int q = 0; q < 4; ++q) { const int c = q * 256 + F.lane * 4;
                { const f32x4 xs = (dry && layer > 0) ? xo[q] : x[q]; u32x2 xw; xw.x = pk2(xs[0], xs[1]); xw.y = pk2(xs[2], xs[3]); *(u32x2*)(X + (size_t)r * D + c) = xw; }
                const f32x4 h = x[q] * rstd * cA[q] + cB[q];
                u32x2 w; w.x = pk2(h[0], h[1]); w.y = pk2(h[2], h[3]);
                *(u32x2*)(dst + (size_t)r * ldh + c) = w; }
        }
    }
}
__device__ __forceinline__ void phase_mix(const Frame& F, int a) {
    bf16_t* H2 = F.ar<bf16_t>(AR_H2); bf16_t* XM = F.ar<bf16_t>(AR_XR);
    const float* mu = F.in(8) + (size_t)a * 6 * D;
    f32x4 cm[2][3][2];
#pragma unroll
    for (int q = 0; q < 2; ++q)
#pragma unroll
        for (int m = 0; m < 3; ++m) { const int mi = m == 0 ? 0 : (m == 1 ? 2 : 3); const int c = q * 512 + F.lane * 8;
            cm[q][m][0] = *(const f32x4*)(mu + mi * D + c); cm[q][m][1] = *(const f32x4*)(mu + mi * D + c + 4); }
    const int rpb = (TG + F.G - 1) / F.G, rbeg = F.bid * rpb, rend = (rbeg + rpb) < TG ? (rbeg + rpb) : TG;
    for (int r = rbeg + F.wave; r < rend; r += NWAVES) {
        const int t = r % LT; const bool isctx = t < LC; const int p = t - LC;
#pragma unroll
        for (int q = 0; q < 2; ++q) {
            const int c = q * 512 + F.lane * 8;
            int nr;
            if (isctx) nr = (q == 0) ? (t > 0 ? r - 1 : -1) : (t < LC - 1 ? r + 1 : -1);
            else { const int qu = c >> 8;
                nr = qu == 0 ? ((p & 63) > 0 ? r - 1 : -1) : qu == 1 ? ((p & 63) < 63 ? r + 1 : -1) : qu == 2 ? (p >= 64 ? r - 64 : -1) : (p < SEQ - 64 ? r + 64 : -1); }
            const u32x4 hs = *(const u32x4*)(H2 + (size_t)r * 2048 + c);
            u32x4 hn = (u32x4){0u, 0u, 0u, 0u};
            if (nr >= 0) hn = *(const u32x4*)(H2 + (size_t)nr * 2048 + c);
            const float h[8] = {lo16(hs.x), hi16(hs.x), lo16(hs.y), hi16(hs.y), lo16(hs.z), hi16(hs.z), lo16(hs.w), hi16(hs.w)};
            const float n[8] = {lo16(hn.x), hi16(hn.x), lo16(hn.y), hi16(hn.y), lo16(hn.z), hi16(hn.z), lo16(hn.w), hi16(hn.w)};
            float dd[8];
#pragma unroll
            for (int e = 0; e < 8; ++e) dd[e] = n[e] - h[e];
            *(u32x4*)(H2 + (size_t)r * 2048 + 1024 + c) = (u32x4){pk2(dd[0], dd[1]), pk2(dd[2], dd[3]), pk2(dd[4], dd[5]), pk2(dd[6], dd[7])};
#pragma unroll
            for (int m = 0; m < 3; ++m) {
                const f32x4 m0 = cm[q][m][0], m1 = cm[q][m][1];
                float x[8];
#pragma unroll
                for (int e = 0; e < 4; ++e) { x[e] = h[e] + dd[e] * m0[e]; x[4 + e] = h[4 + e] + dd[4 + e] * m1[e]; }
                *(u32x4*)(XM + (size_t)m * TG * D + (size_t)r * D + c) = (u32x4){pk2(x[0], x[1]), pk2(x[2], x[3]), pk2(x[4], x[5]), pk2(x[6], x[7])};
            }
        }
    }
}
__device__ __forceinline__ void phase_vfix(const Frame& F) {
    bf16_t* V = F.ar<bf16_t>(AR_V); const bf16_t* VF = F.wsp<bf16_t>(WS_VF); const bf16_t* GT = F.ar<bf16_t>(AR_VGATE);
    const size_t tot = (size_t)TG * D / 8;
    for (size_t i = (size_t)F.bid * NTHREADS + F.tid; i < tot; i += (size_t)F.G * NTHREADS) {
        const u32x4 v = *(const u32x4*)(V + i * 8), f = *(const u32x4*)(VF + i * 8), g = *(const u32x4*)(GT + i * 8);
        u32x4 o;
        o.x = pk2(lo16(v.x) + (lo16(f.x) - lo16(v.x)) * lo16(g.x), hi16(v.x) + (hi16(f.x) - hi16(v.x)) * hi16(g.x));
        o.y = pk2(lo16(v.y) + (lo16(f.y) - lo16(v.y)) * lo16(g.y), hi16(v.y) + (hi16(f.y) - hi16(v.y)) * hi16(g.y));
        o.z = pk2(lo16(v.z) + (lo16(f.z) - lo16(v.z)) * lo16(g.z), hi16(v.z) + (hi16(f.z) - hi16(v.z)) * hi16(g.z));
        o.w = pk2(lo16(v.w) + (lo16(f.w) - lo16(v.w)) * lo16(g.w), hi16(v.w) + (hi16(f.w) - hi16(v.w)) * hi16(g.w));
        *(u32x4*)(V + i * 8) = o;
    }
}
__device__ __forceinline__ void phase_post(const Frame& F, int a, const bf16_t* V) {
    const bf16_t* Y0 = F.ar<bf16_t>(AR_Y0); bf16_t* YG = F.ar<bf16_t>(AR_R); const bf16_t* Y1 = F.ar<bf16_t>(AR_Y1); const float* DOT = F.ar<float>(AR_DOT); const bf16_t* Gb = F.ar<bf16_t>(AR_G);
    const float* lgp = F.in(27) + (size_t)a * D + F.lane * 16; const float* lbp = F.in(28) + (size_t)a * D + F.lane * 16;
    float lg[16], lb[16];
#pragma unroll
    for (int e = 0; e < 16; e += 4) { const f32x4 gq = *(const f32x4*)(lgp + e), bq = *(const f32x4*)(lbp + e);
        lg[e] = gq[0]; lg[e + 1] = gq[1]; lg[e + 2] = gq[2]; lg[e + 3] = gq[3]; lb[e] = bq[0]; lb[e + 1] = bq[1]; lb[e + 2] = bq[2]; lb[e + 3] = bq[3]; }
    const int rpb = (TG + F.G - 1) / F.G, rbeg = F.bid * rpb, rend = (rbeg + rpb) < TG ? (rbeg + rpb) : TG;
    for (int r = rbeg + F.wave; r < rend; r += NWAVES) {
        const int c = F.lane * 16, h = F.lane >> 2;
        float y[16], vv[16];
#pragma unroll
        for (int q = 0; q < 2; ++q) {
            const u32x4 a0 = *(const u32x4*)(Y0 + (size_t)r * D + c + q * 8), a1 = *(const u32x4*)(Y1 + (size_t)r * D + c + q * 8), v4 = *(const u32x4*)(V + (size_t)r * D + c + q * 8);
            y[q * 8 + 0] = lo16(a0.x) + lo16(a1.x); y[q * 8 + 1] = hi16(a0.x) + hi16(a1.x); y[q * 8 + 2] = lo16(a0.y) + lo16(a1.y); y[q * 8 + 3] = hi16(a0.y) + hi16(a1.y);
            y[q * 8 + 4] = lo16(a0.z) + lo16(a1.z); y[q * 8 + 5] = hi16(a0.z) + hi16(a1.z); y[q * 8 + 6] = lo16(a0.w) + lo16(a1.w); y[q * 8 + 7] = hi16(a0.w) + hi16(a1.w);
            vv[q * 8 + 0] = lo16(v4.x); vv[q * 8 + 1] = hi16(v4.x); vv[q * 8 + 2] = lo16(v4.y); vv[q * 8 + 3] = hi16(v4.y);
            vv[q * 8 + 4] = lo16(v4.z); vv[q * 8 + 5] = hi16(v4.z); vv[q * 8 + 6] = lo16(v4.w); vv[q * 8 + 7] = hi16(v4.w);
        }
        float s = 0.f;
#pragma unroll
        for (int e = 0; e < 16; ++e) s += y[e];
        s = red4(s); const float mean = s * (1.0f / 64.0f);
        float qv = 0.f;
#pragma unroll
        for (int e = 0; e < 16; ++e) { const float dd = y[e] - mean; qv += dd * dd; }
        qv = red4(qv); const float rstd = rsqrtf(qv * (1.0f / 64.0f) + 64e-5f);
        const float dsum = DOT[(size_t)r * NH + h] + DOT[((size_t)TG + r) * NH + h];
        unsigned o[8];
        const u32x4 g0 = *(const u32x4*)(Gb + (size_t)r * D + c), g1 = *(const u32x4*)(Gb + (size_t)r * D + c + 8);
        const unsigned gw[8] = {g0.x, g0.y, g0.z, g0.w, g1.x, g1.y, g1.z, g1.w};
#pragma unroll
        for (int e = 0; e < 16; e += 2) {
            const float o0 = ((y[e] - mean) * rstd * lg[e] + lb[e] + vv[e] * dsum) * lo16(gw[e >> 1]);
            const float o1 = ((y[e + 1] - mean) * rstd * lg[e + 1] + lb[e + 1] + vv[e + 1] * dsum) * hi16(gw[e >> 1]);
            o[e >> 1] = pk2(o0, o1);
        }
        *(u32x4*)(YG + (size_t)r * D + c) = (u32x4){o[0], o[1], o[2], o[3]};
        *(u32x4*)(YG + (size_t)r * D + c + 8) = (u32x4){o[4], o[5], o[6], o[7]};
    }
}
__device__ __forceinline__ void phase_norm2(const Frame& F, int g, int layer, bool dry = false) {
    bf16_t* X = F.wsp<bf16_t>(WS_X); bf16_t* HM = F.ar<bf16_t>(AR_HM); const bf16_t* Ob = F.ar<bf16_t>(AR_O);
    int* lists = dry ? F.ar<int>(AR_YM0) : F.ar<int>(AR_LIST); float* lwt = dry ? F.ar<float>(AR_YM0) + (size_t)32 * TG : F.ar<float>(AR_LW);
    unsigned* cnt = (unsigned*)(F.ws + WS_CTL + CTL_CNT_OFF) + (((size_t)g * 4 + layer) * 32 + (dry ? NG * 4 * 32 : 0)) * 16;
    LAS float* wr = (LAS float*)F.lds;
    __syncthreads();
    for (int i = F.tid; i < D * NEXP / 4; i += NTHREADS) { const int c = i >> 2, e4 = i & 3; const int rho = (c & ~255) + (c & 3) * 64 + ((c & 255) >> 2);
        *(LAS f32x4*)(wr + rho * 20 + e4 * 4) = *(const f32x4*)(F.in(36) + i * 4); }
    __syncthreads();
    const float* rbias = F.in(37);
    float rb4[4];
#pragma unroll
    for (int e = 0; e < 4; ++e) rb4[e] = rbias[(F.lane >> 4) * 4 + e];
    const bool ctx_out = layer < 2;
    LAS int* lcnt = (LAS int*)(F.lds + LDS_MISC + 512);
    LAS int* lbase = (LAS int*)(F.lds + LDS_MISC + 640);
    LAS int* rec = (LAS int*)(F.lds + 81920);
    const int rpb = (TG + F.G - 1) / F.G, rbeg = F.bid * rpb, rend = (rbeg + rpb) < TG ? (rbeg + rpb) : TG;
    const int niter = (rpb + NWAVES - 1) / NWAVES;
    int key = -1; f32x4 cg[4], cA[4], cB[4];
#pragma unroll
    for (int q = 0; q < 4; ++q) { cg[q] = (f32x4){0.f, 0.f, 0.f, 0.f}; cA[q] = cg[q]; cB[q] = cg[q]; }
    for (int it0 = 0; it0 < niter; it0 += 64) {
        if (F.tid < 32) lcnt[F.tid] = 0;
        __syncthreads();
        const int itn = (niter - it0) < 64 ? (niter - it0) : 64;
        for (int itl = 0; itl < itn; ++itl) {
            const int r = rbeg + (it0 + itl) * NWAVES + F.wave;
            const int bl = r / LT, t = r % LT, b = g * BG + bl; const bool isctx = t < LC;
            const int slot = itl * NWAVES + F.wave;
            if (r >= rend || (isctx && !ctx_out)) { if (F.lane == 0) rec[slot * 4] = -1; continue; }
            if (key != b * 2 + (int)isctx) {
                key = b * 2 + (int)isctx;
#pragma unroll
                for (int q = 0; q < 4; ++q) { const int c = q * 256 + F.lane * 4;
                    cg[q] = *(const f32x4*)((isctx ? F.modC(layer, 2) : F.modL(layer, b, 2)) + c);
                    const f32x4 gv = *(const f32x4*)(F.in(7) + (size_t)layer * D + c), cv = *(const f32x4*)((isctx ? F.modC(layer, 4) : F.modL(layer, b, 4)) + c);
                    cA[q] = gv * (1.0f + cv); cB[q] = *(const f32x4*)((isctx ? F.modC(layer, 3) : F.modL(layer, b, 3)) + c); }
            }
            f32x4 x[4]; float ss = 0.f;
#pragma unroll
            for (int q = 0; q < 4; ++q) { const int c = q * 256 + F.lane * 4;
                { const u32x2 xw = *(const u32x2*)(X + (size_t)r * D + c); x[q] = (f32x4){lo16(xw.x), hi16(xw.x), lo16(xw.y), hi16(xw.y)}; }
                const u32x2 ob = *(const u32x2*)(Ob + (size_t)r * D + c); const f32x4 gv = cg[q];
                const f32x4 xo = x[q];
                x[q][0] += gv[0] * lo16(ob.x); x[q][1] += gv[1] * hi16(ob.x); x[q][2] += gv[2] * lo16(ob.y); x[q][3] += gv[3] * hi16(ob.y);
                { const f32x4 xs = dry ? xo : x[q]; u32x2 xw; xw.x = pk2(xs[0], xs[1]); xw.y = pk2(xs[2], xs[3]); *(u32x2*)(X + (size_t)r * D + c) = xw; }
                ss += x[q][0] * x[q][0] + x[q][1] * x[q][1] + x[q][2] * x[q][2] + x[q][3] * x[q][3]; }
            ss = wave_sum_dpp(ss);
            const float rstd = rsqrtf(ss * (1.0f / D) + 1e-6f);
            float lg[16];
#pragma unroll
            for (int e = 0; e < 16; ++e) lg[e] = 0.f;
#pragma unroll
            for (int q = 0; q < 4; ++q) { const int c = q * 256 + F.lane * 4;
                const f32x4 h = x[q] * rstd * cA[q] + cB[q];
                u32x2 w; w.x = pk2(h[0], h[1]); w.y = pk2(h[2], h[3]);
                *(u32x2*)(HM + (size_t)r * D + c) = w;
#pragma unroll
                for (int j = 0; j < 4; ++j) {
#pragma unroll
                    for (int e4 = 0; e4 < 4; ++e4) { const f32x4 wv = *(const LAS f32x4*)(wr + (q * 256 + j * 64 + F.lane) * 20 + e4 * 4);
                        lg[e4 * 4 + 0] += h[j] * wv[0]; lg[e4 * 4 + 1] += h[j] * wv[1]; lg[e4 * 4 + 2] += h[j] * wv[2]; lg[e4 * 4 + 3] += h[j] * wv[3]; } }
            }
            float m8[8], xg[4];
#pragma unroll
            for (int e = 0; e < 8; ++e) { const auto sw = __builtin_amdgcn_permlane32_swap(__float_as_uint(lg[e]), __float_as_uint(lg[e + 8]), false, false); m8[e] = __uint_as_float(sw[0]) + __uint_as_float(sw[1]); }
#pragma unroll
            for (int e = 0; e < 4; ++e) { const auto sw = __builtin_amdgcn_permlane16_swap(__float_as_uint(m8[e]), __float_as_uint(m8[e + 4]), false, false); xg[e] = red16(__uint_as_float(sw[0]) + __uint_as_float(sw[1])); }
            float sc_[4], bs[4];
#pragma unroll
            for (int e = 0; e < 4; ++e) { sc_[e] = sigmoidf_(xg[e]); bs[e] = sc_[e] + rb4[e]; }
            const float hi01 = fmaxf(bs[0], bs[1]), lo01 = fminf(bs[0], bs[1]), hi23 = fmaxf(bs[2], bs[3]), lo23 = fminf(bs[2], bs[3]);
            const float gsc = fmaxf(hi01, hi23) + fmaxf(fminf(hi01, hi23), fmaxf(lo01, lo23));
            const float g0s = __int_as_float(__builtin_amdgcn_readlane(__float_as_int(gsc), 0)), g1s = __int_as_float(__builtin_amdgcn_readlane(__float_as_int(gsc), 16));
            const float g2s = __int_as_float(__builtin_amdgcn_readlane(__float_as_int(gsc), 32)), g3s = __int_as_float(__builtin_amdgcn_readlane(__float_as_int(gsc), 48));
            const bool c10 = g1s > g0s, c32 = g3s > g2s; const float v01 = c10 ? g1s : g0s, v23 = c32 ? g3s : g2s; const bool chi = v23 > v01;
            const int best = __builtin_amdgcn_readfirstlane(chi ? (c32 ? 3 : 2) : (c10 ? 1 : 0));
            float cb[4], cs[4];
#pragma unroll
            for (int e = 0; e < 4; ++e) { cb[e] = __int_as_float(__builtin_amdgcn_readlane(__float_as_int(bs[e]), best * 16)); cs[e] = __int_as_float(__builtin_amdgcn_readlane(__float_as_int(sc_[e]), best * 16)); }
            const bool d10 = cb[1] > cb[0], d32 = cb[3] > cb[2]; const float w01 = d10 ? cb[1] : cb[0], w23 = d32 ? cb[3] : cb[2]; const bool dhi = w23 > w01;
            const int j1 = dhi ? (d32 ? 3 : 2) : (d10 ? 1 : 0);
            const float e0 = j1 == 0 ? -1e30f : cb[0], e1 = j1 == 1 ? -1e30f : cb[1], e2 = j1 == 2 ? -1e30f : cb[2], e3 = j1 == 3 ? -1e30f : cb[3];
            const bool f10 = e1 > e0, f32_ = e3 > e2; const float u01 = f10 ? e1 : e0, u23 = f32_ ? e3 : e2; const bool fhi = u23 > u01;
            const int j2 = fhi ? (f32_ ? 3 : 2) : (f10 ? 1 : 0);
            const float s1 = (j1 & 2) ? ((j1 & 1) ? cs[3] : cs[2]) : ((j1 & 1) ? cs[1] : cs[0]);
            const float s2 = (j2 & 2) ? ((j2 & 1) ? cs[3] : cs[2]) : ((j2 & 1) ? cs[1] : cs[0]);
            const float inv = __builtin_amdgcn_rcpf(s1 + s2);
            if (F.lane == 0) {
                const int l1 = (best * 4 + j1) * 2 + 0, l2 = (best * 4 + j2) * 2 + 1;
                const int p1 = __hip_atomic_fetch_add(lcnt + l1, 1, __ATOMIC_RELAXED, __HIP_MEMORY_SCOPE_WORKGROUP);
                const int p2 = __hip_atomic_fetch_add(lcnt + l2, 1, __ATOMIC_RELAXED, __HIP_MEMORY_SCOPE_WORKGROUP);
                rec[slot * 4 + 0] = l1 | (p1 << 8); rec[slot * 4 + 1] = l2 | (p2 << 8);
                rec[slot * 4 + 2] = __float_as_int(s1 * inv); rec[slot * 4 + 3] = __float_as_int(s2 * inv);
            }
        }
        __syncthreads();
        if (F.tid < 32) { const int c = lcnt[F.tid]; lbase[F.tid] = c ? (int)atomicAdd(&cnt[F.tid * 16], (unsigned)c) : 0; }
        __syncthreads();
        for (int slot = F.tid; slot < itn * NWAVES; slot += NTHREADS) {
            const int a0 = rec[slot * 4 + 0]; if (a0 < 0) continue;
            const int a1 = rec[slot * 4 + 1];
            const int r = rbeg + (it0 + slot / NWAVES) * NWAVES + (slot % NWAVES);
            const int l1 = a0 & 255, l2 = a1 & 255; const int q1 = lbase[l1] + (a0 >> 8), q2 = lbase[l2] + (a1 >> 8);
            lists[(size_t)l1 * TG + q1] = r; lwt[(size_t)l1 * TG + q1] = __int_as_float(rec[slot * 4 + 2]);
            lists[(size_t)l2 * TG + q2] = r; lwt[(size_t)l2 * TG + q2] = __int_as_float(rec[slot * 4 + 3]);
        }
        __syncthreads();
    }
}
__device__ __forceinline__ int moe_tables(const Frame& F, int g, int layer) {
    LAS int* cn = (LAS int*)(F.lds + LDS_MISC + 64); LAS int* tb = (LAS int*)(F.lds + LDS_MISC + 192);
    const unsigned* cnt = (const unsigned*)(F.ws + WS_CTL + CTL_CNT_OFF) + ((size_t)g * 4 + layer) * 32 * 16;
    __syncthreads();
    if (F.tid < 32) cn[F.tid] = (int)__hip_atomic_load(cnt + F.tid * 16, __ATOMIC_RELAXED, __HIP_MEMORY_SCOPE_AGENT);
    __syncthreads();
    if (F.tid == 0) { int acc = 0; for (int l = 0; l < 32; ++l) { tb[l] = acc; acc += (cn[l] + 255) >> 8; } tb[32] = acc; }
    __syncthreads();
    return tb[32];
}

constexpr int SC_OPB = 6 * 4096;
constexpr int SC_HALF = 2 * SC_OPB + 4096 + 4096;
static_assert(2 * SC_HALF <= LDS_STAGE, "scan lds");
__device__ __forceinline__ int scan_tok(int d, int s) { return d == 0 ? s : (s < LC ? (LC - 1 - s) : (LT + LC - 1 - s)); }
__device__ __forceinline__ void phase_scan(const Frame& F, int a, const bf16_t* V) {
    const bf16_t* R = F.ar<bf16_t>(AR_R); const bf16_t* Kb = F.ar<bf16_t>(AR_K); const bf16_t* L1 = F.ar<bf16_t>(AR_L1);
    const int half = F.wave >> 2, q = F.wave & 3, lane = F.lane, li = q * 64 + lane;
    LAS unsigned char* hb = F.lds + half * SC_HALF;
    LAS float* aT = (LAS float*)(hb + 2 * SC_OPB); LAS float* ybuf = (LAS float*)(hb + 2 * SC_OPB + 4096);
    const int arr = q >> 1, ntl = (q & 1) * 2;
    const int i = lane >> 3, j = lane & 7, r0 = 16 * q + 2 * i;
    const int tB = li >> 4, k4 = (li & 15) * 4;
    for (int pr = F.bid; pr < BG * 16; pr += F.G) {
        const int bl = pr >> 4, d = (pr >> 3) & 1, hp = pr & 7, h = hp * 2 + half;
        bf16_t* Yd = F.ar<bf16_t>(d ? AR_Y1 : AR_Y0); float* DOT = F.ar<float>(AR_DOT) + (size_t)d * TG * NH;
        const size_t rowb = (size_t)bl * LT;
        const bf16_t* W2 = (arr == 0 ? F.wsp<bf16_t>(WS_W2T) : F.wsp<bf16_t>(WS_A2T)) + ((size_t)a * 2 + d) * D * 64;
        bf16x8 Bf[2][2]; float bias[2];
#pragma unroll
        for (int nt = 0; nt < 2; ++nt) { const int cc = h * 64 + (ntl + nt) * 16 + (lane & 15);
            bias[nt] = (arr == 0 ? F.in(13) : F.in(16))[((size_t)a * 2 + d) * D + cc];
#pragma unroll
            for (int s = 0; s < 2; ++s) Bf[nt][s] = *(const bf16x8*)(W2 + (size_t)cc * 64 + 32 * s + 8 * (lane >> 4)); }
        const f32x4 kkc = *(const f32x4*)(F.in(24) + (size_t)a * D + h * 64 + k4), kac = *(const f32x4*)(F.in(25) + (size_t)a * D + h * 64 + k4), rkc = *(const f32x4*)(F.in(26) + (size_t)a * D + h * 64 + k4);
        const int acol = arr * 128 + d * 64 + 8 * (lane >> 4);
        float S0[8], S1[8];
#pragma unroll
        for (int c = 0; c < 8; ++c) { S0[c] = 0.f; S1[c] = 0.f; }
        bf16x8 Af[2]; u32x2 kraw, rraw, vraw;
#define SC_LOAD(ch) do { const size_t rowA = rowb + scan_tok(d, (ch) * 16 + (lane & 15)); \
        Af[0] = *(const bf16x8*)(L1 + rowA * 512 + acol); Af[1] = *(const bf16x8*)(L1 + rowA * 512 + acol + 32); \
        const size_t rowBq = (rowb + scan_tok(d, (ch) * 16 + tB)) * D + h * 64 + k4; \
        kraw = *(const u32x2*)(Kb + rowBq); rraw = *(const u32x2*)(R + rowBq); vraw = *(const u32x2*)(V + rowBq); } while (0)
#define SC_PASSA(buf) do { LAS float* op = (LAS float*)(hb + (buf) * SC_OPB); \
        _Pragma("unroll") for (int nt = 0; nt < 2; ++nt) { f32x4 ac = (f32x4){0.f, 0.f, 0.f, 0.f}; \
            ac = __builtin_amdgcn_mfma_f32_16x16x32_bf16(Af[0], Bf[nt][0], ac, 0, 0, 0); ac = __builtin_amdgcn_mfma_f32_16x16x32_bf16(Af[1], Bf[nt][1], ac, 0, 0, 0); \
            const int n = (ntl + nt) * 16 + (lane & 15); \
              \
            f32x4 sg; _Pragma("unroll") for (int rg = 0; rg < 4; ++rg) sg[rg] = sigmoidf_(ac[rg] + bias[nt]); \
            if (arr == 0) { _Pragma("unroll") for (int rg = 0; rg < 4; ++rg) op[1024 + ((lane >> 4) * 4 + rg) * 64 + n] = __expf(-0.60653066f * sg[rg]); } \
            else { _Pragma("unroll") for (int rg = 0; rg < 4; ++rg) aT[((lane >> 4) * 4 + rg) * 64 + n] = sg[rg]; } } } while (0)
#define SC_PASSB(ch, buf) do { LAS float* op = (LAS float*)(hb + (buf) * SC_OPB); \
        const float kf[4] = {lo16(kraw.x), hi16(kraw.x), lo16(kraw.y), hi16(kraw.y)}; const float rf[4] = {lo16(rraw.x), hi16(rraw.x), lo16(rraw.y), hi16(rraw.y)}; \
        const float vf[4] = {lo16(vraw.x), hi16(vraw.x), lo16(vraw.y), hi16(vraw.y)}; \
        const f32x4 av = *(const LAS f32x4*)(aT + tB * 64 + k4); \
        float kq[4], ssq = 0.f; _Pragma("unroll") for (int e = 0; e < 4; ++e) { kq[e] = kf[e] * kkc[e]; ssq += kq[e] * kq[e]; } \
        ssq = red16(ssq); const float inv = __builtin_amdgcn_rsqf(fmaxf(ssq, 1e-24f)); \
        f32x4 o_kk, o_kka, o_kd, o_r, o_v; float dp = 0.f; \
        _Pragma("unroll") for (int e = 0; e < 4; ++e) { const float kkv = kq[e] * inv; const float kd = kf[e] * (1.0f + (av[e] - 1.0f) * kac[e]); \
            o_kk[e] = kkv; o_kka[e] = kkv * av[e]; o_kd[e] = kd; o_r[e] = rf[e]; o_v[e] = vf[e]; dp += rf[e] * kd * rkc[e]; } \
        dp = red16(dp); \
        if ((li & 15) == 0) DOT[(rowb + scan_tok(d, (ch) * 16 + tB)) * NH + h] = dp; \
        *(LAS f32x4*)(op + 0 * 1024 + tB * 64 + k4) = o_kk; *(LAS f32x4*)(op + 2 * 1024 + tB * 64 + k4) = o_kka; *(LAS f32x4*)(op + 3 * 1024 + tB * 64 + k4) = o_kd; \
        *(LAS f32x4*)(op + 4 * 1024 + tB * 64 + k4) = o_r; *(LAS f32x4*)(op + 5 * 1024 + tB * 64 + k4) = o_v; } while (0)
        __syncthreads();
        SC_LOAD(0);
        SC_PASSA(0);
        __syncthreads();
        SC_PASSB(0, 0);
        __syncthreads();
        constexpr int NCH = LT / 16;
        for (int ch = 0; ch < NCH; ++ch) {
            const int buf = ch & 1;
            if (ch + 1 < NCH) SC_LOAD(ch + 1);
            const LAS float* op = (const LAS float*)(hb + buf * SC_OPB);
            f32x4 cA[5], cB[5], nA[5], nB[5]; f32x2 cv, nv;
#define SC_OPLOAD(dA, dB, dv, t) do { const LAS float* ob_ = op + (t) * 64 + j * 8; \
                _Pragma("unroll") for (int q_ = 0; q_ < 5; ++q_) { dA[q_] = *(const LAS f32x4*)(ob_ + q_ * 1024); dB[q_] = *(const LAS f32x4*)(ob_ + q_ * 1024 + 4); } \
                dv = *(const LAS f32x2*)(op + 5 * 1024 + (t) * 64 + r0); } while (0)
            SC_OPLOAD(cA, cB, cv, 0);
#pragma unroll
            for (int t = 0; t < 16; ++t) {
                if (t + 1 < 16) SC_OPLOAD(nA, nB, nv, t + 1);
                const float kk[8] = {cA[0][0], cA[0][1], cA[0][2], cA[0][3], cB[0][0], cB[0][1], cB[0][2], cB[0][3]};
                const float dc[8] = {cA[1][0], cA[1][1], cA[1][2], cA[1][3], cB[1][0], cB[1][1], cB[1][2], cB[1][3]};
                const float ka[8] = {cA[2][0], cA[2][1], cA[2][2], cA[2][3], cB[2][0], cB[2][1], cB[2][2], cB[2][3]};
                const float kd[8] = {cA[3][0], cA[3][1], cA[3][2], cA[3][3], cB[3][0], cB[3][1], cB[3][2], cB[3][3]};
                const float rr[8] = {cA[4][0], cA[4][1], cA[4][2], cA[4][3], cB[4][0], cB[4][1], cB[4][2], cB[4][3]};
                float sa0 = (S0[0] * kk[0] + S0[1] * kk[1]) + (S0[2] * kk[2] + S0[3] * kk[3]) + ((S0[4] * kk[4] + S0[5] * kk[5]) + (S0[6] * kk[6] + S0[7] * kk[7]));
                float sa1 = (S1[0] * kk[0] + S1[1] * kk[1]) + (S1[2] * kk[2] + S1[3] * kk[3]) + ((S1[4] * kk[4] + S1[5] * kk[5]) + (S1[6] * kk[6] + S1[7] * kk[7]));
                sa0 = red8(sa0); sa1 = red8(sa1);
#pragma unroll
                for (int c = 0; c < 8; ++c) {
                    S0[c] = S0[c] * dc[c] + (cv[0] * kd[c] - sa0 * ka[c]);
                    S1[c] = S1[c] * dc[c] + (cv[1] * kd[c] - sa1 * ka[c]);
                }
                float y0 = (S0[0] * rr[0] + S0[1] * rr[1]) + (S0[2] * rr[2] + S0[3] * rr[3]) + ((S0[4] * rr[4] + S0[5] * rr[5]) + (S0[6] * rr[6] + S0[7] * rr[7]));
                float y1 = (S1[0] * rr[0] + S1[1] * rr[1]) + (S1[2] * rr[2] + S1[3] * rr[3]) + ((S1[4] * rr[4] + S1[5] * rr[5]) + (S1[6] * rr[6] + S1[7] * rr[7]));
                y0 = red8(y0); y1 = red8(y1);
                if (j == 0) *(LAS f32x2*)(ybuf + t * 64 + r0) = (f32x2){y0, y1};
#pragma unroll
                for (int q_ = 0; q_ < 5; ++q_) { cA[q_] = nA[q_]; cB[q_] = nB[q_]; }
                cv = nv;
            }
#undef SC_OPLOAD
            __syncthreads();
            {
                const f32x4 yv = *(const LAS f32x4*)(ybuf + tB * 64 + k4);
                u32x2 w; w.x = pk2(yv[0], yv[1]); w.y = pk2(yv[2], yv[3]);
                *(u32x2*)(Yd + (rowb + scan_tok(d, ch * 16 + tB)) * D + h * 64 + k4) = w;
            }
            if (ch + 1 < NCH) SC_PASSA(buf ^ 1);
            __syncthreads();
            if (ch + 1 < NCH) SC_PASSB(ch + 1, buf ^ 1);
            __syncthreads();
        }
#undef SC_LOAD
#undef SC_PASSA
#undef SC_PASSB
    }
}

constexpr int S4_KKP = 0, S4_RPP = 2048, S4_KDP = 4096, S4_KAP = 6144, S4_KDT = 8192, S4_KAT = 10496, S4_VT = 12800, S4_A1 = 15104, S4_B1 = 15616, S4_B2 = 16128,
              S4_A2 = 16640, S4_P15 = 17664, S4_LI = 17920, S4_LX = 22016, S4_AT = 26112, S4_YB = 30208, S4_HALF = 34304;
static_assert(2 * S4_HALF <= LDS_STAGE, "scan4 lds");
#define MF16(a, b, c) __builtin_amdgcn_mfma_f32_16x16x32_bf16((a), (b), (c), 0, 0, 0)
__device__ __forceinline__ bf16x8 mkfrag(unsigned a, unsigned b, unsigned c, unsigned d) { return __builtin_bit_cast(bf16x8, (u32x4){a, b, c, d}); }
__device__ __forceinline__ void phase_scan4(const Frame& F, int a, const bf16_t* V) {
    const bf16_t* R = F.ar<bf16_t>(AR_R); const bf16_t* Kb = F.ar<bf16_t>(AR_K); const bf16_t* L1 = F.ar<bf16_t>(AR_L1);
    const int half = F.wave >> 2, q = F.wave & 3, lane = F.lane, li = q * 64 + lane;
    LAS unsigned char* hb = F.lds + half * S4_HALF;
    const int arr = q >> 1, ntl = (q & 1) * 2;
    const int g = lane >> 4, j = lane & 15;
    const int tB = li >> 4, k4 = (li & 15) * 4;
    const int poff = (tB * 64 + (k4 >> 5) * 32 + ((k4 >> 2) & 3) * 8 + ((k4 >> 4) & 1) * 4) * 2;
    const float gm0 = g == 0 ? 1.f : 0.f, gm1 = g == 1 ? 1.f : 0.f, gm2 = g == 2 ? 1.f : 0.f, gm3 = g == 3 ? 1.f : 0.f;
    f32x2 eye2[8];
#pragma unroll
    for (int p_ = 0; p_ < 8; ++p_) eye2[p_] = (f32x2){j == 2 * p_ ? 1.f : 0.f, j == 2 * p_ + 1 ? 1.f : 0.f};
    for (int pr = F.bid; pr < BG * 16; pr += F.G) {
        const int bl = pr >> 4, d = (pr >> 3) & 1, hp = pr & 7, h = hp * 2 + half;
        bf16_t* Yd = F.ar<bf16_t>(d ? AR_Y1 : AR_Y0); float* DOT = F.ar<float>(AR_DOT) + (size_t)d * TG * NH;
        const size_t rowb = (size_t)bl * LT;
        const bf16_t* W2 = (arr == 0 ? F.wsp<bf16_t>(WS_W2T) : F.wsp<bf16_t>(WS_A2T)) + ((size_t)a * 2 + d) * D * 64;
        const float* b0p = (arr == 0 ? F.in(13) : F.in(16)) + ((size_t)a * 2 + d) * D + h * 64;
        const int acol = arr * 128 + d * 64 + 8 * (lane >> 4);
        f32x4 Cb[4];
#pragma unroll
        for (int b = 0; b < 4; ++b) Cb[b] = (f32x4){0.f, 0.f, 0.f, 0.f};
        bf16x8 Af[2]; u32x2 kraw, rraw, vraw;
#define SC_LOAD(ch) do { const size_t rowA = rowb + scan_tok(d, (ch) * 16 + (lane & 15)); \
        Af[0] = *(const bf16x8*)(L1 + rowA * 512 + acol); Af[1] = *(const bf16x8*)(L1 + rowA * 512 + acol + 32); \
        const size_t rowBq = (rowb + scan_tok(d, (ch) * 16 + tB)) * D + h * 64 + k4; \
        kraw = *(const u32x2*)(Kb + rowBq); rraw = *(const u32x2*)(R + rowBq); vraw = *(const u32x2*)(V + rowBq); } while (0)
#define SC_PASSA() do { \
        _Pragma("unroll") for (int nt = 0; nt < 2; ++nt) { f32x4 ac = (f32x4){0.f, 0.f, 0.f, 0.f}; \
            const int n = (ntl + nt) * 16 + (lane & 15); const float bias_ = b0p[n]; \
            const bf16x8 bf0_ = *(const bf16x8*)(W2 + (size_t)(h * 64 + n) * 64 + 8 * (lane >> 4)), bf1_ = *(const bf16x8*)(W2 + (size_t)(h * 64 + n) * 64 + 32 + 8 * (lane >> 4)); \
            ac = MF16(Af[0], bf0_, ac); ac = MF16(Af[1], bf1_, ac); \
            f32x4 sg; _Pragma("unroll") for (int rg = 0; rg < 4; ++rg) sg[rg] = sigmoidf_(ac[rg] + bias_); \
            if (arr == 0) { \
                const float l0 = -0.60653066f * sg[0], l1 = -0.60653066f * sg[1], l2 = -0.60653066f * sg[2], l3 = -0.60653066f * sg[3]; \
                const float p0 = l0, p1 = p0 + l1, p2 = p1 + l2, p3 = p2 + l3;                         \
                const auto s16 = __builtin_amdgcn_permlane16_swap(__float_as_uint(p3), __float_as_uint(p3), false, false);     \
                const float sv = __uint_as_float(s16[0]), pq = sv + __uint_as_float(s16[1]); \
                const auto s32 = __builtin_amdgcn_permlane32_swap(__float_as_uint(pq), __float_as_uint(pq), false, false);     \
                const float E = ((g & 1) ? sv : 0.f) + ((g & 2) ? __uint_as_float(s32[0]) : 0.f);      \
                LAS float* li_ = (LAS float*)(hb + S4_LI) + (4 * g) * 64 + n; LAS float* lx_ = (LAS float*)(hb + S4_LX) + (4 * g) * 64 + n; \
                li_[0] = E + p0; li_[64] = E + p1; li_[128] = E + p2; li_[192] = E + p3; lx_[0] = E; lx_[64] = E + p0; lx_[128] = E + p1; lx_[192] = E + p2; \
            } else { _Pragma("unroll") for (int rg = 0; rg < 4; ++rg) ((LAS float*)(hb + S4_AT))[(4 * g + rg) * 64 + n] = sg[rg]; } } } while (0)
#define SC_PASSB(ch) do { \
        const f32x4 kkc = *(const f32x4*)(F.in(24) + (size_t)a * D + h * 64 + k4), kac = *(const f32x4*)(F.in(25) + (size_t)a * D + h * 64 + k4), rkc = *(const f32x4*)(F.in(26) + (size_t)a * D + h * 64 + k4); \
        const float kf[4] = {lo16(kraw.x), hi16(kraw.x), lo16(kraw.y), hi16(kraw.y)}; const float rf[4] = {lo16(rraw.x), hi16(rraw.x), lo16(rraw.y), hi16(rraw.y)}; \
        const f32x4 av = *(const LAS f32x4*)((LAS float*)(hb + S4_AT) + tB * 64 + k4), Li = *(const LAS f32x4*)((LAS float*)(hb + S4_LI) + tB * 64 + k4), Lx = *(const LAS f32x4*)((LAS float*)(hb + S4_LX) + tB * 64 + k4); \
        float kq[4], ssq = 0.f; _Pragma("unroll") for (int e = 0; e < 4; ++e) { kq[e] = kf[e] * kkc[e]; ssq += kq[e] * kq[e]; } \
        ssq = red16(ssq); const float inv = __builtin_amdgcn_rsqf(fmaxf(ssq, 1e-24f)); \
        float o_kk[4], o_ka[4], o_kd[4], o_r[4]; f32x4 o_p; float dp = 0.f; \
        _Pragma("unroll") for (int e = 0; e < 4; ++e) { const float Pt = __expf(Li[e]), Px = __expf(Lx[e]), iP = __builtin_amdgcn_rcpf(Pt); \
            const float kkv = kq[e] * inv; const float kd = kf[e] * (1.0f + (av[e] - 1.0f) * kac[e]); const float ka = kkv * av[e]; \
            o_kk[e] = kkv * Px; o_ka[e] = ka * iP; o_kd[e] = kd * iP; o_r[e] = rf[e] * Pt; o_p[e] = Pt; \
            dp += rf[e] * kd * rkc[e]; } \
        dp = red16(dp); \
        if ((li & 15) == 0) DOT[(rowb + scan_tok(d, (ch) * 16 + tB)) * NH + h] = dp; \
        const u32x2 w_kk = (u32x2){pk2(o_kk[0], o_kk[1]), pk2(o_kk[2], o_kk[3])}, w_r = (u32x2){pk2(o_r[0], o_r[1]), pk2(o_r[2], o_r[3])}; \
        const u32x2 w_kd = (u32x2){pk2(o_kd[0], o_kd[1]), pk2(o_kd[2], o_kd[3])}, w_ka = (u32x2){pk2(o_ka[0], o_ka[1]), pk2(o_ka[2], o_ka[3])}; \
        *(LAS u32x2*)(hb + S4_KKP + poff) = w_kk; *(LAS u32x2*)(hb + S4_RPP + poff) = w_r; *(LAS u32x2*)(hb + S4_KDP + poff) = w_kd; *(LAS u32x2*)(hb + S4_KAP + poff) = w_ka; \
        { LAS unsigned char* td = hb + S4_KDT + k4 * 36 + tB * 2; LAS unsigned char* ta = hb + S4_KAT + k4 * 36 + tB * 2; LAS unsigned char* tv = hb + S4_VT + k4 * 36 + tB * 2; \
          *(LAS unsigned short*)(td) = (unsigned short)w_kd.x; *(LAS unsigned short*)(td + 36) = (unsigned short)(w_kd.x >> 16); *(LAS unsigned short*)(td + 72) = (unsigned short)w_kd.y; *(LAS unsigned short*)(td + 108) = (unsigned short)(w_kd.y >> 16); \
          *(LAS unsigned short*)(ta) = (unsigned short)w_ka.x; *(LAS unsigned short*)(ta + 36) = (unsigned short)(w_ka.x >> 16); *(LAS unsigned short*)(ta + 72) = (unsigned short)w_ka.y; *(LAS unsigned short*)(ta + 108) = (unsigned short)(w_ka.y >> 16); \
          *(LAS unsigned short*)(tv) = (unsigned short)vraw.x; *(LAS unsigned short*)(tv + 36) = (unsigned short)(vraw.x >> 16); *(LAS unsigned short*)(tv + 72) = (unsigned short)vraw.y; *(LAS unsigned short*)(tv + 108) = (unsigned short)(vraw.y >> 16); } \
        if (tB == 15) *(LAS f32x4*)((LAS float*)(hb + S4_P15) + k4) = o_p; } while (0)
#define SC_PROD() do { const int lo_ = (q < 2 ? S4_KKP : S4_RPP) + j * 128 + g * 16, ro_ = ((q == 0 || q == 3) ? S4_KAP : S4_KDP) + j * 128 + g * 16; \
        f32x4 pa = (f32x4){0.f, 0.f, 0.f, 0.f}; \
        pa = MF16(*(const LAS bf16x8*)(hb + lo_), *(const LAS bf16x8*)(hb + ro_), pa); pa = MF16(*(const LAS bf16x8*)(hb + lo_ + 64), *(const LAS bf16x8*)(hb + ro_ + 64), pa); \
        _Pragma("unroll") for (int r_ = 0; r_ < 4; ++r_) { const int t_ = 4 * g + r_; const bool keep = (q < 2) ? (j < t_) : (j <= t_); pa[r_] = keep ? pa[r_] : 0.f; } \
        if (q == 0) { LAS float* dm = (LAS float*)(hb + S4_A2) + (4 * g) * 16 + j; dm[0] = pa[0]; dm[16] = pa[1]; dm[32] = pa[2]; dm[48] = pa[3]; } \
        else { LAS unsigned char* dm = hb + (q == 1 ? S4_A1 : (q == 2 ? S4_B1 : S4_B2)) + ((4 * g) * 16 + j) * 2; const unsigned w0_ = pk2(pa[0], pa[1]), w1_ = pk2(pa[2], pa[3]); \
            *(LAS unsigned short*)(dm) = (unsigned short)w0_; *(LAS unsigned short*)(dm + 32) = (unsigned short)(w0_ >> 16); *(LAS unsigned short*)(dm + 64) = (unsigned short)w1_; *(LAS unsigned short*)(dm + 96) = (unsigned short)(w1_ >> 16); } } while (0)
        __syncthreads();
        SC_LOAD(0);
        SC_PASSA();
        __syncthreads();
        SC_PASSB(0);
        __syncthreads();
        SC_PROD();
        __syncthreads();
        constexpr int NCH = LT / 16;
        for (int ch = 0; ch < NCH; ++ch) {
            if (ch + 1 < NCH) SC_LOAD(ch + 1);
            const bf16x8 Bs0 = mkfrag(pk2(Cb[0][0], Cb[0][1]), pk2(Cb[0][2], Cb[0][3]), pk2(Cb[1][0], Cb[1][1]), pk2(Cb[1][2], Cb[1][3]));
            const bf16x8 Bs1 = mkfrag(pk2(Cb[2][0], Cb[2][1]), pk2(Cb[2][2], Cb[2][3]), pk2(Cb[3][0], Cb[3][1]), pk2(Cb[3][2], Cb[3][3]));
            f32x4 X = (f32x4){0.f, 0.f, 0.f, 0.f}, H = (f32x4){0.f, 0.f, 0.f, 0.f};
            X = MF16(*(const LAS bf16x8*)(hb + S4_KKP + j * 128 + g * 16), Bs0, X); H = MF16(*(const LAS bf16x8*)(hb + S4_RPP + j * 128 + g * 16), Bs0, H);
            X = MF16(*(const LAS bf16x8*)(hb + S4_KKP + j * 128 + g * 16 + 64), Bs1, X); H = MF16(*(const LAS bf16x8*)(hb + S4_RPP + j * 128 + g * 16 + 64), Bs1, H);
            f32x2 ac2[8];
#pragma unroll
            for (int p_ = 0; p_ < 8; ++p_) ac2[p_] = eye2[p_];
            float Mr[16];
            {
                f32x4 rw[7][4];
#pragma unroll
                for (int u = 15; u >= 9; --u)
#pragma unroll
                    for (int x_ = 0; x_ * 4 < u; ++x_) rw[u - 9][x_] = *(const LAS f32x4*)((LAS float*)(hb + S4_A2) + u * 16 + 4 * x_);
                __builtin_amdgcn_sched_barrier(0);
#pragma unroll
                for (int u = 15; u >= 9; --u) {
                    const float mu = ac2[u >> 1][u & 1]; Mr[u] = mu;
#pragma unroll
                    for (int x_ = 0; x_ * 4 < u; ++x_) {
                        const f32x4 av_ = rw[u - 9][x_];
                        ac2[2 * x_] = ac2[2 * x_] - (f32x2){mu, mu} * (f32x2){av_[0], av_[1]};
                        if (4 * x_ + 2 < u) ac2[2 * x_ + 1] = ac2[2 * x_ + 1] - (f32x2){mu, mu} * (f32x2){av_[2], av_[3]};
                    }
                }
            }
            {
                f32x4 rw[8][2];
#pragma unroll
                for (int u = 8; u >= 1; --u)
#pragma unroll
                    for (int x_ = 0; x_ * 4 < u; ++x_) rw[u - 1][x_] = *(const LAS f32x4*)((LAS float*)(hb + S4_A2) + u * 16 + 4 * x_);
                __builtin_amdgcn_sched_barrier(0);
#pragma unroll
                for (int u = 8; u >= 1; --u) {
                    const float mu = ac2[u >> 1][u & 1]; Mr[u] = mu;
#pragma unroll
                    for (int x_ = 0; x_ * 4 < u; ++x_) {
                        const f32x4 av_ = rw[u - 1][x_];
                        ac2[2 * x_] = ac2[2 * x_] - (f32x2){mu, mu} * (f32x2){av_[0], av_[1]};
                        if (4 * x_ + 2 < u) ac2[2 * x_ + 1] = ac2[2 * x_ + 1] - (f32x2){mu, mu} * (f32x2){av_[2], av_[3]};
                    }
                }
            }
            Mr[0] = ac2[0][0];
            const u32x2 vw = (u32x2){*(const LAS unsigned*)(hb + S4_VT + (16 * q + j) * 36 + 8 * g), *(const LAS unsigned*)(hb + S4_VT + (16 * q + j) * 36 + 8 * g + 4)};
            const bf16x8 Bv = mkfrag(vw.x, vw.y, 0u, 0u);
            {
                const u32x2 a1w = *(const LAS u32x2*)(hb + S4_A1 + (j * 16 + 4 * g) * 2), b1w = *(const LAS u32x2*)(hb + S4_B1 + (j * 16 + 4 * g) * 2);
                X = MF16(mkfrag(a1w.x, a1w.y, 0u, 0u), Bv, X); H = MF16(mkfrag(b1w.x, b1w.y, 0u, 0u), Bv, H);
            }
            float mA[4];
#pragma unroll
            for (int r_ = 0; r_ < 4; ++r_) mA[r_] = (Mr[r_] * gm0 + Mr[4 + r_] * gm1) + (Mr[8 + r_] * gm2 + Mr[12 + r_] * gm3);
            f32x4 SA = (f32x4){0.f, 0.f, 0.f, 0.f};
            SA = MF16(mkfrag(pk2(mA[0], mA[1]), pk2(mA[2], mA[3]), 0u, 0u), mkfrag(pk2(X[0], X[1]), pk2(X[2], X[3]), 0u, 0u), SA);
            const bf16x8 Bn = mkfrag(pk2(-SA[0], -SA[1]), pk2(-SA[2], -SA[3]), 0u, 0u);
            {
                const u32x2 b2w = *(const LAS u32x2*)(hb + S4_B2 + (j * 16 + 4 * g) * 2);
                H = MF16(mkfrag(b2w.x, b2w.y, 0u, 0u), Bn, H);
                LAS float* yb = (LAS float*)(hb + S4_YB) + (4 * g) * 64 + 16 * q + j; yb[0] = H[0]; yb[64] = H[1]; yb[128] = H[2]; yb[192] = H[3];
            }
#pragma unroll
            for (int b = 0; b < 4; ++b) {
                const u32x2 kdw = (u32x2){*(const LAS unsigned*)(hb + S4_KDT + (16 * b + j) * 36 + 8 * g), *(const LAS unsigned*)(hb + S4_KDT + (16 * b + j) * 36 + 8 * g + 4)};
                const u32x2 kaw = (u32x2){*(const LAS unsigned*)(hb + S4_KAT + (16 * b + j) * 36 + 8 * g), *(const LAS unsigned*)(hb + S4_KAT + (16 * b + j) * 36 + 8 * g + 4)};
                Cb[b] = MF16(mkfrag(kdw.x, kdw.y, 0u, 0u), Bv, Cb[b]);
                Cb[b] = MF16(mkfrag(kaw.x, kaw.y, 0u, 0u), Bn, Cb[b]);
            }
#pragma unroll
            for (int b = 0; b < 4; ++b) { const f32x4 pv = *(const LAS f32x4*)((LAS float*)(hb + S4_P15) + 16 * b + 4 * g); Cb[b] = Cb[b] * pv; }
            if (ch + 1 < NCH) SC_PASSA();
            __syncthreads();
            {
                const f32x4 yv = *(const LAS f32x4*)((LAS float*)(hb + S4_YB) + tB * 64 + k4);
                u32x2 w; w.x = pk2(yv[0], yv[1]); w.y = pk2(yv[2], yv[3]);
                *(u32x2*)(Yd + (rowb + scan_tok(d, ch * 16 + tB)) * D + h * 64 + k4) = w;
            }
            if (ch + 1 < NCH) {
                SC_PASSB(ch + 1);
                __syncthreads();
                SC_PROD();
                __syncthreads();
            }
        }
#undef SC_LOAD
#undef SC_PASSA
#undef SC_PASSB
#undef SC_PROD
    }
}

__device__ __forceinline__ void phase_sgstats(const Frame& F, int layer) {
    const bf16_t* Z = F.ar<bf16_t>(AR_Z); float* ST = F.ar<float>(AR_ST);
    for (int r = F.bid * NWAVES + F.wave; r < TG; r += F.G * NWAVES) {
        const int t = r % LT; if (t < LC && layer >= 3) continue;
        float x[32];
#pragma unroll
        for (int q = 0; q < 4; ++q) { const u32x4 w = *(const u32x4*)(Z + (size_t)r * 4096 + 2048 + q * 512 + F.lane * 8);
            x[q * 8 + 0] = lo16(w.x); x[q * 8 + 1] = hi16(w.x); x[q * 8 + 2] = lo16(w.y); x[q * 8 + 3] = hi16(w.y); x[q * 8 + 4] = lo16(w.z); x[q * 8 + 5] = hi16(w.z); x[q * 8 + 6] = lo16(w.w); x[q * 8 + 7] = hi16(w.w); }
        float s = 0.f;
#pragma unroll
        for (int e = 0; e < 32; ++e) s += x[e];
        s = wave_sum(s); const float mean = s * (1.0f / 2048.0f);
        float qv = 0.f;
#pragma unroll
        for (int e = 0; e < 32; ++e) { const float dd = x[e] - mean; qv += dd * dd; }
        qv = wave_sum(qv);
        if (F.lane == 0) *(f32x2*)(ST + (size_t)r * 2) = (f32x2){mean, rsqrtf(qv * (1.0f / 2048.0f) + 1e-5f)};
    }
}
__device__ __forceinline__ int vt_off(int dch, int jb) { return dch * 256 + ((jb ^ ((dch & 15) ^ (((dch >> 4) & 7) << 1))) << 4); }
__device__ __forceinline__ void phase_spatial(const Frame& F, int bsg, int layer) {
    const bf16_t* Z = F.ar<bf16_t>(AR_Z); const float* ST = F.ar<float>(AR_ST); bf16_t* Pb = F.ar<bf16_t>(AR_P);
    const bf16_t* Ws = F.wsp<bf16_t>(WS_WSP) + (size_t)bsg * 16 * 128 * 128;
    const float* lng = F.in(31) + (size_t)bsg * 2048; const float* lnb = F.in(32) + (size_t)bsg * 2048; const float* bs = F.in(34) + (size_t)bsg * 16 * 128;
    LAS unsigned char* vt = F.lds;
    const int skip = layer >= 3;
    const int nchunk = skip ? BG * 16 : BG * 18;
    const int w = F.wave, lane = F.lane, dt = w >> 1, it0 = (w & 1) * 2;
    const int jj0 = F.tid >> 4, c8 = (F.tid & 15) * 8;
    u32x4 zz[4]; f32x2 st[4];
#define SP_ROW0(U_) ((size_t)(skip ? (((U_) >> 4) >> 4) * 18 + 2 + (((U_) >> 4) & 15) : ((U_) >> 4)) * 128)
#define SP_LOADZ(U_) do { const size_t r0_ = SP_ROW0(U_); const int gi_ = (U_) & 15; _Pragma("unroll") for (int k = 0; k < 4; ++k) { \
        zz[k] = *(const u32x4*)(Z + (r0_ + jj0 + 32 * k) * 4096 + 2048 + gi_ * 128 + c8); st[k] = *(const f32x2*)(ST + (r0_ + jj0 + 32 * k) * 2); } } while (0)
    if (F.bid < nchunk * 16) SP_LOADZ(F.bid);
    int gic = -1; float gg[8], bb[8], bias[2]; bf16x8 B0[8], B1[8];
#pragma unroll
    for (int e = 0; e < 8; ++e) { gg[e] = 0.f; bb[e] = 0.f; B0[e] = (bf16x8){0, 0, 0, 0, 0, 0, 0, 0}; B1[e] = B0[e]; }
    bias[0] = bias[1] = 0.f;
    for (int U = F.bid; U < nchunk * 16; U += F.G) {
        const int gi = U & 15;
        const size_t row0 = SP_ROW0(U);
        if (gi != gic) {
            gic = gi;
            const f32x4 g0 = *(const f32x4*)(lng + gi * 128 + c8), g1 = *(const f32x4*)(lng + gi * 128 + c8 + 4), b0 = *(const f32x4*)(lnb + gi * 128 + c8), b1 = *(const f32x4*)(lnb + gi * 128 + c8 + 4);
            gg[0] = g0[0]; gg[1] = g0[1]; gg[2] = g0[2]; gg[3] = g0[3]; gg[4] = g1[0]; gg[5] = g1[1]; gg[6] = g1[2]; gg[7] = g1[3];
            bb[0] = b0[0]; bb[1] = b0[1]; bb[2] = b0[2]; bb[3] = b0[3]; bb[4] = b1[0]; bb[5] = b1[1]; bb[6] = b1[2]; bb[7] = b1[3];
            const bf16_t* w0p = Ws + ((size_t)gi * 128 + it0 * 32 + (lane & 31)) * 128 + 8 * (lane >> 5);
#pragma unroll
            for (int s_ = 0; s_ < 8; ++s_) { B0[s_] = *(const bf16x8*)(w0p + 16 * s_); B1[s_] = *(const bf16x8*)(w0p + 32 * 128 + 16 * s_); }
#pragma unroll
            for (int it = 0; it < 2; ++it) bias[it] = bs[gi * 128 + (it0 + it) * 32 + (lane & 31)];
        }
        __syncthreads();
#pragma unroll
        for (int k = 0; k < 4; ++k) {
            const int jj = jj0 + 32 * k;
            const float xv[8] = {lo16(zz[k].x), hi16(zz[k].x), lo16(zz[k].y), hi16(zz[k].y), lo16(zz[k].z), hi16(zz[k].z), lo16(zz[k].w), hi16(zz[k].w)};
#pragma unroll
            for (int e = 0; e < 8; e += 2) {
                const unsigned pw = pk2((xv[e] - st[k][0]) * st[k][1] * gg[e] + bb[e], (xv[e + 1] - st[k][0]) * st[k][1] * gg[e + 1] + bb[e + 1]);
                *(LAS unsigned short*)(vt + vt_off(c8 + e, jj >> 3) + (jj & 7) * 2) = (unsigned short)(pw & 0xFFFFu);
                *(LAS unsigned short*)(vt + vt_off(c8 + e + 1, jj >> 3) + (jj & 7) * 2) = (unsigned short)(pw >> 16);
            }
        }
        u32x2 uu[2][4];
#pragma unroll
        for (int it = 0; it < 2; ++it) { const int ii = (it0 + it) * 32 + (lane & 31);
#pragma unroll
            for (int rq = 0; rq < 4; ++rq) uu[it][rq] = *(const u32x2*)(Z + (row0 + ii) * 4096 + gi * 128 + dt * 32 + 8 * rq + 4 * (lane >> 5)); }
        if (U + F.G < nchunk * 16) SP_LOADZ(U + F.G);
        __syncthreads();
        f32x16 acc0, acc1;
#pragma unroll
        for (int e = 0; e < 16; ++e) { acc0[e] = 0.f; acc1[e] = 0.f; }
        const int dA = dt * 32 + (lane & 31);
#pragma unroll
        for (int s_ = 0; s_ < 8; ++s_) {
            const bf16x8 Afr = *(const LAS bf16x8*)(vt + vt_off(dA, 2 * s_ + (lane >> 5)));
            acc0 = __builtin_amdgcn_mfma_f32_32x32x16_bf16(Afr, B0[s_], acc0, 0, 0, 0);
            acc1 = __builtin_amdgcn_mfma_f32_32x32x16_bf16(Afr, B1[s_], acc1, 0, 0, 0);
        }
#pragma unroll
        for (int it = 0; it < 2; ++it) {
            const int ii = (it0 + it) * 32 + (lane & 31); const size_t row = row0 + ii;
#pragma unroll
            for (int rq = 0; rq < 4; ++rq) {
                const int d0 = dt * 32 + 8 * rq + 4 * (lane >> 5);
                float vs[4];
#pragma unroll
                for (int e = 0; e < 4; ++e) vs[e] = (it == 0 ? acc0[rq * 4 + e] : acc1[rq * 4 + e]) + bias[it];
                u32x2 o; o.x = pk2(lo16(uu[it][rq].x) * vs[0], hi16(uu[it][rq].x) * vs[1]); o.y = pk2(lo16(uu[it][rq].y) * vs[2], hi16(uu[it][rq].y) * vs[3]);
                *(u32x2*)(Pb + row * 2048 + gi * 128 + d0) = o;
            }
        }
    }
#undef SP_ROW0
#undef SP_LOADZ
    __syncthreads();
}

__global__ void __launch_bounds__(NTHREADS, 2) fwd_kernel(Params P) {
    extern __shared__ __attribute__((aligned(16))) unsigned char lds_raw[];
    Frame F; F.lds = (LAS unsigned char*)lds_raw; F.tid = threadIdx.x; F.lane = F.tid & 63; F.wave = __builtin_amdgcn_readfirstlane(F.tid >> 6);
    F.G = gridDim.x; F.bid = blockIdx.x; F.ws = P.ws; F.kp = (const Params __attribute__((address_space(4)))*)__builtin_amdgcn_kernarg_segment_ptr();
    const int lo = P.ph_lo, hi = P.ph_hi;
    volatile LAS unsigned* misc = (volatile LAS unsigned*)(F.lds + LDS_MISC);
    if (F.tid < 4) misc[F.tid] = 0u;
    __syncthreads();
    XcdBarrier bar; bar.bar = (unsigned*)(F.ws + WS_CTL); bar.x = 0; bar.st = misc;
    if (hi - lo > 1) bar = xcd_barrier_post((unsigned*)(F.ws + WS_CTL), misc);
    int ph = 0;
#define RUN(id, ...) do { if (ph >= lo && ph < hi) { const int nrep_ = ((REP_MASK >> (id)) & 1u) ? 2 : 1; for (int rep_ = 0; rep_ < nrep_; ++rep_) { const bool dry_ = (rep_ + 1 < nrep_); (void)dry_; { int t_ = threadIdx.x; const Params __attribute__((address_space(4)))* kp_ = (const Params __attribute__((address_space(4)))*)__builtin_amdgcn_kernarg_segment_ptr(); asm volatile("" : "+v"(t_), "+s"(kp_)); F.tid = t_; F.lane = t_ & 63; F.kp = kp_; F.ws = kp_->ws; } __VA_ARGS__; if (rep_ + 1 < nrep_ || ph + 1 < hi) xcd_barrier(bar); } } ++ph; } while (0)

    RUN(0, phase_prologue(F));
    for (int g = 0; g < NG; ++g) {
        for (int layer = 0; layer < 4; ++layer) {
            const int a = layer >> 1;
            if ((layer & 1) == 0) {
                const bf16_t* Vc = layer == 0 ? F.wsp<bf16_t>(WS_VF) : F.ar<bf16_t>(AR_V);
                RUN(1, phase_norm1(F, g, layer, F.ar<bf16_t>(AR_H2), 2048, dry_));
                RUN(2, phase_mix(F, a));
                RUN(3, { { pg8::SchedPlain S; S.init(TG / 256, 2, F.G, F.bid, 0);
                        EpiL1 E{F.ar<bf16_t>(AR_L1)};
                        pg8::gemm_phase(F.tid, F.lds, F.ar<bf16_t>(AR_H2), K1CAT, F.wsp<bf16_t>(WS_WL) + (size_t)a * 512 * K1CAT, K1CAT, K1CAT, S, E); }
                      { int t_ = threadIdx.x; asm volatile("" : "+v"(t_)); F.tid = t_; F.lane = t_ & 63; }
                      { pg8::SchedRKV S; S.init(TG / 256, 12, F.G, (F.bid + 192) % F.G, 0);
                        EpiRKV E{F.ws, layer == 0 ? WS_VF : WS_ARENA + AR_V};
                        pg8::gemm_phase(F.tid, F.lds, F.ar<bf16_t>(AR_XR), D, F.wsp<bf16_t>(WS_WRKV) + (size_t)a * 3072 * D, D, D, S, E); } });
                if (layer == 2) {
                    RUN(4, { pg8::SchedPlain S; S.init(TG / 256, 4, F.G, F.bid, 0);
                          EpiStore<1> E{F.ar<bf16_t>(AR_VGATE), F.in(19)};
                          pg8::gemm_phase(F.tid, F.lds, F.ar<bf16_t>(AR_L1) + 256, 512, F.wsp<bf16_t>(WS_V2T), 256, 256, S, E); });
                    RUN(5, phase_vfix(F));
                }
                RUN(6, phase_scan4(F, a, Vc));
                RUN(7, { pg8::SchedPlain S; S.init(TG / 256, 4, F.G, F.bid, 0);
                      EpiStore<0> E{F.ar<bf16_t>(AR_G), nullptr};
                      pg8::gemm_phase(F.tid, F.lds, F.ar<bf16_t>(AR_L1) + 256, 512, F.wsp<bf16_t>(WS_G2T) + (size_t)a * D * 256, 256, 256, S, E); });
                RUN(8, phase_post(F, a, Vc));
                RUN(9, { const int skip = layer == 2; pg8::SchedPlain S; S.init(skip ? BG * 8 : TG / 256, 4, F.G, F.bid, skip);
                      EpiStore<0> E{F.ar<bf16_t>(AR_O), nullptr};
                      pg8::gemm_phase(F.tid, F.lds, F.ar<bf16_t>(AR_R), D, F.wsp<bf16_t>(WS_WO) + (size_t)a * D * D, D, D, S, E); });
            } else {
                const int skip = layer == 3;
                RUN(10, phase_norm1(F, g, layer, F.ar<bf16_t>(AR_H), D, dry_));
                RUN(11, { pg8::SchedPlain S; S.init(skip ? BG * 8 : TG / 256, 16, F.G, F.bid, skip);
                      EpiGelu E{F.ar<bf16_t>(AR_Z), F.in(30) + (size_t)a * 4096};
                      pg8::gemm_phase(F.tid, F.lds, F.ar<bf16_t>(AR_H), D, F.wsp<bf16_t>(WS_WIN) + (size_t)a * 4096 * D, D, D, S, E); });
                RUN(12, phase_sgstats(F, layer));
                RUN(13, phase_spatial(F, a, layer));
                RUN(14, { pg8::SchedPlain S; S.init(skip ? BG * 8 : TG / 256, 4, F.G, F.bid, skip);
                      EpiStore<0> E{F.ar<bf16_t>(AR_O), nullptr};
                      pg8::gemm_phase(F.tid, F.lds, F.ar<bf16_t>(AR_P), 2048, F.wsp<bf16_t>(WS_WOUT) + (size_t)a * D * 2048, 2048, 2048, S, E); });
            }
            RUN(15, phase_norm2(F, g, layer, dry_));
            RUN(16, { const int total = moe_tables(F, g, layer);
                  pg8::SchedMoe<true> S{(const LAS int*)(F.lds + LDS_MISC + 64), (const LAS int*)(F.lds + LDS_MISC + 192), F.ar<int>(AR_LIST), F.G, F.bid, total};
                  EpiMG E{F.ar<bf16_t>(AR_HE)};
                  pg8::gemm_phase(F.tid, F.lds, F.ar<bf16_t>(AR_HM), D, F.wsp<bf16_t>(WS_WGU) + (size_t)layer * NEXP * 1024 * D, D, D, S, E); });
            RUN(17, { const int total = moe_tables(F, g, layer);
                  pg8::SchedMoe<false> S{(const LAS int*)(F.lds + LDS_MISC + 64), (const LAS int*)(F.lds + LDS_MISC + 192), F.ar<int>(AR_LIST), F.G, F.bid, total};
                  EpiMD E{F.ar<bf16_t>(AR_YM0), F.ar<int>(AR_LIST), F.ar<float>(AR_LW), (const LAS int*)(F.lds + LDS_MISC + 64)};
                  pg8::gemm_phase(F.tid, F.lds, F.ar<bf16_t>(AR_HE), FEXP, F.wsp<bf16_t>(WS_WD) + (size_t)layer * NEXP * D * FEXP, FEXP, FEXP, S, E); });
        }
        RUN(18, phase_norm1(F, g, 4, nullptr, 0));
    }
#undef RUN
}
constexpr int NPHASES = 1 + NG * (10 + 8 + 12 + 8 + 1);

__global__ void nan_fill(float* out, size_t n) { for (size_t i = (size_t)blockIdx.x * blockDim.x + threadIdx.x; i < n; i += (size_t)gridDim.x * blockDim.x) out[i] = __uint_as_float(0x7FC00000u); }

extern "C" void kernel_launch(void* const* d_in, const int* in_sizes, int n_in, void* d_out, int out_size, void* d_ws, size_t ws_size, hipStream_t stream) {
    static int grid = 0;
    if (grid == 0) {
        int dev = 0, cus = 0, per_cu = 0;
        if (n_in != 42 || ws_size < WS_END || hipGetDevice(&dev) != hipSuccess || hipDeviceGetAttribute(&cus, hipDeviceAttributeMultiprocessorCount, dev) != hipSuccess) {
            fprintf(stderr, "kernel_launch: bad setup (n_in %d, ws %zu need %zu)\n", n_in, ws_size, (size_t)WS_END); grid = -1;
        } else if (hipFuncSetAttribute((const void*)fwd_kernel, hipFuncAttributeMaxDynamicSharedMemorySize, LDS_BYTES) != hipSuccess) { fprintf(stderr, "kernel_launch: hipFuncSetAttribute failed\n"); grid = -1; }
        else {
            if (hipOccupancyMaxActiveBlocksPerMultiprocessor(&per_cu, (const void*)fwd_kernel, NTHREADS, LDS_BYTES) != hipSuccess || per_cu < 1) { fprintf(stderr, "kernel_launch: occupancy query reports %d\n", per_cu); }
            (void)hipGetLastError();
            grid = cus;
        }
    }
    if (grid < 0) { hipLaunchKernelGGL(nan_fill, dim3(1024), dim3(256), 0, stream, (float*)d_out, (size_t)out_size); return; }
    (void)hipMemsetAsync((char*)d_ws + WS_CTL, 0, CTL_BYTES, stream);
    Params p{};
    for (int i = 0; i < 42; ++i) p.in[i] = (const float*)d_in[i];
    p.out = (float*)d_out; p.ws = (unsigned char*)d_ws;
#if PER_PHASE_LAUNCH
    for (int k = 0; k < NPHASES; ++k) { p.ph_lo = k; p.ph_hi = k + 1; hipLaunchKernelGGL(fwd_kernel, dim3(grid), dim3(NTHREADS), LDS_BYTES, stream, p); }
#else
    p.ph_lo = 0; p.ph_hi = NPHASES;
    hipLaunchKernelGGL(fwd_kernel, dim3(grid), dim3(NTHREADS), LDS_BYTES, stream, p);
#endif
}
```

```cpp
#include <hip/hip_runtime.h>
#include <cstdio>
#include <cstdint>

#ifndef REP_MASK
#define REP_MASK 0u
#endif
#ifndef PER_PHASE_LAUNCH
#define PER_PHASE_LAUNCH 0
#endif

#define LAS __attribute__((address_space(3)))
typedef unsigned short bf16_t;
typedef short bf16x8 __attribute__((ext_vector_type(8)));
typedef float f32x4 __attribute__((ext_vector_type(4)));
typedef float f32x2 __attribute__((ext_vector_type(2)));
typedef float f32x16 __attribute__((ext_vector_type(16)));
typedef unsigned u32x4 __attribute__((ext_vector_type(4)));
typedef unsigned u32x2 __attribute__((ext_vector_type(2)));

constexpr int NB = 32, SEQ = 2048, LC = 256, LT = SEQ + LC, D = 1024, NH = 16;
constexpr int NG = 2, BG = NB / NG, TG = BG * LT;
constexpr int NTHREADS = 512, NWAVES = 8;
constexpr int N1CAT = 3584, K1CAT = 2048;
constexpr int NEXP = 16, FEXP = 512;

constexpr size_t al256(size_t x) { return (x + 255) & ~(size_t)255; }
constexpr int XCD_BAR_WORDS_C = 3456;
constexpr size_t WS_CTL = 0;
constexpr size_t CTL_BAR_BYTES = (size_t)XCD_BAR_WORDS_C * 4;
constexpr size_t CTL_CNT_OFF = al256(CTL_BAR_BYTES);
constexpr size_t CTL_BYTES = al256(CTL_CNT_OFF + (size_t)2 * NG * 4 * 32 * 64);
constexpr size_t WS_X = al256(WS_CTL + CTL_BYTES);
constexpr size_t WS_VF = WS_X + (size_t)TG * D * 2;
constexpr size_t WS_MODL = WS_VF + (size_t)TG * D * 2;
constexpr size_t WS_MODC = WS_MODL + (size_t)4 * NB * 6 * D * 4;
constexpr size_t WS_WRKV = al256(WS_MODC + (size_t)4 * 6 * D * 4);
constexpr size_t WS_WL = WS_WRKV + (size_t)2 * 3072 * D * 2;
constexpr size_t WS_WO = WS_WL + (size_t)2 * 512 * K1CAT * 2;
constexpr size_t WS_G2T = WS_WO + (size_t)2 * D * D * 2;
constexpr size_t WS_V2T = WS_G2T + (size_t)2 * D * 256 * 2;
constexpr size_t WS_W2T = WS_V2T + (size_t)D * 256 * 2;
constexpr size_t WS_A2T = WS_W2T + (size_t)4 * D * 64 * 2;
constexpr size_t WS_WIN = WS_A2T + (size_t)4 * D * 64 * 2;
constexpr size_t WS_WOUT = WS_WIN + (size_t)2 * 4096 * D * 2;
constexpr size_t WS_WSP = WS_WOUT + (size_t)2 * D * 2048 * 2;
constexpr size_t WS_WGU = WS_WSP + (size_t)2 * 16 * 128 * 128 * 2;
constexpr size_t WS_WD = WS_WGU + (size_t)4 * NEXP * 1024 * D * 2;
constexpr size_t WS_ARENA = al256(WS_WD + (size_t)4 * NEXP * D * FEXP * 2);
constexpr size_t SZB = (size_t)TG * D * 2;
constexpr size_t AR_H2 = 0;
constexpr size_t AR_Y0 = 0, AR_Y1 = SZB;
constexpr size_t AR_XR = 2 * SZB;
constexpr size_t AR_R = 5 * SZB, AR_K = 6 * SZB, AR_V = 7 * SZB;
constexpr size_t AR_L1 = 8 * SZB;
constexpr size_t AR_DOT = AR_L1 + SZB / 2;
constexpr size_t AR_G = 2 * SZB;
constexpr size_t AR_VGATE = 0;
constexpr size_t AR_O = 3 * SZB;
constexpr size_t AR_H = 0;
constexpr size_t AR_Z = SZB;
constexpr size_t AR_P = 5 * SZB;
constexpr size_t AR_ST = 7 * SZB;
constexpr size_t AR_HM = 0;
constexpr size_t AR_HE = SZB;
constexpr size_t HE_ROWS = (size_t)2 * TG + 32 * 256;
constexpr size_t AR_LIST = al256(AR_HE + HE_ROWS * FEXP * 2);
constexpr size_t AR_LW = AR_LIST + (size_t)32 * TG * 4;
constexpr size_t AR_YM0 = 5 * SZB, AR_YM1 = 6 * SZB;
constexpr size_t ARENA_BYTES = AR_DOT + (size_t)2 * TG * 16 * 4 + 4096;
constexpr size_t WS_END = WS_ARENA + ARENA_BYTES;
static_assert(AR_LW + (size_t)32 * TG * 4 <= AR_O, "moe lists overlap");

constexpr int LDS_STAGE = 131072;
constexpr int LDS_MISC = LDS_STAGE;
constexpr int LDS_BYTES = LDS_STAGE + 1024;

struct Params {
    const float* in[42];
    float* out;
    unsigned char* ws;
    int ph_lo, ph_hi;
};

__device__ __forceinline__ float bf2f(unsigned short b) { return __uint_as_float(((unsigned)b) << 16); }
__device__ __forceinline__ unsigned short f2bf(float f) { unsigned u = __float_as_uint(f); u += 0x7FFFu + ((u >> 16) & 1u); return (unsigned short)(u >> 16); }
typedef __bf16 bf16x2_t __attribute__((ext_vector_type(2)));
__device__ __forceinline__ unsigned pk2(float lo, float hi) { const bf16x2_t v = __builtin_convertvector((f32x2){lo, hi}, bf16x2_t); return __builtin_bit_cast(unsigned, v); }
__device__ __forceinline__ float lo16(unsigned w) { return __uint_as_float(w << 16); }
__device__ __forceinline__ float hi16(unsigned w) { return __uint_as_float(w & 0xFFFF0000u); }
__device__ __forceinline__ float sigmoidf_(float x) { return __builtin_amdgcn_rcpf(1.0f + __expf(-x)); }
__device__ __forceinline__ float tanhf_(float x) { return 1.0f - 2.0f * __builtin_amdgcn_rcpf(__expf(2.0f * x) + 1.0f); }
__device__ __forceinline__ float wave_sum(float v) {
#pragma unroll
    for (int o = 32; o > 0; o >>= 1) v += __shfl_xor(v, o);
    return v;
}
template <int CTRL> __device__ __forceinline__ float dpp_f(float v) {
    return __int_as_float(__builtin_amdgcn_update_dpp(0, __float_as_int(v), CTRL, 0xF, 0xF, true));
}
__device__ __forceinline__ float red8(float v) { v += dpp_f<0xB1>(v); v += dpp_f<0x4E>(v); v += dpp_f<0x141>(v); return v; }
__device__ __forceinline__ float red16(float v) { v = red8(v); v += dpp_f<0x140>(v); return v; }
__device__ __forceinline__ float wave_sum_dpp(float v) {
    v = red16(v);
    const float a = __int_as_float(__builtin_amdgcn_readlane(__float_as_int(v), 0)), b = __int_as_float(__builtin_amdgcn_readlane(__float_as_int(v), 16));
    const float c = __int_as_float(__builtin_amdgcn_readlane(__float_as_int(v), 32)), d = __int_as_float(__builtin_amdgcn_readlane(__float_as_int(v), 48));
    return (a + b) + (c + d);
}
__device__ __forceinline__ float red4(float v) { v += dpp_f<0xB1>(v); v += dpp_f<0x4E>(v); return v; }
__device__ __forceinline__ f32x2 gelu_pk(f32x2 v) {
    const f32x2 av = __builtin_elementwise_abs(v), d = av * 0.2316418882f + 1.0f;
    f32x2 t; t.x = __builtin_amdgcn_rcpf(d.x); t.y = __builtin_amdgcn_rcpf(d.y);
    f32x2 q = t * 0.5307027145f + (-0.7265760135f); q = q * t + 0.7107068705f; q = q * t + (-0.142248368f); q = q * t + 0.127414796f; q = q * t;
    const f32x2 s = (v * v) * (-0.72134752044f);
    f32x2 e; e.x = __builtin_amdgcn_exp2f(s.x); e.y = __builtin_amdgcn_exp2f(s.y);
    const f32x2 m = v * (q * e), r = v - m;
    f32x2 o; o.x = v.x < 0.f ? m.x : r.x; o.y = v.y < 0.f ? m.y : r.y; return o;
}
__device__ __forceinline__ float gelu_f(float v) {
    const float av = fabsf(v), t = __builtin_amdgcn_rcpf(av * 0.2316418882f + 1.0f);
    float q = t * 0.5307027145f + (-0.7265760135f); q = q * t + 0.7107068705f; q = q * t + (-0.142248368f); q = q * t + 0.127414796f; q = q * t;
    const float e = __builtin_amdgcn_exp2f((v * v) * (-0.72134752044f));
    const float m = v * (q * e);
    return v < 0.f ? m : v - m;
}

#define XB_TMO      128
#define XB_XCNT(j)  (256  + 64 * (j))
#define XB_XSUB(j)  (1280 + 64 * (j))
#define XB_XGEN(j)  (2304 + 64 * (j))
#define XB_TOP      3328
#define XB_TOPGEN   3392
#define XCD_BAR_WORDS 3456
#define XB_SPIN_CAP (1u << 22)
static_assert(XCD_BAR_WORDS == XCD_BAR_WORDS_C, "barrier words");
__device__ __forceinline__ unsigned xb_ld(unsigned* p)              { return __hip_atomic_load(p, __ATOMIC_RELAXED, __HIP_MEMORY_SCOPE_AGENT); }
__device__ __forceinline__ unsigned xb_add(unsigned* p, unsigned v) { return __hip_atomic_fetch_add(p, v, __ATOMIC_RELAXED, __HIP_MEMORY_SCOPE_AGENT); }
__device__ __forceinline__ unsigned xb_xcc_id() { return (unsigned)__builtin_amdgcn_s_getreg((3 << 11) | 20) & 0xFu; }
#define XB_SPIN(cond, bar) do { unsigned _sp = 0; while (cond) { __builtin_amdgcn_s_sleep(1); \
    if ((++_sp & 255u) == 0u) { if (xb_ld(&(bar)[XB_TMO])) break; if (_sp > XB_SPIN_CAP) { atomicAdd(&(bar)[XB_TMO], 1u); break; } } } } while (0)
struct XcdBarrier { unsigned* bar; unsigned x; volatile LAS unsigned* st; };
__device__ __forceinline__ XcdBarrier xcd_barrier_post(unsigned* bar, volatile LAS unsigned* st) {
    XcdBarrier b; b.bar = bar; b.x = xb_xcc_id(); b.st = st;
    if (threadIdx.x == 0) (void)xb_add(&bar[XB_XCNT(b.x)], 1u);
    return b;
}
__device__ __forceinline__ void xcd_barrier_complete(unsigned* bar, unsigned x, unsigned& nloc, unsigned& nx) {
    const unsigned G = gridDim.x * gridDim.y * gridDim.z;
    unsigned sum, cnt, mine, sp = 0u;
    for (;;) {
        sum = 0u; cnt = 0u; mine = 0u;
#pragma unroll
        for (unsigned j = 0; j < 16; ++j) { const unsigned c = xb_ld(&bar[XB_XCNT(j)]); sum += c; cnt += (c > 0u) ? 1u : 0u; mine = (j == x) ? c : mine; }
        if (sum == G) break;
        __builtin_amdgcn_s_sleep(1);
        if ((++sp & 255u) == 0u) { if (xb_ld(&bar[XB_TMO])) break; if (sp > XB_SPIN_CAP) { atomicAdd(&bar[XB_TMO], 1u); break; } }
    }
    nloc = mine > 0u ? mine : 1u; nx = cnt > 0u ? cnt : 1u;
}
__device__ __forceinline__ void xcd_barrier(const XcdBarrier& b) {
    asm volatile("s_waitcnt vmcnt(0)" ::: "memory");
    __syncthreads();
    if (threadIdx.x == 0) {
        unsigned* bar = b.bar;
        __builtin_amdgcn_s_waitcnt(0);
        unsigned nloc = b.st[0], nx = b.st[1];
        if (nloc == 0u) { xcd_barrier_complete(bar, b.x, nloc, nx); b.st[0] = nloc; b.st[1] = nx; }
        const unsigned old = xb_add(&bar[XB_XSUB(b.x)], 1u);
        const unsigned gen = old / nloc;
        if (old + 1u == (gen + 1u) * nloc) {
            __builtin_amdgcn_fence(__ATOMIC_RELEASE, "agent");
            asm volatile("s_waitcnt vmcnt(0)" ::: "memory");
            const unsigned og = xb_add(&bar[XB_TOP], 1u);
            const unsigned tg = og / nx;
            if (og + 1u == (tg + 1u) * nx) xb_add(&bar[XB_TOPGEN], 1u);
            else XB_SPIN(xb_ld(&bar[XB_TOPGEN]) == tg, bar);
            __builtin_amdgcn_fence(__ATOMIC_ACQUIRE, "agent");
            xb_add(&bar[XB_XGEN(b.x)], 1u);
            asm volatile("s_waitcnt vmcnt(0)" ::: "memory");
        } else {
            XB_SPIN(xb_ld(&bar[XB_XGEN(b.x)]) == gen, bar);
            __builtin_amdgcn_fence(__ATOMIC_ACQUIRE, "agent");
            asm volatile("s_waitcnt vmcnt(0)" ::: "memory");
        }
    }
    __syncthreads();
}

namespace pg8 {
constexpr int BM = 256, BK = 64, HALF = 128, HTB = HALF * BK * 2, STAGE_BYTES = 8 * HTB, NXCD = 8, WGM = 8;
__host__ __device__ __forceinline__ int lds_byte(int r, int c) { const int st = (r >> 4) * 2 + (c >> 5), rr = r & 15, cc = c & 31, ob = rr * 64 + cc * 2; return st * 1024 + (ob ^ (((ob >> 9) & 1) << 5)); }
__host__ __device__ __forceinline__ void stage_rc(int b, int& R, int& C) { const int st = b / 1024, sb = b % 1024, swz = sb ^ (((sb >> 9) & 1) << 5); R = (st >> 1) * 16 + swz / 64; C = (st & 1) * 32 + (swz % 64) / 2; }
__host__ __device__ __forceinline__ int perm32(int rho) { const int n = rho >> 4, i = rho & 15; return 8 * (i >> 2) + 4 * n + (i & 3); }
struct Unit { int pm, pn, aux; };

struct SchedPlain {
    static constexpr bool GATHER = false;
    int nM, nN, nwg, G, c, skipctx;
    __device__ void init(int nM_, int nN_, int G_, int c_, int skipctx_) { nM = nM_; nN = nN_; nwg = nM * nN; G = G_; c = c_; skipctx = skipctx_; }
    __device__ bool next(int i, Unit& u) const {
        const long L = (long)i * G + c; if (L >= nwg) return false;
        int wgid = (int)L; { const int q = nwg / NXCD, r = nwg % NXCD, xcd = wgid % NXCD, off = wgid / NXCD; wgid = (xcd < r ? xcd * (q + 1) : r * (q + 1) + (xcd - r) * q) + off; }
        const int nig = WGM * nN, gid = wgid / nig, fm = gid * WGM, gsz = (nM - fm) < WGM ? (nM - fm) : WGM;
        int pm = fm + ((wgid % nig) % gsz); u.pn = (wgid % nig) / gsz; u.aux = 0;
        if (skipctx) pm = (pm >> 3) * 9 + 1 + (pm & 7);
        u.pm = pm; return true;
    }
    __device__ __forceinline__ int arow(const Unit& u, int r) const { return u.pm * BM + r; }
};
struct SchedRKV : SchedPlain {
    __device__ bool next(int i, Unit& u) const { if (!SchedPlain::next(i, u)) return false; u.pm += (u.pn >> 2) * nM; return true; }
};
template <bool GATH> struct SchedMoe {
    static constexpr bool GATHER = GATH;
    const LAS int* cn; const LAS int* tb; const int* lists; int G, c, total;
    __device__ bool next(int i, Unit& u) const {
        const int U = i * G + c; if (U >= total * 4) return false;
        const int T = U >> 2, pn = U & 3; int l = 0;
        while (tb[l + 1] <= T) ++l;
        u.pm = T; u.pn = (l >> 1) * 4 + pn; u.aux = l | ((T - tb[l]) << 8); return true;
    }
    __device__ __forceinline__ int arow(const Unit& u, int r) const {
        if (!GATH) return u.pm * BM + r;
        const int l = u.aux & 255, idx = (u.aux >> 8) * BM + r;
        return idx < cn[l] ? lists[(size_t)l * TG + idx] : 0;
    }
};

template <class Epi, class Sched>
__device__ __forceinline__ void gemm_phase(const int tid, LAS unsigned char* lds, const bf16_t* A, int lda, const bf16_t* Bt, int ldb, int K, const Sched& S, const Epi& E) {
    constexpr bool GA = Sched::GATHER;
    const int wid = __builtin_amdgcn_readfirstlane(tid >> 6), lane = tid & 63, wr = wid >> 2, wc = wid & 3, fr = lane & 15, fq = lane >> 4;
    const int nt = K / BK;
    unsigned voffA[2], voffB[2];
#pragma unroll
    for (int i = 0; i < 2; ++i) { int R, C; stage_rc(tid * 16 + i * 8192, R, C); const int Rb = (R & ~31) + perm32(R & 31);
        voffA[i] = (unsigned)(R * lda + C) * 2u; voffB[i] = (unsigned)(Rb * ldb + C) * 2u; }
    const size_t kstep = (size_t)(BK * 2);
    const size_t hstepA = (size_t)HALF * lda * 2, tstepA = 2 * hstepA;
    const size_t hstepB = (size_t)HALF * ldb * 2, tstepB = 2 * hstepB;
    const unsigned ldsw = (unsigned)wid * 1024u;
    const int aoff = lds_byte(wr * 64 + fr, fq * 8), boff = lds_byte(wc * 32 + fr, fq * 8);
#define PG8_SA(b, h) (((b) * 2 + (h)) * HTB)
#define PG8_SB(b, h) ((4 + (b) * 2 + (h)) * HTB)
#define PG8_STAGE(bufoff, gbase, voff) do { _Pragma("unroll") for (int _i = 0; _i < 2; ++_i) \
        __builtin_amdgcn_global_load_lds((const unsigned*)((const char*)(gbase) + (voff)[_i]), (LAS unsigned*)(lds + (bufoff) + ldsw + _i * 8192), 16, 0, 0); } while (0)
#define PG8_STAGE_A(bufoff, ub, gv, h, koff) do { if constexpr (GA) { PG8_STAGE(bufoff, (const char*)A + (koff), gv[h]); } else { PG8_STAGE(bufoff, (ub) + (h) * hstepA + (koff), voffA); } } while (0)
#define PG8_LDA(dst, b, h) do { _Pragma("unroll") for (int m = 0; m < 4; ++m) _Pragma("unroll") for (int k = 0; k < 2; ++k) dst[m][k] = *(const LAS bf16x8*)(lds + PG8_SA(b, h) + aoff + m * 2048 + k * 1024); } while (0)
#define PG8_LDB(dst, b, h) do { _Pragma("unroll") for (int n = 0; n < 2; ++n) _Pragma("unroll") for (int k = 0; k < 2; ++k) dst[n][k] = *(const LAS bf16x8*)(lds + PG8_SB(b, h) + boff + n * 2048 + k * 1024); } while (0)
#define PG8_MMA(ai, bj, At, Bt_) do { __builtin_amdgcn_s_setprio(1); _Pragma("unroll") for (int m = 0; m < 4; ++m) _Pragma("unroll") for (int n = 0; n < 2; ++n) _Pragma("unroll") for (int k = 0; k < 2; ++k) \
        acc[ai][bj][m][n] = __builtin_amdgcn_mfma_f32_16x16x32_bf16(Bt_[n][k], At[m][k], acc[ai][bj][m][n], 0, 0, 0); __builtin_amdgcn_s_setprio(0); } while (0)
#define PG8_WAIT_V(n) asm volatile("s_waitcnt vmcnt(" #n ")" ::: "memory")
#define PG8_WAIT_L(n) asm volatile("s_waitcnt lgkmcnt(" #n ")" ::: "memory")
#define PG8_BAR __builtin_amdgcn_s_barrier()
#define PG8_SCHED __builtin_amdgcn_sched_barrier(0)
#define PG8_GOFF(dst, u) do { if constexpr (GA) { _Pragma("unroll") for (int _h = 0; _h < 2; ++_h) _Pragma("unroll") for (int _i = 0; _i < 2; ++_i) { int R_, C_; stage_rc(tid * 16 + _i * 8192, R_, C_); \
        dst[_h][_i] = ((unsigned)S.arow(u, _h * HALF + R_) * (unsigned)lda + (unsigned)C_) * 2u; } } } while (0)
    Unit cur, nxt; int ui = 0;
    if (!S.next(0, cur)) return;
    f32x4 acc[2][2][4][2];
#pragma unroll
    for (int a = 0; a < 2; ++a)
#pragma unroll
        for (int b = 0; b < 2; ++b)
#pragma unroll
            for (int m = 0; m < 4; ++m)
#pragma unroll
                for (int n = 0; n < 2; ++n) acc[a][b][m][n] = (f32x4){0.f, 0.f, 0.f, 0.f};
    bf16x8 At[4][2], B0[2][2], B1[2][2];
    unsigned gAc[2][2], gAn[2][2];
    PG8_GOFF(gAc, cur);
    const char* cA = (const char*)A + (GA ? (size_t)0 : (size_t)cur.pm * tstepA);
    const char* cB = (const char*)Bt + (size_t)cur.pn * tstepB;
    PG8_STAGE(PG8_SB(0, 0), cB, voffB); PG8_STAGE_A(PG8_SA(0, 0), cA, gAc, 0, 0); PG8_STAGE(PG8_SB(0, 1), cB + hstepB, voffB); PG8_STAGE_A(PG8_SA(0, 1), cA, gAc, 1, 0);
    if (wr == 1) PG8_BAR;
    PG8_WAIT_V(4); PG8_BAR;
    PG8_STAGE(PG8_SB(1, 0), cB + kstep, voffB); PG8_STAGE_A(PG8_SA(1, 0), cA, gAc, 0, kstep); PG8_STAGE(PG8_SB(1, 1), cB + hstepB + kstep, voffB);
    PG8_WAIT_V(6); PG8_BAR;
    for (;;) {
        const bool has_next = S.next(ui + 1, nxt);
        if (has_next) { PG8_GOFF(gAn, nxt); }
        else if constexpr (GA) {
#pragma unroll
            for (int _h = 0; _h < 2; ++_h)
#pragma unroll
                for (int _i = 0; _i < 2; ++_i) gAn[_h][_i] = gAc[_h][_i];
        }
        const char* nA = (has_next && !GA) ? (const char*)A + (size_t)nxt.pm * tstepA : cA;
        const char* nB = has_next ? (const char*)Bt + (size_t)nxt.pn * tstepB : cB;
#pragma unroll 1
        for (int t = 0; t < nt; t += 2) {
            const bool last = (t == nt - 2);
            const size_t k1 = (size_t)(t + 1) * kstep;
            const size_t k2 = last ? (size_t)0 : (size_t)(t + 2) * kstep, k3 = k2 + kstep;
            const char* a2 = last ? nA : cA; const char* b2 = last ? nB : cB;
            unsigned g2[2][2];
            if constexpr (GA) {
#pragma unroll
                for (int _h = 0; _h < 2; ++_h)
#pragma unroll
                    for (int _i = 0; _i < 2; ++_i) g2[_h][_i] = last ? gAn[_h][_i] : gAc[_h][_i];
            }
            PG8_LDB(B0, 0, 0); PG8_SCHED; PG8_LDA(At, 0, 0); PG8_STAGE_A(PG8_SA(1, 1), cA, gAc, 1, k1);
            PG8_WAIT_L(8); PG8_BAR; PG8_WAIT_L(0); PG8_MMA(0, 0, At, B0); PG8_BAR; PG8_SCHED;
            PG8_LDB(B1, 0, 1); PG8_STAGE(PG8_SB(0, 0), b2 + k2, voffB);
            PG8_BAR; PG8_WAIT_L(0); PG8_MMA(0, 1, At, B1); PG8_BAR;
            PG8_LDA(At, 0, 1); PG8_STAGE_A(PG8_SA(0, 0), a2, g2, 0, k2);
            PG8_BAR; PG8_WAIT_L(0); PG8_MMA(1, 0, At, B0); PG8_BAR; PG8_SCHED;
            PG8_STAGE(PG8_SB(0, 1), b2 + hstepB + k2, voffB);
            PG8_WAIT_V(6); PG8_BAR; PG8_MMA(1, 1, At, B1); PG8_BAR;
            PG8_LDB(B0, 1, 0); PG8_SCHED; PG8_LDA(At, 1, 0); PG8_STAGE_A(PG8_SA(0, 1), a2, g2, 1, k2);
            PG8_WAIT_L(8); PG8_BAR; PG8_WAIT_L(0); PG8_MMA(0, 0, At, B0); PG8_BAR; PG8_SCHED;
            PG8_LDB(B1, 1, 1); PG8_STAGE(PG8_SB(1, 0), b2 + k3, voffB);
            PG8_BAR; PG8_WAIT_L(0); PG8_MMA(0, 1, At, B1); PG8_BAR;
            PG8_LDA(At, 1, 1); PG8_STAGE_A(PG8_SA(1, 0), a2, g2, 0, k3);
            PG8_BAR; PG8_WAIT_L(0); PG8_MMA(1, 0, At, B0); PG8_BAR; PG8_SCHED;
            PG8_STAGE(PG8_SB(1, 1), b2 + hstepB + k3, voffB);
            PG8_WAIT_V(6); PG8_BAR; PG8_MMA(1, 1, At, B1); PG8_BAR;
        }
        { int fr_e = fr, fq_e = fq; asm volatile("" : "+v"(fr_e), "+v"(fq_e)); E(acc, cur, wr, wc, fr_e, fq_e); }
        if (!has_next) break;
#pragma unroll
        for (int a = 0; a < 2; ++a)
#pragma unroll
            for (int b = 0; b < 2; ++b)
#pragma unroll
                for (int m = 0; m < 4; ++m)
#pragma unroll
                    for (int n = 0; n < 2; ++n) acc[a][b][m][n] = (f32x4){0.f, 0.f, 0.f, 0.f};
        cur = nxt; cA = nA; cB = nB; ++ui;
        if constexpr (GA) {
#pragma unroll
            for (int _h = 0; _h < 2; ++_h)
#pragma unroll
                for (int _i = 0; _i < 2; ++_i) gAc[_h][_i] = gAn[_h][_i];
        }
    }
    PG8_WAIT_V(0);
    if (wr == 0) PG8_BAR;
    PG8_BAR;
#undef PG8_SA
#undef PG8_SB
#undef PG8_STAGE
#undef PG8_STAGE_A
#undef PG8_LDA
#undef PG8_LDB
#undef PG8_MMA
#undef PG8_WAIT_V
#undef PG8_WAIT_L
#undef PG8_BAR
#undef PG8_SCHED
#undef PG8_GOFF
}
}
using pg8::Unit;

#define EPI_LOOP_BEGIN \
    _Pragma("unroll") for (int ai = 0; ai < 2; ++ai) _Pragma("unroll") for (int m = 0; m < 4; ++m) { const int trow = ai * 128 + wr * 64 + m * 16 + fr; \
    _Pragma("unroll") for (int bj = 0; bj < 2; ++bj) { const int tcol = bj * 128 + wc * 32 + 8 * fq; const f32x4 v0 = acc[ai][bj][m][0], v1 = acc[ai][bj][m][1];
#define EPI_LOOP_END } asm volatile("" ::: "memory"); }
__device__ __forceinline__ u32x4 pk8(const f32x4 a, const f32x4 b) { return (u32x4){pk2(a[0], a[1]), pk2(a[2], a[3]), pk2(b[0], b[1]), pk2(b[2], b[3])}; }

struct EpiRKV {
    unsigned char* ws; size_t voff;
    __device__ __forceinline__ void operator()(const f32x4 (&acc)[2][2][4][2], const Unit& u, int wr, int wc, int fr, int fq) const {
        const int which = u.pn >> 2; const size_t row0 = (size_t)(u.pm - which * (TG / 256)) * 256;
        const size_t off = which == 0 ? (WS_ARENA + AR_R) : (which == 1 ? (WS_ARENA + AR_K) : voff);
        bf16_t* dst = (bf16_t*)(ws + off); const int cb = (u.pn & 3) * 256;
        EPI_LOOP_BEGIN
            *(u32x4*)(dst + (row0 + trow) * D + cb + tcol) = pk8(v0, v1);
        EPI_LOOP_END
    }
};
struct EpiL1 {
    bf16_t* L1;
    __device__ __forceinline__ void operator()(const f32x4 (&acc)[2][2][4][2], const Unit& u, int wr, int wc, int fr, int fq) const {
        const int pn = u.pn; const size_t row0 = (size_t)u.pm * 256; const int cb = pn * 256;
        EPI_LOOP_BEGIN
            f32x4 o0 = v0, o1 = v1;
            if (pn == 0 && bj == 0) { _Pragma("unroll") for (int e = 0; e < 4; ++e) { o0[e] = tanhf_(v0[e]); o1[e] = tanhf_(v1[e]); } }
            if (pn == 1 && bj == 0) { _Pragma("unroll") for (int e = 0; e < 4; ++e) { o0[e] = sigmoidf_(v0[e]); o1[e] = sigmoidf_(v1[e]); } }
            *(u32x4*)(L1 + (row0 + trow) * 512 + cb + tcol) = pk8(o0, o1);
        EPI_LOOP_END
    }
};
template <int ACT> struct EpiStore {
    bf16_t* O; const float* bias;
    __device__ __forceinline__ void operator()(const f32x4 (&acc)[2][2][4][2], const Unit& u, int wr, int wc, int fr, int fq) const {
        const size_t row0 = (size_t)u.pm * 256; const int cb = u.pn * 256;
        f32x4 bv[2][2];
#pragma unroll
        for (int bj = 0; bj < 2; ++bj)
#pragma unroll
            for (int n = 0; n < 2; ++n) bv[bj][n] = ACT == 1 ? *(const f32x4*)(bias + cb + bj * 128 + wc * 32 + 8 * fq + 4 * n) : (f32x4){0.f, 0.f, 0.f, 0.f};
        EPI_LOOP_BEGIN
            f32x4 o0 = v0, o1 = v1;
            if (ACT == 1) { _Pragma("unroll") for (int e = 0; e < 4; ++e) { o0[e] = sigmoidf_(v0[e] + bv[bj][0][e]); o1[e] = sigmoidf_(v1[e] + bv[bj][1][e]); } }
            *(u32x4*)(O + (row0 + trow) * D + cb + tcol) = pk8(o0, o1);
        EPI_LOOP_END
    }
};
struct EpiGelu {
    bf16_t* Z; const float* bias;
    __device__ __forceinline__ void operator()(const f32x4 (&acc)[2][2][4][2], const Unit& u, int wr, int wc, int fr, int fq) const {
        const size_t row0 = (size_t)u.pm * 256; const int cb = u.pn * 256;
        f32x4 bv[2][2];
#pragma unroll
        for (int bj = 0; bj < 2; ++bj)
#pragma unroll
            for (int n = 0; n < 2; ++n) bv[bj][n] = *(const f32x4*)(bias + cb + bj * 128 + wc * 32 + 8 * fq + 4 * n);
        EPI_LOOP_BEGIN
            const f32x4 b0 = bv[bj][0], b1 = bv[bj][1];
            const f32x2 g0 = gelu_pk((f32x2){v0[0] + b0[0], v0[1] + b0[1]}), g1 = gelu_pk((f32x2){v0[2] + b0[2], v0[3] + b0[3]});
            const f32x2 g2 = gelu_pk((f32x2){v1[0] + b1[0], v1[1] + b1[1]}), g3 = gelu_pk((f32x2){v1[2] + b1[2], v1[3] + b1[3]});
            *(u32x4*)(Z + (row0 + trow) * 4096 + cb + tcol) = (u32x4){pk2(g0.x, g0.y), pk2(g1.x, g1.y), pk2(g2.x, g2.y), pk2(g3.x, g3.y)};
        EPI_LOOP_END
    }
};
struct EpiMG {
    bf16_t* HE;
    __device__ __forceinline__ void operator()(const f32x4 (&acc)[2][2][4][2], const Unit& u, int wr, int wc, int fr, int fq) const {
        const size_t row0 = (size_t)u.pm * 256; const int pnl = u.pn & 3;
#pragma unroll
        for (int ai = 0; ai < 2; ++ai)
#pragma unroll
            for (int m = 0; m < 4; ++m) { const int trow = ai * 128 + wr * 64 + m * 16 + fr;
#pragma unroll
                for (int bj = 0; bj < 2; ++bj) {
                    const f32x4 gt = acc[ai][bj][m][0], up = acc[ai][bj][m][1];
                    const int f = (8 * pnl + 4 * bj + wc) * 16 + 4 * fq;
                    float o[4];
#pragma unroll
                    for (int e = 0; e < 4; ++e) o[e] = gt[e] * sigmoidf_(gt[e]) * up[e];
                    u32x2 w; w.x = pk2(o[0], o[1]); w.y = pk2(o[2], o[3]);
                    *(u32x2*)(HE + (row0 + trow) * FEXP + f) = w;
                } }
    }
};
struct EpiMD {
    bf16_t* Y0; const int* lists; const float* lw; const LAS int* cn;
    __device__ __forceinline__ void operator()(const f32x4 (&acc)[2][2][4][2], const Unit& u, int wr, int wc, int fr, int fq) const {
        const int l = u.aux & 255, t0 = (u.aux >> 8) * 256, cnt = cn[l]; const int cb = (u.pn & 3) * 256;
        bf16_t* Y = Y0 + (size_t)(l & 1) * ((AR_YM1 - AR_YM0) / 2);
        int tok[2][4]; float wgt[2][4];
#pragma unroll
        for (int ai = 0; ai < 2; ++ai)
#pragma unroll
            for (int m = 0; m < 4; ++m) { const int idx = t0 + ai * 128 + wr * 64 + m * 16 + fr; const bool ok = idx < cnt;
                tok[ai][m] = ok ? lists[(size_t)l * TG + idx] : -1; wgt[ai][m] = ok ? lw[(size_t)l * TG + idx] : 0.f; }
#pragma unroll
        for (int ai = 0; ai < 2; ++ai)
#pragma unroll
            for (int m = 0; m < 4; ++m) {
                if (tok[ai][m] >= 0) {
                    const float wg = wgt[ai][m]; bf16_t* yr = Y + (size_t)tok[ai][m] * D + cb;
#pragma unroll
                    for (int bj = 0; bj < 2; ++bj) { const int tcol = bj * 128 + wc * 32 + 8 * fq;
                        *(u32x4*)(yr + tcol) = pk8(acc[ai][bj][m][0] * wg, acc[ai][bj][m][1] * wg); }
                } }
    }
};

struct Frame {
    const Params __attribute__((address_space(4)))* kp; LAS unsigned char* lds; int tid, lane, wave, G, bid;
    unsigned char* ws;
    __device__ __forceinline__ const float* in(int k) const { return kp->in[k]; }
    __device__ __forceinline__ float* outp() const { return kp->out; }
    template <class T> __device__ __forceinline__ T* wsp(size_t off) const { return (T*)(ws + off); }
    template <class T> __device__ __forceinline__ T* ar(size_t off) const { return (T*)(ws + WS_ARENA + off); }
    __device__ __forceinline__ const float* modL(int layer, int b, int j) const { return (const float*)(ws + WS_MODL) + (((size_t)layer * NB + b) * 6 + j) * D; }
    __device__ __forceinline__ const float* modC(int layer, int j) const { return (const float*)(ws + WS_MODC) + ((size_t)layer * 6 + j) * D; }
};

struct TJob { const float* src; bf16_t* dst; const float* ksc; int lds, K, N, ldd, kofs, nofs, inter; };
constexpr int NJOBS = 2 * 21 + 1 + 4 + 4 * NEXP * 3;
__device__ __forceinline__ TJob get_job(const Frame& F, int j) {
    TJob J; J.ksc = nullptr; J.kofs = 0; J.nofs = 0; J.inter = 0; J.K = 0; J.N = 0; J.lds = 0; J.ldd = 0; J.src = nullptr; J.dst = nullptr;
    if (j < 42) {
        const int a = j / 21, q = j % 21;
        if (q < 3) { J.src = F.in(9 + q) + (size_t)a * D * D; J.lds = D; J.K = D; J.N = D; J.dst = F.wsp<bf16_t>(WS_WRKV) + (size_t)a * 3072 * D; J.ldd = D; J.nofs = q * 1024; }
        else if (q < 15) {
            const int half = (q - 3) / 6, w = (q - 3) % 6; const float* mu = F.in(8) + (size_t)a * 6 * D;
            J.dst = F.wsp<bf16_t>(WS_WL) + (size_t)a * 512 * K1CAT; J.ldd = K1CAT; J.kofs = half * 1024; J.K = D; int mi = 0;
            if (w < 2) { J.src = F.in(14) + ((size_t)a * 2 + w) * D * 64; J.lds = 64; J.N = 64; J.nofs = w * 64; mi = 1; }
            else if (w < 4) { const int d = w - 2; J.src = F.in(17) + ((size_t)a * 2 + d) * D * 64; J.lds = 64; J.N = 64; J.nofs = 128 + d * 64; mi = 4; }
            else if (w == 4) { J.src = F.in(22) + (size_t)a * D * 128; J.lds = 128; J.N = 128; J.nofs = 256; mi = 5; }
            else { J.src = F.in(20); J.lds = 32; J.N = (a == 1) ? 32 : 0; J.nofs = 384; mi = 3; }
            if (half) J.ksc = mu + mi * D;
        } else if (q == 15) { J.src = F.in(12) + (size_t)a * D * D; J.lds = D; J.K = D; J.N = D; J.dst = F.wsp<bf16_t>(WS_WO) + (size_t)a * D * D; J.ldd = D; }
        else if (q == 16) { J.src = F.in(23) + (size_t)a * 128 * D; J.lds = D; J.K = 128; J.N = D; J.dst = F.wsp<bf16_t>(WS_G2T) + (size_t)a * D * 256; J.ldd = 256; }
        else if (q < 19) { const int d = q - 17; J.src = F.in(15) + ((size_t)a * 2 + d) * 64 * D; J.lds = D; J.K = 64; J.N = D; J.dst = F.wsp<bf16_t>(WS_W2T) + ((size_t)a * 2 + d) * D * 64; J.ldd = 64; }
        else { const int d = q - 19; J.src = F.in(18) + ((size_t)a * 2 + d) * 64 * D; J.lds = D; J.K = 64; J.N = D; J.dst = F.wsp<bf16_t>(WS_A2T) + ((size_t)a * 2 + d) * D * 64; J.ldd = 64; }
    } else if (j == 42) { J.src = F.in(21); J.lds = D; J.K = 32; J.N = D; J.dst = F.wsp<bf16_t>(WS_V2T); J.ldd = 256; J.kofs = 128; }
    else if (j < 47) {
        const int q = j - 43, b = q >> 1;
        if ((q & 1) == 0) { J.src = F.in(29) + (size_t)b * D * 4096; J.lds = 4096; J.K = D; J.N = 4096; J.dst = F.wsp<bf16_t>(WS_WIN) + (size_t)b * 4096 * D; J.ldd = D; }
        else { J.src = F.in(35) + (size_t)b * 2048 * D; J.lds = D; J.K = 2048; J.N = D; J.dst = F.wsp<bf16_t>(WS_WOUT) + (size_t)b * D * 2048; J.ldd = 2048; }
    } else {
        const int q = j - 47, ie = q / 3, w = q % 3;
        if (w < 2) { J.src = F.in(38 + w) + (size_t)ie * D * FEXP; J.lds = FEXP; J.K = D; J.N = FEXP; J.dst = F.wsp<bf16_t>(WS_WGU) + (size_t)ie * 1024 * D; J.ldd = D; J.nofs = w * 4; J.inter = 1; }
        else { J.src = F.in(40) + (size_t)ie * FEXP * D; J.lds = D; J.K = FEXP; J.N = D; J.dst = F.wsp<bf16_t>(WS_WD) + (size_t)ie * D * FEXP; J.ldd = FEXP; }
    }
    return J;
}
__device__ __forceinline__ void transpose_all(const Frame& F) {
    LAS float* tile = (LAS float*)F.lds;
    int tilectr = 0;
#pragma unroll 1
    for (int j = 0; j < NJOBS; ++j) {
        const TJob J = get_job(F, j);
        const int tk = (J.K + 127) / 128, tn = (J.N + 127) / 128, ntile = tk * tn;
        int t = (F.bid - (tilectr % F.G) + F.G) % F.G;
        tilectr += ntile;
#pragma unroll 1
        for (; t < ntile; t += F.G) {
            const int k0 = (t / tn) * 128, n0 = (t % tn) * 128;
            __syncthreads();
            float v[32];
#pragma unroll
            for (int e = 0; e < 32; ++e) { const int idx = F.tid + e * 512, kk = idx >> 7, nn = idx & 127;
                v[e] = 0.f; if (k0 + kk < J.K && n0 + nn < J.N) v[e] = J.src[(size_t)(k0 + kk) * J.lds + n0 + nn]; }
#pragma unroll
            for (int e = 0; e < 32; ++e) { const int idx = F.tid + e * 512, kk = idx >> 7, nn = idx & 127;
                float x = v[e]; if (J.ksc && k0 + kk < J.K) x *= J.ksc[k0 + kk];
                tile[kk * 129 + nn] = x; }
            __syncthreads();
#pragma unroll
            for (int e = 0; e < 16; ++e) { const int idx = F.tid + e * 512, nn = idx >> 6, kk = (idx & 63) * 2;
                if (k0 + kk < J.K && n0 + nn < J.N) { const int n = n0 + nn; const int row = J.nofs + (J.inter ? ((n >> 4) * 32 + ((n & 15) >> 2) * 8 + (n & 3)) : n);
                    *(unsigned*)(J.dst + (size_t)row * J.ldd + J.kofs + k0 + kk) = pk2(tile[kk * 129 + nn], tile[(kk + 1) * 129 + nn]); } }
        }
    }
    __syncthreads();
}
__device__ __forceinline__ void zero_rows(const Frame& F, bf16_t* dst, int ldd, int row0, int nrows, int col0, int ncols) {
    const int per = ncols / 8; const long tot = (long)nrows * per;
    for (long i = (long)F.bid * NTHREADS + F.tid; i < tot; i += (long)F.G * NTHREADS) { const int r = (int)(i / per), c = (int)(i % per) * 8;
        *(u32x4*)(dst + (size_t)(row0 + r) * ldd + col0 + c) = (u32x4){0u, 0u, 0u, 0u}; }
}
__device__ __forceinline__ void phase_prologue(const Frame& F) {
    {
        LAS float* sl = (LAS float*)F.lds;
        LAS float* red = (LAS float*)(F.lds + 33 * 256 * 4);
        const float* c = F.in(1); const float* cc = F.in(3); const float* wm = F.in(4); const float* bm = F.in(5);
        const int tx = F.tid & 63, ty = F.tid >> 6;
        for (int unit = F.bid; unit < 4 * 96; unit += F.G) {
            const int layer = unit / 96, col0 = (unit % 96) * 64;
            float acc[33];
#pragma unroll
            for (int r = 0; r < 33; ++r) acc[r] = 0.f;
#pragma unroll 1
            for (int kc = 0; kc < 4; ++kc) {
                __syncthreads();
                for (int i = F.tid; i < 33 * 256; i += NTHREADS) { const int r = i >> 8, k = (i & 255) + kc * 256; const float x = r < 32 ? c[r * D + k] : cc[k]; sl[i] = x * sigmoidf_(x); }
                __syncthreads();
#pragma unroll 1
                for (int k4 = 0; k4 < 32; k4 += 4) {
                    const int kl = ty * 32 + k4;
                    float w[4];
#pragma unroll
                    for (int e = 0; e < 4; ++e) w[e] = wm[((size_t)layer * D + kc * 256 + kl + e) * 6144 + col0 + tx];
#pragma unroll
                    for (int r = 0; r < 33; ++r) { const f32x4 s = *(const LAS f32x4*)(sl + r * 256 + kl); acc[r] += s[0] * w[0] + s[1] * w[1] + s[2] * w[2] + s[3] * w[3]; if ((r & 7) == 7) asm volatile("" ::: "memory"); }
                }
            }
            __syncthreads();
#pragma unroll
            for (int r = 0; r < 33; ++r) red[(ty * 33 + r) * 64 + tx] = acc[r];
            __syncthreads();
            for (int i = F.tid; i < 33 * 64; i += NTHREADS) { const int r = i >> 6, x = i & 63; float s = 0.f;
#pragma unroll
                for (int y = 0; y < 8; ++y) s += red[(y * 33 + r) * 64 + x];
                const int col = col0 + x; s += bm[layer * 6144 + col];
                if (r < 32) F.wsp<float>(WS_MODL)[((size_t)layer * NB + r) * 6144 + col] = s; else F.wsp<float>(WS_MODC)[(size_t)layer * 6144 + col] = s; }
        }
    }
    __syncthreads();
    transpose_all(F);
    for (int a = 0; a < 2; ++a) {
        bf16_t* WLp = F.wsp<bf16_t>(WS_WL) + (size_t)a * 512 * K1CAT;
        if (a == 0) zero_rows(F, WLp, K1CAT, 384, 128, 0, K1CAT); else zero_rows(F, WLp, K1CAT, 416, 96, 0, K1CAT);
        zero_rows(F, F.wsp<bf16_t>(WS_G2T) + (size_t)a * D * 256, 256, 0, D, 128, 128);
    }
    zero_rows(F, F.wsp<bf16_t>(WS_V2T), 256, 0, D, 0, 128); zero_rows(F, F.wsp<bf16_t>(WS_V2T), 256, 0, D, 160, 96);
    {
        const float* src = F.in(33); bf16_t* dst = F.wsp<bf16_t>(WS_WSP); const long tot = (long)2 * 16 * 128 * 128 / 4;
        for (long i = (long)F.bid * NTHREADS + F.tid; i < tot; i += (long)F.G * NTHREADS) { const f32x4 v = *(const f32x4*)(src + i * 4); u32x2 w; w.x = pk2(v[0], v[1]); w.y = pk2(v[2], v[3]); *(u32x2*)(dst + i * 4) = w; }
    }
    __syncthreads();
}

__device__ __forceinline__ void phase_norm1(const Frame& F, int g, int layer  , bf16_t* dst, int ldh, bool dry = false) {
    bf16_t* X = F.wsp<bf16_t>(WS_X);
    const bf16_t* Y0 = F.ar<bf16_t>(AR_YM0); const bf16_t* Y1 = F.ar<bf16_t>(AR_YM1);
    const bool fin = layer == 4;
    const int rpb = (TG + F.G - 1) / F.G, rbeg = F.bid * rpb, rend = (rbeg + rpb) < TG ? (rbeg + rpb) : TG;
    int key = -1; f32x4 cg[4], cA[4], cB[4];
#pragma unroll
    for (int q = 0; q < 4; ++q) { cg[q] = (f32x4){0.f, 0.f, 0.f, 0.f}; cA[q] = cg[q]; cB[q] = cg[q]; }
    for (int r = rbeg + F.wave; r < rend; r += NWAVES) {
        const int bl = r / LT, t = r % LT, b = g * BG + bl; const bool isctx = t < LC;
        if (isctx && layer >= 3) continue;
        if (key != b * 2 + (int)isctx) {
            key = b * 2 + (int)isctx;
#pragma unroll
            for (int q = 0; q < 4; ++q) { const int c = q * 256 + F.lane * 4;
                if (layer > 0) cg[q] = *(const f32x4*)((isctx ? F.modC(layer - 1, 5) : F.modL(layer - 1, b, 5)) + c);
                if (fin) cA[q] = *(const f32x4*)(F.in(41) + c);
                else { const f32x4 gv = *(const f32x4*)(F.in(6) + (size_t)layer * D + c), cv = *(const f32x4*)((isctx ? F.modC(layer, 1) : F.modL(layer, b, 1)) + c);
                    cA[q] = gv * (1.0f + cv); cB[q] = *(const f32x4*)((isctx ? F.modC(layer, 0) : F.modL(layer, b, 0)) + c); } }
        }
        f32x4 x[4], xo[4];
#pragma unroll
        for (int q = 0; q < 4; ++q) xo[q] = (f32x4){0.f, 0.f, 0.f, 0.f};
        if (layer == 0) {
            const float* src = isctx ? F.in(2) + ((size_t)b * LC + t) * D : F.in(0) + ((size_t)b * SEQ + (t - LC)) * D;
#pragma unroll
            for (int q = 0; q < 4; ++q) x[q] = *(const f32x4*)(src + q * 256 + F.lane * 4);
        } else {
#pragma unroll
            for (int q = 0; q < 4; ++q) { const int c = q * 256 + F.lane * 4;
                { const u32x2 xw = *(const u32x2*)(X + (size_t)r * D + c); x[q] = (f32x4){lo16(xw.x), hi16(xw.x), lo16(xw.y), hi16(xw.y)}; } xo[q] = x[q];
                const u32x2 a = *(const u32x2*)(Y0 + (size_t)r * D + c), bb = *(const u32x2*)(Y1 + (size_t)r * D + c);
                x[q][0] += cg[q][0] * (lo16(a.x) + lo16(bb.x)); x[q][1] += cg[q][1] * (hi16(a.x) + hi16(bb.x));
                x[q][2] += cg[q][2] * (lo16(a.y) + lo16(bb.y)); x[q][3] += cg[q][3] * (hi16(a.y) + hi16(bb.y)); }
        }
        float ss = 0.f;
#pragma unroll
        for (int q = 0; q < 4; ++q) ss += x[q][0] * x[q][0] + x[q][1] * x[q][1] + x[q][2] * x[q][2] + x[q][3] * x[q][3];
        ss = wave_sum_dpp(ss);
        const float rstd = rsqrtf(ss * (1.0f / D) + 1e-6f);
        if (fin) {
            float* o = F.outp() + ((size_t)b * SEQ + (t - LC)) * D;
#pragma unroll
            for (int q = 0; q < 4; ++q) { const int c = q * 256 + F.lane * 4; *(f32x4*)(o + c) = x[q] * rstd * cA[q]; }
        } else {
#pragma unroll
            for (int q = 0; q < 4; ++q) { const int c = q * 256 + F.lane * 4;
                { const f32x4 xs = (dry && layer > 0) ? xo[q] : x[q]; u32x2 xw; xw.x = pk2(xs[0], xs[1]); xw.y = pk2(xs[2], xs[3]); *(u32x2*)(X + (size_t)r * D + c) = xw; }
                const f32x4 h = x[q] * rstd * cA[q] + cB[q];
                u32x2 w; w.x = pk2(h[0], h[1]); w.y = pk2(h[2], h[3]);
                *(u32x2*)(dst + (size_t)r * ldh + c) = w; }
        }
    }
}
__device__ __forceinline__ void phase_mix(const Frame& F, int a) {
    bf16_t* H2 = F.ar<bf16_t>(AR_H2); bf16_t* XM = F.ar<bf16_t>(AR_XR);
    const float* mu = F.in(8) + (size_t)a * 6 * D;
    f32x4 cm[2][3][2];
#pragma unroll
    for (int q = 0; q < 2; ++q)
#pragma unroll
        for (int m = 0; m < 3; ++m) { const int mi = m == 0 ? 0 : (m == 1 ? 2 : 3); const int c = q * 512 + F.lane * 8;
            cm[q][m][0] = *(const f32x4*)(mu + mi * D + c); cm[q][m][1] = *(const f32x4*)(mu + mi * D + c + 4); }
    const int rpb = (TG + F.G - 1) / F.G, rbeg = F.bid * rpb, rend = (rbeg + rpb) < TG ? (rbeg + rpb) : TG;
    for (int r = rbeg + F.wave; r < rend; r += NWAVES) {
        const int t = r % LT; const bool isctx = t < LC; const int p = t - LC;
#pragma unroll
        for (int q = 0; q < 2; ++q) {
            const int c = q * 512 + F.lane * 8;
            int nr;
            if (isctx) nr = (q == 0) ? (t > 0 ? r - 1 : -1) : (t < LC - 1 ? r + 1 : -1);
            else { const int qu = c >> 8;
                nr = qu == 0 ? ((p & 63) > 0 ? r - 1 : -1) : qu == 1 ? ((p & 63) < 63 ? r + 1 : -1) : qu == 2 ? (p >= 64 ? r - 64 : -1) : (p < SEQ - 64 ? r + 64 : -1); }
            const u32x4 hs = *(const u32x4*)(H2 + (size_t)r * 2048 + c);
            u32x4 hn = (u32x4){0u, 0u, 0u, 0u};
            if (nr >= 0) hn = *(const u32x4*)(H2 + (size_t)nr * 2048 + c);
            const float h[8] = {lo16(hs.x), hi16(hs.x), lo16(hs.y), hi16(hs.y), lo16(hs.z), hi16(hs.z), lo16(hs.w), hi16(hs.w)};
            const float n[8] = {lo16(hn.x), hi16(hn.x), lo16(hn.y), hi16(hn.y), lo16(hn.z), hi16(hn.z), lo16(hn.w), hi16(hn.w)};
            float dd[8];
#pragma unroll
            for (int e = 0; e < 8; ++e) dd[e] = n[e] - h[e];
            *(u32x4*)(H2 + (size_t)r * 2048 + 1024 + c) = (u32x4){pk2(dd[0], dd[1]), pk2(dd[2], dd[3]), pk2(dd[4], dd[5]), pk2(dd[6], dd[7])};
#pragma unroll
            for (int m = 0; m < 3; ++m) {
                const f32x4 m0 = cm[q][m][0], m1 = cm[q][m][1];
                float x[8];
#pragma unroll
                for (int e = 0; e < 4; ++e) { x[e] = h[e] + dd[e] * m0[e]; x[4 + e] = h[4 + e] + dd[4 + e] * m1[e]; }
                *(u32x4*)(XM + (size_t)m * TG * D + (size_t)r * D + c) = (u32x4){pk2(x[0], x[1]), pk2(x[2], x[3]), pk2(x[4], x[5]), pk2(x[6], x[7])};
            }
        }
    }
}
__device__ __forceinline__ void phase_vfix(const Frame& F) {
    bf16_t* V = F.ar<bf16_t>(AR_V); const bf16_t* VF = F.wsp<bf16_t>(WS_VF); const bf16_t* GT = F.ar<bf16_t>(AR_VGATE);
    const size_t tot = (size_t)TG * D / 8;
    for (size_t i = (size_t)F.bid * NTHREADS + F.tid; i < tot; i += (size_t)F.G * NTHREADS) {
        const u32x4 v = *(const u32x4*)(V + i * 8), f = *(const u32x4*)(VF + i * 8), g = *(const u32x4*)(GT + i * 8);
        u32x4 o;
        o.x = pk2(lo16(v.x) + (lo16(f.x) - lo16(v.x)) * lo16(g.x), hi16(v.x) + (hi16(f.x) - hi16(v.x)) * hi16(g.x));
        o.y = pk2(lo16(v.y) + (lo16(f.y) - lo16(v.y)) * lo16(g.y), hi16(v.y) + (hi16(f.y) - hi16(v.y)) * hi16(g.y));
        o.z = pk2(lo16(v.z) + (lo16(f.z) - lo16(v.z)) * lo16(g.z), hi16(v.z) + (hi16(f.z) - hi16(v.z)) * hi16(g.z));
        o.w = pk2(lo16(v.w) + (lo16(f.w) - lo16(v.w)) * lo16(g.w), hi16(v.w) + (hi16(f.w) - hi16(v.w)) * hi16(g.w));
        *(u32x4*)(V + i * 8) = o;
    }
}
__device__ __forceinline__ void phase_post(const Frame& F, int a, const bf16_t* V) {
    const bf16_t* Y0 = F.ar<bf16_t>(AR_Y0); bf16_t* YG = F.ar<bf16_t>(AR_R); const bf16_t* Y1 = F.ar<bf16_t>(AR_Y1); const float* DOT = F.ar<float>(AR_DOT); const bf16_t* Gb = F.ar<bf16_t>(AR_G);
    const float* lgp = F.in(27) + (size_t)a * D + F.lane * 16; const float* lbp = F.in(28) + (size_t)a * D + F.lane * 16;
    float lg[16], lb[16];
#pragma unroll
    for (int e = 0; e < 16; e += 4) { const f32x4 gq = *(const f32x4*)(lgp + e), bq = *(const f32x4*)(lbp + e);
        lg[e] = gq[0]; lg[e + 1] = gq[1]; lg[e + 2] = gq[2]; lg[e + 3] = gq[3]; lb[e] = bq[0]; lb[e + 1] = bq[1]; lb[e + 2] = bq[2]; lb[e + 3] = bq[3]; }
    const int rpb = (TG + F.G - 1) / F.G, rbeg = F.bid * rpb, rend = (rbeg + rpb) < TG ? (rbeg + rpb) : TG;
    for (int r = rbeg + F.wave; r < rend; r += NWAVES) {
        const int c = F.lane * 16, h = F.lane >> 2;
        float y[16], vv[16];
#pragma unroll
        for (int q = 0; q < 2; ++q) {
            const u32x4 a0 = *(const u32x4*)(Y0 + (size_t)r * D + c + q * 8), a1 = *(const u32x4*)(Y1 + (size_t)r * D + c + q * 8), v4 = *(const u32x4*)(V + (size_t)r * D + c + q * 8);
            y[q * 8 + 0] = lo16(a0.x) + lo16(a1.x); y[q * 8 + 1] = hi16(a0.x) + hi16(a1.x); y[q * 8 + 2] = lo16(a0.y) + lo16(a1.y); y[q * 8 + 3] = hi16(a0.y) + hi16(a1.y);
            y[q * 8 + 4] = lo16(a0.z) + lo16(a1.z); y[q * 8 + 5] = hi16(a0.z) + hi16(a1.z); y[q * 8 + 6] = lo16(a0.w) + lo16(a1.w); y[q * 8 + 7] = hi16(a0.w) + hi16(a1.w);
            vv[q * 8 + 0] = lo16(v4.x); vv[q * 8 + 1] = hi16(v4.x); vv[q * 8 + 2] = lo16(v4.y); vv[q * 8 + 3] = hi16(v4.y);
            vv[q * 8 + 4] = lo16(v4.z); vv[q * 8 + 5] = hi16(v4.z); vv[q * 8 + 6] = lo16(v4.w); vv[q * 8 + 7] = hi16(v4.w);
        }
        float s = 0.f;
#pragma unroll
        for (int e = 0; e < 16; ++e) s += y[e];
        s = red4(s); const float mean = s * (1.0f / 64.0f);
        float qv = 0.f;
#pragma unroll
        for (int e = 0; e < 16; ++e) { const float dd = y[e] - mean; qv += dd * dd; }
        qv = red4(qv); const float rstd = rsqrtf(qv * (1.0f / 64.0f) + 64e-5f);
        const float dsum = DOT[(size_t)r * NH + h] + DOT[((size_t)TG + r) * NH + h];
        unsigned o[8];
        const u32x4 g0 = *(const u32x4*)(Gb + (size_t)r * D + c), g1 = *(const u32x4*)(Gb + (size_t)r * D + c + 8);
        const unsigned gw[8] = {g0.x, g0.y, g0.z, g0.w, g1.x, g1.y, g1.z, g1.w};
#pragma unroll
        for (int e = 0; e < 16; e += 2) {
            const float o0 = ((y[e] - mean) * rstd * lg[e] + lb[e] + vv[e] * dsum) * lo16(gw[e >> 1]);
            const float o1 = ((y[e + 1] - mean) * rstd * lg[e + 1] + lb[e + 1] + vv[e + 1] * dsum) * hi16(gw[e >> 1]);
            o[e >> 1] = pk2(o0, o1);
        }
        *(u32x4*)(YG + (size_t)r * D + c) = (u32x4){o[0], o[1], o[2], o[3]};
        *(u32x4*)(YG + (size_t)r * D + c + 8) = (u32x4){o[4], o[5], o[6], o[7]};
    }
}
__device__ __forceinline__ void phase_norm2(const Frame& F, int g, int layer, bool dry = false) {
    bf16_t* X = F.wsp<bf16_t>(WS_X); bf16_t* HM = F.ar<bf16_t>(AR_HM); const bf16_t* Ob = F.ar<bf16_t>(AR_O);
    int* lists = dry ? F.ar<int>(AR_YM0) : F.ar<int>(AR_LIST); float* lwt = dry ? F.ar<float>(AR_YM0) + (size_t)32 * TG : F.ar<float>(AR_LW);
    unsigned* cnt = (unsigned*)(F.ws + WS_CTL + CTL_CNT_OFF) + (((size_t)g * 4 + layer) * 32 + (dry ? NG * 4 * 32 : 0)) * 16;
    LAS float* wr = (LAS float*)F.lds;
    __syncthreads();
    for (int i = F.tid; i < D * NEXP / 4; i += NTHREADS) { const int c = i >> 2, e4 = i & 3; const int rho = (c & ~255) + (c & 3) * 64 + ((c & 255) >> 2);
        *(LAS f32x4*)(wr + rho * 20 + e4 * 4) = *(const f32x4*)(F.in(36) + i * 4); }
    __syncthreads();
    const float* rbias = F.in(37);
    float rb4[4];
#pragma unroll
    for (int e = 0; e < 4; ++e) rb4[e] = rbias[(F.lane >> 4) * 4 + e];
    const bool ctx_out = layer < 2;
    LAS int* lcnt = (LAS int*)(F.lds + LDS_MISC + 512);
    LAS int* lbase = (LAS int*)(F.lds + LDS_MISC + 640);
    LAS int* rec = (LAS int*)(F.lds + 81920);
    const int rpb = (TG + F.G - 1) / F.G, rbeg = F.bid * rpb, rend = (rbeg + rpb) < TG ? (rbeg + rpb) : TG;
    const int niter = (rpb + NWAVES - 1) / NWAVES;
    int key = -1; f32x4 cg[4], cA[4], cB[4];
#pragma unroll
    for (int q = 0; q < 4; ++q) { cg[q] = (f32x4){0.f, 0.f, 0.f, 0.f}; cA[q] = cg[q]; cB[q] = cg[q]; }
    for (int it0 = 0; it0 < niter; it0 += 64) {
        if (F.tid < 32) lcnt[F.tid] = 0;
        __syncthreads();
        const int itn = (niter - it0) < 64 ? (niter - it0) : 64;
        for (int itl = 0; itl < itn; ++itl) {
            const int r = rbeg + (it0 + itl) * NWAVES + F.wave;
            const int bl = r / LT, t = r % LT, b = g * BG + bl; const bool isctx = t < LC;
            const int slot = itl * NWAVES + F.wave;
            if (r >= rend || (isctx && !ctx_out)) { if (F.lane == 0) rec[slot * 4] = -1; continue; }
            if (key != b * 2 + (int)isctx) {
                key = b * 2 + (int)isctx;
#pragma unroll
                for (int q = 0; q < 4; ++q) { const int c = q * 256 + F.lane * 4;
                    cg[q] = *(const f32x4*)((isctx ? F.modC(layer, 2) : F.modL(layer, b, 2)) + c);
                    const f32x4 gv = *(const f32x4*)(F.in(7) + (size_t)layer * D + c), cv = *(const f32x4*)((isctx ? F.modC(layer, 4) : F.modL(layer, b, 4)) + c);
                    cA[q] = gv * (1.0f + cv); cB[q] = *(const f32x4*)((isctx ? F.modC(layer, 3) : F.modL(layer, b, 3)) + c); }
            }
            f32x4 x[4]; float ss = 0.f;
#pragma unroll
            for (int q = 0; q < 4; ++q) { const int c = q * 256 + F.lane * 4;
                { const u32x2 xw = *(const u32x2*)(X + (size_t)r * D + c); x[q] = (f32x4){lo16(xw.x), hi16(xw.x), lo16(xw.y), hi16(xw.y)}; }
                const u32x2 ob = *(const u32x2*)(Ob + (size_t)r * D + c); const f32x4 gv = cg[q];
                const f32x4 xo = x[q];
                x[q][0] += gv[0] * lo16(ob.x); x[q][1] += gv[1] * hi16(ob.x); x[q][2] += gv[2] * lo16(ob.y); x[q][3] += gv[3] * hi16(ob.y);
                { const f32x4 xs = dry ? xo : x[q]; u32x2 xw; xw.x = pk2(xs[0], xs[1]); xw.y = pk2(xs[2], xs[3]); *(u32x2*)(X + (size_t)r * D + c) = xw; }
                ss += x[q][0] * x[q][0] + x[q][1] * x[q][1] + x[q][2] * x[q][2] + x[q][3] * x[q][3]; }
            ss = wave_sum_dpp(ss);
            const float rstd = rsqrtf(ss * (1.0f / D) + 1e-6f);
            float lg[16];
#pragma unroll
            for (int e = 0; e < 16; ++e) lg[e] = 0.f;
#pragma unroll
            for (int q = 0; q < 4; ++q) { const int c = q * 256 + F.lane * 4;
                const f32x4 h = x[q] * rstd * cA[q] + cB[q];
                u32x2 w; w.x = pk2(h[0], h[1]); w.y = pk2(h[2], h[3]);
                *(u32x2*)(HM + (size_t)r * D + c) = w;
#pragma unroll
                for (int j = 0; j < 4; ++j) {
#pragma unroll
                    for (int e4 = 0; e4 < 4; ++e4) { const f32x4 wv = *(const LAS f32x4*)(wr + (q * 256 + j * 64 + F.lane) * 20 + e4 * 4);
                        lg[e4 * 4 + 0] += h[j] * wv[0]; lg[e4 * 4 + 1] += h[j] * wv[1]; lg[e4 * 4 + 2] += h[j] * wv[2]; lg[e4 * 4 + 3] += h[j] * wv[3]; } }
            }
            float m8[8], xg[4];
#pragma unroll
            for (int e = 0; e < 8; ++e) { const auto sw = __builtin_amdgcn_permlane32_swap(__float_as_uint(lg[e]), __float_as_uint(lg[e + 8]), false, false); m8[e] = __uint_as_float(sw[0]) + __uint_as_float(sw[1]); }
#pragma unroll
            for (int e = 0; e < 4; ++e) { const auto sw = __builtin_amdgcn_permlane16_swap(__float_as_uint(m8[e]), __float_as_uint(m8[e + 4]), false, false); xg[e] = red16(__uint_as_float(sw[0]) + __uint_as_float(sw[1])); }
            float sc_[4], bs[4];
#pragma unroll
            for (int e = 0; e < 4; ++e) { sc_[e] = sigmoidf_(xg[e]); bs[e] = sc_[e] + rb4[e]; }
            const float hi01 = fmaxf(bs[0], bs[1]), lo01 = fminf(bs[0], bs[1]), hi23 = fmaxf(bs[2], bs[3]), lo23 = fminf(bs[2], bs[3]);
            const float gsc = fmaxf(hi01, hi23) + fmaxf(fminf(hi01, hi23), fmaxf(lo01, lo23));
            const float g0s = __int_as_float(__builtin_amdgcn_readlane(__float_as_int(gsc), 0)), g1s = __int_as_float(__builtin_amdgcn_readlane(__float_as_int(gsc), 16));
            const float g2s = __int_as_float(__builtin_amdgcn_readlane(__float_as_int(gsc), 32)), g3s = __int_as_float(__builtin_amdgcn_readlane(__float_as_int(gsc), 48));
            const bool c10 = g1s > g0s, c32 = g3s > g2s; const float v01 = c10 ? g1s : g0s, v23 = c32 ? g3s : g2s; const bool chi = v23 > v01;
            const int best = __builtin_amdgcn_readfirstlane(chi ? (c32 ? 3 : 2) : (c10 ? 1 : 0));
            float cb[4], cs[4];
#pragma unroll
            for (int e = 0; e < 4; ++e) { cb[e] = __int_as_float(__builtin_amdgcn_readlane(__float_as_int(bs[e]), best * 16)); cs[e] = __int_as_float(__builtin_amdgcn_readlane(__float_as_int(sc_[e]), best * 16)); }
            const bool d10 = cb[1] > cb[0], d32 = cb[3] > cb[2]; const float w01 = d10 ? cb[1] : cb[0], w23 = d32 ? cb[3] : cb[2]; const bool dhi = w23 > w01;
            const int j1 = dhi ? (d32 ? 3 : 2) : (d10 ? 1 : 0);
            const float e0 = j1 == 0 ? -1e30f : cb[0], e1 = j1 == 1 ? -1e30f : cb[1], e2 = j1 == 2 ? -1e30f : cb[2], e3 = j1 == 3 ? -1e30f : cb[3];
            const bool f10 = e1 > e0, f32_ = e3 > e2; const float u01 = f10 ? e1 : e0, u23 = f32_ ? e3 : e2; const bool fhi = u23 > u01;
            const int j2 = fhi ? (f32_ ? 3 : 2) : (f10 ? 1 : 0);
            const float s1 = (j1 & 2) ? ((j1 & 1) ? cs[3] : cs[2]) : ((j1 & 1) ? cs[1] : cs[0]);
            const float s2 = (j2 & 2) ? ((j2 & 1) ? cs[3] : cs[2]) : ((j2 & 1) ? cs[1] : cs[0]);
            const float inv = __builtin_amdgcn_rcpf(s1 + s2);
            if (F.lane == 0) {
                const int l1 = (best * 4 + j1) * 2 + 0, l2 = (best * 4 + j2) * 2 + 1;
                const int p1 = __hip_atomic_fetch_add(lcnt + l1, 1, __ATOMIC_RELAXED, __HIP_MEMORY_SCOPE_WORKGROUP);
                const int p2 = __hip_atomic_fetch_add(lcnt + l2, 1, __ATOMIC_RELAXED, __HIP_MEMORY_SCOPE_WORKGROUP);
                rec[slot * 4 + 0] = l1 | (p1 << 8); rec[slot * 4 + 1] = l2 | (p2 << 8);
                rec[slot * 4 + 2] = __float_as_int(s1 * inv); rec[slot * 4 + 3] = __float_as_int(s2 * inv);
            }
        }
        __syncthreads();
        if (F.tid < 32) { const int c = lcnt[F.tid]; lbase[F.tid] = c ? (int)atomicAdd(&cnt[F.tid * 16], (unsigned)c) : 0; }
        __syncthreads();
        for (int slot = F.tid; slot < itn * NWAVES; slot += NTHREADS) {
            const int a0 = rec[slot * 4 + 0]; if (a0 < 0) continue;
            const int a1 = rec[slot * 4 + 1];
            const int r = rbeg + (it0 + slot / NWAVES) * NWAVES + (slot % NWAVES);
            const int l1 = a0 & 255, l2 = a1 & 255; const int q1 = lbase[l1] + (a0 >> 8), q2 = lbase[l2] + (a1 >> 8);
            lists[(size_t)l1 * TG + q1] = r; lwt[(size_t)l1 * TG + q1] = __int_as_float(rec[slot * 4 + 2]);
            lists[(size_t)l2 * TG + q2] = r; lwt[(size_t)l2 * TG + q2] = __int_as_float(rec[slot * 4 + 3]);
        }
        __syncthreads();
    }
}
__device__ __forceinline__ int moe_tables(const Frame& F, int g, int layer) {
    LAS int* cn = (LAS int*)(F.lds + LDS_MISC + 64); LAS int* tb = (LAS int*)(F.lds + LDS_MISC + 192);
    const unsigned* cnt = (const unsigned*)(F.ws + WS_CTL + CTL_CNT_OFF) + ((size_t)g * 4 + layer) * 32 * 16;
    __syncthreads();
    if (F.tid < 32) cn[F.tid] = (int)__hip_atomic_load(cnt + F.tid * 16, __ATOMIC_RELAXED, __HIP_MEMORY_SCOPE_AGENT);
    __syncthreads();
    if (F.tid == 0) { int acc = 0; for (int l = 0; l < 32; ++l) { tb[l] = acc; acc += (cn[l] + 255) >> 8; } tb[32] = acc; }
    __syncthreads();
    return tb[32];
}

constexpr int SC_OPB = 6 * 4096;
constexpr int SC_HALF = 2 * SC_OPB + 4096 + 4096;
static_assert(2 * SC_HALF <= LDS_STAGE, "scan lds");
__device__ __forceinline__ int scan_tok(int d, int s) { return d == 0 ? s : (s < LC ? (LC - 1 - s) : (LT + LC - 1 - s)); }

constexpr int S4_KKP = 0, S4_RPP = 2048, S4_KDP = 4096, S4_KAP = 6144, S4_KDT = 8192, S4_KAT = 10496, S4_VT = 12800, S4_P15 = 15104, S4_PBSZ = 15360,
              S4_A1 = 30720, S4_B1 = 31232, S4_B2 = 31744, S4_A2 = 32256, S4_MI = 33280, S4_LI = 33792, S4_LX = 37888, S4_AT = 41984, S4_YB = 46080, S4_HALF = 50176;
static_assert(2 * S4_HALF <= LDS_STAGE, "scan4 lds");
#define MF16(a, b, c) __builtin_amdgcn_mfma_f32_16x16x32_bf16((a), (b), (c), 0, 0, 0)
__device__ __forceinline__ bf16x8 mkfrag(unsigned a, unsigned b, unsigned c, unsigned d) { return __builtin_bit_cast(bf16x8, (u32x4){a, b, c, d}); }
__device__ __forceinline__ void scan_inverse(LAS unsigned char* hb, int g, int j) {
    f32x2 ac2[8];
#pragma unroll
    for (int p_ = 0; p_ < 8; ++p_) ac2[p_] = (f32x2){j == 2 * p_ ? 1.f : 0.f, j == 2 * p_ + 1 ? 1.f : 0.f};
    float Mr[16];
    {
        f32x4 rw[3][4];
#pragma unroll
        for (int u = 15; u >= 13; --u)
#pragma unroll
            for (int x_ = 0; x_ * 4 < u; ++x_) rw[u - 13][x_] = *(const LAS f32x4*)((LAS float*)(hb + S4_A2) + u * 16 + 4 * x_);
        __builtin_amdgcn_sched_barrier(0);
#pragma unroll
        for (int u = 15; u >= 13; --u) {
            const float mu = ac2[u >> 1][u & 1]; Mr[u] = mu;
#pragma unroll
            for (int x_ = 0; x_ * 4 < u; ++x_) {
                const f32x4 av_ = rw[u - 13][x_];
                ac2[2 * x_] = ac2[2 * x_] - (f32x2){mu, mu} * (f32x2){av_[0], av_[1]};
                if (4 * x_ + 2 < u) ac2[2 * x_ + 1] = ac2[2 * x_ + 1] - (f32x2){mu, mu} * (f32x2){av_[2], av_[3]};
            }
        }
        __builtin_amdgcn_sched_barrier(0); asm volatile("" ::: "memory");
    }
    {
        f32x4 rw[4][3];
#pragma unroll
        for (int u = 12; u >= 9; --u)
#pragma unroll
            for (int x_ = 0; x_ * 4 < u; ++x_) rw[u - 9][x_] = *(const LAS f32x4*)((LAS float*)(hb + S4_A2) + u * 16 + 4 * x_);
        __builtin_amdgcn_sched_barrier(0);
#pragma unroll
        for (int u = 12; u >= 9; --u) {
            const float mu = ac2[u >> 1][u & 1]; Mr[u] = mu;
#pragma unroll
            for (int x_ = 0; x_ * 4 < u; ++x_) {
                const f32x4 av_ = rw[u - 9][x_];
                ac2[2 * x_] = ac2[2 * x_] - (f32x2){mu, mu} * (f32x2){av_[0], av_[1]};
                if (4 * x_ + 2 < u) ac2[2 * x_ + 1] = ac2[2 * x_ + 1] - (f32x2){mu, mu} * (f32x2){av_[2], av_[3]};
            }
        }
        __builtin_amdgcn_sched_barrier(0); asm volatile("" ::: "memory");
    }
    {
        f32x4 rw[8][2];
#pragma unroll
        for (int u = 8; u >= 1; --u)
#pragma unroll
            for (int x_ = 0; x_ * 4 < u; ++x_) rw[u - 1][x_] = *(const LAS f32x4*)((LAS float*)(hb + S4_A2) + u * 16 + 4 * x_);
        __builtin_amdgcn_sched_barrier(0);
#pragma unroll
        for (int u = 8; u >= 1; --u) {
            const float mu = ac2[u >> 1][u & 1]; Mr[u] = mu;
#pragma unroll
            for (int x_ = 0; x_ * 4 < u; ++x_) {
                const f32x4 av_ = rw[u - 1][x_];
                ac2[2 * x_] = ac2[2 * x_] - (f32x2){mu, mu} * (f32x2){av_[0], av_[1]};
                if (4 * x_ + 2 < u) ac2[2 * x_ + 1] = ac2[2 * x_ + 1] - (f32x2){mu, mu} * (f32x2){av_[2], av_[3]};
            }
        }
        __builtin_amdgcn_sched_barrier(0); asm volatile("" ::: "memory");
    }
    Mr[0] = ac2[0][0];
    u32x4 m0 = (u32x4){pk2(Mr[0], Mr[1]), pk2(Mr[2], Mr[3]), pk2(Mr[4], Mr[5]), pk2(Mr[6], Mr[7])}, m1 = (u32x4){pk2(Mr[8], Mr[9]), pk2(Mr[10], Mr[11]), pk2(Mr[12], Mr[13]), pk2(Mr[14], Mr[15])};
    asm volatile("" : "+v"(m0), "+v"(m1));
    if (g == 0) { *(LAS u32x4*)(hb + S4_MI + j * 32) = m0; *(LAS u32x4*)(hb + S4_MI + j * 32 + 16) = m1; }
}
__device__ __forceinline__ void phase_scan4(const Frame& F, int a, const bf16_t* V) {
    const bf16_t* R = F.ar<bf16_t>(AR_R); const bf16_t* Kb = F.ar<bf16_t>(AR_K); const bf16_t* L1 = F.ar<bf16_t>(AR_L1);
    const int half = F.wave >> 2, q = F.wave & 3, lane = F.lane, li = q * 64 + lane;
    const int role = (q - half) & 3;
    LAS unsigned char* hb = F.lds + half * S4_HALF;
    const int arr = q >> 1, ntl = (q & 1) * 2;
    const int g = lane >> 4, j = lane & 15;
    const int tB = li >> 4, k4 = (li & 15) * 4;
    const int poff = (tB * 64 + (k4 >> 5) * 32 + ((k4 >> 2) & 3) * 8 + ((k4 >> 4) & 1) * 4) * 2;
    for (int pr = F.bid; pr < BG * 16; pr += F.G) {
        const int bl = pr >> 4, d = (pr >> 3) & 1, hp = pr & 7, h = hp * 2 + half;
        bf16_t* Yd = F.ar<bf16_t>(d ? AR_Y1 : AR_Y0); float* DOT = F.ar<float>(AR_DOT) + (size_t)d * TG * NH;
        const size_t rowb = (size_t)bl * LT;
        const bf16_t* W2 = (arr == 0 ? F.wsp<bf16_t>(WS_W2T) : F.wsp<bf16_t>(WS_A2T)) + ((size_t)a * 2 + d) * D * 64;
        const float* b0p = (arr == 0 ? F.in(13) : F.in(16)) + ((size_t)a * 2 + d) * D + h * 64;
        const int acol = arr * 128 + d * 64 + 8 * (lane >> 4);
        f32x4 Cb[4];
#pragma unroll
        for (int b = 0; b < 4; ++b) Cb[b] = (f32x4){0.f, 0.f, 0.f, 0.f};
        bf16x8 Af[2]; u32x2 kraw, rraw, vraw;
        bf16x8 wf0[2], wf1[2]; float bias2[2];
#pragma unroll
        for (int nt = 0; nt < 2; ++nt) { const int n = (ntl + nt) * 16 + (lane & 15); bias2[nt] = b0p[n];
            wf0[nt] = *(const bf16x8*)(W2 + (size_t)(h * 64 + n) * 64 + 8 * (lane >> 4)); wf1[nt] = *(const bf16x8*)(W2 + (size_t)(h * 64 + n) * 64 + 32 + 8 * (lane >> 4)); }
        const f32x4 kkc = *(const f32x4*)(F.in(24) + (size_t)a * D + h * 64 + k4), kac = *(const f32x4*)(F.in(25) + (size_t)a * D + h * 64 + k4), rkc = *(const f32x4*)(F.in(26) + (size_t)a * D + h * 64 + k4);
#define SC_BAR() asm volatile("s_waitcnt lgkmcnt(0)\n\ts_barrier" ::: "memory")
#define SC_LOAD(ch) do { const size_t rowA = rowb + scan_tok(d, (ch) * 16 + (lane & 15)); \
        Af[0] = *(const bf16x8*)(L1 + rowA * 512 + acol); Af[1] = *(const bf16x8*)(L1 + rowA * 512 + acol + 32); \
        const size_t rowBq = (rowb + scan_tok(d, (ch) * 16 + tB)) * D + h * 64 + k4; \
        kraw = *(const u32x2*)(Kb + rowBq); rraw = *(const u32x2*)(R + rowBq); vraw = *(const u32x2*)(V + rowBq); } while (0)
#define SC_PASSA() do { \
        _Pragma("unroll") for (int nt = 0; nt < 2; ++nt) { f32x4 ac = (f32x4){0.f, 0.f, 0.f, 0.f}; \
            const int n = (ntl + nt) * 16 + (lane & 15); const float bias_ = bias2[nt]; \
            ac = MF16(Af[0], wf0[nt], ac); ac = MF16(Af[1], wf1[nt], ac); \
            f32x4 sg; _Pragma("unroll") for (int rg = 0; rg < 4; ++rg) sg[rg] = sigmoidf_(ac[rg] + bias_); \
            if (arr == 0) { \
                const float l0 = -0.60653066f * sg[0], l1 = -0.60653066f * sg[1], l2 = -0.60653066f * sg[2], l3 = -0.60653066f * sg[3]; \
                const float p0 = l0, p1 = p0 + l1, p2 = p1 + l2, p3 = p2 + l3;                         \
                const auto s16 = __builtin_amdgcn_permlane16_swap(__float_as_uint(p3), __float_as_uint(p3), false, false);     \
                const float sv = __uint_as_float(s16[0]), pq = sv + __uint_as_float(s16[1]); \
                const auto s32 = __builtin_amdgcn_permlane32_swap(__float_as_uint(pq), __float_as_uint(pq), false, false);     \
                const float E = ((g & 1) ? sv : 0.f) + ((g & 2) ? __uint_as_float(s32[0]) : 0.f);      \
                LAS float* li_ = (LAS float*)(hb + S4_LI) + (4 * g) * 64 + n; LAS float* lx_ = (LAS float*)(hb + S4_LX) + (4 * g) * 64 + n; \
                li_[0] = E + p0; li_[64] = E + p1; li_[128] = E + p2; li_[192] = E + p3; lx_[0] = E; lx_[64] = E + p0; lx_[128] = E + p1; lx_[192] = E + p2; \
            } else { _Pragma("unroll") for (int rg = 0; rg < 4; ++rg) ((LAS float*)(hb + S4_AT))[(4 * g + rg) * 64 + n] = sg[rg]; } } } while (0)
#define SC_PASSB(ch, pbo_) do { LAS unsigned char* hq_ = hb + (pbo_); \
        const float kf[4] = {lo16(kraw.x), hi16(kraw.x), lo16(kraw.y), hi16(kraw.y)}; const float rf[4] = {lo16(rraw.x), hi16(rraw.x), lo16(rraw.y), hi16(rraw.y)}; \
        const f32x4 av = *(const LAS f32x4*)((LAS float*)(hb + S4_AT) + tB * 64 + k4), Li = *(const LAS f32x4*)((LAS float*)(hb + S4_LI) + tB * 64 + k4), Lx = *(const LAS f32x4*)((LAS float*)(hb + S4_LX) + tB * 64 + k4); \
        float kq[4], ssq = 0.f; _Pragma("unroll") for (int e = 0; e < 4; ++e) { kq[e] = kf[e] * kkc[e]; ssq += kq[e] * kq[e]; } \
        ssq = red16(ssq); const float inv = __builtin_amdgcn_rsqf(fmaxf(ssq, 1e-24f)); \
        float o_kk[4], o_ka[4], o_kd[4], o_r[4]; f32x4 o_p; float dp = 0.f; \
        _Pragma("unroll") for (int e = 0; e < 4; ++e) { const float Pt = __expf(Li[e]), Px = __expf(Lx[e]), iP = __builtin_amdgcn_rcpf(Pt); \
            const float kkv = kq[e] * inv; const float kd = kf[e] * (1.0f + (av[e] - 1.0f) * kac[e]); const float ka = kkv * av[e]; \
            o_kk[e] = kkv * Px; o_ka[e] = ka * iP; o_kd[e] = kd * iP; o_r[e] = rf[e] * Pt; o_p[e] = Pt; \
            dp += rf[e] * kd * rkc[e]; } \
        dp = red16(dp); \
        if ((li & 15) == 0) DOT[(rowb + scan_tok(d, (ch) * 16 + tB)) * NH + h] = dp; \
        const u32x2 w_kk = (u32x2){pk2(o_kk[0], o_kk[1]), pk2(o_kk[2], o_kk[3])}, w_r = (u32x2){pk2(o_r[0], o_r[1]), pk2(o_r[2], o_r[3])}; \
        const u32x2 w_kd = (u32x2){pk2(o_kd[0], o_kd[1]), pk2(o_kd[2], o_kd[3])}, w_ka = (u32x2){pk2(o_ka[0], o_ka[1]), pk2(o_ka[2], o_ka[3])}; \
        *(LAS u32x2*)(hq_ + S4_KKP + poff) = w_kk; *(LAS u32x2*)(hq_ + S4_RPP + poff) = w_r; *(LAS u32x2*)(hq_ + S4_KDP + poff) = w_kd; *(LAS u32x2*)(hq_ + S4_KAP + poff) = w_ka; \
        { LAS unsigned char* td = hq_ + S4_KDT + k4 * 36 + tB * 2; LAS unsigned char* ta = hq_ + S4_KAT + k4 * 36 + tB * 2; LAS unsigned char* tv = hq_ + S4_VT + k4 * 36 + tB * 2; \
          *(LAS unsigned short*)(td) = (unsigned short)w_kd.x; *(LAS unsigned short*)(td + 36) = (unsigned short)(w_kd.x >> 16); *(LAS unsigned short*)(td + 72) = (unsigned short)w_kd.y; *(LAS unsigned short*)(td + 108) = (unsigned short)(w_kd.y >> 16); \
          *(LAS unsigned short*)(ta) = (unsigned short)w_ka.x; *(LAS unsigned short*)(ta + 36) = (unsigned short)(w_ka.x >> 16); *(LAS unsigned short*)(ta + 72) = (unsigned short)w_ka.y; *(LAS unsigned short*)(ta + 108) = (unsigned short)(w_ka.y >> 16); \
          *(LAS unsigned short*)(tv) = (unsigned short)vraw.x; *(LAS unsigned short*)(tv + 36) = (unsigned short)(vraw.x >> 16); *(LAS unsigned short*)(tv + 72) = (unsigned short)vraw.y; *(LAS unsigned short*)(tv + 108) = (unsigned short)(vraw.y >> 16); } \
        if (tB == 15) *(LAS f32x4*)((LAS float*)(hq_ + S4_P15) + k4) = o_p; } while (0)
#define SC_PROD(pbo_) do { LAS unsigned char* hq_ = hb + (pbo_); \
        const int lo_ = (role < 2 ? S4_KKP : S4_RPP) + j * 128 + g * 16, ro_ = ((role == 0 || role == 3) ? S4_KAP : S4_KDP) + j * 128 + g * 16; \
        f32x4 pa = (f32x4){0.f, 0.f, 0.f, 0.f}; \
        pa = MF16(*(const LAS bf16x8*)(hq_ + lo_), *(const LAS bf16x8*)(hq_ + ro_), pa); pa = MF16(*(const LAS bf16x8*)(hq_ + lo_ + 64), *(const LAS bf16x8*)(hq_ + ro_ + 64), pa); \
        _Pragma("unroll") for (int r_ = 0; r_ < 4; ++r_) { const int t_ = 4 * g + r_; const bool keep = (role < 2) ? (j < t_) : (j <= t_); pa[r_] = keep ? pa[r_] : 0.f; } \
        if (role == 0) { LAS float* dm = (LAS float*)(hb + S4_A2) + (4 * g) * 16 + j; dm[0] = pa[0]; dm[16] = pa[1]; dm[32] = pa[2]; dm[48] = pa[3]; \
            __builtin_amdgcn_fence(__ATOMIC_RELEASE, "wavefront"); __builtin_amdgcn_wave_barrier(); __builtin_amdgcn_fence(__ATOMIC_ACQUIRE, "wavefront"); \
            scan_inverse(hb, g, j); } \
        else { LAS unsigned char* dm = hb + (role == 1 ? S4_A1 : (role == 2 ? S4_B1 : S4_B2)) + ((4 * g) * 16 + j) * 2; const unsigned w0_ = pk2(pa[0], pa[1]), w1_ = pk2(pa[2], pa[3]); \
            *(LAS unsigned short*)(dm) = (unsigned short)w0_; *(LAS unsigned short*)(dm + 32) = (unsigned short)(w0_ >> 16); *(LAS unsigned short*)(dm + 64) = (unsigned short)w1_; *(LAS unsigned short*)(dm + 96) = (unsigned short)(w1_ >> 16); } } while (0)
        constexpr int NCH = LT / 16;
        __syncthreads();
        SC_LOAD(0);
        SC_PASSA();
        SC_BAR();
        SC_PASSB(0, 0);
        SC_BAR();
        SC_LOAD(1);
        SC_PASSA();
        SC_PROD(0);
        SC_BAR();
        SC_PASSB(1, S4_PBSZ);
        SC_BAR();
        for (int ch = 0; ch < NCH; ++ch) {
            const int pbo = (ch & 1) * S4_PBSZ;
            LAS unsigned char* hc = hb + pbo;
            if (ch + 2 < NCH) SC_LOAD(ch + 2);
            const bf16x8 Bs0 = mkfrag(pk2(Cb[0][0], Cb[0][1]), pk2(Cb[0][2], Cb[0][3]), pk2(Cb[1][0], Cb[1][1]), pk2(Cb[1][2], Cb[1][3]));
            const bf16x8 Bs1 = mkfrag(pk2(Cb[2][0], Cb[2][1]), pk2(Cb[2][2], Cb[2][3]), pk2(Cb[3][0], Cb[3][1]), pk2(Cb[3][2], Cb[3][3]));
            f32x4 X = (f32x4){0.f, 0.f, 0.f, 0.f}, H = (f32x4){0.f, 0.f, 0.f, 0.f};
            X = MF16(*(const LAS bf16x8*)(hc + S4_KKP + j * 128 + g * 16), Bs0, X); H = MF16(*(const LAS bf16x8*)(hc + S4_RPP + j * 128 + g * 16), Bs0, H);
            X = MF16(*(const LAS bf16x8*)(hc + S4_KKP + j * 128 + g * 16 + 64), Bs1, X); H = MF16(*(const LAS bf16x8*)(hc + S4_RPP + j * 128 + g * 16 + 64), Bs1, H);
            const u32x2 vw = (u32x2){*(const LAS unsigned*)(hc + S4_VT + (16 * q + j) * 36 + 8 * g), *(const LAS unsigned*)(hc + S4_VT + (16 * q + j) * 36 + 8 * g + 4)};
            const bf16x8 Bv = mkfrag(vw.x, vw.y, 0u, 0u);
            {
                const u32x2 a1w = *(const LAS u32x2*)(hb + S4_A1 + (j * 16 + 4 * g) * 2), b1w = *(const LAS u32x2*)(hb + S4_B1 + (j * 16 + 4 * g) * 2);
                X = MF16(mkfrag(a1w.x, a1w.y, 0u, 0u), Bv, X); H = MF16(mkfrag(b1w.x, b1w.y, 0u, 0u), Bv, H);
            }
            const u32x2 mw = *(const LAS u32x2*)(hb + S4_MI + j * 32 + g * 8);
            f32x4 SA = (f32x4){0.f, 0.f, 0.f, 0.f};
            SA = MF16(mkfrag(mw.x, mw.y, 0u, 0u), mkfrag(pk2(X[0], X[1]), pk2(X[2], X[3]), 0u, 0u), SA);
            const bf16x8 Bn = mkfrag(pk2(-SA[0], -SA[1]), pk2(-SA[2], -SA[3]), 0u, 0u);
            {
                const u32x2 b2w = *(const LAS u32x2*)(hb + S4_B2 + (j * 16 + 4 * g) * 2);
                H = MF16(mkfrag(b2w.x, b2w.y, 0u, 0u), Bn, H);
                LAS float* yb = (LAS float*)(hb + S4_YB) + (4 * g) * 64 + 16 * q + j; yb[0] = H[0]; yb[64] = H[1]; yb[128] = H[2]; yb[192] = H[3];
            }
#pragma unroll
            for (int b = 0; b < 4; ++b) {
                const u32x2 kdw = (u32x2){*(const LAS unsigned*)(hc + S4_KDT + (16 * b + j) * 36 + 8 * g), *(const LAS unsigned*)(hc + S4_KDT + (16 * b + j) * 36 + 8 * g + 4)};
                const u32x2 kaw = (u32x2){*(const LAS unsigned*)(hc + S4_KAT + (16 * b + j) * 36 + 8 * g), *(const LAS unsigned*)(hc + S4_KAT + (16 * b + j) * 36 + 8 * g + 4)};
                Cb[b] = MF16(mkfrag(kdw.x, kdw.y, 0u, 0u), Bv, Cb[b]);
                Cb[b] = MF16(mkfrag(kaw.x, kaw.y, 0u, 0u), Bn, Cb[b]);
            }
#pragma unroll
            for (int b = 0; b < 4; ++b) { const f32x4 pv = *(const LAS f32x4*)((LAS float*)(hc + S4_P15) + 16 * b + 4 * g); Cb[b] = Cb[b] * pv; }
            if (ch + 2 < NCH) SC_PASSA();
            SC_BAR();
            {
                const f32x4 yv = *(const LAS f32x4*)((LAS float*)(hb + S4_YB) + tB * 64 + k4);
                u32x2 w; w.x = pk2(yv[0], yv[1]); w.y = pk2(yv[2], yv[3]);
                *(u32x2*)(Yd + (rowb + scan_tok(d, ch * 16 + tB)) * D + h * 64 + k4) = w;
            }
            if (ch + 2 < NCH) SC_PASSB(ch + 2, pbo);
            __builtin_amdgcn_sched_barrier(0);
            if (ch + 1 < NCH) SC_PROD(pbo ^ S4_PBSZ);
            SC_BAR();
        }
#undef SC_LOAD
#undef SC_PASSA
#undef SC_PASSB
#undef SC_PROD
    }
}

__device__ __forceinline__ void phase_sgstats(const Frame& F, int layer) {
    const bf16_t* Z = F.ar<bf16_t>(AR_Z); float* ST = F.ar<float>(AR_ST);
    for (int r = F.bid * NWAVES + F.wave; r < TG; r += F.G * NWAVES) {
        const int t = r % LT; if (t < LC && layer >= 3) continue;
        float x[32];
#pragma unroll
        for (int q = 0; q < 4; ++q) { const u32x4 w = *(const u32x4*)(Z + (size_t)r * 4096 + 2048 + q * 512 + F.lane * 8);
            x[q * 8 + 0] = lo16(w.x); x[q * 8 + 1] = hi16(w.x); x[q * 8 + 2] = lo16(w.y); x[q * 8 + 3] = hi16(w.y); x[q * 8 + 4] = lo16(w.z); x[q * 8 + 5] = hi16(w.z); x[q * 8 + 6] = lo16(w.w); x[q * 8 + 7] = hi16(w.w); }
        float s = 0.f;
#pragma unroll
        for (int e = 0; e < 32; ++e) s += x[e];
        s = wave_sum(s); const float mean = s * (1.0f / 2048.0f);
        float qv = 0.f;
#pragma unroll
        for (int e = 0; e < 32; ++e) { const float dd = x[e] - mean; qv += dd * dd; }
        qv = wave_sum(qv);
        if (F.lane == 0) *(f32x2*)(ST + (size_t)r * 2) = (f32x2){mean, rsqrtf(qv * (1.0f / 2048.0f) + 1e-5f)};
    }
}
__device__ __forceinline__ int vt_off(int dch, int jb) { return dch * 256 + ((jb ^ ((dch & 15) ^ (((dch >> 4) & 7) << 1))) << 4); }
__device__ __forceinline__ void phase_spatial(const Frame& F, int bsg, int layer) {
    const bf16_t* Z = F.ar<bf16_t>(AR_Z); const float* ST = F.ar<float>(AR_ST); bf16_t* Pb = F.ar<bf16_t>(AR_P);
    const bf16_t* Ws = F.wsp<bf16_t>(WS_WSP) + (size_t)bsg * 16 * 128 * 128;
    const float* lng = F.in(31) + (size_t)bsg * 2048; const float* lnb = F.in(32) + (size_t)bsg * 2048; const float* bs = F.in(34) + (size_t)bsg * 16 * 128;
    LAS unsigned char* vt = F.lds;
    const int skip = layer >= 3;
    const int nchunk = skip ? BG * 16 : BG * 18;
    const int w = F.wave, lane = F.lane, dt = w >> 1, it0 = (w & 1) * 2;
    const int jj0 = F.tid >> 4, c8 = (F.tid & 15) * 8;
    u32x4 zz[4]; f32x2 st[4];
#define SP_ROW0(U_) ((size_t)(skip ? (((U_) >> 4) >> 4) * 18 + 2 + (((U_) >> 4) & 15) : ((U_) >> 4)) * 128)
#define SP_LOADZ(U_) do { const size_t r0_ = SP_ROW0(U_); const int gi_ = (U_) & 15; _Pragma("unroll") for (int k = 0; k < 4; ++k) { \
        zz[k] = *(const u32x4*)(Z + (r0_ + jj0 + 32 * k) * 4096 + 2048 + gi_ * 128 + c8); st[k] = *(const f32x2*)(ST + (r0_ + jj0 + 32 * k) * 2); } } while (0)
    if (F.bid < nchunk * 16) SP_LOADZ(F.bid);
    int gic = -1; float gg[8], bb[8], bias[2]; bf16x8 B0[8], B1[8];
#pragma unroll
    for (int e = 0; e < 8; ++e) { gg[e] = 0.f; bb[e] = 0.f; B0[e] = (bf16x8){0, 0, 0, 0, 0, 0, 0, 0}; B1[e] = B0[e]; }
    bias[0] = bias[1] = 0.f;
    for (int U = F.bid; U < nchunk * 16; U += F.G) {
        const int gi = U & 15;
        const size_t row0 = SP_ROW0(U);
        if (gi != gic) {
            gic = gi;
            const f32x4 g0 = *(const f32x4*)(lng + gi * 128 + c8), g1 = *(const f32x4*)(lng + gi * 128 + c8 + 4), b0 = *(const f32x4*)(lnb + gi * 128 + c8), b1 = *(const f32x4*)(lnb + gi * 128 + c8 + 4);
            gg[0] = g0[0]; gg[1] = g0[1]; gg[2] = g0[2]; gg[3] = g0[3]; gg[4] = g1[0]; gg[5] = g1[1]; gg[6] = g1[2]; gg[7] = g1[3];
            bb[0] = b0[0]; bb[1] = b0[1]; bb[2] = b0[2]; bb[3] = b0[3]; bb[4] = b1[0]; bb[5] = b1[1]; bb[6] = b1[2]; bb[7] = b1[3];
            const bf16_t* w0p = Ws + ((size_t)gi * 128 + it0 * 32 + (lane & 31)) * 128 + 8 * (lane >> 5);
#pragma unroll
            for (int s_ = 0; s_ < 8; ++s_) { B0[s_] = *(const bf16x8*)(w0p + 16 * s_); B1[s_] = *(const bf16x8*)(w0p + 32 * 128 + 16 * s_); }
#pragma unroll
            for (int it = 0; it < 2; ++it) bias[it] = bs[gi * 128 + (it0 + it) * 32 + (lane & 31)];
        }
        __syncthreads();
#pragma unroll
        for (int k = 0; k < 4; ++k) {
            const int jj = jj0 + 32 * k;
            const float xv[8] = {lo16(zz[k].x), hi16(zz[k].x), lo16(zz[k].y), hi16(zz[k].y), lo16(zz[k].z), hi16(zz[k].z), lo16(zz[k].w), hi16(zz[k].w)};
#pragma unroll
            for (int e = 0; e < 8; e += 2) {
                const unsigned pw = pk2((xv[e] - st[k][0]) * st[k][1] * gg[e] + bb[e], (xv[e + 1] - st[k][0]) * st[k][1] * gg[e + 1] + bb[e + 1]);
                *(LAS unsigned short*)(vt + vt_off(c8 + e, jj >> 3) + (jj & 7) * 2) = (unsigned short)(pw & 0xFFFFu);
                *(LAS unsigned short*)(vt + vt_off(c8 + e + 1, jj >> 3) + (jj & 7) * 2) = (unsigned short)(pw >> 16);
            }
        }
        u32x2 uu[2][4];
#pragma unroll
        for (int it = 0; it < 2; ++it) { const int ii = (it0 + it) * 32 + (lane & 31);
#pragma unroll
            for (int rq = 0; rq < 4; ++rq) uu[it][rq] = *(const u32x2*)(Z + (row0 + ii) * 4096 + gi * 128 + dt * 32 + 8 * rq + 4 * (lane >> 5)); }
        if (U + F.G < nchunk * 16) SP_LOADZ(U + F.G);
        __syncthreads();
        f32x16 acc0, acc1;
#pragma unroll
        for (int e = 0; e < 16; ++e) { acc0[e] = 0.f; acc1[e] = 0.f; }
        const int dA = dt * 32 + (lane & 31);
#pragma unroll
        for (int s_ = 0; s_ < 8; ++s_) {
            const bf16x8 Afr = *(const LAS bf16x8*)(vt + vt_off(dA, 2 * s_ + (lane >> 5)));
            acc0 = __builtin_amdgcn_mfma_f32_32x32x16_bf16(Afr, B0[s_], acc0, 0, 0, 0);
            acc1 = __builtin_amdgcn_mfma_f32_32x32x16_bf16(Afr, B1[s_], acc1, 0, 0, 0);
        }
#pragma unroll
        for (int it = 0; it < 2; ++it) {
            const int ii = (it0 + it) * 32 + (lane & 31); const size_t row = row0 + ii;
#pragma unroll
            for (int rq = 0; rq < 4; ++rq) {
                const int d0 = dt * 32 + 8 * rq + 4 * (lane >> 5);
                float vs[4];
#pragma unroll
                for (int e = 0; e < 4; ++e) vs[e] = (it == 0 ? acc0[rq * 4 + e] : acc1[rq * 4 + e]) + bias[it];
                u32x2 o; o.x = pk2(lo16(uu[it][rq].x) * vs[0], hi16(uu[it][rq].x) * vs[1]); o.y = pk2(lo16(uu[it][rq].y) * vs[2], hi16(uu[it][rq].y) * vs[3]);
                *(u32x2*)(Pb + row * 2048 + gi * 128 + d0) = o;
            }
        }
    }
#undef SP_ROW0
#undef SP_LOADZ
    __syncthreads();
}

__global__ void __launch_bounds__(NTHREADS, 2) fwd_kernel(Params P) {
    extern __shared__ __attribute__((aligned(16))) unsigned char lds_raw[];
    Frame F; F.lds = (LAS unsigned char*)lds_raw; F.tid = threadIdx.x; F.lane = F.tid & 63; F.wave = __builtin_amdgcn_readfirstlane(F.tid >> 6);
    F.G = gridDim.x; F.bid = blockIdx.x; F.ws = P.ws; F.kp = (const Params __attribute__((address_space(4)))*)__builtin_amdgcn_kernarg_segment_ptr();
    const int lo = P.ph_lo, hi = P.ph_hi;
    volatile LAS unsigned* misc = (volatile LAS unsigned*)(F.lds + LDS_MISC);
    if (F.tid < 4) misc[F.tid] = 0u;
    __syncthreads();
    XcdBarrier bar; bar.bar = (unsigned*)(F.ws + WS_CTL); bar.x = 0; bar.st = misc;
    if (hi - lo > 1) bar = xcd_barrier_post((unsigned*)(F.ws + WS_CTL), misc);
    int ph = 0;
#define RUN(id, ...) do { if (ph >= lo && ph < hi) { const int nrep_ = ((REP_MASK >> (id)) & 1u) ? 2 : 1; for (int rep_ = 0; rep_ < nrep_; ++rep_) { const bool dry_ = (rep_ + 1 < nrep_); (void)dry_; { int t_ = threadIdx.x; const Params __attribute__((address_space(4)))* kp_ = (const Params __attribute__((address_space(4)))*)__builtin_amdgcn_kernarg_segment_ptr(); asm volatile("" : "+v"(t_), "+s"(kp_)); F.tid = t_; F.lane = t_ & 63; F.kp = kp_; F.ws = kp_->ws; } __VA_ARGS__; if (rep_ + 1 < nrep_ || ph + 1 < hi) xcd_barrier(bar); } } ++ph; } while (0)

    RUN(0, phase_prologue(F));
    for (int g = 0; g < NG; ++g) {
        for (int layer = 0; layer < 4; ++layer) {
            const int a = layer >> 1;
            if ((layer & 1) == 0) {
                const bf16_t* Vc = layer == 0 ? F.wsp<bf16_t>(WS_VF) : F.ar<bf16_t>(AR_V);
                RUN(1, phase_norm1(F, g, layer, F.ar<bf16_t>(AR_H2), 2048, dry_));
                RUN(2, phase_mix(F, a));
                RUN(3, { { pg8::SchedPlain S; S.init(TG / 256, 2, F.G, F.bid, 0);
                        EpiL1 E{F.ar<bf16_t>(AR_L1)};
                        pg8::gemm_phase(F.tid, F.lds, F.ar<bf16_t>(AR_H2), K1CAT, F.wsp<bf16_t>(WS_WL) + (size_t)a * 512 * K1CAT, K1CAT, K1CAT, S, E); }
                      { int t_ = threadIdx.x; asm volatile("" : "+v"(t_)); F.tid = t_; F.lane = t_ & 63; }
                      { pg8::SchedRKV S; S.init(TG / 256, 12, F.G, (F.bid + 192) % F.G, 0);
                        EpiRKV E{F.ws, layer == 0 ? WS_VF : WS_ARENA + AR_V};
                        pg8::gemm_phase(F.tid, F.lds, F.ar<bf16_t>(AR_XR), D, F.wsp<bf16_t>(WS_WRKV) + (size_t)a * 3072 * D, D, D, S, E); } });
                if (layer == 2) {
                    RUN(4, { pg8::SchedPlain S; S.init(TG / 256, 4, F.G, F.bid, 0);
                          EpiStore<1> E{F.ar<bf16_t>(AR_VGATE), F.in(19)};
                          pg8::gemm_phase(F.tid, F.lds, F.ar<bf16_t>(AR_L1) + 256, 512, F.wsp<bf16_t>(WS_V2T), 256, 256, S, E); });
                    RUN(5, phase_vfix(F));
                }
                RUN(6, phase_scan4(F, a, Vc));
                RUN(7, { pg8::SchedPlain S; S.init(TG / 256, 4, F.G, F.bid, 0);
                      EpiStore<0> E{F.ar<bf16_t>(AR_G), nullptr};
                      pg8::gemm_phase(F.tid, F.lds, F.ar<bf16_t>(AR_L1) + 256, 512, F.wsp<bf16_t>(WS_G2T) + (size_t)a * D * 256, 256, 256, S, E); });
                RUN(8, phase_post(F, a, Vc));
                RUN(9, { const int skip = layer == 2; pg8::SchedPlain S; S.init(skip ? BG * 8 : TG / 256, 4, F.G, F.bid, skip);
                      EpiStore<0> E{F.ar<bf16_t>(AR_O), nullptr};
                      pg8::gemm_phase(F.tid, F.lds, F.ar<bf16_t>(AR_R), D, F.wsp<bf16_t>(WS_WO) + (size_t)a * D * D, D, D, S, E); });
            } else {
                const int skip = layer == 3;
                RUN(10, phase_norm1(F, g, layer, F.ar<bf16_t>(AR_H), D, dry_));
                RUN(11, { pg8::SchedPlain S; S.init(skip ? BG * 8 : TG / 256, 16, F.G, F.bid, skip);
                      EpiGelu E{F.ar<bf16_t>(AR_Z), F.in(30) + (size_t)a * 4096};
                      pg8::gemm_phase(F.tid, F.lds, F.ar<bf16_t>(AR_H), D, F.wsp<bf16_t>(WS_WIN) + (size_t)a * 4096 * D, D, D, S, E); });
                RUN(12, phase_sgstats(F, layer));
                RUN(13, phase_spatial(F, a, layer));
                RUN(14, { pg8::SchedPlain S; S.init(skip ? BG * 8 : TG / 256, 4, F.G, F.bid, skip);
                      EpiStore<0> E{F.ar<bf16_t>(AR_O), nullptr};
                      pg8::gemm_phase(F.tid, F.lds, F.ar<bf16_t>(AR_P), 2048, F.wsp<bf16_t>(WS_WOUT) + (size_t)a * D * 2048, 2048, 2048, S, E); });
            }
            RUN(15, phase_norm2(F, g, layer, dry_));
            RUN(16, { const int total = moe_tables(F, g, layer);
                  pg8::SchedMoe<true> S{(const LAS int*)(F.lds + LDS_MISC + 64), (const LAS int*)(F.lds + LDS_MISC + 192), F.ar<int>(AR_LIST), F.G, F.bid, total};
                  EpiMG E{F.ar<bf16_t>(AR_HE)};
                  pg8::gemm_phase(F.tid, F.lds, F.ar<bf16_t>(AR_HM), D, F.wsp<bf16_t>(WS_WGU) + (size_t)layer * NEXP * 1024 * D, D, D, S, E); });
            RUN(17, { const int total = moe_tables(F, g, layer);
                  pg8::SchedMoe<false> S{(const LAS int*)(F.lds + LDS_MISC + 64), (const LAS int*)(F.lds + LDS_MISC + 192), F.ar<int>(AR_LIST), F.G, F.bid, total};
                  EpiMD E{F.ar<bf16_t>(AR_YM0), F.ar<int>(AR_LIST), F.ar<float>(AR_LW), (const LAS int*)(F.lds + LDS_MISC + 64)};
                  pg8::gemm_phase(F.tid, F.lds, F.ar<bf16_t>(AR_HE), FEXP, F.wsp<bf16_t>(WS_WD) + (size_t)layer * NEXP * D * FEXP, FEXP, FEXP, S, E); });
        }
        RUN(18, phase_norm1(F, g, 4, nullptr, 0));
    }
#undef RUN
}
constexpr int NPHASES = 1 + NG * (10 + 8 + 12 + 8 + 1);

__global__ void nan_fill(float* out, size_t n) { for (size_t i = (size_t)blockIdx.x * blockDim.x + threadIdx.x; i < n; i += (size_t)gridDim.x * blockDim.x) out[i] = __uint_as_float(0x7FC00000u); }

extern "C" void kernel_launch(void* const* d_in, const int* in_sizes, int n_in, void* d_out, int out_size, void* d_ws, size_t ws_size, hipStream_t stream) {
    static int grid = 0;
    if (grid == 0) {
        int dev = 0, cus = 0, per_cu = 0;
        if (n_in != 42 || ws_size < WS_END || hipGetDevice(&dev) != hipSuccess || hipDeviceGetAttribute(&cus, hipDeviceAttributeMultiprocessorCount, dev) != hipSuccess) {
            fprintf(stderr, "kernel_launch: bad setup (n_in %d, ws %zu need %zu)\n", n_in, ws_size, (size_t)WS_END); grid = -1;
        } else if (hipFuncSetAttribute((const void*)fwd_kernel, hipFuncAttributeMaxDynamicSharedMemorySize, LDS_BYTES) != hipSuccess) { fprintf(stderr, "kernel_launch: hipFuncSetAttribute failed\n"); grid = -1; }
        else {
            if (hipOccupancyMaxActiveBlocksPerMultiprocessor(&per_cu, (const void*)fwd_kernel, NTHREADS, LDS_BYTES) != hipSuccess || per_cu < 1) { fprintf(stderr, "kernel_launch: occupancy query reports %d\n", per_cu); }
            (void)hipGetLastError();
            grid = cus;
        }
    }
    if (grid < 0) { hipLaunchKernelGGL(nan_fill, dim3(1024), dim3(256), 0, stream, (float*)d_out, (size_t)out_size); return; }
    (void)hipMemsetAsync((char*)d_ws + WS_CTL, 0, CTL_BYTES, stream);
    Params p{};
    for (int i = 0; i < 42; ++i) p.in[i] = (const float*)d_in[i];
    p.out = (float*)d_out; p.ws = (unsigned char*)d_ws;
#if PER_PHASE_LAUNCH
    for (int k = 0; k < NPHASES; ++k) { p.ph_lo = k; p.ph_hi = k + 1; hipLaunchKernelGGL(fwd_kernel, dim3(grid), dim3(NTHREADS), LDS_BYTES, stream, p); }
#else
    p.ph_lo = 0; p.ph_hi = NPHASES;
    hipLaunchKernelGGL(fwd_kernel, dim3(grid), dim3(NTHREADS), LDS_BYTES, stream, p);
#endif
}
```

```cpp
#include <hip/hip_runtime.h>
#include <cstdio>
#include <cstdint>

#ifndef REP_MASK
#define REP_MASK 0u
#endif
#ifndef PER_PHASE_LAUNCH
#define PER_PHASE_LAUNCH 0
#endif

#define LAS __attribute__((address_space(3)))
typedef unsigned short bf16_t;
typedef short bf16x8 __attribute__((ext_vector_type(8)));
typedef float f32x4 __attribute__((ext_vector_type(4)));
typedef float f32x2 __attribute__((ext_vector_type(2)));
typedef float f32x16 __attribute__((ext_vector_type(16)));
typedef unsigned u32x4 __attribute__((ext_vector_type(4)));
typedef unsigned u32x2 __attribute__((ext_vector_type(2)));

constexpr int NB = 32, SEQ = 2048, LC = 256, LT = SEQ + LC, D = 1024, NH = 16;
constexpr int NG = 2, BG = NB / NG, TG = BG * LT;
constexpr int NTHREADS = 512, NWAVES = 8;
constexpr int N1CAT = 3584, K1CAT = 2048;
constexpr int NEXP = 16, FEXP = 512;

constexpr size_t al256(size_t x) { return (x + 255) & ~(size_t)255; }
constexpr int XCD_BAR_WORDS_C = 3456;
constexpr size_t WS_CTL = 0;
constexpr size_t CTL_BAR_BYTES = (size_t)XCD_BAR_WORDS_C * 4;
constexpr size_t CTL_CNT_OFF = al256(CTL_BAR_BYTES);
constexpr size_t CTL_BYTES = al256(CTL_CNT_OFF + (size_t)2 * NG * 4 * 32 * 64);
constexpr size_t WS_X = al256(WS_CTL + CTL_BYTES);
constexpr size_t WS_VF = WS_X + (size_t)TG * D * 2;
constexpr size_t WS_MODL = WS_VF + (size_t)TG * D * 2;
constexpr size_t WS_MODC = WS_MODL + (size_t)4 * NB * 6 * D * 4;
constexpr size_t WS_WRKV = al256(WS_MODC + (size_t)4 * 6 * D * 4);
constexpr size_t WS_WL = WS_WRKV + (size_t)2 * 3072 * D * 2;
constexpr size_t WS_WO = WS_WL + (size_t)2 * 512 * K1CAT * 2;
constexpr size_t WS_G2T = WS_WO + (size_t)2 * D * D * 2;
constexpr size_t WS_V2T = WS_G2T + (size_t)2 * D * 256 * 2;
constexpr size_t WS_W2T = WS_V2T + (size_t)D * 256 * 2;
constexpr size_t WS_A2T = WS_W2T + (size_t)4 * D * 64 * 2;
constexpr size_t WS_WIN = WS_A2T + (size_t)4 * D * 64 * 2;
constexpr size_t WS_WOUT = WS_WIN + (size_t)2 * 4096 * D * 2;
constexpr size_t WS_WSP = WS_WOUT + (size_t)2 * D * 2048 * 2;
constexpr size_t WS_WGU = WS_WSP + (size_t)2 * 16 * 128 * 128 * 2;
constexpr size_t WS_WD = WS_WGU + (size_t)4 * NEXP * 1024 * D * 2;
constexpr size_t WS_ARENA = al256(WS_WD + (size_t)4 * NEXP * D * FEXP * 2);
constexpr size_t SZB = (size_t)TG * D * 2;
constexpr size_t AR_H2 = 0;
constexpr size_t AR_Y0 = 0, AR_Y1 = SZB;
constexpr size_t AR_XR = 2 * SZB;
constexpr size_t AR_R = 5 * SZB, AR_K = 6 * SZB, AR_V = 7 * SZB;
constexpr size_t AR_L1 = 8 * SZB;
constexpr size_t AR_DOT = AR_L1 + SZB / 2;
constexpr size_t AR_G = 2 * SZB;
constexpr size_t AR_VGATE = 0;
constexpr size_t AR_O = 3 * SZB;
constexpr size_t AR_H = 0;
constexpr size_t AR_Z = SZB;
constexpr size_t AR_P = 5 * SZB;
constexpr size_t AR_ST = 7 * SZB;
constexpr size_t AR_HM = 0;
constexpr size_t AR_HE = SZB;
constexpr size_t HE_ROWS = (size_t)2 * TG + 32 * 256;
constexpr size_t AR_LIST = al256(AR_HE + HE_ROWS * FEXP * 2);
constexpr size_t AR_LW = AR_LIST + (size_t)32 * TG * 4;
constexpr size_t AR_YM0 = 5 * SZB, AR_YM1 = 6 * SZB;
constexpr size_t ARENA_BYTES = AR_DOT + (size_t)2 * TG * 16 * 4 + 4096;
constexpr size_t WS_END = WS_ARENA + ARENA_BYTES;
static_assert(AR_LW + (size_t)32 * TG * 4 <= AR_O, "moe lists overlap");

constexpr int LDS_STAGE = 131072;
constexpr int LDS_MISC = LDS_STAGE;
constexpr int LDS_BYTES = LDS_STAGE + 1024;

struct Params {
    const float* in[42];
    float* out;
    unsigned char* ws;
    int ph_lo, ph_hi;
};

__device__ __forceinline__ float bf2f(unsigned short b) { return __uint_as_float(((unsigned)b) << 16); }
__device__ __forceinline__ unsigned short f2bf(float f) { unsigned u = __float_as_uint(f); u += 0x7FFFu + ((u >> 16) & 1u); return (unsigned short)(u >> 16); }
typedef __bf16 bf16x2_t __attribute__((ext_vector_type(2)));
__device__ __forceinline__ unsigned pk2(float lo, float hi) { const bf16x2_t v = __builtin_convertvector((f32x2){lo, hi}, bf16x2_t); return __builtin_bit_cast(unsigned, v); }
__device__ __forceinline__ float lo16(unsigned w) { return __uint_as_float(w << 16); }
__device__ __forceinline__ float hi16(unsigned w) { return __uint_as_float(w & 0xFFFF0000u); }
__device__ __forceinline__ float sigmoidf_(float x) { return __builtin_amdgcn_rcpf(1.0f + __expf(-x)); }
__device__ __forceinline__ float tanhf_(float x) { return 1.0f - 2.0f * __builtin_amdgcn_rcpf(__expf(2.0f * x) + 1.0f); }
__device__ __forceinline__ float wave_sum(float v) {
#pragma unroll
    for (int o = 32; o > 0; o >>= 1) v += __shfl_xor(v, o);
    return v;
}
template <int CTRL> __device__ __forceinline__ float dpp_f(float v) {
    return __int_as_float(__builtin_amdgcn_update_dpp(0, __float_as_int(v), CTRL, 0xF, 0xF, true));
}
__device__ __forceinline__ float red8(float v) { v += dpp_f<0xB1>(v); v += dpp_f<0x4E>(v); v += dpp_f<0x141>(v); return v; }
__device__ __forceinline__ float red16(float v) { v = red8(v); v += dpp_f<0x140>(v); return v; }
__device__ __forceinline__ float wave_sum_dpp(float v) {
    v = red16(v);
    const float a = __int_as_float(__builtin_amdgcn_readlane(__float_as_int(v), 0)), b = __int_as_float(__builtin_amdgcn_readlane(__float_as_int(v), 16));
    const float c = __int_as_float(__builtin_amdgcn_readlane(__float_as_int(v), 32)), d = __int_as_float(__builtin_amdgcn_readlane(__float_as_int(v), 48));
    return (a + b) + (c + d);
}
__device__ __forceinline__ float red4(float v) { v += dpp_f<0xB1>(v); v += dpp_f<0x4E>(v); return v; }
__device__ __forceinline__ f32x2 gelu_pk(f32x2 v) {
    const f32x2 av = __builtin_elementwise_abs(v), d = av * 0.2316418882f + 1.0f;
    f32x2 t; t.x = __builtin_amdgcn_rcpf(d.x); t.y = __builtin_amdgcn_rcpf(d.y);
    f32x2 q = t * 0.5307027145f + (-0.7265760135f); q = q * t + 0.7107068705f; q = q * t + (-0.142248368f); q = q * t + 0.127414796f; q = q * t;
    const f32x2 s = (v * v) * (-0.72134752044f);
    f32x2 e; e.x = __builtin_amdgcn_exp2f(s.x); e.y = __builtin_amdgcn_exp2f(s.y);
    const f32x2 m = v * (q * e), r = v - m;
    f32x2 o; o.x = v.x < 0.f ? m.x : r.x; o.y = v.y < 0.f ? m.y : r.y; return o;
}
__device__ __forceinline__ float gelu_f(float v) {
    const float av = fabsf(v), t = __builtin_amdgcn_rcpf(av * 0.2316418882f + 1.0f);
    float q = t * 0.5307027145f + (-0.7265760135f); q = q * t + 0.7107068705f; q = q * t + (-0.142248368f); q = q * t + 0.127414796f; q = q * t;
    const float e = __builtin_amdgcn_exp2f((v * v) * (-0.72134752044f));
    const float m = v * (q * e);
    return v < 0.f ? m : v - m;
}

#define XB_TMO      128
#define XB_XCNT(j)  (256  + 64 * (j))
#define XB_XSUB(j)  (1280 + 64 * (j))
#define XB_XGEN(j)  (2304 + 64 * (j))
#define XB_TOP      3328
#define XB_TOPGEN   3392
#define XCD_BAR_WORDS 3456
#define XB_SPIN_CAP (1u << 22)
static_assert(XCD_BAR_WORDS == XCD_BAR_WORDS_C, "barrier words");
__device__ __forceinline__ unsigned xb_ld(unsigned* p)              { return __hip_atomic_load(p, __ATOMIC_RELAXED, __HIP_MEMORY_SCOPE_AGENT); }
__device__ __forceinline__ unsigned xb_add(unsigned* p, unsigned v) { return __hip_atomic_fetch_add(p, v, __ATOMIC_RELAXED, __HIP_MEMORY_SCOPE_AGENT); }
__device__ __forceinline__ unsigned xb_xcc_id() { return (unsigned)__builtin_amdgcn_s_getreg((3 << 11) | 20) & 0xFu; }
#define XB_SPIN(cond, bar) do { unsigned _sp = 0; while (cond) { __builtin_amdgcn_s_sleep(1); \
    if ((++_sp & 255u) == 0u) { if (xb_ld(&(bar)[XB_TMO])) break; if (_sp > XB_SPIN_CAP) { atomicAdd(&(bar)[XB_TMO], 1u); break; } } } } while (0)
struct XcdBarrier { unsigned* bar; unsigned x; volatile LAS unsigned* st; };
__device__ __forceinline__ XcdBarrier xcd_barrier_post(unsigned* bar, volatile LAS unsigned* st) {
    XcdBarrier b; b.bar = bar; b.x = xb_xcc_id(); b.st = st;
    if (threadIdx.x == 0) (void)xb_add(&bar[XB_XCNT(b.x)], 1u);
    return b;
}
__device__ __forceinline__ void xcd_barrier_complete(unsigned* bar, unsigned x, unsigned& nloc, unsigned& nx) {
    const unsigned G = gridDim.x * gridDim.y * gridDim.z;
    unsigned sum, cnt, mine, sp = 0u;
    for (;;) {
        sum = 0u; cnt = 0u; mine = 0u;
#pragma unroll
        for (unsigned j = 0; j < 16; ++j) { const unsigned c = xb_ld(&bar[XB_XCNT(j)]); sum += c; cnt += (c > 0u) ? 1u : 0u; mine = (j == x) ? c : mine; }
        if (sum == G) break;
        __builtin_amdgcn_s_sleep(1);
        if ((++sp & 255u) == 0u) { if (xb_ld(&bar[XB_TMO])) break; if (sp > XB_SPIN_CAP) { atomicAdd(&bar[XB_TMO], 1u); break; } }
    }
    nloc = mine > 0u ? mine : 1u; nx = cnt > 0u ? cnt : 1u;
}
__device__ __forceinline__ void xcd_barrier(const XcdBarrier& b) {
    asm volatile("s_waitcnt vmcnt(0)" ::: "memory");
    __syncthreads();
    if (threadIdx.x == 0) {
        unsigned* bar = b.bar;
        __builtin_amdgcn_s_waitcnt(0);
        unsigned nloc = b.st[0], nx = b.st[1];
        if (nloc == 0u) { xcd_barrier_complete(bar, b.x, nloc, nx); b.st[0] = nloc; b.st[1] = nx; }
        const unsigned old = xb_add(&bar[XB_XSUB(b.x)], 1u);
        const unsigned gen = old / nloc;
        if (old + 1u == (gen + 1u) * nloc) {
            __builtin_amdgcn_fence(__ATOMIC_RELEASE, "agent");
            asm volatile("s_waitcnt vmcnt(0)" ::: "memory");
            const unsigned og = xb_add(&bar[XB_TOP], 1u);
            const unsigned tg = og / nx;
            if (og + 1u == (tg + 1u) * nx) xb_add(&bar[XB_TOPGEN], 1u);
            else XB_SPIN(xb_ld(&bar[XB_TOPGEN]) == tg, bar);
            __builtin_amdgcn_fence(__ATOMIC_ACQUIRE, "agent");
            xb_add(&bar[XB_XGEN(b.x)], 1u);
            asm volatile("s_waitcnt vmcnt(0)" ::: "memory");
        } else {
            XB_SPIN(xb_ld(&bar[XB_XGEN(b.x)]) == gen, bar);
            __builtin_amdgcn_fence(__ATOMIC_ACQUIRE, "agent");
            asm volatile("s_waitcnt vmcnt(0)" ::: "memory");
        }
    }
    __syncthreads();
}

#define LDS_BAR() asm volatile("s_waitcnt lgkmcnt(0)\n\ts_barrier" ::: "memory")
namespace pg8 {
constexpr int BM = 256, BK = 64, HALF = 128, HTB = HALF * BK * 2, STAGE_BYTES = 8 * HTB, NXCD = 8, WGM = 8;
__host__ __device__ __forceinline__ int lds_byte(int r, int c) { const int st = (r >> 4) * 2 + (c >> 5), rr = r & 15, cc = c & 31, ob = rr * 64 + cc * 2; return st * 1024 + (ob ^ (((ob >> 9) & 1) << 5)); }
__host__ __device__ __forceinline__ void stage_rc(int b, int& R, int& C) { const int st = b / 1024, sb = b % 1024, swz = sb ^ (((sb >> 9) & 1) << 5); R = (st >> 1) * 16 + swz / 64; C = (st & 1) * 32 + (swz % 64) / 2; }
__host__ __device__ __forceinline__ int perm32(int rho) { const int n = rho >> 4, i = rho & 15; return 8 * (i >> 2) + 4 * n + (i & 3); }
struct Unit { int pm, pn, aux; };

struct SchedPlain {
    static constexpr bool GATHER = false;
    int nM, nN, nwg, G, c, skipctx;
    __device__ void init(int nM_, int nN_, int G_, int c_, int skipctx_) { nM = nM_; nN = nN_; nwg = nM * nN; G = G_; c = c_; skipctx = skipctx_; }
    __device__ bool next(int i, Unit& u) const {
        const long L = (long)i * G + c; if (L >= nwg) return false;
        int wgid = (int)L; { const int q = nwg / NXCD, r = nwg % NXCD, xcd = wgid % NXCD, off = wgid / NXCD; wgid = (xcd < r ? xcd * (q + 1) : r * (q + 1) + (xcd - r) * q) + off; }
        const int nig = WGM * nN, gid = wgid / nig, fm = gid * WGM, gsz = (nM - fm) < WGM ? (nM - fm) : WGM;
        int pm = fm + ((wgid % nig) % gsz); u.pn = (wgid % nig) / gsz; u.aux = 0;
        if (skipctx) pm = (pm >> 3) * 9 + 1 + (pm & 7);
        u.pm = pm; return true;
    }
    __device__ __forceinline__ int arow(const Unit& u, int r) const { return u.pm * BM + r; }
};
struct SchedRKV : SchedPlain {
    __device__ bool next(int i, Unit& u) const { if (!SchedPlain::next(i, u)) return false; u.pm += (u.pn >> 2) * nM; return true; }
};
template <bool GATH> struct SchedMoe {
    static constexpr bool GATHER = GATH;
    const LAS int* cn; const LAS int* tb; const int* lists; int G, c, total;
    __device__ bool next(int i, Unit& u) const {
        const int U = i * G + c; if (U >= total * 4) return false;
        const int T = U >> 2, pn = U & 3; int l = 0;
        while (tb[l + 1] <= T) ++l;
        u.pm = T; u.pn = (l >> 1) * 4 + pn; u.aux = l | ((T - tb[l]) << 8); return true;
    }
    __device__ __forceinline__ int arow(const Unit& u, int r) const {
        if (!GATH) return u.pm * BM + r;
        const int l = u.aux & 255, idx = (u.aux >> 8) * BM + r;
        return idx < cn[l] ? lists[(size_t)l * TG + idx] : 0;
    }
};

template <class Epi, class Sched>
__device__ __forceinline__ void gemm_phase(const int tid, LAS unsigned char* lds, const bf16_t* A, int lda, const bf16_t* Bt, int ldb, int K, const Sched& S, const Epi& E) {
    constexpr bool GA = Sched::GATHER;
    const int wid = __builtin_amdgcn_readfirstlane(tid >> 6), lane = tid & 63, wr = wid >> 2, wc = wid & 3, fr = lane & 15, fq = lane >> 4;
    const int nt = K / BK;
    unsigned voffA[2], voffB[2];
#pragma unroll
    for (int i = 0; i < 2; ++i) { int R, C; stage_rc(tid * 16 + i * 8192, R, C); const int Rb = (R & ~31) + perm32(R & 31);
        voffA[i] = (unsigned)(R * lda + C) * 2u; voffB[i] = (unsigned)(Rb * ldb + C) * 2u; }
    const size_t kstep = (size_t)(BK * 2);
    const size_t hstepA = (size_t)HALF * lda * 2, tstepA = 2 * hstepA;
    const size_t hstepB = (size_t)HALF * ldb * 2, tstepB = 2 * hstepB;
    const unsigned ldsw = (unsigned)wid * 1024u;
    const int aoff = lds_byte(wr * 64 + fr, fq * 8), boff = lds_byte(wc * 32 + fr, fq * 8);
#define PG8_SA(b, h) (((b) * 2 + (h)) * HTB)
#define PG8_SB(b, h) ((4 + (b) * 2 + (h)) * HTB)
#define PG8_STAGE(bufoff, gbase, voff) do { _Pragma("unroll") for (int _i = 0; _i < 2; ++_i) \
        __builtin_amdgcn_global_load_lds((const unsigned*)((const char*)(gbase) + (voff)[_i]), (LAS unsigned*)(lds + (bufoff) + ldsw + _i * 8192), 16, 0, 0); } while (0)
#define PG8_STAGE_A(bufoff, ub, gv, h, koff) do { if constexpr (GA) { PG8_STAGE(bufoff, (const char*)A + (koff), gv[h]); } else { PG8_STAGE(bufoff, (ub) + (h) * hstepA + (koff), voffA); } } while (0)
#define PG8_LDA(dst, b, h) do { _Pragma("unroll") for (int m = 0; m < 4; ++m) _Pragma("unroll") for (int k = 0; k < 2; ++k) dst[m][k] = *(const LAS bf16x8*)(lds + PG8_SA(b, h) + aoff + m * 2048 + k * 1024); } while (0)
#define PG8_LDB(dst, b, h) do { _Pragma("unroll") for (int n = 0; n < 2; ++n) _Pragma("unroll") for (int k = 0; k < 2; ++k) dst[n][k] = *(const LAS bf16x8*)(lds + PG8_SB(b, h) + boff + n * 2048 + k * 1024); } while (0)
#define PG8_MMA(ai, bj, At, Bt_) do { __builtin_amdgcn_s_setprio(1); _Pragma("unroll") for (int m = 0; m < 4; ++m) _Pragma("unroll") for (int n = 0; n < 2; ++n) _Pragma("unroll") for (int k = 0; k < 2; ++k) \
        acc[ai][bj][m][n] = __builtin_amdgcn_mfma_f32_16x16x32_bf16(Bt_[n][k], At[m][k], acc[ai][bj][m][n], 0, 0, 0); __builtin_amdgcn_s_setprio(0); } while (0)
#define PG8_WAIT_V(n) asm volatile("s_waitcnt vmcnt(" #n ")" ::: "memory")
#define PG8_WAIT_L(n) asm volatile("s_waitcnt lgkmcnt(" #n ")" ::: "memory")
#define PG8_BAR __builtin_amdgcn_s_barrier()
#define PG8_SCHED __builtin_amdgcn_sched_barrier(0)
#define PG8_GOFF(dst, u) do { if constexpr (GA) { _Pragma("unroll") for (int _h = 0; _h < 2; ++_h) _Pragma("unroll") for (int _i = 0; _i < 2; ++_i) { int R_, C_; stage_rc(tid * 16 + _i * 8192, R_, C_); \
        dst[_h][_i] = ((unsigned)S.arow(u, _h * HALF + R_) * (unsigned)lda + (unsigned)C_) * 2u; } } } while (0)
    Unit cur, nxt; int ui = 0;
    if (!S.next(0, cur)) return;
    f32x4 acc[2][2][4][2];
#pragma unroll
    for (int a = 0; a < 2; ++a)
#pragma unroll
        for (int b = 0; b < 2; ++b)
#pragma unroll
            for (int m = 0; m < 4; ++m)
#pragma unroll
                for (int n = 0; n < 2; ++n) acc[a][b][m][n] = (f32x4){0.f, 0.f, 0.f, 0.f};
    bf16x8 At[4][2], B0[2][2], B1[2][2];
    unsigned gAc[2][2], gAn[2][2];
    PG8_GOFF(gAc, cur);
    const char* cA = (const char*)A + (GA ? (size_t)0 : (size_t)cur.pm * tstepA);
    const char* cB = (const char*)Bt + (size_t)cur.pn * tstepB;
    PG8_STAGE(PG8_SB(0, 0), cB, voffB); PG8_STAGE_A(PG8_SA(0, 0), cA, gAc, 0, 0); PG8_STAGE(PG8_SB(0, 1), cB + hstepB, voffB); PG8_STAGE_A(PG8_SA(0, 1), cA, gAc, 1, 0);
    if (wr == 1) PG8_BAR;
    PG8_WAIT_V(4); PG8_BAR;
    PG8_STAGE(PG8_SB(1, 0), cB + kstep, voffB); PG8_STAGE_A(PG8_SA(1, 0), cA, gAc, 0, kstep); PG8_STAGE(PG8_SB(1, 1), cB + hstepB + kstep, voffB);
    PG8_WAIT_V(6); PG8_BAR;
    for (;;) {
        const bool has_next = S.next(ui + 1, nxt);
        if (has_next) { PG8_GOFF(gAn, nxt); }
        else if constexpr (GA) {
#pragma unroll
            for (int _h = 0; _h < 2; ++_h)
#pragma unroll
                for (int _i = 0; _i < 2; ++_i) gAn[_h][_i] = gAc[_h][_i];
        }
        const char* nA = (has_next && !GA) ? (const char*)A + (size_t)nxt.pm * tstepA : cA;
        const char* nB = has_next ? (const char*)Bt + (size_t)nxt.pn * tstepB : cB;
#pragma unroll 1
        for (int t = 0; t < nt; t += 2) {
            const bool last = (t == nt - 2);
            const size_t k1 = (size_t)(t + 1) * kstep;
            const size_t k2 = last ? (size_t)0 : (size_t)(t + 2) * kstep, k3 = k2 + kstep;
            const char* a2 = last ? nA : cA; const char* b2 = last ? nB : cB;
            unsigned g2[2][2];
            if constexpr (GA) {
#pragma unroll
                for (int _h = 0; _h < 2; ++_h)
#pragma unroll
                    for (int _i = 0; _i < 2; ++_i) g2[_h][_i] = last ? gAn[_h][_i] : gAc[_h][_i];
            }
            PG8_LDB(B0, 0, 0); PG8_SCHED; PG8_LDA(At, 0, 0); PG8_STAGE_A(PG8_SA(1, 1), cA, gAc, 1, k1);
            PG8_WAIT_L(8); PG8_BAR; PG8_WAIT_L(0); PG8_MMA(0, 0, At, B0); PG8_BAR; PG8_SCHED;
            PG8_LDB(B1, 0, 1); PG8_STAGE(PG8_SB(0, 0), b2 + k2, voffB);
            PG8_BAR; PG8_WAIT_L(0); PG8_MMA(0, 1, At, B1); PG8_BAR;
            PG8_LDA(At, 0, 1); PG8_STAGE_A(PG8_SA(0, 0), a2, g2, 0, k2);
            PG8_BAR; PG8_WAIT_L(0); PG8_MMA(1, 0, At, B0); PG8_BAR; PG8_SCHED;
            PG8_STAGE(PG8_SB(0, 1), b2 + hstepB + k2, voffB);
            PG8_WAIT_V(6); PG8_BAR; PG8_MMA(1, 1, At, B1); PG8_BAR;
            PG8_LDB(B0, 1, 0); PG8_SCHED; PG8_LDA(At, 1, 0); PG8_STAGE_A(PG8_SA(0, 1), a2, g2, 1, k2);
            PG8_WAIT_L(8); PG8_BAR; PG8_WAIT_L(0); PG8_MMA(0, 0, At, B0); PG8_BAR; PG8_SCHED;
            PG8_LDB(B1, 1, 1); PG8_STAGE(PG8_SB(1, 0), b2 + k3, voffB);
            PG8_BAR; PG8_WAIT_L(0); PG8_MMA(0, 1, At, B1); PG8_BAR;
            PG8_LDA(At, 1, 1); PG8_STAGE_A(PG8_SA(1, 0), a2, g2, 0, k3);
            PG8_BAR; PG8_WAIT_L(0); PG8_MMA(1, 0, At, B0); PG8_BAR; PG8_SCHED;
            PG8_STAGE(PG8_SB(1, 1), b2 + hstepB + k3, voffB);
            PG8_WAIT_V(6); PG8_BAR; PG8_MMA(1, 1, At, B1); PG8_BAR;
        }
        { int fr_e = fr, fq_e = fq; asm volatile("" : "+v"(fr_e), "+v"(fq_e)); E(acc, cur, wr, wc, fr_e, fq_e); }
        if (!has_next) break;
#pragma unroll
        for (int a = 0; a < 2; ++a)
#pragma unroll
            for (int b = 0; b < 2; ++b)
#pragma unroll
                for (int m = 0; m < 4; ++m)
#pragma unroll
                    for (int n = 0; n < 2; ++n) acc[a][b][m][n] = (f32x4){0.f, 0.f, 0.f, 0.f};
        cur = nxt; cA = nA; cB = nB; ++ui;
        if constexpr (GA) {
#pragma unroll
            for (int _h = 0; _h < 2; ++_h)
#pragma unroll
                for (int _i = 0; _i < 2; ++_i) gAc[_h][_i] = gAn[_h][_i];
        }
    }
    PG8_WAIT_V(0);
    if (wr == 0) PG8_BAR;
    PG8_BAR;
#undef PG8_SA
#undef PG8_SB
#undef PG8_STAGE
#undef PG8_STAGE_A
#undef PG8_LDA
#undef PG8_LDB
#undef PG8_MMA
#undef PG8_WAIT_V
#undef PG8_WAIT_L
#undef PG8_BAR
#undef PG8_SCHED
#undef PG8_GOFF
}
}
using pg8::Unit;

#define EPI_LOOP_BEGIN \
    _Pragma("unroll") for (int ai = 0; ai < 2; ++ai) _Pragma("unroll") for (int m = 0; m < 4; ++m) { const int trow = ai * 128 + wr * 64 + m * 16 + fr; \
    _Pragma("unroll") for (int bj = 0; bj < 2; ++bj) { const int tcol = bj * 128 + wc * 32 + 8 * fq; const f32x4 v0 = acc[ai][bj][m][0], v1 = acc[ai][bj][m][1];
#define EPI_LOOP_END } asm volatile("" ::: "memory"); }
__device__ __forceinline__ u32x4 pk8(const f32x4 a, const f32x4 b) { return (u32x4){pk2(a[0], a[1]), pk2(a[2], a[3]), pk2(b[0], b[1]), pk2(b[2], b[3])}; }

struct EpiRKV {
    unsigned char* ws; size_t voff;
    __device__ __forceinline__ void operator()(const f32x4 (&acc)[2][2][4][2], const Unit& u, int wr, int wc, int fr, int fq) const {
        const int which = u.pn >> 2; const size_t row0 = (size_t)(u.pm - which * (TG / 256)) * 256;
        const size_t off = which == 0 ? (WS_ARENA + AR_R) : (which == 1 ? (WS_ARENA + AR_K) : voff);
        bf16_t* dst = (bf16_t*)(ws + off); const int cb = (u.pn & 3) * 256;
        EPI_LOOP_BEGIN
            *(u32x4*)(dst + (row0 + trow) * D + cb + tcol) = pk8(v0, v1);
        EPI_LOOP_END
    }
};
struct EpiL1 {
    bf16_t* L1;
    __device__ __forceinline__ void operator()(const f32x4 (&acc)[2][2][4][2], const Unit& u, int wr, int wc, int fr, int fq) const {
        const int pn = u.pn; const size_t row0 = (size_t)u.pm * 256; const int cb = pn * 256;
        EPI_LOOP_BEGIN
            f32x4 o0 = v0, o1 = v1;
            if (pn == 0 && bj == 0) { _Pragma("unroll") for (int e = 0; e < 4; ++e) { o0[e] = tanhf_(v0[e]); o1[e] = tanhf_(v1[e]); } }
            if (pn == 1 && bj == 0) { _Pragma("unroll") for (int e = 0; e < 4; ++e) { o0[e] = sigmoidf_(v0[e]); o1[e] = sigmoidf_(v1[e]); } }
            *(u32x4*)(L1 + (row0 + trow) * 512 + cb + tcol) = pk8(o0, o1);
        EPI_LOOP_END
    }
};
template <int ACT> struct EpiStore {
    bf16_t* O; const float* bias;
    __device__ __forceinline__ void operator()(const f32x4 (&acc)[2][2][4][2], const Unit& u, int wr, int wc, int fr, int fq) const {
        const size_t row0 = (size_t)u.pm * 256; const int cb = u.pn * 256;
        f32x4 bv[2][2];
#pragma unroll
        for (int bj = 0; bj < 2; ++bj)
#pragma unroll
            for (int n = 0; n < 2; ++n) bv[bj][n] = ACT == 1 ? *(const f32x4*)(bias + cb + bj * 128 + wc * 32 + 8 * fq + 4 * n) : (f32x4){0.f, 0.f, 0.f, 0.f};
        EPI_LOOP_BEGIN
            f32x4 o0 = v0, o1 = v1;
            if (ACT == 1) { _Pragma("unroll") for (int e = 0; e < 4; ++e) { o0[e] = sigmoidf_(v0[e] + bv[bj][0][e]); o1[e] = sigmoidf_(v1[e] + bv[bj][1][e]); } }
            *(u32x4*)(O + (row0 + trow) * D + cb + tcol) = pk8(o0, o1);
        EPI_LOOP_END
    }
};
struct EpiGelu {
    bf16_t* Z; const float* bias;
    __device__ __forceinline__ void operator()(const f32x4 (&acc)[2][2][4][2], const Unit& u, int wr, int wc, int fr, int fq) const {
        const size_t row0 = (size_t)u.pm * 256; const int cb = u.pn * 256;
        f32x4 bv[2][2];
#pragma unroll
        for (int bj = 0; bj < 2; ++bj)
#pragma unroll
            for (int n = 0; n < 2; ++n) bv[bj][n] = *(const f32x4*)(bias + cb + bj * 128 + wc * 32 + 8 * fq + 4 * n);
        EPI_LOOP_BEGIN
            const f32x4 b0 = bv[bj][0], b1 = bv[bj][1];
            const f32x2 g0 = gelu_pk((f32x2){v0[0] + b0[0], v0[1] + b0[1]}), g1 = gelu_pk((f32x2){v0[2] + b0[2], v0[3] + b0[3]});
            const f32x2 g2 = gelu_pk((f32x2){v1[0] + b1[0], v1[1] + b1[1]}), g3 = gelu_pk((f32x2){v1[2] + b1[2], v1[3] + b1[3]});
            *(u32x4*)(Z + (row0 + trow) * 4096 + cb + tcol) = (u32x4){pk2(g0.x, g0.y), pk2(g1.x, g1.y), pk2(g2.x, g2.y), pk2(g3.x, g3.y)};
        EPI_LOOP_END
    }
};
struct EpiMG {
    bf16_t* HE;
    __device__ __forceinline__ void operator()(const f32x4 (&acc)[2][2][4][2], const Unit& u, int wr, int wc, int fr, int fq) const {
        const size_t row0 = (size_t)u.pm * 256; const int pnl = u.pn & 3;
#pragma unroll
        for (int ai = 0; ai < 2; ++ai)
#pragma unroll
            for (int m = 0; m < 4; ++m) { const int trow = ai * 128 + wr * 64 + m * 16 + fr;
#pragma unroll
                for (int bj = 0; bj < 2; ++bj) {
                    const f32x4 gt = acc[ai][bj][m][0], up = acc[ai][bj][m][1];
                    const int f = (8 * pnl + 4 * bj + wc) * 16 + 4 * fq;
                    float o[4];
#pragma unroll
                    for (int e = 0; e < 4; ++e) o[e] = gt[e] * sigmoidf_(gt[e]) * up[e];
                    u32x2 w; w.x = pk2(o[0], o[1]); w.y = pk2(o[2], o[3]);
                    *(u32x2*)(HE + (row0 + trow) * FEXP + f) = w;
                } }
    }
};
struct EpiMD {
    bf16_t* Y0; const int* lists; const float* lw; const LAS int* cn;
    __device__ __forceinline__ void operator()(const f32x4 (&acc)[2][2][4][2], const Unit& u, int wr, int wc, int fr, int fq) const {
        const int l = u.aux & 255, t0 = (u.aux >> 8) * 256, cnt = cn[l]; const int cb = (u.pn & 3) * 256;
        bf16_t* Y = Y0 + (size_t)(l & 1) * ((AR_YM1 - AR_YM0) / 2);
        int tok[2][4]; float wgt[2][4];
#pragma unroll
        for (int ai = 0; ai < 2; ++ai)
#pragma unroll
            for (int m = 0; m < 4; ++m) { const int idx = t0 + ai * 128 + wr * 64 + m * 16 + fr; const bool ok = idx < cnt;
                tok[ai][m] = ok ? lists[(size_t)l * TG + idx] : -1; wgt[ai][m] = ok ? lw[(size_t)l * TG + idx] : 0.f; }
#pragma unroll
        for (int ai = 0; ai < 2; ++ai)
#pragma unroll
            for (int m = 0; m < 4; ++m) {
                if (tok[ai][m] >= 0) {
                    const float wg = wgt[ai][m]; bf16_t* yr = Y + (size_t)tok[ai][m] * D + cb;
#pragma unroll
                    for (int bj = 0; bj < 2; ++bj) { const int tcol = bj * 128 + wc * 32 + 8 * fq;
                        *(u32x4*)(yr + tcol) = pk8(acc[ai][bj][m][0] * wg, acc[ai][bj][m][1] * wg); }
                } }
    }
};

struct Frame {
    const Params __attribute__((address_space(4)))* kp; LAS unsigned char* lds; int tid, lane, wave, G, bid;
    unsigned char* ws;
    __device__ __forceinline__ const float* in(int k) const { return kp->in[k]; }
    __device__ __forceinline__ float* outp() const { return kp->out; }
    template <class T> __device__ __forceinline__ T* wsp(size_t off) const { return (T*)(ws + off); }
    template <class T> __device__ __forceinline__ T* ar(size_t off) const { return (T*)(ws + WS_ARENA + off); }
    __device__ __forceinline__ const float* modL(int layer, int b, int j) const { return (const float*)(ws + WS_MODL) + (((size_t)layer * NB + b) * 6 + j) * D; }
    __device__ __forceinline__ const float* modC(int layer, int j) const { return (const float*)(ws + WS_MODC) + ((size_t)layer * 6 + j) * D; }
};

struct TJob { const float* src; bf16_t* dst; const float* ksc; int lds, K, N, ldd, kofs, nofs, inter; };
constexpr int NJOBS = 2 * 21 + 1 + 4 + 4 * NEXP * 3;
__device__ __forceinline__ TJob get_job(const Frame& F, int j) {
    TJob J; J.ksc = nullptr; J.kofs = 0; J.nofs = 0; J.inter = 0; J.K = 0; J.N = 0; J.lds = 0; J.ldd = 0; J.src = nullptr; J.dst = nullptr;
    if (j < 42) {
        const int a = j / 21, q = j % 21;
        if (q < 3) { J.src = F.in(9 + q) + (size_t)a * D * D; J.lds = D; J.K = D; J.N = D; J.dst = F.wsp<bf16_t>(WS_WRKV) + (size_t)a * 3072 * D; J.ldd = D; J.nofs = q * 1024; }
        else if (q < 15) {
            const int half = (q - 3) / 6, w = (q - 3) % 6; const float* mu = F.in(8) + (size_t)a * 6 * D;
            J.dst = F.wsp<bf16_t>(WS_WL) + (size_t)a * 512 * K1CAT; J.ldd = K1CAT; J.kofs = half * 1024; J.K = D; int mi = 0;
            if (w < 2) { J.src = F.in(14) + ((size_t)a * 2 + w) * D * 64; J.lds = 64; J.N = 64; J.nofs = w * 64; mi = 1; }
            else if (w < 4) { const int d = w - 2; J.src = F.in(17) + ((size_t)a * 2 + d) * D * 64; J.lds = 64; J.N = 64; J.nofs = 128 + d * 64; mi = 4; }
            else if (w == 4) { J.src = F.in(22) + (size_t)a * D * 128; J.lds = 128; J.N = 128; J.nofs = 256; mi = 5; }
            else { J.src = F.in(20); J.lds = 32; J.N = (a == 1) ? 32 : 0; J.nofs = 384; mi = 3; }
            if (half) J.ksc = mu + mi * D;
        } else if (q == 15) { J.src = F.in(12) + (size_t)a * D * D; J.lds = D; J.K = D; J.N = D; J.dst = F.wsp<bf16_t>(WS_WO) + (size_t)a * D * D; J.ldd = D; }
        else if (q == 16) { J.src = F.in(23) + (size_t)a * 128 * D; J.lds = D; J.K = 128; J.N = D; J.dst = F.wsp<bf16_t>(WS_G2T) + (size_t)a * D * 256; J.ldd = 256; }
        else if (q < 19) { const int d = q - 17; J.src = F.in(15) + ((size_t)a * 2 + d) * 64 * D; J.lds = D; J.K = 64; J.N = D; J.dst = F.wsp<bf16_t>(WS_W2T) + ((size_t)a * 2 + d) * D * 64; J.ldd = 64; }
        else { const int d = q - 19; J.src = F.in(18) + ((size_t)a * 2 + d) * 64 * D; J.lds = D; J.K = 64; J.N = D; J.dst = F.wsp<bf16_t>(WS_A2T) + ((size_t)a * 2 + d) * D * 64; J.ldd = 64; }
    } else if (j == 42) { J.src = F.in(21); J.lds = D; J.K = 32; J.N = D; J.dst = F.wsp<bf16_t>(WS_V2T); J.ldd = 256; J.kofs = 128; }
    else if (j < 47) {
        const int q = j - 43, b = q >> 1;
        if ((q & 1) == 0) { J.src = F.in(29) + (size_t)b * D * 4096; J.lds = 4096; J.K = D; J.N = 4096; J.dst = F.wsp<bf16_t>(WS_WIN) + (size_t)b * 4096 * D; J.ldd = D; }
        else { J.src = F.in(35) + (size_t)b * 2048 * D; J.lds = D; J.K = 2048; J.N = D; J.dst = F.wsp<bf16_t>(WS_WOUT) + (size_t)b * D * 2048; J.ldd = 2048; }
    } else {
        const int q = j - 47, ie = q / 3, w = q % 3;
        if (w < 2) { J.src = F.in(38 + w) + (size_t)ie * D * FEXP; J.lds = FEXP; J.K = D; J.N = FEXP; J.dst = F.wsp<bf16_t>(WS_WGU) + (size_t)ie * 1024 * D; J.ldd = D; J.nofs = w * 4; J.inter = 1; }
        else { J.src = F.in(40) + (size_t)ie * FEXP * D; J.lds = D; J.K = FEXP; J.N = D; J.dst = F.wsp<bf16_t>(WS_WD) + (size_t)ie * D * FEXP; J.ldd = FEXP; }
    }
    return J;
}
__device__ __forceinline__ void transpose_all(const Frame& F) {
    LAS unsigned* T = (LAS unsigned*)F.lds;
    LAS int* tab = (LAS int*)(F.lds + 32768);
    __syncthreads();
#pragma unroll 1
    for (int jj = F.wave; jj < NJOBS; jj += NWAVES) { const TJob J = get_job(F, jj); LAS int* e = tab + jj * 16;
        e[0] = (int)(unsigned)(size_t)J.src; e[1] = (int)(unsigned)((size_t)J.src >> 32); e[2] = (int)(unsigned)(size_t)J.dst; e[3] = (int)(unsigned)((size_t)J.dst >> 32);
        e[4] = (int)(unsigned)(size_t)J.ksc; e[5] = (int)(unsigned)((size_t)J.ksc >> 32); e[6] = J.lds; e[7] = J.K; e[8] = J.N; e[9] = J.ldd; e[10] = J.kofs; e[11] = J.nofs; e[12] = J.inter;
        const int tn_ = (J.N + 127) / 128; e[13] = ((J.K + 127) / 128) * tn_; e[15] = tn_; }
    __syncthreads();
    for (int jj = F.tid; jj < NJOBS; jj += NTHREADS) { int acc = 0; for (int i = 0; i < jj; ++i) acc += tab[i * 16 + 13]; tab[jj * 16 + 14] = acc; }
    __syncthreads();
#define TJI(j_, f_) __builtin_amdgcn_readfirstlane(tab[(j_) * 16 + (f_)])
#define TJP(T_, j_, f_) ((T_)(size_t)(((unsigned long long)(unsigned)TJI(j_, (f_) + 1) << 32) | (unsigned long long)(unsigned)TJI(j_, f_)))
    int j = 0, t = 0;
#define TR_ENTER() do { t = (F.bid - (TJI(j, 14) % F.G) + F.G) % F.G; } while (0)
#define TR_SKIP() do { while (j < NJOBS && t >= TJI(j, 13)) { ++j; if (j < NJOBS) TR_ENTER(); } } while (0)
#define TR_LOAD() do { const int jl_ = j < NJOBS ? j : NJOBS - 1, tl_ = j < NJOBS ? t : 0; \
        const int tn_ = TJI(jl_, 15), K_ = TJI(jl_, 7), N_ = TJI(jl_, 8), ls_ = TJI(jl_, 6); const float* src_ = TJP(const float*, jl_, 0); \
        const int k0_ = (tl_ / tn_) * 128, n0_ = (tl_ % tn_) * 128; _Pragma("unroll") for (int e = 0; e < 4; ++e) { const int idx = F.tid + e * 512, n4 = idx & 31, kp = idx >> 5; \
        const bool ok_ = (k0_ + 2 * kp < K_) && (n0_ + 4 * n4 < N_); const float* q_ = src_ + (ok_ ? ((size_t)(k0_ + 2 * kp) * ls_ + n0_ + 4 * n4) : (size_t)0); \
        const f32x4 x0_ = *(const f32x4*)q_, x1_ = *(const f32x4*)(q_ + (ok_ ? ls_ : 0)); const f32x4 z_ = (f32x4){0.f, 0.f, 0.f, 0.f}; va[e] = ok_ ? x0_ : z_; vb[e] = ok_ ? x1_ : z_; } } while (0)
    TR_ENTER(); TR_SKIP();
    f32x4 va[4], vb[4];
    TR_LOAD();
#pragma unroll 1
    while (j < NJOBS) {
        const int jc = j, tnc = TJI(jc, 15), Kc = TJI(jc, 7), Nc = TJI(jc, 8), k0 = (t / tnc) * 128, n0 = (t % tnc) * 128;
        const float* ksc = TJP(const float*, jc, 4);
        LDS_BAR();
#pragma unroll
        for (int e = 0; e < 4; ++e) { const int idx = F.tid + e * 512, n4 = idx & 31, kp = idx >> 5;
            float s0 = 1.f, s1 = 1.f; if (ksc && k0 + 2 * kp < Kc) { s0 = ksc[k0 + 2 * kp]; s1 = ksc[k0 + 2 * kp + 1]; }
            LAS unsigned* q = T + (4 * n4) * 64 + (((kp >> 2) ^ (n4 & 15)) << 2) + (kp & 3);
            q[0] = pk2(va[e][0] * s0, vb[e][0] * s1); q[64] = pk2(va[e][1] * s0, vb[e][1] * s1); q[128] = pk2(va[e][2] * s0, vb[e][2] * s1); q[192] = pk2(va[e][3] * s0, vb[e][3] * s1); }
        t += F.G; TR_SKIP();
        TR_LOAD();
        LDS_BAR();
        bf16_t* dst = TJP(bf16_t*, jc, 2); const int ldd = TJI(jc, 9), kofs = TJI(jc, 10), nofs = TJI(jc, 11), inter = TJI(jc, 12);
#pragma unroll
        for (int e = 0; e < 4; ++e) { const int idx = F.tid + e * 512, kg = idx & 15, nn = idx >> 4;
            if (k0 + 8 * kg < Kc && n0 + nn < Nc) { const int n = n0 + nn; const int row = nofs + (inter ? ((n >> 4) * 32 + ((n & 15) >> 2) * 8 + (n & 3)) : n);
                *(u32x4*)(dst + (size_t)row * ldd + kofs + k0 + 8 * kg) = *(const LAS u32x4*)(T + nn * 64 + ((kg ^ ((nn >> 2) & 15)) << 2)); } }
    }
#undef TR_ENTER
#undef TR_SKIP
#undef TR_LOAD
#undef TJI
#undef TJP
    __syncthreads();
}
__device__ __forceinline__ void zero_rows(const Frame& F, bf16_t* dst, int ldd, int row0, int nrows, int col0, int ncols) {
    const int per = ncols / 8; const long tot = (long)nrows * per;
    for (long i = (long)F.bid * NTHREADS + F.tid; i < tot; i += (long)F.G * NTHREADS) { const int r = (int)(i / per), c = (int)(i % per) * 8;
        *(u32x4*)(dst + (size_t)(row0 + r) * ldd + col0 + c) = (u32x4){0u, 0u, 0u, 0u}; }
}
__device__ __forceinline__ void phase_prologue(const Frame& F) {
    {
        LAS float* sl = (LAS float*)F.lds;
        LAS float* red = (LAS float*)(F.lds + 33 * 256 * 4);
        LAS float* cred = red + 8 * 32 * 64;
        const float* c = F.in(1); const float* cc = F.in(3); const float* wm = F.in(4); const float* bm = F.in(5);
        const int wv = F.wave, li = F.lane & 15, kq = F.lane >> 4;
        for (int unit = F.bid; unit < 4 * 96; unit += F.G) {
            const int layer = unit / 96, col0 = (unit % 96) * 64;
            f32x4 acc[2][4]; float cacc[4];
#pragma unroll
            for (int nt = 0; nt < 4; ++nt) { acc[0][nt] = (f32x4){0.f, 0.f, 0.f, 0.f}; acc[1][nt] = acc[0][nt]; cacc[nt] = 0.f; }
#pragma unroll 1
            for (int kc = 0; kc < 4; ++kc) {
                float xs[17];
#pragma unroll
                for (int e = 0; e < 17; ++e) { const int i = F.tid + e * NTHREADS, r = i >> 8, k = (i & 255) + kc * 256; xs[e] = i < 33 * 256 ? (r < 32 ? c[r * D + k] : cc[k]) : 0.f; }
                float w[2][4][4];
#pragma unroll
                for (int gq = 0; gq < 2; ++gq)
#pragma unroll
                    for (int st = 0; st < 4; ++st)
#pragma unroll
                        for (int nt = 0; nt < 4; ++nt) w[gq][st][nt] = wm[((size_t)layer * D + kc * 256 + wv * 32 + 16 * gq + 4 * kq + st) * 6144 + col0 + 16 * nt + li];
                LDS_BAR();
#pragma unroll
                for (int e = 0; e < 17; ++e) { const int i = F.tid + e * NTHREADS; if (i < 33 * 256) sl[i] = xs[e] * sigmoidf_(xs[e]); }
                LDS_BAR();
#pragma unroll
                for (int gq = 0; gq < 2; ++gq) {
                    const int kl = wv * 32 + 16 * gq + 4 * kq;
                    const f32x4 a0 = *(const LAS f32x4*)(sl + li * 256 + kl), a1 = *(const LAS f32x4*)(sl + (16 + li) * 256 + kl), ac = *(const LAS f32x4*)(sl + 32 * 256 + kl);
#pragma unroll
                    for (int st = 0; st < 4; ++st)
#pragma unroll
                        for (int nt = 0; nt < 4; ++nt) {
                            acc[0][nt] = __builtin_amdgcn_mfma_f32_16x16x4f32(a0[st], w[gq][st][nt], acc[0][nt], 0, 0, 0);
                            acc[1][nt] = __builtin_amdgcn_mfma_f32_16x16x4f32(a1[st], w[gq][st][nt], acc[1][nt], 0, 0, 0);
                            cacc[nt] = __builtin_fmaf(ac[st], w[gq][st][nt], cacc[nt]);
                        }
                }
            }
            LDS_BAR();
#pragma unroll
            for (int mt = 0; mt < 2; ++mt)
#pragma unroll
                for (int nt = 0; nt < 4; ++nt)
#pragma unroll
                    for (int r = 0; r < 4; ++r) red[(wv * 32 + mt * 16 + 4 * kq + r) * 64 + 16 * nt + li] = acc[mt][nt][r];
#pragma unroll
            for (int nt = 0; nt < 4; ++nt) cred[(wv * 4 + kq) * 64 + 16 * nt + li] = cacc[nt];
            LDS_BAR();
            for (int i = F.tid; i < 33 * 64; i += NTHREADS) { const int r = i >> 6, x = i & 63; float s = 0.f;
                if (r < 32) {
#pragma unroll
                    for (int y = 0; y < 8; ++y) s += red[(y * 32 + r) * 64 + x];
                } else {
#pragma unroll
                    for (int y = 0; y < 32; ++y) s += cred[y * 64 + x];
                }
                const int col = col0 + x; s += bm[layer * 6144 + col];
                if (r < 32) F.wsp<float>(WS_MODL)[((size_t)layer * NB + r) * 6144 + col] = s; else F.wsp<float>(WS_MODC)[(size_t)layer * 6144 + col] = s; }
        }
    }
    __syncthreads();
    transpose_all(F);
    for (int a = 0; a < 2; ++a) {
        bf16_t* WLp = F.wsp<bf16_t>(WS_WL) + (size_t)a * 512 * K1CAT;
        if (a == 0) zero_rows(F, WLp, K1CAT, 384, 128, 0, K1CAT); else zero_rows(F, WLp, K1CAT, 416, 96, 0, K1CAT);
        zero_rows(F, F.wsp<bf16_t>(WS_G2T) + (size_t)a * D * 256, 256, 0, D, 128, 128);
    }
    zero_rows(F, F.wsp<bf16_t>(WS_V2T), 256, 0, D, 0, 128); zero_rows(F, F.wsp<bf16_t>(WS_V2T), 256, 0, D, 160, 96);
    {
        const float* src = F.in(33); bf16_t* dst = F.wsp<bf16_t>(WS_WSP); const long tot = (long)2 * 16 * 128 * 128 / 4;
        for (long i = (long)F.bid * NTHREADS + F.tid; i < tot; i += (long)F.G * NTHREADS) { const f32x4 v = *(const f32x4*)(src + i * 4); u32x2 w; w.x = pk2(v[0], v[1]); w.y = pk2(v[2], v[3]); *(u32x2*)(dst + i * 4) = w; }
    }
    __syncthreads();
}

__device__ __forceinline__ void phase_norm1(const Frame& F, int g, int layer  , bf16_t* dst, int ldh, bool dry = false) {
    bf16_t* X = F.wsp<bf16_t>(WS_X);
    const bf16_t* Y0 = F.ar<bf16_t>(AR_YM0); const bf16_t* Y1 = F.ar<bf16_t>(AR_YM1);
    const bool fin = layer == 4;
    const int rpb = (TG + F.G - 1) / F.G, rbeg = F.bid * rpb, rend = (rbeg + rpb) < TG ? (rbeg + rpb) : TG;
    int key = -1; f32x4 cg[4], cA[4], cB[4];
#pragma unroll
    for (int q = 0; q < 4; ++q) { cg[q] = (f32x4){0.f, 0.f, 0.f, 0.f}; cA[q] = cg[q]; cB[q] = cg[q]; }
    for (int r = rbeg + F.wave; r < rend; r += NWAVES) {
        const int bl = r / LT, t = r % LT, b = g * BG + bl; const bool isctx = t < LC;
        if (isctx && layer >= 3) continue;
        if (key != b * 2 + (int)isctx) {
            key = b * 2 + (int)isctx;
#pragma unroll
            for (int q = 0; q < 4; ++q) { const int c = q * 256 + F.lane * 4;
                if (layer > 0) cg[q] = *(const f32x4*)((isctx ? F.modC(layer - 1, 5) : F.modL(layer - 1, b, 5)) + c);
                if (fin) cA[q] = *(const f32x4*)(F.in(41) + c);
                else { const f32x4 gv = *(const f32x4*)(F.in(6) + (size_t)layer * D + c), cv = *(const f32x4*)((isctx ? F.modC(layer, 1) : F.modL(layer, b, 1)) + c);
                    cA[q] = gv * (1.0f + cv); cB[q] = *(const f32x4*)((isctx ? F.modC(layer, 0) : F.modL(layer, b, 0)) + c); } }
        }
        f32x4 x[4], xo[4];
#pragma unroll
        for (int q = 0; q < 4; ++q) xo[q] = (f32x4){0.f, 0.f, 0.f, 0.f};
        if (layer == 0) {
            const float* src = isctx ? F.in(2) + ((size_t)b * LC + t) * D : F.in(0) + ((size_t)b * SEQ + (t - LC)) * D;
#pragma unroll
            for (int q = 0; q < 4; ++q) x[q] = *(const f32x4*)(src + q * 256 + F.lane * 4);
        } else {
#pragma unroll
            for (int q = 0; q < 4; ++q) { const int c = q * 256 + F.lane * 4;
                { const u32x2 xw = *(const u32x2*)(X + (size_t)r * D + c); x[q] = (f32x4){lo16(xw.x), hi16(xw.x), lo16(xw.y), hi16(xw.y)}; } xo[q] = x[q];
                const u32x2 a = *(const u32x2*)(Y0 + (size_t)r * D + c), bb = *(const u32x2*)(Y1 + (size_t)r * D + c);
                x[q][0] += cg[q][0] * (lo16(a.x) + lo16(bb.x)); x[q][1] += cg[q][1] * (hi16(a.x) + hi16(bb.x));
                x[q][2] += cg[q][2] * (lo16(a.y) + lo16(bb.y)); x[q][3] += cg[q][3] * (hi16(a.y) + hi16(bb.y)); }
        }
        float ss = 0.f;
#pragma unroll
        for (int q = 0; q < 4; ++q) ss += x[q][0] * x[q][0] + x[q][1] * x[q][1] + x[q][2] * x[q][2] + x[q][3] * x[q][3];
        ss = wave_sum_dpp(ss);
        const float rstd = rsqrtf(ss * (1.0f / D) + 1e-6f);
        if (fin) {
            float* o = F.outp() + ((size_t)b * SEQ + (t - LC)) * D;
#pragma unroll
            for (int q = 0; q < 4; ++q) { const int c = q * 256 + F.lane * 4; *(f32x4*)(o + c) = x[q] * rstd * cA[q]; }
        } else {
#pragma unroll
            for (int q = 0; q < 4; ++q) { const int c = q * 256 + F.lane * 4;
                { const f32x4 xs = (dry && layer > 0) ? xo[q] : x[q]; u32x2 xw; xw.x = pk2(xs[0], xs[1]); xw.y = pk2(xs[2], xs[3]); *(u32x2*)(X + (size_t)r * D + c) = xw; }
                const f32x4 h = x[q] * rstd * cA[q] + cB[q];
                u32x2 w; w.x = pk2(h[0], h[1]); w.y = pk2(h[2], h[3]);
                *(u32x2*)(dst + (size_t)r * ldh + c) = w; }
        }
    }
}
__device__ __forceinline__ void phase_mix(const Frame& F, int a) {
    bf16_t* H2 = F.ar<bf16_t>(AR_H2); bf16_t* XM = F.ar<bf16_t>(AR_XR);
    const float* mu = F.in(8) + (size_t)a * 6 * D;
    f32x4 cm[2][3][2];
#pragma unroll
    for (int q = 0; q < 2; ++q)
#pragma unroll
        for (int m = 0; m < 3; ++m) { const int mi = m == 0 ? 0 : (m == 1 ? 2 : 3); const int c = q * 512 + F.lane * 8;
            cm[q][m][0] = *(const f32x4*)(mu + mi * D + c); cm[q][m][1] = *(const f32x4*)(mu + mi * D + c + 4); }
    const int rpb = (TG + F.G - 1) / F.G, rbeg = F.bid * rpb, rend = (rbeg + rpb) < TG ? (rbeg + rpb) : TG;
    for (int r = rbeg + F.wave; r < rend; r += NWAVES) {
        const int t = r % LT; const bool isctx = t < LC; const int p = t - LC;
#pragma unroll
        for (int q = 0; q < 2; ++q) {
            const int c = q * 512 + F.lane * 8;
            int nr;
            if (isctx) nr = (q == 0) ? (t > 0 ? r - 1 : -1) : (t < LC - 1 ? r + 1 : -1);
            else { const int qu = c >> 8;
                nr = qu == 0 ? ((p & 63) > 0 ? r - 1 : -1) : qu == 1 ? ((p & 63) < 63 ? r + 1 : -1) : qu == 2 ? (p >= 64 ? r - 64 : -1) : (p < SEQ - 64 ? r + 64 : -1); }
            const u32x4 hs = *(const u32x4*)(H2 + (size_t)r * 2048 + c);
            u32x4 hn = (u32x4){0u, 0u, 0u, 0u};
            if (nr >= 0) hn = *(const u32x4*)(H2 + (size_t)nr * 2048 + c);
            const float h[8] = {lo16(hs.x), hi16(hs.x), lo16(hs.y), hi16(hs.y), lo16(hs.z), hi16(hs.z), lo16(hs.w), hi16(hs.w)};
            const float n[8] = {lo16(hn.x), hi16(hn.x), lo16(hn.y), hi16(hn.y), lo16(hn.z), hi16(hn.z), lo16(hn.w), hi16(hn.w)};
            float dd[8];
#pragma unroll
            for (int e = 0; e < 8; ++e) dd[e] = n[e] - h[e];
            *(u32x4*)(H2 + (size_t)r * 2048 + 1024 + c) = (u32x4){pk2(dd[0], dd[1]), pk2(dd[2], dd[3]), pk2(dd[4], dd[5]), pk2(dd[6], dd[7])};
#pragma unroll
            for (int m = 0; m < 3; ++m) {
                const f32x4 m0 = cm[q][m][0], m1 = cm[q][m][1];
                float x[8];
#pragma unroll
                for (int e = 0; e < 4; ++e) { x[e] = h[e] + dd[e] * m0[e]; x[4 + e] = h[4 + e] + dd[4 + e] * m1[e]; }
                *(u32x4*)(XM + (size_t)m * TG * D + (size_t)r * D + c) = (u32x4){pk2(x[0], x[1]), pk2(x[2], x[3]), pk2(x[4], x[5]), pk2(x[6], x[7])};
            }
        }
    }
}
__device__ __forceinline__ void phase_vfix(const Frame& F) {
    bf16_t* V = F.ar<bf16_t>(AR_V); const bf16_t* VF = F.wsp<bf16_t>(WS_VF); const bf16_t* GT = F.ar<bf16_t>(AR_VGATE);
    const size_t tot = (size_t)TG * D / 8;
    for (size_t i = (size_t)F.bid * NTHREADS + F.tid; i < tot; i += (size_t)F.G * NTHREADS) {
        const u32x4 v = *(const u32x4*)(V + i * 8), f = *(const u32x4*)(VF + i * 8), g = *(const u32x4*)(GT + i * 8);
        u32x4 o;
        o.x = pk2(lo16(v.x) + (lo16(f.x) - lo16(v.x)) * lo16(g.x), hi16(v.x) + (hi16(f.x) - hi16(v.x)) * hi16(g.x));
        o.y = pk2(lo16(v.y) + (lo16(f.y) - lo16(v.y)) * lo16(g.y), hi16(v.y) + (hi16(f.y) - hi16(v.y)) * hi16(g.y));
        o.z = pk2(lo16(v.z) + (lo16(f.z) - lo16(v.z)) * lo16(g.z), hi16(v.z) + (hi16(f.z) - hi16(v.z)) * hi16(g.z));
        o.w = pk2(lo16(v.w) + (lo16(f.w) - lo16(v.w)) * lo16(g.w), hi16(v.w) + (hi16(f.w) - hi16(v.w)) * hi16(g.w));
        *(u32x4*)(V + i * 8) = o;
    }
}
__device__ __forceinline__ void phase_post(const Frame& F, int a, const bf16_t* V) {
    const bf16_t* Y0 = F.ar<bf16_t>(AR_Y0); bf16_t* YG = F.ar<bf16_t>(AR_R); const bf16_t* Y1 = F.ar<bf16_t>(AR_Y1); const float* DOT = F.ar<float>(AR_DOT); const bf16_t* Gb = F.ar<bf16_t>(AR_G);
    const float* lgp = F.in(27) + (size_t)a * D + F.lane * 16; const float* lbp = F.in(28) + (size_t)a * D + F.lane * 16;
    float lg[16], lb[16];
#pragma unroll
    for (int e = 0; e < 16; e += 4) { const f32x4 gq = *(const f32x4*)(lgp + e), bq = *(const f32x4*)(lbp + e);
        lg[e] = gq[0]; lg[e + 1] = gq[1]; lg[e + 2] = gq[2]; lg[e + 3] = gq[3]; lb[e] = bq[0]; lb[e + 1] = bq[1]; lb[e + 2] = bq[2]; lb[e + 3] = bq[3]; }
    const int rpb = (TG + F.G - 1) / F.G, rbeg = F.bid * rpb, rend = (rbeg + rpb) < TG ? (rbeg + rpb) : TG;
    for (int r = rbeg + F.wave; r < rend; r += NWAVES) {
        const int c = F.lane * 16, h = F.lane >> 2;
        float y[16], vv[16];
#pragma unroll
        for (int q = 0; q < 2; ++q) {
            const u32x4 a0 = *(const u32x4*)(Y0 + (size_t)r * D + c + q * 8), a1 = *(const u32x4*)(Y1 + (size_t)r * D + c + q * 8), v4 = *(const u32x4*)(V + (size_t)r * D + c + q * 8);
            y[q * 8 + 0] = lo16(a0.x) + lo16(a1.x); y[q * 8 + 1] = hi16(a0.x) + hi16(a1.x); y[q * 8 + 2] = lo16(a0.y) + lo16(a1.y); y[q * 8 + 3] = hi16(a0.y) + hi16(a1.y);
            y[q * 8 + 4] = lo16(a0.z) + lo16(a1.z); y[q * 8 + 5] = hi16(a0.z) + hi16(a1.z); y[q * 8 + 6] = lo16(a0.w) + lo16(a1.w); y[q * 8 + 7] = hi16(a0.w) + hi16(a1.w);
            vv[q * 8 + 0] = lo16(v4.x); vv[q * 8 + 1] = hi16(v4.x); vv[q * 8 + 2] = lo16(v4.y); vv[q * 8 + 3] = hi16(v4.y);
            vv[q * 8 + 4] = lo16(v4.z); vv[q * 8 + 5] = hi16(v4.z); vv[q * 8 + 6] = lo16(v4.w); vv[q * 8 + 7] = hi16(v4.w);
        }
        float s = 0.f;
#pragma unroll
        for (int e = 0; e < 16; ++e) s += y[e];
        s = red4(s); const float mean = s * (1.0f / 64.0f);
        float qv = 0.f;
#pragma unroll
        for (int e = 0; e < 16; ++e) { const float dd = y[e] - mean; qv += dd * dd; }
        qv = red4(qv); const float rstd = rsqrtf(qv * (1.0f / 64.0f) + 64e-5f);
        const float dsum = DOT[(size_t)r * NH + h] + DOT[((size_t)TG + r) * NH + h];
        unsigned o[8];
        const u32x4 g0 = *(const u32x4*)(Gb + (size_t)r * D + c), g1 = *(const u32x4*)(Gb + (size_t)r * D + c + 8);
        const unsigned gw[8] = {g0.x, g0.y, g0.z, g0.w, g1.x, g1.y, g1.z, g1.w};
#pragma unroll
        for (int e = 0; e < 16; e += 2) {
            const float o0 = ((y[e] - mean) * rstd * lg[e] + lb[e] + vv[e] * dsum) * lo16(gw[e >> 1]);
            const float o1 = ((y[e + 1] - mean) * rstd * lg[e + 1] + lb[e + 1] + vv[e + 1] * dsum) * hi16(gw[e >> 1]);
            o[e >> 1] = pk2(o0, o1);
        }
        *(u32x4*)(YG + (size_t)r * D + c) = (u32x4){o[0], o[1], o[2], o[3]};
        *(u32x4*)(YG + (size_t)r * D + c + 8) = (u32x4){o[4], o[5], o[6], o[7]};
    }
}
__device__ __forceinline__ void phase_norm2(const Frame& F, int g, int layer, bool dry = false) {
    bf16_t* X = F.wsp<bf16_t>(WS_X); bf16_t* HM = F.ar<bf16_t>(AR_HM); const bf16_t* Ob = F.ar<bf16_t>(AR_O);
    int* lists = dry ? F.ar<int>(AR_YM0) : F.ar<int>(AR_LIST); float* lwt = dry ? F.ar<float>(AR_YM0) + (size_t)32 * TG : F.ar<float>(AR_LW);
    unsigned* cnt = (unsigned*)(F.ws + WS_CTL + CTL_CNT_OFF) + (((size_t)g * 4 + layer) * 32 + (dry ? NG * 4 * 32 : 0)) * 16;
    LAS float* wr = (LAS float*)F.lds;
    __syncthreads();
    for (int i = F.tid; i < D * NEXP / 4; i += NTHREADS) { const int c = i >> 2, e4 = i & 3; const int rho = (c & ~255) + (c & 3) * 64 + ((c & 255) >> 2);
        *(LAS f32x4*)(wr + rho * 20 + e4 * 4) = *(const f32x4*)(F.in(36) + i * 4); }
    __syncthreads();
    const float* rbias = F.in(37);
    float rb4[4];
#pragma unroll
    for (int e = 0; e < 4; ++e) rb4[e] = rbias[(F.lane >> 4) * 4 + e];
    const bool ctx_out = layer < 2;
    LAS int* lcnt = (LAS int*)(F.lds + LDS_MISC + 512);
    LAS int* lbase = (LAS int*)(F.lds + LDS_MISC + 640);
    LAS int* rec = (LAS int*)(F.lds + 81920);
    const int rpb = (TG + F.G - 1) / F.G, rbeg = F.bid * rpb, rend = (rbeg + rpb) < TG ? (rbeg + rpb) : TG;
    const int niter = (rpb + NWAVES - 1) / NWAVES;
    int key = -1; f32x4 cg[4], cA[4], cB[4];
#pragma unroll
    for (int q = 0; q < 4; ++q) { cg[q] = (f32x4){0.f, 0.f, 0.f, 0.f}; cA[q] = cg[q]; cB[q] = cg[q]; }
    for (int it0 = 0; it0 < niter; it0 += 64) {
        if (F.tid < 32) lcnt[F.tid] = 0;
        __syncthreads();
        const int itn = (niter - it0) < 64 ? (niter - it0) : 64;
        for (int itl = 0; itl < itn; ++itl) {
            const int r = rbeg + (it0 + itl) * NWAVES + F.wave;
            const int bl = r / LT, t = r % LT, b = g * BG + bl; const bool isctx = t < LC;
            const int slot = itl * NWAVES + F.wave;
            if (r >= rend || (isctx && !ctx_out)) { if (F.lane == 0) rec[slot * 4] = -1; continue; }
            if (key != b * 2 + (int)isctx) {
                key = b * 2 + (int)isctx;
#pragma unroll
                for (int q = 0; q < 4; ++q) { const int c = q * 256 + F.lane * 4;
                    cg[q] = *(const f32x4*)((isctx ? F.modC(layer, 2) : F.modL(layer, b, 2)) + c);
                    const f32x4 gv = *(const f32x4*)(F.in(7) + (size_t)layer * D + c), cv = *(const f32x4*)((isctx ? F.modC(layer, 4) : F.modL(layer, b, 4)) + c);
                    cA[q] = gv * (1.0f + cv); cB[q] = *(const f32x4*)((isctx ? F.modC(layer, 3) : F.modL(layer, b, 3)) + c); }
            }
            f32x4 x[4]; float ss = 0.f;
#pragma unroll
            for (int q = 0; q < 4; ++q) { const int c = q * 256 + F.lane * 4;
                { const u32x2 xw = *(const u32x2*)(X + (size_t)r * D + c); x[q] = (f32x4){lo16(xw.x), hi16(xw.x), lo16(xw.y), hi16(xw.y)}; }
                const u32x2 ob = *(const u32x2*)(Ob + (size_t)r * D + c); const f32x4 gv = cg[q];
                const f32x4 xo = x[q];
                x[q][0] += gv[0] * lo16(ob.x); x[q][1] += gv[1] * hi16(ob.x); x[q][2] += gv[2] * lo16(ob.y); x[q][3] += gv[3] * hi16(ob.y);
                { const f32x4 xs = dry ? xo : x[q]; u32x2 xw; xw.x = pk2(xs[0], xs[1]); xw.y = pk2(xs[2], xs[3]); *(u32x2*)(X + (size_t)r * D + c) = xw; }
                ss += x[q][0] * x[q][0] + x[q][1] * x[q][1] + x[q][2] * x[q][2] + x[q][3] * x[q][3]; }
            ss = wave_sum_dpp(ss);
            const float rstd = rsqrtf(ss * (1.0f / D) + 1e-6f);
            float lg[16];
#pragma unroll
            for (int e = 0; e < 16; ++e) lg[e] = 0.f;
#pragma unroll
            for (int q = 0; q < 4; ++q) { const int c = q * 256 + F.lane * 4;
                const f32x4 h = x[q] * rstd * cA[q] + cB[q];
                u32x2 w; w.x = pk2(h[0], h[1]); w.y = pk2(h[2], h[3]);
                *(u32x2*)(HM + (size_t)r * D + c) = w;
#pragma unroll
                for (int j = 0; j < 4; ++j) {
#pragma unroll
                    for (int e4 = 0; e4 < 4; ++e4) { const f32x4 wv = *(const LAS f32x4*)(wr + (q * 256 + j * 64 + F.lane) * 20 + e4 * 4);
                        lg[e4 * 4 + 0] += h[j] * wv[0]; lg[e4 * 4 + 1] += h[j] * wv[1]; lg[e4 * 4 + 2] += h[j] * wv[2]; lg[e4 * 4 + 3] += h[j] * wv[3]; } }
            }
            float m8[8], xg[4];
#pragma unroll
            for (int e = 0; e < 8; ++e) { const auto sw = __builtin_amdgcn_permlane32_swap(__float_as_uint(lg[e]), __float_as_uint(lg[e + 8]), false, false); m8[e] = __uint_as_float(sw[0]) + __uint_as_float(sw[1]); }
#pragma unroll
            for (int e = 0; e < 4; ++e) { const auto sw = __builtin_amdgcn_permlane16_swap(__float_as_uint(m8[e]), __float_as_uint(m8[e + 4]), false, false); xg[e] = red16(__uint_as_float(sw[0]) + __uint_as_float(sw[1])); }
            float sc_[4], bs[4];
#pragma unroll
            for (int e = 0; e < 4; ++e) { sc_[e] = sigmoidf_(xg[e]); bs[e] = sc_[e] + rb4[e]; }
            const float hi01 = fmaxf(bs[0], bs[1]), lo01 = fminf(bs[0], bs[1]), hi23 = fmaxf(bs[2], bs[3]), lo23 = fminf(bs[2], bs[3]);
            const float gsc = fmaxf(hi01, hi23) + fmaxf(fminf(hi01, hi23), fmaxf(lo01, lo23));
            const float g0s = __int_as_float(__builtin_amdgcn_readlane(__float_as_int(gsc), 0)), g1s = __int_as_float(__builtin_amdgcn_readlane(__float_as_int(gsc), 16));
            const float g2s = __int_as_float(__builtin_amdgcn_readlane(__float_as_int(gsc), 32)), g3s = __int_as_float(__builtin_amdgcn_readlane(__float_as_int(gsc), 48));
            const bool c10 = g1s > g0s, c32 = g3s > g2s; const float v01 = c10 ? g1s : g0s, v23 = c32 ? g3s : g2s; const bool chi = v23 > v01;
            const int best = __builtin_amdgcn_readfirstlane(chi ? (c32 ? 3 : 2) : (c10 ? 1 : 0));
            float cb[4], cs[4];
#pragma unroll
            for (int e = 0; e < 4; ++e) { cb[e] = __int_as_float(__builtin_amdgcn_readlane(__float_as_int(bs[e]), best * 16)); cs[e] = __int_as_float(__builtin_amdgcn_readlane(__float_as_int(sc_[e]), best * 16)); }
            const bool d10 = cb[1] > cb[0], d32 = cb[3] > cb[2]; const float w01 = d10 ? cb[1] : cb[0], w23 = d32 ? cb[3] : cb[2]; const bool dhi = w23 > w01;
            const int j1 = dhi ? (d32 ? 3 : 2) : (d10 ? 1 : 0);
            const float e0 = j1 == 0 ? -1e30f : cb[0], e1 = j1 == 1 ? -1e30f : cb[1], e2 = j1 == 2 ? -1e30f : cb[2], e3 = j1 == 3 ? -1e30f : cb[3];
            const bool f10 = e1 > e0, f32_ = e3 > e2; const float u01 = f10 ? e1 : e0, u23 = f32_ ? e3 : e2; const bool fhi = u23 > u01;
            const int j2 = fhi ? (f32_ ? 3 : 2) : (f10 ? 1 : 0);
            const float s1 = (j1 & 2) ? ((j1 & 1) ? cs[3] : cs[2]) : ((j1 & 1) ? cs[1] : cs[0]);
            const float s2 = (j2 & 2) ? ((j2 & 1) ? cs[3] : cs[2]) : ((j2 & 1) ? cs[1] : cs[0]);
            const float inv = __builtin_amdgcn_rcpf(s1 + s2);
            if (F.lane == 0) {
                const int l1 = (best * 4 + j1) * 2 + 0, l2 = (best * 4 + j2) * 2 + 1;
                const int p1 = __hip_atomic_fetch_add(lcnt + l1, 1, __ATOMIC_RELAXED, __HIP_MEMORY_SCOPE_WORKGROUP);
                const int p2 = __hip_atomic_fetch_add(lcnt + l2, 1, __ATOMIC_RELAXED, __HIP_MEMORY_SCOPE_WORKGROUP);
                rec[slot * 4 + 0] = l1 | (p1 << 8); rec[slot * 4 + 1] = l2 | (p2 << 8);
                rec[slot * 4 + 2] = __float_as_int(s1 * inv); rec[slot * 4 + 3] = __float_as_int(s2 * inv);
            }
        }
        __syncthreads();
        if (F.tid < 32) { const int c = lcnt[F.tid]; lbase[F.tid] = c ? (int)atomicAdd(&cnt[F.tid * 16], (unsigned)c) : 0; }
        __syncthreads();
        for (int slot = F.tid; slot < itn * NWAVES; slot += NTHREADS) {
            const int a0 = rec[slot * 4 + 0]; if (a0 < 0) continue;
            const int a1 = rec[slot * 4 + 1];
            const int r = rbeg + (it0 + slot / NWAVES) * NWAVES + (slot % NWAVES);
            const int l1 = a0 & 255, l2 = a1 & 255; const int q1 = lbase[l1] + (a0 >> 8), q2 = lbase[l2] + (a1 >> 8);
            lists[(size_t)l1 * TG + q1] = r; lwt[(size_t)l1 * TG + q1] = __int_as_float(rec[slot * 4 + 2]);
            lists[(size_t)l2 * TG + q2] = r; lwt[(size_t)l2 * TG + q2] = __int_as_float(rec[slot * 4 + 3]);
        }
        __syncthreads();
    }
}
__device__ __forceinline__ int moe_tables(const Frame& F, int g, int layer) {
    LAS int* cn = (LAS int*)(F.lds + LDS_MISC + 64); LAS int* tb = (LAS int*)(F.lds + LDS_MISC + 192);
    const unsigned* cnt = (const unsigned*)(F.ws + WS_CTL + CTL_CNT_OFF) + ((size_t)g * 4 + layer) * 32 * 16;
    __syncthreads();
    if (F.tid < 32) cn[F.tid] = (int)__hip_atomic_load(cnt + F.tid * 16, __ATOMIC_RELAXED, __HIP_MEMORY_SCOPE_AGENT);
    __syncthreads();
    if (F.tid == 0) { int acc = 0; for (int l = 0; l < 32; ++l) { tb[l] = acc; acc += (cn[l] + 255) >> 8; } tb[32] = acc; }
    __syncthreads();
    return tb[32];
}

constexpr int SC_OPB = 6 * 4096;
constexpr int SC_HALF = 2 * SC_OPB + 4096 + 4096;
static_assert(2 * SC_HALF <= LDS_STAGE, "scan lds");
__device__ __forceinline__ int scan_tok(int d, int s) { return d == 0 ? s : (s < LC ? (LC - 1 - s) : (LT + LC - 1 - s)); }

constexpr int S4_KKP = 0, S4_RPP = 2048, S4_KDP = 4096, S4_KAP = 6144, S4_KDT = 8192, S4_KAT = 10496, S4_VT = 12800, S4_P15 = 15104, S4_PBSZ = 15360,
              S4_A1 = 30720, S4_B1 = 31232, S4_B2 = 31744, S4_A2 = 32256, S4_MI = 33280, S4_LI = 33792, S4_LX = 37888, S4_AT = 41984, S4_YB = 46080, S4_HALF = 50176;
static_assert(2 * S4_HALF <= LDS_STAGE, "scan4 lds");
#define MF16(a, b, c) __builtin_amdgcn_mfma_f32_16x16x32_bf16((a), (b), (c), 0, 0, 0)
__device__ __forceinline__ bf16x8 mkfrag(unsigned a, unsigned b, unsigned c, unsigned d) { return __builtin_bit_cast(bf16x8, (u32x4){a, b, c, d}); }
__device__ __forceinline__ f32x4 scan_inverse_mfma(f32x4 N, f32x4 NT, int g, int j) {
    const f32x4 z = (f32x4){0.f, 0.f, 0.f, 0.f};
#define P2(v) mkfrag(pk2((v)[0], (v)[1]), pk2((v)[2], (v)[3]), 0u, 0u)
    const bf16x8 Nc = P2(N), Ntc = P2(NT);
    const f32x4 Z2 = MF16(Ntc, Nc, z), Z2t = MF16(Nc, Ntc, z);
    f32x4 Q = (f32x4){(4 * g == j ? 1.f : 0.f) - NT[0], (4 * g + 1 == j ? 1.f : 0.f) - NT[1], (4 * g + 2 == j ? 1.f : 0.f) - NT[2], (4 * g + 3 == j ? 1.f : 0.f) - NT[3]};
    const bf16x8 Z2c = P2(Z2), Z2tc = P2(Z2t);
    const f32x4 Z4 = MF16(Z2tc, Z2c, z), Z4t = MF16(Z2c, Z2tc, z);
    Q = MF16(Z2c, P2(Q), Q);
    const bf16x8 Z4c = P2(Z4), Z4tc = P2(Z4t);
    const f32x4 Z8 = MF16(Z4tc, Z4c, z);
    Q = MF16(Z4c, P2(Q), Q);
    Q = MF16(P2(Z8), P2(Q), Q);
#undef P2
    return Q;
}
__device__ __forceinline__ void phase_scan4(const Frame& F, int a, const bf16_t* V) {
    const bf16_t* R = F.ar<bf16_t>(AR_R); const bf16_t* Kb = F.ar<bf16_t>(AR_K); const bf16_t* L1 = F.ar<bf16_t>(AR_L1);
    const int half = F.wave >> 2, q = F.wave & 3, lane = F.lane, li = q * 64 + lane;
    const int role = (q - half) & 3;
    LAS unsigned char* hb = F.lds + half * S4_HALF;
    const int arr = q >> 1, ntl = (q & 1) * 2;
    const int g = lane >> 4, j = lane & 15;
    const int tB = li >> 4, k4 = (li & 15) * 4;
    const int poff = (tB * 64 + (k4 >> 5) * 32 + ((k4 >> 2) & 3) * 8 + ((k4 >> 4) & 1) * 4) * 2;
    for (int pr = F.bid; pr < BG * 16; pr += F.G) {
        const int bl = pr >> 4, d = (pr >> 3) & 1, hp = pr & 7, h = hp * 2 + half;
        bf16_t* Yd = F.ar<bf16_t>(d ? AR_Y1 : AR_Y0); float* DOT = F.ar<float>(AR_DOT) + (size_t)d * TG * NH;
        const size_t rowb = (size_t)bl * LT;
        const bf16_t* W2 = (arr == 0 ? F.wsp<bf16_t>(WS_W2T) : F.wsp<bf16_t>(WS_A2T)) + ((size_t)a * 2 + d) * D * 64;
        const float* b0p = (arr == 0 ? F.in(13) : F.in(16)) + ((size_t)a * 2 + d) * D + h * 64;
        const int acol = arr * 128 + d * 64 + 8 * (lane >> 4);
        f32x4 Cb[4];
#pragma unroll
        for (int b = 0; b < 4; ++b) Cb[b] = (f32x4){0.f, 0.f, 0.f, 0.f};
        bf16x8 Af[2]; u32x2 kraw, rraw, vraw;
        bf16x8 wf0[2], wf1[2]; float bias2[2];
#pragma unroll
        for (int nt = 0; nt < 2; ++nt) { const int n = (ntl + nt) * 16 + (lane & 15); bias2[nt] = b0p[n];
            wf0[nt] = *(const bf16x8*)(W2 + (size_t)(h * 64 + n) * 64 + 8 * (lane >> 4)); wf1[nt] = *(const bf16x8*)(W2 + (size_t)(h * 64 + n) * 64 + 32 + 8 * (lane >> 4)); }
        const f32x4 kkc = *(const f32x4*)(F.in(24) + (size_t)a * D + h * 64 + k4), kac = *(const f32x4*)(F.in(25) + (size_t)a * D + h * 64 + k4), rkc = *(const f32x4*)(F.in(26) + (size_t)a * D + h * 64 + k4);
#define SC_BAR() asm volatile("s_waitcnt lgkmcnt(0)\n\ts_barrier" ::: "memory")
#define SC_LOAD(ch) do { const size_t rowA = rowb + scan_tok(d, (ch) * 16 + (lane & 15)); \
        Af[0] = *(const bf16x8*)(L1 + rowA * 512 + acol); Af[1] = *(const bf16x8*)(L1 + rowA * 512 + acol + 32); \
        const size_t rowBq = (rowb + scan_tok(d, (ch) * 16 + tB)) * D + h * 64 + k4; \
        kraw = *(const u32x2*)(Kb + rowBq); rraw = *(const u32x2*)(R + rowBq); vraw = *(const u32x2*)(V + rowBq); } while (0)
#define SC_PASSA() do { \
        _Pragma("unroll") for (int nt = 0; nt < 2; ++nt) { f32x4 ac = (f32x4){0.f, 0.f, 0.f, 0.f}; \
            const int n = (ntl + nt) * 16 + (lane & 15); const float bias_ = bias2[nt]; \
            ac = MF16(Af[0], wf0[nt], ac); ac = MF16(Af[1], wf1[nt], ac); \
            f32x4 sg; _Pragma("unroll") for (int rg = 0; rg < 4; ++rg) sg[rg] = sigmoidf_(ac[rg] + bias_); \
            if (arr == 0) { \
                const float l0 = -0.60653066f * sg[0], l1 = -0.60653066f * sg[1], l2 = -0.60653066f * sg[2], l3 = -0.60653066f * sg[3]; \
                const float p0 = l0, p1 = p0 + l1, p2 = p1 + l2, p3 = p2 + l3;                         \
                const auto s16 = __builtin_amdgcn_permlane16_swap(__float_as_uint(p3), __float_as_uint(p3), false, false);     \
                const float sv = __uint_as_float(s16[0]), pq = sv + __uint_as_float(s16[1]); \
                const auto s32 = __builtin_amdgcn_permlane32_swap(__float_as_uint(pq), __float_as_uint(pq), false, false);     \
                const float E = ((g & 1) ? sv : 0.f) + ((g & 2) ? __uint_as_float(s32[0]) : 0.f);      \
                LAS float* li_ = (LAS float*)(hb + S4_LI) + (4 * g) * 64 + n; LAS float* lx_ = (LAS float*)(hb + S4_LX) + (4 * g) * 64 + n; \
                li_[0] = E + p0; li_[64] = E + p1; li_[128] = E + p2; li_[192] = E + p3; lx_[0] = E; lx_[64] = E + p0; lx_[128] = E + p1; lx_[192] = E + p2; \
            } else { _Pragma("unroll") for (int rg = 0; rg < 4; ++rg) ((LAS float*)(hb + S4_AT))[(4 * g + rg) * 64 + n] = sg[rg]; } } } while (0)
#define SC_PASSB(ch, pbo_) do { LAS unsigned char* hq_ = hb + (pbo_); \
        const float kf[4] = {lo16(kraw.x), hi16(kraw.x), lo16(kraw.y), hi16(kraw.y)}; const float rf[4] = {lo16(rraw.x), hi16(rraw.x), lo16(rraw.y), hi16(rraw.y)}; \
        const f32x4 av = *(const LAS f32x4*)((LAS float*)(hb + S4_AT) + tB * 64 + k4), Li = *(const LAS f32x4*)((LAS float*)(hb + S4_LI) + tB * 64 + k4), Lx = *(const LAS f32x4*)((LAS float*)(hb + S4_LX) + tB * 64 + k4); \
        float kq[4], ssq = 0.f; _Pragma("unroll") for (int e = 0; e < 4; ++e) { kq[e] = kf[e] * kkc[e]; ssq += kq[e] * kq[e]; } \
        ssq = red16(ssq); const float inv = __builtin_amdgcn_rsqf(fmaxf(ssq, 1e-24f)); \
        float o_kk[4], o_ka[4], o_kd[4], o_r[4]; f32x4 o_p; float dp = 0.f; \
        _Pragma("unroll") for (int e = 0; e < 4; ++e) { const float Pt = __expf(Li[e]), Px = __expf(Lx[e]), iP = __builtin_amdgcn_rcpf(Pt); \
            const float kkv = kq[e] * inv; const float kd = kf[e] * (1.0f + (av[e] - 1.0f) * kac[e]); const float ka = kkv * av[e]; \
            o_kk[e] = kkv * Px; o_ka[e] = ka * iP; o_kd[e] = kd * iP; o_r[e] = rf[e] * Pt; o_p[e] = Pt; \
            dp += rf[e] * kd * rkc[e]; } \
        dp = red16(dp); \
        if ((li & 15) == 0) DOT[(rowb + scan_tok(d, (ch) * 16 + tB)) * NH + h] = dp; \
        const u32x2 w_kk = (u32x2){pk2(o_kk[0], o_kk[1]), pk2(o_kk[2], o_kk[3])}, w_r = (u32x2){pk2(o_r[0], o_r[1]), pk2(o_r[2], o_r[3])}; \
        const u32x2 w_kd = (u32x2){pk2(o_kd[0], o_kd[1]), pk2(o_kd[2], o_kd[3])}, w_ka = (u32x2){pk2(o_ka[0], o_ka[1]), pk2(o_ka[2], o_ka[3])}; \
        *(LAS u32x2*)(hq_ + S4_KKP + poff) = w_kk; *(LAS u32x2*)(hq_ + S4_RPP + poff) = w_r; *(LAS u32x2*)(hq_ + S4_KDP + poff) = w_kd; *(LAS u32x2*)(hq_ + S4_KAP + poff) = w_ka; \
        { LAS unsigned char* td = hq_ + S4_KDT + k4 * 36 + tB * 2; LAS unsigned char* ta = hq_ + S4_KAT + k4 * 36 + tB * 2; LAS unsigned char* tv = hq_ + S4_VT + k4 * 36 + tB * 2; \
          *(LAS unsigned short*)(td) = (unsigned short)w_kd.x; *(LAS unsigned short*)(td + 36) = (unsigned short)(w_kd.x >> 16); *(LAS unsigned short*)(td + 72) = (unsigned short)w_kd.y; *(LAS unsigned short*)(td + 108) = (unsigned short)(w_kd.y >> 16); \
          *(LAS unsigned short*)(ta) = (unsigned short)w_ka.x; *(LAS unsigned short*)(ta + 36) = (unsigned short)(w_ka.x >> 16); *(LAS unsigned short*)(ta + 72) = (unsigned short)w_ka.y; *(LAS unsigned short*)(ta + 108) = (unsigned short)(w_ka.y >> 16); \
          *(LAS unsigned short*)(tv) = (unsigned short)vraw.x; *(LAS unsigned short*)(tv + 36) = (unsigned short)(vraw.x >> 16); *(LAS unsigned short*)(tv + 72) = (unsigned short)vraw.y; *(LAS unsigned short*)(tv + 108) = (unsigned short)(vraw.y >> 16); } \
        if (tB == 15) *(LAS f32x4*)((LAS float*)(hq_ + S4_P15) + k4) = o_p; } while (0)
#define SC_PROD(pbo_) do { LAS unsigned char* hq_ = hb + (pbo_); \
        const int lo_ = (role < 2 ? S4_KKP : S4_RPP) + j * 128 + g * 16, ro_ = ((role == 0 || role == 3) ? S4_KAP : S4_KDP) + j * 128 + g * 16; \
        const bf16x8 fl0_ = *(const LAS bf16x8*)(hq_ + lo_), fr0_ = *(const LAS bf16x8*)(hq_ + ro_), fl1_ = *(const LAS bf16x8*)(hq_ + lo_ + 64), fr1_ = *(const LAS bf16x8*)(hq_ + ro_ + 64); \
        f32x4 pa = (f32x4){0.f, 0.f, 0.f, 0.f}; \
        pa = MF16(fl0_, fr0_, pa); pa = MF16(fl1_, fr1_, pa); \
        _Pragma("unroll") for (int r_ = 0; r_ < 4; ++r_) { const int t_ = 4 * g + r_; const bool keep = (role < 2) ? (j < t_) : (j <= t_); pa[r_] = keep ? pa[r_] : 0.f; } \
        if (role == 0) { f32x4 pt = (f32x4){0.f, 0.f, 0.f, 0.f}; pt = MF16(fr0_, fl0_, pt); pt = MF16(fr1_, fl1_, pt);        \
            _Pragma("unroll") for (int r_ = 0; r_ < 4; ++r_) pt[r_] = (j > 4 * g + r_) ? pt[r_] : 0.f; \
            const f32x4 mt_ = scan_inverse_mfma(pa, pt, g, j); \
            *(LAS u32x2*)(hb + S4_MI + j * 32 + g * 8) = (u32x2){pk2(mt_[0], mt_[1]), pk2(mt_[2], mt_[3])}; } \
        else { LAS unsigned char* dm = hb + (role == 1 ? S4_A1 : (role == 2 ? S4_B1 : S4_B2)) + ((4 * g) * 16 + j) * 2; const unsigned w0_ = pk2(pa[0], pa[1]), w1_ = pk2(pa[2], pa[3]); \
            *(LAS unsigned short*)(dm) = (unsigned short)w0_; *(LAS unsigned short*)(dm + 32) = (unsigned short)(w0_ >> 16); *(LAS unsigned short*)(dm + 64) = (unsigned short)w1_; *(LAS unsigned short*)(dm + 96) = (unsigned short)(w1_ >> 16); } } while (0)
        constexpr int NCH = LT / 16;
        __syncthreads();
        SC_LOAD(0);
        SC_PASSA();
        SC_BAR();
        SC_PASSB(0, 0);
        SC_BAR();
        SC_LOAD(1);
        SC_PASSA();
        SC_PROD(0);
        SC_BAR();
        SC_PASSB(1, S4_PBSZ);
        SC_BAR();
#pragma unroll 1
        for (int it = 0; it < 2 * NCH + 1; ++it) {
            const int s_ = it - half;
            if (s_ >= 0 && s_ < 2 * NCH) {
            const int ch = s_ >> 1;
            const int pbo = (ch & 1) * S4_PBSZ;
            LAS unsigned char* hc = hb + pbo;
            if ((s_ & 1) == 0) {
            if (ch + 2 < NCH) SC_LOAD(ch + 2);
            const bf16x8 Bs0 = mkfrag(pk2(Cb[0][0], Cb[0][1]), pk2(Cb[0][2], Cb[0][3]), pk2(Cb[1][0], Cb[1][1]), pk2(Cb[1][2], Cb[1][3]));
            const bf16x8 Bs1 = mkfrag(pk2(Cb[2][0], Cb[2][1]), pk2(Cb[2][2], Cb[2][3]), pk2(Cb[3][0], Cb[3][1]), pk2(Cb[3][2], Cb[3][3]));
            f32x4 X = (f32x4){0.f, 0.f, 0.f, 0.f}, H = (f32x4){0.f, 0.f, 0.f, 0.f};
            X = MF16(*(const LAS bf16x8*)(hc + S4_KKP + j * 128 + g * 16), Bs0, X); H = MF16(*(const LAS bf16x8*)(hc + S4_RPP + j * 128 + g * 16), Bs0, H);
            X = MF16(*(const LAS bf16x8*)(hc + S4_KKP + j * 128 + g * 16 + 64), Bs1, X); H = MF16(*(const LAS bf16x8*)(hc + S4_RPP + j * 128 + g * 16 + 64), Bs1, H);
            const u32x2 vw = (u32x2){*(const LAS unsigned*)(hc + S4_VT + (16 * q + j) * 36 + 8 * g), *(const LAS unsigned*)(hc + S4_VT + (16 * q + j) * 36 + 8 * g + 4)};
            const bf16x8 Bv = mkfrag(vw.x, vw.y, 0u, 0u);
            {
                const u32x2 a1w = *(const LAS u32x2*)(hb + S4_A1 + (j * 16 + 4 * g) * 2), b1w = *(const LAS u32x2*)(hb + S4_B1 + (j * 16 + 4 * g) * 2);
                X = MF16(mkfrag(a1w.x, a1w.y, 0u, 0u), Bv, X); H = MF16(mkfrag(b1w.x, b1w.y, 0u, 0u), Bv, H);
            }
            const u32x2 mw = *(const LAS u32x2*)(hb + S4_MI + j * 32 + g * 8);
            f32x4 SA = (f32x4){0.f, 0.f, 0.f, 0.f};
            SA = MF16(mkfrag(mw.x, mw.y, 0u, 0u), mkfrag(pk2(X[0], X[1]), pk2(X[2], X[3]), 0u, 0u), SA);
            const bf16x8 Bn = mkfrag(pk2(-SA[0], -SA[1]), pk2(-SA[2], -SA[3]), 0u, 0u);
            {
                const u32x2 b2w = *(const LAS u32x2*)(hb + S4_B2 + (j * 16 + 4 * g) * 2);
                H = MF16(mkfrag(b2w.x, b2w.y, 0u, 0u), Bn, H);
                LAS float* yb = (LAS float*)(hb + S4_YB) + (4 * g) * 64 + 16 * q + j; yb[0] = H[0]; yb[64] = H[1]; yb[128] = H[2]; yb[192] = H[3];
            }
#pragma unroll
            for (int b = 0; b < 4; ++b) {
                const u32x2 kdw = (u32x2){*(const LAS unsigned*)(hc + S4_KDT + (16 * b + j) * 36 + 8 * g), *(const LAS unsigned*)(hc + S4_KDT + (16 * b + j) * 36 + 8 * g + 4)};
                const u32x2 kaw = (u32x2){*(const LAS unsigned*)(hc + S4_KAT + (16 * b + j) * 36 + 8 * g), *(const LAS unsigned*)(hc + S4_KAT + (16 * b + j) * 36 + 8 * g + 4)};
                Cb[b] = MF16(mkfrag(kdw.x, kdw.y, 0u, 0u), Bv, Cb[b]);
                Cb[b] = MF16(mkfrag(kaw.x, kaw.y, 0u, 0u), Bn, Cb[b]);
            }
#pragma unroll
            for (int b = 0; b < 4; ++b) { const f32x4 pv = *(const LAS f32x4*)((LAS float*)(hc + S4_P15) + 16 * b + 4 * g); Cb[b] = Cb[b] * pv; }
            if (ch + 2 < NCH) SC_PASSA();
            } else {
            {
                const f32x4 yv = *(const LAS f32x4*)((LAS float*)(hb + S4_YB) + tB * 64 + k4);
                u32x2 w; w.x = pk2(yv[0], yv[1]); w.y = pk2(yv[2], yv[3]);
                *(u32x2*)(Yd + (rowb + scan_tok(d, ch * 16 + tB)) * D + h * 64 + k4) = w;
            }
            if (ch + 2 < NCH) SC_PASSB(ch + 2, pbo);
            __builtin_amdgcn_sched_barrier(0);
            if (ch + 1 < NCH) SC_PROD(pbo ^ S4_PBSZ);
            }
            }
            SC_BAR();
        }
#undef SC_LOAD
#undef SC_PASSA
#undef SC_PASSB
#undef SC_PROD
    }
}

__device__ __forceinline__ void phase_sgstats(const Frame& F, int layer) {
    const bf16_t* Z = F.ar<bf16_t>(AR_Z); float* ST = F.ar<float>(AR_ST);
    for (int r = F.bid * NWAVES + F.wave; r < TG; r += F.G * NWAVES) {
        const int t = r % LT; if (t < LC && layer >= 3) continue;
        float x[32];
#pragma unroll
        for (int q = 0; q < 4; ++q) { const u32x4 w = *(const u32x4*)(Z + (size_t)r * 4096 + 2048 + q * 512 + F.lane * 8);
            x[q * 8 + 0] = lo16(w.x); x[q * 8 + 1] = hi16(w.x); x[q * 8 + 2] = lo16(w.y); x[q * 8 + 3] = hi16(w.y); x[q * 8 + 4] = lo16(w.z); x[q * 8 + 5] = hi16(w.z); x[q * 8 + 6] = lo16(w.w); x[q * 8 + 7] = hi16(w.w); }
        float s = 0.f;
#pragma unroll
        for (int e = 0; e < 32; ++e) s += x[e];
        s = wave_sum(s); const float mean = s * (1.0f / 2048.0f);
        float qv = 0.f;
#pragma unroll
        for (int e = 0; e < 32; ++e) { const float dd = x[e] - mean; qv += dd * dd; }
        qv = wave_sum(qv);
        if (F.lane == 0) *(f32x2*)(ST + (size_t)r * 2) = (f32x2){mean, rsqrtf(qv * (1.0f / 2048.0f) + 1e-5f)};
    }
}
__device__ __forceinline__ int vt_off(int dch, int jb) { return dch * 256 + ((jb ^ ((dch & 15) ^ (((dch >> 4) & 7) << 1))) << 4); }
__device__ __forceinline__ void phase_spatial(const Frame& F, int bsg, int layer) {
    const bf16_t* Z = F.ar<bf16_t>(AR_Z); const float* ST = F.ar<float>(AR_ST); bf16_t* Pb = F.ar<bf16_t>(AR_P);
    const bf16_t* Ws = F.wsp<bf16_t>(WS_WSP) + (size_t)bsg * 16 * 128 * 128;
    const float* lng = F.in(31) + (size_t)bsg * 2048; const float* lnb = F.in(32) + (size_t)bsg * 2048; const float* bs = F.in(34) + (size_t)bsg * 16 * 128;
    LAS unsigned char* vt = F.lds;
    const int skip = layer >= 3;
    const int nchunk = skip ? BG * 16 : BG * 18;
    const int w = F.wave, lane = F.lane, dt = w >> 1, it0 = (w & 1) * 2;
    const int jj0 = F.tid >> 4, c8 = (F.tid & 15) * 8;
    u32x4 zz[4]; f32x2 st[4];
#define SP_ROW0(U_) ((size_t)(skip ? (((U_) >> 4) >> 4) * 18 + 2 + (((U_) >> 4) & 15) : ((U_) >> 4)) * 128)
#define SP_LOADZ(U_) do { const size_t r0_ = SP_ROW0(U_); const int gi_ = (U_) & 15; _Pragma("unroll") for (int k = 0; k < 4; ++k) { \
        zz[k] = *(const u32x4*)(Z + (r0_ + jj0 + 32 * k) * 4096 + 2048 + gi_ * 128 + c8); st[k] = *(const f32x2*)(ST + (r0_ + jj0 + 32 * k) * 2); } } while (0)
    if (F.bid < nchunk * 16) SP_LOADZ(F.bid);
    int gic = -1; float gg[8], bb[8], bias[2]; bf16x8 B0[8], B1[8];
#pragma unroll
    for (int e = 0; e < 8; ++e) { gg[e] = 0.f; bb[e] = 0.f; B0[e] = (bf16x8){0, 0, 0, 0, 0, 0, 0, 0}; B1[e] = B0[e]; }
    bias[0] = bias[1] = 0.f;
    for (int U = F.bid; U < nchunk * 16; U += F.G) {
        const int gi = U & 15;
        const size_t row0 = SP_ROW0(U);
        if (gi != gic) {
            gic = gi;
            const f32x4 g0 = *(const f32x4*)(lng + gi * 128 + c8), g1 = *(const f32x4*)(lng + gi * 128 + c8 + 4), b0 = *(const f32x4*)(lnb + gi * 128 + c8), b1 = *(const f32x4*)(lnb + gi * 128 + c8 + 4);
            gg[0] = g0[0]; gg[1] = g0[1]; gg[2] = g0[2]; gg[3] = g0[3]; gg[4] = g1[0]; gg[5] = g1[1]; gg[6] = g1[2]; gg[7] = g1[3];
            bb[0] = b0[0]; bb[1] = b0[1]; bb[2] = b0[2]; bb[3] = b0[3]; bb[4] = b1[0]; bb[5] = b1[1]; bb[6] = b1[2]; bb[7] = b1[3];
            const bf16_t* w0p = Ws + ((size_t)gi * 128 + it0 * 32 + (lane & 31)) * 128 + 8 * (lane >> 5);
#pragma unroll
            for (int s_ = 0; s_ < 8; ++s_) { B0[s_] = *(const bf16x8*)(w0p + 16 * s_); B1[s_] = *(const bf16x8*)(w0p + 32 * 128 + 16 * s_); }
#pragma unroll
            for (int it = 0; it < 2; ++it) bias[it] = bs[gi * 128 + (it0 + it) * 32 + (lane & 31)];
        }
        LDS_BAR();
#pragma unroll
        for (int k = 0; k < 4; ++k) {
            const int jj = jj0 + 32 * k;
            const float xv[8] = {lo16(zz[k].x), hi16(zz[k].x), lo16(zz[k].y), hi16(zz[k].y), lo16(zz[k].z), hi16(zz[k].z), lo16(zz[k].w), hi16(zz[k].w)};
#pragma unroll
            for (int e = 0; e < 8; e += 2) {
                const unsigned pw = pk2((xv[e] - st[k][0]) * st[k][1] * gg[e] + bb[e], (xv[e + 1] - st[k][0]) * st[k][1] * gg[e + 1] + bb[e + 1]);
                *(LAS unsigned short*)(vt + vt_off(c8 + e, jj >> 3) + (jj & 7) * 2) = (unsigned short)(pw & 0xFFFFu);
                *(LAS unsigned short*)(vt + vt_off(c8 + e + 1, jj >> 3) + (jj & 7) * 2) = (unsigned short)(pw >> 16);
            }
        }
        u32x2 uu[2][4];
#pragma unroll
        for (int it = 0; it < 2; ++it) { const int ii = (it0 + it) * 32 + (lane & 31);
#pragma unroll
            for (int rq = 0; rq < 4; ++rq) uu[it][rq] = *(const u32x2*)(Z + (row0 + ii) * 4096 + gi * 128 + dt * 32 + 8 * rq + 4 * (lane >> 5)); }
        if (U + F.G < nchunk * 16) SP_LOADZ(U + F.G);
        LDS_BAR();
        f32x16 acc0, acc1;
#pragma unroll
        for (int e = 0; e < 16; ++e) { acc0[e] = 0.f; acc1[e] = 0.f; }
        const int dA = dt * 32 + (lane & 31);
#pragma unroll
        for (int s_ = 0; s_ < 8; ++s_) {
            const bf16x8 Afr = *(const LAS bf16x8*)(vt + vt_off(dA, 2 * s_ + (lane >> 5)));
            acc0 = __builtin_amdgcn_mfma_f32_32x32x16_bf16(Afr, B0[s_], acc0, 0, 0, 0);
            acc1 = __builtin_amdgcn_mfma_f32_32x32x16_bf16(Afr, B1[s_], acc1, 0, 0, 0);
        }
#pragma unroll
        for (int it = 0; it < 2; ++it) {
            const int ii = (it0 + it) * 32 + (lane & 31); const size_t row = row0 + ii;
#pragma unroll
            for (int rq = 0; rq < 4; ++rq) {
                const int d0 = dt * 32 + 8 * rq + 4 * (lane >> 5);
                float vs[4];
#pragma unroll
                for (int e = 0; e < 4; ++e) vs[e] = (it == 0 ? acc0[rq * 4 + e] : acc1[rq * 4 + e]) + bias[it];
                u32x2 o; o.x = pk2(lo16(uu[it][rq].x) * vs[0], hi16(uu[it][rq].x) * vs[1]); o.y = pk2(lo16(uu[it][rq].y) * vs[2], hi16(uu[it][rq].y) * vs[3]);
                *(u32x2*)(Pb + row * 2048 + gi * 128 + d0) = o;
            }
        }
    }
#undef SP_ROW0
#undef SP_LOADZ
    __syncthreads();
}

__global__ void __launch_bounds__(NTHREADS, 2) fwd_kernel(Params P) {
    extern __shared__ __attribute__((aligned(16))) unsigned char lds_raw[];
    Frame F; F.lds = (LAS unsigned char*)lds_raw; F.tid = threadIdx.x; F.lane = F.tid & 63; F.wave = __builtin_amdgcn_readfirstlane(F.tid >> 6);
    F.G = gridDim.x; F.bid = blockIdx.x; F.ws = P.ws; F.kp = (const Params __attribute__((address_space(4)))*)__builtin_amdgcn_kernarg_segment_ptr();
    const int lo = P.ph_lo, hi = P.ph_hi;
    volatile LAS unsigned* misc = (volatile LAS unsigned*)(F.lds + LDS_MISC);
    if (F.tid < 4) misc[F.tid] = 0u;
    __syncthreads();
    XcdBarrier bar; bar.bar = (unsigned*)(F.ws + WS_CTL); bar.x = 0; bar.st = misc;
    if (hi - lo > 1) bar = xcd_barrier_post((unsigned*)(F.ws + WS_CTL), misc);
    int ph = 0;
#define RUN(id, ...) do { if (ph >= lo && ph < hi) { const int nrep_ = ((REP_MASK >> (id)) & 1u) ? 2 : 1; for (int rep_ = 0; rep_ < nrep_; ++rep_) { const bool dry_ = (rep_ + 1 < nrep_); (void)dry_; { int t_ = threadIdx.x; const Params __attribute__((address_space(4)))* kp_ = (const Params __attribute__((address_space(4)))*)__builtin_amdgcn_kernarg_segment_ptr(); asm volatile("" : "+v"(t_), "+s"(kp_)); F.tid = t_; F.lane = t_ & 63; F.kp = kp_; F.ws = kp_->ws; } __VA_ARGS__; if (rep_ + 1 < nrep_ || ph + 1 < hi) xcd_barrier(bar); } } ++ph; } while (0)

    RUN(0, phase_prologue(F));
    for (int g = 0; g < NG; ++g) {
        for (int layer = 0; layer < 4; ++layer) {
            const int a = layer >> 1;
            if ((layer & 1) == 0) {
                const bf16_t* Vc = layer == 0 ? F.wsp<bf16_t>(WS_VF) : F.ar<bf16_t>(AR_V);
                RUN(1, phase_norm1(F, g, layer, F.ar<bf16_t>(AR_H2), 2048, dry_));
                RUN(2, phase_mix(F, a));
                RUN(3, { { pg8::SchedPlain S; S.init(TG / 256, 2, F.G, F.bid, 0);
                        EpiL1 E{F.ar<bf16_t>(AR_L1)};
                        pg8::gemm_phase(F.tid, F.lds, F.ar<bf16_t>(AR_H2), K1CAT, F.wsp<bf16_t>(WS_WL) + (size_t)a * 512 * K1CAT, K1CAT, K1CAT, S, E); }
                      { int t_ = threadIdx.x; asm volatile("" : "+v"(t_)); F.tid = t_; F.lane = t_ & 63; }
                      { pg8::SchedRKV S; S.init(TG / 256, 12, F.G, (F.bid + 192) % F.G, 0);
                        EpiRKV E{F.ws, layer == 0 ? WS_VF : WS_ARENA + AR_V};
                        pg8::gemm_phase(F.tid, F.lds, F.ar<bf16_t>(AR_XR), D, F.wsp<bf16_t>(WS_WRKV) + (size_t)a * 3072 * D, D, D, S, E); } });
                if (layer == 2) {
                    RUN(4, { pg8::SchedPlain S; S.init(TG / 256, 4, F.G, F.bid, 0);
                          EpiStore<1> E{F.ar<bf16_t>(AR_VGATE), F.in(19)};
                          pg8::gemm_phase(F.tid, F.lds, F.ar<bf16_t>(AR_L1) + 256, 512, F.wsp<bf16_t>(WS_V2T), 256, 256, S, E); });
                    RUN(5, phase_vfix(F));
                }
                RUN(6, phase_scan4(F, a, Vc));
                RUN(7, { pg8::SchedPlain S; S.init(TG / 256, 4, F.G, F.bid, 0);
                      EpiStore<0> E{F.ar<bf16_t>(AR_G), nullptr};
                      pg8::gemm_phase(F.tid, F.lds, F.ar<bf16_t>(AR_L1) + 256, 512, F.wsp<bf16_t>(WS_G2T) + (size_t)a * D * 256, 256, 256, S, E); });
                RUN(8, phase_post(F, a, Vc));
                RUN(9, { const int skip = layer == 2; pg8::SchedPlain S; S.init(skip ? BG * 8 : TG / 256, 4, F.G, F.bid, skip);
                      EpiStore<0> E{F.ar<bf16_t>(AR_O), nullptr};
                      pg8::gemm_phase(F.tid, F.lds, F.ar<bf16_t>(AR_R), D, F.wsp<bf16_t>(WS_WO) + (size_t)a * D * D, D, D, S, E); });
            } else {
                const int skip = layer == 3;
                RUN(10, phase_norm1(F, g, layer, F.ar<bf16_t>(AR_H), D, dry_));
                RUN(11, { pg8::SchedPlain S; S.init(skip ? BG * 8 : TG / 256, 16, F.G, F.bid, skip);
                      EpiGelu E{F.ar<bf16_t>(AR_Z), F.in(30) + (size_t)a * 4096};
                      pg8::gemm_phase(F.tid, F.lds, F.ar<bf16_t>(AR_H), D, F.wsp<bf16_t>(WS_WIN) + (size_t)a * 4096 * D, D, D, S, E); });
                RUN(12, phase_sgstats(F, layer));
                RUN(13, phase_spatial(F, a, layer));
                RUN(14, { pg8::SchedPlain S; S.init(skip ? BG * 8 : TG / 256, 4, F.G, F.bid, skip);
                      EpiStore<0> E{F.ar<bf16_t>(AR_O), nullptr};
                      pg8::gemm_phase(F.tid, F.lds, F.ar<bf16_t>(AR_P), 2048, F.wsp<bf16_t>(WS_WOUT) + (size_t)a * D * 2048, 2048, 2048, S, E); });
            }
            RUN(15, phase_norm2(F, g, layer, dry_));
            RUN(16, { const int total = moe_tables(F, g, layer);
                  pg8::SchedMoe<true> S{(const LAS int*)(F.lds + LDS_MISC + 64), (const LAS int*)(F.lds + LDS_MISC + 192), F.ar<int>(AR_LIST), F.G, F.bid, total};
                  EpiMG E{F.ar<bf16_t>(AR_HE)};
                  pg8::gemm_phase(F.tid, F.lds, F.ar<bf16_t>(AR_HM), D, F.wsp<bf16_t>(WS_WGU) + (size_t)layer * NEXP * 1024 * D, D, D, S, E); });
            RUN(17, { const int total = moe_tables(F, g, layer);
                  pg8::SchedMoe<false> S{(const LAS int*)(F.lds + LDS_MISC + 64), (const LAS int*)(F.lds + LDS_MISC + 192), F.ar<int>(AR_LIST), F.G, F.bid, total};
                  EpiMD E{F.ar<bf16_t>(AR_YM0), F.ar<int>(AR_LIST), F.ar<float>(AR_LW), (const LAS int*)(F.lds + LDS_MISC + 64)};
                  pg8::gemm_phase(F.tid, F.lds, F.ar<bf16_t>(AR_HE), FEXP, F.wsp<bf16_t>(WS_WD) + (size_t)layer * NEXP * D * FEXP, FEXP, FEXP, S, E); });
        }
        RUN(18, phase_norm1(F, g, 4, nullptr, 0));
    }
#undef RUN
}
constexpr int NPHASES = 1 + NG * (10 + 8 + 12 + 8 + 1);

__global__ void nan_fill(float* out, size_t n) { for (size_t i = (size_t)blockIdx.x * blockDim.x + threadIdx.x; i < n; i += (size_t)gridDim.x * blockDim.x) out[i] = __uint_as_float(0x7FC00000u); }

extern "C" void kernel_launch(void* const* d_in, const int* in_sizes, int n_in, void* d_out, int out_size, void* d_ws, size_t ws_size, hipStream_t stream) {
    static int grid = 0;
    if (grid == 0) {
        int dev = 0, cus = 0, per_cu = 0;
        if (n_in != 42 || ws_size < WS_END || hipGetDevice(&dev) != hipSuccess || hipDeviceGetAttribute(&cus, hipDeviceAttributeMultiprocessorCount, dev) != hipSuccess) {
            fprintf(stderr, "kernel_launch: bad setup (n_in %d, ws %zu need %zu)\n", n_in, ws_size, (size_t)WS_END); grid = -1;
        } else if (hipFuncSetAttribute((const void*)fwd_kernel, hipFuncAttributeMaxDynamicSharedMemorySize, LDS_BYTES) != hipSuccess) { fprintf(stderr, "kernel_launch: hipFuncSetAttribute failed\n"); grid = -1; }
        else {
            if (hipOccupancyMaxActiveBlocksPerMultiprocessor(&per_cu, (const void*)fwd_kernel, NTHREADS, LDS_BYTES) != hipSuccess || per_cu < 1) { fprintf(stderr, "kernel_launch: occupancy query reports %d\n", per_cu); }
            (void)hipGetLastError();
            grid = cus;
        }
    }
    if (grid < 0) { hipLaunchKernelGGL(nan_fill, dim3(1024), dim3(256), 0, stream, (float*)d_out, (size_t)out_size); return; }
    (void)hipMemsetAsync((char*)d_ws + WS_CTL, 0, CTL_BYTES, stream);
    Params p{};
    for (int i = 0; i < 42; ++i) p.in[i] = (const float*)d_in[i];
    p.out = (float*)d_out; p.ws = (unsigned char*)d_ws;
#if PER_PHASE_LAUNCH
    for (int k = 0; k < NPHASES; ++k) { p.ph_lo = k; p.ph_hi = k + 1; hipLaunchKernelGGL(fwd_kernel, dim3(grid), dim3(NTHREADS), LDS_BYTES, stream, p); }
#else
    p.ph_lo = 0; p.ph_hi = NPHASES;
    hipLaunchKernelGGL(fwd_kernel, dim3(grid), dim3(NTHREADS), LDS_BYTES, stream, p);
#endif
}
```

```cpp
#include <hip/hip_runtime.h>
#include <cstdio>
#include <cstdint>

#ifndef REP_MASK
#define REP_MASK 0u
#endif
#ifndef PER_PHASE_LAUNCH
#define PER_PHASE_LAUNCH 0
#endif

#define LAS __attribute__((address_space(3)))
typedef unsigned short bf16_t;
typedef short bf16x8 __attribute__((ext_vector_type(8)));
typedef float f32x4 __attribute__((ext_vector_type(4)));
typedef float f32x2 __attribute__((ext_vector_type(2)));
typedef float f32x16 __attribute__((ext_vector_type(16)));
typedef unsigned u32x4 __attribute__((ext_vector_type(4)));
typedef unsigned u32x2 __attribute__((ext_vector_type(2)));

constexpr int NB = 32, SEQ = 2048, LC = 256, LT = SEQ + LC, D = 1024, NH = 16;
constexpr int NG = 2, BG = NB / NG, TG = BG * LT;
constexpr int NTHREADS = 512, NWAVES = 8;
constexpr int N1CAT = 3584, K1CAT = 2048;
constexpr int NEXP = 16, FEXP = 512;

constexpr size_t al256(size_t x) { return (x + 255) & ~(size_t)255; }
constexpr int XCD_BAR_WORDS_C = 3456;
constexpr size_t WS_CTL = 0;
constexpr size_t CTL_BAR_BYTES = (size_t)XCD_BAR_WORDS_C * 4;
constexpr size_t CTL_CNT_OFF = al256(CTL_BAR_BYTES);
constexpr size_t CTL_BYTES = al256(CTL_CNT_OFF + (size_t)2 * NG * 4 * 32 * 64);
constexpr size_t WS_X = al256(WS_CTL + CTL_BYTES);
constexpr size_t WS_VF = WS_X + (size_t)TG * D * 2;
constexpr size_t WS_MODL = WS_VF + (size_t)TG * D * 2;
constexpr size_t WS_MODC = WS_MODL + (size_t)4 * NB * 6 * D * 4;
constexpr size_t WS_WRKV = al256(WS_MODC + (size_t)4 * 6 * D * 4);
constexpr size_t WS_WL = WS_WRKV + (size_t)2 * 3072 * D * 2;
constexpr size_t WS_WO = WS_WL + (size_t)2 * 512 * K1CAT * 2;
constexpr size_t WS_G2T = WS_WO + (size_t)2 * D * D * 2;
constexpr size_t WS_V2T = WS_G2T + (size_t)2 * D * 256 * 2;
constexpr size_t WS_W2T = WS_V2T + (size_t)D * 256 * 2;
constexpr size_t WS_A2T = WS_W2T + (size_t)4 * D * 64 * 2;
constexpr size_t WS_WIN = WS_A2T + (size_t)4 * D * 64 * 2;
constexpr size_t WS_WOUT = WS_WIN + (size_t)2 * 4096 * D * 2;
constexpr size_t WS_WSP = WS_WOUT + (size_t)2 * D * 2048 * 2;
constexpr size_t WS_WGU = WS_WSP + (size_t)2 * 16 * 128 * 128 * 2;
constexpr size_t WS_WD = WS_WGU + (size_t)4 * NEXP * 1024 * D * 2;
constexpr size_t WS_ARENA = al256(WS_WD + (size_t)4 * NEXP * D * FEXP * 2);
constexpr size_t SZB = (size_t)TG * D * 2;
constexpr size_t AR_H2 = 0;
constexpr size_t AR_Y0 = 0, AR_Y1 = SZB;
constexpr size_t AR_XR = 2 * SZB;
constexpr size_t AR_R = 5 * SZB, AR_K = 6 * SZB, AR_V = 7 * SZB;
constexpr size_t AR_L1 = 8 * SZB;
constexpr size_t AR_DOT = AR_L1 + SZB / 2;
constexpr size_t AR_G = 2 * SZB;
constexpr size_t AR_VGATE = 0;
constexpr size_t AR_O = 3 * SZB;
constexpr size_t AR_H = 0;
constexpr size_t AR_Z = SZB;
constexpr size_t AR_P = 5 * SZB;
constexpr size_t AR_ST = 7 * SZB;
constexpr size_t AR_HM = 0;
constexpr size_t AR_HE = SZB;
constexpr size_t HE_ROWS = (size_t)2 * TG + 32 * 256;
constexpr size_t AR_LIST = al256(AR_HE + HE_ROWS * FEXP * 2);
constexpr size_t AR_LW = AR_LIST + (size_t)32 * TG * 4;
constexpr size_t AR_YM0 = 5 * SZB, AR_YM1 = 6 * SZB;
constexpr size_t ARENA_BYTES = AR_DOT + (size_t)2 * TG * 16 * 4 + 4096;
constexpr size_t WS_END = WS_ARENA + ARENA_BYTES;
static_assert(AR_LW + (size_t)32 * TG * 4 <= AR_O, "moe lists overlap");

constexpr int LDS_STAGE = 131072;
constexpr int LDS_MISC = LDS_STAGE;
constexpr int LDS_BYTES = LDS_STAGE + 1024;

struct Params {
    const float* in[42];
    float* out;
    unsigned char* ws;
    int ph_lo, ph_hi;
};

__device__ __forceinline__ float bf2f(unsigned short b) { return __uint_as_float(((unsigned)b) << 16); }
__device__ __forceinline__ unsigned short f2bf(float f) { unsigned u = __float_as_uint(f); u += 0x7FFFu + ((u >> 16) & 1u); return (unsigned short)(u >> 16); }
typedef __bf16 bf16x2_t __attribute__((ext_vector_type(2)));
__device__ __forceinline__ unsigned pk2(float lo, float hi) { const bf16x2_t v = __builtin_convertvector((f32x2){lo, hi}, bf16x2_t); return __builtin_bit_cast(unsigned, v); }
__device__ __forceinline__ float lo16(unsigned w) { return __uint_as_float(w << 16); }
__device__ __forceinline__ float hi16(unsigned w) { return __uint_as_float(w & 0xFFFF0000u); }
__device__ __forceinline__ float sigmoidf_(float x) { return __builtin_amdgcn_rcpf(1.0f + __expf(-x)); }
__device__ __forceinline__ float tanhf_(float x) { return 1.0f - 2.0f * __builtin_amdgcn_rcpf(__expf(2.0f * x) + 1.0f); }
__device__ __forceinline__ float wave_sum(float v) {
#pragma unroll
    for (int o = 32; o > 0; o >>= 1) v += __shfl_xor(v, o);
    return v;
}
template <int CTRL> __device__ __forceinline__ float dpp_f(float v) {
    return __int_as_float(__builtin_amdgcn_update_dpp(0, __float_as_int(v), CTRL, 0xF, 0xF, true));
}
__device__ __forceinline__ float red8(float v) { v += dpp_f<0xB1>(v); v += dpp_f<0x4E>(v); v += dpp_f<0x141>(v); return v; }
__device__ __forceinline__ float red16(float v) { v = red8(v); v += dpp_f<0x140>(v); return v; }
__device__ __forceinline__ float wave_sum_dpp(float v) {
    v = red16(v);
    const float a = __int_as_float(__builtin_amdgcn_readlane(__float_as_int(v), 0)), b = __int_as_float(__builtin_amdgcn_readlane(__float_as_int(v), 16));
    const float c = __int_as_float(__builtin_amdgcn_readlane(__float_as_int(v), 32)), d = __int_as_float(__builtin_amdgcn_readlane(__float_as_int(v), 48));
    return (a + b) + (c + d);
}
__device__ __forceinline__ float red4(float v) { v += dpp_f<0xB1>(v); v += dpp_f<0x4E>(v); return v; }
__device__ __forceinline__ f32x2 gelu_pk(f32x2 v) {
    const f32x2 av = __builtin_elementwise_abs(v), d = av * 0.2316418882f + 1.0f;
    f32x2 t; t.x = __builtin_amdgcn_rcpf(d.x); t.y = __builtin_amdgcn_rcpf(d.y);
    f32x2 q = t * 0.5307027145f + (-0.7265760135f); q = q * t + 0.7107068705f; q = q * t + (-0.142248368f); q = q * t + 0.127414796f; q = q * t;
    const f32x2 s = (v * v) * (-0.72134752044f);
    f32x2 e; e.x = __builtin_amdgcn_exp2f(s.x); e.y = __builtin_amdgcn_exp2f(s.y);
    const f32x2 m = v * (q * e), r = v - m;
    f32x2 o; o.x = v.x < 0.f ? m.x : r.x; o.y = v.y < 0.f ? m.y : r.y; return o;
}
__device__ __forceinline__ float gelu_f(float v) {
    const float av = fabsf(v), t = __builtin_amdgcn_rcpf(av * 0.2316418882f + 1.0f);
    float q = t * 0.5307027145f + (-0.7265760135f); q = q * t + 0.7107068705f; q = q * t + (-0.142248368f); q = q * t + 0.127414796f; q = q * t;
    const float e = __builtin_amdgcn_exp2f((v * v) * (-0.72134752044f));
    const float m = v * (q * e);
    return v < 0.f ? m : v - m;
}

#define XB_TMO      128
#define XB_XCNT(j)  (256  + 64 * (j))
#define XB_XSUB(j)  (1280 + 64 * (j))
#define XB_XGEN(j)  (2304 + 64 * (j))
#define XB_TOP      3328
#define XB_TOPGEN   3392
#define XCD_BAR_WORDS 3456
#define XB_SPIN_CAP (1u << 22)
static_assert(XCD_BAR_WORDS == XCD_BAR_WORDS_C, "barrier words");
__device__ __forceinline__ unsigned xb_ld(unsigned* p)              { return __hip_atomic_load(p, __ATOMIC_RELAXED, __HIP_MEMORY_SCOPE_AGENT); }
__device__ __forceinline__ unsigned xb_add(unsigned* p, unsigned v) { return __hip_atomic_fetch_add(p, v, __ATOMIC_RELAXED, __HIP_MEMORY_SCOPE_AGENT); }
__device__ __forceinline__ unsigned xb_xcc_id() { return (unsigned)__builtin_amdgcn_s_getreg((3 << 11) | 20) & 0xFu; }
#define XB_SPIN(cond, bar) do { unsigned _sp = 0; while (cond) { __builtin_amdgcn_s_sleep(1); \
    if ((++_sp & 255u) == 0u) { if (xb_ld(&(bar)[XB_TMO])) break; if (_sp > XB_SPIN_CAP) { atomicAdd(&(bar)[XB_TMO], 1u); break; } } } } while (0)
struct XcdBarrier { unsigned* bar; unsigned x; volatile LAS unsigned* st; };
__device__ __forceinline__ XcdBarrier xcd_barrier_post(unsigned* bar, volatile LAS unsigned* st) {
    XcdBarrier b; b.bar = bar; b.x = xb_xcc_id(); b.st = st;
    if (threadIdx.x == 0) (void)xb_add(&bar[XB_XCNT(b.x)], 1u);
    return b;
}
__device__ __forceinline__ void xcd_barrier_complete(unsigned* bar, unsigned x, unsigned& nloc, unsigned& nx) {
    const unsigned G = gridDim.x * gridDim.y * gridDim.z;
    unsigned sum, cnt, mine, sp = 0u;
    for (;;) {
        sum = 0u; cnt = 0u; mine = 0u;
#pragma unroll
        for (unsigned j = 0; j < 16; ++j) { const unsigned c = xb_ld(&bar[XB_XCNT(j)]); sum += c; cnt += (c > 0u) ? 1u : 0u; mine = (j == x) ? c : mine; }
        if (sum == G) break;
        __builtin_amdgcn_s_sleep(1);
        if ((++sp & 255u) == 0u) { if (xb_ld(&bar[XB_TMO])) break; if (sp > XB_SPIN_CAP) { atomicAdd(&bar[XB_TMO], 1u); break; } }
    }
    nloc = mine > 0u ? mine : 1u; nx = cnt > 0u ? cnt : 1u;
}
__device__ __forceinline__ void xcd_barrier(const XcdBarrier& b) {
    asm volatile("s_waitcnt vmcnt(0)" ::: "memory");
    __syncthreads();
    if (threadIdx.x == 0) {
        unsigned* bar = b.bar;
        __builtin_amdgcn_s_waitcnt(0);
        unsigned nloc = b.st[0], nx = b.st[1];
        if (nloc == 0u) { xcd_barrier_complete(bar, b.x, nloc, nx); b.st[0] = nloc; b.st[1] = nx; }
        const unsigned old = xb_add(&bar[XB_XSUB(b.x)], 1u);
        const unsigned gen = old / nloc;
        if (old + 1u == (gen + 1u) * nloc) {
            __builtin_amdgcn_fence(__ATOMIC_RELEASE, "agent");
            asm volatile("s_waitcnt vmcnt(0)" ::: "memory");
            const unsigned og = xb_add(&bar[XB_TOP], 1u);
            const unsigned tg = og / nx;
            if (og + 1u == (tg + 1u) * nx) xb_add(&bar[XB_TOPGEN], 1u);
            else XB_SPIN(xb_ld(&bar[XB_TOPGEN]) == tg, bar);
            __builtin_amdgcn_fence(__ATOMIC_ACQUIRE, "agent");
            xb_add(&bar[XB_XGEN(b.x)], 1u);
            asm volatile("s_waitcnt vmcnt(0)" ::: "memory");
        } else {
            XB_SPIN(xb_ld(&bar[XB_XGEN(b.x)]) == gen, bar);
            __builtin_amdgcn_fence(__ATOMIC_ACQUIRE, "agent");
            asm volatile("s_waitcnt vmcnt(0)" ::: "memory");
        }
    }
    __syncthreads();
}

#define LDS_BAR() asm volatile("s_waitcnt lgkmcnt(0)\n\ts_barrier" ::: "memory")
namespace pg8 {
constexpr int BM = 256, BK = 64, HALF = 128, HTB = HALF * BK * 2, STAGE_BYTES = 8 * HTB, NXCD = 8, WGM = 8;
__host__ __device__ __forceinline__ int lds_byte(int r, int c) { const int st = (r >> 4) * 2 + (c >> 5), rr = r & 15, cc = c & 31, ob = rr * 64 + cc * 2; return st * 1024 + (ob ^ (((ob >> 9) & 1) << 5)); }
__host__ __device__ __forceinline__ void stage_rc(int b, int& R, int& C) { const int st = b / 1024, sb = b % 1024, swz = sb ^ (((sb >> 9) & 1) << 5); R = (st >> 1) * 16 + swz / 64; C = (st & 1) * 32 + (swz % 64) / 2; }
__host__ __device__ __forceinline__ int perm32(int rho) { const int n = rho >> 4, i = rho & 15; return 8 * (i >> 2) + 4 * n + (i & 3); }
struct Unit { int pm, pn, aux; };

struct SchedPlain {
    static constexpr bool GATHER = false;
    int nM, nN, nwg, G, c, skipctx;
    __device__ void init(int nM_, int nN_, int G_, int c_, int skipctx_) { nM = nM_; nN = nN_; nwg = nM * nN; G = G_; c = c_; skipctx = skipctx_; }
    __device__ bool next(int i, Unit& u) const {
        const long L = (long)i * G + c; if (L >= nwg) return false;
        int wgid = (int)L; { const int q = nwg / NXCD, r = nwg % NXCD, xcd = wgid % NXCD, off = wgid / NXCD; wgid = (xcd < r ? xcd * (q + 1) : r * (q + 1) + (xcd - r) * q) + off; }
        const int nig = WGM * nN, gid = wgid / nig, fm = gid * WGM, gsz = (nM - fm) < WGM ? (nM - fm) : WGM;
        int pm = fm + ((wgid % nig) % gsz); u.pn = (wgid % nig) / gsz; u.aux = 0;
        if (skipctx) pm = (pm >> 3) * 9 + 1 + (pm & 7);
        u.pm = pm; return true;
    }
    __device__ __forceinline__ int arow(const Unit& u, int r) const { return u.pm * BM + r; }
};
struct SchedRKV : SchedPlain {
    __device__ bool next(int i, Unit& u) const { if (!SchedPlain::next(i, u)) return false; u.pm += (u.pn >> 2) * nM; return true; }
};
template <bool GATH> struct SchedMoe {
    static constexpr bool GATHER = GATH;
    const LAS int* cn; const LAS int* tb; const int* lists; int G, c, total;
    __device__ bool next(int i, Unit& u) const {
        const int U = i * G + c; if (U >= total * 4) return false;
        const int T = U >> 2, pn = U & 3; int l = 0;
        while (tb[l + 1] <= T) ++l;
        u.pm = T; u.pn = (l >> 1) * 4 + pn; u.aux = l | ((T - tb[l]) << 8); return true;
    }
    __device__ __forceinline__ int arow(const Unit& u, int r) const {
        if (!GATH) return u.pm * BM + r;
        const int l = u.aux & 255, idx = (u.aux >> 8) * BM + r;
        return idx < cn[l] ? lists[(size_t)l * TG + idx] : 0;
    }
};

template <class Epi, class Sched>
__device__ __forceinline__ void gemm_phase(const int tid, LAS unsigned char* lds, const bf16_t* A, int lda, const bf16_t* Bt, int ldb, int K, const Sched& S, const Epi& E) {
    constexpr bool GA = Sched::GATHER;
    const int wid = __builtin_amdgcn_readfirstlane(tid >> 6), lane = tid & 63, wr = wid >> 2, wc = wid & 3, fr = lane & 15, fq = lane >> 4;
    const int nt = K / BK;
    unsigned voffA[2], voffB[2];
#pragma unroll
    for (int i = 0; i < 2; ++i) { int R, C; stage_rc(tid * 16 + i * 8192, R, C); const int Rb = (R & ~31) + perm32(R & 31);
        voffA[i] = (unsigned)(R * lda + C) * 2u; voffB[i] = (unsigned)(Rb * ldb + C) * 2u; }
    const size_t kstep = (size_t)(BK * 2);
    const size_t hstepA = (size_t)HALF * lda * 2, tstepA = 2 * hstepA;
    const size_t hstepB = (size_t)HALF * ldb * 2, tstepB = 2 * hstepB;
    const unsigned ldsw = (unsigned)wid * 1024u;
    const int aoff = lds_byte(wr * 64 + fr, fq * 8), boff = lds_byte(wc * 32 + fr, fq * 8);
#define PG8_SA(b, h) (((b) * 2 + (h)) * HTB)
#define PG8_SB(b, h) ((4 + (b) * 2 + (h)) * HTB)
#define PG8_STAGE(bufoff, gbase, voff) do { _Pragma("unroll") for (int _i = 0; _i < 2; ++_i) \
        __builtin_amdgcn_global_load_lds((const unsigned*)((const char*)(gbase) + (voff)[_i]), (LAS unsigned*)(lds + (bufoff) + ldsw + _i * 8192), 16, 0, 0); } while (0)
#define PG8_STAGE_A(bufoff, ub, gv, h, koff) do { if constexpr (GA) { PG8_STAGE(bufoff, (const char*)A + (koff), gv[h]); } else { PG8_STAGE(bufoff, (ub) + (h) * hstepA + (koff), voffA); } } while (0)
#define PG8_LDA(dst, b, h) do { _Pragma("unroll") for (int m = 0; m < 4; ++m) _Pragma("unroll") for (int k = 0; k < 2; ++k) dst[m][k] = *(const LAS bf16x8*)(lds + PG8_SA(b, h) + aoff + m * 2048 + k * 1024); } while (0)
#define PG8_LDB(dst, b, h) do { _Pragma("unroll") for (int n = 0; n < 2; ++n) _Pragma("unroll") for (int k = 0; k < 2; ++k) dst[n][k] = *(const LAS bf16x8*)(lds + PG8_SB(b, h) + boff + n * 2048 + k * 1024); } while (0)
#define PG8_MMA(ai, bj, At, Bt_) do { __builtin_amdgcn_s_setprio(1); _Pragma("unroll") for (int m = 0; m < 4; ++m) _Pragma("unroll") for (int n = 0; n < 2; ++n) _Pragma("unroll") for (int k = 0; k < 2; ++k) \
        acc[ai][bj][m][n] = __builtin_amdgcn_mfma_f32_16x16x32_bf16(Bt_[n][k], At[m][k], acc[ai][bj][m][n], 0, 0, 0); __builtin_amdgcn_s_setprio(0); } while (0)
#define PG8_WAIT_V(n) asm volatile("s_waitcnt vmcnt(" #n ")" ::: "memory")
#define PG8_WAIT_L(n) asm volatile("s_waitcnt lgkmcnt(" #n ")" ::: "memory")
#define PG8_BAR __builtin_amdgcn_s_barrier()
#define PG8_SCHED __builtin_amdgcn_sched_barrier(0)
#define PG8_GOFF(dst, u) do { if constexpr (GA) { _Pragma("unroll") for (int _h = 0; _h < 2; ++_h) _Pragma("unroll") for (int _i = 0; _i < 2; ++_i) { int R_, C_; stage_rc(tid * 16 + _i * 8192, R_, C_); \
        dst[_h][_i] = ((unsigned)S.arow(u, _h * HALF + R_) * (unsigned)lda + (unsigned)C_) * 2u; } } } while (0)
    Unit cur, nxt; int ui = 0;
    if (!S.next(0, cur)) return;
    f32x4 acc[2][2][4][2];
#pragma unroll
    for (int a = 0; a < 2; ++a)
#pragma unroll
        for (int b = 0; b < 2; ++b)
#pragma unroll
            for (int m = 0; m < 4; ++m)
#pragma unroll
                for (int n = 0; n < 2; ++n) acc[a][b][m][n] = (f32x4){0.f, 0.f, 0.f, 0.f};
    bf16x8 At[4][2], B0[2][2], B1[2][2];
    unsigned gAc[2][2], gAn[2][2];
    PG8_GOFF(gAc, cur);
    const char* cA = (const char*)A + (GA ? (size_t)0 : (size_t)cur.pm * tstepA);
    const char* cB = (const char*)Bt + (size_t)cur.pn * tstepB;
    PG8_STAGE(PG8_SB(0, 0), cB, voffB); PG8_STAGE_A(PG8_SA(0, 0), cA, gAc, 0, 0); PG8_STAGE(PG8_SB(0, 1), cB + hstepB, voffB); PG8_STAGE_A(PG8_SA(0, 1), cA, gAc, 1, 0);
    if (wr == 1) PG8_BAR;
    PG8_WAIT_V(4); PG8_BAR;
    PG8_STAGE(PG8_SB(1, 0), cB + kstep, voffB); PG8_STAGE_A(PG8_SA(1, 0), cA, gAc, 0, kstep); PG8_STAGE(PG8_SB(1, 1), cB + hstepB + kstep, voffB);
    PG8_WAIT_V(6); PG8_BAR;
    for (;;) {
        const bool has_next = S.next(ui + 1, nxt);
        if (has_next) { PG8_GOFF(gAn, nxt); }
        else if constexpr (GA) {
#pragma unroll
            for (int _h = 0; _h < 2; ++_h)
#pragma unroll
                for (int _i = 0; _i < 2; ++_i) gAn[_h][_i] = gAc[_h][_i];
        }
        const char* nA = (has_next && !GA) ? (const char*)A + (size_t)nxt.pm * tstepA : cA;
        const char* nB = has_next ? (const char*)Bt + (size_t)nxt.pn * tstepB : cB;
#pragma unroll 1
        for (int t = 0; t < nt; t += 2) {
            const bool last = (t == nt - 2);
            const size_t k1 = (size_t)(t + 1) * kstep;
            const size_t k2 = last ? (size_t)0 : (size_t)(t + 2) * kstep, k3 = k2 + kstep;
            const char* a2 = last ? nA : cA; const char* b2 = last ? nB : cB;
            unsigned g2[2][2];
            if constexpr (GA) {
#pragma unroll
                for (int _h = 0; _h < 2; ++_h)
#pragma unroll
                    for (int _i = 0; _i < 2; ++_i) g2[_h][_i] = last ? gAn[_h][_i] : gAc[_h][_i];
            }
            PG8_LDB(B0, 0, 0); PG8_SCHED; PG8_LDA(At, 0, 0); PG8_STAGE_A(PG8_SA(1, 1), cA, gAc, 1, k1);
            PG8_WAIT_L(8); PG8_BAR; PG8_WAIT_L(0); PG8_MMA(0, 0, At, B0); PG8_BAR; PG8_SCHED;
            PG8_LDB(B1, 0, 1); PG8_STAGE(PG8_SB(0, 0), b2 + k2, voffB);
            PG8_BAR; PG8_WAIT_L(0); PG8_MMA(0, 1, At, B1); PG8_BAR;
            PG8_LDA(At, 0, 1); PG8_STAGE_A(PG8_SA(0, 0), a2, g2, 0, k2);
            PG8_BAR; PG8_WAIT_L(0); PG8_MMA(1, 0, At, B0); PG8_BAR; PG8_SCHED;
            PG8_STAGE(PG8_SB(0, 1), b2 + hstepB + k2, voffB);
            PG8_WAIT_V(6); PG8_BAR; PG8_MMA(1, 1, At, B1); PG8_BAR;
            PG8_LDB(B0, 1, 0); PG8_SCHED; PG8_LDA(At, 1, 0); PG8_STAGE_A(PG8_SA(0, 1), a2, g2, 1, k2);
            PG8_WAIT_L(8); PG8_BAR; PG8_WAIT_L(0); PG8_MMA(0, 0, At, B0); PG8_BAR; PG8_SCHED;
            PG8_LDB(B1, 1, 1); PG8_STAGE(PG8_SB(1, 0), b2 + k3, voffB);
            PG8_BAR; PG8_WAIT_L(0); PG8_MMA(0, 1, At, B1); PG8_BAR;
            PG8_LDA(At, 1, 1); PG8_STAGE_A(PG8_SA(1, 0), a2, g2, 0, k3);
            PG8_BAR; PG8_WAIT_L(0); PG8_MMA(1, 0, At, B0); PG8_BAR; PG8_SCHED;
            PG8_STAGE(PG8_SB(1, 1), b2 + hstepB + k3, voffB);
            PG8_WAIT_V(6); PG8_BAR; PG8_MMA(1, 1, At, B1); PG8_BAR;
        }
        { int fr_e = fr, fq_e = fq; asm volatile("" : "+v"(fr_e), "+v"(fq_e)); E(acc, cur, wr, wc, fr_e, fq_e); }
        if (!has_next) break;
#pragma unroll
        for (int a = 0; a < 2; ++a)
#pragma unroll
            for (int b = 0; b < 2; ++b)
#pragma unroll
                for (int m = 0; m < 4; ++m)
#pragma unroll
                    for (int n = 0; n < 2; ++n) acc[a][b][m][n] = (f32x4){0.f, 0.f, 0.f, 0.f};
        cur = nxt; cA = nA; cB = nB; ++ui;
        if constexpr (GA) {
#pragma unroll
            for (int _h = 0; _h < 2; ++_h)
#pragma unroll
                for (int _i = 0; _i < 2; ++_i) gAc[_h][_i] = gAn[_h][_i];
        }
    }
    PG8_WAIT_V(0);
    if (wr == 0) PG8_BAR;
    PG8_BAR;
#undef PG8_SA
#undef PG8_SB
#undef PG8_STAGE
#undef PG8_STAGE_A
#undef PG8_LDA
#undef PG8_LDB
#undef PG8_MMA
#undef PG8_WAIT_V
#undef PG8_WAIT_L
#undef PG8_BAR
#undef PG8_SCHED
#undef PG8_GOFF
}
}
using pg8::Unit;

#define EPI_LOOP_BEGIN \
    _Pragma("unroll") for (int ai = 0; ai < 2; ++ai) _Pragma("unroll") for (int m = 0; m < 4; ++m) { const int trow = ai * 128 + wr * 64 + m * 16 + fr; \
    _Pragma("unroll") for (int bj = 0; bj < 2; ++bj) { const int tcol = bj * 128 + wc * 32 + 8 * fq; const f32x4 v0 = acc[ai][bj][m][0], v1 = acc[ai][bj][m][1];
#define EPI_LOOP_END } asm volatile("" ::: "memory"); }
__device__ __forceinline__ u32x4 pk8(const f32x4 a, const f32x4 b) { return (u32x4){pk2(a[0], a[1]), pk2(a[2], a[3]), pk2(b[0], b[1]), pk2(b[2], b[3])}; }

struct EpiRKV {
    unsigned char* ws; size_t voff;
    __device__ __forceinline__ void operator()(const f32x4 (&acc)[2][2][4][2], const Unit& u, int wr, int wc, int fr, int fq) const {
        const int which = u.pn >> 2; const size_t row0 = (size_t)(u.pm - which * (TG / 256)) * 256;
        const size_t off = which == 0 ? (WS_ARENA + AR_R) : (which == 1 ? (WS_ARENA + AR_K) : voff);
        bf16_t* dst = (bf16_t*)(ws + off); const int cb = (u.pn & 3) * 256;
        EPI_LOOP_BEGIN
            *(u32x4*)(dst + (row0 + trow) * D + cb + tcol) = pk8(v0, v1);
        EPI_LOOP_END
    }
};
struct EpiL1 {
    bf16_t* L1;
    __device__ __forceinline__ void operator()(const f32x4 (&acc)[2][2][4][2], const Unit& u, int wr, int wc, int fr, int fq) const {
        const int pn = u.pn; const size_t row0 = (size_t)u.pm * 256; const int cb = pn * 256;
        EPI_LOOP_BEGIN
            f32x4 o0 = v0, o1 = v1;
            if (pn == 0 && bj == 0) { _Pragma("unroll") for (int e = 0; e < 4; ++e) { o0[e] = tanhf_(v0[e]); o1[e] = tanhf_(v1[e]); } }
            if (pn == 1 && bj == 0) { _Pragma("unroll") for (int e = 0; e < 4; ++e) { o0[e] = sigmoidf_(v0[e]); o1[e] = sigmoidf_(v1[e]); } }
            *(u32x4*)(L1 + (row0 + trow) * 512 + cb + tcol) = pk8(o0, o1);
        EPI_LOOP_END
    }
};
template <int ACT> struct EpiStore {
    bf16_t* O; const float* bias;
    __device__ __forceinline__ void operator()(const f32x4 (&acc)[2][2][4][2], const Unit& u, int wr, int wc, int fr, int fq) const {
        const size_t row0 = (size_t)u.pm * 256; const int cb = u.pn * 256;
        f32x4 bv[2][2];
#pragma unroll
        for (int bj = 0; bj < 2; ++bj)
#pragma unroll
            for (int n = 0; n < 2; ++n) bv[bj][n] = ACT == 1 ? *(const f32x4*)(bias + cb + bj * 128 + wc * 32 + 8 * fq + 4 * n) : (f32x4){0.f, 0.f, 0.f, 0.f};
        EPI_LOOP_BEGIN
            f32x4 o0 = v0, o1 = v1;
            if (ACT == 1) { _Pragma("unroll") for (int e = 0; e < 4; ++e) { o0[e] = sigmoidf_(v0[e] + bv[bj][0][e]); o1[e] = sigmoidf_(v1[e] + bv[bj][1][e]); } }
            *(u32x4*)(O + (row0 + trow) * D + cb + tcol) = pk8(o0, o1);
        EPI_LOOP_END
    }
};
struct EpiGelu {
    bf16_t* Z; const float* bias;
    __device__ __forceinline__ void operator()(const f32x4 (&acc)[2][2][4][2], const Unit& u, int wr, int wc, int fr, int fq) const {
        const size_t row0 = (size_t)u.pm * 256; const int cb = u.pn * 256;
        f32x4 bv[2][2];
#pragma unroll
        for (int bj = 0; bj < 2; ++bj)
#pragma unroll
            for (int n = 0; n < 2; ++n) bv[bj][n] = *(const f32x4*)(bias + cb + bj * 128 + wc * 32 + 8 * fq + 4 * n);
        EPI_LOOP_BEGIN
            const f32x4 b0 = bv[bj][0], b1 = bv[bj][1];
            const f32x2 g0 = gelu_pk((f32x2){v0[0] + b0[0], v0[1] + b0[1]}), g1 = gelu_pk((f32x2){v0[2] + b0[2], v0[3] + b0[3]});
            const f32x2 g2 = gelu_pk((f32x2){v1[0] + b1[0], v1[1] + b1[1]}), g3 = gelu_pk((f32x2){v1[2] + b1[2], v1[3] + b1[3]});
            *(u32x4*)(Z + (row0 + trow) * 4096 + cb + tcol) = (u32x4){pk2(g0.x, g0.y), pk2(g1.x, g1.y), pk2(g2.x, g2.y), pk2(g3.x, g3.y)};
        EPI_LOOP_END
    }
};
struct EpiMG {
    bf16_t* HE;
    __device__ __forceinline__ void operator()(const f32x4 (&acc)[2][2][4][2], const Unit& u, int wr, int wc, int fr, int fq) const {
        const size_t row0 = (size_t)u.pm * 256; const int pnl = u.pn & 3;
#pragma unroll
        for (int ai = 0; ai < 2; ++ai)
#pragma unroll
            for (int m = 0; m < 4; ++m) { const int trow = ai * 128 + wr * 64 + m * 16 + fr;
#pragma unroll
                for (int bj = 0; bj < 2; ++bj) {
                    const f32x4 gt = acc[ai][bj][m][0], up = acc[ai][bj][m][1];
                    const int f = (8 * pnl + 4 * bj + wc) * 16 + 4 * fq;
                    float o[4];
#pragma unroll
                    for (int e = 0; e < 4; ++e) o[e] = gt[e] * sigmoidf_(gt[e]) * up[e];
                    u32x2 w; w.x = pk2(o[0], o[1]); w.y = pk2(o[2], o[3]);
                    *(u32x2*)(HE + (row0 + trow) * FEXP + f) = w;
                } }
    }
};
struct EpiMD {
    bf16_t* Y0; const int* lists; const float* lw; const LAS int* cn;
    __device__ __forceinline__ void operator()(const f32x4 (&acc)[2][2][4][2], const Unit& u, int wr, int wc, int fr, int fq) const {
        const int l = u.aux & 255, t0 = (u.aux >> 8) * 256, cnt = cn[l]; const int cb = (u.pn & 3) * 256;
        bf16_t* Y = Y0 + (size_t)(l & 1) * ((AR_YM1 - AR_YM0) / 2);
        int tok[2][4]; float wgt[2][4];
#pragma unroll
        for (int ai = 0; ai < 2; ++ai)
#pragma unroll
            for (int m = 0; m < 4; ++m) { const int idx = t0 + ai * 128 + wr * 64 + m * 16 + fr; const bool ok = idx < cnt;
                tok[ai][m] = ok ? lists[(size_t)l * TG + idx] : -1; wgt[ai][m] = ok ? lw[(size_t)l * TG + idx] : 0.f; }
#pragma unroll
        for (int ai = 0; ai < 2; ++ai)
#pragma unroll
            for (int m = 0; m < 4; ++m) {
                if (tok[ai][m] >= 0) {
                    const float wg = wgt[ai][m]; bf16_t* yr = Y + (size_t)tok[ai][m] * D + cb;
#pragma unroll
                    for (int bj = 0; bj < 2; ++bj) { const int tcol = bj * 128 + wc * 32 + 8 * fq;
                        *(u32x4*)(yr + tcol) = pk8(acc[ai][bj][m][0] * wg, acc[ai][bj][m][1] * wg); }
                } }
    }
};

struct Frame {
    const Params __attribute__((address_space(4)))* kp; LAS unsigned char* lds; int tid, lane, wave, G, bid;
    unsigned char* ws;
    __device__ __forceinline__ const float* in(int k) const { return kp->in[k]; }
    __device__ __forceinline__ float* outp() const { return kp->out; }
    template <class T> __device__ __forceinline__ T* wsp(size_t off) const { return (T*)(ws + off); }
    template <class T> __device__ __forceinline__ T* ar(size_t off) const { return (T*)(ws + WS_ARENA + off); }
    __device__ __forceinline__ const float* modL(int layer, int b, int j) const { return (const float*)(ws + WS_MODL) + (((size_t)layer * NB + b) * 6 + j) * D; }
    __device__ __forceinline__ const float* modC(int layer, int j) const { return (const float*)(ws + WS_MODC) + ((size_t)layer * 6 + j) * D; }
};

struct TJob { const float* src; bf16_t* dst; const float* ksc; int lds, K, N, ldd, kofs, nofs, inter; };
constexpr int NJOBS = 2 * 21 + 1 + 4 + 4 * NEXP * 3;
__device__ __forceinline__ TJob get_job(const Frame& F, int j) {
    TJob J; J.ksc = nullptr; J.kofs = 0; J.nofs = 0; J.inter = 0; J.K = 0; J.N = 0; J.lds = 0; J.ldd = 0; J.src = nullptr; J.dst = nullptr;
    if (j < 42) {
        const int a = j / 21, q = j % 21;
        if (q < 3) { J.src = F.in(9 + q) + (size_t)a * D * D; J.lds = D; J.K = D; J.N = D; J.dst = F.wsp<bf16_t>(WS_WRKV) + (size_t)a * 3072 * D; J.ldd = D; J.nofs = q * 1024; }
        else if (q < 15) {
            const int half = (q - 3) / 6, w = (q - 3) % 6; const float* mu = F.in(8) + (size_t)a * 6 * D;
            J.dst = F.wsp<bf16_t>(WS_WL) + (size_t)a * 512 * K1CAT; J.ldd = K1CAT; J.kofs = half * 1024; J.K = D; int mi = 0;
            if (w < 2) { J.src = F.in(14) + ((size_t)a * 2 + w) * D * 64; J.lds = 64; J.N = 64; J.nofs = w * 64; mi = 1; }
            else if (w < 4) { const int d = w - 2; J.src = F.in(17) + ((size_t)a * 2 + d) * D * 64; J.lds = 64; J.N = 64; J.nofs = 128 + d * 64; mi = 4; }
            else if (w == 4) { J.src = F.in(22) + (size_t)a * D * 128; J.lds = 128; J.N = 128; J.nofs = 256; mi = 5; }
            else { J.src = F.in(20); J.lds = 32; J.N = (a == 1) ? 32 : 0; J.nofs = 384; mi = 3; }
            if (half) J.ksc = mu + mi * D;
        } else if (q == 15) { J.src = F.in(12) + (size_t)a * D * D; J.lds = D; J.K = D; J.N = D; J.dst = F.wsp<bf16_t>(WS_WO) + (size_t)a * D * D; J.ldd = D; }
        else if (q == 16) { J.src = F.in(23) + (size_t)a * 128 * D; J.lds = D; J.K = 128; J.N = D; J.dst = F.wsp<bf16_t>(WS_G2T) + (size_t)a * D * 256; J.ldd = 256; }
        else if (q < 19) { const int d = q - 17; J.src = F.in(15) + ((size_t)a * 2 + d) * 64 * D; J.lds = D; J.K = 64; J.N = D; J.dst = F.wsp<bf16_t>(WS_W2T) + ((size_t)a * 2 + d) * D * 64; J.ldd = 64; }
        else { const int d = q - 19; J.src = F.in(18) + ((size_t)a * 2 + d) * 64 * D; J.lds = D; J.K = 64; J.N = D; J.dst = F.wsp<bf16_t>(WS_A2T) + ((size_t)a * 2 + d) * D * 64; J.ldd = 64; }
    } else if (j == 42) { J.src = F.in(21); J.lds = D; J.K = 32; J.N = D; J.dst = F.wsp<bf16_t>(WS_V2T); J.ldd = 256; J.kofs = 128; }
    else if (j < 47) {
        const int q = j - 43, b = q >> 1;
        if ((q & 1) == 0) { J.src = F.in(29) + (size_t)b * D * 4096; J.lds = 4096; J.K = D; J.N = 4096; J.dst = F.wsp<bf16_t>(WS_WIN) + (size_t)b * 4096 * D; J.ldd = D; }
        else { J.src = F.in(35) + (size_t)b * 2048 * D; J.lds = D; J.K = 2048; J.N = D; J.dst = F.wsp<bf16_t>(WS_WOUT) + (size_t)b * D * 2048; J.ldd = 2048; }
    } else {
        const int q = j - 47, ie = q / 3, w = q % 3;
        if (w < 2) { J.src = F.in(38 + w) + (size_t)ie * D * FEXP; J.lds = FEXP; J.K = D; J.N = FEXP; J.dst = F.wsp<bf16_t>(WS_WGU) + (size_t)ie * 1024 * D; J.ldd = D; J.nofs = w * 4; J.inter = 1; }
        else { J.src = F.in(40) + (size_t)ie * FEXP * D; J.lds = D; J.K = FEXP; J.N = D; J.dst = F.wsp<bf16_t>(WS_WD) + (size_t)ie * D * FEXP; J.ldd = FEXP; }
    }
    return J;
}
__device__ __forceinline__ void transpose_all(const Frame& F) {
    LAS unsigned* T = (LAS unsigned*)F.lds;
    LAS int* tab = (LAS int*)(F.lds + 32768);
    __syncthreads();
#pragma unroll 1
    for (int jj = F.wave; jj < NJOBS; jj += NWAVES) { const TJob J = get_job(F, jj); LAS int* e = tab + jj * 16;
        e[0] = (int)(unsigned)(size_t)J.src; e[1] = (int)(unsigned)((size_t)J.src >> 32); e[2] = (int)(unsigned)(size_t)J.dst; e[3] = (int)(unsigned)((size_t)J.dst >> 32);
        e[4] = (int)(unsigned)(size_t)J.ksc; e[5] = (int)(unsigned)((size_t)J.ksc >> 32); e[6] = J.lds; e[7] = J.K; e[8] = J.N; e[9] = J.ldd; e[10] = J.kofs; e[11] = J.nofs; e[12] = J.inter;
        const int tn_ = (J.N + 127) / 128; e[13] = ((J.K + 127) / 128) * tn_; e[15] = tn_; }
    __syncthreads();
    for (int jj = F.tid; jj < NJOBS; jj += NTHREADS) { int acc = 0; for (int i = 0; i < jj; ++i) acc += tab[i * 16 + 13]; tab[jj * 16 + 14] = acc; }
    __syncthreads();
#define TJI(j_, f_) __builtin_amdgcn_readfirstlane(tab[(j_) * 16 + (f_)])
#define TJP(T_, j_, f_) ((T_)(size_t)(((unsigned long long)(unsigned)TJI(j_, (f_) + 1) << 32) | (unsigned long long)(unsigned)TJI(j_, f_)))
    int j = 0, t = 0;
#define TR_ENTER() do { t = (F.bid - (TJI(j, 14) % F.G) + F.G) % F.G; } while (0)
#define TR_SKIP() do { while (j < NJOBS && t >= TJI(j, 13)) { ++j; if (j < NJOBS) TR_ENTER(); } } while (0)
#define TR_LOAD() do { const int jl_ = j < NJOBS ? j : NJOBS - 1, tl_ = j < NJOBS ? t : 0; \
        const int tn_ = TJI(jl_, 15), K_ = TJI(jl_, 7), N_ = TJI(jl_, 8), ls_ = TJI(jl_, 6); const float* src_ = TJP(const float*, jl_, 0); \
        const int k0_ = (tl_ / tn_) * 128, n0_ = (tl_ % tn_) * 128; _Pragma("unroll") for (int e = 0; e < 4; ++e) { const int idx = F.tid + e * 512, n4 = idx & 31, kp = idx >> 5; \
        const bool ok_ = (k0_ + 2 * kp < K_) && (n0_ + 4 * n4 < N_); const float* q_ = src_ + (ok_ ? ((size_t)(k0_ + 2 * kp) * ls_ + n0_ + 4 * n4) : (size_t)0); \
        const f32x4 x0_ = *(const f32x4*)q_, x1_ = *(const f32x4*)(q_ + (ok_ ? ls_ : 0)); const f32x4 z_ = (f32x4){0.f, 0.f, 0.f, 0.f}; va[e] = ok_ ? x0_ : z_; vb[e] = ok_ ? x1_ : z_; } } while (0)
    TR_ENTER(); TR_SKIP();
    f32x4 va[4], vb[4];
    TR_LOAD();
#pragma unroll 1
    while (j < NJOBS) {
        const int jc = j, tnc = TJI(jc, 15), Kc = TJI(jc, 7), Nc = TJI(jc, 8), k0 = (t / tnc) * 128, n0 = (t % tnc) * 128;
        const float* ksc = TJP(const float*, jc, 4);
        LDS_BAR();
#pragma unroll
        for (int e = 0; e < 4; ++e) { const int idx = F.tid + e * 512, n4 = idx & 31, kp = idx >> 5;
            float s0 = 1.f, s1 = 1.f; if (ksc && k0 + 2 * kp < Kc) { s0 = ksc[k0 + 2 * kp]; s1 = ksc[k0 + 2 * kp + 1]; }
            LAS unsigned* q = T + (4 * n4) * 64 + (((kp >> 2) ^ (n4 & 15)) << 2) + (kp & 3);
            q[0] = pk2(va[e][0] * s0, vb[e][0] * s1); q[64] = pk2(va[e][1] * s0, vb[e][1] * s1); q[128] = pk2(va[e][2] * s0, vb[e][2] * s1); q[192] = pk2(va[e][3] * s0, vb[e][3] * s1); }
        t += F.G; TR_SKIP();
        TR_LOAD();
        LDS_BAR();
        bf16_t* dst = TJP(bf16_t*, jc, 2); const int ldd = TJI(jc, 9), kofs = TJI(jc, 10), nofs = TJI(jc, 11), inter = TJI(jc, 12);
#pragma unroll
        for (int e = 0; e < 4; ++e) { const int idx = F.tid + e * 512, kg = idx & 15, nn = idx >> 4;
            if (k0 + 8 * kg < Kc && n0 + nn < Nc) { const int n = n0 + nn; const int row = nofs + (inter ? ((n >> 4) * 32 + ((n & 15) >> 2) * 8 + (n & 3)) : n);
                *(u32x4*)(dst + (size_t)row * ldd + kofs + k0 + 8 * kg) = *(const LAS u32x4*)(T + nn * 64 + ((kg ^ ((nn >> 2) & 15)) << 2)); } }
    }
#undef TR_ENTER
#undef TR_SKIP
#undef TR_LOAD
#undef TJI
#undef TJP
    __syncthreads();
}
__device__ __forceinline__ void zero_rows(const Frame& F, bf16_t* dst, int ldd, int row0, int nrows, int col0, int ncols) {
    const int per = ncols / 8; const long tot = (long)nrows * per;
    for (long i = (long)F.bid * NTHREADS + F.tid; i < tot; i += (long)F.G * NTHREADS) { const int r = (int)(i / per), c = (int)(i % per) * 8;
        *(u32x4*)(dst + (size_t)(row0 + r) * ldd + col0 + c) = (u32x4){0u, 0u, 0u, 0u}; }
}
__device__ __forceinline__ void phase_prologue(const Frame& F) {
    {
        LAS float* sl = (LAS float*)F.lds;
        LAS float* red = (LAS float*)(F.lds + 33 * 256 * 4);
        LAS float* cred = red + 8 * 32 * 64;
        const float* c = F.in(1); const float* cc = F.in(3); const float* wm = F.in(4); const float* bm = F.in(5);
        const int wv = F.wave, li = F.lane & 15, kq = F.lane >> 4;
        for (int unit = F.bid; unit < 4 * 96; unit += F.G) {
            const int layer = unit / 96, col0 = (unit % 96) * 64;
            f32x4 acc[2][4]; float cacc[4];
#pragma unroll
            for (int nt = 0; nt < 4; ++nt) { acc[0][nt] = (f32x4){0.f, 0.f, 0.f, 0.f}; acc[1][nt] = acc[0][nt]; cacc[nt] = 0.f; }
#pragma unroll 1
            for (int kc = 0; kc < 4; ++kc) {
                float xs[17];
#pragma unroll
                for (int e = 0; e < 17; ++e) { const int i = F.tid + e * NTHREADS, r = i >> 8, k = (i & 255) + kc * 256; xs[e] = i < 33 * 256 ? (r < 32 ? c[r * D + k] : cc[k]) : 0.f; }
                float w[2][4][4];
#pragma unroll
                for (int gq = 0; gq < 2; ++gq)
#pragma unroll
                    for (int st = 0; st < 4; ++st)
#pragma unroll
                        for (int nt = 0; nt < 4; ++nt) w[gq][st][nt] = wm[((size_t)layer * D + kc * 256 + wv * 32 + 16 * gq + 4 * kq + st) * 6144 + col0 + 16 * nt + li];
                LDS_BAR();
#pragma unroll
                for (int e = 0; e < 17; ++e) { const int i = F.tid + e * NTHREADS; if (i < 33 * 256) sl[i] = xs[e] * sigmoidf_(xs[e]); }
                LDS_BAR();
#pragma unroll
                for (int gq = 0; gq < 2; ++gq) {
                    const int kl = wv * 32 + 16 * gq + 4 * kq;
                    const f32x4 a0 = *(const LAS f32x4*)(sl + li * 256 + kl), a1 = *(const LAS f32x4*)(sl + (16 + li) * 256 + kl), ac = *(const LAS f32x4*)(sl + 32 * 256 + kl);
#pragma unroll
                    for (int st = 0; st < 4; ++st)
#pragma unroll
                        for (int nt = 0; nt < 4; ++nt) {
                            acc[0][nt] = __builtin_amdgcn_mfma_f32_16x16x4f32(a0[st], w[gq][st][nt], acc[0][nt], 0, 0, 0);
                            acc[1][nt] = __builtin_amdgcn_mfma_f32_16x16x4f32(a1[st], w[gq][st][nt], acc[1][nt], 0, 0, 0);
                            cacc[nt] = __builtin_fmaf(ac[st], w[gq][st][nt], cacc[nt]);
                        }
                }
            }
            LDS_BAR();
#pragma unroll
            for (int mt = 0; mt < 2; ++mt)
#pragma unroll
                for (int nt = 0; nt < 4; ++nt)
#pragma unroll
                    for (int r = 0; r < 4; ++r) red[(wv * 32 + mt * 16 + 4 * kq + r) * 64 + 16 * nt + li] = acc[mt][nt][r];
#pragma unroll
            for (int nt = 0; nt < 4; ++nt) cred[(wv * 4 + kq) * 64 + 16 * nt + li] = cacc[nt];
            LDS_BAR();
            for (int i = F.tid; i < 33 * 64; i += NTHREADS) { const int r = i >> 6, x = i & 63; float s = 0.f;
                if (r < 32) {
#pragma unroll
                    for (int y = 0; y < 8; ++y) s += red[(y * 32 + r) * 64 + x];
                } else {
#pragma unroll
                    for (int y = 0; y < 32; ++y) s += cred[y * 64 + x];
                }
                const int col = col0 + x; s += bm[layer * 6144 + col];
                if (r < 32) F.wsp<float>(WS_MODL)[((size_t)layer * NB + r) * 6144 + col] = s; else F.wsp<float>(WS_MODC)[(size_t)layer * 6144 + col] = s; }
        }
    }
    __syncthreads();
    transpose_all(F);
    for (int a = 0; a < 2; ++a) {
        bf16_t* WLp = F.wsp<bf16_t>(WS_WL) + (size_t)a * 512 * K1CAT;
        if (a == 0) zero_rows(F, WLp, K1CAT, 384, 128, 0, K1CAT); else zero_rows(F, WLp, K1CAT, 416, 96, 0, K1CAT);
        zero_rows(F, F.wsp<bf16_t>(WS_G2T) + (size_t)a * D * 256, 256, 0, D, 128, 128);
    }
    zero_rows(F, F.wsp<bf16_t>(WS_V2T), 256, 0, D, 0, 128); zero_rows(F, F.wsp<bf16_t>(WS_V2T), 256, 0, D, 160, 96);
    {
        const float* src = F.in(33); bf16_t* dst = F.wsp<bf16_t>(WS_WSP); const long tot = (long)2 * 16 * 128 * 128 / 4;
        for (long i = (long)F.bid * NTHREADS + F.tid; i < tot; i += (long)F.G * NTHREADS) { const f32x4 v = *(const f32x4*)(src + i * 4); u32x2 w; w.x = pk2(v[0], v[1]); w.y = pk2(v[2], v[3]); *(u32x2*)(dst + i * 4) = w; }
    }
    __syncthreads();
}

__device__ __forceinline__ void phase_norm1(const Frame& F, int g, int layer  , bf16_t* dst, int ldh, bool dry = false) {
    bf16_t* X = F.wsp<bf16_t>(WS_X);
    const bf16_t* Y0 = F.ar<bf16_t>(AR_YM0); const bf16_t* Y1 = F.ar<bf16_t>(AR_YM1);
    const bool fin = layer == 4;
    const int rpb = (TG + F.G - 1) / F.G, rbeg = F.bid * rpb, rend = (rbeg + rpb) < TG ? (rbeg + rpb) : TG;
    int key = -1; f32x4 cg[4], cA[4], cB[4];
#pragma unroll
    for (int q = 0; q < 4; ++q) { cg[q] = (f32x4){0.f, 0.f, 0.f, 0.f}; cA[q] = cg[q]; cB[q] = cg[q]; }
    for (int r = rbeg + F.wave; r < rend; r += NWAVES) {
        const int bl = r / LT, t = r % LT, b = g * BG + bl; const bool isctx = t < LC;
        if (isctx && layer >= 3) continue;
        if (key != b * 2 + (int)isctx) {
            key = b * 2 + (int)isctx;
#pragma unroll
            for (int q = 0; q < 4; ++q) { const int c = q * 256 + F.lane * 4;
                if (layer > 0) cg[q] = *(const f32x4*)((isctx ? F.modC(layer - 1, 5) : F.modL(layer - 1, b, 5)) + c);
                if (fin) cA[q] = *(const f32x4*)(F.in(41) + c);
                else { const f32x4 gv = *(const f32x4*)(F.in(6) + (size_t)layer * D + c), cv = *(const f32x4*)((isctx ? F.modC(layer, 1) : F.modL(layer, b, 1)) + c);
                    cA[q] = gv * (1.0f + cv); cB[q] = *(const f32x4*)((isctx ? F.modC(layer, 0) : F.modL(layer, b, 0)) + c); } }
        }
        f32x4 x[4], xo[4];
#pragma unroll
        for (int q = 0; q < 4; ++q) xo[q] = (f32x4){0.f, 0.f, 0.f, 0.f};
        if (layer == 0) {
            const float* src = isctx ? F.in(2) + ((size_t)b * LC + t) * D : F.in(0) + ((size_t)b * SEQ + (t - LC)) * D;
#pragma unroll
            for (int q = 0; q < 4; ++q) x[q] = *(const f32x4*)(src + q * 256 + F.lane * 4);
        } else {
#pragma unroll
            for (int q = 0; q < 4; ++q) { const int c = q * 256 + F.lane * 4;
                { const u32x2 xw = *(const u32x2*)(X + (size_t)r * D + c); x[q] = (f32x4){lo16(xw.x), hi16(xw.x), lo16(xw.y), hi16(xw.y)}; } xo[q] = x[q];
                const u32x2 a = *(const u32x2*)(Y0 + (size_t)r * D + c), bb = *(const u32x2*)(Y1 + (size_t)r * D + c);
                x[q][0] += cg[q][0] * (lo16(a.x) + lo16(bb.x)); x[q][1] += cg[q][1] * (hi16(a.x) + hi16(bb.x));
                x[q][2] += cg[q][2] * (lo16(a.y) + lo16(bb.y)); x[q][3] += cg[q][3] * (hi16(a.y) + hi16(bb.y)); }
        }
        float ss = 0.f;
#pragma unroll
        for (int q = 0; q < 4; ++q) ss += x[q][0] * x[q][0] + x[q][1] * x[q][1] + x[q][2] * x[q][2] + x[q][3] * x[q][3];
        ss = wave_sum_dpp(ss);
        const float rstd = rsqrtf(ss * (1.0f / D) + 1e-6f);
        if (fin) {
            float* o = F.outp() + ((size_t)b * SEQ + (t - LC)) * D;
#pragma unroll
            for (int q = 0; q < 4; ++q) { const int c = q * 256 + F.lane * 4; *(f32x4*)(o + c) = x[q] * rstd * cA[q]; }
        } else {
#pragma unroll
            for (int q = 0; q < 4; ++q) { const int c = q * 256 + F.lane * 4;
                { const f32x4 xs = (dry && layer > 0) ? xo[q] : x[q]; u32x2 xw; xw.x = pk2(xs[0], xs[1]); xw.y = pk2(xs[2], xs[3]); *(u32x2*)(X + (size_t)r * D + c) = xw; }
                const f32x4 h = x[q] * rstd * cA[q] + cB[q];
                u32x2 w; w.x = pk2(h[0], h[1]); w.y = pk2(h[2], h[3]);
                *(u32x2*)(dst + (size_t)r * ldh + c) = w; }
        }
    }
}
__device__ __forceinline__ void phase_mix(const Frame& F, int a) {
    bf16_t* H2 = F.ar<bf16_t>(AR_H2); bf16_t* XM = F.ar<bf16_t>(AR_XR);
    const float* mu = F.in(8) + (size_t)a * 6 * D;
    f32x4 cm[2][3][2];
#pragma unroll
    for (int q = 0; q < 2; ++q)
#pragma unroll
        for (int m = 0; m < 3; ++m) { const int mi = m == 0 ? 0 : (m == 1 ? 2 : 3); const int c = q * 512 + F.lane * 8;
            cm[q][m][0] = *(const f32x4*)(mu + mi * D + c); cm[q][m][1] = *(const f32x4*)(mu + mi * D + c + 4); }
    const int rpb = (TG + F.G - 1) / F.G, rbeg = F.bid * rpb, rend = (rbeg + rpb) < TG ? (rbeg + rpb) : TG;
    for (int r = rbeg + F.wave; r < rend; r += NWAVES) {
        const int t = r % LT; const bool isctx = t < LC; const int p = t - LC;
#pragma unroll
        for (int q = 0; q < 2; ++q) {
            const int c = q * 512 + F.lane * 8;
            int nr;
            if (isctx) nr = (q == 0) ? (t > 0 ? r - 1 : -1) : (t < LC - 1 ? r + 1 : -1);
            else { const int qu = c >> 8;
                nr = qu == 0 ? ((p & 63) > 0 ? r - 1 : -1) : qu == 1 ? ((p & 63) < 63 ? r + 1 : -1) : qu == 2 ? (p >= 64 ? r - 64 : -1) : (p < SEQ - 64 ? r + 64 : -1); }
            const u32x4 hs = *(const u32x4*)(H2 + (size_t)r * 2048 + c);
            u32x4 hn = (u32x4){0u, 0u, 0u, 0u};
            if (nr >= 0) hn = *(const u32x4*)(H2 + (size_t)nr * 2048 + c);
            const float h[8] = {lo16(hs.x), hi16(hs.x), lo16(hs.y), hi16(hs.y), lo16(hs.z), hi16(hs.z), lo16(hs.w), hi16(hs.w)};
            const float n[8] = {lo16(hn.x), hi16(hn.x), lo16(hn.y), hi16(hn.y), lo16(hn.z), hi16(hn.z), lo16(hn.w), hi16(hn.w)};
            float dd[8];
#pragma unroll
            for (int e = 0; e < 8; ++e) dd[e] = n[e] - h[e];
            *(u32x4*)(H2 + (size_t)r * 2048 + 1024 + c) = (u32x4){pk2(dd[0], dd[1]), pk2(dd[2], dd[3]), pk2(dd[4], dd[5]), pk2(dd[6], dd[7])};
#pragma unroll
            for (int m = 0; m < 3; ++m) {
                const f32x4 m0 = cm[q][m][0], m1 = cm[q][m][1];
                float x[8];
#pragma unroll
                for (int e = 0; e < 4; ++e) { x[e] = h[e] + dd[e] * m0[e]; x[4 + e] = h[4 + e] + dd[4 + e] * m1[e]; }
                *(u32x4*)(XM + (size_t)m * TG * D + (size_t)r * D + c) = (u32x4){pk2(x[0], x[1]), pk2(x[2], x[3]), pk2(x[4], x[5]), pk2(x[6], x[7])};
            }
        }
    }
}
__device__ __forceinline__ void phase_vfix(const Frame& F) {
    bf16_t* V = F.ar<bf16_t>(AR_V); const bf16_t* VF = F.wsp<bf16_t>(WS_VF); const bf16_t* GT = F.ar<bf16_t>(AR_VGATE);
    const size_t tot = (size_t)TG * D / 8;
    for (size_t i = (size_t)F.bid * NTHREADS + F.tid; i < tot; i += (size_t)F.G * NTHREADS) {
        const u32x4 v = *(const u32x4*)(V + i * 8), f = *(const u32x4*)(VF + i * 8), g = *(const u32x4*)(GT + i * 8);
        u32x4 o;
        o.x = pk2(lo16(v.x) + (lo16(f.x) - lo16(v.x)) * lo16(g.x), hi16(v.x) + (hi16(f.x) - hi16(v.x)) * hi16(g.x));
        o.y = pk2(lo16(v.y) + (lo16(f.y) - lo16(v.y)) * lo16(g.y), hi16(v.y) + (hi16(f.y) - hi16(v.y)) * hi16(g.y));
        o.z = pk2(lo16(v.z) + (lo16(f.z) - lo16(v.z)) * lo16(g.z), hi16(v.z) + (hi16(f.z) - hi16(v.z)) * hi16(g.z));
        o.w = pk2(lo16(v.w) + (lo16(f.w) - lo16(v.w)) * lo16(g.w), hi16(v.w) + (hi16(f.w) - hi16(v.w)) * hi16(g.w));
        *(u32x4*)(V + i * 8) = o;
    }
}
__device__ __forceinline__ void phase_post(const Frame& F, int a, const bf16_t* V) {
    const bf16_t* Y0 = F.ar<bf16_t>(AR_Y0); bf16_t* YG = F.ar<bf16_t>(AR_R); const bf16_t* Y1 = F.ar<bf16_t>(AR_Y1); const float* DOT = F.ar<float>(AR_DOT); const bf16_t* Gb = F.ar<bf16_t>(AR_G);
    const float* lgp = F.in(27) + (size_t)a * D + F.lane * 16; const float* lbp = F.in(28) + (size_t)a * D + F.lane * 16;
    float lg[16], lb[16];
#pragma unroll
    for (int e = 0; e < 16; e += 4) { const f32x4 gq = *(const f32x4*)(lgp + e), bq = *(const f32x4*)(lbp + e);
        lg[e] = gq[0]; lg[e + 1] = gq[1]; lg[e + 2] = gq[2]; lg[e + 3] = gq[3]; lb[e] = bq[0]; lb[e + 1] = bq[1]; lb[e + 2] = bq[2]; lb[e + 3] = bq[3]; }
    const int rpb = (TG + F.G - 1) / F.G, rbeg = F.bid * rpb, rend = (rbeg + rpb) < TG ? (rbeg + rpb) : TG;
    for (int r = rbeg + F.wave; r < rend; r += NWAVES) {
        const int c = F.lane * 16, h = F.lane >> 2;
        float y[16], vv[16];
#pragma unroll
        for (int q = 0; q < 2; ++q) {
            const u32x4 a0 = *(const u32x4*)(Y0 + (size_t)r * D + c + q * 8), a1 = *(const u32x4*)(Y1 + (size_t)r * D + c + q * 8), v4 = *(const u32x4*)(V + (size_t)r * D + c + q * 8);
            y[q * 8 + 0] = lo16(a0.x) + lo16(a1.x); y[q * 8 + 1] = hi16(a0.x) + hi16(a1.x); y[q * 8 + 2] = lo16(a0.y) + lo16(a1.y); y[q * 8 + 3] = hi16(a0.y) + hi16(a1.y);
            y[q * 8 + 4] = lo16(a0.z) + lo16(a1.z); y[q * 8 + 5] = hi16(a0.z) + hi16(a1.z); y[q * 8 + 6] = lo16(a0.w) + lo16(a1.w); y[q * 8 + 7] = hi16(a0.w) + hi16(a1.w);
            vv[q * 8 + 0] = lo16(v4.x); vv[q * 8 + 1] = hi16(v4.x); vv[q * 8 + 2] = lo16(v4.y); vv[q * 8 + 3] = hi16(v4.y);
            vv[q * 8 + 4] = lo16(v4.z); vv[q * 8 + 5] = hi16(v4.z); vv[q * 8 + 6] = lo16(v4.w); vv[q * 8 + 7] = hi16(v4.w);
        }
        float s = 0.f;
#pragma unroll
        for (int e = 0; e < 16; ++e) s += y[e];
        s = red4(s); const float mean = s * (1.0f / 64.0f);
        float qv = 0.f;
#pragma unroll
        for (int e = 0; e < 16; ++e) { const float dd = y[e] - mean; qv += dd * dd; }
        qv = red4(qv); const float rstd = rsqrtf(qv * (1.0f / 64.0f) + 64e-5f);
        const float dsum = DOT[(size_t)r * NH + h] + DOT[((size_t)TG + r) * NH + h];
        unsigned o[8];
        const u32x4 g0 = *(const u32x4*)(Gb + (size_t)r * D + c), g1 = *(const u32x4*)(Gb + (size_t)r * D + c + 8);
        const unsigned gw[8] = {g0.x, g0.y, g0.z, g0.w, g1.x, g1.y, g1.z, g1.w};
#pragma unroll
        for (int e = 0; e < 16; e += 2) {
            const float o0 = ((y[e] - mean) * rstd * lg[e] + lb[e] + vv[e] * dsum) * lo16(gw[e >> 1]);
            const float o1 = ((y[e + 1] - mean) * rstd * lg[e + 1] + lb[e + 1] + vv[e + 1] * dsum) * hi16(gw[e >> 1]);
            o[e >> 1] = pk2(o0, o1);
        }
        *(u32x4*)(YG + (size_t)r * D + c) = (u32x4){o[0], o[1], o[2], o[3]};
        *(u32x4*)(YG + (size_t)r * D + c + 8) = (u32x4){o[4], o[5], o[6], o[7]};
    }
}
__device__ __forceinline__ void phase_norm2(const Frame& F, int g, int layer, bool dry = false) {
    bf16_t* X = F.wsp<bf16_t>(WS_X); bf16_t* HM = F.ar<bf16_t>(AR_HM); const bf16_t* Ob = F.ar<bf16_t>(AR_O);
    int* lists = dry ? F.ar<int>(AR_YM0) : F.ar<int>(AR_LIST); float* lwt = dry ? F.ar<float>(AR_YM0) + (size_t)32 * TG : F.ar<float>(AR_LW);
    unsigned* cnt = (unsigned*)(F.ws + WS_CTL + CTL_CNT_OFF) + (((size_t)g * 4 + layer) * 32 + (dry ? NG * 4 * 32 : 0)) * 16;
    LAS float* wr = (LAS float*)F.lds;
    __syncthreads();
    for (int i = F.tid; i < D * NEXP / 4; i += NTHREADS) { const int c = i >> 2, e4 = i & 3; const int rho = (c & ~255) + (c & 3) * 64 + ((c & 255) >> 2);
        *(LAS f32x4*)(wr + rho * 20 + e4 * 4) = *(const f32x4*)(F.in(36) + i * 4); }
    __syncthreads();
    const float* rbias = F.in(37);
    float rb4[4];
#pragma unroll
    for (int e = 0; e < 4; ++e) rb4[e] = rbias[(F.lane >> 4) * 4 + e];
    const bool ctx_out = layer < 2;
    LAS int* lcnt = (LAS int*)(F.lds + LDS_MISC + 512);
    LAS int* lbase = (LAS int*)(F.lds + LDS_MISC + 640);
    LAS int* rec = (LAS int*)(F.lds + 81920);
    const int rpb = (TG + F.G - 1) / F.G, rbeg = F.bid * rpb, rend = (rbeg + rpb) < TG ? (rbeg + rpb) : TG;
    const int niter = (rpb + NWAVES - 1) / NWAVES;
    int key = -1; f32x4 cg[4], cA[4], cB[4];
#pragma unroll
    for (int q = 0; q < 4; ++q) { cg[q] = (f32x4){0.f, 0.f, 0.f, 0.f}; cA[q] = cg[q]; cB[q] = cg[q]; }
    for (int it0 = 0; it0 < niter; it0 += 64) {
        if (F.tid < 32) lcnt[F.tid] = 0;
        __syncthreads();
        const int itn = (niter - it0) < 64 ? (niter - it0) : 64;
        u32x2 nxw[4], nob[4];
        { const int r_ = rbeg + it0 * NWAVES + F.wave; const int rc_ = r_ < rend ? r_ : rbeg;
#pragma unroll
          for (int q = 0; q < 4; ++q) { const int c = q * 256 + F.lane * 4; nxw[q] = *(const u32x2*)(X + (size_t)rc_ * D + c); nob[q] = *(const u32x2*)(Ob + (size_t)rc_ * D + c); } }
        for (int itl = 0; itl < itn; ++itl) {
            const int r = rbeg + (it0 + itl) * NWAVES + F.wave;
            const int bl = r / LT, t = r % LT, b = g * BG + bl; const bool isctx = t < LC;
            const int slot = itl * NWAVES + F.wave;
            u32x2 cxw[4], cob[4];
#pragma unroll
            for (int q = 0; q < 4; ++q) { cxw[q] = nxw[q]; cob[q] = nob[q]; }
            { const int r_ = r + NWAVES; const int rc_ = (itl + 1 < itn && r_ < rend) ? r_ : rbeg;
#pragma unroll
              for (int q = 0; q < 4; ++q) { const int c = q * 256 + F.lane * 4; nxw[q] = *(const u32x2*)(X + (size_t)rc_ * D + c); nob[q] = *(const u32x2*)(Ob + (size_t)rc_ * D + c); } }
            if (r >= rend || (isctx && !ctx_out)) { if (F.lane == 0) rec[slot * 4] = -1; continue; }
            if (key != b * 2 + (int)isctx) {
                key = b * 2 + (int)isctx;
#pragma unroll
                for (int q = 0; q < 4; ++q) { const int c = q * 256 + F.lane * 4;
                    cg[q] = *(const f32x4*)((isctx ? F.modC(layer, 2) : F.modL(layer, b, 2)) + c);
                    const f32x4 gv = *(const f32x4*)(F.in(7) + (size_t)layer * D + c), cv = *(const f32x4*)((isctx ? F.modC(layer, 4) : F.modL(layer, b, 4)) + c);
                    cA[q] = gv * (1.0f + cv); cB[q] = *(const f32x4*)((isctx ? F.modC(layer, 3) : F.modL(layer, b, 3)) + c); }
            }
            f32x4 x[4]; float ss = 0.f;
#pragma unroll
            for (int q = 0; q < 4; ++q) { const int c = q * 256 + F.lane * 4;
                { const u32x2 xw = cxw[q]; x[q] = (f32x4){lo16(xw.x), hi16(xw.x), lo16(xw.y), hi16(xw.y)}; }
                const u32x2 ob = cob[q]; const f32x4 gv = cg[q];
                const f32x4 xo = x[q];
                x[q][0] += gv[0] * lo16(ob.x); x[q][1] += gv[1] * hi16(ob.x); x[q][2] += gv[2] * lo16(ob.y); x[q][3] += gv[3] * hi16(ob.y);
                { const f32x4 xs = dry ? xo : x[q]; u32x2 xw; xw.x = pk2(xs[0], xs[1]); xw.y = pk2(xs[2], xs[3]); *(u32x2*)(X + (size_t)r * D + c) = xw; }
                ss += x[q][0] * x[q][0] + x[q][1] * x[q][1] + x[q][2] * x[q][2] + x[q][3] * x[q][3]; }
            ss = wave_sum_dpp(ss);
            const float rstd = rsqrtf(ss * (1.0f / D) + 1e-6f);
            float lg[16];
#pragma unroll
            for (int e = 0; e < 16; ++e) lg[e] = 0.f;
#pragma unroll
            for (int q = 0; q < 4; ++q) { const int c = q * 256 + F.lane * 4;
                const f32x4 h = x[q] * rstd * cA[q] + cB[q];
                u32x2 w; w.x = pk2(h[0], h[1]); w.y = pk2(h[2], h[3]);
                *(u32x2*)(HM + (size_t)r * D + c) = w;
#pragma unroll
                for (int j = 0; j < 4; ++j) {
#pragma unroll
                    for (int e4 = 0; e4 < 4; ++e4) { const f32x4 wv = *(const LAS f32x4*)(wr + (q * 256 + j * 64 + F.lane) * 20 + e4 * 4);
                        lg[e4 * 4 + 0] += h[j] * wv[0]; lg[e4 * 4 + 1] += h[j] * wv[1]; lg[e4 * 4 + 2] += h[j] * wv[2]; lg[e4 * 4 + 3] += h[j] * wv[3]; } }
            }
            float m8[8], xg[4];
#pragma unroll
            for (int e = 0; e < 8; ++e) { const auto sw = __builtin_amdgcn_permlane32_swap(__float_as_uint(lg[e]), __float_as_uint(lg[e + 8]), false, false); m8[e] = __uint_as_float(sw[0]) + __uint_as_float(sw[1]); }
#pragma unroll
            for (int e = 0; e < 4; ++e) { const auto sw = __builtin_amdgcn_permlane16_swap(__float_as_uint(m8[e]), __float_as_uint(m8[e + 4]), false, false); xg[e] = red16(__uint_as_float(sw[0]) + __uint_as_float(sw[1])); }
            float sc_[4], bs[4];
#pragma unroll
            for (int e = 0; e < 4; ++e) { sc_[e] = sigmoidf_(xg[e]); bs[e] = sc_[e] + rb4[e]; }
            const float hi01 = fmaxf(bs[0], bs[1]), lo01 = fminf(bs[0], bs[1]), hi23 = fmaxf(bs[2], bs[3]), lo23 = fminf(bs[2], bs[3]);
            const float gsc = fmaxf(hi01, hi23) + fmaxf(fminf(hi01, hi23), fmaxf(lo01, lo23));
            const float g0s = __int_as_float(__builtin_amdgcn_readlane(__float_as_int(gsc), 0)), g1s = __int_as_float(__builtin_amdgcn_readlane(__float_as_int(gsc), 16));
            const float g2s = __int_as_float(__builtin_amdgcn_readlane(__float_as_int(gsc), 32)), g3s = __int_as_float(__builtin_amdgcn_readlane(__float_as_int(gsc), 48));
            const bool c10 = g1s > g0s, c32 = g3s > g2s; const float v01 = c10 ? g1s : g0s, v23 = c32 ? g3s : g2s; const bool chi = v23 > v01;
            const int best = __builtin_amdgcn_readfirstlane(chi ? (c32 ? 3 : 2) : (c10 ? 1 : 0));
            float cb[4], cs[4];
#pragma unroll
            for (int e = 0; e < 4; ++e) { cb[e] = __int_as_float(__builtin_amdgcn_readlane(__float_as_int(bs[e]), best * 16)); cs[e] = __int_as_float(__builtin_amdgcn_readlane(__float_as_int(sc_[e]), best * 16)); }
            const bool d10 = cb[1] > cb[0], d32 = cb[3] > cb[2]; const float w01 = d10 ? cb[1] : cb[0], w23 = d32 ? cb[3] : cb[2]; const bool dhi = w23 > w01;
            const int j1 = dhi ? (d32 ? 3 : 2) : (d10 ? 1 : 0);
            const float e0 = j1 == 0 ? -1e30f : cb[0], e1 = j1 == 1 ? -1e30f : cb[1], e2 = j1 == 2 ? -1e30f : cb[2], e3 = j1 == 3 ? -1e30f : cb[3];
            const bool f10 = e1 > e0, f32_ = e3 > e2; const float u01 = f10 ? e1 : e0, u23 = f32_ ? e3 : e2; const bool fhi = u23 > u01;
            const int j2 = fhi ? (f32_ ? 3 : 2) : (f10 ? 1 : 0);
            const float s1 = (j1 & 2) ? ((j1 & 1) ? cs[3] : cs[2]) : ((j1 & 1) ? cs[1] : cs[0]);
            const float s2 = (j2 & 2) ? ((j2 & 1) ? cs[3] : cs[2]) : ((j2 & 1) ? cs[1] : cs[0]);
            const float inv = __builtin_amdgcn_rcpf(s1 + s2);
            if (F.lane == 0) {
                const int l1 = (best * 4 + j1) * 2 + 0, l2 = (best * 4 + j2) * 2 + 1;
                const int p1 = __hip_atomic_fetch_add(lcnt + l1, 1, __ATOMIC_RELAXED, __HIP_MEMORY_SCOPE_WORKGROUP);
                const int p2 = __hip_atomic_fetch_add(lcnt + l2, 1, __ATOMIC_RELAXED, __HIP_MEMORY_SCOPE_WORKGROUP);
                rec[slot * 4 + 0] = l1 | (p1 << 8); rec[slot * 4 + 1] = l2 | (p2 << 8);
                rec[slot * 4 + 2] = __float_as_int(s1 * inv); rec[slot * 4 + 3] = __float_as_int(s2 * inv);
            }
        }
        __syncthreads();
        if (F.tid < 32) { const int c = lcnt[F.tid]; lbase[F.tid] = c ? (int)atomicAdd(&cnt[F.tid * 16], (unsigned)c) : 0; }
        __syncthreads();
        for (int slot = F.tid; slot < itn * NWAVES; slot += NTHREADS) {
            const int a0 = rec[slot * 4 + 0]; if (a0 < 0) continue;
            const int a1 = rec[slot * 4 + 1];
            const int r = rbeg + (it0 + slot / NWAVES) * NWAVES + (slot % NWAVES);
            const int l1 = a0 & 255, l2 = a1 & 255; const int q1 = lbase[l1] + (a0 >> 8), q2 = lbase[l2] + (a1 >> 8);
            lists[(size_t)l1 * TG + q1] = r; lwt[(size_t)l1 * TG + q1] = __int_as_float(rec[slot * 4 + 2]);
            lists[(size_t)l2 * TG + q2] = r; lwt[(size_t)l2 * TG + q2] = __int_as_float(rec[slot * 4 + 3]);
        }
        __syncthreads();
    }
}
__device__ __forceinline__ int moe_tables(const Frame& F, int g, int layer) {
    LAS int* cn = (LAS int*)(F.lds + LDS_MISC + 64); LAS int* tb = (LAS int*)(F.lds + LDS_MISC + 192);
    const unsigned* cnt = (const unsigned*)(F.ws + WS_CTL + CTL_CNT_OFF) + ((size_t)g * 4 + layer) * 32 * 16;
    __syncthreads();
    if (F.tid < 32) cn[F.tid] = (int)__hip_atomic_load(cnt + F.tid * 16, __ATOMIC_RELAXED, __HIP_MEMORY_SCOPE_AGENT);
    __syncthreads();
    if (F.tid == 0) { int acc = 0; for (int l = 0; l < 32; ++l) { tb[l] = acc; acc += (cn[l] + 255) >> 8; } tb[32] = acc; }
    __syncthreads();
    return tb[32];
}

constexpr int SC_OPB = 6 * 4096;
constexpr int SC_HALF = 2 * SC_OPB + 4096 + 4096;
static_assert(2 * SC_HALF <= LDS_STAGE, "scan lds");
__device__ __forceinline__ int scan_tok(int d, int s) { return d == 0 ? s : (s < LC ? (LC - 1 - s) : (LT + LC - 1 - s)); }

constexpr int S4_KKP = 0, S4_RPP = 2048, S4_KDP = 4096, S4_KAP = 6144, S4_KDT = 8192, S4_KAT = 10496, S4_VT = 12800, S4_P15 = 15104, S4_PBSZ = 15360,
              S4_A1 = 30720, S4_B1 = 31232, S4_B2 = 31744, S4_A2 = 32256, S4_MI = 33280, S4_LI = 33792, S4_LX = 37888, S4_AT = 41984, S4_YB = 46080, S4_HALF = 50176;
static_assert(2 * S4_HALF <= LDS_STAGE, "scan4 lds");
#define MF16(a, b, c) __builtin_amdgcn_mfma_f32_16x16x32_bf16((a), (b), (c), 0, 0, 0)
__device__ __forceinline__ bf16x8 mkfrag(unsigned a, unsigned b, unsigned c, unsigned d) { return __builtin_bit_cast(bf16x8, (u32x4){a, b, c, d}); }
__device__ __forceinline__ f32x4 scan_inverse_mfma(f32x4 N, f32x4 NT, int g, int j) {
    const f32x4 z = (f32x4){0.f, 0.f, 0.f, 0.f};
#define P2(v) mkfrag(pk2((v)[0], (v)[1]), pk2((v)[2], (v)[3]), 0u, 0u)
    const bf16x8 Nc = P2(N), Ntc = P2(NT);
    const f32x4 Z2 = MF16(Ntc, Nc, z), Z2t = MF16(Nc, Ntc, z);
    f32x4 Q = (f32x4){(4 * g == j ? 1.f : 0.f) - NT[0], (4 * g + 1 == j ? 1.f : 0.f) - NT[1], (4 * g + 2 == j ? 1.f : 0.f) - NT[2], (4 * g + 3 == j ? 1.f : 0.f) - NT[3]};
    const bf16x8 Z2c = P2(Z2), Z2tc = P2(Z2t);
    const f32x4 Z4 = MF16(Z2tc, Z2c, z), Z4t = MF16(Z2c, Z2tc, z);
    Q = MF16(Z2c, P2(Q), Q);
    const bf16x8 Z4c = P2(Z4), Z4tc = P2(Z4t);
    const f32x4 Z8 = MF16(Z4tc, Z4c, z);
    Q = MF16(Z4c, P2(Q), Q);
    Q = MF16(P2(Z8), P2(Q), Q);
#undef P2
    return Q;
}
__device__ __forceinline__ void phase_scan4(const Frame& F, int a, const bf16_t* V) {
    const bf16_t* R = F.ar<bf16_t>(AR_R); const bf16_t* Kb = F.ar<bf16_t>(AR_K); const bf16_t* L1 = F.ar<bf16_t>(AR_L1);
    const int half = F.wave >> 2, q = F.wave & 3, lane = F.lane, li = q * 64 + lane;
    const int role = (q - half) & 3;
    LAS unsigned char* hb = F.lds + half * S4_HALF;
    const int arr = q >> 1, ntl = (q & 1) * 2;
    const int g = lane >> 4, j = lane & 15;
    const int tB = li >> 4, k4 = (li & 15) * 4;
    const int poff = (tB * 64 + (k4 >> 5) * 32 + ((k4 >> 2) & 3) * 8 + ((k4 >> 4) & 1) * 4) * 2;
    for (int pr = F.bid; pr < BG * 16; pr += F.G) {
        const int bl = pr >> 4, d = (pr >> 3) & 1, hp = pr & 7, h = hp * 2 + half;
        bf16_t* Yd = F.ar<bf16_t>(d ? AR_Y1 : AR_Y0); float* DOT = F.ar<float>(AR_DOT) + (size_t)d * TG * NH;
        const size_t rowb = (size_t)bl * LT;
        const bf16_t* W2 = (arr == 0 ? F.wsp<bf16_t>(WS_W2T) : F.wsp<bf16_t>(WS_A2T)) + ((size_t)a * 2 + d) * D * 64;
        const float* b0p = (arr == 0 ? F.in(13) : F.in(16)) + ((size_t)a * 2 + d) * D + h * 64;
        const int acol = arr * 128 + d * 64 + 8 * (lane >> 4);
        f32x4 Cb[4];
#pragma unroll
        for (int b = 0; b < 4; ++b) Cb[b] = (f32x4){0.f, 0.f, 0.f, 0.f};
        bf16x8 Af[2]; u32x2 kraw, rraw, vraw;
        bf16x8 wf0[2], wf1[2]; float bias2[2];
#pragma unroll
        for (int nt = 0; nt < 2; ++nt) { const int n = (ntl + nt) * 16 + (lane & 15); bias2[nt] = b0p[n];
            wf0[nt] = *(const bf16x8*)(W2 + (size_t)(h * 64 + n) * 64 + 8 * (lane >> 4)); wf1[nt] = *(const bf16x8*)(W2 + (size_t)(h * 64 + n) * 64 + 32 + 8 * (lane >> 4)); }
        const f32x4 kkc = *(const f32x4*)(F.in(24) + (size_t)a * D + h * 64 + k4), kac = *(const f32x4*)(F.in(25) + (size_t)a * D + h * 64 + k4), rkc = *(const f32x4*)(F.in(26) + (size_t)a * D + h * 64 + k4);
#define SC_BAR() asm volatile("s_waitcnt lgkmcnt(0)\n\ts_barrier" ::: "memory")
#define SC_LOAD(ch) do { const size_t rowA = rowb + scan_tok(d, (ch) * 16 + (lane & 15)); \
        Af[0] = *(const bf16x8*)(L1 + rowA * 512 + acol); Af[1] = *(const bf16x8*)(L1 + rowA * 512 + acol + 32); \
        const size_t rowBq = (rowb + scan_tok(d, (ch) * 16 + tB)) * D + h * 64 + k4; \
        kraw = *(const u32x2*)(Kb + rowBq); rraw = *(const u32x2*)(R + rowBq); vraw = *(const u32x2*)(V + rowBq); } while (0)
#define SC_PASSA() do { \
        _Pragma("unroll") for (int nt = 0; nt < 2; ++nt) { f32x4 ac = (f32x4){0.f, 0.f, 0.f, 0.f}; \
            const int n = (ntl + nt) * 16 + (lane & 15); const float bias_ = bias2[nt]; \
            ac = MF16(Af[0], wf0[nt], ac); ac = MF16(Af[1], wf1[nt], ac); \
            f32x4 sg; _Pragma("unroll") for (int rg = 0; rg < 4; ++rg) sg[rg] = sigmoidf_(ac[rg] + bias_); \
            if (arr == 0) { \
                const float l0 = -0.60653066f * sg[0], l1 = -0.60653066f * sg[1], l2 = -0.60653066f * sg[2], l3 = -0.60653066f * sg[3]; \
                const float p0 = l0, p1 = p0 + l1, p2 = p1 + l2, p3 = p2 + l3;                         \
                const auto s16 = __builtin_amdgcn_permlane16_swap(__float_as_uint(p3), __float_as_uint(p3), false, false);     \
                const float sv = __uint_as_float(s16[0]), pq = sv + __uint_as_float(s16[1]); \
                const auto s32 = __builtin_amdgcn_permlane32_swap(__float_as_uint(pq), __float_as_uint(pq), false, false);     \
                const float E = ((g & 1) ? sv : 0.f) + ((g & 2) ? __uint_as_float(s32[0]) : 0.f);      \
                LAS float* li_ = (LAS float*)(hb + S4_LI) + (4 * g) * 64 + n; LAS float* lx_ = (LAS float*)(hb + S4_LX) + (4 * g) * 64 + n; \
                li_[0] = E + p0; li_[64] = E + p1; li_[128] = E + p2; li_[192] = E + p3; lx_[0] = E; lx_[64] = E + p0; lx_[128] = E + p1; lx_[192] = E + p2; \
            } else { _Pragma("unroll") for (int rg = 0; rg < 4; ++rg) ((LAS float*)(hb + S4_AT))[(4 * g + rg) * 64 + n] = sg[rg]; } } } while (0)
#define SC_PASSB(ch, pbo_) do { LAS unsigned char* hq_ = hb + (pbo_); \
        const float kf[4] = {lo16(kraw.x), hi16(kraw.x), lo16(kraw.y), hi16(kraw.y)}; const float rf[4] = {lo16(rraw.x), hi16(rraw.x), lo16(rraw.y), hi16(rraw.y)}; \
        const f32x4 av = *(const LAS f32x4*)((LAS float*)(hb + S4_AT) + tB * 64 + k4), Li = *(const LAS f32x4*)((LAS float*)(hb + S4_LI) + tB * 64 + k4), Lx = *(const LAS f32x4*)((LAS float*)(hb + S4_LX) + tB * 64 + k4); \
        float kq[4], ssq = 0.f; _Pragma("unroll") for (int e = 0; e < 4; ++e) { kq[e] = kf[e] * kkc[e]; ssq += kq[e] * kq[e]; } \
        ssq = red16(ssq); const float inv = __builtin_amdgcn_rsqf(fmaxf(ssq, 1e-24f)); \
        float o_kk[4], o_ka[4], o_kd[4], o_r[4]; f32x4 o_p; float dp = 0.f; \
        _Pragma("unroll") for (int e = 0; e < 4; ++e) { const float Pt = __expf(Li[e]), Px = __expf(Lx[e]), iP = __builtin_amdgcn_rcpf(Pt); \
            const float kkv = kq[e] * inv; const float kd = kf[e] * (1.0f + (av[e] - 1.0f) * kac[e]); const float ka = kkv * av[e]; \
            o_kk[e] = kkv * Px; o_ka[e] = ka * iP; o_kd[e] = kd * iP; o_r[e] = rf[e] * Pt; o_p[e] = Pt; \
            dp += rf[e] * kd * rkc[e]; } \
        dp = red16(dp); \
        if ((li & 15) == 0) DOT[(rowb + scan_tok(d, (ch) * 16 + tB)) * NH + h] = dp; \
        const u32x2 w_kk = (u32x2){pk2(o_kk[0], o_kk[1]), pk2(o_kk[2], o_kk[3])}, w_r = (u32x2){pk2(o_r[0], o_r[1]), pk2(o_r[2], o_r[3])}; \
        const u32x2 w_kd = (u32x2){pk2(o_kd[0], o_kd[1]), pk2(o_kd[2], o_kd[3])}, w_ka = (u32x2){pk2(o_ka[0], o_ka[1]), pk2(o_ka[2], o_ka[3])}; \
        *(LAS u32x2*)(hq_ + S4_KKP + poff) = w_kk; *(LAS u32x2*)(hq_ + S4_RPP + poff) = w_r; *(LAS u32x2*)(hq_ + S4_KDP + poff) = w_kd; *(LAS u32x2*)(hq_ + S4_KAP + poff) = w_ka; \
        { LAS unsigned char* td = hq_ + S4_KDT + k4 * 36 + tB * 2; LAS unsigned char* ta = hq_ + S4_KAT + k4 * 36 + tB * 2; LAS unsigned char* tv = hq_ + S4_VT + k4 * 36 + tB * 2; \
          *(LAS unsigned short*)(td) = (unsigned short)w_kd.x; *(LAS unsigned short*)(td + 36) = (unsigned short)(w_kd.x >> 16); *(LAS unsigned short*)(td + 72) = (unsigned short)w_kd.y; *(LAS unsigned short*)(td + 108) = (unsigned short)(w_kd.y >> 16); \
          *(LAS unsigned short*)(ta) = (unsigned short)w_ka.x; *(LAS unsigned short*)(ta + 36) = (unsigned short)(w_ka.x >> 16); *(LAS unsigned short*)(ta + 72) = (unsigned short)w_ka.y; *(LAS unsigned short*)(ta + 108) = (unsigned short)(w_ka.y >> 16); \
          *(LAS unsigned short*)(tv) = (unsigned short)vraw.x; *(LAS unsigned short*)(tv + 36) = (unsigned short)(vraw.x >> 16); *(LAS unsigned short*)(tv + 72) = (unsigned short)vraw.y; *(LAS unsigned short*)(tv + 108) = (unsigned short)(vraw.y >> 16); } \
        if (tB == 15) *(LAS f32x4*)((LAS float*)(hq_ + S4_P15) + k4) = o_p; } while (0)
#define SC_PROD(pbo_) do { LAS unsigned char* hq_ = hb + (pbo_); \
        const int lo_ = (role < 2 ? S4_KKP : S4_RPP) + j * 128 + g * 16, ro_ = ((role == 0 || role == 3) ? S4_KAP : S4_KDP) + j * 128 + g * 16; \
        const bf16x8 fl0_ = *(const LAS bf16x8*)(hq_ + lo_), fr0_ = *(const LAS bf16x8*)(hq_ + ro_), fl1_ = *(const LAS bf16x8*)(hq_ + lo_ + 64), fr1_ = *(const LAS bf16x8*)(hq_ + ro_ + 64); \
        f32x4 pa = (f32x4){0.f, 0.f, 0.f, 0.f}; \
        pa = MF16(fl0_, fr0_, pa); pa = MF16(fl1_, fr1_, pa); \
        _Pragma("unroll") for (int r_ = 0; r_ < 4; ++r_) { const int t_ = 4 * g + r_; const bool keep = (role < 2) ? (j < t_) : (j <= t_); pa[r_] = keep ? pa[r_] : 0.f; } \
        if (role == 0) { f32x4 pt = (f32x4){0.f, 0.f, 0.f, 0.f}; pt = MF16(fr0_, fl0_, pt); pt = MF16(fr1_, fl1_, pt);        \
            _Pragma("unroll") for (int r_ = 0; r_ < 4; ++r_) pt[r_] = (j > 4 * g + r_) ? pt[r_] : 0.f; \
            const f32x4 mt_ = scan_inverse_mfma(pa, pt, g, j); \
            *(LAS u32x2*)(hb + S4_MI + j * 32 + g * 8) = (u32x2){pk2(mt_[0], mt_[1]), pk2(mt_[2], mt_[3])}; } \
        else { LAS unsigned char* dm = hb + (role == 1 ? S4_A1 : (role == 2 ? S4_B1 : S4_B2)) + ((4 * g) * 16 + j) * 2; const unsigned w0_ = pk2(pa[0], pa[1]), w1_ = pk2(pa[2], pa[3]); \
            *(LAS unsigned short*)(dm) = (unsigned short)w0_; *(LAS unsigned short*)(dm + 32) = (unsigned short)(w0_ >> 16); *(LAS unsigned short*)(dm + 64) = (unsigned short)w1_; *(LAS unsigned short*)(dm + 96) = (unsigned short)(w1_ >> 16); } } while (0)
        constexpr int NCH = LT / 16;
        __syncthreads();
        SC_LOAD(0);
        SC_PASSA();
        SC_BAR();
        SC_PASSB(0, 0);
        SC_BAR();
        SC_LOAD(1);
        SC_PASSA();
        SC_PROD(0);
        SC_BAR();
        SC_PASSB(1, S4_PBSZ);
        SC_BAR();
#pragma unroll 1
        for (int it = 0; it < 2 * NCH + 1; ++it) {
            const int s_ = it - half;
            if (s_ >= 0 && s_ < 2 * NCH) {
            const int ch = s_ >> 1;
            const int pbo = (ch & 1) * S4_PBSZ;
            LAS unsigned char* hc = hb + pbo;
            if ((s_ & 1) == 0) {
            if (ch + 2 < NCH) SC_LOAD(ch + 2);
            const bf16x8 Bs0 = mkfrag(pk2(Cb[0][0], Cb[0][1]), pk2(Cb[0][2], Cb[0][3]), pk2(Cb[1][0], Cb[1][1]), pk2(Cb[1][2], Cb[1][3]));
            const bf16x8 Bs1 = mkfrag(pk2(Cb[2][0], Cb[2][1]), pk2(Cb[2][2], Cb[2][3]), pk2(Cb[3][0], Cb[3][1]), pk2(Cb[3][2], Cb[3][3]));
            f32x4 X = (f32x4){0.f, 0.f, 0.f, 0.f}, H = (f32x4){0.f, 0.f, 0.f, 0.f};
            X = MF16(*(const LAS bf16x8*)(hc + S4_KKP + j * 128 + g * 16), Bs0, X); H = MF16(*(const LAS bf16x8*)(hc + S4_RPP + j * 128 + g * 16), Bs0, H);
            X = MF16(*(const LAS bf16x8*)(hc + S4_KKP + j * 128 + g * 16 + 64), Bs1, X); H = MF16(*(const LAS bf16x8*)(hc + S4_RPP + j * 128 + g * 16 + 64), Bs1, H);
            const u32x2 vw = (u32x2){*(const LAS unsigned*)(hc + S4_VT + (16 * q + j) * 36 + 8 * g), *(const LAS unsigned*)(hc + S4_VT + (16 * q + j) * 36 + 8 * g + 4)};
            const bf16x8 Bv = mkfrag(vw.x, vw.y, 0u, 0u);
            {
                const u32x2 a1w = *(const LAS u32x2*)(hb + S4_A1 + (j * 16 + 4 * g) * 2), b1w = *(const LAS u32x2*)(hb + S4_B1 + (j * 16 + 4 * g) * 2);
                X = MF16(mkfrag(a1w.x, a1w.y, 0u, 0u), Bv, X); H = MF16(mkfrag(b1w.x, b1w.y, 0u, 0u), Bv, H);
            }
            const u32x2 mw = *(const LAS u32x2*)(hb + S4_MI + j * 32 + g * 8);
            f32x4 SA = (f32x4){0.f, 0.f, 0.f, 0.f};
            SA = MF16(mkfrag(mw.x, mw.y, 0u, 0u), mkfrag(pk2(X[0], X[1]), pk2(X[2], X[3]), 0u, 0u), SA);
            const bf16x8 Bn = mkfrag(pk2(-SA[0], -SA[1]), pk2(-SA[2], -SA[3]), 0u, 0u);
            {
                const u32x2 b2w = *(const LAS u32x2*)(hb + S4_B2 + (j * 16 + 4 * g) * 2);
                H = MF16(mkfrag(b2w.x, b2w.y, 0u, 0u), Bn, H);
                LAS float* yb = (LAS float*)(hb + S4_YB) + (4 * g) * 64 + 16 * q + j; yb[0] = H[0]; yb[64] = H[1]; yb[128] = H[2]; yb[192] = H[3];
            }
#pragma unroll
            for (int b = 0; b < 4; ++b) {
                const u32x2 kdw = (u32x2){*(const LAS unsigned*)(hc + S4_KDT + (16 * b + j) * 36 + 8 * g), *(const LAS unsigned*)(hc + S4_KDT + (16 * b + j) * 36 + 8 * g + 4)};
                const u32x2 kaw = (u32x2){*(const LAS unsigned*)(hc + S4_KAT + (16 * b + j) * 36 + 8 * g), *(const LAS unsigned*)(hc + S4_KAT + (16 * b + j) * 36 + 8 * g + 4)};
                Cb[b] = MF16(mkfrag(kdw.x, kdw.y, 0u, 0u), Bv, Cb[b]);
                Cb[b] = MF16(mkfrag(kaw.x, kaw.y, 0u, 0u), Bn, Cb[b]);
            }
#pragma unroll
            for (int b = 0; b < 4; ++b) { const f32x4 pv = *(const LAS f32x4*)((LAS float*)(hc + S4_P15) + 16 * b + 4 * g); Cb[b] = Cb[b] * pv; }
            if (ch + 2 < NCH) SC_PASSA();
            } else {
            {
                const f32x4 yv = *(const LAS f32x4*)((LAS float*)(hb + S4_YB) + tB * 64 + k4);
                u32x2 w; w.x = pk2(yv[0], yv[1]); w.y = pk2(yv[2], yv[3]);
                *(u32x2*)(Yd + (rowb + scan_tok(d, ch * 16 + tB)) * D + h * 64 + k4) = w;
            }
            if (ch + 2 < NCH) SC_PASSB(ch + 2, pbo);
            __builtin_amdgcn_sched_barrier(0);
            if (ch + 1 < NCH) SC_PROD(pbo ^ S4_PBSZ);
            }
            }
            SC_BAR();
        }
#undef SC_LOAD
#undef SC_PASSA
#undef SC_PASSB
#undef SC_PROD
    }
}

__device__ __forceinline__ void phase_sgstats(const Frame& F, int layer) {
    const bf16_t* Z = F.ar<bf16_t>(AR_Z); float* ST = F.ar<float>(AR_ST);
    for (int r0 = (F.bid * NWAVES + F.wave) * 2; r0 < TG; r0 += F.G * NWAVES * 2) {
        u32x4 w[2][4];
#pragma unroll
        for (int h = 0; h < 2; ++h)
#pragma unroll
            for (int q = 0; q < 4; ++q) w[h][q] = *(const u32x4*)(Z + (size_t)(r0 + h) * 4096 + 2048 + q * 512 + F.lane * 8);
#pragma unroll
        for (int h = 0; h < 2; ++h) {
            const int r = r0 + h, t = r % LT; if (t < LC && layer >= 3) continue;
            float x[32];
#pragma unroll
            for (int q = 0; q < 4; ++q) { const u32x4 ww = w[h][q];
                x[q * 8 + 0] = lo16(ww.x); x[q * 8 + 1] = hi16(ww.x); x[q * 8 + 2] = lo16(ww.y); x[q * 8 + 3] = hi16(ww.y); x[q * 8 + 4] = lo16(ww.z); x[q * 8 + 5] = hi16(ww.z); x[q * 8 + 6] = lo16(ww.w); x[q * 8 + 7] = hi16(ww.w); }
            float s = 0.f;
#pragma unroll
            for (int e = 0; e < 32; ++e) s += x[e];
            s = wave_sum_dpp(s); const float mean = s * (1.0f / 2048.0f);
            float qv = 0.f;
#pragma unroll
            for (int e = 0; e < 32; ++e) { const float dd = x[e] - mean; qv += dd * dd; }
            qv = wave_sum_dpp(qv);
            if (F.lane == 0) *(f32x2*)(ST + (size_t)r * 2) = (f32x2){mean, rsqrtf(qv * (1.0f / 2048.0f) + 1e-5f)};
        }
    }
}
__device__ __forceinline__ int vt_off(int dch, int jb) { return dch * 256 + ((jb ^ ((dch & 15) ^ (((dch >> 4) & 7) << 1))) << 4); }
__device__ __forceinline__ void phase_spatial(const Frame& F, int bsg, int layer) {
    const bf16_t* Z = F.ar<bf16_t>(AR_Z); const float* ST = F.ar<float>(AR_ST); bf16_t* Pb = F.ar<bf16_t>(AR_P);
    const bf16_t* Ws = F.wsp<bf16_t>(WS_WSP) + (size_t)bsg * 16 * 128 * 128;
    const float* lng = F.in(31) + (size_t)bsg * 2048; const float* lnb = F.in(32) + (size_t)bsg * 2048; const float* bs = F.in(34) + (size_t)bsg * 16 * 128;
    LAS unsigned char* vt = F.lds;
    const int skip = layer >= 3;
    const int nchunk = skip ? BG * 16 : BG * 18;
    const int w = F.wave, lane = F.lane, dt = w >> 1, it0 = (w & 1) * 2;
    const int jj0 = F.tid >> 4, c8 = (F.tid & 15) * 8;
    u32x4 zz[4]; f32x2 st[4];
#define SP_ROW0(U_) ((size_t)(skip ? (((U_) >> 4) >> 4) * 18 + 2 + (((U_) >> 4) & 15) : ((U_) >> 4)) * 128)
#define SP_LOADZ(U_) do { const size_t r0_ = SP_ROW0(U_); const int gi_ = (U_) & 15; _Pragma("unroll") for (int k = 0; k < 4; ++k) { \
        zz[k] = *(const u32x4*)(Z + (r0_ + jj0 + 32 * k) * 4096 + 2048 + gi_ * 128 + c8); st[k] = *(const f32x2*)(ST + (r0_ + jj0 + 32 * k) * 2); } } while (0)
    if (F.bid < nchunk * 16) SP_LOADZ(F.bid);
    int gic = -1; float gg[8], bb[8], bias[2]; bf16x8 B0[8], B1[8];
#pragma unroll
    for (int e = 0; e < 8; ++e) { gg[e] = 0.f; bb[e] = 0.f; B0[e] = (bf16x8){0, 0, 0, 0, 0, 0, 0, 0}; B1[e] = B0[e]; }
    bias[0] = bias[1] = 0.f;
    for (int U = F.bid; U < nchunk * 16; U += F.G) {
        const int gi = U & 15;
        const size_t row0 = SP_ROW0(U);
        if (gi != gic) {
            gic = gi;
            const f32x4 g0 = *(const f32x4*)(lng + gi * 128 + c8), g1 = *(const f32x4*)(lng + gi * 128 + c8 + 4), b0 = *(const f32x4*)(lnb + gi * 128 + c8), b1 = *(const f32x4*)(lnb + gi * 128 + c8 + 4);
            gg[0] = g0[0]; gg[1] = g0[1]; gg[2] = g0[2]; gg[3] = g0[3]; gg[4] = g1[0]; gg[5] = g1[1]; gg[6] = g1[2]; gg[7] = g1[3];
            bb[0] = b0[0]; bb[1] = b0[1]; bb[2] = b0[2]; bb[3] = b0[3]; bb[4] = b1[0]; bb[5] = b1[1]; bb[6] = b1[2]; bb[7] = b1[3];
            const bf16_t* w0p = Ws + ((size_t)gi * 128 + it0 * 32 + (lane & 31)) * 128 + 8 * (lane >> 5);
#pragma unroll
            for (int s_ = 0; s_ < 8; ++s_) { B0[s_] = *(const bf16x8*)(w0p + 16 * s_); B1[s_] = *(const bf16x8*)(w0p + 32 * 128 + 16 * s_); }
#pragma unroll
            for (int it = 0; it < 2; ++it) bias[it] = bs[gi * 128 + (it0 + it) * 32 + (lane & 31)];
        }
        LDS_BAR();
#pragma unroll
        for (int k = 0; k < 4; ++k) {
            const int jj = jj0 + 32 * k;
            const float xv[8] = {lo16(zz[k].x), hi16(zz[k].x), lo16(zz[k].y), hi16(zz[k].y), lo16(zz[k].z), hi16(zz[k].z), lo16(zz[k].w), hi16(zz[k].w)};
#pragma unroll
            for (int e = 0; e < 8; e += 2) {
                const unsigned pw = pk2((xv[e] - st[k][0]) * st[k][1] * gg[e] + bb[e], (xv[e + 1] - st[k][0]) * st[k][1] * gg[e + 1] + bb[e + 1]);
                *(LAS unsigned short*)(vt + vt_off(c8 + e, jj >> 3) + (jj & 7) * 2) = (unsigned short)(pw & 0xFFFFu);
                *(LAS unsigned short*)(vt + vt_off(c8 + e + 1, jj >> 3) + (jj & 7) * 2) = (unsigned short)(pw >> 16);
            }
        }
        u32x2 uu[2][4];
#pragma unroll
        for (int it = 0; it < 2; ++it) { const int ii = (it0 + it) * 32 + (lane & 31);
#pragma unroll
            for (int rq = 0; rq < 4; ++rq) uu[it][rq] = *(const u32x2*)(Z + (row0 + ii) * 4096 + gi * 128 + dt * 32 + 8 * rq + 4 * (lane >> 5)); }
        if (U + F.G < nchunk * 16) SP_LOADZ(U + F.G);
        LDS_BAR();
        f32x16 acc0, acc1;
#pragma unroll
        for (int e = 0; e < 16; ++e) { acc0[e] = 0.f; acc1[e] = 0.f; }
        const int dA = dt * 32 + (lane & 31);
#pragma unroll
        for (int s_ = 0; s_ < 8; ++s_) {
            const bf16x8 Afr = *(const LAS bf16x8*)(vt + vt_off(dA, 2 * s_ + (lane >> 5)));
            acc0 = __builtin_amdgcn_mfma_f32_32x32x16_bf16(Afr, B0[s_], acc0, 0, 0, 0);
            acc1 = __builtin_amdgcn_mfma_f32_32x32x16_bf16(Afr, B1[s_], acc1, 0, 0, 0);
        }
#pragma unroll
        for (int it = 0; it < 2; ++it) {
            const int ii = (it0 + it) * 32 + (lane & 31); const size_t row = row0 + ii;
#pragma unroll
            for (int rq = 0; rq < 4; ++rq) {
                const int d0 = dt * 32 + 8 * rq + 4 * (lane >> 5);
                float vs[4];
#pragma unroll
                for (int e = 0; e < 4; ++e) vs[e] = (it == 0 ? acc0[rq * 4 + e] : acc1[rq * 4 + e]) + bias[it];
                u32x2 o; o.x = pk2(lo16(uu[it][rq].x) * vs[0], hi16(uu[it][rq].x) * vs[1]); o.y = pk2(lo16(uu[it][rq].y) * vs[2], hi16(uu[it][rq].y) * vs[3]);
                *(u32x2*)(Pb + row * 2048 + gi * 128 + d0) = o;
            }
        }
    }
#undef SP_ROW0
#undef SP_LOADZ
    __syncthreads();
}

__global__ void __launch_bounds__(NTHREADS, 2) fwd_kernel(Params P) {
    extern __shared__ __attribute__((aligned(16))) unsigned char lds_raw[];
    Frame F; F.lds = (LAS unsigned char*)lds_raw; F.tid = threadIdx.x; F.lane = F.tid & 63; F.wave = __builtin_amdgcn_readfirstlane(F.tid >> 6);
    F.G = gridDim.x; F.bid = blockIdx.x; F.ws = P.ws; F.kp = (const Params __attribute__((address_space(4)))*)__builtin_amdgcn_kernarg_segment_ptr();
    const int lo = P.ph_lo, hi = P.ph_hi;
    volatile LAS unsigned* misc = (volatile LAS unsigned*)(F.lds + LDS_MISC);
    if (F.tid < 4) misc[F.tid] = 0u;
    __syncthreads();
    XcdBarrier bar; bar.bar = (unsigned*)(F.ws + WS_CTL); bar.x = 0; bar.st = misc;
    if (hi - lo > 1) bar = xcd_barrier_post((unsigned*)(F.ws + WS_CTL), misc);
    int ph = 0;
#define RUN(id, ...) do { if (ph >= lo && ph < hi) { const int nrep_ = ((REP_MASK >> (id)) & 1u) ? 2 : 1; for (int rep_ = 0; rep_ < nrep_; ++rep_) { const bool dry_ = (rep_ + 1 < nrep_); (void)dry_; { int t_ = threadIdx.x; const Params __attribute__((address_space(4)))* kp_ = (const Params __attribute__((address_space(4)))*)__builtin_amdgcn_kernarg_segment_ptr(); asm volatile("" : "+v"(t_), "+s"(kp_)); F.tid = t_; F.lane = t_ & 63; F.kp = kp_; F.ws = kp_->ws; } __VA_ARGS__; if (rep_ + 1 < nrep_ || ph + 1 < hi) xcd_barrier(bar); } } ++ph; } while (0)

    RUN(0, phase_prologue(F));
    for (int g = 0; g < NG; ++g) {
        for (int layer = 0; layer < 4; ++layer) {
            const int a = layer >> 1;
            if ((layer & 1) == 0) {
                const bf16_t* Vc = layer == 0 ? F.wsp<bf16_t>(WS_VF) : F.ar<bf16_t>(AR_V);
                RUN(1, phase_norm1(F, g, layer, F.ar<bf16_t>(AR_H2), 2048, dry_));
                RUN(2, phase_mix(F, a));
                RUN(3, { { pg8::SchedPlain S; S.init(TG / 256, 2, F.G, F.bid, 0);
                        EpiL1 E{F.ar<bf16_t>(AR_L1)};
                        pg8::gemm_phase(F.tid, F.lds, F.ar<bf16_t>(AR_H2), K1CAT, F.wsp<bf16_t>(WS_WL) + (size_t)a * 512 * K1CAT, K1CAT, K1CAT, S, E); }
                      { int t_ = threadIdx.x; asm volatile("" : "+v"(t_)); F.tid = t_; F.lane = t_ & 63; }
                      { pg8::SchedRKV S; S.init(TG / 256, 12, F.G, (F.bid + 192) % F.G, 0);
                        EpiRKV E{F.ws, layer == 0 ? WS_VF : WS_ARENA + AR_V};
                        pg8::gemm_phase(F.tid, F.lds, F.ar<bf16_t>(AR_XR), D, F.wsp<bf16_t>(WS_WRKV) + (size_t)a * 3072 * D, D, D, S, E); } });
                if (layer == 2) {
                    RUN(4, { pg8::SchedPlain S; S.init(TG / 256, 4, F.G, F.bid, 0);
                          EpiStore<1> E{F.ar<bf16_t>(AR_VGATE), F.in(19)};
                          pg8::gemm_phase(F.tid, F.lds, F.ar<bf16_t>(AR_L1) + 256, 512, F.wsp<bf16_t>(WS_V2T), 256, 256, S, E); });
                    RUN(5, phase_vfix(F));
                }
                RUN(6, phase_scan4(F, a, Vc));
                RUN(7, { pg8::SchedPlain S; S.init(TG / 256, 4, F.G, F.bid, 0);
                      EpiStore<0> E{F.ar<bf16_t>(AR_G), nullptr};
                      pg8::gemm_phase(F.tid, F.lds, F.ar<bf16_t>(AR_L1) + 256, 512, F.wsp<bf16_t>(WS_G2T) + (size_t)a * D * 256, 256, 256, S, E); });
                RUN(8, phase_post(F, a, Vc));
                RUN(9, { const int skip = layer == 2; pg8::SchedPlain S; S.init(skip ? BG * 8 : TG / 256, 4, F.G, F.bid, skip);
                      EpiStore<0> E{F.ar<bf16_t>(AR_O), nullptr};
                      pg8::gemm_phase(F.tid, F.lds, F.ar<bf16_t>(AR_R), D, F.wsp<bf16_t>(WS_WO) + (size_t)a * D * D, D, D, S, E); });
            } else {
                const int skip = layer == 3;
                RUN(10, phase_norm1(F, g, layer, F.ar<bf16_t>(AR_H), D, dry_));
                RUN(11, { pg8::SchedPlain S; S.init(skip ? BG * 8 : TG / 256, 16, F.G, F.bid, skip);
                      EpiGelu E{F.ar<bf16_t>(AR_Z), F.in(30) + (size_t)a * 4096};
                      pg8::gemm_phase(F.tid, F.lds, F.ar<bf16_t>(AR_H), D, F.wsp<bf16_t>(WS_WIN) + (size_t)a * 4096 * D, D, D, S, E); });
                RUN(12, phase_sgstats(F, layer));
                RUN(13, phase_spatial(F, a, layer));
                RUN(14, { pg8::SchedPlain S; S.init(skip ? BG * 8 : TG / 256, 4, F.G, F.bid, skip);
                      EpiStore<0> E{F.ar<bf16_t>(AR_O), nullptr};
                      pg8::gemm_phase(F.tid, F.lds, F.ar<bf16_t>(AR_P), 2048, F.wsp<bf16_t>(WS_WOUT) + (size_t)a * D * 2048, 2048, 2048, S, E); });
            }
            RUN(15, phase_norm2(F, g, layer, dry_));
            RUN(16, { const int total = moe_tables(F, g, layer);
                  pg8::SchedMoe<true> S{(const LAS int*)(F.lds + LDS_MISC + 64), (const LAS int*)(F.lds + LDS_MISC + 192), F.ar<int>(AR_LIST), F.G, F.bid, total};
                  EpiMG E{F.ar<bf16_t>(AR_HE)};
                  pg8::gemm_phase(F.tid, F.lds, F.ar<bf16_t>(AR_HM), D, F.wsp<bf16_t>(WS_WGU) + (size_t)layer * NEXP * 1024 * D, D, D, S, E); });
            RUN(17, { const int total = moe_tables(F, g, layer);
                  pg8::SchedMoe<false> S{(const LAS int*)(F.lds + LDS_MISC + 64), (const LAS int*)(F.lds + LDS_MISC + 192), F.ar<int>(AR_LIST), F.G, F.bid, total};
                  EpiMD E{F.ar<bf16_t>(AR_YM0), F.ar<int>(AR_LIST), F.ar<float>(AR_LW), (const LAS int*)(F.lds + LDS_MISC + 64)};
                  pg8::gemm_phase(F.tid, F.lds, F.ar<bf16_t>(AR_HE), FEXP, F.wsp<bf16_t>(WS_WD) + (size_t)layer * NEXP * D * FEXP, FEXP, FEXP, S, E); });
        }
        RUN(18, phase_norm1(F, g, 4, nullptr, 0));
    }
#undef RUN
}
constexpr int NPHASES = 1 + NG * (10 + 8 + 12 + 8 + 1);

__global__ void nan_fill(float* out, size_t n) { for (size_t i = (size_t)blockIdx.x * blockDim.x + threadIdx.x; i < n; i += (size_t)gridDim.x * blockDim.x) out[i] = __uint_as_float(0x7FC00000u); }

extern "C" void kernel_launch(void* const* d_in, const int* in_sizes, int n_in, void* d_out, int out_size, void* d_ws, size_t ws_size, hipStream_t stream) {
    static int grid = 0;
    if (grid == 0) {
        int dev = 0, cus = 0, per_cu = 0;
        if (n_in != 42 || ws_size < WS_END || hipGetDevice(&dev) != hipSuccess || hipDeviceGetAttribute(&cus, hipDeviceAttributeMultiprocessorCount, dev) != hipSuccess) {
            fprintf(stderr, "kernel_launch: bad setup (n_in %d, ws %zu need %zu)\n", n_in, ws_size, (size_t)WS_END); grid = -1;
        } else if (hipFuncSetAttribute((const void*)fwd_kernel, hipFuncAttributeMaxDynamicSharedMemorySize, LDS_BYTES) != hipSuccess) { fprintf(stderr, "kernel_launch: hipFuncSetAttribute failed\n"); grid = -1; }
        else {
            if (hipOccupancyMaxActiveBlocksPerMultiprocessor(&per_cu, (const void*)fwd_kernel, NTHREADS, LDS_BYTES) != hipSuccess || per_cu < 1) { fprintf(stderr, "kernel_launch: occupancy query reports %d\n", per_cu); }
            (void)hipGetLastError();
            grid = cus;
        }
    }
    if (grid < 0) { hipLaunchKernelGGL(nan_fill, dim3(1024), dim3(256), 0, stream, (float*)d_out, (size_t)out_size); return; }
    (void)hipMemsetAsync((char*)d_ws + WS_CTL, 0, CTL_BYTES, stream);
    Params p{};
    for (int i = 0; i < 42; ++i) p.in[i] = (const float*)d_in[i];
    p.out = (float*)d_out; p.ws = (unsigned char*)d_ws;
#if PER_PHASE_LAUNCH
    for (int k = 0; k < NPHASES; ++k) { p.ph_lo = k; p.ph_hi = k + 1; hipLaunchKernelGGL(fwd_kernel, dim3(grid), dim3(NTHREADS), LDS_BYTES, stream, p); }
#else
    p.ph_lo = 0; p.ph_hi = NPHASES;
    hipLaunchKernelGGL(fwd_kernel, dim3(grid), dim3(NTHREADS), LDS_BYTES, stream, p);
#endif
}
```

```cpp
#include <hip/hip_runtime.h>
#include <cstdio>
#include <cstdint>

#ifndef REP_MASK
#define REP_MASK 0u
#endif
#ifndef PER_PHASE_LAUNCH
#define PER_PHASE_LAUNCH 0
#endif

#define LAS __attribute__((address_space(3)))
typedef unsigned short bf16_t;
typedef short bf16x8 __attribute__((ext_vector_type(8)));
typedef float f32x4 __attribute__((ext_vector_type(4)));
typedef float f32x2 __attribute__((ext_vector_type(2)));
typedef float f32x16 __attribute__((ext_vector_type(16)));
typedef unsigned u32x4 __attribute__((ext_vector_type(4)));
typedef unsigned u32x2 __attribute__((ext_vector_type(2)));

constexpr int NB = 32, SEQ = 2048, LC = 256, LT = SEQ + LC, D = 1024, NH = 16;
constexpr int NG = 2, BG = NB / NG, TG = BG * LT;
constexpr int NTHREADS = 512, NWAVES = 8;
constexpr int N1CAT = 3584, K1CAT = 2048;
constexpr int NEXP = 16, FEXP = 512;

constexpr size_t al256(size_t x) { return (x + 255) & ~(size_t)255; }
constexpr int XCD_BAR_WORDS_C = 3456;
constexpr size_t WS_CTL = 0;
constexpr size_t CTL_BAR_BYTES = (size_t)XCD_BAR_WORDS_C * 4;
constexpr size_t CTL_CNT_OFF = al256(CTL_BAR_BYTES);
constexpr size_t CTL_BYTES = al256(CTL_CNT_OFF + (size_t)2 * NG * 4 * 32 * 64);
constexpr size_t WS_X = al256(WS_CTL + CTL_BYTES);
constexpr size_t WS_VF = WS_X + (size_t)TG * D * 2;
constexpr size_t WS_MODL = WS_VF + (size_t)TG * D * 2;
constexpr size_t WS_MODC = WS_MODL + (size_t)4 * NB * 6 * D * 4;
constexpr size_t WS_WRKV = al256(WS_MODC + (size_t)4 * 6 * D * 4);
constexpr size_t WS_WL = WS_WRKV + (size_t)2 * 3072 * D * 2;
constexpr size_t WS_WO = WS_WL + (size_t)2 * 512 * K1CAT * 2;
constexpr size_t WS_G2T = WS_WO + (size_t)2 * D * D * 2;
constexpr size_t WS_V2T = WS_G2T + (size_t)2 * D * 256 * 2;
constexpr size_t WS_W2T = WS_V2T + (size_t)D * 256 * 2;
constexpr size_t WS_A2T = WS_W2T + (size_t)4 * D * 64 * 2;
constexpr size_t WS_WIN = WS_A2T + (size_t)4 * D * 64 * 2;
constexpr size_t WS_WOUT = WS_WIN + (size_t)2 * 4096 * D * 2;
constexpr size_t WS_WSP = WS_WOUT + (size_t)2 * D * 2048 * 2;
constexpr size_t WS_WGU = WS_WSP + (size_t)2 * 16 * 128 * 128 * 2;
constexpr size_t WS_WD = WS_WGU + (size_t)4 * NEXP * 1024 * D * 2;
constexpr size_t WS_ARENA = al256(WS_WD + (size_t)4 * NEXP * D * FEXP * 2);
constexpr size_t SZB = (size_t)TG * D * 2;
constexpr size_t AR_H2 = 0;
constexpr size_t AR_Y0 = 0, AR_Y1 = SZB;
constexpr size_t AR_XR = 2 * SZB;
constexpr size_t AR_R = 5 * SZB, AR_K = 6 * SZB, AR_V = 7 * SZB;
constexpr size_t AR_L1 = 8 * SZB;
constexpr size_t AR_DOT = AR_L1 + SZB / 2;
constexpr size_t AR_G = 2 * SZB;
constexpr size_t AR_VGATE = 0;
constexpr size_t AR_O = 3 * SZB;
constexpr size_t AR_H = 0;
constexpr size_t AR_Z = SZB;
constexpr size_t AR_P = 5 * SZB;
constexpr size_t AR_ST = 7 * SZB;
constexpr size_t AR_HM = 0;
constexpr size_t AR_HE = SZB;
constexpr size_t HE_ROWS = (size_t)2 * TG + 32 * 256;
constexpr size_t AR_LIST = al256(AR_HE + HE_ROWS * FEXP * 2);
constexpr size_t AR_LW = AR_LIST + (size_t)32 * TG * 4;
constexpr size_t AR_YM0 = 5 * SZB, AR_YM1 = 6 * SZB;
constexpr size_t ARENA_BYTES = AR_DOT + (size_t)2 * TG * 16 * 4 + 4096;
constexpr size_t WS_END = WS_ARENA + ARENA_BYTES;
static_assert(AR_LW + (size_t)32 * TG * 4 <= AR_O, "moe lists overlap");

constexpr int LDS_STAGE = 131072;
constexpr int LDS_MISC = LDS_STAGE;
constexpr int LDS_BYTES = LDS_STAGE + 1024;

struct Params {
    const float* in[42];
    float* out;
    unsigned char* ws;
    int ph_lo, ph_hi;
};

__device__ __forceinline__ float bf2f(unsigned short b) { return __uint_as_float(((unsigned)b) << 16); }
__device__ __forceinline__ unsigned short f2bf(float f) { unsigned u = __float_as_uint(f); u += 0x7FFFu + ((u >> 16) & 1u); return (unsigned short)(u >> 16); }
typedef __bf16 bf16x2_t __attribute__((ext_vector_type(2)));
__device__ __forceinline__ unsigned pk2(float lo, float hi) { const bf16x2_t v = __builtin_convertvector((f32x2){lo, hi}, bf16x2_t); return __builtin_bit_cast(unsigned, v); }
__device__ __forceinline__ float lo16(unsigned w) { return __uint_as_float(w << 16); }
__device__ __forceinline__ float hi16(unsigned w) { return __uint_as_float(w & 0xFFFF0000u); }
__device__ __forceinline__ float sigmoidf_(float x) { return __builtin_amdgcn_rcpf(1.0f + __expf(-x)); }
__device__ __forceinline__ float tanhf_(float x) { return 1.0f - 2.0f * __builtin_amdgcn_rcpf(__expf(2.0f * x) + 1.0f); }
__device__ __forceinline__ float wave_sum(float v) {
#pragma unroll
    for (int o = 32; o > 0; o >>= 1) v += __shfl_xor(v, o);
    return v;
}
template <int CTRL> __device__ __forceinline__ float dpp_f(float v) {
    return __int_as_float(__builtin_amdgcn_update_dpp(0, __float_as_int(v), CTRL, 0xF, 0xF, true));
}
__device__ __forceinline__ float red8(float v) { v += dpp_f<0xB1>(v); v += dpp_f<0x4E>(v); v += dpp_f<0x141>(v); return v; }
__device__ __forceinline__ float red16(float v) { v = red8(v); v += dpp_f<0x140>(v); return v; }
__device__ __forceinline__ float wave_sum_dpp(float v) {
    v = red16(v);
    const float a = __int_as_float(__builtin_amdgcn_readlane(__float_as_int(v), 0)), b = __int_as_float(__builtin_amdgcn_readlane(__float_as_int(v), 16));
    const float c = __int_as_float(__builtin_amdgcn_readlane(__float_as_int(v), 32)), d = __int_as_float(__builtin_amdgcn_readlane(__float_as_int(v), 48));
    return (a + b) + (c + d);
}
__device__ __forceinline__ float red4(float v) { v += dpp_f<0xB1>(v); v += dpp_f<0x4E>(v); return v; }
__device__ __forceinline__ f32x2 gelu_pk(f32x2 v) {
    const f32x2 av = __builtin_elementwise_abs(v), d = av * 0.2316418882f + 1.0f;
    f32x2 t; t.x = __builtin_amdgcn_rcpf(d.x); t.y = __builtin_amdgcn_rcpf(d.y);
    f32x2 q = t * 0.5307027145f + (-0.7265760135f); q = q * t + 0.7107068705f; q = q * t + (-0.142248368f); q = q * t + 0.127414796f; q = q * t;
    const f32x2 s = (v * v) * (-0.72134752044f);
    f32x2 e; e.x = __builtin_amdgcn_exp2f(s.x); e.y = __builtin_amdgcn_exp2f(s.y);
    const f32x2 m = v * (q * e), r = v - m;
    f32x2 o; o.x = v.x < 0.f ? m.x : r.x; o.y = v.y < 0.f ? m.y : r.y; return o;
}
__device__ __forceinline__ float gelu_f(float v) {
    const float av = fabsf(v), t = __builtin_amdgcn_rcpf(av * 0.2316418882f + 1.0f);
    float q = t * 0.5307027145f + (-0.7265760135f); q = q * t + 0.7107068705f; q = q * t + (-0.142248368f); q = q * t + 0.127414796f; q = q * t;
    const float e = __builtin_amdgcn_exp2f((v * v) * (-0.72134752044f));
    const float m = v * (q * e);
    return v < 0.f ? m : v - m;
}

#define XB_TMO      128
#define XB_XCNT(j)  (256  + 64 * (j))
#define XB_XSUB(j)  (1280 + 64 * (j))
#define XB_XGEN(j)  (2304 + 64 * (j))
#define XB_TOP      3328
#define XB_TOPGEN   3392
#define XCD_BAR_WORDS 3456
#define XB_SPIN_CAP (1u << 22)
static_assert(XCD_BAR_WORDS == XCD_BAR_WORDS_C, "barrier words");
__device__ __forceinline__ unsigned xb_ld(unsigned* p)              { return __hip_atomic_load(p, __ATOMIC_RELAXED, __HIP_MEMORY_SCOPE_AGENT); }
__device__ __forceinline__ unsigned xb_add(unsigned* p, unsigned v) { return __hip_atomic_fetch_add(p, v, __ATOMIC_RELAXED, __HIP_MEMORY_SCOPE_AGENT); }
__device__ __forceinline__ unsigned xb_xcc_id() { return (unsigned)__builtin_amdgcn_s_getreg((3 << 11) | 20) & 0xFu; }
#define XB_SPIN(cond, bar) do { unsigned _sp = 0; while (cond) { __builtin_amdgcn_s_sleep(1); \
    if ((++_sp & 255u) == 0u) { if (xb_ld(&(bar)[XB_TMO])) break; if (_sp > XB_SPIN_CAP) { atomicAdd(&(bar)[XB_TMO], 1u); break; } } } } while (0)
struct XcdBarrier { unsigned* bar; unsigned x; volatile LAS unsigned* st; };
__device__ __forceinline__ XcdBarrier xcd_barrier_post(unsigned* bar, volatile LAS unsigned* st) {
    XcdBarrier b; b.bar = bar; b.x = xb_xcc_id(); b.st = st;
    if (threadIdx.x == 0) (void)xb_add(&bar[XB_XCNT(b.x)], 1u);
    return b;
}
__device__ __forceinline__ void xcd_barrier_complete(unsigned* bar, unsigned x, unsigned& nloc, unsigned& nx) {
    const unsigned G = gridDim.x * gridDim.y * gridDim.z;
    unsigned sum, cnt, mine, sp = 0u;
    for (;;) {
        sum = 0u; cnt = 0u; mine = 0u;
#pragma unroll
        for (unsigned j = 0; j < 16; ++j) { const unsigned c = xb_ld(&bar[XB_XCNT(j)]); sum += c; cnt += (c > 0u) ? 1u : 0u; mine = (j == x) ? c : mine; }
        if (sum == G) break;
        __builtin_amdgcn_s_sleep(1);
        if ((++sp & 255u) == 0u) { if (xb_ld(&bar[XB_TMO])) break; if (sp > XB_SPIN_CAP) { atomicAdd(&bar[XB_TMO], 1u); break; } }
    }
    nloc = mine > 0u ? mine : 1u; nx = cnt > 0u ? cnt : 1u;
}
__device__ __forceinline__ void xcd_barrier(const XcdBarrier& b) {
    asm volatile("s_waitcnt vmcnt(0)" ::: "memory");
    __syncthreads();
    if (threadIdx.x == 0) {
        unsigned* bar = b.bar;
        __builtin_amdgcn_s_waitcnt(0);
        unsigned nloc = b.st[0], nx = b.st[1];
        if (nloc == 0u) { xcd_barrier_complete(bar, b.x, nloc, nx); b.st[0] = nloc; b.st[1] = nx; }
        const unsigned old = xb_add(&bar[XB_XSUB(b.x)], 1u);
        const unsigned gen = old / nloc;
        if (old + 1u == (gen + 1u) * nloc) {
            __builtin_amdgcn_fence(__ATOMIC_RELEASE, "agent");
            asm volatile("s_waitcnt vmcnt(0)" ::: "memory");
            const unsigned og = xb_add(&bar[XB_TOP], 1u);
            const unsigned tg = og / nx;
            if (og + 1u == (tg + 1u) * nx) xb_add(&bar[XB_TOPGEN], 1u);
            else XB_SPIN(xb_ld(&bar[XB_TOPGEN]) == tg, bar);
            __builtin_amdgcn_fence(__ATOMIC_ACQUIRE, "agent");
            xb_add(&bar[XB_XGEN(b.x)], 1u);
            asm volatile("s_waitcnt vmcnt(0)" ::: "memory");
        } else {
            XB_SPIN(xb_ld(&bar[XB_XGEN(b.x)]) == gen, bar);
            __builtin_amdgcn_fence(__ATOMIC_ACQUIRE, "agent");
            asm volatile("s_waitcnt vmcnt(0)" ::: "memory");
        }
    }
    __syncthreads();
}

#define LDS_BAR() asm volatile("s_waitcnt lgkmcnt(0)\n\ts_barrier" ::: "memory")
namespace pg8 {
constexpr int BM = 256, BK = 64, HALF = 128, HTB = HALF * BK * 2, STAGE_BYTES = 8 * HTB, NXCD = 8, WGM = 8;
__host__ __device__ __forceinline__ int lds_byte(int r, int c) { const int st = (r >> 4) * 2 + (c >> 5), rr = r & 15, cc = c & 31, ob = rr * 64 + cc * 2; return st * 1024 + (ob ^ (((ob >> 9) & 1) << 5)); }
__host__ __device__ __forceinline__ void stage_rc(int b, int& R, int& C) { const int st = b / 1024, sb = b % 1024, swz = sb ^ (((sb >> 9) & 1) << 5); R = (st >> 1) * 16 + swz / 64; C = (st & 1) * 32 + (swz % 64) / 2; }
__host__ __device__ __forceinline__ int perm32(int rho) { const int n = rho >> 4, i = rho & 15; return 8 * (i >> 2) + 4 * n + (i & 3); }
struct Unit { int pm, pn, aux; };

struct SchedPlain {
    static constexpr bool GATHER = false;
    int nM, nN, nwg, G, c, skipctx;
    __device__ void init(int nM_, int nN_, int G_, int c_, int skipctx_) { nM = nM_; nN = nN_; nwg = nM * nN; G = G_; c = c_; skipctx = skipctx_; }
    __device__ bool next(int i, Unit& u) const {
        const long L = (long)i * G + c; if (L >= nwg) return false;
        int wgid = (int)L; { const int q = nwg / NXCD, r = nwg % NXCD, xcd = wgid % NXCD, off = wgid / NXCD; wgid = (xcd < r ? xcd * (q + 1) : r * (q + 1) + (xcd - r) * q) + off; }
        const int nig = WGM * nN, gid = wgid / nig, fm = gid * WGM, gsz = (nM - fm) < WGM ? (nM - fm) : WGM;
        int pm = fm + ((wgid % nig) % gsz); u.pn = (wgid % nig) / gsz; u.aux = 0;
        if (skipctx) pm = (pm >> 3) * 9 + 1 + (pm & 7);
        u.pm = pm; return true;
    }
    __device__ __forceinline__ int arow(const Unit& u, int r) const { return u.pm * BM + r; }
};
struct SchedRKV : SchedPlain {
    __device__ bool next(int i, Unit& u) const { if (!SchedPlain::next(i, u)) return false; u.pm += (u.pn >> 2) * nM; return true; }
};
template <bool GATH> struct SchedMoe {
    static constexpr bool GATHER = GATH;
    const LAS int* cn; const LAS int* tb; const int* lists; int G, c, total;
    __device__ bool next(int i, Unit& u) const {
        const int U = i * G + c; if (U >= total * 4) return false;
        const int T = U >> 2, pn = U & 3; int l = 0;
        while (tb[l + 1] <= T) ++l;
        u.pm = T; u.pn = (l >> 1) * 4 + pn; u.aux = l | ((T - tb[l]) << 8); return true;
    }
    __device__ __forceinline__ int arow(const Unit& u, int r) const {
        if (!GATH) return u.pm * BM + r;
        const int l = u.aux & 255, idx = (u.aux >> 8) * BM + r;
        return idx < cn[l] ? lists[(size_t)l * TG + idx] : 0;
    }
};

template <class Epi, class Sched>
__device__ __forceinline__ void gemm_phase(const int tid, LAS unsigned char* lds, const bf16_t* A, int lda, const bf16_t* Bt, int ldb, int K, const Sched& S, const Epi& E) {
    constexpr bool GA = Sched::GATHER;
    const int wid = __builtin_amdgcn_readfirstlane(tid >> 6), lane = tid & 63, wr = wid >> 2, wc = wid & 3, fr = lane & 15, fq = lane >> 4;
    const int nt = K / BK;
    unsigned voffA[2], voffB[2];
#pragma unroll
    for (int i = 0; i < 2; ++i) { int R, C; stage_rc(tid * 16 + i * 8192, R, C); const int Rb = (R & ~31) + perm32(R & 31);
        voffA[i] = (unsigned)(R * lda + C) * 2u; voffB[i] = (unsigned)(Rb * ldb + C) * 2u; }
    const size_t kstep = (size_t)(BK * 2);
    const size_t hstepA = (size_t)HALF * lda * 2, tstepA = 2 * hstepA;
    const size_t hstepB = (size_t)HALF * ldb * 2, tstepB = 2 * hstepB;
    const unsigned ldsw = (unsigned)wid * 1024u;
    const int aoff = lds_byte(wr * 64 + fr, fq * 8), boff = lds_byte(wc * 32 + fr, fq * 8);
#define PG8_SA(b, h) (((b) * 2 + (h)) * HTB)
#define PG8_SB(b, h) ((4 + (b) * 2 + (h)) * HTB)
#define PG8_STAGE(bufoff, gbase, voff) do { _Pragma("unroll") for (int _i = 0; _i < 2; ++_i) \
        __builtin_amdgcn_global_load_lds((const unsigned*)((const char*)(gbase) + (voff)[_i]), (LAS unsigned*)(lds + (bufoff) + ldsw + _i * 8192), 16, 0, 0); } while (0)
#define PG8_STAGE_A(bufoff, ub, gv, h, koff) do { if constexpr (GA) { PG8_STAGE(bufoff, (const char*)A + (koff), gv[h]); } else { PG8_STAGE(bufoff, (ub) + (h) * hstepA + (koff), voffA); } } while (0)
#define PG8_LDA(dst, b, h) do { _Pragma("unroll") for (int m = 0; m < 4; ++m) _Pragma("unroll") for (int k = 0; k < 2; ++k) dst[m][k] = *(const LAS bf16x8*)(lds + PG8_SA(b, h) + aoff + m * 2048 + k * 1024); } while (0)
#define PG8_LDB(dst, b, h) do { _Pragma("unroll") for (int n = 0; n < 2; ++n) _Pragma("unroll") for (int k = 0; k < 2; ++k) dst[n][k] = *(const LAS bf16x8*)(lds + PG8_SB(b, h) + boff + n * 2048 + k * 1024); } while (0)
#define PG8_MMA(ai, bj, At, Bt_) do { __builtin_amdgcn_s_setprio(1); _Pragma("unroll") for (int m = 0; m < 4; ++m) _Pragma("unroll") for (int n = 0; n < 2; ++n) _Pragma("unroll") for (int k = 0; k < 2; ++k) \
        acc[ai][bj][m][n] = __builtin_amdgcn_mfma_f32_16x16x32_bf16(Bt_[n][k], At[m][k], acc[ai][bj][m][n], 0, 0, 0); __builtin_amdgcn_s_setprio(0); } while (0)
#define PG8_WAIT_V(n) asm volatile("s_waitcnt vmcnt(" #n ")" ::: "memory")
#define PG8_WAIT_L(n) asm volatile("s_waitcnt lgkmcnt(" #n ")" ::: "memory")
#define PG8_BAR __builtin_amdgcn_s_barrier()
#define PG8_SCHED __builtin_amdgcn_sched_barrier(0)
#define PG8_GOFF(dst, u) do { if constexpr (GA) { _Pragma("unroll") for (int _h = 0; _h < 2; ++_h) _Pragma("unroll") for (int _i = 0; _i < 2; ++_i) { int R_, C_; stage_rc(tid * 16 + _i * 8192, R_, C_); \
        dst[_h][_i] = ((unsigned)S.arow(u, _h * HALF + R_) * (unsigned)lda + (unsigned)C_) * 2u; } } } while (0)
    Unit cur, nxt; int ui = 0;
    if (!S.next(0, cur)) return;
    f32x4 acc[2][2][4][2];
#pragma unroll
    for (int a = 0; a < 2; ++a)
#pragma unroll
        for (int b = 0; b < 2; ++b)
#pragma unroll
            for (int m = 0; m < 4; ++m)
#pragma unroll
                for (int n = 0; n < 2; ++n) acc[a][b][m][n] = (f32x4){0.f, 0.f, 0.f, 0.f};
    bf16x8 At[4][2], B0[2][2], B1[2][2];
    unsigned gAc[2][2], gAn[2][2];
    PG8_GOFF(gAc, cur);
    const char* cA = (const char*)A + (GA ? (size_t)0 : (size_t)cur.pm * tstepA);
    const char* cB = (const char*)Bt + (size_t)cur.pn * tstepB;
    PG8_STAGE(PG8_SB(0, 0), cB, voffB); PG8_STAGE_A(PG8_SA(0, 0), cA, gAc, 0, 0); PG8_STAGE(PG8_SB(0, 1), cB + hstepB, voffB); PG8_STAGE_A(PG8_SA(0, 1), cA, gAc, 1, 0);
    if (wr == 1) PG8_BAR;
    PG8_WAIT_V(4); PG8_BAR;
    PG8_STAGE(PG8_SB(1, 0), cB + kstep, voffB); PG8_STAGE_A(PG8_SA(1, 0), cA, gAc, 0, kstep); PG8_STAGE(PG8_SB(1, 1), cB + hstepB + kstep, voffB);
    PG8_WAIT_V(6); PG8_BAR;
    for (;;) {
        const bool has_next = S.next(ui + 1, nxt);
        if (has_next) { PG8_GOFF(gAn, nxt); }
        else if constexpr (GA) {
#pragma unroll
            for (int _h = 0; _h < 2; ++_h)
#pragma unroll
                for (int _i = 0; _i < 2; ++_i) gAn[_h][_i] = gAc[_h][_i];
        }
        const char* nA = (has_next && !GA) ? (const char*)A + (size_t)nxt.pm * tstepA : cA;
        const char* nB = has_next ? (const char*)Bt + (size_t)nxt.pn * tstepB : cB;
#pragma unroll 1
        for (int t = 0; t < nt; t += 2) {
            const bool last = (t == nt - 2);
            const size_t k1 = (size_t)(t + 1) * kstep;
            const size_t k2 = last ? (size_t)0 : (size_t)(t + 2) * kstep, k3 = k2 + kstep;
            const char* a2 = last ? nA : cA; const char* b2 = last ? nB : cB;
            unsigned g2[2][2];
            if constexpr (GA) {
#pragma unroll
                for (int _h = 0; _h < 2; ++_h)
#pragma unroll
                    for (int _i = 0; _i < 2; ++_i) g2[_h][_i] = last ? gAn[_h][_i] : gAc[_h][_i];
            }
            PG8_LDB(B0, 0, 0); PG8_SCHED; PG8_LDA(At, 0, 0); PG8_STAGE_A(PG8_SA(1, 1), cA, gAc, 1, k1);
            PG8_WAIT_L(8); PG8_BAR; PG8_WAIT_L(0); PG8_MMA(0, 0, At, B0); PG8_BAR; PG8_SCHED;
            PG8_LDB(B1, 0, 1); PG8_STAGE(PG8_SB(0, 0), b2 + k2, voffB);
            PG8_BAR; PG8_WAIT_L(0); PG8_MMA(0, 1, At, B1); PG8_BAR;
            PG8_LDA(At, 0, 1); PG8_STAGE_A(PG8_SA(0, 0), a2, g2, 0, k2);
            PG8_BAR; PG8_WAIT_L(0); PG8_MMA(1, 0, At, B0); PG8_BAR; PG8_SCHED;
            PG8_STAGE(PG8_SB(0, 1), b2 + hstepB + k2, voffB);
            PG8_WAIT_V(6); PG8_BAR; PG8_MMA(1, 1, At, B1); PG8_BAR;
            PG8_LDB(B0, 1, 0); PG8_SCHED; PG8_LDA(At, 1, 0); PG8_STAGE_A(PG8_SA(0, 1), a2, g2, 1, k2);
            PG8_WAIT_L(8); PG8_BAR; PG8_WAIT_L(0); PG8_MMA(0, 0, At, B0); PG8_BAR; PG8_SCHED;
            PG8_LDB(B1, 1, 1); PG8_STAGE(PG8_SB(1, 0), b2 + k3, voffB);
            PG8_BAR; PG8_WAIT_L(0); PG8_MMA(0, 1, At, B1); PG8_BAR;
            PG8_LDA(At, 1, 1); PG8_STAGE_A(PG8_SA(1, 0), a2, g2, 0, k3);
            PG8_BAR; PG8_WAIT_L(0); PG8_MMA(1, 0, At, B0); PG8_BAR; PG8_SCHED;
            PG8_STAGE(PG8_SB(1, 1), b2 + hstepB + k3, voffB);
            PG8_WAIT_V(6); PG8_BAR; PG8_MMA(1, 1, At, B1); PG8_BAR;
        }
        { int fr_e = fr, fq_e = fq; asm volatile("" : "+v"(fr_e), "+v"(fq_e)); E(acc, cur, wr, wc, fr_e, fq_e); }
        if (!has_next) break;
#pragma unroll
        for (int a = 0; a < 2; ++a)
#pragma unroll
            for (int b = 0; b < 2; ++b)
#pragma unroll
                for (int m = 0; m < 4; ++m)
#pragma unroll
                    for (int n = 0; n < 2; ++n) acc[a][b][m][n] = (f32x4){0.f, 0.f, 0.f, 0.f};
        cur = nxt; cA = nA; cB = nB; ++ui;
        if constexpr (GA) {
#pragma unroll
            for (int _h = 0; _h < 2; ++_h)
#pragma unroll
                for (int _i = 0; _i < 2; ++_i) gAc[_h][_i] = gAn[_h][_i];
        }
    }
    PG8_WAIT_V(0);
    if (wr == 0) PG8_BAR;
    PG8_BAR;
#undef PG8_SA
#undef PG8_SB
#undef PG8_STAGE
#undef PG8_STAGE_A
#undef PG8_LDA
#undef PG8_LDB
#undef PG8_MMA
#undef PG8_WAIT_V
#undef PG8_WAIT_L
#undef PG8_BAR
#undef PG8_SCHED
#undef PG8_GOFF
}
}
using pg8::Unit;

#define EPI_LOOP_BEGIN \
    _Pragma("unroll") for (int ai = 0; ai < 2; ++ai) _Pragma("unroll") for (int m = 0; m < 4; ++m) { const int trow = ai * 128 + wr * 64 + m * 16 + fr; \
    _Pragma("unroll") for (int bj = 0; bj < 2; ++bj) { const int tcol = bj * 128 + wc * 32 + 8 * fq; const f32x4 v0 = acc[ai][bj][m][0], v1 = acc[ai][bj][m][1];
#define EPI_LOOP_END } asm volatile("" ::: "memory"); }
__device__ __forceinline__ u32x4 pk8(const f32x4 a, const f32x4 b) { return (u32x4){pk2(a[0], a[1]), pk2(a[2], a[3]), pk2(b[0], b[1]), pk2(b[2], b[3])}; }

struct EpiRKV {
    unsigned char* ws; size_t voff;
    __device__ __forceinline__ void operator()(const f32x4 (&acc)[2][2][4][2], const Unit& u, int wr, int wc, int fr, int fq) const {
        const int which = u.pn >> 2; const size_t row0 = (size_t)(u.pm - which * (TG / 256)) * 256;
        const size_t off = which == 0 ? (WS_ARENA + AR_R) : (which == 1 ? (WS_ARENA + AR_K) : voff);
        bf16_t* dst = (bf16_t*)(ws + off); const int cb = (u.pn & 3) * 256;
        EPI_LOOP_BEGIN
            *(u32x4*)(dst + (row0 + trow) * D + cb + tcol) = pk8(v0, v1);
        EPI_LOOP_END
    }
};
struct EpiL1 {
    bf16_t* L1;
    __device__ __forceinline__ void operator()(const f32x4 (&acc)[2][2][4][2], const Unit& u, int wr, int wc, int fr, int fq) const {
        const int pn = u.pn; const size_t row0 = (size_t)u.pm * 256; const int cb = pn * 256;
        EPI_LOOP_BEGIN
            f32x4 o0 = v0, o1 = v1;
            if (pn == 0 && bj == 0) { _Pragma("unroll") for (int e = 0; e < 4; ++e) { o0[e] = tanhf_(v0[e]); o1[e] = tanhf_(v1[e]); } }
            if (pn == 1 && bj == 0) { _Pragma("unroll") for (int e = 0; e < 4; ++e) { o0[e] = sigmoidf_(v0[e]); o1[e] = sigmoidf_(v1[e]); } }
            *(u32x4*)(L1 + (row0 + trow) * 512 + cb + tcol) = pk8(o0, o1);
        EPI_LOOP_END
    }
};
template <int ACT> struct EpiStore {
    bf16_t* O; const float* bias;
    __device__ __forceinline__ void operator()(const f32x4 (&acc)[2][2][4][2], const Unit& u, int wr, int wc, int fr, int fq) const {
        const size_t row0 = (size_t)u.pm * 256; const int cb = u.pn * 256;
        f32x4 bv[2][2];
#pragma unroll
        for (int bj = 0; bj < 2; ++bj)
#pragma unroll
            for (int n = 0; n < 2; ++n) bv[bj][n] = ACT == 1 ? *(const f32x4*)(bias + cb + bj * 128 + wc * 32 + 8 * fq + 4 * n) : (f32x4){0.f, 0.f, 0.f, 0.f};
        EPI_LOOP_BEGIN
            f32x4 o0 = v0, o1 = v1;
            if (ACT == 1) { _Pragma("unroll") for (int e = 0; e < 4; ++e) { o0[e] = sigmoidf_(v0[e] + bv[bj][0][e]); o1[e] = sigmoidf_(v1[e] + bv[bj][1][e]); } }
            *(u32x4*)(O + (row0 + trow) * D + cb + tcol) = pk8(o0, o1);
        EPI_LOOP_END
    }
};
struct EpiGelu {
    bf16_t* Z; const float* bias;
    __device__ __forceinline__ void operator()(const f32x4 (&acc)[2][2][4][2], const Unit& u, int wr, int wc, int fr, int fq) const {
        const size_t row0 = (size_t)u.pm * 256; const int cb = u.pn * 256;
        f32x4 bv[2][2];
#pragma unroll
        for (int bj = 0; bj < 2; ++bj)
#pragma unroll
            for (int n = 0; n < 2; ++n) bv[bj][n] = *(const f32x4*)(bias + cb + bj * 128 + wc * 32 + 8 * fq + 4 * n);
        EPI_LOOP_BEGIN
            const f32x4 b0 = bv[bj][0], b1 = bv[bj][1];
            const f32x2 g0 = gelu_pk((f32x2){v0[0] + b0[0], v0[1] + b0[1]}), g1 = gelu_pk((f32x2){v0[2] + b0[2], v0[3] + b0[3]});
            const f32x2 g2 = gelu_pk((f32x2){v1[0] + b1[0], v1[1] + b1[1]}), g3 = gelu_pk((f32x2){v1[2] + b1[2], v1[3] + b1[3]});
            *(u32x4*)(Z + (row0 + trow) * 4096 + cb + tcol) = (u32x4){pk2(g0.x, g0.y), pk2(g1.x, g1.y), pk2(g2.x, g2.y), pk2(g3.x, g3.y)};
        EPI_LOOP_END
    }
};
struct EpiMG {
    bf16_t* HE;
    __device__ __forceinline__ void operator()(const f32x4 (&acc)[2][2][4][2], const Unit& u, int wr, int wc, int fr, int fq) const {
        const size_t row0 = (size_t)u.pm * 256; const int pnl = u.pn & 3;
#pragma unroll
        for (int ai = 0; ai < 2; ++ai)
#pragma unroll
            for (int m = 0; m < 4; ++m) { const int trow = ai * 128 + wr * 64 + m * 16 + fr;
#pragma unroll
                for (int bj = 0; bj < 2; ++bj) {
                    const f32x4 gt = acc[ai][bj][m][0], up = acc[ai][bj][m][1];
                    const int f = (8 * pnl + 4 * bj + wc) * 16 + 4 * fq;
                    float o[4];
#pragma unroll
                    for (int e = 0; e < 4; ++e) o[e] = gt[e] * sigmoidf_(gt[e]) * up[e];
                    u32x2 w; w.x = pk2(o[0], o[1]); w.y = pk2(o[2], o[3]);
                    *(u32x2*)(HE + (row0 + trow) * FEXP + f) = w;
                } }
    }
};
struct EpiMD {
    bf16_t* Y0; const int* lists; const float* lw; const LAS int* cn;
    __device__ __forceinline__ void operator()(const f32x4 (&acc)[2][2][4][2], const Unit& u, int wr, int wc, int fr, int fq) const {
        const int l = u.aux & 255, t0 = (u.aux >> 8) * 256, cnt = cn[l]; const int cb = (u.pn & 3) * 256;
        bf16_t* Y = Y0 + (size_t)(l & 1) * ((AR_YM1 - AR_YM0) / 2);
        int tok[2][4]; float wgt[2][4];
#pragma unroll
        for (int ai = 0; ai < 2; ++ai)
#pragma unroll
            for (int m = 0; m < 4; ++m) { const int idx = t0 + ai * 128 + wr * 64 + m * 16 + fr; const bool ok = idx < cnt;
                tok[ai][m] = ok ? lists[(size_t)l * TG + idx] : -1; wgt[ai][m] = ok ? lw[(size_t)l * TG + idx] : 0.f; }
#pragma unroll
        for (int ai = 0; ai < 2; ++ai)
#pragma unroll
            for (int m = 0; m < 4; ++m) {
                if (tok[ai][m] >= 0) {
                    const float wg = wgt[ai][m]; bf16_t* yr = Y + (size_t)tok[ai][m] * D + cb;
#pragma unroll
                    for (int bj = 0; bj < 2; ++bj) { const int tcol = bj * 128 + wc * 32 + 8 * fq;
                        *(u32x4*)(yr + tcol) = pk8(acc[ai][bj][m][0] * wg, acc[ai][bj][m][1] * wg); }
                } }
    }
};

struct Frame {
    const Params __attribute__((address_space(4)))* kp; LAS unsigned char* lds; int tid, lane, wave, G, bid;
    unsigned char* ws;
    __device__ __forceinline__ const float* in(int k) const { return kp->in[k]; }
    __device__ __forceinline__ float* outp() const { return kp->out; }
    template <class T> __device__ __forceinline__ T* wsp(size_t off) const { return (T*)(ws + off); }
    template <class T> __device__ __forceinline__ T* ar(size_t off) const { return (T*)(ws + WS_ARENA + off); }
    __device__ __forceinline__ const float* modL(int layer, int b, int j) const { return (const float*)(ws + WS_MODL) + (((size_t)layer * NB + b) * 6 + j) * D; }
    __device__ __forceinline__ const float* modC(int layer, int j) const { return (const float*)(ws + WS_MODC) + ((size_t)layer * 6 + j) * D; }
};

struct TJob { const float* src; bf16_t* dst; const float* ksc; int lds, K, N, ldd, kofs, nofs, inter; };
constexpr int NJOBS = 2 * 21 + 1 + 4 + 4 * NEXP * 3;
__device__ __forceinline__ TJob get_job(const Frame& F, int j) {
    TJob J; J.ksc = nullptr; J.kofs = 0; J.nofs = 0; J.inter = 0; J.K = 0; J.N = 0; J.lds = 0; J.ldd = 0; J.src = nullptr; J.dst = nullptr;
    if (j < 42) {
        const int a = j / 21, q = j % 21;
        if (q < 3) { J.src = F.in(9 + q) + (size_t)a * D * D; J.lds = D; J.K = D; J.N = D; J.dst = F.wsp<bf16_t>(WS_WRKV) + (size_t)a * 3072 * D; J.ldd = D; J.nofs = q * 1024; }
        else if (q < 15) {
            const int half = (q - 3) / 6, w = (q - 3) % 6; const float* mu = F.in(8) + (size_t)a * 6 * D;
            J.dst = F.wsp<bf16_t>(WS_WL) + (size_t)a * 512 * K1CAT; J.ldd = K1CAT; J.kofs = half * 1024; J.K = D; int mi = 0;
            if (w < 2) { J.src = F.in(14) + ((size_t)a * 2 + w) * D * 64; J.lds = 64; J.N = 64; J.nofs = w * 64; mi = 1; }
            else if (w < 4) { const int d = w - 2; J.src = F.in(17) + ((size_t)a * 2 + d) * D * 64; J.lds = 64; J.N = 64; J.nofs = 128 + d * 64; mi = 4; }
            else if (w == 4) { J.src = F.in(22) + (size_t)a * D * 128; J.lds = 128; J.N = 128; J.nofs = 256; mi = 5; }
            else { J.src = F.in(20); J.lds = 32; J.N = (a == 1) ? 32 : 0; J.nofs = 384; mi = 3; }
            if (half) J.ksc = mu + mi * D;
        } else if (q == 15) { J.src = F.in(12) + (size_t)a * D * D; J.lds = D; J.K = D; J.N = D; J.dst = F.wsp<bf16_t>(WS_WO) + (size_t)a * D * D; J.ldd = D; }
        else if (q == 16) { J.src = F.in(23) + (size_t)a * 128 * D; J.lds = D; J.K = 128; J.N = D; J.dst = F.wsp<bf16_t>(WS_G2T) + (size_t)a * D * 256; J.ldd = 256; }
        else if (q < 19) { const int d = q - 17; J.src = F.in(15) + ((size_t)a * 2 + d) * 64 * D; J.lds = D; J.K = 64; J.N = D; J.dst = F.wsp<bf16_t>(WS_W2T) + ((size_t)a * 2 + d) * D * 64; J.ldd = 64; }
        else { const int d = q - 19; J.src = F.in(18) + ((size_t)a * 2 + d) * 64 * D; J.lds = D; J.K = 64; J.N = D; J.dst = F.wsp<bf16_t>(WS_A2T) + ((size_t)a * 2 + d) * D * 64; J.ldd = 64; }
    } else if (j == 42) { J.src = F.in(21); J.lds = D; J.K = 32; J.N = D; J.dst = F.wsp<bf16_t>(WS_V2T); J.ldd = 256; J.kofs = 128; }
    else if (j < 47) {
        const int q = j - 43, b = q >> 1;
        if ((q & 1) == 0) { J.src = F.in(29) + (size_t)b * D * 4096; J.lds = 4096; J.K = D; J.N = 4096; J.dst = F.wsp<bf16_t>(WS_WIN) + (size_t)b * 4096 * D; J.ldd = D; }
        else { J.src = F.in(35) + (size_t)b * 2048 * D; J.lds = D; J.K = 2048; J.N = D; J.dst = F.wsp<bf16_t>(WS_WOUT) + (size_t)b * D * 2048; J.ldd = 2048; }
    } else {
        const int q = j - 47, ie = q / 3, w = q % 3;
        if (w < 2) { J.src = F.in(38 + w) + (size_t)ie * D * FEXP; J.lds = FEXP; J.K = D; J.N = FEXP; J.dst = F.wsp<bf16_t>(WS_WGU) + (size_t)ie * 1024 * D; J.ldd = D; J.nofs = w * 4; J.inter = 1; }
        else { J.src = F.in(40) + (size_t)ie * FEXP * D; J.lds = D; J.K = FEXP; J.N = D; J.dst = F.wsp<bf16_t>(WS_WD) + (size_t)ie * D * FEXP; J.ldd = FEXP; }
    }
    return J;
}
__device__ __forceinline__ void transpose_all(const Frame& F) {
    LAS unsigned* T = (LAS unsigned*)F.lds;
    LAS int* tab = (LAS int*)(F.lds + 32768);
    __syncthreads();
#pragma unroll 1
    for (int jj = F.wave; jj < NJOBS; jj += NWAVES) { const TJob J = get_job(F, jj); LAS int* e = tab + jj * 16;
        e[0] = (int)(unsigned)(size_t)J.src; e[1] = (int)(unsigned)((size_t)J.src >> 32); e[2] = (int)(unsigned)(size_t)J.dst; e[3] = (int)(unsigned)((size_t)J.dst >> 32);
        e[4] = (int)(unsigned)(size_t)J.ksc; e[5] = (int)(unsigned)((size_t)J.ksc >> 32); e[6] = J.lds; e[7] = J.K; e[8] = J.N; e[9] = J.ldd; e[10] = J.kofs; e[11] = J.nofs; e[12] = J.inter;
        const int tn_ = (J.N + 127) / 128; e[13] = ((J.K + 127) / 128) * tn_; e[15] = tn_; }
    __syncthreads();
    for (int jj = F.tid; jj < NJOBS; jj += NTHREADS) { int acc = 0; for (int i = 0; i < jj; ++i) acc += tab[i * 16 + 13]; tab[jj * 16 + 14] = acc; }
    __syncthreads();
#define TJI(j_, f_) __builtin_amdgcn_readfirstlane(tab[(j_) * 16 + (f_)])
#define TJP(T_, j_, f_) ((T_)(size_t)(((unsigned long long)(unsigned)TJI(j_, (f_) + 1) << 32) | (unsigned long long)(unsigned)TJI(j_, f_)))
    int j = 0, t = 0;
#define TR_ENTER() do { t = (F.bid - (TJI(j, 14) % F.G) + F.G) % F.G; } while (0)
#define TR_SKIP() do { while (j < NJOBS && t >= TJI(j, 13)) { ++j; if (j < NJOBS) TR_ENTER(); } } while (0)
#define TR_LOAD() do { const int jl_ = j < NJOBS ? j : NJOBS - 1, tl_ = j < NJOBS ? t : 0; \
        const int tn_ = TJI(jl_, 15), K_ = TJI(jl_, 7), N_ = TJI(jl_, 8), ls_ = TJI(jl_, 6); const float* src_ = TJP(const float*, jl_, 0); \
        const int k0_ = (tl_ / tn_) * 128, n0_ = (tl_ % tn_) * 128; _Pragma("unroll") for (int e = 0; e < 4; ++e) { const int idx = F.tid + e * 512, n4 = idx & 31, kp = idx >> 5; \
        const bool ok_ = (k0_ + 2 * kp < K_) && (n0_ + 4 * n4 < N_); const float* q_ = src_ + (ok_ ? ((size_t)(k0_ + 2 * kp) * ls_ + n0_ + 4 * n4) : (size_t)0); \
        const f32x4 x0_ = *(const f32x4*)q_, x1_ = *(const f32x4*)(q_ + (ok_ ? ls_ : 0)); const f32x4 z_ = (f32x4){0.f, 0.f, 0.f, 0.f}; va[e] = ok_ ? x0_ : z_; vb[e] = ok_ ? x1_ : z_; } } while (0)
    TR_ENTER(); TR_SKIP();
    f32x4 va[4], vb[4];
    TR_LOAD();
#pragma unroll 1
    while (j < NJOBS) {
        const int jc = j, tnc = TJI(jc, 15), Kc = TJI(jc, 7), Nc = TJI(jc, 8), k0 = (t / tnc) * 128, n0 = (t % tnc) * 128;
        const float* ksc = TJP(const float*, jc, 4);
        LDS_BAR();
#pragma unroll
        for (int e = 0; e < 4; ++e) { const int idx = F.tid + e * 512, n4 = idx & 31, kp = idx >> 5;
            float s0 = 1.f, s1 = 1.f; if (ksc && k0 + 2 * kp < Kc) { s0 = ksc[k0 + 2 * kp]; s1 = ksc[k0 + 2 * kp + 1]; }
            LAS unsigned* q = T + (4 * n4) * 64 + (((kp >> 2) ^ (n4 & 15)) << 2) + (kp & 3);
            q[0] = pk2(va[e][0] * s0, vb[e][0] * s1); q[64] = pk2(va[e][1] * s0, vb[e][1] * s1); q[128] = pk2(va[e][2] * s0, vb[e][2] * s1); q[192] = pk2(va[e][3] * s0, vb[e][3] * s1); }
        t += F.G; TR_SKIP();
        TR_LOAD();
        LDS_BAR();
        bf16_t* dst = TJP(bf16_t*, jc, 2); const int ldd = TJI(jc, 9), kofs = TJI(jc, 10), nofs = TJI(jc, 11), inter = TJI(jc, 12);
#pragma unroll
        for (int e = 0; e < 4; ++e) { const int idx = F.tid + e * 512, kg = idx & 15, nn = idx >> 4;
            if (k0 + 8 * kg < Kc && n0 + nn < Nc) { const int n = n0 + nn; const int row = nofs + (inter ? ((n >> 4) * 32 + ((n & 15) >> 2) * 8 + (n & 3)) : n);
                *(u32x4*)(dst + (size_t)row * ldd + kofs + k0 + 8 * kg) = *(const LAS u32x4*)(T + nn * 64 + ((kg ^ ((nn >> 2) & 15)) << 2)); } }
    }
#undef TR_ENTER
#undef TR_SKIP
#undef TR_LOAD
#undef TJI
#undef TJP
    __syncthreads();
}
__device__ __forceinline__ void zero_rows(const Frame& F, bf16_t* dst, int ldd, int row0, int nrows, int col0, int ncols) {
    const int per = ncols / 8; const long tot = (long)nrows * per;
    for (long i = (long)F.bid * NTHREADS + F.tid; i < tot; i += (long)F.G * NTHREADS) { const int r = (int)(i / per), c = (int)(i % per) * 8;
        *(u32x4*)(dst + (size_t)(row0 + r) * ldd + col0 + c) = (u32x4){0u, 0u, 0u, 0u}; }
}
__device__ __forceinline__ void phase_prologue(const Frame& F) {
    {
        LAS float* sl = (LAS float*)F.lds;
        LAS float* red = (LAS float*)(F.lds + 33 * 256 * 4);
        LAS float* cred = red + 8 * 32 * 64;
        const float* c = F.in(1); const float* cc = F.in(3); const float* wm = F.in(4); const float* bm = F.in(5);
        const int wv = F.wave, li = F.lane & 15, kq = F.lane >> 4;
        for (int unit = F.bid; unit < 4 * 96; unit += F.G) {
            const int layer = unit / 96, col0 = (unit % 96) * 64;
            f32x4 acc[2][4]; float cacc[4];
#pragma unroll
            for (int nt = 0; nt < 4; ++nt) { acc[0][nt] = (f32x4){0.f, 0.f, 0.f, 0.f}; acc[1][nt] = acc[0][nt]; cacc[nt] = 0.f; }
#pragma unroll 1
            for (int kc = 0; kc < 4; ++kc) {
                float xs[17];
#pragma unroll
                for (int e = 0; e < 17; ++e) { const int i = F.tid + e * NTHREADS, r = i >> 8, k = (i & 255) + kc * 256; xs[e] = i < 33 * 256 ? (r < 32 ? c[r * D + k] : cc[k]) : 0.f; }
                float w[2][4][4];
#pragma unroll
                for (int gq = 0; gq < 2; ++gq)
#pragma unroll
                    for (int st = 0; st < 4; ++st)
#pragma unroll
                        for (int nt = 0; nt < 4; ++nt) w[gq][st][nt] = wm[((size_t)layer * D + kc * 256 + wv * 32 + 16 * gq + 4 * kq + st) * 6144 + col0 + 16 * nt + li];
                LDS_BAR();
#pragma unroll
                for (int e = 0; e < 17; ++e) { const int i = F.tid + e * NTHREADS; if (i < 33 * 256) sl[i] = xs[e] * sigmoidf_(xs[e]); }
                LDS_BAR();
#pragma unroll
                for (int gq = 0; gq < 2; ++gq) {
                    const int kl = wv * 32 + 16 * gq + 4 * kq;
                    const f32x4 a0 = *(const LAS f32x4*)(sl + li * 256 + kl), a1 = *(const LAS f32x4*)(sl + (16 + li) * 256 + kl), ac = *(const LAS f32x4*)(sl + 32 * 256 + kl);
#pragma unroll
                    for (int st = 0; st < 4; ++st)
#pragma unroll
                        for (int nt = 0; nt < 4; ++nt) {
                            acc[0][nt] = __builtin_amdgcn_mfma_f32_16x16x4f32(a0[st], w[gq][st][nt], acc[0][nt], 0, 0, 0);
                            acc[1][nt] = __builtin_amdgcn_mfma_f32_16x16x4f32(a1[st], w[gq][st][nt], acc[1][nt], 0, 0, 0);
                            cacc[nt] = __builtin_fmaf(ac[st], w[gq][st][nt], cacc[nt]);
                        }
                }
            }
            LDS_BAR();
#pragma unroll
            for (int mt = 0; mt < 2; ++mt)
#pragma unroll
                for (int nt = 0; nt < 4; ++nt)
#pragma unroll
                    for (int r = 0; r < 4; ++r) red[(wv * 32 + mt * 16 + 4 * kq + r) * 64 + 16 * nt + li] = acc[mt][nt][r];
#pragma unroll
            for (int nt = 0; nt < 4; ++nt) cred[(wv * 4 + kq) * 64 + 16 * nt + li] = cacc[nt];
            LDS_BAR();
            for (int i = F.tid; i < 33 * 64; i += NTHREADS) { const int r = i >> 6, x = i & 63; float s = 0.f;
                if (r < 32) {
#pragma unroll
                    for (int y = 0; y < 8; ++y) s += red[(y * 32 + r) * 64 + x];
                } else {
#pragma unroll
                    for (int y = 0; y < 32; ++y) s += cred[y * 64 + x];
                }
                const int col = col0 + x; s += bm[layer * 6144 + col];
                if (r < 32) F.wsp<float>(WS_MODL)[((size_t)layer * NB + r) * 6144 + col] = s; else F.wsp<float>(WS_MODC)[(size_t)layer * 6144 + col] = s; }
        }
    }
    __syncthreads();
    transpose_all(F);
    for (int a = 0; a < 2; ++a) {
        bf16_t* WLp = F.wsp<bf16_t>(WS_WL) + (size_t)a * 512 * K1CAT;
        if (a == 0) zero_rows(F, WLp, K1CAT, 384, 128, 0, K1CAT); else zero_rows(F, WLp, K1CAT, 416, 96, 0, K1CAT);
        zero_rows(F, F.wsp<bf16_t>(WS_G2T) + (size_t)a * D * 256, 256, 0, D, 128, 128);
    }
    zero_rows(F, F.wsp<bf16_t>(WS_V2T), 256, 0, D, 0, 128); zero_rows(F, F.wsp<bf16_t>(WS_V2T), 256, 0, D, 160, 96);
    {
        const float* src = F.in(33); bf16_t* dst = F.wsp<bf16_t>(WS_WSP); const long tot = (long)2 * 16 * 128 * 128 / 4;
        for (long i = (long)F.bid * NTHREADS + F.tid; i < tot; i += (long)F.G * NTHREADS) { const f32x4 v = *(const f32x4*)(src + i * 4); u32x2 w; w.x = pk2(v[0], v[1]); w.y = pk2(v[2], v[3]); *(u32x2*)(dst + i * 4) = w; }
    }
    __syncthreads();
}

__device__ __forceinline__ void phase_norm1(const Frame& F, int g, int layer  , bf16_t* dst, int ldh, bool dry = false) {
    bf16_t* X = F.wsp<bf16_t>(WS_X);
    const bf16_t* Y0 = F.ar<bf16_t>(AR_YM0); const bf16_t* Y1 = F.ar<bf16_t>(AR_YM1);
    const bool fin = layer == 4;
    const int rpb = (TG + F.G - 1) / F.G, rbeg = F.bid * rpb, rend = (rbeg + rpb) < TG ? (rbeg + rpb) : TG;
    int key = -1; f32x4 cg[4], cA[4], cB[4];
#pragma unroll
    for (int q = 0; q < 4; ++q) { cg[q] = (f32x4){0.f, 0.f, 0.f, 0.f}; cA[q] = cg[q]; cB[q] = cg[q]; }
    f32x4 nf[4]; u32x2 nxw[4], na[4], nb[4];
#pragma unroll
    for (int q = 0; q < 4; ++q) { nf[q] = (f32x4){0.f, 0.f, 0.f, 0.f}; nxw[q] = (u32x2){0u, 0u}; na[q] = nxw[q]; nb[q] = nxw[q]; }
#define N1_FETCH(rr_) do { const int rq_ = (rr_) < rend ? (rr_) : rbeg; \
        if (layer == 0) { const int bl_ = rq_ / LT, t_ = rq_ % LT, b_ = g * BG + bl_; \
            const float* src_ = t_ < LC ? F.in(2) + ((size_t)b_ * LC + t_) * D : F.in(0) + ((size_t)b_ * SEQ + (t_ - LC)) * D; \
            _Pragma("unroll") for (int q = 0; q < 4; ++q) nf[q] = *(const f32x4*)(src_ + q * 256 + F.lane * 4); } \
        else { _Pragma("unroll") for (int q = 0; q < 4; ++q) { const int c = q * 256 + F.lane * 4; \
            nxw[q] = *(const u32x2*)(X + (size_t)rq_ * D + c); na[q] = *(const u32x2*)(Y0 + (size_t)rq_ * D + c); nb[q] = *(const u32x2*)(Y1 + (size_t)rq_ * D + c); } } } while (0)
    N1_FETCH(rbeg + F.wave);
    for (int r = rbeg + F.wave; r < rend; r += NWAVES) {
        const int bl = r / LT, t = r % LT, b = g * BG + bl; const bool isctx = t < LC;
        f32x4 cf[4]; u32x2 cxw[4], ca[4], cb2[4];
#pragma unroll
        for (int q = 0; q < 4; ++q) { cf[q] = nf[q]; cxw[q] = nxw[q]; ca[q] = na[q]; cb2[q] = nb[q]; }
        N1_FETCH(r + NWAVES);
        if (isctx && layer >= 3) continue;
        if (key != b * 2 + (int)isctx) {
            key = b * 2 + (int)isctx;
#pragma unroll
            for (int q = 0; q < 4; ++q) { const int c = q * 256 + F.lane * 4;
                if (layer > 0) cg[q] = *(const f32x4*)((isctx ? F.modC(layer - 1, 5) : F.modL(layer - 1, b, 5)) + c);
                if (fin) cA[q] = *(const f32x4*)(F.in(41) + c);
                else { const f32x4 gv = *(const f32x4*)(F.in(6) + (size_t)layer * D + c), cv = *(const f32x4*)((isctx ? F.modC(layer, 1) : F.modL(layer, b, 1)) + c);
                    cA[q] = gv * (1.0f + cv); cB[q] = *(const f32x4*)((isctx ? F.modC(layer, 0) : F.modL(layer, b, 0)) + c); } }
        }
        f32x4 x[4], xo[4];
#pragma unroll
        for (int q = 0; q < 4; ++q) xo[q] = (f32x4){0.f, 0.f, 0.f, 0.f};
        if (layer == 0) {
#pragma unroll
            for (int q = 0; q < 4; ++q) x[q] = cf[q];
        } else {
#pragma unroll
            for (int q = 0; q < 4; ++q) {
                { const u32x2 xw = cxw[q]; x[q] = (f32x4){lo16(xw.x), hi16(xw.x), lo16(xw.y), hi16(xw.y)}; } xo[q] = x[q];
                const u32x2 a = ca[q], bb = cb2[q];
                x[q][0] += cg[q][0] * (lo16(a.x) + lo16(bb.x)); x[q][1] += cg[q][1] * (hi16(a.x) + hi16(bb.x));
                x[q][2] += cg[q][2] * (lo16(a.y) + lo16(bb.y)); x[q][3] += cg[q][3] * (hi16(a.y) + hi16(bb.y)); }
        }
        float ss = 0.f;
#pragma unroll
        for (int q = 0; q < 4; ++q) ss += x[q][0] * x[q][0] + x[q][1] * x[q][1] + x[q][2] * x[q][2] + x[q][3] * x[q][3];
        ss = wave_sum_dpp(ss);
        const float rstd = rsqrtf(ss * (1.0f / D) + 1e-6f);
        if (fin) {
            float* o = F.outp() + ((size_t)b * SEQ + (t - LC)) * D;
#pragma unroll
            for (int q = 0; q < 4; ++q) { const int c = q * 256 + F.lane * 4; *(f32x4*)(o + c) = x[q] * rstd * cA[q]; }
        } else {
#pragma unroll
            for (int q = 0; q < 4; ++q) { const int c = q * 256 + F.lane * 4;
                { const f32x4 xs = (dry && layer > 0) ? xo[q] : x[q]; u32x2 xw; xw.x = pk2(xs[0], xs[1]); xw.y = pk2(xs[2], xs[3]); *(u32x2*)(X + (size_t)r * D + c) = xw; }
                const f32x4 h = x[q] * rstd * cA[q] + cB[q];
                u32x2 w; w.x = pk2(h[0], h[1]); w.y = pk2(h[2], h[3]);
                *(u32x2*)(dst + (size_t)r * ldh + c) = w; }
        }
    }
}
#undef N1_FETCH
__device__ __forceinline__ void phase_mix(const Frame& F, int a) {
    bf16_t* H2 = F.ar<bf16_t>(AR_H2); bf16_t* XM = F.ar<bf16_t>(AR_XR);
    const float* mu = F.in(8) + (size_t)a * 6 * D;
    f32x4 cm[2][3][2];
#pragma unroll
    for (int q = 0; q < 2; ++q)
#pragma unroll
        for (int m = 0; m < 3; ++m) { const int mi = m == 0 ? 0 : (m == 1 ? 2 : 3); const int c = q * 512 + F.lane * 8;
            cm[q][m][0] = *(const f32x4*)(mu + mi * D + c); cm[q][m][1] = *(const f32x4*)(mu + mi * D + c + 4); }
    const int rpb = (TG + F.G - 1) / F.G, rbeg = F.bid * rpb, rend = (rbeg + rpb) < TG ? (rbeg + rpb) : TG;
    u32x4 nhs[2], nhn[2];
#define MIX_FETCH(rr_) do { const int rq_ = (rr_) < rend ? (rr_) : rbeg; const int t_ = rq_ % LT; const bool ic_ = t_ < LC; const int p_ = t_ - LC; \
        _Pragma("unroll") for (int q = 0; q < 2; ++q) { const int c = q * 512 + F.lane * 8; int nr; \
            if (ic_) nr = (q == 0) ? (t_ > 0 ? rq_ - 1 : -1) : (t_ < LC - 1 ? rq_ + 1 : -1); \
            else { const int qu = c >> 8; \
                nr = qu == 0 ? ((p_ & 63) > 0 ? rq_ - 1 : -1) : qu == 1 ? ((p_ & 63) < 63 ? rq_ + 1 : -1) : qu == 2 ? (p_ >= 64 ? rq_ - 64 : -1) : (p_ < SEQ - 64 ? rq_ + 64 : -1); } \
            nhs[q] = *(const u32x4*)(H2 + (size_t)rq_ * 2048 + c); \
            const u32x4 hv_ = *(const u32x4*)(H2 + (size_t)(nr >= 0 ? nr : rq_) * 2048 + c); nhn[q] = nr >= 0 ? hv_ : (u32x4){0u, 0u, 0u, 0u}; } } while (0)
    MIX_FETCH(rbeg + F.wave);
    for (int r = rbeg + F.wave; r < rend; r += NWAVES) {
        u32x4 chs[2], chn[2];
#pragma unroll
        for (int q = 0; q < 2; ++q) { chs[q] = nhs[q]; chn[q] = nhn[q]; }
        MIX_FETCH(r + NWAVES);
#pragma unroll
        for (int q = 0; q < 2; ++q) {
            const int c = q * 512 + F.lane * 8;
            const u32x4 hs = chs[q];
            const u32x4 hn = chn[q];
            const float h[8] = {lo16(hs.x), hi16(hs.x), lo16(hs.y), hi16(hs.y), lo16(hs.z), hi16(hs.z), lo16(hs.w), hi16(hs.w)};
            const float n[8] = {lo16(hn.x), hi16(hn.x), lo16(hn.y), hi16(hn.y), lo16(hn.z), hi16(hn.z), lo16(hn.w), hi16(hn.w)};
            float dd[8];
#pragma unroll
            for (int e = 0; e < 8; ++e) dd[e] = n[e] - h[e];
            *(u32x4*)(H2 + (size_t)r * 2048 + 1024 + c) = (u32x4){pk2(dd[0], dd[1]), pk2(dd[2], dd[3]), pk2(dd[4], dd[5]), pk2(dd[6], dd[7])};
#pragma unroll
            for (int m = 0; m < 3; ++m) {
                const f32x4 m0 = cm[q][m][0], m1 = cm[q][m][1];
                float x[8];
#pragma unroll
                for (int e = 0; e < 4; ++e) { x[e] = h[e] + dd[e] * m0[e]; x[4 + e] = h[4 + e] + dd[4 + e] * m1[e]; }
                *(u32x4*)(XM + (size_t)m * TG * D + (size_t)r * D + c) = (u32x4){pk2(x[0], x[1]), pk2(x[2], x[3]), pk2(x[4], x[5]), pk2(x[6], x[7])};
            }
        }
    }
}
#undef MIX_FETCH
__device__ __forceinline__ void phase_vfix(const Frame& F) {
    bf16_t* V = F.ar<bf16_t>(AR_V); const bf16_t* VF = F.wsp<bf16_t>(WS_VF); const bf16_t* GT = F.ar<bf16_t>(AR_VGATE);
    const size_t tot = (size_t)TG * D / 8;
    for (size_t i = (size_t)F.bid * NTHREADS + F.tid; i < tot; i += (size_t)F.G * NTHREADS) {
        const u32x4 v = *(const u32x4*)(V + i * 8), f = *(const u32x4*)(VF + i * 8), g = *(const u32x4*)(GT + i * 8);
        u32x4 o;
        o.x = pk2(lo16(v.x) + (lo16(f.x) - lo16(v.x)) * lo16(g.x), hi16(v.x) + (hi16(f.x) - hi16(v.x)) * hi16(g.x));
        o.y = pk2(lo16(v.y) + (lo16(f.y) - lo16(v.y)) * lo16(g.y), hi16(v.y) + (hi16(f.y) - hi16(v.y)) * hi16(g.y));
        o.z = pk2(lo16(v.z) + (lo16(f.z) - lo16(v.z)) * lo16(g.z), hi16(v.z) + (hi16(f.z) - hi16(v.z)) * hi16(g.z));
        o.w = pk2(lo16(v.w) + (lo16(f.w) - lo16(v.w)) * lo16(g.w), hi16(v.w) + (hi16(f.w) - hi16(v.w)) * hi16(g.w));
        *(u32x4*)(V + i * 8) = o;
    }
}
__device__ __forceinline__ void phase_post(const Frame& F, int a, const bf16_t* V) {
    const bf16_t* Y0 = F.ar<bf16_t>(AR_Y0); bf16_t* YG = F.ar<bf16_t>(AR_R); const bf16_t* Y1 = F.ar<bf16_t>(AR_Y1); const float* DOT = F.ar<float>(AR_DOT); const bf16_t* Gb = F.ar<bf16_t>(AR_G);
    const float* lgp = F.in(27) + (size_t)a * D + F.lane * 16; const float* lbp = F.in(28) + (size_t)a * D + F.lane * 16;
    float lg[16], lb[16];
#pragma unroll
    for (int e = 0; e < 16; e += 4) { const f32x4 gq = *(const f32x4*)(lgp + e), bq = *(const f32x4*)(lbp + e);
        lg[e] = gq[0]; lg[e + 1] = gq[1]; lg[e + 2] = gq[2]; lg[e + 3] = gq[3]; lb[e] = bq[0]; lb[e + 1] = bq[1]; lb[e + 2] = bq[2]; lb[e + 3] = bq[3]; }
    const int rpb = (TG + F.G - 1) / F.G, rbeg = F.bid * rpb, rend = (rbeg + rpb) < TG ? (rbeg + rpb) : TG;
    u32x4 ny0[2], ny1[2], nv[2], ng[2]; float nd0, nd1;
#define POST_FETCH(rr_) do { const int rq_ = (rr_) < rend ? (rr_) : rbeg; const int c_ = F.lane * 16; \
        _Pragma("unroll") for (int q = 0; q < 2; ++q) { ny0[q] = *(const u32x4*)(Y0 + (size_t)rq_ * D + c_ + q * 8); ny1[q] = *(const u32x4*)(Y1 + (size_t)rq_ * D + c_ + q * 8); \
            nv[q] = *(const u32x4*)(V + (size_t)rq_ * D + c_ + q * 8); ng[q] = *(const u32x4*)(Gb + (size_t)rq_ * D + c_ + q * 8); } \
        nd0 = DOT[(size_t)rq_ * NH + (F.lane >> 2)]; nd1 = DOT[((size_t)TG + rq_) * NH + (F.lane >> 2)]; } while (0)
    POST_FETCH(rbeg + F.wave);
    for (int r = rbeg + F.wave; r < rend; r += NWAVES) {
        const int c = F.lane * 16;
        float y[16], vv[16];
        u32x4 cy0[2], cy1[2], cv[2], cgq[2];
#pragma unroll
        for (int q = 0; q < 2; ++q) { cy0[q] = ny0[q]; cy1[q] = ny1[q]; cv[q] = nv[q]; cgq[q] = ng[q]; }
        const float dsum = nd0 + nd1;
        POST_FETCH(r + NWAVES);
#pragma unroll
        for (int q = 0; q < 2; ++q) {
            const u32x4 a0 = cy0[q], a1 = cy1[q], v4 = cv[q];
            y[q * 8 + 0] = lo16(a0.x) + lo16(a1.x); y[q * 8 + 1] = hi16(a0.x) + hi16(a1.x); y[q * 8 + 2] = lo16(a0.y) + lo16(a1.y); y[q * 8 + 3] = hi16(a0.y) + hi16(a1.y);
            y[q * 8 + 4] = lo16(a0.z) + lo16(a1.z); y[q * 8 + 5] = hi16(a0.z) + hi16(a1.z); y[q * 8 + 6] = lo16(a0.w) + lo16(a1.w); y[q * 8 + 7] = hi16(a0.w) + hi16(a1.w);
            vv[q * 8 + 0] = lo16(v4.x); vv[q * 8 + 1] = hi16(v4.x); vv[q * 8 + 2] = lo16(v4.y); vv[q * 8 + 3] = hi16(v4.y);
            vv[q * 8 + 4] = lo16(v4.z); vv[q * 8 + 5] = hi16(v4.z); vv[q * 8 + 6] = lo16(v4.w); vv[q * 8 + 7] = hi16(v4.w);
        }
        float s = 0.f;
#pragma unroll
        for (int e = 0; e < 16; ++e) s += y[e];
        s = red4(s); const float mean = s * (1.0f / 64.0f);
        float qv = 0.f;
#pragma unroll
        for (int e = 0; e < 16; ++e) { const float dd = y[e] - mean; qv += dd * dd; }
        qv = red4(qv); const float rstd = rsqrtf(qv * (1.0f / 64.0f) + 64e-5f);
        unsigned o[8];
        const u32x4 g0 = cgq[0], g1 = cgq[1];
        const unsigned gw[8] = {g0.x, g0.y, g0.z, g0.w, g1.x, g1.y, g1.z, g1.w};
#pragma unroll
        for (int e = 0; e < 16; e += 2) {
            const float o0 = ((y[e] - mean) * rstd * lg[e] + lb[e] + vv[e] * dsum) * lo16(gw[e >> 1]);
            const float o1 = ((y[e + 1] - mean) * rstd * lg[e + 1] + lb[e + 1] + vv[e + 1] * dsum) * hi16(gw[e >> 1]);
            o[e >> 1] = pk2(o0, o1);
        }
        *(u32x4*)(YG + (size_t)r * D + c) = (u32x4){o[0], o[1], o[2], o[3]};
        *(u32x4*)(YG + (size_t)r * D + c + 8) = (u32x4){o[4], o[5], o[6], o[7]};
    }
}
#undef POST_FETCH
__device__ __forceinline__ void phase_norm2(const Frame& F, int g, int layer, bool dry = false) {
    bf16_t* X = F.wsp<bf16_t>(WS_X); bf16_t* HM = F.ar<bf16_t>(AR_HM); const bf16_t* Ob = F.ar<bf16_t>(AR_O);
    int* lists = dry ? F.ar<int>(AR_YM0) : F.ar<int>(AR_LIST); float* lwt = dry ? F.ar<float>(AR_YM0) + (size_t)32 * TG : F.ar<float>(AR_LW);
    unsigned* cnt = (unsigned*)(F.ws + WS_CTL + CTL_CNT_OFF) + (((size_t)g * 4 + layer) * 32 + (dry ? NG * 4 * 32 : 0)) * 16;
    LAS float* wr = (LAS float*)F.lds;
    __syncthreads();
    for (int i = F.tid; i < D * NEXP / 4; i += NTHREADS) { const int c = i >> 2, e4 = i & 3; const int rho = (c & ~255) + (c & 3) * 64 + ((c & 255) >> 2);
        *(LAS f32x4*)(wr + rho * 20 + e4 * 4) = *(const f32x4*)(F.in(36) + i * 4); }
    __syncthreads();
    const float* rbias = F.in(37);
    float rb4[4];
#pragma unroll
    for (int e = 0; e < 4; ++e) rb4[e] = rbias[(F.lane >> 4) * 4 + e];
    const bool ctx_out = layer < 2;
    LAS int* lcnt = (LAS int*)(F.lds + LDS_MISC + 512);
    LAS int* lbase = (LAS int*)(F.lds + LDS_MISC + 640);
    LAS int* rec = (LAS int*)(F.lds + 81920);
    const int rpb = (TG + F.G - 1) / F.G, rbeg = F.bid * rpb, rend = (rbeg + rpb) < TG ? (rbeg + rpb) : TG;
    const int niter = (rpb + NWAVES - 1) / NWAVES;
    int key = -1; f32x4 cg[4], cA[4], cB[4];
#pragma unroll
    for (int q = 0; q < 4; ++q) { cg[q] = (f32x4){0.f, 0.f, 0.f, 0.f}; cA[q] = cg[q]; cB[q] = cg[q]; }
    for (int it0 = 0; it0 < niter; it0 += 64) {
        if (F.tid < 32) lcnt[F.tid] = 0;
        __syncthreads();
        const int itn = (niter - it0) < 64 ? (niter - it0) : 64;
        u32x2 nxw[4], nob[4];
        { const int r_ = rbeg + it0 * NWAVES + F.wave; const int rc_ = r_ < rend ? r_ : rbeg;
#pragma unroll
          for (int q = 0; q < 4; ++q) { const int c = q * 256 + F.lane * 4; nxw[q] = *(const u32x2*)(X + (size_t)rc_ * D + c); nob[q] = *(const u32x2*)(Ob + (size_t)rc_ * D + c); } }
        for (int itl = 0; itl < itn; ++itl) {
            const int r = rbeg + (it0 + itl) * NWAVES + F.wave;
            const int bl = r / LT, t = r % LT, b = g * BG + bl; const bool isctx = t < LC;
            const int slot = itl * NWAVES + F.wave;
            u32x2 cxw[4], cob[4];
#pragma unroll
            for (int q = 0; q < 4; ++q) { cxw[q] = nxw[q]; cob[q] = nob[q]; }
            { const int r_ = r + NWAVES; const int rc_ = (itl + 1 < itn && r_ < rend) ? r_ : rbeg;
#pragma unroll
              for (int q = 0; q < 4; ++q) { const int c = q * 256 + F.lane * 4; nxw[q] = *(const u32x2*)(X + (size_t)rc_ * D + c); nob[q] = *(const u32x2*)(Ob + (size_t)rc_ * D + c); } }
            if (r >= rend || (isctx && !ctx_out)) { if (F.lane == 0) rec[slot * 4] = -1; continue; }
            if (key != b * 2 + (int)isctx) {
                key = b * 2 + (int)isctx;
#pragma unroll
                for (int q = 0; q < 4; ++q) { const int c = q * 256 + F.lane * 4;
                    cg[q] = *(const f32x4*)((isctx ? F.modC(layer, 2) : F.modL(layer, b, 2)) + c);
                    const f32x4 gv = *(const f32x4*)(F.in(7) + (size_t)layer * D + c), cv = *(const f32x4*)((isctx ? F.modC(layer, 4) : F.modL(layer, b, 4)) + c);
                    cA[q] = gv * (1.0f + cv); cB[q] = *(const f32x4*)((isctx ? F.modC(layer, 3) : F.modL(layer, b, 3)) + c); }
            }
            f32x4 x[4]; float ss = 0.f;
#pragma unroll
            for (int q = 0; q < 4; ++q) { const int c = q * 256 + F.lane * 4;
                { const u32x2 xw = cxw[q]; x[q] = (f32x4){lo16(xw.x), hi16(xw.x), lo16(xw.y), hi16(xw.y)}; }
                const u32x2 ob = cob[q]; const f32x4 gv = cg[q];
                const f32x4 xo = x[q];
                x[q][0] += gv[0] * lo16(ob.x); x[q][1] += gv[1] * hi16(ob.x); x[q][2] += gv[2] * lo16(ob.y); x[q][3] += gv[3] * hi16(ob.y);
                { const f32x4 xs = dry ? xo : x[q]; u32x2 xw; xw.x = pk2(xs[0], xs[1]); xw.y = pk2(xs[2], xs[3]); *(u32x2*)(X + (size_t)r * D + c) = xw; }
                ss += x[q][0] * x[q][0] + x[q][1] * x[q][1] + x[q][2] * x[q][2] + x[q][3] * x[q][3]; }
            ss = wave_sum_dpp(ss);
            const float rstd = rsqrtf(ss * (1.0f / D) + 1e-6f);
            float lg[16];
#pragma unroll
            for (int e = 0; e < 16; ++e) lg[e] = 0.f;
#pragma unroll
            for (int q = 0; q < 4; ++q) { const int c = q * 256 + F.lane * 4;
                const f32x4 h = x[q] * rstd * cA[q] + cB[q];
                u32x2 w; w.x = pk2(h[0], h[1]); w.y = pk2(h[2], h[3]);
                *(u32x2*)(HM + (size_t)r * D + c) = w;
#pragma unroll
                for (int j = 0; j < 4; ++j) {
#pragma unroll
                    for (int e4 = 0; e4 < 4; ++e4) { const f32x4 wv = *(const LAS f32x4*)(wr + (q * 256 + j * 64 + F.lane) * 20 + e4 * 4);
                        lg[e4 * 4 + 0] += h[j] * wv[0]; lg[e4 * 4 + 1] += h[j] * wv[1]; lg[e4 * 4 + 2] += h[j] * wv[2]; lg[e4 * 4 + 3] += h[j] * wv[3]; } }
            }
            float m8[8], xg[4];
#pragma unroll
            for (int e = 0; e < 8; ++e) { const auto sw = __builtin_amdgcn_permlane32_swap(__float_as_uint(lg[e]), __float_as_uint(lg[e + 8]), false, false); m8[e] = __uint_as_float(sw[0]) + __uint_as_float(sw[1]); }
#pragma unroll
            for (int e = 0; e < 4; ++e) { const auto sw = __builtin_amdgcn_permlane16_swap(__float_as_uint(m8[e]), __float_as_uint(m8[e + 4]), false, false); xg[e] = red16(__uint_as_float(sw[0]) + __uint_as_float(sw[1])); }
            float sc_[4], bs[4];
#pragma unroll
            for (int e = 0; e < 4; ++e) { sc_[e] = sigmoidf_(xg[e]); bs[e] = sc_[e] + rb4[e]; }
            const float hi01 = fmaxf(bs[0], bs[1]), lo01 = fminf(bs[0], bs[1]), hi23 = fmaxf(bs[2], bs[3]), lo23 = fminf(bs[2], bs[3]);
            const float gsc = fmaxf(hi01, hi23) + fmaxf(fminf(hi01, hi23), fmaxf(lo01, lo23));
            const float g0s = __int_as_float(__builtin_amdgcn_readlane(__float_as_int(gsc), 0)), g1s = __int_as_float(__builtin_amdgcn_readlane(__float_as_int(gsc), 16));
            const float g2s = __int_as_float(__builtin_amdgcn_readlane(__float_as_int(gsc), 32)), g3s = __int_as_float(__builtin_amdgcn_readlane(__float_as_int(gsc), 48));
            const bool c10 = g1s > g0s, c32 = g3s > g2s; const float v01 = c10 ? g1s : g0s, v23 = c32 ? g3s : g2s; const bool chi = v23 > v01;
            const int best = __builtin_amdgcn_readfirstlane(chi ? (c32 ? 3 : 2) : (c10 ? 1 : 0));
            float cb[4], cs[4];
#pragma unroll
            for (int e = 0; e < 4; ++e) { cb[e] = __int_as_float(__builtin_amdgcn_readlane(__float_as_int(bs[e]), best * 16)); cs[e] = __int_as_float(__builtin_amdgcn_readlane(__float_as_int(sc_[e]), best * 16)); }
            const bool d10 = cb[1] > cb[0], d32 = cb[3] > cb[2]; const float w01 = d10 ? cb[1] : cb[0], w23 = d32 ? cb[3] : cb[2]; const bool dhi = w23 > w01;
            const int j1 = dhi ? (d32 ? 3 : 2) : (d10 ? 1 : 0);
            const float e0 = j1 == 0 ? -1e30f : cb[0], e1 = j1 == 1 ? -1e30f : cb[1], e2 = j1 == 2 ? -1e30f : cb[2], e3 = j1 == 3 ? -1e30f : cb[3];
            const bool f10 = e1 > e0, f32_ = e3 > e2; const float u01 = f10 ? e1 : e0, u23 = f32_ ? e3 : e2; const bool fhi = u23 > u01;
            const int j2 = fhi ? (f32_ ? 3 : 2) : (f10 ? 1 : 0);
            const float s1 = (j1 & 2) ? ((j1 & 1) ? cs[3] : cs[2]) : ((j1 & 1) ? cs[1] : cs[0]);
            const float s2 = (j2 & 2) ? ((j2 & 1) ? cs[3] : cs[2]) : ((j2 & 1) ? cs[1] : cs[0]);
            const float inv = __builtin_amdgcn_rcpf(s1 + s2);
            if (F.lane == 0) {
                const int l1 = (best * 4 + j1) * 2 + 0, l2 = (best * 4 + j2) * 2 + 1;
                const int p1 = __hip_atomic_fetch_add(lcnt + l1, 1, __ATOMIC_RELAXED, __HIP_MEMORY_SCOPE_WORKGROUP);
                const int p2 = __hip_atomic_fetch_add(lcnt + l2, 1, __ATOMIC_RELAXED, __HIP_MEMORY_SCOPE_WORKGROUP);
                rec[slot * 4 + 0] = l1 | (p1 << 8); rec[slot * 4 + 1] = l2 | (p2 << 8);
                rec[slot * 4 + 2] = __float_as_int(s1 * inv); rec[slot * 4 + 3] = __float_as_int(s2 * inv);
            }
        }
        __syncthreads();
        if (F.tid < 32) { const int c = lcnt[F.tid]; lbase[F.tid] = c ? (int)atomicAdd(&cnt[F.tid * 16], (unsigned)c) : 0; }
        __syncthreads();
        for (int slot = F.tid; slot < itn * NWAVES; slot += NTHREADS) {
            const int a0 = rec[slot * 4 + 0]; if (a0 < 0) continue;
            const int a1 = rec[slot * 4 + 1];
            const int r = rbeg + (it0 + slot / NWAVES) * NWAVES + (slot % NWAVES);
            const int l1 = a0 & 255, l2 = a1 & 255; const int q1 = lbase[l1] + (a0 >> 8), q2 = lbase[l2] + (a1 >> 8);
            lists[(size_t)l1 * TG + q1] = r; lwt[(size_t)l1 * TG + q1] = __int_as_float(rec[slot * 4 + 2]);
            lists[(size_t)l2 * TG + q2] = r; lwt[(size_t)l2 * TG + q2] = __int_as_float(rec[slot * 4 + 3]);
        }
        __syncthreads();
    }
}
__device__ __forceinline__ int moe_tables(const Frame& F, int g, int layer) {
    LAS int* cn = (LAS int*)(F.lds + LDS_MISC + 64); LAS int* tb = (LAS int*)(F.lds + LDS_MISC + 192);
    const unsigned* cnt = (const unsigned*)(F.ws + WS_CTL + CTL_CNT_OFF) + ((size_t)g * 4 + layer) * 32 * 16;
    __syncthreads();
    if (F.tid < 32) cn[F.tid] = (int)__hip_atomic_load(cnt + F.tid * 16, __ATOMIC_RELAXED, __HIP_MEMORY_SCOPE_AGENT);
    __syncthreads();
    if (F.tid == 0) { int acc = 0; for (int l = 0; l < 32; ++l) { tb[l] = acc; acc += (cn[l] + 255) >> 8; } tb[32] = acc; }
    __syncthreads();
    return tb[32];
}

constexpr int SC_OPB = 6 * 4096;
constexpr int SC_HALF = 2 * SC_OPB + 4096 + 4096;
static_assert(2 * SC_HALF <= LDS_STAGE, "scan lds");
__device__ __forceinline__ int scan_tok(int d, int s) { return d == 0 ? s : (s < LC ? (LC - 1 - s) : (LT + LC - 1 - s)); }

constexpr int S4_KKP = 0, S4_RPP = 2048, S4_KDP = 4096, S4_KAP = 6144, S4_KDT = 8192, S4_KAT = 10496, S4_VT = 12800, S4_P15 = 15104, S4_PBSZ = 15360,
              S4_A1 = 30720, S4_B1 = 31232, S4_B2 = 31744, S4_A2 = 32256, S4_MI = 33280, S4_LI = 33792, S4_LX = 37888, S4_AT = 41984, S4_YB = 46080, S4_HALF = 50176;
static_assert(2 * S4_HALF <= LDS_STAGE, "scan4 lds");
#define MF16(a, b, c) __builtin_amdgcn_mfma_f32_16x16x32_bf16((a), (b), (c), 0, 0, 0)
__device__ __forceinline__ bf16x8 mkfrag(unsigned a, unsigned b, unsigned c, unsigned d) { return __builtin_bit_cast(bf16x8, (u32x4){a, b, c, d}); }
__device__ __forceinline__ f32x4 scan_inverse_mfma(f32x4 N, f32x4 NT, int g, int j) {
    const f32x4 z = (f32x4){0.f, 0.f, 0.f, 0.f};
#define P2(v) mkfrag(pk2((v)[0], (v)[1]), pk2((v)[2], (v)[3]), 0u, 0u)
    const bf16x8 Nc = P2(N), Ntc = P2(NT);
    const f32x4 Z2 = MF16(Ntc, Nc, z), Z2t = MF16(Nc, Ntc, z);
    f32x4 Q = (f32x4){(4 * g == j ? 1.f : 0.f) - NT[0], (4 * g + 1 == j ? 1.f : 0.f) - NT[1], (4 * g + 2 == j ? 1.f : 0.f) - NT[2], (4 * g + 3 == j ? 1.f : 0.f) - NT[3]};
    const bf16x8 Z2c = P2(Z2), Z2tc = P2(Z2t);
    const f32x4 Z4 = MF16(Z2tc, Z2c, z), Z4t = MF16(Z2c, Z2tc, z);
    Q = MF16(Z2c, P2(Q), Q);
    const bf16x8 Z4c = P2(Z4), Z4tc = P2(Z4t);
    const f32x4 Z8 = MF16(Z4tc, Z4c, z);
    Q = MF16(Z4c, P2(Q), Q);
    Q = MF16(P2(Z8), P2(Q), Q);
#undef P2
    return Q;
}
__device__ __forceinline__ void phase_scan4(const Frame& F, int a, const bf16_t* V) {
    const bf16_t* R = F.ar<bf16_t>(AR_R); const bf16_t* Kb = F.ar<bf16_t>(AR_K); const bf16_t* L1 = F.ar<bf16_t>(AR_L1);
    const int half = F.wave >> 2, q = F.wave & 3, lane = F.lane, li = q * 64 + lane;
    const int role = (q - half) & 3;
    LAS unsigned char* hb = F.lds + half * S4_HALF;
    const int arr = q >> 1, ntl = (q & 1) * 2;
    const int g = lane >> 4, j = lane & 15;
    const int tB = li >> 4, k4 = (li & 15) * 4;
    const int poff = (tB * 64 + (k4 >> 5) * 32 + ((k4 >> 2) & 3) * 8 + ((k4 >> 4) & 1) * 4) * 2;
    for (int pr = F.bid; pr < BG * 16; pr += F.G) {
        const int bl = pr >> 4, d = (pr >> 3) & 1, hp = pr & 7, h = hp * 2 + half;
        bf16_t* Yd = F.ar<bf16_t>(d ? AR_Y1 : AR_Y0); float* DOT = F.ar<float>(AR_DOT) + (size_t)d * TG * NH;
        const size_t rowb = (size_t)bl * LT;
        const bf16_t* W2 = (arr == 0 ? F.wsp<bf16_t>(WS_W2T) : F.wsp<bf16_t>(WS_A2T)) + ((size_t)a * 2 + d) * D * 64;
        const float* b0p = (arr == 0 ? F.in(13) : F.in(16)) + ((size_t)a * 2 + d) * D + h * 64;
        const int acol = arr * 128 + d * 64 + 8 * (lane >> 4);
        f32x4 Cb[4];
#pragma unroll
        for (int b = 0; b < 4; ++b) Cb[b] = (f32x4){0.f, 0.f, 0.f, 0.f};
        bf16x8 Af[2]; u32x2 kraw, rraw, vraw;
        bf16x8 wf0[2], wf1[2]; float bias2[2];
#pragma unroll
        for (int nt = 0; nt < 2; ++nt) { const int n = (ntl + nt) * 16 + (lane & 15); bias2[nt] = b0p[n];
            wf0[nt] = *(const bf16x8*)(W2 + (size_t)(h * 64 + n) * 64 + 8 * (lane >> 4)); wf1[nt] = *(const bf16x8*)(W2 + (size_t)(h * 64 + n) * 64 + 32 + 8 * (lane >> 4)); }
        const f32x4 kkc = *(const f32x4*)(F.in(24) + (size_t)a * D + h * 64 + k4), kac = *(const f32x4*)(F.in(25) + (size_t)a * D + h * 64 + k4), rkc = *(const f32x4*)(F.in(26) + (size_t)a * D + h * 64 + k4);
#define SC_BAR() asm volatile("s_waitcnt lgkmcnt(0)\n\ts_barrier" ::: "memory")
#define SC_LOAD(ch) do { const size_t rowA = rowb + scan_tok(d, (ch) * 16 + (lane & 15)); \
        Af[0] = *(const bf16x8*)(L1 + rowA * 512 + acol); Af[1] = *(const bf16x8*)(L1 + rowA * 512 + acol + 32); \
        const size_t rowBq = (rowb + scan_tok(d, (ch) * 16 + tB)) * D + h * 64 + k4; \
        kraw = *(const u32x2*)(Kb + rowBq); rraw = *(const u32x2*)(R + rowBq); vraw = *(const u32x2*)(V + rowBq); } while (0)
#define SC_PASSA() do { \
        _Pragma("unroll") for (int nt = 0; nt < 2; ++nt) { f32x4 ac = (f32x4){0.f, 0.f, 0.f, 0.f}; \
            const int n = (ntl + nt) * 16 + (lane & 15); const float bias_ = bias2[nt]; \
            ac = MF16(Af[0], wf0[nt], ac); ac = MF16(Af[1], wf1[nt], ac); \
            f32x4 sg; _Pragma("unroll") for (int rg = 0; rg < 4; ++rg) sg[rg] = sigmoidf_(ac[rg] + bias_); \
            if (arr == 0) { \
                const float l0 = -0.60653066f * sg[0], l1 = -0.60653066f * sg[1], l2 = -0.60653066f * sg[2], l3 = -0.60653066f * sg[3]; \
                const float p0 = l0, p1 = p0 + l1, p2 = p1 + l2, p3 = p2 + l3;                         \
                const auto s16 = __builtin_amdgcn_permlane16_swap(__float_as_uint(p3), __float_as_uint(p3), false, false);     \
                const float sv = __uint_as_float(s16[0]), pq = sv + __uint_as_float(s16[1]); \
                const auto s32 = __builtin_amdgcn_permlane32_swap(__float_as_uint(pq), __float_as_uint(pq), false, false);     \
                const float E = ((g & 1) ? sv : 0.f) + ((g & 2) ? __uint_as_float(s32[0]) : 0.f);      \
                LAS float* li_ = (LAS float*)(hb + S4_LI) + (4 * g) * 64 + n; LAS float* lx_ = (LAS float*)(hb + S4_LX) + (4 * g) * 64 + n; \
                li_[0] = E + p0; li_[64] = E + p1; li_[128] = E + p2; li_[192] = E + p3; lx_[0] = E; lx_[64] = E + p0; lx_[128] = E + p1; lx_[192] = E + p2; \
            } else { _Pragma("unroll") for (int rg = 0; rg < 4; ++rg) ((LAS float*)(hb + S4_AT))[(4 * g + rg) * 64 + n] = sg[rg]; } } } while (0)
#define SC_PASSB(ch, pbo_) do { LAS unsigned char* hq_ = hb + (pbo_); \
        const float kf[4] = {lo16(kraw.x), hi16(kraw.x), lo16(kraw.y), hi16(kraw.y)}; const float rf[4] = {lo16(rraw.x), hi16(rraw.x), lo16(rraw.y), hi16(rraw.y)}; \
        const f32x4 av = *(const LAS f32x4*)((LAS float*)(hb + S4_AT) + tB * 64 + k4), Li = *(const LAS f32x4*)((LAS float*)(hb + S4_LI) + tB * 64 + k4), Lx = *(const LAS f32x4*)((LAS float*)(hb + S4_LX) + tB * 64 + k4); \
        float kq[4], ssq = 0.f; _Pragma("unroll") for (int e = 0; e < 4; ++e) { kq[e] = kf[e] * kkc[e]; ssq += kq[e] * kq[e]; } \
        ssq = red16(ssq); const float inv = __builtin_amdgcn_rsqf(fmaxf(ssq, 1e-24f)); \
        float o_kk[4], o_ka[4], o_kd[4], o_r[4]; f32x4 o_p; float dp = 0.f; \
        _Pragma("unroll") for (int e = 0; e < 4; ++e) { const float Pt = __expf(Li[e]), Px = __expf(Lx[e]), iP = __builtin_amdgcn_rcpf(Pt); \
            const float kkv = kq[e] * inv; const float kd = kf[e] * (1.0f + (av[e] - 1.0f) * kac[e]); const float ka = kkv * av[e]; \
            o_kk[e] = kkv * Px; o_ka[e] = ka * iP; o_kd[e] = kd * iP; o_r[e] = rf[e] * Pt; o_p[e] = Pt; \
            dp += rf[e] * kd * rkc[e]; } \
        dp = red16(dp); \
        if ((li & 15) == 0) DOT[(rowb + scan_tok(d, (ch) * 16 + tB)) * NH + h] = dp; \
        const u32x2 w_kk = (u32x2){pk2(o_kk[0], o_kk[1]), pk2(o_kk[2], o_kk[3])}, w_r = (u32x2){pk2(o_r[0], o_r[1]), pk2(o_r[2], o_r[3])}; \
        const u32x2 w_kd = (u32x2){pk2(o_kd[0], o_kd[1]), pk2(o_kd[2], o_kd[3])}, w_ka = (u32x2){pk2(o_ka[0], o_ka[1]), pk2(o_ka[2], o_ka[3])}; \
        *(LAS u32x2*)(hq_ + S4_KKP + poff) = w_kk; *(LAS u32x2*)(hq_ + S4_RPP + poff) = w_r; *(LAS u32x2*)(hq_ + S4_KDP + poff) = w_kd; *(LAS u32x2*)(hq_ + S4_KAP + poff) = w_ka; \
        { LAS unsigned char* td = hq_ + S4_KDT + k4 * 36 + tB * 2; LAS unsigned char* ta = hq_ + S4_KAT + k4 * 36 + tB * 2; LAS unsigned char* tv = hq_ + S4_VT + k4 * 36 + tB * 2; \
          *(LAS unsigned short*)(td) = (unsigned short)w_kd.x; *(LAS unsigned short*)(td + 36) = (unsigned short)(w_kd.x >> 16); *(LAS unsigned short*)(td + 72) = (unsigned short)w_kd.y; *(LAS unsigned short*)(td + 108) = (unsigned short)(w_kd.y >> 16); \
          *(LAS unsigned short*)(ta) = (unsigned short)w_ka.x; *(LAS unsigned short*)(ta + 36) = (unsigned short)(w_ka.x >> 16); *(LAS unsigned short*)(ta + 72) = (unsigned short)w_ka.y; *(LAS unsigned short*)(ta + 108) = (unsigned short)(w_ka.y >> 16); \
          *(LAS unsigned short*)(tv) = (unsigned short)vraw.x; *(LAS unsigned short*)(tv + 36) = (unsigned short)(vraw.x >> 16); *(LAS unsigned short*)(tv + 72) = (unsigned short)vraw.y; *(LAS unsigned short*)(tv + 108) = (unsigned short)(vraw.y >> 16); } \
        if (tB == 15) *(LAS f32x4*)((LAS float*)(hq_ + S4_P15) + k4) = o_p; } while (0)
#define SC_PROD(pbo_) do { LAS unsigned char* hq_ = hb + (pbo_); \
        const int lo_ = (role < 2 ? S4_KKP : S4_RPP) + j * 128 + g * 16, ro_ = ((role == 0 || role == 3) ? S4_KAP : S4_KDP) + j * 128 + g * 16; \
        const bf16x8 fl0_ = *(const LAS bf16x8*)(hq_ + lo_), fr0_ = *(const LAS bf16x8*)(hq_ + ro_), fl1_ = *(const LAS bf16x8*)(hq_ + lo_ + 64), fr1_ = *(const LAS bf16x8*)(hq_ + ro_ + 64); \
        f32x4 pa = (f32x4){0.f, 0.f, 0.f, 0.f}; \
        pa = MF16(fl0_, fr0_, pa); pa = MF16(fl1_, fr1_, pa); \
        _Pragma("unroll") for (int r_ = 0; r_ < 4; ++r_) { const int t_ = 4 * g + r_; const bool keep = (role < 2) ? (j < t_) : (j <= t_); pa[r_] = keep ? pa[r_] : 0.f; } \
        if (role == 0) { f32x4 pt = (f32x4){0.f, 0.f, 0.f, 0.f}; pt = MF16(fr0_, fl0_, pt); pt = MF16(fr1_, fl1_, pt);        \
            _Pragma("unroll") for (int r_ = 0; r_ < 4; ++r_) pt[r_] = (j > 4 * g + r_) ? pt[r_] : 0.f; \
            const f32x4 mt_ = scan_inverse_mfma(pa, pt, g, j); \
            *(LAS u32x2*)(hb + S4_MI + j * 32 + g * 8) = (u32x2){pk2(mt_[0], mt_[1]), pk2(mt_[2], mt_[3])}; } \
        else { LAS unsigned char* dm = hb + (role == 1 ? S4_A1 : (role == 2 ? S4_B1 : S4_B2)) + ((4 * g) * 16 + j) * 2; const unsigned w0_ = pk2(pa[0], pa[1]), w1_ = pk2(pa[2], pa[3]); \
            *(LAS unsigned short*)(dm) = (unsigned short)w0_; *(LAS unsigned short*)(dm + 32) = (unsigned short)(w0_ >> 16); *(LAS unsigned short*)(dm + 64) = (unsigned short)w1_; *(LAS unsigned short*)(dm + 96) = (unsigned short)(w1_ >> 16); } } while (0)
        constexpr int NCH = LT / 16;
        __syncthreads();
        SC_LOAD(0);
        SC_PASSA();
        SC_BAR();
        SC_PASSB(0, 0);
        SC_BAR();
        SC_LOAD(1);
        SC_PASSA();
        SC_PROD(0);
        SC_BAR();
        SC_PASSB(1, S4_PBSZ);
        SC_BAR();
#pragma unroll 1
        for (int it = 0; it < 2 * NCH + 1; ++it) {
            const int s_ = it - half;
            if (s_ >= 0 && s_ < 2 * NCH) {
            const int ch = s_ >> 1;
            const int pbo = (ch & 1) * S4_PBSZ;
            LAS unsigned char* hc = hb + pbo;
            if ((s_ & 1) == 0) {
            if (ch + 2 < NCH) SC_LOAD(ch + 2);
            const bf16x8 Bs0 = mkfrag(pk2(Cb[0][0], Cb[0][1]), pk2(Cb[0][2], Cb[0][3]), pk2(Cb[1][0], Cb[1][1]), pk2(Cb[1][2], Cb[1][3]));
            const bf16x8 Bs1 = mkfrag(pk2(Cb[2][0], Cb[2][1]), pk2(Cb[2][2], Cb[2][3]), pk2(Cb[3][0], Cb[3][1]), pk2(Cb[3][2], Cb[3][3]));
            f32x4 X = (f32x4){0.f, 0.f, 0.f, 0.f}, H = (f32x4){0.f, 0.f, 0.f, 0.f};
            X = MF16(*(const LAS bf16x8*)(hc + S4_KKP + j * 128 + g * 16), Bs0, X); H = MF16(*(const LAS bf16x8*)(hc + S4_RPP + j * 128 + g * 16), Bs0, H);
            X = MF16(*(const LAS bf16x8*)(hc + S4_KKP + j * 128 + g * 16 + 64), Bs1, X); H = MF16(*(const LAS bf16x8*)(hc + S4_RPP + j * 128 + g * 16 + 64), Bs1, H);
            const u32x2 vw = (u32x2){*(const LAS unsigned*)(hc + S4_VT + (16 * q + j) * 36 + 8 * g), *(const LAS unsigned*)(hc + S4_VT + (16 * q + j) * 36 + 8 * g + 4)};
            const bf16x8 Bv = mkfrag(vw.x, vw.y, 0u, 0u);
            {
                const u32x2 a1w = *(const LAS u32x2*)(hb + S4_A1 + (j * 16 + 4 * g) * 2), b1w = *(const LAS u32x2*)(hb + S4_B1 + (j * 16 + 4 * g) * 2);
                X = MF16(mkfrag(a1w.x, a1w.y, 0u, 0u), Bv, X); H = MF16(mkfrag(b1w.x, b1w.y, 0u, 0u), Bv, H);
            }
            const u32x2 mw = *(const LAS u32x2*)(hb + S4_MI + j * 32 + g * 8);
            f32x4 SA = (f32x4){0.f, 0.f, 0.f, 0.f};
            SA = MF16(mkfrag(mw.x, mw.y, 0u, 0u), mkfrag(pk2(X[0], X[1]), pk2(X[2], X[3]), 0u, 0u), SA);
            const bf16x8 Bn = mkfrag(pk2(-SA[0], -SA[1]), pk2(-SA[2], -SA[3]), 0u, 0u);
            {
                const u32x2 b2w = *(const LAS u32x2*)(hb + S4_B2 + (j * 16 + 4 * g) * 2);
                H = MF16(mkfrag(b2w.x, b2w.y, 0u, 0u), Bn, H);
                LAS float* yb = (LAS float*)(hb + S4_YB) + (4 * g) * 64 + 16 * q + j; yb[0] = H[0]; yb[64] = H[1]; yb[128] = H[2]; yb[192] = H[3];
            }
#pragma unroll
            for (int b = 0; b < 4; ++b) {
                const u32x2 kdw = (u32x2){*(const LAS unsigned*)(hc + S4_KDT + (16 * b + j) * 36 + 8 * g), *(const LAS unsigned*)(hc + S4_KDT + (16 * b + j) * 36 + 8 * g + 4)};
                const u32x2 kaw = (u32x2){*(const LAS unsigned*)(hc + S4_KAT + (16 * b + j) * 36 + 8 * g), *(const LAS unsigned*)(hc + S4_KAT + (16 * b + j) * 36 + 8 * g + 4)};
                Cb[b] = MF16(mkfrag(kdw.x, kdw.y, 0u, 0u), Bv, Cb[b]);
                Cb[b] = MF16(mkfrag(kaw.x, kaw.y, 0u, 0u), Bn, Cb[b]);
            }
#pragma unroll
            for (int b = 0; b < 4; ++b) { const f32x4 pv = *(const LAS f32x4*)((LAS float*)(hc + S4_P15) + 16 * b + 4 * g); Cb[b] = Cb[b] * pv; }
            if (ch + 2 < NCH) SC_PASSA();
            } else {
            {
                const f32x4 yv = *(const LAS f32x4*)((LAS float*)(hb + S4_YB) + tB * 64 + k4);
                u32x2 w; w.x = pk2(yv[0], yv[1]); w.y = pk2(yv[2], yv[3]);
                *(u32x2*)(Yd + (rowb + scan_tok(d, ch * 16 + tB)) * D + h * 64 + k4) = w;
            }
            if (ch + 2 < NCH) SC_PASSB(ch + 2, pbo);
            __builtin_amdgcn_sched_barrier(0);
            if (ch + 1 < NCH) SC_PROD(pbo ^ S4_PBSZ);
            }
            }
            SC_BAR();
        }
#undef SC_LOAD
#undef SC_PASSA
#undef SC_PASSB
#undef SC_PROD
    }
}

__device__ __forceinline__ void phase_sgstats(const Frame& F, int layer) {
    const bf16_t* Z = F.ar<bf16_t>(AR_Z); float* ST = F.ar<float>(AR_ST);
    for (int r0 = (F.bid * NWAVES + F.wave) * 2; r0 < TG; r0 += F.G * NWAVES * 2) {
        u32x4 w[2][4];
#pragma unroll
        for (int h = 0; h < 2; ++h)
#pragma unroll
            for (int q = 0; q < 4; ++q) w[h][q] = *(const u32x4*)(Z + (size_t)(r0 + h) * 4096 + 2048 + q * 512 + F.lane * 8);
#pragma unroll
        for (int h = 0; h < 2; ++h) {
            const int r = r0 + h, t = r % LT; if (t < LC && layer >= 3) continue;
            float x[32];
#pragma unroll
            for (int q = 0; q < 4; ++q) { const u32x4 ww = w[h][q];
                x[q * 8 + 0] = lo16(ww.x); x[q * 8 + 1] = hi16(ww.x); x[q * 8 + 2] = lo16(ww.y); x[q * 8 + 3] = hi16(ww.y); x[q * 8 + 4] = lo16(ww.z); x[q * 8 + 5] = hi16(ww.z); x[q * 8 + 6] = lo16(ww.w); x[q * 8 + 7] = hi16(ww.w); }
            float s = 0.f;
#pragma unroll
            for (int e = 0; e < 32; ++e) s += x[e];
            s = wave_sum_dpp(s); const float mean = s * (1.0f / 2048.0f);
            float qv = 0.f;
#pragma unroll
            for (int e = 0; e < 32; ++e) { const float dd = x[e] - mean; qv += dd * dd; }
            qv = wave_sum_dpp(qv);
            if (F.lane == 0) *(f32x2*)(ST + (size_t)r * 2) = (f32x2){mean, rsqrtf(qv * (1.0f / 2048.0f) + 1e-5f)};
        }
    }
}
__device__ __forceinline__ int vt_off(int dch, int jb) { return dch * 256 + ((jb ^ ((dch & 15) ^ (((dch >> 4) & 7) << 1))) << 4); }
__device__ __forceinline__ void phase_spatial(const Frame& F, int bsg, int layer) {
    const bf16_t* Z = F.ar<bf16_t>(AR_Z); const float* ST = F.ar<float>(AR_ST); bf16_t* Pb = F.ar<bf16_t>(AR_P);
    const bf16_t* Ws = F.wsp<bf16_t>(WS_WSP) + (size_t)bsg * 16 * 128 * 128;
    const float* lng = F.in(31) + (size_t)bsg * 2048; const float* lnb = F.in(32) + (size_t)bsg * 2048; const float* bs = F.in(34) + (size_t)bsg * 16 * 128;
    LAS unsigned char* vt = F.lds;
    const int skip = layer >= 3;
    const int nchunk = skip ? BG * 16 : BG * 18;
    const int w = F.wave, lane = F.lane, dt = w >> 1, it0 = (w & 1) * 2;
    const int jj0 = F.tid >> 4, c8 = (F.tid & 15) * 8;
    u32x4 zz[4]; f32x2 st[4];
#define SP_ROW0(U_) ((size_t)(skip ? (((U_) >> 4) >> 4) * 18 + 2 + (((U_) >> 4) & 15) : ((U_) >> 4)) * 128)
#define SP_LOADZ(U_) do { const size_t r0_ = SP_ROW0(U_); const int gi_ = (U_) & 15; _Pragma("unroll") for (int k = 0; k < 4; ++k) { \
        zz[k] = *(const u32x4*)(Z + (r0_ + jj0 + 32 * k) * 4096 + 2048 + gi_ * 128 + c8); st[k] = *(const f32x2*)(ST + (r0_ + jj0 + 32 * k) * 2); } } while (0)
    if (F.bid < nchunk * 16) SP_LOADZ(F.bid);
    int gic = -1; float gg[8], bb[8], bias[2]; bf16x8 B0[8], B1[8];
#pragma unroll
    for (int e = 0; e < 8; ++e) { gg[e] = 0.f; bb[e] = 0.f; B0[e] = (bf16x8){0, 0, 0, 0, 0, 0, 0, 0}; B1[e] = B0[e]; }
    bias[0] = bias[1] = 0.f;
    for (int U = F.bid; U < nchunk * 16; U += F.G) {
        const int gi = U & 15;
        const size_t row0 = SP_ROW0(U);
        if (gi != gic) {
            gic = gi;
            const f32x4 g0 = *(const f32x4*)(lng + gi * 128 + c8), g1 = *(const f32x4*)(lng + gi * 128 + c8 + 4), b0 = *(const f32x4*)(lnb + gi * 128 + c8), b1 = *(const f32x4*)(lnb + gi * 128 + c8 + 4);
            gg[0] = g0[0]; gg[1] = g0[1]; gg[2] = g0[2]; gg[3] = g0[3]; gg[4] = g1[0]; gg[5] = g1[1]; gg[6] = g1[2]; gg[7] = g1[3];
            bb[0] = b0[0]; bb[1] = b0[1]; bb[2] = b0[2]; bb[3] = b0[3]; bb[4] = b1[0]; bb[5] = b1[1]; bb[6] = b1[2]; bb[7] = b1[3];
            const bf16_t* w0p = Ws + ((size_t)gi * 128 + it0 * 32 + (lane & 31)) * 128 + 8 * (lane >> 5);
#pragma unroll
            for (int s_ = 0; s_ < 8; ++s_) { B0[s_] = *(const bf16x8*)(w0p + 16 * s_); B1[s_] = *(const bf16x8*)(w0p + 32 * 128 + 16 * s_); }
#pragma unroll
            for (int it = 0; it < 2; ++it) bias[it] = bs[gi * 128 + (it0 + it) * 32 + (lane & 31)];
        }
        LDS_BAR();
#pragma unroll
        for (int k = 0; k < 4; ++k) {
            const int jj = jj0 + 32 * k;
            const float xv[8] = {lo16(zz[k].x), hi16(zz[k].x), lo16(zz[k].y), hi16(zz[k].y), lo16(zz[k].z), hi16(zz[k].z), lo16(zz[k].w), hi16(zz[k].w)};
#pragma unroll
            for (int e = 0; e < 8; e += 2) {
                const unsigned pw = pk2((xv[e] - st[k][0]) * st[k][1] * gg[e] + bb[e], (xv[e + 1] - st[k][0]) * st[k][1] * gg[e + 1] + bb[e + 1]);
                *(LAS unsigned short*)(vt + vt_off(c8 + e, jj >> 3) + (jj & 7) * 2) = (unsigned short)(pw & 0xFFFFu);
                *(LAS unsigned short*)(vt + vt_off(c8 + e + 1, jj >> 3) + (jj & 7) * 2) = (unsigned short)(pw >> 16);
            }
        }
        u32x2 uu[2][4];
#pragma unroll
        for (int it = 0; it < 2; ++it) { const int ii = (it0 + it) * 32 + (lane & 31);
#pragma unroll
            for (int rq = 0; rq < 4; ++rq) uu[it][rq] = *(const u32x2*)(Z + (row0 + ii) * 4096 + gi * 128 + dt * 32 + 8 * rq + 4 * (lane >> 5)); }
        if (U + F.G < nchunk * 16) SP_LOADZ(U + F.G);
        LDS_BAR();
        f32x16 acc0, acc1;
#pragma unroll
        for (int e = 0; e < 16; ++e) { acc0[e] = 0.f; acc1[e] = 0.f; }
        const int dA = dt * 32 + (lane & 31);
#pragma unroll
        for (int s_ = 0; s_ < 8; ++s_) {
            const bf16x8 Afr = *(const LAS bf16x8*)(vt + vt_off(dA, 2 * s_ + (lane >> 5)));
            acc0 = __builtin_amdgcn_mfma_f32_32x32x16_bf16(Afr, B0[s_], acc0, 0, 0, 0);
            acc1 = __builtin_amdgcn_mfma_f32_32x32x16_bf16(Afr, B1[s_], acc1, 0, 0, 0);
        }
#pragma unroll
        for (int it = 0; it < 2; ++it) {
            const int ii = (it0 + it) * 32 + (lane & 31); const size_t row = row0 + ii;
#pragma unroll
            for (int rq = 0; rq < 4; ++rq) {
                const int d0 = dt * 32 + 8 * rq + 4 * (lane >> 5);
                float vs[4];
#pragma unroll
                for (int e = 0; e < 4; ++e) vs[e] = (it == 0 ? acc0[rq * 4 + e] : acc1[rq * 4 + e]) + bias[it];
                u32x2 o; o.x = pk2(lo16(uu[it][rq].x) * vs[0], hi16(uu[it][rq].x) * vs[1]); o.y = pk2(lo16(uu[it][rq].y) * vs[2], hi16(uu[it][rq].y) * vs[3]);
                *(u32x2*)(Pb + row * 2048 + gi * 128 + d0) = o;
            }
        }
    }
#undef SP_ROW0
#undef SP_LOADZ
    __syncthreads();
}

__global__ void __launch_bounds__(NTHREADS, 2) fwd_kernel(Params P) {
    extern __shared__ __attribute__((aligned(16))) unsigned char lds_raw[];
    Frame F; F.lds = (LAS unsigned char*)lds_raw; F.tid = threadIdx.x; F.lane = F.tid & 63; F.wave = __builtin_amdgcn_readfirstlane(F.tid >> 6);
    F.G = gridDim.x; F.bid = blockIdx.x; F.ws = P.ws; F.kp = (const Params __attribute__((address_space(4)))*)__builtin_amdgcn_kernarg_segment_ptr();
    const int lo = P.ph_lo, hi = P.ph_hi;
    volatile LAS unsigned* misc = (volatile LAS unsigned*)(F.lds + LDS_MISC);
    if (F.tid < 4) misc[F.tid] = 0u;
    __syncthreads();
    XcdBarrier bar; bar.bar = (unsigned*)(F.ws + WS_CTL); bar.x = 0; bar.st = misc;
    if (hi - lo > 1) bar = xcd_barrier_post((unsigned*)(F.ws + WS_CTL), misc);
    int ph = 0;
#define RUN(id, ...) do { if (ph >= lo && ph < hi) { const int nrep_ = ((REP_MASK >> (id)) & 1u) ? 2 : 1; for (int rep_ = 0; rep_ < nrep_; ++rep_) { const bool dry_ = (rep_ + 1 < nrep_); (void)dry_; { int t_ = threadIdx.x; const Params __attribute__((address_space(4)))* kp_ = (const Params __attribute__((address_space(4)))*)__builtin_amdgcn_kernarg_segment_ptr(); asm volatile("" : "+v"(t_), "+s"(kp_)); F.tid = t_; F.lane = t_ & 63; F.kp = kp_; F.ws = kp_->ws; } __VA_ARGS__; if (rep_ + 1 < nrep_ || ph + 1 < hi) xcd_barrier(bar); } } ++ph; } while (0)

    RUN(0, phase_prologue(F));
    for (int g = 0; g < NG; ++g) {
        for (int layer = 0; layer < 4; ++layer) {
            const int a = layer >> 1;
            if ((layer & 1) == 0) {
                const bf16_t* Vc = layer == 0 ? F.wsp<bf16_t>(WS_VF) : F.ar<bf16_t>(AR_V);
                RUN(1, phase_norm1(F, g, layer, F.ar<bf16_t>(AR_H2), 2048, dry_));
                RUN(2, phase_mix(F, a));
                RUN(3, { { pg8::SchedPlain S; S.init(TG / 256, 2, F.G, F.bid, 0);
                        EpiL1 E{F.ar<bf16_t>(AR_L1)};
                        pg8::gemm_phase(F.tid, F.lds, F.ar<bf16_t>(AR_H2), K1CAT, F.wsp<bf16_t>(WS_WL) + (size_t)a * 512 * K1CAT, K1CAT, K1CAT, S, E); }
                      { int t_ = threadIdx.x; asm volatile("" : "+v"(t_)); F.tid = t_; F.lane = t_ & 63; }
                      { pg8::SchedRKV S; S.init(TG / 256, 12, F.G, (F.bid + 192) % F.G, 0);
                        EpiRKV E{F.ws, layer == 0 ? WS_VF : WS_ARENA + AR_V};
                        pg8::gemm_phase(F.tid, F.lds, F.ar<bf16_t>(AR_XR), D, F.wsp<bf16_t>(WS_WRKV) + (size_t)a * 3072 * D, D, D, S, E); } });
                if (layer == 2) {
                    RUN(4, { pg8::SchedPlain S; S.init(TG / 256, 4, F.G, F.bid, 0);
                          EpiStore<1> E{F.ar<bf16_t>(AR_VGATE), F.in(19)};
                          pg8::gemm_phase(F.tid, F.lds, F.ar<bf16_t>(AR_L1) + 256, 512, F.wsp<bf16_t>(WS_V2T), 256, 256, S, E); });
                    RUN(5, phase_vfix(F));
                }
                RUN(6, phase_scan4(F, a, Vc));
                RUN(7, { pg8::SchedPlain S; S.init(TG / 256, 4, F.G, F.bid, 0);
                      EpiStore<0> E{F.ar<bf16_t>(AR_G), nullptr};
                      pg8::gemm_phase(F.tid, F.lds, F.ar<bf16_t>(AR_L1) + 256, 512, F.wsp<bf16_t>(WS_G2T) + (size_t)a * D * 256, 256, 256, S, E); });
                RUN(8, phase_post(F, a, Vc));
                RUN(9, { const int skip = layer == 2; pg8::SchedPlain S; S.init(skip ? BG * 8 : TG / 256, 4, F.G, F.bid, skip);
                      EpiStore<0> E{F.ar<bf16_t>(AR_O), nullptr};
                      pg8::gemm_phase(F.tid, F.lds, F.ar<bf16_t>(AR_R), D, F.wsp<bf16_t>(WS_WO) + (size_t)a * D * D, D, D, S, E); });
            } else {
                const int skip = layer == 3;
                RUN(10, phase_norm1(F, g, layer, F.ar<bf16_t>(AR_H), D, dry_));
                RUN(11, { pg8::SchedPlain S; S.init(skip ? BG * 8 : TG / 256, 16, F.G, F.bid, skip);
                      EpiGelu E{F.ar<bf16_t>(AR_Z), F.in(30) + (size_t)a * 4096};
                      pg8::gemm_phase(F.tid, F.lds, F.ar<bf16_t>(AR_H), D, F.wsp<bf16_t>(WS_WIN) + (size_t)a * 4096 * D, D, D, S, E); });
                RUN(12, phase_sgstats(F, layer));
                RUN(13, phase_spatial(F, a, layer));
                RUN(14, { pg8::SchedPlain S; S.init(skip ? BG * 8 : TG / 256, 4, F.G, F.bid, skip);
                      EpiStore<0> E{F.ar<bf16_t>(AR_O), nullptr};
                      pg8::gemm_phase(F.tid, F.lds, F.ar<bf16_t>(AR_P), 2048, F.wsp<bf16_t>(WS_WOUT) + (size_t)a * D * 2048, 2048, 2048, S, E); });
            }
            RUN(15, phase_norm2(F, g, layer, dry_));
            RUN(16, { const int total = moe_tables(F, g, layer);
                  pg8::SchedMoe<true> S{(const LAS int*)(F.lds + LDS_MISC + 64), (const LAS int*)(F.lds + LDS_MISC + 192), F.ar<int>(AR_LIST), F.G, F.bid, total};
                  EpiMG E{F.ar<bf16_t>(AR_HE)};
                  pg8::gemm_phase(F.tid, F.lds, F.ar<bf16_t>(AR_HM), D, F.wsp<bf16_t>(WS_WGU) + (size_t)layer * NEXP * 1024 * D, D, D, S, E); });
            RUN(17, { const int total = moe_tables(F, g, layer);
                  pg8::SchedMoe<false> S{(const LAS int*)(F.lds + LDS_MISC + 64), (const LAS int*)(F.lds + LDS_MISC + 192), F.ar<int>(AR_LIST), F.G, F.bid, total};
                  EpiMD E{F.ar<bf16_t>(AR_YM0), F.ar<int>(AR_LIST), F.ar<float>(AR_LW), (const LAS int*)(F.lds + LDS_MISC + 64)};
                  pg8::gemm_phase(F.tid, F.lds, F.ar<bf16_t>(AR_HE), FEXP, F.wsp<bf16_t>(WS_WD) + (size_t)layer * NEXP * D * FEXP, FEXP, FEXP, S, E); });
        }
        RUN(18, phase_norm1(F, g, 4, nullptr, 0));
    }
#undef RUN
}
constexpr int NPHASES = 1 + NG * (10 + 8 + 12 + 8 + 1);

__global__ void nan_fill(float* out, size_t n) { for (size_t i = (size_t)blockIdx.x * blockDim.x + threadIdx.x; i < n; i += (size_t)gridDim.x * blockDim.x) out[i] = __uint_as_float(0x7FC00000u); }

extern "C" void kernel_launch(void* const* d_in, const int* in_sizes, int n_in, void* d_out, int out_size, void* d_ws, size_t ws_size, hipStream_t stream) {
    static int grid = 0;
    if (grid == 0) {
        int dev = 0, cus = 0, per_cu = 0;
        if (n_in != 42 || ws_size < WS_END || hipGetDevice(&dev) != hipSuccess || hipDeviceGetAttribute(&cus, hipDeviceAttributeMultiprocessorCount, dev) != hipSuccess) {
            fprintf(stderr, "kernel_launch: bad setup (n_in %d, ws %zu need %zu)\n", n_in, ws_size, (size_t)WS_END); grid = -1;
        } else if (hipFuncSetAttribute((const void*)fwd_kernel, hipFuncAttributeMaxDynamicSharedMemorySize, LDS_BYTES) != hipSuccess) { fprintf(stderr, "kernel_launch: hipFuncSetAttribute failed\n"); grid = -1; }
        else {
            if (hipOccupancyMaxActiveBlocksPerMultiprocessor(&per_cu, (const void*)fwd_kernel, NTHREADS, LDS_BYTES) != hipSuccess || per_cu < 1) { fprintf(stderr, "kernel_launch: occupancy query reports %d\n", per_cu); }
            (void)hipGetLastError();
            grid = cus;
        }
    }
    if (grid < 0) { hipLaunchKernelGGL(nan_fill, dim3(1024), dim3(256), 0, stream, (float*)d_out, (size_t)out_size); return; }
    (void)hipMemsetAsync((char*)d_ws + WS_CTL, 0, CTL_BYTES, stream);
    Params p{};
    for (int i = 0; i < 42; ++i) p.in[i] = (const float*)d_in[i];
    p.out = (float*)d_out; p.ws = (unsigned char*)d_ws;
#if PER_PHASE_LAUNCH
    for (int k = 0; k < NPHASES; ++k) { p.ph_lo = k; p.ph_hi = k + 1; hipLaunchKernelGGL(fwd_kernel, dim3(grid), dim3(NTHREADS), LDS_BYTES, stream, p); }
#else
    p.ph_lo = 0; p.ph_hi = NPHASES;
    hipLaunchKernelGGL(fwd_kernel, dim3(grid), dim3(NTHREADS), LDS_BYTES, stream, p);
#endif
}
```

```cpp
#include <hip/hip_runtime.h>
#include <cstdio>
#include <cstdint>

#ifndef REP_MASK
#define REP_MASK 0u
#endif
#ifndef PER_PHASE_LAUNCH
#define PER_PHASE_LAUNCH 0
#endif

#define LAS __attribute__((address_space(3)))
typedef unsigned short bf16_t;
typedef short bf16x8 __attribute__((ext_vector_type(8)));
typedef float f32x4 __attribute__((ext_vector_type(4)));
typedef float f32x2 __attribute__((ext_vector_type(2)));
typedef float f32x16 __attribute__((ext_vector_type(16)));
typedef unsigned u32x4 __attribute__((ext_vector_type(4)));
typedef unsigned u32x2 __attribute__((ext_vector_type(2)));

constexpr int NB = 32, SEQ = 2048, LC = 256, LT = SEQ + LC, D = 1024, NH = 16;
constexpr int NG = 2, BG = NB / NG, TG = BG * LT;
constexpr int NTHREADS = 512, NWAVES = 8;
constexpr int N1CAT = 3584, K1CAT = 2048;
constexpr int NEXP = 16, FEXP = 512;

constexpr size_t al256(size_t x) { return (x + 255) & ~(size_t)255; }
constexpr int XCD_BAR_WORDS_C = 3456;
constexpr size_t WS_CTL = 0;
constexpr size_t CTL_BAR_BYTES = (size_t)XCD_BAR_WORDS_C * 4;
constexpr size_t CTL_CNT_OFF = al256(CTL_BAR_BYTES);
constexpr size_t CTL_BYTES = al256(CTL_CNT_OFF + (size_t)2 * NG * 4 * 32 * 64);
constexpr size_t WS_X = al256(WS_CTL + CTL_BYTES);
constexpr size_t WS_VF = WS_X + (size_t)TG * D * 2;
constexpr size_t WS_MODL = WS_VF + (size_t)TG * D * 2;
constexpr size_t WS_MODC = WS_MODL + (size_t)4 * NB * 6 * D * 4;
constexpr size_t WS_WRKV = al256(WS_MODC + (size_t)4 * 6 * D * 4);
constexpr size_t WS_WL = WS_WRKV + (size_t)2 * 3072 * D * 2;
constexpr size_t WS_WO = WS_WL + (size_t)2 * 512 * K1CAT * 2;
constexpr size_t WS_G2T = WS_WO + (size_t)2 * D * D * 2;
constexpr size_t WS_V2T = WS_G2T + (size_t)2 * D * 256 * 2;
constexpr size_t WS_W2T = WS_V2T + (size_t)D * 256 * 2;
constexpr size_t WS_A2T = WS_W2T + (size_t)4 * D * 64 * 2;
constexpr size_t WS_WIN = WS_A2T + (size_t)4 * D * 64 * 2;
constexpr size_t WS_WOUT = WS_WIN + (size_t)2 * 4096 * D * 2;
constexpr size_t WS_WSP = WS_WOUT + (size_t)2 * D * 2048 * 2;
constexpr size_t WS_WGU = WS_WSP + (size_t)2 * 16 * 128 * 128 * 2;
constexpr size_t WS_WD = WS_WGU + (size_t)4 * NEXP * 1024 * D * 2;
constexpr size_t WS_ARENA = al256(WS_WD + (size_t)4 * NEXP * D * FEXP * 2);
constexpr size_t SZB = (size_t)TG * D * 2;
constexpr size_t AR_H2 = 0;
constexpr size_t AR_Y0 = 0, AR_Y1 = SZB;
constexpr size_t AR_XR = 2 * SZB;
constexpr size_t AR_R = 5 * SZB, AR_K = 6 * SZB, AR_V = 7 * SZB;
constexpr size_t AR_L1 = 8 * SZB;
constexpr size_t AR_DOT = AR_L1 + SZB / 2;
constexpr size_t AR_G = 2 * SZB;
constexpr size_t AR_VGATE = 0;
constexpr size_t AR_O = 3 * SZB;
constexpr size_t AR_H = 0;
constexpr size_t AR_Z = SZB;
constexpr size_t AR_P = 5 * SZB;
constexpr size_t AR_ST = 7 * SZB;
constexpr size_t AR_HM = 0;
constexpr size_t AR_HE = SZB;
constexpr size_t HE_ROWS = (size_t)2 * TG + 32 * 256;
constexpr size_t AR_LIST = al256(AR_HE + HE_ROWS * FEXP * 2);
constexpr size_t AR_LW = AR_LIST + (size_t)32 * TG * 4;
constexpr size_t AR_YM0 = 5 * SZB, AR_YM1 = 6 * SZB;
constexpr size_t ARENA_BYTES = AR_DOT + (size_t)2 * TG * 16 * 4 + 4096;
constexpr size_t WS_END = WS_ARENA + ARENA_BYTES;
static_assert(AR_LW + (size_t)32 * TG * 4 <= AR_O, "moe lists overlap");

constexpr int LDS_STAGE = 131072;
constexpr int LDS_MISC = LDS_STAGE;
constexpr int LDS_BYTES = LDS_STAGE + 1024;

struct Params {
    const float* in[42];
    float* out;
    unsigned char* ws;
    int ph_lo, ph_hi;
};

__device__ __forceinline__ float bf2f(unsigned short b) { return __uint_as_float(((unsigned)b) << 16); }
__device__ __forceinline__ unsigned short f2bf(float f) { unsigned u = __float_as_uint(f); u += 0x7FFFu + ((u >> 16) & 1u); return (unsigned short)(u >> 16); }
typedef __bf16 bf16x2_t __attribute__((ext_vector_type(2)));
__device__ __forceinline__ unsigned pk2(float lo, float hi) { const bf16x2_t v = __builtin_convertvector((f32x2){lo, hi}, bf16x2_t); return __builtin_bit_cast(unsigned, v); }
__device__ __forceinline__ float lo16(unsigned w) { return __uint_as_float(w << 16); }
__device__ __forceinline__ float hi16(unsigned w) { return __uint_as_float(w & 0xFFFF0000u); }
__device__ __forceinline__ float sigmoidf_(float x) { return __builtin_amdgcn_rcpf(1.0f + __expf(-x)); }
__device__ __forceinline__ float tanhf_(float x) { return 1.0f - 2.0f * __builtin_amdgcn_rcpf(__expf(2.0f * x) + 1.0f); }
__device__ __forceinline__ float wave_sum(float v) {
#pragma unroll
    for (int o = 32; o > 0; o >>= 1) v += __shfl_xor(v, o);
    return v;
}
template <int CTRL> __device__ __forceinline__ float dpp_f(float v) {
    return __int_as_float(__builtin_amdgcn_update_dpp(0, __float_as_int(v), CTRL, 0xF, 0xF, true));
}
__device__ __forceinline__ float red8(float v) { v += dpp_f<0xB1>(v); v += dpp_f<0x4E>(v); v += dpp_f<0x141>(v); return v; }
__device__ __forceinline__ float red16(float v) { v = red8(v); v += dpp_f<0x140>(v); return v; }
__device__ __forceinline__ float wave_sum_dpp(float v) {
    v = red16(v);
    const float a = __int_as_float(__builtin_amdgcn_readlane(__float_as_int(v), 0)), b = __int_as_float(__builtin_amdgcn_readlane(__float_as_int(v), 16));
    const float c = __int_as_float(__builtin_amdgcn_readlane(__float_as_int(v), 32)), d = __int_as_float(__builtin_amdgcn_readlane(__float_as_int(v), 48));
    return (a + b) + (c + d);
}
__device__ __forceinline__ float red4(float v) { v += dpp_f<0xB1>(v); v += dpp_f<0x4E>(v); return v; }
__device__ __forceinline__ f32x2 gelu_pk(f32x2 v) {
    const f32x2 av = __builtin_elementwise_abs(v), d = av * 0.2316418882f + 1.0f;
    f32x2 t; t.x = __builtin_amdgcn_rcpf(d.x); t.y = __builtin_amdgcn_rcpf(d.y);
    f32x2 q = t * 0.5307027145f + (-0.7265760135f); q = q * t + 0.7107068705f; q = q * t + (-0.142248368f); q = q * t + 0.127414796f; q = q * t;
    const f32x2 s = (v * v) * (-0.72134752044f);
    f32x2 e; e.x = __builtin_amdgcn_exp2f(s.x); e.y = __builtin_amdgcn_exp2f(s.y);
    const f32x2 m = v * (q * e), r = v - m;
    f32x2 o; o.x = v.x < 0.f ? m.x : r.x; o.y = v.y < 0.f ? m.y : r.y; return o;
}
__device__ __forceinline__ float gelu_f(float v) {
    const float av = fabsf(v), t = __builtin_amdgcn_rcpf(av * 0.2316418882f + 1.0f);
    float q = t * 0.5307027145f + (-0.7265760135f); q = q * t + 0.7107068705f; q = q * t + (-0.142248368f); q = q * t + 0.127414796f; q = q * t;
    const float e = __builtin_amdgcn_exp2f((v * v) * (-0.72134752044f));
    const float m = v * (q * e);
    return v < 0.f ? m : v - m;
}

#define XB_TMO      128
#define XB_XCNT(j)  (256  + 64 * (j))
#define XB_XSUB(j)  (1280 + 64 * (j))
#define XB_XGEN(j)  (2304 + 64 * (j))
#define XB_TOP      3328
#define XB_TOPGEN   3392
#define XCD_BAR_WORDS 3456
#define XB_SPIN_CAP (1u << 22)
static_assert(XCD_BAR_WORDS == XCD_BAR_WORDS_C, "barrier words");
__device__ __forceinline__ unsigned xb_ld(unsigned* p)              { return __hip_atomic_load(p, __ATOMIC_RELAXED, __HIP_MEMORY_SCOPE_AGENT); }
__device__ __forceinline__ unsigned xb_add(unsigned* p, unsigned v) { return __hip_atomic_fetch_add(p, v, __ATOMIC_RELAXED, __HIP_MEMORY_SCOPE_AGENT); }
__device__ __forceinline__ unsigned xb_xcc_id() { return (unsigned)__builtin_amdgcn_s_getreg((3 << 11) | 20) & 0xFu; }
#define XB_SPIN(cond, bar) do { unsigned _sp = 0; while (cond) { __builtin_amdgcn_s_sleep(1); \
    if ((++_sp & 255u) == 0u) { if (xb_ld(&(bar)[XB_TMO])) break; if (_sp > XB_SPIN_CAP) { atomicAdd(&(bar)[XB_TMO], 1u); break; } } } } while (0)
struct XcdBarrier { unsigned* bar; unsigned x; volatile LAS unsigned* st; };
__device__ __forceinline__ XcdBarrier xcd_barrier_post(unsigned* bar, volatile LAS unsigned* st) {
    XcdBarrier b; b.bar = bar; b.x = xb_xcc_id(); b.st = st;
    if (threadIdx.x == 0) (void)xb_add(&bar[XB_XCNT(b.x)], 1u);
    return b;
}
__device__ __forceinline__ void xcd_barrier_complete(unsigned* bar, unsigned x, unsigned& nloc, unsigned& nx) {
    const unsigned G = gridDim.x * gridDim.y * gridDim.z;
    unsigned sum, cnt, mine, sp = 0u;
    for (;;) {
        sum = 0u; cnt = 0u; mine = 0u;
#pragma unroll
        for (unsigned j = 0; j < 16; ++j) { const unsigned c = xb_ld(&bar[XB_XCNT(j)]); sum += c; cnt += (c > 0u) ? 1u : 0u; mine = (j == x) ? c : mine; }
        if (sum == G) break;
        __builtin_amdgcn_s_sleep(1);
        if ((++sp & 255u) == 0u) { if (xb_ld(&bar[XB_TMO])) break; if (sp > XB_SPIN_CAP) { atomicAdd(&bar[XB_TMO], 1u); break; } }
    }
    nloc = mine > 0u ? mine : 1u; nx = cnt > 0u ? cnt : 1u;
}
__device__ __forceinline__ void xcd_barrier(const XcdBarrier& b) {
    asm volatile("s_waitcnt vmcnt(0)" ::: "memory");
    __syncthreads();
    if (threadIdx.x == 0) {
        unsigned* bar = b.bar;
        __builtin_amdgcn_s_waitcnt(0);
        unsigned nloc = b.st[0], nx = b.st[1];
        if (nloc == 0u) { xcd_barrier_complete(bar, b.x, nloc, nx); b.st[0] = nloc; b.st[1] = nx; }
        const unsigned old = xb_add(&bar[XB_XSUB(b.x)], 1u);
        const unsigned gen = old / nloc;
        if (old + 1u == (gen + 1u) * nloc) {
            __builtin_amdgcn_fence(__ATOMIC_RELEASE, "agent");
            asm volatile("s_waitcnt vmcnt(0)" ::: "memory");
            const unsigned og = xb_add(&bar[XB_TOP], 1u);
            const unsigned tg = og / nx;
            if (og + 1u == (tg + 1u) * nx) xb_add(&bar[XB_TOPGEN], 1u);
            else XB_SPIN(xb_ld(&bar[XB_TOPGEN]) == tg, bar);
            __builtin_amdgcn_fence(__ATOMIC_ACQUIRE, "agent");
            xb_add(&bar[XB_XGEN(b.x)], 1u);
            asm volatile("s_waitcnt vmcnt(0)" ::: "memory");
        } else {
            XB_SPIN(xb_ld(&bar[XB_XGEN(b.x)]) == gen, bar);
            __builtin_amdgcn_fence(__ATOMIC_ACQUIRE, "agent");
            asm volatile("s_waitcnt vmcnt(0)" ::: "memory");
        }
    }
    __syncthreads();
}

#define LDS_BAR() asm volatile("s_waitcnt lgkmcnt(0)\n\ts_barrier" ::: "memory")
namespace pg8 {
constexpr int BM = 256, BK = 64, HALF = 128, HTB = HALF * BK * 2, STAGE_BYTES = 8 * HTB, NXCD = 8, WGM = 8;
__host__ __device__ __forceinline__ int lds_byte(int r, int c) { const int st = (r >> 4) * 2 + (c >> 5), rr = r & 15, cc = c & 31, ob = rr * 64 + cc * 2; return st * 1024 + (ob ^ (((ob >> 9) & 1) << 5)); }
__host__ __device__ __forceinline__ void stage_rc(int b, int& R, int& C) { const int st = b / 1024, sb = b % 1024, swz = sb ^ (((sb >> 9) & 1) << 5); R = (st >> 1) * 16 + swz / 64; C = (st & 1) * 32 + (swz % 64) / 2; }
__host__ __device__ __forceinline__ int perm32(int rho) { const int n = rho >> 4, i = rho & 15; return 8 * (i >> 2) + 4 * n + (i & 3); }
struct Unit { int pm, pn, aux; };

struct SchedPlain {
    static constexpr bool GATHER = false;
    int nM, nN, nwg, G, c, skipctx;
    __device__ void init(int nM_, int nN_, int G_, int c_, int skipctx_) { nM = nM_; nN = nN_; nwg = nM * nN; G = G_; c = c_; skipctx = skipctx_; }
    __device__ bool next(int i, Unit& u) const {
        const long L = (long)i * G + c; if (L >= nwg) return false;
        int wgid = (int)L; { const int q = nwg / NXCD, r = nwg % NXCD, xcd = wgid % NXCD, off = wgid / NXCD; wgid = (xcd < r ? xcd * (q + 1) : r * (q + 1) + (xcd - r) * q) + off; }
        const int nig = WGM * nN, gid = wgid / nig, fm = gid * WGM, gsz = (nM - fm) < WGM ? (nM - fm) : WGM;
        int pm = fm + ((wgid % nig) % gsz); u.pn = (wgid % nig) / gsz; u.aux = 0;
        if (skipctx) pm = (pm >> 3) * 9 + 1 + (pm & 7);
        u.pm = pm; return true;
    }
    __device__ __forceinline__ int arow(const Unit& u, int r) const { return u.pm * BM + r; }
};
struct SchedRKV : SchedPlain {
    __device__ bool next(int i, Unit& u) const { if (!SchedPlain::next(i, u)) return false; u.pm += (u.pn >> 2) * nM; return true; }
};
template <bool GATH> struct SchedMoe {
    static constexpr bool GATHER = GATH;
    const LAS int* cn; const LAS int* tb; const int* lists; int G, c, total;
    __device__ bool next(int i, Unit& u) const {
        const int U = i * G + c; if (U >= total * 4) return false;
        const int T = U >> 2, pn = U & 3; int l = 0;
        while (tb[l + 1] <= T) ++l;
        u.pm = T; u.pn = (l >> 1) * 4 + pn; u.aux = l | ((T - tb[l]) << 8); return true;
    }
    __device__ __forceinline__ int arow(const Unit& u, int r) const {
        if (!GATH) return u.pm * BM + r;
        const int l = u.aux & 255, idx = (u.aux >> 8) * BM + r;
        return idx < cn[l] ? lists[(size_t)l * TG + idx] : 0;
    }
};

template <class Epi, class Sched>
__device__ __forceinline__ void gemm_phase(const int tid, LAS unsigned char* lds, const bf16_t* A, int lda, const bf16_t* Bt, int ldb, int K, const Sched& S, const Epi& E) {
    constexpr bool GA = Sched::GATHER;
    const int wid = __builtin_amdgcn_readfirstlane(tid >> 6), lane = tid & 63, wr = wid >> 2, wc = wid & 3, fr = lane & 15, fq = lane >> 4;
    const int nt = K / BK;
    unsigned voffA[2], voffB[2];
#pragma unroll
    for (int i = 0; i < 2; ++i) { int R, C; stage_rc(tid * 16 + i * 8192, R, C); const int Rb = (R & ~31) + perm32(R & 31);
        voffA[i] = (unsigned)(R * lda + C) * 2u; voffB[i] = (unsigned)(Rb * ldb + C) * 2u; }
    const size_t kstep = (size_t)(BK * 2);
    const size_t hstepA = (size_t)HALF * lda * 2, tstepA = 2 * hstepA;
    const size_t hstepB = (size_t)HALF * ldb * 2, tstepB = 2 * hstepB;
    const unsigned ldsw = (unsigned)wid * 1024u;
    const int aoff = lds_byte(wr * 64 + fr, fq * 8), boff = lds_byte(wc * 32 + fr, fq * 8);
#define PG8_SA(b, h) (((b) * 2 + (h)) * HTB)
#define PG8_SB(b, h) ((4 + (b) * 2 + (h)) * HTB)
#define PG8_STAGE(bufoff, gbase, voff) do { _Pragma("unroll") for (int _i = 0; _i < 2; ++_i) \
        __builtin_amdgcn_global_load_lds((const unsigned*)((const char*)(gbase) + (voff)[_i]), (LAS unsigned*)(lds + (bufoff) + ldsw + _i * 8192), 16, 0, 0); } while (0)
#define PG8_STAGE_A(bufoff, ub, gv, h, koff) do { if constexpr (GA) { PG8_STAGE(bufoff, (const char*)A + (koff), gv[h]); } else { PG8_STAGE(bufoff, (ub) + (h) * hstepA + (koff), voffA); } } while (0)
#define PG8_LDA(dst, b, h) do { _Pragma("unroll") for (int m = 0; m < 4; ++m) _Pragma("unroll") for (int k = 0; k < 2; ++k) dst[m][k] = *(const LAS bf16x8*)(lds + PG8_SA(b, h) + aoff + m * 2048 + k * 1024); } while (0)
#define PG8_LDB(dst, b, h) do { _Pragma("unroll") for (int n = 0; n < 2; ++n) _Pragma("unroll") for (int k = 0; k < 2; ++k) dst[n][k] = *(const LAS bf16x8*)(lds + PG8_SB(b, h) + boff + n * 2048 + k * 1024); } while (0)
#define PG8_MMA(ai, bj, At, Bt_) do { __builtin_amdgcn_s_setprio(1); _Pragma("unroll") for (int m = 0; m < 4; ++m) _Pragma("unroll") for (int n = 0; n < 2; ++n) _Pragma("unroll") for (int k = 0; k < 2; ++k) \
        acc[ai][bj][m][n] = __builtin_amdgcn_mfma_f32_16x16x32_bf16(Bt_[n][k], At[m][k], acc[ai][bj][m][n], 0, 0, 0); __builtin_amdgcn_s_setprio(0); } while (0)
#define PG8_WAIT_V(n) asm volatile("s_waitcnt vmcnt(" #n ")" ::: "memory")
#define PG8_WAIT_L(n) asm volatile("s_waitcnt lgkmcnt(" #n ")" ::: "memory")
#define PG8_BAR __builtin_amdgcn_s_barrier()
#define PG8_SCHED __builtin_amdgcn_sched_barrier(0)
#define PG8_GOFF(dst, u) do { if constexpr (GA) { _Pragma("unroll") for (int _h = 0; _h < 2; ++_h) _Pragma("unroll") for (int _i = 0; _i < 2; ++_i) { int R_, C_; stage_rc(tid * 16 + _i * 8192, R_, C_); \
        dst[_h][_i] = ((unsigned)S.arow(u, _h * HALF + R_) * (unsigned)lda + (unsigned)C_) * 2u; } } } while (0)
    Unit cur, nxt; int ui = 0;
    if (!S.next(0, cur)) return;
    f32x4 acc[2][2][4][2];
#pragma unroll
    for (int a = 0; a < 2; ++a)
#pragma unroll
        for (int b = 0; b < 2; ++b)
#pragma unroll
            for (int m = 0; m < 4; ++m)
#pragma unroll
                for (int n = 0; n < 2; ++n) acc[a][b][m][n] = (f32x4){0.f, 0.f, 0.f, 0.f};
    bf16x8 At[4][2], B0[2][2], B1[2][2];
    unsigned gAc[2][2], gAn[2][2];
    PG8_GOFF(gAc, cur);
    const char* cA = (const char*)A + (GA ? (size_t)0 : (size_t)cur.pm * tstepA);
    const char* cB = (const char*)Bt + (size_t)cur.pn * tstepB;
    PG8_STAGE(PG8_SB(0, 0), cB, voffB); PG8_STAGE_A(PG8_SA(0, 0), cA, gAc, 0, 0); PG8_STAGE(PG8_SB(0, 1), cB + hstepB, voffB); PG8_STAGE_A(PG8_SA(0, 1), cA, gAc, 1, 0);
    if (wr == 1) PG8_BAR;
    PG8_WAIT_V(4); PG8_BAR;
    PG8_STAGE(PG8_SB(1, 0), cB + kstep, voffB); PG8_STAGE_A(PG8_SA(1, 0), cA, gAc, 0, kstep); PG8_STAGE(PG8_SB(1, 1), cB + hstepB + kstep, voffB);
    PG8_WAIT_V(6); PG8_BAR;
    for (;;) {
        const bool has_next = S.next(ui + 1, nxt);
        if (has_next) { PG8_GOFF(gAn, nxt); }
        else if constexpr (GA) {
#pragma unroll
            for (int _h = 0; _h < 2; ++_h)
#pragma unroll
                for (int _i = 0; _i < 2; ++_i) gAn[_h][_i] = gAc[_h][_i];
        }
        const char* nA = (has_next && !GA) ? (const char*)A + (size_t)nxt.pm * tstepA : cA;
        const char* nB = has_next ? (const char*)Bt + (size_t)nxt.pn * tstepB : cB;
#pragma unroll 1
        for (int t = 0; t < nt; t += 2) {
            const bool last = (t == nt - 2);
            const size_t k1 = (size_t)(t + 1) * kstep;
            const size_t k2 = last ? (size_t)0 : (size_t)(t + 2) * kstep, k3 = k2 + kstep;
            const char* a2 = last ? nA : cA; const char* b2 = last ? nB : cB;
            unsigned g2[2][2];
            if constexpr (GA) {
#pragma unroll
                for (int _h = 0; _h < 2; ++_h)
#pragma unroll
                    for (int _i = 0; _i < 2; ++_i) g2[_h][_i] = last ? gAn[_h][_i] : gAc[_h][_i];
            }
            PG8_LDB(B0, 0, 0); PG8_SCHED; PG8_LDA(At, 0, 0); PG8_STAGE_A(PG8_SA(1, 1), cA, gAc, 1, k1);
            PG8_WAIT_L(8); PG8_BAR; PG8_WAIT_L(0); PG8_MMA(0, 0, At, B0); PG8_BAR; PG8_SCHED;
            PG8_LDB(B1, 0, 1); PG8_STAGE(PG8_SB(0, 0), b2 + k2, voffB);
            PG8_BAR; PG8_WAIT_L(0); PG8_MMA(0, 1, At, B1); PG8_BAR;
            PG8_LDA(At, 0, 1); PG8_STAGE_A(PG8_SA(0, 0), a2, g2, 0, k2);
            PG8_BAR; PG8_WAIT_L(0); PG8_MMA(1, 0, At, B0); PG8_BAR; PG8_SCHED;
            PG8_STAGE(PG8_SB(0, 1), b2 + hstepB + k2, voffB);
            PG8_WAIT_V(6); PG8_BAR; PG8_MMA(1, 1, At, B1); PG8_BAR;
            PG8_LDB(B0, 1, 0); PG8_SCHED; PG8_LDA(At, 1, 0); PG8_STAGE_A(PG8_SA(0, 1), a2, g2, 1, k2);
            PG8_WAIT_L(8); PG8_BAR; PG8_WAIT_L(0); PG8_MMA(0, 0, At, B0); PG8_BAR; PG8_SCHED;
            PG8_LDB(B1, 1, 1); PG8_STAGE(PG8_SB(1, 0), b2 + k3, voffB);
            PG8_BAR; PG8_WAIT_L(0); PG8_MMA(0, 1, At, B1); PG8_BAR;
            PG8_LDA(At, 1, 1); PG8_STAGE_A(PG8_SA(1, 0), a2, g2, 0, k3);
            PG8_BAR; PG8_WAIT_L(0); PG8_MMA(1, 0, At, B0); PG8_BAR; PG8_SCHED;
            PG8_STAGE(PG8_SB(1, 1), b2 + hstepB + k3, voffB);
            PG8_WAIT_V(6); PG8_BAR; PG8_MMA(1, 1, At, B1); PG8_BAR;
        }
        { int fr_e = fr, fq_e = fq; asm volatile("" : "+v"(fr_e), "+v"(fq_e)); E(acc, cur, wr, wc, fr_e, fq_e); }
        if (!has_next) break;
#pragma unroll
        for (int a = 0; a < 2; ++a)
#pragma unroll
            for (int b = 0; b < 2; ++b)
#pragma unroll
                for (int m = 0; m < 4; ++m)
#pragma unroll
                    for (int n = 0; n < 2; ++n) acc[a][b][m][n] = (f32x4){0.f, 0.f, 0.f, 0.f};
        cur = nxt; cA = nA; cB = nB; ++ui;
        if constexpr (GA) {
#pragma unroll
            for (int _h = 0; _h < 2; ++_h)
#pragma unroll
                for (int _i = 0; _i < 2; ++_i) gAc[_h][_i] = gAn[_h][_i];
        }
    }
    PG8_WAIT_V(0);
    if (wr == 0) PG8_BAR;
    PG8_BAR;
#undef PG8_SA
#undef PG8_SB
#undef PG8_STAGE
#undef PG8_STAGE_A
#undef PG8_LDA
#undef PG8_LDB
#undef PG8_MMA
#undef PG8_WAIT_V
#undef PG8_WAIT_L
#undef PG8_BAR
#undef PG8_SCHED
#undef PG8_GOFF
}
}
using pg8::Unit;

#define EPI_LOOP_BEGIN \
    _Pragma("unroll") for (int ai = 0; ai < 2; ++ai) _Pragma("unroll") for (int m = 0; m < 4; ++m) { const int trow = ai * 128 + wr * 64 + m * 16 + fr; \
    _Pragma("unroll") for (int bj = 0; bj < 2; ++bj) { const int tcol = bj * 128 + wc * 32 + 8 * fq; const f32x4 v0 = acc[ai][bj][m][0], v1 = acc[ai][bj][m][1];
#define EPI_LOOP_END } asm volatile("" ::: "memory"); }
__device__ __forceinline__ u32x4 pk8(const f32x4 a, const f32x4 b) { return (u32x4){pk2(a[0], a[1]), pk2(a[2], a[3]), pk2(b[0], b[1]), pk2(b[2], b[3])}; }

struct EpiRKV {
    unsigned char* ws; size_t voff;
    __device__ __forceinline__ void operator()(const f32x4 (&acc)[2][2][4][2], const Unit& u, int wr, int wc, int fr, int fq) const {
        const int which = u.pn >> 2; const size_t row0 = (size_t)(u.pm - which * (TG / 256)) * 256;
        const size_t off = which == 0 ? (WS_ARENA + AR_R) : (which == 1 ? (WS_ARENA + AR_K) : voff);
        bf16_t* dst = (bf16_t*)(ws + off); const int cb = (u.pn & 3) * 256;
        EPI_LOOP_BEGIN
            *(u32x4*)(dst + (row0 + trow) * D + cb + tcol) = pk8(v0, v1);
        EPI_LOOP_END
    }
};
struct EpiL1 {
    bf16_t* L1;
    __device__ __forceinline__ void operator()(const f32x4 (&acc)[2][2][4][2], const Unit& u, int wr, int wc, int fr, int fq) const {
        const int pn = u.pn; const size_t row0 = (size_t)u.pm * 256; const int cb = pn * 256;
        EPI_LOOP_BEGIN
            f32x4 o0 = v0, o1 = v1;
            if (pn == 0 && bj == 0) { _Pragma("unroll") for (int e = 0; e < 4; ++e) { o0[e] = tanhf_(v0[e]); o1[e] = tanhf_(v1[e]); } }
            if (pn == 1 && bj == 0) { _Pragma("unroll") for (int e = 0; e < 4; ++e) { o0[e] = sigmoidf_(v0[e]); o1[e] = sigmoidf_(v1[e]); } }
            *(u32x4*)(L1 + (row0 + trow) * 512 + cb + tcol) = pk8(o0, o1);
        EPI_LOOP_END
    }
};
template <int ACT> struct EpiStore {
    bf16_t* O; const float* bias;
    __device__ __forceinline__ void operator()(const f32x4 (&acc)[2][2][4][2], const Unit& u, int wr, int wc, int fr, int fq) const {
        const size_t row0 = (size_t)u.pm * 256; const int cb = u.pn * 256;
        f32x4 bv[2][2];
#pragma unroll
        for (int bj = 0; bj < 2; ++bj)
#pragma unroll
            for (int n = 0; n < 2; ++n) bv[bj][n] = ACT == 1 ? *(const f32x4*)(bias + cb + bj * 128 + wc * 32 + 8 * fq + 4 * n) : (f32x4){0.f, 0.f, 0.f, 0.f};
        EPI_LOOP_BEGIN
            f32x4 o0 = v0, o1 = v1;
            if (ACT == 1) { _Pragma("unroll") for (int e = 0; e < 4; ++e) { o0[e] = sigmoidf_(v0[e] + bv[bj][0][e]); o1[e] = sigmoidf_(v1[e] + bv[bj][1][e]); } }
            *(u32x4*)(O + (row0 + trow) * D + cb + tcol) = pk8(o0, o1);
        EPI_LOOP_END
    }
};
struct EpiGelu {
    bf16_t* Z; const float* bias;
    __device__ __forceinline__ void operator()(const f32x4 (&acc)[2][2][4][2], const Unit& u, int wr, int wc, int fr, int fq) const {
        const size_t row0 = (size_t)u.pm * 256; const int cb = u.pn * 256;
        f32x4 bv[2][2];
#pragma unroll
        for (int bj = 0; bj < 2; ++bj)
#pragma unroll
            for (int n = 0; n < 2; ++n) bv[bj][n] = *(const f32x4*)(bias + cb + bj * 128 + wc * 32 + 8 * fq + 4 * n);
        EPI_LOOP_BEGIN
            const f32x4 b0 = bv[bj][0], b1 = bv[bj][1];
            const f32x2 g0 = gelu_pk((f32x2){v0[0] + b0[0], v0[1] + b0[1]}), g1 = gelu_pk((f32x2){v0[2] + b0[2], v0[3] + b0[3]});
            const f32x2 g2 = gelu_pk((f32x2){v1[0] + b1[0], v1[1] + b1[1]}), g3 = gelu_pk((f32x2){v1[2] + b1[2], v1[3] + b1[3]});
            *(u32x4*)(Z + (row0 + trow) * 4096 + cb + tcol) = (u32x4){pk2(g0.x, g0.y), pk2(g1.x, g1.y), pk2(g2.x, g2.y), pk2(g3.x, g3.y)};
        EPI_LOOP_END
    }
};
struct EpiMG {
    bf16_t* HE;
    __device__ __forceinline__ void operator()(const f32x4 (&acc)[2][2][4][2], const Unit& u, int wr, int wc, int fr, int fq) const {
        const size_t row0 = (size_t)u.pm * 256; const int pnl = u.pn & 3;
#pragma unroll
        for (int ai = 0; ai < 2; ++ai)
#pragma unroll
            for (int m = 0; m < 4; ++m) { const int trow = ai * 128 + wr * 64 + m * 16 + fr;
#pragma unroll
                for (int bj = 0; bj < 2; ++bj) {
                    const f32x4 gt = acc[ai][bj][m][0], up = acc[ai][bj][m][1];
                    const int f = (8 * pnl + 4 * bj + wc) * 16 + 4 * fq;
                    float o[4];
#pragma unroll
                    for (int e = 0; e < 4; ++e) o[e] = gt[e] * sigmoidf_(gt[e]) * up[e];
                    u32x2 w; w.x = pk2(o[0], o[1]); w.y = pk2(o[2], o[3]);
                    *(u32x2*)(HE + (row0 + trow) * FEXP + f) = w;
                } }
    }
};
struct EpiMD {
    bf16_t* Y0; const int* lists; const float* lw; const LAS int* cn;
    __device__ __forceinline__ void operator()(const f32x4 (&acc)[2][2][4][2], const Unit& u, int wr, int wc, int fr, int fq) const {
        const int l = u.aux & 255, t0 = (u.aux >> 8) * 256, cnt = cn[l]; const int cb = (u.pn & 3) * 256;
        bf16_t* Y = Y0 + (size_t)(l & 1) * ((AR_YM1 - AR_YM0) / 2);
        int tok[2][4]; float wgt[2][4];
#pragma unroll
        for (int ai = 0; ai < 2; ++ai)
#pragma unroll
            for (int m = 0; m < 4; ++m) { const int idx = t0 + ai * 128 + wr * 64 + m * 16 + fr; const bool ok = idx < cnt;
                tok[ai][m] = ok ? lists[(size_t)l * TG + idx] : -1; wgt[ai][m] = ok ? lw[(size_t)l * TG + idx] : 0.f; }
#pragma unroll
        for (int ai = 0; ai < 2; ++ai)
#pragma unroll
            for (int m = 0; m < 4; ++m) {
                if (tok[ai][m] >= 0) {
                    const float wg = wgt[ai][m]; bf16_t* yr = Y + (size_t)tok[ai][m] * D + cb;
#pragma unroll
                    for (int bj = 0; bj < 2; ++bj) { const int tcol = bj * 128 + wc * 32 + 8 * fq;
                        *(u32x4*)(yr + tcol) = pk8(acc[ai][bj][m][0] * wg, acc[ai][bj][m][1] * wg); }
                } }
    }
};

struct Frame {
    const Params __attribute__((address_space(4)))* kp; LAS unsigned char* lds; int tid, lane, wave, G, bid;
    unsigned char* ws;
    __device__ __forceinline__ const float* in(int k) const { return kp->in[k]; }
    __device__ __forceinline__ float* outp() const { return kp->out; }
    __device__ __forceinline__ int rowblk() const { return (G % 8 == 0) ? (bid % 8) * (G / 8) + bid / 8 : bid; }
    template <class T> __device__ __forceinline__ T* wsp(size_t off) const { return (T*)(ws + off); }
    template <class T> __device__ __forceinline__ T* ar(size_t off) const { return (T*)(ws + WS_ARENA + off); }
    __device__ __forceinline__ const float* modL(int layer, int b, int j) const { return (const float*)(ws + WS_MODL) + (((size_t)layer * NB + b) * 6 + j) * D; }
    __device__ __forceinline__ const float* modC(int layer, int j) const { return (const float*)(ws + WS_MODC) + ((size_t)layer * 6 + j) * D; }
};

struct TJob { const float* src; bf16_t* dst; const float* ksc; int lds, K, N, ldd, kofs, nofs, inter; };
constexpr int NJOBS = 2 * 21 + 1 + 4 + 4 * NEXP * 3;
__device__ __forceinline__ TJob get_job(const Frame& F, int j) {
    TJob J; J.ksc = nullptr; J.kofs = 0; J.nofs = 0; J.inter = 0; J.K = 0; J.N = 0; J.lds = 0; J.ldd = 0; J.src = nullptr; J.dst = nullptr;
    if (j < 42) {
        const int a = j / 21, q = j % 21;
        if (q < 3) { J.src = F.in(9 + q) + (size_t)a * D * D; J.lds = D; J.K = D; J.N = D; J.dst = F.wsp<bf16_t>(WS_WRKV) + (size_t)a * 3072 * D; J.ldd = D; J.nofs = q * 1024; }
        else if (q < 15) {
            const int half = (q - 3) / 6, w = (q - 3) % 6; const float* mu = F.in(8) + (size_t)a * 6 * D;
            J.dst = F.wsp<bf16_t>(WS_WL) + (size_t)a * 512 * K1CAT; J.ldd = K1CAT; J.kofs = half * 1024; J.K = D; int mi = 0;
            if (w < 2) { J.src = F.in(14) + ((size_t)a * 2 + w) * D * 64; J.lds = 64; J.N = 64; J.nofs = w * 64; mi = 1; }
            else if (w < 4) { const int d = w - 2; J.src = F.in(17) + ((size_t)a * 2 + d) * D * 64; J.lds = 64; J.N = 64; J.nofs = 128 + d * 64; mi = 4; }
            else if (w == 4) { J.src = F.in(22) + (size_t)a * D * 128; J.lds = 128; J.N = 128; J.nofs = 256; mi = 5; }
            else { J.src = F.in(20); J.lds = 32; J.N = (a == 1) ? 32 : 0; J.nofs = 384; mi = 3; }
            if (half) J.ksc = mu + mi * D;
        } else if (q == 15) { J.src = F.in(12) + (size_t)a * D * D; J.lds = D; J.K = D; J.N = D; J.dst = F.wsp<bf16_t>(WS_WO) + (size_t)a * D * D; J.ldd = D; }
        else if (q == 16) { J.src = F.in(23) + (size_t)a * 128 * D; J.lds = D; J.K = 128; J.N = D; J.dst = F.wsp<bf16_t>(WS_G2T) + (size_t)a * D * 256; J.ldd = 256; }
        else if (q < 19) { const int d = q - 17; J.src = F.in(15) + ((size_t)a * 2 + d) * 64 * D; J.lds = D; J.K = 64; J.N = D; J.dst = F.wsp<bf16_t>(WS_W2T) + ((size_t)a * 2 + d) * D * 64; J.ldd = 64; }
        else { const int d = q - 19; J.src = F.in(18) + ((size_t)a * 2 + d) * 64 * D; J.lds = D; J.K = 64; J.N = D; J.dst = F.wsp<bf16_t>(WS_A2T) + ((size_t)a * 2 + d) * D * 64; J.ldd = 64; }
    } else if (j == 42) { J.src = F.in(21); J.lds = D; J.K = 32; J.N = D; J.dst = F.wsp<bf16_t>(WS_V2T); J.ldd = 256; J.kofs = 128; }
    else if (j < 47) {
        const int q = j - 43, b = q >> 1;
        if ((q & 1) == 0) { J.src = F.in(29) + (size_t)b * D * 4096; J.lds = 4096; J.K = D; J.N = 4096; J.dst = F.wsp<bf16_t>(WS_WIN) + (size_t)b * 4096 * D; J.ldd = D; }
        else { J.src = F.in(35) + (size_t)b * 2048 * D; J.lds = D; J.K = 2048; J.N = D; J.dst = F.wsp<bf16_t>(WS_WOUT) + (size_t)b * D * 2048; J.ldd = 2048; }
    } else {
        const int q = j - 47, ie = q / 3, w = q % 3;
        if (w < 2) { J.src = F.in(38 + w) + (size_t)ie * D * FEXP; J.lds = FEXP; J.K = D; J.N = FEXP; J.dst = F.wsp<bf16_t>(WS_WGU) + (size_t)ie * 1024 * D; J.ldd = D; J.nofs = w * 4; J.inter = 1; }
        else { J.src = F.in(40) + (size_t)ie * FEXP * D; J.lds = D; J.K = FEXP; J.N = D; J.dst = F.wsp<bf16_t>(WS_WD) + (size_t)ie * D * FEXP; J.ldd = FEXP; }
    }
    return J;
}
__device__ __forceinline__ void transpose_all(const Frame& F) {
    LAS unsigned* T = (LAS unsigned*)F.lds;
    LAS int* tab = (LAS int*)(F.lds + 32768);
    __syncthreads();
#pragma unroll 1
    for (int jj = F.wave; jj < NJOBS; jj += NWAVES) { const TJob J = get_job(F, jj); LAS int* e = tab + jj * 16;
        e[0] = (int)(unsigned)(size_t)J.src; e[1] = (int)(unsigned)((size_t)J.src >> 32); e[2] = (int)(unsigned)(size_t)J.dst; e[3] = (int)(unsigned)((size_t)J.dst >> 32);
        e[4] = (int)(unsigned)(size_t)J.ksc; e[5] = (int)(unsigned)((size_t)J.ksc >> 32); e[6] = J.lds; e[7] = J.K; e[8] = J.N; e[9] = J.ldd; e[10] = J.kofs; e[11] = J.nofs; e[12] = J.inter;
        const int tn_ = (J.N + 127) / 128; e[13] = ((J.K + 127) / 128) * tn_; e[15] = tn_; }
    __syncthreads();
    for (int jj = F.tid; jj < NJOBS; jj += NTHREADS) { int acc = 0; for (int i = 0; i < jj; ++i) acc += tab[i * 16 + 13]; tab[jj * 16 + 14] = acc; }
    __syncthreads();
#define TJI(j_, f_) __builtin_amdgcn_readfirstlane(tab[(j_) * 16 + (f_)])
#define TJP(T_, j_, f_) ((T_)(size_t)(((unsigned long long)(unsigned)TJI(j_, (f_) + 1) << 32) | (unsigned long long)(unsigned)TJI(j_, f_)))
    int j = 0, t = 0;
#define TR_ENTER() do { t = (F.bid - (TJI(j, 14) % F.G) + F.G) % F.G; } while (0)
#define TR_SKIP() do { while (j < NJOBS && t >= TJI(j, 13)) { ++j; if (j < NJOBS) TR_ENTER(); } } while (0)
#define TR_LOAD() do { const int jl_ = j < NJOBS ? j : NJOBS - 1, tl_ = j < NJOBS ? t : 0; \
        const int tn_ = TJI(jl_, 15), K_ = TJI(jl_, 7), N_ = TJI(jl_, 8), ls_ = TJI(jl_, 6); const float* src_ = TJP(const float*, jl_, 0); \
        const int k0_ = (tl_ / tn_) * 128, n0_ = (tl_ % tn_) * 128; _Pragma("unroll") for (int e = 0; e < 4; ++e) { const int idx = F.tid + e * 512, n4 = idx & 31, kp = idx >> 5; \
        const bool ok_ = (k0_ + 2 * kp < K_) && (n0_ + 4 * n4 < N_); const float* q_ = src_ + (ok_ ? ((size_t)(k0_ + 2 * kp) * ls_ + n0_ + 4 * n4) : (size_t)0); \
        const f32x4 x0_ = *(const f32x4*)q_, x1_ = *(const f32x4*)(q_ + (ok_ ? ls_ : 0)); const f32x4 z_ = (f32x4){0.f, 0.f, 0.f, 0.f}; va[e] = ok_ ? x0_ : z_; vb[e] = ok_ ? x1_ : z_; } } while (0)
    TR_ENTER(); TR_SKIP();
    f32x4 va[4], vb[4];
    TR_LOAD();
#pragma unroll 1
    while (j < NJOBS) {
        const int jc = j, tnc = TJI(jc, 15), Kc = TJI(jc, 7), Nc = TJI(jc, 8), k0 = (t / tnc) * 128, n0 = (t % tnc) * 128;
        const float* ksc = TJP(const float*, jc, 4);
        LDS_BAR();
#pragma unroll
        for (int e = 0; e < 4; ++e) { const int idx = F.tid + e * 512, n4 = idx & 31, kp = idx >> 5;
            float s0 = 1.f, s1 = 1.f; if (ksc && k0 + 2 * kp < Kc) { s0 = ksc[k0 + 2 * kp]; s1 = ksc[k0 + 2 * kp + 1]; }
            LAS unsigned* q = T + (4 * n4) * 64 + (((kp >> 2) ^ (n4 & 15)) << 2) + (kp & 3);
            q[0] = pk2(va[e][0] * s0, vb[e][0] * s1); q[64] = pk2(va[e][1] * s0, vb[e][1] * s1); q[128] = pk2(va[e][2] * s0, vb[e][2] * s1); q[192] = pk2(va[e][3] * s0, vb[e][3] * s1); }
        t += F.G; TR_SKIP();
        TR_LOAD();
        LDS_BAR();
        bf16_t* dst = TJP(bf16_t*, jc, 2); const int ldd = TJI(jc, 9), kofs = TJI(jc, 10), nofs = TJI(jc, 11), inter = TJI(jc, 12);
#pragma unroll
        for (int e = 0; e < 4; ++e) { const int idx = F.tid + e * 512, kg = idx & 15, nn = idx >> 4;
            if (k0 + 8 * kg < Kc && n0 + nn < Nc) { const int n = n0 + nn; const int row = nofs + (inter ? ((n >> 4) * 32 + ((n & 15) >> 2) * 8 + (n & 3)) : n);
                *(u32x4*)(dst + (size_t)row * ldd + kofs + k0 + 8 * kg) = *(const LAS u32x4*)(T + nn * 64 + ((kg ^ ((nn >> 2) & 15)) << 2)); } }
    }
#undef TR_ENTER
#undef TR_SKIP
#undef TR_LOAD
#undef TJI
#undef TJP
    __syncthreads();
}
__device__ __forceinline__ void zero_rows(const Frame& F, bf16_t* dst, int ldd, int row0, int nrows, int col0, int ncols) {
    const int per = ncols / 8; const long tot = (long)nrows * per;
    for (long i = (long)F.bid * NTHREADS + F.tid; i < tot; i += (long)F.G * NTHREADS) { const int r = (int)(i / per), c = (int)(i % per) * 8;
        *(u32x4*)(dst + (size_t)(row0 + r) * ldd + col0 + c) = (u32x4){0u, 0u, 0u, 0u}; }
}
__device__ __forceinline__ void phase_prologue(const Frame& F) {
    {
        LAS float* sl = (LAS float*)F.lds;
        LAS float* red = (LAS float*)(F.lds + 33 * 256 * 4);
        LAS float* cred = red + 8 * 32 * 64;
        const float* c = F.in(1); const float* cc = F.in(3); const float* wm = F.in(4); const float* bm = F.in(5);
        const int wv = F.wave, li = F.lane & 15, kq = F.lane >> 4;
        for (int unit = F.bid; unit < 4 * 96; unit += F.G) {
            const int layer = unit / 96, col0 = (unit % 96) * 64;
            f32x4 acc[2][4]; float cacc[4];
#pragma unroll
            for (int nt = 0; nt < 4; ++nt) { acc[0][nt] = (f32x4){0.f, 0.f, 0.f, 0.f}; acc[1][nt] = acc[0][nt]; cacc[nt] = 0.f; }
#pragma unroll 1
            for (int kc = 0; kc < 4; ++kc) {
                float xs[17];
#pragma unroll
                for (int e = 0; e < 17; ++e) { const int i = F.tid + e * NTHREADS, r = i >> 8, k = (i & 255) + kc * 256; xs[e] = i < 33 * 256 ? (r < 32 ? c[r * D + k] : cc[k]) : 0.f; }
                float w[2][4][4];
#pragma unroll
                for (int gq = 0; gq < 2; ++gq)
#pragma unroll
                    for (int st = 0; st < 4; ++st)
#pragma unroll
                        for (int nt = 0; nt < 4; ++nt) w[gq][st][nt] = wm[((size_t)layer * D + kc * 256 + wv * 32 + 16 * gq + 4 * kq + st) * 6144 + col0 + 16 * nt + li];
                LDS_BAR();
#pragma unroll
                for (int e = 0; e < 17; ++e) { const int i = F.tid + e * NTHREADS; if (i < 33 * 256) sl[i] = xs[e] * sigmoidf_(xs[e]); }
                LDS_BAR();
#pragma unroll
                for (int gq = 0; gq < 2; ++gq) {
                    const int kl = wv * 32 + 16 * gq + 4 * kq;
                    const f32x4 a0 = *(const LAS f32x4*)(sl + li * 256 + kl), a1 = *(const LAS f32x4*)(sl + (16 + li) * 256 + kl), ac = *(const LAS f32x4*)(sl + 32 * 256 + kl);
#pragma unroll
                    for (int st = 0; st < 4; ++st)
#pragma unroll
                        for (int nt = 0; nt < 4; ++nt) {
                            acc[0][nt] = __builtin_amdgcn_mfma_f32_16x16x4f32(a0[st], w[gq][st][nt], acc[0][nt], 0, 0, 0);
                            acc[1][nt] = __builtin_amdgcn_mfma_f32_16x16x4f32(a1[st], w[gq][st][nt], acc[1][nt], 0, 0, 0);
                            cacc[nt] = __builtin_fmaf(ac[st], w[gq][st][nt], cacc[nt]);
                        }
                }
            }
            LDS_BAR();
#pragma unroll
            for (int mt = 0; mt < 2; ++mt)
#pragma unroll
                for (int nt = 0; nt < 4; ++nt)
#pragma unroll
                    for (int r = 0; r < 4; ++r) red[(wv * 32 + mt * 16 + 4 * kq + r) * 64 + 16 * nt + li] = acc[mt][nt][r];
#pragma unroll
            for (int nt = 0; nt < 4; ++nt) cred[(wv * 4 + kq) * 64 + 16 * nt + li] = cacc[nt];
            LDS_BAR();
            for (int i = F.tid; i < 33 * 64; i += NTHREADS) { const int r = i >> 6, x = i & 63; float s = 0.f;
                if (r < 32) {
#pragma unroll
                    for (int y = 0; y < 8; ++y) s += red[(y * 32 + r) * 64 + x];
                } else {
#pragma unroll
                    for (int y = 0; y < 32; ++y) s += cred[y * 64 + x];
                }
                const int col = col0 + x; s += bm[layer * 6144 + col];
                if (r < 32) F.wsp<float>(WS_MODL)[((size_t)layer * NB + r) * 6144 + col] = s; else F.wsp<float>(WS_MODC)[(size_t)layer * 6144 + col] = s; }
        }
    }
    __syncthreads();
    transpose_all(F);
    for (int a = 0; a < 2; ++a) {
        bf16_t* WLp = F.wsp<bf16_t>(WS_WL) + (size_t)a * 512 * K1CAT;
        if (a == 0) zero_rows(F, WLp, K1CAT, 384, 128, 0, K1CAT); else zero_rows(F, WLp, K1CAT, 416, 96, 0, K1CAT);
        zero_rows(F, F.wsp<bf16_t>(WS_G2T) + (size_t)a * D * 256, 256, 0, D, 128, 128);
    }
    zero_rows(F, F.wsp<bf16_t>(WS_V2T), 256, 0, D, 0, 128); zero_rows(F, F.wsp<bf16_t>(WS_V2T), 256, 0, D, 160, 96);
    {
        const float* src = F.in(33); bf16_t* dst = F.wsp<bf16_t>(WS_WSP); const long tot = (long)2 * 16 * 128 * 128 / 4;
        for (long i = (long)F.bid * NTHREADS + F.tid; i < tot; i += (long)F.G * NTHREADS) { const f32x4 v = *(const f32x4*)(src + i * 4); u32x2 w; w.x = pk2(v[0], v[1]); w.y = pk2(v[2], v[3]); *(u32x2*)(dst + i * 4) = w; }
    }
    __syncthreads();
}

__device__ __forceinline__ void phase_norm1(const Frame& F, int g, int layer  , bf16_t* dst, int ldh, bool dry = false) {
    bf16_t* X = F.wsp<bf16_t>(WS_X);
    const bf16_t* Y0 = F.ar<bf16_t>(AR_YM0); const bf16_t* Y1 = F.ar<bf16_t>(AR_YM1);
    const bool fin = layer == 4;
    const int rpb = (TG + F.G - 1) / F.G, rbeg = F.rowblk() * rpb, rend = (rbeg + rpb) < TG ? (rbeg + rpb) : TG;
    int key = -1; f32x4 cg[4], cA[4], cB[4];
#pragma unroll
    for (int q = 0; q < 4; ++q) { cg[q] = (f32x4){0.f, 0.f, 0.f, 0.f}; cA[q] = cg[q]; cB[q] = cg[q]; }
    f32x4 nf[4]; u32x2 nxw[4], na[4], nb[4];
#pragma unroll
    for (int q = 0; q < 4; ++q) { nf[q] = (f32x4){0.f, 0.f, 0.f, 0.f}; nxw[q] = (u32x2){0u, 0u}; na[q] = nxw[q]; nb[q] = nxw[q]; }
#define N1_FETCH(rr_) do { const int rq_ = (rr_) < rend ? (rr_) : rbeg; \
        if (layer == 0) { const int bl_ = rq_ / LT, t_ = rq_ % LT, b_ = g * BG + bl_; \
            const float* src_ = t_ < LC ? F.in(2) + ((size_t)b_ * LC + t_) * D : F.in(0) + ((size_t)b_ * SEQ + (t_ - LC)) * D; \
            _Pragma("unroll") for (int q = 0; q < 4; ++q) nf[q] = *(const f32x4*)(src_ + q * 256 + F.lane * 4); } \
        else { _Pragma("unroll") for (int q = 0; q < 4; ++q) { const int c = q * 256 + F.lane * 4; \
            nxw[q] = *(const u32x2*)(X + (size_t)rq_ * D + c); na[q] = *(const u32x2*)(Y0 + (size_t)rq_ * D + c); nb[q] = *(const u32x2*)(Y1 + (size_t)rq_ * D + c); } } } while (0)
    N1_FETCH(rbeg + F.wave);
    for (int r = rbeg + F.wave; r < rend; r += NWAVES) {
        const int bl = r / LT, t = r % LT, b = g * BG + bl; const bool isctx = t < LC;
        f32x4 cf[4]; u32x2 cxw[4], ca[4], cb2[4];
#pragma unroll
        for (int q = 0; q < 4; ++q) { cf[q] = nf[q]; cxw[q] = nxw[q]; ca[q] = na[q]; cb2[q] = nb[q]; }
        N1_FETCH(r + NWAVES);
        if (isctx && layer >= 3) continue;
        if (key != b * 2 + (int)isctx) {
            key = b * 2 + (int)isctx;
#pragma unroll
            for (int q = 0; q < 4; ++q) { const int c = q * 256 + F.lane * 4;
                if (layer > 0) cg[q] = *(const f32x4*)((isctx ? F.modC(layer - 1, 5) : F.modL(layer - 1, b, 5)) + c);
                if (fin) cA[q] = *(const f32x4*)(F.in(41) + c);
                else { const f32x4 gv = *(const f32x4*)(F.in(6) + (size_t)layer * D + c), cv = *(const f32x4*)((isctx ? F.modC(layer, 1) : F.modL(layer, b, 1)) + c);
                    cA[q] = gv * (1.0f + cv); cB[q] = *(const f32x4*)((isctx ? F.modC(layer, 0) : F.modL(layer, b, 0)) + c); } }
        }
        f32x4 x[4], xo[4];
#pragma unroll
        for (int q = 0; q < 4; ++q) xo[q] = (f32x4){0.f, 0.f, 0.f, 0.f};
        if (layer == 0) {
#pragma unroll
            for (int q = 0; q < 4; ++q) x[q] = cf[q];
        } else {
#pragma unroll
            for (int q = 0; q < 4; ++q) {
                { const u32x2 xw = cxw[q]; x[q] = (f32x4){lo16(xw.x), hi16(xw.x), lo16(xw.y), hi16(xw.y)}; } xo[q] = x[q];
                const u32x2 a = ca[q], bb = cb2[q];
                x[q][0] += cg[q][0] * (lo16(a.x) + lo16(bb.x)); x[q][1] += cg[q][1] * (hi16(a.x) + hi16(bb.x));
                x[q][2] += cg[q][2] * (lo16(a.y) + lo16(bb.y)); x[q][3] += cg[q][3] * (hi16(a.y) + hi16(bb.y)); }
        }
        float ss = 0.f;
#pragma unroll
        for (int q = 0; q < 4; ++q) ss += x[q][0] * x[q][0] + x[q][1] * x[q][1] + x[q][2] * x[q][2] + x[q][3] * x[q][3];
        ss = wave_sum_dpp(ss);
        const float rstd = rsqrtf(ss * (1.0f / D) + 1e-6f);
        if (fin) {
            float* o = F.outp() + ((size_t)b * SEQ + (t - LC)) * D;
#pragma unroll
            for (int q = 0; q < 4; ++q) { const int c = q * 256 + F.lane * 4; *(f32x4*)(o + c) = x[q] * rstd * cA[q]; }
        } else {
#pragma unroll
            for (int q = 0; q < 4; ++q) { const int c = q * 256 + F.lane * 4;
                { const f32x4 xs = (dry && layer > 0) ? xo[q] : x[q]; u32x2 xw; xw.x = pk2(xs[0], xs[1]); xw.y = pk2(xs[2], xs[3]); *(u32x2*)(X + (size_t)r * D + c) = xw; }
                const f32x4 h = x[q] * rstd * cA[q] + cB[q];
                u32x2 w; w.x = pk2(h[0], h[1]); w.y = pk2(h[2], h[3]);
                *(u32x2*)(dst + (size_t)r * ldh + c) = w; }
        }
    }
}
#undef N1_FETCH
__device__ __forceinline__ void phase_mix(const Frame& F, int a) {
    bf16_t* H2 = F.ar<bf16_t>(AR_H2); bf16_t* XM = F.ar<bf16_t>(AR_XR);
    const float* mu = F.in(8) + (size_t)a * 6 * D;
    f32x4 cm[2][3][2];
#pragma unroll
    for (int q = 0; q < 2; ++q)
#pragma unroll
        for (int m = 0; m < 3; ++m) { const int mi = m == 0 ? 0 : (m == 1 ? 2 : 3); const int c = q * 512 + F.lane * 8;
            cm[q][m][0] = *(const f32x4*)(mu + mi * D + c); cm[q][m][1] = *(const f32x4*)(mu + mi * D + c + 4); }
    const int rpb = (TG + F.G - 1) / F.G, rbeg = F.rowblk() * rpb, rend = (rbeg + rpb) < TG ? (rbeg + rpb) : TG;
    u32x4 nhs[2], nhn[2];
#define MIX_FETCH(rr_) do { const int rq_ = (rr_) < rend ? (rr_) : rbeg; const int t_ = rq_ % LT; const bool ic_ = t_ < LC; const int p_ = t_ - LC; \
        _Pragma("unroll") for (int q = 0; q < 2; ++q) { const int c = q * 512 + F.lane * 8; int nr; \
            if (ic_) nr = (q == 0) ? (t_ > 0 ? rq_ - 1 : -1) : (t_ < LC - 1 ? rq_ + 1 : -1); \
            else { const int qu = c >> 8; \
                nr = qu == 0 ? ((p_ & 63) > 0 ? rq_ - 1 : -1) : qu == 1 ? ((p_ & 63) < 63 ? rq_ + 1 : -1) : qu == 2 ? (p_ >= 64 ? rq_ - 64 : -1) : (p_ < SEQ - 64 ? rq_ + 64 : -1); } \
            nhs[q] = *(const u32x4*)(H2 + (size_t)rq_ * 2048 + c); \
            const u32x4 hv_ = *(const u32x4*)(H2 + (size_t)(nr >= 0 ? nr : rq_) * 2048 + c); nhn[q] = nr >= 0 ? hv_ : (u32x4){0u, 0u, 0u, 0u}; } } while (0)
    MIX_FETCH(rbeg + F.wave);
    for (int r = rbeg + F.wave; r < rend; r += NWAVES) {
        u32x4 chs[2], chn[2];
#pragma unroll
        for (int q = 0; q < 2; ++q) { chs[q] = nhs[q]; chn[q] = nhn[q]; }
        MIX_FETCH(r + NWAVES);
#pragma unroll
        for (int q = 0; q < 2; ++q) {
            const int c = q * 512 + F.lane * 8;
            const u32x4 hs = chs[q];
            const u32x4 hn = chn[q];
            const float h[8] = {lo16(hs.x), hi16(hs.x), lo16(hs.y), hi16(hs.y), lo16(hs.z), hi16(hs.z), lo16(hs.w), hi16(hs.w)};
            const float n[8] = {lo16(hn.x), hi16(hn.x), lo16(hn.y), hi16(hn.y), lo16(hn.z), hi16(hn.z), lo16(hn.w), hi16(hn.w)};
            float dd[8];
#pragma unroll
            for (int e = 0; e < 8; ++e) dd[e] = n[e] - h[e];
            *(u32x4*)(H2 + (size_t)r * 2048 + 1024 + c) = (u32x4){pk2(dd[0], dd[1]), pk2(dd[2], dd[3]), pk2(dd[4], dd[5]), pk2(dd[6], dd[7])};
#pragma unroll
            for (int m = 0; m < 3; ++m) {
                const f32x4 m0 = cm[q][m][0], m1 = cm[q][m][1];
                float x[8];
#pragma unroll
                for (int e = 0; e < 4; ++e) { x[e] = h[e] + dd[e] * m0[e]; x[4 + e] = h[4 + e] + dd[4 + e] * m1[e]; }
                *(u32x4*)(XM + (size_t)m * TG * D + (size_t)r * D + c) = (u32x4){pk2(x[0], x[1]), pk2(x[2], x[3]), pk2(x[4], x[5]), pk2(x[6], x[7])};
            }
        }
    }
}
#undef MIX_FETCH
__device__ __forceinline__ void phase_vfix(const Frame& F) {
    bf16_t* V = F.ar<bf16_t>(AR_V); const bf16_t* VF = F.wsp<bf16_t>(WS_VF); const bf16_t* GT = F.ar<bf16_t>(AR_VGATE);
    const size_t tot = (size_t)TG * D / 8;
    for (size_t i = (size_t)F.bid * NTHREADS + F.tid; i < tot; i += (size_t)F.G * NTHREADS) {
        const u32x4 v = *(const u32x4*)(V + i * 8), f = *(const u32x4*)(VF + i * 8), g = *(const u32x4*)(GT + i * 8);
        u32x4 o;
        o.x = pk2(lo16(v.x) + (lo16(f.x) - lo16(v.x)) * lo16(g.x), hi16(v.x) + (hi16(f.x) - hi16(v.x)) * hi16(g.x));
        o.y = pk2(lo16(v.y) + (lo16(f.y) - lo16(v.y)) * lo16(g.y), hi16(v.y) + (hi16(f.y) - hi16(v.y)) * hi16(g.y));
        o.z = pk2(lo16(v.z) + (lo16(f.z) - lo16(v.z)) * lo16(g.z), hi16(v.z) + (hi16(f.z) - hi16(v.z)) * hi16(g.z));
        o.w = pk2(lo16(v.w) + (lo16(f.w) - lo16(v.w)) * lo16(g.w), hi16(v.w) + (hi16(f.w) - hi16(v.w)) * hi16(g.w));
        *(u32x4*)(V + i * 8) = o;
    }
}
__device__ __forceinline__ void phase_post(const Frame& F, int a, const bf16_t* V) {
    const bf16_t* Y0 = F.ar<bf16_t>(AR_Y0); bf16_t* YG = F.ar<bf16_t>(AR_R); const bf16_t* Y1 = F.ar<bf16_t>(AR_Y1); const float* DOT = F.ar<float>(AR_DOT); const bf16_t* Gb = F.ar<bf16_t>(AR_G);
    const float* lgp = F.in(27) + (size_t)a * D + F.lane * 16; const float* lbp = F.in(28) + (size_t)a * D + F.lane * 16;
    float lg[16], lb[16];
#pragma unroll
    for (int e = 0; e < 16; e += 4) { const f32x4 gq = *(const f32x4*)(lgp + e), bq = *(const f32x4*)(lbp + e);
        lg[e] = gq[0]; lg[e + 1] = gq[1]; lg[e + 2] = gq[2]; lg[e + 3] = gq[3]; lb[e] = bq[0]; lb[e + 1] = bq[1]; lb[e + 2] = bq[2]; lb[e + 3] = bq[3]; }
    const int rpb = (TG + F.G - 1) / F.G, rbeg = F.rowblk() * rpb, rend = (rbeg + rpb) < TG ? (rbeg + rpb) : TG;
    u32x4 ny0[2], ny1[2], nv[2], ng[2]; float nd0, nd1;
#define POST_FETCH(rr_) do { const int rq_ = (rr_) < rend ? (rr_) : rbeg; const int c_ = F.lane * 16; \
        _Pragma("unroll") for (int q = 0; q < 2; ++q) { ny0[q] = *(const u32x4*)(Y0 + (size_t)rq_ * D + c_ + q * 8); ny1[q] = *(const u32x4*)(Y1 + (size_t)rq_ * D + c_ + q * 8); \
            nv[q] = *(const u32x4*)(V + (size_t)rq_ * D + c_ + q * 8); ng[q] = *(const u32x4*)(Gb + (size_t)rq_ * D + c_ + q * 8); } \
        nd0 = DOT[(size_t)rq_ * NH + (F.lane >> 2)]; nd1 = DOT[((size_t)TG + rq_) * NH + (F.lane >> 2)]; } while (0)
    POST_FETCH(rbeg + F.wave);
    for (int r = rbeg + F.wave; r < rend; r += NWAVES) {
        const int c = F.lane * 16;
        float y[16], vv[16];
        u32x4 cy0[2], cy1[2], cv[2], cgq[2];
#pragma unroll
        for (int q = 0; q < 2; ++q) { cy0[q] = ny0[q]; cy1[q] = ny1[q]; cv[q] = nv[q]; cgq[q] = ng[q]; }
        const float dsum = nd0 + nd1;
        POST_FETCH(r + NWAVES);
#pragma unroll
        for (int q = 0; q < 2; ++q) {
            const u32x4 a0 = cy0[q], a1 = cy1[q], v4 = cv[q];
            y[q * 8 + 0] = lo16(a0.x) + lo16(a1.x); y[q * 8 + 1] = hi16(a0.x) + hi16(a1.x); y[q * 8 + 2] = lo16(a0.y) + lo16(a1.y); y[q * 8 + 3] = hi16(a0.y) + hi16(a1.y);
            y[q * 8 + 4] = lo16(a0.z) + lo16(a1.z); y[q * 8 + 5] = hi16(a0.z) + hi16(a1.z); y[q * 8 + 6] = lo16(a0.w) + lo16(a1.w); y[q * 8 + 7] = hi16(a0.w) + hi16(a1.w);
            vv[q * 8 + 0] = lo16(v4.x); vv[q * 8 + 1] = hi16(v4.x); vv[q * 8 + 2] = lo16(v4.y); vv[q * 8 + 3] = hi16(v4.y);
            vv[q * 8 + 4] = lo16(v4.z); vv[q * 8 + 5] = hi16(v4.z); vv[q * 8 + 6] = lo16(v4.w); vv[q * 8 + 7] = hi16(v4.w);
        }
        float s = 0.f;
#pragma unroll
        for (int e = 0; e < 16; ++e) s += y[e];
        s = red4(s); const float mean = s * (1.0f / 64.0f);
        float qv = 0.f;
#pragma unroll
        for (int e = 0; e < 16; ++e) { const float dd = y[e] - mean; qv += dd * dd; }
        qv = red4(qv); const float rstd = rsqrtf(qv * (1.0f / 64.0f) + 64e-5f);
        unsigned o[8];
        const u32x4 g0 = cgq[0], g1 = cgq[1];
        const unsigned gw[8] = {g0.x, g0.y, g0.z, g0.w, g1.x, g1.y, g1.z, g1.w};
#pragma unroll
        for (int e = 0; e < 16; e += 2) {
            const float o0 = ((y[e] - mean) * rstd * lg[e] + lb[e] + vv[e] * dsum) * lo16(gw[e >> 1]);
            const float o1 = ((y[e + 1] - mean) * rstd * lg[e + 1] + lb[e + 1] + vv[e + 1] * dsum) * hi16(gw[e >> 1]);
            o[e >> 1] = pk2(o0, o1);
        }
        *(u32x4*)(YG + (size_t)r * D + c) = (u32x4){o[0], o[1], o[2], o[3]};
        *(u32x4*)(YG + (size_t)r * D + c + 8) = (u32x4){o[4], o[5], o[6], o[7]};
    }
}
#undef POST_FETCH
__device__ __forceinline__ void phase_norm2(const Frame& F, int g, int layer, bool dry = false) {
    bf16_t* X = F.wsp<bf16_t>(WS_X); bf16_t* HM = F.ar<bf16_t>(AR_HM); const bf16_t* Ob = F.ar<bf16_t>(AR_O);
    int* lists = dry ? F.ar<int>(AR_YM0) : F.ar<int>(AR_LIST); float* lwt = dry ? F.ar<float>(AR_YM0) + (size_t)32 * TG : F.ar<float>(AR_LW);
    unsigned* cnt = (unsigned*)(F.ws + WS_CTL + CTL_CNT_OFF) + (((size_t)g * 4 + layer) * 32 + (dry ? NG * 4 * 32 : 0)) * 16;
    LAS float* hbuf = (LAS float*)F.lds;
    LAS float* part = (LAS float*)(F.lds + 16 * 1028 * 4);
    const int wv = F.wave, li = F.lane & 15, kq = F.lane >> 4;
    float wreg[32];
#pragma unroll
    for (int gq = 0; gq < 8; ++gq)
#pragma unroll
        for (int st = 0; st < 4; ++st) wreg[gq * 4 + st] = F.in(36)[(size_t)(128 * wv + 16 * gq + 4 * kq + st) * NEXP + li];
    const float* rbias = F.in(37);
    float rb4[4];
#pragma unroll
    for (int e = 0; e < 4; ++e) rb4[e] = rbias[(F.lane >> 4) * 4 + e];
    const bool ctx_out = layer < 2;
    LAS int* lcnt = (LAS int*)(F.lds + LDS_MISC + 512);
    LAS int* lbase = (LAS int*)(F.lds + LDS_MISC + 640);
    LAS int* rec = (LAS int*)(F.lds + 81920);
    const int rpb = (TG + F.G - 1) / F.G, rbeg = F.rowblk() * rpb, rend = (rbeg + rpb) < TG ? (rbeg + rpb) : TG;
    int key = -1; f32x4 cg[4], cA[4], cB[4];
#pragma unroll
    for (int q = 0; q < 4; ++q) { cg[q] = (f32x4){0.f, 0.f, 0.f, 0.f}; cA[q] = cg[q]; cB[q] = cg[q]; }
    __syncthreads();
    for (int b0 = 0; b0 < rpb; b0 += 512) {
        if (F.tid < 32) lcnt[F.tid] = 0;
        __syncthreads();
        const int nrb = (rpb - b0) < 512 ? (rpb - b0) : 512, nsteps = (nrb + 15) >> 4;
        u32x2 nxw[4], nob[4];
#define N2_FETCH(rr_) do { const int rc_ = (rr_) < rend ? (rr_) : rbeg; \
        _Pragma("unroll") for (int q = 0; q < 4; ++q) { const int c = q * 256 + F.lane * 4; nxw[q] = *(const u32x2*)(X + (size_t)rc_ * D + c); nob[q] = *(const u32x2*)(Ob + (size_t)rc_ * D + c); } } while (0)
        N2_FETCH(rbeg + b0 + 2 * wv);
#pragma unroll 1
        for (int sp = 0; sp < nsteps; ++sp) {
#pragma unroll 1
            for (int hr = 0; hr < 2; ++hr) {
                const int off = b0 + sp * 16 + 2 * wv + hr, r = rbeg + off;
                const int bl = r / LT, t = r % LT, b = g * BG + bl; const bool isctx = t < LC;
                u32x2 cxw[4], cob[4];
#pragma unroll
                for (int q = 0; q < 4; ++q) { cxw[q] = nxw[q]; cob[q] = nob[q]; }
                N2_FETCH(hr == 0 ? r + 1 : r + 15);
                if (off < rpb && r < rend && !(isctx && !ctx_out)) {
                    if (key != b * 2 + (int)isctx) {
                        key = b * 2 + (int)isctx;
#pragma unroll
                        for (int q = 0; q < 4; ++q) { const int c = q * 256 + F.lane * 4;
                            cg[q] = *(const f32x4*)((isctx ? F.modC(layer, 2) : F.modL(layer, b, 2)) + c);
                            const f32x4 gv = *(const f32x4*)(F.in(7) + (size_t)layer * D + c), cv = *(const f32x4*)((isctx ? F.modC(layer, 4) : F.modL(layer, b, 4)) + c);
                            cA[q] = gv * (1.0f + cv); cB[q] = *(const f32x4*)((isctx ? F.modC(layer, 3) : F.modL(layer, b, 3)) + c); }
                    }
                    f32x4 x[4]; float ss = 0.f;
#pragma unroll
                    for (int q = 0; q < 4; ++q) { const int c = q * 256 + F.lane * 4;
                        { const u32x2 xw = cxw[q]; x[q] = (f32x4){lo16(xw.x), hi16(xw.x), lo16(xw.y), hi16(xw.y)}; }
                        const u32x2 ob = cob[q]; const f32x4 gv = cg[q];
                        const f32x4 xo = x[q];
                        x[q][0] += gv[0] * lo16(ob.x); x[q][1] += gv[1] * hi16(ob.x); x[q][2] += gv[2] * lo16(ob.y); x[q][3] += gv[3] * hi16(ob.y);
                        { const f32x4 xs = dry ? xo : x[q]; u32x2 xw; xw.x = pk2(xs[0], xs[1]); xw.y = pk2(xs[2], xs[3]); *(u32x2*)(X + (size_t)r * D + c) = xw; }
                        ss += x[q][0] * x[q][0] + x[q][1] * x[q][1] + x[q][2] * x[q][2] + x[q][3] * x[q][3]; }
                    ss = wave_sum_dpp(ss);
                    const float rstd = rsqrtf(ss * (1.0f / D) + 1e-6f);
#pragma unroll
                    for (int q = 0; q < 4; ++q) { const int c = q * 256 + F.lane * 4;
                        const f32x4 h = x[q] * rstd * cA[q] + cB[q];
                        u32x2 w; w.x = pk2(h[0], h[1]); w.y = pk2(h[2], h[3]);
                        *(u32x2*)(HM + (size_t)r * D + c) = w;
                        *(LAS f32x4*)(hbuf + (2 * wv + hr) * 1028 + c) = h; }
                }
            }
            LDS_BAR();
            {
                f32x4 pl = (f32x4){0.f, 0.f, 0.f, 0.f};
#pragma unroll
                for (int gq = 0; gq < 8; ++gq) { const f32x4 av = *(const LAS f32x4*)(hbuf + li * 1028 + 128 * wv + 16 * gq + 4 * kq);
#pragma unroll
                    for (int st = 0; st < 4; ++st) pl = __builtin_amdgcn_mfma_f32_16x16x4f32(av[st], wreg[gq * 4 + st], pl, 0, 0, 0); }
                LAS float* pp = part + wv * 256 + (4 * kq) * 16 + li; pp[0] = pl[0]; pp[16] = pl[1]; pp[32] = pl[2]; pp[48] = pl[3];
            }
            LDS_BAR();
#pragma unroll 1
            for (int hr = 0; hr < 2; ++hr) {
                const int slot = sp * 16 + 2 * wv + hr, off = b0 + slot, r = rbeg + off;
                const int t = r % LT; const bool isctx = t < LC;
                if (!(off < rpb && r < rend && !(isctx && !ctx_out))) { if (F.lane == 0) rec[slot * 4] = -1; continue; }
                f32x4 xs4 = (f32x4){0.f, 0.f, 0.f, 0.f};
#pragma unroll
                for (int w8 = 0; w8 < 8; ++w8) xs4 = xs4 + *(const LAS f32x4*)(part + w8 * 256 + (2 * wv + hr) * 16 + 4 * (F.lane >> 4));
                const float xg[4] = {xs4[0], xs4[1], xs4[2], xs4[3]};
                float sc_[4], bs[4];
#pragma unroll
                for (int e = 0; e < 4; ++e) { sc_[e] = sigmoidf_(xg[e]); bs[e] = sc_[e] + rb4[e]; }
                const float hi01 = fmaxf(bs[0], bs[1]), lo01 = fminf(bs[0], bs[1]), hi23 = fmaxf(bs[2], bs[3]), lo23 = fminf(bs[2], bs[3]);
                const float gsc = fmaxf(hi01, hi23) + fmaxf(fminf(hi01, hi23), fmaxf(lo01, lo23));
                const float g0s = __int_as_float(__builtin_amdgcn_readlane(__float_as_int(gsc), 0)), g1s = __int_as_float(__builtin_amdgcn_readlane(__float_as_int(gsc), 16));
                const float g2s = __int_as_float(__builtin_amdgcn_readlane(__float_as_int(gsc), 32)), g3s = __int_as_float(__builtin_amdgcn_readlane(__float_as_int(gsc), 48));
                const bool c10 = g1s > g0s, c32 = g3s > g2s; const float v01 = c10 ? g1s : g0s, v23 = c32 ? g3s : g2s; const bool chi = v23 > v01;
                const int best = __builtin_amdgcn_readfirstlane(chi ? (c32 ? 3 : 2) : (c10 ? 1 : 0));
                float cb[4], cs[4];
#pragma unroll
                for (int e = 0; e < 4; ++e) { cb[e] = __int_as_float(__builtin_amdgcn_readlane(__float_as_int(bs[e]), best * 16)); cs[e] = __int_as_float(__builtin_amdgcn_readlane(__float_as_int(sc_[e]), best * 16)); }
                const bool d10 = cb[1] > cb[0], d32 = cb[3] > cb[2]; const float w01 = d10 ? cb[1] : cb[0], w23 = d32 ? cb[3] : cb[2]; const bool dhi = w23 > w01;
                const int j1 = dhi ? (d32 ? 3 : 2) : (d10 ? 1 : 0);
                const float e0 = j1 == 0 ? -1e30f : cb[0], e1 = j1 == 1 ? -1e30f : cb[1], e2 = j1 == 2 ? -1e30f : cb[2], e3 = j1 == 3 ? -1e30f : cb[3];
                const bool f10 = e1 > e0, f32_ = e3 > e2; const float u01 = f10 ? e1 : e0, u23 = f32_ ? e3 : e2; const bool fhi = u23 > u01;
                const int j2 = fhi ? (f32_ ? 3 : 2) : (f10 ? 1 : 0);
                const float s1 = (j1 & 2) ? ((j1 & 1) ? cs[3] : cs[2]) : ((j1 & 1) ? cs[1] : cs[0]);
                const float s2 = (j2 & 2) ? ((j2 & 1) ? cs[3] : cs[2]) : ((j2 & 1) ? cs[1] : cs[0]);
                const float inv = __builtin_amdgcn_rcpf(s1 + s2);
                if (F.lane == 0) {
                    const int l1 = (best * 4 + j1) * 2 + 0, l2 = (best * 4 + j2) * 2 + 1;
                    const int p1 = __hip_atomic_fetch_add(lcnt + l1, 1, __ATOMIC_RELAXED, __HIP_MEMORY_SCOPE_WORKGROUP);
                    const int p2 = __hip_atomic_fetch_add(lcnt + l2, 1, __ATOMIC_RELAXED, __HIP_MEMORY_SCOPE_WORKGROUP);
                    rec[slot * 4 + 0] = l1 | (p1 << 8); rec[slot * 4 + 1] = l2 | (p2 << 8);
                    rec[slot * 4 + 2] = __float_as_int(s1 * inv); rec[slot * 4 + 3] = __float_as_int(s2 * inv);
                }
            }
        }
#undef N2_FETCH
        __syncthreads();
        if (F.tid < 32) { const int c = lcnt[F.tid]; lbase[F.tid] = c ? (int)atomicAdd(&cnt[F.tid * 16], (unsigned)c) : 0; }
        __syncthreads();
        for (int slot = F.tid; slot < nsteps * 16; slot += NTHREADS) {
            const int a0 = rec[slot * 4 + 0]; if (a0 < 0) continue;
            const int a1 = rec[slot * 4 + 1];
            const int r = rbeg + b0 + slot;
            const int l1 = a0 & 255, l2 = a1 & 255; const int q1 = lbase[l1] + (a0 >> 8), q2 = lbase[l2] + (a1 >> 8);
            lists[(size_t)l1 * TG + q1] = r; lwt[(size_t)l1 * TG + q1] = __int_as_float(rec[slot * 4 + 2]);
            lists[(size_t)l2 * TG + q2] = r; lwt[(size_t)l2 * TG + q2] = __int_as_float(rec[slot * 4 + 3]);
        }
        __syncthreads();
    }
}
__device__ __forceinline__ int moe_tables(const Frame& F, int g, int layer) {
    LAS int* cn = (LAS int*)(F.lds + LDS_MISC + 64); LAS int* tb = (LAS int*)(F.lds + LDS_MISC + 192);
    const unsigned* cnt = (const unsigned*)(F.ws + WS_CTL + CTL_CNT_OFF) + ((size_t)g * 4 + layer) * 32 * 16;
    __syncthreads();
    if (F.tid < 32) cn[F.tid] = (int)__hip_atomic_load(cnt + F.tid * 16, __ATOMIC_RELAXED, __HIP_MEMORY_SCOPE_AGENT);
    __syncthreads();
    if (F.tid == 0) { int acc = 0; for (int l = 0; l < 32; ++l) { tb[l] = acc; acc += (cn[l] + 255) >> 8; } tb[32] = acc; }
    __syncthreads();
    return tb[32];
}

constexpr int SC_OPB = 6 * 4096;
constexpr int SC_HALF = 2 * SC_OPB + 4096 + 4096;
static_assert(2 * SC_HALF <= LDS_STAGE, "scan lds");
__device__ __forceinline__ int scan_tok(int d, int s) { return d == 0 ? s : (s < LC ? (LC - 1 - s) : (LT + LC - 1 - s)); }

constexpr int S4_RS = 144;
constexpr int S4_KKP = 0, S4_RPP = 16 * S4_RS, S4_KDP = 32 * S4_RS, S4_KAP = 48 * S4_RS, S4_VP = 64 * S4_RS, S4_P15 = 80 * S4_RS, S4_PBSZ = S4_P15 + 256,
              S4_A1 = 2 * S4_PBSZ, S4_B1 = S4_A1 + 512, S4_B2 = S4_B1 + 512, S4_MI = S4_B2 + 512, S4_LI = S4_MI + 512, S4_LX = S4_LI + 4096, S4_AT = S4_LX + 4096, S4_YB = S4_AT + 4096, S4_HALF = S4_YB + 4096;
typedef short s16x4 __attribute__((ext_vector_type(4)));
__device__ __forceinline__ u32x2 lds_tr16(const LAS unsigned char* p) { return __builtin_bit_cast(u32x2, __builtin_amdgcn_ds_read_tr16_b64_v4i16((LAS s16x4*)p)); }
static_assert(2 * S4_HALF <= LDS_STAGE, "scan4 lds");
#define MF16(a, b, c) __builtin_amdgcn_mfma_f32_16x16x32_bf16((a), (b), (c), 0, 0, 0)
__device__ __forceinline__ bf16x8 mkfrag(unsigned a, unsigned b, unsigned c, unsigned d) { return __builtin_bit_cast(bf16x8, (u32x4){a, b, c, d}); }
__device__ __forceinline__ f32x4 scan_inverse_mfma(f32x4 N, f32x4 NT, int g, int j) {
    const f32x4 z = (f32x4){0.f, 0.f, 0.f, 0.f};
#define P2(v) mkfrag(pk2((v)[0], (v)[1]), pk2((v)[2], (v)[3]), 0u, 0u)
    const bf16x8 Nc = P2(N), Ntc = P2(NT);
    const f32x4 Z2 = MF16(Ntc, Nc, z), Z2t = MF16(Nc, Ntc, z);
    f32x4 Q = (f32x4){(4 * g == j ? 1.f : 0.f) - NT[0], (4 * g + 1 == j ? 1.f : 0.f) - NT[1], (4 * g + 2 == j ? 1.f : 0.f) - NT[2], (4 * g + 3 == j ? 1.f : 0.f) - NT[3]};
    const bf16x8 Z2c = P2(Z2), Z2tc = P2(Z2t);
    const f32x4 Z4 = MF16(Z2tc, Z2c, z), Z4t = MF16(Z2c, Z2tc, z);
    Q = MF16(Z2c, P2(Q), Q);
    const bf16x8 Z4c = P2(Z4), Z4tc = P2(Z4t);
    const f32x4 Z8 = MF16(Z4tc, Z4c, z);
    Q = MF16(Z4c, P2(Q), Q);
    Q = MF16(P2(Z8), P2(Q), Q);
#undef P2
    return Q;
}
__device__ __forceinline__ void phase_scan4(const Frame& F, int a, const bf16_t* V) {
    const bf16_t* R = F.ar<bf16_t>(AR_R); const bf16_t* Kb = F.ar<bf16_t>(AR_K); const bf16_t* L1 = F.ar<bf16_t>(AR_L1);
    const int half = F.wave >> 2, q = F.wave & 3, lane = F.lane, li = q * 64 + lane;
    const int role = (q - half) & 3;
    LAS unsigned char* hb = F.lds + half * S4_HALF;
    const int arr = q >> 1, ntl = (q & 1) * 2;
    const int g = lane >> 4, j = lane & 15;
    const int tB = li >> 4, k4 = (li & 15) * 4;
    const int trrow = (4 * g + ((lane & 15) >> 2)) * S4_RS;
    const int poff = tB * S4_RS + ((k4 >> 5) * 32 + ((k4 >> 2) & 3) * 8 + ((k4 >> 4) & 1) * 4) * 2;
    for (int pr = F.rowblk(); pr < BG * 16; pr += F.G) {
        const int bl = pr >> 4, d = (pr >> 3) & 1, hp = pr & 7, h = hp * 2 + half;
        bf16_t* Yd = F.ar<bf16_t>(d ? AR_Y1 : AR_Y0); float* DOT = F.ar<float>(AR_DOT) + (size_t)d * TG * NH;
        const size_t rowb = (size_t)bl * LT;
        const bf16_t* W2 = (arr == 0 ? F.wsp<bf16_t>(WS_W2T) : F.wsp<bf16_t>(WS_A2T)) + ((size_t)a * 2 + d) * D * 64;
        const float* b0p = (arr == 0 ? F.in(13) : F.in(16)) + ((size_t)a * 2 + d) * D + h * 64;
        const int acol = arr * 128 + d * 64 + 8 * (lane >> 4);
        f32x4 Cb[4];
#pragma unroll
        for (int b = 0; b < 4; ++b) Cb[b] = (f32x4){0.f, 0.f, 0.f, 0.f};
        bf16x8 Af[2]; u32x2 kraw, rraw, vraw;
        bf16x8 wf0[2], wf1[2]; float bias2[2];
#pragma unroll
        for (int nt = 0; nt < 2; ++nt) { const int n = (ntl + nt) * 16 + (lane & 15); bias2[nt] = b0p[n];
            wf0[nt] = *(const bf16x8*)(W2 + (size_t)(h * 64 + n) * 64 + 8 * (lane >> 4)); wf1[nt] = *(const bf16x8*)(W2 + (size_t)(h * 64 + n) * 64 + 32 + 8 * (lane >> 4)); }
        const f32x4 kkc = *(const f32x4*)(F.in(24) + (size_t)a * D + h * 64 + k4), kac = *(const f32x4*)(F.in(25) + (size_t)a * D + h * 64 + k4), rkc = *(const f32x4*)(F.in(26) + (size_t)a * D + h * 64 + k4);
#define SC_BAR() asm volatile("s_waitcnt lgkmcnt(0)\n\ts_barrier" ::: "memory")
#define SC_LOAD(ch) do { const size_t rowA = rowb + scan_tok(d, (ch) * 16 + (lane & 15)); \
        Af[0] = *(const bf16x8*)(L1 + rowA * 512 + acol); Af[1] = *(const bf16x8*)(L1 + rowA * 512 + acol + 32); \
        const size_t rowBq = (rowb + scan_tok(d, (ch) * 16 + tB)) * D + h * 64 + k4; \
        kraw = *(const u32x2*)(Kb + rowBq); rraw = *(const u32x2*)(R + rowBq); vraw = *(const u32x2*)(V + rowBq); } while (0)
#define SC_PASSA() do { \
        _Pragma("unroll") for (int nt = 0; nt < 2; ++nt) { f32x4 ac = (f32x4){0.f, 0.f, 0.f, 0.f}; \
            const int n = (ntl + nt) * 16 + (lane & 15); const float bias_ = bias2[nt]; \
            ac = MF16(Af[0], wf0[nt], ac); ac = MF16(Af[1], wf1[nt], ac); \
            f32x4 sg; _Pragma("unroll") for (int rg = 0; rg < 4; ++rg) sg[rg] = sigmoidf_(ac[rg] + bias_); \
            if (arr == 0) { \
                const float l0 = -0.60653066f * sg[0], l1 = -0.60653066f * sg[1], l2 = -0.60653066f * sg[2], l3 = -0.60653066f * sg[3]; \
                const float p0 = l0, p1 = p0 + l1, p2 = p1 + l2, p3 = p2 + l3;                         \
                const auto s16 = __builtin_amdgcn_permlane16_swap(__float_as_uint(p3), __float_as_uint(p3), false, false);     \
                const float sv = __uint_as_float(s16[0]), pq = sv + __uint_as_float(s16[1]); \
                const auto s32 = __builtin_amdgcn_permlane32_swap(__float_as_uint(pq), __float_as_uint(pq), false, false);     \
                const float E = ((g & 1) ? sv : 0.f) + ((g & 2) ? __uint_as_float(s32[0]) : 0.f);      \
                LAS float* li_ = (LAS float*)(hb + S4_LI) + (4 * g) * 64 + n; LAS float* lx_ = (LAS float*)(hb + S4_LX) + (4 * g) * 64 + n; \
                li_[0] = E + p0; li_[64] = E + p1; li_[128] = E + p2; li_[192] = E + p3; lx_[0] = E; lx_[64] = E + p0; lx_[128] = E + p1; lx_[192] = E + p2; \
            } else { _Pragma("unroll") for (int rg = 0; rg < 4; ++rg) ((LAS float*)(hb + S4_AT))[(4 * g + rg) * 64 + n] = sg[rg]; } } } while (0)
#define SC_PASSB(ch, pbo_) do { LAS unsigned char* hq_ = hb + (pbo_); \
        const float kf[4] = {lo16(kraw.x), hi16(kraw.x), lo16(kraw.y), hi16(kraw.y)}; const float rf[4] = {lo16(rraw.x), hi16(rraw.x), lo16(rraw.y), hi16(rraw.y)}; \
        const f32x4 av = *(const LAS f32x4*)((LAS float*)(hb + S4_AT) + tB * 64 + k4), Li = *(const LAS f32x4*)((LAS float*)(hb + S4_LI) + tB * 64 + k4), Lx = *(const LAS f32x4*)((LAS float*)(hb + S4_LX) + tB * 64 + k4); \
        float kq[4], ssq = 0.f; _Pragma("unroll") for (int e = 0; e < 4; ++e) { kq[e] = kf[e] * kkc[e]; ssq += kq[e] * kq[e]; } \
        ssq = red16(ssq); const float inv = __builtin_amdgcn_rsqf(fmaxf(ssq, 1e-24f)); \
        float o_kk[4], o_ka[4], o_kd[4], o_r[4]; f32x4 o_p; float dp = 0.f; \
        _Pragma("unroll") for (int e = 0; e < 4; ++e) { const float Pt = __expf(Li[e]), Px = __expf(Lx[e]), iP = __builtin_amdgcn_rcpf(Pt); \
            const float kkv = kq[e] * inv; const float kd = kf[e] * (1.0f + (av[e] - 1.0f) * kac[e]); const float ka = kkv * av[e]; \
            o_kk[e] = kkv * Px; o_ka[e] = ka * iP; o_kd[e] = kd * iP; o_r[e] = rf[e] * Pt; o_p[e] = Pt; \
            dp += rf[e] * kd * rkc[e]; } \
        dp = red16(dp); \
        if ((li & 15) == 0) DOT[(rowb + scan_tok(d, (ch) * 16 + tB)) * NH + h] = dp; \
        const u32x2 w_kk = (u32x2){pk2(o_kk[0], o_kk[1]), pk2(o_kk[2], o_kk[3])}, w_r = (u32x2){pk2(o_r[0], o_r[1]), pk2(o_r[2], o_r[3])}; \
        const u32x2 w_kd = (u32x2){pk2(o_kd[0], o_kd[1]), pk2(o_kd[2], o_kd[3])}, w_ka = (u32x2){pk2(o_ka[0], o_ka[1]), pk2(o_ka[2], o_ka[3])}; \
        *(LAS u32x2*)(hq_ + S4_KKP + poff) = w_kk; *(LAS u32x2*)(hq_ + S4_RPP + poff) = w_r; *(LAS u32x2*)(hq_ + S4_KDP + poff) = w_kd; *(LAS u32x2*)(hq_ + S4_KAP + poff) = w_ka; \
        *(LAS u32x2*)(hq_ + S4_VP + tB * S4_RS + k4 * 2) = vraw;        \
        if (tB == 15) *(LAS f32x4*)((LAS float*)(hq_ + S4_P15) + k4) = o_p; } while (0)
#define SC_PROD(pbo_) do { LAS unsigned char* hq_ = hb + (pbo_); \
        const int lo_ = (role < 2 ? S4_KKP : S4_RPP) + j * S4_RS + g * 16, ro_ = ((role == 0 || role == 3) ? S4_KAP : S4_KDP) + j * S4_RS + g * 16; \
        const bf16x8 fl0_ = *(const LAS bf16x8*)(hq_ + lo_), fr0_ = *(const LAS bf16x8*)(hq_ + ro_), fl1_ = *(const LAS bf16x8*)(hq_ + lo_ + 64), fr1_ = *(const LAS bf16x8*)(hq_ + ro_ + 64); \
        f32x4 pa = (f32x4){0.f, 0.f, 0.f, 0.f}; \
        pa = MF16(fl0_, fr0_, pa); pa = MF16(fl1_, fr1_, pa); \
        _Pragma("unroll") for (int r_ = 0; r_ < 4; ++r_) { const int t_ = 4 * g + r_; const bool keep = (role < 2) ? (j < t_) : (j <= t_); pa[r_] = keep ? pa[r_] : 0.f; } \
        if (role == 0) { f32x4 pt = (f32x4){0.f, 0.f, 0.f, 0.f}; pt = MF16(fr0_, fl0_, pt); pt = MF16(fr1_, fl1_, pt);        \
            _Pragma("unroll") for (int r_ = 0; r_ < 4; ++r_) pt[r_] = (j > 4 * g + r_) ? pt[r_] : 0.f; \
            const f32x4 mt_ = scan_inverse_mfma(pa, pt, g, j); \
            *(LAS u32x2*)(hb + S4_MI + j * 32 + g * 8) = (u32x2){pk2(mt_[0], mt_[1]), pk2(mt_[2], mt_[3])}; } \
        else { LAS unsigned char* dm = hb + (role == 1 ? S4_A1 : (role == 2 ? S4_B1 : S4_B2)) + ((4 * g) * 16 + j) * 2; const unsigned w0_ = pk2(pa[0], pa[1]), w1_ = pk2(pa[2], pa[3]); \
            *(LAS unsigned short*)(dm) = (unsigned short)w0_; *(LAS unsigned short*)(dm + 32) = (unsigned short)(w0_ >> 16); *(LAS unsigned short*)(dm + 64) = (unsigned short)w1_; *(LAS unsigned short*)(dm + 96) = (unsigned short)(w1_ >> 16); } } while (0)
        constexpr int NCH = LT / 16;
        __syncthreads();
        SC_LOAD(0);
        SC_PASSA();
        SC_BAR();
        SC_PASSB(0, 0);
        SC_BAR();
        SC_LOAD(1);
        SC_PASSA();
        SC_PROD(0);
        SC_BAR();
        SC_PASSB(1, S4_PBSZ);
        SC_BAR();
#pragma unroll 1
        for (int it = 0; it < 2 * NCH + 1; ++it) {
            const int s_ = it - half;
            if (s_ >= 0 && s_ < 2 * NCH) {
            const int ch = s_ >> 1;
            const int pbo = (ch & 1) * S4_PBSZ;
            LAS unsigned char* hc = hb + pbo;
            if ((s_ & 1) == 0) {
            if (ch + 2 < NCH) SC_LOAD(ch + 2);
            const bf16x8 Bs0 = mkfrag(pk2(Cb[0][0], Cb[0][1]), pk2(Cb[0][2], Cb[0][3]), pk2(Cb[1][0], Cb[1][1]), pk2(Cb[1][2], Cb[1][3]));
            const bf16x8 Bs1 = mkfrag(pk2(Cb[2][0], Cb[2][1]), pk2(Cb[2][2], Cb[2][3]), pk2(Cb[3][0], Cb[3][1]), pk2(Cb[3][2], Cb[3][3]));
            f32x4 X = (f32x4){0.f, 0.f, 0.f, 0.f}, H = (f32x4){0.f, 0.f, 0.f, 0.f};
            X = MF16(*(const LAS bf16x8*)(hc + S4_KKP + j * S4_RS + g * 16), Bs0, X); H = MF16(*(const LAS bf16x8*)(hc + S4_RPP + j * S4_RS + g * 16), Bs0, H);
            X = MF16(*(const LAS bf16x8*)(hc + S4_KKP + j * S4_RS + g * 16 + 64), Bs1, X); H = MF16(*(const LAS bf16x8*)(hc + S4_RPP + j * S4_RS + g * 16 + 64), Bs1, H);
            const u32x2 vw = lds_tr16(hc + S4_VP + trrow + 32 * q + 8 * (lane & 3));
            const bf16x8 Bv = mkfrag(vw.x, vw.y, 0u, 0u);
            {
                const u32x2 a1w = *(const LAS u32x2*)(hb + S4_A1 + (j * 16 + 4 * g) * 2), b1w = *(const LAS u32x2*)(hb + S4_B1 + (j * 16 + 4 * g) * 2);
                X = MF16(mkfrag(a1w.x, a1w.y, 0u, 0u), Bv, X); H = MF16(mkfrag(b1w.x, b1w.y, 0u, 0u), Bv, H);
            }
            const u32x2 mw = *(const LAS u32x2*)(hb + S4_MI + j * 32 + g * 8);
            f32x4 SA = (f32x4){0.f, 0.f, 0.f, 0.f};
            SA = MF16(mkfrag(mw.x, mw.y, 0u, 0u), mkfrag(pk2(X[0], X[1]), pk2(X[2], X[3]), 0u, 0u), SA);
            const bf16x8 Bn = mkfrag(pk2(-SA[0], -SA[1]), pk2(-SA[2], -SA[3]), 0u, 0u);
            {
                const u32x2 b2w = *(const LAS u32x2*)(hb + S4_B2 + (j * 16 + 4 * g) * 2);
                H = MF16(mkfrag(b2w.x, b2w.y, 0u, 0u), Bn, H);
                LAS float* yb = (LAS float*)(hb + S4_YB) + (4 * g) * 64 + 16 * q + j; yb[0] = H[0]; yb[64] = H[1]; yb[128] = H[2]; yb[192] = H[3];
            }
#pragma unroll
            for (int b = 0; b < 4; ++b) {
                const u32x2 kdw = lds_tr16(hc + S4_KDP + trrow + 16 * (lane & 3) + 64 * (b >> 1) + 8 * (b & 1));
                const u32x2 kaw = lds_tr16(hc + S4_KAP + trrow + 16 * (lane & 3) + 64 * (b >> 1) + 8 * (b & 1));
                Cb[b] = MF16(mkfrag(kdw.x, kdw.y, 0u, 0u), Bv, Cb[b]);
                Cb[b] = MF16(mkfrag(kaw.x, kaw.y, 0u, 0u), Bn, Cb[b]);
            }
#pragma unroll
            for (int b = 0; b < 4; ++b) { const f32x4 pv = *(const LAS f32x4*)((LAS float*)(hc + S4_P15) + 16 * b + 4 * g); Cb[b] = Cb[b] * pv; }
            if (ch + 2 < NCH) SC_PASSA();
            } else {
            {
                const f32x4 yv = *(const LAS f32x4*)((LAS float*)(hb + S4_YB) + tB * 64 + k4);
                u32x2 w; w.x = pk2(yv[0], yv[1]); w.y = pk2(yv[2], yv[3]);
                *(u32x2*)(Yd + (rowb + scan_tok(d, ch * 16 + tB)) * D + h * 64 + k4) = w;
            }
            if (ch + 2 < NCH) SC_PASSB(ch + 2, pbo);
            __builtin_amdgcn_sched_barrier(0);
            if (ch + 1 < NCH) SC_PROD(pbo ^ S4_PBSZ);
            }
            }
            SC_BAR();
        }
#undef SC_LOAD
#undef SC_PASSA
#undef SC_PASSB
#undef SC_PROD
    }
}

__device__ __forceinline__ void phase_sgstats(const Frame& F, int layer) {
    const bf16_t* Z = F.ar<bf16_t>(AR_Z); float* ST = F.ar<float>(AR_ST);
    const int rpb = (TG + F.G - 1) / F.G, rbeg = F.rowblk() * rpb, rend = (rbeg + rpb) < TG ? (rbeg + rpb) : TG;
    for (int r0 = rbeg + 2 * F.wave; r0 < rend; r0 += 2 * NWAVES) {
        u32x4 w[2][4];
#pragma unroll
        for (int h = 0; h < 2; ++h)
#pragma unroll
            for (int q = 0; q < 4; ++q) w[h][q] = *(const u32x4*)(Z + (size_t)(r0 + h) * 4096 + 2048 + q * 512 + F.lane * 8);
#pragma unroll
        for (int h = 0; h < 2; ++h) {
            const int r = r0 + h, t = r % LT; if (t < LC && layer >= 3) continue;
            float x[32];
#pragma unroll
            for (int q = 0; q < 4; ++q) { const u32x4 ww = w[h][q];
                x[q * 8 + 0] = lo16(ww.x); x[q * 8 + 1] = hi16(ww.x); x[q * 8 + 2] = lo16(ww.y); x[q * 8 + 3] = hi16(ww.y); x[q * 8 + 4] = lo16(ww.z); x[q * 8 + 5] = hi16(ww.z); x[q * 8 + 6] = lo16(ww.w); x[q * 8 + 7] = hi16(ww.w); }
            float s = 0.f;
#pragma unroll
            for (int e = 0; e < 32; ++e) s += x[e];
            s = wave_sum_dpp(s); const float mean = s * (1.0f / 2048.0f);
            float qv = 0.f;
#pragma unroll
            for (int e = 0; e < 32; ++e) { const float dd = x[e] - mean; qv += dd * dd; }
            qv = wave_sum_dpp(qv);
            if (F.lane == 0) *(f32x2*)(ST + (size_t)r * 2) = (f32x2){mean, rsqrtf(qv * (1.0f / 2048.0f) + 1e-5f)};
        }
    }
}
__device__ __forceinline__ int vt_off(int dch, int jb) { return dch * 256 + ((jb ^ ((dch & 15) ^ (((dch >> 4) & 7) << 1))) << 4); }
__device__ __forceinline__ void phase_spatial(const Frame& F, int bsg, int layer) {
    const bf16_t* Z = F.ar<bf16_t>(AR_Z); const float* ST = F.ar<float>(AR_ST); bf16_t* Pb = F.ar<bf16_t>(AR_P);
    const bf16_t* Ws = F.wsp<bf16_t>(WS_WSP) + (size_t)bsg * 16 * 128 * 128;
    const float* lng = F.in(31) + (size_t)bsg * 2048; const float* lnb = F.in(32) + (size_t)bsg * 2048; const float* bs = F.in(34) + (size_t)bsg * 16 * 128;
    LAS unsigned char* vt = F.lds;
    const int skip = layer >= 3;
    const int nchunk = skip ? BG * 16 : BG * 18;
    const int w = F.wave, lane = F.lane, dt = w >> 1, it0 = (w & 1) * 2;
    const int jj0 = F.tid >> 4, c8 = (F.tid & 15) * 8;
    u32x4 zz[4]; f32x2 st[4];
#define SP_ROW0(U_) ((size_t)(skip ? (((U_) >> 4) >> 4) * 18 + 2 + (((U_) >> 4) & 15) : ((U_) >> 4)) * 128)
#define SP_LOADZ(U_) do { const size_t r0_ = SP_ROW0(U_); const int gi_ = (U_) & 15; _Pragma("unroll") for (int k = 0; k < 4; ++k) { \
        zz[k] = *(const u32x4*)(Z + (r0_ + jj0 + 32 * k) * 4096 + 2048 + gi_ * 128 + c8); st[k] = *(const f32x2*)(ST + (r0_ + jj0 + 32 * k) * 2); } } while (0)
    const bool xmap = F.G == 256 && (nchunk & 7) == 0; const int xq = F.bid & 7, xr = F.bid >> 3, cpx = nchunk >> 3;
#define SP_UNIT(k_) (xmap ? (((xr >> 4) + 2 * (k_) < cpx) ? ((xq * cpx + (xr >> 4) + 2 * (k_)) * 16 + (xr & 15)) : -1) : ((F.bid + (k_) * F.G < nchunk * 16) ? (F.bid + (k_) * F.G) : -1))
    if (SP_UNIT(0) >= 0) SP_LOADZ(SP_UNIT(0));
    int gic = -1; float gg[8], bb[8], bias[2]; bf16x8 B0[8], B1[8];
#pragma unroll
    for (int e = 0; e < 8; ++e) { gg[e] = 0.f; bb[e] = 0.f; B0[e] = (bf16x8){0, 0, 0, 0, 0, 0, 0, 0}; B1[e] = B0[e]; }
    bias[0] = bias[1] = 0.f;
    for (int uk = 0; SP_UNIT(uk) >= 0; ++uk) {
        const int U = SP_UNIT(uk), Un = SP_UNIT(uk + 1);
        const int gi = U & 15;
        const size_t row0 = SP_ROW0(U);
        if (gi != gic) {
            gic = gi;
            const f32x4 g0 = *(const f32x4*)(lng + gi * 128 + c8), g1 = *(const f32x4*)(lng + gi * 128 + c8 + 4), b0 = *(const f32x4*)(lnb + gi * 128 + c8), b1 = *(const f32x4*)(lnb + gi * 128 + c8 + 4);
            gg[0] = g0[0]; gg[1] = g0[1]; gg[2] = g0[2]; gg[3] = g0[3]; gg[4] = g1[0]; gg[5] = g1[1]; gg[6] = g1[2]; gg[7] = g1[3];
            bb[0] = b0[0]; bb[1] = b0[1]; bb[2] = b0[2]; bb[3] = b0[3]; bb[4] = b1[0]; bb[5] = b1[1]; bb[6] = b1[2]; bb[7] = b1[3];
            const bf16_t* w0p = Ws + ((size_t)gi * 128 + it0 * 32 + (lane & 31)) * 128 + 8 * (lane >> 5);
#pragma unroll
            for (int s_ = 0; s_ < 8; ++s_) { B0[s_] = *(const bf16x8*)(w0p + 16 * s_); B1[s_] = *(const bf16x8*)(w0p + 32 * 128 + 16 * s_); }
#pragma unroll
            for (int it = 0; it < 2; ++it) bias[it] = bs[gi * 128 + (it0 + it) * 32 + (lane & 31)];
        }
        LDS_BAR();
#pragma unroll
        for (int k = 0; k < 4; ++k) {
            const int jj = jj0 + 32 * k;
            const float xv[8] = {lo16(zz[k].x), hi16(zz[k].x), lo16(zz[k].y), hi16(zz[k].y), lo16(zz[k].z), hi16(zz[k].z), lo16(zz[k].w), hi16(zz[k].w)};
#pragma unroll
            for (int e = 0; e < 8; e += 2) {
                const unsigned pw = pk2((xv[e] - st[k][0]) * st[k][1] * gg[e] + bb[e], (xv[e + 1] - st[k][0]) * st[k][1] * gg[e + 1] + bb[e + 1]);
                *(LAS unsigned short*)(vt + vt_off(c8 + e, jj >> 3) + (jj & 7) * 2) = (unsigned short)(pw & 0xFFFFu);
                *(LAS unsigned short*)(vt + vt_off(c8 + e + 1, jj >> 3) + (jj & 7) * 2) = (unsigned short)(pw >> 16);
            }
        }
        u32x2 uu[2][4];
#pragma unroll
        for (int it = 0; it < 2; ++it) { const int ii = (it0 + it) * 32 + (lane & 31);
#pragma unroll
            for (int rq = 0; rq < 4; ++rq) uu[it][rq] = *(const u32x2*)(Z + (row0 + ii) * 4096 + gi * 128 + dt * 32 + 8 * rq + 4 * (lane >> 5)); }
        if (Un >= 0) SP_LOADZ(Un);
        LDS_BAR();
        f32x16 acc0, acc1;
#pragma unroll
        for (int e = 0; e < 16; ++e) { acc0[e] = 0.f; acc1[e] = 0.f; }
        const int dA = dt * 32 + (lane & 31);
#pragma unroll
        for (int s_ = 0; s_ < 8; ++s_) {
            const bf16x8 Afr = *(const LAS bf16x8*)(vt + vt_off(dA, 2 * s_ + (lane >> 5)));
            acc0 = __builtin_amdgcn_mfma_f32_32x32x16_bf16(Afr, B0[s_], acc0, 0, 0, 0);
            acc1 = __builtin_amdgcn_mfma_f32_32x32x16_bf16(Afr, B1[s_], acc1, 0, 0, 0);
        }
#pragma unroll
        for (int it = 0; it < 2; ++it) {
            const int ii = (it0 + it) * 32 + (lane & 31); const size_t row = row0 + ii;
#pragma unroll
            for (int rq = 0; rq < 4; ++rq) {
                const int d0 = dt * 32 + 8 * rq + 4 * (lane >> 5);
                float vs[4];
#pragma unroll
                for (int e = 0; e < 4; ++e) vs[e] = (it == 0 ? acc0[rq * 4 + e] : acc1[rq * 4 + e]) + bias[it];
                u32x2 o; o.x = pk2(lo16(uu[it][rq].x) * vs[0], hi16(uu[it][rq].x) * vs[1]); o.y = pk2(lo16(uu[it][rq].y) * vs[2], hi16(uu[it][rq].y) * vs[3]);
                *(u32x2*)(Pb + row * 2048 + gi * 128 + d0) = o;
            }
        }
    }
#undef SP_ROW0
#undef SP_UNIT
#undef SP_LOADZ
    __syncthreads();
}

__global__ void __launch_bounds__(NTHREADS, 2) fwd_kernel(Params P) {
    extern __shared__ __attribute__((aligned(16))) unsigned char lds_raw[];
    Frame F; F.lds = (LAS unsigned char*)lds_raw; F.tid = threadIdx.x; F.lane = F.tid & 63; F.wave = __builtin_amdgcn_readfirstlane(F.tid >> 6);
    F.G = gridDim.x; F.bid = blockIdx.x; F.ws = P.ws; F.kp = (const Params __attribute__((address_space(4)))*)__builtin_amdgcn_kernarg_segment_ptr();
    const int lo = P.ph_lo, hi = P.ph_hi;
    volatile LAS unsigned* misc = (volatile LAS unsigned*)(F.lds + LDS_MISC);
    if (F.tid < 4) misc[F.tid] = 0u;
    __syncthreads();
    XcdBarrier bar; bar.bar = (unsigned*)(F.ws + WS_CTL); bar.x = 0; bar.st = misc;
    if (hi - lo > 1) bar = xcd_barrier_post((unsigned*)(F.ws + WS_CTL), misc);
    int ph = 0;
#define RUN(id, ...) do { if (ph >= lo && ph < hi) { const int nrep_ = ((REP_MASK >> (id)) & 1u) ? 2 : 1; for (int rep_ = 0; rep_ < nrep_; ++rep_) { const bool dry_ = (rep_ + 1 < nrep_); (void)dry_; { int t_ = threadIdx.x; const Params __attribute__((address_space(4)))* kp_ = (const Params __attribute__((address_space(4)))*)__builtin_amdgcn_kernarg_segment_ptr(); asm volatile("" : "+v"(t_), "+s"(kp_)); F.tid = t_; F.lane = t_ & 63; F.kp = kp_; F.ws = kp_->ws; } __VA_ARGS__; if (rep_ + 1 < nrep_ || ph + 1 < hi) xcd_barrier(bar); } } ++ph; } while (0)

    RUN(0, phase_prologue(F));
    for (int g = 0; g < NG; ++g) {
        for (int layer = 0; layer < 4; ++layer) {
            const int a = layer >> 1;
            if ((layer & 1) == 0) {
                const bf16_t* Vc = layer == 0 ? F.wsp<bf16_t>(WS_VF) : F.ar<bf16_t>(AR_V);
                RUN(1, phase_norm1(F, g, layer, F.ar<bf16_t>(AR_H2), 2048, dry_));
                RUN(2, phase_mix(F, a));
                RUN(3, { { pg8::SchedPlain S; S.init(TG / 256, 2, F.G, F.bid, 0);
                        EpiL1 E{F.ar<bf16_t>(AR_L1)};
                        pg8::gemm_phase(F.tid, F.lds, F.ar<bf16_t>(AR_H2), K1CAT, F.wsp<bf16_t>(WS_WL) + (size_t)a * 512 * K1CAT, K1CAT, K1CAT, S, E); }
                      { int t_ = threadIdx.x; asm volatile("" : "+v"(t_)); F.tid = t_; F.lane = t_ & 63; }
                      { pg8::SchedRKV S; S.init(TG / 256, 12, F.G, (F.bid + 192) % F.G, 0);
                        EpiRKV E{F.ws, layer == 0 ? WS_VF : WS_ARENA + AR_V};
                        pg8::gemm_phase(F.tid, F.lds, F.ar<bf16_t>(AR_XR), D, F.wsp<bf16_t>(WS_WRKV) + (size_t)a * 3072 * D, D, D, S, E); } });
                if (layer == 2) {
                    RUN(4, { pg8::SchedPlain S; S.init(TG / 256, 4, F.G, F.bid, 0);
                          EpiStore<1> E{F.ar<bf16_t>(AR_VGATE), F.in(19)};
                          pg8::gemm_phase(F.tid, F.lds, F.ar<bf16_t>(AR_L1) + 256, 512, F.wsp<bf16_t>(WS_V2T), 256, 256, S, E); });
                    RUN(5, phase_vfix(F));
                }
                RUN(6, phase_scan4(F, a, Vc));
                RUN(7, { pg8::SchedPlain S; S.init(TG / 256, 4, F.G, F.bid, 0);
                      EpiStore<0> E{F.ar<bf16_t>(AR_G), nullptr};
                      pg8::gemm_phase(F.tid, F.lds, F.ar<bf16_t>(AR_L1) + 256, 512, F.wsp<bf16_t>(WS_G2T) + (size_t)a * D * 256, 256, 256, S, E); });
                RUN(8, phase_post(F, a, Vc));
                RUN(9, { const int skip = layer == 2; pg8::SchedPlain S; S.init(skip ? BG * 8 : TG / 256, 4, F.G, F.bid, skip);
                      EpiStore<0> E{F.ar<bf16_t>(AR_O), nullptr};
                      pg8::gemm_phase(F.tid, F.lds, F.ar<bf16_t>(AR_R), D, F.wsp<bf16_t>(WS_WO) + (size_t)a * D * D, D, D, S, E); });
            } else {
                const int skip = layer == 3;
                RUN(10, phase_norm1(F, g, layer, F.ar<bf16_t>(AR_H), D, dry_));
                RUN(11, { pg8::SchedPlain S; S.init(skip ? BG * 8 : TG / 256, 16, F.G, F.bid, skip);
                      EpiGelu E{F.ar<bf16_t>(AR_Z), F.in(30) + (size_t)a * 4096};
                      pg8::gemm_phase(F.tid, F.lds, F.ar<bf16_t>(AR_H), D, F.wsp<bf16_t>(WS_WIN) + (size_t)a * 4096 * D, D, D, S, E); });
                RUN(12, phase_sgstats(F, layer));
                RUN(13, phase_spatial(F, a, layer));
                RUN(14, { pg8::SchedPlain S; S.init(skip ? BG * 8 : TG / 256, 4, F.G, F.bid, skip);
                      EpiStore<0> E{F.ar<bf16_t>(AR_O), nullptr};
                      pg8::gemm_phase(F.tid, F.lds, F.ar<bf16_t>(AR_P), 2048, F.wsp<bf16_t>(WS_WOUT) + (size_t)a * D * 2048, 2048, 2048, S, E); });
            }
            RUN(15, phase_norm2(F, g, layer, dry_));
            RUN(16, { const int total = moe_tables(F, g, layer);
                  pg8::SchedMoe<true> S{(const LAS int*)(F.lds + LDS_MISC + 64), (const LAS int*)(F.lds + LDS_MISC + 192), F.ar<int>(AR_LIST), F.G, F.bid, total};
                  EpiMG E{F.ar<bf16_t>(AR_HE)};
                  pg8::gemm_phase(F.tid, F.lds, F.ar<bf16_t>(AR_HM), D, F.wsp<bf16_t>(WS_WGU) + (size_t)layer * NEXP * 1024 * D, D, D, S, E); });
            RUN(17, { const int total = (PER_PHASE_LAUNCH || REP_MASK) ? moe_tables(F, g, layer) : __builtin_amdgcn_readfirstlane(((const LAS int*)(F.lds + LDS_MISC + 192))[32]);
                  pg8::SchedMoe<false> S{(const LAS int*)(F.lds + LDS_MISC + 64), (const LAS int*)(F.lds + LDS_MISC + 192), F.ar<int>(AR_LIST), F.G, F.bid, total};
                  EpiMD E{F.ar<bf16_t>(AR_YM0), F.ar<int>(AR_LIST), F.ar<float>(AR_LW), (const LAS int*)(F.lds + LDS_MISC + 64)};
                  pg8::gemm_phase(F.tid, F.lds, F.ar<bf16_t>(AR_HE), FEXP, F.wsp<bf16_t>(WS_WD) + (size_t)layer * NEXP * D * FEXP, FEXP, FEXP, S, E); });
        }
        RUN(18, phase_norm1(F, g, 4, nullptr, 0));
    }
#undef RUN
}
constexpr int NPHASES = 1 + NG * (10 + 8 + 12 + 8 + 1);

__global__ void nan_fill(float* out, size_t n) { for (size_t i = (size_t)blockIdx.x * blockDim.x + threadIdx.x; i < n; i += (size_t)gridDim.x * blockDim.x) out[i] = __uint_as_float(0x7FC00000u); }

extern "C" void kernel_launch(void* const* d_in, const int* in_sizes, int n_in, void* d_out, int out_size, void* d_ws, size_t ws_size, hipStream_t stream) {
    static int grid = 0;
    if (grid == 0) {
        int dev = 0, cus = 0, per_cu = 0;
        if (n_in != 42 || ws_size < WS_END || hipGetDevice(&dev) != hipSuccess || hipDeviceGetAttribute(&cus, hipDeviceAttributeMultiprocessorCount, dev) != hipSuccess) {
            fprintf(stderr, "kernel_launch: bad setup (n_in %d, ws %zu need %zu)\n", n_in, ws_size, (size_t)WS_END); grid = -1;
        } else if (hipFuncSetAttribute((const void*)fwd_kernel, hipFuncAttributeMaxDynamicSharedMemorySize, LDS_BYTES) != hipSuccess) { fprintf(stderr, "kernel_launch: hipFuncSetAttribute failed\n"); grid = -1; }
        else {
            if (hipOccupancyMaxActiveBlocksPerMultiprocessor(&per_cu, (const void*)fwd_kernel, NTHREADS, LDS_BYTES) != hipSuccess || per_cu < 1) { fprintf(stderr, "kernel_launch: occupancy query reports %d\n", per_cu); }
            (void)hipGetLastError();
            grid = cus;
        }
    }
    if (grid < 0) { hipLaunchKernelGGL(nan_fill, dim3(1024), dim3(256), 0, stream, (float*)d_out, (size_t)out_size); return; }
    (void)hipMemsetAsync((char*)d_ws + WS_CTL, 0, CTL_BYTES, stream);
    Params p{};
    for (int i = 0; i < 42; ++i) p.in[i] = (const float*)d_in[i];
    p.out = (float*)d_out; p.ws = (unsigned char*)d_ws;
#if PER_PHASE_LAUNCH
    for (int k = 0; k < NPHASES; ++k) { p.ph_lo = k; p.ph_hi = k + 1; hipLaunchKernelGGL(fwd_kernel, dim3(grid), dim3(NTHREADS), LDS_BYTES, stream, p); }
#else
    p.ph_lo = 0; p.ph_hi = NPHASES;
    hipLaunchKernelGGL(fwd_kernel, dim3(grid), dim3(NTHREADS), LDS_BYTES, stream, p);
#endif
}
```

```cpp
#include <hip/hip_runtime.h>
#include <cstdio>
#include <cstdint>

#ifndef REP_MASK
#define REP_MASK 0u
#endif
#ifndef PER_PHASE_LAUNCH
#define PER_PHASE_LAUNCH 0
#endif

#define LAS __attribute__((address_space(3)))
typedef unsigned short bf16_t;
typedef short bf16x8 __attribute__((ext_vector_type(8)));
typedef float f32x4 __attribute__((ext_vector_type(4)));
typedef float f32x2 __attribute__((ext_vector_type(2)));
typedef float f32x16 __attribute__((ext_vector_type(16)));
typedef unsigned u32x4 __attribute__((ext_vector_type(4)));
typedef unsigned u32x2 __attribute__((ext_vector_type(2)));

constexpr int NB = 32, SEQ = 2048, LC = 256, LT = SEQ + LC, D = 1024, NH = 16;
constexpr int NG = 2, BG = NB / NG, TG = BG * LT;
constexpr int NTHREADS = 512, NWAVES = 8;
constexpr int N1CAT = 3584, K1CAT = 2048;
constexpr int NEXP = 16, FEXP = 512;

constexpr size_t al256(size_t x) { return (x + 255) & ~(size_t)255; }
constexpr int XCD_BAR_WORDS_C = 3456;
constexpr size_t WS_CTL = 0;
constexpr size_t CTL_BAR_BYTES = (size_t)XCD_BAR_WORDS_C * 4;
constexpr size_t CTL_CNT_OFF = al256(CTL_BAR_BYTES);
constexpr size_t CTL_BYTES = al256(CTL_CNT_OFF + (size_t)2 * NG * 4 * 32 * 64);
constexpr size_t WS_X = al256(WS_CTL + CTL_BYTES);
constexpr size_t WS_VF = WS_X + (size_t)TG * D * 2;
constexpr size_t WS_MODL = WS_VF + (size_t)TG * D * 2;
constexpr size_t WS_MODC = WS_MODL + (size_t)4 * NB * 6 * D * 4;
constexpr size_t WS_WRKV = al256(WS_MODC + (size_t)4 * 6 * D * 4);
constexpr size_t WS_WL = WS_WRKV + (size_t)2 * 3072 * D * 2;
constexpr size_t WS_WO = WS_WL + (size_t)2 * 512 * K1CAT * 2;
constexpr size_t WS_G2T = WS_WO + (size_t)2 * D * D * 2;
constexpr size_t WS_V2T = WS_G2T + (size_t)2 * D * 256 * 2;
constexpr size_t WS_W2T = WS_V2T + (size_t)D * 256 * 2;
constexpr size_t WS_A2T = WS_W2T + (size_t)4 * D * 64 * 2;
constexpr size_t WS_WIN = WS_A2T + (size_t)4 * D * 64 * 2;
constexpr size_t WS_WOUT = WS_WIN + (size_t)2 * 4096 * D * 2;
constexpr size_t WS_WSP = WS_WOUT + (size_t)2 * D * 2048 * 2;
constexpr size_t WS_WGU = WS_WSP + (size_t)2 * 16 * 128 * 128 * 2;
constexpr size_t WS_WD = WS_WGU + (size_t)4 * NEXP * 1024 * D * 2;
constexpr size_t WS_ARENA = al256(WS_WD + (size_t)4 * NEXP * D * FEXP * 2);
constexpr size_t SZB = (size_t)TG * D * 2;
constexpr size_t AR_H2 = 0;
constexpr size_t AR_Y0 = 0, AR_Y1 = SZB;
constexpr size_t AR_XR = 2 * SZB;
constexpr size_t AR_R = 5 * SZB, AR_K = 6 * SZB, AR_V = 7 * SZB;
constexpr size_t AR_L1 = 8 * SZB;
constexpr size_t AR_DOT = AR_L1 + SZB / 2;
constexpr size_t AR_G = 2 * SZB;
constexpr size_t AR_VGATE = 0;
constexpr size_t AR_O = 3 * SZB;
constexpr size_t AR_H = 0;
constexpr size_t AR_Z = SZB;
constexpr size_t AR_P = 5 * SZB;
constexpr size_t AR_ST = 7 * SZB;
constexpr size_t AR_HM = 0;
constexpr size_t AR_HE = SZB;
constexpr size_t HE_ROWS = (size_t)2 * TG + 32 * 256;
constexpr size_t AR_LIST = al256(AR_HE + HE_ROWS * FEXP * 2);
constexpr size_t AR_LW = AR_LIST + (size_t)32 * TG * 4;
constexpr size_t AR_YM0 = 5 * SZB, AR_YM1 = 6 * SZB;
constexpr size_t ARENA_BYTES = AR_DOT + (size_t)2 * TG * 16 * 4 + 4096;
constexpr size_t WS_END = WS_ARENA + ARENA_BYTES;
static_assert(AR_LW + (size_t)32 * TG * 4 <= AR_O, "moe lists overlap");

constexpr int LDS_STAGE = 131072;
constexpr int LDS_MISC = LDS_STAGE;
constexpr int LDS_BYTES = LDS_STAGE + 1024;

struct Params {
    const float* in[42];
    float* out;
    unsigned char* ws;
    int ph_lo, ph_hi;
};

__device__ __forceinline__ float bf2f(unsigned short b) { return __uint_as_float(((unsigned)b) << 16); }
__device__ __forceinline__ unsigned short f2bf(float f) { unsigned u = __float_as_uint(f); u += 0x7FFFu + ((u >> 16) & 1u); return (unsigned short)(u >> 16); }
typedef __bf16 bf16x2_t __attribute__((ext_vector_type(2)));
__device__ __forceinline__ unsigned pk2(float lo, float hi) { const bf16x2_t v = __builtin_convertvector((f32x2){lo, hi}, bf16x2_t); return __builtin_bit_cast(unsigned, v); }
__device__ __forceinline__ float lo16(unsigned w) { return __uint_as_float(w << 16); }
__device__ __forceinline__ float hi16(unsigned w) { return __uint_as_float(w & 0xFFFF0000u); }
__device__ __forceinline__ float sigmoidf_(float x) { return __builtin_amdgcn_rcpf(1.0f + __expf(-x)); }
__device__ __forceinline__ float tanhf_(float x) { return 1.0f - 2.0f * __builtin_amdgcn_rcpf(__expf(2.0f * x) + 1.0f); }
__device__ __forceinline__ float wave_sum(float v) {
#pragma unroll
    for (int o = 32; o > 0; o >>= 1) v += __shfl_xor(v, o);
    return v;
}
template <int CTRL> __device__ __forceinline__ float dpp_f(float v) {
    return __int_as_float(__builtin_amdgcn_update_dpp(0, __float_as_int(v), CTRL, 0xF, 0xF, true));
}
__device__ __forceinline__ float red8(float v) { v += dpp_f<0xB1>(v); v += dpp_f<0x4E>(v); v += dpp_f<0x141>(v); return v; }
__device__ __forceinline__ float red16(float v) { v = red8(v); v += dpp_f<0x140>(v); return v; }
__device__ __forceinline__ float wave_sum_dpp(float v) {
    v = red16(v);
    const float a = __int_as_float(__builtin_amdgcn_readlane(__float_as_int(v), 0)), b = __int_as_float(__builtin_amdgcn_readlane(__float_as_int(v), 16));
    const float c = __int_as_float(__builtin_amdgcn_readlane(__float_as_int(v), 32)), d = __int_as_float(__builtin_amdgcn_readlane(__float_as_int(v), 48));
    return (a + b) + (c + d);
}
__device__ __forceinline__ float red4(float v) { v += dpp_f<0xB1>(v); v += dpp_f<0x4E>(v); return v; }
__device__ __forceinline__ f32x2 gelu_pk(f32x2 v) {
    f32x2 t; t.x = __builtin_amdgcn_rcpf(__builtin_fmaf(__builtin_fabsf(v.x), 0.2316418882f, 1.0f)); t.y = __builtin_amdgcn_rcpf(__builtin_fmaf(__builtin_fabsf(v.y), 0.2316418882f, 1.0f));
    f32x2 q = t * 0.5307027145f + (-0.7265760135f); q = q * t + 0.7107068705f; q = q * t + (-0.142248368f); q = q * t + 0.127414796f; q = q * t;
    const f32x2 s = (v * v) * (-0.72134752044f);
    f32x2 e; e.x = __builtin_amdgcn_exp2f(s.x); e.y = __builtin_amdgcn_exp2f(s.y);
    const f32x2 qe = q * e;
    f32x2 o; o.x = __builtin_fmaf(-__builtin_fabsf(v.x), qe.x, __builtin_fmaxf(v.x, 0.f)); o.y = __builtin_fmaf(-__builtin_fabsf(v.y), qe.y, __builtin_fmaxf(v.y, 0.f)); return o;
}
__device__ __forceinline__ float gelu_f(float v) {
    const float av = fabsf(v), t = __builtin_amdgcn_rcpf(av * 0.2316418882f + 1.0f);
    float q = t * 0.5307027145f + (-0.7265760135f); q = q * t + 0.7107068705f; q = q * t + (-0.142248368f); q = q * t + 0.127414796f; q = q * t;
    const float e = __builtin_amdgcn_exp2f((v * v) * (-0.72134752044f));
    const float m = v * (q * e);
    return v < 0.f ? m : v - m;
}

#define XB_TMO      128
#define XB_XCNT(j)  (256  + 64 * (j))
#define XB_XSUB(j)  (1280 + 64 * (j))
#define XB_XGEN(j)  (2304 + 64 * (j))
#define XB_TOP      3328
#define XB_TOPGEN   3392
#define XCD_BAR_WORDS 3456
#define XB_SPIN_CAP (1u << 22)
static_assert(XCD_BAR_WORDS == XCD_BAR_WORDS_C, "barrier words");
__device__ __forceinline__ unsigned xb_ld(unsigned* p)              { return __hip_atomic_load(p, __ATOMIC_RELAXED, __HIP_MEMORY_SCOPE_AGENT); }
__device__ __forceinline__ unsigned xb_add(unsigned* p, unsigned v) { return __hip_atomic_fetch_add(p, v, __ATOMIC_RELAXED, __HIP_MEMORY_SCOPE_AGENT); }
__device__ __forceinline__ unsigned xb_xcc_id() { return (unsigned)__builtin_amdgcn_s_getreg((3 << 11) | 20) & 0xFu; }
#define XB_SPIN(cond, bar) do { unsigned _sp = 0; while (cond) { __builtin_amdgcn_s_sleep(1); \
    if ((++_sp & 255u) == 0u) { if (xb_ld(&(bar)[XB_TMO])) break; if (_sp > XB_SPIN_CAP) { atomicAdd(&(bar)[XB_TMO], 1u); break; } } } } while (0)
struct XcdBarrier { unsigned* bar; unsigned x; volatile LAS unsigned* st; };
__device__ __forceinline__ XcdBarrier xcd_barrier_post(unsigned* bar, volatile LAS unsigned* st) {
    XcdBarrier b; b.bar = bar; b.x = xb_xcc_id(); b.st = st;
    if (threadIdx.x == 0) (void)xb_add(&bar[XB_XCNT(b.x)], 1u);
    return b;
}
__device__ __forceinline__ void xcd_barrier_complete(unsigned* bar, unsigned x, unsigned& nloc, unsigned& nx) {
    const unsigned G = gridDim.x * gridDim.y * gridDim.z;
    unsigned sum, cnt, mine, sp = 0u;
    for (;;) {
        sum = 0u; cnt = 0u; mine = 0u;
#pragma unroll
        for (unsigned j = 0; j < 16; ++j) { const unsigned c = xb_ld(&bar[XB_XCNT(j)]); sum += c; cnt += (c > 0u) ? 1u : 0u; mine = (j == x) ? c : mine; }
        if (sum == G) break;
        __builtin_amdgcn_s_sleep(1);
        if ((++sp & 255u) == 0u) { if (xb_ld(&bar[XB_TMO])) break; if (sp > XB_SPIN_CAP) { atomicAdd(&bar[XB_TMO], 1u); break; } }
    }
    nloc = mine > 0u ? mine : 1u; nx = cnt > 0u ? cnt : 1u;
}
__device__ __forceinline__ void xcd_barrier(const XcdBarrier& b) {
    asm volatile("s_waitcnt vmcnt(0)" ::: "memory");
    __syncthreads();
    if (threadIdx.x == 0) {
        unsigned* bar = b.bar;
        __builtin_amdgcn_s_waitcnt(0);
        unsigned nloc = b.st[0], nx = b.st[1];
        if (nloc == 0u) { xcd_barrier_complete(bar, b.x, nloc, nx); b.st[0] = nloc; b.st[1] = nx; }
        const unsigned old = xb_add(&bar[XB_XSUB(b.x)], 1u);
        const unsigned gen = old / nloc;
        if (old + 1u == (gen + 1u) * nloc) {
            __builtin_amdgcn_fence(__ATOMIC_RELEASE, "agent");
            asm volatile("s_waitcnt vmcnt(0)" ::: "memory");
            const unsigned og = xb_add(&bar[XB_TOP], 1u);
            const unsigned tg = og / nx;
            if (og + 1u == (tg + 1u) * nx) xb_add(&bar[XB_TOPGEN], 1u);
            else XB_SPIN(xb_ld(&bar[XB_TOPGEN]) == tg, bar);
            __builtin_amdgcn_fence(__ATOMIC_ACQUIRE, "agent");
            xb_add(&bar[XB_XGEN(b.x)], 1u);
            asm volatile("s_waitcnt vmcnt(0)" ::: "memory");
        } else {
            XB_SPIN(xb_ld(&bar[XB_XGEN(b.x)]) == gen, bar);
            __builtin_amdgcn_fence(__ATOMIC_ACQUIRE, "agent");
            asm volatile("s_waitcnt vmcnt(0)" ::: "memory");
        }
    }
    __syncthreads();
}

__device__ __forceinline__ float clamp_f8(float x) { return __builtin_amdgcn_fmed3f(x, -448.0f, 448.0f); }
__device__ __forceinline__ unsigned pk4_f8(float a, float b, float c, float d) { int p = 0; p = __builtin_amdgcn_cvt_pk_fp8_f32(clamp_f8(a), clamp_f8(b), p, false); p = __builtin_amdgcn_cvt_pk_fp8_f32(clamp_f8(c), clamp_f8(d), p, true); return (unsigned)p; }
typedef int i32x8 __attribute__((ext_vector_type(8)));
typedef int i32x4 __attribute__((ext_vector_type(4)));
__device__ __forceinline__ i32x8 cat8(bf16x8 a, bf16x8 b) { return __builtin_shufflevector(__builtin_bit_cast(i32x4, a), __builtin_bit_cast(i32x4, b), 0, 1, 2, 3, 4, 5, 6, 7); }
#define LDS_BAR() asm volatile("s_waitcnt lgkmcnt(0)\n\ts_barrier" ::: "memory")
namespace pg8 {
constexpr int BM = 256, BK = 64, HALF = 128, HTB = HALF * BK * 2, STAGE_BYTES = 8 * HTB, NXCD = 8, WGM = 8;
__host__ __device__ __forceinline__ int lds_byte(int r, int c) { const int st = (r >> 4) * 2 + (c >> 5), rr = r & 15, cc = c & 31, ob = rr * 64 + cc * 2; return st * 1024 + (ob ^ (((ob >> 9) & 1) << 5)); }
__host__ __device__ __forceinline__ void stage_rc(int b, int& R, int& C) { const int st = b / 1024, sb = b % 1024, swz = sb ^ (((sb >> 9) & 1) << 5); R = (st >> 1) * 16 + swz / 64; C = (st & 1) * 32 + (swz % 64) / 2; }
__host__ __device__ __forceinline__ int perm32(int rho) { const int n = rho >> 4, i = rho & 15; return 8 * (i >> 2) + 4 * n + (i & 3); }
struct Unit { int pm, pn, aux; };

struct SchedPlain {
    static constexpr bool GATHER = false;
    int nM, nN, nwg, G, c, skipctx;
    __device__ void init(int nM_, int nN_, int G_, int c_, int skipctx_) { nM = nM_; nN = nN_; nwg = nM * nN; G = G_; c = c_; skipctx = skipctx_; }
    __device__ bool next(int i, Unit& u) const { return at((long)i * G + c, u); }
    __device__ bool at(long L, Unit& u) const {
        if (L >= nwg) return false;
        int wgid = (int)L; { const int q = nwg / NXCD, r = nwg % NXCD, xcd = wgid % NXCD, off = wgid / NXCD; wgid = (xcd < r ? xcd * (q + 1) : r * (q + 1) + (xcd - r) * q) + off; }
        const int nig = WGM * nN, gid = wgid / nig, fm = gid * WGM, gsz = (nM - fm) < WGM ? (nM - fm) : WGM;
        int pm = fm + ((wgid % nig) % gsz); u.pn = (wgid % nig) / gsz; u.aux = 0;
        if (skipctx) pm = (pm >> 3) * 9 + 1 + (pm & 7);
        u.pm = pm; return true;
    }
    __device__ __forceinline__ int arow(const Unit& u, int r) const { return u.pm * BM + r; }
};
struct SchedRKV : SchedPlain {
    __device__ bool next(int i, Unit& u) const {
        long L;
        if (G == 256 && nwg == 1728) { if (i < 5) L = (long)i * 256 + c; else { if (c < 32 || i > 6) return false; L = 1280 + (i - 5) * 224 + (c - 32); } }
        else L = (long)i * G + (c + 192) % G;
        if (!SchedPlain::at(L, u)) return false;
        u.pm += (u.pn >> 2) * nM; return true; }
};
template <bool GATH> struct SchedMoe {
    static constexpr bool GATHER = GATH;
    const LAS int* cn; const LAS int* tb; const int* lists; int G, c, total;
    __device__ bool next(int i, Unit& u) const {
        const int U = i * G + c; if (U >= total * 4) return false;
        const int T = U >> 2, pn = U & 3; int l = 0;
        while (tb[l + 1] <= T) ++l;
        u.pm = T; u.pn = (l >> 1) * 4 + pn; u.aux = l | ((T - tb[l]) << 8); return true;
    }
    __device__ __forceinline__ int arow(const Unit& u, int r) const {
        if (!GATH) return u.pm * BM + r;
        const int l = u.aux & 255, idx = (u.aux >> 8) * BM + r;
        return idx < cn[l] ? lists[(size_t)l * TG + idx] : 0;
    }
};

constexpr int UL_MAX = 21;
template <class Base> struct SchedList {
    static constexpr bool GATHER = Base::GATHER;
    const LAS int* tab; int n; Base base;
    __device__ __forceinline__ bool next(int i, Unit& u) const {
        if (i >= UL_MAX) return base.next(i, u);
        if (i >= n) return false;
        u.pm = __builtin_amdgcn_readfirstlane(tab[3 * i]); u.pn = __builtin_amdgcn_readfirstlane(tab[3 * i + 1]); u.aux = __builtin_amdgcn_readfirstlane(tab[3 * i + 2]); return true;
    }
    __device__ __forceinline__ int arow(const Unit& u, int r) const { return base.arow(u, r); }
};
template <class Base> __device__ __forceinline__ SchedList<Base> make_list(int tid, LAS unsigned char* lds, const Base& S) {
    LAS int* tab = (LAS int*)(lds + 131072 + 768);
    __syncthreads();
    if (tid < UL_MAX) { Unit u; u.pm = 0; u.pn = 0; u.aux = 0; const bool ok = S.next(tid, u); tab[3 * tid] = ok ? u.pm : -1; tab[3 * tid + 1] = u.pn; tab[3 * tid + 2] = u.aux; }
    __syncthreads();
    int n = 0;
    while (n < UL_MAX && __builtin_amdgcn_readfirstlane(tab[3 * n]) >= 0) ++n;
    return SchedList<Base>{tab, n, S};
}

template <class Epi, class Sched, bool F8 = false>
__device__ __forceinline__ void gemm_phase(const int tid, LAS unsigned char* lds, const bf16_t* A, int lda, const bf16_t* Bt, int ldb, int K, const Sched& S, const Epi& E) {
    constexpr bool GA = Sched::GATHER;
    const int wid = __builtin_amdgcn_readfirstlane(tid >> 6), lane = tid & 63, wr = wid >> 2, wc = wid & 3, fr = lane & 15, fq = lane >> 4;
    const int nt = K / BK;
    unsigned voffA[2], voffB[2];
#pragma unroll
    for (int i = 0; i < 2; ++i) { int R, C; stage_rc(tid * 16 + i * 8192, R, C); const int Rb = (R & ~31) + perm32(R & 31);
        voffA[i] = (unsigned)(R * lda + C) * 2u; voffB[i] = (unsigned)(Rb * ldb + C) * 2u; }
    const size_t kstep = (size_t)(BK * 2);
    const size_t hstepA = (size_t)HALF * lda * 2, tstepA = 2 * hstepA;
    const size_t hstepB = (size_t)HALF * ldb * 2, tstepB = 2 * hstepB;
    const unsigned ldsw = (unsigned)wid * 1024u;
    const int aoff = lds_byte(wr * 64 + fr, fq * 8), boff = lds_byte(wc * 32 + fr, fq * 8);
#define PG8_SA(b, h) (((b) * 2 + (h)) * HTB)
#define PG8_SB(b, h) ((4 + (b) * 2 + (h)) * HTB)
#define PG8_STAGE(bufoff, gbase, voff) do { _Pragma("unroll") for (int _i = 0; _i < 2; ++_i) \
        __builtin_amdgcn_global_load_lds((const unsigned*)((const char*)(gbase) + (voff)[_i]), (LAS unsigned*)(lds + (bufoff) + ldsw + _i * 8192), 16, 0, 0); } while (0)
#define PG8_STAGE_A(bufoff, ub, gv, h, koff) do { if constexpr (GA) { PG8_STAGE(bufoff, (const char*)A + (koff), gv[h]); } else { PG8_STAGE(bufoff, (ub) + (h) * hstepA + (koff), voffA); } } while (0)
#define PG8_LDA(dst, b, h) do { _Pragma("unroll") for (int m = 0; m < 4; ++m) _Pragma("unroll") for (int k = 0; k < 2; ++k) dst[m].k[k] = *(const LAS bf16x8*)(lds + PG8_SA(b, h) + aoff + m * 2048 + k * 1024); } while (0)
#define PG8_LDB(dst, b, h) do { _Pragma("unroll") for (int n = 0; n < 2; ++n) _Pragma("unroll") for (int k = 0; k < 2; ++k) dst[n].k[k] = *(const LAS bf16x8*)(lds + PG8_SB(b, h) + boff + n * 2048 + k * 1024); } while (0)
#define PG8_MMA(ai, bj, At, Bt_) do { __builtin_amdgcn_s_setprio(1); \
        if constexpr (F8) { _Pragma("unroll") for (int m = 0; m < 4; ++m) _Pragma("unroll") for (int n = 0; n < 2; ++n) \
            asm volatile("v_mfma_f32_16x16x128_f8f6f4 %0, %1, %2, %0" : "+v"(acc[ai][bj][m][n]) : "v"(__builtin_bit_cast(i32x8, Bt_[n])), "v"(__builtin_bit_cast(i32x8, At[m]))); } \
        else { _Pragma("unroll") for (int m = 0; m < 4; ++m) _Pragma("unroll") for (int n = 0; n < 2; ++n) _Pragma("unroll") for (int k = 0; k < 2; ++k) \
            acc[ai][bj][m][n] = __builtin_amdgcn_mfma_f32_16x16x32_bf16(Bt_[n].k[k], At[m].k[k], acc[ai][bj][m][n], 0, 0, 0); } \
        __builtin_amdgcn_s_setprio(0); } while (0)
#define PG8_WAIT_V(n) asm volatile("s_waitcnt vmcnt(" #n ")" ::: "memory")
#define PG8_WAIT_L(n) asm volatile("s_waitcnt lgkmcnt(" #n ")" ::: "memory")
#define PG8_BAR __builtin_amdgcn_s_barrier()
#define PG8_SCHED __builtin_amdgcn_sched_barrier(0)
#define PG8_GOFF(dst, u) do { if constexpr (GA) { _Pragma("unroll") for (int _h = 0; _h < 2; ++_h) _Pragma("unroll") for (int _i = 0; _i < 2; ++_i) { int R_, C_; stage_rc(tid * 16 + _i * 8192, R_, C_); \
        dst[_h][_i] = ((unsigned)S.arow(u, _h * HALF + R_) * (unsigned)lda + (unsigned)C_) * 2u; } } } while (0)
#define PG8_ITER(MM0) do { \
            const bool last = (t == nt - 2); \
            const size_t k1 = (size_t)(t + 1) * kstep; \
            const size_t k2 = last ? (size_t)0 : (size_t)(t + 2) * kstep, k3 = k2 + kstep; \
            const char* a2 = last ? nA : cA; const char* b2 = last ? nB : cB; \
            unsigned g2[2][2]; \
            if constexpr (GA) { \
                _Pragma("unroll") for (int _h = 0; _h < 2; ++_h) _Pragma("unroll") for (int _i = 0; _i < 2; ++_i) g2[_h][_i] = last ? gAn[_h][_i] : gAc[_h][_i]; \
            } \
              \
            PG8_LDB(B0, 0, 0); PG8_SCHED; PG8_LDA(At, 0, 0); PG8_STAGE_A(PG8_SA(1, 1), cA, gAc, 1, k1); \
            PG8_WAIT_L(8); PG8_BAR; PG8_WAIT_L(0); MM0(0, 0, At, B0); PG8_BAR; PG8_SCHED; \
              \
            PG8_LDB(B1, 0, 1); PG8_STAGE(PG8_SB(0, 0), b2 + k2, voffB); \
            PG8_BAR; PG8_WAIT_L(0); MM0(0, 1, At, B1); PG8_BAR; \
              \
            PG8_LDA(At, 0, 1); PG8_STAGE_A(PG8_SA(0, 0), a2, g2, 0, k2); \
            PG8_BAR; PG8_WAIT_L(0); MM0(1, 0, At, B0); PG8_BAR; PG8_SCHED; \
              \
            PG8_STAGE(PG8_SB(0, 1), b2 + hstepB + k2, voffB); \
            PG8_WAIT_V(6); PG8_BAR; MM0(1, 1, At, B1); PG8_BAR; \
              \
            PG8_LDB(B0, 1, 0); PG8_SCHED; PG8_LDA(At, 1, 0); PG8_STAGE_A(PG8_SA(0, 1), a2, g2, 1, k2); \
            PG8_WAIT_L(8); PG8_BAR; PG8_WAIT_L(0); PG8_MMA(0, 0, At, B0); PG8_BAR; PG8_SCHED; \
              \
            PG8_LDB(B1, 1, 1); PG8_STAGE(PG8_SB(1, 0), b2 + k3, voffB); \
            PG8_BAR; PG8_WAIT_L(0); PG8_MMA(0, 1, At, B1); PG8_BAR; \
              \
            PG8_LDA(At, 1, 1); PG8_STAGE_A(PG8_SA(1, 0), a2, g2, 0, k3); \
            PG8_BAR; PG8_WAIT_L(0); PG8_MMA(1, 0, At, B0); PG8_BAR; PG8_SCHED; \
              \
            PG8_STAGE(PG8_SB(1, 1), b2 + hstepB + k3, voffB); \
            PG8_WAIT_V(6); PG8_BAR; PG8_MMA(1, 1, At, B1); PG8_BAR; } while (0)
#define PG8_MMAZ(ai, bj, At, Bt_) do { __builtin_amdgcn_s_setprio(1); _Pragma("unroll") for (int m = 0; m < 4; ++m) _Pragma("unroll") for (int n = 0; n < 2; ++n) \
            asm volatile("v_mfma_f32_16x16x128_f8f6f4 %0, %1, %2, 0" : "=v"(acc[ai][bj][m][n]) : "v"(__builtin_bit_cast(i32x8, Bt_[n])), "v"(__builtin_bit_cast(i32x8, At[m]))); \
            __builtin_amdgcn_s_setprio(0); } while (0)
    Unit cur, nxt; int ui = 0;
    if (!S.next(0, cur)) return;
    f32x4 acc[2][2][4][2];
#pragma unroll
    for (int a = 0; a < 2; ++a)
#pragma unroll
        for (int b = 0; b < 2; ++b)
#pragma unroll
            for (int m = 0; m < 4; ++m)
#pragma unroll
                for (int n = 0; n < 2; ++n) acc[a][b][m][n] = (f32x4){0.f, 0.f, 0.f, 0.f};
    struct Frag { bf16x8 k[2]; };
    Frag At[4], B0[2], B1[2];
    unsigned gAc[2][2], gAn[2][2];
    PG8_GOFF(gAc, cur);
    const char* cA = (const char*)A + (GA ? (size_t)0 : (size_t)cur.pm * tstepA);
    const char* cB = (const char*)Bt + (size_t)cur.pn * tstepB;
    PG8_STAGE(PG8_SB(0, 0), cB, voffB); PG8_STAGE_A(PG8_SA(0, 0), cA, gAc, 0, 0); PG8_STAGE(PG8_SB(0, 1), cB + hstepB, voffB); PG8_STAGE_A(PG8_SA(0, 1), cA, gAc, 1, 0);
    if (wr == 1) PG8_BAR;
    PG8_WAIT_V(4); PG8_BAR;
    PG8_STAGE(PG8_SB(1, 0), cB + kstep, voffB); PG8_STAGE_A(PG8_SA(1, 0), cA, gAc, 0, kstep); PG8_STAGE(PG8_SB(1, 1), cB + hstepB + kstep, voffB);
    PG8_WAIT_V(6); PG8_BAR;
    for (;;) {
        const bool has_next = S.next(ui + 1, nxt);
        if (has_next) { PG8_GOFF(gAn, nxt); }
        else if constexpr (GA) {
#pragma unroll
            for (int _h = 0; _h < 2; ++_h)
#pragma unroll
                for (int _i = 0; _i < 2; ++_i) gAn[_h][_i] = gAc[_h][_i];
        }
        const char* nA = (has_next && !GA) ? (const char*)A + (size_t)nxt.pm * tstepA : cA;
        const char* nB = has_next ? (const char*)Bt + (size_t)nxt.pn * tstepB : cB;
        if constexpr (Epi::HAS_PRE) E.pre(cur, wr, fr);
        if constexpr (F8) {
            { const int t = 0; PG8_ITER(PG8_MMAZ); }
#pragma unroll 1
            for (int t = 2; t < nt; t += 2) PG8_ITER(PG8_MMA);
        } else {
#pragma unroll 1
            for (int t = 0; t < nt; t += 2) PG8_ITER(PG8_MMA);
        }
        if constexpr (F8) asm volatile("s_nop 15\n\ts_nop 15" ::: "memory");
        { int fr_e = fr, fq_e = fq; asm volatile("" : "+v"(fr_e), "+v"(fq_e)); E(acc, cur, wr, wc, fr_e, fq_e); }
        if (!has_next) break;
        if constexpr (!F8) {
#pragma unroll
        for (int a = 0; a < 2; ++a)
#pragma unroll
            for (int b = 0; b < 2; ++b)
#pragma unroll
                for (int m = 0; m < 4; ++m)
#pragma unroll
                    for (int n = 0; n < 2; ++n) acc[a][b][m][n] = (f32x4){0.f, 0.f, 0.f, 0.f};
        }
        cur = nxt; cA = nA; cB = nB; ++ui;
        if constexpr (GA) {
#pragma unroll
            for (int _h = 0; _h < 2; ++_h)
#pragma unroll
                for (int _i = 0; _i < 2; ++_i) gAc[_h][_i] = gAn[_h][_i];
        }
    }
    PG8_WAIT_V(0);
    if (wr == 0) PG8_BAR;
    PG8_BAR;
#undef PG8_SA
#undef PG8_SB
#undef PG8_STAGE
#undef PG8_STAGE_A
#undef PG8_LDA
#undef PG8_LDB
#undef PG8_MMA
#undef PG8_WAIT_V
#undef PG8_WAIT_L
#undef PG8_BAR
#undef PG8_SCHED
#undef PG8_GOFF
#undef PG8_ITER
#undef PG8_MMAZ
}
}
using pg8::Unit;

#define EPI_LOOP_BEGIN \
    _Pragma("unroll") for (int ai = 0; ai < 2; ++ai) _Pragma("unroll") for (int m = 0; m < 4; ++m) { const int trow = ai * 128 + wr * 64 + m * 16 + fr; \
    _Pragma("unroll") for (int bj = 0; bj < 2; ++bj) { const int tcol = bj * 128 + wc * 32 + 8 * fq; const f32x4 v0 = acc[ai][bj][m][0], v1 = acc[ai][bj][m][1];
#define EPI_LOOP_END } asm volatile("" ::: "memory"); }
__device__ __forceinline__ u32x4 pk8(const f32x4 a, const f32x4 b) { return (u32x4){pk2(a[0], a[1]), pk2(a[2], a[3]), pk2(b[0], b[1]), pk2(b[2], b[3])}; }

struct EpiRKV {
    static constexpr bool HAS_PRE = false;
    unsigned char* ws; size_t voff;
    __device__ __forceinline__ void operator()(const f32x4 (&acc)[2][2][4][2], const Unit& u, int wr, int wc, int fr, int fq) const {
        const int which = u.pn >> 2; const size_t row0 = (size_t)(u.pm - which * (TG / 256)) * 256;
        const size_t off = which == 0 ? (WS_ARENA + AR_R) : (which == 1 ? (WS_ARENA + AR_K) : voff);
        bf16_t* dst = (bf16_t*)(ws + off); const int cb = (u.pn & 3) * 256;
        EPI_LOOP_BEGIN
            *(u32x4*)(dst + (row0 + trow) * D + cb + tcol) = pk8(v0, v1);
        EPI_LOOP_END
    }
};
struct EpiL1 {
    static constexpr bool HAS_PRE = false;
    bf16_t* L1;
    __device__ __forceinline__ void operator()(const f32x4 (&acc)[2][2][4][2], const Unit& u, int wr, int wc, int fr, int fq) const {
        const int pn = u.pn; const size_t row0 = (size_t)u.pm * 256; const int cb = pn * 256;
        EPI_LOOP_BEGIN
            f32x4 o0 = v0, o1 = v1;
            if (pn == 0 && bj == 0) { _Pragma("unroll") for (int e = 0; e < 4; ++e) { o0[e] = tanhf_(v0[e]); o1[e] = tanhf_(v1[e]); } }
            if (pn == 1 && bj == 0) { _Pragma("unroll") for (int e = 0; e < 4; ++e) { o0[e] = sigmoidf_(v0[e]); o1[e] = sigmoidf_(v1[e]); } }
            *(u32x4*)(L1 + (row0 + trow) * 512 + cb + tcol) = pk8(o0, o1);
        EPI_LOOP_END
    }
};
template <int ACT> struct EpiStore {
    static constexpr bool HAS_PRE = false;
    bf16_t* O; const float* bias; float osc = 1.f;
    __device__ __forceinline__ void operator()(const f32x4 (&acc)[2][2][4][2], const Unit& u, int wr, int wc, int fr, int fq) const {
        const size_t row0 = (size_t)u.pm * 256; const int cb = u.pn * 256;
        f32x4 bv[2][2];
#pragma unroll
        for (int bj = 0; bj < 2; ++bj)
#pragma unroll
            for (int n = 0; n < 2; ++n) bv[bj][n] = ACT == 1 ? *(const f32x4*)(bias + cb + bj * 128 + wc * 32 + 8 * fq + 4 * n) : (f32x4){0.f, 0.f, 0.f, 0.f};
        EPI_LOOP_BEGIN
            f32x4 o0 = v0 * osc, o1 = v1 * osc;
            if (ACT == 1) { _Pragma("unroll") for (int e = 0; e < 4; ++e) { o0[e] = sigmoidf_(v0[e] + bv[bj][0][e]); o1[e] = sigmoidf_(v1[e] + bv[bj][1][e]); } }
            *(u32x4*)(O + (row0 + trow) * D + cb + tcol) = pk8(o0, o1);
        EPI_LOOP_END
    }
};
struct EpiGelu {
    static constexpr bool HAS_PRE = false;
    bf16_t* Z; const float* bias; float osc = 1.f;
    __device__ __forceinline__ void operator()(const f32x4 (&acc)[2][2][4][2], const Unit& u, int wr, int wc, int fr, int fq) const {
        const size_t row0 = (size_t)u.pm * 256; const int cb = u.pn * 256;
        f32x4 bv[2][2];
#pragma unroll
        for (int bj = 0; bj < 2; ++bj)
#pragma unroll
            for (int n = 0; n < 2; ++n) bv[bj][n] = *(const f32x4*)(bias + cb + bj * 128 + wc * 32 + 8 * fq + 4 * n);
        EPI_LOOP_BEGIN
            const f32x4 b0 = bv[bj][0], b1 = bv[bj][1];
            const f32x2 g0 = gelu_pk((f32x2){v0[0] * osc + b0[0], v0[1] * osc + b0[1]}), g1 = gelu_pk((f32x2){v0[2] * osc + b0[2], v0[3] * osc + b0[3]});
            const f32x2 g2 = gelu_pk((f32x2){v1[0] * osc + b1[0], v1[1] * osc + b1[1]}), g3 = gelu_pk((f32x2){v1[2] * osc + b1[2], v1[3] * osc + b1[3]});
            *(u32x4*)(Z + (row0 + trow) * 4096 + cb + tcol) = (u32x4){pk2(g0.x, g0.y), pk2(g1.x, g1.y), pk2(g2.x, g2.y), pk2(g3.x, g3.y)};
        EPI_LOOP_END
    }
};
struct EpiMG {
    static constexpr bool HAS_PRE = false;
    unsigned char* HE; float osc;
    __device__ __forceinline__ void operator()(const f32x4 (&acc)[2][2][4][2], const Unit& u, int wr, int wc, int fr, int fq) const {
        const size_t row0 = (size_t)u.pm * 256; const int pnl = u.pn & 3;
        const int f = pnl * 128 + wc * 32 + fq * 8;
#pragma unroll
        for (int ai = 0; ai < 2; ++ai)
#pragma unroll
            for (int m = 0; m < 4; ++m) { const int trow = ai * 128 + wr * 64 + m * 16 + fr;
                f32x4 o[2];
#pragma unroll
                for (int bj = 0; bj < 2; ++bj) {
                    const f32x4 ga = acc[ai][bj][m][0], up = acc[ai][bj][m][1] * (osc * osc * 8.f);
#pragma unroll
                    for (int e = 0; e < 4; ++e) o[bj][e] = ga[e] * __builtin_amdgcn_rcpf(1.0f + __builtin_amdgcn_exp2f(ga[e] * (osc * -1.44269504089f))) * up[e];
                }
                *(u32x2*)(HE + (row0 + trow) * FEXP + f) = (u32x2){pk4_f8(o[0][0], o[0][1], o[0][2], o[0][3]), pk4_f8(o[1][0], o[1][1], o[1][2], o[1][3])};
            }
    }
};
struct EpiMD {
    static constexpr bool HAS_PRE = true;
    bf16_t* Y0; const int* lists; const float* lw; const LAS int* cn; float osc;
    mutable int tok[2][4]; mutable float wgt[2][4];
    __device__ __forceinline__ void pre(const Unit& u, int wr, int fr) const {
        const int l = u.aux & 255, t0 = (u.aux >> 8) * 256, cnt = cn[l];
#pragma unroll
        for (int ai = 0; ai < 2; ++ai)
#pragma unroll
            for (int m = 0; m < 4; ++m) { const int idx = t0 + ai * 128 + wr * 64 + m * 16 + fr; const bool ok = idx < cnt;
                const size_t at = (size_t)l * TG + (ok ? idx : 0); const int tk = lists[at]; const float wg = lw[at]; tok[ai][m] = ok ? tk : -1; wgt[ai][m] = ok ? wg : 0.f; }
    }
    __device__ __forceinline__ void operator()(const f32x4 (&acc)[2][2][4][2], const Unit& u, int wr, int wc, int fr, int fq) const {
        const int l = u.aux & 255; const int cb = (u.pn & 3) * 256;
        bf16_t* Y = Y0 + (size_t)(l & 1) * ((AR_YM1 - AR_YM0) / 2);
#pragma unroll
        for (int ai = 0; ai < 2; ++ai)
#pragma unroll
            for (int m = 0; m < 4; ++m) {
                if (tok[ai][m] >= 0) {
                    const float wg = wgt[ai][m] * osc; bf16_t* yr = Y + (size_t)tok[ai][m] * D + cb;
#pragma unroll
                    for (int bj = 0; bj < 2; ++bj) { const int tcol = bj * 128 + wc * 32 + 8 * fq;
                        *(u32x4*)(yr + tcol) = pk8(acc[ai][bj][m][0] * wg, acc[ai][bj][m][1] * wg); }
                } }
    }
};

struct Frame {
    const Params __attribute__((address_space(4)))* kp; LAS unsigned char* lds; int tid, lane, wave, G, bid;
    unsigned char* ws;
    __device__ __forceinline__ const float* in(int k) const { return kp->in[k]; }
    __device__ __forceinline__ float* outp() const { return kp->out; }
    __device__ __forceinline__ int rowblk() const { return (G % 8 == 0) ? (bid % 8) * (G / 8) + bid / 8 : bid; }
    template <class T> __device__ __forceinline__ T* wsp(size_t off) const { return (T*)(ws + off); }
    template <class T> __device__ __forceinline__ T* ar(size_t off) const { return (T*)(ws + WS_ARENA + off); }
    __device__ __forceinline__ const float* modL(int layer, int b, int j) const { return (const float*)(ws + WS_MODL) + (((size_t)layer * NB + b) * 6 + j) * D; }
    __device__ __forceinline__ const float* modC(int layer, int j) const { return (const float*)(ws + WS_MODC) + ((size_t)layer * 6 + j) * D; }
};

struct TJob { const float* src; bf16_t* dst; const float* ksc; int lds, K, N, ldd, kofs, nofs, inter, f8; };
constexpr int NJOBS = 2 * 21 + 1 + 4 + 4 * NEXP * 3;
__device__ __forceinline__ TJob get_job(const Frame& F, int j) {
    TJob J; J.ksc = nullptr; J.kofs = 0; J.nofs = 0; J.inter = 0; J.f8 = 0; J.K = 0; J.N = 0; J.lds = 0; J.ldd = 0; J.src = nullptr; J.dst = nullptr;
    if (j < 42) {
        const int a = j / 21, q = j % 21;
        if (q < 3) { J.src = F.in(9 + q) + (size_t)a * D * D; J.lds = D; J.K = D; J.N = D; J.dst = F.wsp<bf16_t>(WS_WRKV) + (size_t)a * 3072 * D; J.ldd = D; J.nofs = q * 1024; }
        else if (q < 15) {
            const int half = (q - 3) / 6, w = (q - 3) % 6; const float* mu = F.in(8) + (size_t)a * 6 * D;
            J.dst = F.wsp<bf16_t>(WS_WL) + (size_t)a * 512 * K1CAT; J.ldd = K1CAT; J.kofs = half * 1024; J.K = D; int mi = 0;
            if (w < 2) { J.src = F.in(14) + ((size_t)a * 2 + w) * D * 64; J.lds = 64; J.N = 64; J.nofs = w * 64; mi = 1; }
            else if (w < 4) { const int d = w - 2; J.src = F.in(17) + ((size_t)a * 2 + d) * D * 64; J.lds = 64; J.N = 64; J.nofs = 128 + d * 64; mi = 4; }
            else if (w == 4) { J.src = F.in(22) + (size_t)a * D * 128; J.lds = 128; J.N = 128; J.nofs = 256; mi = 5; }
            else { J.src = F.in(20); J.lds = 32; J.N = (a == 1) ? 32 : 0; J.nofs = 384; mi = 3; }
            if (half) J.ksc = mu + mi * D;
        } else if (q == 15) { J.src = F.in(12) + (size_t)a * D * D; J.lds = D; J.K = D; J.N = D; J.dst = (bf16_t*)(F.ws + WS_WO + (size_t)a * D * D); J.ldd = D; J.f8 = 1; }
        else if (q == 16) { J.src = F.in(23) + (size_t)a * 128 * D; J.lds = D; J.K = 128; J.N = D; J.dst = F.wsp<bf16_t>(WS_G2T) + (size_t)a * D * 256; J.ldd = 256; }
        else if (q < 19) { const int d = q - 17; J.src = F.in(15) + ((size_t)a * 2 + d) * 64 * D; J.lds = D; J.K = 64; J.N = D; J.dst = F.wsp<bf16_t>(WS_W2T) + ((size_t)a * 2 + d) * D * 64; J.ldd = 64; }
        else { const int d = q - 19; J.src = F.in(18) + ((size_t)a * 2 + d) * 64 * D; J.lds = D; J.K = 64; J.N = D; J.dst = F.wsp<bf16_t>(WS_A2T) + ((size_t)a * 2 + d) * D * 64; J.ldd = 64; }
    } else if (j == 42) { J.src = F.in(21); J.lds = D; J.K = 32; J.N = D; J.dst = F.wsp<bf16_t>(WS_V2T); J.ldd = 256; J.kofs = 128; }
    else if (j < 47) {
        const int q = j - 43, b = q >> 1;
        if ((q & 1) == 0) { J.src = F.in(29) + (size_t)b * D * 4096; J.lds = 4096; J.K = D; J.N = 4096; J.dst = (bf16_t*)(F.ws + WS_WIN + (size_t)b * 4096 * D); J.ldd = D; J.f8 = 1; }
        else { J.src = F.in(35) + (size_t)b * 2048 * D; J.lds = D; J.K = 2048; J.N = D; J.dst = (bf16_t*)(F.ws + WS_WOUT + (size_t)b * D * 2048); J.ldd = 2048; J.f8 = 1; }
    } else {
        const int q = j - 47, ie = q / 3, w = q % 3;
        if (w < 2) { J.src = F.in(38 + w) + (size_t)ie * D * FEXP; J.lds = FEXP; J.K = D; J.N = FEXP; J.dst = (bf16_t*)(F.ws + WS_WGU + (size_t)ie * 1024 * D); J.ldd = D; J.nofs = w * 4; J.inter = 1; J.f8 = 1; }
        else { J.src = F.in(40) + (size_t)ie * FEXP * D; J.lds = D; J.K = FEXP; J.N = D; J.dst = (bf16_t*)(F.ws + WS_WD + (size_t)ie * D * FEXP); J.ldd = FEXP; J.f8 = 1; }
    }
    return J;
}
__device__ __forceinline__ void transpose_all(const Frame& F) {
    LAS unsigned* T = (LAS unsigned*)F.lds;
    LAS int* tab = (LAS int*)(F.lds + 32768);
    __syncthreads();
#pragma unroll 1
    for (int jj = F.wave; jj < NJOBS; jj += NWAVES) { const TJob J = get_job(F, jj); LAS int* e = tab + jj * 16;
        e[0] = (int)(unsigned)(size_t)J.src; e[1] = (int)(unsigned)((size_t)J.src >> 32); e[2] = (int)(unsigned)(size_t)J.dst; e[3] = (int)(unsigned)((size_t)J.dst >> 32);
        e[4] = (int)(unsigned)(size_t)J.ksc; e[5] = (int)(unsigned)((size_t)J.ksc >> 32); e[6] = J.lds; e[7] = J.K; e[8] = J.N; e[9] = J.ldd; e[10] = J.kofs; e[11] = J.nofs; e[12] = J.inter | (J.f8 << 1);
        const int tn_ = (J.N + 127) / 128; e[13] = ((J.K + 127) / 128) * tn_; e[15] = tn_; }
    __syncthreads();
    for (int jj = F.tid; jj < NJOBS; jj += NTHREADS) { int acc = 0; for (int i = 0; i < jj; ++i) acc += tab[i * 16 + 13]; tab[jj * 16 + 14] = acc; }
    __syncthreads();
#define TJI(j_, f_) __builtin_amdgcn_readfirstlane(tab[(j_) * 16 + (f_)])
#define TJP(T_, j_, f_) ((T_)(size_t)(((unsigned long long)(unsigned)TJI(j_, (f_) + 1) << 32) | (unsigned long long)(unsigned)TJI(j_, f_)))
    int j = 0, t = 0;
#define TR_ENTER() do { t = (F.bid - (TJI(j, 14) % F.G) + F.G) % F.G; } while (0)
#define TR_SKIP() do { while (j < NJOBS && t >= TJI(j, 13)) { ++j; if (j < NJOBS) TR_ENTER(); } } while (0)
#define TR_LOAD() do { const int jl_ = j < NJOBS ? j : NJOBS - 1, tl_ = j < NJOBS ? t : 0; \
        const int tn_ = TJI(jl_, 15), K_ = TJI(jl_, 7), N_ = TJI(jl_, 8), ls_ = TJI(jl_, 6); const float* src_ = TJP(const float*, jl_, 0); \
        const int k0_ = (tl_ / tn_) * 128, n0_ = (tl_ % tn_) * 128; _Pragma("unroll") for (int e = 0; e < 4; ++e) { const int n4 = F.tid & 31, kp = 2 * ((F.tid >> 5) + 16 * (e >> 1)) + (e & 1); \
        const bool ok_ = (k0_ + 2 * kp < K_) && (n0_ + 4 * n4 < N_); const float* q_ = src_ + (ok_ ? ((size_t)(k0_ + 2 * kp) * ls_ + n0_ + 4 * n4) : (size_t)0); \
        const f32x4 x0_ = *(const f32x4*)q_, x1_ = *(const f32x4*)(q_ + (ok_ ? ls_ : 0)); const f32x4 z_ = (f32x4){0.f, 0.f, 0.f, 0.f}; va[e] = ok_ ? x0_ : z_; vb[e] = ok_ ? x1_ : z_; } } while (0)
    TR_ENTER(); TR_SKIP();
    f32x4 va[4], vb[4];
    TR_LOAD();
#pragma unroll 1
    while (j < NJOBS) {
        const int jc = j, tnc = TJI(jc, 15), Kc = TJI(jc, 7), Nc = TJI(jc, 8), k0 = (t / tnc) * 128, n0 = (t % tnc) * 128;
        const float* ksc = TJP(const float*, jc, 4);
        LDS_BAR();
        const int flags = TJI(jc, 12), inter = flags & 1, f8 = flags >> 1;
        const int n4 = F.tid & 31;
        if (!f8) {
#pragma unroll
            for (int e = 0; e < 4; ++e) { const int kp = 2 * ((F.tid >> 5) + 16 * (e >> 1)) + (e & 1);
                float s0 = 1.f, s1 = 1.f; if (ksc && k0 + 2 * kp < Kc) { s0 = ksc[k0 + 2 * kp]; s1 = ksc[k0 + 2 * kp + 1]; }
                LAS unsigned* q = T + (4 * n4) * 64 + (((kp >> 2) ^ (n4 & 15)) << 2) + (kp & 3);
                q[0] = pk2(va[e][0] * s0, vb[e][0] * s1); q[64] = pk2(va[e][1] * s0, vb[e][1] * s1); q[128] = pk2(va[e][2] * s0, vb[e][2] * s1); q[192] = pk2(va[e][3] * s0, vb[e][3] * s1); }
        } else {
#pragma unroll
            for (int h2 = 0; h2 < 2; ++h2) { const int kq = (F.tid >> 5) + 16 * h2;
                LAS unsigned* q = T + (4 * n4) * 32 + (((kq >> 2) ^ (n4 & 7)) << 2) + (kq & 3);
#pragma unroll
                for (int c_ = 0; c_ < 4; ++c_) q[32 * c_] = pk4_f8(va[2 * h2][c_] * 64.f, vb[2 * h2][c_] * 64.f, va[2 * h2 + 1][c_] * 64.f, vb[2 * h2 + 1][c_] * 64.f); }
        }
        t += F.G; TR_SKIP();
        TR_LOAD();
        LDS_BAR();
        bf16_t* dst = TJP(bf16_t*, jc, 2); const int ldd = TJI(jc, 9), kofs = TJI(jc, 10), nofs = TJI(jc, 11);
        if (!f8) {
#pragma unroll
            for (int e = 0; e < 4; ++e) { const int idx = F.tid + e * 512, kg = idx & 15, nn = idx >> 4;
                if (k0 + 8 * kg < Kc && n0 + nn < Nc) { const int n = n0 + nn; const int row = nofs + (inter ? (((n >> 7) << 8) + (((n >> 2) & 1) << 7) + (((n >> 5) & 3) << 5) + (((n >> 3) & 3) << 3) + (n & 3)) : n);
                    *(u32x4*)(dst + (size_t)row * ldd + kofs + k0 + 8 * kg) = *(const LAS u32x4*)(T + nn * 64 + ((kg ^ ((nn >> 2) & 15)) << 2)); } }
        } else {
#pragma unroll
            for (int e = 0; e < 2; ++e) { const int idx = F.tid + e * 512, kg = idx & 7, nn = idx >> 3;
                if (k0 + 16 * kg < Kc && n0 + nn < Nc) { const int n = n0 + nn; const int row = nofs + (inter ? (((n >> 7) << 8) + (((n >> 2) & 1) << 7) + (((n >> 5) & 3) << 5) + (((n >> 3) & 3) << 3) + (n & 3)) : n);
                    *(u32x4*)((unsigned char*)dst + (size_t)row * ldd + kofs + k0 + 16 * kg) = *(const LAS u32x4*)(T + nn * 32 + ((kg ^ ((nn >> 2) & 7)) << 2)); } }
        }
    }
#undef TR_ENTER
#undef TR_SKIP
#undef TR_LOAD
#undef TJI
#undef TJP
    __syncthreads();
}
__device__ __forceinline__ void zero_rows(const Frame& F, bf16_t* dst, int ldd, int row0, int nrows, int col0, int ncols) {
    const int per = ncols / 8; const long tot = (long)nrows * per;
    for (long i = (long)F.bid * NTHREADS + F.tid; i < tot; i += (long)F.G * NTHREADS) { const int r = (int)(i / per), c = (int)(i % per) * 8;
        *(u32x4*)(dst + (size_t)(row0 + r) * ldd + col0 + c) = (u32x4){0u, 0u, 0u, 0u}; }
}
__device__ __forceinline__ void phase_prologue(const Frame& F) {
    {
        LAS float* sl = (LAS float*)F.lds;
        LAS float* red = (LAS float*)(F.lds + 33 * 256 * 4);
        LAS float* cred = red + 8 * 32 * 64;
        const float* c = F.in(1); const float* cc = F.in(3); const float* wm = F.in(4); const float* bm = F.in(5);
        const int wv = F.wave, li = F.lane & 15, kq = F.lane >> 4;
        for (int unit = F.bid; unit < 4 * 96; unit += F.G) {
            const int layer = unit / 96, col0 = (unit % 96) * 64;
            f32x4 acc[2][4]; float cacc[4];
#pragma unroll
            for (int nt = 0; nt < 4; ++nt) { acc[0][nt] = (f32x4){0.f, 0.f, 0.f, 0.f}; acc[1][nt] = acc[0][nt]; cacc[nt] = 0.f; }
#pragma unroll 1
            for (int kc = 0; kc < 4; ++kc) {
                float xs[17];
#pragma unroll
                for (int e = 0; e < 17; ++e) { const int i = F.tid + e * NTHREADS, r = i >> 8, k = (i & 255) + kc * 256; xs[e] = i < 33 * 256 ? (r < 32 ? c[r * D + k] : cc[k]) : 0.f; }
                float w[2][4][4];
#pragma unroll
                for (int gq = 0; gq < 2; ++gq)
#pragma unroll
                    for (int st = 0; st < 4; ++st)
#pragma unroll
                        for (int nt = 0; nt < 4; ++nt) w[gq][st][nt] = wm[((size_t)layer * D + kc * 256 + wv * 32 + 16 * gq + 4 * kq + st) * 6144 + col0 + 16 * nt + li];
                LDS_BAR();
#pragma unroll
                for (int e = 0; e < 17; ++e) { const int i = F.tid + e * NTHREADS; if (i < 33 * 256) sl[i] = xs[e] * sigmoidf_(xs[e]); }
                LDS_BAR();
#pragma unroll
                for (int gq = 0; gq < 2; ++gq) {
                    const int kl = wv * 32 + 16 * gq + 4 * kq;
                    const f32x4 a0 = *(const LAS f32x4*)(sl + li * 256 + kl), a1 = *(const LAS f32x4*)(sl + (16 + li) * 256 + kl), ac = *(const LAS f32x4*)(sl + 32 * 256 + kl);
#pragma unroll
                    for (int st = 0; st < 4; ++st)
#pragma unroll
                        for (int nt = 0; nt < 4; ++nt) {
                            acc[0][nt] = __builtin_amdgcn_mfma_f32_16x16x4f32(a0[st], w[gq][st][nt], acc[0][nt], 0, 0, 0);
                            acc[1][nt] = __builtin_amdgcn_mfma_f32_16x16x4f32(a1[st], w[gq][st][nt], acc[1][nt], 0, 0, 0);
                            cacc[nt] = __builtin_fmaf(ac[st], w[gq][st][nt], cacc[nt]);
                        }
                }
            }
            LDS_BAR();
#pragma unroll
            for (int mt = 0; mt < 2; ++mt)
#pragma unroll
                for (int nt = 0; nt < 4; ++nt)
#pragma unroll
                    for (int r = 0; r < 4; ++r) red[(wv * 32 + mt * 16 + 4 * kq + r) * 64 + 16 * nt + li] = acc[mt][nt][r];
#pragma unroll
            for (int nt = 0; nt < 4; ++nt) cred[(wv * 4 + kq) * 64 + 16 * nt + li] = cacc[nt];
            LDS_BAR();
            for (int i = F.tid; i < 33 * 64; i += NTHREADS) { const int r = i >> 6, x = i & 63; float s = 0.f;
                if (r < 32) {
#pragma unroll
                    for (int y = 0; y < 8; ++y) s += red[(y * 32 + r) * 64 + x];
                } else {
#pragma unroll
                    for (int y = 0; y < 32; ++y) s += cred[y * 64 + x];
                }
                const int col = col0 + x; s += bm[layer * 6144 + col];
                if (r < 32) F.wsp<float>(WS_MODL)[((size_t)layer * NB + r) * 6144 + col] = s; else F.wsp<float>(WS_MODC)[(size_t)layer * 6144 + col] = s; }
        }
    }
    __syncthreads();
    transpose_all(F);
    for (int a = 0; a < 2; ++a) {
        bf16_t* WLp = F.wsp<bf16_t>(WS_WL) + (size_t)a * 512 * K1CAT;
        if (a == 0) zero_rows(F, WLp, K1CAT, 384, 128, 0, K1CAT); else zero_rows(F, WLp, K1CAT, 416, 96, 0, K1CAT);
        zero_rows(F, F.wsp<bf16_t>(WS_G2T) + (size_t)a * D * 256, 256, 0, D, 128, 128);
    }
    zero_rows(F, F.wsp<bf16_t>(WS_V2T), 256, 0, D, 0, 128); zero_rows(F, F.wsp<bf16_t>(WS_V2T), 256, 0, D, 160, 96);
    {
        const float* src = F.in(33); bf16_t* dst = F.wsp<bf16_t>(WS_WSP); const long tot = (long)2 * 16 * 128 * 128 / 4;
        for (long i = (long)F.bid * NTHREADS + F.tid; i < tot; i += (long)F.G * NTHREADS) { const f32x4 v = *(const f32x4*)(src + i * 4); u32x2 w; w.x = pk2(v[0], v[1]); w.y = pk2(v[2], v[3]); *(u32x2*)(dst + i * 4) = w; }
    }
    __syncthreads();
}

__device__ __forceinline__ void phase_norm1(const Frame& F, int g, int layer  , bf16_t* dst, int ldh, bool dry = false, bool f8 = false) {
    bf16_t* X = F.wsp<bf16_t>(WS_X);
    const bf16_t* Y0 = F.ar<bf16_t>(AR_YM0); const bf16_t* Y1 = F.ar<bf16_t>(AR_YM1);
    const bool fin = layer == 4;
    const bool lat = layer >= 3; const int NR = lat ? BG * SEQ : TG;
    const int rpb = (NR + F.G - 1) / F.G, rbeg = F.rowblk() * rpb, rend = (rbeg + rpb) < NR ? (rbeg + rpb) : NR;
#define N1_ROW(i_) (lat ? ((i_) / SEQ) * LT + LC + ((i_) % SEQ) : (i_))
    int key = -1; f32x4 cg[4], cA[4], cB[4];
#pragma unroll
    for (int q = 0; q < 4; ++q) { cg[q] = (f32x4){0.f, 0.f, 0.f, 0.f}; cA[q] = cg[q]; cB[q] = cg[q]; }
    f32x4 nf[4]; u32x2 nxw[4], na[4], nb[4];
#pragma unroll
    for (int q = 0; q < 4; ++q) { nf[q] = (f32x4){0.f, 0.f, 0.f, 0.f}; nxw[q] = (u32x2){0u, 0u}; na[q] = nxw[q]; nb[q] = nxw[q]; }
#define N1_FETCH(rr_) do { const int iq_ = (rr_) < rend ? (rr_) : rbeg; const int rq_ = N1_ROW(iq_); \
        if (layer == 0) { const int bl_ = rq_ / LT, t_ = rq_ % LT, b_ = g * BG + bl_; \
            const float* src_ = t_ < LC ? F.in(2) + ((size_t)b_ * LC + t_) * D : F.in(0) + ((size_t)b_ * SEQ + (t_ - LC)) * D; \
            _Pragma("unroll") for (int q = 0; q < 4; ++q) nf[q] = *(const f32x4*)(src_ + q * 256 + F.lane * 4); } \
        else { _Pragma("unroll") for (int q = 0; q < 4; ++q) { const int c = q * 256 + F.lane * 4; \
            nxw[q] = *(const u32x2*)(X + (size_t)rq_ * D + c); na[q] = *(const u32x2*)(Y0 + (size_t)rq_ * D + c); nb[q] = *(const u32x2*)(Y1 + (size_t)rq_ * D + c); } } } while (0)
    N1_FETCH(rbeg + F.wave);
    for (int ri = rbeg + F.wave; ri < rend; ri += NWAVES) { const int r = N1_ROW(ri);
        const int bl = r / LT, t = r % LT, b = g * BG + bl; const bool isctx = t < LC;
        f32x4 cf[4]; u32x2 cxw[4], ca[4], cb2[4];
#pragma unroll
        for (int q = 0; q < 4; ++q) { cf[q] = nf[q]; cxw[q] = nxw[q]; ca[q] = na[q]; cb2[q] = nb[q]; }
        N1_FETCH(ri + NWAVES);
        if (isctx && layer >= 3) continue;
        if (key != b * 2 + (int)isctx) {
            key = b * 2 + (int)isctx;
#pragma unroll
            for (int q = 0; q < 4; ++q) { const int c = q * 256 + F.lane * 4;
                if (layer > 0) cg[q] = *(const f32x4*)((isctx ? F.modC(layer - 1, 5) : F.modL(layer - 1, b, 5)) + c);
                if (fin) cA[q] = *(const f32x4*)(F.in(41) + c);
                else { const f32x4 gv = *(const f32x4*)(F.in(6) + (size_t)layer * D + c), cv = *(const f32x4*)((isctx ? F.modC(layer, 1) : F.modL(layer, b, 1)) + c);
                    cA[q] = gv * (1.0f + cv); cB[q] = *(const f32x4*)((isctx ? F.modC(layer, 0) : F.modL(layer, b, 0)) + c); } }
        }
        f32x4 x[4], xo[4];
#pragma unroll
        for (int q = 0; q < 4; ++q) xo[q] = (f32x4){0.f, 0.f, 0.f, 0.f};
        if (layer == 0) {
#pragma unroll
            for (int q = 0; q < 4; ++q) x[q] = cf[q];
        } else {
#pragma unroll
            for (int q = 0; q < 4; ++q) {
                { const u32x2 xw = cxw[q]; x[q] = (f32x4){lo16(xw.x), hi16(xw.x), lo16(xw.y), hi16(xw.y)}; } xo[q] = x[q];
                const u32x2 a = ca[q], bb = cb2[q];
                x[q][0] += cg[q][0] * (lo16(a.x) + lo16(bb.x)); x[q][1] += cg[q][1] * (hi16(a.x) + hi16(bb.x));
                x[q][2] += cg[q][2] * (lo16(a.y) + lo16(bb.y)); x[q][3] += cg[q][3] * (hi16(a.y) + hi16(bb.y)); }
        }
        float ss = 0.f;
#pragma unroll
        for (int q = 0; q < 4; ++q) ss += x[q][0] * x[q][0] + x[q][1] * x[q][1] + x[q][2] * x[q][2] + x[q][3] * x[q][3];
        ss = wave_sum_dpp(ss);
        const float rstd = rsqrtf(ss * (1.0f / D) + 1e-6f);
        if (fin) {
            float* o = F.outp() + ((size_t)b * SEQ + (t - LC)) * D;
#pragma unroll
            for (int q = 0; q < 4; ++q) { const int c = q * 256 + F.lane * 4; *(f32x4*)(o + c) = x[q] * rstd * cA[q]; }
        } else {
#pragma unroll
            for (int q = 0; q < 4; ++q) { const int c = q * 256 + F.lane * 4;
                { const f32x4 xs = (dry && layer > 0) ? xo[q] : x[q]; u32x2 xw; xw.x = pk2(xs[0], xs[1]); xw.y = pk2(xs[2], xs[3]); *(u32x2*)(X + (size_t)r * D + c) = xw; }
                const f32x4 h = x[q] * rstd * cA[q] + cB[q];
                if (f8) *(unsigned*)((unsigned char*)dst + (size_t)r * D + c) = pk4_f8(h[0] * 4.f, h[1] * 4.f, h[2] * 4.f, h[3] * 4.f);
                else { u32x2 w; w.x = pk2(h[0], h[1]); w.y = pk2(h[2], h[3]);
                    *(u32x2*)(dst + (size_t)r * ldh + c) = w; } }
        }
    }
}
#undef N1_FETCH
#undef N1_ROW
__device__ __forceinline__ void phase_mix(const Frame& F, int a) {
    bf16_t* H2 = F.ar<bf16_t>(AR_H2); bf16_t* XM = F.ar<bf16_t>(AR_XR);
    const float* mu = F.in(8) + (size_t)a * 6 * D;
    f32x4 cm[2][3][2];
#pragma unroll
    for (int q = 0; q < 2; ++q)
#pragma unroll
        for (int m = 0; m < 3; ++m) { const int mi = m == 0 ? 0 : (m == 1 ? 2 : 3); const int c = q * 512 + F.lane * 8;
            cm[q][m][0] = *(const f32x4*)(mu + mi * D + c); cm[q][m][1] = *(const f32x4*)(mu + mi * D + c + 4); }
    const int rpb = (TG + F.G - 1) / F.G, rbeg = F.rowblk() * rpb, rend = (rbeg + rpb) < TG ? (rbeg + rpb) : TG;
    u32x4 nhs[2], nhn[2];
#define MIX_FETCH(rr_) do { const int rq_ = (rr_) < rend ? (rr_) : rbeg; const int t_ = rq_ % LT; const bool ic_ = t_ < LC; const int p_ = t_ - LC; \
        _Pragma("unroll") for (int q = 0; q < 2; ++q) { const int c = q * 512 + F.lane * 8; int nr; \
            if (ic_) nr = (q == 0) ? (t_ > 0 ? rq_ - 1 : -1) : (t_ < LC - 1 ? rq_ + 1 : -1); \
            else { const int qu = c >> 8; \
                nr = qu == 0 ? ((p_ & 63) > 0 ? rq_ - 1 : -1) : qu == 1 ? ((p_ & 63) < 63 ? rq_ + 1 : -1) : qu == 2 ? (p_ >= 64 ? rq_ - 64 : -1) : (p_ < SEQ - 64 ? rq_ + 64 : -1); } \
            nhs[q] = *(const u32x4*)(H2 + (size_t)rq_ * 2048 + c); \
            const u32x4 hv_ = *(const u32x4*)(H2 + (size_t)(nr >= 0 ? nr : rq_) * 2048 + c); nhn[q] = nr >= 0 ? hv_ : (u32x4){0u, 0u, 0u, 0u}; } } while (0)
    MIX_FETCH(rbeg + F.wave);
    for (int r = rbeg + F.wave; r < rend; r += NWAVES) {
        u32x4 chs[2], chn[2];
#pragma unroll
        for (int q = 0; q < 2; ++q) { chs[q] = nhs[q]; chn[q] = nhn[q]; }
        MIX_FETCH(r + NWAVES);
#pragma unroll
        for (int q = 0; q < 2; ++q) {
            const int c = q * 512 + F.lane * 8;
            const u32x4 hs = chs[q];
            const u32x4 hn = chn[q];
            const float h[8] = {lo16(hs.x), hi16(hs.x), lo16(hs.y), hi16(hs.y), lo16(hs.z), hi16(hs.z), lo16(hs.w), hi16(hs.w)};
            const float n[8] = {lo16(hn.x), hi16(hn.x), lo16(hn.y), hi16(hn.y), lo16(hn.z), hi16(hn.z), lo16(hn.w), hi16(hn.w)};
            float dd[8];
#pragma unroll
            for (int e = 0; e < 8; ++e) dd[e] = n[e] - h[e];
            *(u32x4*)(H2 + (size_t)r * 2048 + 1024 + c) = (u32x4){pk2(dd[0], dd[1]), pk2(dd[2], dd[3]), pk2(dd[4], dd[5]), pk2(dd[6], dd[7])};
#pragma unroll
            for (int m = 0; m < 3; ++m) {
                const f32x4 m0 = cm[q][m][0], m1 = cm[q][m][1];
                float x[8];
#pragma unroll
                for (int e = 0; e < 4; ++e) { x[e] = h[e] + dd[e] * m0[e]; x[4 + e] = h[4 + e] + dd[4 + e] * m1[e]; }
                *(u32x4*)(XM + (size_t)m * TG * D + (size_t)r * D + c) = (u32x4){pk2(x[0], x[1]), pk2(x[2], x[3]), pk2(x[4], x[5]), pk2(x[6], x[7])};
            }
        }
    }
}
#undef MIX_FETCH
__device__ __forceinline__ void phase_vfix(const Frame& F) {
    bf16_t* V = F.ar<bf16_t>(AR_V); const bf16_t* VF = F.wsp<bf16_t>(WS_VF); const bf16_t* GT = F.ar<bf16_t>(AR_VGATE);
    const size_t tot = (size_t)TG * D / 8;
    for (size_t i = (size_t)F.bid * NTHREADS + F.tid; i < tot; i += (size_t)F.G * NTHREADS) {
        const u32x4 v = *(const u32x4*)(V + i * 8), f = *(const u32x4*)(VF + i * 8), g = *(const u32x4*)(GT + i * 8);
        u32x4 o;
        o.x = pk2(lo16(v.x) + (lo16(f.x) - lo16(v.x)) * lo16(g.x), hi16(v.x) + (hi16(f.x) - hi16(v.x)) * hi16(g.x));
        o.y = pk2(lo16(v.y) + (lo16(f.y) - lo16(v.y)) * lo16(g.y), hi16(v.y) + (hi16(f.y) - hi16(v.y)) * hi16(g.y));
        o.z = pk2(lo16(v.z) + (lo16(f.z) - lo16(v.z)) * lo16(g.z), hi16(v.z) + (hi16(f.z) - hi16(v.z)) * hi16(g.z));
        o.w = pk2(lo16(v.w) + (lo16(f.w) - lo16(v.w)) * lo16(g.w), hi16(v.w) + (hi16(f.w) - hi16(v.w)) * hi16(g.w));
        *(u32x4*)(V + i * 8) = o;
    }
}
__device__ __forceinline__ void phase_post(const Frame& F, int a, const bf16_t* V, bool skipctx) {
    const bf16_t* Y0 = F.ar<bf16_t>(AR_Y0); bf16_t* YG = F.ar<bf16_t>(AR_R); const bf16_t* Y1 = F.ar<bf16_t>(AR_Y1); const float* DOT = F.ar<float>(AR_DOT); const bf16_t* Gb = F.ar<bf16_t>(AR_G);
    const float* lgp = F.in(27) + (size_t)a * D + F.lane * 16; const float* lbp = F.in(28) + (size_t)a * D + F.lane * 16;
    float lg[16], lb[16];
#pragma unroll
    for (int e = 0; e < 16; e += 4) { const f32x4 gq = *(const f32x4*)(lgp + e), bq = *(const f32x4*)(lbp + e);
        lg[e] = gq[0]; lg[e + 1] = gq[1]; lg[e + 2] = gq[2]; lg[e + 3] = gq[3]; lb[e] = bq[0]; lb[e + 1] = bq[1]; lb[e + 2] = bq[2]; lb[e + 3] = bq[3]; }
    const int rpb = (TG + F.G - 1) / F.G, rbeg = F.rowblk() * rpb, rend = (rbeg + rpb) < TG ? (rbeg + rpb) : TG;
    u32x4 ny0[2], ny1[2], nv[2], ng[2]; float nd0, nd1;
#define POST_FETCH(rr_) do { const int rq_ = (rr_) < rend ? (rr_) : rbeg; const int c_ = F.lane * 16; \
        _Pragma("unroll") for (int q = 0; q < 2; ++q) { ny0[q] = *(const u32x4*)(Y0 + (size_t)rq_ * D + c_ + q * 8); ny1[q] = *(const u32x4*)(Y1 + (size_t)rq_ * D + c_ + q * 8); \
            nv[q] = *(const u32x4*)(V + (size_t)rq_ * D + c_ + q * 8); ng[q] = *(const u32x4*)(Gb + (size_t)rq_ * D + c_ + q * 8); } \
        nd0 = DOT[(size_t)rq_ * NH + (F.lane >> 2)]; nd1 = DOT[((size_t)TG + rq_) * NH + (F.lane >> 2)]; } while (0)
    POST_FETCH(rbeg + F.wave);
    for (int r = rbeg + F.wave; r < rend; r += NWAVES) {
        const int c = F.lane * 16;
        float y[16], vv[16];
        u32x4 cy0[2], cy1[2], cv[2], cgq[2];
#pragma unroll
        for (int q = 0; q < 2; ++q) { cy0[q] = ny0[q]; cy1[q] = ny1[q]; cv[q] = nv[q]; cgq[q] = ng[q]; }
        const float dsum = nd0 + nd1;
        POST_FETCH(r + NWAVES);
        if (skipctx && (r % LT) < LC) continue;
#pragma unroll
        for (int q = 0; q < 2; ++q) {
            const u32x4 a0 = cy0[q], a1 = cy1[q], v4 = cv[q];
            y[q * 8 + 0] = lo16(a0.x) + lo16(a1.x); y[q * 8 + 1] = hi16(a0.x) + hi16(a1.x); y[q * 8 + 2] = lo16(a0.y) + lo16(a1.y); y[q * 8 + 3] = hi16(a0.y) + hi16(a1.y);
            y[q * 8 + 4] = lo16(a0.z) + lo16(a1.z); y[q * 8 + 5] = hi16(a0.z) + hi16(a1.z); y[q * 8 + 6] = lo16(a0.w) + lo16(a1.w); y[q * 8 + 7] = hi16(a0.w) + hi16(a1.w);
            vv[q * 8 + 0] = lo16(v4.x); vv[q * 8 + 1] = hi16(v4.x); vv[q * 8 + 2] = lo16(v4.y); vv[q * 8 + 3] = hi16(v4.y);
            vv[q * 8 + 4] = lo16(v4.z); vv[q * 8 + 5] = hi16(v4.z); vv[q * 8 + 6] = lo16(v4.w); vv[q * 8 + 7] = hi16(v4.w);
        }
        float s = 0.f;
#pragma unroll
        for (int e = 0; e < 16; ++e) s += y[e];
        s = red4(s); const float mean = s * (1.0f / 64.0f);
        float qv = 0.f;
#pragma unroll
        for (int e = 0; e < 16; ++e) { const float dd = y[e] - mean; qv += dd * dd; }
        qv = red4(qv); const float rstd = rsqrtf(qv * (1.0f / 64.0f) + 64e-5f);
        float of[16];
        const u32x4 g0 = cgq[0], g1 = cgq[1];
        const unsigned gw[8] = {g0.x, g0.y, g0.z, g0.w, g1.x, g1.y, g1.z, g1.w};
#pragma unroll
        for (int e = 0; e < 16; e += 2) {
            of[e] = ((y[e] - mean) * rstd * lg[e] + lb[e] + vv[e] * dsum) * lo16(gw[e >> 1]) * 4.f;
            of[e + 1] = ((y[e + 1] - mean) * rstd * lg[e + 1] + lb[e + 1] + vv[e + 1] * dsum) * hi16(gw[e >> 1]) * 4.f;
        }
        *(u32x4*)((unsigned char*)YG + (size_t)r * D + c) = (u32x4){pk4_f8(of[0], of[1], of[2], of[3]), pk4_f8(of[4], of[5], of[6], of[7]), pk4_f8(of[8], of[9], of[10], of[11]), pk4_f8(of[12], of[13], of[14], of[15])};
    }
}
#undef POST_FETCH
__device__ __forceinline__ void phase_norm2(const Frame& F, int g, int layer, bool dry = false) {
    bf16_t* X = F.wsp<bf16_t>(WS_X); bf16_t* HM = F.ar<bf16_t>(AR_HM); const bf16_t* Ob = F.ar<bf16_t>(AR_O);
    int* lists = dry ? F.ar<int>(AR_YM0) : F.ar<int>(AR_LIST); float* lwt = dry ? F.ar<float>(AR_YM0) + (size_t)32 * TG : F.ar<float>(AR_LW);
    unsigned* cnt = (unsigned*)(F.ws + WS_CTL + CTL_CNT_OFF) + (((size_t)g * 4 + layer) * 32 + (dry ? NG * 4 * 32 : 0)) * 16;
    LAS float* hbuf = (LAS float*)F.lds;
    LAS float* part = (LAS float*)(F.lds + 16 * 1028 * 4);
    const int wv = F.wave, li = F.lane & 15, kq = F.lane >> 4;
    float wreg[32];
#pragma unroll
    for (int gq = 0; gq < 8; ++gq)
#pragma unroll
        for (int st = 0; st < 4; ++st) wreg[gq * 4 + st] = F.in(36)[(size_t)(128 * wv + 16 * gq + 4 * kq + st) * NEXP + li];
    const float* rbias = F.in(37);
    float rb4[4];
#pragma unroll
    for (int e = 0; e < 4; ++e) rb4[e] = rbias[(F.lane >> 4) * 4 + e];
    const bool ctx_out = layer < 2;
    LAS int* lcnt = (LAS int*)(F.lds + LDS_MISC + 512);
    LAS int* lbase = (LAS int*)(F.lds + LDS_MISC + 640);
    LAS int* rec = (LAS int*)(F.lds + 81920);
    const bool lat = !ctx_out; const int NR = lat ? BG * SEQ : TG;
    const int rpb = (NR + F.G - 1) / F.G, rbeg = F.rowblk() * rpb, rend = (rbeg + rpb) < NR ? (rbeg + rpb) : NR;
#define N2_ROW(i_) (lat ? ((i_) / SEQ) * LT + LC + ((i_) % SEQ) : (i_))
    int key = -1; f32x4 cg[4], cA[4], cB[4];
#pragma unroll
    for (int q = 0; q < 4; ++q) { cg[q] = (f32x4){0.f, 0.f, 0.f, 0.f}; cA[q] = cg[q]; cB[q] = cg[q]; }
    __syncthreads();
    for (int b0 = 0; b0 < rpb; b0 += 512) {
        if (F.tid < 32) lcnt[F.tid] = 0;
        __syncthreads();
        const int nrb = (rpb - b0) < 512 ? (rpb - b0) : 512, nsteps = (nrb + 15) >> 4;
        u32x2 nxw[4], nob[4];
#define N2_FETCH(rr_) do { const int ic_ = (rr_) < rend ? (rr_) : rbeg; const int rc_ = N2_ROW(ic_); \
        _Pragma("unroll") for (int q = 0; q < 4; ++q) { const int c = q * 256 + F.lane * 4; nxw[q] = *(const u32x2*)(X + (size_t)rc_ * D + c); nob[q] = *(const u32x2*)(Ob + (size_t)rc_ * D + c); } } while (0)
        N2_FETCH(rbeg + b0 + 2 * wv);
#pragma unroll 1
        for (int sp = 0; sp < nsteps; ++sp) {
#pragma unroll 1
            for (int hr = 0; hr < 2; ++hr) {
                const int off = b0 + sp * 16 + 2 * wv + hr, ri = rbeg + off, r = N2_ROW(ri);
                const int bl = r / LT, t = r % LT, b = g * BG + bl; const bool isctx = t < LC;
                u32x2 cxw[4], cob[4];
#pragma unroll
                for (int q = 0; q < 4; ++q) { cxw[q] = nxw[q]; cob[q] = nob[q]; }
                N2_FETCH(hr == 0 ? ri + 1 : ri + 15);
                if (off < rpb && ri < rend && !(isctx && !ctx_out)) {
                    if (key != b * 2 + (int)isctx) {
                        key = b * 2 + (int)isctx;
#pragma unroll
                        for (int q = 0; q < 4; ++q) { const int c = q * 256 + F.lane * 4;
                            cg[q] = *(const f32x4*)((isctx ? F.modC(layer, 2) : F.modL(layer, b, 2)) + c);
                            const f32x4 gv = *(const f32x4*)(F.in(7) + (size_t)layer * D + c), cv = *(const f32x4*)((isctx ? F.modC(layer, 4) : F.modL(layer, b, 4)) + c);
                            cA[q] = gv * (1.0f + cv); cB[q] = *(const f32x4*)((isctx ? F.modC(layer, 3) : F.modL(layer, b, 3)) + c); }
                    }
                    f32x4 x[4]; float ss = 0.f;
#pragma unroll
                    for (int q = 0; q < 4; ++q) { const int c = q * 256 + F.lane * 4;
                        { const u32x2 xw = cxw[q]; x[q] = (f32x4){lo16(xw.x), hi16(xw.x), lo16(xw.y), hi16(xw.y)}; }
                        const u32x2 ob = cob[q]; const f32x4 gv = cg[q];
                        const f32x4 xo = x[q];
                        x[q][0] += gv[0] * lo16(ob.x); x[q][1] += gv[1] * hi16(ob.x); x[q][2] += gv[2] * lo16(ob.y); x[q][3] += gv[3] * hi16(ob.y);
                        { const f32x4 xs = dry ? xo : x[q]; u32x2 xw; xw.x = pk2(xs[0], xs[1]); xw.y = pk2(xs[2], xs[3]); *(u32x2*)(X + (size_t)r * D + c) = xw; }
                        ss += x[q][0] * x[q][0] + x[q][1] * x[q][1] + x[q][2] * x[q][2] + x[q][3] * x[q][3]; }
                    ss = wave_sum_dpp(ss);
                    const float rstd = rsqrtf(ss * (1.0f / D) + 1e-6f);
#pragma unroll
                    for (int q = 0; q < 4; ++q) { const int c = q * 256 + F.lane * 4;
                        const f32x4 h = x[q] * rstd * cA[q] + cB[q];
                        *(unsigned*)((unsigned char*)HM + (size_t)r * D + c) = pk4_f8(h[0] * 4.f, h[1] * 4.f, h[2] * 4.f, h[3] * 4.f);
                        *(LAS f32x4*)(hbuf + (2 * wv + hr) * 1028 + c) = h; }
                }
            }
            LDS_BAR();
            {
                f32x4 pl = (f32x4){0.f, 0.f, 0.f, 0.f};
#pragma unroll
                for (int gq = 0; gq < 8; ++gq) { const f32x4 av = *(const LAS f32x4*)(hbuf + li * 1028 + 128 * wv + 16 * gq + 4 * kq);
#pragma unroll
                    for (int st = 0; st < 4; ++st) pl = __builtin_amdgcn_mfma_f32_16x16x4f32(av[st], wreg[gq * 4 + st], pl, 0, 0, 0); }
                LAS float* pp = part + wv * 256 + (4 * kq) * 16 + li; pp[0] = pl[0]; pp[16] = pl[1]; pp[32] = pl[2]; pp[48] = pl[3];
            }
            LDS_BAR();
#pragma unroll 1
            for (int hr = 0; hr < 2; ++hr) {
                const int slot = sp * 16 + 2 * wv + hr, off = b0 + slot, ri = rbeg + off, r = N2_ROW(ri);
                const int t = r % LT; const bool isctx = t < LC;
                if (!(off < rpb && ri < rend && !(isctx && !ctx_out))) { if (F.lane == 0) rec[slot * 4] = -1; continue; }
                f32x4 xs4 = (f32x4){0.f, 0.f, 0.f, 0.f};
#pragma unroll
                for (int w8 = 0; w8 < 8; ++w8) xs4 = xs4 + *(const LAS f32x4*)(part + w8 * 256 + (2 * wv + hr) * 16 + 4 * (F.lane >> 4));
                const float xg[4] = {xs4[0], xs4[1], xs4[2], xs4[3]};
                float sc_[4], bs[4];
#pragma unroll
                for (int e = 0; e < 4; ++e) { sc_[e] = sigmoidf_(xg[e]); bs[e] = sc_[e] + rb4[e]; }
                const float hi01 = fmaxf(bs[0], bs[1]), lo01 = fminf(bs[0], bs[1]), hi23 = fmaxf(bs[2], bs[3]), lo23 = fminf(bs[2], bs[3]);
                const float gsc = fmaxf(hi01, hi23) + fmaxf(fminf(hi01, hi23), fmaxf(lo01, lo23));
                const float g0s = __int_as_float(__builtin_amdgcn_readlane(__float_as_int(gsc), 0)), g1s = __int_as_float(__builtin_amdgcn_readlane(__float_as_int(gsc), 16));
                const float g2s = __int_as_float(__builtin_amdgcn_readlane(__float_as_int(gsc), 32)), g3s = __int_as_float(__builtin_amdgcn_readlane(__float_as_int(gsc), 48));
                const bool c10 = g1s > g0s, c32 = g3s > g2s; const float v01 = c10 ? g1s : g0s, v23 = c32 ? g3s : g2s; const bool chi = v23 > v01;
                const int best = __builtin_amdgcn_readfirstlane(chi ? (c32 ? 3 : 2) : (c10 ? 1 : 0));
                float cb[4], cs[4];
#pragma unroll
                for (int e = 0; e < 4; ++e) { cb[e] = __int_as_float(__builtin_amdgcn_readlane(__float_as_int(bs[e]), best * 16)); cs[e] = __int_as_float(__builtin_amdgcn_readlane(__float_as_int(sc_[e]), best * 16)); }
                const bool d10 = cb[1] > cb[0], d32 = cb[3] > cb[2]; const float w01 = d10 ? cb[1] : cb[0], w23 = d32 ? cb[3] : cb[2]; const bool dhi = w23 > w01;
                const int j1 = dhi ? (d32 ? 3 : 2) : (d10 ? 1 : 0);
                const float e0 = j1 == 0 ? -1e30f : cb[0], e1 = j1 == 1 ? -1e30f : cb[1], e2 = j1 == 2 ? -1e30f : cb[2], e3 = j1 == 3 ? -1e30f : cb[3];
                const bool f10 = e1 > e0, f32_ = e3 > e2; const float u01 = f10 ? e1 : e0, u23 = f32_ ? e3 : e2; const bool fhi = u23 > u01;
                const int j2 = fhi ? (f32_ ? 3 : 2) : (f10 ? 1 : 0);
                const float s1 = (j1 & 2) ? ((j1 & 1) ? cs[3] : cs[2]) : ((j1 & 1) ? cs[1] : cs[0]);
                const float s2 = (j2 & 2) ? ((j2 & 1) ? cs[3] : cs[2]) : ((j2 & 1) ? cs[1] : cs[0]);
                const float inv = __builtin_amdgcn_rcpf(s1 + s2);
                if (F.lane == 0) {
                    const int l1 = (best * 4 + j1) * 2 + 0, l2 = (best * 4 + j2) * 2 + 1;
                    const int p1 = __hip_atomic_fetch_add(lcnt + l1, 1, __ATOMIC_RELAXED, __HIP_MEMORY_SCOPE_WORKGROUP);
                    const int p2 = __hip_atomic_fetch_add(lcnt + l2, 1, __ATOMIC_RELAXED, __HIP_MEMORY_SCOPE_WORKGROUP);
                    rec[slot * 4 + 0] = l1 | (p1 << 8); rec[slot * 4 + 1] = l2 | (p2 << 8);
                    rec[slot * 4 + 2] = __float_as_int(s1 * inv); rec[slot * 4 + 3] = __float_as_int(s2 * inv);
                }
            }
        }
#undef N2_FETCH
        __syncthreads();
        if (F.tid < 32) { const int c = lcnt[F.tid]; lbase[F.tid] = c ? (int)atomicAdd(&cnt[F.tid * 16], (unsigned)c) : 0; }
        __syncthreads();
        for (int slot = F.tid; slot < nsteps * 16; slot += NTHREADS) {
            const int a0 = rec[slot * 4 + 0]; if (a0 < 0) continue;
            const int a1 = rec[slot * 4 + 1];
            const int r = N2_ROW(rbeg + b0 + slot);
            const int l1 = a0 & 255, l2 = a1 & 255; const int q1 = lbase[l1] + (a0 >> 8), q2 = lbase[l2] + (a1 >> 8);
            lists[(size_t)l1 * TG + q1] = r; lwt[(size_t)l1 * TG + q1] = __int_as_float(rec[slot * 4 + 2]);
            lists[(size_t)l2 * TG + q2] = r; lwt[(size_t)l2 * TG + q2] = __int_as_float(rec[slot * 4 + 3]);
        }
        __syncthreads();
    }
}
#undef N2_ROW
__device__ __forceinline__ int moe_tables(const Frame& F, int g, int layer) {
    LAS int* cn = (LAS int*)(F.lds + LDS_MISC + 64); LAS int* tb = (LAS int*)(F.lds + LDS_MISC + 192);
    const unsigned* cnt = (const unsigned*)(F.ws + WS_CTL + CTL_CNT_OFF) + ((size_t)g * 4 + layer) * 32 * 16;
    __syncthreads();
    if (F.tid < 32) cn[F.tid] = (int)__hip_atomic_load(cnt + F.tid * 16, __ATOMIC_RELAXED, __HIP_MEMORY_SCOPE_AGENT);
    __syncthreads();
    if (F.tid == 0) { int acc = 0; for (int l = 0; l < 32; ++l) { tb[l] = acc; acc += (cn[l] + 255) >> 8; } tb[32] = acc; }
    __syncthreads();
    return tb[32];
}

constexpr int SC_OPB = 6 * 4096;
constexpr int SC_HALF = 2 * SC_OPB + 4096 + 4096;
static_assert(2 * SC_HALF <= LDS_STAGE, "scan lds");
__device__ __forceinline__ int scan_tok(int d, int s) { return d == 0 ? s : (s < LC ? (LC - 1 - s) : (LT + LC - 1 - s)); }

constexpr int S4_RS = 144;
constexpr int S4_KKP = 0, S4_RPP = 16 * S4_RS, S4_KDP = 32 * S4_RS, S4_KAP = 48 * S4_RS, S4_VP = 64 * S4_RS, S4_P15 = 80 * S4_RS, S4_PBSZ = S4_P15 + 256,
              S4_A1 = 2 * S4_PBSZ, S4_B1 = S4_A1 + 512, S4_B2 = S4_B1 + 512, S4_MI = S4_B2 + 512, S4_LI = S4_MI + 512, S4_LX = S4_LI + 4096, S4_AT = S4_LX + 4096, S4_YB = S4_AT + 4096, S4_HALF = S4_YB + 4096;
typedef short s16x4 __attribute__((ext_vector_type(4)));
__device__ __forceinline__ u32x2 lds_tr16(const LAS unsigned char* p) { return __builtin_bit_cast(u32x2, __builtin_amdgcn_ds_read_tr16_b64_v4i16((LAS s16x4*)p)); }
static_assert(2 * S4_HALF <= LDS_STAGE, "scan4 lds");
#define MF16(a, b, c) __builtin_amdgcn_mfma_f32_16x16x32_bf16((a), (b), (c), 0, 0, 0)
__device__ __forceinline__ bf16x8 mkfrag(unsigned a, unsigned b, unsigned c, unsigned d) { return __builtin_bit_cast(bf16x8, (u32x4){a, b, c, d}); }
__device__ __forceinline__ f32x4 scan_inverse_mfma(f32x4 N, f32x4 NT, int g, int j) {
    const f32x4 z = (f32x4){0.f, 0.f, 0.f, 0.f};
#define P2(v) mkfrag(pk2((v)[0], (v)[1]), pk2((v)[2], (v)[3]), 0u, 0u)
    const bf16x8 Nc = P2(N), Ntc = P2(NT);
    const f32x4 Z2 = MF16(Ntc, Nc, z), Z2t = MF16(Nc, Ntc, z);
    f32x4 Q = (f32x4){(4 * g == j ? 1.f : 0.f) - NT[0], (4 * g + 1 == j ? 1.f : 0.f) - NT[1], (4 * g + 2 == j ? 1.f : 0.f) - NT[2], (4 * g + 3 == j ? 1.f : 0.f) - NT[3]};
    const bf16x8 Z2c = P2(Z2), Z2tc = P2(Z2t);
    const f32x4 Z4 = MF16(Z2tc, Z2c, z), Z4t = MF16(Z2c, Z2tc, z);
    Q = MF16(Z2c, P2(Q), Q);
    const bf16x8 Z4c = P2(Z4), Z4tc = P2(Z4t);
    const f32x4 Z8 = MF16(Z4tc, Z4c, z);
    Q = MF16(Z4c, P2(Q), Q);
    Q = MF16(P2(Z8), P2(Q), Q);
#undef P2
    return Q;
}
__device__ __forceinline__ void phase_scan4(const Frame& F, int a, const bf16_t* V) {
    const bf16_t* R = F.ar<bf16_t>(AR_R); const bf16_t* Kb = F.ar<bf16_t>(AR_K); const bf16_t* L1 = F.ar<bf16_t>(AR_L1);
    const int half = F.wave >> 2, q = F.wave & 3, lane = F.lane, li = q * 64 + lane;
    const int role = (q - half) & 3;
    LAS unsigned char* hb = F.lds + half * S4_HALF;
    const int arr = q >> 1, ntl = (q & 1) * 2;
    const int g = lane >> 4, j = lane & 15;
    const int tB = li >> 4, k4 = (li & 15) * 4;
    const int trrow = (4 * g + ((lane & 15) >> 2)) * S4_RS;
    const int poff = tB * S4_RS + ((k4 >> 5) * 32 + ((k4 >> 2) & 3) * 8 + ((k4 >> 4) & 1) * 4) * 2;
    for (int pr = F.bid; pr < BG * 16; pr += F.G) {
        const int bl = pr >> 4, d = (pr >> 3) & 1, hp = pr & 7, h = hp * 2 + half;
        bf16_t* Yd = F.ar<bf16_t>(d ? AR_Y1 : AR_Y0); float* DOT = F.ar<float>(AR_DOT) + (size_t)d * TG * NH;
        const size_t rowb = (size_t)bl * LT;
        const bf16_t* W2 = (arr == 0 ? F.wsp<bf16_t>(WS_W2T) : F.wsp<bf16_t>(WS_A2T)) + ((size_t)a * 2 + d) * D * 64;
        const float* b0p = (arr == 0 ? F.in(13) : F.in(16)) + ((size_t)a * 2 + d) * D + h * 64;
        const int acol = arr * 128 + d * 64 + 8 * (lane >> 4);
        f32x4 Cb[4];
#pragma unroll
        for (int b = 0; b < 4; ++b) Cb[b] = (f32x4){0.f, 0.f, 0.f, 0.f};
        bf16x8 Af[2]; u32x2 kraw, rraw, vraw;
        bf16x8 wf0[2], wf1[2]; float bias2[2];
#pragma unroll
        for (int nt = 0; nt < 2; ++nt) { const int n = (ntl + nt) * 16 + (lane & 15); bias2[nt] = b0p[n];
            wf0[nt] = *(const bf16x8*)(W2 + (size_t)(h * 64 + n) * 64 + 8 * (lane >> 4)); wf1[nt] = *(const bf16x8*)(W2 + (size_t)(h * 64 + n) * 64 + 32 + 8 * (lane >> 4)); }
        const f32x4 kkc = *(const f32x4*)(F.in(24) + (size_t)a * D + h * 64 + k4), kac = *(const f32x4*)(F.in(25) + (size_t)a * D + h * 64 + k4), rkc = *(const f32x4*)(F.in(26) + (size_t)a * D + h * 64 + k4);
#define SC_BAR() asm volatile("s_waitcnt lgkmcnt(0)\n\ts_barrier" ::: "memory")
#define SC_LOAD(ch) do { const size_t rowA = rowb + scan_tok(d, (ch) * 16 + (lane & 15)); \
        Af[0] = *(const bf16x8*)(L1 + rowA * 512 + acol); Af[1] = *(const bf16x8*)(L1 + rowA * 512 + acol + 32); \
        const size_t rowBq = (rowb + scan_tok(d, (ch) * 16 + tB)) * D + h * 64 + k4; \
        kraw = *(const u32x2*)(Kb + rowBq); rraw = *(const u32x2*)(R + rowBq); vraw = *(const u32x2*)(V + rowBq); } while (0)
#define SC_PASSA() do { \
        _Pragma("unroll") for (int nt = 0; nt < 2; ++nt) { f32x4 ac = (f32x4){0.f, 0.f, 0.f, 0.f}; \
            const int n = (ntl + nt) * 16 + (lane & 15); const float bias_ = bias2[nt]; \
            ac = MF16(Af[0], wf0[nt], ac); ac = MF16(Af[1], wf1[nt], ac); \
            f32x4 sg; _Pragma("unroll") for (int rg = 0; rg < 4; ++rg) sg[rg] = sigmoidf_(ac[rg] + bias_); \
            if (arr == 0) { \
                const float l0 = -0.60653066f * sg[0], l1 = -0.60653066f * sg[1], l2 = -0.60653066f * sg[2], l3 = -0.60653066f * sg[3]; \
                const float p0 = l0, p1 = p0 + l1, p2 = p1 + l2, p3 = p2 + l3;                         \
                const auto s16 = __builtin_amdgcn_permlane16_swap(__float_as_uint(p3), __float_as_uint(p3), false, false);     \
                const float sv = __uint_as_float(s16[0]), pq = sv + __uint_as_float(s16[1]); \
                const auto s32 = __builtin_amdgcn_permlane32_swap(__float_as_uint(pq), __float_as_uint(pq), false, false);     \
                const float E = ((g & 1) ? sv : 0.f) + ((g & 2) ? __uint_as_float(s32[0]) : 0.f);      \
                LAS float* li_ = (LAS float*)(hb + S4_LI) + (4 * g) * 64 + n; LAS float* lx_ = (LAS float*)(hb + S4_LX) + (4 * g) * 64 + n; \
                li_[0] = E + p0; li_[64] = E + p1; li_[128] = E + p2; li_[192] = E + p3; lx_[0] = E; lx_[64] = E + p0; lx_[128] = E + p1; lx_[192] = E + p2; \
            } else { _Pragma("unroll") for (int rg = 0; rg < 4; ++rg) ((LAS float*)(hb + S4_AT))[(4 * g + rg) * 64 + n] = sg[rg]; } } } while (0)
#define SC_PASSB(ch, pbo_) do { LAS unsigned char* hq_ = hb + (pbo_); \
        const float kf[4] = {lo16(kraw.x), hi16(kraw.x), lo16(kraw.y), hi16(kraw.y)}; const float rf[4] = {lo16(rraw.x), hi16(rraw.x), lo16(rraw.y), hi16(rraw.y)}; \
        const f32x4 av = *(const LAS f32x4*)((LAS float*)(hb + S4_AT) + tB * 64 + k4), Li = *(const LAS f32x4*)((LAS float*)(hb + S4_LI) + tB * 64 + k4), Lx = *(const LAS f32x4*)((LAS float*)(hb + S4_LX) + tB * 64 + k4); \
        float kq[4], ssq = 0.f; _Pragma("unroll") for (int e = 0; e < 4; ++e) { kq[e] = kf[e] * kkc[e]; ssq += kq[e] * kq[e]; } \
        ssq = red16(ssq); const float inv = __builtin_amdgcn_rsqf(fmaxf(ssq, 1e-24f)); \
        float o_kk[4], o_ka[4], o_kd[4], o_r[4]; f32x4 o_p; float dp = 0.f; \
        _Pragma("unroll") for (int e = 0; e < 4; ++e) { const float Pt = __expf(Li[e]), Px = __expf(Lx[e]), iP = __builtin_amdgcn_rcpf(Pt); \
            const float kkv = kq[e] * inv; const float kd = kf[e] * (1.0f + (av[e] - 1.0f) * kac[e]); const float ka = kkv * av[e]; \
            o_kk[e] = kkv * Px; o_ka[e] = ka * iP; o_kd[e] = kd * iP; o_r[e] = rf[e] * Pt; o_p[e] = Pt; \
            dp += rf[e] * kd * rkc[e]; } \
        dp = red16(dp); \
        if ((li & 15) == 0) DOT[(rowb + scan_tok(d, (ch) * 16 + tB)) * NH + h] = dp; \
        const u32x2 w_kk = (u32x2){pk2(o_kk[0], o_kk[1]), pk2(o_kk[2], o_kk[3])}, w_r = (u32x2){pk2(o_r[0], o_r[1]), pk2(o_r[2], o_r[3])}; \
        const u32x2 w_kd = (u32x2){pk2(o_kd[0], o_kd[1]), pk2(o_kd[2], o_kd[3])}, w_ka = (u32x2){pk2(o_ka[0], o_ka[1]), pk2(o_ka[2], o_ka[3])}; \
        *(LAS u32x2*)(hq_ + S4_KKP + poff) = w_kk; *(LAS u32x2*)(hq_ + S4_RPP + poff) = w_r; *(LAS u32x2*)(hq_ + S4_KDP + poff) = w_kd; *(LAS u32x2*)(hq_ + S4_KAP + poff) = w_ka; \
        *(LAS u32x2*)(hq_ + S4_VP + tB * S4_RS + k4 * 2) = vraw;        \
        if (tB == 15) *(LAS f32x4*)((LAS float*)(hq_ + S4_P15) + k4) = o_p; } while (0)
#define SC_PROD(pbo_) do { LAS unsigned char* hq_ = hb + (pbo_); \
        const int lo_ = (role < 2 ? S4_KKP : S4_RPP) + j * S4_RS + g * 16, ro_ = ((role == 0 || role == 3) ? S4_KAP : S4_KDP) + j * S4_RS + g * 16; \
        const bf16x8 fl0_ = *(const LAS bf16x8*)(hq_ + lo_), fr0_ = *(const LAS bf16x8*)(hq_ + ro_), fl1_ = *(const LAS bf16x8*)(hq_ + lo_ + 64), fr1_ = *(const LAS bf16x8*)(hq_ + ro_ + 64); \
        f32x4 pa = (f32x4){0.f, 0.f, 0.f, 0.f}; \
        pa = MF16(fl0_, fr0_, pa); pa = MF16(fl1_, fr1_, pa); \
        _Pragma("unroll") for (int r_ = 0; r_ < 4; ++r_) { const int t_ = 4 * g + r_; const bool keep = (role < 2) ? (j < t_) : (j <= t_); pa[r_] = keep ? pa[r_] : 0.f; } \
        if (role == 0) { f32x4 pt = (f32x4){0.f, 0.f, 0.f, 0.f}; pt = MF16(fr0_, fl0_, pt); pt = MF16(fr1_, fl1_, pt);        \
            _Pragma("unroll") for (int r_ = 0; r_ < 4; ++r_) pt[r_] = (j > 4 * g + r_) ? pt[r_] : 0.f; \
            const f32x4 mt_ = scan_inverse_mfma(pa, pt, g, j); \
            *(LAS u32x2*)(hb + S4_MI + j * 32 + g * 8) = (u32x2){pk2(mt_[0], mt_[1]), pk2(mt_[2], mt_[3])}; } \
        else { LAS unsigned char* dm = hb + (role == 1 ? S4_A1 : (role == 2 ? S4_B1 : S4_B2)) + ((4 * g) * 16 + j) * 2; const unsigned w0_ = pk2(pa[0], pa[1]), w1_ = pk2(pa[2], pa[3]); \
            *(LAS unsigned short*)(dm) = (unsigned short)w0_; *(LAS unsigned short*)(dm + 32) = (unsigned short)(w0_ >> 16); *(LAS unsigned short*)(dm + 64) = (unsigned short)w1_; *(LAS unsigned short*)(dm + 96) = (unsigned short)(w1_ >> 16); } } while (0)
        constexpr int NCH = LT / 16;
        __syncthreads();
        SC_LOAD(0);
        SC_PASSA();
        SC_BAR();
        SC_PASSB(0, 0);
        SC_BAR();
        SC_LOAD(1);
        SC_PASSA();
        SC_PROD(0);
        SC_BAR();
        SC_PASSB(1, S4_PBSZ);
        SC_BAR();
#pragma unroll 1
        for (int it = 0; it < 2 * NCH + 1; ++it) {
            const int s_ = it - half;
            if (s_ >= 0 && s_ < 2 * NCH) {
            const int ch = s_ >> 1;
            const int pbo = (ch & 1) * S4_PBSZ;
            LAS unsigned char* hc = hb + pbo;
            if ((s_ & 1) == 0) {
            if (ch + 2 < NCH) SC_LOAD(ch + 2);
            const bf16x8 Bs0 = mkfrag(pk2(Cb[0][0], Cb[0][1]), pk2(Cb[0][2], Cb[0][3]), pk2(Cb[1][0], Cb[1][1]), pk2(Cb[1][2], Cb[1][3]));
            const bf16x8 Bs1 = mkfrag(pk2(Cb[2][0], Cb[2][1]), pk2(Cb[2][2], Cb[2][3]), pk2(Cb[3][0], Cb[3][1]), pk2(Cb[3][2], Cb[3][3]));
            f32x4 X = (f32x4){0.f, 0.f, 0.f, 0.f}, H = (f32x4){0.f, 0.f, 0.f, 0.f};
            X = MF16(*(const LAS bf16x8*)(hc + S4_KKP + j * S4_RS + g * 16), Bs0, X); H = MF16(*(const LAS bf16x8*)(hc + S4_RPP + j * S4_RS + g * 16), Bs0, H);
            X = MF16(*(const LAS bf16x8*)(hc + S4_KKP + j * S4_RS + g * 16 + 64), Bs1, X); H = MF16(*(const LAS bf16x8*)(hc + S4_RPP + j * S4_RS + g * 16 + 64), Bs1, H);
            const u32x2 vw = lds_tr16(hc + S4_VP + trrow + 32 * q + 8 * (lane & 3));
            const bf16x8 Bv = mkfrag(vw.x, vw.y, 0u, 0u);
            {
                const u32x2 a1w = *(const LAS u32x2*)(hb + S4_A1 + (j * 16 + 4 * g) * 2), b1w = *(const LAS u32x2*)(hb + S4_B1 + (j * 16 + 4 * g) * 2);
                X = MF16(mkfrag(a1w.x, a1w.y, 0u, 0u), Bv, X); H = MF16(mkfrag(b1w.x, b1w.y, 0u, 0u), Bv, H);
            }
            const u32x2 mw = *(const LAS u32x2*)(hb + S4_MI + j * 32 + g * 8);
            f32x4 SA = (f32x4){0.f, 0.f, 0.f, 0.f};
            SA = MF16(mkfrag(mw.x, mw.y, 0u, 0u), mkfrag(pk2(X[0], X[1]), pk2(X[2], X[3]), 0u, 0u), SA);
            const bf16x8 Bn = mkfrag(pk2(-SA[0], -SA[1]), pk2(-SA[2], -SA[3]), 0u, 0u);
            {
                const u32x2 b2w = *(const LAS u32x2*)(hb + S4_B2 + (j * 16 + 4 * g) * 2);
                H = MF16(mkfrag(b2w.x, b2w.y, 0u, 0u), Bn, H);
                LAS float* yb = (LAS float*)(hb + S4_YB) + (4 * g) * 64 + 16 * q + j; yb[0] = H[0]; yb[64] = H[1]; yb[128] = H[2]; yb[192] = H[3];
            }
#pragma unroll
            for (int b = 0; b < 4; ++b) {
                const u32x2 kdw = lds_tr16(hc + S4_KDP + trrow + 16 * (lane & 3) + 64 * (b >> 1) + 8 * (b & 1));
                const u32x2 kaw = lds_tr16(hc + S4_KAP + trrow + 16 * (lane & 3) + 64 * (b >> 1) + 8 * (b & 1));
                Cb[b] = MF16(mkfrag(kdw.x, kdw.y, 0u, 0u), Bv, Cb[b]);
                Cb[b] = MF16(mkfrag(kaw.x, kaw.y, 0u, 0u), Bn, Cb[b]);
            }
#pragma unroll
            for (int b = 0; b < 4; ++b) { const f32x4 pv = *(const LAS f32x4*)((LAS float*)(hc + S4_P15) + 16 * b + 4 * g); Cb[b] = Cb[b] * pv; }
            if (ch + 2 < NCH) SC_PASSA();
            } else {
            {
                const f32x4 yv = *(const LAS f32x4*)((LAS float*)(hb + S4_YB) + tB * 64 + k4);
                u32x2 w; w.x = pk2(yv[0], yv[1]); w.y = pk2(yv[2], yv[3]);
                *(u32x2*)(Yd + (rowb + scan_tok(d, ch * 16 + tB)) * D + h * 64 + k4) = w;
            }
            if (ch + 2 < NCH) SC_PASSB(ch + 2, pbo);
            __builtin_amdgcn_sched_barrier(0);
            if (ch + 1 < NCH) SC_PROD(pbo ^ S4_PBSZ);
            }
            }
            SC_BAR();
        }
#undef SC_LOAD
#undef SC_PASSA
#undef SC_PASSB
#undef SC_PROD
    }
}

__device__ __forceinline__ void phase_sgstats(const Frame& F, int layer) {
    const bf16_t* Z = F.ar<bf16_t>(AR_Z); float* ST = F.ar<float>(AR_ST);
    u32x4 nw[2][4];
#define SS_FETCH(R_) do { _Pragma("unroll") for (int h = 0; h < 2; ++h) _Pragma("unroll") for (int q = 0; q < 4; ++q) \
        nw[h][q] = *(const u32x4*)(Z + (size_t)((R_) + h) * 4096 + 2048 + q * 512 + F.lane * 8); } while (0)
    { const int rs = (F.bid * NWAVES + F.wave) * 2; if (rs < TG) SS_FETCH(rs); }
    for (int r0 = (F.bid * NWAVES + F.wave) * 2; r0 < TG; r0 += F.G * NWAVES * 2) {
        u32x4 w[2][4];
#pragma unroll
        for (int h = 0; h < 2; ++h)
#pragma unroll
            for (int q = 0; q < 4; ++q) w[h][q] = nw[h][q];
        if (r0 + F.G * NWAVES * 2 < TG) SS_FETCH(r0 + F.G * NWAVES * 2);
#pragma unroll
        for (int h = 0; h < 2; ++h) {
            const int r = r0 + h, t = r % LT; if (t < LC && layer >= 3) continue;
            float x[32];
#pragma unroll
            for (int q = 0; q < 4; ++q) { const u32x4 ww = w[h][q];
                x[q * 8 + 0] = lo16(ww.x); x[q * 8 + 1] = hi16(ww.x); x[q * 8 + 2] = lo16(ww.y); x[q * 8 + 3] = hi16(ww.y); x[q * 8 + 4] = lo16(ww.z); x[q * 8 + 5] = hi16(ww.z); x[q * 8 + 6] = lo16(ww.w); x[q * 8 + 7] = hi16(ww.w); }
            float s = 0.f;
#pragma unroll
            for (int e = 0; e < 32; ++e) s += x[e];
            s = wave_sum_dpp(s); const float mean = s * (1.0f / 2048.0f);
            float qv = 0.f;
#pragma unroll
            for (int e = 0; e < 32; ++e) { const float dd = x[e] - mean; qv += dd * dd; }
            qv = wave_sum_dpp(qv);
            if (F.lane == 0) *(f32x2*)(ST + (size_t)r * 2) = (f32x2){mean, rsqrtf(qv * (1.0f / 2048.0f) + 1e-5f)};
        }
    }
#undef SS_FETCH
}
__device__ __forceinline__ int vt_off(int dch, int jb) { return dch * 256 + ((jb ^ ((dch & 15) ^ (((dch >> 4) & 7) << 1))) << 4); }
__device__ __forceinline__ void phase_spatial(const Frame& F, int bsg, int layer) {
    const bf16_t* Z = F.ar<bf16_t>(AR_Z); const float* ST = F.ar<float>(AR_ST); bf16_t* Pb = F.ar<bf16_t>(AR_P);
    const bf16_t* Ws = F.wsp<bf16_t>(WS_WSP) + (size_t)bsg * 16 * 128 * 128;
    const float* lng = F.in(31) + (size_t)bsg * 2048; const float* lnb = F.in(32) + (size_t)bsg * 2048; const float* bs = F.in(34) + (size_t)bsg * 16 * 128;
    LAS unsigned char* vt = F.lds;
    const int skip = layer >= 3;
    const int nchunk = skip ? BG * 16 : BG * 18;
    const int w = F.wave, lane = F.lane, dt = w >> 1, it0 = (w & 1) * 2;
    const int jj0 = F.tid >> 4, c8 = (F.tid & 15) * 8;
    u32x4 zz[4]; f32x2 st[4];
#define SP_ROW0(U_) ((size_t)(skip ? (((U_) >> 4) >> 4) * 18 + 2 + (((U_) >> 4) & 15) : ((U_) >> 4)) * 128)
#define SP_LOADZ(U_) do { const size_t r0_ = SP_ROW0(U_); const int gi_ = (U_) & 15; _Pragma("unroll") for (int k = 0; k < 4; ++k) { \
        zz[k] = *(const u32x4*)(Z + (r0_ + jj0 + 32 * k) * 4096 + 2048 + gi_ * 128 + c8); st[k] = *(const f32x2*)(ST + (r0_ + jj0 + 32 * k) * 2); } } while (0)
    u32x2 nu[2][4];
#define SP_LOADU(U_) do { const size_t r0_ = SP_ROW0(U_); const int gi_ = (U_) & 15; _Pragma("unroll") for (int it = 0; it < 2; ++it) { const int ii_ = (it0 + it) * 32 + (lane & 31); \
        _Pragma("unroll") for (int rq = 0; rq < 4; ++rq) nu[it][rq] = *(const u32x2*)(Z + (r0_ + ii_) * 4096 + gi_ * 128 + dt * 32 + 8 * rq + 4 * (lane >> 5)); } } while (0)
    if (F.bid < nchunk * 16) { SP_LOADZ(F.bid); SP_LOADU(F.bid); }
    int gic = -1; float gg[8], bb[8], bias[2]; bf16x8 B0[8], B1[8];
#pragma unroll
    for (int e = 0; e < 8; ++e) { gg[e] = 0.f; bb[e] = 0.f; B0[e] = (bf16x8){0, 0, 0, 0, 0, 0, 0, 0}; B1[e] = B0[e]; }
    bias[0] = bias[1] = 0.f;
    int ub = 0;
    for (int U = F.bid; U < nchunk * 16; U += F.G) {
        LAS unsigned char* vtc = vt + ub * 32768; ub ^= 1;
        const int gi = U & 15;
        const size_t row0 = SP_ROW0(U);
        if (gi != gic) {
            gic = gi;
            const f32x4 g0 = *(const f32x4*)(lng + gi * 128 + c8), g1 = *(const f32x4*)(lng + gi * 128 + c8 + 4), b0 = *(const f32x4*)(lnb + gi * 128 + c8), b1 = *(const f32x4*)(lnb + gi * 128 + c8 + 4);
            gg[0] = g0[0]; gg[1] = g0[1]; gg[2] = g0[2]; gg[3] = g0[3]; gg[4] = g1[0]; gg[5] = g1[1]; gg[6] = g1[2]; gg[7] = g1[3];
            bb[0] = b0[0]; bb[1] = b0[1]; bb[2] = b0[2]; bb[3] = b0[3]; bb[4] = b1[0]; bb[5] = b1[1]; bb[6] = b1[2]; bb[7] = b1[3];
            const bf16_t* w0p = Ws + ((size_t)gi * 128 + it0 * 32 + (lane & 31)) * 128 + 8 * (lane >> 5);
#pragma unroll
            for (int s_ = 0; s_ < 8; ++s_) { B0[s_] = *(const bf16x8*)(w0p + 16 * s_); B1[s_] = *(const bf16x8*)(w0p + 32 * 128 + 16 * s_); }
#pragma unroll
            for (int it = 0; it < 2; ++it) bias[it] = bs[gi * 128 + (it0 + it) * 32 + (lane & 31)];
        }
#pragma unroll
        for (int k = 0; k < 4; ++k) {
            const int jj = jj0 + 32 * k;
            const float xv[8] = {lo16(zz[k].x), hi16(zz[k].x), lo16(zz[k].y), hi16(zz[k].y), lo16(zz[k].z), hi16(zz[k].z), lo16(zz[k].w), hi16(zz[k].w)};
#pragma unroll
            for (int e = 0; e < 8; e += 2) {
                const unsigned pw = pk2((xv[e] - st[k][0]) * st[k][1] * gg[e] + bb[e], (xv[e + 1] - st[k][0]) * st[k][1] * gg[e + 1] + bb[e + 1]);
                *(LAS unsigned short*)(vtc + vt_off(c8 + e, jj >> 3) + (jj & 7) * 2) = (unsigned short)(pw & 0xFFFFu);
                *(LAS unsigned short*)(vtc + vt_off(c8 + e + 1, jj >> 3) + (jj & 7) * 2) = (unsigned short)(pw >> 16);
            }
        }
        u32x2 uu[2][4];
#pragma unroll
        for (int it = 0; it < 2; ++it)
#pragma unroll
            for (int rq = 0; rq < 4; ++rq) uu[it][rq] = nu[it][rq];
        if (U + F.G < nchunk * 16) { SP_LOADZ(U + F.G); SP_LOADU(U + F.G); }
        LDS_BAR();
        f32x16 acc0, acc1;
#pragma unroll
        for (int e = 0; e < 16; ++e) { acc0[e] = 0.f; acc1[e] = 0.f; }
        const int dA = dt * 32 + (lane & 31);
#pragma unroll
        for (int s_ = 0; s_ < 8; ++s_) {
            const bf16x8 Afr = *(const LAS bf16x8*)(vtc + vt_off(dA, 2 * s_ + (lane >> 5)));
            acc0 = __builtin_amdgcn_mfma_f32_32x32x16_bf16(Afr, B0[s_], acc0, 0, 0, 0);
            acc1 = __builtin_amdgcn_mfma_f32_32x32x16_bf16(Afr, B1[s_], acc1, 0, 0, 0);
        }
#pragma unroll
        for (int it = 0; it < 2; ++it) {
            const int ii = (it0 + it) * 32 + (lane & 31); const size_t row = row0 + ii;
            unsigned xw[4];
#pragma unroll
            for (int rq = 0; rq < 4; ++rq) {
                float vs[4];
#pragma unroll
                for (int e = 0; e < 4; ++e) vs[e] = (it == 0 ? acc0[rq * 4 + e] : acc1[rq * 4 + e]) + bias[it];
                xw[rq] = pk4_f8(lo16(uu[it][rq].x) * vs[0] * 4.f, hi16(uu[it][rq].x) * vs[1] * 4.f, lo16(uu[it][rq].y) * vs[2] * 4.f, hi16(uu[it][rq].y) * vs[3] * 4.f);
            }
            const auto s02 = __builtin_amdgcn_permlane32_swap(xw[0], xw[2], false, false), s13 = __builtin_amdgcn_permlane32_swap(xw[1], xw[3], false, false);
            *(u32x4*)((unsigned char*)Pb + row * 2048 + gi * 128 + dt * 32 + 16 * (lane >> 5)) = (u32x4){s02[0], s02[1], s13[0], s13[1]};
        }
    }
#undef SP_ROW0
#undef SP_LOADZ
#undef SP_LOADU
    __syncthreads();
}

__global__ void __launch_bounds__(NTHREADS, 2) fwd_kernel(Params P) {
    extern __shared__ __attribute__((aligned(16))) unsigned char lds_raw[];
    Frame F; F.lds = (LAS unsigned char*)lds_raw; F.tid = threadIdx.x; F.lane = F.tid & 63; F.wave = __builtin_amdgcn_readfirstlane(F.tid >> 6);
    F.G = gridDim.x; F.bid = blockIdx.x; F.ws = P.ws; F.kp = (const Params __attribute__((address_space(4)))*)__builtin_amdgcn_kernarg_segment_ptr();
    const int lo = P.ph_lo, hi = P.ph_hi;
    volatile LAS unsigned* misc = (volatile LAS unsigned*)(F.lds + LDS_MISC);
    if (F.tid < 4) misc[F.tid] = 0u;
    __syncthreads();
    XcdBarrier bar; bar.bar = (unsigned*)(F.ws + WS_CTL); bar.x = 0; bar.st = misc;
    if (hi - lo > 1) bar = xcd_barrier_post((unsigned*)(F.ws + WS_CTL), misc);
    int ph = 0;
#define RUN(id, ...) do { if (ph >= lo && ph < hi) { const int nrep_ = ((REP_MASK >> (id)) & 1u) ? 2 : 1; for (int rep_ = 0; rep_ < nrep_; ++rep_) { const bool dry_ = (rep_ + 1 < nrep_); (void)dry_; { int t_ = threadIdx.x; const Params __attribute__((address_space(4)))* kp_ = (const Params __attribute__((address_space(4)))*)__builtin_amdgcn_kernarg_segment_ptr(); asm volatile("" : "+v"(t_), "+s"(kp_)); F.tid = t_; F.lane = t_ & 63; F.kp = kp_; F.ws = kp_->ws; } __VA_ARGS__; if (rep_ + 1 < nrep_ || ph + 1 < hi) xcd_barrier(bar); } } ++ph; } while (0)

    RUN(0, phase_prologue(F));
    for (int g = 0; g < NG; ++g) {
        for (int layer = 0; layer < 4; ++layer) {
            const int a = layer >> 1;
            if ((layer & 1) == 0) {
                const bf16_t* Vc = layer == 0 ? F.wsp<bf16_t>(WS_VF) : F.ar<bf16_t>(AR_V);
                RUN(1, {
                      phase_norm1(F, g, layer, F.ar<bf16_t>(AR_H2), 2048, dry_); });
                RUN(2, phase_mix(F, a));
                RUN(3, { { pg8::SchedPlain S; S.init(TG / 256, 2, F.G, F.bid, 0);
                        EpiL1 E{F.ar<bf16_t>(AR_L1)};
                        pg8::gemm_phase(F.tid, F.lds, F.ar<bf16_t>(AR_H2), K1CAT, F.wsp<bf16_t>(WS_WL) + (size_t)a * 512 * K1CAT, K1CAT, K1CAT, pg8::make_list(F.tid, F.lds, S), E); }
                      { int t_ = threadIdx.x; asm volatile("" : "+v"(t_)); F.tid = t_; F.lane = t_ & 63; }
                      { pg8::SchedRKV S; S.init(TG / 256, 12, F.G, F.bid, 0);
                        EpiRKV E{F.ws, layer == 0 ? WS_VF : WS_ARENA + AR_V};
                        pg8::gemm_phase(F.tid, F.lds, F.ar<bf16_t>(AR_XR), D, F.wsp<bf16_t>(WS_WRKV) + (size_t)a * 3072 * D, D, D, pg8::make_list(F.tid, F.lds, S), E); } });
                if (layer == 2) {
                    RUN(4, { int kg_ = 128; asm volatile("" : "+s"(kg_));
                          pg8::SchedPlain S; S.init(TG / 256, 4, F.G, F.bid, 0);
                          EpiStore<1> E{F.ar<bf16_t>(AR_VGATE), F.in(19)};
                          pg8::gemm_phase(F.tid, F.lds, F.ar<bf16_t>(AR_L1) + 384, 512, F.wsp<bf16_t>(WS_V2T) + 128, 256, kg_, pg8::make_list(F.tid, F.lds, S), E); });
                    RUN(5, phase_vfix(F));
                }
                RUN(6, phase_scan4(F, a, Vc));
                RUN(7, { int kg_ = 128; asm volatile("" : "+s"(kg_));
                      const int skipg = layer == 2;
                      pg8::SchedPlain S; S.init(skipg ? BG * 8 : TG / 256, 4, F.G, F.bid, skipg);
                      EpiStore<0> E{F.ar<bf16_t>(AR_G), nullptr};
                      pg8::gemm_phase(F.tid, F.lds, F.ar<bf16_t>(AR_L1) + 256, 512, F.wsp<bf16_t>(WS_G2T) + (size_t)a * D * 256, 256, kg_, pg8::make_list(F.tid, F.lds, S), E); });
                RUN(8, phase_post(F, a, Vc, layer == 2));
                RUN(9, { const int skip = layer == 2; pg8::SchedPlain S; S.init(skip ? BG * 8 : TG / 256, 4, F.G, F.bid, skip);
                      EpiStore<0> E{F.ar<bf16_t>(AR_O), nullptr, 1.0f / 256.0f};
                      int k8_ = D / 2; asm volatile("" : "+s"(k8_));
                      pg8::gemm_phase<EpiStore<0>, pg8::SchedList<pg8::SchedPlain>, true>(F.tid, F.lds, F.ar<bf16_t>(AR_R), k8_, (const bf16_t*)(F.ws + WS_WO + (size_t)a * D * D), k8_, k8_, pg8::make_list(F.tid, F.lds, S), E); });
            } else {
                const int skip = layer == 3;
                RUN(10, phase_norm1(F, g, layer, F.ar<bf16_t>(AR_H), D, dry_, true));
                RUN(11, { int k8_ = D / 2; asm volatile("" : "+s"(k8_));
                      pg8::SchedPlain S; S.init(skip ? BG * 8 : TG / 256, 16, F.G, F.bid, skip);
                      EpiGelu E{F.ar<bf16_t>(AR_Z), F.in(30) + (size_t)a * 4096, 1.0f / 256.0f};
                      pg8::gemm_phase<EpiGelu, pg8::SchedList<pg8::SchedPlain>, true>(F.tid, F.lds, F.ar<bf16_t>(AR_H), k8_, (const bf16_t*)(F.ws + WS_WIN + (size_t)a * 4096 * D), k8_, k8_, pg8::make_list(F.tid, F.lds, S), E); });
                RUN(12, phase_sgstats(F, layer));
                RUN(13, phase_spatial(F, a, layer));
                RUN(14, { pg8::SchedPlain S; S.init(skip ? BG * 8 : TG / 256, 4, F.G, F.bid, skip);
                      EpiStore<0> E{F.ar<bf16_t>(AR_O), nullptr, 1.0f / 256.0f};
                      int k8_ = 1024; asm volatile("" : "+s"(k8_));
                      pg8::gemm_phase<EpiStore<0>, pg8::SchedList<pg8::SchedPlain>, true>(F.tid, F.lds, F.ar<bf16_t>(AR_P), k8_, (const bf16_t*)(F.ws + WS_WOUT + (size_t)a * D * 2048), k8_, k8_, pg8::make_list(F.tid, F.lds, S), E); });
            }
            RUN(15, phase_norm2(F, g, layer, dry_));
            RUN(16, { const int total = moe_tables(F, g, layer);
                  pg8::SchedMoe<true> S{(const LAS int*)(F.lds + LDS_MISC + 64), (const LAS int*)(F.lds + LDS_MISC + 192), F.ar<int>(AR_LIST), F.G, F.bid, total};
                  EpiMG E{(unsigned char*)F.ar<bf16_t>(AR_HE), 1.0f / 256.0f};
                  int k8_ = D / 2; asm volatile("" : "+s"(k8_));
                  pg8::gemm_phase<EpiMG, pg8::SchedList<pg8::SchedMoe<true>>, true>(F.tid, F.lds, F.ar<bf16_t>(AR_HM), k8_, (const bf16_t*)(F.ws + WS_WGU + (size_t)layer * NEXP * 1024 * D), k8_, k8_, pg8::make_list(F.tid, F.lds, S), E); });
            RUN(17, { const int total = (PER_PHASE_LAUNCH || REP_MASK) ? moe_tables(F, g, layer) : __builtin_amdgcn_readfirstlane(((const LAS int*)(F.lds + LDS_MISC + 192))[32]);
                  pg8::SchedMoe<false> S{(const LAS int*)(F.lds + LDS_MISC + 64), (const LAS int*)(F.lds + LDS_MISC + 192), F.ar<int>(AR_LIST), F.G, F.bid, total};
                  EpiMD E{F.ar<bf16_t>(AR_YM0), F.ar<int>(AR_LIST), F.ar<float>(AR_LW), (const LAS int*)(F.lds + LDS_MISC + 64), 1.0f / 512.0f, {}, {}};
                  int k8_ = FEXP / 2; asm volatile("" : "+s"(k8_));
                  pg8::gemm_phase<EpiMD, pg8::SchedList<pg8::SchedMoe<false>>, true>(F.tid, F.lds, F.ar<bf16_t>(AR_HE), k8_, (const bf16_t*)(F.ws + WS_WD + (size_t)layer * NEXP * D * FEXP), k8_, k8_, pg8::make_list(F.tid, F.lds, S), E); });
        }
        RUN(18, phase_norm1(F, g, 4, nullptr, 0));
    }
#undef RUN
}
constexpr int NPHASES = 1 + NG * (10 + 8 + 12 + 8 + 1);

__global__ void nan_fill(float* out, size_t n) { for (size_t i = (size_t)blockIdx.x * blockDim.x + threadIdx.x; i < n; i += (size_t)gridDim.x * blockDim.x) out[i] = __uint_as_float(0x7FC00000u); }

extern "C" void kernel_launch(void* const* d_in, const int* in_sizes, int n_in, void* d_out, int out_size, void* d_ws, size_t ws_size, hipStream_t stream) {
    static int grid = 0;
    if (grid == 0) {
        int dev = 0, cus = 0, per_cu = 0;
        if (n_in != 42 || ws_size < WS_END || hipGetDevice(&dev) != hipSuccess || hipDeviceGetAttribute(&cus, hipDeviceAttributeMultiprocessorCount, dev) != hipSuccess) {
            fprintf(stderr, "kernel_launch: bad setup (n_in %d, ws %zu need %zu)\n", n_in, ws_size, (size_t)WS_END); grid = -1;
        } else if (hipFuncSetAttribute((const void*)fwd_kernel, hipFuncAttributeMaxDynamicSharedMemorySize, LDS_BYTES) != hipSuccess) { fprintf(stderr, "kernel_launch: hipFuncSetAttribute failed\n"); grid = -1; }
        else {
            if (hipOccupancyMaxActiveBlocksPerMultiprocessor(&per_cu, (const void*)fwd_kernel, NTHREADS, LDS_BYTES) != hipSuccess || per_cu < 1) { fprintf(stderr, "kernel_launch: occupancy query reports %d\n", per_cu); }
            (void)hipGetLastError();
            grid = cus;
        }
    }
    if (grid < 0) { hipLaunchKernelGGL(nan_fill, dim3(1024), dim3(256), 0, stream, (float*)d_out, (size_t)out_size); return; }
    (void)hipMemsetAsync((char*)d_ws + WS_CTL, 0, CTL_BYTES, stream);
    Params p{};
    for (int i = 0; i < 42; ++i) p.in[i] = (const float*)d_in[i];
    p.out = (float*)d_out; p.ws = (unsigned char*)d_ws;
#if PER_PHASE_LAUNCH
    for (int k = 0; k < NPHASES; ++k) { p.ph_lo = k; p.ph_hi = k + 1; hipLaunchKernelGGL(fwd_kernel, dim3(grid), dim3(NTHREADS), LDS_BYTES, stream, p); }
#else
    p.ph_lo = 0; p.ph_hi = NPHASES;
    hipLaunchKernelGGL(fwd_kernel, dim3(grid), dim3(NTHREADS), LDS_BYTES, stream, p);
#endif
}
```
